# Optimizing an MI355X kernel written in HIP

```python
import math
import jax, jax.numpy as jnp
from jax import lax
import numpy as np

D_MODEL = 2048
BATCH = 16
SEQ = 256
DEPTH = 4
DEC_BATCH = 4
DEC_SEQ = 2048
PAST_LEN = 512

GRID_W = 64
WIN_H = 8
WIN_W = 16
NA_H = 8
NA_HD = 64
NA_W = NA_H * NA_HD
S5_W = 512
S5_GS = 16
S5_G = S5_W // S5_GS
S5_N = 64
SSD_W = 512
SSD_P = 64
SSD_H = SSD_W // SSD_P
SSD_NG = 2
SSD_N = 128
SSD_CONV = 5
SSD_XBC = SSD_W + 2 * SSD_NG * SSD_N
ML_H = 4
ML_DK = 128
ML_W = ML_H * ML_DK
N_BRANCH = 4
BRANCH_W = 512
D_FF = 4 * D_MODEL
CHUNK = 128
ROPE_THETA = 10000.0
EPS = 1e-6
IN_SPLITS = (NA_W, NA_W, NA_W, S5_W, SSD_W, SSD_XBC, 2 * SSD_H,
             ML_W, ML_W, ML_W, ML_W, 2 * ML_H, 2 * ML_H, N_BRANCH * D_MODEL)
IN_DIM = sum(IN_SPLITS)

kernel_name = "hybrid_diffusion_na_s5_ssd_mlstm_step"

F32 = jnp.float32


def _split_points():
    return [int(v) for v in np.cumsum(IN_SPLITS)[:-1]]


def rmsnorm(x, g):
    xf = x.astype(F32)
    y = xf * lax.rsqrt(jnp.mean(xf * xf, axis=-1, keepdims=True) + EPS)
    return y.astype(x.dtype) * g


def _rot_axis(x, pos):
    half = x.shape[-1] // 2
    inv = ROPE_THETA ** (-jnp.arange(half, dtype=F32) / half)
    ang = pos.astype(F32)[:, None] * inv[None, :]
    cos = jnp.cos(ang)[None, :, None, :].astype(x.dtype)
    sin = jnp.sin(ang)[None, :, None, :].astype(x.dtype)
    x1, x2 = x[..., :half], x[..., half:]
    return jnp.concatenate([x1 * cos - x2 * sin, x1 * sin + x2 * cos], axis=-1)


def rope_2d(x):
    L = x.shape[1]
    t = jnp.arange(L)
    a = x.shape[-1] // 2
    return jnp.concatenate([_rot_axis(x[..., :a], t // GRID_W),
                            _rot_axis(x[..., a:], t % GRID_W)], axis=-1)


def dense_context_attention(q, k, v):
    B, S, H, d = q.shape
    nb = S // CHUNK
    scale = d ** -0.5
    qb = q.reshape(B, nb, CHUNK, H, d).transpose(1, 0, 2, 3, 4)

    def block(qi):
        s = jnp.einsum('bqhd,bshd->bhqs', qi, k).astype(F32) * scale
        p = jax.nn.softmax(s, axis=-1).astype(v.dtype)
        return jnp.einsum('bhqs,bshd->bqhd', p, v)

    o = lax.map(block, qb)
    return o.transpose(1, 0, 2, 3, 4).reshape(B, S, H, d)


def neighbourhood_attention(q, k, v, k_ctx, v_ctx, rpb):
    B, L, H, d = q.shape
    R = L // GRID_W
    kh = min(WIN_H, R)
    scale = d ** -0.5
    qg = q.reshape(B, R, GRID_W, H, d)
    kg = k.reshape(B, R, GRID_W, H, d)
    vg = v.reshape(B, R, GRID_W, H, d)
    rows = jnp.arange(R)
    r_start = jnp.clip(rows - kh // 2, 0, R - kh)
    cols = jnp.arange(GRID_W)
    c_start = jnp.clip(cols - WIN_W // 2, 0, GRID_W - WIN_W)
    col_idx = c_start[:, None] + jnp.arange(WIN_W)[None, :]
    dc = col_idx - cols[:, None]
    onehot = (col_idx[:, :, None] == cols[None, None, :]).astype(v.dtype)
    gather_idx = jnp.broadcast_to(col_idx[None, :, None, None, :], (B, GRID_W, H, kh, WIN_W))
    rpb_c = rpb[:, :, dc + WIN_W - 1]
    n_win = kh * WIN_W

    def row_block(args):
        q_r, rs, r = args
        k_band = lax.dynamic_slice_in_dim(kg, rs, kh, axis=1)
        v_band = lax.dynamic_slice_in_dim(vg, rs, kh, axis=1)
        s_band = jnp.einsum('bqhd,bjkhd->bqhjk', q_r, k_band).astype(F32) * scale
        s_win = jnp.take_along_axis(s_band, gather_idx, axis=-1)
        dr = rs + jnp.arange(kh) - r
        bias = rpb_c[:, dr + WIN_H - 1].transpose(2, 0, 1, 3)
        s_win = s_win + bias[None].astype(F32)
        s_ctx = jnp.einsum('bqhd,bshd->bqhs', q_r, k_ctx).astype(F32) * scale
        s = jnp.concatenate([s_win.reshape(B, GRID_W, H, n_win), s_ctx], axis=-1)
        p = jax.nn.softmax(s, axis=-1).astype(v.dtype)
        p_win = p[..., :n_win].reshape(B, GRID_W, H, kh, WIN_W)
        p_band = jnp.einsum('bqhjw,qwk->bqhjk', p_win, onehot)
        return (jnp.einsum('bqhjk,bjkhd->bqhd', p_band, v_band)
                + jnp.einsum('bqhs,bshd->bqhd', p[..., n_win:], v_ctx))

    o = lax.map(row_block, (qg.transpose(1, 0, 2, 3, 4), r_start, rows))
    return o.transpose(1, 0, 2, 3, 4).reshape(B, L, H, d)


def _s5_direction(u, a_re, a_im, log_dt, b_re, b_im, c_re, c_im, h0_re, h0_im):
    a_re = jnp.minimum(a_re.astype(F32), -1e-4)
    a_im = a_im.astype(F32)
    dt = jnp.exp(log_dt.astype(F32))[:, None]
    mag = jnp.exp(dt * a_re)
    ab_re = mag * jnp.cos(dt * a_im)
    ab_im = mag * jnp.sin(dt * a_im)
    den = a_re * a_re + a_im * a_im
    nr = ab_re - 1.0
    coef_re = (nr * a_re + ab_im * a_im) / den
    coef_im = (ab_im * a_re - nr * a_im) / den
    b_re = b_re.astype(F32)
    b_im = b_im.astype(F32)
    bb_re = coef_re[..., None] * b_re - coef_im[..., None] * b_im
    bb_im = coef_re[..., None] * b_im + coef_im[..., None] * b_re
    bu_re = jnp.einsum('blgk,gnk->blgn', u, bb_re)
    bu_im = jnp.einsum('blgk,gnk->blgn', u, bb_im)
    h0_re = h0_re.astype(F32)
    h0_im = h0_im.astype(F32)
    bu_re = bu_re.at[:, 0].add(ab_re * h0_re - ab_im * h0_im)
    bu_im = bu_im.at[:, 0].add(ab_re * h0_im + ab_im * h0_re)
    a_re_b = jnp.broadcast_to(ab_re, bu_re.shape)
    a_im_b = jnp.broadcast_to(ab_im, bu_re.shape)

    def combine(e1, e2):
        a1r, a1i, b1r, b1i = e1
        a2r, a2i, b2r, b2i = e2
        return (a2r * a1r - a2i * a1i, a2r * a1i + a2i * a1r,
                a2r * b1r - a2i * b1i + b2r, a2r * b1i + a2i * b1r + b2i)

    _, _, h_re, h_im = lax.associative_scan(combine, (a_re_b, a_im_b, bu_re, bu_im), axis=1)
    y = (jnp.einsum('blgn,gkn->blgk', h_re, c_re.astype(F32))
         - jnp.einsum('blgn,gkn->blgk', h_im, c_im.astype(F32)))
    return y, h_re[:, -1], h_im[:, -1]


def s5_mixer(u, P, h0_re, h0_im):
    B, L, _ = u.shape
    uf = u.astype(F32)
    ug = uf.reshape(B, L, S5_G, S5_GS)
    ys, fr, fi = [], [], []
    for d in range(2):
        ud = ug if d == 0 else jnp.flip(ug, axis=1)
        y, hr, hi = _s5_direction(ud, P['s5_a_re'][d], P['s5_a_im'][d], P['s5_log_dt'][d],
                                  P['s5_b_re'][d], P['s5_b_im'][d], P['s5_c_re'][d],
                                  P['s5_c_im'][d], h0_re[:, d], h0_im[:, d])
        ys.append(y if d == 0 else jnp.flip(y, axis=1))
        fr.append(hr)
        fi.append(hi)
    y = (ys[0] + ys[1]).reshape(B, L, S5_W) + uf * P['s5_d'].astype(F32)
    z = jax.nn.gelu(y)
    out = z * jax.nn.sigmoid(z @ P['s5_w_glu'].astype(F32) + P['s5_b_glu'].astype(F32))
    return out.astype(u.dtype), jnp.stack(fr, axis=1), jnp.stack(fi, axis=1)


def _ssd_direction(x, la, bh, ch, h0):
    B, L, H, P = x.shape
    N = bh.shape[-1]
    nc = L // CHUNK
    xc = x.reshape(B, nc, CHUNK, H, P)
    bc = bh.reshape(B, nc, CHUNK, H, N)
    cc = ch.reshape(B, nc, CHUNK, H, N)
    acs = jnp.cumsum(la.reshape(B, nc, CHUNK, H), axis=2)
    seg = acs[:, :, :, None, :] - acs[:, :, None, :, :]
    tril = jnp.tril(jnp.ones((CHUNK, CHUNK), dtype=bool))[None, None, :, :, None]
    lmat = jnp.exp(jnp.where(tril, seg, -jnp.inf))
    scores = jnp.einsum('bcthn,bcshn->bctsh', cc, bc) * lmat
    y_diag = jnp.einsum('bctsh,bcshp->bcthp', scores, xc)
    decay_s = jnp.exp(acs[:, :, -1:, :] - acs)
    chunk_states = jnp.einsum('bclhn,bclh,bclhp->bchpn', bc, decay_s, xc)
    chunk_decay = jnp.exp(acs[:, :, -1, :])

    def step(h, xs):
        dec, st = xs
        return dec[..., None, None] * h + st, h

    h_final, starts = lax.scan(step, h0.astype(F32),
                               (chunk_decay.transpose(1, 0, 2), chunk_states.transpose(1, 0, 2, 3, 4)))
    starts = starts.transpose(1, 0, 2, 3, 4)
    y_off = jnp.einsum('bclhn,bchpn,bclh->bclhp', cc, starts, jnp.exp(acs))
    return (y_diag + y_off).reshape(B, L, H, P), h_final


def ssd_mixer(z, xbc, dt_raw, P, h0):
    B, L, _ = z.shape
    pad = SSD_CONV // 2
    xbc = lax.conv_general_dilated(xbc, P['ssd_conv_w'][:, None, :].astype(xbc.dtype), (1,),
                                   [(pad, pad)], dimension_numbers=('NWC', 'WIO', 'NWC'),
                                   feature_group_count=SSD_XBC) + P['ssd_conv_b']
    xbc = jax.nn.silu(xbc.astype(F32))
    x, bg, cg = jnp.split(xbc, [SSD_W, SSD_W + SSD_NG * SSD_N], axis=-1)
    x = x.reshape(B, L, SSD_H, SSD_P)
    hpg = SSD_H // SSD_NG
    bh = jnp.repeat(bg.reshape(B, L, SSD_NG, SSD_N), hpg, axis=2)
    ch = jnp.repeat(cg.reshape(B, L, SSD_NG, SSD_N), hpg, axis=2)
    dt_raw = dt_raw.reshape(B, L, 2, SSD_H).astype(F32)
    ys, finals = [], []
    for d in range(2):
        dt = jax.nn.softplus(dt_raw[:, :, d] + P['ssd_dt_bias'][d].astype(F32))
        la = dt * (-jnp.exp(P['ssd_a_log'][d].astype(F32)))
        xdt = x * dt[..., None]
        if d == 0:
            y, hf = _ssd_direction(xdt, la, bh, ch, h0[:, d])
        else:
            y, hf = _ssd_direction(jnp.flip(xdt, 1), jnp.flip(la, 1), jnp.flip(bh, 1),
                                   jnp.flip(ch, 1), h0[:, d])
            y = jnp.flip(y, 1)
        ys.append(y)
        finals.append(hf)
    y = ys[0] + ys[1] + x * P['ssd_d'].astype(F32)[:, None]
    y = y.reshape(B, L, SSD_W) * jax.nn.silu(z.astype(F32))
    return rmsnorm(y, P['ssd_norm_g']).astype(z.dtype), jnp.stack(finals, axis=1)


def _mlstm_direction(q, k, v, ig, lf, c0, n0, m0):
    B, L, H, dk = q.shape
    dv = v.shape[-1]
    nc = L // CHUNK
    qc = q.reshape(B, nc, CHUNK, H, dk)
    kc = k.reshape(B, nc, CHUNK, H, dk)
    vc = v.reshape(B, nc, CHUNK, H, dv)
    igc = ig.reshape(B, nc, CHUNK, H)
    bcum = jnp.cumsum(lf.reshape(B, nc, CHUNK, H), axis=2)
    blast = bcum[:, :, -1]
    w = blast[:, :, None] - bcum + igc
    m_loc = jnp.max(w, axis=2)
    e = jnp.exp(w - m_loc[:, :, None])
    c_loc = jnp.einsum('bclh,bclhk,bclhv->bchkv', e, kc, vc)
    n_loc = jnp.einsum('bclh,bclhk->bchk', e, kc)

    def step(carry, xs):
        c, n, m = carry
        bl, ml, cl, nl = xs
        m_new = jnp.maximum(bl + m, ml)
        a = jnp.exp(bl + m - m_new)
        b = jnp.exp(ml - m_new)
        c_new = a[..., None, None] * c + b[..., None, None] * cl
        n_new = a[..., None] * n + b[..., None] * nl
        return (c_new, n_new, m_new), (c, n, m)

    (cf, nf, mf), (cs, ns, ms) = lax.scan(
        step, (c0.astype(F32), n0.astype(F32), m0.astype(F32)),
        (blast.transpose(1, 0, 2), m_loc.transpose(1, 0, 2),
         c_loc.transpose(1, 0, 2, 3, 4), n_loc.transpose(1, 0, 2, 3)))
    cs = cs.transpose(1, 0, 2, 3, 4)
    ns = ns.transpose(1, 0, 2, 3)
    ms = ms.transpose(1, 0, 2)
    bt = bcum.transpose(0, 1, 3, 2)
    it = igc.transpose(0, 1, 3, 2)
    tril = jnp.tril(jnp.ones((CHUNK, CHUNK), dtype=bool))
    logd = jnp.where(tril, bt[..., :, None] - bt[..., None, :] + it[..., None, :], -jnp.inf)
    a_inter = bt + ms[..., None]
    m_t = jnp.maximum(a_inter, jnp.max(logd, axis=-1))
    s = jnp.einsum('bcthk,bcshk->bchts', qc, kc) * jnp.exp(logd - m_t[..., None])
    sc_inter = jnp.exp(a_inter - m_t)
    num = (jnp.einsum('bchts,bcshv->bcthv', s, vc)
           + sc_inter.transpose(0, 1, 3, 2)[..., None] * jnp.einsum('bcthk,bchkv->bcthv', qc, cs))
    den = jnp.sum(s, axis=-1) + sc_inter * jnp.einsum('bcthk,bchk->bcht', qc, ns)
    den = jnp.maximum(jnp.abs(den), jnp.exp(-m_t))
    h = num / den.transpose(0, 1, 3, 2)[..., None]
    return h.reshape(B, L, H, dv), cf, nf, mf


def mlstm_mixer(q, k, v, o, i_pre, f_pre, P, c0, n0, m0, latent):
    B, L, _ = q.shape
    q = q.reshape(B, L, ML_H, ML_DK)
    k = k.reshape(B, L, ML_H, ML_DK)
    v = v.reshape(B, L, ML_H, ML_DK).astype(F32)
    if latent:
        q = rope_2d(q)
        k = rope_2d(k)
    q = q.astype(F32)
    k = k.astype(F32) * (ML_DK ** -0.5)
    i_pre = i_pre.reshape(B, L, 2, ML_H).astype(F32)
    f_pre = f_pre.reshape(B, L, 2, ML_H).astype(F32)
    hs, cfs, nfs, mfs = [], [], [], []
    for d in range(2):
        ig = i_pre[:, :, d] + P['ml_i_bias'][d].astype(F32)
        lf = jax.nn.log_sigmoid(f_pre[:, :, d] + P['ml_f_bias'][d].astype(F32))
        if d == 0:
            h, cf, nf, mf = _mlstm_direction(q, k, v, ig, lf, c0[:, d], n0[:, d], m0[:, d])
        else:
            h, cf, nf, mf = _mlstm_direction(jnp.flip(q, 1), jnp.flip(k, 1), jnp.flip(v, 1),
                                             jnp.flip(ig, 1), jnp.flip(lf, 1),
                                             c0[:, d], n0[:, d], m0[:, d])
            h = jnp.flip(h, 1)
        hs.append(h)
        cfs.append(cf)
        nfs.append(nf)
        mfs.append(mf)
    h = rmsnorm(hs[0] + hs[1], P['ml_norm_g'].reshape(ML_H, ML_DK).astype(F32))
    out = h.reshape(B, L, ML_W) * jax.nn.sigmoid(o.astype(F32))
    return (out.astype(o.dtype), jnp.stack(cfs, axis=1), jnp.stack(nfs, axis=1),
            jnp.stack(mfs, axis=1))


def trunk_layer(x, cvec, P, ctx_kv, init, latent):
    B, L, _ = x.shape
    mod = jax.nn.silu(cvec) @ P['w_ada'] + P['b_ada']
    sh1, sc1, g1, sh2, sc2, g2 = jnp.split(mod[:, None, :], 6, axis=-1)
    h = rmsnorm(x, P['norm1_g']) * (1 + sc1) + sh1
    proj = h @ P['w_in']
    (na_q, na_k, na_v, s5_u, ssd_z, ssd_xbc, ssd_dt, ml_q, ml_k, ml_v, ml_o, ml_i, ml_f,
     gate_pre) = jnp.split(proj, _split_points(), axis=-1)
    q = rmsnorm(na_q.reshape(B, L, NA_H, NA_HD), P['na_qn_g'])
    k = rmsnorm(na_k.reshape(B, L, NA_H, NA_HD), P['na_kn_g'])
    v = na_v.reshape(B, L, NA_H, NA_HD)
    if latent:
        a_out = neighbourhood_attention(q, k, v, ctx_kv[0], ctx_kv[1], P['na_rpb'])
    else:
        a_out = dense_context_attention(q, k, v)
    s5_re0, s5_im0, ssd0, mc0, mn0, mm0 = init
    b_out, s5_re, s5_im = s5_mixer(s5_u, P, s5_re0, s5_im0)
    c_out, ssd_h = ssd_mixer(ssd_z, ssd_xbc, ssd_dt, P, ssd0)
    d_out, mc, mn, mm = mlstm_mixer(ml_q, ml_k, ml_v, ml_o, ml_i, ml_f, P, mc0, mn0, mm0, latent)
    branches = jnp.stack([a_out.reshape(B, L, NA_W), b_out, c_out, d_out], axis=0)
    up = jnp.einsum('kbli,kid->blkd', branches, P['w_branch'])
    gates = jax.nn.sigmoid(gate_pre.reshape(B, L, N_BRANCH, D_MODEL).astype(F32))
    merged = jnp.sum(up * gates, axis=2).astype(x.dtype)
    x = x + g1 * (merged @ P['w_out'])
    h2 = rmsnorm(x, P['norm2_g']) * (1 + sc2) + sh2
    x = x + g2 * (jnp.square(jax.nn.relu(h2 @ P['w_mlp1'])) @ P['w_mlp2'])
    return x, (k, v, s5_re, s5_im, ssd_h, mc, mn, mm)


def setup_inputs(seed: int = 0) -> dict:
    key = jax.random.key(seed)
    ks = iter(jax.random.split(key, 64))

    def nrm(shape, s):
        return jax.random.normal(next(ks), shape, F32) * s

    def unif(shape, lo, hi):
        return jax.random.uniform(next(ks), shape, F32, minval=lo, maxval=hi)

    x_prompt = nrm((BATCH, SEQ, D_MODEL), 1.0)
    x_sample = nrm((DEC_BATCH, DEC_SEQ, D_MODEL), 1.0)
    cache_na_k = nrm((DEC_BATCH, DEPTH, PAST_LEN, NA_H, NA_HD), 1.0)
    cache_na_v = nrm((DEC_BATCH, DEPTH, PAST_LEN, NA_H, NA_HD), 1.0)
    state_s5_re = nrm((DEC_BATCH, DEPTH, 2, S5_G, S5_N), 0.5)
    state_s5_im = nrm((DEC_BATCH, DEPTH, 2, S5_G, S5_N), 0.5)
    state_ssd = nrm((DEC_BATCH, DEPTH, 2, SSD_H, SSD_P, SSD_N), 0.1)
    state_ml_c = nrm((DEC_BATCH, DEPTH, 2, ML_H, ML_DK, ML_DK), 0.1)
    state_ml_n = nrm((DEC_BATCH, DEPTH, 2, ML_H, ML_DK), 0.1)
    state_ml_m = nrm((DEC_BATCH, DEPTH, 2, ML_H), 0.5)
    c = nrm((DEC_BATCH, D_MODEL), 1.0)
    c_ctx = nrm((D_MODEL,), 1.0)
    w_ada = nrm((DEPTH, D_MODEL, 6 * D_MODEL), 0.5 * D_MODEL ** -0.5)
    b_ada = nrm((DEPTH, 6 * D_MODEL), 0.02)
    norm1_g = 1.0 + nrm((DEPTH, D_MODEL), 0.02)
    norm2_g = 1.0 + nrm((DEPTH, D_MODEL), 0.02)
    w_in = nrm((DEPTH, D_MODEL, IN_DIM), D_MODEL ** -0.5)
    na_qn_g = 1.0 + nrm((DEPTH, NA_HD), 0.02)
    na_kn_g = 1.0 + nrm((DEPTH, NA_HD), 0.02)
    na_rpb = nrm((DEPTH, NA_H, 2 * WIN_H - 1, 2 * WIN_W - 1), 0.1)
    s5_a_re = -0.5 + nrm((DEPTH, 2, S5_G, S5_N), 0.01)
    s5_a_im = math.pi * jnp.arange(S5_N, dtype=F32) + nrm((DEPTH, 2, S5_G, S5_N), 0.01)
    s5_log_dt = unif((DEPTH, 2, S5_G), math.log(1e-3), math.log(1e-1))
    s5_b_re = nrm((DEPTH, 2, S5_G, S5_N, S5_GS), (2 * S5_GS) ** -0.5)
    s5_b_im = nrm((DEPTH, 2, S5_G, S5_N, S5_GS), (2 * S5_GS) ** -0.5)
    s5_c_re = nrm((DEPTH, 2, S5_G, S5_GS, S5_N), (2 * S5_N) ** -0.5)
    s5_c_im = nrm((DEPTH, 2, S5_G, S5_GS, S5_N), (2 * S5_N) ** -0.5)
    s5_d = nrm((DEPTH, S5_W), 0.5)
    s5_w_glu = nrm((DEPTH, S5_W, S5_W), S5_W ** -0.5)
    s5_b_glu = nrm((DEPTH, S5_W), 0.02)
    ssd_conv_w = nrm((DEPTH, SSD_CONV, SSD_XBC), SSD_CONV ** -0.5)
    ssd_conv_b = nrm((DEPTH, SSD_XBC), 0.02)
    dt0 = jnp.exp(unif((DEPTH, 2, SSD_H), math.log(1e-3), math.log(1e-1)))
    ssd_dt_bias = dt0 + jnp.log(-jnp.expm1(-dt0))
    ssd_a_log = jnp.log(unif((DEPTH, 2, SSD_H), 1.0, 16.0))
    ssd_d = 1.0 + nrm((DEPTH, SSD_H), 0.02)
    ssd_norm_g = 1.0 + nrm((DEPTH, SSD_W), 0.02)
    ml_i_bias = nrm((DEPTH, 2, ML_H), 0.1)
    ml_f_bias = jnp.linspace(3.0, 6.0, ML_H, dtype=F32) + nrm((DEPTH, 2, ML_H), 0.1)
    ml_norm_g = 1.0 + nrm((DEPTH, ML_W), 0.02)
    w_branch = nrm((DEPTH, N_BRANCH, BRANCH_W, D_MODEL), BRANCH_W ** -0.5)
    w_out = nrm((DEPTH, D_MODEL, D_MODEL), D_MODEL ** -0.5)
    w_mlp1 = nrm((DEPTH, D_MODEL, D_FF), D_MODEL ** -0.5)
    w_mlp2 = nrm((DEPTH, D_FF, D_MODEL), D_FF ** -0.5)
    return {
        'x_prompt': x_prompt, 'x_sample': x_sample,
        'cache_na_k': cache_na_k, 'cache_na_v': cache_na_v,
        'state_s5_re': state_s5_re, 'state_s5_im': state_s5_im, 'state_ssd': state_ssd,
        'state_ml_c': state_ml_c, 'state_ml_n': state_ml_n, 'state_ml_m': state_ml_m,
        'c': c, 'c_ctx': c_ctx,
        'w_ada': w_ada, 'b_ada': b_ada, 'norm1_g': norm1_g, 'norm2_g': norm2_g, 'w_in': w_in,
        'na_qn_g': na_qn_g, 'na_kn_g': na_kn_g, 'na_rpb': na_rpb,
        's5_a_re': s5_a_re, 's5_a_im': s5_a_im, 's5_log_dt': s5_log_dt,
        's5_b_re': s5_b_re, 's5_b_im': s5_b_im, 's5_c_re': s5_c_re, 's5_c_im': s5_c_im,
        's5_d': s5_d, 's5_w_glu': s5_w_glu, 's5_b_glu': s5_b_glu,
        'ssd_conv_w': ssd_conv_w, 'ssd_conv_b': ssd_conv_b, 'ssd_dt_bias': ssd_dt_bias,
        'ssd_a_log': ssd_a_log, 'ssd_d': ssd_d, 'ssd_norm_g': ssd_norm_g,
        'ml_i_bias': ml_i_bias, 'ml_f_bias': ml_f_bias, 'ml_norm_g': ml_norm_g,
        'w_branch': w_branch, 'w_out': w_out, 'w_mlp1': w_mlp1, 'w_mlp2': w_mlp2,
    }


def reference(x_prompt, x_sample, cache_na_k, cache_na_v, state_s5_re, state_s5_im, state_ssd,
              state_ml_c, state_ml_n, state_ml_m, c, c_ctx, w_ada, b_ada, norm1_g, norm2_g,
              w_in, na_qn_g, na_kn_g, na_rpb, s5_a_re, s5_a_im, s5_log_dt, s5_b_re, s5_b_im,
              s5_c_re, s5_c_im, s5_d, s5_w_glu, s5_b_glu, ssd_conv_w, ssd_conv_b, ssd_dt_bias,
              ssd_a_log, ssd_d, ssd_norm_g, ml_i_bias, ml_f_bias, ml_norm_g, w_branch, w_out,
              w_mlp1, w_mlp2):
    bp = x_prompt.shape[0]
    zero_init = (jnp.zeros((bp, 2, S5_G, S5_N), F32), jnp.zeros((bp, 2, S5_G, S5_N), F32),
                 jnp.zeros((bp, 2, SSD_H, SSD_P, SSD_N), F32),
                 jnp.zeros((bp, 2, ML_H, ML_DK, ML_DK), F32),
                 jnp.zeros((bp, 2, ML_H, ML_DK), F32), jnp.zeros((bp, 2, ML_H), F32))
    xp = x_prompt
    xs = x_sample
    nk, nv, n5r, n5i, nssd, nmc, nmn, nmm = [], [], [], [], [], [], [], []
    for l in range(DEPTH):
        P = {'w_ada': w_ada[l], 'b_ada': b_ada[l], 'norm1_g': norm1_g[l], 'norm2_g': norm2_g[l],
             'w_in': w_in[l], 'na_qn_g': na_qn_g[l], 'na_kn_g': na_kn_g[l], 'na_rpb': na_rpb[l],
             's5_a_re': s5_a_re[l], 's5_a_im': s5_a_im[l], 's5_log_dt': s5_log_dt[l],
             's5_b_re': s5_b_re[l], 's5_b_im': s5_b_im[l], 's5_c_re': s5_c_re[l],
             's5_c_im': s5_c_im[l], 's5_d': s5_d[l], 's5_w_glu': s5_w_glu[l],
             's5_b_glu': s5_b_glu[l], 'ssd_conv_w': ssd_conv_w[l], 'ssd_conv_b': ssd_conv_b[l],
             'ssd_dt_bias': ssd_dt_bias[l], 'ssd_a_log': ssd_a_log[l], 'ssd_d': ssd_d[l],
             'ssd_norm_g': ssd_norm_g[l], 'ml_i_bias': ml_i_bias[l], 'ml_f_bias': ml_f_bias[l],
             'ml_norm_g': ml_norm_g[l], 'w_branch': w_branch[l], 'w_out': w_out[l],
             'w_mlp1': w_mlp1[l], 'w_mlp2': w_mlp2[l]}
        xp, (k, v, s5r, s5i, ssdh, mc, mn, mm) = trunk_layer(xp, c_ctx[None, :], P, None,
                                                            zero_init, False)
        nk.append(k)
        nv.append(v)
        n5r.append(s5r)
        n5i.append(s5i)
        nssd.append(ssdh)
        nmc.append(mc)
        nmn.append(mn)
        nmm.append(mm)
        lat_init = (state_s5_re[:, l], state_s5_im[:, l], state_ssd[:, l], state_ml_c[:, l],
                    state_ml_n[:, l], state_ml_m[:, l])
        xs, _ = trunk_layer(xs, c, P, (cache_na_k[:, l], cache_na_v[:, l]), lat_init, True)
    return (xp, xs, jnp.stack(nk, axis=1), jnp.stack(nv, axis=1), jnp.stack(n5r, axis=1),
            jnp.stack(n5i, axis=1), jnp.stack(nssd, axis=1), jnp.stack(nmc, axis=1),
            jnp.stack(nmn, axis=1), jnp.stack(nmm, axis=1))
```

```cpp
#include <hip/hip_runtime.h>
#include <math.h>
namespace nv {
constexpr int D = 2048, MP = 4096, ML = 8192, M = MP + ML, DEPTH = 4, INDIM = 13856, DFF = 8192;
constexpr int NSEQ = 20;
constexpr int C_Q = 0, C_K = 512, C_V = 1024, C_S5U = 1536, C_Z = 2048, C_XBC = 2560, C_DT = 3584, C_MQ = 3600, C_MK = 4112, C_MV = 4624,
              C_MO = 5136, C_MI = 5648, C_MF = 5656, C_GATE = 5664;
constexpr size_t O_YP = 0, O_YS = 8388608, O_NK = 25165824, O_NV = 33554432, O_S5R = 41943040, O_S5I = 42205184, O_SSD = 42467328,
                 O_MLC = 50855936, O_MLN = 59244544, O_MLM = 59310080;

__host__ __device__ inline void seq_info(int sq, int& row0, int& L, int& lat, int& b) {
    if (sq < 16) { row0 = sq * 256; L = 256; lat = 0; b = sq; } else { b = sq - 16; row0 = MP + b * 2048; L = 2048; lat = 1; }
}
__device__ inline int row_cvec(int row) { return row < MP ? 0 : 1 + (row - MP) / 2048; }
__device__ inline float siluf(float x) { return x / (1.f + expf(-x)); }
__device__ inline float sigmf(float x) { return 1.f / (1.f + expf(-x)); }
__device__ inline float softplusf(float x) { return x > 20.f ? x : log1pf(expf(x)); }
__device__ inline float gelu_tanh(float x) { return 0.5f * x * (1.f + tanhf(0.7978845608028654f * (x + 0.044715f * x * x * x))); }

__global__ void k_ada(const float* c, const float* cctx, const float* w_ada, const float* b_ada, float* mod) {
    int idx = blockIdx.x * blockDim.x + threadIdx.x; if (idx >= DEPTH * 6 * D) return;
    int l = idx / (6 * D), n = idx % (6 * D);
    float acc[5] = {0, 0, 0, 0, 0};
    const float* w = w_ada + (size_t)l * D * 6 * D + n;
    for (int k = 0; k < D; ++k) { float wv = w[(size_t)k * 6 * D];
        acc[0] += siluf(cctx[k]) * wv;
#pragma unroll
        for (int j = 0; j < 4; ++j) acc[1 + j] += siluf(c[j * D + k]) * wv; }
    for (int j = 0; j < 5; ++j) mod[((size_t)l * 5 + j) * 6 * D + n] = acc[j] + b_ada[l * 6 * D + n];
}
__global__ void k_norm_mod(const float* xp, const float* xs, const float* g, const float* modl, int sh_off, int sc_off, float* h) {
    int row = blockIdx.x; const float* x = row < MP ? xp + (size_t)row * D : xs + (size_t)(row - MP) * D;
    __shared__ float red[256];
    float s = 0; for (int i = threadIdx.x; i < D; i += 256) s += x[i] * x[i];
    red[threadIdx.x] = s; __syncthreads();
    for (int o = 128; o > 0; o >>= 1) { if (threadIdx.x < o) red[threadIdx.x] += red[threadIdx.x + o]; __syncthreads(); }
    float r = rsqrtf(red[0] / D + 1e-6f);
    const float* md = modl + (size_t)row_cvec(row) * 6 * D;
    for (int i = threadIdx.x; i < D; i += 256) h[(size_t)row * D + i] = x[i] * r * g[i] * (1.f + md[sc_off + i]) + md[sh_off + i];
}
__global__ void __launch_bounds__(256) k_gemm(const float* A, int lda, const float* W, int ldw, float* C, int ldc, int Mm, int N, int K) {
    __shared__ float As[16][128 + 4], Bs[16][128 + 4];
    const int tid = threadIdx.x, ty = tid / 16, tx = tid % 16, row0 = blockIdx.y * 128, col0 = blockIdx.x * 128;
    float acc[8][8];
#pragma unroll
    for (int i = 0; i < 8; ++i)
#pragma unroll
        for (int j = 0; j < 8; ++j) acc[i][j] = 0.f;
    for (int k0 = 0; k0 < K; k0 += 16) {
        { int r = tid / 2, kk = (tid % 2) * 8; const float* ap = A + (size_t)(row0 + r) * lda + k0 + kk;
          float4 v0 = *(const float4*)ap, v1 = *(const float4*)(ap + 4);
          As[kk + 0][r] = v0.x; As[kk + 1][r] = v0.y; As[kk + 2][r] = v0.z; As[kk + 3][r] = v0.w; As[kk + 4][r] = v1.x; As[kk + 5][r] = v1.y; As[kk + 6][r] = v1.z; As[kk + 7][r] = v1.w; }
        { int kk = tid / 16, c = (tid % 16) * 8; const float* wp = W + (size_t)(k0 + kk) * ldw + col0 + c;
          float4 v0 = make_float4(0, 0, 0, 0), v1 = v0; if (col0 + c < N) { v0 = *(const float4*)wp; v1 = *(const float4*)(wp + 4); }
          *(float4*)&Bs[kk][c] = v0; *(float4*)&Bs[kk][c + 4] = v1; }
        __syncthreads();
#pragma unroll
        for (int k = 0; k < 16; ++k) { float a[8], b[8];
#pragma unroll
            for (int i = 0; i < 8; ++i) { a[i] = As[k][ty * 8 + i]; b[i] = Bs[k][tx * 8 + i]; }
#pragma unroll
            for (int i = 0; i < 8; ++i)
#pragma unroll
                for (int j = 0; j < 8; ++j) acc[i][j] += a[i] * b[j]; }
        __syncthreads();
    }
#pragma unroll
    for (int i = 0; i < 8; ++i) { int r = row0 + ty * 8 + i;
#pragma unroll
        for (int j = 0; j < 8; ++j) { int c = col0 + tx * 8 + j; if (c < N) C[(size_t)r * ldc + c] = acc[i][j]; } }
}
__global__ void k_qknorm(float* proj, const float* qg, const float* kg, float* out, int layer) {
    int idx = blockIdx.x * blockDim.x + threadIdx.x; if (idx >= M * 8) return; int row = idx / 8, hh = idx % 8;
    float* q = proj + (size_t)row * INDIM + C_Q + hh * 64; float* k = proj + (size_t)row * INDIM + C_K + hh * 64; const float* v = proj + (size_t)row * INDIM + C_V + hh * 64;
    float sq = 0, sk = 0; for (int i = 0; i < 64; ++i) { sq += q[i] * q[i]; sk += k[i] * k[i]; }
    float rq = rsqrtf(sq / 64 + 1e-6f), rk = rsqrtf(sk / 64 + 1e-6f);
    for (int i = 0; i < 64; ++i) { q[i] = q[i] * rq * qg[i]; k[i] = k[i] * rk * kg[i]; }
    if (row < MP) { int b = row / 256, s = row % 256; size_t o = ((((size_t)b * DEPTH + layer) * 256 + s) * 8 + hh) * 64;
        for (int i = 0; i < 64; ++i) { out[O_NK + o + i] = k[i]; out[O_NV + o + i] = v[i]; } }
}
__global__ void __launch_bounds__(64) k_attn_dense(const float* proj, float* br) {
    int idx = blockIdx.x * blockDim.x + threadIdx.x; if (idx >= MP * 8) return; int hh = idx % 8, row = idx / 8, b = row / 256;
    float q[64], o[64]; const float* qp = proj + (size_t)row * INDIM + C_Q + hh * 64;
    _Pragma("unroll") for (int i = 0; i < 64; ++i) { q[i] = qp[i]; o[i] = 0.f; }
    float mx = -1e30f, sum = 0.f;
    for (int s = 0; s < 256; ++s) { const float* kp = proj + (size_t)(b * 256 + s) * INDIM + C_K + hh * 64; const float* vp = kp + (C_V - C_K);
        float sc = 0; _Pragma("unroll") for (int i = 0; i < 64; ++i) sc += q[i] * kp[i]; sc *= 0.125f;
        float mn = fmaxf(mx, sc), a = expf(mx - mn), p = expf(sc - mn); sum = sum * a + p;
        _Pragma("unroll") for (int i = 0; i < 64; ++i) o[i] = o[i] * a + p * vp[i]; mx = mn; }
    _Pragma("unroll") for (int i = 0; i < 64; ++i) br[(size_t)row * D + hh * 64 + i] = o[i] / sum;
}
__global__ void __launch_bounds__(64) k_attn_na(const float* proj, const float* ck, const float* cv, const float* rpb  , int layer, float* br) {
    int idx = blockIdx.x * blockDim.x + threadIdx.x; if (idx >= ML * 8) return; int hh = idx % 8, lt = idx / 8, b = lt / 2048, t = lt % 2048, r = t / 64, c = t % 64;
    int row = MP + lt; float q[64], o[64]; const float* qp = proj + (size_t)row * INDIM + C_Q + hh * 64;
    _Pragma("unroll") for (int i = 0; i < 64; ++i) { q[i] = qp[i]; o[i] = 0.f; }
    int rs = min(max(r - 4, 0), 32 - 8), cs = min(max(c - 8, 0), 64 - 16);
    float mx = -1e30f, sum = 0.f;
    for (int j = 0; j < 8; ++j) for (int w = 0; w < 16; ++w) { int kr = rs + j, kc = cs + w; int krow = MP + b * 2048 + kr * 64 + kc;
        const float* kp = proj + (size_t)krow * INDIM + C_K + hh * 64; const float* vp = kp + (C_V - C_K);
        float sc = 0; _Pragma("unroll") for (int i = 0; i < 64; ++i) sc += q[i] * kp[i]; sc = sc * 0.125f + rpb[(hh * 15 + (kr - r + 7)) * 31 + (kc - c + 15)];
        float mn = fmaxf(mx, sc), a = expf(mx - mn), p = expf(sc - mn); sum = sum * a + p;
        _Pragma("unroll") for (int i = 0; i < 64; ++i) o[i] = o[i] * a + p * vp[i]; mx = mn; }
    for (int s = 0; s < 512; ++s) { size_t off = ((((size_t)b * DEPTH + layer) * 512 + s) * 8 + hh) * 64; const float* kp = ck + off; const float* vp = cv + off;
        float sc = 0; _Pragma("unroll") for (int i = 0; i < 64; ++i) sc += q[i] * kp[i]; sc *= 0.125f;
        float mn = fmaxf(mx, sc), a = expf(mx - mn), p = expf(sc - mn); sum = sum * a + p;
        _Pragma("unroll") for (int i = 0; i < 64; ++i) o[i] = o[i] * a + p * vp[i]; mx = mn; }
    _Pragma("unroll") for (int i = 0; i < 64; ++i) br[(size_t)row * D + hh * 64 + i] = o[i] / sum;
}
__global__ void k_s5(const float* proj, const float* a_re, const float* a_im, const float* log_dt, const float* b_re, const float* b_im, const float* c_re, const float* c_im,
                     const float* st_re, const float* st_im, int layer, float* ys5, float* out) {
    int wid = blockIdx.x; int dir = wid % 2, g = (wid / 2) % 32, sq = wid / 64; int n = threadIdx.x;
    int row0, L, lat, b; seq_info(sq, row0, L, lat, b);
    int pi = (dir * 32 + g) * 64 + n;
    float are = fminf(a_re[pi], -1e-4f), aim = a_im[pi], dt = expf(log_dt[dir * 32 + g]);
    float mag = expf(dt * are), abr = mag * cosf(dt * aim), abi = mag * sinf(dt * aim);
    float den = are * are + aim * aim, nr = abr - 1.f, cfr = (nr * are + abi * aim) / den, cfi = (abi * are - nr * aim) / den;
    float bbr[16], bbi[16], cr[16], ci[16];
    for (int k = 0; k < 16; ++k) { float br_ = b_re[(size_t)pi * 16 + k], bi_ = b_im[(size_t)pi * 16 + k]; bbr[k] = cfr * br_ - cfi * bi_; bbi[k] = cfr * bi_ + cfi * br_;
        cr[k] = c_re[((size_t)(dir * 32 + g) * 16 + k) * 64 + n]; ci[k] = c_im[((size_t)(dir * 32 + g) * 16 + k) * 64 + n]; }
    float hr = 0.f, hi = 0.f;
    if (lat) { size_t so = ((((size_t)b * DEPTH + layer) * 2 + dir) * 32 + g) * 64 + n; hr = st_re[so]; hi = st_im[so]; }
    for (int s = 0; s < L; ++s) { int t = dir ? L - 1 - s : s; const float* u = proj + (size_t)(row0 + t) * INDIM + C_S5U + g * 16;
        float bur = 0, bui = 0;
        for (int k = 0; k < 16; ++k) { float uv = u[k]; bur += uv * bbr[k]; bui += uv * bbi[k]; }
        float nhr = abr * hr - abi * hi + bur, nhi = abr * hi + abi * hr + bui; hr = nhr; hi = nhi;
        float myy = 0.f;
        for (int k = 0; k < 16; ++k) { float v = hr * cr[k] - hi * ci[k];
            for (int o = 32; o > 0; o >>= 1) v += __shfl_xor(v, o);
            if (n == k) myy = v; }
        if (n < 16) ys5[((size_t)dir * M + row0 + t) * 512 + g * 16 + n] = myy; }
    if (!lat) { size_t oo = ((((size_t)b * DEPTH + layer) * 2 + dir) * 32 + g) * 64 + n; out[O_S5R + oo] = hr; out[O_S5I + oo] = hi; }
}
__global__ void k_s5_z(const float* proj, const float* ys5, const float* s5d, float* zbuf) {
    size_t idx = (size_t)blockIdx.x * blockDim.x + threadIdx.x; if (idx >= (size_t)M * 512) return; int row = idx / 512, cidx = idx % 512;
    float y = ys5[idx] + ys5[(size_t)M * 512 + idx] + proj[(size_t)row * INDIM + C_S5U + cidx] * s5d[cidx]; zbuf[idx] = gelu_tanh(y);
}
__global__ void k_s5_out(const float* zbuf, const float* tmp, const float* bglu, float* br) {
    size_t idx = (size_t)blockIdx.x * blockDim.x + threadIdx.x; if (idx >= (size_t)M * 512) return; int row = idx / 512, cidx = idx % 512;
    br[(size_t)row * D + 512 + cidx] = zbuf[idx] * sigmf(tmp[idx] + bglu[cidx]);
}
__global__ void k_ssd_conv(const float* proj, const float* cw  , const float* cb, float* xbc) {
    size_t idx = (size_t)blockIdx.x * blockDim.x + threadIdx.x; if (idx >= (size_t)M * 1024) return; int row = idx / 1024, ch = idx % 1024;
    int sq = row < MP ? row / 256 : 16 + (row - MP) / 2048; int row0, L, lat, b; seq_info(sq, row0, L, lat, b); int t = row - row0;
    float acc = cb[ch];
    for (int j = 0; j < 5; ++j) { int tt = t + j - 2; if (tt >= 0 && tt < L) acc += proj[(size_t)(row0 + tt) * INDIM + C_XBC + ch] * cw[j * 1024 + ch]; }
    xbc[idx] = siluf(acc);
}
__global__ void __launch_bounds__(64) k_ssd_seq(const float* proj, const float* xbc, const float* dt_bias  , const float* a_log  , const float* st  ,
                                                int layer, float* yssd, float* out) {
    int wid = blockIdx.x; int dir = wid % 2, hh = (wid / 2) % 8, sq = wid / 16; int p = threadIdx.x;
    int row0, L, lat, b; seq_info(sq, row0, L, lat, b);
    float h[128];
    if (lat) { const float* sp = st + (((((size_t)b * DEPTH + layer) * 2 + dir) * 8 + hh) * 64 + p) * 128; _Pragma("unroll") for (int n = 0; n < 128; ++n) h[n] = sp[n]; }
    else { _Pragma("unroll") for (int n = 0; n < 128; ++n) h[n] = 0.f; }
    float A = -expf(a_log[dir * 8 + hh]), dtb = dt_bias[dir * 8 + hh]; int grp = hh / 4;
    for (int s = 0; s < L; ++s) { int t = dir ? L - 1 - s : s; int row = row0 + t;
        float dt = softplusf(proj[(size_t)row * INDIM + C_DT + dir * 8 + hh] + dtb), dec = expf(dt * A);
        float xd = xbc[(size_t)row * 1024 + hh * 64 + p] * dt;
        const float* Bv = xbc + (size_t)row * 1024 + 512 + grp * 128; const float* Cv = xbc + (size_t)row * 1024 + 768 + grp * 128;
        float y = 0.f;
#pragma unroll
        for (int n = 0; n < 128; ++n) { h[n] = dec * h[n] + Bv[n] * xd; y += Cv[n] * h[n]; }
        yssd[((size_t)dir * M + row) * 512 + hh * 64 + p] = y; }
    if (!lat) { float* op = out + O_SSD + (((((size_t)b * DEPTH + layer) * 2 + dir) * 8 + hh) * 64 + p) * 128; _Pragma("unroll") for (int n = 0; n < 128; ++n) op[n] = h[n]; }
}
__global__ void k_ssd_fin(const float* proj, const float* xbc, const float* yssd, const float* ssd_d  , const float* ng  , float* br) {
    int row = blockIdx.x; __shared__ float red[256]; float v[2]; float s = 0;
    for (int i = 0; i < 2; ++i) { int ch = threadIdx.x + i * 256; float y = yssd[(size_t)row * 512 + ch] + yssd[((size_t)M + row) * 512 + ch] + xbc[(size_t)row * 1024 + ch] * ssd_d[ch / 64];
        y *= siluf(proj[(size_t)row * INDIM + C_Z + ch]); v[i] = y; s += y * y; }
    red[threadIdx.x] = s; __syncthreads();
    for (int o = 128; o > 0; o >>= 1) { if (threadIdx.x < o) red[threadIdx.x] += red[threadIdx.x + o]; __syncthreads(); }
    float r = rsqrtf(red[0] / 512 + 1e-6f);
    for (int i = 0; i < 2; ++i) { int ch = threadIdx.x + i * 256; br[(size_t)row * D + 1024 + ch] = v[i] * r * ng[ch]; }
}
__global__ void k_ml_rope(const float* proj, float* qr, float* kr) {
    size_t idx = (size_t)blockIdx.x * blockDim.x + threadIdx.x; if (idx >= (size_t)M * 512) return; int row = idx / 512, cidx = idx % 512, dd = cidx % 128;
    const float* qp = proj + (size_t)row * INDIM + C_MQ + cidx - dd; const float* kp = proj + (size_t)row * INDIM + C_MK + cidx - dd;
    float qv, kv;
    if (row < MP) { qv = qp[dd]; kv = kp[dd]; }
    else { int t = (row - MP) % 2048; int half = dd / 64, i64 = dd % 64, i = i64 % 32; float pos = half == 0 ? (float)(t / 64) : (float)(t % 64);
        float inv = powf(10000.f, -(float)i / 32.f), ang = pos * inv, cs = cosf(ang), sn = sinf(ang);
        int i1 = half * 64 + i, i2 = i1 + 32;
        if (i64 < 32) { qv = qp[i1] * cs - qp[i2] * sn; kv = kp[i1] * cs - kp[i2] * sn; } else { qv = qp[i1] * sn + qp[i2] * cs; kv = kp[i1] * sn + kp[i2] * cs; } }
    qr[idx] = qv; kr[idx] = kv * 0.08838834764831845f;
}
__global__ void __launch_bounds__(128) k_ml_seq(const float* proj, const float* qr, const float* kr, const float* ib  , const float* fb, const float* stc, const float* stn, const float* stm,
                                                 int layer, float* hml, float* out) {
    int wid = blockIdx.x; int dir = wid % 2, hh = (wid / 2) % 4, sq = wid / 8; int v = threadIdx.x;
    int row0, L, lat, b; seq_info(sq, row0, L, lat, b);
    __shared__ float ns[128], qs[128], ks[128];
    float C[128]; float m = 0.f;
    if (lat) { size_t so = (((size_t)b * DEPTH + layer) * 2 + dir) * 4 + hh; _Pragma("unroll") for (int k = 0; k < 128; ++k) C[k] = stc[(so * 128 + k) * 128 + v]; ns[v] = stn[so * 128 + v]; m = stm[so]; }
    else { _Pragma("unroll") for (int k = 0; k < 128; ++k) C[k] = 0.f; ns[v] = 0.f; }
    float ibv = ib[dir * 4 + hh], fbv = fb[dir * 4 + hh];
    __syncthreads();
    for (int s = 0; s < L; ++s) { int t = dir ? L - 1 - s : s; int row = row0 + t;
        qs[v] = qr[(size_t)row * 512 + hh * 128 + v]; ks[v] = kr[(size_t)row * 512 + hh * 128 + v];
        float vv = proj[(size_t)row * INDIM + C_MV + hh * 128 + v];
        float ig = proj[(size_t)row * INDIM + C_MI + dir * 4 + hh] + ibv, fp = proj[(size_t)row * INDIM + C_MF + dir * 4 + hh] + fbv;
        float lf = -softplusf(-fp);
        float mn = fmaxf(lf + m, ig), a = expf(lf + m - mn), bb = expf(ig - mn); m = mn;
        __syncthreads();
        float nv_ = a * ns[v] + bb * ks[v];
        float num = 0.f;
#pragma unroll
        for (int k = 0; k < 128; ++k) { C[k] = a * C[k] + bb * ks[k] * vv; num += qs[k] * C[k]; }
        __syncthreads();
        ns[v] = nv_;
        __syncthreads();
        float den = 0.f; for (int k = 0; k < 128; ++k) den += qs[k] * ns[k];
        den = fmaxf(fabsf(den), expf(-m));
        hml[((size_t)dir * M + row) * 512 + hh * 128 + v] = num / den;
        __syncthreads(); }
    if (!lat) { size_t so = (((size_t)b * DEPTH + layer) * 2 + dir) * 4 + hh; _Pragma("unroll") for (int k = 0; k < 128; ++k) out[O_MLC + (so * 128 + k) * 128 + v] = C[k]; out[O_MLN + so * 128 + v] = ns[v]; if (v == 0) out[O_MLM + so] = m; }
}
__global__ void k_ml_fin(const float* proj, const float* hml, const float* ng  , float* br) {
    int row = blockIdx.x, cidx = threadIdx.x; __shared__ float red[512];
    float hv = hml[(size_t)row * 512 + cidx] + hml[((size_t)M + row) * 512 + cidx]; red[cidx] = hv * hv; __syncthreads();
    for (int o = 64; o > 0; o >>= 1) { if ((cidx & 127) < o) red[cidx] += red[cidx + o]; __syncthreads(); }
    float r = rsqrtf(red[cidx & ~127] / 128 + 1e-6f);
    br[(size_t)row * D + 1536 + cidx] = hv * r * ng[cidx] * sigmf(proj[(size_t)row * INDIM + C_MO + cidx]);
}
__global__ void k_merge(const float* proj, const float* tmp, float* merged, int k) {
    size_t idx = (size_t)blockIdx.x * blockDim.x + threadIdx.x; if (idx >= (size_t)M * D) return; int row = idx / D, d = idx % D;
    float v = sigmf(proj[(size_t)row * INDIM + C_GATE + k * D + d]) * tmp[idx]; merged[idx] = k == 0 ? v : merged[idx] + v;
}
__global__ void k_resid(const float* xp, const float* xs, const float* modl, int g_off, const float* tmp, float* xout) {
    size_t idx = (size_t)blockIdx.x * blockDim.x + threadIdx.x; if (idx >= (size_t)M * D) return; int row = idx / D, d = idx % D;
    float xv = row < MP ? xp[idx] : xs[idx - (size_t)MP * D];
    xout[idx] = xv + modl[(size_t)row_cvec(row) * 6 * D + g_off + d] * tmp[idx];
}
__global__ void k_relu2(float* hmat, size_t n) { size_t idx = (size_t)blockIdx.x * blockDim.x + threadIdx.x; if (idx >= n) return; float v = fmaxf(hmat[idx], 0.f); hmat[idx] = v * v; }

inline void gemm(hipStream_t st, const float* A, int lda, const float* W, int ldw, float* C, int ldc, int Mm, int N, int K) {
    hipLaunchKernelGGL(k_gemm, dim3((N + 127) / 128, Mm / 128), dim3(256), 0, st, A, lda, W, ldw, C, ldc, Mm, N, K);
}
inline unsigned nb(size_t n, int t = 256) { return (unsigned)((n + t - 1) / t); }

inline void forward(void* const* d_in, float* out, float* ws, hipStream_t st) {
    auto I = [&](int i) { return (const float*)d_in[i]; };
    float* H = ws; float* PROJ = H + (size_t)M * D; float* BR = PROJ + (size_t)M * INDIM; float* MERGED = BR + (size_t)M * D; float* TMP = MERGED + (size_t)M * D;
    float* XBC = TMP + (size_t)M * D; float* YA = XBC + (size_t)M * 1024;   float* QR = YA + (size_t)2 * M * 512; float* KR = QR + (size_t)M * 512;
    float* ZB = KR + (size_t)M * 512; float* MOD = ZB + (size_t)M * 512; float* HID = PROJ;
    float* X = out;
    hipLaunchKernelGGL(k_ada, dim3(nb(DEPTH * 6 * D)), dim3(256), 0, st, I(10), I(11), I(12), I(13), MOD);
    for (int l = 0; l < DEPTH; ++l) {
        const float* xp = l == 0 ? I(0) : X; const float* xs = l == 0 ? I(1) : X + (size_t)MP * D;
        const float* modl = MOD + (size_t)l * 5 * 6 * D;
        hipLaunchKernelGGL(k_norm_mod, dim3(M), dim3(256), 0, st, xp, xs, I(14) + l * D, modl, 0, D, H);
        gemm(st, H, D, I(16) + (size_t)l * D * INDIM, INDIM, PROJ, INDIM, M, INDIM, D);
        hipLaunchKernelGGL(k_qknorm, dim3(nb(M * 8)), dim3(256), 0, st, PROJ, I(17) + l * 64, I(18) + l * 64, out, l);
        hipLaunchKernelGGL(k_attn_dense, dim3(nb(MP * 8, 64)), dim3(64), 0, st, PROJ, BR);
        hipLaunchKernelGGL(k_attn_na, dim3(nb(ML * 8, 64)), dim3(64), 0, st, PROJ, I(2), I(3), I(19) + (size_t)l * 8 * 15 * 31, l, BR);
        hipLaunchKernelGGL(k_s5, dim3(NSEQ * 64), dim3(64), 0, st, PROJ, I(20) + l * 4096, I(21) + l * 4096, I(22) + l * 64, I(23) + (size_t)l * 65536, I(24) + (size_t)l * 65536,
                           I(25) + (size_t)l * 65536, I(26) + (size_t)l * 65536, I(4), I(5), l, YA, out);
        hipLaunchKernelGGL(k_s5_z, dim3(nb((size_t)M * 512)), dim3(256), 0, st, PROJ, YA, I(27) + l * 512, ZB);
        gemm(st, ZB, 512, I(28) + (size_t)l * 512 * 512, 512, TMP, 512, M, 512, 512);
        hipLaunchKernelGGL(k_s5_out, dim3(nb((size_t)M * 512)), dim3(256), 0, st, ZB, TMP, I(29) + l * 512, BR);
        hipLaunchKernelGGL(k_ssd_conv, dim3(nb((size_t)M * 1024)), dim3(256), 0, st, PROJ, I(30) + l * 5 * 1024, I(31) + l * 1024, XBC);
        hipLaunchKernelGGL(k_ssd_seq, dim3(NSEQ * 16), dim3(64), 0, st, PROJ, XBC, I(32) + l * 16, I(33) + l * 16, I(6), l, YA, out);
        hipLaunchKernelGGL(k_ssd_fin, dim3(M), dim3(256), 0, st, PROJ, XBC, YA, I(34) + l * 8, I(35) + l * 512, BR);
        hipLaunchKernelGGL(k_ml_rope, dim3(nb((size_t)M * 512)), dim3(256), 0, st, PROJ, QR, KR);
        hipLaunchKernelGGL(k_ml_seq, dim3(NSEQ * 8), dim3(128), 0, st, PROJ, QR, KR, I(36) + l * 8, I(37) + l * 8, I(7), I(8), I(9), l, YA, out);
        hipLaunchKernelGGL(k_ml_fin, dim3(M), dim3(512), 0, st, PROJ, YA, I(38) + l * 512, BR);
        for (int k = 0; k < 4; ++k) {
            gemm(st, BR + k * 512, D, I(39) + ((size_t)l * 4 + k) * 512 * D, D, TMP, D, M, D, 512);
            hipLaunchKernelGGL(k_merge, dim3(nb((size_t)M * D)), dim3(256), 0, st, PROJ, TMP, MERGED, k);
        }
        gemm(st, MERGED, D, I(40) + (size_t)l * D * D, D, TMP, D, M, D, D);
        hipLaunchKernelGGL(k_resid, dim3(nb((size_t)M * D)), dim3(256), 0, st, xp, xs, modl, 2 * D, TMP, X);
        hipLaunchKernelGGL(k_norm_mod, dim3(M), dim3(256), 0, st, X, X + (size_t)MP * D, I(15) + l * D, modl, 3 * D, 4 * D, H);
        gemm(st, H, D, I(41) + (size_t)l * D * DFF, DFF, HID, DFF, M, DFF, D);
        hipLaunchKernelGGL(k_relu2, dim3(nb((size_t)M * DFF)), dim3(256), 0, st, HID, (size_t)M * DFF);
        gemm(st, HID, DFF, I(42) + (size_t)l * DFF * D, D, TMP, D, M, D, DFF);
        hipLaunchKernelGGL(k_resid, dim3(nb((size_t)M * D)), dim3(256), 0, st, X, X + (size_t)MP * D, modl, 5 * D, TMP, X);
    }
}
}
extern "C" void kernel_launch(void* const* d_in, const int* in_sizes, int n_in, void* d_out, int out_size, void* d_ws, size_t ws_size, hipStream_t stream) {
    nv::forward(d_in, (float*)d_out, (float*)d_ws, stream);
}
```

```cpp
#define SAFE_GEMM 0
#include <hip/hip_runtime.h>
#include <math.h>
namespace nv {
constexpr int D = 2048, MP = 4096, ML = 8192, M = MP + ML, DEPTH = 4, INDIM = 13856, DFF = 8192;
constexpr int NSEQ = 20;
constexpr int C_Q = 0, C_K = 512, C_V = 1024, C_S5U = 1536, C_Z = 2048, C_XBC = 2560, C_DT = 3584, C_MQ = 3600, C_MK = 4112, C_MV = 4624,
              C_MO = 5136, C_MI = 5648, C_MF = 5656, C_GATE = 5664;
constexpr size_t O_YP = 0, O_YS = 8388608, O_NK = 25165824, O_NV = 33554432, O_S5R = 41943040, O_S5I = 42205184, O_SSD = 42467328,
                 O_MLC = 50855936, O_MLN = 59244544, O_MLM = 59310080;

__host__ __device__ inline void seq_info(int sq, int& row0, int& L, int& lat, int& b) {
    if (sq < 16) { row0 = sq * 256; L = 256; lat = 0; b = sq; } else { b = sq - 16; row0 = MP + b * 2048; L = 2048; lat = 1; }
}
__device__ inline int row_cvec(int row) { return row < MP ? 0 : 1 + (row - MP) / 2048; }
__device__ inline float siluf(float x) { return x / (1.f + expf(-x)); }
__device__ inline float sigmf(float x) { return 1.f / (1.f + expf(-x)); }
__device__ inline float softplusf(float x) { return x > 20.f ? x : log1pf(expf(x)); }
__device__ inline float gelu_tanh(float x) { return 0.5f * x * (1.f + tanhf(0.7978845608028654f * (x + 0.044715f * x * x * x))); }


struct PBF {
    const unsigned short* p; const float* sm;
    __device__ __forceinline__ float operator()(int row, int col) const {
        if (col < 3584) return __uint_as_float(((unsigned)p[(size_t)row * 13824 + col]) << 16);
        if (col < 3600) return sm[(size_t)row * 32 + col - 3584];
        if (col < 5648) return __uint_as_float(((unsigned)p[(size_t)row * 13824 + col - 16]) << 16);
        if (col < 5664) return sm[(size_t)row * 32 + 16 + col - 5648];
        return __uint_as_float(((unsigned)p[(size_t)row * 13824 + col - 32]) << 16);
    }
};
__device__ __forceinline__ unsigned short f2bf_rne(float f) { unsigned u = __float_as_uint(f); u += 0x7FFFu + ((u >> 16) & 1u); return (unsigned short)(u >> 16); }
__device__ __forceinline__ void st(float* p, size_t i, float v) { p[i] = v; }
__device__ __forceinline__ void st(unsigned short* p, size_t i, float v) { p[i] = f2bf_rne(v); }

__global__ void k_ada(const float* c, const float* cctx, const float* w_ada, const float* b_ada, float* mod) {
    int idx = blockIdx.x * blockDim.x + threadIdx.x; if (idx >= DEPTH * 6 * D) return;
    int l = idx / (6 * D), n = idx % (6 * D);
    float acc[5] = {0, 0, 0, 0, 0};
    const float* w = w_ada + (size_t)l * D * 6 * D + n;
    for (int k = 0; k < D; ++k) { float wv = w[(size_t)k * 6 * D];
        acc[0] += siluf(cctx[k]) * wv;
#pragma unroll
        for (int j = 0; j < 4; ++j) acc[1 + j] += siluf(c[j * D + k]) * wv; }
    for (int j = 0; j < 5; ++j) mod[((size_t)l * 5 + j) * 6 * D + n] = acc[j] + b_ada[l * 6 * D + n];
}
__global__ void k_norm_mod(const float* xp, const float* xs, const float* g, const float* modl, int sh_off, int sc_off, float* h) {
    int row = blockIdx.x; const float* x = row < MP ? xp + (size_t)row * D : xs + (size_t)(row - MP) * D;
    __shared__ float red[256];
    float s = 0; for (int i = threadIdx.x; i < D; i += 256) s += x[i] * x[i];
    red[threadIdx.x] = s; __syncthreads();
    for (int o = 128; o > 0; o >>= 1) { if (threadIdx.x < o) red[threadIdx.x] += red[threadIdx.x + o]; __syncthreads(); }
    float r = rsqrtf(red[0] / D + 1e-6f);
    const float* md = modl + (size_t)row_cvec(row) * 6 * D;
    for (int i = threadIdx.x; i < D; i += 256) h[(size_t)row * D + i] = x[i] * r * g[i] * (1.f + md[sc_off + i]) + md[sh_off + i];
}
__global__ void __launch_bounds__(256) k_gemm(const float* A, int lda, const float* W, int ldw, float* C, int ldc, int Mm, int N, int K) {
    __shared__ float As[16][128 + 4], Bs[16][128 + 4];
    const int tid = threadIdx.x, ty = tid / 16, tx = tid % 16, row0 = blockIdx.y * 128, col0 = blockIdx.x * 128;
    float acc[8][8];
#pragma unroll
    for (int i = 0; i < 8; ++i)
#pragma unroll
        for (int j = 0; j < 8; ++j) acc[i][j] = 0.f;
    for (int k0 = 0; k0 < K; k0 += 16) {
        { int r = tid / 2, kk = (tid % 2) * 8; const float* ap = A + (size_t)(row0 + r) * lda + k0 + kk;
          float4 v0 = *(const float4*)ap, v1 = *(const float4*)(ap + 4);
          As[kk + 0][r] = v0.x; As[kk + 1][r] = v0.y; As[kk + 2][r] = v0.z; As[kk + 3][r] = v0.w; As[kk + 4][r] = v1.x; As[kk + 5][r] = v1.y; As[kk + 6][r] = v1.z; As[kk + 7][r] = v1.w; }
        { int kk = tid / 16, c = (tid % 16) * 8; const float* wp = W + (size_t)(k0 + kk) * ldw + col0 + c;
          float4 v0 = make_float4(0, 0, 0, 0), v1 = v0; if (col0 + c < N) { v0 = *(const float4*)wp; v1 = *(const float4*)(wp + 4); }
          *(float4*)&Bs[kk][c] = v0; *(float4*)&Bs[kk][c + 4] = v1; }
        __syncthreads();
#pragma unroll
        for (int k = 0; k < 16; ++k) { float a[8], b[8];
#pragma unroll
            for (int i = 0; i < 8; ++i) { a[i] = As[k][ty * 8 + i]; b[i] = Bs[k][tx * 8 + i]; }
#pragma unroll
            for (int i = 0; i < 8; ++i)
#pragma unroll
                for (int j = 0; j < 8; ++j) acc[i][j] += a[i] * b[j]; }
        __syncthreads();
    }
#pragma unroll
    for (int i = 0; i < 8; ++i) { int r = row0 + ty * 8 + i;
#pragma unroll
        for (int j = 0; j < 8; ++j) { int c = col0 + tx * 8 + j; if (c < N) C[(size_t)r * ldc + c] = acc[i][j]; } }
}
__global__ void k_qknorm(float* proj, const float* qg, const float* kg, float* out, int layer) {
    int idx = blockIdx.x * blockDim.x + threadIdx.x; if (idx >= M * 8) return; int row = idx / 8, hh = idx % 8;
    float* q = proj + (size_t)row * INDIM + C_Q + hh * 64; float* k = proj + (size_t)row * INDIM + C_K + hh * 64; const float* v = proj + (size_t)row * INDIM + C_V + hh * 64;
    float sq = 0, sk = 0; for (int i = 0; i < 64; ++i) { sq += q[i] * q[i]; sk += k[i] * k[i]; }
    float rq = rsqrtf(sq / 64 + 1e-6f), rk = rsqrtf(sk / 64 + 1e-6f);
    for (int i = 0; i < 64; ++i) { q[i] = q[i] * rq * qg[i]; k[i] = k[i] * rk * kg[i]; }
    if (row < MP) { int b = row / 256, s = row % 256; size_t o = ((((size_t)b * DEPTH + layer) * 256 + s) * 8 + hh) * 64;
        for (int i = 0; i < 64; ++i) { out[O_NK + o + i] = k[i]; out[O_NV + o + i] = v[i]; } }
}
template <class PA, class OT> __global__ void __launch_bounds__(64) k_attn_dense(PA proj, OT* br) {
    int idx = blockIdx.x * blockDim.x + threadIdx.x; if (idx >= MP * 8) return; int hh = idx % 8, row = idx / 8, b = row / 256;
    float q[64], o[64];
    _Pragma("unroll") for (int i = 0; i < 64; ++i) { q[i] = proj(row, C_Q + hh * 64 + i); o[i] = 0.f; }
    float mx = -1e30f, sum = 0.f;
    for (int s = 0; s < 256; ++s) { const int kr_ = b * 256 + s;
        float sc = 0; _Pragma("unroll") for (int i = 0; i < 64; ++i) sc += q[i] * proj(kr_, C_K + hh * 64 + i); sc *= 0.125f;
        float mn = fmaxf(mx, sc), a = expf(mx - mn), p = expf(sc - mn); sum = sum * a + p;
        _Pragma("unroll") for (int i = 0; i < 64; ++i) o[i] = o[i] * a + p * proj(kr_, C_V + hh * 64 + i); mx = mn; }
    _Pragma("unroll") for (int i = 0; i < 64; ++i) st(br, (size_t)row * D + hh * 64 + i, o[i] / sum);
}
template <class PA, class OT> __global__ void __launch_bounds__(64) k_attn_na(PA proj, const float* ck, const float* cv, const float* rpb  , int layer, OT* br) {
    int idx = blockIdx.x * blockDim.x + threadIdx.x; if (idx >= ML * 8) return; int hh = idx % 8, lt = idx / 8, b = lt / 2048, t = lt % 2048, r = t / 64, c = t % 64;
    int row = MP + lt; float q[64], o[64];
    _Pragma("unroll") for (int i = 0; i < 64; ++i) { q[i] = proj(row, C_Q + hh * 64 + i); o[i] = 0.f; }
    int rs = min(max(r - 4, 0), 32 - 8), cs = min(max(c - 8, 0), 64 - 16);
    float mx = -1e30f, sum = 0.f;
    for (int j = 0; j < 8; ++j) for (int w = 0; w < 16; ++w) { int kr = rs + j, kc = cs + w; int krow = MP + b * 2048 + kr * 64 + kc;
        float sc = 0; _Pragma("unroll") for (int i = 0; i < 64; ++i) sc += q[i] * proj(krow, C_K + hh * 64 + i); sc = sc * 0.125f + rpb[(hh * 15 + (kr - r + 7)) * 31 + (kc - c + 15)];
        float mn = fmaxf(mx, sc), a = expf(mx - mn), p = expf(sc - mn); sum = sum * a + p;
        _Pragma("unroll") for (int i = 0; i < 64; ++i) o[i] = o[i] * a + p * proj(krow, C_V + hh * 64 + i); mx = mn; }
    for (int s = 0; s < 512; ++s) { size_t off = ((((size_t)b * DEPTH + layer) * 512 + s) * 8 + hh) * 64; const float* kp = ck + off; const float* vp = cv + off;
        float sc = 0; _Pragma("unroll") for (int i = 0; i < 64; ++i) sc += q[i] * kp[i]; sc *= 0.125f;
        float mn = fmaxf(mx, sc), a = expf(mx - mn), p = expf(sc - mn); sum = sum * a + p;
        _Pragma("unroll") for (int i = 0; i < 64; ++i) o[i] = o[i] * a + p * vp[i]; mx = mn; }
    _Pragma("unroll") for (int i = 0; i < 64; ++i) st(br, (size_t)row * D + hh * 64 + i, o[i] / sum);
}
template <class PA> __global__ void k_s5(PA proj, const float* a_re, const float* a_im, const float* log_dt, const float* b_re, const float* b_im, const float* c_re, const float* c_im,
                     const float* st_re, const float* st_im, int layer, float* ys5, float* out) {
    int wid = blockIdx.x; int dir = wid % 2, g = (wid / 2) % 32, sq = wid / 64; int n = threadIdx.x;
    int row0, L, lat, b; seq_info(sq, row0, L, lat, b);
    int pi = (dir * 32 + g) * 64 + n;
    float are = fminf(a_re[pi], -1e-4f), aim = a_im[pi], dt = expf(log_dt[dir * 32 + g]);
    float mag = expf(dt * are), abr = mag * cosf(dt * aim), abi = mag * sinf(dt * aim);
    float den = are * are + aim * aim, nr = abr - 1.f, cfr = (nr * are + abi * aim) / den, cfi = (abi * are - nr * aim) / den;
    float bbr[16], bbi[16], cr[16], ci[16];
    for (int k = 0; k < 16; ++k) { float br_ = b_re[(size_t)pi * 16 + k], bi_ = b_im[(size_t)pi * 16 + k]; bbr[k] = cfr * br_ - cfi * bi_; bbi[k] = cfr * bi_ + cfi * br_;
        cr[k] = c_re[((size_t)(dir * 32 + g) * 16 + k) * 64 + n]; ci[k] = c_im[((size_t)(dir * 32 + g) * 16 + k) * 64 + n]; }
    float hr = 0.f, hi = 0.f;
    if (lat) { size_t so = ((((size_t)b * DEPTH + layer) * 2 + dir) * 32 + g) * 64 + n; hr = st_re[so]; hi = st_im[so]; }
    for (int s = 0; s < L; ++s) { int t = dir ? L - 1 - s : s;
        float bur = 0, bui = 0;
        for (int k = 0; k < 16; ++k) { float uv = proj(row0 + t, C_S5U + g * 16 + k); bur += uv * bbr[k]; bui += uv * bbi[k]; }
        float nhr = abr * hr - abi * hi + bur, nhi = abr * hi + abi * hr + bui; hr = nhr; hi = nhi;
        float myy = 0.f;
        for (int k = 0; k < 16; ++k) { float v = hr * cr[k] - hi * ci[k];
            for (int o = 32; o > 0; o >>= 1) v += __shfl_xor(v, o);
            if (n == k) myy = v; }
        if (n < 16) ys5[((size_t)dir * M + row0 + t) * 512 + g * 16 + n] = myy; }
    if (!lat) { size_t oo = ((((size_t)b * DEPTH + layer) * 2 + dir) * 32 + g) * 64 + n; out[O_S5R + oo] = hr; out[O_S5I + oo] = hi; }
}
template <class PA, class OT> __global__ void k_s5_z(PA proj, const float* ys5, const float* s5d, OT* zbuf) {
    size_t idx = (size_t)blockIdx.x * blockDim.x + threadIdx.x; if (idx >= (size_t)M * 512) return; int row = idx / 512, cidx = idx % 512;
    float y = ys5[idx] + ys5[(size_t)M * 512 + idx] + proj(row, C_S5U + cidx) * s5d[cidx]; st(zbuf, idx, gelu_tanh(y));
}
__global__ void k_s5_out(const float* zbuf, const float* tmp, const float* bglu, float* br) {
    size_t idx = (size_t)blockIdx.x * blockDim.x + threadIdx.x; if (idx >= (size_t)M * 512) return; int row = idx / 512, cidx = idx % 512;
    br[(size_t)row * D + 512 + cidx] = zbuf[idx] * sigmf(tmp[idx] + bglu[cidx]);
}
template <class PA> __global__ void k_ssd_conv(PA proj, const float* cw  , const float* cb, float* xbc) {
    size_t idx = (size_t)blockIdx.x * blockDim.x + threadIdx.x; if (idx >= (size_t)M * 1024) return; int row = idx / 1024, ch = idx % 1024;
    int sq = row < MP ? row / 256 : 16 + (row - MP) / 2048; int row0, L, lat, b; seq_info(sq, row0, L, lat, b); int t = row - row0;
    float acc = cb[ch];
    for (int j = 0; j < 5; ++j) { int tt = t + j - 2; if (tt >= 0 && tt < L) acc += proj(row0 + tt, C_XBC + ch) * cw[j * 1024 + ch]; }
    xbc[idx] = siluf(acc);
}
template <class PA> __global__ void __launch_bounds__(64) k_ssd_seq(PA proj, const float* xbc, const float* dt_bias  , const float* a_log  , const float* st  ,
                                                int layer, float* yssd, float* out) {
    int wid = blockIdx.x; int dir = wid % 2, hh = (wid / 2) % 8, sq = wid / 16; int p = threadIdx.x;
    int row0, L, lat, b; seq_info(sq, row0, L, lat, b);
    float h[128];
    if (lat) { const float* sp = st + (((((size_t)b * DEPTH + layer) * 2 + dir) * 8 + hh) * 64 + p) * 128; _Pragma("unroll") for (int n = 0; n < 128; ++n) h[n] = sp[n]; }
    else { _Pragma("unroll") for (int n = 0; n < 128; ++n) h[n] = 0.f; }
    float A = -expf(a_log[dir * 8 + hh]), dtb = dt_bias[dir * 8 + hh]; int grp = hh / 4;
    for (int s = 0; s < L; ++s) { int t = dir ? L - 1 - s : s; int row = row0 + t;
        float dt = softplusf(proj(row, C_DT + dir * 8 + hh) + dtb), dec = expf(dt * A);
        float xd = xbc[(size_t)row * 1024 + hh * 64 + p] * dt;
        const float* Bv = xbc + (size_t)row * 1024 + 512 + grp * 128; const float* Cv = xbc + (size_t)row * 1024 + 768 + grp * 128;
        float y = 0.f;
#pragma unroll
        for (int n = 0; n < 128; ++n) { h[n] = dec * h[n] + Bv[n] * xd; y += Cv[n] * h[n]; }
        yssd[((size_t)dir * M + row) * 512 + hh * 64 + p] = y; }
    if (!lat) { float* op = out + O_SSD + (((((size_t)b * DEPTH + layer) * 2 + dir) * 8 + hh) * 64 + p) * 128; _Pragma("unroll") for (int n = 0; n < 128; ++n) op[n] = h[n]; }
}
template <class PA, class OT> __global__ void k_ssd_fin(PA proj, const float* xbc, const float* yssd, const float* ssd_d  , const float* ng  , OT* br) {
    int row = blockIdx.x; __shared__ float red[256]; float v[2]; float s = 0;
    for (int i = 0; i < 2; ++i) { int ch = threadIdx.x + i * 256; float y = yssd[(size_t)row * 512 + ch] + yssd[((size_t)M + row) * 512 + ch] + xbc[(size_t)row * 1024 + ch] * ssd_d[ch / 64];
        y *= siluf(proj(row, C_Z + ch)); v[i] = y; s += y * y; }
    red[threadIdx.x] = s; __syncthreads();
    for (int o = 128; o > 0; o >>= 1) { if (threadIdx.x < o) red[threadIdx.x] += red[threadIdx.x + o]; __syncthreads(); }
    float r = rsqrtf(red[0] / 512 + 1e-6f);
    for (int i = 0; i < 2; ++i) { int ch = threadIdx.x + i * 256; st(br, (size_t)row * D + 1024 + ch, v[i] * r * ng[ch]); }
}
template <class PA> __global__ void k_ml_rope(PA proj, float* qr, float* kr) {
    size_t idx = (size_t)blockIdx.x * blockDim.x + threadIdx.x; if (idx >= (size_t)M * 512) return; int row = idx / 512, cidx = idx % 512, dd = cidx % 128;
    const int qb = C_MQ + cidx - dd, kb = C_MK + cidx - dd;
    float qv, kv;
    if (row < MP) { qv = proj(row, qb + dd); kv = proj(row, kb + dd); }
    else { int t = (row - MP) % 2048; int half = dd / 64, i64 = dd % 64, i = i64 % 32; float pos = half == 0 ? (float)(t / 64) : (float)(t % 64);
        float inv = powf(10000.f, -(float)i / 32.f), ang = pos * inv, cs = cosf(ang), sn = sinf(ang);
        int i1 = half * 64 + i, i2 = i1 + 32;
        if (i64 < 32) { qv = proj(row, qb + i1) * cs - proj(row, qb + i2) * sn; kv = proj(row, kb + i1) * cs - proj(row, kb + i2) * sn; } else { qv = proj(row, qb + i1) * sn + proj(row, qb + i2) * cs; kv = proj(row, kb + i1) * sn + proj(row, kb + i2) * cs; } }
    qr[idx] = qv; kr[idx] = kv * 0.08838834764831845f;
}
template <class PA> __global__ void __launch_bounds__(128) k_ml_seq(PA proj, const float* qr, const float* kr, const float* ib  , const float* fb, const float* stc, const float* stn, const float* stm,
                                                 int layer, float* hml, float* out) {
    int wid = blockIdx.x; int dir = wid % 2, hh = (wid / 2) % 4, sq = wid / 8; int v = threadIdx.x;
    int row0, L, lat, b; seq_info(sq, row0, L, lat, b);
    __shared__ float ns[128], qs[128], ks[128];
    float C[128]; float m = 0.f;
    if (lat) { size_t so = (((size_t)b * DEPTH + layer) * 2 + dir) * 4 + hh; _Pragma("unroll") for (int k = 0; k < 128; ++k) C[k] = stc[(so * 128 + k) * 128 + v]; ns[v] = stn[so * 128 + v]; m = stm[so]; }
    else { _Pragma("unroll") for (int k = 0; k < 128; ++k) C[k] = 0.f; ns[v] = 0.f; }
    float ibv = ib[dir * 4 + hh], fbv = fb[dir * 4 + hh];
    __syncthreads();
    for (int s = 0; s < L; ++s) { int t = dir ? L - 1 - s : s; int row = row0 + t;
        qs[v] = qr[(size_t)row * 512 + hh * 128 + v]; ks[v] = kr[(size_t)row * 512 + hh * 128 + v];
        float vv = proj(row, C_MV + hh * 128 + v);
        float ig = proj(row, C_MI + dir * 4 + hh) + ibv, fp = proj(row, C_MF + dir * 4 + hh) + fbv;
        float lf = -softplusf(-fp);
        float mn = fmaxf(lf + m, ig), a = expf(lf + m - mn), bb = expf(ig - mn); m = mn;
        __syncthreads();
        float nv_ = a * ns[v] + bb * ks[v];
        float num = 0.f;
#pragma unroll
        for (int k = 0; k < 128; ++k) { C[k] = a * C[k] + bb * ks[k] * vv; num += qs[k] * C[k]; }
        __syncthreads();
        ns[v] = nv_;
        __syncthreads();
        float den = 0.f; for (int k = 0; k < 128; ++k) den += qs[k] * ns[k];
        den = fmaxf(fabsf(den), expf(-m));
        hml[((size_t)dir * M + row) * 512 + hh * 128 + v] = num / den;
        __syncthreads(); }
    if (!lat) { size_t so = (((size_t)b * DEPTH + layer) * 2 + dir) * 4 + hh; _Pragma("unroll") for (int k = 0; k < 128; ++k) out[O_MLC + (so * 128 + k) * 128 + v] = C[k]; out[O_MLN + so * 128 + v] = ns[v]; if (v == 0) out[O_MLM + so] = m; }
}
template <class PA, class OT> __global__ void k_ml_fin(PA proj, const float* hml, const float* ng  , OT* br) {
    int row = blockIdx.x, cidx = threadIdx.x; __shared__ float red[512];
    float hv = hml[(size_t)row * 512 + cidx] + hml[((size_t)M + row) * 512 + cidx]; red[cidx] = hv * hv; __syncthreads();
    for (int o = 64; o > 0; o >>= 1) { if ((cidx & 127) < o) red[cidx] += red[cidx + o]; __syncthreads(); }
    float r = rsqrtf(red[cidx & ~127] / 128 + 1e-6f);
    st(br, (size_t)row * D + 1536 + cidx, hv * r * ng[cidx] * sigmf(proj(row, C_MO + cidx)));
}
__global__ void k_merge(const float* proj, const float* tmp, float* merged, int k) {
    size_t idx = (size_t)blockIdx.x * blockDim.x + threadIdx.x; if (idx >= (size_t)M * D) return; int row = idx / D, d = idx % D;
    float v = sigmf(proj[(size_t)row * INDIM + C_GATE + k * D + d]) * tmp[idx]; merged[idx] = k == 0 ? v : merged[idx] + v;
}
__global__ void k_resid(const float* xp, const float* xs, const float* modl, int g_off, const float* tmp, float* xout) {
    size_t idx = (size_t)blockIdx.x * blockDim.x + threadIdx.x; if (idx >= (size_t)M * D) return; int row = idx / D, d = idx % D;
    float xv = row < MP ? xp[idx] : xs[idx - (size_t)MP * D];
    xout[idx] = xv + modl[(size_t)row_cvec(row) * 6 * D + g_off + d] * tmp[idx];
}
__global__ void k_relu2(float* hmat, size_t n) { size_t idx = (size_t)blockIdx.x * blockDim.x + threadIdx.x; if (idx >= n) return; float v = fmaxf(hmat[idx], 0.f); hmat[idx] = v * v; }

inline void gemm(hipStream_t st, const float* A, int lda, const float* W, int ldw, float* C, int ldc, int Mm, int N, int K) {
    hipLaunchKernelGGL(k_gemm, dim3((N + 127) / 128, Mm / 128), dim3(256), 0, st, A, lda, W, ldw, C, ldc, Mm, N, K);
}
inline unsigned nb(size_t n, int t = 256) { return (unsigned)((n + t - 1) / t); }

}
namespace mk {
#define LAS __attribute__((address_space(3)))
typedef unsigned short bf16_t;
typedef short bf16x8 __attribute__((ext_vector_type(8)));
typedef float f32x4 __attribute__((ext_vector_type(4)));
typedef float f32x2 __attribute__((ext_vector_type(2)));
typedef unsigned u32x4 __attribute__((ext_vector_type(4)));
typedef unsigned u32x2 __attribute__((ext_vector_type(2)));
constexpr int NT = 512, NWV = 8;
constexpr int D = 2048, MP = 4096, MLAT = 8192, M = MP + MLAT, DEPTH = 4, DFF = 8192;
constexpr int PJ = 13824;
constexpr int NIN = 14080;
constexpr int P_Q = 0, P_K = 512, P_V = 1024, P_S5U = 1536, P_Z = 2048, P_XBC = 2560, P_MQ = 3584, P_MK = 4096, P_MV = 4608, P_MO = 5120, P_GATE = 5632;
constexpr int S_DT = 0, S_MI = 16, S_MF = 24;

typedef __bf16 bf16x2_t __attribute__((ext_vector_type(2)));
__device__ __forceinline__ unsigned pk2(float lo, float hi) { f32x2 v = {lo, hi}; bf16x2_t b = __builtin_convertvector(v, bf16x2_t); return __builtin_bit_cast(unsigned, b); }
__device__ __forceinline__ float bf2f(bf16_t v) { return __uint_as_float(((unsigned)v) << 16); }
__device__ __forceinline__ float bflo(unsigned w) { return __uint_as_float(w << 16); }
__device__ __forceinline__ float bfhi(unsigned w) { return __uint_as_float(w & 0xffff0000u); }
__device__ __forceinline__ bf16_t f2bf(float f) { return (bf16_t)(pk2(f, 0.f) & 0xffffu); }
__device__ __forceinline__ float fsigm(float x) { return __builtin_amdgcn_rcpf(1.f + __expf(-x)); }
__device__ __forceinline__ float fsilu(float x) { return x * fsigm(x); }
__device__ __forceinline__ int row_cvec(int row) { return row < MP ? 0 : 1 + (row - MP) / 2048; }

#define XB_TMO      128
#define XB_XCNT(j)  (256  + 64 * (j))
#define XB_XSUB(j)  (1280 + 64 * (j))
#define XB_XGEN(j)  (2304 + 64 * (j))
#define XB_TOP      3328
#define XB_TOPGEN   3392
#define XCD_BAR_WORDS 3456
#define XB_SPIN_CAP (1u << 18)
__device__ __forceinline__ unsigned xb_ld(unsigned* p)              { return __hip_atomic_load(p, __ATOMIC_RELAXED, __HIP_MEMORY_SCOPE_AGENT); }
__device__ __forceinline__ unsigned xb_add(unsigned* p, unsigned v) { return __hip_atomic_fetch_add(p, v, __ATOMIC_RELAXED, __HIP_MEMORY_SCOPE_AGENT); }
__device__ __forceinline__ unsigned xb_xcc_id() { return (unsigned)__builtin_amdgcn_s_getreg((3 << 11) | 20) & 0xFu; }
#define XB_SPIN(cond, bar) do { unsigned _sp = 0; while (cond) { __builtin_amdgcn_s_sleep(1); \
    if ((++_sp & 255u) == 0u) { if (xb_ld(&(bar)[XB_TMO])) break; if (_sp > XB_SPIN_CAP) { atomicAdd(&(bar)[XB_TMO], 1u); break; } } } } while (0)
struct XcdBarrier { unsigned* bar; unsigned x; volatile LAS unsigned* st; };
__device__ __forceinline__ XcdBarrier xcd_barrier_post(unsigned* bar, volatile LAS unsigned* st) {
    XcdBarrier b; b.bar = bar; b.x = xb_xcc_id(); b.st = st;
    if (threadIdx.x == 0) (void)xb_add(&bar[XB_XCNT(b.x)], 1u);
    return b;
}
__device__ __forceinline__ void xcd_barrier_complete(unsigned* bar, unsigned x, unsigned& nloc, unsigned& nx) {
    const unsigned G = gridDim.x * gridDim.y * gridDim.z;
    unsigned sum, cnt, mine, sp = 0u;
    for (;;) {
        sum = 0u; cnt = 0u; mine = 0u;
#pragma unroll
        for (unsigned j = 0; j < 16; ++j) { const unsigned c = xb_ld(&bar[XB_XCNT(j)]); sum += c; cnt += (c > 0u) ? 1u : 0u; mine = (j == x) ? c : mine; }
        if (sum == G) break;
        __builtin_amdgcn_s_sleep(1);
        if ((++sp & 255u) == 0u) { if (xb_ld(&bar[XB_TMO])) break; if (sp > XB_SPIN_CAP) { atomicAdd(&bar[XB_TMO], 1u); break; } }
    }
    nloc = mine > 0u ? mine : 1u; nx = cnt > 0u ? cnt : 1u;
}
__device__ __forceinline__ void xcd_barrier(const XcdBarrier& b) {
    asm volatile("s_waitcnt vmcnt(0)" ::: "memory");
    __syncthreads();
    if (threadIdx.x == 0) {
        unsigned* bar = b.bar;
        __builtin_amdgcn_s_waitcnt(0);
        unsigned nloc = b.st[0], nx = b.st[1];
        if (nloc == 0u) { xcd_barrier_complete(bar, b.x, nloc, nx); b.st[0] = nloc; b.st[1] = nx; }
        const unsigned old = xb_add(&bar[XB_XSUB(b.x)], 1u);
        const unsigned gen = old / nloc;
        if (old + 1u == (gen + 1u) * nloc) {
            __builtin_amdgcn_fence(__ATOMIC_RELEASE, "agent");
            asm volatile("s_waitcnt vmcnt(0)" ::: "memory");
            const unsigned og = xb_add(&bar[XB_TOP], 1u);
            const unsigned tg = og / nx;
            if (og + 1u == (tg + 1u) * nx) xb_add(&bar[XB_TOPGEN], 1u);
            else XB_SPIN(xb_ld(&bar[XB_TOPGEN]) == tg, bar);
            __builtin_amdgcn_fence(__ATOMIC_ACQUIRE, "agent");
            xb_add(&bar[XB_XGEN(b.x)], 1u);
            asm volatile("s_waitcnt vmcnt(0)" ::: "memory");
        } else {
            XB_SPIN(xb_ld(&bar[XB_XGEN(b.x)]) == gen, bar);
            __builtin_amdgcn_fence(__ATOMIC_ACQUIRE, "agent");
            asm volatile("s_waitcnt vmcnt(0)" ::: "memory");
        }
    }
    __syncthreads();
}

constexpr int BM = 256, BK = 64, HALF = 128, HTB = HALF * BK * 2, STAGE_BYTES = 8 * HTB, NXCD = 8, WGM = 8;
__host__ __device__ __forceinline__ int lds_byte(int r, int c) { const int st = (r >> 4) * 2 + (c >> 5), rr = r & 15, cc = c & 31, ob = rr * 64 + cc * 2; return st * 1024 + (ob ^ (((ob >> 9) & 1) << 5)); }
__host__ __device__ __forceinline__ void stage_rc(int b, int& R, int& C) { const int st = b / 1024, sb = b % 1024, swz = sb ^ (((sb >> 9) & 1) << 5); R = (st >> 1) * 16 + swz / 64; C = (st & 1) * 32 + (swz % 64) / 2; }
__host__ __device__ __forceinline__ int perm32(int rho) { const int n = rho >> 4, i = rho & 15; return 8 * (i >> 2) + 4 * n + (i & 3); }

struct Unit { int pm, pn, kz; };
struct Gemm { const bf16_t* A; const bf16_t* Bt; int M, N, K, lda, nkz; size_t a_kz, b_kz; };

struct StaticOrder {
    int nM, nN, nwg, G, c, nkz;
    __device__ void init(int M_, int N_, int G_, int c_, int nkz_ = 1) { nM = M_ / BM; nN = N_ / BM; nwg = nM * nN; G = G_; c = c_; nkz = nkz_; }
    __device__ bool next(int i, Unit& u) const {
        const int it = i / nkz; u.kz = i - it * nkz;
        const long L = (long)it * G + c; if (L >= nwg) return false;
        int wgid = (int)L; { const int q = nwg / NXCD, r = nwg % NXCD, xcd = wgid % NXCD, off = wgid / NXCD; wgid = (xcd < r ? xcd * (q + 1) : r * (q + 1) + (xcd - r) * q) + off; }
        const int nig = WGM * nN, gid = wgid / nig, fm = gid * WGM, gsz = (nM - fm) < WGM ? (nM - fm) : WGM;
        u.pm = fm + ((wgid % nig) % gsz); u.pn = (wgid % nig) / gsz; return true;
    }
};

template <class Epi>
__device__ __forceinline__ void gemm_phase(LAS unsigned char* lds, const Gemm g, const StaticOrder& S, const Epi& E) {
    int tid_ = threadIdx.x; asm volatile("" : "+v"(tid_));
    const int tid = tid_, wid = __builtin_amdgcn_readfirstlane(tid >> 6), lane = tid & 63, wr = wid >> 2, wc = wid & 3, fr = lane & 15, fq = lane >> 4;
    const int K = g.K, nt = K / BK;
    unsigned voffA[2], voffB[2];
#pragma unroll
    for (int i = 0; i < 2; ++i) { int R, C; stage_rc(tid * 16 + i * 8192, R, C); const int Rb = Epi::PERM ? ((R & ~31) + perm32(R & 31)) : R;
        voffA[i] = (unsigned)(R * g.lda + C) * 2u; voffB[i] = (unsigned)(Rb * K + C) * 2u; }
    const size_t kstep = (size_t)(BK * 2);
    const size_t hstepA = (size_t)HALF * g.lda * 2, hstepB = (size_t)HALF * K * 2;
    const size_t tstepA = 2 * hstepA, tstepB = 2 * hstepB;
    const unsigned ldsw = (unsigned)wid * 1024u;
    const int aoff = lds_byte(wr * 64 + fr, fq * 8), boff = lds_byte(wc * 32 + fr, fq * 8);
#define PG8_SA(b, h) (((b) * 2 + (h)) * HTB)
#define PG8_SB(b, h) ((4 + (b) * 2 + (h)) * HTB)
#define PG8_STAGE(bufoff, gbase, voff) do { _Pragma("unroll") for (int _i = 0; _i < 2; ++_i) \
        __builtin_amdgcn_global_load_lds((const unsigned*)((const char*)(gbase) + (voff)[_i]), (LAS unsigned*)(lds + (bufoff) + ldsw + _i * 8192), 16, 0, 0); } while (0)
#define PG8_LDA(dst, b, h) do { _Pragma("unroll") for (int m = 0; m < 4; ++m) _Pragma("unroll") for (int k = 0; k < 2; ++k) dst[m][k] = *(const LAS bf16x8*)(lds + PG8_SA(b, h) + aoff + m * 2048 + k * 1024); } while (0)
#define PG8_LDB(dst, b, h) do { _Pragma("unroll") for (int n = 0; n < 2; ++n) _Pragma("unroll") for (int k = 0; k < 2; ++k) dst[n][k] = *(const LAS bf16x8*)(lds + PG8_SB(b, h) + boff + n * 2048 + k * 1024); } while (0)
#define PG8_MMA(ai, bj, At, Bt) do { __builtin_amdgcn_s_setprio(1); _Pragma("unroll") for (int m = 0; m < 4; ++m) _Pragma("unroll") for (int n = 0; n < 2; ++n) _Pragma("unroll") for (int k = 0; k < 2; ++k) \
        acc[ai][bj][m][n] = __builtin_amdgcn_mfma_f32_16x16x32_bf16(Bt[n][k], At[m][k], acc[ai][bj][m][n], 0, 0, 0); __builtin_amdgcn_s_setprio(0); } while (0)
#if SAFE_GEMM == 1 || SAFE_GEMM == 3
#define PG8_WAIT_V(n) asm volatile("s_waitcnt vmcnt(0)" ::: "memory")
#else
#define PG8_WAIT_V(n) asm volatile("s_waitcnt vmcnt(" #n ")" ::: "memory")
#endif
#define PG8_WAIT_L(n) asm volatile("s_waitcnt lgkmcnt(" #n ")" ::: "memory")
#if SAFE_GEMM == 1
#define PG8_BAR do { asm volatile("s_waitcnt vmcnt(0) lgkmcnt(0)" ::: "memory"); __builtin_amdgcn_s_barrier(); asm volatile("" ::: "memory"); } while (0)
#elif SAFE_GEMM == 2
#define PG8_BAR asm volatile("s_barrier" ::: "memory")
#elif SAFE_GEMM == 4
#define PG8_BAR do { asm volatile("s_waitcnt lgkmcnt(0)" ::: "memory"); __builtin_amdgcn_s_barrier(); } while (0)
#else
#define PG8_BAR __builtin_amdgcn_s_barrier()
#endif
#define PG8_SCHED __builtin_amdgcn_sched_barrier(0)
    Unit cur, nxt; int ui = 0;
    if (!S.next(0, cur)) return;
    f32x4 acc[2][2][4][2];
#pragma unroll
    for (int a = 0; a < 2; ++a)
#pragma unroll
        for (int b = 0; b < 2; ++b)
#pragma unroll
            for (int m = 0; m < 4; ++m)
#pragma unroll
                for (int n = 0; n < 2; ++n) acc[a][b][m][n] = (f32x4){0.f, 0.f, 0.f, 0.f};
    bf16x8 At[4][2], B0[2][2], B1[2][2];
    const char* cA = (const char*)(g.A + (size_t)cur.kz * g.a_kz) + (size_t)cur.pm * tstepA; const char* cB = (const char*)(g.Bt + (size_t)cur.kz * g.b_kz) + (size_t)cur.pn * tstepB;
    PG8_STAGE(PG8_SB(0, 0), cB, voffB); PG8_STAGE(PG8_SA(0, 0), cA, voffA); PG8_STAGE(PG8_SB(0, 1), cB + hstepB, voffB); PG8_STAGE(PG8_SA(0, 1), cA + hstepA, voffA);
    if (wr == 1) PG8_BAR;
    PG8_WAIT_V(4); PG8_BAR;
    PG8_STAGE(PG8_SB(1, 0), cB + kstep, voffB); PG8_STAGE(PG8_SA(1, 0), cA + kstep, voffA); PG8_STAGE(PG8_SB(1, 1), cB + hstepB + kstep, voffB);
    PG8_WAIT_V(6); PG8_BAR;
    for (;;) {
        const bool has_next = S.next(ui + 1, nxt);
        const char* nA = has_next ? (const char*)(g.A + (size_t)nxt.kz * g.a_kz) + (size_t)nxt.pm * tstepA : cA;
        const char* nB = has_next ? (const char*)(g.Bt + (size_t)nxt.kz * g.b_kz) + (size_t)nxt.pn * tstepB : cB;
        for (int t = 0; t < nt; t += 2) {
            const bool last = (t == nt - 2);
            const char* a1 = cA + (size_t)(t + 1) * kstep;
            const char* a2 = last ? nA : cA + (size_t)(t + 2) * kstep; const char* b2 = last ? nB : cB + (size_t)(t + 2) * kstep;
            const char* a3 = a2 + kstep; const char* b3 = b2 + kstep;
            PG8_LDB(B0, 0, 0); PG8_SCHED; PG8_LDA(At, 0, 0); PG8_STAGE(PG8_SA(1, 1), a1 + hstepA, voffA);
            PG8_WAIT_L(8); PG8_BAR; PG8_WAIT_L(0); PG8_MMA(0, 0, At, B0); PG8_BAR; PG8_SCHED;
            PG8_LDB(B1, 0, 1); PG8_STAGE(PG8_SB(0, 0), b2, voffB);
            PG8_BAR; PG8_WAIT_L(0); PG8_MMA(0, 1, At, B1); PG8_BAR;
            PG8_LDA(At, 0, 1); PG8_STAGE(PG8_SA(0, 0), a2, voffA);
            PG8_BAR; PG8_WAIT_L(0); PG8_MMA(1, 0, At, B0); PG8_BAR; PG8_SCHED;
            PG8_STAGE(PG8_SB(0, 1), b2 + hstepB, voffB);
            PG8_WAIT_V(6); PG8_BAR; PG8_MMA(1, 1, At, B1); PG8_BAR;
            PG8_LDB(B0, 1, 0); PG8_SCHED; PG8_LDA(At, 1, 0); PG8_STAGE(PG8_SA(0, 1), a2 + hstepA, voffA);
            PG8_WAIT_L(8); PG8_BAR; PG8_WAIT_L(0); PG8_MMA(0, 0, At, B0); PG8_BAR; PG8_SCHED;
            PG8_LDB(B1, 1, 1); PG8_STAGE(PG8_SB(1, 0), b3, voffB);
            PG8_BAR; PG8_WAIT_L(0); PG8_MMA(0, 1, At, B1); PG8_BAR;
            PG8_LDA(At, 1, 1); PG8_STAGE(PG8_SA(1, 0), a3, voffA);
            PG8_BAR; PG8_WAIT_L(0); PG8_MMA(1, 0, At, B0); PG8_BAR; PG8_SCHED;
            PG8_STAGE(PG8_SB(1, 1), b3 + hstepB, voffB);
            PG8_WAIT_V(6); PG8_BAR; PG8_MMA(1, 1, At, B1); PG8_BAR;
        }
        E(acc, cur, wr, wc, fr, fq);
        asm volatile("s_waitcnt vmcnt(0)" ::: "memory");
        if (!has_next) break;
#pragma unroll
        for (int a = 0; a < 2; ++a)
#pragma unroll
            for (int b = 0; b < 2; ++b)
#pragma unroll
                for (int m = 0; m < 4; ++m)
#pragma unroll
                    for (int n = 0; n < 2; ++n) acc[a][b][m][n] = (f32x4){0.f, 0.f, 0.f, 0.f};
        cur = nxt; cA = nA; cB = nB; ++ui;
    }
    PG8_WAIT_V(0);
    if (wr == 0) PG8_BAR;
    PG8_BAR;
#undef PG8_SA
#undef PG8_SB
#undef PG8_STAGE
#undef PG8_LDA
#undef PG8_LDB
#undef PG8_MMA
#undef PG8_WAIT_V
#undef PG8_WAIT_L
#undef PG8_BAR
#undef PG8_SCHED
}
}
namespace mk {
constexpr size_t O_YP = 0, O_YS = 8388608, O_NK = 25165824, O_NV = 33554432, O_S5R = 41943040, O_S5I = 42205184, O_SSD = 42467328,
                 O_MLC = 50855936, O_MLN = 59244544, O_MLM = 59310080;

__device__ __forceinline__ u32x4 pack8(const f32x4 a, const f32x4 b) { u32x4 w; w.x = pk2(a[0], a[1]); w.y = pk2(a[2], a[3]); w.z = pk2(b[0], b[1]); w.w = pk2(b[2], b[3]); return w; }

struct EpiIn {
    static constexpr bool PERM = true;
    bf16_t* proj; float* small; float* out; const float* qg; const float* kg; int layer;
    __device__ __forceinline__ void operator()(const f32x4 (&acc)[2][2][4][2], const Unit& u, int wr, int wc, int fr, int fq) const {
        const int T = u.pn, rowb = u.pm * BM + wr * 64 + fr;
        if (T == 54) {
            if (wc == 0) {
#pragma unroll
                for (int ai = 0; ai < 2; ++ai)
#pragma unroll
                    for (int m = 0; m < 4; ++m) { float* sp = small + (size_t)(rowb + ai * HALF + m * 16) * 32 + 8 * fq; *(f32x4*)sp = acc[ai][0][m][0]; *(f32x4*)(sp + 4) = acc[ai][0][m][1]; }
            }
            return;
        }
        const int colb = T * 256 + 64 * wc + 8 * fq;
        if (T < 4) {
            const float* g = T < 2 ? qg : kg;
            f32x4 gv[2][2];
#pragma unroll
            for (int bj = 0; bj < 2; ++bj)
#pragma unroll
                for (int n = 0; n < 2; ++n) gv[bj][n] = *(const f32x4*)(g + 32 * bj + 8 * fq + 4 * n);
#pragma unroll
            for (int ai = 0; ai < 2; ++ai)
#pragma unroll
                for (int m = 0; m < 4; ++m) {
                    float ss = 0.f;
#pragma unroll
                    for (int bj = 0; bj < 2; ++bj)
#pragma unroll
                        for (int n = 0; n < 2; ++n) { const f32x4 x = acc[ai][bj][m][n]; ss += (x[0] * x[0] + x[1] * x[1]) + (x[2] * x[2] + x[3] * x[3]); }
                    ss += __shfl_xor(ss, 16); ss += __shfl_xor(ss, 32);
                    const float r = rsqrtf(ss * (1.f / 64.f) + 1e-6f);
                    const int row = rowb + ai * HALF + m * 16;
#pragma unroll
                    for (int bj = 0; bj < 2; ++bj) { const f32x4 v0 = acc[ai][bj][m][0] * r * gv[bj][0], v1 = acc[ai][bj][m][1] * r * gv[bj][1];
                        *(u32x4*)(proj + (size_t)row * PJ + colb + 32 * bj) = pack8(v0, v1);
                        if (T >= 2 && row < MP) { float* o = out + O_NK + ((size_t)((row >> 8) * DEPTH + layer) * 256 + (row & 255)) * 512 + (colb - 512) + 32 * bj; *(f32x4*)o = v0; *(f32x4*)(o + 4) = v1; } }
                }
        } else if (T < 6) {
#pragma unroll
            for (int ai = 0; ai < 2; ++ai)
#pragma unroll
                for (int m = 0; m < 4; ++m) { const int row = rowb + ai * HALF + m * 16;
#pragma unroll
                    for (int bj = 0; bj < 2; ++bj) { const f32x4 v0 = acc[ai][bj][m][0], v1 = acc[ai][bj][m][1];
                        *(u32x4*)(proj + (size_t)row * PJ + colb + 32 * bj) = pack8(v0, v1);
                        if (row < MP) { float* o = out + O_NV + ((size_t)((row >> 8) * DEPTH + layer) * 256 + (row & 255)) * 512 + (colb - 1024) + 32 * bj; *(f32x4*)o = v0; *(f32x4*)(o + 4) = v1; } } }
        } else if (T < 22) {
#pragma unroll
            for (int ai = 0; ai < 2; ++ai)
#pragma unroll
                for (int m = 0; m < 4; ++m) { const int row = rowb + ai * HALF + m * 16;
#pragma unroll
                    for (int bj = 0; bj < 2; ++bj) *(u32x4*)(proj + (size_t)row * PJ + colb + 32 * bj) = pack8(acc[ai][bj][m][0], acc[ai][bj][m][1]); }
        } else {
#pragma unroll
            for (int ai = 0; ai < 2; ++ai)
#pragma unroll
                for (int m = 0; m < 4; ++m) { const int row = rowb + ai * HALF + m * 16;
#pragma unroll
                    for (int bj = 0; bj < 2; ++bj) { f32x4 v0 = acc[ai][bj][m][0], v1 = acc[ai][bj][m][1];
#pragma unroll
                        for (int j = 0; j < 4; ++j) { v0[j] = fsigm(v0[j]); v1[j] = fsigm(v1[j]); }
                        *(u32x4*)(proj + (size_t)row * PJ + colb + 32 * bj) = pack8(v0, v1); } }
        }
    }
};
struct EpiRelu2 {
    static constexpr bool PERM = true;
    bf16_t* O; int ldo;
    __device__ __forceinline__ void operator()(const f32x4 (&acc)[2][2][4][2], const Unit& u, int wr, int wc, int fr, int fq) const {
        const int rowb = u.pm * BM + wr * 64 + fr, colb = u.pn * 256 + 64 * wc + 8 * fq;
#pragma unroll
        for (int ai = 0; ai < 2; ++ai)
#pragma unroll
            for (int m = 0; m < 4; ++m) { const int row = rowb + ai * HALF + m * 16;
#pragma unroll
                for (int bj = 0; bj < 2; ++bj) { f32x4 v0 = acc[ai][bj][m][0], v1 = acc[ai][bj][m][1];
#pragma unroll
                    for (int j = 0; j < 4; ++j) { const float a = fmaxf(v0[j], 0.f), b = fmaxf(v1[j], 0.f); v0[j] = a * a; v1[j] = b * b; }
                    *(u32x4*)(O + (size_t)row * ldo + colb + 32 * bj) = pack8(v0, v1); } }
    }
};
struct EpiGlu {
    static constexpr bool PERM = true;
    const bf16_t* Z; const float* bias; bf16_t* br;
    __device__ __forceinline__ void operator()(const f32x4 (&acc)[2][2][4][2], const Unit& u, int wr, int wc, int fr, int fq) const {
        const int rowb = u.pm * BM + wr * 64 + fr, colb = u.pn * 256 + 64 * wc + 8 * fq;
#pragma unroll
        for (int bj = 0; bj < 2; ++bj) { const int c = colb + 32 * bj; const f32x4 b0 = *(const f32x4*)(bias + c), b1 = *(const f32x4*)(bias + c + 4);
#pragma unroll
            for (int ai = 0; ai < 2; ++ai)
#pragma unroll
                for (int m = 0; m < 4; ++m) { const int row = rowb + ai * HALF + m * 16;
                    const u32x4 zz = *(const u32x4*)(Z + (size_t)row * 512 + c);
                    f32x4 v0 = acc[ai][bj][m][0] + b0, v1 = acc[ai][bj][m][1] + b1;
                    v0[0] = bflo(zz.x) * fsigm(v0[0]); v0[1] = bfhi(zz.x) * fsigm(v0[1]); v0[2] = bflo(zz.y) * fsigm(v0[2]); v0[3] = bfhi(zz.y) * fsigm(v0[3]);
                    v1[0] = bflo(zz.z) * fsigm(v1[0]); v1[1] = bfhi(zz.z) * fsigm(v1[1]); v1[2] = bflo(zz.w) * fsigm(v1[2]); v1[3] = bfhi(zz.w) * fsigm(v1[3]);
                    *(u32x4*)(br + (size_t)row * D + 512 + c) = pack8(v0, v1); } }
    }
};
struct EpiBranch {
    static constexpr bool PERM = true;
    const bf16_t* proj; float* macc; bf16_t* merged;
    __device__ __forceinline__ void operator()(const f32x4 (&acc)[2][2][4][2], const Unit& u, int wr, int wc, int fr, int fq) const {
        const int rowb = u.pm * BM + wr * 64 + fr, colb = u.pn * 256 + 64 * wc + 8 * fq, kz = u.kz;
#pragma unroll
        for (int ai = 0; ai < 2; ++ai)
#pragma unroll
            for (int m = 0; m < 4; ++m) { const int row = rowb + ai * HALF + m * 16;
#pragma unroll
                for (int bj = 0; bj < 2; ++bj) { const int c = colb + 32 * bj;
                    const u32x4 gg = *(const u32x4*)(proj + (size_t)row * PJ + P_GATE + kz * D + c);
                    f32x4 v0 = acc[ai][bj][m][0], v1 = acc[ai][bj][m][1];
                    v0[0] *= bflo(gg.x); v0[1] *= bfhi(gg.x); v0[2] *= bflo(gg.y); v0[3] *= bfhi(gg.y); v1[0] *= bflo(gg.z); v1[1] *= bfhi(gg.z); v1[2] *= bflo(gg.w); v1[3] *= bfhi(gg.w);
                    float* mp = macc + (size_t)row * D + c;
                    if (kz > 0) { v0 += *(const f32x4*)mp; v1 += *(const f32x4*)(mp + 4); }
                    if (kz < 3) { *(f32x4*)mp = v0; *(f32x4*)(mp + 4) = v1; }
                    else *(u32x4*)(merged + (size_t)row * D + c) = pack8(v0, v1); } }
    }
};
struct EpiResid {
    static constexpr bool PERM = false;
    const float* xp; const float* xs; const float* modl; int g_off; float* xout;
    __device__ __forceinline__ void operator()(const f32x4 (&acc)[2][2][4][2], const Unit& u, int wr, int wc, int fr, int fq) const {
        const int row0 = u.pm * BM, rowb = row0 + wr * 64 + fr, colb = u.pn * 256 + wc * 32 + 4 * fq;
        const float* xin = row0 < MP ? xp : xs - (size_t)MP * D;
        const float* gate = modl + (size_t)row_cvec(row0) * 6 * D + g_off;
        f32x4 gv[2][2];
#pragma unroll
        for (int bj = 0; bj < 2; ++bj)
#pragma unroll
            for (int n = 0; n < 2; ++n) gv[bj][n] = *(const f32x4*)(gate + colb + bj * HALF + n * 16);
#pragma unroll
        for (int ai = 0; ai < 2; ++ai)
#pragma unroll
            for (int m = 0; m < 4; ++m) { const size_t ro = (size_t)(rowb + ai * HALF + m * 16) * D + colb;
#pragma unroll
                for (int bj = 0; bj < 2; ++bj)
#pragma unroll
                    for (int n = 0; n < 2; ++n) { const size_t o = ro + bj * HALF + n * 16; *(f32x4*)(xout + o) = *(const f32x4*)(xin + o) + gv[bj][n] * acc[ai][bj][m][n]; } }
    }
};
}
namespace mk {
constexpr size_t AL(size_t x) { return (x + 255) & ~(size_t)255; }
constexpr size_t WS_CTL = 0, CTL_BYTES = 65536;
constexpr size_t WS_MOD = WS_CTL + CTL_BYTES;
constexpr size_t WS_W = AL(WS_MOD + (size_t)DEPTH * 5 * 6 * D * 4);
constexpr size_t W_IN = 0, W_GLU = W_IN + (size_t)NIN * D, W_BR = W_GLU + 512 * 512, W_OUT = W_BR + (size_t)4 * D * 512, W_1 = W_OUT + (size_t)D * D, W_2 = W_1 + (size_t)DFF * D,
                 W_LAYER = W_2 + (size_t)D * DFF;
constexpr size_t WS_H = AL(WS_W + W_LAYER * 2 * DEPTH);
constexpr size_t WS_PROJ = AL(WS_H + (size_t)M * D * 2);
constexpr size_t WS_SMALL = AL(WS_PROJ + (size_t)M * PJ * 2);
constexpr size_t WS_BR = AL(WS_SMALL + (size_t)M * 32 * 4);
constexpr size_t WS_MERGED = AL(WS_BR + (size_t)M * D * 2);
constexpr size_t WS_MACC = AL(WS_MERGED + (size_t)M * D * 2);
constexpr size_t WS_ZB = AL(WS_MACC + (size_t)M * D * 4);
constexpr size_t WS_SCR = AL(WS_ZB + (size_t)M * 512 * 2);
constexpr int LDS_BYTES = 140 * 1024, LDS_CTL = STAGE_BYTES;

struct Args { const float* in[43]; float* out; unsigned char* ws; int ph_lo, ph_hi; };

__device__ __forceinline__ float wave_sum(float v) {
#pragma unroll
    for (int o = 1; o < 64; o <<= 1) v += __shfl_xor(v, o);
    return v;
}
#define LDS_WAIT() asm volatile("s_waitcnt lgkmcnt(0)" ::: "memory")

__device__ __forceinline__ void xpose_item(const float* W, int ldw, int k0, int sc, bf16_t* dst, int K, LAS float* scr, int lane, int mode) {
    const int j = lane & 31;
    const int col = mode == 1 ? (j < 16 ? 3584 + j : 5648 + (j - 16)) : sc + j;
#pragma unroll 8
    for (int i = 0; i < 32; ++i) { const int kk = 2 * i + (lane >> 5); scr[kk * 33 + j] = mode == 2 ? 0.f : W[(size_t)(k0 + kk) * ldw + col]; }
    LDS_WAIT(); asm volatile("" ::: "memory");
    const int c = lane & 7;
#pragma unroll
    for (int jj = 0; jj < 4; ++jj) { const int n = (lane >> 3) + 8 * jj; const LAS float* s = scr + (8 * c) * 33 + n;
        u32x4 o; o.x = pk2(s[0 * 33], s[1 * 33]); o.y = pk2(s[2 * 33], s[3 * 33]); o.z = pk2(s[4 * 33], s[5 * 33]); o.w = pk2(s[6 * 33], s[7 * 33]);
        *(u32x4*)(dst + (size_t)n * K + k0 + 8 * c) = o; }
    LDS_WAIT(); asm volatile("" ::: "memory");
}
__device__ __forceinline__ int hm_col(int grp) { const int T = grp >> 3, q8 = grp & 7; return 256 * T + 32 * (2 * (q8 & 3) + (q8 >> 2)); }

__device__ __forceinline__ void prologue_convert(const Args& a, LAS unsigned char* lds, int gw, int ngw, int wave, int lane) {
    LAS float* scr = (LAS float*)(lds + wave * 8704);
    bf16_t* WB = (bf16_t*)(a.ws + WS_W);
    constexpr int I_IN = 440 * 32, I_GLU = 16 * 8, I_BR = 4 * 64 * 8, I_OUT = 64 * 32, I_1 = 256 * 32, I_2 = 64 * 128, I_L = I_IN + I_GLU + I_BR + I_OUT + I_1 + I_2;
    for (int it = gw; it < I_L * DEPTH; it += ngw) {
        const int l = it / I_L; int r = it - l * I_L; bf16_t* wl = WB + (size_t)l * W_LAYER;
        if (r < I_IN) { const int kb = r / 440, grp = r % 440, T = grp >> 3; int sc = hm_col(grp), mode = 0;
            if (T == 54) mode = (grp & 7) == 0 ? 1 : 2; else if (T >= 22) sc += 32; else if (T >= 14) sc += 16;
            xpose_item(a.in[16] + (size_t)l * D * 13856, 13856, 64 * kb, sc, wl + W_IN + (size_t)(32 * grp) * D, D, scr, lane, mode); continue; } r -= I_IN;
        if (r < I_GLU) { const int kb = r / 16, grp = r % 16; xpose_item(a.in[28] + (size_t)l * 512 * 512, 512, 64 * kb, hm_col(grp), wl + W_GLU + (size_t)(32 * grp) * 512, 512, scr, lane, 0); continue; } r -= I_GLU;
        if (r < I_BR) { const int k = r / 512, r2 = r % 512, kb = r2 / 64, grp = r2 % 64;
            xpose_item(a.in[39] + ((size_t)l * 4 + k) * 512 * D, D, 64 * kb, hm_col(grp), wl + W_BR + (size_t)k * D * 512 + (size_t)(32 * grp) * 512, 512, scr, lane, 0); continue; } r -= I_BR;
        if (r < I_OUT) { const int kb = r / 64, grp = r % 64; xpose_item(a.in[40] + (size_t)l * D * D, D, 64 * kb, 32 * grp, wl + W_OUT + (size_t)(32 * grp) * D, D, scr, lane, 0); continue; } r -= I_OUT;
        if (r < I_1) { const int kb = r / 256, grp = r % 256; xpose_item(a.in[41] + (size_t)l * D * DFF, DFF, 64 * kb, hm_col(grp), wl + W_1 + (size_t)(32 * grp) * D, D, scr, lane, 0); continue; } r -= I_1;
        { const int kb = r / 64, grp = r % 64; xpose_item(a.in[42] + (size_t)l * DFF * D, D, 64 * kb, 32 * grp, wl + W_2 + (size_t)(32 * grp) * DFF, DFF, scr, lane, 0); }
    }
}
__device__ __forceinline__ void prologue_ada(const Args& a, LAS unsigned char* lds, int tid) {
    LAS float* sl = (LAS float*)lds;
    LAS float* red = (LAS float*)(lds + 40960);
    float* mod = (float*)(a.ws + WS_MOD);
    for (int i = tid; i < 5 * D; i += NT) { const int j = i / D, k = i % D; const float x = j == 0 ? a.in[11][k] : a.in[10][(j - 1) * D + k]; sl[i] = x / (1.f + __expf(-x)); }
    __syncthreads();
    const int ks = tid >> 6, c = tid & 63;
    for (int unit = blockIdx.x; unit < DEPTH * 6 * D / 64; unit += gridDim.x) {
        const int l = unit / (6 * D / 64), n0 = (unit % (6 * D / 64)) * 64;
        const float* w = a.in[12] + (size_t)l * D * 6 * D + n0 + c;
        float acc[5] = {0.f, 0.f, 0.f, 0.f, 0.f};
#pragma unroll 4
        for (int k = ks * 256; k < ks * 256 + 256; ++k) { const float wv = w[(size_t)k * 6 * D];
#pragma unroll
            for (int j = 0; j < 5; ++j) acc[j] += sl[j * D + k] * wv; }
#pragma unroll
        for (int j = 0; j < 5; ++j) red[(ks * 5 + j) * 64 + c] = acc[j];
        __syncthreads();
        if (tid < 320) { const int j = tid >> 6; float s = 0.f;
#pragma unroll
            for (int q = 0; q < 8; ++q) s += red[(q * 5 + j) * 64 + c];
            mod[((size_t)l * 5 + j) * 6 * D + n0 + c] = s + a.in[13][l * 6 * D + n0 + c]; }
        __syncthreads();
    }
}
__device__ __forceinline__ void norm_phase(const float* xp, const float* xs, const float* g, const float* modl, int sh_off, int sc_off, bf16_t* H, int gw, int ngw, int lane_) {
    int lane = lane_; asm volatile("" : "+v"(lane));
    for (int row = gw; row < M; row += ngw) {
        const float* x = row < MP ? xp + (size_t)row * D : xs + (size_t)(row - MP) * D;
        f32x4 v[8]; float ss = 0.f;
#pragma unroll
        for (int j = 0; j < 8; ++j) { v[j] = *(const f32x4*)(x + 4 * (lane + 64 * j)); ss += (v[j][0] * v[j][0] + v[j][1] * v[j][1]) + (v[j][2] * v[j][2] + v[j][3] * v[j][3]); }
        const float r = rsqrtf(wave_sum(ss) * (1.f / D) + 1e-6f);
        const float* md = modl + (size_t)row_cvec(row) * 6 * D;
#pragma unroll
        for (int j = 0; j < 8; ++j) { const int i = 4 * (lane + 64 * j);
            const f32x4 gg = *(const f32x4*)(g + i), sc = *(const f32x4*)(md + sc_off + i), sh = *(const f32x4*)(md + sh_off + i);
            const f32x4 o = v[j] * r * gg * (sc + 1.f) + sh;
            u32x2 w; w.x = pk2(o[0], o[1]); w.y = pk2(o[2], o[3]); *(u32x2*)(H + (size_t)row * D + i) = w; }
    }
}

#ifndef PHMASK
#define PHMASK 0xfffff
#endif
#define PHM(k) ((PHMASK >> (k)) & 1)
constexpr int NPH = 11;
constexpr int PH_TOTAL = 1 + DEPTH * NPH;
__global__ void __launch_bounds__(NT, 2) mk_fwd(Args a) {
    extern __shared__ __attribute__((aligned(16))) unsigned char lds_raw[];
    LAS unsigned char* lds = (LAS unsigned char*)lds_raw;
    const int tid = threadIdx.x, lane = tid & 63, wave = __builtin_amdgcn_readfirstlane(tid >> 6);
    const int G = gridDim.x, gw = blockIdx.x * NWV + wave, ngw = G * NWV;
    volatile LAS unsigned* ctlw = (volatile LAS unsigned*)(lds + LDS_CTL);
    if (tid < 4) ctlw[tid] = 0u;
    __syncthreads();
    XcdBarrier bar = xcd_barrier_post((unsigned*)(a.ws + WS_CTL), ctlw);
    const int lo = a.ph_lo, hi = a.ph_hi;
#define IN(k) (lo <= (k) && (k) < hi)
#define SEAM(k) do { if (IN(k) && IN((k) + 1)) xcd_barrier(bar); } while (0)
    unsigned char* ws = a.ws;
    bf16_t* H = (bf16_t*)(ws + WS_H); bf16_t* PROJ = (bf16_t*)(ws + WS_PROJ); float* SMALL = (float*)(ws + WS_SMALL); bf16_t* BR = (bf16_t*)(ws + WS_BR);
    bf16_t* MERGED = (bf16_t*)(ws + WS_MERGED); float* MACC = (float*)(ws + WS_MACC); bf16_t* ZB = (bf16_t*)(ws + WS_ZB); bf16_t* HID = PROJ;
    const float* MOD = (const float*)(ws + WS_MOD); float* X = a.out;
    if (PHM(0) && IN(0)) { prologue_convert(a, lds, gw, ngw, wave, lane); __syncthreads(); prologue_ada(a, lds, tid); }
    SEAM(0);
    for (int l = 0; l < DEPTH; ++l) {
        const int pb = 1 + l * NPH;
        const float* xp = l == 0 ? a.in[0] : X; const float* xs = l == 0 ? a.in[1] : X + (size_t)MP * D;
        const float* modl = MOD + (size_t)l * 5 * 6 * D;
        const bf16_t* wl = (const bf16_t*)(ws + WS_W) + (size_t)l * W_LAYER;
        if (PHM(1) && IN(pb + 0)) norm_phase(xp, xs, a.in[14] + l * D, modl, 0, D, H, gw, ngw, lane);
        SEAM(pb + 0);
        if (PHM(2) && IN(pb + 1)) { Gemm g{H, wl + W_IN, M, NIN, D, D, 1, 0, 0}; StaticOrder S; S.init(M, NIN, G, blockIdx.x);
            EpiIn E{PROJ, SMALL, a.out, a.in[17] + l * 64, a.in[18] + l * 64, l}; gemm_phase(lds, g, S, E); }
        SEAM(pb + 1);
        SEAM(pb + 2); SEAM(pb + 3); SEAM(pb + 4);
        if (PHM(6) && IN(pb + 5)) { Gemm g{ZB, wl + W_GLU, M, 512, 512, 512, 1, 0, 0}; StaticOrder S; S.init(M, 512, G, blockIdx.x);
            EpiGlu E{ZB, a.in[29] + l * 512, BR}; gemm_phase(lds, g, S, E); }
        SEAM(pb + 5);
        if (PHM(7) && IN(pb + 6)) { Gemm g{BR, wl + W_BR, M, D, 512, D, 4, 512, (size_t)D * 512}; StaticOrder S; S.init(M, D, G, blockIdx.x, 4);
            EpiBranch E{PROJ, MACC, MERGED}; gemm_phase(lds, g, S, E); }
        SEAM(pb + 6);
        if (PHM(8) && IN(pb + 7)) { Gemm g{MERGED, wl + W_OUT, M, D, D, D, 1, 0, 0}; StaticOrder S; S.init(M, D, G, blockIdx.x);
            EpiResid E{xp, xs, modl, 2 * D, X}; gemm_phase(lds, g, S, E); }
        SEAM(pb + 7);
        if (PHM(9) && IN(pb + 8)) norm_phase(X, X + (size_t)MP * D, a.in[15] + l * D, modl, 3 * D, 4 * D, H, gw, ngw, lane);
        SEAM(pb + 8);
        if (PHM(10) && IN(pb + 9)) { Gemm g{H, wl + W_1, M, DFF, D, D, 1, 0, 0}; StaticOrder S; S.init(M, DFF, G, blockIdx.x);
            EpiRelu2 E{HID, DFF}; gemm_phase(lds, g, S, E); }
        SEAM(pb + 9);
        if (PHM(11) && IN(pb + 10)) { Gemm g{HID, wl + W_2, M, D, DFF, DFF, 1, 0, 0}; StaticOrder S; S.init(M, D, G, blockIdx.x);
            EpiResid E{X, X + (size_t)MP * D, modl, 5 * D, X}; gemm_phase(lds, g, S, E); }
        SEAM(pb + 10);
    }
#undef IN
#undef SEAM
}
}
static void mk_launch(const mk::Args& a0, int lo, int hi, int grid, hipStream_t st) {
    mk::Args a = a0; a.ph_lo = lo; a.ph_hi = hi;
    hipMemsetAsync(a.ws + mk::WS_CTL, 0, mk::CTL_BYTES, st);
    hipLaunchKernelGGL(mk::mk_fwd, dim3(grid), dim3(mk::NT), mk::LDS_BYTES, st, a);
}
extern "C" void kernel_launch(void* const* d_in, const int* in_sizes, int n_in, void* d_out, int out_size, void* d_ws, size_t ws_size, hipStream_t stream) {
    using namespace nv;
    static int grid = 0;
    if (grid == 0) {
        int dev = 0, cus = 0; hipGetDevice(&dev); hipDeviceGetAttribute(&cus, hipDeviceAttributeMultiprocessorCount, dev);
        hipFuncSetAttribute((const void*)mk::mk_fwd, hipFuncAttributeMaxDynamicSharedMemorySize, mk::LDS_BYTES);
        int per_cu = 0; hipOccupancyMaxActiveBlocksPerMultiprocessor(&per_cu, (const void*)mk::mk_fwd, mk::NT, mk::LDS_BYTES); (void)hipGetLastError();
        grid = cus > 0 ? cus : 256;
    }
    mk::Args a{}; for (int i = 0; i < 43; ++i) a.in[i] = (const float*)d_in[i];
    a.out = (float*)d_out; a.ws = (unsigned char*)d_ws;
    auto I = [&](int i) { return (const float*)d_in[i]; };
    float* out = (float*)d_out; unsigned char* ws = (unsigned char*)d_ws; hipStream_t st = stream;
    PBF pj{(const unsigned short*)(ws + mk::WS_PROJ), (const float*)(ws + mk::WS_SMALL)};
    unsigned short* BR = (unsigned short*)(ws + mk::WS_BR); unsigned short* ZB = (unsigned short*)(ws + mk::WS_ZB);
    float* XBC = (float*)(ws + mk::WS_SCR); float* YA = XBC + (size_t)M * 1024; float* QR = YA + (size_t)2 * M * 512; float* KR = QR + (size_t)M * 512;
    mk_launch(a, 0, 1, grid, st);
    for (int l = 0; l < DEPTH; ++l) {
        const int pb = 1 + l * mk::NPH;
        mk_launch(a, pb + 0, pb + 1, grid, st); mk_launch(a, pb + 1, pb + 2, grid, st);
        hipLaunchKernelGGL((k_attn_dense<PBF, unsigned short>), dim3(nb(MP * 8, 64)), dim3(64), 0, st, pj, BR);
        hipLaunchKernelGGL((k_attn_na<PBF, unsigned short>), dim3(nb(ML * 8, 64)), dim3(64), 0, st, pj, I(2), I(3), I(19) + (size_t)l * 8 * 15 * 31, l, BR);
        hipLaunchKernelGGL((k_s5<PBF>), dim3(NSEQ * 64), dim3(64), 0, st, pj, I(20) + l * 4096, I(21) + l * 4096, I(22) + l * 64, I(23) + (size_t)l * 65536, I(24) + (size_t)l * 65536,
                           I(25) + (size_t)l * 65536, I(26) + (size_t)l * 65536, I(4), I(5), l, YA, out);
        hipLaunchKernelGGL((k_s5_z<PBF, unsigned short>), dim3(nb((size_t)M * 512)), dim3(256), 0, st, pj, YA, I(27) + l * 512, ZB);
        mk_launch(a, pb + 5, pb + 6, grid, st);
        hipLaunchKernelGGL((k_ssd_conv<PBF>), dim3(nb((size_t)M * 1024)), dim3(256), 0, st, pj, I(30) + l * 5 * 1024, I(31) + l * 1024, XBC);
        hipLaunchKernelGGL((k_ssd_seq<PBF>), dim3(NSEQ * 16), dim3(64), 0, st, pj, XBC, I(32) + l * 16, I(33) + l * 16, I(6), l, YA, out);
        hipLaunchKernelGGL((k_ssd_fin<PBF, unsigned short>), dim3(M), dim3(256), 0, st, pj, XBC, YA, I(34) + l * 8, I(35) + l * 512, BR);
        hipLaunchKernelGGL((k_ml_rope<PBF>), dim3(nb((size_t)M * 512)), dim3(256), 0, st, pj, QR, KR);
        hipLaunchKernelGGL((k_ml_seq<PBF>), dim3(NSEQ * 8), dim3(128), 0, st, pj, QR, KR, I(36) + l * 8, I(37) + l * 8, I(7), I(8), I(9), l, YA, out);
        hipLaunchKernelGGL((k_ml_fin<PBF, unsigned short>), dim3(M), dim3(512), 0, st, pj, YA, I(38) + l * 512, BR);
        for (int k = 6; k < 11; ++k) mk_launch(a, pb + k, pb + k + 1, grid, st);
    }
}
```

```cpp
#define SAFE_GEMM 0
#include <hip/hip_runtime.h>
#include <math.h>
namespace mk {
#define LAS __attribute__((address_space(3)))
typedef unsigned short bf16_t;
typedef short bf16x8 __attribute__((ext_vector_type(8)));
typedef float f32x4 __attribute__((ext_vector_type(4)));
typedef float f32x2 __attribute__((ext_vector_type(2)));
typedef unsigned u32x4 __attribute__((ext_vector_type(4)));
typedef unsigned u32x2 __attribute__((ext_vector_type(2)));
constexpr int NT = 512, NWV = 8;
constexpr int D = 2048, MP = 4096, MLAT = 8192, M = MP + MLAT, DEPTH = 4, DFF = 8192;
constexpr int PJ = 13824;
constexpr int NIN = 14080;
constexpr int P_Q = 0, P_K = 512, P_V = 1024, P_S5U = 1536, P_Z = 2048, P_XBC = 2560, P_MQ = 3584, P_MK = 4096, P_MV = 4608, P_MO = 5120, P_GATE = 5632;
constexpr int S_DT = 0, S_MI = 16, S_MF = 24;

typedef __bf16 bf16x2_t __attribute__((ext_vector_type(2)));
__device__ __forceinline__ unsigned pk2(float lo, float hi) { f32x2 v = {lo, hi}; bf16x2_t b = __builtin_convertvector(v, bf16x2_t); return __builtin_bit_cast(unsigned, b); }
__device__ __forceinline__ float bf2f(bf16_t v) { return __uint_as_float(((unsigned)v) << 16); }
__device__ __forceinline__ float bflo(unsigned w) { return __uint_as_float(w << 16); }
__device__ __forceinline__ float bfhi(unsigned w) { return __uint_as_float(w & 0xffff0000u); }
__device__ __forceinline__ bf16_t f2bf(float f) { return (bf16_t)(pk2(f, 0.f) & 0xffffu); }
__device__ __forceinline__ float fsigm(float x) { return __builtin_amdgcn_rcpf(1.f + __expf(-x)); }
__device__ __forceinline__ float fsilu(float x) { return x * fsigm(x); }
__device__ __forceinline__ int row_cvec(int row) { return row < MP ? 0 : 1 + (row - MP) / 2048; }

#define XB_TMO      128
#define XB_XCNT(j)  (256  + 64 * (j))
#define XB_XSUB(j)  (1280 + 64 * (j))
#define XB_XGEN(j)  (2304 + 64 * (j))
#define XB_TOP      3328
#define XB_TOPGEN   3392
#define XCD_BAR_WORDS 3456
#define XB_SPIN_CAP (1u << 18)
__device__ __forceinline__ unsigned xb_ld(unsigned* p)              { return __hip_atomic_load(p, __ATOMIC_RELAXED, __HIP_MEMORY_SCOPE_AGENT); }
__device__ __forceinline__ unsigned xb_add(unsigned* p, unsigned v) { return __hip_atomic_fetch_add(p, v, __ATOMIC_RELAXED, __HIP_MEMORY_SCOPE_AGENT); }
__device__ __forceinline__ unsigned xb_xcc_id() { return (unsigned)__builtin_amdgcn_s_getreg((3 << 11) | 20) & 0xFu; }
#define XB_SPIN(cond, bar) do { unsigned _sp = 0; while (cond) { __builtin_amdgcn_s_sleep(1); \
    if ((++_sp & 255u) == 0u) { if (xb_ld(&(bar)[XB_TMO])) break; if (_sp > XB_SPIN_CAP) { atomicAdd(&(bar)[XB_TMO], 1u); break; } } } } while (0)
struct XcdBarrier { unsigned* bar; unsigned x; volatile LAS unsigned* st; };
__device__ __forceinline__ XcdBarrier xcd_barrier_post(unsigned* bar, volatile LAS unsigned* st) {
    XcdBarrier b; b.bar = bar; b.x = xb_xcc_id(); b.st = st;
    if (threadIdx.x == 0) (void)xb_add(&bar[XB_XCNT(b.x)], 1u);
    return b;
}
__device__ __forceinline__ void xcd_barrier_complete(unsigned* bar, unsigned x, unsigned& nloc, unsigned& nx) {
    const unsigned G = gridDim.x * gridDim.y * gridDim.z;
    unsigned sum, cnt, mine, sp = 0u;
    for (;;) {
        sum = 0u; cnt = 0u; mine = 0u;
#pragma unroll
        for (unsigned j = 0; j < 16; ++j) { const unsigned c = xb_ld(&bar[XB_XCNT(j)]); sum += c; cnt += (c > 0u) ? 1u : 0u; mine = (j == x) ? c : mine; }
        if (sum == G) break;
        __builtin_amdgcn_s_sleep(1);
        if ((++sp & 255u) == 0u) { if (xb_ld(&bar[XB_TMO])) break; if (sp > XB_SPIN_CAP) { atomicAdd(&bar[XB_TMO], 1u); break; } }
    }
    nloc = mine > 0u ? mine : 1u; nx = cnt > 0u ? cnt : 1u;
}
__device__ __forceinline__ void xcd_barrier(const XcdBarrier& b) {
    asm volatile("s_waitcnt vmcnt(0)" ::: "memory");
    __syncthreads();
    if (threadIdx.x == 0) {
        unsigned* bar = b.bar;
        __builtin_amdgcn_s_waitcnt(0);
        unsigned nloc = b.st[0], nx = b.st[1];
        if (nloc == 0u) { xcd_barrier_complete(bar, b.x, nloc, nx); b.st[0] = nloc; b.st[1] = nx; }
        const unsigned old = xb_add(&bar[XB_XSUB(b.x)], 1u);
        const unsigned gen = old / nloc;
        if (old + 1u == (gen + 1u) * nloc) {
            __builtin_amdgcn_fence(__ATOMIC_RELEASE, "agent");
            asm volatile("s_waitcnt vmcnt(0)" ::: "memory");
            const unsigned og = xb_add(&bar[XB_TOP], 1u);
            const unsigned tg = og / nx;
            if (og + 1u == (tg + 1u) * nx) xb_add(&bar[XB_TOPGEN], 1u);
            else XB_SPIN(xb_ld(&bar[XB_TOPGEN]) == tg, bar);
            __builtin_amdgcn_fence(__ATOMIC_ACQUIRE, "agent");
            xb_add(&bar[XB_XGEN(b.x)], 1u);
            asm volatile("s_waitcnt vmcnt(0)" ::: "memory");
        } else {
            XB_SPIN(xb_ld(&bar[XB_XGEN(b.x)]) == gen, bar);
            __builtin_amdgcn_fence(__ATOMIC_ACQUIRE, "agent");
            asm volatile("s_waitcnt vmcnt(0)" ::: "memory");
        }
    }
    __syncthreads();
}

constexpr int BM = 256, BK = 64, HALF = 128, HTB = HALF * BK * 2, STAGE_BYTES = 8 * HTB, NXCD = 8, WGM = 8;
__host__ __device__ __forceinline__ int lds_byte(int r, int c) { const int st = (r >> 4) * 2 + (c >> 5), rr = r & 15, cc = c & 31, ob = rr * 64 + cc * 2; return st * 1024 + (ob ^ (((ob >> 9) & 1) << 5)); }
__host__ __device__ __forceinline__ void stage_rc(int b, int& R, int& C) { const int st = b / 1024, sb = b % 1024, swz = sb ^ (((sb >> 9) & 1) << 5); R = (st >> 1) * 16 + swz / 64; C = (st & 1) * 32 + (swz % 64) / 2; }
__host__ __device__ __forceinline__ int perm32(int rho) { const int n = rho >> 4, i = rho & 15; return 8 * (i >> 2) + 4 * n + (i & 3); }

struct Unit { int pm, pn, kz; };
struct Gemm { const bf16_t* A; const bf16_t* Bt; int M, N, K, lda, nkz; size_t a_kz, b_kz; };

struct StaticOrder {
    int nM, nN, nwg, G, c, nkz;
    __device__ void init(int M_, int N_, int G_, int c_, int nkz_ = 1) { nM = M_ / BM; nN = N_ / BM; nwg = nM * nN; G = G_; c = c_; nkz = nkz_; }
    __device__ bool next(int i, Unit& u) const {
        const int it = i / nkz; u.kz = i - it * nkz;
        const long L = (long)it * G + c; if (L >= nwg) return false;
        int wgid = (int)L; { const int q = nwg / NXCD, r = nwg % NXCD, xcd = wgid % NXCD, off = wgid / NXCD; wgid = (xcd < r ? xcd * (q + 1) : r * (q + 1) + (xcd - r) * q) + off; }
        const int nig = WGM * nN, gid = wgid / nig, fm = gid * WGM, gsz = (nM - fm) < WGM ? (nM - fm) : WGM;
        u.pm = fm + ((wgid % nig) % gsz); u.pn = (wgid % nig) / gsz; return true;
    }
};

template <class Epi>
__device__ __forceinline__ void gemm_phase(LAS unsigned char* lds, const Gemm g, const StaticOrder& S, const Epi& E) {
    int tid_ = threadIdx.x; asm volatile("" : "+v"(tid_));
    const int tid = tid_, wid = __builtin_amdgcn_readfirstlane(tid >> 6), lane = tid & 63, wr = wid >> 2, wc = wid & 3, fr = lane & 15, fq = lane >> 4;
    const int K = g.K, nt = K / BK;
    unsigned voffA[2], voffB[2];
#pragma unroll
    for (int i = 0; i < 2; ++i) { int R, C; stage_rc(tid * 16 + i * 8192, R, C); const int Rb = Epi::PERM ? ((R & ~31) + perm32(R & 31)) : R;
        voffA[i] = (unsigned)(R * g.lda + C) * 2u; voffB[i] = (unsigned)(Rb * K + C) * 2u; }
    const size_t kstep = (size_t)(BK * 2);
    const size_t hstepA = (size_t)HALF * g.lda * 2, hstepB = (size_t)HALF * K * 2;
    const size_t tstepA = 2 * hstepA, tstepB = 2 * hstepB;
    const unsigned ldsw = (unsigned)wid * 1024u;
    const int aoff = lds_byte(wr * 64 + fr, fq * 8), boff = lds_byte(wc * 32 + fr, fq * 8);
#define PG8_SA(b, h) (((b) * 2 + (h)) * HTB)
#define PG8_SB(b, h) ((4 + (b) * 2 + (h)) * HTB)
#define PG8_STAGE(bufoff, gbase, voff) do { _Pragma("unroll") for (int _i = 0; _i < 2; ++_i) \
        __builtin_amdgcn_global_load_lds((const unsigned*)((const char*)(gbase) + (voff)[_i]), (LAS unsigned*)(lds + (bufoff) + ldsw + _i * 8192), 16, 0, 0); } while (0)
#define PG8_LDA(dst, b, h) do { _Pragma("unroll") for (int m = 0; m < 4; ++m) _Pragma("unroll") for (int k = 0; k < 2; ++k) dst[m][k] = *(const LAS bf16x8*)(lds + PG8_SA(b, h) + aoff + m * 2048 + k * 1024); } while (0)
#define PG8_LDB(dst, b, h) do { _Pragma("unroll") for (int n = 0; n < 2; ++n) _Pragma("unroll") for (int k = 0; k < 2; ++k) dst[n][k] = *(const LAS bf16x8*)(lds + PG8_SB(b, h) + boff + n * 2048 + k * 1024); } while (0)
#define PG8_MMA(ai, bj, At, Bt) do { __builtin_amdgcn_s_setprio(1); _Pragma("unroll") for (int m = 0; m < 4; ++m) _Pragma("unroll") for (int n = 0; n < 2; ++n) _Pragma("unroll") for (int k = 0; k < 2; ++k) \
        acc[ai][bj][m][n] = __builtin_amdgcn_mfma_f32_16x16x32_bf16(Bt[n][k], At[m][k], acc[ai][bj][m][n], 0, 0, 0); __builtin_amdgcn_s_setprio(0); } while (0)
#if SAFE_GEMM == 1 || SAFE_GEMM == 3
#define PG8_WAIT_V(n) asm volatile("s_waitcnt vmcnt(0)" ::: "memory")
#else
#define PG8_WAIT_V(n) asm volatile("s_waitcnt vmcnt(" #n ")" ::: "memory")
#endif
#define PG8_WAIT_L(n) asm volatile("s_waitcnt lgkmcnt(" #n ")" ::: "memory")
#if SAFE_GEMM == 1
#define PG8_BAR do { asm volatile("s_waitcnt vmcnt(0) lgkmcnt(0)" ::: "memory"); __builtin_amdgcn_s_barrier(); asm volatile("" ::: "memory"); } while (0)
#elif SAFE_GEMM == 2
#define PG8_BAR asm volatile("s_barrier" ::: "memory")
#elif SAFE_GEMM == 4
#define PG8_BAR do { asm volatile("s_waitcnt lgkmcnt(0)" ::: "memory"); __builtin_amdgcn_s_barrier(); } while (0)
#else
#define PG8_BAR __builtin_amdgcn_s_barrier()
#endif
#define PG8_SCHED __builtin_amdgcn_sched_barrier(0)
    Unit cur, nxt; int ui = 0;
    if (!S.next(0, cur)) return;
    f32x4 acc[2][2][4][2];
#pragma unroll
    for (int a = 0; a < 2; ++a)
#pragma unroll
        for (int b = 0; b < 2; ++b)
#pragma unroll
            for (int m = 0; m < 4; ++m)
#pragma unroll
                for (int n = 0; n < 2; ++n) acc[a][b][m][n] = (f32x4){0.f, 0.f, 0.f, 0.f};
    bf16x8 At[4][2], B0[2][2], B1[2][2];
    const char* cA = (const char*)(g.A + (size_t)cur.kz * g.a_kz) + (size_t)cur.pm * tstepA; const char* cB = (const char*)(g.Bt + (size_t)cur.kz * g.b_kz) + (size_t)cur.pn * tstepB;
    PG8_STAGE(PG8_SB(0, 0), cB, voffB); PG8_STAGE(PG8_SA(0, 0), cA, voffA); PG8_STAGE(PG8_SB(0, 1), cB + hstepB, voffB); PG8_STAGE(PG8_SA(0, 1), cA + hstepA, voffA);
    if (wr == 1) PG8_BAR;
    PG8_WAIT_V(4); PG8_BAR;
    PG8_STAGE(PG8_SB(1, 0), cB + kstep, voffB); PG8_STAGE(PG8_SA(1, 0), cA + kstep, voffA); PG8_STAGE(PG8_SB(1, 1), cB + hstepB + kstep, voffB);
    PG8_WAIT_V(6); PG8_BAR;
    for (;;) {
        const bool has_next = S.next(ui + 1, nxt);
        const char* nA = has_next ? (const char*)(g.A + (size_t)nxt.kz * g.a_kz) + (size_t)nxt.pm * tstepA : cA;
        const char* nB = has_next ? (const char*)(g.Bt + (size_t)nxt.kz * g.b_kz) + (size_t)nxt.pn * tstepB : cB;
        for (int t = 0; t < nt; t += 2) {
            const bool last = (t == nt - 2);
            const char* a1 = cA + (size_t)(t + 1) * kstep;
            const char* a2 = last ? nA : cA + (size_t)(t + 2) * kstep; const char* b2 = last ? nB : cB + (size_t)(t + 2) * kstep;
            const char* a3 = a2 + kstep; const char* b3 = b2 + kstep;
            PG8_LDB(B0, 0, 0); PG8_SCHED; PG8_LDA(At, 0, 0); PG8_STAGE(PG8_SA(1, 1), a1 + hstepA, voffA);
            PG8_WAIT_L(8); PG8_BAR; PG8_WAIT_L(0); PG8_MMA(0, 0, At, B0); PG8_BAR; PG8_SCHED;
            PG8_LDB(B1, 0, 1); PG8_STAGE(PG8_SB(0, 0), b2, voffB);
            PG8_BAR; PG8_WAIT_L(0); PG8_MMA(0, 1, At, B1); PG8_BAR;
            PG8_LDA(At, 0, 1); PG8_STAGE(PG8_SA(0, 0), a2, voffA);
            PG8_BAR; PG8_WAIT_L(0); PG8_MMA(1, 0, At, B0); PG8_BAR; PG8_SCHED;
            PG8_STAGE(PG8_SB(0, 1), b2 + hstepB, voffB);
            PG8_WAIT_V(6); PG8_BAR; PG8_MMA(1, 1, At, B1); PG8_BAR;
            PG8_LDB(B0, 1, 0); PG8_SCHED; PG8_LDA(At, 1, 0); PG8_STAGE(PG8_SA(0, 1), a2 + hstepA, voffA);
            PG8_WAIT_L(8); PG8_BAR; PG8_WAIT_L(0); PG8_MMA(0, 0, At, B0); PG8_BAR; PG8_SCHED;
            PG8_LDB(B1, 1, 1); PG8_STAGE(PG8_SB(1, 0), b3, voffB);
            PG8_BAR; PG8_WAIT_L(0); PG8_MMA(0, 1, At, B1); PG8_BAR;
            PG8_LDA(At, 1, 1); PG8_STAGE(PG8_SA(1, 0), a3, voffA);
            PG8_BAR; PG8_WAIT_L(0); PG8_MMA(1, 0, At, B0); PG8_BAR; PG8_SCHED;
            PG8_STAGE(PG8_SB(1, 1), b3 + hstepB, voffB);
            PG8_WAIT_V(6); PG8_BAR; PG8_MMA(1, 1, At, B1); PG8_BAR;
        }
        E(acc, cur, wr, wc, fr, fq);
        asm volatile("s_waitcnt vmcnt(0)" ::: "memory");
        if (!has_next) break;
#pragma unroll
        for (int a = 0; a < 2; ++a)
#pragma unroll
            for (int b = 0; b < 2; ++b)
#pragma unroll
                for (int m = 0; m < 4; ++m)
#pragma unroll
                    for (int n = 0; n < 2; ++n) acc[a][b][m][n] = (f32x4){0.f, 0.f, 0.f, 0.f};
        cur = nxt; cA = nA; cB = nB; ++ui;
    }
    PG8_WAIT_V(0);
    if (wr == 0) PG8_BAR;
    PG8_BAR;
#undef PG8_SA
#undef PG8_SB
#undef PG8_STAGE
#undef PG8_LDA
#undef PG8_LDB
#undef PG8_MMA
#undef PG8_WAIT_V
#undef PG8_WAIT_L
#undef PG8_BAR
#undef PG8_SCHED
}
}
namespace mk {
constexpr size_t O_YP = 0, O_YS = 8388608, O_NK = 25165824, O_NV = 33554432, O_S5R = 41943040, O_S5I = 42205184, O_SSD = 42467328,
                 O_MLC = 50855936, O_MLN = 59244544, O_MLM = 59310080;

__device__ __forceinline__ u32x4 pack8(const f32x4 a, const f32x4 b) { u32x4 w; w.x = pk2(a[0], a[1]); w.y = pk2(a[2], a[3]); w.z = pk2(b[0], b[1]); w.w = pk2(b[2], b[3]); return w; }

struct EpiIn {
    static constexpr bool PERM = true;
    bf16_t* proj; float* small; float* out; const float* qg; const float* kg; int layer;
    __device__ __forceinline__ void operator()(const f32x4 (&acc)[2][2][4][2], const Unit& u, int wr, int wc, int fr, int fq) const {
        const int T = u.pn, rowb = u.pm * BM + wr * 64 + fr;
        if (T == 54) {
            if (wc == 0) {
#pragma unroll
                for (int ai = 0; ai < 2; ++ai)
#pragma unroll
                    for (int m = 0; m < 4; ++m) { float* sp = small + (size_t)(rowb + ai * HALF + m * 16) * 32 + 8 * fq; *(f32x4*)sp = acc[ai][0][m][0]; *(f32x4*)(sp + 4) = acc[ai][0][m][1]; }
            }
            return;
        }
        const int colb = T * 256 + 64 * wc + 8 * fq;
        if (T < 4) {
            const float* g = T < 2 ? qg : kg;
            f32x4 gv[2][2];
#pragma unroll
            for (int bj = 0; bj < 2; ++bj)
#pragma unroll
                for (int n = 0; n < 2; ++n) gv[bj][n] = *(const f32x4*)(g + 32 * bj + 8 * fq + 4 * n);
#pragma unroll
            for (int ai = 0; ai < 2; ++ai)
#pragma unroll
                for (int m = 0; m < 4; ++m) {
                    float ss = 0.f;
#pragma unroll
                    for (int bj = 0; bj < 2; ++bj)
#pragma unroll
                        for (int n = 0; n < 2; ++n) { const f32x4 x = acc[ai][bj][m][n]; ss += (x[0] * x[0] + x[1] * x[1]) + (x[2] * x[2] + x[3] * x[3]); }
                    ss += __shfl_xor(ss, 16); ss += __shfl_xor(ss, 32);
                    const float r = rsqrtf(ss * (1.f / 64.f) + 1e-6f);
                    const int row = rowb + ai * HALF + m * 16;
#pragma unroll
                    for (int bj = 0; bj < 2; ++bj) { const f32x4 v0 = acc[ai][bj][m][0] * r * gv[bj][0], v1 = acc[ai][bj][m][1] * r * gv[bj][1];
                        *(u32x4*)(proj + (size_t)row * PJ + colb + 32 * bj) = pack8(v0, v1);
                        if (T >= 2 && row < MP) { float* o = out + O_NK + ((size_t)((row >> 8) * DEPTH + layer) * 256 + (row & 255)) * 512 + (colb - 512) + 32 * bj; *(f32x4*)o = v0; *(f32x4*)(o + 4) = v1; } }
                }
        } else if (T < 6) {
#pragma unroll
            for (int ai = 0; ai < 2; ++ai)
#pragma unroll
                for (int m = 0; m < 4; ++m) { const int row = rowb + ai * HALF + m * 16;
#pragma unroll
                    for (int bj = 0; bj < 2; ++bj) { const f32x4 v0 = acc[ai][bj][m][0], v1 = acc[ai][bj][m][1];
                        *(u32x4*)(proj + (size_t)row * PJ + colb + 32 * bj) = pack8(v0, v1);
                        if (row < MP) { float* o = out + O_NV + ((size_t)((row >> 8) * DEPTH + layer) * 256 + (row & 255)) * 512 + (colb - 1024) + 32 * bj; *(f32x4*)o = v0; *(f32x4*)(o + 4) = v1; } } }
        } else if (T < 22) {
#pragma unroll
            for (int ai = 0; ai < 2; ++ai)
#pragma unroll
                for (int m = 0; m < 4; ++m) { const int row = rowb + ai * HALF + m * 16;
#pragma unroll
                    for (int bj = 0; bj < 2; ++bj) *(u32x4*)(proj + (size_t)row * PJ + colb + 32 * bj) = pack8(acc[ai][bj][m][0], acc[ai][bj][m][1]); }
        } else {
#pragma unroll
            for (int ai = 0; ai < 2; ++ai)
#pragma unroll
                for (int m = 0; m < 4; ++m) { const int row = rowb + ai * HALF + m * 16;
#pragma unroll
                    for (int bj = 0; bj < 2; ++bj) { f32x4 v0 = acc[ai][bj][m][0], v1 = acc[ai][bj][m][1];
#pragma unroll
                        for (int j = 0; j < 4; ++j) { v0[j] = fsigm(v0[j]); v1[j] = fsigm(v1[j]); }
                        *(u32x4*)(proj + (size_t)row * PJ + colb + 32 * bj) = pack8(v0, v1); } }
        }
    }
};
struct EpiRelu2 {
    static constexpr bool PERM = true;
    bf16_t* O; int ldo;
    __device__ __forceinline__ void operator()(const f32x4 (&acc)[2][2][4][2], const Unit& u, int wr, int wc, int fr, int fq) const {
        const int rowb = u.pm * BM + wr * 64 + fr, colb = u.pn * 256 + 64 * wc + 8 * fq;
#pragma unroll
        for (int ai = 0; ai < 2; ++ai)
#pragma unroll
            for (int m = 0; m < 4; ++m) { const int row = rowb + ai * HALF + m * 16;
#pragma unroll
                for (int bj = 0; bj < 2; ++bj) { f32x4 v0 = acc[ai][bj][m][0], v1 = acc[ai][bj][m][1];
#pragma unroll
                    for (int j = 0; j < 4; ++j) { const float a = fmaxf(v0[j], 0.f), b = fmaxf(v1[j], 0.f); v0[j] = a * a; v1[j] = b * b; }
                    *(u32x4*)(O + (size_t)row * ldo + colb + 32 * bj) = pack8(v0, v1); } }
    }
};
struct EpiGlu {
    static constexpr bool PERM = true;
    const bf16_t* Z; const float* bias; bf16_t* br;
    __device__ __forceinline__ void operator()(const f32x4 (&acc)[2][2][4][2], const Unit& u, int wr, int wc, int fr, int fq) const {
        const int rowb = u.pm * BM + wr * 64 + fr, colb = u.pn * 256 + 64 * wc + 8 * fq;
#pragma unroll
        for (int bj = 0; bj < 2; ++bj) { const int c = colb + 32 * bj; const f32x4 b0 = *(const f32x4*)(bias + c), b1 = *(const f32x4*)(bias + c + 4);
#pragma unroll
            for (int ai = 0; ai < 2; ++ai)
#pragma unroll
                for (int m = 0; m < 4; ++m) { const int row = rowb + ai * HALF + m * 16;
                    const u32x4 zz = *(const u32x4*)(Z + (size_t)row * 512 + c);
                    f32x4 v0 = acc[ai][bj][m][0] + b0, v1 = acc[ai][bj][m][1] + b1;
                    v0[0] = bflo(zz.x) * fsigm(v0[0]); v0[1] = bfhi(zz.x) * fsigm(v0[1]); v0[2] = bflo(zz.y) * fsigm(v0[2]); v0[3] = bfhi(zz.y) * fsigm(v0[3]);
                    v1[0] = bflo(zz.z) * fsigm(v1[0]); v1[1] = bfhi(zz.z) * fsigm(v1[1]); v1[2] = bflo(zz.w) * fsigm(v1[2]); v1[3] = bfhi(zz.w) * fsigm(v1[3]);
                    *(u32x4*)(br + (size_t)row * D + 512 + c) = pack8(v0, v1); } }
    }
};
struct EpiBranch {
    static constexpr bool PERM = true;
    const bf16_t* proj; float* macc; bf16_t* merged;
    __device__ __forceinline__ void operator()(const f32x4 (&acc)[2][2][4][2], const Unit& u, int wr, int wc, int fr, int fq) const {
        const int rowb = u.pm * BM + wr * 64 + fr, colb = u.pn * 256 + 64 * wc + 8 * fq, kz = u.kz;
#pragma unroll
        for (int ai = 0; ai < 2; ++ai)
#pragma unroll
            for (int m = 0; m < 4; ++m) { const int row = rowb + ai * HALF + m * 16;
#pragma unroll
                for (int bj = 0; bj < 2; ++bj) { const int c = colb + 32 * bj;
                    const u32x4 gg = *(const u32x4*)(proj + (size_t)row * PJ + P_GATE + kz * D + c);
                    f32x4 v0 = acc[ai][bj][m][0], v1 = acc[ai][bj][m][1];
                    v0[0] *= bflo(gg.x); v0[1] *= bfhi(gg.x); v0[2] *= bflo(gg.y); v0[3] *= bfhi(gg.y); v1[0] *= bflo(gg.z); v1[1] *= bfhi(gg.z); v1[2] *= bflo(gg.w); v1[3] *= bfhi(gg.w);
                    float* mp = macc + (size_t)row * D + c;
                    if (kz > 0) { v0 += *(const f32x4*)mp; v1 += *(const f32x4*)(mp + 4); }
                    if (kz < 3) { *(f32x4*)mp = v0; *(f32x4*)(mp + 4) = v1; }
                    else *(u32x4*)(merged + (size_t)row * D + c) = pack8(v0, v1); } }
    }
};
struct EpiResid {
    static constexpr bool PERM = false;
    const float* xp; const float* xs; const float* modl; int g_off; float* xout;
    __device__ __forceinline__ void operator()(const f32x4 (&acc)[2][2][4][2], const Unit& u, int wr, int wc, int fr, int fq) const {
        const int row0 = u.pm * BM, rowb = row0 + wr * 64 + fr, colb = u.pn * 256 + wc * 32 + 4 * fq;
        const float* xin = row0 < MP ? xp : xs - (size_t)MP * D;
        const float* gate = modl + (size_t)row_cvec(row0) * 6 * D + g_off;
        f32x4 gv[2][2];
#pragma unroll
        for (int bj = 0; bj < 2; ++bj)
#pragma unroll
            for (int n = 0; n < 2; ++n) gv[bj][n] = *(const f32x4*)(gate + colb + bj * HALF + n * 16);
#pragma unroll
        for (int ai = 0; ai < 2; ++ai)
#pragma unroll
            for (int m = 0; m < 4; ++m) { const size_t ro = (size_t)(rowb + ai * HALF + m * 16) * D + colb;
#pragma unroll
                for (int bj = 0; bj < 2; ++bj)
#pragma unroll
                    for (int n = 0; n < 2; ++n) { const size_t o = ro + bj * HALF + n * 16; *(f32x4*)(xout + o) = *(const f32x4*)(xin + o) + gv[bj][n] * acc[ai][bj][m][n]; } }
    }
};
}
namespace mk {
constexpr size_t AL(size_t x) { return (x + 255) & ~(size_t)255; }
constexpr size_t WS_CTL = 0, CTL_BYTES = 65536;
constexpr size_t WS_MOD = WS_CTL + CTL_BYTES;
constexpr size_t WS_W = AL(WS_MOD + (size_t)DEPTH * 5 * 6 * D * 4);
constexpr size_t W_IN = 0, W_GLU = W_IN + (size_t)NIN * D, W_BR = W_GLU + 512 * 512, W_OUT = W_BR + (size_t)4 * D * 512, W_1 = W_OUT + (size_t)D * D, W_2 = W_1 + (size_t)DFF * D,
                 W_LAYER = W_2 + (size_t)D * DFF;
constexpr size_t WS_H = AL(WS_W + W_LAYER * 2 * DEPTH);
constexpr size_t WS_PROJ = AL(WS_H + (size_t)M * D * 2);
constexpr size_t WS_SMALL = AL(WS_PROJ + (size_t)M * PJ * 2);
constexpr size_t WS_BR = AL(WS_SMALL + (size_t)M * 32 * 4);
constexpr size_t WS_MERGED = AL(WS_BR + (size_t)M * D * 2);
constexpr size_t WS_MACC = AL(WS_MERGED + (size_t)M * D * 2);
constexpr size_t WS_ZB = AL(WS_MACC + (size_t)M * D * 4);
constexpr size_t WS_SCR = AL(WS_ZB + (size_t)M * 512 * 2);
constexpr int LDS_BYTES = 140 * 1024, LDS_CTL = STAGE_BYTES;

struct Args { const float* in[43]; float* out; unsigned char* ws; int ph_lo, ph_hi; };

__device__ __forceinline__ float wave_sum(float v) {
#pragma unroll
    for (int o = 1; o < 64; o <<= 1) v += __shfl_xor(v, o);
    return v;
}
#define LDS_WAIT() asm volatile("s_waitcnt lgkmcnt(0)" ::: "memory")

__device__ __forceinline__ void xpose_item(const float* W, int ldw, int k0, int sc, bf16_t* dst, int K, LAS float* scr, int lane, int mode) {
    const int j = lane & 31;
    const int col = mode == 1 ? (j < 16 ? 3584 + j : 5648 + (j - 16)) : sc + j;
#pragma unroll 8
    for (int i = 0; i < 32; ++i) { const int kk = 2 * i + (lane >> 5); scr[kk * 33 + j] = mode == 2 ? 0.f : W[(size_t)(k0 + kk) * ldw + col]; }
    LDS_WAIT(); asm volatile("" ::: "memory");
    const int c = lane & 7;
#pragma unroll
    for (int jj = 0; jj < 4; ++jj) { const int n = (lane >> 3) + 8 * jj; const LAS float* s = scr + (8 * c) * 33 + n;
        u32x4 o; o.x = pk2(s[0 * 33], s[1 * 33]); o.y = pk2(s[2 * 33], s[3 * 33]); o.z = pk2(s[4 * 33], s[5 * 33]); o.w = pk2(s[6 * 33], s[7 * 33]);
        *(u32x4*)(dst + (size_t)n * K + k0 + 8 * c) = o; }
    LDS_WAIT(); asm volatile("" ::: "memory");
}
__device__ __forceinline__ int hm_col(int grp) { const int T = grp >> 3, q8 = grp & 7; return 256 * T + 32 * (2 * (q8 & 3) + (q8 >> 2)); }

__device__ __forceinline__ void prologue_convert(const Args& a, LAS unsigned char* lds, int gw, int ngw, int wave, int lane) {
    LAS float* scr = (LAS float*)(lds + wave * 8704);
    bf16_t* WB = (bf16_t*)(a.ws + WS_W);
    constexpr int I_IN = 440 * 32, I_GLU = 16 * 8, I_BR = 4 * 64 * 8, I_OUT = 64 * 32, I_1 = 256 * 32, I_2 = 64 * 128, I_L = I_IN + I_GLU + I_BR + I_OUT + I_1 + I_2;
    for (int it = gw; it < I_L * DEPTH; it += ngw) {
        const int l = it / I_L; int r = it - l * I_L; bf16_t* wl = WB + (size_t)l * W_LAYER;
        if (r < I_IN) { const int kb = r / 440, grp = r % 440, T = grp >> 3; int sc = hm_col(grp), mode = 0;
            if (T == 54) mode = (grp & 7) == 0 ? 1 : 2; else if (T >= 22) sc += 32; else if (T >= 14) sc += 16;
            xpose_item(a.in[16] + (size_t)l * D * 13856, 13856, 64 * kb, sc, wl + W_IN + (size_t)(32 * grp) * D, D, scr, lane, mode); continue; } r -= I_IN;
        if (r < I_GLU) { const int kb = r / 16, grp = r % 16; xpose_item(a.in[28] + (size_t)l * 512 * 512, 512, 64 * kb, hm_col(grp), wl + W_GLU + (size_t)(32 * grp) * 512, 512, scr, lane, 0); continue; } r -= I_GLU;
        if (r < I_BR) { const int k = r / 512, r2 = r % 512, kb = r2 / 64, grp = r2 % 64;
            xpose_item(a.in[39] + ((size_t)l * 4 + k) * 512 * D, D, 64 * kb, hm_col(grp), wl + W_BR + (size_t)k * D * 512 + (size_t)(32 * grp) * 512, 512, scr, lane, 0); continue; } r -= I_BR;
        if (r < I_OUT) { const int kb = r / 64, grp = r % 64; xpose_item(a.in[40] + (size_t)l * D * D, D, 64 * kb, 32 * grp, wl + W_OUT + (size_t)(32 * grp) * D, D, scr, lane, 0); continue; } r -= I_OUT;
        if (r < I_1) { const int kb = r / 256, grp = r % 256; xpose_item(a.in[41] + (size_t)l * D * DFF, DFF, 64 * kb, hm_col(grp), wl + W_1 + (size_t)(32 * grp) * D, D, scr, lane, 0); continue; } r -= I_1;
        { const int kb = r / 64, grp = r % 64; xpose_item(a.in[42] + (size_t)l * DFF * D, D, 64 * kb, 32 * grp, wl + W_2 + (size_t)(32 * grp) * DFF, DFF, scr, lane, 0); }
    }
}
__device__ __forceinline__ void prologue_ada(const Args& a, LAS unsigned char* lds, int tid) {
    LAS float* sl = (LAS float*)lds;
    LAS float* red = (LAS float*)(lds + 40960);
    float* mod = (float*)(a.ws + WS_MOD);
    for (int i = tid; i < 5 * D; i += NT) { const int j = i / D, k = i % D; const float x = j == 0 ? a.in[11][k] : a.in[10][(j - 1) * D + k]; sl[i] = x / (1.f + __expf(-x)); }
    __syncthreads();
    const int ks = tid >> 6, c = tid & 63;
    for (int unit = blockIdx.x; unit < DEPTH * 6 * D / 64; unit += gridDim.x) {
        const int l = unit / (6 * D / 64), n0 = (unit % (6 * D / 64)) * 64;
        const float* w = a.in[12] + (size_t)l * D * 6 * D + n0 + c;
        float acc[5] = {0.f, 0.f, 0.f, 0.f, 0.f};
#pragma unroll 4
        for (int k = ks * 256; k < ks * 256 + 256; ++k) { const float wv = w[(size_t)k * 6 * D];
#pragma unroll
            for (int j = 0; j < 5; ++j) acc[j] += sl[j * D + k] * wv; }
#pragma unroll
        for (int j = 0; j < 5; ++j) red[(ks * 5 + j) * 64 + c] = acc[j];
        __syncthreads();
        if (tid < 320) { const int j = tid >> 6; float s = 0.f;
#pragma unroll
            for (int q = 0; q < 8; ++q) s += red[(q * 5 + j) * 64 + c];
            mod[((size_t)l * 5 + j) * 6 * D + n0 + c] = s + a.in[13][l * 6 * D + n0 + c]; }
        __syncthreads();
    }
}
__device__ __forceinline__ void norm_phase(const float* xp, const float* xs, const float* g, const float* modl, int sh_off, int sc_off, bf16_t* H, int gw, int ngw, int lane_) {
    int lane = lane_; asm volatile("" : "+v"(lane));
    for (int row = gw; row < M; row += ngw) {
        const float* x = row < MP ? xp + (size_t)row * D : xs + (size_t)(row - MP) * D;
        f32x4 v[8]; float ss = 0.f;
#pragma unroll
        for (int j = 0; j < 8; ++j) { v[j] = *(const f32x4*)(x + 4 * (lane + 64 * j)); ss += (v[j][0] * v[j][0] + v[j][1] * v[j][1]) + (v[j][2] * v[j][2] + v[j][3] * v[j][3]); }
        const float r = rsqrtf(wave_sum(ss) * (1.f / D) + 1e-6f);
        const float* md = modl + (size_t)row_cvec(row) * 6 * D;
#pragma unroll
        for (int j = 0; j < 8; ++j) { const int i = 4 * (lane + 64 * j);
            const f32x4 gg = *(const f32x4*)(g + i), sc = *(const f32x4*)(md + sc_off + i), sh = *(const f32x4*)(md + sh_off + i);
            const f32x4 o = v[j] * r * gg * (sc + 1.f) + sh;
            u32x2 w; w.x = pk2(o[0], o[1]); w.y = pk2(o[2], o[3]); *(u32x2*)(H + (size_t)row * D + i) = w; }
    }
}

}
namespace mk {
constexpr int C_Q = 0, C_K = 512, C_V = 1024, C_S5U = 1536, C_Z = 2048, C_XBC = 2560, C_DT = 3584, C_MQ = 3600, C_MK = 4112, C_MV = 4624, C_MO = 5136, C_MI = 5648, C_MF = 5656;
constexpr int NSEQ = 20;
struct PJA {
    const bf16_t* p; const float* sm;
    __device__ __forceinline__ float operator()(int row, int col) const {
        if (col < 3584) return bf2f(p[(size_t)row * PJ + col]);
        if (col < 3600) return sm[(size_t)row * 32 + col - 3584];
        if (col < 5648) return bf2f(p[(size_t)row * PJ + col - 16]);
        if (col < 5664) return sm[(size_t)row * 32 + 16 + col - 5648];
        return bf2f(p[(size_t)row * PJ + col - 32]);
    }
};
__device__ __forceinline__ void seq_info(int sq, int& row0, int& L, int& lat, int& b) {
    if (sq < 16) { row0 = sq * 256; L = 256; lat = 0; b = sq; } else { b = sq - 16; row0 = MP + b * 2048; L = 2048; lat = 1; }
}
__device__ __forceinline__ float nsilu(float x) { return x / (1.f + expf(-x)); }
__device__ __forceinline__ float nsigm(float x) { return 1.f / (1.f + expf(-x)); }
__device__ __forceinline__ float nsoftplus(float x) { return x > 20.f ? x : log1pf(expf(x)); }
__device__ __forceinline__ float ngelu(float x) { return 0.5f * x * (1.f + tanhf(0.7978845608028654f * (x + 0.044715f * x * x * x))); }

__device__ __forceinline__ void nv_attn_dense(const PJA& proj, bf16_t* br, int idx) {
    const int hh = idx % 8, row = idx / 8, b = row / 256;
    float q[64], o[64];
#pragma unroll
    for (int i = 0; i < 64; ++i) { q[i] = proj(row, C_Q + hh * 64 + i); o[i] = 0.f; }
    float mx = -1e30f, sum = 0.f;
    for (int s = 0; s < 256; ++s) { const int kr_ = b * 256 + s;
        float sc = 0;
#pragma unroll
        for (int i = 0; i < 64; ++i) sc += q[i] * proj(kr_, C_K + hh * 64 + i);
        sc *= 0.125f;
        const float mn = fmaxf(mx, sc), a = expf(mx - mn), p = expf(sc - mn); sum = sum * a + p;
#pragma unroll
        for (int i = 0; i < 64; ++i) o[i] = o[i] * a + p * proj(kr_, C_V + hh * 64 + i);
        mx = mn; }
#pragma unroll
    for (int i = 0; i < 64; ++i) br[(size_t)row * D + hh * 64 + i] = f2bf(o[i] / sum);
}
__device__ __forceinline__ void nv_attn_na(const PJA& proj, const float* ck, const float* cv, const float* rpb, int layer, bf16_t* br, int idx) {
    const int hh = idx % 8, lt = idx / 8, b = lt / 2048, t = lt % 2048, r = t / 64, c = t % 64;
    const int row = MP + lt; float q[64], o[64];
#pragma unroll
    for (int i = 0; i < 64; ++i) { q[i] = proj(row, C_Q + hh * 64 + i); o[i] = 0.f; }
    const int rs = min(max(r - 4, 0), 32 - 8), cs = min(max(c - 8, 0), 64 - 16);
    float mx = -1e30f, sum = 0.f;
    for (int j = 0; j < 8; ++j) for (int w = 0; w < 16; ++w) { const int kr = rs + j, kc = cs + w; const int krow = MP + b * 2048 + kr * 64 + kc;
        float sc = 0;
#pragma unroll
        for (int i = 0; i < 64; ++i) sc += q[i] * proj(krow, C_K + hh * 64 + i);
        sc = sc * 0.125f + rpb[(hh * 15 + (kr - r + 7)) * 31 + (kc - c + 15)];
        const float mn = fmaxf(mx, sc), a = expf(mx - mn), p = expf(sc - mn); sum = sum * a + p;
#pragma unroll
        for (int i = 0; i < 64; ++i) o[i] = o[i] * a + p * proj(krow, C_V + hh * 64 + i);
        mx = mn; }
    for (int s = 0; s < 512; ++s) { const size_t off = ((((size_t)b * DEPTH + layer) * 512 + s) * 8 + hh) * 64; const float* kp = ck + off; const float* vp = cv + off;
        float sc = 0;
#pragma unroll
        for (int i = 0; i < 64; ++i) sc += q[i] * kp[i];
        sc *= 0.125f;
        const float mn = fmaxf(mx, sc), a = expf(mx - mn), p = expf(sc - mn); sum = sum * a + p;
#pragma unroll
        for (int i = 0; i < 64; ++i) o[i] = o[i] * a + p * vp[i];
        mx = mn; }
#pragma unroll
    for (int i = 0; i < 64; ++i) br[(size_t)row * D + hh * 64 + i] = f2bf(o[i] / sum);
}
__device__ __forceinline__ void nv_s5(const PJA& proj, const Args& a, int layer, float* ys5, float* out, int wid, int n) {
    const int dir = wid % 2, g = (wid / 2) % 32, sq = wid / 64;
    int row0, L, lat, b; seq_info(sq, row0, L, lat, b);
    const float* a_re = a.in[20] + layer * 4096; const float* a_im = a.in[21] + layer * 4096; const float* log_dt = a.in[22] + layer * 64;
    const float* b_re = a.in[23] + (size_t)layer * 65536; const float* b_im = a.in[24] + (size_t)layer * 65536; const float* c_re = a.in[25] + (size_t)layer * 65536; const float* c_im = a.in[26] + (size_t)layer * 65536;
    const int pi = (dir * 32 + g) * 64 + n;
    const float are = fminf(a_re[pi], -1e-4f), aim = a_im[pi], dt = expf(log_dt[dir * 32 + g]);
    const float mag = expf(dt * are), abr = mag * cosf(dt * aim), abi = mag * sinf(dt * aim);
    const float den = are * are + aim * aim, nr = abr - 1.f, cfr = (nr * are + abi * aim) / den, cfi = (abi * are - nr * aim) / den;
    float bbr[16], bbi[16], cr[16], ci[16];
#pragma unroll
    for (int k = 0; k < 16; ++k) { const float br_ = b_re[(size_t)pi * 16 + k], bi_ = b_im[(size_t)pi * 16 + k]; bbr[k] = cfr * br_ - cfi * bi_; bbi[k] = cfr * bi_ + cfi * br_;
        cr[k] = c_re[((size_t)(dir * 32 + g) * 16 + k) * 64 + n]; ci[k] = c_im[((size_t)(dir * 32 + g) * 16 + k) * 64 + n]; }
    float hr = 0.f, hi = 0.f;
    if (lat) { const size_t so = ((((size_t)b * DEPTH + layer) * 2 + dir) * 32 + g) * 64 + n; hr = a.in[4][so]; hi = a.in[5][so]; }
    for (int s = 0; s < L; ++s) { const int t = dir ? L - 1 - s : s;
        float bur = 0, bui = 0;
#pragma unroll
        for (int k = 0; k < 16; ++k) { const float uv = proj(row0 + t, C_S5U + g * 16 + k); bur += uv * bbr[k]; bui += uv * bbi[k]; }
        const float nhr = abr * hr - abi * hi + bur, nhi = abr * hi + abi * hr + bui; hr = nhr; hi = nhi;
        float myy = 0.f;
#pragma unroll
        for (int k = 0; k < 16; ++k) { float v = hr * cr[k] - hi * ci[k];
#pragma unroll
            for (int o = 32; o > 0; o >>= 1) v += __shfl_xor(v, o);
            if (n == k) myy = v; }
        if (n < 16) ys5[((size_t)dir * M + row0 + t) * 512 + g * 16 + n] = myy; }
    if (!lat) { const size_t oo = ((((size_t)b * DEPTH + layer) * 2 + dir) * 32 + g) * 64 + n; out[O_S5R + oo] = hr; out[O_S5I + oo] = hi; }
}
__device__ __forceinline__ void nv_ssd_seq(const PJA& proj, const float* xbc, const Args& a, int layer, float* yssd, float* out, int wid, int p) {
    const int dir = wid % 2, hh = (wid / 2) % 8, sq = wid / 16;
    int row0, L, lat, b; seq_info(sq, row0, L, lat, b);
    float h[128];
    if (lat) { const float* sp = a.in[6] + (((((size_t)b * DEPTH + layer) * 2 + dir) * 8 + hh) * 64 + p) * 128;
#pragma unroll
        for (int n = 0; n < 128; ++n) h[n] = sp[n]; }
    else {
#pragma unroll
        for (int n = 0; n < 128; ++n) h[n] = 0.f; }
    const float A = -expf(a.in[33][layer * 16 + dir * 8 + hh]), dtb = a.in[32][layer * 16 + dir * 8 + hh]; const int grp = hh / 4;
    for (int s = 0; s < L; ++s) { const int t = dir ? L - 1 - s : s; const int row = row0 + t;
        const float dt = nsoftplus(proj(row, C_DT + dir * 8 + hh) + dtb), dec = expf(dt * A);
        const float xd = xbc[(size_t)row * 1024 + hh * 64 + p] * dt;
        const float* Bv = xbc + (size_t)row * 1024 + 512 + grp * 128; const float* Cv = xbc + (size_t)row * 1024 + 768 + grp * 128;
        float y = 0.f;
#pragma unroll
        for (int n = 0; n < 128; ++n) { h[n] = dec * h[n] + Bv[n] * xd; y += Cv[n] * h[n]; }
        yssd[((size_t)dir * M + row) * 512 + hh * 64 + p] = y; }
    if (!lat) { float* op = out + O_SSD + (((((size_t)b * DEPTH + layer) * 2 + dir) * 8 + hh) * 64 + p) * 128;
#pragma unroll
        for (int n = 0; n < 128; ++n) op[n] = h[n]; }
}
__device__ __forceinline__ void nv_ml_seq(const PJA& proj, const float* qr, const float* kr, const Args& a, int layer, float* hml, float* out, LAS float* sh, int item, int tid) {
    const int sub = tid >> 8, t8 = tid & 255, v = t8 & 127, half = t8 >> 7; item += sub;
    const int dir = item % 2, hh = (item / 2) % 4, sq = item / 8;
    int row0, L, lat, b; seq_info(sq, row0, L, lat, b);
    LAS float* ns = sh + sub * 640; LAS float* qs = ns + 128; LAS float* ks = ns + 256; LAS float* nump = ns + 384;
    float C[64]; float m = 0.f;
    const size_t so = (((size_t)b * DEPTH + layer) * 2 + dir) * 4 + hh;
    if (lat) {
#pragma unroll
        for (int k = 0; k < 64; ++k) C[k] = a.in[7][(so * 128 + 64 * half + k) * 128 + v];
        if (half == 0) ns[v] = a.in[8][so * 128 + v];
        m = a.in[9][so]; }
    else {
#pragma unroll
        for (int k = 0; k < 64; ++k) C[k] = 0.f;
        if (half == 0) ns[v] = 0.f; }
    const float ibv = a.in[36][layer * 8 + dir * 4 + hh], fbv = a.in[37][layer * 8 + dir * 4 + hh];
    __syncthreads();
    for (int s = 0; s < L; ++s) { const int t = dir ? L - 1 - s : s; const int row = row0 + t;
        if (half == 0) { qs[v] = qr[(size_t)row * 512 + hh * 128 + v]; ks[v] = kr[(size_t)row * 512 + hh * 128 + v]; }
        const float vv = proj(row, C_MV + hh * 128 + v);
        const float ig = proj(row, C_MI + dir * 4 + hh) + ibv, fp = proj(row, C_MF + dir * 4 + hh) + fbv;
        const float lf = -nsoftplus(-fp);
        const float mn = fmaxf(lf + m, ig), aa = expf(lf + m - mn), bb = expf(ig - mn); m = mn;
        __syncthreads();
        const float nv_ = aa * ns[v] + bb * ks[v];
        float part = 0.f;
#pragma unroll
        for (int k = 0; k < 64; ++k) { C[k] = aa * C[k] + bb * ks[64 * half + k] * vv; part += qs[64 * half + k] * C[k]; }
        nump[half * 128 + v] = part;
        __syncthreads();
        if (half == 0) ns[v] = nv_;
        __syncthreads();
        if (half == 0) { float den = 0.f;
#pragma unroll 16
            for (int k = 0; k < 128; ++k) den += qs[k] * ns[k];
            den = fmaxf(fabsf(den), expf(-m));
            hml[((size_t)dir * M + row) * 512 + hh * 128 + v] = (nump[v] + nump[128 + v]) / den; }
        __syncthreads(); }
    if (!lat) {
#pragma unroll
        for (int k = 0; k < 64; ++k) out[O_MLC + (so * 128 + 64 * half + k) * 128 + v] = C[k];
        if (half == 0) { out[O_MLN + so * 128 + v] = ns[v]; if (v == 0) out[O_MLM + so] = m; } }
    __syncthreads();
}
struct MixScr { float* xbc; float* ys5; float* yssd; float* yml; float* qr; float* kr; };
__device__ __forceinline__ MixScr mix_scr(unsigned char* ws) { MixScr s; s.xbc = (float*)(ws + WS_SCR); s.ys5 = s.xbc + (size_t)M * 1024; s.yssd = s.ys5 + (size_t)2 * M * 512; s.yml = s.yssd + (size_t)2 * M * 512;
    s.qr = s.yml + (size_t)2 * M * 512; s.kr = s.qr + (size_t)M * 512; return s; }

__device__ __forceinline__ void nmix_a(const Args& a, int layer, int gw_, int ngw, int lane_) {
    int lane = lane_, gw = gw_; asm volatile("" : "+v"(lane));
    const PJA proj{(const bf16_t*)(a.ws + WS_PROJ), (const float*)(a.ws + WS_SMALL)}; bf16_t* BR = (bf16_t*)(a.ws + WS_BR); const MixScr sc = mix_scr(a.ws);
    for (int it = gw; it < 2816; it += ngw) {
        if (it < 256) nv_s5(proj, a, layer, sc.ys5, a.out, 1024 + it, lane);
        else if (it < 1280) nv_attn_na(proj, a.in[2], a.in[3], a.in[19] + (size_t)layer * 8 * 15 * 31, layer, BR, (it - 256) * 64 + lane);
        else if (it < 1792) nv_attn_dense(proj, BR, (it - 1280) * 64 + lane);
        else nv_s5(proj, a, layer, sc.ys5, a.out, it - 1792, lane);
    }
    const float* cw = a.in[30] + layer * 5 * 1024; const float* cb = a.in[31] + layer * 1024;
    for (size_t idx = (size_t)gw * 64 + lane; idx < (size_t)M * 1024; idx += (size_t)ngw * 64) { const int row = idx / 1024, ch = idx % 1024;
        const int sq = row < MP ? row / 256 : 16 + (row - MP) / 2048; int row0, L, lat, b; seq_info(sq, row0, L, lat, b); const int t = row - row0;
        float acc = cb[ch];
#pragma unroll
        for (int j = 0; j < 5; ++j) { const int tt = t + j - 2; if (tt >= 0 && tt < L) acc += proj(row0 + tt, C_XBC + ch) * cw[j * 1024 + ch]; }
        sc.xbc[idx] = nsilu(acc); }
    for (size_t idx = (size_t)gw * 64 + lane; idx < (size_t)M * 512; idx += (size_t)ngw * 64) { const int row = idx / 512, cidx = idx % 512, dd = cidx % 128;
        const int qb = C_MQ + cidx - dd, kb = C_MK + cidx - dd; float qv, kv;
        if (row < MP) { qv = proj(row, qb + dd); kv = proj(row, kb + dd); }
        else { const int t = (row - MP) % 2048; const int half = dd / 64, i64 = dd % 64, i = i64 % 32; const float pos = half == 0 ? (float)(t / 64) : (float)(t % 64);
            const float inv = powf(10000.f, -(float)i / 32.f), ang = pos * inv, cs = cosf(ang), sn = sinf(ang);
            const int i1 = half * 64 + i, i2 = i1 + 32;
            if (i64 < 32) { qv = proj(row, qb + i1) * cs - proj(row, qb + i2) * sn; kv = proj(row, kb + i1) * cs - proj(row, kb + i2) * sn; }
            else { qv = proj(row, qb + i1) * sn + proj(row, qb + i2) * cs; kv = proj(row, kb + i1) * sn + proj(row, kb + i2) * cs; } }
        sc.qr[idx] = qv; sc.kr[idx] = kv * 0.08838834764831845f; }
}
__device__ __forceinline__ void nmix_b(const Args& a, int layer, LAS unsigned char* lds, int tid_, int G) {
    int tid = tid_; asm volatile("" : "+v"(tid));
    const int lane = tid & 63, wave = __builtin_amdgcn_readfirstlane(tid >> 6), blk = blockIdx.x;
    const PJA proj{(const bf16_t*)(a.ws + WS_PROJ), (const float*)(a.ws + WS_SMALL)}; const MixScr sc = mix_scr(a.ws);
    if (blk < 80) {
        const int item = blk < 16 ? 128 + blk * 2 : (blk - 16) * 2;
        nv_ml_seq(proj, sc.qr, sc.kr, a, layer, sc.yml, a.out, (LAS float*)lds, item, tid);
    } else if (blk < 144) {
        if (wave == 0) nv_ssd_seq(proj, sc.xbc, a, layer, sc.yssd, a.out, 256 + (blk - 80), lane);
    } else if (blk < 176) {
        nv_ssd_seq(proj, sc.xbc, a, layer, sc.yssd, a.out, (blk - 144) * 8 + wave, lane);
    } else {
        bf16_t* ZB = (bf16_t*)(a.ws + WS_ZB); const float* s5d = a.in[27] + layer * 512; const int nb_ = G - 176;
        for (size_t idx = (size_t)(blk - 176) * NT + tid; idx < (size_t)M * 512; idx += (size_t)nb_ * NT) { const int row = idx / 512, cidx = idx % 512;
            const float y = sc.ys5[idx] + sc.ys5[(size_t)M * 512 + idx] + proj(row, C_S5U + cidx) * s5d[cidx]; ZB[idx] = f2bf(ngelu(y)); }
    }
}
__device__ __forceinline__ void nmix_c(const Args& a, int layer, int gw, int ngw, int lane_) {
    int lane = lane_; asm volatile("" : "+v"(lane));
    const PJA proj{(const bf16_t*)(a.ws + WS_PROJ), (const float*)(a.ws + WS_SMALL)}; bf16_t* BR = (bf16_t*)(a.ws + WS_BR); const MixScr sc = mix_scr(a.ws);
    const float* ssd_d = a.in[34] + layer * 8; const float* sng = a.in[35] + layer * 512; const float* mng = a.in[38] + layer * 512;
    for (int row = gw; row < M; row += ngw) {
        float v[8]; float ss = 0.f;
#pragma unroll
        for (int i = 0; i < 8; ++i) { const int ch = lane + 64 * i; float y = sc.yssd[(size_t)row * 512 + ch] + sc.yssd[((size_t)M + row) * 512 + ch] + sc.xbc[(size_t)row * 1024 + ch] * ssd_d[ch / 64];
            y *= nsilu(proj(row, C_Z + ch)); v[i] = y; ss += y * y; }
        const float r = rsqrtf(wave_sum(ss) * (1.f / 512.f) + 1e-6f);
#pragma unroll
        for (int i = 0; i < 8; ++i) { const int ch = lane + 64 * i; BR[(size_t)row * D + 1024 + ch] = f2bf(v[i] * r * sng[ch]); }
#pragma unroll
        for (int hh = 0; hh < 4; ++hh) { const int c0 = hh * 128 + lane, c1 = c0 + 64;
            const float h0 = sc.yml[(size_t)row * 512 + c0] + sc.yml[((size_t)M + row) * 512 + c0], h1 = sc.yml[(size_t)row * 512 + c1] + sc.yml[((size_t)M + row) * 512 + c1];
            const float rr = rsqrtf(wave_sum(h0 * h0 + h1 * h1) * (1.f / 128.f) + 1e-6f);
            BR[(size_t)row * D + 1536 + c0] = f2bf(h0 * rr * mng[c0] * nsigm(proj(row, C_MO + c0)));
            BR[(size_t)row * D + 1536 + c1] = f2bf(h1 * rr * mng[c1] * nsigm(proj(row, C_MO + c1))); }
    }
}
}
namespace mk {
#ifndef PHMASK
#define PHMASK 0xfffff
#endif
#define PHM(k) ((PHMASK >> (k)) & 1)
constexpr int NPH = 11;
constexpr int PH_TOTAL = 1 + DEPTH * NPH;
__global__ void __launch_bounds__(NT, 2) mk_fwd(Args a) {
    extern __shared__ __attribute__((aligned(16))) unsigned char lds_raw[];
    LAS unsigned char* lds = (LAS unsigned char*)lds_raw;
#define TID ((int)threadIdx.x)
#define LANE ((int)(threadIdx.x & 63))
#define WAVE (__builtin_amdgcn_readfirstlane((int)(threadIdx.x >> 6)))
#define GW ((int)blockIdx.x * NWV + WAVE)
    const int G = gridDim.x, ngw = G * NWV;
    volatile LAS unsigned* ctlw = (volatile LAS unsigned*)(lds + LDS_CTL);
    if (TID < 4) ctlw[TID] = 0u;
    __syncthreads();
    XcdBarrier bar = xcd_barrier_post((unsigned*)(a.ws + WS_CTL), ctlw);
    const int lo = a.ph_lo, hi = a.ph_hi;
#define IN(k) (lo <= (k) && (k) < hi)
#define SEAM(k) do { if (IN(k) && IN((k) + 1)) xcd_barrier(bar); } while (0)
    unsigned char* ws = a.ws;
    bf16_t* H = (bf16_t*)(ws + WS_H); bf16_t* PROJ = (bf16_t*)(ws + WS_PROJ); float* SMALL = (float*)(ws + WS_SMALL); bf16_t* BR = (bf16_t*)(ws + WS_BR);
    bf16_t* MERGED = (bf16_t*)(ws + WS_MERGED); float* MACC = (float*)(ws + WS_MACC); bf16_t* ZB = (bf16_t*)(ws + WS_ZB); bf16_t* HID = PROJ;
    const float* MOD = (const float*)(ws + WS_MOD); float* X = a.out;
    if (PHM(0) && IN(0)) { prologue_convert(a, lds, GW, ngw, WAVE, LANE); __syncthreads(); prologue_ada(a, lds, TID); }
    SEAM(0);
    for (int l = 0; l < DEPTH; ++l) {
        const int pb = 1 + l * NPH;
        const float* xp = l == 0 ? a.in[0] : X; const float* xs = l == 0 ? a.in[1] : X + (size_t)MP * D;
        const float* modl = MOD + (size_t)l * 5 * 6 * D;
        const bf16_t* wl = (const bf16_t*)(ws + WS_W) + (size_t)l * W_LAYER;
        if (PHM(1) && IN(pb + 0)) norm_phase(xp, xs, a.in[14] + l * D, modl, 0, D, H, GW, ngw, LANE);
        SEAM(pb + 0);
        if (PHM(2) && IN(pb + 1)) { Gemm g{H, wl + W_IN, M, NIN, D, D, 1, 0, 0}; StaticOrder S; S.init(M, NIN, G, blockIdx.x);
            EpiIn E{PROJ, SMALL, a.out, a.in[17] + l * 64, a.in[18] + l * 64, l}; gemm_phase(lds, g, S, E); }
        SEAM(pb + 1);
        if (PHM(3) && IN(pb + 2)) nmix_a(a, l, GW, ngw, LANE);
        SEAM(pb + 2);
        if (PHM(4) && IN(pb + 3)) nmix_b(a, l, lds, TID, G);
        SEAM(pb + 3);
        if (PHM(5) && IN(pb + 4)) nmix_c(a, l, GW, ngw, LANE);
        SEAM(pb + 4);
        if (PHM(6) && IN(pb + 5)) { Gemm g{ZB, wl + W_GLU, M, 512, 512, 512, 1, 0, 0}; StaticOrder S; S.init(M, 512, G, blockIdx.x);
            EpiGlu E{ZB, a.in[29] + l * 512, BR}; gemm_phase(lds, g, S, E); }
        SEAM(pb + 5);
        if (PHM(7) && IN(pb + 6)) { Gemm g{BR, wl + W_BR, M, D, 512, D, 4, 512, (size_t)D * 512}; StaticOrder S; S.init(M, D, G, blockIdx.x, 4);
            EpiBranch E{PROJ, MACC, MERGED}; gemm_phase(lds, g, S, E); }
        SEAM(pb + 6);
        if (PHM(8) && IN(pb + 7)) { Gemm g{MERGED, wl + W_OUT, M, D, D, D, 1, 0, 0}; StaticOrder S; S.init(M, D, G, blockIdx.x);
            EpiResid E{xp, xs, modl, 2 * D, X}; gemm_phase(lds, g, S, E); }
        SEAM(pb + 7);
        if (PHM(9) && IN(pb + 8)) norm_phase(X, X + (size_t)MP * D, a.in[15] + l * D, modl, 3 * D, 4 * D, H, GW, ngw, LANE);
        SEAM(pb + 8);
        if (PHM(10) && IN(pb + 9)) { Gemm g{H, wl + W_1, M, DFF, D, D, 1, 0, 0}; StaticOrder S; S.init(M, DFF, G, blockIdx.x);
            EpiRelu2 E{HID, DFF}; gemm_phase(lds, g, S, E); }
        SEAM(pb + 9);
        if (PHM(11) && IN(pb + 10)) { Gemm g{HID, wl + W_2, M, D, DFF, DFF, 1, 0, 0}; StaticOrder S; S.init(M, D, G, blockIdx.x);
            EpiResid E{X, X + (size_t)MP * D, modl, 5 * D, X}; gemm_phase(lds, g, S, E); }
        SEAM(pb + 10);
    }
#undef IN
#undef SEAM
}
}
extern "C" void kernel_launch(void* const* d_in, const int* in_sizes, int n_in, void* d_out, int out_size, void* d_ws, size_t ws_size, hipStream_t stream) {
    static int grid = 0;
    if (grid == 0) {
        int dev = 0, cus = 0; (void)hipGetDevice(&dev); (void)hipDeviceGetAttribute(&cus, hipDeviceAttributeMultiprocessorCount, dev);
        (void)hipFuncSetAttribute((const void*)mk::mk_fwd, hipFuncAttributeMaxDynamicSharedMemorySize, mk::LDS_BYTES);
        int per_cu = 0; (void)hipOccupancyMaxActiveBlocksPerMultiprocessor(&per_cu, (const void*)mk::mk_fwd, mk::NT, mk::LDS_BYTES); (void)hipGetLastError();
        grid = cus > 0 ? cus : 256;
    }
    mk::Args a{}; for (int i = 0; i < 43; ++i) a.in[i] = (const float*)d_in[i];
    a.out = (float*)d_out; a.ws = (unsigned char*)d_ws; a.ph_lo = 0; a.ph_hi = mk::PH_TOTAL;
    (void)hipMemsetAsync(a.ws + mk::WS_CTL, 0, mk::CTL_BYTES, stream);
    hipLaunchKernelGGL(mk::mk_fwd, dim3(grid), dim3(mk::NT), mk::LDS_BYTES, stream, a);
}
```

```cpp
#define SAFE_GEMM 0
#include <hip/hip_runtime.h>
#include <math.h>
namespace mk {
#define LAS __attribute__((address_space(3)))
typedef unsigned short bf16_t;
typedef short bf16x8 __attribute__((ext_vector_type(8)));
typedef float f32x4 __attribute__((ext_vector_type(4)));
typedef float f32x2 __attribute__((ext_vector_type(2)));
typedef unsigned u32x4 __attribute__((ext_vector_type(4)));
typedef unsigned u32x2 __attribute__((ext_vector_type(2)));
constexpr int NT = 512, NWV = 8;
constexpr int D = 2048, MP = 4096, MLAT = 8192, M = MP + MLAT, DEPTH = 4, DFF = 8192;
constexpr int PJ = 13824;
constexpr int NIN = 14080;
constexpr int P_Q = 0, P_K = 512, P_V = 1024, P_S5U = 1536, P_Z = 2048, P_XBC = 2560, P_MQ = 3584, P_MK = 4096, P_MV = 4608, P_MO = 5120, P_GATE = 5632;
constexpr int S_DT = 0, S_MI = 16, S_MF = 24;

typedef __bf16 bf16x2_t __attribute__((ext_vector_type(2)));
__device__ __forceinline__ unsigned pk2(float lo, float hi) { f32x2 v = {lo, hi}; bf16x2_t b = __builtin_convertvector(v, bf16x2_t); return __builtin_bit_cast(unsigned, b); }
__device__ __forceinline__ float bf2f(bf16_t v) { return __uint_as_float(((unsigned)v) << 16); }
__device__ __forceinline__ float bflo(unsigned w) { return __uint_as_float(w << 16); }
__device__ __forceinline__ float bfhi(unsigned w) { return __uint_as_float(w & 0xffff0000u); }
__device__ __forceinline__ bf16_t f2bf(float f) { return (bf16_t)(pk2(f, 0.f) & 0xffffu); }
__device__ __forceinline__ float fsigm(float x) { return __builtin_amdgcn_rcpf(1.f + __expf(-x)); }
__device__ __forceinline__ float fsilu(float x) { return x * fsigm(x); }
__device__ __forceinline__ int row_cvec(int row) { return row < MP ? 0 : 1 + (row - MP) / 2048; }

#define XB_TMO      128
#define XB_XCNT(j)  (256  + 64 * (j))
#define XB_XSUB(j)  (1280 + 64 * (j))
#define XB_XGEN(j)  (2304 + 64 * (j))
#define XB_TOP      3328
#define XB_TOPGEN   3392
#define XCD_BAR_WORDS 3456
#define XB_SPIN_CAP (1u << 18)
__device__ __forceinline__ unsigned xb_ld(unsigned* p)              { return __hip_atomic_load(p, __ATOMIC_RELAXED, __HIP_MEMORY_SCOPE_AGENT); }
__device__ __forceinline__ unsigned xb_add(unsigned* p, unsigned v) { return __hip_atomic_fetch_add(p, v, __ATOMIC_RELAXED, __HIP_MEMORY_SCOPE_AGENT); }
__device__ __forceinline__ unsigned xb_xcc_id() { return (unsigned)__builtin_amdgcn_s_getreg((3 << 11) | 20) & 0xFu; }
#define XB_SPIN(cond, bar) do { unsigned _sp = 0; while (cond) { __builtin_amdgcn_s_sleep(1); \
    if ((++_sp & 255u) == 0u) { if (xb_ld(&(bar)[XB_TMO])) break; if (_sp > XB_SPIN_CAP) { atomicAdd(&(bar)[XB_TMO], 1u); break; } } } } while (0)
struct XcdBarrier { unsigned* bar; unsigned x; volatile LAS unsigned* st; };
__device__ __forceinline__ XcdBarrier xcd_barrier_post(unsigned* bar, volatile LAS unsigned* st) {
    XcdBarrier b; b.bar = bar; b.x = xb_xcc_id(); b.st = st;
    if (threadIdx.x == 0) (void)xb_add(&bar[XB_XCNT(b.x)], 1u);
    return b;
}
__device__ __forceinline__ void xcd_barrier_complete(unsigned* bar, unsigned x, unsigned& nloc, unsigned& nx) {
    const unsigned G = gridDim.x * gridDim.y * gridDim.z;
    unsigned sum, cnt, mine, sp = 0u;
    for (;;) {
        sum = 0u; cnt = 0u; mine = 0u;
#pragma unroll
        for (unsigned j = 0; j < 16; ++j) { const unsigned c = xb_ld(&bar[XB_XCNT(j)]); sum += c; cnt += (c > 0u) ? 1u : 0u; mine = (j == x) ? c : mine; }
        if (sum == G) break;
        __builtin_amdgcn_s_sleep(1);
        if ((++sp & 255u) == 0u) { if (xb_ld(&bar[XB_TMO])) break; if (sp > XB_SPIN_CAP) { atomicAdd(&bar[XB_TMO], 1u); break; } }
    }
    nloc = mine > 0u ? mine : 1u; nx = cnt > 0u ? cnt : 1u;
}
__device__ __forceinline__ void xcd_barrier(const XcdBarrier& b) {
    asm volatile("s_waitcnt vmcnt(0)" ::: "memory");
    __syncthreads();
    if (threadIdx.x == 0) {
        unsigned* bar = b.bar;
        __builtin_amdgcn_s_waitcnt(0);
        unsigned nloc = b.st[0], nx = b.st[1];
        if (nloc == 0u) { xcd_barrier_complete(bar, b.x, nloc, nx); b.st[0] = nloc; b.st[1] = nx; }
        const unsigned old = xb_add(&bar[XB_XSUB(b.x)], 1u);
        const unsigned gen = old / nloc;
        if (old + 1u == (gen + 1u) * nloc) {
            __builtin_amdgcn_fence(__ATOMIC_RELEASE, "agent");
            asm volatile("s_waitcnt vmcnt(0)" ::: "memory");
            const unsigned og = xb_add(&bar[XB_TOP], 1u);
            const unsigned tg = og / nx;
            if (og + 1u == (tg + 1u) * nx) xb_add(&bar[XB_TOPGEN], 1u);
            else XB_SPIN(xb_ld(&bar[XB_TOPGEN]) == tg, bar);
            __builtin_amdgcn_fence(__ATOMIC_ACQUIRE, "agent");
            xb_add(&bar[XB_XGEN(b.x)], 1u);
            asm volatile("s_waitcnt vmcnt(0)" ::: "memory");
        } else {
            XB_SPIN(xb_ld(&bar[XB_XGEN(b.x)]) == gen, bar);
            __builtin_amdgcn_fence(__ATOMIC_ACQUIRE, "agent");
            asm volatile("s_waitcnt vmcnt(0)" ::: "memory");
        }
    }
    __syncthreads();
}

constexpr int BM = 256, BK = 64, HALF = 128, HTB = HALF * BK * 2, STAGE_BYTES = 8 * HTB, NXCD = 8, WGM = 8;
__host__ __device__ __forceinline__ int lds_byte(int r, int c) { const int st = (r >> 4) * 2 + (c >> 5), rr = r & 15, cc = c & 31, ob = rr * 64 + cc * 2; return st * 1024 + (ob ^ (((ob >> 9) & 1) << 5)); }
__host__ __device__ __forceinline__ void stage_rc(int b, int& R, int& C) { const int st = b / 1024, sb = b % 1024, swz = sb ^ (((sb >> 9) & 1) << 5); R = (st >> 1) * 16 + swz / 64; C = (st & 1) * 32 + (swz % 64) / 2; }
__host__ __device__ __forceinline__ int perm32(int rho) { const int n = rho >> 4, i = rho & 15; return 8 * (i >> 2) + 4 * n + (i & 3); }

struct Unit { int pm, pn, kz; };
struct Gemm { const bf16_t* A; const bf16_t* Bt; int M, N, K, lda, nkz; size_t a_kz, b_kz; };

struct StaticOrder {
    int nM, nN, nwg, G, c, nkz;
    __device__ void init(int M_, int N_, int G_, int c_, int nkz_ = 1) { nM = M_ / BM; nN = N_ / BM; nwg = nM * nN; G = G_; c = c_; nkz = nkz_; }
    __device__ bool next(int i, Unit& u) const {
        const int it = i / nkz; u.kz = i - it * nkz;
        const long L = (long)it * G + c; if (L >= nwg) return false;
        int wgid = (int)L; { const int q = nwg / NXCD, r = nwg % NXCD, xcd = wgid % NXCD, off = wgid / NXCD; wgid = (xcd < r ? xcd * (q + 1) : r * (q + 1) + (xcd - r) * q) + off; }
        const int nig = WGM * nN, gid = wgid / nig, fm = gid * WGM, gsz = (nM - fm) < WGM ? (nM - fm) : WGM;
        u.pm = fm + ((wgid % nig) % gsz); u.pn = (wgid % nig) / gsz; return true;
    }
};

template <class Epi>
__device__ __forceinline__ void gemm_phase(LAS unsigned char* lds, const Gemm g, const StaticOrder& S, const Epi& E) {
    int tid_ = threadIdx.x; asm volatile("" : "+v"(tid_));
    const int tid = tid_, wid = __builtin_amdgcn_readfirstlane(tid >> 6), lane = tid & 63, wr = wid >> 2, wc = wid & 3, fr = lane & 15, fq = lane >> 4;
    const int K = g.K, nt = K / BK;
    unsigned voffA[2], voffB[2];
#pragma unroll
    for (int i = 0; i < 2; ++i) { int R, C; stage_rc(tid * 16 + i * 8192, R, C); const int Rb = Epi::PERM ? ((R & ~31) + perm32(R & 31)) : R;
        voffA[i] = (unsigned)(R * g.lda + C) * 2u; voffB[i] = (unsigned)(Rb * K + C) * 2u; }
    const size_t kstep = (size_t)(BK * 2);
    const size_t hstepA = (size_t)HALF * g.lda * 2, hstepB = (size_t)HALF * K * 2;
    const size_t tstepA = 2 * hstepA, tstepB = 2 * hstepB;
    const unsigned ldsw = (unsigned)wid * 1024u;
    const int aoff = lds_byte(wr * 64 + fr, fq * 8), boff = lds_byte(wc * 32 + fr, fq * 8);
#define PG8_SA(b, h) (((b) * 2 + (h)) * HTB)
#define PG8_SB(b, h) ((4 + (b) * 2 + (h)) * HTB)
#define PG8_STAGE(bufoff, gbase, voff) do { _Pragma("unroll") for (int _i = 0; _i < 2; ++_i) \
        __builtin_amdgcn_global_load_lds((const unsigned*)((const char*)(gbase) + (voff)[_i]), (LAS unsigned*)(lds + (bufoff) + ldsw + _i * 8192), 16, 0, 0); } while (0)
#define PG8_LDA(dst, b, h) do { _Pragma("unroll") for (int m = 0; m < 4; ++m) _Pragma("unroll") for (int k = 0; k < 2; ++k) dst[m][k] = *(const LAS bf16x8*)(lds + PG8_SA(b, h) + aoff + m * 2048 + k * 1024); } while (0)
#define PG8_LDB(dst, b, h) do { _Pragma("unroll") for (int n = 0; n < 2; ++n) _Pragma("unroll") for (int k = 0; k < 2; ++k) dst[n][k] = *(const LAS bf16x8*)(lds + PG8_SB(b, h) + boff + n * 2048 + k * 1024); } while (0)
#define PG8_MMA(ai, bj, At, Bt) do { __builtin_amdgcn_s_setprio(1); _Pragma("unroll") for (int m = 0; m < 4; ++m) _Pragma("unroll") for (int n = 0; n < 2; ++n) _Pragma("unroll") for (int k = 0; k < 2; ++k) \
        acc[ai][bj][m][n] = __builtin_amdgcn_mfma_f32_16x16x32_bf16(Bt[n][k], At[m][k], acc[ai][bj][m][n], 0, 0, 0); __builtin_amdgcn_s_setprio(0); } while (0)
#if SAFE_GEMM == 1 || SAFE_GEMM == 3
#define PG8_WAIT_V(n) asm volatile("s_waitcnt vmcnt(0)" ::: "memory")
#else
#define PG8_WAIT_V(n) asm volatile("s_waitcnt vmcnt(" #n ")" ::: "memory")
#endif
#define PG8_WAIT_L(n) asm volatile("s_waitcnt lgkmcnt(" #n ")" ::: "memory")
#if SAFE_GEMM == 1
#define PG8_BAR do { asm volatile("s_waitcnt vmcnt(0) lgkmcnt(0)" ::: "memory"); __builtin_amdgcn_s_barrier(); asm volatile("" ::: "memory"); } while (0)
#elif SAFE_GEMM == 2
#define PG8_BAR asm volatile("s_barrier" ::: "memory")
#elif SAFE_GEMM == 4
#define PG8_BAR do { asm volatile("s_waitcnt lgkmcnt(0)" ::: "memory"); __builtin_amdgcn_s_barrier(); } while (0)
#else
#define PG8_BAR __builtin_amdgcn_s_barrier()
#endif
#define PG8_SCHED __builtin_amdgcn_sched_barrier(0)
    Unit cur, nxt; int ui = 0;
    if (!S.next(0, cur)) return;
    f32x4 acc[2][2][4][2];
#pragma unroll
    for (int a = 0; a < 2; ++a)
#pragma unroll
        for (int b = 0; b < 2; ++b)
#pragma unroll
            for (int m = 0; m < 4; ++m)
#pragma unroll
                for (int n = 0; n < 2; ++n) acc[a][b][m][n] = (f32x4){0.f, 0.f, 0.f, 0.f};
    bf16x8 At[4][2], B0[2][2], B1[2][2];
    const char* cA = (const char*)(g.A + (size_t)cur.kz * g.a_kz) + (size_t)cur.pm * tstepA; const char* cB = (const char*)(g.Bt + (size_t)cur.kz * g.b_kz) + (size_t)cur.pn * tstepB;
    PG8_STAGE(PG8_SB(0, 0), cB, voffB); PG8_STAGE(PG8_SA(0, 0), cA, voffA); PG8_STAGE(PG8_SB(0, 1), cB + hstepB, voffB); PG8_STAGE(PG8_SA(0, 1), cA + hstepA, voffA);
    if (wr == 1) PG8_BAR;
    PG8_WAIT_V(4); PG8_BAR;
    PG8_STAGE(PG8_SB(1, 0), cB + kstep, voffB); PG8_STAGE(PG8_SA(1, 0), cA + kstep, voffA); PG8_STAGE(PG8_SB(1, 1), cB + hstepB + kstep, voffB);
    PG8_WAIT_V(6); PG8_BAR;
    for (;;) {
        const bool has_next = S.next(ui + 1, nxt);
        const char* nA = has_next ? (const char*)(g.A + (size_t)nxt.kz * g.a_kz) + (size_t)nxt.pm * tstepA : cA;
        const char* nB = has_next ? (const char*)(g.Bt + (size_t)nxt.kz * g.b_kz) + (size_t)nxt.pn * tstepB : cB;
        for (int t = 0; t < nt; t += 2) {
            const bool last = (t == nt - 2);
            const char* a1 = cA + (size_t)(t + 1) * kstep;
            const char* a2 = last ? nA : cA + (size_t)(t + 2) * kstep; const char* b2 = last ? nB : cB + (size_t)(t + 2) * kstep;
            const char* a3 = a2 + kstep; const char* b3 = b2 + kstep;
            PG8_LDB(B0, 0, 0); PG8_SCHED; PG8_LDA(At, 0, 0); PG8_STAGE(PG8_SA(1, 1), a1 + hstepA, voffA);
            PG8_WAIT_L(8); PG8_BAR; PG8_WAIT_L(0); PG8_MMA(0, 0, At, B0); PG8_BAR; PG8_SCHED;
            PG8_LDB(B1, 0, 1); PG8_STAGE(PG8_SB(0, 0), b2, voffB);
            PG8_BAR; PG8_WAIT_L(0); PG8_MMA(0, 1, At, B1); PG8_BAR;
            PG8_LDA(At, 0, 1); PG8_STAGE(PG8_SA(0, 0), a2, voffA);
            PG8_BAR; PG8_WAIT_L(0); PG8_MMA(1, 0, At, B0); PG8_BAR; PG8_SCHED;
            PG8_STAGE(PG8_SB(0, 1), b2 + hstepB, voffB);
            PG8_WAIT_V(6); PG8_BAR; PG8_MMA(1, 1, At, B1); PG8_BAR;
            PG8_LDB(B0, 1, 0); PG8_SCHED; PG8_LDA(At, 1, 0); PG8_STAGE(PG8_SA(0, 1), a2 + hstepA, voffA);
            PG8_WAIT_L(8); PG8_BAR; PG8_WAIT_L(0); PG8_MMA(0, 0, At, B0); PG8_BAR; PG8_SCHED;
            PG8_LDB(B1, 1, 1); PG8_STAGE(PG8_SB(1, 0), b3, voffB);
            PG8_BAR; PG8_WAIT_L(0); PG8_MMA(0, 1, At, B1); PG8_BAR;
            PG8_LDA(At, 1, 1); PG8_STAGE(PG8_SA(1, 0), a3, voffA);
            PG8_BAR; PG8_WAIT_L(0); PG8_MMA(1, 0, At, B0); PG8_BAR; PG8_SCHED;
            PG8_STAGE(PG8_SB(1, 1), b3 + hstepB, voffB);
            PG8_WAIT_V(6); PG8_BAR; PG8_MMA(1, 1, At, B1); PG8_BAR;
        }
        E(acc, cur, wr, wc, fr, fq);
        asm volatile("s_waitcnt vmcnt(0)" ::: "memory");
        if (!has_next) break;
#pragma unroll
        for (int a = 0; a < 2; ++a)
#pragma unroll
            for (int b = 0; b < 2; ++b)
#pragma unroll
                for (int m = 0; m < 4; ++m)
#pragma unroll
                    for (int n = 0; n < 2; ++n) acc[a][b][m][n] = (f32x4){0.f, 0.f, 0.f, 0.f};
        cur = nxt; cA = nA; cB = nB; ++ui;
    }
    PG8_WAIT_V(0);
    if (wr == 0) PG8_BAR;
    PG8_BAR;
#undef PG8_SA
#undef PG8_SB
#undef PG8_STAGE
#undef PG8_LDA
#undef PG8_LDB
#undef PG8_MMA
#undef PG8_WAIT_V
#undef PG8_WAIT_L
#undef PG8_BAR
#undef PG8_SCHED
}
}
namespace mk {
constexpr size_t O_YP = 0, O_YS = 8388608, O_NK = 25165824, O_NV = 33554432, O_S5R = 41943040, O_S5I = 42205184, O_SSD = 42467328,
                 O_MLC = 50855936, O_MLN = 59244544, O_MLM = 59310080;

__device__ __forceinline__ u32x4 pack8(const f32x4 a, const f32x4 b) { u32x4 w; w.x = pk2(a[0], a[1]); w.y = pk2(a[2], a[3]); w.z = pk2(b[0], b[1]); w.w = pk2(b[2], b[3]); return w; }

struct EpiIn {
    static constexpr bool PERM = true;
    bf16_t* proj; float* small; float* out; const float* qg; const float* kg; int layer;
    __device__ __forceinline__ void operator()(const f32x4 (&acc)[2][2][4][2], const Unit& u, int wr, int wc, int fr, int fq) const {
        const int T = u.pn, rowb = u.pm * BM + wr * 64 + fr;
        if (T == 54) {
            if (wc == 0) {
#pragma unroll
                for (int ai = 0; ai < 2; ++ai)
#pragma unroll
                    for (int m = 0; m < 4; ++m) { float* sp = small + (size_t)(rowb + ai * HALF + m * 16) * 32 + 8 * fq; *(f32x4*)sp = acc[ai][0][m][0]; *(f32x4*)(sp + 4) = acc[ai][0][m][1]; }
            }
            return;
        }
        const int colb = T * 256 + 64 * wc + 8 * fq;
        if (T < 4) {
            const float* g = T < 2 ? qg : kg;
            f32x4 gv[2][2];
#pragma unroll
            for (int bj = 0; bj < 2; ++bj)
#pragma unroll
                for (int n = 0; n < 2; ++n) gv[bj][n] = *(const f32x4*)(g + 32 * bj + 8 * fq + 4 * n);
#pragma unroll
            for (int ai = 0; ai < 2; ++ai)
#pragma unroll
                for (int m = 0; m < 4; ++m) {
                    float ss = 0.f;
#pragma unroll
                    for (int bj = 0; bj < 2; ++bj)
#pragma unroll
                        for (int n = 0; n < 2; ++n) { const f32x4 x = acc[ai][bj][m][n]; ss += (x[0] * x[0] + x[1] * x[1]) + (x[2] * x[2] + x[3] * x[3]); }
                    ss += __shfl_xor(ss, 16); ss += __shfl_xor(ss, 32);
                    const float r = rsqrtf(ss * (1.f / 64.f) + 1e-6f);
                    const int row = rowb + ai * HALF + m * 16;
#pragma unroll
                    for (int bj = 0; bj < 2; ++bj) { const f32x4 v0 = acc[ai][bj][m][0] * r * gv[bj][0], v1 = acc[ai][bj][m][1] * r * gv[bj][1];
                        *(u32x4*)(proj + (size_t)row * PJ + colb + 32 * bj) = pack8(v0, v1);
                        if (T >= 2 && row < MP) { float* o = out + O_NK + ((size_t)((row >> 8) * DEPTH + layer) * 256 + (row & 255)) * 512 + (colb - 512) + 32 * bj; *(f32x4*)o = v0; *(f32x4*)(o + 4) = v1; } }
                }
        } else if (T < 6) {
#pragma unroll
            for (int ai = 0; ai < 2; ++ai)
#pragma unroll
                for (int m = 0; m < 4; ++m) { const int row = rowb + ai * HALF + m * 16;
#pragma unroll
                    for (int bj = 0; bj < 2; ++bj) { const f32x4 v0 = acc[ai][bj][m][0], v1 = acc[ai][bj][m][1];
                        *(u32x4*)(proj + (size_t)row * PJ + colb + 32 * bj) = pack8(v0, v1);
                        if (row < MP) { float* o = out + O_NV + ((size_t)((row >> 8) * DEPTH + layer) * 256 + (row & 255)) * 512 + (colb - 1024) + 32 * bj; *(f32x4*)o = v0; *(f32x4*)(o + 4) = v1; } } }
        } else if (T < 22) {
#pragma unroll
            for (int ai = 0; ai < 2; ++ai)
#pragma unroll
                for (int m = 0; m < 4; ++m) { const int row = rowb + ai * HALF + m * 16;
#pragma unroll
                    for (int bj = 0; bj < 2; ++bj) *(u32x4*)(proj + (size_t)row * PJ + colb + 32 * bj) = pack8(acc[ai][bj][m][0], acc[ai][bj][m][1]); }
        } else {
#pragma unroll
            for (int ai = 0; ai < 2; ++ai)
#pragma unroll
                for (int m = 0; m < 4; ++m) { const int row = rowb + ai * HALF + m * 16;
#pragma unroll
                    for (int bj = 0; bj < 2; ++bj) { f32x4 v0 = acc[ai][bj][m][0], v1 = acc[ai][bj][m][1];
#pragma unroll
                        for (int j = 0; j < 4; ++j) { v0[j] = fsigm(v0[j]); v1[j] = fsigm(v1[j]); }
                        *(u32x4*)(proj + (size_t)row * PJ + colb + 32 * bj) = pack8(v0, v1); } }
        }
    }
};
struct EpiRelu2 {
    static constexpr bool PERM = true;
    bf16_t* O; int ldo;
    __device__ __forceinline__ void operator()(const f32x4 (&acc)[2][2][4][2], const Unit& u, int wr, int wc, int fr, int fq) const {
        const int rowb = u.pm * BM + wr * 64 + fr, colb = u.pn * 256 + 64 * wc + 8 * fq;
#pragma unroll
        for (int ai = 0; ai < 2; ++ai)
#pragma unroll
            for (int m = 0; m < 4; ++m) { const int row = rowb + ai * HALF + m * 16;
#pragma unroll
                for (int bj = 0; bj < 2; ++bj) { f32x4 v0 = acc[ai][bj][m][0], v1 = acc[ai][bj][m][1];
#pragma unroll
                    for (int j = 0; j < 4; ++j) { const float a = fmaxf(v0[j], 0.f), b = fmaxf(v1[j], 0.f); v0[j] = a * a; v1[j] = b * b; }
                    *(u32x4*)(O + (size_t)row * ldo + colb + 32 * bj) = pack8(v0, v1); } }
    }
};
struct EpiGlu {
    static constexpr bool PERM = true;
    const bf16_t* Z; const float* bias; bf16_t* br;
    __device__ __forceinline__ void operator()(const f32x4 (&acc)[2][2][4][2], const Unit& u, int wr, int wc, int fr, int fq) const {
        const int rowb = u.pm * BM + wr * 64 + fr, colb = u.pn * 256 + 64 * wc + 8 * fq;
#pragma unroll
        for (int bj = 0; bj < 2; ++bj) { const int c = colb + 32 * bj; const f32x4 b0 = *(const f32x4*)(bias + c), b1 = *(const f32x4*)(bias + c + 4);
#pragma unroll
            for (int ai = 0; ai < 2; ++ai)
#pragma unroll
                for (int m = 0; m < 4; ++m) { const int row = rowb + ai * HALF + m * 16;
                    const u32x4 zz = *(const u32x4*)(Z + (size_t)row * 512 + c);
                    f32x4 v0 = acc[ai][bj][m][0] + b0, v1 = acc[ai][bj][m][1] + b1;
                    v0[0] = bflo(zz.x) * fsigm(v0[0]); v0[1] = bfhi(zz.x) * fsigm(v0[1]); v0[2] = bflo(zz.y) * fsigm(v0[2]); v0[3] = bfhi(zz.y) * fsigm(v0[3]);
                    v1[0] = bflo(zz.z) * fsigm(v1[0]); v1[1] = bfhi(zz.z) * fsigm(v1[1]); v1[2] = bflo(zz.w) * fsigm(v1[2]); v1[3] = bfhi(zz.w) * fsigm(v1[3]);
                    *(u32x4*)(br + (size_t)row * D + 512 + c) = pack8(v0, v1); } }
    }
};
struct EpiBranch {
    static constexpr bool PERM = true;
    const bf16_t* proj; float* macc; bf16_t* merged;
    __device__ __forceinline__ void operator()(const f32x4 (&acc)[2][2][4][2], const Unit& u, int wr, int wc, int fr, int fq) const {
        const int rowb = u.pm * BM + wr * 64 + fr, colb = u.pn * 256 + 64 * wc + 8 * fq, kz = u.kz;
#pragma unroll
        for (int ai = 0; ai < 2; ++ai)
#pragma unroll
            for (int m = 0; m < 4; ++m) { const int row = rowb + ai * HALF + m * 16;
#pragma unroll
                for (int bj = 0; bj < 2; ++bj) { const int c = colb + 32 * bj;
                    const u32x4 gg = *(const u32x4*)(proj + (size_t)row * PJ + P_GATE + kz * D + c);
                    f32x4 v0 = acc[ai][bj][m][0], v1 = acc[ai][bj][m][1];
                    v0[0] *= bflo(gg.x); v0[1] *= bfhi(gg.x); v0[2] *= bflo(gg.y); v0[3] *= bfhi(gg.y); v1[0] *= bflo(gg.z); v1[1] *= bfhi(gg.z); v1[2] *= bflo(gg.w); v1[3] *= bfhi(gg.w);
                    float* mp = macc + (size_t)row * D + c;
                    if (kz > 0) { v0 += *(const f32x4*)mp; v1 += *(const f32x4*)(mp + 4); }
                    if (kz < 3) { *(f32x4*)mp = v0; *(f32x4*)(mp + 4) = v1; }
                    else *(u32x4*)(merged + (size_t)row * D + c) = pack8(v0, v1); } }
    }
};
struct EpiResid {
    static constexpr bool PERM = false;
    const float* xp; const float* xs; const float* modl; int g_off; float* xout;
    __device__ __forceinline__ void operator()(const f32x4 (&acc)[2][2][4][2], const Unit& u, int wr, int wc, int fr, int fq) const {
        const int row0 = u.pm * BM, rowb = row0 + wr * 64 + fr, colb = u.pn * 256 + wc * 32 + 4 * fq;
        const float* xin = row0 < MP ? xp : xs - (size_t)MP * D;
        const float* gate = modl + (size_t)row_cvec(row0) * 6 * D + g_off;
        f32x4 gv[2][2];
#pragma unroll
        for (int bj = 0; bj < 2; ++bj)
#pragma unroll
            for (int n = 0; n < 2; ++n) gv[bj][n] = *(const f32x4*)(gate + colb + bj * HALF + n * 16);
#pragma unroll
        for (int ai = 0; ai < 2; ++ai)
#pragma unroll
            for (int m = 0; m < 4; ++m) { const size_t ro = (size_t)(rowb + ai * HALF + m * 16) * D + colb;
#pragma unroll
                for (int bj = 0; bj < 2; ++bj)
#pragma unroll
                    for (int n = 0; n < 2; ++n) { const size_t o = ro + bj * HALF + n * 16; *(f32x4*)(xout + o) = *(const f32x4*)(xin + o) + gv[bj][n] * acc[ai][bj][m][n]; } }
    }
};
}
namespace mk {
constexpr size_t AL(size_t x) { return (x + 255) & ~(size_t)255; }
constexpr size_t WS_CTL = 0, CTL_BYTES = 65536;
constexpr size_t WS_MOD = WS_CTL + CTL_BYTES;
constexpr size_t WS_W = AL(WS_MOD + (size_t)DEPTH * 5 * 6 * D * 4);
constexpr size_t W_IN = 0, W_GLU = W_IN + (size_t)NIN * D, W_BR = W_GLU + 512 * 512, W_OUT = W_BR + (size_t)4 * D * 512, W_1 = W_OUT + (size_t)D * D, W_2 = W_1 + (size_t)DFF * D,
                 W_LAYER = W_2 + (size_t)D * DFF;
constexpr size_t WS_H = AL(WS_W + W_LAYER * 2 * DEPTH);
constexpr size_t WS_PROJ = AL(WS_H + (size_t)M * D * 2);
constexpr size_t WS_SMALL = AL(WS_PROJ + (size_t)M * PJ * 2);
constexpr size_t WS_BR = AL(WS_SMALL + (size_t)M * 32 * 4);
constexpr size_t WS_MERGED = AL(WS_BR + (size_t)M * D * 2);
constexpr size_t WS_MACC = AL(WS_MERGED + (size_t)M * D * 2);
constexpr size_t WS_ZB = AL(WS_MACC + (size_t)M * D * 4);
constexpr size_t WS_SCR = AL(WS_ZB + (size_t)M * 512 * 2);
constexpr int LDS_BYTES = 140 * 1024, LDS_CTL = LDS_BYTES - 256;

struct Args { const float* in[43]; float* out; unsigned char* ws; int ph_lo, ph_hi; };

__device__ __forceinline__ float wave_sum(float v) {
#pragma unroll
    for (int o = 1; o < 64; o <<= 1) v += __shfl_xor(v, o);
    return v;
}
#define LDS_WAIT() asm volatile("s_waitcnt lgkmcnt(0)" ::: "memory")

__device__ __forceinline__ void xpose_item(const float* W, int ldw, int k0, int sc, bf16_t* dst, int K, LAS float* scr, int lane, int mode) {
    const int j = lane & 31;
    const int col = mode == 1 ? (j < 16 ? 3584 + j : 5648 + (j - 16)) : sc + j;
#pragma unroll 8
    for (int i = 0; i < 32; ++i) { const int kk = 2 * i + (lane >> 5); scr[kk * 33 + j] = mode == 2 ? 0.f : W[(size_t)(k0 + kk) * ldw + col]; }
    LDS_WAIT(); asm volatile("" ::: "memory");
    const int c = lane & 7;
#pragma unroll
    for (int jj = 0; jj < 4; ++jj) { const int n = (lane >> 3) + 8 * jj; const LAS float* s = scr + (8 * c) * 33 + n;
        u32x4 o; o.x = pk2(s[0 * 33], s[1 * 33]); o.y = pk2(s[2 * 33], s[3 * 33]); o.z = pk2(s[4 * 33], s[5 * 33]); o.w = pk2(s[6 * 33], s[7 * 33]);
        *(u32x4*)(dst + (size_t)n * K + k0 + 8 * c) = o; }
    LDS_WAIT(); asm volatile("" ::: "memory");
}
__device__ __forceinline__ int hm_col(int grp) { const int T = grp >> 3, q8 = grp & 7; return 256 * T + 32 * (2 * (q8 & 3) + (q8 >> 2)); }

__device__ __forceinline__ void prologue_convert(const Args& a, LAS unsigned char* lds, int gw, int ngw, int wave, int lane) {
    LAS float* scr = (LAS float*)(lds + wave * 8704);
    bf16_t* WB = (bf16_t*)(a.ws + WS_W);
    constexpr int I_IN = 440 * 32, I_GLU = 16 * 8, I_BR = 4 * 64 * 8, I_OUT = 64 * 32, I_1 = 256 * 32, I_2 = 64 * 128, I_L = I_IN + I_GLU + I_BR + I_OUT + I_1 + I_2;
    for (int it = gw; it < I_L * DEPTH; it += ngw) {
        const int l = it / I_L; int r = it - l * I_L; bf16_t* wl = WB + (size_t)l * W_LAYER;
        if (r < I_IN) { const int kb = r / 440, grp = r % 440, T = grp >> 3; int sc = hm_col(grp), mode = 0;
            if (T == 54) mode = (grp & 7) == 0 ? 1 : 2; else if (T >= 22) sc += 32; else if (T >= 14) sc += 16;
            xpose_item(a.in[16] + (size_t)l * D * 13856, 13856, 64 * kb, sc, wl + W_IN + (size_t)(32 * grp) * D, D, scr, lane, mode); continue; } r -= I_IN;
        if (r < I_GLU) { const int kb = r / 16, grp = r % 16; xpose_item(a.in[28] + (size_t)l * 512 * 512, 512, 64 * kb, hm_col(grp), wl + W_GLU + (size_t)(32 * grp) * 512, 512, scr, lane, 0); continue; } r -= I_GLU;
        if (r < I_BR) { const int k = r / 512, r2 = r % 512, kb = r2 / 64, grp = r2 % 64;
            xpose_item(a.in[39] + ((size_t)l * 4 + k) * 512 * D, D, 64 * kb, hm_col(grp), wl + W_BR + (size_t)k * D * 512 + (size_t)(32 * grp) * 512, 512, scr, lane, 0); continue; } r -= I_BR;
        if (r < I_OUT) { const int kb = r / 64, grp = r % 64; xpose_item(a.in[40] + (size_t)l * D * D, D, 64 * kb, 32 * grp, wl + W_OUT + (size_t)(32 * grp) * D, D, scr, lane, 0); continue; } r -= I_OUT;
        if (r < I_1) { const int kb = r / 256, grp = r % 256; xpose_item(a.in[41] + (size_t)l * D * DFF, DFF, 64 * kb, hm_col(grp), wl + W_1 + (size_t)(32 * grp) * D, D, scr, lane, 0); continue; } r -= I_1;
        { const int kb = r / 64, grp = r % 64; xpose_item(a.in[42] + (size_t)l * DFF * D, D, 64 * kb, 32 * grp, wl + W_2 + (size_t)(32 * grp) * DFF, DFF, scr, lane, 0); }
    }
}
__device__ __forceinline__ void prologue_ada(const Args& a, LAS unsigned char* lds, int tid) {
    LAS float* sl = (LAS float*)lds;
    LAS float* red = (LAS float*)(lds + 40960);
    float* mod = (float*)(a.ws + WS_MOD);
    for (int i = tid; i < 5 * D; i += NT) { const int j = i / D, k = i % D; const float x = j == 0 ? a.in[11][k] : a.in[10][(j - 1) * D + k]; sl[i] = x / (1.f + __expf(-x)); }
    __syncthreads();
    const int ks = tid >> 6, c = tid & 63;
    for (int unit = blockIdx.x; unit < DEPTH * 6 * D / 64; unit += gridDim.x) {
        const int l = unit / (6 * D / 64), n0 = (unit % (6 * D / 64)) * 64;
        const float* w = a.in[12] + (size_t)l * D * 6 * D + n0 + c;
        float acc[5] = {0.f, 0.f, 0.f, 0.f, 0.f};
#pragma unroll 4
        for (int k = ks * 256; k < ks * 256 + 256; ++k) { const float wv = w[(size_t)k * 6 * D];
#pragma unroll
            for (int j = 0; j < 5; ++j) acc[j] += sl[j * D + k] * wv; }
#pragma unroll
        for (int j = 0; j < 5; ++j) red[(ks * 5 + j) * 64 + c] = acc[j];
        __syncthreads();
        if (tid < 320) { const int j = tid >> 6; float s = 0.f;
#pragma unroll
            for (int q = 0; q < 8; ++q) s += red[(q * 5 + j) * 64 + c];
            mod[((size_t)l * 5 + j) * 6 * D + n0 + c] = s + a.in[13][l * 6 * D + n0 + c]; }
        __syncthreads();
    }
}
__device__ __forceinline__ void norm_phase(const float* xp, const float* xs, const float* g, const float* modl, int sh_off, int sc_off, bf16_t* H, int gw, int ngw, int lane_) {
    int lane = lane_; asm volatile("" : "+v"(lane));
    for (int row = gw; row < M; row += ngw) {
        const float* x = row < MP ? xp + (size_t)row * D : xs + (size_t)(row - MP) * D;
        f32x4 v[8]; float ss = 0.f;
#pragma unroll
        for (int j = 0; j < 8; ++j) { v[j] = *(const f32x4*)(x + 4 * (lane + 64 * j)); ss += (v[j][0] * v[j][0] + v[j][1] * v[j][1]) + (v[j][2] * v[j][2] + v[j][3] * v[j][3]); }
        const float r = rsqrtf(wave_sum(ss) * (1.f / D) + 1e-6f);
        const float* md = modl + (size_t)row_cvec(row) * 6 * D;
#pragma unroll
        for (int j = 0; j < 8; ++j) { const int i = 4 * (lane + 64 * j);
            const f32x4 gg = *(const f32x4*)(g + i), sc = *(const f32x4*)(md + sc_off + i), sh = *(const f32x4*)(md + sh_off + i);
            const f32x4 o = v[j] * r * gg * (sc + 1.f) + sh;
            u32x2 w; w.x = pk2(o[0], o[1]); w.y = pk2(o[2], o[3]); *(u32x2*)(H + (size_t)row * D + i) = w; }
    }
}

}
namespace mk {
constexpr int C_Q = 0, C_K = 512, C_V = 1024, C_S5U = 1536, C_Z = 2048, C_XBC = 2560, C_DT = 3584, C_MQ = 3600, C_MK = 4112, C_MV = 4624, C_MO = 5136, C_MI = 5648, C_MF = 5656;
constexpr int NSEQ = 20;
struct PJA {
    const bf16_t* p; const float* sm;
    __device__ __forceinline__ float operator()(int row, int col) const {
        if (col < 3584) return bf2f(p[(size_t)row * PJ + col]);
        if (col < 3600) return sm[(size_t)row * 32 + col - 3584];
        if (col < 5648) return bf2f(p[(size_t)row * PJ + col - 16]);
        if (col < 5664) return sm[(size_t)row * 32 + 16 + col - 5648];
        return bf2f(p[(size_t)row * PJ + col - 32]);
    }
};
__device__ __forceinline__ void seq_info(int sq, int& row0, int& L, int& lat, int& b) {
    if (sq < 16) { row0 = sq * 256; L = 256; lat = 0; b = sq; } else { b = sq - 16; row0 = MP + b * 2048; L = 2048; lat = 1; }
}
__device__ __forceinline__ float nsilu(float x) { return x / (1.f + expf(-x)); }
__device__ __forceinline__ float nsigm(float x) { return 1.f / (1.f + expf(-x)); }
__device__ __forceinline__ float nsoftplus(float x) { return x > 20.f ? x : log1pf(expf(x)); }
__device__ __forceinline__ float ngelu(float x) { return 0.5f * x * (1.f + tanhf(0.7978845608028654f * (x + 0.044715f * x * x * x))); }

__device__ __forceinline__ void nv_attn_dense(const PJA& proj, bf16_t* br, int idx) {
    const int hh = idx % 8, row = idx / 8, b = row / 256;
    float q[64], o[64];
#pragma unroll
    for (int i = 0; i < 64; ++i) { q[i] = proj(row, C_Q + hh * 64 + i); o[i] = 0.f; }
    float mx = -1e30f, sum = 0.f;
    for (int s = 0; s < 256; ++s) { const int kr_ = b * 256 + s;
        float sc = 0;
#pragma unroll
        for (int i = 0; i < 64; ++i) sc += q[i] * proj(kr_, C_K + hh * 64 + i);
        sc *= 0.125f;
        const float mn = fmaxf(mx, sc), a = expf(mx - mn), p = expf(sc - mn); sum = sum * a + p;
#pragma unroll
        for (int i = 0; i < 64; ++i) o[i] = o[i] * a + p * proj(kr_, C_V + hh * 64 + i);
        mx = mn; }
#pragma unroll
    for (int i = 0; i < 64; ++i) br[(size_t)row * D + hh * 64 + i] = f2bf(o[i] / sum);
}
__device__ __forceinline__ void nv_attn_na(const PJA& proj, const float* ck, const float* cv, const float* rpb, int layer, bf16_t* br, int idx) {
    const int hh = idx % 8, lt = idx / 8, b = lt / 2048, t = lt % 2048, r = t / 64, c = t % 64;
    const int row = MP + lt; float q[64], o[64];
#pragma unroll
    for (int i = 0; i < 64; ++i) { q[i] = proj(row, C_Q + hh * 64 + i); o[i] = 0.f; }
    const int rs = min(max(r - 4, 0), 32 - 8), cs = min(max(c - 8, 0), 64 - 16);
    float mx = -1e30f, sum = 0.f;
    for (int j = 0; j < 8; ++j) for (int w = 0; w < 16; ++w) { const int kr = rs + j, kc = cs + w; const int krow = MP + b * 2048 + kr * 64 + kc;
        float sc = 0;
#pragma unroll
        for (int i = 0; i < 64; ++i) sc += q[i] * proj(krow, C_K + hh * 64 + i);
        sc = sc * 0.125f + rpb[(hh * 15 + (kr - r + 7)) * 31 + (kc - c + 15)];
        const float mn = fmaxf(mx, sc), a = expf(mx - mn), p = expf(sc - mn); sum = sum * a + p;
#pragma unroll
        for (int i = 0; i < 64; ++i) o[i] = o[i] * a + p * proj(krow, C_V + hh * 64 + i);
        mx = mn; }
    for (int s = 0; s < 512; ++s) { const size_t off = ((((size_t)b * DEPTH + layer) * 512 + s) * 8 + hh) * 64; const float* kp = ck + off; const float* vp = cv + off;
        float sc = 0;
#pragma unroll
        for (int i = 0; i < 64; ++i) sc += q[i] * kp[i];
        sc *= 0.125f;
        const float mn = fmaxf(mx, sc), a = expf(mx - mn), p = expf(sc - mn); sum = sum * a + p;
#pragma unroll
        for (int i = 0; i < 64; ++i) o[i] = o[i] * a + p * vp[i];
        mx = mn; }
#pragma unroll
    for (int i = 0; i < 64; ++i) br[(size_t)row * D + hh * 64 + i] = f2bf(o[i] / sum);
}
__device__ __forceinline__ void nv_s5(const PJA& proj, const Args& a, int layer, float* ys5, float* out, int wid, int n) {
    const int dir = wid % 2, g = (wid / 2) % 32, sq = wid / 64;
    int row0, L, lat, b; seq_info(sq, row0, L, lat, b);
    const float* a_re = a.in[20] + layer * 4096; const float* a_im = a.in[21] + layer * 4096; const float* log_dt = a.in[22] + layer * 64;
    const float* b_re = a.in[23] + (size_t)layer * 65536; const float* b_im = a.in[24] + (size_t)layer * 65536; const float* c_re = a.in[25] + (size_t)layer * 65536; const float* c_im = a.in[26] + (size_t)layer * 65536;
    const int pi = (dir * 32 + g) * 64 + n;
    const float are = fminf(a_re[pi], -1e-4f), aim = a_im[pi], dt = expf(log_dt[dir * 32 + g]);
    const float mag = expf(dt * are), abr = mag * cosf(dt * aim), abi = mag * sinf(dt * aim);
    const float den = are * are + aim * aim, nr = abr - 1.f, cfr = (nr * are + abi * aim) / den, cfi = (abi * are - nr * aim) / den;
    float bbr[16], bbi[16], cr[16], ci[16];
#pragma unroll
    for (int k = 0; k < 16; ++k) { const float br_ = b_re[(size_t)pi * 16 + k], bi_ = b_im[(size_t)pi * 16 + k]; bbr[k] = cfr * br_ - cfi * bi_; bbi[k] = cfr * bi_ + cfi * br_;
        cr[k] = c_re[((size_t)(dir * 32 + g) * 16 + k) * 64 + n]; ci[k] = c_im[((size_t)(dir * 32 + g) * 16 + k) * 64 + n]; }
    float hr = 0.f, hi = 0.f;
    if (lat) { const size_t so = ((((size_t)b * DEPTH + layer) * 2 + dir) * 32 + g) * 64 + n; hr = a.in[4][so]; hi = a.in[5][so]; }
    for (int s = 0; s < L; ++s) { const int t = dir ? L - 1 - s : s;
        float bur = 0, bui = 0;
#pragma unroll
        for (int k = 0; k < 16; ++k) { const float uv = proj(row0 + t, C_S5U + g * 16 + k); bur += uv * bbr[k]; bui += uv * bbi[k]; }
        const float nhr = abr * hr - abi * hi + bur, nhi = abr * hi + abi * hr + bui; hr = nhr; hi = nhi;
        float myy = 0.f;
#pragma unroll
        for (int k = 0; k < 16; ++k) { float v = hr * cr[k] - hi * ci[k];
#pragma unroll
            for (int o = 32; o > 0; o >>= 1) v += __shfl_xor(v, o);
            if (n == k) myy = v; }
        if (n < 16) ys5[((size_t)dir * M + row0 + t) * 512 + g * 16 + n] = myy; }
    if (!lat) { const size_t oo = ((((size_t)b * DEPTH + layer) * 2 + dir) * 32 + g) * 64 + n; out[O_S5R + oo] = hr; out[O_S5I + oo] = hi; }
}
__device__ __forceinline__ void nv_ssd_seq(const PJA& proj, const float* xbc, const Args& a, int layer, float* yssd, float* out, int wid, int p) {
    const int dir = wid % 2, hh = (wid / 2) % 8, sq = wid / 16;
    int row0, L, lat, b; seq_info(sq, row0, L, lat, b);
    float h[128];
    if (lat) { const float* sp = a.in[6] + (((((size_t)b * DEPTH + layer) * 2 + dir) * 8 + hh) * 64 + p) * 128;
#pragma unroll
        for (int n = 0; n < 128; ++n) h[n] = sp[n]; }
    else {
#pragma unroll
        for (int n = 0; n < 128; ++n) h[n] = 0.f; }
    const float A = -expf(a.in[33][layer * 16 + dir * 8 + hh]), dtb = a.in[32][layer * 16 + dir * 8 + hh]; const int grp = hh / 4;
    for (int s = 0; s < L; ++s) { const int t = dir ? L - 1 - s : s; const int row = row0 + t;
        const float dt = nsoftplus(proj(row, C_DT + dir * 8 + hh) + dtb), dec = expf(dt * A);
        const float xd = xbc[(size_t)row * 1024 + hh * 64 + p] * dt;
        const float* Bv = xbc + (size_t)row * 1024 + 512 + grp * 128; const float* Cv = xbc + (size_t)row * 1024 + 768 + grp * 128;
        float y = 0.f;
#pragma unroll
        for (int n = 0; n < 128; ++n) { h[n] = dec * h[n] + Bv[n] * xd; y += Cv[n] * h[n]; }
        yssd[((size_t)dir * M + row) * 512 + hh * 64 + p] = y; }
    if (!lat) { float* op = out + O_SSD + (((((size_t)b * DEPTH + layer) * 2 + dir) * 8 + hh) * 64 + p) * 128;
#pragma unroll
        for (int n = 0; n < 128; ++n) op[n] = h[n]; }
}
struct MixScr { float* xbc; float* ys5; float* yssd; float* yml; float* qr; float* kr; };
__device__ __forceinline__ MixScr mix_scr(unsigned char* ws) { MixScr s; s.xbc = (float*)(ws + WS_SCR); s.ys5 = s.xbc + (size_t)M * 1024; s.yssd = s.ys5 + (size_t)2 * M * 512; s.yml = s.yssd + (size_t)2 * M * 512;
    s.qr = s.yml + (size_t)2 * M * 512; s.kr = s.qr + (size_t)M * 512; return s; }

__device__ __forceinline__ void nmix_a(const Args& a, int layer, int gw_, int ngw, int lane_) {
    int lane = lane_, gw = gw_; asm volatile("" : "+v"(lane));
    const PJA proj{(const bf16_t*)(a.ws + WS_PROJ), (const float*)(a.ws + WS_SMALL)}; bf16_t* BR = (bf16_t*)(a.ws + WS_BR); const MixScr sc = mix_scr(a.ws);
    for (int it = gw; it < 2816; it += ngw) {
        if (it < 256) nv_s5(proj, a, layer, sc.ys5, a.out, 1024 + it, lane);
        else if (it < 1280) nv_attn_na(proj, a.in[2], a.in[3], a.in[19] + (size_t)layer * 8 * 15 * 31, layer, BR, (it - 256) * 64 + lane);
        else if (it < 1792) nv_attn_dense(proj, BR, (it - 1280) * 64 + lane);
        else nv_s5(proj, a, layer, sc.ys5, a.out, it - 1792, lane);
    }
    const float* cw = a.in[30] + layer * 5 * 1024; const float* cb = a.in[31] + layer * 1024;
    for (size_t idx = (size_t)gw * 64 + lane; idx < (size_t)M * 1024; idx += (size_t)ngw * 64) { const int row = idx / 1024, ch = idx % 1024;
        const int sq = row < MP ? row / 256 : 16 + (row - MP) / 2048; int row0, L, lat, b; seq_info(sq, row0, L, lat, b); const int t = row - row0;
        float acc = cb[ch];
#pragma unroll
        for (int j = 0; j < 5; ++j) { const int tt = t + j - 2; if (tt >= 0 && tt < L) acc += proj(row0 + tt, C_XBC + ch) * cw[j * 1024 + ch]; }
        sc.xbc[idx] = nsilu(acc); }
}
__device__ __forceinline__ void nmix_b(const Args& a, int layer, LAS unsigned char* lds, int tid_, int G) {
    int tid = tid_; asm volatile("" : "+v"(tid));
    const int lane = tid & 63, wave = __builtin_amdgcn_readfirstlane(tid >> 6), blk = blockIdx.x;
    const PJA proj{(const bf16_t*)(a.ws + WS_PROJ), (const float*)(a.ws + WS_SMALL)}; const MixScr sc = mix_scr(a.ws);
    if (blk < 64) {
        if (wave == 0) nv_ssd_seq(proj, sc.xbc, a, layer, sc.yssd, a.out, 256 + blk, lane);
    } else if (blk < 96) {
        nv_ssd_seq(proj, sc.xbc, a, layer, sc.yssd, a.out, (blk - 64) * 8 + wave, lane);
    } else {
        bf16_t* ZB = (bf16_t*)(a.ws + WS_ZB); const float* s5d = a.in[27] + layer * 512; const int nb_ = G - 96;
        for (size_t idx = (size_t)(blk - 96) * NT + tid; idx < (size_t)M * 512; idx += (size_t)nb_ * NT) { const int row = idx / 512, cidx = idx % 512;
            const float y = sc.ys5[idx] + sc.ys5[(size_t)M * 512 + idx] + proj(row, C_S5U + cidx) * s5d[cidx]; ZB[idx] = f2bf(ngelu(y)); }
    }
}
__device__ __forceinline__ void nmix_c(const Args& a, int layer, int gw, int ngw, int lane_) {
    int lane = lane_; asm volatile("" : "+v"(lane));
    const PJA proj{(const bf16_t*)(a.ws + WS_PROJ), (const float*)(a.ws + WS_SMALL)}; bf16_t* BR = (bf16_t*)(a.ws + WS_BR); const MixScr sc = mix_scr(a.ws);
    const float* ssd_d = a.in[34] + layer * 8; const float* sng = a.in[35] + layer * 512; const float* mng = a.in[38] + layer * 512;
    for (int row = gw; row < M; row += ngw) {
        float v[8]; float ss = 0.f;
#pragma unroll
        for (int i = 0; i < 8; ++i) { const int ch = lane + 64 * i; float y = sc.yssd[(size_t)row * 512 + ch] + sc.yssd[((size_t)M + row) * 512 + ch] + sc.xbc[(size_t)row * 1024 + ch] * ssd_d[ch / 64];
            y *= nsilu(proj(row, C_Z + ch)); v[i] = y; ss += y * y; }
        const float r = rsqrtf(wave_sum(ss) * (1.f / 512.f) + 1e-6f);
#pragma unroll
        for (int i = 0; i < 8; ++i) { const int ch = lane + 64 * i; BR[(size_t)row * D + 1024 + ch] = f2bf(v[i] * r * sng[ch]); }
    }
}
}
namespace mk {
constexpr size_t WS_NAT = AL(WS_SCR + (size_t)M * (1024 + 6 * 512 + 2 * 512) * 4);
constexpr int NATP = 2048, N_XBC = 0, N_Q = 1024, N_K = 1536;
constexpr size_t WS_TR = AL(WS_NAT + (size_t)M * NATP * 2);
constexpr int T_X = 0, T_B = 512, T_K = 768, T_MV = 1280, T_V = 1792, TRR = 2304;
constexpr int NCH = 96;
constexpr size_t WS_MLC = AL(WS_TR + (size_t)TRR * M * 2);
constexpr size_t WS_MLN = AL(WS_MLC + (size_t)NCH * 4 * 2 * 16384 * 4);
constexpr size_t WS_MLS = AL(WS_MLN + (size_t)NCH * 4 * 2 * 128 * 4);
constexpr size_t WS_MLCS = AL(WS_MLS + (size_t)NCH * 4 * 2 * 4 * 4);
constexpr size_t WS_MLNS = AL(WS_MLCS + (size_t)NCH * 4 * 2 * 16384 * 2);
constexpr size_t WS_MLMS = AL(WS_MLNS + (size_t)NCH * 4 * 2 * 128 * 4);
constexpr size_t WS_OPT_END = AL(WS_MLMS + (size_t)NCH * 4 * 2 * 4);

__device__ __forceinline__ f32x4 mfma16(bf16x8 a, bf16x8 b, f32x4 c) { return __builtin_amdgcn_mfma_f32_16x16x32_bf16(a, b, c, 0, 0, 0); }
__device__ __forceinline__ void chunk_info(int ch, int& row0, int& seq0, int& L, int& lat, int& b, int& ci, int& nc) {
    if (ch < 32) { b = ch >> 1; ci = ch & 1; nc = 2; seq0 = b * 256; L = 256; lat = 0; } else { const int c2 = ch - 32; b = c2 >> 4; ci = c2 & 15; nc = 16; seq0 = MP + b * 2048; L = 2048; lat = 1; }
    row0 = seq0 + ci * 128;
}
__device__ __forceinline__ float fast_exp(float x) { return __expf(x); }

__device__ __forceinline__ void prep_phase(const Args& a, int layer, LAS unsigned char* lds, int gw_, int ngw, int wave, int lane_) {
    int lane = lane_, gw = gw_; asm volatile("" : "+v"(lane));
    const bf16_t* PROJ = (const bf16_t*)(a.ws + WS_PROJ); bf16_t* NAT = (bf16_t*)(a.ws + WS_NAT); bf16_t* TR = (bf16_t*)(a.ws + WS_TR);
    LAS bf16_t* tile = (LAS bf16_t*)(lds + wave * 16896); LAS bf16_t* otile = tile + 68 * 64;
    const int c = lane & 7, r8 = lane >> 3;
    const float* cw = a.in[30] + layer * 5 * 1024; const float* cb = a.in[31] + layer * 1024;
    for (int u = gw; u < 48 * 192; u += ngw) {
        const int cg = u / 192, tt = u % 192, m0 = tt * 64;
        const int lat = m0 >= MP; const int seq0 = lat ? MP + ((m0 - MP) / 2048) * 2048 : (m0 / 256) * 256, L = lat ? 2048 : 256, t0 = m0 - seq0;
        int kind, src, natcol = -1, trrow = -1;
        if (cg < 16) { kind = 0; src = P_XBC + 64 * cg; natcol = N_XBC + 64 * cg; if (cg < 12) trrow = T_X + 64 * cg; }
        else if (cg < 24) { kind = 1; src = P_MQ + 64 * (cg - 16); natcol = N_Q + 64 * (cg - 16); }
        else if (cg < 32) { kind = 2; src = P_MK + 64 * (cg - 24); natcol = N_K + 64 * (cg - 24); trrow = T_K + 64 * (cg - 24); }
        else if (cg < 40) { kind = 3; src = P_MV + 64 * (cg - 32); trrow = T_MV + 64 * (cg - 32); }
        else { kind = 3; src = P_V + 64 * (cg - 40); trrow = T_V + 64 * (cg - 40); }
        const int roff = kind == 0 ? -2 : 0, nrows = kind == 0 ? 68 : 64;
#pragma unroll
        for (int i = 0; i < 9; ++i) { const int r = r8 + 8 * i; if (r < nrows) { const int t = t0 + r + roff; u32x4 v = {0u, 0u, 0u, 0u};
                if (t >= 0 && t < L) v = *(const u32x4*)(PROJ + (size_t)(seq0 + t) * PJ + src + 8 * c);
                *(LAS u32x4*)(tile + r * 64 + 8 * c) = v; } }
        LDS_WAIT(); asm volatile("" ::: "memory");
#define PREP_EMIT(i_, r_) do { if (natcol >= 0) *(u32x4*)(NAT + (size_t)(m0 + r8 + 8 * (i_)) * NATP + natcol + 8 * c) = (r_); if (trrow >= 0) *(LAS u32x4*)(otile + (r8 + 8 * (i_)) * 64 + 8 * c) = (r_); } while (0)
        if (kind == 0) {
            float w[5][8], bz[8];
#pragma unroll
            for (int e = 0; e < 8; ++e) { bz[e] = cb[64 * cg + 8 * c + e];
#pragma unroll
                for (int j = 0; j < 5; ++j) w[j][e] = cw[j * 1024 + 64 * cg + 8 * c + e]; }
#pragma unroll 2
            for (int i = 0; i < 8; ++i) { const int tk = r8 + 8 * i; float acc[8];
#pragma unroll
                for (int e = 0; e < 8; ++e) acc[e] = bz[e];
#pragma unroll
                for (int j = 0; j < 5; ++j) { const u32x4 v = *(const LAS u32x4*)(tile + (tk + j) * 64 + 8 * c);
                    acc[0] += bflo(v.x) * w[j][0]; acc[1] += bfhi(v.x) * w[j][1]; acc[2] += bflo(v.y) * w[j][2]; acc[3] += bfhi(v.y) * w[j][3];
                    acc[4] += bflo(v.z) * w[j][4]; acc[5] += bfhi(v.z) * w[j][5]; acc[6] += bflo(v.w) * w[j][6]; acc[7] += bfhi(v.w) * w[j][7]; }
#pragma unroll
                for (int e = 0; e < 8; ++e) acc[e] = fsilu(acc[e]);
                u32x4 rv; rv.x = pk2(acc[0], acc[1]); rv.y = pk2(acc[2], acc[3]); rv.z = pk2(acc[4], acc[5]); rv.w = pk2(acc[6], acc[7]); PREP_EMIT(i, rv); }
        } else if (kind == 3 || !lat) {
            const float sc = kind == 2 ? 0.08838834764831845f : 1.f;
#pragma unroll
            for (int i = 0; i < 8; ++i) { const u32x4 v = *(const LAS u32x4*)(tile + (r8 + 8 * i) * 64 + 8 * c);
                u32x4 rv = v;
                if (kind == 2) { rv.x = pk2(bflo(v.x) * sc, bfhi(v.x) * sc); rv.y = pk2(bflo(v.y) * sc, bfhi(v.y) * sc); rv.z = pk2(bflo(v.z) * sc, bfhi(v.z) * sc); rv.w = pk2(bflo(v.w) * sc, bfhi(v.w) * sc); }
                PREP_EMIT(i, rv); }
        } else {
            const float sc = kind == 2 ? 0.08838834764831845f : 1.f; const int odd = cg & 1;
            float inv[8];
#pragma unroll
            for (int e = 0; e < 8; ++e) inv[e] = exp2f(-(float)(8 * (c & 3) + e) * (13.287712379549449f / 32.f));
#pragma unroll
            for (int i = 0; i < 8; ++i) { const int tk = r8 + 8 * i, t = t0 + tk; const float pos = odd ? (float)(t & 63) : (float)(t >> 6);
                const u32x4 vo = *(const LAS u32x4*)(tile + tk * 64 + 8 * c), vp = *(const LAS u32x4*)(tile + tk * 64 + 8 * (c ^ 4));
                float o[8], p[8], rr[8];
                o[0] = bflo(vo.x); o[1] = bfhi(vo.x); o[2] = bflo(vo.y); o[3] = bfhi(vo.y); o[4] = bflo(vo.z); o[5] = bfhi(vo.z); o[6] = bflo(vo.w); o[7] = bfhi(vo.w);
                p[0] = bflo(vp.x); p[1] = bfhi(vp.x); p[2] = bflo(vp.y); p[3] = bfhi(vp.y); p[4] = bflo(vp.z); p[5] = bfhi(vp.z); p[6] = bflo(vp.w); p[7] = bfhi(vp.w);
#pragma unroll
                for (int e = 0; e < 8; ++e) { const float ang = pos * inv[e], cs = __cosf(ang), sn = __sinf(ang);
                    rr[e] = (c < 4 ? o[e] * cs - p[e] * sn : p[e] * sn + o[e] * cs) * sc; }
                u32x4 rv; rv.x = pk2(rr[0], rr[1]); rv.y = pk2(rr[2], rr[3]); rv.z = pk2(rr[4], rr[5]); rv.w = pk2(rr[6], rr[7]); PREP_EMIT(i, rv); }
        }
        if (trrow >= 0) {
            LDS_WAIT(); asm volatile("" ::: "memory");
            bf16_t* dst = TR + (size_t)(trrow + lane) * M + m0;
#pragma unroll
            for (int j = 0; j < 8; ++j) { unsigned wv[4];
#pragma unroll
                for (int q = 0; q < 4; ++q) { const unsigned lo = otile[(8 * j + 2 * q) * 64 + lane], hi = otile[(8 * j + 2 * q + 1) * 64 + lane]; wv[q] = lo | (hi << 16); }
                u32x4 o; o.x = wv[0]; o.y = wv[1]; o.z = wv[2]; o.w = wv[3]; *(u32x4*)(dst + 8 * j) = o; }
        }
        LDS_WAIT(); asm volatile("" ::: "memory");
    }
}

struct MlGate { float lf0, lf1, ig0, ig1, P0, P1, tot; };
__device__ __forceinline__ float wave_incl_scan(float v, int lane) {
#pragma unroll
    for (int o = 1; o < 64; o <<= 1) { const float t = __shfl_up(v, o); if (lane >= o) v += t; }
    return v;
}
__device__ __forceinline__ float wave_max(float v) {
#pragma unroll
    for (int o = 1; o < 64; o <<= 1) v = fmaxf(v, __shfl_xor(v, o));
    return v;
}
__device__ __forceinline__ MlGate ml_gates(const Args& a, int layer, int row0, int hh, int dir, int lane) {
    const float* SMALL = (const float*)(a.ws + WS_SMALL);
    const float ib = a.in[36][layer * 8 + dir * 4 + hh], fb = a.in[37][layer * 8 + dir * 4 + hh];
    MlGate g;
    const float f0 = SMALL[(size_t)(row0 + lane) * 32 + S_MF + dir * 4 + hh] + fb, f1 = SMALL[(size_t)(row0 + lane + 64) * 32 + S_MF + dir * 4 + hh] + fb;
    g.ig0 = SMALL[(size_t)(row0 + lane) * 32 + S_MI + dir * 4 + hh] + ib; g.ig1 = SMALL[(size_t)(row0 + lane + 64) * 32 + S_MI + dir * 4 + hh] + ib;
    g.lf0 = fminf(f0, 0.f) - log1pf(__expf(-fabsf(f0))); g.lf1 = fminf(f1, 0.f) - log1pf(__expf(-fabsf(f1)));
    const float s0 = wave_incl_scan(g.lf0, lane); const float tot0 = __shfl(s0, 63);
    const float s1 = wave_incl_scan(g.lf1, lane) + tot0;
    g.P0 = s0; g.P1 = s1; g.tot = __shfl(s1, 63);
    return g;
}

__device__ __forceinline__ void ml_states_phase(const Args& a, int layer, int tid_, int G) {
    int tid = tid_; asm volatile("" : "+v"(tid));
    const int lane = tid & 63, wave = __builtin_amdgcn_readfirstlane(tid >> 6), fr = lane & 15, fq = lane >> 4;
    const bf16_t* TR = (const bf16_t*)(a.ws + WS_TR);
    float* MLC = (float*)(a.ws + WS_MLC); float* MLN = (float*)(a.ws + WS_MLN); float* MLS = (float*)(a.ws + WS_MLS);
    for (int u = blockIdx.x; u < NCH * 4; u += G) {
        const int ch = u >> 2, hh = u & 3; int row0, seq0, L, lat, b, ci, nc; chunk_info(ch, row0, seq0, L, lat, b, ci, nc);
#pragma unroll
        for (int dir = 0; dir < 2; ++dir) {
            const MlGate g = ml_gates(a, layer, row0, hh, dir, lane);
            const float w0 = (dir == 0 ? g.tot - g.P0 : g.P0 - g.lf0) + g.ig0, w1 = (dir == 0 ? g.tot - g.P1 : g.P1 - g.lf1) + g.ig1;
            const float mloc = wave_max(fmaxf(w0, w1));
            const float e0 = __expf(w0 - mloc), e1 = __expf(w1 - mloc);
            f32x4 acc[8];
#pragma unroll
            for (int j = 0; j < 8; ++j) acc[j] = (f32x4){0.f, 0.f, 0.f, 0.f};
            float nacc[8];
#pragma unroll
            for (int j = 0; j < 8; ++j) nacc[j] = 0.f;
            const bf16_t* vrow = TR + (size_t)(T_MV + hh * 128 + wave * 16 + fr) * M + row0 + 8 * fq;
#pragma unroll
            for (int ks = 0; ks < 4; ++ks) {
                const bf16x8 af = *(const bf16x8*)(vrow + 32 * ks);
                float ev[8];
#pragma unroll
                for (int j = 0; j < 8; ++j) { const int tok = 32 * ks + 8 * fq + j; const float x0 = __shfl(e0, tok & 63), x1 = __shfl(e1, tok & 63); ev[j] = tok < 64 ? x0 : x1; }
#pragma unroll
                for (int jt = 0; jt < 8; ++jt) {
                    const u32x4 kv = *(const u32x4*)(TR + (size_t)(T_K + hh * 128 + jt * 16 + fr) * M + row0 + 32 * ks + 8 * fq);
                    const float k0 = bflo(kv.x) * ev[0], k1 = bfhi(kv.x) * ev[1], k2 = bflo(kv.y) * ev[2], k3 = bfhi(kv.y) * ev[3], k4 = bflo(kv.z) * ev[4], k5 = bfhi(kv.z) * ev[5], k6 = bflo(kv.w) * ev[6], k7 = bfhi(kv.w) * ev[7];
                    if (wave == 0) nacc[jt] += ((k0 + k1) + (k2 + k3)) + ((k4 + k5) + (k6 + k7));
                    u32x4 kb; kb.x = pk2(k0, k1); kb.y = pk2(k2, k3); kb.z = pk2(k4, k5); kb.w = pk2(k6, k7);
                    acc[jt] = mfma16(af, __builtin_bit_cast(bf16x8, kb), acc[jt]);
                }
            }
            float* cdst = MLC + ((size_t)(ch * 4 + hh) * 2 + dir) * 16384;
#pragma unroll
            for (int jt = 0; jt < 8; ++jt)
#pragma unroll
                for (int i = 0; i < 4; ++i) cdst[(size_t)(wave * 16 + 4 * fq + i) * 128 + jt * 16 + fr] = acc[jt][i];
            if (wave == 0) {
#pragma unroll
                for (int jt = 0; jt < 8; ++jt) { float v = nacc[jt]; v += __shfl_xor(v, 16); v += __shfl_xor(v, 32); if (fq == 0) MLN[((size_t)(ch * 4 + hh) * 2 + dir) * 128 + jt * 16 + fr] = v; }
                if (lane == 0) { MLS[((size_t)(ch * 4 + hh) * 2 + dir) * 4 + 0] = mloc; MLS[((size_t)(ch * 4 + hh) * 2 + dir) * 4 + 1] = g.tot; }
            }
        }
    }
}
__device__ __forceinline__ void ml_scan_phase(const Args& a, int layer, int tid_, int G) {
    int tid = tid_; asm volatile("" : "+v"(tid));
    const float* MLC = (const float*)(a.ws + WS_MLC); const float* MLN = (const float*)(a.ws + WS_MLN); const float* MLS = (const float*)(a.ws + WS_MLS);
    bf16_t* CS = (bf16_t*)(a.ws + WS_MLCS); float* NS = (float*)(a.ws + WS_MLNS); float* MS = (float*)(a.ws + WS_MLMS);
    for (int task = blockIdx.x; task < 256; task += G) {
        int lat, b, hh, dir, part, nparts;
        if (task < 128) { lat = 1; part = task & 3; dir = (task >> 2) & 1; hh = (task >> 3) & 3; b = task >> 5; nparts = 4; }
        else { const int t2 = task - 128; lat = 0; part = 0; dir = t2 & 1; hh = (t2 >> 1) & 3; b = t2 >> 3; nparts = 1; }
        const int nc = lat ? 16 : 2, ch0 = lat ? 32 + b * 16 : b * 2;
        const int nel = 16384 / nparts, e0 = part * nel, per = nel / NT;
        float c[32]; float n = 0.f, m = 0.f;
        const size_t so = (((size_t)b * DEPTH + layer) * 2 + dir) * 4 + hh;
#pragma unroll
        for (int i = 0; i < 32; ++i) if (i < per) { const int e = e0 + i * NT + tid, vd = e >> 7, kd = e & 127; c[i] = lat ? a.in[7][(so * 128 + kd) * 128 + vd] : 0.f; }
        if (tid < 128) n = lat ? a.in[8][so * 128 + tid] : 0.f;
        m = lat ? a.in[9][so] : 0.f;
        for (int s = 0; s < nc; ++s) { const int ci = dir ? nc - 1 - s : s, ch = ch0 + ci; const size_t sb = (size_t)(ch * 4 + hh) * 2 + dir;
#pragma unroll
            for (int i = 0; i < 32; ++i) if (i < per) CS[sb * 16384 + e0 + i * NT + tid] = f2bf(c[i]);
            if (part == 0) { if (tid < 128) NS[sb * 128 + tid] = n; if (tid == 0) MS[sb] = m; }
            const float ml = MLS[sb * 4 + 0], bl = MLS[sb * 4 + 1];
            const float mn = fmaxf(bl + m, ml), fa = __expf(bl + m - mn), fb = __expf(ml - mn);
#pragma unroll
            for (int i = 0; i < 32; ++i) if (i < per) c[i] = fa * c[i] + fb * MLC[sb * 16384 + e0 + i * NT + tid];
            if (tid < 128) n = fa * n + fb * MLN[sb * 128 + tid];
            m = mn; }
        if (!lat) {
#pragma unroll
            for (int i = 0; i < 32; ++i) if (i < per) { const int e = e0 + i * NT + tid, vd = e >> 7, kd = e & 127; a.out[O_MLC + (so * 128 + kd) * 128 + vd] = c[i]; }
            if (tid < 128) a.out[O_MLN + so * 128 + tid] = n; if (tid == 0) a.out[O_MLM + so] = m; }
    }
}
__device__ __forceinline__ void ml_out_phase(const Args& a, int layer, LAS unsigned char* lds, int tid_, int G) {
    int tid = tid_; asm volatile("" : "+v"(tid));
    const int lane = tid & 63, wave = __builtin_amdgcn_readfirstlane(tid >> 6), fr = lane & 15, fq = lane >> 4;
    const bf16_t* NAT = (const bf16_t*)(a.ws + WS_NAT); const bf16_t* TR = (const bf16_t*)(a.ws + WS_TR); const bf16_t* PROJ = (const bf16_t*)(a.ws + WS_PROJ);
    const bf16_t* CS = (const bf16_t*)(a.ws + WS_MLCS); const float* NS = (const float*)(a.ws + WS_MLNS); const float* MS = (const float*)(a.ws + WS_MLMS);
    bf16_t* BR = (bf16_t*)(a.ws + WS_BR);
    LAS float* U = (LAS float*)lds; LAS float* Wv = U + 128; LAS float* SI = U + 256; LAS float* EM = U + 384; LAS float* NSs = U + 512;
    for (int u = blockIdx.x; u < NCH * 4; u += G) {
        const int ch = u >> 2, hh = u & 3; int row0, seq0, L, lat, b, ci, nc; chunk_info(ch, row0, seq0, L, lat, b, ci, nc);
        const int t = wave * 16 + fr;
        bf16x8 qf[4];
#pragma unroll
        for (int ks = 0; ks < 4; ++ks) qf[ks] = *(const bf16x8*)(NAT + (size_t)(row0 + t) * NATP + N_Q + hh * 128 + 32 * ks + 8 * fq);
        f32x4 hsum[8];
#pragma unroll
        for (int j = 0; j < 8; ++j) hsum[j] = (f32x4){0.f, 0.f, 0.f, 0.f};
#pragma unroll 1
        for (int dir = 0; dir < 2; ++dir) {
            const size_t sb = (size_t)(ch * 4 + hh) * 2 + dir;
            __syncthreads();
            if (wave == 0) {
                const MlGate g = ml_gates(a, layer, row0, hh, dir, lane); const float ms = MS[sb];
                float u0, u1, c0, c1, ai0, ai1;
                if (dir == 0) { u0 = g.ig0 - g.P0; u1 = g.ig1 - g.P1; c0 = g.P0; c1 = g.P1; ai0 = g.P0 + ms; ai1 = g.P1 + ms; }
                else { const float E0 = g.P0 - g.lf0, E1 = g.P1 - g.lf1; u0 = E0 + g.ig0; u1 = E1 + g.ig1; c0 = -E0; c1 = -E1; ai0 = g.tot - E0 + ms; ai1 = g.tot - E1 + ms; }
                float g0 = u0, g1 = u1;
                if (dir == 0) {
#pragma unroll
                    for (int o = 1; o < 64; o <<= 1) { const float x0 = __shfl_up(g0, o), x1 = __shfl_up(g1, o); if (lane >= o) { g0 = fmaxf(g0, x0); g1 = fmaxf(g1, x1); } }
                    g1 = fmaxf(g1, __shfl(g0, 63));
                } else {
#pragma unroll
                    for (int o = 1; o < 64; o <<= 1) { const float x0 = __shfl_down(g0, o), x1 = __shfl_down(g1, o); if (lane + o < 64) { g0 = fmaxf(g0, x0); g1 = fmaxf(g1, x1); } }
                    g0 = fmaxf(g0, __shfl(g1, 0));
                }
                const float mt0 = fmaxf(ai0, c0 + g0), mt1 = fmaxf(ai1, c1 + g1);
                U[lane] = u0; U[lane + 64] = u1; Wv[lane] = c0 - mt0; Wv[lane + 64] = c1 - mt1;
                SI[lane] = __expf(ai0 - mt0); SI[lane + 64] = __expf(ai1 - mt1); EM[lane] = __expf(-mt0); EM[lane + 64] = __expf(-mt1);
                NSs[lane] = NS[sb * 128 + lane]; NSs[lane + 64] = NS[sb * 128 + lane + 64];
            }
            __syncthreads();
            const float wt = Wv[t], sit = SI[t], emt = EM[t];
            f32x4 acc[8];
#pragma unroll
            for (int j = 0; j < 8; ++j) acc[j] = (f32x4){0.f, 0.f, 0.f, 0.f};
#pragma unroll
            for (int ks = 0; ks < 4; ++ks)
#pragma unroll
                for (int j = 0; j < 8; ++j) { const bf16x8 cf = *(const bf16x8*)(CS + sb * 16384 + (size_t)(16 * j + fr) * 128 + 32 * ks + 8 * fq); acc[j] = mfma16(cf, qf[ks], acc[j]); }
            float qn = 0.f;
#pragma unroll
            for (int ks = 0; ks < 4; ++ks) { const u32x4 qv = __builtin_bit_cast(u32x4, qf[ks]); const LAS float* nn = NSs + 32 * ks + 8 * fq;
                qn += bflo(qv.x) * nn[0] + bfhi(qv.x) * nn[1] + bflo(qv.y) * nn[2] + bfhi(qv.y) * nn[3] + bflo(qv.z) * nn[4] + bfhi(qv.z) * nn[5] + bflo(qv.w) * nn[6] + bfhi(qv.w) * nn[7]; }
            qn += __shfl_xor(qn, 16); qn += __shfl_xor(qn, 32);
#pragma unroll
            for (int j = 0; j < 8; ++j) acc[j] *= sit;
            float den = sit * qn;
            const int jlo = dir == 0 ? 0 : (wave >> 1), jhi = dir == 0 ? (wave >> 1) : 3;
            float psum = 0.f;
            for (int jp = jlo; jp <= jhi; ++jp) {
                const int ta = 32 * jp + 8 * (fr >> 2) + (fr & 3);
                f32x4 sa = (f32x4){0.f, 0.f, 0.f, 0.f}, sb2 = (f32x4){0.f, 0.f, 0.f, 0.f};
#pragma unroll
                for (int ks = 0; ks < 4; ++ks) {
                    const bf16x8 ka = *(const bf16x8*)(NAT + (size_t)(row0 + ta) * NATP + N_K + hh * 128 + 32 * ks + 8 * fq);
                    const bf16x8 kb = *(const bf16x8*)(NAT + (size_t)(row0 + ta + 4) * NATP + N_K + hh * 128 + 32 * ks + 8 * fq);
                    sa = mfma16(ka, qf[ks], sa); sb2 = mfma16(kb, qf[ks], sb2); }
                float pa[4], pb[4];
#pragma unroll
                for (int i = 0; i < 4; ++i) { const int s0 = 32 * jp + 8 * fq + i, s1 = s0 + 4;
                    const bool ok0 = dir == 0 ? s0 <= t : s0 >= t, ok1 = dir == 0 ? s1 <= t : s1 >= t;
                    pa[i] = ok0 ? sa[i] * __expf(U[s0] + wt) : 0.f; pb[i] = ok1 ? sb2[i] * __expf(U[s1] + wt) : 0.f;
                    psum += pa[i] + pb[i]; }
                u32x4 pw; pw.x = pk2(pa[0], pa[1]); pw.y = pk2(pa[2], pa[3]); pw.z = pk2(pb[0], pb[1]); pw.w = pk2(pb[2], pb[3]);
                const bf16x8 pf = __builtin_bit_cast(bf16x8, pw);
#pragma unroll
                for (int j = 0; j < 8; ++j) { const bf16x8 vf = *(const bf16x8*)(TR + (size_t)(T_MV + hh * 128 + 16 * j + fr) * M + row0 + 32 * jp + 8 * fq); acc[j] = mfma16(vf, pf, acc[j]); }
            }
            psum += __shfl_xor(psum, 16); psum += __shfl_xor(psum, 32);
            den += psum;
            const float rden = 1.f / fmaxf(fabsf(den), emt);
#pragma unroll
            for (int j = 0; j < 8; ++j) hsum[j] += acc[j] * rden;
        }
        float ss = 0.f;
#pragma unroll
        for (int j = 0; j < 8; ++j) ss += (hsum[j][0] * hsum[j][0] + hsum[j][1] * hsum[j][1]) + (hsum[j][2] * hsum[j][2] + hsum[j][3] * hsum[j][3]);
        ss += __shfl_xor(ss, 16); ss += __shfl_xor(ss, 32);
        const float r = rsqrtf(ss * (1.f / 128.f) + 1e-6f);
        const float* ng = a.in[38] + layer * 512 + hh * 128;
#pragma unroll
        for (int j = 0; j < 8; ++j) { const int vd = 16 * j + 4 * fq; const f32x4 gg = *(const f32x4*)(ng + vd);
            const u32x2 ov = *(const u32x2*)(PROJ + (size_t)(row0 + t) * PJ + P_MO + hh * 128 + vd);
            const float o0 = hsum[j][0] * r * gg[0] * fsigm(bflo(ov.x)), o1 = hsum[j][1] * r * gg[1] * fsigm(bfhi(ov.x)), o2 = hsum[j][2] * r * gg[2] * fsigm(bflo(ov.y)), o3 = hsum[j][3] * r * gg[3] * fsigm(bfhi(ov.y));
            u32x2 w; w.x = pk2(o0, o1); w.y = pk2(o2, o3); *(u32x2*)(BR + (size_t)(row0 + t) * D + 1536 + hh * 128 + vd) = w; }
    }
}
}
namespace mk {
#ifndef PHMASK
#define PHMASK 0xfffff
#endif
#define PHM(k) ((PHMASK >> (k)) & 1)
constexpr int NPH = 12;
constexpr int PH_TOTAL = 1 + DEPTH * NPH;
__global__ void __launch_bounds__(NT, 2) mk_fwd(Args a) {
    extern __shared__ __attribute__((aligned(16))) unsigned char lds_raw[];
    LAS unsigned char* lds = (LAS unsigned char*)lds_raw;
#define TID ((int)threadIdx.x)
#define LANE ((int)(threadIdx.x & 63))
#define WAVE (__builtin_amdgcn_readfirstlane((int)(threadIdx.x >> 6)))
#define GW ((int)blockIdx.x * NWV + WAVE)
    const int G = gridDim.x, ngw = G * NWV;
    volatile LAS unsigned* ctlw = (volatile LAS unsigned*)(lds + LDS_CTL);
    if (TID < 4) ctlw[TID] = 0u;
    __syncthreads();
    XcdBarrier bar = xcd_barrier_post((unsigned*)(a.ws + WS_CTL), ctlw);
    const int lo = a.ph_lo, hi = a.ph_hi;
#define IN(k) (lo <= (k) && (k) < hi)
#define SEAM(k) do { if (IN(k) && IN((k) + 1)) xcd_barrier(bar); } while (0)
    unsigned char* ws = a.ws;
    bf16_t* H = (bf16_t*)(ws + WS_H); bf16_t* PROJ = (bf16_t*)(ws + WS_PROJ); float* SMALL = (float*)(ws + WS_SMALL); bf16_t* BR = (bf16_t*)(ws + WS_BR);
    bf16_t* MERGED = (bf16_t*)(ws + WS_MERGED); float* MACC = (float*)(ws + WS_MACC); bf16_t* ZB = (bf16_t*)(ws + WS_ZB); bf16_t* HID = PROJ;
    const float* MOD = (const float*)(ws + WS_MOD); float* X = a.out;
    if (PHM(0) && IN(0)) { prologue_convert(a, lds, GW, ngw, WAVE, LANE); __syncthreads(); prologue_ada(a, lds, TID); }
    SEAM(0);
    for (int l = 0; l < DEPTH; ++l) {
        const int pb = 1 + l * NPH;
        const float* xp = l == 0 ? a.in[0] : X; const float* xs = l == 0 ? a.in[1] : X + (size_t)MP * D;
        const float* modl = MOD + (size_t)l * 5 * 6 * D;
        const bf16_t* wl = (const bf16_t*)(ws + WS_W) + (size_t)l * W_LAYER;
        if (PHM(1) && IN(pb + 0)) norm_phase(xp, xs, a.in[14] + l * D, modl, 0, D, H, GW, ngw, LANE);
        SEAM(pb + 0);
        if (PHM(2) && IN(pb + 1)) { Gemm g{H, wl + W_IN, M, NIN, D, D, 1, 0, 0}; StaticOrder S; S.init(M, NIN, G, blockIdx.x);
            EpiIn E{PROJ, SMALL, a.out, a.in[17] + l * 64, a.in[18] + l * 64, l}; gemm_phase(lds, g, S, E); }
        SEAM(pb + 1);
        if (PHM(3) && IN(pb + 2)) { prep_phase(a, l, lds, GW, ngw, WAVE, LANE); nmix_a(a, l, GW, ngw, LANE); }
        SEAM(pb + 2);
        if (PHM(4) && IN(pb + 3)) { ml_states_phase(a, l, TID, G); nmix_b(a, l, lds, TID, G); }
        SEAM(pb + 3);
        if (PHM(5) && IN(pb + 4)) ml_scan_phase(a, l, TID, G);
        SEAM(pb + 4);
        if (PHM(12) && IN(pb + 5)) { ml_out_phase(a, l, lds, TID, G); nmix_c(a, l, GW, ngw, LANE); }
        SEAM(pb + 5);
        if (PHM(6) && IN(pb + 6)) { Gemm g{ZB, wl + W_GLU, M, 512, 512, 512, 1, 0, 0}; StaticOrder S; S.init(M, 512, G, blockIdx.x);
            EpiGlu E{ZB, a.in[29] + l * 512, BR}; gemm_phase(lds, g, S, E); }
        SEAM(pb + 6);
        if (PHM(7) && IN(pb + 7)) { Gemm g{BR, wl + W_BR, M, D, 512, D, 4, 512, (size_t)D * 512}; StaticOrder S; S.init(M, D, G, blockIdx.x, 4);
            EpiBranch E{PROJ, MACC, MERGED}; gemm_phase(lds, g, S, E); }
        SEAM(pb + 7);
        if (PHM(8) && IN(pb + 8)) { Gemm g{MERGED, wl + W_OUT, M, D, D, D, 1, 0, 0}; StaticOrder S; S.init(M, D, G, blockIdx.x);
            EpiResid E{xp, xs, modl, 2 * D, X}; gemm_phase(lds, g, S, E); }
        SEAM(pb + 8);
        if (PHM(9) && IN(pb + 9)) norm_phase(X, X + (size_t)MP * D, a.in[15] + l * D, modl, 3 * D, 4 * D, H, GW, ngw, LANE);
        SEAM(pb + 9);
        if (PHM(10) && IN(pb + 10)) { Gemm g{H, wl + W_1, M, DFF, D, D, 1, 0, 0}; StaticOrder S; S.init(M, DFF, G, blockIdx.x);
            EpiRelu2 E{HID, DFF}; gemm_phase(lds, g, S, E); }
        SEAM(pb + 10);
        if (PHM(11) && IN(pb + 11)) { Gemm g{HID, wl + W_2, M, D, DFF, DFF, 1, 0, 0}; StaticOrder S; S.init(M, D, G, blockIdx.x);
            EpiResid E{X, X + (size_t)MP * D, modl, 5 * D, X}; gemm_phase(lds, g, S, E); }
        SEAM(pb + 11);
    }
#undef IN
#undef SEAM
}
}
extern "C" void kernel_launch(void* const* d_in, const int* in_sizes, int n_in, void* d_out, int out_size, void* d_ws, size_t ws_size, hipStream_t stream) {
    static int grid = 0;
    if (grid == 0) {
        int dev = 0, cus = 0; (void)hipGetDevice(&dev); (void)hipDeviceGetAttribute(&cus, hipDeviceAttributeMultiprocessorCount, dev);
        (void)hipFuncSetAttribute((const void*)mk::mk_fwd, hipFuncAttributeMaxDynamicSharedMemorySize, mk::LDS_BYTES);
        int per_cu = 0; (void)hipOccupancyMaxActiveBlocksPerMultiprocessor(&per_cu, (const void*)mk::mk_fwd, mk::NT, mk::LDS_BYTES); (void)hipGetLastError();
        grid = cus > 0 ? cus : 256;
    }
    mk::Args a{}; for (int i = 0; i < 43; ++i) a.in[i] = (const float*)d_in[i];
    a.out = (float*)d_out; a.ws = (unsigned char*)d_ws; a.ph_lo = 0; a.ph_hi = mk::PH_TOTAL;
    (void)hipMemsetAsync(a.ws + mk::WS_CTL, 0, mk::CTL_BYTES, stream);
    hipLaunchKernelGGL(mk::mk_fwd, dim3(grid), dim3(mk::NT), mk::LDS_BYTES, stream, a);
}
```

```cpp
#define SAFE_GEMM 0
#include <hip/hip_runtime.h>
#include <math.h>
namespace mk {
#define LAS __attribute__((address_space(3)))
typedef unsigned short bf16_t;
typedef short bf16x8 __attribute__((ext_vector_type(8)));
typedef float f32x4 __attribute__((ext_vector_type(4)));
typedef float f32x2 __attribute__((ext_vector_type(2)));
typedef unsigned u32x4 __attribute__((ext_vector_type(4)));
typedef unsigned u32x2 __attribute__((ext_vector_type(2)));
constexpr int NT = 512, NWV = 8;
constexpr int D = 2048, MP = 4096, MLAT = 8192, M = MP + MLAT, DEPTH = 4, DFF = 8192;
constexpr int PJ = 13824;
constexpr int NIN = 14080;
constexpr int P_Q = 0, P_K = 512, P_V = 1024, P_S5U = 1536, P_Z = 2048, P_XBC = 2560, P_MQ = 3584, P_MK = 4096, P_MV = 4608, P_MO = 5120, P_GATE = 5632;
constexpr int S_DT = 0, S_MI = 16, S_MF = 24;

typedef __bf16 bf16x2_t __attribute__((ext_vector_type(2)));
__device__ __forceinline__ unsigned pk2(float lo, float hi) { f32x2 v = {lo, hi}; bf16x2_t b = __builtin_convertvector(v, bf16x2_t); return __builtin_bit_cast(unsigned, b); }
__device__ __forceinline__ float bf2f(bf16_t v) { return __uint_as_float(((unsigned)v) << 16); }
__device__ __forceinline__ float bflo(unsigned w) { return __uint_as_float(w << 16); }
__device__ __forceinline__ float bfhi(unsigned w) { return __uint_as_float(w & 0xffff0000u); }
__device__ __forceinline__ bf16_t f2bf(float f) { return (bf16_t)(pk2(f, 0.f) & 0xffffu); }
__device__ __forceinline__ float fsigm(float x) { return __builtin_amdgcn_rcpf(1.f + __expf(-x)); }
__device__ __forceinline__ float fsilu(float x) { return x * fsigm(x); }
__device__ __forceinline__ int row_cvec(int row) { return row < MP ? 0 : 1 + (row - MP) / 2048; }

#define XB_TMO      128
#define XB_XCNT(j)  (256  + 64 * (j))
#define XB_XSUB(j)  (1280 + 64 * (j))
#define XB_XGEN(j)  (2304 + 64 * (j))
#define XB_TOP      3328
#define XB_TOPGEN   3392
#define XCD_BAR_WORDS 3456
#define XB_SPIN_CAP (1u << 18)
__device__ __forceinline__ unsigned xb_ld(unsigned* p)              { return __hip_atomic_load(p, __ATOMIC_RELAXED, __HIP_MEMORY_SCOPE_AGENT); }
__device__ __forceinline__ unsigned xb_add(unsigned* p, unsigned v) { return __hip_atomic_fetch_add(p, v, __ATOMIC_RELAXED, __HIP_MEMORY_SCOPE_AGENT); }
__device__ __forceinline__ unsigned xb_xcc_id() { return (unsigned)__builtin_amdgcn_s_getreg((3 << 11) | 20) & 0xFu; }
#define XB_SPIN(cond, bar) do { unsigned _sp = 0; while (cond) { __builtin_amdgcn_s_sleep(1); \
    if ((++_sp & 255u) == 0u) { if (xb_ld(&(bar)[XB_TMO])) break; if (_sp > XB_SPIN_CAP) { atomicAdd(&(bar)[XB_TMO], 1u); break; } } } } while (0)
struct XcdBarrier { unsigned* bar; unsigned x; volatile LAS unsigned* st; };
__device__ __forceinline__ XcdBarrier xcd_barrier_post(unsigned* bar, volatile LAS unsigned* st) {
    XcdBarrier b; b.bar = bar; b.x = xb_xcc_id(); b.st = st;
    if (threadIdx.x == 0) (void)xb_add(&bar[XB_XCNT(b.x)], 1u);
    return b;
}
__device__ __forceinline__ void xcd_barrier_complete(unsigned* bar, unsigned x, unsigned& nloc, unsigned& nx) {
    const unsigned G = gridDim.x * gridDim.y * gridDim.z;
    unsigned sum, cnt, mine, sp = 0u;
    for (;;) {
        sum = 0u; cnt = 0u; mine = 0u;
#pragma unroll
        for (unsigned j = 0; j < 16; ++j) { const unsigned c = xb_ld(&bar[XB_XCNT(j)]); sum += c; cnt += (c > 0u) ? 1u : 0u; mine = (j == x) ? c : mine; }
        if (sum == G) break;
        __builtin_amdgcn_s_sleep(1);
        if ((++sp & 255u) == 0u) { if (xb_ld(&bar[XB_TMO])) break; if (sp > XB_SPIN_CAP) { atomicAdd(&bar[XB_TMO], 1u); break; } }
    }
    nloc = mine > 0u ? mine : 1u; nx = cnt > 0u ? cnt : 1u;
}
__device__ __forceinline__ void xcd_barrier(const XcdBarrier& b) {
    asm volatile("s_waitcnt vmcnt(0)" ::: "memory");
    __syncthreads();
    if (threadIdx.x == 0) {
        unsigned* bar = b.bar;
        __builtin_amdgcn_s_waitcnt(0);
        unsigned nloc = b.st[0], nx = b.st[1];
        if (nloc == 0u) { xcd_barrier_complete(bar, b.x, nloc, nx); b.st[0] = nloc; b.st[1] = nx; }
        const unsigned old = xb_add(&bar[XB_XSUB(b.x)], 1u);
        const unsigned gen = old / nloc;
        if (old + 1u == (gen + 1u) * nloc) {
            __builtin_amdgcn_fence(__ATOMIC_RELEASE, "agent");
            asm volatile("s_waitcnt vmcnt(0)" ::: "memory");
            const unsigned og = xb_add(&bar[XB_TOP], 1u);
            const unsigned tg = og / nx;
            if (og + 1u == (tg + 1u) * nx) xb_add(&bar[XB_TOPGEN], 1u);
            else XB_SPIN(xb_ld(&bar[XB_TOPGEN]) == tg, bar);
            __builtin_amdgcn_fence(__ATOMIC_ACQUIRE, "agent");
            xb_add(&bar[XB_XGEN(b.x)], 1u);
            asm volatile("s_waitcnt vmcnt(0)" ::: "memory");
        } else {
            XB_SPIN(xb_ld(&bar[XB_XGEN(b.x)]) == gen, bar);
            __builtin_amdgcn_fence(__ATOMIC_ACQUIRE, "agent");
            asm volatile("s_waitcnt vmcnt(0)" ::: "memory");
        }
    }
    __syncthreads();
}

constexpr int BM = 256, BK = 64, HALF = 128, HTB = HALF * BK * 2, STAGE_BYTES = 8 * HTB, NXCD = 8, WGM = 8;
__host__ __device__ __forceinline__ int lds_byte(int r, int c) { const int st = (r >> 4) * 2 + (c >> 5), rr = r & 15, cc = c & 31, ob = rr * 64 + cc * 2; return st * 1024 + (ob ^ (((ob >> 9) & 1) << 5)); }
__host__ __device__ __forceinline__ void stage_rc(int b, int& R, int& C) { const int st = b / 1024, sb = b % 1024, swz = sb ^ (((sb >> 9) & 1) << 5); R = (st >> 1) * 16 + swz / 64; C = (st & 1) * 32 + (swz % 64) / 2; }
__host__ __device__ __forceinline__ int perm32(int rho) { const int n = rho >> 4, i = rho & 15; return 8 * (i >> 2) + 4 * n + (i & 3); }

struct Unit { int pm, pn, kz; };
struct Gemm { const bf16_t* A; const bf16_t* Bt; int M, N, K, lda, nkz; size_t a_kz, b_kz; };

struct StaticOrder {
    int nM, nN, nwg, G, c, nkz;
    __device__ void init(int M_, int N_, int G_, int c_, int nkz_ = 1) { nM = M_ / BM; nN = N_ / BM; nwg = nM * nN; G = G_; c = c_; nkz = nkz_; }
    __device__ bool next(int i, Unit& u) const {
        const int it = i / nkz; u.kz = i - it * nkz;
        const long L = (long)it * G + c; if (L >= nwg) return false;
        int wgid = (int)L; { const int q = nwg / NXCD, r = nwg % NXCD, xcd = wgid % NXCD, off = wgid / NXCD; wgid = (xcd < r ? xcd * (q + 1) : r * (q + 1) + (xcd - r) * q) + off; }
        const int nig = WGM * nN, gid = wgid / nig, fm = gid * WGM, gsz = (nM - fm) < WGM ? (nM - fm) : WGM;
        u.pm = fm + ((wgid % nig) % gsz); u.pn = (wgid % nig) / gsz; return true;
    }
};

template <class Epi>
__device__ __forceinline__ void gemm_phase(LAS unsigned char* lds, const Gemm g, const StaticOrder& S, const Epi& E) {
    int tid_ = threadIdx.x; asm volatile("" : "+v"(tid_));
    const int tid = tid_, wid = __builtin_amdgcn_readfirstlane(tid >> 6), lane = tid & 63, wr = wid >> 2, wc = wid & 3, fr = lane & 15, fq = lane >> 4;
    const int K = g.K, nt = K / BK;
    unsigned voffA[2], voffB[2];
#pragma unroll
    for (int i = 0; i < 2; ++i) { int R, C; stage_rc(tid * 16 + i * 8192, R, C); const int Rb = Epi::PERM ? ((R & ~31) + perm32(R & 31)) : R;
        voffA[i] = (unsigned)(R * g.lda + C) * 2u; voffB[i] = (unsigned)(Rb * K + C) * 2u; }
    const size_t kstep = (size_t)(BK * 2);
    const size_t hstepA = (size_t)HALF * g.lda * 2, hstepB = (size_t)HALF * K * 2;
    const size_t tstepA = 2 * hstepA, tstepB = 2 * hstepB;
    const unsigned ldsw = (unsigned)wid * 1024u;
    const int aoff = lds_byte(wr * 64 + fr, fq * 8), boff = lds_byte(wc * 32 + fr, fq * 8);
#define PG8_SA(b, h) (((b) * 2 + (h)) * HTB)
#define PG8_SB(b, h) ((4 + (b) * 2 + (h)) * HTB)
#define PG8_STAGE(bufoff, gbase, voff) do { _Pragma("unroll") for (int _i = 0; _i < 2; ++_i) \
        __builtin_amdgcn_global_load_lds((const unsigned*)((const char*)(gbase) + (voff)[_i]), (LAS unsigned*)(lds + (bufoff) + ldsw + _i * 8192), 16, 0, 0); } while (0)
#define PG8_LDA(dst, b, h) do { _Pragma("unroll") for (int m = 0; m < 4; ++m) _Pragma("unroll") for (int k = 0; k < 2; ++k) dst[m][k] = *(const LAS bf16x8*)(lds + PG8_SA(b, h) + aoff + m * 2048 + k * 1024); } while (0)
#define PG8_LDB(dst, b, h) do { _Pragma("unroll") for (int n = 0; n < 2; ++n) _Pragma("unroll") for (int k = 0; k < 2; ++k) dst[n][k] = *(const LAS bf16x8*)(lds + PG8_SB(b, h) + boff + n * 2048 + k * 1024); } while (0)
#define PG8_MMA(ai, bj, At, Bt) do { __builtin_amdgcn_s_setprio(1); _Pragma("unroll") for (int m = 0; m < 4; ++m) _Pragma("unroll") for (int n = 0; n < 2; ++n) _Pragma("unroll") for (int k = 0; k < 2; ++k) \
        acc[ai][bj][m][n] = __builtin_amdgcn_mfma_f32_16x16x32_bf16(Bt[n][k], At[m][k], acc[ai][bj][m][n], 0, 0, 0); __builtin_amdgcn_s_setprio(0); } while (0)
#if SAFE_GEMM == 1 || SAFE_GEMM == 3
#define PG8_WAIT_V(n) asm volatile("s_waitcnt vmcnt(0)" ::: "memory")
#else
#define PG8_WAIT_V(n) asm volatile("s_waitcnt vmcnt(" #n ")" ::: "memory")
#endif
#define PG8_WAIT_L(n) asm volatile("s_waitcnt lgkmcnt(" #n ")" ::: "memory")
#if SAFE_GEMM == 1
#define PG8_BAR do { asm volatile("s_waitcnt vmcnt(0) lgkmcnt(0)" ::: "memory"); __builtin_amdgcn_s_barrier(); asm volatile("" ::: "memory"); } while (0)
#elif SAFE_GEMM == 2
#define PG8_BAR asm volatile("s_barrier" ::: "memory")
#elif SAFE_GEMM == 4
#define PG8_BAR do { asm volatile("s_waitcnt lgkmcnt(0)" ::: "memory"); __builtin_amdgcn_s_barrier(); } while (0)
#else
#define PG8_BAR __builtin_amdgcn_s_barrier()
#endif
#define PG8_SCHED __builtin_amdgcn_sched_barrier(0)
    Unit cur, nxt; int ui = 0;
    if (!S.next(0, cur)) return;
    f32x4 acc[2][2][4][2];
#pragma unroll
    for (int a = 0; a < 2; ++a)
#pragma unroll
        for (int b = 0; b < 2; ++b)
#pragma unroll
            for (int m = 0; m < 4; ++m)
#pragma unroll
                for (int n = 0; n < 2; ++n) acc[a][b][m][n] = (f32x4){0.f, 0.f, 0.f, 0.f};
    bf16x8 At[4][2], B0[2][2], B1[2][2];
    const char* cA = (const char*)(g.A + (size_t)cur.kz * g.a_kz) + (size_t)cur.pm * tstepA; const char* cB = (const char*)(g.Bt + (size_t)cur.kz * g.b_kz) + (size_t)cur.pn * tstepB;
    PG8_STAGE(PG8_SB(0, 0), cB, voffB); PG8_STAGE(PG8_SA(0, 0), cA, voffA); PG8_STAGE(PG8_SB(0, 1), cB + hstepB, voffB); PG8_STAGE(PG8_SA(0, 1), cA + hstepA, voffA);
    if (wr == 1) PG8_BAR;
    PG8_WAIT_V(4); PG8_BAR;
    PG8_STAGE(PG8_SB(1, 0), cB + kstep, voffB); PG8_STAGE(PG8_SA(1, 0), cA + kstep, voffA); PG8_STAGE(PG8_SB(1, 1), cB + hstepB + kstep, voffB);
    PG8_WAIT_V(6); PG8_BAR;
    for (;;) {
        const bool has_next = S.next(ui + 1, nxt);
        const char* nA = has_next ? (const char*)(g.A + (size_t)nxt.kz * g.a_kz) + (size_t)nxt.pm * tstepA : cA;
        const char* nB = has_next ? (const char*)(g.Bt + (size_t)nxt.kz * g.b_kz) + (size_t)nxt.pn * tstepB : cB;
        for (int t = 0; t < nt; t += 2) {
            const bool last = (t == nt - 2);
            const char* a1 = cA + (size_t)(t + 1) * kstep;
            const char* a2 = last ? nA : cA + (size_t)(t + 2) * kstep; const char* b2 = last ? nB : cB + (size_t)(t + 2) * kstep;
            const char* a3 = a2 + kstep; const char* b3 = b2 + kstep;
            PG8_LDB(B0, 0, 0); PG8_SCHED; PG8_LDA(At, 0, 0); PG8_STAGE(PG8_SA(1, 1), a1 + hstepA, voffA);
            PG8_WAIT_L(8); PG8_BAR; PG8_WAIT_L(0); PG8_MMA(0, 0, At, B0); PG8_BAR; PG8_SCHED;
            PG8_LDB(B1, 0, 1); PG8_STAGE(PG8_SB(0, 0), b2, voffB);
            PG8_BAR; PG8_WAIT_L(0); PG8_MMA(0, 1, At, B1); PG8_BAR;
            PG8_LDA(At, 0, 1); PG8_STAGE(PG8_SA(0, 0), a2, voffA);
            PG8_BAR; PG8_WAIT_L(0); PG8_MMA(1, 0, At, B0); PG8_BAR; PG8_SCHED;
            PG8_STAGE(PG8_SB(0, 1), b2 + hstepB, voffB);
            PG8_WAIT_V(6); PG8_BAR; PG8_MMA(1, 1, At, B1); PG8_BAR;
            PG8_LDB(B0, 1, 0); PG8_SCHED; PG8_LDA(At, 1, 0); PG8_STAGE(PG8_SA(0, 1), a2 + hstepA, voffA);
            PG8_WAIT_L(8); PG8_BAR; PG8_WAIT_L(0); PG8_MMA(0, 0, At, B0); PG8_BAR; PG8_SCHED;
            PG8_LDB(B1, 1, 1); PG8_STAGE(PG8_SB(1, 0), b3, voffB);
            PG8_BAR; PG8_WAIT_L(0); PG8_MMA(0, 1, At, B1); PG8_BAR;
            PG8_LDA(At, 1, 1); PG8_STAGE(PG8_SA(1, 0), a3, voffA);
            PG8_BAR; PG8_WAIT_L(0); PG8_MMA(1, 0, At, B0); PG8_BAR; PG8_SCHED;
            PG8_STAGE(PG8_SB(1, 1), b3 + hstepB, voffB);
            PG8_WAIT_V(6); PG8_BAR; PG8_MMA(1, 1, At, B1); PG8_BAR;
        }
        E(acc, cur, wr, wc, fr, fq);
        asm volatile("s_waitcnt vmcnt(0)" ::: "memory");
        if (!has_next) break;
#pragma unroll
        for (int a = 0; a < 2; ++a)
#pragma unroll
            for (int b = 0; b < 2; ++b)
#pragma unroll
                for (int m = 0; m < 4; ++m)
#pragma unroll
                    for (int n = 0; n < 2; ++n) acc[a][b][m][n] = (f32x4){0.f, 0.f, 0.f, 0.f};
        cur = nxt; cA = nA; cB = nB; ++ui;
    }
    PG8_WAIT_V(0);
    if (wr == 0) PG8_BAR;
    PG8_BAR;
#undef PG8_SA
#undef PG8_SB
#undef PG8_STAGE
#undef PG8_LDA
#undef PG8_LDB
#undef PG8_MMA
#undef PG8_WAIT_V
#undef PG8_WAIT_L
#undef PG8_BAR
#undef PG8_SCHED
}
}
namespace mk {
constexpr size_t O_YP = 0, O_YS = 8388608, O_NK = 25165824, O_NV = 33554432, O_S5R = 41943040, O_S5I = 42205184, O_SSD = 42467328,
                 O_MLC = 50855936, O_MLN = 59244544, O_MLM = 59310080;

__device__ __forceinline__ u32x4 pack8(const f32x4 a, const f32x4 b) { u32x4 w; w.x = pk2(a[0], a[1]); w.y = pk2(a[2], a[3]); w.z = pk2(b[0], b[1]); w.w = pk2(b[2], b[3]); return w; }

struct EpiIn {
    static constexpr bool PERM = true;
    bf16_t* proj; float* small; float* out; const float* qg; const float* kg; int layer;
    __device__ __forceinline__ void operator()(const f32x4 (&acc)[2][2][4][2], const Unit& u, int wr, int wc, int fr, int fq) const {
        const int T = u.pn, rowb = u.pm * BM + wr * 64 + fr;
        if (T == 54) {
            if (wc == 0) {
#pragma unroll
                for (int ai = 0; ai < 2; ++ai)
#pragma unroll
                    for (int m = 0; m < 4; ++m) { float* sp = small + (size_t)(rowb + ai * HALF + m * 16) * 32 + 8 * fq; *(f32x4*)sp = acc[ai][0][m][0]; *(f32x4*)(sp + 4) = acc[ai][0][m][1]; }
            }
            return;
        }
        const int colb = T * 256 + 64 * wc + 8 * fq;
        if (T < 4) {
            const float* g = T < 2 ? qg : kg;
            f32x4 gv[2][2];
#pragma unroll
            for (int bj = 0; bj < 2; ++bj)
#pragma unroll
                for (int n = 0; n < 2; ++n) gv[bj][n] = *(const f32x4*)(g + 32 * bj + 8 * fq + 4 * n);
#pragma unroll
            for (int ai = 0; ai < 2; ++ai)
#pragma unroll
                for (int m = 0; m < 4; ++m) {
                    float ss = 0.f;
#pragma unroll
                    for (int bj = 0; bj < 2; ++bj)
#pragma unroll
                        for (int n = 0; n < 2; ++n) { const f32x4 x = acc[ai][bj][m][n]; ss += (x[0] * x[0] + x[1] * x[1]) + (x[2] * x[2] + x[3] * x[3]); }
                    ss += __shfl_xor(ss, 16); ss += __shfl_xor(ss, 32);
                    const float r = rsqrtf(ss * (1.f / 64.f) + 1e-6f);
                    const int row = rowb + ai * HALF + m * 16;
#pragma unroll
                    for (int bj = 0; bj < 2; ++bj) { const f32x4 v0 = acc[ai][bj][m][0] * r * gv[bj][0], v1 = acc[ai][bj][m][1] * r * gv[bj][1];
                        *(u32x4*)(proj + (size_t)row * PJ + colb + 32 * bj) = pack8(v0, v1);
                        if (T >= 2 && row < MP) { float* o = out + O_NK + ((size_t)((row >> 8) * DEPTH + layer) * 256 + (row & 255)) * 512 + (colb - 512) + 32 * bj; *(f32x4*)o = v0; *(f32x4*)(o + 4) = v1; } }
                }
        } else if (T < 6) {
#pragma unroll
            for (int ai = 0; ai < 2; ++ai)
#pragma unroll
                for (int m = 0; m < 4; ++m) { const int row = rowb + ai * HALF + m * 16;
#pragma unroll
                    for (int bj = 0; bj < 2; ++bj) { const f32x4 v0 = acc[ai][bj][m][0], v1 = acc[ai][bj][m][1];
                        *(u32x4*)(proj + (size_t)row * PJ + colb + 32 * bj) = pack8(v0, v1);
                        if (row < MP) { float* o = out + O_NV + ((size_t)((row >> 8) * DEPTH + layer) * 256 + (row & 255)) * 512 + (colb - 1024) + 32 * bj; *(f32x4*)o = v0; *(f32x4*)(o + 4) = v1; } } }
        } else if (T < 22) {
#pragma unroll
            for (int ai = 0; ai < 2; ++ai)
#pragma unroll
                for (int m = 0; m < 4; ++m) { const int row = rowb + ai * HALF + m * 16;
#pragma unroll
                    for (int bj = 0; bj < 2; ++bj) *(u32x4*)(proj + (size_t)row * PJ + colb + 32 * bj) = pack8(acc[ai][bj][m][0], acc[ai][bj][m][1]); }
        } else {
#pragma unroll
            for (int ai = 0; ai < 2; ++ai)
#pragma unroll
                for (int m = 0; m < 4; ++m) { const int row = rowb + ai * HALF + m * 16;
#pragma unroll
                    for (int bj = 0; bj < 2; ++bj) { f32x4 v0 = acc[ai][bj][m][0], v1 = acc[ai][bj][m][1];
#pragma unroll
                        for (int j = 0; j < 4; ++j) { v0[j] = fsigm(v0[j]); v1[j] = fsigm(v1[j]); }
                        *(u32x4*)(proj + (size_t)row * PJ + colb + 32 * bj) = pack8(v0, v1); } }
        }
    }
};
struct EpiRelu2 {
    static constexpr bool PERM = true;
    bf16_t* O; int ldo;
    __device__ __forceinline__ void operator()(const f32x4 (&acc)[2][2][4][2], const Unit& u, int wr, int wc, int fr, int fq) const {
        const int rowb = u.pm * BM + wr * 64 + fr, colb = u.pn * 256 + 64 * wc + 8 * fq;
#pragma unroll
        for (int ai = 0; ai < 2; ++ai)
#pragma unroll
            for (int m = 0; m < 4; ++m) { const int row = rowb + ai * HALF + m * 16;
#pragma unroll
                for (int bj = 0; bj < 2; ++bj) { f32x4 v0 = acc[ai][bj][m][0], v1 = acc[ai][bj][m][1];
#pragma unroll
                    for (int j = 0; j < 4; ++j) { const float a = fmaxf(v0[j], 0.f), b = fmaxf(v1[j], 0.f); v0[j] = a * a; v1[j] = b * b; }
                    *(u32x4*)(O + (size_t)row * ldo + colb + 32 * bj) = pack8(v0, v1); } }
    }
};
struct EpiGlu {
    static constexpr bool PERM = true;
    const bf16_t* Z; const float* bias; bf16_t* br;
    __device__ __forceinline__ void operator()(const f32x4 (&acc)[2][2][4][2], const Unit& u, int wr, int wc, int fr, int fq) const {
        const int rowb = u.pm * BM + wr * 64 + fr, colb = u.pn * 256 + 64 * wc + 8 * fq;
#pragma unroll
        for (int bj = 0; bj < 2; ++bj) { const int c = colb + 32 * bj; const f32x4 b0 = *(const f32x4*)(bias + c), b1 = *(const f32x4*)(bias + c + 4);
#pragma unroll
            for (int ai = 0; ai < 2; ++ai)
#pragma unroll
                for (int m = 0; m < 4; ++m) { const int row = rowb + ai * HALF + m * 16;
                    const u32x4 zz = *(const u32x4*)(Z + (size_t)row * 512 + c);
                    f32x4 v0 = acc[ai][bj][m][0] + b0, v1 = acc[ai][bj][m][1] + b1;
                    v0[0] = bflo(zz.x) * fsigm(v0[0]); v0[1] = bfhi(zz.x) * fsigm(v0[1]); v0[2] = bflo(zz.y) * fsigm(v0[2]); v0[3] = bfhi(zz.y) * fsigm(v0[3]);
                    v1[0] = bflo(zz.z) * fsigm(v1[0]); v1[1] = bfhi(zz.z) * fsigm(v1[1]); v1[2] = bflo(zz.w) * fsigm(v1[2]); v1[3] = bfhi(zz.w) * fsigm(v1[3]);
                    *(u32x4*)(br + (size_t)row * D + 512 + c) = pack8(v0, v1); } }
    }
};
struct EpiBranch {
    static constexpr bool PERM = true;
    const bf16_t* proj; float* macc; bf16_t* merged;
    __device__ __forceinline__ void operator()(const f32x4 (&acc)[2][2][4][2], const Unit& u, int wr, int wc, int fr, int fq) const {
        const int rowb = u.pm * BM + wr * 64 + fr, colb = u.pn * 256 + 64 * wc + 8 * fq, kz = u.kz;
#pragma unroll
        for (int ai = 0; ai < 2; ++ai)
#pragma unroll
            for (int m = 0; m < 4; ++m) { const int row = rowb + ai * HALF + m * 16;
#pragma unroll
                for (int bj = 0; bj < 2; ++bj) { const int c = colb + 32 * bj;
                    const u32x4 gg = *(const u32x4*)(proj + (size_t)row * PJ + P_GATE + kz * D + c);
                    f32x4 v0 = acc[ai][bj][m][0], v1 = acc[ai][bj][m][1];
                    v0[0] *= bflo(gg.x); v0[1] *= bfhi(gg.x); v0[2] *= bflo(gg.y); v0[3] *= bfhi(gg.y); v1[0] *= bflo(gg.z); v1[1] *= bfhi(gg.z); v1[2] *= bflo(gg.w); v1[3] *= bfhi(gg.w);
                    float* mp = macc + (size_t)row * D + c;
                    if (kz > 0) { v0 += *(const f32x4*)mp; v1 += *(const f32x4*)(mp + 4); }
                    if (kz < 3) { *(f32x4*)mp = v0; *(f32x4*)(mp + 4) = v1; }
                    else *(u32x4*)(merged + (size_t)row * D + c) = pack8(v0, v1); } }
    }
};
struct EpiResid {
    static constexpr bool PERM = false;
    const float* xp; const float* xs; const float* modl; int g_off; float* xout;
    __device__ __forceinline__ void operator()(const f32x4 (&acc)[2][2][4][2], const Unit& u, int wr, int wc, int fr, int fq) const {
        const int row0 = u.pm * BM, rowb = row0 + wr * 64 + fr, colb = u.pn * 256 + wc * 32 + 4 * fq;
        const float* xin = row0 < MP ? xp : xs - (size_t)MP * D;
        const float* gate = modl + (size_t)row_cvec(row0) * 6 * D + g_off;
        f32x4 gv[2][2];
#pragma unroll
        for (int bj = 0; bj < 2; ++bj)
#pragma unroll
            for (int n = 0; n < 2; ++n) gv[bj][n] = *(const f32x4*)(gate + colb + bj * HALF + n * 16);
#pragma unroll
        for (int ai = 0; ai < 2; ++ai)
#pragma unroll
            for (int m = 0; m < 4; ++m) { const size_t ro = (size_t)(rowb + ai * HALF + m * 16) * D + colb;
#pragma unroll
                for (int bj = 0; bj < 2; ++bj)
#pragma unroll
                    for (int n = 0; n < 2; ++n) { const size_t o = ro + bj * HALF + n * 16; *(f32x4*)(xout + o) = *(const f32x4*)(xin + o) + gv[bj][n] * acc[ai][bj][m][n]; } }
    }
};
}
namespace mk {
constexpr size_t AL(size_t x) { return (x + 255) & ~(size_t)255; }
constexpr size_t WS_CTL = 0, CTL_BYTES = 65536;
constexpr size_t WS_MOD = WS_CTL + CTL_BYTES;
constexpr size_t WS_W = AL(WS_MOD + (size_t)DEPTH * 5 * 6 * D * 4);
constexpr size_t W_IN = 0, W_GLU = W_IN + (size_t)NIN * D, W_BR = W_GLU + 512 * 512, W_OUT = W_BR + (size_t)4 * D * 512, W_1 = W_OUT + (size_t)D * D, W_2 = W_1 + (size_t)DFF * D,
                 W_LAYER = W_2 + (size_t)D * DFF;
constexpr size_t WS_H = AL(WS_W + W_LAYER * 2 * DEPTH);
constexpr size_t WS_PROJ = AL(WS_H + (size_t)M * D * 2);
constexpr size_t WS_SMALL = AL(WS_PROJ + (size_t)M * PJ * 2);
constexpr size_t WS_BR = AL(WS_SMALL + (size_t)M * 32 * 4);
constexpr size_t WS_MERGED = AL(WS_BR + (size_t)M * D * 2);
constexpr size_t WS_MACC = AL(WS_MERGED + (size_t)M * D * 2);
constexpr size_t WS_ZB = AL(WS_MACC + (size_t)M * D * 4);
constexpr size_t WS_SCR = AL(WS_ZB + (size_t)M * 512 * 2);
constexpr int LDS_BYTES = 140 * 1024, LDS_CTL = LDS_BYTES - 256;

struct Args { const float* in[43]; float* out; unsigned char* ws; int ph_lo, ph_hi; };

__device__ __forceinline__ float wave_sum(float v) {
#pragma unroll
    for (int o = 1; o < 64; o <<= 1) v += __shfl_xor(v, o);
    return v;
}
#define LDS_WAIT() asm volatile("s_waitcnt lgkmcnt(0)" ::: "memory")

__device__ __forceinline__ void xpose_item(const float* W, int ldw, int k0, int sc, bf16_t* dst, int K, LAS float* scr, int lane, int mode) {
    const int j = lane & 31;
    const int col = mode == 1 ? (j < 16 ? 3584 + j : 5648 + (j - 16)) : sc + j;
#pragma unroll 8
    for (int i = 0; i < 32; ++i) { const int kk = 2 * i + (lane >> 5); scr[kk * 33 + j] = mode == 2 ? 0.f : W[(size_t)(k0 + kk) * ldw + col]; }
    LDS_WAIT(); asm volatile("" ::: "memory");
    const int c = lane & 7;
#pragma unroll
    for (int jj = 0; jj < 4; ++jj) { const int n = (lane >> 3) + 8 * jj; const LAS float* s = scr + (8 * c) * 33 + n;
        u32x4 o; o.x = pk2(s[0 * 33], s[1 * 33]); o.y = pk2(s[2 * 33], s[3 * 33]); o.z = pk2(s[4 * 33], s[5 * 33]); o.w = pk2(s[6 * 33], s[7 * 33]);
        *(u32x4*)(dst + (size_t)n * K + k0 + 8 * c) = o; }
    LDS_WAIT(); asm volatile("" ::: "memory");
}
__device__ __forceinline__ int hm_col(int grp) { const int T = grp >> 3, q8 = grp & 7; return 256 * T + 32 * (2 * (q8 & 3) + (q8 >> 2)); }

__device__ __forceinline__ void prologue_convert(const Args& a, LAS unsigned char* lds, int gw, int ngw, int wave, int lane) {
    LAS float* scr = (LAS float*)(lds + wave * 8704);
    bf16_t* WB = (bf16_t*)(a.ws + WS_W);
    constexpr int I_IN = 440 * 32, I_GLU = 16 * 8, I_BR = 4 * 64 * 8, I_OUT = 64 * 32, I_1 = 256 * 32, I_2 = 64 * 128, I_L = I_IN + I_GLU + I_BR + I_OUT + I_1 + I_2;
    for (int it = gw; it < I_L * DEPTH; it += ngw) {
        const int l = it / I_L; int r = it - l * I_L; bf16_t* wl = WB + (size_t)l * W_LAYER;
        if (r < I_IN) { const int kb = r / 440, grp = r % 440, T = grp >> 3; int sc = hm_col(grp), mode = 0;
            if (T == 54) mode = (grp & 7) == 0 ? 1 : 2; else if (T >= 22) sc += 32; else if (T >= 14) sc += 16;
            xpose_item(a.in[16] + (size_t)l * D * 13856, 13856, 64 * kb, sc, wl + W_IN + (size_t)(32 * grp) * D, D, scr, lane, mode); continue; } r -= I_IN;
        if (r < I_GLU) { const int kb = r / 16, grp = r % 16; xpose_item(a.in[28] + (size_t)l * 512 * 512, 512, 64 * kb, hm_col(grp), wl + W_GLU + (size_t)(32 * grp) * 512, 512, scr, lane, 0); continue; } r -= I_GLU;
        if (r < I_BR) { const int k = r / 512, r2 = r % 512, kb = r2 / 64, grp = r2 % 64;
            xpose_item(a.in[39] + ((size_t)l * 4 + k) * 512 * D, D, 64 * kb, hm_col(grp), wl + W_BR + (size_t)k * D * 512 + (size_t)(32 * grp) * 512, 512, scr, lane, 0); continue; } r -= I_BR;
        if (r < I_OUT) { const int kb = r / 64, grp = r % 64; xpose_item(a.in[40] + (size_t)l * D * D, D, 64 * kb, 32 * grp, wl + W_OUT + (size_t)(32 * grp) * D, D, scr, lane, 0); continue; } r -= I_OUT;
        if (r < I_1) { const int kb = r / 256, grp = r % 256; xpose_item(a.in[41] + (size_t)l * D * DFF, DFF, 64 * kb, hm_col(grp), wl + W_1 + (size_t)(32 * grp) * D, D, scr, lane, 0); continue; } r -= I_1;
        { const int kb = r / 64, grp = r % 64; xpose_item(a.in[42] + (size_t)l * DFF * D, D, 64 * kb, 32 * grp, wl + W_2 + (size_t)(32 * grp) * DFF, DFF, scr, lane, 0); }
    }
}
__device__ __forceinline__ void prologue_ada(const Args& a, LAS unsigned char* lds, int tid) {
    LAS float* sl = (LAS float*)lds;
    LAS float* red = (LAS float*)(lds + 40960);
    float* mod = (float*)(a.ws + WS_MOD);
    for (int i = tid; i < 5 * D; i += NT) { const int j = i / D, k = i % D; const float x = j == 0 ? a.in[11][k] : a.in[10][(j - 1) * D + k]; sl[i] = x / (1.f + __expf(-x)); }
    __syncthreads();
    const int ks = tid >> 6, c = tid & 63;
    for (int unit = blockIdx.x; unit < DEPTH * 6 * D / 64; unit += gridDim.x) {
        const int l = unit / (6 * D / 64), n0 = (unit % (6 * D / 64)) * 64;
        const float* w = a.in[12] + (size_t)l * D * 6 * D + n0 + c;
        float acc[5] = {0.f, 0.f, 0.f, 0.f, 0.f};
#pragma unroll 4
        for (int k = ks * 256; k < ks * 256 + 256; ++k) { const float wv = w[(size_t)k * 6 * D];
#pragma unroll
            for (int j = 0; j < 5; ++j) acc[j] += sl[j * D + k] * wv; }
#pragma unroll
        for (int j = 0; j < 5; ++j) red[(ks * 5 + j) * 64 + c] = acc[j];
        __syncthreads();
        if (tid < 320) { const int j = tid >> 6; float s = 0.f;
#pragma unroll
            for (int q = 0; q < 8; ++q) s += red[(q * 5 + j) * 64 + c];
            mod[((size_t)l * 5 + j) * 6 * D + n0 + c] = s + a.in[13][l * 6 * D + n0 + c]; }
        __syncthreads();
    }
}
__device__ __forceinline__ void norm_phase(const float* xp, const float* xs, const float* g, const float* modl, int sh_off, int sc_off, bf16_t* H, int gw, int ngw, int lane_) {
    int lane = lane_; asm volatile("" : "+v"(lane));
    for (int row = gw; row < M; row += ngw) {
        const float* x = row < MP ? xp + (size_t)row * D : xs + (size_t)(row - MP) * D;
        f32x4 v[8]; float ss = 0.f;
#pragma unroll
        for (int j = 0; j < 8; ++j) { v[j] = *(const f32x4*)(x + 4 * (lane + 64 * j)); ss += (v[j][0] * v[j][0] + v[j][1] * v[j][1]) + (v[j][2] * v[j][2] + v[j][3] * v[j][3]); }
        const float r = rsqrtf(wave_sum(ss) * (1.f / D) + 1e-6f);
        const float* md = modl + (size_t)row_cvec(row) * 6 * D;
#pragma unroll
        for (int j = 0; j < 8; ++j) { const int i = 4 * (lane + 64 * j);
            const f32x4 gg = *(const f32x4*)(g + i), sc = *(const f32x4*)(md + sc_off + i), sh = *(const f32x4*)(md + sh_off + i);
            const f32x4 o = v[j] * r * gg * (sc + 1.f) + sh;
            u32x2 w; w.x = pk2(o[0], o[1]); w.y = pk2(o[2], o[3]); *(u32x2*)(H + (size_t)row * D + i) = w; }
    }
}

}
namespace mk {
constexpr int C_Q = 0, C_K = 512, C_V = 1024, C_S5U = 1536, C_Z = 2048, C_XBC = 2560, C_DT = 3584, C_MQ = 3600, C_MK = 4112, C_MV = 4624, C_MO = 5136, C_MI = 5648, C_MF = 5656;
constexpr int NSEQ = 20;
struct PJA {
    const bf16_t* p; const float* sm;
    __device__ __forceinline__ float operator()(int row, int col) const {
        if (col < 3584) return bf2f(p[(size_t)row * PJ + col]);
        if (col < 3600) return sm[(size_t)row * 32 + col - 3584];
        if (col < 5648) return bf2f(p[(size_t)row * PJ + col - 16]);
        if (col < 5664) return sm[(size_t)row * 32 + 16 + col - 5648];
        return bf2f(p[(size_t)row * PJ + col - 32]);
    }
};
__device__ __forceinline__ void seq_info(int sq, int& row0, int& L, int& lat, int& b) {
    if (sq < 16) { row0 = sq * 256; L = 256; lat = 0; b = sq; } else { b = sq - 16; row0 = MP + b * 2048; L = 2048; lat = 1; }
}
__device__ __forceinline__ float nsilu(float x) { return x / (1.f + expf(-x)); }
__device__ __forceinline__ float nsigm(float x) { return 1.f / (1.f + expf(-x)); }
__device__ __forceinline__ float nsoftplus(float x) { return x > 20.f ? x : log1pf(expf(x)); }
__device__ __forceinline__ float ngelu(float x) { return 0.5f * x * (1.f + tanhf(0.7978845608028654f * (x + 0.044715f * x * x * x))); }

__device__ __forceinline__ void nv_attn_dense(const PJA& proj, bf16_t* br, int idx) {
    const int hh = idx % 8, row = idx / 8, b = row / 256;
    float q[64], o[64];
#pragma unroll
    for (int i = 0; i < 64; ++i) { q[i] = proj(row, C_Q + hh * 64 + i); o[i] = 0.f; }
    float mx = -1e30f, sum = 0.f;
    for (int s = 0; s < 256; ++s) { const int kr_ = b * 256 + s;
        float sc = 0;
#pragma unroll
        for (int i = 0; i < 64; ++i) sc += q[i] * proj(kr_, C_K + hh * 64 + i);
        sc *= 0.125f;
        const float mn = fmaxf(mx, sc), a = expf(mx - mn), p = expf(sc - mn); sum = sum * a + p;
#pragma unroll
        for (int i = 0; i < 64; ++i) o[i] = o[i] * a + p * proj(kr_, C_V + hh * 64 + i);
        mx = mn; }
#pragma unroll
    for (int i = 0; i < 64; ++i) br[(size_t)row * D + hh * 64 + i] = f2bf(o[i] / sum);
}
__device__ __forceinline__ void nv_attn_na(const PJA& proj, const float* ck, const float* cv, const float* rpb, int layer, bf16_t* br, int idx) {
    const int hh = idx % 8, lt = idx / 8, b = lt / 2048, t = lt % 2048, r = t / 64, c = t % 64;
    const int row = MP + lt; float q[64], o[64];
#pragma unroll
    for (int i = 0; i < 64; ++i) { q[i] = proj(row, C_Q + hh * 64 + i); o[i] = 0.f; }
    const int rs = min(max(r - 4, 0), 32 - 8), cs = min(max(c - 8, 0), 64 - 16);
    float mx = -1e30f, sum = 0.f;
    for (int j = 0; j < 8; ++j) for (int w = 0; w < 16; ++w) { const int kr = rs + j, kc = cs + w; const int krow = MP + b * 2048 + kr * 64 + kc;
        float sc = 0;
#pragma unroll
        for (int i = 0; i < 64; ++i) sc += q[i] * proj(krow, C_K + hh * 64 + i);
        sc = sc * 0.125f + rpb[(hh * 15 + (kr - r + 7)) * 31 + (kc - c + 15)];
        const float mn = fmaxf(mx, sc), a = expf(mx - mn), p = expf(sc - mn); sum = sum * a + p;
#pragma unroll
        for (int i = 0; i < 64; ++i) o[i] = o[i] * a + p * proj(krow, C_V + hh * 64 + i);
        mx = mn; }
    for (int s = 0; s < 512; ++s) { const size_t off = ((((size_t)b * DEPTH + layer) * 512 + s) * 8 + hh) * 64; const float* kp = ck + off; const float* vp = cv + off;
        float sc = 0;
#pragma unroll
        for (int i = 0; i < 64; ++i) sc += q[i] * kp[i];
        sc *= 0.125f;
        const float mn = fmaxf(mx, sc), a = expf(mx - mn), p = expf(sc - mn); sum = sum * a + p;
#pragma unroll
        for (int i = 0; i < 64; ++i) o[i] = o[i] * a + p * vp[i];
        mx = mn; }
#pragma unroll
    for (int i = 0; i < 64; ++i) br[(size_t)row * D + hh * 64 + i] = f2bf(o[i] / sum);
}
__device__ __forceinline__ void nv_s5(const PJA& proj, const Args& a, int layer, float* ys5, float* out, int wid, int n) {
    const int dir = wid % 2, g = (wid / 2) % 32, sq = wid / 64;
    int row0, L, lat, b; seq_info(sq, row0, L, lat, b);
    const float* a_re = a.in[20] + layer * 4096; const float* a_im = a.in[21] + layer * 4096; const float* log_dt = a.in[22] + layer * 64;
    const float* b_re = a.in[23] + (size_t)layer * 65536; const float* b_im = a.in[24] + (size_t)layer * 65536; const float* c_re = a.in[25] + (size_t)layer * 65536; const float* c_im = a.in[26] + (size_t)layer * 65536;
    const int pi = (dir * 32 + g) * 64 + n;
    const float are = fminf(a_re[pi], -1e-4f), aim = a_im[pi], dt = expf(log_dt[dir * 32 + g]);
    const float mag = expf(dt * are), abr = mag * cosf(dt * aim), abi = mag * sinf(dt * aim);
    const float den = are * are + aim * aim, nr = abr - 1.f, cfr = (nr * are + abi * aim) / den, cfi = (abi * are - nr * aim) / den;
    float bbr[16], bbi[16], cr[16], ci[16];
#pragma unroll
    for (int k = 0; k < 16; ++k) { const float br_ = b_re[(size_t)pi * 16 + k], bi_ = b_im[(size_t)pi * 16 + k]; bbr[k] = cfr * br_ - cfi * bi_; bbi[k] = cfr * bi_ + cfi * br_;
        cr[k] = c_re[((size_t)(dir * 32 + g) * 16 + k) * 64 + n]; ci[k] = c_im[((size_t)(dir * 32 + g) * 16 + k) * 64 + n]; }
    float hr = 0.f, hi = 0.f;
    if (lat) { const size_t so = ((((size_t)b * DEPTH + layer) * 2 + dir) * 32 + g) * 64 + n; hr = a.in[4][so]; hi = a.in[5][so]; }
    for (int s = 0; s < L; ++s) { const int t = dir ? L - 1 - s : s;
        float bur = 0, bui = 0;
#pragma unroll
        for (int k = 0; k < 16; ++k) { const float uv = proj(row0 + t, C_S5U + g * 16 + k); bur += uv * bbr[k]; bui += uv * bbi[k]; }
        const float nhr = abr * hr - abi * hi + bur, nhi = abr * hi + abi * hr + bui; hr = nhr; hi = nhi;
        float myy = 0.f;
#pragma unroll
        for (int k = 0; k < 16; ++k) { float v = hr * cr[k] - hi * ci[k];
#pragma unroll
            for (int o = 32; o > 0; o >>= 1) v += __shfl_xor(v, o);
            if (n == k) myy = v; }
        if (n < 16) ys5[((size_t)dir * M + row0 + t) * 512 + g * 16 + n] = myy; }
    if (!lat) { const size_t oo = ((((size_t)b * DEPTH + layer) * 2 + dir) * 32 + g) * 64 + n; out[O_S5R + oo] = hr; out[O_S5I + oo] = hi; }
}
__device__ __forceinline__ void nv_ssd_seq(const PJA& proj, const float* xbc, const Args& a, int layer, float* yssd, float* out, int wid, int p) {
    const int dir = wid % 2, hh = (wid / 2) % 8, sq = wid / 16;
    int row0, L, lat, b; seq_info(sq, row0, L, lat, b);
    float h[128];
    if (lat) { const float* sp = a.in[6] + (((((size_t)b * DEPTH + layer) * 2 + dir) * 8 + hh) * 64 + p) * 128;
#pragma unroll
        for (int n = 0; n < 128; ++n) h[n] = sp[n]; }
    else {
#pragma unroll
        for (int n = 0; n < 128; ++n) h[n] = 0.f; }
    const float A = -expf(a.in[33][layer * 16 + dir * 8 + hh]), dtb = a.in[32][layer * 16 + dir * 8 + hh]; const int grp = hh / 4;
    for (int s = 0; s < L; ++s) { const int t = dir ? L - 1 - s : s; const int row = row0 + t;
        const float dt = nsoftplus(proj(row, C_DT + dir * 8 + hh) + dtb), dec = expf(dt * A);
        const float xd = xbc[(size_t)row * 1024 + hh * 64 + p] * dt;
        const float* Bv = xbc + (size_t)row * 1024 + 512 + grp * 128; const float* Cv = xbc + (size_t)row * 1024 + 768 + grp * 128;
        float y = 0.f;
#pragma unroll
        for (int n = 0; n < 128; ++n) { h[n] = dec * h[n] + Bv[n] * xd; y += Cv[n] * h[n]; }
        yssd[((size_t)dir * M + row) * 512 + hh * 64 + p] = y; }
    if (!lat) { float* op = out + O_SSD + (((((size_t)b * DEPTH + layer) * 2 + dir) * 8 + hh) * 64 + p) * 128;
#pragma unroll
        for (int n = 0; n < 128; ++n) op[n] = h[n]; }
}
struct MixScr { float* xbc; float* ys5; float* yssd; float* yml; float* qr; float* kr; };
__device__ __forceinline__ MixScr mix_scr(unsigned char* ws) { MixScr s; s.xbc = (float*)(ws + WS_SCR); s.ys5 = s.xbc + (size_t)M * 1024; s.yssd = s.ys5 + (size_t)2 * M * 512; s.yml = s.yssd + (size_t)2 * M * 512;
    s.qr = s.yml + (size_t)2 * M * 512; s.kr = s.qr + (size_t)M * 512; return s; }

__device__ __forceinline__ void nmix_a(const Args& a, int layer, int gw_, int ngw, int lane_) {
    int lane = lane_, gw = gw_; asm volatile("" : "+v"(lane));
    const PJA proj{(const bf16_t*)(a.ws + WS_PROJ), (const float*)(a.ws + WS_SMALL)}; bf16_t* BR = (bf16_t*)(a.ws + WS_BR); const MixScr sc = mix_scr(a.ws);
    for (int it = gw; it < 2816; it += ngw) {
        if (it < 256) nv_s5(proj, a, layer, sc.ys5, a.out, 1024 + it, lane);
        else if (it < 1280) nv_attn_na(proj, a.in[2], a.in[3], a.in[19] + (size_t)layer * 8 * 15 * 31, layer, BR, (it - 256) * 64 + lane);
        else if (it < 1792) nv_attn_dense(proj, BR, (it - 1280) * 64 + lane);
        else nv_s5(proj, a, layer, sc.ys5, a.out, it - 1792, lane);
    }
}
__device__ __forceinline__ void nmix_b(const Args& a, int layer, LAS unsigned char* lds, int tid_, int G) {
    int tid = tid_; asm volatile("" : "+v"(tid));
    const int lane = tid & 63, wave = __builtin_amdgcn_readfirstlane(tid >> 6), blk = blockIdx.x;
    const PJA proj{(const bf16_t*)(a.ws + WS_PROJ), (const float*)(a.ws + WS_SMALL)}; const MixScr sc = mix_scr(a.ws);
    {
        bf16_t* ZB = (bf16_t*)(a.ws + WS_ZB); const float* s5d = a.in[27] + layer * 512; const int nb_ = G;
        for (size_t idx = (size_t)blk * NT + tid; idx < (size_t)M * 512; idx += (size_t)nb_ * NT) { const int row = idx / 512, cidx = idx % 512;
            const float y = sc.ys5[idx] + sc.ys5[(size_t)M * 512 + idx] + proj(row, C_S5U + cidx) * s5d[cidx]; ZB[idx] = f2bf(ngelu(y)); }
    }
}
__device__ __forceinline__ void nmix_c(const Args& a, int layer, int gw, int ngw, int lane_) {
    int lane = lane_; asm volatile("" : "+v"(lane));
    const PJA proj{(const bf16_t*)(a.ws + WS_PROJ), (const float*)(a.ws + WS_SMALL)}; bf16_t* BR = (bf16_t*)(a.ws + WS_BR); const MixScr sc = mix_scr(a.ws);
    const float* ssd_d = a.in[34] + layer * 8; const float* sng = a.in[35] + layer * 512; const float* mng = a.in[38] + layer * 512;
    for (int row = gw; row < M; row += ngw) {
        float v[8]; float ss = 0.f;
#pragma unroll
        for (int i = 0; i < 8; ++i) { const int ch = lane + 64 * i; float y = sc.yssd[(size_t)row * 512 + ch] + sc.yssd[((size_t)M + row) * 512 + ch] + sc.xbc[(size_t)row * 1024 + ch] * ssd_d[ch / 64];
            y *= nsilu(proj(row, C_Z + ch)); v[i] = y; ss += y * y; }
        const float r = rsqrtf(wave_sum(ss) * (1.f / 512.f) + 1e-6f);
#pragma unroll
        for (int i = 0; i < 8; ++i) { const int ch = lane + 64 * i; BR[(size_t)row * D + 1024 + ch] = f2bf(v[i] * r * sng[ch]); }
    }
}
}
namespace mk {
constexpr size_t WS_NAT = AL(WS_SCR + (size_t)M * (1024 + 6 * 512 + 2 * 512) * 4);
constexpr int NATP = 2048, N_XBC = 0, N_Q = 1024, N_K = 1536;
constexpr size_t WS_TR = AL(WS_NAT + (size_t)M * NATP * 2);
constexpr int T_X = 0, T_B = 512, T_K = 768, T_MV = 1280, T_V = 1792, TRR = 2304;
constexpr int NCH = 96;
constexpr size_t WS_MLC = AL(WS_TR + (size_t)TRR * M * 2);
constexpr size_t WS_MLN = AL(WS_MLC + (size_t)NCH * 4 * 2 * 16384 * 4);
constexpr size_t WS_MLS = AL(WS_MLN + (size_t)NCH * 4 * 2 * 128 * 4);
constexpr size_t WS_MLCS = AL(WS_MLS + (size_t)NCH * 4 * 2 * 4 * 4);
constexpr size_t WS_MLNS = AL(WS_MLCS + (size_t)NCH * 4 * 2 * 16384 * 2);
constexpr size_t WS_MLMS = AL(WS_MLNS + (size_t)NCH * 4 * 2 * 128 * 4);
constexpr size_t WS_OPT_END = AL(WS_MLMS + (size_t)NCH * 4 * 2 * 4);

__device__ __forceinline__ f32x4 mfma16(bf16x8 a, bf16x8 b, f32x4 c) { return __builtin_amdgcn_mfma_f32_16x16x32_bf16(a, b, c, 0, 0, 0); }
__device__ __forceinline__ void chunk_info(int ch, int& row0, int& seq0, int& L, int& lat, int& b, int& ci, int& nc) {
    if (ch < 32) { b = ch >> 1; ci = ch & 1; nc = 2; seq0 = b * 256; L = 256; lat = 0; } else { const int c2 = ch - 32; b = c2 >> 4; ci = c2 & 15; nc = 16; seq0 = MP + b * 2048; L = 2048; lat = 1; }
    row0 = seq0 + ci * 128;
}
__device__ __forceinline__ float fast_exp(float x) { return __expf(x); }

__device__ __forceinline__ void prep_phase(const Args& a, int layer, LAS unsigned char* lds, int gw_, int ngw, int wave, int lane_) {
    int lane = lane_, gw = gw_; asm volatile("" : "+v"(lane));
    const bf16_t* PROJ = (const bf16_t*)(a.ws + WS_PROJ); bf16_t* NAT = (bf16_t*)(a.ws + WS_NAT); bf16_t* TR = (bf16_t*)(a.ws + WS_TR);
    LAS bf16_t* tile = (LAS bf16_t*)(lds + wave * 16896); LAS bf16_t* otile = tile + 68 * 64;
    const int c = lane & 7, r8 = lane >> 3;
    const float* cw = a.in[30] + layer * 5 * 1024; const float* cb = a.in[31] + layer * 1024;
    for (int u = gw; u < 48 * 192; u += ngw) {
        const int cg = u / 192, tt = u % 192, m0 = tt * 64;
        const int lat = m0 >= MP; const int seq0 = lat ? MP + ((m0 - MP) / 2048) * 2048 : (m0 / 256) * 256, L = lat ? 2048 : 256, t0 = m0 - seq0;
        int kind, src, natcol = -1, trrow = -1;
        if (cg < 16) { kind = 0; src = P_XBC + 64 * cg; natcol = N_XBC + 64 * cg; if (cg < 12) trrow = T_X + 64 * cg; }
        else if (cg < 24) { kind = 1; src = P_MQ + 64 * (cg - 16); natcol = N_Q + 64 * (cg - 16); }
        else if (cg < 32) { kind = 2; src = P_MK + 64 * (cg - 24); natcol = N_K + 64 * (cg - 24); trrow = T_K + 64 * (cg - 24); }
        else if (cg < 40) { kind = 3; src = P_MV + 64 * (cg - 32); trrow = T_MV + 64 * (cg - 32); }
        else { kind = 3; src = P_V + 64 * (cg - 40); trrow = T_V + 64 * (cg - 40); }
        const int roff = kind == 0 ? -2 : 0, nrows = kind == 0 ? 68 : 64;
#pragma unroll
        for (int i = 0; i < 9; ++i) { const int r = r8 + 8 * i; if (r < nrows) { const int t = t0 + r + roff; u32x4 v = {0u, 0u, 0u, 0u};
                if (t >= 0 && t < L) v = *(const u32x4*)(PROJ + (size_t)(seq0 + t) * PJ + src + 8 * c);
                *(LAS u32x4*)(tile + r * 64 + 8 * c) = v; } }
        LDS_WAIT(); asm volatile("" ::: "memory");
#define PREP_EMIT(i_, r_) do { if (natcol >= 0) *(u32x4*)(NAT + (size_t)(m0 + r8 + 8 * (i_)) * NATP + natcol + 8 * c) = (r_); if (trrow >= 0) *(LAS u32x4*)(otile + (r8 + 8 * (i_)) * 64 + 8 * c) = (r_); } while (0)
        if (kind == 0) {
            float w[5][8], bz[8];
#pragma unroll
            for (int e = 0; e < 8; ++e) { bz[e] = cb[64 * cg + 8 * c + e];
#pragma unroll
                for (int j = 0; j < 5; ++j) w[j][e] = cw[j * 1024 + 64 * cg + 8 * c + e]; }
#pragma unroll 2
            for (int i = 0; i < 8; ++i) { const int tk = r8 + 8 * i; float acc[8];
#pragma unroll
                for (int e = 0; e < 8; ++e) acc[e] = bz[e];
#pragma unroll
                for (int j = 0; j < 5; ++j) { const u32x4 v = *(const LAS u32x4*)(tile + (tk + j) * 64 + 8 * c);
                    acc[0] += bflo(v.x) * w[j][0]; acc[1] += bfhi(v.x) * w[j][1]; acc[2] += bflo(v.y) * w[j][2]; acc[3] += bfhi(v.y) * w[j][3];
                    acc[4] += bflo(v.z) * w[j][4]; acc[5] += bfhi(v.z) * w[j][5]; acc[6] += bflo(v.w) * w[j][6]; acc[7] += bfhi(v.w) * w[j][7]; }
#pragma unroll
                for (int e = 0; e < 8; ++e) acc[e] = fsilu(acc[e]);
                u32x4 rv; rv.x = pk2(acc[0], acc[1]); rv.y = pk2(acc[2], acc[3]); rv.z = pk2(acc[4], acc[5]); rv.w = pk2(acc[6], acc[7]); PREP_EMIT(i, rv); }
        } else if (kind == 3 || !lat) {
            const float sc = kind == 2 ? 0.08838834764831845f : 1.f;
#pragma unroll
            for (int i = 0; i < 8; ++i) { const u32x4 v = *(const LAS u32x4*)(tile + (r8 + 8 * i) * 64 + 8 * c);
                u32x4 rv = v;
                if (kind == 2) { rv.x = pk2(bflo(v.x) * sc, bfhi(v.x) * sc); rv.y = pk2(bflo(v.y) * sc, bfhi(v.y) * sc); rv.z = pk2(bflo(v.z) * sc, bfhi(v.z) * sc); rv.w = pk2(bflo(v.w) * sc, bfhi(v.w) * sc); }
                PREP_EMIT(i, rv); }
        } else {
            const float sc = kind == 2 ? 0.08838834764831845f : 1.f; const int odd = cg & 1;
            float inv[8];
#pragma unroll
            for (int e = 0; e < 8; ++e) inv[e] = exp2f(-(float)(8 * (c & 3) + e) * (13.287712379549449f / 32.f));
#pragma unroll
            for (int i = 0; i < 8; ++i) { const int tk = r8 + 8 * i, t = t0 + tk; const float pos = odd ? (float)(t & 63) : (float)(t >> 6);
                const u32x4 vo = *(const LAS u32x4*)(tile + tk * 64 + 8 * c), vp = *(const LAS u32x4*)(tile + tk * 64 + 8 * (c ^ 4));
                float o[8], p[8], rr[8];
                o[0] = bflo(vo.x); o[1] = bfhi(vo.x); o[2] = bflo(vo.y); o[3] = bfhi(vo.y); o[4] = bflo(vo.z); o[5] = bfhi(vo.z); o[6] = bflo(vo.w); o[7] = bfhi(vo.w);
                p[0] = bflo(vp.x); p[1] = bfhi(vp.x); p[2] = bflo(vp.y); p[3] = bfhi(vp.y); p[4] = bflo(vp.z); p[5] = bfhi(vp.z); p[6] = bflo(vp.w); p[7] = bfhi(vp.w);
#pragma unroll
                for (int e = 0; e < 8; ++e) { const float ang = pos * inv[e], cs = __cosf(ang), sn = __sinf(ang);
                    rr[e] = (c < 4 ? o[e] * cs - p[e] * sn : p[e] * sn + o[e] * cs) * sc; }
                u32x4 rv; rv.x = pk2(rr[0], rr[1]); rv.y = pk2(rr[2], rr[3]); rv.z = pk2(rr[4], rr[5]); rv.w = pk2(rr[6], rr[7]); PREP_EMIT(i, rv); }
        }
        if (trrow >= 0) {
            LDS_WAIT(); asm volatile("" ::: "memory");
            bf16_t* dst = TR + (size_t)(trrow + lane) * M + m0;
#pragma unroll
            for (int j = 0; j < 8; ++j) { unsigned wv[4];
#pragma unroll
                for (int q = 0; q < 4; ++q) { const unsigned lo = otile[(8 * j + 2 * q) * 64 + lane], hi = otile[(8 * j + 2 * q + 1) * 64 + lane]; wv[q] = lo | (hi << 16); }
                u32x4 o; o.x = wv[0]; o.y = wv[1]; o.z = wv[2]; o.w = wv[3]; *(u32x4*)(dst + 8 * j) = o; }
        }
        LDS_WAIT(); asm volatile("" ::: "memory");
    }
}

struct MlGate { float lf0, lf1, ig0, ig1, P0, P1, tot; };
__device__ __forceinline__ float wave_incl_scan(float v, int lane) {
#pragma unroll
    for (int o = 1; o < 64; o <<= 1) { const float t = __shfl_up(v, o); if (lane >= o) v += t; }
    return v;
}
__device__ __forceinline__ float wave_max(float v) {
#pragma unroll
    for (int o = 1; o < 64; o <<= 1) v = fmaxf(v, __shfl_xor(v, o));
    return v;
}
__device__ __forceinline__ MlGate ml_gates(const Args& a, int layer, int row0, int hh, int dir, int lane) {
    const float* SMALL = (const float*)(a.ws + WS_SMALL);
    const float ib = a.in[36][layer * 8 + dir * 4 + hh], fb = a.in[37][layer * 8 + dir * 4 + hh];
    MlGate g;
    const float f0 = SMALL[(size_t)(row0 + lane) * 32 + S_MF + dir * 4 + hh] + fb, f1 = SMALL[(size_t)(row0 + lane + 64) * 32 + S_MF + dir * 4 + hh] + fb;
    g.ig0 = SMALL[(size_t)(row0 + lane) * 32 + S_MI + dir * 4 + hh] + ib; g.ig1 = SMALL[(size_t)(row0 + lane + 64) * 32 + S_MI + dir * 4 + hh] + ib;
    g.lf0 = fminf(f0, 0.f) - log1pf(__expf(-fabsf(f0))); g.lf1 = fminf(f1, 0.f) - log1pf(__expf(-fabsf(f1)));
    const float s0 = wave_incl_scan(g.lf0, lane); const float tot0 = __shfl(s0, 63);
    const float s1 = wave_incl_scan(g.lf1, lane) + tot0;
    g.P0 = s0; g.P1 = s1; g.tot = __shfl(s1, 63);
    return g;
}

__device__ __forceinline__ void ml_states_phase(const Args& a, int layer, int tid_, int G) {
    int tid = tid_; asm volatile("" : "+v"(tid));
    const int lane = tid & 63, wave = __builtin_amdgcn_readfirstlane(tid >> 6), fr = lane & 15, fq = lane >> 4;
    const bf16_t* TR = (const bf16_t*)(a.ws + WS_TR);
    float* MLC = (float*)(a.ws + WS_MLC); float* MLN = (float*)(a.ws + WS_MLN); float* MLS = (float*)(a.ws + WS_MLS);
    for (int u = blockIdx.x; u < NCH * 4; u += G) {
        const int ch = u >> 2, hh = u & 3; int row0, seq0, L, lat, b, ci, nc; chunk_info(ch, row0, seq0, L, lat, b, ci, nc);
#pragma unroll
        for (int dir = 0; dir < 2; ++dir) {
            const MlGate g = ml_gates(a, layer, row0, hh, dir, lane);
            const float w0 = (dir == 0 ? g.tot - g.P0 : g.P0 - g.lf0) + g.ig0, w1 = (dir == 0 ? g.tot - g.P1 : g.P1 - g.lf1) + g.ig1;
            const float mloc = wave_max(fmaxf(w0, w1));
            const float e0 = __expf(w0 - mloc), e1 = __expf(w1 - mloc);
            f32x4 acc[8];
#pragma unroll
            for (int j = 0; j < 8; ++j) acc[j] = (f32x4){0.f, 0.f, 0.f, 0.f};
            float nacc[8];
#pragma unroll
            for (int j = 0; j < 8; ++j) nacc[j] = 0.f;
            const bf16_t* vrow = TR + (size_t)(T_MV + hh * 128 + wave * 16 + fr) * M + row0 + 8 * fq;
#pragma unroll
            for (int ks = 0; ks < 4; ++ks) {
                const bf16x8 af = *(const bf16x8*)(vrow + 32 * ks);
                float ev[8];
#pragma unroll
                for (int j = 0; j < 8; ++j) { const int tok = 32 * ks + 8 * fq + j; const float x0 = __shfl(e0, tok & 63), x1 = __shfl(e1, tok & 63); ev[j] = tok < 64 ? x0 : x1; }
#pragma unroll
                for (int jt = 0; jt < 8; ++jt) {
                    const u32x4 kv = *(const u32x4*)(TR + (size_t)(T_K + hh * 128 + jt * 16 + fr) * M + row0 + 32 * ks + 8 * fq);
                    const float k0 = bflo(kv.x) * ev[0], k1 = bfhi(kv.x) * ev[1], k2 = bflo(kv.y) * ev[2], k3 = bfhi(kv.y) * ev[3], k4 = bflo(kv.z) * ev[4], k5 = bfhi(kv.z) * ev[5], k6 = bflo(kv.w) * ev[6], k7 = bfhi(kv.w) * ev[7];
                    if (wave == 0) nacc[jt] += ((k0 + k1) + (k2 + k3)) + ((k4 + k5) + (k6 + k7));
                    u32x4 kb; kb.x = pk2(k0, k1); kb.y = pk2(k2, k3); kb.z = pk2(k4, k5); kb.w = pk2(k6, k7);
                    acc[jt] = mfma16(af, __builtin_bit_cast(bf16x8, kb), acc[jt]);
                }
            }
            float* cdst = MLC + ((size_t)(ch * 4 + hh) * 2 + dir) * 16384;
#pragma unroll
            for (int jt = 0; jt < 8; ++jt)
#pragma unroll
                for (int i = 0; i < 4; ++i) cdst[(size_t)(wave * 16 + 4 * fq + i) * 128 + jt * 16 + fr] = acc[jt][i];
            if (wave == 0) {
#pragma unroll
                for (int jt = 0; jt < 8; ++jt) { float v = nacc[jt]; v += __shfl_xor(v, 16); v += __shfl_xor(v, 32); if (fq == 0) MLN[((size_t)(ch * 4 + hh) * 2 + dir) * 128 + jt * 16 + fr] = v; }
                if (lane == 0) { MLS[((size_t)(ch * 4 + hh) * 2 + dir) * 4 + 0] = mloc; MLS[((size_t)(ch * 4 + hh) * 2 + dir) * 4 + 1] = g.tot; }
            }
        }
    }
}
__device__ __forceinline__ void ml_scan_phase(const Args& a, int layer, int tid_, int G) {
    int tid = tid_; asm volatile("" : "+v"(tid));
    const float* MLC = (const float*)(a.ws + WS_MLC); const float* MLN = (const float*)(a.ws + WS_MLN); const float* MLS = (const float*)(a.ws + WS_MLS);
    bf16_t* CS = (bf16_t*)(a.ws + WS_MLCS); float* NS = (float*)(a.ws + WS_MLNS); float* MS = (float*)(a.ws + WS_MLMS);
    for (int task = blockIdx.x; task < 256; task += G) {
        int lat, b, hh, dir, part, nparts;
        if (task < 128) { lat = 1; part = task & 3; dir = (task >> 2) & 1; hh = (task >> 3) & 3; b = task >> 5; nparts = 4; }
        else { const int t2 = task - 128; lat = 0; part = 0; dir = t2 & 1; hh = (t2 >> 1) & 3; b = t2 >> 3; nparts = 1; }
        const int nc = lat ? 16 : 2, ch0 = lat ? 32 + b * 16 : b * 2;
        const int nel = 16384 / nparts, e0 = part * nel, per = nel / NT;
        float c[32]; float n = 0.f, m = 0.f;
        const size_t so = (((size_t)b * DEPTH + layer) * 2 + dir) * 4 + hh;
#pragma unroll
        for (int i = 0; i < 32; ++i) if (i < per) { const int e = e0 + i * NT + tid, vd = e >> 7, kd = e & 127; c[i] = lat ? a.in[7][(so * 128 + kd) * 128 + vd] : 0.f; }
        if (tid < 128) n = lat ? a.in[8][so * 128 + tid] : 0.f;
        m = lat ? a.in[9][so] : 0.f;
        for (int s = 0; s < nc; ++s) { const int ci = dir ? nc - 1 - s : s, ch = ch0 + ci; const size_t sb = (size_t)(ch * 4 + hh) * 2 + dir;
#pragma unroll
            for (int i = 0; i < 32; ++i) if (i < per) CS[sb * 16384 + e0 + i * NT + tid] = f2bf(c[i]);
            if (part == 0) { if (tid < 128) NS[sb * 128 + tid] = n; if (tid == 0) MS[sb] = m; }
            const float ml = MLS[sb * 4 + 0], bl = MLS[sb * 4 + 1];
            const float mn = fmaxf(bl + m, ml), fa = __expf(bl + m - mn), fb = __expf(ml - mn);
#pragma unroll
            for (int i = 0; i < 32; ++i) if (i < per) c[i] = fa * c[i] + fb * MLC[sb * 16384 + e0 + i * NT + tid];
            if (tid < 128) n = fa * n + fb * MLN[sb * 128 + tid];
            m = mn; }
        if (!lat) {
#pragma unroll
            for (int i = 0; i < 32; ++i) if (i < per) { const int e = e0 + i * NT + tid, vd = e >> 7, kd = e & 127; a.out[O_MLC + (so * 128 + kd) * 128 + vd] = c[i]; }
            if (tid < 128) a.out[O_MLN + so * 128 + tid] = n; if (tid == 0) a.out[O_MLM + so] = m; }
    }
}
__device__ __forceinline__ void ml_out_phase(const Args& a, int layer, LAS unsigned char* lds, int tid_, int G) {
    int tid = tid_; asm volatile("" : "+v"(tid));
    const int lane = tid & 63, wave = __builtin_amdgcn_readfirstlane(tid >> 6), fr = lane & 15, fq = lane >> 4;
    const bf16_t* NAT = (const bf16_t*)(a.ws + WS_NAT); const bf16_t* TR = (const bf16_t*)(a.ws + WS_TR); const bf16_t* PROJ = (const bf16_t*)(a.ws + WS_PROJ);
    const bf16_t* CS = (const bf16_t*)(a.ws + WS_MLCS); const float* NS = (const float*)(a.ws + WS_MLNS); const float* MS = (const float*)(a.ws + WS_MLMS);
    bf16_t* BR = (bf16_t*)(a.ws + WS_BR);
    LAS float* U = (LAS float*)lds; LAS float* Wv = U + 128; LAS float* SI = U + 256; LAS float* EM = U + 384; LAS float* NSs = U + 512;
    for (int u = blockIdx.x; u < NCH * 4; u += G) {
        const int ch = u >> 2, hh = u & 3; int row0, seq0, L, lat, b, ci, nc; chunk_info(ch, row0, seq0, L, lat, b, ci, nc);
        const int t = wave * 16 + fr;
        bf16x8 qf[4];
#pragma unroll
        for (int ks = 0; ks < 4; ++ks) qf[ks] = *(const bf16x8*)(NAT + (size_t)(row0 + t) * NATP + N_Q + hh * 128 + 32 * ks + 8 * fq);
        f32x4 hsum[8];
#pragma unroll
        for (int j = 0; j < 8; ++j) hsum[j] = (f32x4){0.f, 0.f, 0.f, 0.f};
#pragma unroll 1
        for (int dir = 0; dir < 2; ++dir) {
            const size_t sb = (size_t)(ch * 4 + hh) * 2 + dir;
            __syncthreads();
            if (wave == 0) {
                const MlGate g = ml_gates(a, layer, row0, hh, dir, lane); const float ms = MS[sb];
                float u0, u1, c0, c1, ai0, ai1;
                if (dir == 0) { u0 = g.ig0 - g.P0; u1 = g.ig1 - g.P1; c0 = g.P0; c1 = g.P1; ai0 = g.P0 + ms; ai1 = g.P1 + ms; }
                else { const float E0 = g.P0 - g.lf0, E1 = g.P1 - g.lf1; u0 = E0 + g.ig0; u1 = E1 + g.ig1; c0 = -E0; c1 = -E1; ai0 = g.tot - E0 + ms; ai1 = g.tot - E1 + ms; }
                float g0 = u0, g1 = u1;
                if (dir == 0) {
#pragma unroll
                    for (int o = 1; o < 64; o <<= 1) { const float x0 = __shfl_up(g0, o), x1 = __shfl_up(g1, o); if (lane >= o) { g0 = fmaxf(g0, x0); g1 = fmaxf(g1, x1); } }
                    g1 = fmaxf(g1, __shfl(g0, 63));
                } else {
#pragma unroll
                    for (int o = 1; o < 64; o <<= 1) { const float x0 = __shfl_down(g0, o), x1 = __shfl_down(g1, o); if (lane + o < 64) { g0 = fmaxf(g0, x0); g1 = fmaxf(g1, x1); } }
                    g0 = fmaxf(g0, __shfl(g1, 0));
                }
                const float mt0 = fmaxf(ai0, c0 + g0), mt1 = fmaxf(ai1, c1 + g1);
                U[lane] = u0; U[lane + 64] = u1; Wv[lane] = c0 - mt0; Wv[lane + 64] = c1 - mt1;
                SI[lane] = __expf(ai0 - mt0); SI[lane + 64] = __expf(ai1 - mt1); EM[lane] = __expf(-mt0); EM[lane + 64] = __expf(-mt1);
                NSs[lane] = NS[sb * 128 + lane]; NSs[lane + 64] = NS[sb * 128 + lane + 64];
            }
            __syncthreads();
            const float wt = Wv[t], sit = SI[t], emt = EM[t];
            f32x4 acc[8];
#pragma unroll
            for (int j = 0; j < 8; ++j) acc[j] = (f32x4){0.f, 0.f, 0.f, 0.f};
#pragma unroll
            for (int ks = 0; ks < 4; ++ks)
#pragma unroll
                for (int j = 0; j < 8; ++j) { const bf16x8 cf = *(const bf16x8*)(CS + sb * 16384 + (size_t)(16 * j + fr) * 128 + 32 * ks + 8 * fq); acc[j] = mfma16(cf, qf[ks], acc[j]); }
            float qn = 0.f;
#pragma unroll
            for (int ks = 0; ks < 4; ++ks) { const u32x4 qv = __builtin_bit_cast(u32x4, qf[ks]); const LAS float* nn = NSs + 32 * ks + 8 * fq;
                qn += bflo(qv.x) * nn[0] + bfhi(qv.x) * nn[1] + bflo(qv.y) * nn[2] + bfhi(qv.y) * nn[3] + bflo(qv.z) * nn[4] + bfhi(qv.z) * nn[5] + bflo(qv.w) * nn[6] + bfhi(qv.w) * nn[7]; }
            qn += __shfl_xor(qn, 16); qn += __shfl_xor(qn, 32);
#pragma unroll
            for (int j = 0; j < 8; ++j) acc[j] *= sit;
            float den = sit * qn;
            const int jlo = dir == 0 ? 0 : (wave >> 1), jhi = dir == 0 ? (wave >> 1) : 3;
            float psum = 0.f;
            for (int jp = jlo; jp <= jhi; ++jp) {
                const int ta = 32 * jp + 8 * (fr >> 2) + (fr & 3);
                f32x4 sa = (f32x4){0.f, 0.f, 0.f, 0.f}, sb2 = (f32x4){0.f, 0.f, 0.f, 0.f};
#pragma unroll
                for (int ks = 0; ks < 4; ++ks) {
                    const bf16x8 ka = *(const bf16x8*)(NAT + (size_t)(row0 + ta) * NATP + N_K + hh * 128 + 32 * ks + 8 * fq);
                    const bf16x8 kb = *(const bf16x8*)(NAT + (size_t)(row0 + ta + 4) * NATP + N_K + hh * 128 + 32 * ks + 8 * fq);
                    sa = mfma16(ka, qf[ks], sa); sb2 = mfma16(kb, qf[ks], sb2); }
                float pa[4], pb[4];
#pragma unroll
                for (int i = 0; i < 4; ++i) { const int s0 = 32 * jp + 8 * fq + i, s1 = s0 + 4;
                    const bool ok0 = dir == 0 ? s0 <= t : s0 >= t, ok1 = dir == 0 ? s1 <= t : s1 >= t;
                    pa[i] = ok0 ? sa[i] * __expf(U[s0] + wt) : 0.f; pb[i] = ok1 ? sb2[i] * __expf(U[s1] + wt) : 0.f;
                    psum += pa[i] + pb[i]; }
                u32x4 pw; pw.x = pk2(pa[0], pa[1]); pw.y = pk2(pa[2], pa[3]); pw.z = pk2(pb[0], pb[1]); pw.w = pk2(pb[2], pb[3]);
                const bf16x8 pf = __builtin_bit_cast(bf16x8, pw);
#pragma unroll
                for (int j = 0; j < 8; ++j) { const bf16x8 vf = *(const bf16x8*)(TR + (size_t)(T_MV + hh * 128 + 16 * j + fr) * M + row0 + 32 * jp + 8 * fq); acc[j] = mfma16(vf, pf, acc[j]); }
            }
            psum += __shfl_xor(psum, 16); psum += __shfl_xor(psum, 32);
            den += psum;
            const float rden = 1.f / fmaxf(fabsf(den), emt);
#pragma unroll
            for (int j = 0; j < 8; ++j) hsum[j] += acc[j] * rden;
        }
        float ss = 0.f;
#pragma unroll
        for (int j = 0; j < 8; ++j) ss += (hsum[j][0] * hsum[j][0] + hsum[j][1] * hsum[j][1]) + (hsum[j][2] * hsum[j][2] + hsum[j][3] * hsum[j][3]);
        ss += __shfl_xor(ss, 16); ss += __shfl_xor(ss, 32);
        const float r = rsqrtf(ss * (1.f / 128.f) + 1e-6f);
        const float* ng = a.in[38] + layer * 512 + hh * 128;
#pragma unroll
        for (int j = 0; j < 8; ++j) { const int vd = 16 * j + 4 * fq; const f32x4 gg = *(const f32x4*)(ng + vd);
            const u32x2 ov = *(const u32x2*)(PROJ + (size_t)(row0 + t) * PJ + P_MO + hh * 128 + vd);
            const float o0 = hsum[j][0] * r * gg[0] * fsigm(bflo(ov.x)), o1 = hsum[j][1] * r * gg[1] * fsigm(bfhi(ov.x)), o2 = hsum[j][2] * r * gg[2] * fsigm(bflo(ov.y)), o3 = hsum[j][3] * r * gg[3] * fsigm(bfhi(ov.y));
            u32x2 w; w.x = pk2(o0, o1); w.y = pk2(o2, o3); *(u32x2*)(BR + (size_t)(row0 + t) * D + 1536 + hh * 128 + vd) = w; }
    }
}
}
namespace mk {
constexpr size_t WS_SST = WS_OPT_END;
constexpr size_t WS_SSL = AL(WS_SST + (size_t)NCH * 8 * 2 * 8192 * 4);
constexpr size_t WS_SSCS = AL(WS_SSL + (size_t)NCH * 8 * 2 * 4);
constexpr size_t WS_YPRE = AL(WS_SSCS + (size_t)NCH * 8 * 2 * 8192 * 2);
constexpr size_t WS_SSQ = AL(WS_YPRE + (size_t)M * 512 * 4);
constexpr size_t WS_SSD_END = AL(WS_SSQ + (size_t)M * 8 * 4);

struct SsdGate { float dt0, dt1, la0, la1, P0, P1, tot; };
__device__ __forceinline__ SsdGate ssd_gates(const Args& a, int layer, int row0, int hh, int dir, int lane) {
    const float* SMALL = (const float*)(a.ws + WS_SMALL);
    const float bias = a.in[32][layer * 16 + dir * 8 + hh], A = -__expf(a.in[33][layer * 16 + dir * 8 + hh]);
    SsdGate g;
    const float x0 = SMALL[(size_t)(row0 + lane) * 32 + S_DT + dir * 8 + hh] + bias, x1 = SMALL[(size_t)(row0 + lane + 64) * 32 + S_DT + dir * 8 + hh] + bias;
    g.dt0 = fmaxf(x0, 0.f) + log1pf(__expf(-fabsf(x0))); g.dt1 = fmaxf(x1, 0.f) + log1pf(__expf(-fabsf(x1)));
    g.la0 = g.dt0 * A; g.la1 = g.dt1 * A;
    const float s0 = wave_incl_scan(g.la0, lane); const float t0 = __shfl(s0, 63);
    const float s1 = wave_incl_scan(g.la1, lane) + t0;
    g.P0 = s0; g.P1 = s1; g.tot = __shfl(s1, 63);
    return g;
}
__device__ __forceinline__ void ssd_states_phase(const Args& a, int layer, int tid_, int G) {
    int tid = tid_; asm volatile("" : "+v"(tid));
    const int lane = tid & 63, wave = __builtin_amdgcn_readfirstlane(tid >> 6), fr = lane & 15, fq = lane >> 4;
    const bf16_t* TR = (const bf16_t*)(a.ws + WS_TR); float* SST = (float*)(a.ws + WS_SST); float* SSL = (float*)(a.ws + WS_SSL);
    for (int u = blockIdx.x; u < NCH * 8; u += G) {
        const int ch = u >> 3, hh = u & 7, grp = hh >> 2; int row0, seq0, L, lat, b, ci, nc; chunk_info(ch, row0, seq0, L, lat, b, ci, nc);
#pragma unroll
        for (int dir = 0; dir < 2; ++dir) {
            const SsdGate g = ssd_gates(a, layer, row0, hh, dir, lane);
            const float w0 = g.dt0 * __expf(dir == 0 ? g.tot - g.P0 : g.P0 - g.la0), w1 = g.dt1 * __expf(dir == 0 ? g.tot - g.P1 : g.P1 - g.la1);
            f32x4 acc[4];
#pragma unroll
            for (int j = 0; j < 4; ++j) acc[j] = (f32x4){0.f, 0.f, 0.f, 0.f};
#pragma unroll
            for (int ks = 0; ks < 4; ++ks) {
                float ev[8];
#pragma unroll
                for (int j = 0; j < 8; ++j) { const int tok = 32 * ks + 8 * fq + j; const float y0 = __shfl(w0, tok & 63), y1 = __shfl(w1, tok & 63); ev[j] = tok < 64 ? y0 : y1; }
                const u32x4 bv = *(const u32x4*)(TR + (size_t)(T_B + grp * 128 + wave * 16 + fr) * M + row0 + 32 * ks + 8 * fq);
                u32x4 bw; bw.x = pk2(bflo(bv.x) * ev[0], bfhi(bv.x) * ev[1]); bw.y = pk2(bflo(bv.y) * ev[2], bfhi(bv.y) * ev[3]); bw.z = pk2(bflo(bv.z) * ev[4], bfhi(bv.z) * ev[5]); bw.w = pk2(bflo(bv.w) * ev[6], bfhi(bv.w) * ev[7]);
                const bf16x8 bf = __builtin_bit_cast(bf16x8, bw);
#pragma unroll
                for (int j = 0; j < 4; ++j) { const bf16x8 xf = *(const bf16x8*)(TR + (size_t)(T_X + hh * 64 + 16 * j + fr) * M + row0 + 32 * ks + 8 * fq); acc[j] = mfma16(xf, bf, acc[j]); }
            }
            float* dst = SST + ((size_t)(ch * 8 + hh) * 2 + dir) * 8192;
#pragma unroll
            for (int j = 0; j < 4; ++j)
#pragma unroll
                for (int i = 0; i < 4; ++i) dst[(size_t)(16 * j + 4 * fq + i) * 128 + wave * 16 + fr] = acc[j][i];
            if (tid == 0) SSL[(size_t)(ch * 8 + hh) * 2 + dir] = g.tot;
        }
    }
}
__device__ __forceinline__ void ssd_scan_phase(const Args& a, int layer, int tid_, int G) {
    int tid = tid_; asm volatile("" : "+v"(tid));
    const float* SST = (const float*)(a.ws + WS_SST); const float* SSL = (const float*)(a.ws + WS_SSL); bf16_t* CS = (bf16_t*)(a.ws + WS_SSCS);
    for (int task = blockIdx.x; task < 384; task += G) {
        int lat, b, hh, dir, part, nparts;
        if (task < 128) { lat = 1; part = task & 1; dir = (task >> 1) & 1; hh = (task >> 2) & 7; b = task >> 5; nparts = 2; }
        else { const int t2 = task - 128; lat = 0; part = 0; dir = t2 & 1; hh = (t2 >> 1) & 7; b = t2 >> 4; nparts = 1; }
        const int nc = lat ? 16 : 2, ch0 = lat ? 32 + b * 16 : b * 2;
        const int nel = 8192 / nparts, e0 = part * nel, per = nel / NT;
        float c[16];
        const size_t so = ((((size_t)b * DEPTH + layer) * 2 + dir) * 8 + hh) * 8192;
#pragma unroll
        for (int i = 0; i < 16; ++i) if (i < per) c[i] = lat ? a.in[6][so + e0 + i * NT + tid] : 0.f;
        for (int s = 0; s < nc; ++s) { const int ci = dir ? nc - 1 - s : s, ch = ch0 + ci; const size_t sb = (size_t)(ch * 8 + hh) * 2 + dir;
#pragma unroll
            for (int i = 0; i < 16; ++i) if (i < per) CS[sb * 8192 + e0 + i * NT + tid] = f2bf(c[i]);
            const float dec = __expf(SSL[sb]);
#pragma unroll
            for (int i = 0; i < 16; ++i) if (i < per) c[i] = dec * c[i] + SST[sb * 8192 + e0 + i * NT + tid]; }
        if (!lat) {
#pragma unroll
            for (int i = 0; i < 16; ++i) if (i < per) a.out[O_SSD + so + e0 + i * NT + tid] = c[i]; }
    }
}
__device__ __forceinline__ void ssd_out_phase(const Args& a, int layer, LAS unsigned char* lds, int tid_, int G) {
    int tid = tid_; asm volatile("" : "+v"(tid));
    const int lane = tid & 63, wave = __builtin_amdgcn_readfirstlane(tid >> 6), fr = lane & 15, fq = lane >> 4;
    const bf16_t* NAT = (const bf16_t*)(a.ws + WS_NAT); const bf16_t* TR = (const bf16_t*)(a.ws + WS_TR); const bf16_t* PROJ = (const bf16_t*)(a.ws + WS_PROJ);
    const bf16_t* CS = (const bf16_t*)(a.ws + WS_SSCS); float* YPRE = (float*)(a.ws + WS_YPRE); float* SSQ = (float*)(a.ws + WS_SSQ);
    LAS float* U = (LAS float*)(lds + 4096); LAS float* Wv = U + 128; LAS float* DT = U + 256; LAS float* EO = U + 384;
    for (int u = blockIdx.x; u < NCH * 8; u += G) {
        const int ch = u >> 3, hh = u & 7, grp = hh >> 2; int row0, seq0, L, lat, b, ci, nc; chunk_info(ch, row0, seq0, L, lat, b, ci, nc);
        const int t = wave * 16 + fr;
        bf16x8 cf[4];
#pragma unroll
        for (int ks = 0; ks < 4; ++ks) cf[ks] = *(const bf16x8*)(NAT + (size_t)(row0 + t) * NATP + N_XBC + 768 + grp * 128 + 32 * ks + 8 * fq);
        f32x4 ysum[4];
#pragma unroll
        for (int j = 0; j < 4; ++j) ysum[j] = (f32x4){0.f, 0.f, 0.f, 0.f};
#pragma unroll 1
        for (int dir = 0; dir < 2; ++dir) {
            const size_t sb = (size_t)(ch * 8 + hh) * 2 + dir;
            __syncthreads();
            if (wave == 0) {
                const SsdGate g = ssd_gates(a, layer, row0, hh, dir, lane);
                if (dir == 0) { U[lane] = -g.P0; U[lane + 64] = -g.P1; Wv[lane] = g.P0; Wv[lane + 64] = g.P1; EO[lane] = __expf(g.P0); EO[lane + 64] = __expf(g.P1); }
                else { const float E0 = g.P0 - g.la0, E1 = g.P1 - g.la1; U[lane] = E0; U[lane + 64] = E1; Wv[lane] = -E0; Wv[lane + 64] = -E1; EO[lane] = __expf(g.tot - E0); EO[lane + 64] = __expf(g.tot - E1); }
                DT[lane] = g.dt0; DT[lane + 64] = g.dt1;
            }
            __syncthreads();
            const float wt = Wv[t], eot = EO[t];
            f32x4 acc[4];
#pragma unroll
            for (int j = 0; j < 4; ++j) acc[j] = (f32x4){0.f, 0.f, 0.f, 0.f};
#pragma unroll
            for (int ks = 0; ks < 4; ++ks)
#pragma unroll
                for (int j = 0; j < 4; ++j) { const bf16x8 sf = *(const bf16x8*)(CS + sb * 8192 + (size_t)(16 * j + fr) * 128 + 32 * ks + 8 * fq); acc[j] = mfma16(sf, cf[ks], acc[j]); }
#pragma unroll
            for (int j = 0; j < 4; ++j) acc[j] *= eot;
            const int jlo = dir == 0 ? 0 : (wave >> 1), jhi = dir == 0 ? (wave >> 1) : 3;
            for (int jp = jlo; jp <= jhi; ++jp) {
                const int ta = 32 * jp + 8 * (fr >> 2) + (fr & 3);
                f32x4 sa = (f32x4){0.f, 0.f, 0.f, 0.f}, sb2 = (f32x4){0.f, 0.f, 0.f, 0.f};
#pragma unroll
                for (int ks = 0; ks < 4; ++ks) {
                    const bf16x8 ba = *(const bf16x8*)(NAT + (size_t)(row0 + ta) * NATP + N_XBC + 512 + grp * 128 + 32 * ks + 8 * fq);
                    const bf16x8 bb = *(const bf16x8*)(NAT + (size_t)(row0 + ta + 4) * NATP + N_XBC + 512 + grp * 128 + 32 * ks + 8 * fq);
                    sa = mfma16(ba, cf[ks], sa); sb2 = mfma16(bb, cf[ks], sb2); }
                float pa[4], pb[4];
#pragma unroll
                for (int i = 0; i < 4; ++i) { const int s0 = 32 * jp + 8 * fq + i, s1 = s0 + 4;
                    const bool ok0 = dir == 0 ? s0 <= t : s0 >= t, ok1 = dir == 0 ? s1 <= t : s1 >= t;
                    pa[i] = ok0 ? sa[i] * DT[s0] * __expf(U[s0] + wt) : 0.f; pb[i] = ok1 ? sb2[i] * DT[s1] * __expf(U[s1] + wt) : 0.f; }
                u32x4 pw; pw.x = pk2(pa[0], pa[1]); pw.y = pk2(pa[2], pa[3]); pw.z = pk2(pb[0], pb[1]); pw.w = pk2(pb[2], pb[3]);
                const bf16x8 pf = __builtin_bit_cast(bf16x8, pw);
#pragma unroll
                for (int j = 0; j < 4; ++j) { const bf16x8 xf = *(const bf16x8*)(TR + (size_t)(T_X + hh * 64 + 16 * j + fr) * M + row0 + 32 * jp + 8 * fq); acc[j] = mfma16(xf, pf, acc[j]); }
            }
#pragma unroll
            for (int j = 0; j < 4; ++j) ysum[j] += acc[j];
        }
        const float Dh = a.in[34][layer * 8 + hh]; float ss = 0.f;
#pragma unroll
        for (int j = 0; j < 4; ++j) { const int p = 16 * j + 4 * fq;
            const u32x2 xv = *(const u32x2*)(NAT + (size_t)(row0 + t) * NATP + N_XBC + hh * 64 + p), zv = *(const u32x2*)(PROJ + (size_t)(row0 + t) * PJ + P_Z + hh * 64 + p);
            f32x4 y; y[0] = (ysum[j][0] + bflo(xv.x) * Dh) * fsilu(bflo(zv.x)); y[1] = (ysum[j][1] + bfhi(xv.x) * Dh) * fsilu(bfhi(zv.x));
            y[2] = (ysum[j][2] + bflo(xv.y) * Dh) * fsilu(bflo(zv.y)); y[3] = (ysum[j][3] + bfhi(xv.y) * Dh) * fsilu(bfhi(zv.y));
            ss += (y[0] * y[0] + y[1] * y[1]) + (y[2] * y[2] + y[3] * y[3]);
            *(f32x4*)(YPRE + (size_t)(row0 + t) * 512 + hh * 64 + p) = y; }
        ss += __shfl_xor(ss, 16); ss += __shfl_xor(ss, 32);
        if (fq == 0) SSQ[(size_t)(row0 + t) * 8 + hh] = ss;
    }
}
__device__ __forceinline__ void ssd_fin_phase(const Args& a, int layer, int gw, int ngw, int lane_) {
    int lane = lane_; asm volatile("" : "+v"(lane));
    const float* YPRE = (const float*)(a.ws + WS_YPRE); const float* SSQ = (const float*)(a.ws + WS_SSQ); bf16_t* BR = (bf16_t*)(a.ws + WS_BR); const float* ng = a.in[35] + layer * 512;
    for (int row = gw; row < M; row += ngw) {
        float s = lane < 8 ? SSQ[(size_t)row * 8 + lane] : 0.f; s += __shfl_xor(s, 1); s += __shfl_xor(s, 2); s += __shfl_xor(s, 4); s = __shfl(s, 0);
        const float r = rsqrtf(s * (1.f / 512.f) + 1e-6f);
        const f32x4 y0 = *(const f32x4*)(YPRE + (size_t)row * 512 + 8 * lane), y1 = *(const f32x4*)(YPRE + (size_t)row * 512 + 8 * lane + 4);
        const f32x4 g0 = *(const f32x4*)(ng + 8 * lane), g1 = *(const f32x4*)(ng + 8 * lane + 4);
        *(u32x4*)(BR + (size_t)row * D + 1024 + 8 * lane) = pack8(y0 * r * g0, y1 * r * g1);
    }
}
}
namespace mk {
#ifndef PHMASK
#define PHMASK 0xfffff
#endif
#define PHM(k) ((PHMASK >> (k)) & 1)
constexpr int NPH = 12;
constexpr int PH_TOTAL = 1 + DEPTH * NPH;
__global__ void __launch_bounds__(NT, 2) mk_fwd(Args a) {
    extern __shared__ __attribute__((aligned(16))) unsigned char lds_raw[];
    LAS unsigned char* lds = (LAS unsigned char*)lds_raw;
#define TID ((int)threadIdx.x)
#define LANE ((int)(threadIdx.x & 63))
#define WAVE (__builtin_amdgcn_readfirstlane((int)(threadIdx.x >> 6)))
#define GW ((int)blockIdx.x * NWV + WAVE)
    const int G = gridDim.x, ngw = G * NWV;
    volatile LAS unsigned* ctlw = (volatile LAS unsigned*)(lds + LDS_CTL);
    if (TID < 4) ctlw[TID] = 0u;
    __syncthreads();
    XcdBarrier bar = xcd_barrier_post((unsigned*)(a.ws + WS_CTL), ctlw);
    const int lo = a.ph_lo, hi = a.ph_hi;
#define IN(k) (lo <= (k) && (k) < hi)
#define SEAM(k) do { if (IN(k) && IN((k) + 1)) xcd_barrier(bar); } while (0)
    unsigned char* ws = a.ws;
    bf16_t* H = (bf16_t*)(ws + WS_H); bf16_t* PROJ = (bf16_t*)(ws + WS_PROJ); float* SMALL = (float*)(ws + WS_SMALL); bf16_t* BR = (bf16_t*)(ws + WS_BR);
    bf16_t* MERGED = (bf16_t*)(ws + WS_MERGED); float* MACC = (float*)(ws + WS_MACC); bf16_t* ZB = (bf16_t*)(ws + WS_ZB); bf16_t* HID = PROJ;
    const float* MOD = (const float*)(ws + WS_MOD); float* X = a.out;
    if (PHM(0) && IN(0)) { prologue_convert(a, lds, GW, ngw, WAVE, LANE); __syncthreads(); prologue_ada(a, lds, TID); }
    SEAM(0);
    for (int l = 0; l < DEPTH; ++l) {
        const int pb = 1 + l * NPH;
        const float* xp = l == 0 ? a.in[0] : X; const float* xs = l == 0 ? a.in[1] : X + (size_t)MP * D;
        const float* modl = MOD + (size_t)l * 5 * 6 * D;
        const bf16_t* wl = (const bf16_t*)(ws + WS_W) + (size_t)l * W_LAYER;
        if (PHM(1) && IN(pb + 0)) norm_phase(xp, xs, a.in[14] + l * D, modl, 0, D, H, GW, ngw, LANE);
        SEAM(pb + 0);
        if (PHM(2) && IN(pb + 1)) { Gemm g{H, wl + W_IN, M, NIN, D, D, 1, 0, 0}; StaticOrder S; S.init(M, NIN, G, blockIdx.x);
            EpiIn E{PROJ, SMALL, a.out, a.in[17] + l * 64, a.in[18] + l * 64, l}; gemm_phase(lds, g, S, E); }
        SEAM(pb + 1);
        if (PHM(3) && IN(pb + 2)) { prep_phase(a, l, lds, GW, ngw, WAVE, LANE); nmix_a(a, l, GW, ngw, LANE); }
        SEAM(pb + 2);
        if (PHM(4) && IN(pb + 3)) { ml_states_phase(a, l, TID, G); ssd_states_phase(a, l, TID, G); nmix_b(a, l, lds, TID, G); }
        SEAM(pb + 3);
        if (PHM(5) && IN(pb + 4)) { ml_scan_phase(a, l, TID, G); ssd_scan_phase(a, l, TID, G); }
        SEAM(pb + 4);
        if (PHM(12) && IN(pb + 5)) { ml_out_phase(a, l, lds, TID, G); ssd_out_phase(a, l, lds, TID, G); }
        SEAM(pb + 5);
        if (PHM(6) && IN(pb + 6)) { Gemm g{ZB, wl + W_GLU, M, 512, 512, 512, 1, 0, 0}; StaticOrder S; S.init(M, 512, G, blockIdx.x);
            EpiGlu E{ZB, a.in[29] + l * 512, BR}; gemm_phase(lds, g, S, E); ssd_fin_phase(a, l, GW, ngw, LANE); }
        SEAM(pb + 6);
        if (PHM(7) && IN(pb + 7)) { Gemm g{BR, wl + W_BR, M, D, 512, D, 4, 512, (size_t)D * 512}; StaticOrder S; S.init(M, D, G, blockIdx.x, 4);
            EpiBranch E{PROJ, MACC, MERGED}; gemm_phase(lds, g, S, E); }
        SEAM(pb + 7);
        if (PHM(8) && IN(pb + 8)) { Gemm g{MERGED, wl + W_OUT, M, D, D, D, 1, 0, 0}; StaticOrder S; S.init(M, D, G, blockIdx.x);
            EpiResid E{xp, xs, modl, 2 * D, X}; gemm_phase(lds, g, S, E); }
        SEAM(pb + 8);
        if (PHM(9) && IN(pb + 9)) norm_phase(X, X + (size_t)MP * D, a.in[15] + l * D, modl, 3 * D, 4 * D, H, GW, ngw, LANE);
        SEAM(pb + 9);
        if (PHM(10) && IN(pb + 10)) { Gemm g{H, wl + W_1, M, DFF, D, D, 1, 0, 0}; StaticOrder S; S.init(M, DFF, G, blockIdx.x);
            EpiRelu2 E{HID, DFF}; gemm_phase(lds, g, S, E); }
        SEAM(pb + 10);
        if (PHM(11) && IN(pb + 11)) { Gemm g{HID, wl + W_2, M, D, DFF, DFF, 1, 0, 0}; StaticOrder S; S.init(M, D, G, blockIdx.x);
            EpiResid E{X, X + (size_t)MP * D, modl, 5 * D, X}; gemm_phase(lds, g, S, E); }
        SEAM(pb + 11);
    }
#undef IN
#undef SEAM
}
}
extern "C" void kernel_launch(void* const* d_in, const int* in_sizes, int n_in, void* d_out, int out_size, void* d_ws, size_t ws_size, hipStream_t stream) {
    static int grid = 0;
    if (grid == 0) {
        int dev = 0, cus = 0; (void)hipGetDevice(&dev); (void)hipDeviceGetAttribute(&cus, hipDeviceAttributeMultiprocessorCount, dev);
        (void)hipFuncSetAttribute((const void*)mk::mk_fwd, hipFuncAttributeMaxDynamicSharedMemorySize, mk::LDS_BYTES);
        int per_cu = 0; (void)hipOccupancyMaxActiveBlocksPerMultiprocessor(&per_cu, (const void*)mk::mk_fwd, mk::NT, mk::LDS_BYTES); (void)hipGetLastError();
        grid = cus > 0 ? cus : 256;
    }
    mk::Args a{}; for (int i = 0; i < 43; ++i) a.in[i] = (const float*)d_in[i];
    a.out = (float*)d_out; a.ws = (unsigned char*)d_ws; a.ph_lo = 0; a.ph_hi = mk::PH_TOTAL;
    (void)hipMemsetAsync(a.ws + mk::WS_CTL, 0, mk::CTL_BYTES, stream);
    hipLaunchKernelGGL(mk::mk_fwd, dim3(grid), dim3(mk::NT), mk::LDS_BYTES, stream, a);
}
```

```cpp
#define SAFE_GEMM 0
#include <hip/hip_runtime.h>
#include <math.h>
namespace mk {
#define LAS __attribute__((address_space(3)))
typedef unsigned short bf16_t;
typedef short bf16x8 __attribute__((ext_vector_type(8)));
typedef float f32x4 __attribute__((ext_vector_type(4)));
typedef float f32x2 __attribute__((ext_vector_type(2)));
typedef unsigned u32x4 __attribute__((ext_vector_type(4)));
typedef unsigned u32x2 __attribute__((ext_vector_type(2)));
constexpr int NT = 512, NWV = 8;
constexpr int D = 2048, MP = 4096, MLAT = 8192, M = MP + MLAT, DEPTH = 4, DFF = 8192;
constexpr int PJ = 13824;
constexpr int NIN = 14080;
constexpr int P_Q = 0, P_K = 512, P_V = 1024, P_S5U = 1536, P_Z = 2048, P_XBC = 2560, P_MQ = 3584, P_MK = 4096, P_MV = 4608, P_MO = 5120, P_GATE = 5632;
constexpr int S_DT = 0, S_MI = 16, S_MF = 24;

typedef __bf16 bf16x2_t __attribute__((ext_vector_type(2)));
__device__ __forceinline__ unsigned pk2(float lo, float hi) { f32x2 v = {lo, hi}; bf16x2_t b = __builtin_convertvector(v, bf16x2_t); return __builtin_bit_cast(unsigned, b); }
__device__ __forceinline__ float bf2f(bf16_t v) { return __uint_as_float(((unsigned)v) << 16); }
__device__ __forceinline__ float bflo(unsigned w) { return __uint_as_float(w << 16); }
__device__ __forceinline__ float bfhi(unsigned w) { return __uint_as_float(w & 0xffff0000u); }
__device__ __forceinline__ bf16_t f2bf(float f) { return (bf16_t)(pk2(f, 0.f) & 0xffffu); }
__device__ __forceinline__ float fsigm(float x) { return __builtin_amdgcn_rcpf(1.f + __expf(-x)); }
__device__ __forceinline__ float fsilu(float x) { return x * fsigm(x); }
__device__ __forceinline__ int row_cvec(int row) { return row < MP ? 0 : 1 + (row - MP) / 2048; }

#define XB_TMO      128
#define XB_XCNT(j)  (256  + 64 * (j))
#define XB_XSUB(j)  (1280 + 64 * (j))
#define XB_XGEN(j)  (2304 + 64 * (j))
#define XB_TOP      3328
#define XB_TOPGEN   3392
#define XCD_BAR_WORDS 3456
#define XB_SPIN_CAP (1u << 18)
__device__ __forceinline__ unsigned xb_ld(unsigned* p)              { return __hip_atomic_load(p, __ATOMIC_RELAXED, __HIP_MEMORY_SCOPE_AGENT); }
__device__ __forceinline__ unsigned xb_add(unsigned* p, unsigned v) { return __hip_atomic_fetch_add(p, v, __ATOMIC_RELAXED, __HIP_MEMORY_SCOPE_AGENT); }
__device__ __forceinline__ unsigned xb_xcc_id() { return (unsigned)__builtin_amdgcn_s_getreg((3 << 11) | 20) & 0xFu; }
#define XB_SPIN(cond, bar) do { unsigned _sp = 0; while (cond) { __builtin_amdgcn_s_sleep(1); \
    if ((++_sp & 255u) == 0u) { if (xb_ld(&(bar)[XB_TMO])) break; if (_sp > XB_SPIN_CAP) { atomicAdd(&(bar)[XB_TMO], 1u); break; } } } } while (0)
struct XcdBarrier { unsigned* bar; unsigned x; volatile LAS unsigned* st; };
__device__ __forceinline__ XcdBarrier xcd_barrier_post(unsigned* bar, volatile LAS unsigned* st) {
    XcdBarrier b; b.bar = bar; b.x = xb_xcc_id(); b.st = st;
    if (threadIdx.x == 0) (void)xb_add(&bar[XB_XCNT(b.x)], 1u);
    return b;
}
__device__ __forceinline__ void xcd_barrier_complete(unsigned* bar, unsigned x, unsigned& nloc, unsigned& nx) {
    const unsigned G = gridDim.x * gridDim.y * gridDim.z;
    unsigned sum, cnt, mine, sp = 0u;
    for (;;) {
        sum = 0u; cnt = 0u; mine = 0u;
#pragma unroll
        for (unsigned j = 0; j < 16; ++j) { const unsigned c = xb_ld(&bar[XB_XCNT(j)]); sum += c; cnt += (c > 0u) ? 1u : 0u; mine = (j == x) ? c : mine; }
        if (sum == G) break;
        __builtin_amdgcn_s_sleep(1);
        if ((++sp & 255u) == 0u) { if (xb_ld(&bar[XB_TMO])) break; if (sp > XB_SPIN_CAP) { atomicAdd(&bar[XB_TMO], 1u); break; } }
    }
    nloc = mine > 0u ? mine : 1u; nx = cnt > 0u ? cnt : 1u;
}
__device__ __forceinline__ void xcd_barrier(const XcdBarrier& b) {
    asm volatile("s_waitcnt vmcnt(0)" ::: "memory");
    __syncthreads();
    if (threadIdx.x == 0) {
        unsigned* bar = b.bar;
        __builtin_amdgcn_s_waitcnt(0);
        unsigned nloc = b.st[0], nx = b.st[1];
        if (nloc == 0u) { xcd_barrier_complete(bar, b.x, nloc, nx); b.st[0] = nloc; b.st[1] = nx; }
        const unsigned old = xb_add(&bar[XB_XSUB(b.x)], 1u);
        const unsigned gen = old / nloc;
        if (old + 1u == (gen + 1u) * nloc) {
            __builtin_amdgcn_fence(__ATOMIC_RELEASE, "agent");
            asm volatile("s_waitcnt vmcnt(0)" ::: "memory");
            const unsigned og = xb_add(&bar[XB_TOP], 1u);
            const unsigned tg = og / nx;
            if (og + 1u == (tg + 1u) * nx) xb_add(&bar[XB_TOPGEN], 1u);
            else XB_SPIN(xb_ld(&bar[XB_TOPGEN]) == tg, bar);
            __builtin_amdgcn_fence(__ATOMIC_ACQUIRE, "agent");
            xb_add(&bar[XB_XGEN(b.x)], 1u);
            asm volatile("s_waitcnt vmcnt(0)" ::: "memory");
        } else {
            XB_SPIN(xb_ld(&bar[XB_XGEN(b.x)]) == gen, bar);
            __builtin_amdgcn_fence(__ATOMIC_ACQUIRE, "agent");
            asm volatile("s_waitcnt vmcnt(0)" ::: "memory");
        }
    }
    __syncthreads();
}

constexpr int BM = 256, BK = 64, HALF = 128, HTB = HALF * BK * 2, STAGE_BYTES = 8 * HTB, NXCD = 8, WGM = 8;
__host__ __device__ __forceinline__ int lds_byte(int r, int c) { const int st = (r >> 4) * 2 + (c >> 5), rr = r & 15, cc = c & 31, ob = rr * 64 + cc * 2; return st * 1024 + (ob ^ (((ob >> 9) & 1) << 5)); }
__host__ __device__ __forceinline__ void stage_rc(int b, int& R, int& C) { const int st = b / 1024, sb = b % 1024, swz = sb ^ (((sb >> 9) & 1) << 5); R = (st >> 1) * 16 + swz / 64; C = (st & 1) * 32 + (swz % 64) / 2; }
__host__ __device__ __forceinline__ int perm32(int rho) { const int n = rho >> 4, i = rho & 15; return 8 * (i >> 2) + 4 * n + (i & 3); }

struct Unit { int pm, pn, kz; };
struct Gemm { const bf16_t* A; const bf16_t* Bt; int M, N, K, lda, nkz; size_t a_kz, b_kz; };

struct StaticOrder {
    int nM, nN, nwg, G, c, nkz;
    __device__ void init(int M_, int N_, int G_, int c_, int nkz_ = 1) { nM = M_ / BM; nN = N_ / BM; nwg = nM * nN; G = G_; c = c_; nkz = nkz_; }
    __device__ bool next(int i, Unit& u) const {
        const int it = i / nkz; u.kz = i - it * nkz;
        const long L = (long)it * G + c; if (L >= nwg) return false;
        int wgid = (int)L; { const int q = nwg / NXCD, r = nwg % NXCD, xcd = wgid % NXCD, off = wgid / NXCD; wgid = (xcd < r ? xcd * (q + 1) : r * (q + 1) + (xcd - r) * q) + off; }
        const int nig = WGM * nN, gid = wgid / nig, fm = gid * WGM, gsz = (nM - fm) < WGM ? (nM - fm) : WGM;
        u.pm = fm + ((wgid % nig) % gsz); u.pn = (wgid % nig) / gsz; return true;
    }
};

template <class Epi>
__device__ __forceinline__ void gemm_phase(LAS unsigned char* lds, const Gemm g, const StaticOrder& S, const Epi& E) {
    int tid_ = threadIdx.x; asm volatile("" : "+v"(tid_));
    const int tid = tid_, wid = __builtin_amdgcn_readfirstlane(tid >> 6), lane = tid & 63, wr = wid >> 2, wc = wid & 3, fr = lane & 15, fq = lane >> 4;
    const int K = g.K, nt = K / BK;
    unsigned voffA[2], voffB[2];
#pragma unroll
    for (int i = 0; i < 2; ++i) { int R, C; stage_rc(tid * 16 + i * 8192, R, C); const int Rb = Epi::PERM ? ((R & ~31) + perm32(R & 31)) : R;
        voffA[i] = (unsigned)(R * g.lda + C) * 2u; voffB[i] = (unsigned)(Rb * K + C) * 2u; }
    const size_t kstep = (size_t)(BK * 2);
    const size_t hstepA = (size_t)HALF * g.lda * 2, hstepB = (size_t)HALF * K * 2;
    const size_t tstepA = 2 * hstepA, tstepB = 2 * hstepB;
    const unsigned ldsw = (unsigned)wid * 1024u;
    const int aoff = lds_byte(wr * 64 + fr, fq * 8), boff = lds_byte(wc * 32 + fr, fq * 8);
#define PG8_SA(b, h) (((b) * 2 + (h)) * HTB)
#define PG8_SB(b, h) ((4 + (b) * 2 + (h)) * HTB)
#define PG8_STAGE(bufoff, gbase, voff) do { _Pragma("unroll") for (int _i = 0; _i < 2; ++_i) \
        __builtin_amdgcn_global_load_lds((const unsigned*)((const char*)(gbase) + (voff)[_i]), (LAS unsigned*)(lds + (bufoff) + ldsw + _i * 8192), 16, 0, 0); } while (0)
#define PG8_LDA(dst, b, h) do { _Pragma("unroll") for (int m = 0; m < 4; ++m) _Pragma("unroll") for (int k = 0; k < 2; ++k) dst[m][k] = *(const LAS bf16x8*)(lds + PG8_SA(b, h) + aoff + m * 2048 + k * 1024); } while (0)
#define PG8_LDB(dst, b, h) do { _Pragma("unroll") for (int n = 0; n < 2; ++n) _Pragma("unroll") for (int k = 0; k < 2; ++k) dst[n][k] = *(const LAS bf16x8*)(lds + PG8_SB(b, h) + boff + n * 2048 + k * 1024); } while (0)
#define PG8_MMA(ai, bj, At, Bt) do { __builtin_amdgcn_s_setprio(1); _Pragma("unroll") for (int m = 0; m < 4; ++m) _Pragma("unroll") for (int n = 0; n < 2; ++n) _Pragma("unroll") for (int k = 0; k < 2; ++k) \
        acc[ai][bj][m][n] = __builtin_amdgcn_mfma_f32_16x16x32_bf16(Bt[n][k], At[m][k], acc[ai][bj][m][n], 0, 0, 0); __builtin_amdgcn_s_setprio(0); } while (0)
#if SAFE_GEMM == 1 || SAFE_GEMM == 3
#define PG8_WAIT_V(n) asm volatile("s_waitcnt vmcnt(0)" ::: "memory")
#else
#define PG8_WAIT_V(n) asm volatile("s_waitcnt vmcnt(" #n ")" ::: "memory")
#endif
#define PG8_WAIT_L(n) asm volatile("s_waitcnt lgkmcnt(" #n ")" ::: "memory")
#if SAFE_GEMM == 1
#define PG8_BAR do { asm volatile("s_waitcnt vmcnt(0) lgkmcnt(0)" ::: "memory"); __builtin_amdgcn_s_barrier(); asm volatile("" ::: "memory"); } while (0)
#elif SAFE_GEMM == 2
#define PG8_BAR asm volatile("s_barrier" ::: "memory")
#elif SAFE_GEMM == 4
#define PG8_BAR do { asm volatile("s_waitcnt lgkmcnt(0)" ::: "memory"); __builtin_amdgcn_s_barrier(); } while (0)
#else
#define PG8_BAR __builtin_amdgcn_s_barrier()
#endif
#define PG8_SCHED __builtin_amdgcn_sched_barrier(0)
    Unit cur, nxt; int ui = 0;
    if (!S.next(0, cur)) return;
    f32x4 acc[2][2][4][2];
#pragma unroll
    for (int a = 0; a < 2; ++a)
#pragma unroll
        for (int b = 0; b < 2; ++b)
#pragma unroll
            for (int m = 0; m < 4; ++m)
#pragma unroll
                for (int n = 0; n < 2; ++n) acc[a][b][m][n] = (f32x4){0.f, 0.f, 0.f, 0.f};
    bf16x8 At[4][2], B0[2][2], B1[2][2];
    const char* cA = (const char*)(g.A + (size_t)cur.kz * g.a_kz) + (size_t)cur.pm * tstepA; const char* cB = (const char*)(g.Bt + (size_t)cur.kz * g.b_kz) + (size_t)cur.pn * tstepB;
    PG8_STAGE(PG8_SB(0, 0), cB, voffB); PG8_STAGE(PG8_SA(0, 0), cA, voffA); PG8_STAGE(PG8_SB(0, 1), cB + hstepB, voffB); PG8_STAGE(PG8_SA(0, 1), cA + hstepA, voffA);
    if (wr == 1) PG8_BAR;
    PG8_WAIT_V(4); PG8_BAR;
    PG8_STAGE(PG8_SB(1, 0), cB + kstep, voffB); PG8_STAGE(PG8_SA(1, 0), cA + kstep, voffA); PG8_STAGE(PG8_SB(1, 1), cB + hstepB + kstep, voffB);
    PG8_WAIT_V(6); PG8_BAR;
    for (;;) {
        const bool has_next = S.next(ui + 1, nxt);
        const char* nA = has_next ? (const char*)(g.A + (size_t)nxt.kz * g.a_kz) + (size_t)nxt.pm * tstepA : cA;
        const char* nB = has_next ? (const char*)(g.Bt + (size_t)nxt.kz * g.b_kz) + (size_t)nxt.pn * tstepB : cB;
        for (int t = 0; t < nt; t += 2) {
            const bool last = (t == nt - 2);
            const char* a1 = cA + (size_t)(t + 1) * kstep;
            const char* a2 = last ? nA : cA + (size_t)(t + 2) * kstep; const char* b2 = last ? nB : cB + (size_t)(t + 2) * kstep;
            const char* a3 = a2 + kstep; const char* b3 = b2 + kstep;
            PG8_LDB(B0, 0, 0); PG8_SCHED; PG8_LDA(At, 0, 0); PG8_STAGE(PG8_SA(1, 1), a1 + hstepA, voffA);
            PG8_WAIT_L(8); PG8_BAR; PG8_WAIT_L(0); PG8_MMA(0, 0, At, B0); PG8_BAR; PG8_SCHED;
            PG8_LDB(B1, 0, 1); PG8_STAGE(PG8_SB(0, 0), b2, voffB);
            PG8_BAR; PG8_WAIT_L(0); PG8_MMA(0, 1, At, B1); PG8_BAR;
            PG8_LDA(At, 0, 1); PG8_STAGE(PG8_SA(0, 0), a2, voffA);
            PG8_BAR; PG8_WAIT_L(0); PG8_MMA(1, 0, At, B0); PG8_BAR; PG8_SCHED;
            PG8_STAGE(PG8_SB(0, 1), b2 + hstepB, voffB);
            PG8_WAIT_V(6); PG8_BAR; PG8_MMA(1, 1, At, B1); PG8_BAR;
            PG8_LDB(B0, 1, 0); PG8_SCHED; PG8_LDA(At, 1, 0); PG8_STAGE(PG8_SA(0, 1), a2 + hstepA, voffA);
            PG8_WAIT_L(8); PG8_BAR; PG8_WAIT_L(0); PG8_MMA(0, 0, At, B0); PG8_BAR; PG8_SCHED;
            PG8_LDB(B1, 1, 1); PG8_STAGE(PG8_SB(1, 0), b3, voffB);
            PG8_BAR; PG8_WAIT_L(0); PG8_MMA(0, 1, At, B1); PG8_BAR;
            PG8_LDA(At, 1, 1); PG8_STAGE(PG8_SA(1, 0), a3, voffA);
            PG8_BAR; PG8_WAIT_L(0); PG8_MMA(1, 0, At, B0); PG8_BAR; PG8_SCHED;
            PG8_STAGE(PG8_SB(1, 1), b3 + hstepB, voffB);
            PG8_WAIT_V(6); PG8_BAR; PG8_MMA(1, 1, At, B1); PG8_BAR;
        }
        E(acc, cur, wr, wc, fr, fq);
        asm volatile("s_waitcnt vmcnt(0)" ::: "memory");
        if (!has_next) break;
#pragma unroll
        for (int a = 0; a < 2; ++a)
#pragma unroll
            for (int b = 0; b < 2; ++b)
#pragma unroll
                for (int m = 0; m < 4; ++m)
#pragma unroll
                    for (int n = 0; n < 2; ++n) acc[a][b][m][n] = (f32x4){0.f, 0.f, 0.f, 0.f};
        cur = nxt; cA = nA; cB = nB; ++ui;
    }
    PG8_WAIT_V(0);
    if (wr == 0) PG8_BAR;
    PG8_BAR;
#undef PG8_SA
#undef PG8_SB
#undef PG8_STAGE
#undef PG8_LDA
#undef PG8_LDB
#undef PG8_MMA
#undef PG8_WAIT_V
#undef PG8_WAIT_L
#undef PG8_BAR
#undef PG8_SCHED
}
}
namespace mk {
constexpr size_t O_YP = 0, O_YS = 8388608, O_NK = 25165824, O_NV = 33554432, O_S5R = 41943040, O_S5I = 42205184, O_SSD = 42467328,
                 O_MLC = 50855936, O_MLN = 59244544, O_MLM = 59310080;

__device__ __forceinline__ u32x4 pack8(const f32x4 a, const f32x4 b) { u32x4 w; w.x = pk2(a[0], a[1]); w.y = pk2(a[2], a[3]); w.z = pk2(b[0], b[1]); w.w = pk2(b[2], b[3]); return w; }

struct EpiIn {
    static constexpr bool PERM = true;
    bf16_t* proj; float* small; float* out; const float* qg; const float* kg; int layer;
    __device__ __forceinline__ void operator()(const f32x4 (&acc)[2][2][4][2], const Unit& u, int wr, int wc, int fr, int fq) const {
        const int T = u.pn, rowb = u.pm * BM + wr * 64 + fr;
        if (T == 54) {
            if (wc == 0) {
#pragma unroll
                for (int ai = 0; ai < 2; ++ai)
#pragma unroll
                    for (int m = 0; m < 4; ++m) { float* sp = small + (size_t)(rowb + ai * HALF + m * 16) * 32 + 8 * fq; *(f32x4*)sp = acc[ai][0][m][0]; *(f32x4*)(sp + 4) = acc[ai][0][m][1]; }
            }
            return;
        }
        const int colb = T * 256 + 64 * wc + 8 * fq;
        if (T < 4) {
            const float* g = T < 2 ? qg : kg;
            f32x4 gv[2][2];
#pragma unroll
            for (int bj = 0; bj < 2; ++bj)
#pragma unroll
                for (int n = 0; n < 2; ++n) gv[bj][n] = *(const f32x4*)(g + 32 * bj + 8 * fq + 4 * n);
#pragma unroll
            for (int ai = 0; ai < 2; ++ai)
#pragma unroll
                for (int m = 0; m < 4; ++m) {
                    float ss = 0.f;
#pragma unroll
                    for (int bj = 0; bj < 2; ++bj)
#pragma unroll
                        for (int n = 0; n < 2; ++n) { const f32x4 x = acc[ai][bj][m][n]; ss += (x[0] * x[0] + x[1] * x[1]) + (x[2] * x[2] + x[3] * x[3]); }
                    ss += __shfl_xor(ss, 16); ss += __shfl_xor(ss, 32);
                    const float r = rsqrtf(ss * (1.f / 64.f) + 1e-6f);
                    const int row = rowb + ai * HALF + m * 16;
#pragma unroll
                    for (int bj = 0; bj < 2; ++bj) { const f32x4 v0 = acc[ai][bj][m][0] * r * gv[bj][0], v1 = acc[ai][bj][m][1] * r * gv[bj][1];
                        *(u32x4*)(proj + (size_t)row * PJ + colb + 32 * bj) = pack8(v0, v1);
                        if (T >= 2 && row < MP) { float* o = out + O_NK + ((size_t)((row >> 8) * DEPTH + layer) * 256 + (row & 255)) * 512 + (colb - 512) + 32 * bj; *(f32x4*)o = v0; *(f32x4*)(o + 4) = v1; } }
                }
        } else if (T < 6) {
#pragma unroll
            for (int ai = 0; ai < 2; ++ai)
#pragma unroll
                for (int m = 0; m < 4; ++m) { const int row = rowb + ai * HALF + m * 16;
#pragma unroll
                    for (int bj = 0; bj < 2; ++bj) { const f32x4 v0 = acc[ai][bj][m][0], v1 = acc[ai][bj][m][1];
                        *(u32x4*)(proj + (size_t)row * PJ + colb + 32 * bj) = pack8(v0, v1);
                        if (row < MP) { float* o = out + O_NV + ((size_t)((row >> 8) * DEPTH + layer) * 256 + (row & 255)) * 512 + (colb - 1024) + 32 * bj; *(f32x4*)o = v0; *(f32x4*)(o + 4) = v1; } } }
        } else if (T < 22) {
#pragma unroll
            for (int ai = 0; ai < 2; ++ai)
#pragma unroll
                for (int m = 0; m < 4; ++m) { const int row = rowb + ai * HALF + m * 16;
#pragma unroll
                    for (int bj = 0; bj < 2; ++bj) *(u32x4*)(proj + (size_t)row * PJ + colb + 32 * bj) = pack8(acc[ai][bj][m][0], acc[ai][bj][m][1]); }
        } else {
#pragma unroll
            for (int ai = 0; ai < 2; ++ai)
#pragma unroll
                for (int m = 0; m < 4; ++m) { const int row = rowb + ai * HALF + m * 16;
#pragma unroll
                    for (int bj = 0; bj < 2; ++bj) { f32x4 v0 = acc[ai][bj][m][0], v1 = acc[ai][bj][m][1];
#pragma unroll
                        for (int j = 0; j < 4; ++j) { v0[j] = fsigm(v0[j]); v1[j] = fsigm(v1[j]); }
                        *(u32x4*)(proj + (size_t)row * PJ + colb + 32 * bj) = pack8(v0, v1); } }
        }
    }
};
struct EpiRelu2 {
    static constexpr bool PERM = true;
    bf16_t* O; int ldo;
    __device__ __forceinline__ void operator()(const f32x4 (&acc)[2][2][4][2], const Unit& u, int wr, int wc, int fr, int fq) const {
        const int rowb = u.pm * BM + wr * 64 + fr, colb = u.pn * 256 + 64 * wc + 8 * fq;
#pragma unroll
        for (int ai = 0; ai < 2; ++ai)
#pragma unroll
            for (int m = 0; m < 4; ++m) { const int row = rowb + ai * HALF + m * 16;
#pragma unroll
                for (int bj = 0; bj < 2; ++bj) { f32x4 v0 = acc[ai][bj][m][0], v1 = acc[ai][bj][m][1];
#pragma unroll
                    for (int j = 0; j < 4; ++j) { const float a = fmaxf(v0[j], 0.f), b = fmaxf(v1[j], 0.f); v0[j] = a * a; v1[j] = b * b; }
                    *(u32x4*)(O + (size_t)row * ldo + colb + 32 * bj) = pack8(v0, v1); } }
    }
};
struct EpiGlu {
    static constexpr bool PERM = true;
    const bf16_t* Z; const float* bias; bf16_t* br;
    __device__ __forceinline__ void operator()(const f32x4 (&acc)[2][2][4][2], const Unit& u, int wr, int wc, int fr, int fq) const {
        const int rowb = u.pm * BM + wr * 64 + fr, colb = u.pn * 256 + 64 * wc + 8 * fq;
#pragma unroll
        for (int bj = 0; bj < 2; ++bj) { const int c = colb + 32 * bj; const f32x4 b0 = *(const f32x4*)(bias + c), b1 = *(const f32x4*)(bias + c + 4);
#pragma unroll
            for (int ai = 0; ai < 2; ++ai)
#pragma unroll
                for (int m = 0; m < 4; ++m) { const int row = rowb + ai * HALF + m * 16;
                    const u32x4 zz = *(const u32x4*)(Z + (size_t)row * 512 + c);
                    f32x4 v0 = acc[ai][bj][m][0] + b0, v1 = acc[ai][bj][m][1] + b1;
                    v0[0] = bflo(zz.x) * fsigm(v0[0]); v0[1] = bfhi(zz.x) * fsigm(v0[1]); v0[2] = bflo(zz.y) * fsigm(v0[2]); v0[3] = bfhi(zz.y) * fsigm(v0[3]);
                    v1[0] = bflo(zz.z) * fsigm(v1[0]); v1[1] = bfhi(zz.z) * fsigm(v1[1]); v1[2] = bflo(zz.w) * fsigm(v1[2]); v1[3] = bfhi(zz.w) * fsigm(v1[3]);
                    *(u32x4*)(br + (size_t)row * D + 512 + c) = pack8(v0, v1); } }
    }
};
struct EpiBranch {
    static constexpr bool PERM = true;
    const bf16_t* proj; float* macc; bf16_t* merged;
    __device__ __forceinline__ void operator()(const f32x4 (&acc)[2][2][4][2], const Unit& u, int wr, int wc, int fr, int fq) const {
        const int rowb = u.pm * BM + wr * 64 + fr, colb = u.pn * 256 + 64 * wc + 8 * fq, kz = u.kz;
#pragma unroll
        for (int ai = 0; ai < 2; ++ai)
#pragma unroll
            for (int m = 0; m < 4; ++m) { const int row = rowb + ai * HALF + m * 16;
#pragma unroll
                for (int bj = 0; bj < 2; ++bj) { const int c = colb + 32 * bj;
                    const u32x4 gg = *(const u32x4*)(proj + (size_t)row * PJ + P_GATE + kz * D + c);
                    f32x4 v0 = acc[ai][bj][m][0], v1 = acc[ai][bj][m][1];
                    v0[0] *= bflo(gg.x); v0[1] *= bfhi(gg.x); v0[2] *= bflo(gg.y); v0[3] *= bfhi(gg.y); v1[0] *= bflo(gg.z); v1[1] *= bfhi(gg.z); v1[2] *= bflo(gg.w); v1[3] *= bfhi(gg.w);
                    float* mp = macc + (size_t)row * D + c;
                    if (kz > 0) { v0 += *(const f32x4*)mp; v1 += *(const f32x4*)(mp + 4); }
                    if (kz < 3) { *(f32x4*)mp = v0; *(f32x4*)(mp + 4) = v1; }
                    else *(u32x4*)(merged + (size_t)row * D + c) = pack8(v0, v1); } }
    }
};
struct EpiResid {
    static constexpr bool PERM = false;
    const float* xp; const float* xs; const float* modl; int g_off; float* xout;
    __device__ __forceinline__ void operator()(const f32x4 (&acc)[2][2][4][2], const Unit& u, int wr, int wc, int fr, int fq) const {
        const int row0 = u.pm * BM, rowb = row0 + wr * 64 + fr, colb = u.pn * 256 + wc * 32 + 4 * fq;
        const float* xin = row0 < MP ? xp : xs - (size_t)MP * D;
        const float* gate = modl + (size_t)row_cvec(row0) * 6 * D + g_off;
        f32x4 gv[2][2];
#pragma unroll
        for (int bj = 0; bj < 2; ++bj)
#pragma unroll
            for (int n = 0; n < 2; ++n) gv[bj][n] = *(const f32x4*)(gate + colb + bj * HALF + n * 16);
#pragma unroll
        for (int ai = 0; ai < 2; ++ai)
#pragma unroll
            for (int m = 0; m < 4; ++m) { const size_t ro = (size_t)(rowb + ai * HALF + m * 16) * D + colb;
#pragma unroll
                for (int bj = 0; bj < 2; ++bj)
#pragma unroll
                    for (int n = 0; n < 2; ++n) { const size_t o = ro + bj * HALF + n * 16; *(f32x4*)(xout + o) = *(const f32x4*)(xin + o) + gv[bj][n] * acc[ai][bj][m][n]; } }
    }
};
}
namespace mk {
constexpr size_t AL(size_t x) { return (x + 255) & ~(size_t)255; }
constexpr size_t WS_CTL = 0, CTL_BYTES = 65536;
constexpr size_t WS_MOD = WS_CTL + CTL_BYTES;
constexpr size_t WS_W = AL(WS_MOD + (size_t)DEPTH * 5 * 6 * D * 4);
constexpr size_t W_IN = 0, W_GLU = W_IN + (size_t)NIN * D, W_BR = W_GLU + 512 * 512, W_OUT = W_BR + (size_t)4 * D * 512, W_1 = W_OUT + (size_t)D * D, W_2 = W_1 + (size_t)DFF * D,
                 W_LAYER = W_2 + (size_t)D * DFF;
constexpr size_t WS_H = AL(WS_W + W_LAYER * 2 * DEPTH);
constexpr size_t WS_PROJ = AL(WS_H + (size_t)M * D * 2);
constexpr size_t WS_SMALL = AL(WS_PROJ + (size_t)M * PJ * 2);
constexpr size_t WS_BR = AL(WS_SMALL + (size_t)M * 32 * 4);
constexpr size_t WS_MERGED = AL(WS_BR + (size_t)M * D * 2);
constexpr size_t WS_MACC = AL(WS_MERGED + (size_t)M * D * 2);
constexpr size_t WS_ZB = AL(WS_MACC + (size_t)M * D * 4);
constexpr size_t WS_SCR = AL(WS_ZB + (size_t)M * 512 * 2);
constexpr int LDS_BYTES = 140 * 1024, LDS_CTL = LDS_BYTES - 256;

struct Args { const float* in[43]; float* out; unsigned char* ws; int ph_lo, ph_hi; };

__device__ __forceinline__ float wave_sum(float v) {
#pragma unroll
    for (int o = 1; o < 64; o <<= 1) v += __shfl_xor(v, o);
    return v;
}
#define LDS_WAIT() asm volatile("s_waitcnt lgkmcnt(0)" ::: "memory")

__device__ __forceinline__ void xpose_item(const float* W, int ldw, int k0, int sc, bf16_t* dst, int K, LAS float* scr, int lane, int mode) {
    const int j = lane & 31;
    const int col = mode == 1 ? (j < 16 ? 3584 + j : 5648 + (j - 16)) : sc + j;
#pragma unroll 8
    for (int i = 0; i < 32; ++i) { const int kk = 2 * i + (lane >> 5); scr[kk * 33 + j] = mode == 2 ? 0.f : W[(size_t)(k0 + kk) * ldw + col]; }
    LDS_WAIT(); asm volatile("" ::: "memory");
    const int c = lane & 7;
#pragma unroll
    for (int jj = 0; jj < 4; ++jj) { const int n = (lane >> 3) + 8 * jj; const LAS float* s = scr + (8 * c) * 33 + n;
        u32x4 o; o.x = pk2(s[0 * 33], s[1 * 33]); o.y = pk2(s[2 * 33], s[3 * 33]); o.z = pk2(s[4 * 33], s[5 * 33]); o.w = pk2(s[6 * 33], s[7 * 33]);
        *(u32x4*)(dst + (size_t)n * K + k0 + 8 * c) = o; }
    LDS_WAIT(); asm volatile("" ::: "memory");
}
__device__ __forceinline__ int hm_col(int grp) { const int T = grp >> 3, q8 = grp & 7; return 256 * T + 32 * (2 * (q8 & 3) + (q8 >> 2)); }

__device__ __forceinline__ void prologue_convert(const Args& a, LAS unsigned char* lds, int gw, int ngw, int wave, int lane) {
    LAS float* scr = (LAS float*)(lds + wave * 8704);
    bf16_t* WB = (bf16_t*)(a.ws + WS_W);
    constexpr int I_IN = 440 * 32, I_GLU = 16 * 8, I_BR = 4 * 64 * 8, I_OUT = 64 * 32, I_1 = 256 * 32, I_2 = 64 * 128, I_L = I_IN + I_GLU + I_BR + I_OUT + I_1 + I_2;
    for (int it = gw; it < I_L * DEPTH; it += ngw) {
        const int l = it / I_L; int r = it - l * I_L; bf16_t* wl = WB + (size_t)l * W_LAYER;
        if (r < I_IN) { const int kb = r / 440, grp = r % 440, T = grp >> 3; int sc = hm_col(grp), mode = 0;
            if (T == 54) mode = (grp & 7) == 0 ? 1 : 2; else if (T >= 22) sc += 32; else if (T >= 14) sc += 16;
            xpose_item(a.in[16] + (size_t)l * D * 13856, 13856, 64 * kb, sc, wl + W_IN + (size_t)(32 * grp) * D, D, scr, lane, mode); continue; } r -= I_IN;
        if (r < I_GLU) { const int kb = r / 16, grp = r % 16; xpose_item(a.in[28] + (size_t)l * 512 * 512, 512, 64 * kb, hm_col(grp), wl + W_GLU + (size_t)(32 * grp) * 512, 512, scr, lane, 0); continue; } r -= I_GLU;
        if (r < I_BR) { const int k = r / 512, r2 = r % 512, kb = r2 / 64, grp = r2 % 64;
            xpose_item(a.in[39] + ((size_t)l * 4 + k) * 512 * D, D, 64 * kb, hm_col(grp), wl + W_BR + (size_t)k * D * 512 + (size_t)(32 * grp) * 512, 512, scr, lane, 0); continue; } r -= I_BR;
        if (r < I_OUT) { const int kb = r / 64, grp = r % 64; xpose_item(a.in[40] + (size_t)l * D * D, D, 64 * kb, 32 * grp, wl + W_OUT + (size_t)(32 * grp) * D, D, scr, lane, 0); continue; } r -= I_OUT;
        if (r < I_1) { const int kb = r / 256, grp = r % 256; xpose_item(a.in[41] + (size_t)l * D * DFF, DFF, 64 * kb, hm_col(grp), wl + W_1 + (size_t)(32 * grp) * D, D, scr, lane, 0); continue; } r -= I_1;
        { const int kb = r / 64, grp = r % 64; xpose_item(a.in[42] + (size_t)l * DFF * D, D, 64 * kb, 32 * grp, wl + W_2 + (size_t)(32 * grp) * DFF, DFF, scr, lane, 0); }
    }
}
__device__ __forceinline__ void prologue_ada(const Args& a, LAS unsigned char* lds, int tid) {
    LAS float* sl = (LAS float*)lds;
    LAS float* red = (LAS float*)(lds + 40960);
    float* mod = (float*)(a.ws + WS_MOD);
    for (int i = tid; i < 5 * D; i += NT) { const int j = i / D, k = i % D; const float x = j == 0 ? a.in[11][k] : a.in[10][(j - 1) * D + k]; sl[i] = x / (1.f + __expf(-x)); }
    __syncthreads();
    const int ks = tid >> 6, c = tid & 63;
    for (int unit = blockIdx.x; unit < DEPTH * 6 * D / 64; unit += gridDim.x) {
        const int l = unit / (6 * D / 64), n0 = (unit % (6 * D / 64)) * 64;
        const float* w = a.in[12] + (size_t)l * D * 6 * D + n0 + c;
        float acc[5] = {0.f, 0.f, 0.f, 0.f, 0.f};
#pragma unroll 4
        for (int k = ks * 256; k < ks * 256 + 256; ++k) { const float wv = w[(size_t)k * 6 * D];
#pragma unroll
            for (int j = 0; j < 5; ++j) acc[j] += sl[j * D + k] * wv; }
#pragma unroll
        for (int j = 0; j < 5; ++j) red[(ks * 5 + j) * 64 + c] = acc[j];
        __syncthreads();
        if (tid < 320) { const int j = tid >> 6; float s = 0.f;
#pragma unroll
            for (int q = 0; q < 8; ++q) s += red[(q * 5 + j) * 64 + c];
            mod[((size_t)l * 5 + j) * 6 * D + n0 + c] = s + a.in[13][l * 6 * D + n0 + c]; }
        __syncthreads();
    }
}
__device__ __forceinline__ void norm_phase(const float* xp, const float* xs, const float* g, const float* modl, int sh_off, int sc_off, bf16_t* H, int gw, int ngw, int lane_) {
    int lane = lane_; asm volatile("" : "+v"(lane));
    for (int row = gw; row < M; row += ngw) {
        const float* x = row < MP ? xp + (size_t)row * D : xs + (size_t)(row - MP) * D;
        f32x4 v[8]; float ss = 0.f;
#pragma unroll
        for (int j = 0; j < 8; ++j) { v[j] = *(const f32x4*)(x + 4 * (lane + 64 * j)); ss += (v[j][0] * v[j][0] + v[j][1] * v[j][1]) + (v[j][2] * v[j][2] + v[j][3] * v[j][3]); }
        const float r = rsqrtf(wave_sum(ss) * (1.f / D) + 1e-6f);
        const float* md = modl + (size_t)row_cvec(row) * 6 * D;
#pragma unroll
        for (int j = 0; j < 8; ++j) { const int i = 4 * (lane + 64 * j);
            const f32x4 gg = *(const f32x4*)(g + i), sc = *(const f32x4*)(md + sc_off + i), sh = *(const f32x4*)(md + sh_off + i);
            const f32x4 o = v[j] * r * gg * (sc + 1.f) + sh;
            u32x2 w; w.x = pk2(o[0], o[1]); w.y = pk2(o[2], o[3]); *(u32x2*)(H + (size_t)row * D + i) = w; }
    }
}

}
namespace mk {
constexpr int C_Q = 0, C_K = 512, C_V = 1024, C_S5U = 1536, C_Z = 2048, C_XBC = 2560, C_DT = 3584, C_MQ = 3600, C_MK = 4112, C_MV = 4624, C_MO = 5136, C_MI = 5648, C_MF = 5656;
constexpr int NSEQ = 20;
struct PJA {
    const bf16_t* p; const float* sm;
    __device__ __forceinline__ float operator()(int row, int col) const {
        if (col < 3584) return bf2f(p[(size_t)row * PJ + col]);
        if (col < 3600) return sm[(size_t)row * 32 + col - 3584];
        if (col < 5648) return bf2f(p[(size_t)row * PJ + col - 16]);
        if (col < 5664) return sm[(size_t)row * 32 + 16 + col - 5648];
        return bf2f(p[(size_t)row * PJ + col - 32]);
    }
};
__device__ __forceinline__ void seq_info(int sq, int& row0, int& L, int& lat, int& b) {
    if (sq < 16) { row0 = sq * 256; L = 256; lat = 0; b = sq; } else { b = sq - 16; row0 = MP + b * 2048; L = 2048; lat = 1; }
}
__device__ __forceinline__ float nsilu(float x) { return x / (1.f + expf(-x)); }
__device__ __forceinline__ float nsigm(float x) { return 1.f / (1.f + expf(-x)); }
__device__ __forceinline__ float nsoftplus(float x) { return x > 20.f ? x : log1pf(expf(x)); }
__device__ __forceinline__ float ngelu(float x) { return 0.5f * x * (1.f + tanhf(0.7978845608028654f * (x + 0.044715f * x * x * x))); }

__device__ __forceinline__ void nv_attn_dense(const PJA& proj, bf16_t* br, int idx) {
    const int hh = idx % 8, row = idx / 8, b = row / 256;
    float q[64], o[64];
#pragma unroll
    for (int i = 0; i < 64; ++i) { q[i] = proj(row, C_Q + hh * 64 + i); o[i] = 0.f; }
    float mx = -1e30f, sum = 0.f;
    for (int s = 0; s < 256; ++s) { const int kr_ = b * 256 + s;
        float sc = 0;
#pragma unroll
        for (int i = 0; i < 64; ++i) sc += q[i] * proj(kr_, C_K + hh * 64 + i);
        sc *= 0.125f;
        const float mn = fmaxf(mx, sc), a = expf(mx - mn), p = expf(sc - mn); sum = sum * a + p;
#pragma unroll
        for (int i = 0; i < 64; ++i) o[i] = o[i] * a + p * proj(kr_, C_V + hh * 64 + i);
        mx = mn; }
#pragma unroll
    for (int i = 0; i < 64; ++i) br[(size_t)row * D + hh * 64 + i] = f2bf(o[i] / sum);
}
__device__ __forceinline__ void nv_attn_na(const PJA& proj, const float* ck, const float* cv, const float* rpb, int layer, bf16_t* br, int idx) {
    const int hh = idx % 8, lt = idx / 8, b = lt / 2048, t = lt % 2048, r = t / 64, c = t % 64;
    const int row = MP + lt; float q[64], o[64];
#pragma unroll
    for (int i = 0; i < 64; ++i) { q[i] = proj(row, C_Q + hh * 64 + i); o[i] = 0.f; }
    const int rs = min(max(r - 4, 0), 32 - 8), cs = min(max(c - 8, 0), 64 - 16);
    float mx = -1e30f, sum = 0.f;
    for (int j = 0; j < 8; ++j) for (int w = 0; w < 16; ++w) { const int kr = rs + j, kc = cs + w; const int krow = MP + b * 2048 + kr * 64 + kc;
        float sc = 0;
#pragma unroll
        for (int i = 0; i < 64; ++i) sc += q[i] * proj(krow, C_K + hh * 64 + i);
        sc = sc * 0.125f + rpb[(hh * 15 + (kr - r + 7)) * 31 + (kc - c + 15)];
        const float mn = fmaxf(mx, sc), a = expf(mx - mn), p = expf(sc - mn); sum = sum * a + p;
#pragma unroll
        for (int i = 0; i < 64; ++i) o[i] = o[i] * a + p * proj(krow, C_V + hh * 64 + i);
        mx = mn; }
    for (int s = 0; s < 512; ++s) { const size_t off = ((((size_t)b * DEPTH + layer) * 512 + s) * 8 + hh) * 64; const float* kp = ck + off; const float* vp = cv + off;
        float sc = 0;
#pragma unroll
        for (int i = 0; i < 64; ++i) sc += q[i] * kp[i];
        sc *= 0.125f;
        const float mn = fmaxf(mx, sc), a = expf(mx - mn), p = expf(sc - mn); sum = sum * a + p;
#pragma unroll
        for (int i = 0; i < 64; ++i) o[i] = o[i] * a + p * vp[i];
        mx = mn; }
#pragma unroll
    for (int i = 0; i < 64; ++i) br[(size_t)row * D + hh * 64 + i] = f2bf(o[i] / sum);
}
__device__ __forceinline__ void nv_s5(const PJA& proj, const Args& a, int layer, float* ys5, float* out, int wid, int n) {
    const int dir = wid % 2, g = (wid / 2) % 32, sq = wid / 64;
    int row0, L, lat, b; seq_info(sq, row0, L, lat, b);
    const float* a_re = a.in[20] + layer * 4096; const float* a_im = a.in[21] + layer * 4096; const float* log_dt = a.in[22] + layer * 64;
    const float* b_re = a.in[23] + (size_t)layer * 65536; const float* b_im = a.in[24] + (size_t)layer * 65536; const float* c_re = a.in[25] + (size_t)layer * 65536; const float* c_im = a.in[26] + (size_t)layer * 65536;
    const int pi = (dir * 32 + g) * 64 + n;
    const float are = fminf(a_re[pi], -1e-4f), aim = a_im[pi], dt = expf(log_dt[dir * 32 + g]);
    const float mag = expf(dt * are), abr = mag * cosf(dt * aim), abi = mag * sinf(dt * aim);
    const float den = are * are + aim * aim, nr = abr - 1.f, cfr = (nr * are + abi * aim) / den, cfi = (abi * are - nr * aim) / den;
    float bbr[16], bbi[16], cr[16], ci[16];
#pragma unroll
    for (int k = 0; k < 16; ++k) { const float br_ = b_re[(size_t)pi * 16 + k], bi_ = b_im[(size_t)pi * 16 + k]; bbr[k] = cfr * br_ - cfi * bi_; bbi[k] = cfr * bi_ + cfi * br_;
        cr[k] = c_re[((size_t)(dir * 32 + g) * 16 + k) * 64 + n]; ci[k] = c_im[((size_t)(dir * 32 + g) * 16 + k) * 64 + n]; }
    float hr = 0.f, hi = 0.f;
    if (lat) { const size_t so = ((((size_t)b * DEPTH + layer) * 2 + dir) * 32 + g) * 64 + n; hr = a.in[4][so]; hi = a.in[5][so]; }
    for (int s = 0; s < L; ++s) { const int t = dir ? L - 1 - s : s;
        float bur = 0, bui = 0;
#pragma unroll
        for (int k = 0; k < 16; ++k) { const float uv = proj(row0 + t, C_S5U + g * 16 + k); bur += uv * bbr[k]; bui += uv * bbi[k]; }
        const float nhr = abr * hr - abi * hi + bur, nhi = abr * hi + abi * hr + bui; hr = nhr; hi = nhi;
        float myy = 0.f;
#pragma unroll
        for (int k = 0; k < 16; ++k) { float v = hr * cr[k] - hi * ci[k];
#pragma unroll
            for (int o = 32; o > 0; o >>= 1) v += __shfl_xor(v, o);
            if (n == k) myy = v; }
        if (n < 16) ys5[((size_t)dir * M + row0 + t) * 512 + g * 16 + n] = myy; }
    if (!lat) { const size_t oo = ((((size_t)b * DEPTH + layer) * 2 + dir) * 32 + g) * 64 + n; out[O_S5R + oo] = hr; out[O_S5I + oo] = hi; }
}
__device__ __forceinline__ void nv_ssd_seq(const PJA& proj, const float* xbc, const Args& a, int layer, float* yssd, float* out, int wid, int p) {
    const int dir = wid % 2, hh = (wid / 2) % 8, sq = wid / 16;
    int row0, L, lat, b; seq_info(sq, row0, L, lat, b);
    float h[128];
    if (lat) { const float* sp = a.in[6] + (((((size_t)b * DEPTH + layer) * 2 + dir) * 8 + hh) * 64 + p) * 128;
#pragma unroll
        for (int n = 0; n < 128; ++n) h[n] = sp[n]; }
    else {
#pragma unroll
        for (int n = 0; n < 128; ++n) h[n] = 0.f; }
    const float A = -expf(a.in[33][layer * 16 + dir * 8 + hh]), dtb = a.in[32][layer * 16 + dir * 8 + hh]; const int grp = hh / 4;
    for (int s = 0; s < L; ++s) { const int t = dir ? L - 1 - s : s; const int row = row0 + t;
        const float dt = nsoftplus(proj(row, C_DT + dir * 8 + hh) + dtb), dec = expf(dt * A);
        const float xd = xbc[(size_t)row * 1024 + hh * 64 + p] * dt;
        const float* Bv = xbc + (size_t)row * 1024 + 512 + grp * 128; const float* Cv = xbc + (size_t)row * 1024 + 768 + grp * 128;
        float y = 0.f;
#pragma unroll
        for (int n = 0; n < 128; ++n) { h[n] = dec * h[n] + Bv[n] * xd; y += Cv[n] * h[n]; }
        yssd[((size_t)dir * M + row) * 512 + hh * 64 + p] = y; }
    if (!lat) { float* op = out + O_SSD + (((((size_t)b * DEPTH + layer) * 2 + dir) * 8 + hh) * 64 + p) * 128;
#pragma unroll
        for (int n = 0; n < 128; ++n) op[n] = h[n]; }
}
struct MixScr { float* xbc; float* ys5; float* yssd; float* yml; float* qr; float* kr; };
__device__ __forceinline__ MixScr mix_scr(unsigned char* ws) { MixScr s; s.xbc = (float*)(ws + WS_SCR); s.ys5 = s.xbc + (size_t)M * 1024; s.yssd = s.ys5 + (size_t)2 * M * 512; s.yml = s.yssd + (size_t)2 * M * 512;
    s.qr = s.yml + (size_t)2 * M * 512; s.kr = s.qr + (size_t)M * 512; return s; }

__device__ __forceinline__ void nmix_a(const Args& a, int layer, int gw_, int ngw, int lane_) {
    int lane = lane_, gw = gw_; asm volatile("" : "+v"(lane));
    const PJA proj{(const bf16_t*)(a.ws + WS_PROJ), (const float*)(a.ws + WS_SMALL)}; bf16_t* BR = (bf16_t*)(a.ws + WS_BR); const MixScr sc = mix_scr(a.ws);
    for (int it = gw; it < 1280; it += ngw) {
        if (it < 256) nv_s5(proj, a, layer, sc.ys5, a.out, 1024 + it, lane);
        else nv_s5(proj, a, layer, sc.ys5, a.out, it - 256, lane);
    }
}
__device__ __forceinline__ void nmix_b(const Args& a, int layer, LAS unsigned char* lds, int tid_, int G) {
    int tid = tid_; asm volatile("" : "+v"(tid));
    const int lane = tid & 63, wave = __builtin_amdgcn_readfirstlane(tid >> 6), blk = blockIdx.x;
    const PJA proj{(const bf16_t*)(a.ws + WS_PROJ), (const float*)(a.ws + WS_SMALL)}; const MixScr sc = mix_scr(a.ws);
    {
        bf16_t* ZB = (bf16_t*)(a.ws + WS_ZB); const float* s5d = a.in[27] + layer * 512; const int nb_ = G;
        for (size_t idx = (size_t)blk * NT + tid; idx < (size_t)M * 512; idx += (size_t)nb_ * NT) { const int row = idx / 512, cidx = idx % 512;
            const float y = sc.ys5[idx] + sc.ys5[(size_t)M * 512 + idx] + proj(row, C_S5U + cidx) * s5d[cidx]; ZB[idx] = f2bf(ngelu(y)); }
    }
}
__device__ __forceinline__ void nmix_c(const Args& a, int layer, int gw, int ngw, int lane_) {
    int lane = lane_; asm volatile("" : "+v"(lane));
    const PJA proj{(const bf16_t*)(a.ws + WS_PROJ), (const float*)(a.ws + WS_SMALL)}; bf16_t* BR = (bf16_t*)(a.ws + WS_BR); const MixScr sc = mix_scr(a.ws);
    const float* ssd_d = a.in[34] + layer * 8; const float* sng = a.in[35] + layer * 512; const float* mng = a.in[38] + layer * 512;
    for (int row = gw; row < M; row += ngw) {
        float v[8]; float ss = 0.f;
#pragma unroll
        for (int i = 0; i < 8; ++i) { const int ch = lane + 64 * i; float y = sc.yssd[(size_t)row * 512 + ch] + sc.yssd[((size_t)M + row) * 512 + ch] + sc.xbc[(size_t)row * 1024 + ch] * ssd_d[ch / 64];
            y *= nsilu(proj(row, C_Z + ch)); v[i] = y; ss += y * y; }
        const float r = rsqrtf(wave_sum(ss) * (1.f / 512.f) + 1e-6f);
#pragma unroll
        for (int i = 0; i < 8; ++i) { const int ch = lane + 64 * i; BR[(size_t)row * D + 1024 + ch] = f2bf(v[i] * r * sng[ch]); }
    }
}
}
namespace mk {
constexpr size_t WS_NAT = AL(WS_SCR + (size_t)M * (1024 + 6 * 512 + 2 * 512) * 4);
constexpr int NATP = 2048, N_XBC = 0, N_Q = 1024, N_K = 1536;
constexpr size_t WS_TR = AL(WS_NAT + (size_t)M * NATP * 2);
constexpr int T_X = 0, T_B = 512, T_K = 768, T_MV = 1280, T_V = 1792, TRR = 2304;
constexpr int NCH = 96;
constexpr size_t WS_MLC = AL(WS_TR + (size_t)TRR * M * 2);
constexpr size_t WS_MLN = AL(WS_MLC + (size_t)NCH * 4 * 2 * 16384 * 4);
constexpr size_t WS_MLS = AL(WS_MLN + (size_t)NCH * 4 * 2 * 128 * 4);
constexpr size_t WS_MLCS = AL(WS_MLS + (size_t)NCH * 4 * 2 * 4 * 4);
constexpr size_t WS_MLNS = AL(WS_MLCS + (size_t)NCH * 4 * 2 * 16384 * 2);
constexpr size_t WS_MLMS = AL(WS_MLNS + (size_t)NCH * 4 * 2 * 128 * 4);
constexpr size_t WS_OPT_END = AL(WS_MLMS + (size_t)NCH * 4 * 2 * 4);

__device__ __forceinline__ f32x4 mfma16(bf16x8 a, bf16x8 b, f32x4 c) { return __builtin_amdgcn_mfma_f32_16x16x32_bf16(a, b, c, 0, 0, 0); }
__device__ __forceinline__ void chunk_info(int ch, int& row0, int& seq0, int& L, int& lat, int& b, int& ci, int& nc) {
    if (ch < 32) { b = ch >> 1; ci = ch & 1; nc = 2; seq0 = b * 256; L = 256; lat = 0; } else { const int c2 = ch - 32; b = c2 >> 4; ci = c2 & 15; nc = 16; seq0 = MP + b * 2048; L = 2048; lat = 1; }
    row0 = seq0 + ci * 128;
}
__device__ __forceinline__ float fast_exp(float x) { return __expf(x); }

__device__ __forceinline__ void prep_phase(const Args& a, int layer, LAS unsigned char* lds, int gw_, int ngw, int wave, int lane_) {
    int lane = lane_, gw = gw_; asm volatile("" : "+v"(lane));
    const bf16_t* PROJ = (const bf16_t*)(a.ws + WS_PROJ); bf16_t* NAT = (bf16_t*)(a.ws + WS_NAT); bf16_t* TR = (bf16_t*)(a.ws + WS_TR);
    LAS bf16_t* tile = (LAS bf16_t*)(lds + wave * 16896); LAS bf16_t* otile = tile + 68 * 64;
    const int c = lane & 7, r8 = lane >> 3;
    const float* cw = a.in[30] + layer * 5 * 1024; const float* cb = a.in[31] + layer * 1024;
    for (int u = gw; u < 48 * 192; u += ngw) {
        const int cg = u / 192, tt = u % 192, m0 = tt * 64;
        const int lat = m0 >= MP; const int seq0 = lat ? MP + ((m0 - MP) / 2048) * 2048 : (m0 / 256) * 256, L = lat ? 2048 : 256, t0 = m0 - seq0;
        int kind, src, natcol = -1, trrow = -1;
        if (cg < 16) { kind = 0; src = P_XBC + 64 * cg; natcol = N_XBC + 64 * cg; if (cg < 12) trrow = T_X + 64 * cg; }
        else if (cg < 24) { kind = 1; src = P_MQ + 64 * (cg - 16); natcol = N_Q + 64 * (cg - 16); }
        else if (cg < 32) { kind = 2; src = P_MK + 64 * (cg - 24); natcol = N_K + 64 * (cg - 24); trrow = T_K + 64 * (cg - 24); }
        else if (cg < 40) { kind = 3; src = P_MV + 64 * (cg - 32); trrow = T_MV + 64 * (cg - 32); }
        else { kind = 3; src = P_V + 64 * (cg - 40); trrow = T_V + 64 * (cg - 40); }
        const int roff = kind == 0 ? -2 : 0, nrows = kind == 0 ? 68 : 64;
#pragma unroll
        for (int i = 0; i < 9; ++i) { const int r = r8 + 8 * i; if (r < nrows) { const int t = t0 + r + roff; u32x4 v = {0u, 0u, 0u, 0u};
                if (t >= 0 && t < L) v = *(const u32x4*)(PROJ + (size_t)(seq0 + t) * PJ + src + 8 * c);
                *(LAS u32x4*)(tile + r * 64 + 8 * c) = v; } }
        LDS_WAIT(); asm volatile("" ::: "memory");
#define PREP_EMIT(i_, r_) do { if (natcol >= 0) *(u32x4*)(NAT + (size_t)(m0 + r8 + 8 * (i_)) * NATP + natcol + 8 * c) = (r_); if (trrow >= 0) *(LAS u32x4*)(otile + (r8 + 8 * (i_)) * 64 + 8 * c) = (r_); } while (0)
        if (kind == 0) {
            float w[5][8], bz[8];
#pragma unroll
            for (int e = 0; e < 8; ++e) { bz[e] = cb[64 * cg + 8 * c + e];
#pragma unroll
                for (int j = 0; j < 5; ++j) w[j][e] = cw[j * 1024 + 64 * cg + 8 * c + e]; }
#pragma unroll 2
            for (int i = 0; i < 8; ++i) { const int tk = r8 + 8 * i; float acc[8];
#pragma unroll
                for (int e = 0; e < 8; ++e) acc[e] = bz[e];
#pragma unroll
                for (int j = 0; j < 5; ++j) { const u32x4 v = *(const LAS u32x4*)(tile + (tk + j) * 64 + 8 * c);
                    acc[0] += bflo(v.x) * w[j][0]; acc[1] += bfhi(v.x) * w[j][1]; acc[2] += bflo(v.y) * w[j][2]; acc[3] += bfhi(v.y) * w[j][3];
                    acc[4] += bflo(v.z) * w[j][4]; acc[5] += bfhi(v.z) * w[j][5]; acc[6] += bflo(v.w) * w[j][6]; acc[7] += bfhi(v.w) * w[j][7]; }
#pragma unroll
                for (int e = 0; e < 8; ++e) acc[e] = fsilu(acc[e]);
                u32x4 rv; rv.x = pk2(acc[0], acc[1]); rv.y = pk2(acc[2], acc[3]); rv.z = pk2(acc[4], acc[5]); rv.w = pk2(acc[6], acc[7]); PREP_EMIT(i, rv); }
        } else if (kind == 3 || !lat) {
            const float sc = kind == 2 ? 0.08838834764831845f : 1.f;
#pragma unroll
            for (int i = 0; i < 8; ++i) { const u32x4 v = *(const LAS u32x4*)(tile + (r8 + 8 * i) * 64 + 8 * c);
                u32x4 rv = v;
                if (kind == 2) { rv.x = pk2(bflo(v.x) * sc, bfhi(v.x) * sc); rv.y = pk2(bflo(v.y) * sc, bfhi(v.y) * sc); rv.z = pk2(bflo(v.z) * sc, bfhi(v.z) * sc); rv.w = pk2(bflo(v.w) * sc, bfhi(v.w) * sc); }
                PREP_EMIT(i, rv); }
        } else {
            const float sc = kind == 2 ? 0.08838834764831845f : 1.f; const int odd = cg & 1;
            float inv[8];
#pragma unroll
            for (int e = 0; e < 8; ++e) inv[e] = exp2f(-(float)(8 * (c & 3) + e) * (13.287712379549449f / 32.f));
#pragma unroll
            for (int i = 0; i < 8; ++i) { const int tk = r8 + 8 * i, t = t0 + tk; const float pos = odd ? (float)(t & 63) : (float)(t >> 6);
                const u32x4 vo = *(const LAS u32x4*)(tile + tk * 64 + 8 * c), vp = *(const LAS u32x4*)(tile + tk * 64 + 8 * (c ^ 4));
                float o[8], p[8], rr[8];
                o[0] = bflo(vo.x); o[1] = bfhi(vo.x); o[2] = bflo(vo.y); o[3] = bfhi(vo.y); o[4] = bflo(vo.z); o[5] = bfhi(vo.z); o[6] = bflo(vo.w); o[7] = bfhi(vo.w);
                p[0] = bflo(vp.x); p[1] = bfhi(vp.x); p[2] = bflo(vp.y); p[3] = bfhi(vp.y); p[4] = bflo(vp.z); p[5] = bfhi(vp.z); p[6] = bflo(vp.w); p[7] = bfhi(vp.w);
#pragma unroll
                for (int e = 0; e < 8; ++e) { const float ang = pos * inv[e], cs = __cosf(ang), sn = __sinf(ang);
                    rr[e] = (c < 4 ? o[e] * cs - p[e] * sn : p[e] * sn + o[e] * cs) * sc; }
                u32x4 rv; rv.x = pk2(rr[0], rr[1]); rv.y = pk2(rr[2], rr[3]); rv.z = pk2(rr[4], rr[5]); rv.w = pk2(rr[6], rr[7]); PREP_EMIT(i, rv); }
        }
        if (trrow >= 0) {
            LDS_WAIT(); asm volatile("" ::: "memory");
            bf16_t* dst = TR + (size_t)(trrow + lane) * M + m0;
#pragma unroll
            for (int j = 0; j < 8; ++j) { unsigned wv[4];
#pragma unroll
                for (int q = 0; q < 4; ++q) { const unsigned lo = otile[(8 * j + 2 * q) * 64 + lane], hi = otile[(8 * j + 2 * q + 1) * 64 + lane]; wv[q] = lo | (hi << 16); }
                u32x4 o; o.x = wv[0]; o.y = wv[1]; o.z = wv[2]; o.w = wv[3]; *(u32x4*)(dst + 8 * j) = o; }
        }
        LDS_WAIT(); asm volatile("" ::: "memory");
    }
}

struct MlGate { float lf0, lf1, ig0, ig1, P0, P1, tot; };
__device__ __forceinline__ float wave_incl_scan(float v, int lane) {
#pragma unroll
    for (int o = 1; o < 64; o <<= 1) { const float t = __shfl_up(v, o); if (lane >= o) v += t; }
    return v;
}
__device__ __forceinline__ float wave_max(float v) {
#pragma unroll
    for (int o = 1; o < 64; o <<= 1) v = fmaxf(v, __shfl_xor(v, o));
    return v;
}
__device__ __forceinline__ MlGate ml_gates(const Args& a, int layer, int row0, int hh, int dir, int lane) {
    const float* SMALL = (const float*)(a.ws + WS_SMALL);
    const float ib = a.in[36][layer * 8 + dir * 4 + hh], fb = a.in[37][layer * 8 + dir * 4 + hh];
    MlGate g;
    const float f0 = SMALL[(size_t)(row0 + lane) * 32 + S_MF + dir * 4 + hh] + fb, f1 = SMALL[(size_t)(row0 + lane + 64) * 32 + S_MF + dir * 4 + hh] + fb;
    g.ig0 = SMALL[(size_t)(row0 + lane) * 32 + S_MI + dir * 4 + hh] + ib; g.ig1 = SMALL[(size_t)(row0 + lane + 64) * 32 + S_MI + dir * 4 + hh] + ib;
    g.lf0 = fminf(f0, 0.f) - log1pf(__expf(-fabsf(f0))); g.lf1 = fminf(f1, 0.f) - log1pf(__expf(-fabsf(f1)));
    const float s0 = wave_incl_scan(g.lf0, lane); const float tot0 = __shfl(s0, 63);
    const float s1 = wave_incl_scan(g.lf1, lane) + tot0;
    g.P0 = s0; g.P1 = s1; g.tot = __shfl(s1, 63);
    return g;
}

__device__ __forceinline__ void ml_states_phase(const Args& a, int layer, int tid_, int G) {
    int tid = tid_; asm volatile("" : "+v"(tid));
    const int lane = tid & 63, wave = __builtin_amdgcn_readfirstlane(tid >> 6), fr = lane & 15, fq = lane >> 4;
    const bf16_t* TR = (const bf16_t*)(a.ws + WS_TR);
    float* MLC = (float*)(a.ws + WS_MLC); float* MLN = (float*)(a.ws + WS_MLN); float* MLS = (float*)(a.ws + WS_MLS);
    for (int u = blockIdx.x; u < NCH * 4; u += G) {
        const int ch = u >> 2, hh = u & 3; int row0, seq0, L, lat, b, ci, nc; chunk_info(ch, row0, seq0, L, lat, b, ci, nc);
#pragma unroll
        for (int dir = 0; dir < 2; ++dir) {
            const MlGate g = ml_gates(a, layer, row0, hh, dir, lane);
            const float w0 = (dir == 0 ? g.tot - g.P0 : g.P0 - g.lf0) + g.ig0, w1 = (dir == 0 ? g.tot - g.P1 : g.P1 - g.lf1) + g.ig1;
            const float mloc = wave_max(fmaxf(w0, w1));
            const float e0 = __expf(w0 - mloc), e1 = __expf(w1 - mloc);
            f32x4 acc[8];
#pragma unroll
            for (int j = 0; j < 8; ++j) acc[j] = (f32x4){0.f, 0.f, 0.f, 0.f};
            float nacc[8];
#pragma unroll
            for (int j = 0; j < 8; ++j) nacc[j] = 0.f;
            const bf16_t* vrow = TR + (size_t)(T_MV + hh * 128 + wave * 16 + fr) * M + row0 + 8 * fq;
#pragma unroll
            for (int ks = 0; ks < 4; ++ks) {
                const bf16x8 af = *(const bf16x8*)(vrow + 32 * ks);
                float ev[8];
#pragma unroll
                for (int j = 0; j < 8; ++j) { const int tok = 32 * ks + 8 * fq + j; const float x0 = __shfl(e0, tok & 63), x1 = __shfl(e1, tok & 63); ev[j] = tok < 64 ? x0 : x1; }
#pragma unroll
                for (int jt = 0; jt < 8; ++jt) {
                    const u32x4 kv = *(const u32x4*)(TR + (size_t)(T_K + hh * 128 + jt * 16 + fr) * M + row0 + 32 * ks + 8 * fq);
                    const float k0 = bflo(kv.x) * ev[0], k1 = bfhi(kv.x) * ev[1], k2 = bflo(kv.y) * ev[2], k3 = bfhi(kv.y) * ev[3], k4 = bflo(kv.z) * ev[4], k5 = bfhi(kv.z) * ev[5], k6 = bflo(kv.w) * ev[6], k7 = bfhi(kv.w) * ev[7];
                    if (wave == 0) nacc[jt] += ((k0 + k1) + (k2 + k3)) + ((k4 + k5) + (k6 + k7));
                    u32x4 kb; kb.x = pk2(k0, k1); kb.y = pk2(k2, k3); kb.z = pk2(k4, k5); kb.w = pk2(k6, k7);
                    acc[jt] = mfma16(af, __builtin_bit_cast(bf16x8, kb), acc[jt]);
                }
            }
            float* cdst = MLC + ((size_t)(ch * 4 + hh) * 2 + dir) * 16384;
#pragma unroll
            for (int jt = 0; jt < 8; ++jt)
#pragma unroll
                for (int i = 0; i < 4; ++i) cdst[(size_t)(wave * 16 + 4 * fq + i) * 128 + jt * 16 + fr] = acc[jt][i];
            if (wave == 0) {
#pragma unroll
                for (int jt = 0; jt < 8; ++jt) { float v = nacc[jt]; v += __shfl_xor(v, 16); v += __shfl_xor(v, 32); if (fq == 0) MLN[((size_t)(ch * 4 + hh) * 2 + dir) * 128 + jt * 16 + fr] = v; }
                if (lane == 0) { MLS[((size_t)(ch * 4 + hh) * 2 + dir) * 4 + 0] = mloc; MLS[((size_t)(ch * 4 + hh) * 2 + dir) * 4 + 1] = g.tot; }
            }
        }
    }
}
__device__ __forceinline__ void ml_scan_phase(const Args& a, int layer, int tid_, int G) {
    int tid = tid_; asm volatile("" : "+v"(tid));
    const float* MLC = (const float*)(a.ws + WS_MLC); const float* MLN = (const float*)(a.ws + WS_MLN); const float* MLS = (const float*)(a.ws + WS_MLS);
    bf16_t* CS = (bf16_t*)(a.ws + WS_MLCS); float* NS = (float*)(a.ws + WS_MLNS); float* MS = (float*)(a.ws + WS_MLMS);
    for (int task = blockIdx.x; task < 256; task += G) {
        int lat, b, hh, dir, part, nparts;
        if (task < 128) { lat = 1; part = task & 3; dir = (task >> 2) & 1; hh = (task >> 3) & 3; b = task >> 5; nparts = 4; }
        else { const int t2 = task - 128; lat = 0; part = 0; dir = t2 & 1; hh = (t2 >> 1) & 3; b = t2 >> 3; nparts = 1; }
        const int nc = lat ? 16 : 2, ch0 = lat ? 32 + b * 16 : b * 2;
        const int nel = 16384 / nparts, e0 = part * nel, per = nel / NT;
        float c[32]; float n = 0.f, m = 0.f;
        const size_t so = (((size_t)b * DEPTH + layer) * 2 + dir) * 4 + hh;
#pragma unroll
        for (int i = 0; i < 32; ++i) if (i < per) { const int e = e0 + i * NT + tid, vd = e >> 7, kd = e & 127; c[i] = lat ? a.in[7][(so * 128 + kd) * 128 + vd] : 0.f; }
        if (tid < 128) n = lat ? a.in[8][so * 128 + tid] : 0.f;
        m = lat ? a.in[9][so] : 0.f;
        for (int s = 0; s < nc; ++s) { const int ci = dir ? nc - 1 - s : s, ch = ch0 + ci; const size_t sb = (size_t)(ch * 4 + hh) * 2 + dir;
#pragma unroll
            for (int i = 0; i < 32; ++i) if (i < per) CS[sb * 16384 + e0 + i * NT + tid] = f2bf(c[i]);
            if (part == 0) { if (tid < 128) NS[sb * 128 + tid] = n; if (tid == 0) MS[sb] = m; }
            const float ml = MLS[sb * 4 + 0], bl = MLS[sb * 4 + 1];
            const float mn = fmaxf(bl + m, ml), fa = __expf(bl + m - mn), fb = __expf(ml - mn);
#pragma unroll
            for (int i = 0; i < 32; ++i) if (i < per) c[i] = fa * c[i] + fb * MLC[sb * 16384 + e0 + i * NT + tid];
            if (tid < 128) n = fa * n + fb * MLN[sb * 128 + tid];
            m = mn; }
        if (!lat) {
#pragma unroll
            for (int i = 0; i < 32; ++i) if (i < per) { const int e = e0 + i * NT + tid, vd = e >> 7, kd = e & 127; a.out[O_MLC + (so * 128 + kd) * 128 + vd] = c[i]; }
            if (tid < 128) a.out[O_MLN + so * 128 + tid] = n; if (tid == 0) a.out[O_MLM + so] = m; }
    }
}
__device__ __forceinline__ void ml_out_phase(const Args& a, int layer, LAS unsigned char* lds, int tid_, int G) {
    int tid = tid_; asm volatile("" : "+v"(tid));
    const int lane = tid & 63, wave = __builtin_amdgcn_readfirstlane(tid >> 6), fr = lane & 15, fq = lane >> 4;
    const bf16_t* NAT = (const bf16_t*)(a.ws + WS_NAT); const bf16_t* TR = (const bf16_t*)(a.ws + WS_TR); const bf16_t* PROJ = (const bf16_t*)(a.ws + WS_PROJ);
    const bf16_t* CS = (const bf16_t*)(a.ws + WS_MLCS); const float* NS = (const float*)(a.ws + WS_MLNS); const float* MS = (const float*)(a.ws + WS_MLMS);
    bf16_t* BR = (bf16_t*)(a.ws + WS_BR);
    LAS float* U = (LAS float*)lds; LAS float* Wv = U + 128; LAS float* SI = U + 256; LAS float* EM = U + 384; LAS float* NSs = U + 512;
    for (int u = blockIdx.x; u < NCH * 4; u += G) {
        const int ch = u >> 2, hh = u & 3; int row0, seq0, L, lat, b, ci, nc; chunk_info(ch, row0, seq0, L, lat, b, ci, nc);
        const int t = wave * 16 + fr;
        bf16x8 qf[4];
#pragma unroll
        for (int ks = 0; ks < 4; ++ks) qf[ks] = *(const bf16x8*)(NAT + (size_t)(row0 + t) * NATP + N_Q + hh * 128 + 32 * ks + 8 * fq);
        f32x4 hsum[8];
#pragma unroll
        for (int j = 0; j < 8; ++j) hsum[j] = (f32x4){0.f, 0.f, 0.f, 0.f};
#pragma unroll 1
        for (int dir = 0; dir < 2; ++dir) {
            const size_t sb = (size_t)(ch * 4 + hh) * 2 + dir;
            __syncthreads();
            if (wave == 0) {
                const MlGate g = ml_gates(a, layer, row0, hh, dir, lane); const float ms = MS[sb];
                float u0, u1, c0, c1, ai0, ai1;
                if (dir == 0) { u0 = g.ig0 - g.P0; u1 = g.ig1 - g.P1; c0 = g.P0; c1 = g.P1; ai0 = g.P0 + ms; ai1 = g.P1 + ms; }
                else { const float E0 = g.P0 - g.lf0, E1 = g.P1 - g.lf1; u0 = E0 + g.ig0; u1 = E1 + g.ig1; c0 = -E0; c1 = -E1; ai0 = g.tot - E0 + ms; ai1 = g.tot - E1 + ms; }
                float g0 = u0, g1 = u1;
                if (dir == 0) {
#pragma unroll
                    for (int o = 1; o < 64; o <<= 1) { const float x0 = __shfl_up(g0, o), x1 = __shfl_up(g1, o); if (lane >= o) { g0 = fmaxf(g0, x0); g1 = fmaxf(g1, x1); } }
                    g1 = fmaxf(g1, __shfl(g0, 63));
                } else {
#pragma unroll
                    for (int o = 1; o < 64; o <<= 1) { const float x0 = __shfl_down(g0, o), x1 = __shfl_down(g1, o); if (lane + o < 64) { g0 = fmaxf(g0, x0); g1 = fmaxf(g1, x1); } }
                    g0 = fmaxf(g0, __shfl(g1, 0));
                }
                const float mt0 = fmaxf(ai0, c0 + g0), mt1 = fmaxf(ai1, c1 + g1);
                U[lane] = u0; U[lane + 64] = u1; Wv[lane] = c0 - mt0; Wv[lane + 64] = c1 - mt1;
                SI[lane] = __expf(ai0 - mt0); SI[lane + 64] = __expf(ai1 - mt1); EM[lane] = __expf(-mt0); EM[lane + 64] = __expf(-mt1);
                NSs[lane] = NS[sb * 128 + lane]; NSs[lane + 64] = NS[sb * 128 + lane + 64];
            }
            __syncthreads();
            const float wt = Wv[t], sit = SI[t], emt = EM[t];
            f32x4 acc[8];
#pragma unroll
            for (int j = 0; j < 8; ++j) acc[j] = (f32x4){0.f, 0.f, 0.f, 0.f};
#pragma unroll
            for (int ks = 0; ks < 4; ++ks)
#pragma unroll
                for (int j = 0; j < 8; ++j) { const bf16x8 cf = *(const bf16x8*)(CS + sb * 16384 + (size_t)(16 * j + fr) * 128 + 32 * ks + 8 * fq); acc[j] = mfma16(cf, qf[ks], acc[j]); }
            float qn = 0.f;
#pragma unroll
            for (int ks = 0; ks < 4; ++ks) { const u32x4 qv = __builtin_bit_cast(u32x4, qf[ks]); const LAS float* nn = NSs + 32 * ks + 8 * fq;
                qn += bflo(qv.x) * nn[0] + bfhi(qv.x) * nn[1] + bflo(qv.y) * nn[2] + bfhi(qv.y) * nn[3] + bflo(qv.z) * nn[4] + bfhi(qv.z) * nn[5] + bflo(qv.w) * nn[6] + bfhi(qv.w) * nn[7]; }
            qn += __shfl_xor(qn, 16); qn += __shfl_xor(qn, 32);
#pragma unroll
            for (int j = 0; j < 8; ++j) acc[j] *= sit;
            float den = sit * qn;
            const int jlo = dir == 0 ? 0 : (wave >> 1), jhi = dir == 0 ? (wave >> 1) : 3;
            float psum = 0.f;
            for (int jp = jlo; jp <= jhi; ++jp) {
                const int ta = 32 * jp + 8 * (fr >> 2) + (fr & 3);
                f32x4 sa = (f32x4){0.f, 0.f, 0.f, 0.f}, sb2 = (f32x4){0.f, 0.f, 0.f, 0.f};
#pragma unroll
                for (int ks = 0; ks < 4; ++ks) {
                    const bf16x8 ka = *(const bf16x8*)(NAT + (size_t)(row0 + ta) * NATP + N_K + hh * 128 + 32 * ks + 8 * fq);
                    const bf16x8 kb = *(const bf16x8*)(NAT + (size_t)(row0 + ta + 4) * NATP + N_K + hh * 128 + 32 * ks + 8 * fq);
                    sa = mfma16(ka, qf[ks], sa); sb2 = mfma16(kb, qf[ks], sb2); }
                float pa[4], pb[4];
#pragma unroll
                for (int i = 0; i < 4; ++i) { const int s0 = 32 * jp + 8 * fq + i, s1 = s0 + 4;
                    const bool ok0 = dir == 0 ? s0 <= t : s0 >= t, ok1 = dir == 0 ? s1 <= t : s1 >= t;
                    pa[i] = ok0 ? sa[i] * __expf(U[s0] + wt) : 0.f; pb[i] = ok1 ? sb2[i] * __expf(U[s1] + wt) : 0.f;
                    psum += pa[i] + pb[i]; }
                u32x4 pw; pw.x = pk2(pa[0], pa[1]); pw.y = pk2(pa[2], pa[3]); pw.z = pk2(pb[0], pb[1]); pw.w = pk2(pb[2], pb[3]);
                const bf16x8 pf = __builtin_bit_cast(bf16x8, pw);
#pragma unroll
                for (int j = 0; j < 8; ++j) { const bf16x8 vf = *(const bf16x8*)(TR + (size_t)(T_MV + hh * 128 + 16 * j + fr) * M + row0 + 32 * jp + 8 * fq); acc[j] = mfma16(vf, pf, acc[j]); }
            }
            psum += __shfl_xor(psum, 16); psum += __shfl_xor(psum, 32);
            den += psum;
            const float rden = 1.f / fmaxf(fabsf(den), emt);
#pragma unroll
            for (int j = 0; j < 8; ++j) hsum[j] += acc[j] * rden;
        }
        float ss = 0.f;
#pragma unroll
        for (int j = 0; j < 8; ++j) ss += (hsum[j][0] * hsum[j][0] + hsum[j][1] * hsum[j][1]) + (hsum[j][2] * hsum[j][2] + hsum[j][3] * hsum[j][3]);
        ss += __shfl_xor(ss, 16); ss += __shfl_xor(ss, 32);
        const float r = rsqrtf(ss * (1.f / 128.f) + 1e-6f);
        const float* ng = a.in[38] + layer * 512 + hh * 128;
#pragma unroll
        for (int j = 0; j < 8; ++j) { const int vd = 16 * j + 4 * fq; const f32x4 gg = *(const f32x4*)(ng + vd);
            const u32x2 ov = *(const u32x2*)(PROJ + (size_t)(row0 + t) * PJ + P_MO + hh * 128 + vd);
            const float o0 = hsum[j][0] * r * gg[0] * fsigm(bflo(ov.x)), o1 = hsum[j][1] * r * gg[1] * fsigm(bfhi(ov.x)), o2 = hsum[j][2] * r * gg[2] * fsigm(bflo(ov.y)), o3 = hsum[j][3] * r * gg[3] * fsigm(bfhi(ov.y));
            u32x2 w; w.x = pk2(o0, o1); w.y = pk2(o2, o3); *(u32x2*)(BR + (size_t)(row0 + t) * D + 1536 + hh * 128 + vd) = w; }
    }
}
}
namespace mk {
constexpr size_t WS_SST = WS_OPT_END;
constexpr size_t WS_SSL = AL(WS_SST + (size_t)NCH * 8 * 2 * 8192 * 4);
constexpr size_t WS_SSCS = AL(WS_SSL + (size_t)NCH * 8 * 2 * 4);
constexpr size_t WS_YPRE = AL(WS_SSCS + (size_t)NCH * 8 * 2 * 8192 * 2);
constexpr size_t WS_SSQ = AL(WS_YPRE + (size_t)M * 512 * 4);
constexpr size_t WS_SSD_END = AL(WS_SSQ + (size_t)M * 8 * 4);

struct SsdGate { float dt0, dt1, la0, la1, P0, P1, tot; };
__device__ __forceinline__ SsdGate ssd_gates(const Args& a, int layer, int row0, int hh, int dir, int lane) {
    const float* SMALL = (const float*)(a.ws + WS_SMALL);
    const float bias = a.in[32][layer * 16 + dir * 8 + hh], A = -__expf(a.in[33][layer * 16 + dir * 8 + hh]);
    SsdGate g;
    const float x0 = SMALL[(size_t)(row0 + lane) * 32 + S_DT + dir * 8 + hh] + bias, x1 = SMALL[(size_t)(row0 + lane + 64) * 32 + S_DT + dir * 8 + hh] + bias;
    g.dt0 = fmaxf(x0, 0.f) + log1pf(__expf(-fabsf(x0))); g.dt1 = fmaxf(x1, 0.f) + log1pf(__expf(-fabsf(x1)));
    g.la0 = g.dt0 * A; g.la1 = g.dt1 * A;
    const float s0 = wave_incl_scan(g.la0, lane); const float t0 = __shfl(s0, 63);
    const float s1 = wave_incl_scan(g.la1, lane) + t0;
    g.P0 = s0; g.P1 = s1; g.tot = __shfl(s1, 63);
    return g;
}
__device__ __forceinline__ void ssd_states_phase(const Args& a, int layer, int tid_, int G) {
    int tid = tid_; asm volatile("" : "+v"(tid));
    const int lane = tid & 63, wave = __builtin_amdgcn_readfirstlane(tid >> 6), fr = lane & 15, fq = lane >> 4;
    const bf16_t* TR = (const bf16_t*)(a.ws + WS_TR); float* SST = (float*)(a.ws + WS_SST); float* SSL = (float*)(a.ws + WS_SSL);
    for (int u = blockIdx.x; u < NCH * 8; u += G) {
        const int ch = u >> 3, hh = u & 7, grp = hh >> 2; int row0, seq0, L, lat, b, ci, nc; chunk_info(ch, row0, seq0, L, lat, b, ci, nc);
#pragma unroll
        for (int dir = 0; dir < 2; ++dir) {
            const SsdGate g = ssd_gates(a, layer, row0, hh, dir, lane);
            const float w0 = g.dt0 * __expf(dir == 0 ? g.tot - g.P0 : g.P0 - g.la0), w1 = g.dt1 * __expf(dir == 0 ? g.tot - g.P1 : g.P1 - g.la1);
            f32x4 acc[4];
#pragma unroll
            for (int j = 0; j < 4; ++j) acc[j] = (f32x4){0.f, 0.f, 0.f, 0.f};
#pragma unroll
            for (int ks = 0; ks < 4; ++ks) {
                float ev[8];
#pragma unroll
                for (int j = 0; j < 8; ++j) { const int tok = 32 * ks + 8 * fq + j; const float y0 = __shfl(w0, tok & 63), y1 = __shfl(w1, tok & 63); ev[j] = tok < 64 ? y0 : y1; }
                const u32x4 bv = *(const u32x4*)(TR + (size_t)(T_B + grp * 128 + wave * 16 + fr) * M + row0 + 32 * ks + 8 * fq);
                u32x4 bw; bw.x = pk2(bflo(bv.x) * ev[0], bfhi(bv.x) * ev[1]); bw.y = pk2(bflo(bv.y) * ev[2], bfhi(bv.y) * ev[3]); bw.z = pk2(bflo(bv.z) * ev[4], bfhi(bv.z) * ev[5]); bw.w = pk2(bflo(bv.w) * ev[6], bfhi(bv.w) * ev[7]);
                const bf16x8 bf = __builtin_bit_cast(bf16x8, bw);
#pragma unroll
                for (int j = 0; j < 4; ++j) { const bf16x8 xf = *(const bf16x8*)(TR + (size_t)(T_X + hh * 64 + 16 * j + fr) * M + row0 + 32 * ks + 8 * fq); acc[j] = mfma16(xf, bf, acc[j]); }
            }
            float* dst = SST + ((size_t)(ch * 8 + hh) * 2 + dir) * 8192;
#pragma unroll
            for (int j = 0; j < 4; ++j)
#pragma unroll
                for (int i = 0; i < 4; ++i) dst[(size_t)(16 * j + 4 * fq + i) * 128 + wave * 16 + fr] = acc[j][i];
            if (tid == 0) SSL[(size_t)(ch * 8 + hh) * 2 + dir] = g.tot;
        }
    }
}
__device__ __forceinline__ void ssd_scan_phase(const Args& a, int layer, int tid_, int G) {
    int tid = tid_; asm volatile("" : "+v"(tid));
    const float* SST = (const float*)(a.ws + WS_SST); const float* SSL = (const float*)(a.ws + WS_SSL); bf16_t* CS = (bf16_t*)(a.ws + WS_SSCS);
    for (int task = blockIdx.x; task < 384; task += G) {
        int lat, b, hh, dir, part, nparts;
        if (task < 128) { lat = 1; part = task & 1; dir = (task >> 1) & 1; hh = (task >> 2) & 7; b = task >> 5; nparts = 2; }
        else { const int t2 = task - 128; lat = 0; part = 0; dir = t2 & 1; hh = (t2 >> 1) & 7; b = t2 >> 4; nparts = 1; }
        const int nc = lat ? 16 : 2, ch0 = lat ? 32 + b * 16 : b * 2;
        const int nel = 8192 / nparts, e0 = part * nel, per = nel / NT;
        float c[16];
        const size_t so = ((((size_t)b * DEPTH + layer) * 2 + dir) * 8 + hh) * 8192;
#pragma unroll
        for (int i = 0; i < 16; ++i) if (i < per) c[i] = lat ? a.in[6][so + e0 + i * NT + tid] : 0.f;
        for (int s = 0; s < nc; ++s) { const int ci = dir ? nc - 1 - s : s, ch = ch0 + ci; const size_t sb = (size_t)(ch * 8 + hh) * 2 + dir;
#pragma unroll
            for (int i = 0; i < 16; ++i) if (i < per) CS[sb * 8192 + e0 + i * NT + tid] = f2bf(c[i]);
            const float dec = __expf(SSL[sb]);
#pragma unroll
            for (int i = 0; i < 16; ++i) if (i < per) c[i] = dec * c[i] + SST[sb * 8192 + e0 + i * NT + tid]; }
        if (!lat) {
#pragma unroll
            for (int i = 0; i < 16; ++i) if (i < per) a.out[O_SSD + so + e0 + i * NT + tid] = c[i]; }
    }
}
__device__ __forceinline__ void ssd_out_phase(const Args& a, int layer, LAS unsigned char* lds, int tid_, int G) {
    int tid = tid_; asm volatile("" : "+v"(tid));
    const int lane = tid & 63, wave = __builtin_amdgcn_readfirstlane(tid >> 6), fr = lane & 15, fq = lane >> 4;
    const bf16_t* NAT = (const bf16_t*)(a.ws + WS_NAT); const bf16_t* TR = (const bf16_t*)(a.ws + WS_TR); const bf16_t* PROJ = (const bf16_t*)(a.ws + WS_PROJ);
    const bf16_t* CS = (const bf16_t*)(a.ws + WS_SSCS); float* YPRE = (float*)(a.ws + WS_YPRE); float* SSQ = (float*)(a.ws + WS_SSQ);
    LAS float* U = (LAS float*)(lds + 4096); LAS float* Wv = U + 128; LAS float* DT = U + 256; LAS float* EO = U + 384;
    for (int u = blockIdx.x; u < NCH * 8; u += G) {
        const int ch = u >> 3, hh = u & 7, grp = hh >> 2; int row0, seq0, L, lat, b, ci, nc; chunk_info(ch, row0, seq0, L, lat, b, ci, nc);
        const int t = wave * 16 + fr;
        bf16x8 cf[4];
#pragma unroll
        for (int ks = 0; ks < 4; ++ks) cf[ks] = *(const bf16x8*)(NAT + (size_t)(row0 + t) * NATP + N_XBC + 768 + grp * 128 + 32 * ks + 8 * fq);
        f32x4 ysum[4];
#pragma unroll
        for (int j = 0; j < 4; ++j) ysum[j] = (f32x4){0.f, 0.f, 0.f, 0.f};
#pragma unroll 1
        for (int dir = 0; dir < 2; ++dir) {
            const size_t sb = (size_t)(ch * 8 + hh) * 2 + dir;
            __syncthreads();
            if (wave == 0) {
                const SsdGate g = ssd_gates(a, layer, row0, hh, dir, lane);
                if (dir == 0) { U[lane] = -g.P0; U[lane + 64] = -g.P1; Wv[lane] = g.P0; Wv[lane + 64] = g.P1; EO[lane] = __expf(g.P0); EO[lane + 64] = __expf(g.P1); }
                else { const float E0 = g.P0 - g.la0, E1 = g.P1 - g.la1; U[lane] = E0; U[lane + 64] = E1; Wv[lane] = -E0; Wv[lane + 64] = -E1; EO[lane] = __expf(g.tot - E0); EO[lane + 64] = __expf(g.tot - E1); }
                DT[lane] = g.dt0; DT[lane + 64] = g.dt1;
            }
            __syncthreads();
            const float wt = Wv[t], eot = EO[t];
            f32x4 acc[4];
#pragma unroll
            for (int j = 0; j < 4; ++j) acc[j] = (f32x4){0.f, 0.f, 0.f, 0.f};
#pragma unroll
            for (int ks = 0; ks < 4; ++ks)
#pragma unroll
                for (int j = 0; j < 4; ++j) { const bf16x8 sf = *(const bf16x8*)(CS + sb * 8192 + (size_t)(16 * j + fr) * 128 + 32 * ks + 8 * fq); acc[j] = mfma16(sf, cf[ks], acc[j]); }
#pragma unroll
            for (int j = 0; j < 4; ++j) acc[j] *= eot;
            const int jlo = dir == 0 ? 0 : (wave >> 1), jhi = dir == 0 ? (wave >> 1) : 3;
            for (int jp = jlo; jp <= jhi; ++jp) {
                const int ta = 32 * jp + 8 * (fr >> 2) + (fr & 3);
                f32x4 sa = (f32x4){0.f, 0.f, 0.f, 0.f}, sb2 = (f32x4){0.f, 0.f, 0.f, 0.f};
#pragma unroll
                for (int ks = 0; ks < 4; ++ks) {
                    const bf16x8 ba = *(const bf16x8*)(NAT + (size_t)(row0 + ta) * NATP + N_XBC + 512 + grp * 128 + 32 * ks + 8 * fq);
                    const bf16x8 bb = *(const bf16x8*)(NAT + (size_t)(row0 + ta + 4) * NATP + N_XBC + 512 + grp * 128 + 32 * ks + 8 * fq);
                    sa = mfma16(ba, cf[ks], sa); sb2 = mfma16(bb, cf[ks], sb2); }
                float pa[4], pb[4];
#pragma unroll
                for (int i = 0; i < 4; ++i) { const int s0 = 32 * jp + 8 * fq + i, s1 = s0 + 4;
                    const bool ok0 = dir == 0 ? s0 <= t : s0 >= t, ok1 = dir == 0 ? s1 <= t : s1 >= t;
                    pa[i] = ok0 ? sa[i] * DT[s0] * __expf(U[s0] + wt) : 0.f; pb[i] = ok1 ? sb2[i] * DT[s1] * __expf(U[s1] + wt) : 0.f; }
                u32x4 pw; pw.x = pk2(pa[0], pa[1]); pw.y = pk2(pa[2], pa[3]); pw.z = pk2(pb[0], pb[1]); pw.w = pk2(pb[2], pb[3]);
                const bf16x8 pf = __builtin_bit_cast(bf16x8, pw);
#pragma unroll
                for (int j = 0; j < 4; ++j) { const bf16x8 xf = *(const bf16x8*)(TR + (size_t)(T_X + hh * 64 + 16 * j + fr) * M + row0 + 32 * jp + 8 * fq); acc[j] = mfma16(xf, pf, acc[j]); }
            }
#pragma unroll
            for (int j = 0; j < 4; ++j) ysum[j] += acc[j];
        }
        const float Dh = a.in[34][layer * 8 + hh]; float ss = 0.f;
#pragma unroll
        for (int j = 0; j < 4; ++j) { const int p = 16 * j + 4 * fq;
            const u32x2 xv = *(const u32x2*)(NAT + (size_t)(row0 + t) * NATP + N_XBC + hh * 64 + p), zv = *(const u32x2*)(PROJ + (size_t)(row0 + t) * PJ + P_Z + hh * 64 + p);
            f32x4 y; y[0] = (ysum[j][0] + bflo(xv.x) * Dh) * fsilu(bflo(zv.x)); y[1] = (ysum[j][1] + bfhi(xv.x) * Dh) * fsilu(bfhi(zv.x));
            y[2] = (ysum[j][2] + bflo(xv.y) * Dh) * fsilu(bflo(zv.y)); y[3] = (ysum[j][3] + bfhi(xv.y) * Dh) * fsilu(bfhi(zv.y));
            ss += (y[0] * y[0] + y[1] * y[1]) + (y[2] * y[2] + y[3] * y[3]);
            *(f32x4*)(YPRE + (size_t)(row0 + t) * 512 + hh * 64 + p) = y; }
        ss += __shfl_xor(ss, 16); ss += __shfl_xor(ss, 32);
        if (fq == 0) SSQ[(size_t)(row0 + t) * 8 + hh] = ss;
    }
}
__device__ __forceinline__ void ssd_fin_phase(const Args& a, int layer, int gw, int ngw, int lane_) {
    int lane = lane_; asm volatile("" : "+v"(lane));
    const float* YPRE = (const float*)(a.ws + WS_YPRE); const float* SSQ = (const float*)(a.ws + WS_SSQ); bf16_t* BR = (bf16_t*)(a.ws + WS_BR); const float* ng = a.in[35] + layer * 512;
    for (int row = gw; row < M; row += ngw) {
        float s = lane < 8 ? SSQ[(size_t)row * 8 + lane] : 0.f; s += __shfl_xor(s, 1); s += __shfl_xor(s, 2); s += __shfl_xor(s, 4); s = __shfl(s, 0);
        const float r = rsqrtf(s * (1.f / 512.f) + 1e-6f);
        const f32x4 y0 = *(const f32x4*)(YPRE + (size_t)row * 512 + 8 * lane), y1 = *(const f32x4*)(YPRE + (size_t)row * 512 + 8 * lane + 4);
        const f32x4 g0 = *(const f32x4*)(ng + 8 * lane), g1 = *(const f32x4*)(ng + 8 * lane + 4);
        *(u32x4*)(BR + (size_t)row * D + 1024 + 8 * lane) = pack8(y0 * r * g0, y1 * r * g1);
    }
}
}
namespace mk {
constexpr size_t WS_CK = WS_SSD_END;
constexpr size_t WS_CVT = AL(WS_CK + (size_t)16 * 512 * 512 * 2);
constexpr size_t WS_ATT_END = AL(WS_CVT + (size_t)16 * 512 * 512 * 2);

__device__ __forceinline__ void prologue_cache(const Args& a, int gw, int ngw, int lane) {
    bf16_t* CK = (bf16_t*)(a.ws + WS_CK); bf16_t* CVT = (bf16_t*)(a.ws + WS_CVT);
    for (size_t i = ((size_t)gw * 64 + lane) * 8; i < (size_t)16 * 512 * 512; i += (size_t)ngw * 64 * 8) {
        const f32x4 x0 = *(const f32x4*)(a.in[2] + i), x1 = *(const f32x4*)(a.in[2] + i + 4); *(u32x4*)(CK + i) = pack8(x0, x1); }
    for (size_t i = (size_t)gw * 64 + lane; i < (size_t)16 * 64 * 512; i += (size_t)ngw * 64) { const int c = i & 511, s8 = (i >> 9) & 63, bl = i >> 15;
        const float* src = a.in[3] + ((size_t)bl * 512 + 8 * s8) * 512 + c;
        u32x4 o; o.x = pk2(src[0], src[512]); o.y = pk2(src[1024], src[1536]); o.z = pk2(src[2048], src[2560]); o.w = pk2(src[3072], src[3584]);
        *(u32x4*)(CVT + ((size_t)bl * 512 + c) * 512 + 8 * s8) = o; }
}
struct AttState { float m, l; f32x4 o[4]; };
template <bool MASKED>
__device__ __forceinline__ void attn_group(AttState& st, const bf16x8 (&qf)[2], const bf16_t* kbase, size_t kp, const bf16_t* vt, size_t vp, int fr, int fq,
                                           const float* bias  , int kc0, int cq, int cs) {
    const int ra = 8 * (fr >> 2) + (fr & 3);
    f32x4 sa = (f32x4){0.f, 0.f, 0.f, 0.f}, sb = (f32x4){0.f, 0.f, 0.f, 0.f};
#pragma unroll
    for (int ks = 0; ks < 2; ++ks) { const bf16x8 ka = *(const bf16x8*)(kbase + (size_t)ra * kp + 32 * ks + 8 * fq), kb = *(const bf16x8*)(kbase + (size_t)(ra + 4) * kp + 32 * ks + 8 * fq);
        sa = mfma16(ka, qf[ks], sa); sb = mfma16(kb, qf[ks], sb); }
    float s[8]; float gm = -1e30f;
#pragma unroll
    for (int i = 0; i < 4; ++i) { s[i] = sa[i] * 0.125f; s[4 + i] = sb[i] * 0.125f; }
    if (MASKED) {
#pragma unroll
        for (int e = 0; e < 8; ++e) { const int kc = kc0 + 8 * fq + e; const bool ok = kc >= cs && kc < cs + 16; const int bi = min(max(kc - cq + 15, 0), 30); s[e] = ok ? s[e] + bias[bi] : -1e30f; }
    }
#pragma unroll
    for (int e = 0; e < 8; ++e) gm = fmaxf(gm, s[e]);
    gm = fmaxf(gm, __shfl_xor(gm, 16)); gm = fmaxf(gm, __shfl_xor(gm, 32));
    const float mn = fmaxf(st.m, gm), al = __expf(st.m - mn); st.m = mn;
    float p[8], ps = 0.f;
#pragma unroll
    for (int e = 0; e < 8; ++e) { p[e] = __expf(s[e] - mn); ps += p[e]; }
    st.l = st.l * al + ps;
    u32x4 pw; pw.x = pk2(p[0], p[1]); pw.y = pk2(p[2], p[3]); pw.z = pk2(p[4], p[5]); pw.w = pk2(p[6], p[7]);
    const bf16x8 pf = __builtin_bit_cast(bf16x8, pw);
#pragma unroll
    for (int j = 0; j < 4; ++j) { const bf16x8 vf = *(const bf16x8*)(vt + (size_t)(16 * j + fr) * vp + 8 * fq); st.o[j] = mfma16(vf, pf, st.o[j] * al); }
}
__device__ __forceinline__ void attn_phase(const Args& a, int layer, int gw_, int ngw, int lane_) {
    int lane = lane_, gw = gw_; asm volatile("" : "+v"(lane));
    const int fr = lane & 15, fq = lane >> 4;
    const bf16_t* PROJ = (const bf16_t*)(a.ws + WS_PROJ); const bf16_t* TR = (const bf16_t*)(a.ws + WS_TR); bf16_t* BR = (bf16_t*)(a.ws + WS_BR);
    const bf16_t* CK = (const bf16_t*)(a.ws + WS_CK); const bf16_t* CVT = (const bf16_t*)(a.ws + WS_CVT);
    for (int it = gw; it < 6144; it += ngw) {
        AttState st; st.m = -1e30f; st.l = 0.f;
#pragma unroll
        for (int j = 0; j < 4; ++j) st.o[j] = (f32x4){0.f, 0.f, 0.f, 0.f};
        int qrow, hh;
        if (it < 4096) {
            const int jq = it & 3, r = (it >> 2) & 31; hh = (it >> 7) & 7; const int b = it >> 10;
            const int seq0 = MP + b * 2048; qrow = seq0 + r * 64 + 16 * jq + fr;
            bf16x8 qf[2];
#pragma unroll
            for (int ks = 0; ks < 2; ++ks) qf[ks] = *(const bf16x8*)(PROJ + (size_t)qrow * PJ + P_Q + hh * 64 + 32 * ks + 8 * fq);
            const int rs = min(max(r - 4, 0), 24), cq = 16 * jq + fr, cs = min(max(cq - 8, 0), 48);
            const int kc0 = jq == 0 ? 0 : (jq == 1 ? 8 : (jq == 2 ? 24 : 32));
            const float* rpb = a.in[19] + ((size_t)layer * 8 + hh) * 15 * 31;
            for (int j = 0; j < 8; ++j) { const int kr = rs + j, tok0 = seq0 + kr * 64 + kc0;
                attn_group<true>(st, qf, PROJ + (size_t)tok0 * PJ + P_K + hh * 64, PJ, TR + (size_t)(T_V + hh * 64) * M + tok0, M, fr, fq, rpb + (kr - r + 7) * 31, kc0, cq, cs); }
            const size_t cb = ((size_t)b * DEPTH + layer) * 512;
            for (int g = 0; g < 16; ++g)
                attn_group<false>(st, qf, CK + (cb + 32 * g) * 512 + hh * 64, 512, CVT + (cb + hh * 64) * 512 + 32 * g, 512, fr, fq, nullptr, 0, 0, 0);
        } else {
            const int i2 = it - 4096, qt = i2 & 15; hh = (i2 >> 4) & 7; const int b = i2 >> 7, seq0 = b * 256; qrow = seq0 + 16 * qt + fr;
            bf16x8 qf[2];
#pragma unroll
            for (int ks = 0; ks < 2; ++ks) qf[ks] = *(const bf16x8*)(PROJ + (size_t)qrow * PJ + P_Q + hh * 64 + 32 * ks + 8 * fq);
            for (int g = 0; g < 8; ++g) { const int tok0 = seq0 + 32 * g;
                attn_group<false>(st, qf, PROJ + (size_t)tok0 * PJ + P_K + hh * 64, PJ, TR + (size_t)(T_V + hh * 64) * M + tok0, M, fr, fq, nullptr, 0, 0, 0); }
        }
        float l = st.l; l += __shfl_xor(l, 16); l += __shfl_xor(l, 32);
        const float rl = 1.f / l;
#pragma unroll
        for (int j = 0; j < 4; ++j) { u32x2 w; w.x = pk2(st.o[j][0] * rl, st.o[j][1] * rl); w.y = pk2(st.o[j][2] * rl, st.o[j][3] * rl);
            *(u32x2*)(BR + (size_t)qrow * D + hh * 64 + 16 * j + 4 * fq) = w; }
    }
}
}
namespace mk {
#ifndef PHMASK
#define PHMASK 0xfffff
#endif
#define PHM(k) ((PHMASK >> (k)) & 1)
constexpr int NPH = 12;
constexpr int PH_TOTAL = 1 + DEPTH * NPH;
__global__ void __launch_bounds__(NT, 2) mk_fwd(Args a) {
    extern __shared__ __attribute__((aligned(16))) unsigned char lds_raw[];
    LAS unsigned char* lds = (LAS unsigned char*)lds_raw;
#define TID ((int)threadIdx.x)
#define LANE ((int)(threadIdx.x & 63))
#define WAVE (__builtin_amdgcn_readfirstlane((int)(threadIdx.x >> 6)))
#define GW ((int)blockIdx.x * NWV + WAVE)
    const int G = gridDim.x, ngw = G * NWV;
    volatile LAS unsigned* ctlw = (volatile LAS unsigned*)(lds + LDS_CTL);
    if (TID < 4) ctlw[TID] = 0u;
    __syncthreads();
    XcdBarrier bar = xcd_barrier_post((unsigned*)(a.ws + WS_CTL), ctlw);
    const int lo = a.ph_lo, hi = a.ph_hi;
#define IN(k) (lo <= (k) && (k) < hi)
#define SEAM(k) do { if (IN(k) && IN((k) + 1)) xcd_barrier(bar); } while (0)
    unsigned char* ws = a.ws;
    bf16_t* H = (bf16_t*)(ws + WS_H); bf16_t* PROJ = (bf16_t*)(ws + WS_PROJ); float* SMALL = (float*)(ws + WS_SMALL); bf16_t* BR = (bf16_t*)(ws + WS_BR);
    bf16_t* MERGED = (bf16_t*)(ws + WS_MERGED); float* MACC = (float*)(ws + WS_MACC); bf16_t* ZB = (bf16_t*)(ws + WS_ZB); bf16_t* HID = PROJ;
    const float* MOD = (const float*)(ws + WS_MOD); float* X = a.out;
    if (PHM(0) && IN(0)) { prologue_convert(a, lds, GW, ngw, WAVE, LANE); prologue_cache(a, GW, ngw, LANE); __syncthreads(); prologue_ada(a, lds, TID); }
    SEAM(0);
    for (int l = 0; l < DEPTH; ++l) {
        const int pb = 1 + l * NPH;
        const float* xp = l == 0 ? a.in[0] : X; const float* xs = l == 0 ? a.in[1] : X + (size_t)MP * D;
        const float* modl = MOD + (size_t)l * 5 * 6 * D;
        const bf16_t* wl = (const bf16_t*)(ws + WS_W) + (size_t)l * W_LAYER;
        if (PHM(1) && IN(pb + 0)) norm_phase(xp, xs, a.in[14] + l * D, modl, 0, D, H, GW, ngw, LANE);
        SEAM(pb + 0);
        if (PHM(2) && IN(pb + 1)) { Gemm g{H, wl + W_IN, M, NIN, D, D, 1, 0, 0}; StaticOrder S; S.init(M, NIN, G, blockIdx.x);
            EpiIn E{PROJ, SMALL, a.out, a.in[17] + l * 64, a.in[18] + l * 64, l}; gemm_phase(lds, g, S, E); }
        SEAM(pb + 1);
        if (PHM(3) && IN(pb + 2)) { prep_phase(a, l, lds, GW, ngw, WAVE, LANE); nmix_a(a, l, GW, ngw, LANE); }
        SEAM(pb + 2);
        if (PHM(4) && IN(pb + 3)) { attn_phase(a, l, GW, ngw, LANE); ml_states_phase(a, l, TID, G); ssd_states_phase(a, l, TID, G); nmix_b(a, l, lds, TID, G); }
        SEAM(pb + 3);
        if (PHM(5) && IN(pb + 4)) { ml_scan_phase(a, l, TID, G); ssd_scan_phase(a, l, TID, G); }
        SEAM(pb + 4);
        if (PHM(12) && IN(pb + 5)) { ml_out_phase(a, l, lds, TID, G); ssd_out_phase(a, l, lds, TID, G); }
        SEAM(pb + 5);
        if (PHM(6) && IN(pb + 6)) { Gemm g{ZB, wl + W_GLU, M, 512, 512, 512, 1, 0, 0}; StaticOrder S; S.init(M, 512, G, blockIdx.x);
            EpiGlu E{ZB, a.in[29] + l * 512, BR}; gemm_phase(lds, g, S, E); ssd_fin_phase(a, l, GW, ngw, LANE); }
        SEAM(pb + 6);
        if (PHM(7) && IN(pb + 7)) { Gemm g{BR, wl + W_BR, M, D, 512, D, 4, 512, (size_t)D * 512}; StaticOrder S; S.init(M, D, G, blockIdx.x, 4);
            EpiBranch E{PROJ, MACC, MERGED}; gemm_phase(lds, g, S, E); }
        SEAM(pb + 7);
        if (PHM(8) && IN(pb + 8)) { Gemm g{MERGED, wl + W_OUT, M, D, D, D, 1, 0, 0}; StaticOrder S; S.init(M, D, G, blockIdx.x);
            EpiResid E{xp, xs, modl, 2 * D, X}; gemm_phase(lds, g, S, E); }
        SEAM(pb + 8);
        if (PHM(9) && IN(pb + 9)) norm_phase(X, X + (size_t)MP * D, a.in[15] + l * D, modl, 3 * D, 4 * D, H, GW, ngw, LANE);
        SEAM(pb + 9);
        if (PHM(10) && IN(pb + 10)) { Gemm g{H, wl + W_1, M, DFF, D, D, 1, 0, 0}; StaticOrder S; S.init(M, DFF, G, blockIdx.x);
            EpiRelu2 E{HID, DFF}; gemm_phase(lds, g, S, E); }
        SEAM(pb + 10);
        if (PHM(11) && IN(pb + 11)) { Gemm g{HID, wl + W_2, M, D, DFF, DFF, 1, 0, 0}; StaticOrder S; S.init(M, D, G, blockIdx.x);
            EpiResid E{X, X + (size_t)MP * D, modl, 5 * D, X}; gemm_phase(lds, g, S, E); }
        SEAM(pb + 11);
    }
#undef IN
#undef SEAM
}
}
extern "C" void kernel_launch(void* const* d_in, const int* in_sizes, int n_in, void* d_out, int out_size, void* d_ws, size_t ws_size, hipStream_t stream) {
    static int grid = 0;
    if (grid == 0) {
        int dev = 0, cus = 0; (void)hipGetDevice(&dev); (void)hipDeviceGetAttribute(&cus, hipDeviceAttributeMultiprocessorCount, dev);
        (void)hipFuncSetAttribute((const void*)mk::mk_fwd, hipFuncAttributeMaxDynamicSharedMemorySize, mk::LDS_BYTES);
        int per_cu = 0; (void)hipOccupancyMaxActiveBlocksPerMultiprocessor(&per_cu, (const void*)mk::mk_fwd, mk::NT, mk::LDS_BYTES); (void)hipGetLastError();
        grid = cus > 0 ? cus : 256;
    }
    mk::Args a{}; for (int i = 0; i < 43; ++i) a.in[i] = (const float*)d_in[i];
    a.out = (float*)d_out; a.ws = (unsigned char*)d_ws; a.ph_lo = 0; a.ph_hi = mk::PH_TOTAL;
    (void)hipMemsetAsync(a.ws + mk::WS_CTL, 0, mk::CTL_BYTES, stream);
    hipLaunchKernelGGL(mk::mk_fwd, dim3(grid), dim3(mk::NT), mk::LDS_BYTES, stream, a);
}
```

```cpp
#define SAFE_GEMM 0
#include <hip/hip_runtime.h>
#include <math.h>
namespace mk {
#define LAS __attribute__((address_space(3)))
typedef unsigned short bf16_t;
typedef short bf16x8 __attribute__((ext_vector_type(8)));
typedef float f32x4 __attribute__((ext_vector_type(4)));
typedef float f32x2 __attribute__((ext_vector_type(2)));
typedef unsigned u32x4 __attribute__((ext_vector_type(4)));
typedef unsigned u32x2 __attribute__((ext_vector_type(2)));
constexpr int NT = 512, NWV = 8;
constexpr int D = 2048, MP = 4096, MLAT = 8192, M = MP + MLAT, DEPTH = 4, DFF = 8192;
constexpr int PJ = 13824;
constexpr int NIN = 14080;
constexpr int P_Q = 0, P_K = 512, P_V = 1024, P_S5U = 1536, P_Z = 2048, P_XBC = 2560, P_MQ = 3584, P_MK = 4096, P_MV = 4608, P_MO = 5120, P_GATE = 5632;
constexpr int S_DT = 0, S_MI = 16, S_MF = 24;

typedef __bf16 bf16x2_t __attribute__((ext_vector_type(2)));
__device__ __forceinline__ unsigned pk2(float lo, float hi) { f32x2 v = {lo, hi}; bf16x2_t b = __builtin_convertvector(v, bf16x2_t); return __builtin_bit_cast(unsigned, b); }
__device__ __forceinline__ float bf2f(bf16_t v) { return __uint_as_float(((unsigned)v) << 16); }
__device__ __forceinline__ float bflo(unsigned w) { return __uint_as_float(w << 16); }
__device__ __forceinline__ float bfhi(unsigned w) { return __uint_as_float(w & 0xffff0000u); }
__device__ __forceinline__ bf16_t f2bf(float f) { return (bf16_t)(pk2(f, 0.f) & 0xffffu); }
__device__ __forceinline__ float fsigm(float x) { return __builtin_amdgcn_rcpf(1.f + __expf(-x)); }
__device__ __forceinline__ float fsilu(float x) { return x * fsigm(x); }
__device__ __forceinline__ int row_cvec(int row) { return row < MP ? 0 : 1 + (row - MP) / 2048; }

#define XB_TMO      128
#define XB_XCNT(j)  (256  + 64 * (j))
#define XB_XSUB(j)  (1280 + 64 * (j))
#define XB_XGEN(j)  (2304 + 64 * (j))
#define XB_TOP      3328
#define XB_TOPGEN   3392
#define XCD_BAR_WORDS 3456
#define XB_SPIN_CAP (1u << 18)
__device__ __forceinline__ unsigned xb_ld(unsigned* p)              { return __hip_atomic_load(p, __ATOMIC_RELAXED, __HIP_MEMORY_SCOPE_AGENT); }
__device__ __forceinline__ unsigned xb_add(unsigned* p, unsigned v) { return __hip_atomic_fetch_add(p, v, __ATOMIC_RELAXED, __HIP_MEMORY_SCOPE_AGENT); }
__device__ __forceinline__ unsigned xb_xcc_id() { return (unsigned)__builtin_amdgcn_s_getreg((3 << 11) | 20) & 0xFu; }
#define XB_SPIN(cond, bar) do { unsigned _sp = 0; while (cond) { __builtin_amdgcn_s_sleep(1); \
    if ((++_sp & 255u) == 0u) { if (xb_ld(&(bar)[XB_TMO])) break; if (_sp > XB_SPIN_CAP) { atomicAdd(&(bar)[XB_TMO], 1u); break; } } } } while (0)
struct XcdBarrier { unsigned* bar; unsigned x; volatile LAS unsigned* st; };
__device__ __forceinline__ XcdBarrier xcd_barrier_post(unsigned* bar, volatile LAS unsigned* st) {
    XcdBarrier b; b.bar = bar; b.x = xb_xcc_id(); b.st = st;
    if (threadIdx.x == 0) (void)xb_add(&bar[XB_XCNT(b.x)], 1u);
    return b;
}
__device__ __forceinline__ void xcd_barrier_complete(unsigned* bar, unsigned x, unsigned& nloc, unsigned& nx) {
    const unsigned G = gridDim.x * gridDim.y * gridDim.z;
    unsigned sum, cnt, mine, sp = 0u;
    for (;;) {
        sum = 0u; cnt = 0u; mine = 0u;
#pragma unroll
        for (unsigned j = 0; j < 16; ++j) { const unsigned c = xb_ld(&bar[XB_XCNT(j)]); sum += c; cnt += (c > 0u) ? 1u : 0u; mine = (j == x) ? c : mine; }
        if (sum == G) break;
        __builtin_amdgcn_s_sleep(1);
        if ((++sp & 255u) == 0u) { if (xb_ld(&bar[XB_TMO])) break; if (sp > XB_SPIN_CAP) { atomicAdd(&bar[XB_TMO], 1u); break; } }
    }
    nloc = mine > 0u ? mine : 1u; nx = cnt > 0u ? cnt : 1u;
}
__device__ __forceinline__ void xcd_barrier(const XcdBarrier& b) {
    asm volatile("s_waitcnt vmcnt(0)" ::: "memory");
    __syncthreads();
    if (threadIdx.x == 0) {
        unsigned* bar = b.bar;
        __builtin_amdgcn_s_waitcnt(0);
        unsigned nloc = b.st[0], nx = b.st[1];
        if (nloc == 0u) { xcd_barrier_complete(bar, b.x, nloc, nx); b.st[0] = nloc; b.st[1] = nx; }
        const unsigned old = xb_add(&bar[XB_XSUB(b.x)], 1u);
        const unsigned gen = old / nloc;
        if (old + 1u == (gen + 1u) * nloc) {
            __builtin_amdgcn_fence(__ATOMIC_RELEASE, "agent");
            asm volatile("s_waitcnt vmcnt(0)" ::: "memory");
            const unsigned og = xb_add(&bar[XB_TOP], 1u);
            const unsigned tg = og / nx;
            if (og + 1u == (tg + 1u) * nx) xb_add(&bar[XB_TOPGEN], 1u);
            else XB_SPIN(xb_ld(&bar[XB_TOPGEN]) == tg, bar);
            __builtin_amdgcn_fence(__ATOMIC_ACQUIRE, "agent");
            xb_add(&bar[XB_XGEN(b.x)], 1u);
            asm volatile("s_waitcnt vmcnt(0)" ::: "memory");
        } else {
            XB_SPIN(xb_ld(&bar[XB_XGEN(b.x)]) == gen, bar);
            __builtin_amdgcn_fence(__ATOMIC_ACQUIRE, "agent");
            asm volatile("s_waitcnt vmcnt(0)" ::: "memory");
        }
    }
    __syncthreads();
}

constexpr int BM = 256, BK = 64, HALF = 128, HTB = HALF * BK * 2, STAGE_BYTES = 8 * HTB, NXCD = 8, WGM = 8;
__host__ __device__ __forceinline__ int lds_byte(int r, int c) { const int st = (r >> 4) * 2 + (c >> 5), rr = r & 15, cc = c & 31, ob = rr * 64 + cc * 2; return st * 1024 + (ob ^ (((ob >> 9) & 1) << 5)); }
__host__ __device__ __forceinline__ void stage_rc(int b, int& R, int& C) { const int st = b / 1024, sb = b % 1024, swz = sb ^ (((sb >> 9) & 1) << 5); R = (st >> 1) * 16 + swz / 64; C = (st & 1) * 32 + (swz % 64) / 2; }
__host__ __device__ __forceinline__ int perm32(int rho) { const int n = rho >> 4, i = rho & 15; return 8 * (i >> 2) + 4 * n + (i & 3); }

struct Unit { int pm, pn, kz; };
struct Gemm { const bf16_t* A; const bf16_t* Bt; int M, N, K, lda, nkz; size_t a_kz, b_kz; };

struct StaticOrder {
    int nM, nN, nwg, G, c, nkz;
    __device__ void init(int M_, int N_, int G_, int c_, int nkz_ = 1) { nM = M_ / BM; nN = N_ / BM; nwg = nM * nN; G = G_; c = c_; nkz = nkz_; }
    __device__ bool next(int i, Unit& u) const {
        const int it = i / nkz; u.kz = i - it * nkz;
        const long L = (long)it * G + c; if (L >= nwg) return false;
        int wgid = (int)L; { const int q = nwg / NXCD, r = nwg % NXCD, xcd = wgid % NXCD, off = wgid / NXCD; wgid = (xcd < r ? xcd * (q + 1) : r * (q + 1) + (xcd - r) * q) + off; }
        const int nig = WGM * nN, gid = wgid / nig, fm = gid * WGM, gsz = (nM - fm) < WGM ? (nM - fm) : WGM;
        u.pm = fm + ((wgid % nig) % gsz); u.pn = (wgid % nig) / gsz; return true;
    }
};

template <class Epi>
__device__ __forceinline__ void gemm_phase(LAS unsigned char* lds, const Gemm g, const StaticOrder& S, const Epi& E) {
    int tid_ = threadIdx.x; asm volatile("" : "+v"(tid_));
    const int tid = tid_, wid = __builtin_amdgcn_readfirstlane(tid >> 6), lane = tid & 63, wr = wid >> 2, wc = wid & 3, fr = lane & 15, fq = lane >> 4;
    const int K = g.K, nt = K / BK;
    unsigned voffA[2], voffB[2];
#pragma unroll
    for (int i = 0; i < 2; ++i) { int R, C; stage_rc(tid * 16 + i * 8192, R, C); const int Rb = Epi::PERM ? ((R & ~31) + perm32(R & 31)) : R;
        voffA[i] = (unsigned)(R * g.lda + C) * 2u; voffB[i] = (unsigned)(Rb * K + C) * 2u; }
    const size_t kstep = (size_t)(BK * 2);
    const size_t hstepA = (size_t)HALF * g.lda * 2, hstepB = (size_t)HALF * K * 2;
    const size_t tstepA = 2 * hstepA, tstepB = 2 * hstepB;
    const unsigned ldsw = (unsigned)wid * 1024u;
    const int aoff = lds_byte(wr * 64 + fr, fq * 8), boff = lds_byte(wc * 32 + fr, fq * 8);
#define PG8_SA(b, h) (((b) * 2 + (h)) * HTB)
#define PG8_SB(b, h) ((4 + (b) * 2 + (h)) * HTB)
#define PG8_STAGE(bufoff, gbase, voff) do { _Pragma("unroll") for (int _i = 0; _i < 2; ++_i) \
        __builtin_amdgcn_global_load_lds((const unsigned*)((const char*)(gbase) + (voff)[_i]), (LAS unsigned*)(lds + (bufoff) + ldsw + _i * 8192), 16, 0, 0); } while (0)
#define PG8_LDA(dst, b, h) do { _Pragma("unroll") for (int m = 0; m < 4; ++m) _Pragma("unroll") for (int k = 0; k < 2; ++k) dst[m][k] = *(const LAS bf16x8*)(lds + PG8_SA(b, h) + aoff + m * 2048 + k * 1024); } while (0)
#define PG8_LDB(dst, b, h) do { _Pragma("unroll") for (int n = 0; n < 2; ++n) _Pragma("unroll") for (int k = 0; k < 2; ++k) dst[n][k] = *(const LAS bf16x8*)(lds + PG8_SB(b, h) + boff + n * 2048 + k * 1024); } while (0)
#define PG8_MMA(ai, bj, At, Bt) do { __builtin_amdgcn_s_setprio(1); _Pragma("unroll") for (int m = 0; m < 4; ++m) _Pragma("unroll") for (int n = 0; n < 2; ++n) _Pragma("unroll") for (int k = 0; k < 2; ++k) \
        acc[ai][bj][m][n] = __builtin_amdgcn_mfma_f32_16x16x32_bf16(Bt[n][k], At[m][k], acc[ai][bj][m][n], 0, 0, 0); __builtin_amdgcn_s_setprio(0); } while (0)
#if SAFE_GEMM == 1 || SAFE_GEMM == 3
#define PG8_WAIT_V(n) asm volatile("s_waitcnt vmcnt(0)" ::: "memory")
#else
#define PG8_WAIT_V(n) asm volatile("s_waitcnt vmcnt(" #n ")" ::: "memory")
#endif
#define PG8_WAIT_L(n) asm volatile("s_waitcnt lgkmcnt(" #n ")" ::: "memory")
#if SAFE_GEMM == 1
#define PG8_BAR do { asm volatile("s_waitcnt vmcnt(0) lgkmcnt(0)" ::: "memory"); __builtin_amdgcn_s_barrier(); asm volatile("" ::: "memory"); } while (0)
#elif SAFE_GEMM == 2
#define PG8_BAR asm volatile("s_barrier" ::: "memory")
#elif SAFE_GEMM == 4
#define PG8_BAR do { asm volatile("s_waitcnt lgkmcnt(0)" ::: "memory"); __builtin_amdgcn_s_barrier(); } while (0)
#else
#define PG8_BAR __builtin_amdgcn_s_barrier()
#endif
#define PG8_SCHED __builtin_amdgcn_sched_barrier(0)
    Unit cur, nxt; int ui = 0;
    if (!S.next(0, cur)) return;
    f32x4 acc[2][2][4][2];
#pragma unroll
    for (int a = 0; a < 2; ++a)
#pragma unroll
        for (int b = 0; b < 2; ++b)
#pragma unroll
            for (int m = 0; m < 4; ++m)
#pragma unroll
                for (int n = 0; n < 2; ++n) acc[a][b][m][n] = (f32x4){0.f, 0.f, 0.f, 0.f};
    bf16x8 At[4][2], B0[2][2], B1[2][2];
    const char* cA = (const char*)(g.A + (size_t)cur.kz * g.a_kz) + (size_t)cur.pm * tstepA; const char* cB = (const char*)(g.Bt + (size_t)cur.kz * g.b_kz) + (size_t)cur.pn * tstepB;
    PG8_STAGE(PG8_SB(0, 0), cB, voffB); PG8_STAGE(PG8_SA(0, 0), cA, voffA); PG8_STAGE(PG8_SB(0, 1), cB + hstepB, voffB); PG8_STAGE(PG8_SA(0, 1), cA + hstepA, voffA);
    if (wr == 1) PG8_BAR;
    PG8_WAIT_V(4); PG8_BAR;
    PG8_STAGE(PG8_SB(1, 0), cB + kstep, voffB); PG8_STAGE(PG8_SA(1, 0), cA + kstep, voffA); PG8_STAGE(PG8_SB(1, 1), cB + hstepB + kstep, voffB);
    PG8_WAIT_V(6); PG8_BAR;
    for (;;) {
        const bool has_next = S.next(ui + 1, nxt);
        const char* nA = has_next ? (const char*)(g.A + (size_t)nxt.kz * g.a_kz) + (size_t)nxt.pm * tstepA : cA;
        const char* nB = has_next ? (const char*)(g.Bt + (size_t)nxt.kz * g.b_kz) + (size_t)nxt.pn * tstepB : cB;
        for (int t = 0; t < nt; t += 2) {
            const bool last = (t == nt - 2);
            const char* a1 = cA + (size_t)(t + 1) * kstep;
            const char* a2 = last ? nA : cA + (size_t)(t + 2) * kstep; const char* b2 = last ? nB : cB + (size_t)(t + 2) * kstep;
            const char* a3 = a2 + kstep; const char* b3 = b2 + kstep;
            PG8_LDB(B0, 0, 0); PG8_SCHED; PG8_LDA(At, 0, 0); PG8_STAGE(PG8_SA(1, 1), a1 + hstepA, voffA);
            PG8_WAIT_L(8); PG8_BAR; PG8_WAIT_L(0); PG8_MMA(0, 0, At, B0); PG8_BAR; PG8_SCHED;
            PG8_LDB(B1, 0, 1); PG8_STAGE(PG8_SB(0, 0), b2, voffB);
            PG8_BAR; PG8_WAIT_L(0); PG8_MMA(0, 1, At, B1); PG8_BAR;
            PG8_LDA(At, 0, 1); PG8_STAGE(PG8_SA(0, 0), a2, voffA);
            PG8_BAR; PG8_WAIT_L(0); PG8_MMA(1, 0, At, B0); PG8_BAR; PG8_SCHED;
            PG8_STAGE(PG8_SB(0, 1), b2 + hstepB, voffB);
            PG8_WAIT_V(6); PG8_BAR; PG8_MMA(1, 1, At, B1); PG8_BAR;
            PG8_LDB(B0, 1, 0); PG8_SCHED; PG8_LDA(At, 1, 0); PG8_STAGE(PG8_SA(0, 1), a2 + hstepA, voffA);
            PG8_WAIT_L(8); PG8_BAR; PG8_WAIT_L(0); PG8_MMA(0, 0, At, B0); PG8_BAR; PG8_SCHED;
            PG8_LDB(B1, 1, 1); PG8_STAGE(PG8_SB(1, 0), b3, voffB);
            PG8_BAR; PG8_WAIT_L(0); PG8_MMA(0, 1, At, B1); PG8_BAR;
            PG8_LDA(At, 1, 1); PG8_STAGE(PG8_SA(1, 0), a3, voffA);
            PG8_BAR; PG8_WAIT_L(0); PG8_MMA(1, 0, At, B0); PG8_BAR; PG8_SCHED;
            PG8_STAGE(PG8_SB(1, 1), b3 + hstepB, voffB);
            PG8_WAIT_V(6); PG8_BAR; PG8_MMA(1, 1, At, B1); PG8_BAR;
        }
        E(acc, cur, wr, wc, fr, fq);
        asm volatile("s_waitcnt vmcnt(0)" ::: "memory");
        if (!has_next) break;
#pragma unroll
        for (int a = 0; a < 2; ++a)
#pragma unroll
            for (int b = 0; b < 2; ++b)
#pragma unroll
                for (int m = 0; m < 4; ++m)
#pragma unroll
                    for (int n = 0; n < 2; ++n) acc[a][b][m][n] = (f32x4){0.f, 0.f, 0.f, 0.f};
        cur = nxt; cA = nA; cB = nB; ++ui;
    }
    PG8_WAIT_V(0);
    if (wr == 0) PG8_BAR;
    PG8_BAR;
#undef PG8_SA
#undef PG8_SB
#undef PG8_STAGE
#undef PG8_LDA
#undef PG8_LDB
#undef PG8_MMA
#undef PG8_WAIT_V
#undef PG8_WAIT_L
#undef PG8_BAR
#undef PG8_SCHED
}
}
namespace mk {
constexpr size_t O_YP = 0, O_YS = 8388608, O_NK = 25165824, O_NV = 33554432, O_S5R = 41943040, O_S5I = 42205184, O_SSD = 42467328,
                 O_MLC = 50855936, O_MLN = 59244544, O_MLM = 59310080;

__device__ __forceinline__ u32x4 pack8(const f32x4 a, const f32x4 b) { u32x4 w; w.x = pk2(a[0], a[1]); w.y = pk2(a[2], a[3]); w.z = pk2(b[0], b[1]); w.w = pk2(b[2], b[3]); return w; }

struct EpiIn {
    static constexpr bool PERM = true;
    bf16_t* proj; float* small; float* out; const float* qg; const float* kg; int layer;
    __device__ __forceinline__ void operator()(const f32x4 (&acc)[2][2][4][2], const Unit& u, int wr, int wc, int fr, int fq) const {
        const int T = u.pn, rowb = u.pm * BM + wr * 64 + fr;
        if (T == 54) {
            if (wc == 0) {
#pragma unroll
                for (int ai = 0; ai < 2; ++ai)
#pragma unroll
                    for (int m = 0; m < 4; ++m) { float* sp = small + (size_t)(rowb + ai * HALF + m * 16) * 32 + 8 * fq; *(f32x4*)sp = acc[ai][0][m][0]; *(f32x4*)(sp + 4) = acc[ai][0][m][1]; }
            }
            return;
        }
        const int colb = T * 256 + 64 * wc + 8 * fq;
        if (T < 4) {
            const float* g = T < 2 ? qg : kg;
            f32x4 gv[2][2];
#pragma unroll
            for (int bj = 0; bj < 2; ++bj)
#pragma unroll
                for (int n = 0; n < 2; ++n) gv[bj][n] = *(const f32x4*)(g + 32 * bj + 8 * fq + 4 * n);
#pragma unroll
            for (int ai = 0; ai < 2; ++ai)
#pragma unroll
                for (int m = 0; m < 4; ++m) {
                    float ss = 0.f;
#pragma unroll
                    for (int bj = 0; bj < 2; ++bj)
#pragma unroll
                        for (int n = 0; n < 2; ++n) { const f32x4 x = acc[ai][bj][m][n]; ss += (x[0] * x[0] + x[1] * x[1]) + (x[2] * x[2] + x[3] * x[3]); }
                    ss += __shfl_xor(ss, 16); ss += __shfl_xor(ss, 32);
                    const float r = rsqrtf(ss * (1.f / 64.f) + 1e-6f);
                    const int row = rowb + ai * HALF + m * 16;
#pragma unroll
                    for (int bj = 0; bj < 2; ++bj) { const f32x4 v0 = acc[ai][bj][m][0] * r * gv[bj][0], v1 = acc[ai][bj][m][1] * r * gv[bj][1];
                        *(u32x4*)(proj + (size_t)row * PJ + colb + 32 * bj) = pack8(v0, v1);
                        if (T >= 2 && row < MP) { float* o = out + O_NK + ((size_t)((row >> 8) * DEPTH + layer) * 256 + (row & 255)) * 512 + (colb - 512) + 32 * bj; *(f32x4*)o = v0; *(f32x4*)(o + 4) = v1; } }
                }
        } else if (T < 6) {
#pragma unroll
            for (int ai = 0; ai < 2; ++ai)
#pragma unroll
                for (int m = 0; m < 4; ++m) { const int row = rowb + ai * HALF + m * 16;
#pragma unroll
                    for (int bj = 0; bj < 2; ++bj) { const f32x4 v0 = acc[ai][bj][m][0], v1 = acc[ai][bj][m][1];
                        *(u32x4*)(proj + (size_t)row * PJ + colb + 32 * bj) = pack8(v0, v1);
                        if (row < MP) { float* o = out + O_NV + ((size_t)((row >> 8) * DEPTH + layer) * 256 + (row & 255)) * 512 + (colb - 1024) + 32 * bj; *(f32x4*)o = v0; *(f32x4*)(o + 4) = v1; } } }
        } else if (T < 22) {
#pragma unroll
            for (int ai = 0; ai < 2; ++ai)
#pragma unroll
                for (int m = 0; m < 4; ++m) { const int row = rowb + ai * HALF + m * 16;
#pragma unroll
                    for (int bj = 0; bj < 2; ++bj) *(u32x4*)(proj + (size_t)row * PJ + colb + 32 * bj) = pack8(acc[ai][bj][m][0], acc[ai][bj][m][1]); }
        } else {
#pragma unroll
            for (int ai = 0; ai < 2; ++ai)
#pragma unroll
                for (int m = 0; m < 4; ++m) { const int row = rowb + ai * HALF + m * 16;
#pragma unroll
                    for (int bj = 0; bj < 2; ++bj) { f32x4 v0 = acc[ai][bj][m][0], v1 = acc[ai][bj][m][1];
#pragma unroll
                        for (int j = 0; j < 4; ++j) { v0[j] = fsigm(v0[j]); v1[j] = fsigm(v1[j]); }
                        *(u32x4*)(proj + (size_t)row * PJ + colb + 32 * bj) = pack8(v0, v1); } }
        }
    }
};
struct EpiRelu2 {
    static constexpr bool PERM = true;
    bf16_t* O; int ldo;
    __device__ __forceinline__ void operator()(const f32x4 (&acc)[2][2][4][2], const Unit& u, int wr, int wc, int fr, int fq) const {
        const int rowb = u.pm * BM + wr * 64 + fr, colb = u.pn * 256 + 64 * wc + 8 * fq;
#pragma unroll
        for (int ai = 0; ai < 2; ++ai)
#pragma unroll
            for (int m = 0; m < 4; ++m) { const int row = rowb + ai * HALF + m * 16;
#pragma unroll
                for (int bj = 0; bj < 2; ++bj) { f32x4 v0 = acc[ai][bj][m][0], v1 = acc[ai][bj][m][1];
#pragma unroll
                    for (int j = 0; j < 4; ++j) { const float a = fmaxf(v0[j], 0.f), b = fmaxf(v1[j], 0.f); v0[j] = a * a; v1[j] = b * b; }
                    *(u32x4*)(O + (size_t)row * ldo + colb + 32 * bj) = pack8(v0, v1); } }
    }
};
struct EpiGlu {
    static constexpr bool PERM = true;
    const bf16_t* Z; const float* bias; bf16_t* br;
    __device__ __forceinline__ void operator()(const f32x4 (&acc)[2][2][4][2], const Unit& u, int wr, int wc, int fr, int fq) const {
        const int rowb = u.pm * BM + wr * 64 + fr, colb = u.pn * 256 + 64 * wc + 8 * fq;
#pragma unroll
        for (int bj = 0; bj < 2; ++bj) { const int c = colb + 32 * bj; const f32x4 b0 = *(const f32x4*)(bias + c), b1 = *(const f32x4*)(bias + c + 4);
#pragma unroll
            for (int ai = 0; ai < 2; ++ai)
#pragma unroll
                for (int m = 0; m < 4; ++m) { const int row = rowb + ai * HALF + m * 16;
                    const u32x4 zz = *(const u32x4*)(Z + (size_t)row * 512 + c);
                    f32x4 v0 = acc[ai][bj][m][0] + b0, v1 = acc[ai][bj][m][1] + b1;
                    v0[0] = bflo(zz.x) * fsigm(v0[0]); v0[1] = bfhi(zz.x) * fsigm(v0[1]); v0[2] = bflo(zz.y) * fsigm(v0[2]); v0[3] = bfhi(zz.y) * fsigm(v0[3]);
                    v1[0] = bflo(zz.z) * fsigm(v1[0]); v1[1] = bfhi(zz.z) * fsigm(v1[1]); v1[2] = bflo(zz.w) * fsigm(v1[2]); v1[3] = bfhi(zz.w) * fsigm(v1[3]);
                    *(u32x4*)(br + (size_t)row * D + 512 + c) = pack8(v0, v1); } }
    }
};
struct EpiBranch {
    static constexpr bool PERM = true;
    const bf16_t* proj; float* macc; bf16_t* merged;
    __device__ __forceinline__ void operator()(const f32x4 (&acc)[2][2][4][2], const Unit& u, int wr, int wc, int fr, int fq) const {
        const int rowb = u.pm * BM + wr * 64 + fr, colb = u.pn * 256 + 64 * wc + 8 * fq, kz = u.kz;
#pragma unroll
        for (int ai = 0; ai < 2; ++ai)
#pragma unroll
            for (int m = 0; m < 4; ++m) { const int row = rowb + ai * HALF + m * 16;
#pragma unroll
                for (int bj = 0; bj < 2; ++bj) { const int c = colb + 32 * bj;
                    const u32x4 gg = *(const u32x4*)(proj + (size_t)row * PJ + P_GATE + kz * D + c);
                    f32x4 v0 = acc[ai][bj][m][0], v1 = acc[ai][bj][m][1];
                    v0[0] *= bflo(gg.x); v0[1] *= bfhi(gg.x); v0[2] *= bflo(gg.y); v0[3] *= bfhi(gg.y); v1[0] *= bflo(gg.z); v1[1] *= bfhi(gg.z); v1[2] *= bflo(gg.w); v1[3] *= bfhi(gg.w);
                    float* mp = macc + (size_t)row * D + c;
                    if (kz > 0) { v0 += *(const f32x4*)mp; v1 += *(const f32x4*)(mp + 4); }
                    if (kz < 3) { *(f32x4*)mp = v0; *(f32x4*)(mp + 4) = v1; }
                    else *(u32x4*)(merged + (size_t)row * D + c) = pack8(v0, v1); } }
    }
};
struct EpiResid {
    static constexpr bool PERM = false;
    const float* xp; const float* xs; const float* modl; int g_off; float* xout;
    __device__ __forceinline__ void operator()(const f32x4 (&acc)[2][2][4][2], const Unit& u, int wr, int wc, int fr, int fq) const {
        const int row0 = u.pm * BM, rowb = row0 + wr * 64 + fr, colb = u.pn * 256 + wc * 32 + 4 * fq;
        const float* xin = row0 < MP ? xp : xs - (size_t)MP * D;
        const float* gate = modl + (size_t)row_cvec(row0) * 6 * D + g_off;
        f32x4 gv[2][2];
#pragma unroll
        for (int bj = 0; bj < 2; ++bj)
#pragma unroll
            for (int n = 0; n < 2; ++n) gv[bj][n] = *(const f32x4*)(gate + colb + bj * HALF + n * 16);
#pragma unroll
        for (int ai = 0; ai < 2; ++ai)
#pragma unroll
            for (int m = 0; m < 4; ++m) { const size_t ro = (size_t)(rowb + ai * HALF + m * 16) * D + colb;
#pragma unroll
                for (int bj = 0; bj < 2; ++bj)
#pragma unroll
                    for (int n = 0; n < 2; ++n) { const size_t o = ro + bj * HALF + n * 16; *(f32x4*)(xout + o) = *(const f32x4*)(xin + o) + gv[bj][n] * acc[ai][bj][m][n]; } }
    }
};
}
namespace mk {
constexpr size_t AL(size_t x) { return (x + 255) & ~(size_t)255; }
constexpr size_t WS_CTL = 0, CTL_BYTES = 65536;
constexpr size_t WS_MOD = WS_CTL + CTL_BYTES;
constexpr size_t WS_W = AL(WS_MOD + (size_t)DEPTH * 5 * 6 * D * 4);
constexpr size_t W_IN = 0, W_GLU = W_IN + (size_t)NIN * D, W_BR = W_GLU + 512 * 512, W_OUT = W_BR + (size_t)4 * D * 512, W_1 = W_OUT + (size_t)D * D, W_2 = W_1 + (size_t)DFF * D,
                 W_LAYER = W_2 + (size_t)D * DFF;
constexpr size_t WS_H = AL(WS_W + W_LAYER * 2 * DEPTH);
constexpr size_t WS_PROJ = AL(WS_H + (size_t)M * D * 2);
constexpr size_t WS_SMALL = AL(WS_PROJ + (size_t)M * PJ * 2);
constexpr size_t WS_BR = AL(WS_SMALL + (size_t)M * 32 * 4);
constexpr size_t WS_MERGED = AL(WS_BR + (size_t)M * D * 2);
constexpr size_t WS_MACC = AL(WS_MERGED + (size_t)M * D * 2);
constexpr size_t WS_ZB = AL(WS_MACC + (size_t)M * D * 4);
constexpr size_t WS_SCR = AL(WS_ZB + (size_t)M * 512 * 2);
constexpr int LDS_BYTES = 140 * 1024, LDS_CTL = LDS_BYTES - 256;

struct Args { const float* in[43]; float* out; unsigned char* ws; int ph_lo, ph_hi; };

__device__ __forceinline__ float wave_sum(float v) {
#pragma unroll
    for (int o = 1; o < 64; o <<= 1) v += __shfl_xor(v, o);
    return v;
}
#define LDS_WAIT() asm volatile("s_waitcnt lgkmcnt(0)" ::: "memory")

__device__ __forceinline__ void xpose_item(const float* W, int ldw, int k0, int sc, bf16_t* dst, int K, LAS float* scr, int lane, int mode) {
    const int j = lane & 31;
    const int col = mode == 1 ? (j < 16 ? 3584 + j : 5648 + (j - 16)) : sc + j;
#pragma unroll 8
    for (int i = 0; i < 32; ++i) { const int kk = 2 * i + (lane >> 5); scr[kk * 33 + j] = mode == 2 ? 0.f : W[(size_t)(k0 + kk) * ldw + col]; }
    LDS_WAIT(); asm volatile("" ::: "memory");
    const int c = lane & 7;
#pragma unroll
    for (int jj = 0; jj < 4; ++jj) { const int n = (lane >> 3) + 8 * jj; const LAS float* s = scr + (8 * c) * 33 + n;
        u32x4 o; o.x = pk2(s[0 * 33], s[1 * 33]); o.y = pk2(s[2 * 33], s[3 * 33]); o.z = pk2(s[4 * 33], s[5 * 33]); o.w = pk2(s[6 * 33], s[7 * 33]);
        *(u32x4*)(dst + (size_t)n * K + k0 + 8 * c) = o; }
    LDS_WAIT(); asm volatile("" ::: "memory");
}
__device__ __forceinline__ int hm_col(int grp) { const int T = grp >> 3, q8 = grp & 7; return 256 * T + 32 * (2 * (q8 & 3) + (q8 >> 2)); }

__device__ __forceinline__ void prologue_convert(const Args& a, LAS unsigned char* lds, int gw, int ngw, int wave, int lane) {
    LAS float* scr = (LAS float*)(lds + wave * 8704);
    bf16_t* WB = (bf16_t*)(a.ws + WS_W);
    constexpr int I_IN = 440 * 32, I_GLU = 16 * 8, I_BR = 4 * 64 * 8, I_OUT = 64 * 32, I_1 = 256 * 32, I_2 = 64 * 128, I_L = I_IN + I_GLU + I_BR + I_OUT + I_1 + I_2;
    for (int it = gw; it < I_L * DEPTH; it += ngw) {
        const int l = it / I_L; int r = it - l * I_L; bf16_t* wl = WB + (size_t)l * W_LAYER;
        if (r < I_IN) { const int kb = r / 440, grp = r % 440, T = grp >> 3; int sc = hm_col(grp), mode = 0;
            if (T == 54) mode = (grp & 7) == 0 ? 1 : 2; else if (T >= 22) sc += 32; else if (T >= 14) sc += 16;
            xpose_item(a.in[16] + (size_t)l * D * 13856, 13856, 64 * kb, sc, wl + W_IN + (size_t)(32 * grp) * D, D, scr, lane, mode); continue; } r -= I_IN;
        if (r < I_GLU) { const int kb = r / 16, grp = r % 16; xpose_item(a.in[28] + (size_t)l * 512 * 512, 512, 64 * kb, hm_col(grp), wl + W_GLU + (size_t)(32 * grp) * 512, 512, scr, lane, 0); continue; } r -= I_GLU;
        if (r < I_BR) { const int k = r / 512, r2 = r % 512, kb = r2 / 64, grp = r2 % 64;
            xpose_item(a.in[39] + ((size_t)l * 4 + k) * 512 * D, D, 64 * kb, hm_col(grp), wl + W_BR + (size_t)k * D * 512 + (size_t)(32 * grp) * 512, 512, scr, lane, 0); continue; } r -= I_BR;
        if (r < I_OUT) { const int kb = r / 64, grp = r % 64; xpose_item(a.in[40] + (size_t)l * D * D, D, 64 * kb, 32 * grp, wl + W_OUT + (size_t)(32 * grp) * D, D, scr, lane, 0); continue; } r -= I_OUT;
        if (r < I_1) { const int kb = r / 256, grp = r % 256; xpose_item(a.in[41] + (size_t)l * D * DFF, DFF, 64 * kb, hm_col(grp), wl + W_1 + (size_t)(32 * grp) * D, D, scr, lane, 0); continue; } r -= I_1;
        { const int kb = r / 64, grp = r % 64; xpose_item(a.in[42] + (size_t)l * DFF * D, D, 64 * kb, 32 * grp, wl + W_2 + (size_t)(32 * grp) * DFF, DFF, scr, lane, 0); }
    }
}
__device__ __forceinline__ void prologue_ada(const Args& a, LAS unsigned char* lds, int tid) {
    LAS float* sl = (LAS float*)lds;
    LAS float* red = (LAS float*)(lds + 40960);
    float* mod = (float*)(a.ws + WS_MOD);
    for (int i = tid; i < 5 * D; i += NT) { const int j = i / D, k = i % D; const float x = j == 0 ? a.in[11][k] : a.in[10][(j - 1) * D + k]; sl[i] = x / (1.f + __expf(-x)); }
    __syncthreads();
    const int ks = tid >> 6, c = tid & 63;
    for (int unit = blockIdx.x; unit < DEPTH * 6 * D / 64; unit += gridDim.x) {
        const int l = unit / (6 * D / 64), n0 = (unit % (6 * D / 64)) * 64;
        const float* w = a.in[12] + (size_t)l * D * 6 * D + n0 + c;
        float acc[5] = {0.f, 0.f, 0.f, 0.f, 0.f};
#pragma unroll 4
        for (int k = ks * 256; k < ks * 256 + 256; ++k) { const float wv = w[(size_t)k * 6 * D];
#pragma unroll
            for (int j = 0; j < 5; ++j) acc[j] += sl[j * D + k] * wv; }
#pragma unroll
        for (int j = 0; j < 5; ++j) red[(ks * 5 + j) * 64 + c] = acc[j];
        __syncthreads();
        if (tid < 320) { const int j = tid >> 6; float s = 0.f;
#pragma unroll
            for (int q = 0; q < 8; ++q) s += red[(q * 5 + j) * 64 + c];
            mod[((size_t)l * 5 + j) * 6 * D + n0 + c] = s + a.in[13][l * 6 * D + n0 + c]; }
        __syncthreads();
    }
}
__device__ __forceinline__ void norm_phase(const float* xp, const float* xs, const float* g, const float* modl, int sh_off, int sc_off, bf16_t* H, int gw, int ngw, int lane_) {
    int lane = lane_; asm volatile("" : "+v"(lane));
    for (int row = gw; row < M; row += ngw) {
        const float* x = row < MP ? xp + (size_t)row * D : xs + (size_t)(row - MP) * D;
        f32x4 v[8]; float ss = 0.f;
#pragma unroll
        for (int j = 0; j < 8; ++j) { v[j] = *(const f32x4*)(x + 4 * (lane + 64 * j)); ss += (v[j][0] * v[j][0] + v[j][1] * v[j][1]) + (v[j][2] * v[j][2] + v[j][3] * v[j][3]); }
        const float r = rsqrtf(wave_sum(ss) * (1.f / D) + 1e-6f);
        const float* md = modl + (size_t)row_cvec(row) * 6 * D;
#pragma unroll
        for (int j = 0; j < 8; ++j) { const int i = 4 * (lane + 64 * j);
            const f32x4 gg = *(const f32x4*)(g + i), sc = *(const f32x4*)(md + sc_off + i), sh = *(const f32x4*)(md + sh_off + i);
            const f32x4 o = v[j] * r * gg * (sc + 1.f) + sh;
            u32x2 w; w.x = pk2(o[0], o[1]); w.y = pk2(o[2], o[3]); *(u32x2*)(H + (size_t)row * D + i) = w; }
    }
}

}
namespace mk {
constexpr size_t WS_NAT = AL(WS_SCR);
constexpr int NATP = 2048, N_XBC = 0, N_Q = 1024, N_K = 1536;
constexpr size_t WS_TR = AL(WS_NAT + (size_t)M * NATP * 2);
constexpr int T_X = 0, T_B = 512, T_K = 768, T_MV = 1280, T_V = 1792, TRR = 2304;
constexpr int NCH = 96;
constexpr size_t WS_MLC = AL(WS_TR + (size_t)TRR * M * 2);
constexpr size_t WS_MLN = AL(WS_MLC + (size_t)NCH * 4 * 2 * 16384 * 4);
constexpr size_t WS_MLS = AL(WS_MLN + (size_t)NCH * 4 * 2 * 128 * 4);
constexpr size_t WS_MLCS = AL(WS_MLS + (size_t)NCH * 4 * 2 * 4 * 4);
constexpr size_t WS_MLNS = AL(WS_MLCS + (size_t)NCH * 4 * 2 * 16384 * 2);
constexpr size_t WS_MLMS = AL(WS_MLNS + (size_t)NCH * 4 * 2 * 128 * 4);
constexpr size_t WS_OPT_END = AL(WS_MLMS + (size_t)NCH * 4 * 2 * 4);

__device__ __forceinline__ f32x4 mfma16(bf16x8 a, bf16x8 b, f32x4 c) { return __builtin_amdgcn_mfma_f32_16x16x32_bf16(a, b, c, 0, 0, 0); }
__device__ __forceinline__ void chunk_info(int ch, int& row0, int& seq0, int& L, int& lat, int& b, int& ci, int& nc) {
    if (ch < 32) { b = ch >> 1; ci = ch & 1; nc = 2; seq0 = b * 256; L = 256; lat = 0; } else { const int c2 = ch - 32; b = c2 >> 4; ci = c2 & 15; nc = 16; seq0 = MP + b * 2048; L = 2048; lat = 1; }
    row0 = seq0 + ci * 128;
}
__device__ __forceinline__ float fast_exp(float x) { return __expf(x); }

__device__ __forceinline__ void prep_phase(const Args& a, int layer, LAS unsigned char* lds, int gw_, int ngw, int wave, int lane_) {
    int lane = lane_, gw = gw_; asm volatile("" : "+v"(lane));
    const bf16_t* PROJ = (const bf16_t*)(a.ws + WS_PROJ); bf16_t* NAT = (bf16_t*)(a.ws + WS_NAT); bf16_t* TR = (bf16_t*)(a.ws + WS_TR);
    LAS bf16_t* tile = (LAS bf16_t*)(lds + wave * 16896); LAS bf16_t* otile = tile + 68 * 64;
    const int c = lane & 7, r8 = lane >> 3;
    const float* cw = a.in[30] + layer * 5 * 1024; const float* cb = a.in[31] + layer * 1024;
    for (int u = gw; u < 48 * 192; u += ngw) {
        const int cg = u / 192, tt = u % 192, m0 = tt * 64;
        const int lat = m0 >= MP; const int seq0 = lat ? MP + ((m0 - MP) / 2048) * 2048 : (m0 / 256) * 256, L = lat ? 2048 : 256, t0 = m0 - seq0;
        int kind, src, natcol = -1, trrow = -1;
        if (cg < 16) { kind = 0; src = P_XBC + 64 * cg; natcol = N_XBC + 64 * cg; if (cg < 12) trrow = T_X + 64 * cg; }
        else if (cg < 24) { kind = 1; src = P_MQ + 64 * (cg - 16); natcol = N_Q + 64 * (cg - 16); }
        else if (cg < 32) { kind = 2; src = P_MK + 64 * (cg - 24); natcol = N_K + 64 * (cg - 24); trrow = T_K + 64 * (cg - 24); }
        else if (cg < 40) { kind = 3; src = P_MV + 64 * (cg - 32); trrow = T_MV + 64 * (cg - 32); }
        else { kind = 3; src = P_V + 64 * (cg - 40); trrow = T_V + 64 * (cg - 40); }
        const int roff = kind == 0 ? -2 : 0, nrows = kind == 0 ? 68 : 64;
#pragma unroll
        for (int i = 0; i < 9; ++i) { const int r = r8 + 8 * i; if (r < nrows) { const int t = t0 + r + roff; u32x4 v = {0u, 0u, 0u, 0u};
                if (t >= 0 && t < L) v = *(const u32x4*)(PROJ + (size_t)(seq0 + t) * PJ + src + 8 * c);
                *(LAS u32x4*)(tile + r * 64 + 8 * c) = v; } }
        LDS_WAIT(); asm volatile("" ::: "memory");
#define PREP_EMIT(i_, r_) do { if (natcol >= 0) *(u32x4*)(NAT + (size_t)(m0 + r8 + 8 * (i_)) * NATP + natcol + 8 * c) = (r_); if (trrow >= 0) *(LAS u32x4*)(otile + (r8 + 8 * (i_)) * 64 + 8 * c) = (r_); } while (0)
        if (kind == 0) {
            float w[5][8], bz[8];
#pragma unroll
            for (int e = 0; e < 8; ++e) { bz[e] = cb[64 * cg + 8 * c + e];
#pragma unroll
                for (int j = 0; j < 5; ++j) w[j][e] = cw[j * 1024 + 64 * cg + 8 * c + e]; }
#pragma unroll 2
            for (int i = 0; i < 8; ++i) { const int tk = r8 + 8 * i; float acc[8];
#pragma unroll
                for (int e = 0; e < 8; ++e) acc[e] = bz[e];
#pragma unroll
                for (int j = 0; j < 5; ++j) { const u32x4 v = *(const LAS u32x4*)(tile + (tk + j) * 64 + 8 * c);
                    acc[0] += bflo(v.x) * w[j][0]; acc[1] += bfhi(v.x) * w[j][1]; acc[2] += bflo(v.y) * w[j][2]; acc[3] += bfhi(v.y) * w[j][3];
                    acc[4] += bflo(v.z) * w[j][4]; acc[5] += bfhi(v.z) * w[j][5]; acc[6] += bflo(v.w) * w[j][6]; acc[7] += bfhi(v.w) * w[j][7]; }
#pragma unroll
                for (int e = 0; e < 8; ++e) acc[e] = fsilu(acc[e]);
                u32x4 rv; rv.x = pk2(acc[0], acc[1]); rv.y = pk2(acc[2], acc[3]); rv.z = pk2(acc[4], acc[5]); rv.w = pk2(acc[6], acc[7]); PREP_EMIT(i, rv); }
        } else if (kind == 3 || !lat) {
            const float sc = kind == 2 ? 0.08838834764831845f : 1.f;
#pragma unroll
            for (int i = 0; i < 8; ++i) { const u32x4 v = *(const LAS u32x4*)(tile + (r8 + 8 * i) * 64 + 8 * c);
                u32x4 rv = v;
                if (kind == 2) { rv.x = pk2(bflo(v.x) * sc, bfhi(v.x) * sc); rv.y = pk2(bflo(v.y) * sc, bfhi(v.y) * sc); rv.z = pk2(bflo(v.z) * sc, bfhi(v.z) * sc); rv.w = pk2(bflo(v.w) * sc, bfhi(v.w) * sc); }
                PREP_EMIT(i, rv); }
        } else {
            const float sc = kind == 2 ? 0.08838834764831845f : 1.f; const int odd = cg & 1;
            float inv[8];
#pragma unroll
            for (int e = 0; e < 8; ++e) inv[e] = exp2f(-(float)(8 * (c & 3) + e) * (13.287712379549449f / 32.f));
#pragma unroll
            for (int i = 0; i < 8; ++i) { const int tk = r8 + 8 * i, t = t0 + tk; const float pos = odd ? (float)(t & 63) : (float)(t >> 6);
                const u32x4 vo = *(const LAS u32x4*)(tile + tk * 64 + 8 * c), vp = *(const LAS u32x4*)(tile + tk * 64 + 8 * (c ^ 4));
                float o[8], p[8], rr[8];
                o[0] = bflo(vo.x); o[1] = bfhi(vo.x); o[2] = bflo(vo.y); o[3] = bfhi(vo.y); o[4] = bflo(vo.z); o[5] = bfhi(vo.z); o[6] = bflo(vo.w); o[7] = bfhi(vo.w);
                p[0] = bflo(vp.x); p[1] = bfhi(vp.x); p[2] = bflo(vp.y); p[3] = bfhi(vp.y); p[4] = bflo(vp.z); p[5] = bfhi(vp.z); p[6] = bflo(vp.w); p[7] = bfhi(vp.w);
#pragma unroll
                for (int e = 0; e < 8; ++e) { const float ang = pos * inv[e], cs = __cosf(ang), sn = __sinf(ang);
                    rr[e] = (c < 4 ? o[e] * cs - p[e] * sn : p[e] * sn + o[e] * cs) * sc; }
                u32x4 rv; rv.x = pk2(rr[0], rr[1]); rv.y = pk2(rr[2], rr[3]); rv.z = pk2(rr[4], rr[5]); rv.w = pk2(rr[6], rr[7]); PREP_EMIT(i, rv); }
        }
        if (trrow >= 0) {
            LDS_WAIT(); asm volatile("" ::: "memory");
            bf16_t* dst = TR + (size_t)(trrow + lane) * M + m0;
#pragma unroll
            for (int j = 0; j < 8; ++j) { unsigned wv[4];
#pragma unroll
                for (int q = 0; q < 4; ++q) { const unsigned lo = otile[(8 * j + 2 * q) * 64 + lane], hi = otile[(8 * j + 2 * q + 1) * 64 + lane]; wv[q] = lo | (hi << 16); }
                u32x4 o; o.x = wv[0]; o.y = wv[1]; o.z = wv[2]; o.w = wv[3]; *(u32x4*)(dst + 8 * j) = o; }
        }
        LDS_WAIT(); asm volatile("" ::: "memory");
    }
}

struct MlGate { float lf0, lf1, ig0, ig1, P0, P1, tot; };
__device__ __forceinline__ float wave_incl_scan(float v, int lane) {
#pragma unroll
    for (int o = 1; o < 64; o <<= 1) { const float t = __shfl_up(v, o); if (lane >= o) v += t; }
    return v;
}
__device__ __forceinline__ float wave_max(float v) {
#pragma unroll
    for (int o = 1; o < 64; o <<= 1) v = fmaxf(v, __shfl_xor(v, o));
    return v;
}
__device__ __forceinline__ MlGate ml_gates(const Args& a, int layer, int row0, int hh, int dir, int lane) {
    const float* SMALL = (const float*)(a.ws + WS_SMALL);
    const float ib = a.in[36][layer * 8 + dir * 4 + hh], fb = a.in[37][layer * 8 + dir * 4 + hh];
    MlGate g;
    const float f0 = SMALL[(size_t)(row0 + lane) * 32 + S_MF + dir * 4 + hh] + fb, f1 = SMALL[(size_t)(row0 + lane + 64) * 32 + S_MF + dir * 4 + hh] + fb;
    g.ig0 = SMALL[(size_t)(row0 + lane) * 32 + S_MI + dir * 4 + hh] + ib; g.ig1 = SMALL[(size_t)(row0 + lane + 64) * 32 + S_MI + dir * 4 + hh] + ib;
    g.lf0 = fminf(f0, 0.f) - log1pf(__expf(-fabsf(f0))); g.lf1 = fminf(f1, 0.f) - log1pf(__expf(-fabsf(f1)));
    const float s0 = wave_incl_scan(g.lf0, lane); const float tot0 = __shfl(s0, 63);
    const float s1 = wave_incl_scan(g.lf1, lane) + tot0;
    g.P0 = s0; g.P1 = s1; g.tot = __shfl(s1, 63);
    return g;
}

__device__ __forceinline__ void ml_states_phase(const Args& a, int layer, int tid_, int G) {
    int tid = tid_; asm volatile("" : "+v"(tid));
    const int lane = tid & 63, wave = __builtin_amdgcn_readfirstlane(tid >> 6), fr = lane & 15, fq = lane >> 4;
    const bf16_t* TR = (const bf16_t*)(a.ws + WS_TR);
    float* MLC = (float*)(a.ws + WS_MLC); float* MLN = (float*)(a.ws + WS_MLN); float* MLS = (float*)(a.ws + WS_MLS);
    for (int u = blockIdx.x; u < NCH * 4; u += G) {
        const int ch = u >> 2, hh = u & 3; int row0, seq0, L, lat, b, ci, nc; chunk_info(ch, row0, seq0, L, lat, b, ci, nc);
#pragma unroll
        for (int dir = 0; dir < 2; ++dir) {
            const MlGate g = ml_gates(a, layer, row0, hh, dir, lane);
            const float w0 = (dir == 0 ? g.tot - g.P0 : g.P0 - g.lf0) + g.ig0, w1 = (dir == 0 ? g.tot - g.P1 : g.P1 - g.lf1) + g.ig1;
            const float mloc = wave_max(fmaxf(w0, w1));
            const float e0 = __expf(w0 - mloc), e1 = __expf(w1 - mloc);
            f32x4 acc[8];
#pragma unroll
            for (int j = 0; j < 8; ++j) acc[j] = (f32x4){0.f, 0.f, 0.f, 0.f};
            float nacc[8];
#pragma unroll
            for (int j = 0; j < 8; ++j) nacc[j] = 0.f;
            const bf16_t* vrow = TR + (size_t)(T_MV + hh * 128 + wave * 16 + fr) * M + row0 + 8 * fq;
#pragma unroll
            for (int ks = 0; ks < 4; ++ks) {
                const bf16x8 af = *(const bf16x8*)(vrow + 32 * ks);
                float ev[8];
#pragma unroll
                for (int j = 0; j < 8; ++j) { const int tok = 32 * ks + 8 * fq + j; const float x0 = __shfl(e0, tok & 63), x1 = __shfl(e1, tok & 63); ev[j] = tok < 64 ? x0 : x1; }
#pragma unroll
                for (int jt = 0; jt < 8; ++jt) {
                    const u32x4 kv = *(const u32x4*)(TR + (size_t)(T_K + hh * 128 + jt * 16 + fr) * M + row0 + 32 * ks + 8 * fq);
                    const float k0 = bflo(kv.x) * ev[0], k1 = bfhi(kv.x) * ev[1], k2 = bflo(kv.y) * ev[2], k3 = bfhi(kv.y) * ev[3], k4 = bflo(kv.z) * ev[4], k5 = bfhi(kv.z) * ev[5], k6 = bflo(kv.w) * ev[6], k7 = bfhi(kv.w) * ev[7];
                    if (wave == 0) nacc[jt] += ((k0 + k1) + (k2 + k3)) + ((k4 + k5) + (k6 + k7));
                    u32x4 kb; kb.x = pk2(k0, k1); kb.y = pk2(k2, k3); kb.z = pk2(k4, k5); kb.w = pk2(k6, k7);
                    acc[jt] = mfma16(af, __builtin_bit_cast(bf16x8, kb), acc[jt]);
                }
            }
            float* cdst = MLC + ((size_t)(ch * 4 + hh) * 2 + dir) * 16384;
#pragma unroll
            for (int jt = 0; jt < 8; ++jt)
#pragma unroll
                for (int i = 0; i < 4; ++i) cdst[(size_t)(wave * 16 + 4 * fq + i) * 128 + jt * 16 + fr] = acc[jt][i];
            if (wave == 0) {
#pragma unroll
                for (int jt = 0; jt < 8; ++jt) { float v = nacc[jt]; v += __shfl_xor(v, 16); v += __shfl_xor(v, 32); if (fq == 0) MLN[((size_t)(ch * 4 + hh) * 2 + dir) * 128 + jt * 16 + fr] = v; }
                if (lane == 0) { MLS[((size_t)(ch * 4 + hh) * 2 + dir) * 4 + 0] = mloc; MLS[((size_t)(ch * 4 + hh) * 2 + dir) * 4 + 1] = g.tot; }
            }
        }
    }
}
__device__ __forceinline__ void ml_scan_phase(const Args& a, int layer, int tid_, int G) {
    int tid = tid_; asm volatile("" : "+v"(tid));
    const float* MLC = (const float*)(a.ws + WS_MLC); const float* MLN = (const float*)(a.ws + WS_MLN); const float* MLS = (const float*)(a.ws + WS_MLS);
    bf16_t* CS = (bf16_t*)(a.ws + WS_MLCS); float* NS = (float*)(a.ws + WS_MLNS); float* MS = (float*)(a.ws + WS_MLMS);
    for (int task = blockIdx.x; task < 256; task += G) {
        int lat, b, hh, dir, part, nparts;
        if (task < 128) { lat = 1; part = task & 3; dir = (task >> 2) & 1; hh = (task >> 3) & 3; b = task >> 5; nparts = 4; }
        else { const int t2 = task - 128; lat = 0; part = 0; dir = t2 & 1; hh = (t2 >> 1) & 3; b = t2 >> 3; nparts = 1; }
        const int nc = lat ? 16 : 2, ch0 = lat ? 32 + b * 16 : b * 2;
        const int nel = 16384 / nparts, e0 = part * nel, per = nel / NT;
        float c[32]; float n = 0.f, m = 0.f;
        const size_t so = (((size_t)b * DEPTH + layer) * 2 + dir) * 4 + hh;
#pragma unroll
        for (int i = 0; i < 32; ++i) if (i < per) { const int e = e0 + i * NT + tid, vd = e >> 7, kd = e & 127; c[i] = lat ? a.in[7][(so * 128 + kd) * 128 + vd] : 0.f; }
        if (tid < 128) n = lat ? a.in[8][so * 128 + tid] : 0.f;
        m = lat ? a.in[9][so] : 0.f;
        for (int s = 0; s < nc; ++s) { const int ci = dir ? nc - 1 - s : s, ch = ch0 + ci; const size_t sb = (size_t)(ch * 4 + hh) * 2 + dir;
#pragma unroll
            for (int i = 0; i < 32; ++i) if (i < per) CS[sb * 16384 + e0 + i * NT + tid] = f2bf(c[i]);
            if (part == 0) { if (tid < 128) NS[sb * 128 + tid] = n; if (tid == 0) MS[sb] = m; }
            const float ml = MLS[sb * 4 + 0], bl = MLS[sb * 4 + 1];
            const float mn = fmaxf(bl + m, ml), fa = __expf(bl + m - mn), fb = __expf(ml - mn);
#pragma unroll
            for (int i = 0; i < 32; ++i) if (i < per) c[i] = fa * c[i] + fb * MLC[sb * 16384 + e0 + i * NT + tid];
            if (tid < 128) n = fa * n + fb * MLN[sb * 128 + tid];
            m = mn; }
        if (!lat) {
#pragma unroll
            for (int i = 0; i < 32; ++i) if (i < per) { const int e = e0 + i * NT + tid, vd = e >> 7, kd = e & 127; a.out[O_MLC + (so * 128 + kd) * 128 + vd] = c[i]; }
            if (tid < 128) a.out[O_MLN + so * 128 + tid] = n; if (tid == 0) a.out[O_MLM + so] = m; }
    }
}
__device__ __forceinline__ void ml_out_phase(const Args& a, int layer, LAS unsigned char* lds, int tid_, int G) {
    int tid = tid_; asm volatile("" : "+v"(tid));
    const int lane = tid & 63, wave = __builtin_amdgcn_readfirstlane(tid >> 6), fr = lane & 15, fq = lane >> 4;
    const bf16_t* NAT = (const bf16_t*)(a.ws + WS_NAT); const bf16_t* TR = (const bf16_t*)(a.ws + WS_TR); const bf16_t* PROJ = (const bf16_t*)(a.ws + WS_PROJ);
    const bf16_t* CS = (const bf16_t*)(a.ws + WS_MLCS); const float* NS = (const float*)(a.ws + WS_MLNS); const float* MS = (const float*)(a.ws + WS_MLMS);
    bf16_t* BR = (bf16_t*)(a.ws + WS_BR);
    LAS float* U = (LAS float*)lds; LAS float* Wv = U + 128; LAS float* SI = U + 256; LAS float* EM = U + 384; LAS float* NSs = U + 512;
    for (int u = blockIdx.x; u < NCH * 4; u += G) {
        const int ch = u >> 2, hh = u & 3; int row0, seq0, L, lat, b, ci, nc; chunk_info(ch, row0, seq0, L, lat, b, ci, nc);
        const int t = wave * 16 + fr;
        bf16x8 qf[4];
#pragma unroll
        for (int ks = 0; ks < 4; ++ks) qf[ks] = *(const bf16x8*)(NAT + (size_t)(row0 + t) * NATP + N_Q + hh * 128 + 32 * ks + 8 * fq);
        f32x4 hsum[8];
#pragma unroll
        for (int j = 0; j < 8; ++j) hsum[j] = (f32x4){0.f, 0.f, 0.f, 0.f};
#pragma unroll 1
        for (int dir = 0; dir < 2; ++dir) {
            const size_t sb = (size_t)(ch * 4 + hh) * 2 + dir;
            __syncthreads();
            if (wave == 0) {
                const MlGate g = ml_gates(a, layer, row0, hh, dir, lane); const float ms = MS[sb];
                float u0, u1, c0, c1, ai0, ai1;
                if (dir == 0) { u0 = g.ig0 - g.P0; u1 = g.ig1 - g.P1; c0 = g.P0; c1 = g.P1; ai0 = g.P0 + ms; ai1 = g.P1 + ms; }
                else { const float E0 = g.P0 - g.lf0, E1 = g.P1 - g.lf1; u0 = E0 + g.ig0; u1 = E1 + g.ig1; c0 = -E0; c1 = -E1; ai0 = g.tot - E0 + ms; ai1 = g.tot - E1 + ms; }
                float g0 = u0, g1 = u1;
                if (dir == 0) {
#pragma unroll
                    for (int o = 1; o < 64; o <<= 1) { const float x0 = __shfl_up(g0, o), x1 = __shfl_up(g1, o); if (lane >= o) { g0 = fmaxf(g0, x0); g1 = fmaxf(g1, x1); } }
                    g1 = fmaxf(g1, __shfl(g0, 63));
                } else {
#pragma unroll
                    for (int o = 1; o < 64; o <<= 1) { const float x0 = __shfl_down(g0, o), x1 = __shfl_down(g1, o); if (lane + o < 64) { g0 = fmaxf(g0, x0); g1 = fmaxf(g1, x1); } }
                    g0 = fmaxf(g0, __shfl(g1, 0));
                }
                const float mt0 = fmaxf(ai0, c0 + g0), mt1 = fmaxf(ai1, c1 + g1);
                U[lane] = u0; U[lane + 64] = u1; Wv[lane] = c0 - mt0; Wv[lane + 64] = c1 - mt1;
                SI[lane] = __expf(ai0 - mt0); SI[lane + 64] = __expf(ai1 - mt1); EM[lane] = __expf(-mt0); EM[lane + 64] = __expf(-mt1);
                NSs[lane] = NS[sb * 128 + lane]; NSs[lane + 64] = NS[sb * 128 + lane + 64];
            }
            __syncthreads();
            const float wt = Wv[t], sit = SI[t], emt = EM[t];
            f32x4 acc[8];
#pragma unroll
            for (int j = 0; j < 8; ++j) acc[j] = (f32x4){0.f, 0.f, 0.f, 0.f};
#pragma unroll
            for (int ks = 0; ks < 4; ++ks)
#pragma unroll
                for (int j = 0; j < 8; ++j) { const bf16x8 cf = *(const bf16x8*)(CS + sb * 16384 + (size_t)(16 * j + fr) * 128 + 32 * ks + 8 * fq); acc[j] = mfma16(cf, qf[ks], acc[j]); }
            float qn = 0.f;
#pragma unroll
            for (int ks = 0; ks < 4; ++ks) { const u32x4 qv = __builtin_bit_cast(u32x4, qf[ks]); const LAS float* nn = NSs + 32 * ks + 8 * fq;
                qn += bflo(qv.x) * nn[0] + bfhi(qv.x) * nn[1] + bflo(qv.y) * nn[2] + bfhi(qv.y) * nn[3] + bflo(qv.z) * nn[4] + bfhi(qv.z) * nn[5] + bflo(qv.w) * nn[6] + bfhi(qv.w) * nn[7]; }
            qn += __shfl_xor(qn, 16); qn += __shfl_xor(qn, 32);
#pragma unroll
            for (int j = 0; j < 8; ++j) acc[j] *= sit;
            float den = sit * qn;
            const int jlo = dir == 0 ? 0 : (wave >> 1), jhi = dir == 0 ? (wave >> 1) : 3;
            float psum = 0.f;
            for (int jp = jlo; jp <= jhi; ++jp) {
                const int ta = 32 * jp + 8 * (fr >> 2) + (fr & 3);
                f32x4 sa = (f32x4){0.f, 0.f, 0.f, 0.f}, sb2 = (f32x4){0.f, 0.f, 0.f, 0.f};
#pragma unroll
                for (int ks = 0; ks < 4; ++ks) {
                    const bf16x8 ka = *(const bf16x8*)(NAT + (size_t)(row0 + ta) * NATP + N_K + hh * 128 + 32 * ks + 8 * fq);
                    const bf16x8 kb = *(const bf16x8*)(NAT + (size_t)(row0 + ta + 4) * NATP + N_K + hh * 128 + 32 * ks + 8 * fq);
                    sa = mfma16(ka, qf[ks], sa); sb2 = mfma16(kb, qf[ks], sb2); }
                float pa[4], pb[4];
#pragma unroll
                for (int i = 0; i < 4; ++i) { const int s0 = 32 * jp + 8 * fq + i, s1 = s0 + 4;
                    const bool ok0 = dir == 0 ? s0 <= t : s0 >= t, ok1 = dir == 0 ? s1 <= t : s1 >= t;
                    pa[i] = ok0 ? sa[i] * __expf(U[s0] + wt) : 0.f; pb[i] = ok1 ? sb2[i] * __expf(U[s1] + wt) : 0.f;
                    psum += pa[i] + pb[i]; }
                u32x4 pw; pw.x = pk2(pa[0], pa[1]); pw.y = pk2(pa[2], pa[3]); pw.z = pk2(pb[0], pb[1]); pw.w = pk2(pb[2], pb[3]);
                const bf16x8 pf = __builtin_bit_cast(bf16x8, pw);
#pragma unroll
                for (int j = 0; j < 8; ++j) { const bf16x8 vf = *(const bf16x8*)(TR + (size_t)(T_MV + hh * 128 + 16 * j + fr) * M + row0 + 32 * jp + 8 * fq); acc[j] = mfma16(vf, pf, acc[j]); }
            }
            psum += __shfl_xor(psum, 16); psum += __shfl_xor(psum, 32);
            den += psum;
            const float rden = 1.f / fmaxf(fabsf(den), emt);
#pragma unroll
            for (int j = 0; j < 8; ++j) hsum[j] += acc[j] * rden;
        }
        float ss = 0.f;
#pragma unroll
        for (int j = 0; j < 8; ++j) ss += (hsum[j][0] * hsum[j][0] + hsum[j][1] * hsum[j][1]) + (hsum[j][2] * hsum[j][2] + hsum[j][3] * hsum[j][3]);
        ss += __shfl_xor(ss, 16); ss += __shfl_xor(ss, 32);
        const float r = rsqrtf(ss * (1.f / 128.f) + 1e-6f);
        const float* ng = a.in[38] + layer * 512 + hh * 128;
#pragma unroll
        for (int j = 0; j < 8; ++j) { const int vd = 16 * j + 4 * fq; const f32x4 gg = *(const f32x4*)(ng + vd);
            const u32x2 ov = *(const u32x2*)(PROJ + (size_t)(row0 + t) * PJ + P_MO + hh * 128 + vd);
            const float o0 = hsum[j][0] * r * gg[0] * fsigm(bflo(ov.x)), o1 = hsum[j][1] * r * gg[1] * fsigm(bfhi(ov.x)), o2 = hsum[j][2] * r * gg[2] * fsigm(bflo(ov.y)), o3 = hsum[j][3] * r * gg[3] * fsigm(bfhi(ov.y));
            u32x2 w; w.x = pk2(o0, o1); w.y = pk2(o2, o3); *(u32x2*)(BR + (size_t)(row0 + t) * D + 1536 + hh * 128 + vd) = w; }
    }
}
}
namespace mk {
constexpr size_t WS_SST = WS_OPT_END;
constexpr size_t WS_SSL = AL(WS_SST + (size_t)NCH * 8 * 2 * 8192 * 4);
constexpr size_t WS_SSCS = AL(WS_SSL + (size_t)NCH * 8 * 2 * 4);
constexpr size_t WS_YPRE = AL(WS_SSCS + (size_t)NCH * 8 * 2 * 8192 * 2);
constexpr size_t WS_SSQ = AL(WS_YPRE + (size_t)M * 512 * 4);
constexpr size_t WS_SSD_END = AL(WS_SSQ + (size_t)M * 8 * 4);

struct SsdGate { float dt0, dt1, la0, la1, P0, P1, tot; };
__device__ __forceinline__ SsdGate ssd_gates(const Args& a, int layer, int row0, int hh, int dir, int lane) {
    const float* SMALL = (const float*)(a.ws + WS_SMALL);
    const float bias = a.in[32][layer * 16 + dir * 8 + hh], A = -__expf(a.in[33][layer * 16 + dir * 8 + hh]);
    SsdGate g;
    const float x0 = SMALL[(size_t)(row0 + lane) * 32 + S_DT + dir * 8 + hh] + bias, x1 = SMALL[(size_t)(row0 + lane + 64) * 32 + S_DT + dir * 8 + hh] + bias;
    g.dt0 = fmaxf(x0, 0.f) + log1pf(__expf(-fabsf(x0))); g.dt1 = fmaxf(x1, 0.f) + log1pf(__expf(-fabsf(x1)));
    g.la0 = g.dt0 * A; g.la1 = g.dt1 * A;
    const float s0 = wave_incl_scan(g.la0, lane); const float t0 = __shfl(s0, 63);
    const float s1 = wave_incl_scan(g.la1, lane) + t0;
    g.P0 = s0; g.P1 = s1; g.tot = __shfl(s1, 63);
    return g;
}
__device__ __forceinline__ void ssd_states_phase(const Args& a, int layer, int tid_, int G) {
    int tid = tid_; asm volatile("" : "+v"(tid));
    const int lane = tid & 63, wave = __builtin_amdgcn_readfirstlane(tid >> 6), fr = lane & 15, fq = lane >> 4;
    const bf16_t* TR = (const bf16_t*)(a.ws + WS_TR); float* SST = (float*)(a.ws + WS_SST); float* SSL = (float*)(a.ws + WS_SSL);
    for (int u = blockIdx.x; u < NCH * 8; u += G) {
        const int ch = u >> 3, hh = u & 7, grp = hh >> 2; int row0, seq0, L, lat, b, ci, nc; chunk_info(ch, row0, seq0, L, lat, b, ci, nc);
#pragma unroll
        for (int dir = 0; dir < 2; ++dir) {
            const SsdGate g = ssd_gates(a, layer, row0, hh, dir, lane);
            const float w0 = g.dt0 * __expf(dir == 0 ? g.tot - g.P0 : g.P0 - g.la0), w1 = g.dt1 * __expf(dir == 0 ? g.tot - g.P1 : g.P1 - g.la1);
            f32x4 acc[4];
#pragma unroll
            for (int j = 0; j < 4; ++j) acc[j] = (f32x4){0.f, 0.f, 0.f, 0.f};
#pragma unroll
            for (int ks = 0; ks < 4; ++ks) {
                float ev[8];
#pragma unroll
                for (int j = 0; j < 8; ++j) { const int tok = 32 * ks + 8 * fq + j; const float y0 = __shfl(w0, tok & 63), y1 = __shfl(w1, tok & 63); ev[j] = tok < 64 ? y0 : y1; }
                const u32x4 bv = *(const u32x4*)(TR + (size_t)(T_B + grp * 128 + wave * 16 + fr) * M + row0 + 32 * ks + 8 * fq);
                u32x4 bw; bw.x = pk2(bflo(bv.x) * ev[0], bfhi(bv.x) * ev[1]); bw.y = pk2(bflo(bv.y) * ev[2], bfhi(bv.y) * ev[3]); bw.z = pk2(bflo(bv.z) * ev[4], bfhi(bv.z) * ev[5]); bw.w = pk2(bflo(bv.w) * ev[6], bfhi(bv.w) * ev[7]);
                const bf16x8 bf = __builtin_bit_cast(bf16x8, bw);
#pragma unroll
                for (int j = 0; j < 4; ++j) { const bf16x8 xf = *(const bf16x8*)(TR + (size_t)(T_X + hh * 64 + 16 * j + fr) * M + row0 + 32 * ks + 8 * fq); acc[j] = mfma16(xf, bf, acc[j]); }
            }
            float* dst = SST + ((size_t)(ch * 8 + hh) * 2 + dir) * 8192;
#pragma unroll
            for (int j = 0; j < 4; ++j)
#pragma unroll
                for (int i = 0; i < 4; ++i) dst[(size_t)(16 * j + 4 * fq + i) * 128 + wave * 16 + fr] = acc[j][i];
            if (tid == 0) SSL[(size_t)(ch * 8 + hh) * 2 + dir] = g.tot;
        }
    }
}
__device__ __forceinline__ void ssd_scan_phase(const Args& a, int layer, int tid_, int G) {
    int tid = tid_; asm volatile("" : "+v"(tid));
    const float* SST = (const float*)(a.ws + WS_SST); const float* SSL = (const float*)(a.ws + WS_SSL); bf16_t* CS = (bf16_t*)(a.ws + WS_SSCS);
    for (int task = blockIdx.x; task < 384; task += G) {
        int lat, b, hh, dir, part, nparts;
        if (task < 128) { lat = 1; part = task & 1; dir = (task >> 1) & 1; hh = (task >> 2) & 7; b = task >> 5; nparts = 2; }
        else { const int t2 = task - 128; lat = 0; part = 0; dir = t2 & 1; hh = (t2 >> 1) & 7; b = t2 >> 4; nparts = 1; }
        const int nc = lat ? 16 : 2, ch0 = lat ? 32 + b * 16 : b * 2;
        const int nel = 8192 / nparts, e0 = part * nel, per = nel / NT;
        float c[16];
        const size_t so = ((((size_t)b * DEPTH + layer) * 2 + dir) * 8 + hh) * 8192;
#pragma unroll
        for (int i = 0; i < 16; ++i) if (i < per) c[i] = lat ? a.in[6][so + e0 + i * NT + tid] : 0.f;
        for (int s = 0; s < nc; ++s) { const int ci = dir ? nc - 1 - s : s, ch = ch0 + ci; const size_t sb = (size_t)(ch * 8 + hh) * 2 + dir;
#pragma unroll
            for (int i = 0; i < 16; ++i) if (i < per) CS[sb * 8192 + e0 + i * NT + tid] = f2bf(c[i]);
            const float dec = __expf(SSL[sb]);
#pragma unroll
            for (int i = 0; i < 16; ++i) if (i < per) c[i] = dec * c[i] + SST[sb * 8192 + e0 + i * NT + tid]; }
        if (!lat) {
#pragma unroll
            for (int i = 0; i < 16; ++i) if (i < per) a.out[O_SSD + so + e0 + i * NT + tid] = c[i]; }
    }
}
__device__ __forceinline__ void ssd_out_phase(const Args& a, int layer, LAS unsigned char* lds, int tid_, int G) {
    int tid = tid_; asm volatile("" : "+v"(tid));
    const int lane = tid & 63, wave = __builtin_amdgcn_readfirstlane(tid >> 6), fr = lane & 15, fq = lane >> 4;
    const bf16_t* NAT = (const bf16_t*)(a.ws + WS_NAT); const bf16_t* TR = (const bf16_t*)(a.ws + WS_TR); const bf16_t* PROJ = (const bf16_t*)(a.ws + WS_PROJ);
    const bf16_t* CS = (const bf16_t*)(a.ws + WS_SSCS); float* YPRE = (float*)(a.ws + WS_YPRE); float* SSQ = (float*)(a.ws + WS_SSQ);
    LAS float* U = (LAS float*)(lds + 4096); LAS float* Wv = U + 128; LAS float* DT = U + 256; LAS float* EO = U + 384;
    for (int u = blockIdx.x; u < NCH * 8; u += G) {
        const int ch = u >> 3, hh = u & 7, grp = hh >> 2; int row0, seq0, L, lat, b, ci, nc; chunk_info(ch, row0, seq0, L, lat, b, ci, nc);
        const int t = wave * 16 + fr;
        bf16x8 cf[4];
#pragma unroll
        for (int ks = 0; ks < 4; ++ks) cf[ks] = *(const bf16x8*)(NAT + (size_t)(row0 + t) * NATP + N_XBC + 768 + grp * 128 + 32 * ks + 8 * fq);
        f32x4 ysum[4];
#pragma unroll
        for (int j = 0; j < 4; ++j) ysum[j] = (f32x4){0.f, 0.f, 0.f, 0.f};
#pragma unroll 1
        for (int dir = 0; dir < 2; ++dir) {
            const size_t sb = (size_t)(ch * 8 + hh) * 2 + dir;
            __syncthreads();
            if (wave == 0) {
                const SsdGate g = ssd_gates(a, layer, row0, hh, dir, lane);
                if (dir == 0) { U[lane] = -g.P0; U[lane + 64] = -g.P1; Wv[lane] = g.P0; Wv[lane + 64] = g.P1; EO[lane] = __expf(g.P0); EO[lane + 64] = __expf(g.P1); }
                else { const float E0 = g.P0 - g.la0, E1 = g.P1 - g.la1; U[lane] = E0; U[lane + 64] = E1; Wv[lane] = -E0; Wv[lane + 64] = -E1; EO[lane] = __expf(g.tot - E0); EO[lane + 64] = __expf(g.tot - E1); }
                DT[lane] = g.dt0; DT[lane + 64] = g.dt1;
            }
            __syncthreads();
            const float wt = Wv[t], eot = EO[t];
            f32x4 acc[4];
#pragma unroll
            for (int j = 0; j < 4; ++j) acc[j] = (f32x4){0.f, 0.f, 0.f, 0.f};
#pragma unroll
            for (int ks = 0; ks < 4; ++ks)
#pragma unroll
                for (int j = 0; j < 4; ++j) { const bf16x8 sf = *(const bf16x8*)(CS + sb * 8192 + (size_t)(16 * j + fr) * 128 + 32 * ks + 8 * fq); acc[j] = mfma16(sf, cf[ks], acc[j]); }
#pragma unroll
            for (int j = 0; j < 4; ++j) acc[j] *= eot;
            const int jlo = dir == 0 ? 0 : (wave >> 1), jhi = dir == 0 ? (wave >> 1) : 3;
            for (int jp = jlo; jp <= jhi; ++jp) {
                const int ta = 32 * jp + 8 * (fr >> 2) + (fr & 3);
                f32x4 sa = (f32x4){0.f, 0.f, 0.f, 0.f}, sb2 = (f32x4){0.f, 0.f, 0.f, 0.f};
#pragma unroll
                for (int ks = 0; ks < 4; ++ks) {
                    const bf16x8 ba = *(const bf16x8*)(NAT + (size_t)(row0 + ta) * NATP + N_XBC + 512 + grp * 128 + 32 * ks + 8 * fq);
                    const bf16x8 bb = *(const bf16x8*)(NAT + (size_t)(row0 + ta + 4) * NATP + N_XBC + 512 + grp * 128 + 32 * ks + 8 * fq);
                    sa = mfma16(ba, cf[ks], sa); sb2 = mfma16(bb, cf[ks], sb2); }
                float pa[4], pb[4];
#pragma unroll
                for (int i = 0; i < 4; ++i) { const int s0 = 32 * jp + 8 * fq + i, s1 = s0 + 4;
                    const bool ok0 = dir == 0 ? s0 <= t : s0 >= t, ok1 = dir == 0 ? s1 <= t : s1 >= t;
                    pa[i] = ok0 ? sa[i] * DT[s0] * __expf(U[s0] + wt) : 0.f; pb[i] = ok1 ? sb2[i] * DT[s1] * __expf(U[s1] + wt) : 0.f; }
                u32x4 pw; pw.x = pk2(pa[0], pa[1]); pw.y = pk2(pa[2], pa[3]); pw.z = pk2(pb[0], pb[1]); pw.w = pk2(pb[2], pb[3]);
                const bf16x8 pf = __builtin_bit_cast(bf16x8, pw);
#pragma unroll
                for (int j = 0; j < 4; ++j) { const bf16x8 xf = *(const bf16x8*)(TR + (size_t)(T_X + hh * 64 + 16 * j + fr) * M + row0 + 32 * jp + 8 * fq); acc[j] = mfma16(xf, pf, acc[j]); }
            }
#pragma unroll
            for (int j = 0; j < 4; ++j) ysum[j] += acc[j];
        }
        const float Dh = a.in[34][layer * 8 + hh]; float ss = 0.f;
#pragma unroll
        for (int j = 0; j < 4; ++j) { const int p = 16 * j + 4 * fq;
            const u32x2 xv = *(const u32x2*)(NAT + (size_t)(row0 + t) * NATP + N_XBC + hh * 64 + p), zv = *(const u32x2*)(PROJ + (size_t)(row0 + t) * PJ + P_Z + hh * 64 + p);
            f32x4 y; y[0] = (ysum[j][0] + bflo(xv.x) * Dh) * fsilu(bflo(zv.x)); y[1] = (ysum[j][1] + bfhi(xv.x) * Dh) * fsilu(bfhi(zv.x));
            y[2] = (ysum[j][2] + bflo(xv.y) * Dh) * fsilu(bflo(zv.y)); y[3] = (ysum[j][3] + bfhi(xv.y) * Dh) * fsilu(bfhi(zv.y));
            ss += (y[0] * y[0] + y[1] * y[1]) + (y[2] * y[2] + y[3] * y[3]);
            *(f32x4*)(YPRE + (size_t)(row0 + t) * 512 + hh * 64 + p) = y; }
        ss += __shfl_xor(ss, 16); ss += __shfl_xor(ss, 32);
        if (fq == 0) SSQ[(size_t)(row0 + t) * 8 + hh] = ss;
    }
}
__device__ __forceinline__ void ssd_fin_phase(const Args& a, int layer, int gw, int ngw, int lane_) {
    int lane = lane_; asm volatile("" : "+v"(lane));
    const float* YPRE = (const float*)(a.ws + WS_YPRE); const float* SSQ = (const float*)(a.ws + WS_SSQ); bf16_t* BR = (bf16_t*)(a.ws + WS_BR); const float* ng = a.in[35] + layer * 512;
    for (int row = gw; row < M; row += ngw) {
        float s = lane < 8 ? SSQ[(size_t)row * 8 + lane] : 0.f; s += __shfl_xor(s, 1); s += __shfl_xor(s, 2); s += __shfl_xor(s, 4); s = __shfl(s, 0);
        const float r = rsqrtf(s * (1.f / 512.f) + 1e-6f);
        const f32x4 y0 = *(const f32x4*)(YPRE + (size_t)row * 512 + 8 * lane), y1 = *(const f32x4*)(YPRE + (size_t)row * 512 + 8 * lane + 4);
        const f32x4 g0 = *(const f32x4*)(ng + 8 * lane), g1 = *(const f32x4*)(ng + 8 * lane + 4);
        *(u32x4*)(BR + (size_t)row * D + 1024 + 8 * lane) = pack8(y0 * r * g0, y1 * r * g1);
    }
}
}
namespace mk {
constexpr size_t WS_CK = WS_SSD_END;
constexpr size_t WS_CVT = AL(WS_CK + (size_t)16 * 512 * 512 * 2);
constexpr size_t WS_ATT_END = AL(WS_CVT + (size_t)16 * 512 * 512 * 2);

__device__ __forceinline__ void prologue_cache(const Args& a, int gw, int ngw, int lane) {
    bf16_t* CK = (bf16_t*)(a.ws + WS_CK); bf16_t* CVT = (bf16_t*)(a.ws + WS_CVT);
    for (size_t i = ((size_t)gw * 64 + lane) * 8; i < (size_t)16 * 512 * 512; i += (size_t)ngw * 64 * 8) {
        const f32x4 x0 = *(const f32x4*)(a.in[2] + i), x1 = *(const f32x4*)(a.in[2] + i + 4); *(u32x4*)(CK + i) = pack8(x0, x1); }
    for (size_t i = (size_t)gw * 64 + lane; i < (size_t)16 * 64 * 512; i += (size_t)ngw * 64) { const int c = i & 511, s8 = (i >> 9) & 63, bl = i >> 15;
        const float* src = a.in[3] + ((size_t)bl * 512 + 8 * s8) * 512 + c;
        u32x4 o; o.x = pk2(src[0], src[512]); o.y = pk2(src[1024], src[1536]); o.z = pk2(src[2048], src[2560]); o.w = pk2(src[3072], src[3584]);
        *(u32x4*)(CVT + ((size_t)bl * 512 + c) * 512 + 8 * s8) = o; }
}
struct AttState { float m, l; f32x4 o[4]; };
template <bool MASKED>
__device__ __forceinline__ void attn_group(AttState& st, const bf16x8 (&qf)[2], const bf16_t* kbase, size_t kp, const bf16_t* vt, size_t vp, int fr, int fq,
                                           const float* bias  , int kc0, int cq, int cs) {
    const int ra = 8 * (fr >> 2) + (fr & 3);
    f32x4 sa = (f32x4){0.f, 0.f, 0.f, 0.f}, sb = (f32x4){0.f, 0.f, 0.f, 0.f};
#pragma unroll
    for (int ks = 0; ks < 2; ++ks) { const bf16x8 ka = *(const bf16x8*)(kbase + (size_t)ra * kp + 32 * ks + 8 * fq), kb = *(const bf16x8*)(kbase + (size_t)(ra + 4) * kp + 32 * ks + 8 * fq);
        sa = mfma16(ka, qf[ks], sa); sb = mfma16(kb, qf[ks], sb); }
    float s[8]; float gm = -1e30f;
#pragma unroll
    for (int i = 0; i < 4; ++i) { s[i] = sa[i] * 0.125f; s[4 + i] = sb[i] * 0.125f; }
    if (MASKED) {
#pragma unroll
        for (int e = 0; e < 8; ++e) { const int kc = kc0 + 8 * fq + e; const bool ok = kc >= cs && kc < cs + 16; const int bi = min(max(kc - cq + 15, 0), 30); s[e] = ok ? s[e] + bias[bi] : -1e30f; }
    }
#pragma unroll
    for (int e = 0; e < 8; ++e) gm = fmaxf(gm, s[e]);
    gm = fmaxf(gm, __shfl_xor(gm, 16)); gm = fmaxf(gm, __shfl_xor(gm, 32));
    const float mn = fmaxf(st.m, gm), al = __expf(st.m - mn); st.m = mn;
    float p[8], ps = 0.f;
#pragma unroll
    for (int e = 0; e < 8; ++e) { p[e] = __expf(s[e] - mn); ps += p[e]; }
    st.l = st.l * al + ps;
    u32x4 pw; pw.x = pk2(p[0], p[1]); pw.y = pk2(p[2], p[3]); pw.z = pk2(p[4], p[5]); pw.w = pk2(p[6], p[7]);
    const bf16x8 pf = __builtin_bit_cast(bf16x8, pw);
#pragma unroll
    for (int j = 0; j < 4; ++j) { const bf16x8 vf = *(const bf16x8*)(vt + (size_t)(16 * j + fr) * vp + 8 * fq); st.o[j] = mfma16(vf, pf, st.o[j] * al); }
}
__device__ __forceinline__ void attn_phase(const Args& a, int layer, int gw_, int ngw, int lane_) {
    int lane = lane_, gw = gw_; asm volatile("" : "+v"(lane));
    const int fr = lane & 15, fq = lane >> 4;
    const bf16_t* PROJ = (const bf16_t*)(a.ws + WS_PROJ); const bf16_t* TR = (const bf16_t*)(a.ws + WS_TR); bf16_t* BR = (bf16_t*)(a.ws + WS_BR);
    const bf16_t* CK = (const bf16_t*)(a.ws + WS_CK); const bf16_t* CVT = (const bf16_t*)(a.ws + WS_CVT);
    for (int it = gw; it < 6144; it += ngw) {
        AttState st; st.m = -1e30f; st.l = 0.f;
#pragma unroll
        for (int j = 0; j < 4; ++j) st.o[j] = (f32x4){0.f, 0.f, 0.f, 0.f};
        int qrow, hh;
        if (it < 4096) {
            const int jq = it & 3, r = (it >> 2) & 31; hh = (it >> 7) & 7; const int b = it >> 10;
            const int seq0 = MP + b * 2048; qrow = seq0 + r * 64 + 16 * jq + fr;
            bf16x8 qf[2];
#pragma unroll
            for (int ks = 0; ks < 2; ++ks) qf[ks] = *(const bf16x8*)(PROJ + (size_t)qrow * PJ + P_Q + hh * 64 + 32 * ks + 8 * fq);
            const int rs = min(max(r - 4, 0), 24), cq = 16 * jq + fr, cs = min(max(cq - 8, 0), 48);
            const int kc0 = jq == 0 ? 0 : (jq == 1 ? 8 : (jq == 2 ? 24 : 32));
            const float* rpb = a.in[19] + ((size_t)layer * 8 + hh) * 15 * 31;
            for (int j = 0; j < 8; ++j) { const int kr = rs + j, tok0 = seq0 + kr * 64 + kc0;
                attn_group<true>(st, qf, PROJ + (size_t)tok0 * PJ + P_K + hh * 64, PJ, TR + (size_t)(T_V + hh * 64) * M + tok0, M, fr, fq, rpb + (kr - r + 7) * 31, kc0, cq, cs); }
            const size_t cb = ((size_t)b * DEPTH + layer) * 512;
            for (int g = 0; g < 16; ++g)
                attn_group<false>(st, qf, CK + (cb + 32 * g) * 512 + hh * 64, 512, CVT + (cb + hh * 64) * 512 + 32 * g, 512, fr, fq, nullptr, 0, 0, 0);
        } else {
            const int i2 = it - 4096, qt = i2 & 15; hh = (i2 >> 4) & 7; const int b = i2 >> 7, seq0 = b * 256; qrow = seq0 + 16 * qt + fr;
            bf16x8 qf[2];
#pragma unroll
            for (int ks = 0; ks < 2; ++ks) qf[ks] = *(const bf16x8*)(PROJ + (size_t)qrow * PJ + P_Q + hh * 64 + 32 * ks + 8 * fq);
            for (int g = 0; g < 8; ++g) { const int tok0 = seq0 + 32 * g;
                attn_group<false>(st, qf, PROJ + (size_t)tok0 * PJ + P_K + hh * 64, PJ, TR + (size_t)(T_V + hh * 64) * M + tok0, M, fr, fq, nullptr, 0, 0, 0); }
        }
        float l = st.l; l += __shfl_xor(l, 16); l += __shfl_xor(l, 32);
        const float rl = 1.f / l;
#pragma unroll
        for (int j = 0; j < 4; ++j) { u32x2 w; w.x = pk2(st.o[j][0] * rl, st.o[j][1] * rl); w.y = pk2(st.o[j][2] * rl, st.o[j][3] * rl);
            *(u32x2*)(BR + (size_t)qrow * D + hh * 64 + 16 * j + 4 * fq) = w; }
    }
}
}
namespace mk {
constexpr int S5K = 768;
constexpr size_t WS_S5W = WS_ATT_END;
constexpr size_t WS_S5WS = AL(WS_S5W + (size_t)32 * 512 * S5K * 2);
constexpr size_t WS_S5AP = AL(WS_S5WS + (size_t)32 * 256 * 512 * 2);
constexpr size_t WS_S5SS = AL(WS_S5AP + (size_t)32 * 2 * 64 * 2 * 4);
constexpr size_t WS_S5HS = AL(WS_S5SS + (size_t)32 * 384 * 256 * 4);
constexpr size_t WS_S5_END = AL(WS_S5HS + (size_t)32 * 384 * 256 * 2);

__device__ __forceinline__ void s5_param_phase(const Args& a, int layer, LAS unsigned char* lds, int tid_, int G) {
    int tid = tid_; asm volatile("" : "+v"(tid));
    LAS float* PW = (LAS float*)lds; LAS float* BB = PW + 2 * 33 * 64 * 2; LAS float* CC = BB + 2 * 64 * 16 * 2; LAS float* KT = CC + 2 * 16 * 64 * 2;
    const float* a_re = a.in[20] + layer * 4096; const float* a_im = a.in[21] + layer * 4096; const float* log_dt = a.in[22] + layer * 64;
    const float* b_re = a.in[23] + (size_t)layer * 65536; const float* b_im = a.in[24] + (size_t)layer * 65536; const float* c_re = a.in[25] + (size_t)layer * 65536; const float* c_im = a.in[26] + (size_t)layer * 65536;
    const float* s5d = a.in[27] + layer * 512;
    bf16_t* S5W = (bf16_t*)(a.ws + WS_S5W); bf16_t* S5WS = (bf16_t*)(a.ws + WS_S5WS); float* S5AP = (float*)(a.ws + WS_S5AP);
    for (int g = blockIdx.x; g < 32; g += G) {
        __syncthreads();
        if (tid < 128) { const int dir = tid >> 6, n = tid & 63, pi = (dir * 32 + g) * 64 + n;
            const float are = fminf(a_re[pi], -1e-4f), aim = a_im[pi], dt = expf(log_dt[dir * 32 + g]);
            const float mag = expf(dt * are), abr = mag * cosf(dt * aim), abi = mag * sinf(dt * aim);
            const float den = are * are + aim * aim, nr = abr - 1.f, cfr = (nr * are + abi * aim) / den, cfi = (abi * are - nr * aim) / den;
            float pr = 1.f, pim = 0.f;
            for (int p = 0; p <= 32; ++p) { PW[((dir * 33 + p) * 64 + n) * 2] = pr; PW[((dir * 33 + p) * 64 + n) * 2 + 1] = pim; const float t = pr * abr - pim * abi; pim = pr * abi + pim * abr; pr = t; }
            S5AP[((g * 2 + dir) * 64 + n) * 2] = PW[((dir * 33 + 32) * 64 + n) * 2]; S5AP[((g * 2 + dir) * 64 + n) * 2 + 1] = PW[((dir * 33 + 32) * 64 + n) * 2 + 1];
            for (int k = 0; k < 16; ++k) { const float br_ = b_re[(size_t)pi * 16 + k], bi_ = b_im[(size_t)pi * 16 + k];
                BB[((dir * 64 + n) * 16 + k) * 2] = cfr * br_ - cfi * bi_; BB[((dir * 64 + n) * 16 + k) * 2 + 1] = cfr * bi_ + cfi * br_; }
            for (int j = 0; j < 16; ++j) { CC[((dir * 16 + j) * 64 + n) * 2] = c_re[((size_t)(dir * 32 + g) * 16 + j) * 64 + n]; CC[((dir * 16 + j) * 64 + n) * 2 + 1] = c_im[((size_t)(dir * 32 + g) * 16 + j) * 64 + n]; }
        }
        __syncthreads();
        for (int e = tid; e < 2 * 32 * 256; e += NT) { const int j = e & 15, k = (e >> 4) & 15, tau = (e >> 8) & 31, dir = e >> 13; float s = 0.f;
            for (int n = 0; n < 64; ++n) { const float cr = CC[((dir * 16 + j) * 64 + n) * 2], ci = CC[((dir * 16 + j) * 64 + n) * 2 + 1], pr = PW[((dir * 33 + tau) * 64 + n) * 2], pim = PW[((dir * 33 + tau) * 64 + n) * 2 + 1];
                const float xr = cr * pr - ci * pim, xi = cr * pim + ci * pr, br_ = BB[((dir * 64 + n) * 16 + k) * 2], bi_ = BB[((dir * 64 + n) * 16 + k) * 2 + 1];
                s += xr * br_ - xi * bi_; }
            KT[e] = s; }
        __syncthreads();
        { const int t = tid >> 4, j = tid & 15; bf16_t* dst = S5W + ((size_t)g * 512 + tid) * S5K;
            for (int s = 0; s < 32; ++s) { float v[16];
#pragma unroll
                for (int k = 0; k < 16; ++k) { float x;
                    if (s < t) x = KT[((0 * 32 + (t - s)) * 16 + k) * 16 + j]; else if (s > t) x = KT[((1 * 32 + (s - t)) * 16 + k) * 16 + j];
                    else x = KT[((0 * 32 + 0) * 16 + k) * 16 + j] + KT[((1 * 32 + 0) * 16 + k) * 16 + j] + (k == j ? s5d[g * 16 + k] : 0.f);
                    v[k] = x; }
                u32x4 o0, o1; o0.x = pk2(v[0], v[1]); o0.y = pk2(v[2], v[3]); o0.z = pk2(v[4], v[5]); o0.w = pk2(v[6], v[7]); o1.x = pk2(v[8], v[9]); o1.y = pk2(v[10], v[11]); o1.z = pk2(v[12], v[13]); o1.w = pk2(v[14], v[15]);
                *(u32x4*)(dst + s * 16) = o0; *(u32x4*)(dst + s * 16 + 8) = o1; }
            for (int dir = 0; dir < 2; ++dir) { const int p = dir == 0 ? t + 1 : 32 - t;
                for (int n8 = 0; n8 < 8; ++n8) { float gr[8], gi[8];
#pragma unroll
                    for (int q = 0; q < 8; ++q) { const int n = n8 * 8 + q; const float cr = CC[((dir * 16 + j) * 64 + n) * 2], ci = CC[((dir * 16 + j) * 64 + n) * 2 + 1], pr = PW[((dir * 33 + p) * 64 + n) * 2], pim = PW[((dir * 33 + p) * 64 + n) * 2 + 1];
                        gr[q] = cr * pr - ci * pim; gi[q] = -(cr * pim + ci * pr); }
                    u32x4 o; o.x = pk2(gr[0], gr[1]); o.y = pk2(gr[2], gr[3]); o.z = pk2(gr[4], gr[5]); o.w = pk2(gr[6], gr[7]); *(u32x4*)(dst + 512 + dir * 128 + n8 * 8) = o;
                    o.x = pk2(gi[0], gi[1]); o.y = pk2(gi[2], gi[3]); o.z = pk2(gi[4], gi[5]); o.w = pk2(gi[6], gi[7]); *(u32x4*)(dst + 512 + dir * 128 + 64 + n8 * 8) = o; } }
        }
        if (tid < 256) { const int dir = tid >> 7, reim = (tid >> 6) & 1, n = tid & 63; bf16_t* dst = S5WS + ((size_t)g * 256 + tid) * 512;
            for (int s = 0; s < 32; ++s) { const int p = dir == 0 ? 31 - s : s; const float pr = PW[((dir * 33 + p) * 64 + n) * 2], pim = PW[((dir * 33 + p) * 64 + n) * 2 + 1]; float v[16];
#pragma unroll
                for (int k = 0; k < 16; ++k) { const float br_ = BB[((dir * 64 + n) * 16 + k) * 2], bi_ = BB[((dir * 64 + n) * 16 + k) * 2 + 1]; v[k] = reim == 0 ? pr * br_ - pim * bi_ : pr * bi_ + pim * br_; }
                u32x4 o0, o1; o0.x = pk2(v[0], v[1]); o0.y = pk2(v[2], v[3]); o0.z = pk2(v[4], v[5]); o0.w = pk2(v[6], v[7]); o1.x = pk2(v[8], v[9]); o1.y = pk2(v[10], v[11]); o1.z = pk2(v[12], v[13]); o1.w = pk2(v[14], v[15]);
                *(u32x4*)(dst + s * 16) = o0; *(u32x4*)(dst + s * 16 + 8) = o1; } }
    }
    __syncthreads();
}
__device__ __forceinline__ bf16x8 s5_ufrag(const bf16_t* PROJ, int g, int cg, int ks, int fq) {
    return *(const bf16x8*)(PROJ + (size_t)(32 * cg + 2 * ks + (fq >> 1)) * PJ + P_S5U + g * 16 + 8 * (fq & 1));
}
__device__ __forceinline__ void s5_statein_phase(const Args& a, int tid_, int G) {
    int tid = tid_; asm volatile("" : "+v"(tid));
    const int lane = tid & 63, wave = __builtin_amdgcn_readfirstlane(tid >> 6), fr = lane & 15, fq = lane >> 4;
    const bf16_t* PROJ = (const bf16_t*)(a.ws + WS_PROJ); const bf16_t* S5WS = (const bf16_t*)(a.ws + WS_S5WS); float* SS = (float*)(a.ws + WS_S5SS);
    for (int u = blockIdx.x; u < 96; u += G) { const int g = u / 3, ct = (u % 3) * 8 + wave, cg = 16 * ct + fr;
        bf16x8 uf[16];
#pragma unroll
        for (int ks = 0; ks < 16; ++ks) uf[ks] = s5_ufrag(PROJ, g, cg, ks, fq);
        for (int ot = 0; ot < 16; ++ot) { f32x4 acc = (f32x4){0.f, 0.f, 0.f, 0.f};
#pragma unroll
            for (int ks = 0; ks < 16; ++ks) { const bf16x8 wf = *(const bf16x8*)(S5WS + ((size_t)g * 256 + 16 * ot + fr) * 512 + 32 * ks + 8 * fq); acc = mfma16(wf, uf[ks], acc); }
            *(f32x4*)(SS + ((size_t)g * 384 + cg) * 256 + 16 * ot + 4 * fq) = acc; }
    }
}
__device__ __forceinline__ void s5_scan_phase(const Args& a, int layer, int gw, int ngw, int lane_) {
    int lane = lane_; asm volatile("" : "+v"(lane));
    const float* SS = (const float*)(a.ws + WS_S5SS); bf16_t* HS = (bf16_t*)(a.ws + WS_S5HS); const float* S5AP = (const float*)(a.ws + WS_S5AP);
    for (int task = gw; task < 1280; task += ngw) {
        int sq, g, dir; if (task < 256) { sq = 16 + (task >> 6); g = (task >> 1) & 31; dir = task & 1; } else { const int t2 = task - 256; sq = t2 >> 6; g = (t2 >> 1) & 31; dir = t2 & 1; }
        const int lat = sq >= 16, b = lat ? sq - 16 : sq, nc = lat ? 64 : 8, cg0 = lat ? 128 + b * 64 : b * 8;
        const float apr = S5AP[((g * 2 + dir) * 64 + lane) * 2], api = S5AP[((g * 2 + dir) * 64 + lane) * 2 + 1];
        float hr = 0.f, hi = 0.f;
        if (lat) { const size_t so = ((((size_t)b * DEPTH + layer) * 2 + dir) * 32 + g) * 64 + lane; hr = a.in[4][so]; hi = a.in[5][so]; }
        for (int s = 0; s < nc; ++s) { const int cg = cg0 + (dir ? nc - 1 - s : s); const size_t base = ((size_t)g * 384 + cg) * 256 + dir * 128;
            HS[base + lane] = f2bf(hr); HS[base + 64 + lane] = f2bf(hi);
            const float sr = SS[base + lane], si = SS[base + 64 + lane];
            const float t = apr * hr - api * hi + sr; hi = apr * hi + api * hr + si; hr = t; }
        if (!lat) { const size_t oo = ((((size_t)b * DEPTH + layer) * 2 + dir) * 32 + g) * 64 + lane; a.out[O_S5R + oo] = hr; a.out[O_S5I + oo] = hi; }
    }
}
__device__ __forceinline__ void s5_out_phase(const Args& a, int tid_, int G) {
    int tid = tid_; asm volatile("" : "+v"(tid));
    const int lane = tid & 63, wave = __builtin_amdgcn_readfirstlane(tid >> 6), fr = lane & 15, fq = lane >> 4;
    const bf16_t* PROJ = (const bf16_t*)(a.ws + WS_PROJ); const bf16_t* S5W = (const bf16_t*)(a.ws + WS_S5W); const bf16_t* HS = (const bf16_t*)(a.ws + WS_S5HS); bf16_t* ZB = (bf16_t*)(a.ws + WS_ZB);
    for (int u = blockIdx.x; u < 96; u += G) { const int g = u / 3, ct = (u % 3) * 8 + wave, cg = 16 * ct + fr;
        bf16x8 uf[24];
#pragma unroll
        for (int ks = 0; ks < 16; ++ks) uf[ks] = s5_ufrag(PROJ, g, cg, ks, fq);
#pragma unroll
        for (int ks = 0; ks < 8; ++ks) uf[16 + ks] = *(const bf16x8*)(HS + ((size_t)g * 384 + cg) * 256 + 32 * ks + 8 * fq);
        for (int ot = 0; ot < 32; ++ot) { f32x4 acc = (f32x4){0.f, 0.f, 0.f, 0.f};
#pragma unroll
            for (int ks = 0; ks < 24; ++ks) { const bf16x8 wf = *(const bf16x8*)(S5W + ((size_t)g * 512 + 16 * ot + fr) * S5K + 32 * ks + 8 * fq); acc = mfma16(wf, uf[ks], acc); }
            float z[4];
#pragma unroll
            for (int i = 0; i < 4; ++i) { const float x = acc[i]; const float th = 0.7978845608028654f * (x + 0.044715f * x * x * x); const float e2 = __expf(2.f * th); const float tnh = 1.f - 2.f * __builtin_amdgcn_rcpf(e2 + 1.f); z[i] = 0.5f * x * (1.f + tnh); }
            u32x2 w; w.x = pk2(z[0], z[1]); w.y = pk2(z[2], z[3]);
            *(u32x2*)(ZB + (size_t)(32 * cg + ot) * 512 + g * 16 + 4 * fq) = w; }
    }
}
}
namespace mk { static_assert(WS_S5_END < (size_t)1780 * 1024 * 1024, "workspace map exceeds the guaranteed size"); }
namespace mk {
#ifndef PHMASK
#define PHMASK 0xfffff
#endif
#define PHM(k) ((PHMASK >> (k)) & 1)
constexpr int NPH = 12;
constexpr int PH_TOTAL = 1 + DEPTH * NPH;
__global__ void __launch_bounds__(NT, 2) mk_fwd(Args a) {
    extern __shared__ __attribute__((aligned(16))) unsigned char lds_raw[];
    LAS unsigned char* lds = (LAS unsigned char*)lds_raw;
#define TID ((int)threadIdx.x)
#define LANE ((int)(threadIdx.x & 63))
#define WAVE (__builtin_amdgcn_readfirstlane((int)(threadIdx.x >> 6)))
#define GW ((int)blockIdx.x * NWV + WAVE)
    const int G = gridDim.x, ngw = G * NWV;
    volatile LAS unsigned* ctlw = (volatile LAS unsigned*)(lds + LDS_CTL);
    if (TID < 4) ctlw[TID] = 0u;
    __syncthreads();
    XcdBarrier bar = xcd_barrier_post((unsigned*)(a.ws + WS_CTL), ctlw);
    const int lo = a.ph_lo, hi = a.ph_hi;
#define IN(k) (lo <= (k) && (k) < hi)
#define SEAM(k) do { if (IN(k) && IN((k) + 1)) xcd_barrier(bar); } while (0)
    unsigned char* ws = a.ws;
    bf16_t* H = (bf16_t*)(ws + WS_H); bf16_t* PROJ = (bf16_t*)(ws + WS_PROJ); float* SMALL = (float*)(ws + WS_SMALL); bf16_t* BR = (bf16_t*)(ws + WS_BR);
    bf16_t* MERGED = (bf16_t*)(ws + WS_MERGED); float* MACC = (float*)(ws + WS_MACC); bf16_t* ZB = (bf16_t*)(ws + WS_ZB); bf16_t* HID = PROJ;
    const float* MOD = (const float*)(ws + WS_MOD); float* X = a.out;
    if (PHM(0) && IN(0)) { prologue_convert(a, lds, GW, ngw, WAVE, LANE); prologue_cache(a, GW, ngw, LANE); __syncthreads(); prologue_ada(a, lds, TID); }
    SEAM(0);
    for (int l = 0; l < DEPTH; ++l) {
        const int pb = 1 + l * NPH;
        const float* xp = l == 0 ? a.in[0] : X; const float* xs = l == 0 ? a.in[1] : X + (size_t)MP * D;
        const float* modl = MOD + (size_t)l * 5 * 6 * D;
        const bf16_t* wl = (const bf16_t*)(ws + WS_W) + (size_t)l * W_LAYER;
        if (PHM(1) && IN(pb + 0)) norm_phase(xp, xs, a.in[14] + l * D, modl, 0, D, H, GW, ngw, LANE);
        SEAM(pb + 0);
        if (PHM(2) && IN(pb + 1)) { Gemm g{H, wl + W_IN, M, NIN, D, D, 1, 0, 0}; StaticOrder S; S.init(M, NIN, G, blockIdx.x);
            EpiIn E{PROJ, SMALL, a.out, a.in[17] + l * 64, a.in[18] + l * 64, l}; gemm_phase(lds, g, S, E); }
        SEAM(pb + 1);
        if (PHM(3) && IN(pb + 2)) { prep_phase(a, l, lds, GW, ngw, WAVE, LANE); s5_param_phase(a, l, lds, TID, G); }
        SEAM(pb + 2);
        if (PHM(4) && IN(pb + 3)) { attn_phase(a, l, GW, ngw, LANE); ml_states_phase(a, l, TID, G); ssd_states_phase(a, l, TID, G); s5_statein_phase(a, TID, G); }
        SEAM(pb + 3);
        if (PHM(5) && IN(pb + 4)) { ml_scan_phase(a, l, TID, G); ssd_scan_phase(a, l, TID, G); s5_scan_phase(a, l, GW, ngw, LANE); }
        SEAM(pb + 4);
        if (PHM(12) && IN(pb + 5)) { ml_out_phase(a, l, lds, TID, G); ssd_out_phase(a, l, lds, TID, G); s5_out_phase(a, TID, G); }
        SEAM(pb + 5);
        if (PHM(6) && IN(pb + 6)) { Gemm g{ZB, wl + W_GLU, M, 512, 512, 512, 1, 0, 0}; StaticOrder S; S.init(M, 512, G, blockIdx.x);
            EpiGlu E{ZB, a.in[29] + l * 512, BR}; gemm_phase(lds, g, S, E); ssd_fin_phase(a, l, GW, ngw, LANE); }
        SEAM(pb + 6);
        if (PHM(7) && IN(pb + 7)) { Gemm g{BR, wl + W_BR, M, D, 512, D, 4, 512, (size_t)D * 512}; StaticOrder S; S.init(M, D, G, blockIdx.x, 4);
            EpiBranch E{PROJ, MACC, MERGED}; gemm_phase(lds, g, S, E); }
        SEAM(pb + 7);
        if (PHM(8) && IN(pb + 8)) { Gemm g{MERGED, wl + W_OUT, M, D, D, D, 1, 0, 0}; StaticOrder S; S.init(M, D, G, blockIdx.x);
            EpiResid E{xp, xs, modl, 2 * D, X}; gemm_phase(lds, g, S, E); }
        SEAM(pb + 8);
        if (PHM(9) && IN(pb + 9)) norm_phase(X, X + (size_t)MP * D, a.in[15] + l * D, modl, 3 * D, 4 * D, H, GW, ngw, LANE);
        SEAM(pb + 9);
        if (PHM(10) && IN(pb + 10)) { Gemm g{H, wl + W_1, M, DFF, D, D, 1, 0, 0}; StaticOrder S; S.init(M, DFF, G, blockIdx.x);
            EpiRelu2 E{HID, DFF}; gemm_phase(lds, g, S, E); }
        SEAM(pb + 10);
        if (PHM(11) && IN(pb + 11)) { Gemm g{HID, wl + W_2, M, D, DFF, DFF, 1, 0, 0}; StaticOrder S; S.init(M, D, G, blockIdx.x);
            EpiResid E{X, X + (size_t)MP * D, modl, 5 * D, X}; gemm_phase(lds, g, S, E); }
        SEAM(pb + 11);
    }
#undef IN
#undef SEAM
}
}
extern "C" void kernel_launch(void* const* d_in, const int* in_sizes, int n_in, void* d_out, int out_size, void* d_ws, size_t ws_size, hipStream_t stream) {
    static int grid = 0;
    if (grid == 0) {
        int dev = 0, cus = 0; (void)hipGetDevice(&dev); (void)hipDeviceGetAttribute(&cus, hipDeviceAttributeMultiprocessorCount, dev);
        (void)hipFuncSetAttribute((const void*)mk::mk_fwd, hipFuncAttributeMaxDynamicSharedMemorySize, mk::LDS_BYTES);
        int per_cu = 0; (void)hipOccupancyMaxActiveBlocksPerMultiprocessor(&per_cu, (const void*)mk::mk_fwd, mk::NT, mk::LDS_BYTES); (void)hipGetLastError();
        grid = cus > 0 ? cus : 256;
    }
    mk::Args a{}; for (int i = 0; i < 43; ++i) a.in[i] = (const float*)d_in[i];
    a.out = (float*)d_out; a.ws = (unsigned char*)d_ws; a.ph_lo = 0; a.ph_hi = mk::PH_TOTAL;
    (void)hipMemsetAsync(a.ws + mk::WS_CTL, 0, mk::CTL_BYTES, stream);
    hipLaunchKernelGGL(mk::mk_fwd, dim3(grid), dim3(mk::NT), mk::LDS_BYTES, stream, a);
}
```

```cpp
#define SAFE_GEMM 0
#define DUPMASK 0
#include <hip/hip_runtime.h>
#include <math.h>
namespace mk {
#define LAS __attribute__((address_space(3)))
typedef unsigned short bf16_t;
typedef short bf16x8 __attribute__((ext_vector_type(8)));
typedef float f32x4 __attribute__((ext_vector_type(4)));
typedef float f32x2 __attribute__((ext_vector_type(2)));
typedef unsigned u32x4 __attribute__((ext_vector_type(4)));
typedef unsigned u32x2 __attribute__((ext_vector_type(2)));
constexpr int NT = 512, NWV = 8;
constexpr int D = 2048, MP = 4096, MLAT = 8192, M = MP + MLAT, DEPTH = 4, DFF = 8192;
constexpr int PJ = 13824;
constexpr int NIN = 14080;
constexpr int P_Q = 0, P_K = 512, P_V = 1024, P_S5U = 1536, P_Z = 2048, P_XBC = 2560, P_MQ = 3584, P_MK = 4096, P_MV = 4608, P_MO = 5120, P_GATE = 5632;
constexpr int S_DT = 0, S_MI = 16, S_MF = 24;

typedef __bf16 bf16x2_t __attribute__((ext_vector_type(2)));
__device__ __forceinline__ unsigned pk2(float lo, float hi) { f32x2 v = {lo, hi}; bf16x2_t b = __builtin_convertvector(v, bf16x2_t); return __builtin_bit_cast(unsigned, b); }
__device__ __forceinline__ float bf2f(bf16_t v) { return __uint_as_float(((unsigned)v) << 16); }
__device__ __forceinline__ float bflo(unsigned w) { return __uint_as_float(w << 16); }
__device__ __forceinline__ float bfhi(unsigned w) { return __uint_as_float(w & 0xffff0000u); }
__device__ __forceinline__ bf16_t f2bf(float f) { return (bf16_t)(pk2(f, 0.f) & 0xffffu); }
__device__ __forceinline__ float fsigm(float x) { return __builtin_amdgcn_rcpf(1.f + __expf(-x)); }
__device__ __forceinline__ float fsilu(float x) { return x * fsigm(x); }
__device__ __forceinline__ int row_cvec(int row) { return row < MP ? 0 : 1 + (row - MP) / 2048; }

#define XB_TMO      128
#define XB_XCNT(j)  (256  + 64 * (j))
#define XB_XSUB(j)  (1280 + 64 * (j))
#define XB_XGEN(j)  (2304 + 64 * (j))
#define XB_TOP      3328
#define XB_TOPGEN   3392
#define XCD_BAR_WORDS 3456
#define XB_SPIN_CAP (1u << 18)
__device__ __forceinline__ unsigned xb_ld(unsigned* p)              { return __hip_atomic_load(p, __ATOMIC_RELAXED, __HIP_MEMORY_SCOPE_AGENT); }
__device__ __forceinline__ unsigned xb_add(unsigned* p, unsigned v) { return __hip_atomic_fetch_add(p, v, __ATOMIC_RELAXED, __HIP_MEMORY_SCOPE_AGENT); }
__device__ __forceinline__ unsigned xb_xcc_id() { return (unsigned)__builtin_amdgcn_s_getreg((3 << 11) | 20) & 0xFu; }
#define XB_SPIN(cond, bar) do { unsigned _sp = 0; while (cond) { __builtin_amdgcn_s_sleep(1); \
    if ((++_sp & 255u) == 0u) { if (xb_ld(&(bar)[XB_TMO])) break; if (_sp > XB_SPIN_CAP) { atomicAdd(&(bar)[XB_TMO], 1u); break; } } } } while (0)
struct XcdBarrier { unsigned* bar; unsigned x; volatile LAS unsigned* st; };
__device__ __forceinline__ XcdBarrier xcd_barrier_post(unsigned* bar, volatile LAS unsigned* st) {
    XcdBarrier b; b.bar = bar; b.x = xb_xcc_id(); b.st = st;
    if (threadIdx.x == 0) (void)xb_add(&bar[XB_XCNT(b.x)], 1u);
    return b;
}
__device__ __forceinline__ void xcd_barrier_complete(unsigned* bar, unsigned x, unsigned& nloc, unsigned& nx) {
    const unsigned G = gridDim.x * gridDim.y * gridDim.z;
    unsigned sum, cnt, mine, sp = 0u;
    for (;;) {
        sum = 0u; cnt = 0u; mine = 0u;
#pragma unroll
        for (unsigned j = 0; j < 16; ++j) { const unsigned c = xb_ld(&bar[XB_XCNT(j)]); sum += c; cnt += (c > 0u) ? 1u : 0u; mine = (j == x) ? c : mine; }
        if (sum == G) break;
        __builtin_amdgcn_s_sleep(1);
        if ((++sp & 255u) == 0u) { if (xb_ld(&bar[XB_TMO])) break; if (sp > XB_SPIN_CAP) { atomicAdd(&bar[XB_TMO], 1u); break; } }
    }
    nloc = mine > 0u ? mine : 1u; nx = cnt > 0u ? cnt : 1u;
}
__device__ __forceinline__ void xcd_barrier(const XcdBarrier& b) {
    asm volatile("s_waitcnt vmcnt(0)" ::: "memory");
    __syncthreads();
    if (threadIdx.x == 0) {
        unsigned* bar = b.bar;
        __builtin_amdgcn_s_waitcnt(0);
        unsigned nloc = b.st[0], nx = b.st[1];
        if (nloc == 0u) { xcd_barrier_complete(bar, b.x, nloc, nx); b.st[0] = nloc; b.st[1] = nx; }
        const unsigned old = xb_add(&bar[XB_XSUB(b.x)], 1u);
        const unsigned gen = old / nloc;
        if (old + 1u == (gen + 1u) * nloc) {
            __builtin_amdgcn_fence(__ATOMIC_RELEASE, "agent");
            asm volatile("s_waitcnt vmcnt(0)" ::: "memory");
            const unsigned og = xb_add(&bar[XB_TOP], 1u);
            const unsigned tg = og / nx;
            if (og + 1u == (tg + 1u) * nx) xb_add(&bar[XB_TOPGEN], 1u);
            else XB_SPIN(xb_ld(&bar[XB_TOPGEN]) == tg, bar);
            __builtin_amdgcn_fence(__ATOMIC_ACQUIRE, "agent");
            xb_add(&bar[XB_XGEN(b.x)], 1u);
            asm volatile("s_waitcnt vmcnt(0)" ::: "memory");
        } else {
            XB_SPIN(xb_ld(&bar[XB_XGEN(b.x)]) == gen, bar);
            __builtin_amdgcn_fence(__ATOMIC_ACQUIRE, "agent");
            asm volatile("s_waitcnt vmcnt(0)" ::: "memory");
        }
    }
    __syncthreads();
}

constexpr int BM = 256, BK = 64, HALF = 128, HTB = HALF * BK * 2, STAGE_BYTES = 8 * HTB, NXCD = 8, WGM = 8;
__host__ __device__ __forceinline__ int lds_byte(int r, int c) { const int st = (r >> 4) * 2 + (c >> 5), rr = r & 15, cc = c & 31, ob = rr * 64 + cc * 2; return st * 1024 + (ob ^ (((ob >> 9) & 1) << 5)); }
__host__ __device__ __forceinline__ void stage_rc(int b, int& R, int& C) { const int st = b / 1024, sb = b % 1024, swz = sb ^ (((sb >> 9) & 1) << 5); R = (st >> 1) * 16 + swz / 64; C = (st & 1) * 32 + (swz % 64) / 2; }
__host__ __device__ __forceinline__ int perm32(int rho) { const int n = rho >> 4, i = rho & 15; return 8 * (i >> 2) + 4 * n + (i & 3); }

struct Unit { int pm, pn, kz; };
struct Gemm { const bf16_t* A; const bf16_t* Bt; int M, N, K, lda, nkz; size_t a_kz, b_kz; };

struct StaticOrder {
    int nM, nN, nwg, G, c, nkz;
    __device__ void init(int M_, int N_, int G_, int c_, int nkz_ = 1) { nM = M_ / BM; nN = N_ / BM; nwg = nM * nN; G = G_; c = c_; nkz = nkz_; }
    __device__ bool next(int i, Unit& u) const {
        const int it = i / nkz; u.kz = i - it * nkz;
        const long L = (long)it * G + c; if (L >= nwg) return false;
        int wgid = (int)L; { const int q = nwg / NXCD, r = nwg % NXCD, xcd = wgid % NXCD, off = wgid / NXCD; wgid = (xcd < r ? xcd * (q + 1) : r * (q + 1) + (xcd - r) * q) + off; }
        const int nig = WGM * nN, gid = wgid / nig, fm = gid * WGM, gsz = (nM - fm) < WGM ? (nM - fm) : WGM;
        u.pm = fm + ((wgid % nig) % gsz); u.pn = (wgid % nig) / gsz; return true;
    }
};

template <class Epi>
__device__ __forceinline__ void gemm_phase(LAS unsigned char* lds, const Gemm g, const StaticOrder& S, const Epi& E) {
    int tid_ = threadIdx.x; asm volatile("" : "+v"(tid_));
    const int tid = tid_, wid = __builtin_amdgcn_readfirstlane(tid >> 6), lane = tid & 63, wr = wid >> 2, wc = wid & 3, fr = lane & 15, fq = lane >> 4;
    const int K = g.K, nt = K / BK;
    unsigned voffA[2], voffB[2];
#pragma unroll
    for (int i = 0; i < 2; ++i) { int R, C; stage_rc(tid * 16 + i * 8192, R, C); const int Rb = Epi::PERM ? ((R & ~31) + perm32(R & 31)) : R;
        voffA[i] = (unsigned)(R * g.lda + C) * 2u; voffB[i] = (unsigned)(Rb * K + C) * 2u; }
    const size_t kstep = (size_t)(BK * 2);
    const size_t hstepA = (size_t)HALF * g.lda * 2, hstepB = (size_t)HALF * K * 2;
    const size_t tstepA = 2 * hstepA, tstepB = 2 * hstepB;
    const unsigned ldsw = (unsigned)wid * 1024u;
    const int aoff = lds_byte(wr * 64 + fr, fq * 8), boff = lds_byte(wc * 32 + fr, fq * 8);
#define PG8_SA(b, h) (((b) * 2 + (h)) * HTB)
#define PG8_SB(b, h) ((4 + (b) * 2 + (h)) * HTB)
#define PG8_STAGE(bufoff, gbase, voff) do { _Pragma("unroll") for (int _i = 0; _i < 2; ++_i) \
        __builtin_amdgcn_global_load_lds((const unsigned*)((const char*)(gbase) + (voff)[_i]), (LAS unsigned*)(lds + (bufoff) + ldsw + _i * 8192), 16, 0, 0); } while (0)
#define PG8_LDA(dst, b, h) do { _Pragma("unroll") for (int m = 0; m < 4; ++m) _Pragma("unroll") for (int k = 0; k < 2; ++k) dst[m][k] = *(const LAS bf16x8*)(lds + PG8_SA(b, h) + aoff + m * 2048 + k * 1024); } while (0)
#define PG8_LDB(dst, b, h) do { _Pragma("unroll") for (int n = 0; n < 2; ++n) _Pragma("unroll") for (int k = 0; k < 2; ++k) dst[n][k] = *(const LAS bf16x8*)(lds + PG8_SB(b, h) + boff + n * 2048 + k * 1024); } while (0)
#define PG8_MMA(ai, bj, At, Bt) do { __builtin_amdgcn_s_setprio(1); _Pragma("unroll") for (int m = 0; m < 4; ++m) _Pragma("unroll") for (int n = 0; n < 2; ++n) _Pragma("unroll") for (int k = 0; k < 2; ++k) \
        acc[ai][bj][m][n] = __builtin_amdgcn_mfma_f32_16x16x32_bf16(Bt[n][k], At[m][k], acc[ai][bj][m][n], 0, 0, 0); __builtin_amdgcn_s_setprio(0); } while (0)
#if SAFE_GEMM == 1 || SAFE_GEMM == 3
#define PG8_WAIT_V(n) asm volatile("s_waitcnt vmcnt(0)" ::: "memory")
#else
#define PG8_WAIT_V(n) asm volatile("s_waitcnt vmcnt(" #n ")" ::: "memory")
#endif
#define PG8_WAIT_L(n) asm volatile("s_waitcnt lgkmcnt(" #n ")" ::: "memory")
#if SAFE_GEMM == 1
#define PG8_BAR do { asm volatile("s_waitcnt vmcnt(0) lgkmcnt(0)" ::: "memory"); __builtin_amdgcn_s_barrier(); asm volatile("" ::: "memory"); } while (0)
#elif SAFE_GEMM == 2
#define PG8_BAR asm volatile("s_barrier" ::: "memory")
#elif SAFE_GEMM == 4
#define PG8_BAR do { asm volatile("s_waitcnt lgkmcnt(0)" ::: "memory"); __builtin_amdgcn_s_barrier(); } while (0)
#else
#define PG8_BAR __builtin_amdgcn_s_barrier()
#endif
#define PG8_SCHED __builtin_amdgcn_sched_barrier(0)
    Unit cur, nxt; int ui = 0;
    if (!S.next(0, cur)) return;
    f32x4 acc[2][2][4][2];
#pragma unroll
    for (int a = 0; a < 2; ++a)
#pragma unroll
        for (int b = 0; b < 2; ++b)
#pragma unroll
            for (int m = 0; m < 4; ++m)
#pragma unroll
                for (int n = 0; n < 2; ++n) acc[a][b][m][n] = (f32x4){0.f, 0.f, 0.f, 0.f};
    bf16x8 At[4][2], B0[2][2], B1[2][2];
    const char* cA = (const char*)(g.A + (size_t)cur.kz * g.a_kz) + (size_t)cur.pm * tstepA; const char* cB = (const char*)(g.Bt + (size_t)cur.kz * g.b_kz) + (size_t)cur.pn * tstepB;
    PG8_STAGE(PG8_SB(0, 0), cB, voffB); PG8_STAGE(PG8_SA(0, 0), cA, voffA); PG8_STAGE(PG8_SB(0, 1), cB + hstepB, voffB); PG8_STAGE(PG8_SA(0, 1), cA + hstepA, voffA);
    if (wr == 1) PG8_BAR;
    PG8_WAIT_V(4); PG8_BAR;
    PG8_STAGE(PG8_SB(1, 0), cB + kstep, voffB); PG8_STAGE(PG8_SA(1, 0), cA + kstep, voffA); PG8_STAGE(PG8_SB(1, 1), cB + hstepB + kstep, voffB);
    PG8_WAIT_V(6); PG8_BAR;
    for (;;) {
        const bool has_next = S.next(ui + 1, nxt);
        const char* nA = has_next ? (const char*)(g.A + (size_t)nxt.kz * g.a_kz) + (size_t)nxt.pm * tstepA : cA;
        const char* nB = has_next ? (const char*)(g.Bt + (size_t)nxt.kz * g.b_kz) + (size_t)nxt.pn * tstepB : cB;
        for (int t = 0; t < nt; t += 2) {
            const bool last = (t == nt - 2);
            const char* a1 = cA + (size_t)(t + 1) * kstep;
            const char* a2 = last ? nA : cA + (size_t)(t + 2) * kstep; const char* b2 = last ? nB : cB + (size_t)(t + 2) * kstep;
            const char* a3 = a2 + kstep; const char* b3 = b2 + kstep;
            PG8_LDB(B0, 0, 0); PG8_SCHED; PG8_LDA(At, 0, 0); PG8_STAGE(PG8_SA(1, 1), a1 + hstepA, voffA);
            PG8_WAIT_L(8); PG8_BAR; PG8_WAIT_L(0); PG8_MMA(0, 0, At, B0); PG8_BAR; PG8_SCHED;
            PG8_LDB(B1, 0, 1); PG8_STAGE(PG8_SB(0, 0), b2, voffB);
            PG8_BAR; PG8_WAIT_L(0); PG8_MMA(0, 1, At, B1); PG8_BAR;
            PG8_LDA(At, 0, 1); PG8_STAGE(PG8_SA(0, 0), a2, voffA);
            PG8_BAR; PG8_WAIT_L(0); PG8_MMA(1, 0, At, B0); PG8_BAR; PG8_SCHED;
            PG8_STAGE(PG8_SB(0, 1), b2 + hstepB, voffB);
            PG8_WAIT_V(6); PG8_BAR; PG8_MMA(1, 1, At, B1); PG8_BAR;
            PG8_LDB(B0, 1, 0); PG8_SCHED; PG8_LDA(At, 1, 0); PG8_STAGE(PG8_SA(0, 1), a2 + hstepA, voffA);
            PG8_WAIT_L(8); PG8_BAR; PG8_WAIT_L(0); PG8_MMA(0, 0, At, B0); PG8_BAR; PG8_SCHED;
            PG8_LDB(B1, 1, 1); PG8_STAGE(PG8_SB(1, 0), b3, voffB);
            PG8_BAR; PG8_WAIT_L(0); PG8_MMA(0, 1, At, B1); PG8_BAR;
            PG8_LDA(At, 1, 1); PG8_STAGE(PG8_SA(1, 0), a3, voffA);
            PG8_BAR; PG8_WAIT_L(0); PG8_MMA(1, 0, At, B0); PG8_BAR; PG8_SCHED;
            PG8_STAGE(PG8_SB(1, 1), b3 + hstepB, voffB);
            PG8_WAIT_V(6); PG8_BAR; PG8_MMA(1, 1, At, B1); PG8_BAR;
        }
        E(acc, cur, wr, wc, fr, fq);
        asm volatile("s_waitcnt vmcnt(0)" ::: "memory");
        if (!has_next) break;
#pragma unroll
        for (int a = 0; a < 2; ++a)
#pragma unroll
            for (int b = 0; b < 2; ++b)
#pragma unroll
                for (int m = 0; m < 4; ++m)
#pragma unroll
                    for (int n = 0; n < 2; ++n) acc[a][b][m][n] = (f32x4){0.f, 0.f, 0.f, 0.f};
        cur = nxt; cA = nA; cB = nB; ++ui;
    }
    PG8_WAIT_V(0);
    if (wr == 0) PG8_BAR;
    PG8_BAR;
#undef PG8_SA
#undef PG8_SB
#undef PG8_STAGE
#undef PG8_LDA
#undef PG8_LDB
#undef PG8_MMA
#undef PG8_WAIT_V
#undef PG8_WAIT_L
#undef PG8_BAR
#undef PG8_SCHED
}
}
namespace mk {
constexpr size_t O_YP = 0, O_YS = 8388608, O_NK = 25165824, O_NV = 33554432, O_S5R = 41943040, O_S5I = 42205184, O_SSD = 42467328,
                 O_MLC = 50855936, O_MLN = 59244544, O_MLM = 59310080;

__device__ __forceinline__ u32x4 pack8(const f32x4 a, const f32x4 b) { u32x4 w; w.x = pk2(a[0], a[1]); w.y = pk2(a[2], a[3]); w.z = pk2(b[0], b[1]); w.w = pk2(b[2], b[3]); return w; }

struct EpiIn {
    static constexpr bool PERM = true;
    bf16_t* proj; float* small; float* out; const float* qg; const float* kg; int layer;
    __device__ __forceinline__ void operator()(const f32x4 (&acc)[2][2][4][2], const Unit& u, int wr, int wc, int fr, int fq) const {
        const int T = u.pn, rowb = u.pm * BM + wr * 64 + fr;
        if (T == 54) {
            if (wc == 0) {
#pragma unroll
                for (int ai = 0; ai < 2; ++ai)
#pragma unroll
                    for (int m = 0; m < 4; ++m) { float* sp = small + (size_t)(rowb + ai * HALF + m * 16) * 32 + 8 * fq; *(f32x4*)sp = acc[ai][0][m][0]; *(f32x4*)(sp + 4) = acc[ai][0][m][1]; }
            }
            return;
        }
        const int colb = T * 256 + 64 * wc + 8 * fq;
        if (T < 4) {
            const float* g = T < 2 ? qg : kg;
            f32x4 gv[2][2];
#pragma unroll
            for (int bj = 0; bj < 2; ++bj)
#pragma unroll
                for (int n = 0; n < 2; ++n) gv[bj][n] = *(const f32x4*)(g + 32 * bj + 8 * fq + 4 * n);
#pragma unroll
            for (int ai = 0; ai < 2; ++ai)
#pragma unroll
                for (int m = 0; m < 4; ++m) {
                    float ss = 0.f;
#pragma unroll
                    for (int bj = 0; bj < 2; ++bj)
#pragma unroll
                        for (int n = 0; n < 2; ++n) { const f32x4 x = acc[ai][bj][m][n]; ss += (x[0] * x[0] + x[1] * x[1]) + (x[2] * x[2] + x[3] * x[3]); }
                    ss += __shfl_xor(ss, 16); ss += __shfl_xor(ss, 32);
                    const float r = rsqrtf(ss * (1.f / 64.f) + 1e-6f);
                    const int row = rowb + ai * HALF + m * 16;
#pragma unroll
                    for (int bj = 0; bj < 2; ++bj) { const f32x4 v0 = acc[ai][bj][m][0] * r * gv[bj][0], v1 = acc[ai][bj][m][1] * r * gv[bj][1];
                        *(u32x4*)(proj + (size_t)row * PJ + colb + 32 * bj) = pack8(v0, v1);
                        if (T >= 2 && row < MP) { float* o = out + O_NK + ((size_t)((row >> 8) * DEPTH + layer) * 256 + (row & 255)) * 512 + (colb - 512) + 32 * bj; *(f32x4*)o = v0; *(f32x4*)(o + 4) = v1; } }
                }
        } else if (T < 6) {
#pragma unroll
            for (int ai = 0; ai < 2; ++ai)
#pragma unroll
                for (int m = 0; m < 4; ++m) { const int row = rowb + ai * HALF + m * 16;
#pragma unroll
                    for (int bj = 0; bj < 2; ++bj) { const f32x4 v0 = acc[ai][bj][m][0], v1 = acc[ai][bj][m][1];
                        *(u32x4*)(proj + (size_t)row * PJ + colb + 32 * bj) = pack8(v0, v1);
                        if (row < MP) { float* o = out + O_NV + ((size_t)((row >> 8) * DEPTH + layer) * 256 + (row & 255)) * 512 + (colb - 1024) + 32 * bj; *(f32x4*)o = v0; *(f32x4*)(o + 4) = v1; } } }
        } else if (T < 22) {
#pragma unroll
            for (int ai = 0; ai < 2; ++ai)
#pragma unroll
                for (int m = 0; m < 4; ++m) { const int row = rowb + ai * HALF + m * 16;
#pragma unroll
                    for (int bj = 0; bj < 2; ++bj) *(u32x4*)(proj + (size_t)row * PJ + colb + 32 * bj) = pack8(acc[ai][bj][m][0], acc[ai][bj][m][1]); }
        } else {
#pragma unroll
            for (int ai = 0; ai < 2; ++ai)
#pragma unroll
                for (int m = 0; m < 4; ++m) { const int row = rowb + ai * HALF + m * 16;
#pragma unroll
                    for (int bj = 0; bj < 2; ++bj) { f32x4 v0 = acc[ai][bj][m][0], v1 = acc[ai][bj][m][1];
#pragma unroll
                        for (int j = 0; j < 4; ++j) { v0[j] = fsigm(v0[j]); v1[j] = fsigm(v1[j]); }
                        *(u32x4*)(proj + (size_t)row * PJ + colb + 32 * bj) = pack8(v0, v1); } }
        }
    }
};
struct EpiRelu2 {
    static constexpr bool PERM = true;
    bf16_t* O; int ldo;
    __device__ __forceinline__ void operator()(const f32x4 (&acc)[2][2][4][2], const Unit& u, int wr, int wc, int fr, int fq) const {
        const int rowb = u.pm * BM + wr * 64 + fr, colb = u.pn * 256 + 64 * wc + 8 * fq;
#pragma unroll
        for (int ai = 0; ai < 2; ++ai)
#pragma unroll
            for (int m = 0; m < 4; ++m) { const int row = rowb + ai * HALF + m * 16;
#pragma unroll
                for (int bj = 0; bj < 2; ++bj) { f32x4 v0 = acc[ai][bj][m][0], v1 = acc[ai][bj][m][1];
#pragma unroll
                    for (int j = 0; j < 4; ++j) { const float a = fmaxf(v0[j], 0.f), b = fmaxf(v1[j], 0.f); v0[j] = a * a; v1[j] = b * b; }
                    *(u32x4*)(O + (size_t)row * ldo + colb + 32 * bj) = pack8(v0, v1); } }
    }
};
struct EpiGlu {
    static constexpr bool PERM = true;
    const bf16_t* Z; const float* bias; bf16_t* br;
    __device__ __forceinline__ void operator()(const f32x4 (&acc)[2][2][4][2], const Unit& u, int wr, int wc, int fr, int fq) const {
        const int rowb = u.pm * BM + wr * 64 + fr, colb = u.pn * 256 + 64 * wc + 8 * fq;
#pragma unroll
        for (int bj = 0; bj < 2; ++bj) { const int c = colb + 32 * bj; const f32x4 b0 = *(const f32x4*)(bias + c), b1 = *(const f32x4*)(bias + c + 4);
#pragma unroll
            for (int ai = 0; ai < 2; ++ai)
#pragma unroll
                for (int m = 0; m < 4; ++m) { const int row = rowb + ai * HALF + m * 16;
                    const u32x4 zz = *(const u32x4*)(Z + (size_t)row * 512 + c);
                    f32x4 v0 = acc[ai][bj][m][0] + b0, v1 = acc[ai][bj][m][1] + b1;
                    v0[0] = bflo(zz.x) * fsigm(v0[0]); v0[1] = bfhi(zz.x) * fsigm(v0[1]); v0[2] = bflo(zz.y) * fsigm(v0[2]); v0[3] = bfhi(zz.y) * fsigm(v0[3]);
                    v1[0] = bflo(zz.z) * fsigm(v1[0]); v1[1] = bfhi(zz.z) * fsigm(v1[1]); v1[2] = bflo(zz.w) * fsigm(v1[2]); v1[3] = bfhi(zz.w) * fsigm(v1[3]);
                    *(u32x4*)(br + (size_t)row * D + 512 + c) = pack8(v0, v1); } }
    }
};
struct EpiBranch {
    static constexpr bool PERM = true;
    const bf16_t* proj; float* macc; bf16_t* merged;
    __device__ __forceinline__ void operator()(const f32x4 (&acc)[2][2][4][2], const Unit& u, int wr, int wc, int fr, int fq) const {
        const int rowb = u.pm * BM + wr * 64 + fr, colb = u.pn * 256 + 64 * wc + 8 * fq, kz = u.kz;
#pragma unroll
        for (int ai = 0; ai < 2; ++ai)
#pragma unroll
            for (int m = 0; m < 4; ++m) { const int row = rowb + ai * HALF + m * 16;
#pragma unroll
                for (int bj = 0; bj < 2; ++bj) { const int c = colb + 32 * bj;
                    const u32x4 gg = *(const u32x4*)(proj + (size_t)row * PJ + P_GATE + kz * D + c);
                    f32x4 v0 = acc[ai][bj][m][0], v1 = acc[ai][bj][m][1];
                    v0[0] *= bflo(gg.x); v0[1] *= bfhi(gg.x); v0[2] *= bflo(gg.y); v0[3] *= bfhi(gg.y); v1[0] *= bflo(gg.z); v1[1] *= bfhi(gg.z); v1[2] *= bflo(gg.w); v1[3] *= bfhi(gg.w);
                    float* mp = macc + (size_t)row * D + c;
                    if (kz > 0) { v0 += *(const f32x4*)mp; v1 += *(const f32x4*)(mp + 4); }
                    if (kz < 3) { *(f32x4*)mp = v0; *(f32x4*)(mp + 4) = v1; }
                    else *(u32x4*)(merged + (size_t)row * D + c) = pack8(v0, v1); } }
    }
};
struct EpiResid {
    static constexpr bool PERM = false;
    const float* xp; const float* xs; const float* modl; int g_off; float* xout;
    __device__ __forceinline__ void operator()(const f32x4 (&acc)[2][2][4][2], const Unit& u, int wr, int wc, int fr, int fq) const {
        const int row0 = u.pm * BM, rowb = row0 + wr * 64 + fr, colb = u.pn * 256 + wc * 32 + 4 * fq;
        const float* xin = row0 < MP ? xp : xs - (size_t)MP * D;
        const float* gate = modl + (size_t)row_cvec(row0) * 6 * D + g_off;
        f32x4 gv[2][2];
#pragma unroll
        for (int bj = 0; bj < 2; ++bj)
#pragma unroll
            for (int n = 0; n < 2; ++n) gv[bj][n] = *(const f32x4*)(gate + colb + bj * HALF + n * 16);
#pragma unroll
        for (int ai = 0; ai < 2; ++ai)
#pragma unroll
            for (int m = 0; m < 4; ++m) { const size_t ro = (size_t)(rowb + ai * HALF + m * 16) * D + colb;
#pragma unroll
                for (int bj = 0; bj < 2; ++bj)
#pragma unroll
                    for (int n = 0; n < 2; ++n) { const size_t o = ro + bj * HALF + n * 16; *(f32x4*)(xout + o) = *(const f32x4*)(xin + o) + gv[bj][n] * acc[ai][bj][m][n]; } }
    }
};
}
namespace mk {
constexpr size_t AL(size_t x) { return (x + 255) & ~(size_t)255; }
constexpr size_t WS_CTL = 0, CTL_BYTES = 65536;
constexpr size_t WS_MOD = WS_CTL + CTL_BYTES;
constexpr size_t WS_W = AL(WS_MOD + (size_t)DEPTH * 5 * 6 * D * 4);
constexpr size_t W_IN = 0, W_GLU = W_IN + (size_t)NIN * D, W_BR = W_GLU + 512 * 512, W_OUT = W_BR + (size_t)4 * D * 512, W_1 = W_OUT + (size_t)D * D, W_2 = W_1 + (size_t)DFF * D,
                 W_LAYER = W_2 + (size_t)D * DFF;
constexpr size_t WS_H = AL(WS_W + W_LAYER * 2 * DEPTH);
constexpr size_t WS_PROJ = AL(WS_H + (size_t)M * D * 2);
constexpr size_t WS_SMALL = AL(WS_PROJ + (size_t)M * PJ * 2);
constexpr size_t WS_BR = AL(WS_SMALL + (size_t)M * 32 * 4);
constexpr size_t WS_MERGED = AL(WS_BR + (size_t)M * D * 2);
constexpr size_t WS_MACC = AL(WS_MERGED + (size_t)M * D * 2);
constexpr size_t WS_ZB = AL(WS_MACC + (size_t)M * D * 4);
constexpr size_t WS_SCR = AL(WS_ZB + (size_t)M * 512 * 2);
constexpr int LDS_BYTES = 140 * 1024, LDS_CTL = LDS_BYTES - 256;

struct Args { const float* in[43]; float* out; unsigned char* ws; int ph_lo, ph_hi; };

__device__ __forceinline__ float wave_sum(float v) {
#pragma unroll
    for (int o = 1; o < 64; o <<= 1) v += __shfl_xor(v, o);
    return v;
}
#define LDS_WAIT() asm volatile("s_waitcnt lgkmcnt(0)" ::: "memory")

__device__ __forceinline__ void xpose_item(const float* W, int ldw, int k0, int sc, bf16_t* dst, int K, LAS float* scr, int lane, int mode) {
    const int j = lane & 31;
    const int col = mode == 1 ? (j < 16 ? 3584 + j : 5648 + (j - 16)) : sc + j;
#pragma unroll 8
    for (int i = 0; i < 32; ++i) { const int kk = 2 * i + (lane >> 5); scr[kk * 33 + j] = mode == 2 ? 0.f : W[(size_t)(k0 + kk) * ldw + col]; }
    LDS_WAIT(); asm volatile("" ::: "memory");
    const int c = lane & 7;
#pragma unroll
    for (int jj = 0; jj < 4; ++jj) { const int n = (lane >> 3) + 8 * jj; const LAS float* s = scr + (8 * c) * 33 + n;
        u32x4 o; o.x = pk2(s[0 * 33], s[1 * 33]); o.y = pk2(s[2 * 33], s[3 * 33]); o.z = pk2(s[4 * 33], s[5 * 33]); o.w = pk2(s[6 * 33], s[7 * 33]);
        *(u32x4*)(dst + (size_t)n * K + k0 + 8 * c) = o; }
    LDS_WAIT(); asm volatile("" ::: "memory");
}
__device__ __forceinline__ int hm_col(int grp) { const int T = grp >> 3, q8 = grp & 7; return 256 * T + 32 * (2 * (q8 & 3) + (q8 >> 2)); }

__device__ __forceinline__ void prologue_convert(const Args& a, LAS unsigned char* lds, int gw, int ngw, int wave, int lane) {
    LAS float* scr = (LAS float*)(lds + wave * 8704);
    bf16_t* WB = (bf16_t*)(a.ws + WS_W);
    constexpr int I_IN = 440 * 32, I_GLU = 16 * 8, I_BR = 4 * 64 * 8, I_OUT = 64 * 32, I_1 = 256 * 32, I_2 = 64 * 128, I_L = I_IN + I_GLU + I_BR + I_OUT + I_1 + I_2;
    for (int it = gw; it < I_L * DEPTH; it += ngw) {
        const int l = it / I_L; int r = it - l * I_L; bf16_t* wl = WB + (size_t)l * W_LAYER;
        if (r < I_IN) { const int kb = r / 440, grp = r % 440, T = grp >> 3; int sc = hm_col(grp), mode = 0;
            if (T == 54) mode = (grp & 7) == 0 ? 1 : 2; else if (T >= 22) sc += 32; else if (T >= 14) sc += 16;
            xpose_item(a.in[16] + (size_t)l * D * 13856, 13856, 64 * kb, sc, wl + W_IN + (size_t)(32 * grp) * D, D, scr, lane, mode); continue; } r -= I_IN;
        if (r < I_GLU) { const int kb = r / 16, grp = r % 16; xpose_item(a.in[28] + (size_t)l * 512 * 512, 512, 64 * kb, hm_col(grp), wl + W_GLU + (size_t)(32 * grp) * 512, 512, scr, lane, 0); continue; } r -= I_GLU;
        if (r < I_BR) { const int k = r / 512, r2 = r % 512, kb = r2 / 64, grp = r2 % 64;
            xpose_item(a.in[39] + ((size_t)l * 4 + k) * 512 * D, D, 64 * kb, hm_col(grp), wl + W_BR + (size_t)k * D * 512 + (size_t)(32 * grp) * 512, 512, scr, lane, 0); continue; } r -= I_BR;
        if (r < I_OUT) { const int kb = r / 64, grp = r % 64; xpose_item(a.in[40] + (size_t)l * D * D, D, 64 * kb, 32 * grp, wl + W_OUT + (size_t)(32 * grp) * D, D, scr, lane, 0); continue; } r -= I_OUT;
        if (r < I_1) { const int kb = r / 256, grp = r % 256; xpose_item(a.in[41] + (size_t)l * D * DFF, DFF, 64 * kb, hm_col(grp), wl + W_1 + (size_t)(32 * grp) * D, D, scr, lane, 0); continue; } r -= I_1;
        { const int kb = r / 64, grp = r % 64; xpose_item(a.in[42] + (size_t)l * DFF * D, D, 64 * kb, 32 * grp, wl + W_2 + (size_t)(32 * grp) * DFF, DFF, scr, lane, 0); }
    }
}
__device__ __forceinline__ void prologue_ada(const Args& a, LAS unsigned char* lds, int tid) {
    LAS float* sl = (LAS float*)lds;
    LAS float* red = (LAS float*)(lds + 40960);
    float* mod = (float*)(a.ws + WS_MOD);
    for (int i = tid; i < 5 * D; i += NT) { const int j = i / D, k = i % D; const float x = j == 0 ? a.in[11][k] : a.in[10][(j - 1) * D + k]; sl[i] = x / (1.f + __expf(-x)); }
    __syncthreads();
    const int ks = tid >> 6, c = tid & 63;
    for (int unit = blockIdx.x; unit < DEPTH * 6 * D / 64; unit += gridDim.x) {
        const int l = unit / (6 * D / 64), n0 = (unit % (6 * D / 64)) * 64;
        const float* w = a.in[12] + (size_t)l * D * 6 * D + n0 + c;
        float acc[5] = {0.f, 0.f, 0.f, 0.f, 0.f};
#pragma unroll 4
        for (int k = ks * 256; k < ks * 256 + 256; ++k) { const float wv = w[(size_t)k * 6 * D];
#pragma unroll
            for (int j = 0; j < 5; ++j) acc[j] += sl[j * D + k] * wv; }
#pragma unroll
        for (int j = 0; j < 5; ++j) red[(ks * 5 + j) * 64 + c] = acc[j];
        __syncthreads();
        if (tid < 320) { const int j = tid >> 6; float s = 0.f;
#pragma unroll
            for (int q = 0; q < 8; ++q) s += red[(q * 5 + j) * 64 + c];
            mod[((size_t)l * 5 + j) * 6 * D + n0 + c] = s + a.in[13][l * 6 * D + n0 + c]; }
        __syncthreads();
    }
}
__device__ __forceinline__ void norm_phase(const float* xp, const float* xs, const float* g, const float* modl, int sh_off, int sc_off, bf16_t* H, int gw, int ngw, int lane_) {
    int lane = lane_; asm volatile("" : "+v"(lane));
    for (int row = gw; row < M; row += ngw) {
        const float* x = row < MP ? xp + (size_t)row * D : xs + (size_t)(row - MP) * D;
        f32x4 v[8]; float ss = 0.f;
#pragma unroll
        for (int j = 0; j < 8; ++j) { v[j] = *(const f32x4*)(x + 4 * (lane + 64 * j)); ss += (v[j][0] * v[j][0] + v[j][1] * v[j][1]) + (v[j][2] * v[j][2] + v[j][3] * v[j][3]); }
        const float r = rsqrtf(wave_sum(ss) * (1.f / D) + 1e-6f);
        const float* md = modl + (size_t)row_cvec(row) * 6 * D;
#pragma unroll
        for (int j = 0; j < 8; ++j) { const int i = 4 * (lane + 64 * j);
            const f32x4 gg = *(const f32x4*)(g + i), sc = *(const f32x4*)(md + sc_off + i), sh = *(const f32x4*)(md + sh_off + i);
            const f32x4 o = v[j] * r * gg * (sc + 1.f) + sh;
            u32x2 w; w.x = pk2(o[0], o[1]); w.y = pk2(o[2], o[3]); *(u32x2*)(H + (size_t)row * D + i) = w; }
    }
}

}
namespace mk {
constexpr size_t WS_NAT = AL(WS_SCR);
constexpr int NATP = 2048, N_XBC = 0, N_Q = 1024, N_K = 1536;
constexpr size_t WS_TR = AL(WS_NAT + (size_t)M * NATP * 2);
constexpr int T_X = 0, T_B = 512, T_K = 768, T_MV = 1280, T_V = 1792, TRR = 2304;
constexpr int NCH = 96;
constexpr size_t WS_MLC = AL(WS_TR + (size_t)TRR * M * 2);
constexpr size_t WS_MLN = AL(WS_MLC + (size_t)NCH * 4 * 2 * 16384 * 4);
constexpr size_t WS_MLS = AL(WS_MLN + (size_t)NCH * 4 * 2 * 128 * 4);
constexpr size_t WS_MLCS = AL(WS_MLS + (size_t)NCH * 4 * 2 * 4 * 4);
constexpr size_t WS_MLNS = AL(WS_MLCS + (size_t)NCH * 4 * 2 * 16384 * 2);
constexpr size_t WS_MLMS = AL(WS_MLNS + (size_t)NCH * 4 * 2 * 128 * 4);
constexpr size_t WS_OPT_END = AL(WS_MLMS + (size_t)NCH * 4 * 2 * 4);

__device__ __forceinline__ f32x4 mfma16(bf16x8 a, bf16x8 b, f32x4 c) { return __builtin_amdgcn_mfma_f32_16x16x32_bf16(a, b, c, 0, 0, 0); }
__device__ __forceinline__ void chunk_info(int ch, int& row0, int& seq0, int& L, int& lat, int& b, int& ci, int& nc) {
    if (ch < 32) { b = ch >> 1; ci = ch & 1; nc = 2; seq0 = b * 256; L = 256; lat = 0; } else { const int c2 = ch - 32; b = c2 >> 4; ci = c2 & 15; nc = 16; seq0 = MP + b * 2048; L = 2048; lat = 1; }
    row0 = seq0 + ci * 128;
}
__device__ __forceinline__ float fast_exp(float x) { return __expf(x); }

__device__ __forceinline__ void prep_phase(const Args& a, int layer, LAS unsigned char* lds, int gw_, int ngw, int wave, int lane_, bf16_t* UPk) {
    int lane = lane_, gw = gw_; asm volatile("" : "+v"(lane));
    const bf16_t* PROJ = (const bf16_t*)(a.ws + WS_PROJ); bf16_t* NAT = (bf16_t*)(a.ws + WS_NAT); bf16_t* TR = (bf16_t*)(a.ws + WS_TR);
    LAS bf16_t* tile = (LAS bf16_t*)(lds + wave * 16896); LAS bf16_t* otile = tile + 68 * 64;
    const int c = lane & 7, r8 = lane >> 3;
    const float* cw = a.in[30] + layer * 5 * 1024; const float* cb = a.in[31] + layer * 1024;
    for (int u = gw; u < 56 * 192; u += ngw) {
        const int cg = u / 192, tt = u % 192, m0 = tt * 64;
        const int lat = m0 >= MP; const int seq0 = lat ? MP + ((m0 - MP) / 2048) * 2048 : (m0 / 256) * 256, L = lat ? 2048 : 256, t0 = m0 - seq0;
        int kind, src, natcol = -1, trrow = -1;
        if (cg < 16) { kind = 0; src = P_XBC + 64 * cg; natcol = N_XBC + 64 * cg; if (cg < 12) trrow = T_X + 64 * cg; }
        else if (cg < 24) { kind = 1; src = P_MQ + 64 * (cg - 16); natcol = N_Q + 64 * (cg - 16); }
        else if (cg < 32) { kind = 2; src = P_MK + 64 * (cg - 24); natcol = N_K + 64 * (cg - 24); trrow = T_K + 64 * (cg - 24); }
        else if (cg < 40) { kind = 3; src = P_MV + 64 * (cg - 32); trrow = T_MV + 64 * (cg - 32); }
        else if (cg < 48) { kind = 3; src = P_V + 64 * (cg - 40); trrow = T_V + 64 * (cg - 40); }
        else { kind = 4; src = P_S5U + 64 * (cg - 48); }
        const int roff = kind == 0 ? -2 : 0, nrows = kind == 0 ? 68 : 64;
#pragma unroll
        for (int i = 0; i < 9; ++i) { const int r = r8 + 8 * i; if (r < nrows) { const int t = t0 + r + roff; u32x4 v = {0u, 0u, 0u, 0u};
                if (t >= 0 && t < L) v = *(const u32x4*)(PROJ + (size_t)(seq0 + t) * PJ + src + 8 * c);
                *(LAS u32x4*)(tile + r * 64 + 8 * c) = v; } }
        LDS_WAIT(); asm volatile("" ::: "memory");
#define PREP_EMIT(i_, r_) do { if (natcol >= 0) *(u32x4*)(NAT + (size_t)(m0 + r8 + 8 * (i_)) * NATP + natcol + 8 * c) = (r_); if (trrow >= 0) *(LAS u32x4*)(otile + (r8 + 8 * (i_)) * 64 + 8 * c) = (r_); } while (0)
        if (kind == 0) {
            float w[5][8], bz[8];
#pragma unroll
            for (int e = 0; e < 8; ++e) { bz[e] = cb[64 * cg + 8 * c + e];
#pragma unroll
                for (int j = 0; j < 5; ++j) w[j][e] = cw[j * 1024 + 64 * cg + 8 * c + e]; }
#pragma unroll 2
            for (int i = 0; i < 8; ++i) { const int tk = r8 + 8 * i; float acc[8];
#pragma unroll
                for (int e = 0; e < 8; ++e) acc[e] = bz[e];
#pragma unroll
                for (int j = 0; j < 5; ++j) { const u32x4 v = *(const LAS u32x4*)(tile + (tk + j) * 64 + 8 * c);
                    acc[0] += bflo(v.x) * w[j][0]; acc[1] += bfhi(v.x) * w[j][1]; acc[2] += bflo(v.y) * w[j][2]; acc[3] += bfhi(v.y) * w[j][3];
                    acc[4] += bflo(v.z) * w[j][4]; acc[5] += bfhi(v.z) * w[j][5]; acc[6] += bflo(v.w) * w[j][6]; acc[7] += bfhi(v.w) * w[j][7]; }
#pragma unroll
                for (int e = 0; e < 8; ++e) acc[e] = fsilu(acc[e]);
                u32x4 rv; rv.x = pk2(acc[0], acc[1]); rv.y = pk2(acc[2], acc[3]); rv.z = pk2(acc[4], acc[5]); rv.w = pk2(acc[6], acc[7]); PREP_EMIT(i, rv); }
        } else if (kind == 4) {
#pragma unroll
            for (int i = 0; i < 8; ++i) { const int tk = r8 + 8 * i, m = m0 + tk; const u32x4 v = *(const LAS u32x4*)(tile + tk * 64 + 8 * c);
                *(u32x4*)(UPk + ((size_t)(4 * (cg - 48) + (c >> 1)) * 384 + (m >> 5)) * 512 + (m & 31) * 16 + 8 * (c & 1)) = v; }
        } else if (kind == 3 || !lat) {
            const float sc = kind == 2 ? 0.08838834764831845f : 1.f;
#pragma unroll
            for (int i = 0; i < 8; ++i) { const u32x4 v = *(const LAS u32x4*)(tile + (r8 + 8 * i) * 64 + 8 * c);
                u32x4 rv = v;
                if (kind == 2) { rv.x = pk2(bflo(v.x) * sc, bfhi(v.x) * sc); rv.y = pk2(bflo(v.y) * sc, bfhi(v.y) * sc); rv.z = pk2(bflo(v.z) * sc, bfhi(v.z) * sc); rv.w = pk2(bflo(v.w) * sc, bfhi(v.w) * sc); }
                PREP_EMIT(i, rv); }
        } else {
            const float sc = kind == 2 ? 0.08838834764831845f : 1.f; const int odd = cg & 1;
            float inv[8];
#pragma unroll
            for (int e = 0; e < 8; ++e) inv[e] = exp2f(-(float)(8 * (c & 3) + e) * (13.287712379549449f / 32.f));
#pragma unroll
            for (int i = 0; i < 8; ++i) { const int tk = r8 + 8 * i, t = t0 + tk; const float pos = odd ? (float)(t & 63) : (float)(t >> 6);
                const u32x4 vo = *(const LAS u32x4*)(tile + tk * 64 + 8 * c), vp = *(const LAS u32x4*)(tile + tk * 64 + 8 * (c ^ 4));
                float o[8], p[8], rr[8];
                o[0] = bflo(vo.x); o[1] = bfhi(vo.x); o[2] = bflo(vo.y); o[3] = bfhi(vo.y); o[4] = bflo(vo.z); o[5] = bfhi(vo.z); o[6] = bflo(vo.w); o[7] = bfhi(vo.w);
                p[0] = bflo(vp.x); p[1] = bfhi(vp.x); p[2] = bflo(vp.y); p[3] = bfhi(vp.y); p[4] = bflo(vp.z); p[5] = bfhi(vp.z); p[6] = bflo(vp.w); p[7] = bfhi(vp.w);
#pragma unroll
                for (int e = 0; e < 8; ++e) { const float ang = pos * inv[e], cs = __cosf(ang), sn = __sinf(ang);
                    rr[e] = (c < 4 ? o[e] * cs - p[e] * sn : p[e] * sn + o[e] * cs) * sc; }
                u32x4 rv; rv.x = pk2(rr[0], rr[1]); rv.y = pk2(rr[2], rr[3]); rv.z = pk2(rr[4], rr[5]); rv.w = pk2(rr[6], rr[7]); PREP_EMIT(i, rv); }
        }
        if (trrow >= 0) {
            LDS_WAIT(); asm volatile("" ::: "memory");
            bf16_t* dst = TR + (size_t)(trrow + lane) * M + m0;
#pragma unroll
            for (int j = 0; j < 8; ++j) { unsigned wv[4];
#pragma unroll
                for (int q = 0; q < 4; ++q) { const unsigned lo = otile[(8 * j + 2 * q) * 64 + lane], hi = otile[(8 * j + 2 * q + 1) * 64 + lane]; wv[q] = lo | (hi << 16); }
                u32x4 o; o.x = wv[0]; o.y = wv[1]; o.z = wv[2]; o.w = wv[3]; *(u32x4*)(dst + 8 * j) = o; }
        }
        LDS_WAIT(); asm volatile("" ::: "memory");
    }
}

struct MlGate { float lf0, lf1, ig0, ig1, P0, P1, tot; };
__device__ __forceinline__ float wave_incl_scan(float v, int lane) {
#pragma unroll
    for (int o = 1; o < 64; o <<= 1) { const float t = __shfl_up(v, o); if (lane >= o) v += t; }
    return v;
}
__device__ __forceinline__ float wave_max(float v) {
#pragma unroll
    for (int o = 1; o < 64; o <<= 1) v = fmaxf(v, __shfl_xor(v, o));
    return v;
}
__device__ __forceinline__ MlGate ml_gates(const Args& a, int layer, int row0, int hh, int dir, int lane) {
    const float* SMALL = (const float*)(a.ws + WS_SMALL);
    const float ib = a.in[36][layer * 8 + dir * 4 + hh], fb = a.in[37][layer * 8 + dir * 4 + hh];
    MlGate g;
    const float f0 = SMALL[(size_t)(row0 + lane) * 32 + S_MF + dir * 4 + hh] + fb, f1 = SMALL[(size_t)(row0 + lane + 64) * 32 + S_MF + dir * 4 + hh] + fb;
    g.ig0 = SMALL[(size_t)(row0 + lane) * 32 + S_MI + dir * 4 + hh] + ib; g.ig1 = SMALL[(size_t)(row0 + lane + 64) * 32 + S_MI + dir * 4 + hh] + ib;
    g.lf0 = fminf(f0, 0.f) - log1pf(__expf(-fabsf(f0))); g.lf1 = fminf(f1, 0.f) - log1pf(__expf(-fabsf(f1)));
    const float s0 = wave_incl_scan(g.lf0, lane); const float tot0 = __shfl(s0, 63);
    const float s1 = wave_incl_scan(g.lf1, lane) + tot0;
    g.P0 = s0; g.P1 = s1; g.tot = __shfl(s1, 63);
    return g;
}

__device__ __forceinline__ void ml_states_phase(const Args& a, int layer, int tid_, int G) {
    int tid = tid_; asm volatile("" : "+v"(tid));
    const int lane = tid & 63, wave = __builtin_amdgcn_readfirstlane(tid >> 6), fr = lane & 15, fq = lane >> 4;
    const bf16_t* TR = (const bf16_t*)(a.ws + WS_TR);
    float* MLC = (float*)(a.ws + WS_MLC); float* MLN = (float*)(a.ws + WS_MLN); float* MLS = (float*)(a.ws + WS_MLS);
    for (int u = blockIdx.x; u < NCH * 4; u += G) {
        const int ch = u >> 2, hh = u & 3; int row0, seq0, L, lat, b, ci, nc; chunk_info(ch, row0, seq0, L, lat, b, ci, nc);
#pragma unroll
        for (int dir = 0; dir < 2; ++dir) {
            const MlGate g = ml_gates(a, layer, row0, hh, dir, lane);
            const float w0 = (dir == 0 ? g.tot - g.P0 : g.P0 - g.lf0) + g.ig0, w1 = (dir == 0 ? g.tot - g.P1 : g.P1 - g.lf1) + g.ig1;
            const float mloc = wave_max(fmaxf(w0, w1));
            const float e0 = __expf(w0 - mloc), e1 = __expf(w1 - mloc);
            f32x4 acc[8];
#pragma unroll
            for (int j = 0; j < 8; ++j) acc[j] = (f32x4){0.f, 0.f, 0.f, 0.f};
            float nacc[8];
#pragma unroll
            for (int j = 0; j < 8; ++j) nacc[j] = 0.f;
            const bf16_t* vrow = TR + (size_t)(T_MV + hh * 128 + wave * 16 + fr) * M + row0 + 8 * fq;
#pragma unroll
            for (int ks = 0; ks < 4; ++ks) {
                const bf16x8 af = *(const bf16x8*)(vrow + 32 * ks);
                float ev[8];
#pragma unroll
                for (int j = 0; j < 8; ++j) { const int tok = 32 * ks + 8 * fq + j; const float x0 = __shfl(e0, tok & 63), x1 = __shfl(e1, tok & 63); ev[j] = tok < 64 ? x0 : x1; }
#pragma unroll
                for (int jt = 0; jt < 8; ++jt) {
                    const u32x4 kv = *(const u32x4*)(TR + (size_t)(T_K + hh * 128 + jt * 16 + fr) * M + row0 + 32 * ks + 8 * fq);
                    const float k0 = bflo(kv.x) * ev[0], k1 = bfhi(kv.x) * ev[1], k2 = bflo(kv.y) * ev[2], k3 = bfhi(kv.y) * ev[3], k4 = bflo(kv.z) * ev[4], k5 = bfhi(kv.z) * ev[5], k6 = bflo(kv.w) * ev[6], k7 = bfhi(kv.w) * ev[7];
                    if (wave == 0) nacc[jt] += ((k0 + k1) + (k2 + k3)) + ((k4 + k5) + (k6 + k7));
                    u32x4 kb; kb.x = pk2(k0, k1); kb.y = pk2(k2, k3); kb.z = pk2(k4, k5); kb.w = pk2(k6, k7);
                    acc[jt] = mfma16(af, __builtin_bit_cast(bf16x8, kb), acc[jt]);
                }
            }
            float* cdst = MLC + ((size_t)(ch * 4 + hh) * 2 + dir) * 16384;
#pragma unroll
            for (int jt = 0; jt < 8; ++jt)
#pragma unroll
                for (int i = 0; i < 4; ++i) cdst[(size_t)(wave * 16 + 4 * fq + i) * 128 + jt * 16 + fr] = acc[jt][i];
            if (wave == 0) {
#pragma unroll
                for (int jt = 0; jt < 8; ++jt) { float v = nacc[jt]; v += __shfl_xor(v, 16); v += __shfl_xor(v, 32); if (fq == 0) MLN[((size_t)(ch * 4 + hh) * 2 + dir) * 128 + jt * 16 + fr] = v; }
                if (lane == 0) { MLS[((size_t)(ch * 4 + hh) * 2 + dir) * 4 + 0] = mloc; MLS[((size_t)(ch * 4 + hh) * 2 + dir) * 4 + 1] = g.tot; }
            }
        }
    }
}
__device__ __forceinline__ void ml_scan_phase(const Args& a, int layer, int tid_, int G) {
    int tid = tid_; asm volatile("" : "+v"(tid));
    const float* MLC = (const float*)(a.ws + WS_MLC); const float* MLN = (const float*)(a.ws + WS_MLN); const float* MLS = (const float*)(a.ws + WS_MLS);
    bf16_t* CS = (bf16_t*)(a.ws + WS_MLCS); float* NS = (float*)(a.ws + WS_MLNS); float* MS = (float*)(a.ws + WS_MLMS);
    for (int task = blockIdx.x; task < 256; task += G) {
        int lat, b, hh, dir, part, nparts;
        if (task < 128) { lat = 1; part = task & 3; dir = (task >> 2) & 1; hh = (task >> 3) & 3; b = task >> 5; nparts = 4; }
        else { const int t2 = task - 128; lat = 0; part = 0; dir = t2 & 1; hh = (t2 >> 1) & 3; b = t2 >> 3; nparts = 1; }
        const int nc = lat ? 16 : 2, ch0 = lat ? 32 + b * 16 : b * 2;
        const int nel = 16384 / nparts, e0 = part * nel, per = nel / NT;
        float c[32]; float n = 0.f, m = 0.f;
        const size_t so = (((size_t)b * DEPTH + layer) * 2 + dir) * 4 + hh;
#pragma unroll
        for (int i = 0; i < 32; ++i) if (i < per) { const int e = e0 + i * NT + tid, vd = e >> 7, kd = e & 127; c[i] = lat ? a.in[7][(so * 128 + kd) * 128 + vd] : 0.f; }
        if (tid < 128) n = lat ? a.in[8][so * 128 + tid] : 0.f;
        m = lat ? a.in[9][so] : 0.f;
        for (int s = 0; s < nc; ++s) { const int ci = dir ? nc - 1 - s : s, ch = ch0 + ci; const size_t sb = (size_t)(ch * 4 + hh) * 2 + dir;
#pragma unroll
            for (int i = 0; i < 32; ++i) if (i < per) CS[sb * 16384 + e0 + i * NT + tid] = f2bf(c[i]);
            if (part == 0) { if (tid < 128) NS[sb * 128 + tid] = n; if (tid == 0) MS[sb] = m; }
            const float ml = MLS[sb * 4 + 0], bl = MLS[sb * 4 + 1];
            const float mn = fmaxf(bl + m, ml), fa = __expf(bl + m - mn), fb = __expf(ml - mn);
#pragma unroll
            for (int i = 0; i < 32; ++i) if (i < per) c[i] = fa * c[i] + fb * MLC[sb * 16384 + e0 + i * NT + tid];
            if (tid < 128) n = fa * n + fb * MLN[sb * 128 + tid];
            m = mn; }
        if (!lat) {
#pragma unroll
            for (int i = 0; i < 32; ++i) if (i < per) { const int e = e0 + i * NT + tid, vd = e >> 7, kd = e & 127; a.out[O_MLC + (so * 128 + kd) * 128 + vd] = c[i]; }
            if (tid < 128) a.out[O_MLN + so * 128 + tid] = n; if (tid == 0) a.out[O_MLM + so] = m; }
    }
}
__device__ __forceinline__ void ml_out_phase(const Args& a, int layer, LAS unsigned char* lds, int tid_, int G) {
    int tid = tid_; asm volatile("" : "+v"(tid));
    const int lane = tid & 63, wave = __builtin_amdgcn_readfirstlane(tid >> 6), fr = lane & 15, fq = lane >> 4;
    const bf16_t* NAT = (const bf16_t*)(a.ws + WS_NAT); const bf16_t* TR = (const bf16_t*)(a.ws + WS_TR); const bf16_t* PROJ = (const bf16_t*)(a.ws + WS_PROJ);
    const bf16_t* CS = (const bf16_t*)(a.ws + WS_MLCS); const float* NS = (const float*)(a.ws + WS_MLNS); const float* MS = (const float*)(a.ws + WS_MLMS);
    bf16_t* BR = (bf16_t*)(a.ws + WS_BR);
    LAS float* U = (LAS float*)lds; LAS float* Wv = U + 128; LAS float* SI = U + 256; LAS float* EM = U + 384; LAS float* NSs = U + 512;
    for (int u = blockIdx.x; u < NCH * 4; u += G) {
        const int ch = u >> 2, hh = u & 3; int row0, seq0, L, lat, b, ci, nc; chunk_info(ch, row0, seq0, L, lat, b, ci, nc);
        const int t = wave * 16 + fr;
        bf16x8 qf[4];
#pragma unroll
        for (int ks = 0; ks < 4; ++ks) qf[ks] = *(const bf16x8*)(NAT + (size_t)(row0 + t) * NATP + N_Q + hh * 128 + 32 * ks + 8 * fq);
        f32x4 hsum[8];
#pragma unroll
        for (int j = 0; j < 8; ++j) hsum[j] = (f32x4){0.f, 0.f, 0.f, 0.f};
#pragma unroll 1
        for (int dir = 0; dir < 2; ++dir) {
            const size_t sb = (size_t)(ch * 4 + hh) * 2 + dir;
            __syncthreads();
            if (wave == 0) {
                const MlGate g = ml_gates(a, layer, row0, hh, dir, lane); const float ms = MS[sb];
                float u0, u1, c0, c1, ai0, ai1;
                if (dir == 0) { u0 = g.ig0 - g.P0; u1 = g.ig1 - g.P1; c0 = g.P0; c1 = g.P1; ai0 = g.P0 + ms; ai1 = g.P1 + ms; }
                else { const float E0 = g.P0 - g.lf0, E1 = g.P1 - g.lf1; u0 = E0 + g.ig0; u1 = E1 + g.ig1; c0 = -E0; c1 = -E1; ai0 = g.tot - E0 + ms; ai1 = g.tot - E1 + ms; }
                float g0 = u0, g1 = u1;
                if (dir == 0) {
#pragma unroll
                    for (int o = 1; o < 64; o <<= 1) { const float x0 = __shfl_up(g0, o), x1 = __shfl_up(g1, o); if (lane >= o) { g0 = fmaxf(g0, x0); g1 = fmaxf(g1, x1); } }
                    g1 = fmaxf(g1, __shfl(g0, 63));
                } else {
#pragma unroll
                    for (int o = 1; o < 64; o <<= 1) { const float x0 = __shfl_down(g0, o), x1 = __shfl_down(g1, o); if (lane + o < 64) { g0 = fmaxf(g0, x0); g1 = fmaxf(g1, x1); } }
                    g0 = fmaxf(g0, __shfl(g1, 0));
                }
                const float mt0 = fmaxf(ai0, c0 + g0), mt1 = fmaxf(ai1, c1 + g1);
                U[lane] = u0; U[lane + 64] = u1; Wv[lane] = c0 - mt0; Wv[lane + 64] = c1 - mt1;
                SI[lane] = __expf(ai0 - mt0); SI[lane + 64] = __expf(ai1 - mt1); EM[lane] = __expf(-mt0); EM[lane + 64] = __expf(-mt1);
                NSs[lane] = NS[sb * 128 + lane]; NSs[lane + 64] = NS[sb * 128 + lane + 64];
            }
            __syncthreads();
            const float wt = Wv[t], sit = SI[t], emt = EM[t];
            f32x4 acc[8];
#pragma unroll
            for (int j = 0; j < 8; ++j) acc[j] = (f32x4){0.f, 0.f, 0.f, 0.f};
#pragma unroll
            for (int ks = 0; ks < 4; ++ks)
#pragma unroll
                for (int j = 0; j < 8; ++j) { const bf16x8 cf = *(const bf16x8*)(CS + sb * 16384 + (size_t)(16 * j + fr) * 128 + 32 * ks + 8 * fq); acc[j] = mfma16(cf, qf[ks], acc[j]); }
            float qn = 0.f;
#pragma unroll
            for (int ks = 0; ks < 4; ++ks) { const u32x4 qv = __builtin_bit_cast(u32x4, qf[ks]); const LAS float* nn = NSs + 32 * ks + 8 * fq;
                qn += bflo(qv.x) * nn[0] + bfhi(qv.x) * nn[1] + bflo(qv.y) * nn[2] + bfhi(qv.y) * nn[3] + bflo(qv.z) * nn[4] + bfhi(qv.z) * nn[5] + bflo(qv.w) * nn[6] + bfhi(qv.w) * nn[7]; }
            qn += __shfl_xor(qn, 16); qn += __shfl_xor(qn, 32);
#pragma unroll
            for (int j = 0; j < 8; ++j) acc[j] *= sit;
            float den = sit * qn;
            const int jlo = dir == 0 ? 0 : (wave >> 1), jhi = dir == 0 ? (wave >> 1) : 3;
            float psum = 0.f;
            for (int jp = jlo; jp <= jhi; ++jp) {
                const int ta = 32 * jp + 8 * (fr >> 2) + (fr & 3);
                f32x4 sa = (f32x4){0.f, 0.f, 0.f, 0.f}, sb2 = (f32x4){0.f, 0.f, 0.f, 0.f};
#pragma unroll
                for (int ks = 0; ks < 4; ++ks) {
                    const bf16x8 ka = *(const bf16x8*)(NAT + (size_t)(row0 + ta) * NATP + N_K + hh * 128 + 32 * ks + 8 * fq);
                    const bf16x8 kb = *(const bf16x8*)(NAT + (size_t)(row0 + ta + 4) * NATP + N_K + hh * 128 + 32 * ks + 8 * fq);
                    sa = mfma16(ka, qf[ks], sa); sb2 = mfma16(kb, qf[ks], sb2); }
                float pa[4], pb[4];
#pragma unroll
                for (int i = 0; i < 4; ++i) { const int s0 = 32 * jp + 8 * fq + i, s1 = s0 + 4;
                    const bool ok0 = dir == 0 ? s0 <= t : s0 >= t, ok1 = dir == 0 ? s1 <= t : s1 >= t;
                    pa[i] = ok0 ? sa[i] * __expf(U[s0] + wt) : 0.f; pb[i] = ok1 ? sb2[i] * __expf(U[s1] + wt) : 0.f;
                    psum += pa[i] + pb[i]; }
                u32x4 pw; pw.x = pk2(pa[0], pa[1]); pw.y = pk2(pa[2], pa[3]); pw.z = pk2(pb[0], pb[1]); pw.w = pk2(pb[2], pb[3]);
                const bf16x8 pf = __builtin_bit_cast(bf16x8, pw);
#pragma unroll
                for (int j = 0; j < 8; ++j) { const bf16x8 vf = *(const bf16x8*)(TR + (size_t)(T_MV + hh * 128 + 16 * j + fr) * M + row0 + 32 * jp + 8 * fq); acc[j] = mfma16(vf, pf, acc[j]); }
            }
            psum += __shfl_xor(psum, 16); psum += __shfl_xor(psum, 32);
            den += psum;
            const float rden = 1.f / fmaxf(fabsf(den), emt);
#pragma unroll
            for (int j = 0; j < 8; ++j) hsum[j] += acc[j] * rden;
        }
        float ss = 0.f;
#pragma unroll
        for (int j = 0; j < 8; ++j) ss += (hsum[j][0] * hsum[j][0] + hsum[j][1] * hsum[j][1]) + (hsum[j][2] * hsum[j][2] + hsum[j][3] * hsum[j][3]);
        ss += __shfl_xor(ss, 16); ss += __shfl_xor(ss, 32);
        const float r = rsqrtf(ss * (1.f / 128.f) + 1e-6f);
        const float* ng = a.in[38] + layer * 512 + hh * 128;
#pragma unroll
        for (int j = 0; j < 8; ++j) { const int vd = 16 * j + 4 * fq; const f32x4 gg = *(const f32x4*)(ng + vd);
            const u32x2 ov = *(const u32x2*)(PROJ + (size_t)(row0 + t) * PJ + P_MO + hh * 128 + vd);
            const float o0 = hsum[j][0] * r * gg[0] * fsigm(bflo(ov.x)), o1 = hsum[j][1] * r * gg[1] * fsigm(bfhi(ov.x)), o2 = hsum[j][2] * r * gg[2] * fsigm(bflo(ov.y)), o3 = hsum[j][3] * r * gg[3] * fsigm(bfhi(ov.y));
            u32x2 w; w.x = pk2(o0, o1); w.y = pk2(o2, o3); *(u32x2*)(BR + (size_t)(row0 + t) * D + 1536 + hh * 128 + vd) = w; }
    }
}
}
namespace mk {
constexpr size_t WS_SST = WS_OPT_END;
constexpr size_t WS_SSL = AL(WS_SST + (size_t)NCH * 8 * 2 * 8192 * 4);
constexpr size_t WS_SSCS = AL(WS_SSL + (size_t)NCH * 8 * 2 * 4);
constexpr size_t WS_YPRE = AL(WS_SSCS + (size_t)NCH * 8 * 2 * 8192 * 2);
constexpr size_t WS_SSQ = AL(WS_YPRE + (size_t)M * 512 * 4);
constexpr size_t WS_SSD_END = AL(WS_SSQ + (size_t)M * 8 * 4);

struct SsdGate { float dt0, dt1, la0, la1, P0, P1, tot; };
__device__ __forceinline__ SsdGate ssd_gates(const Args& a, int layer, int row0, int hh, int dir, int lane) {
    const float* SMALL = (const float*)(a.ws + WS_SMALL);
    const float bias = a.in[32][layer * 16 + dir * 8 + hh], A = -__expf(a.in[33][layer * 16 + dir * 8 + hh]);
    SsdGate g;
    const float x0 = SMALL[(size_t)(row0 + lane) * 32 + S_DT + dir * 8 + hh] + bias, x1 = SMALL[(size_t)(row0 + lane + 64) * 32 + S_DT + dir * 8 + hh] + bias;
    g.dt0 = fmaxf(x0, 0.f) + log1pf(__expf(-fabsf(x0))); g.dt1 = fmaxf(x1, 0.f) + log1pf(__expf(-fabsf(x1)));
    g.la0 = g.dt0 * A; g.la1 = g.dt1 * A;
    const float s0 = wave_incl_scan(g.la0, lane); const float t0 = __shfl(s0, 63);
    const float s1 = wave_incl_scan(g.la1, lane) + t0;
    g.P0 = s0; g.P1 = s1; g.tot = __shfl(s1, 63);
    return g;
}
__device__ __forceinline__ void ssd_states_phase(const Args& a, int layer, int tid_, int G) {
    int tid = tid_; asm volatile("" : "+v"(tid));
    const int lane = tid & 63, wave = __builtin_amdgcn_readfirstlane(tid >> 6), fr = lane & 15, fq = lane >> 4;
    const bf16_t* TR = (const bf16_t*)(a.ws + WS_TR); float* SST = (float*)(a.ws + WS_SST); float* SSL = (float*)(a.ws + WS_SSL);
    for (int u = blockIdx.x; u < NCH * 8; u += G) {
        const int ch = u >> 3, hh = u & 7, grp = hh >> 2; int row0, seq0, L, lat, b, ci, nc; chunk_info(ch, row0, seq0, L, lat, b, ci, nc);
#pragma unroll
        for (int dir = 0; dir < 2; ++dir) {
            const SsdGate g = ssd_gates(a, layer, row0, hh, dir, lane);
            const float w0 = g.dt0 * __expf(dir == 0 ? g.tot - g.P0 : g.P0 - g.la0), w1 = g.dt1 * __expf(dir == 0 ? g.tot - g.P1 : g.P1 - g.la1);
            f32x4 acc[4];
#pragma unroll
            for (int j = 0; j < 4; ++j) acc[j] = (f32x4){0.f, 0.f, 0.f, 0.f};
#pragma unroll
            for (int ks = 0; ks < 4; ++ks) {
                float ev[8];
#pragma unroll
                for (int j = 0; j < 8; ++j) { const int tok = 32 * ks + 8 * fq + j; const float y0 = __shfl(w0, tok & 63), y1 = __shfl(w1, tok & 63); ev[j] = tok < 64 ? y0 : y1; }
                const u32x4 bv = *(const u32x4*)(TR + (size_t)(T_B + grp * 128 + wave * 16 + fr) * M + row0 + 32 * ks + 8 * fq);
                u32x4 bw; bw.x = pk2(bflo(bv.x) * ev[0], bfhi(bv.x) * ev[1]); bw.y = pk2(bflo(bv.y) * ev[2], bfhi(bv.y) * ev[3]); bw.z = pk2(bflo(bv.z) * ev[4], bfhi(bv.z) * ev[5]); bw.w = pk2(bflo(bv.w) * ev[6], bfhi(bv.w) * ev[7]);
                const bf16x8 bf = __builtin_bit_cast(bf16x8, bw);
#pragma unroll
                for (int j = 0; j < 4; ++j) { const bf16x8 xf = *(const bf16x8*)(TR + (size_t)(T_X + hh * 64 + 16 * j + fr) * M + row0 + 32 * ks + 8 * fq); acc[j] = mfma16(xf, bf, acc[j]); }
            }
            float* dst = SST + ((size_t)(ch * 8 + hh) * 2 + dir) * 8192;
#pragma unroll
            for (int j = 0; j < 4; ++j)
#pragma unroll
                for (int i = 0; i < 4; ++i) dst[(size_t)(16 * j + 4 * fq + i) * 128 + wave * 16 + fr] = acc[j][i];
            if (tid == 0) SSL[(size_t)(ch * 8 + hh) * 2 + dir] = g.tot;
        }
    }
}
__device__ __forceinline__ void ssd_scan_phase(const Args& a, int layer, int tid_, int G) {
    int tid = tid_; asm volatile("" : "+v"(tid));
    const float* SST = (const float*)(a.ws + WS_SST); const float* SSL = (const float*)(a.ws + WS_SSL); bf16_t* CS = (bf16_t*)(a.ws + WS_SSCS);
    for (int task = blockIdx.x; task < 384; task += G) {
        int lat, b, hh, dir, part, nparts;
        if (task < 128) { lat = 1; part = task & 1; dir = (task >> 1) & 1; hh = (task >> 2) & 7; b = task >> 5; nparts = 2; }
        else { const int t2 = task - 128; lat = 0; part = 0; dir = t2 & 1; hh = (t2 >> 1) & 7; b = t2 >> 4; nparts = 1; }
        const int nc = lat ? 16 : 2, ch0 = lat ? 32 + b * 16 : b * 2;
        const int nel = 8192 / nparts, e0 = part * nel, per = nel / NT;
        float c[16];
        const size_t so = ((((size_t)b * DEPTH + layer) * 2 + dir) * 8 + hh) * 8192;
#pragma unroll
        for (int i = 0; i < 16; ++i) if (i < per) c[i] = lat ? a.in[6][so + e0 + i * NT + tid] : 0.f;
        for (int s = 0; s < nc; ++s) { const int ci = dir ? nc - 1 - s : s, ch = ch0 + ci; const size_t sb = (size_t)(ch * 8 + hh) * 2 + dir;
#pragma unroll
            for (int i = 0; i < 16; ++i) if (i < per) CS[sb * 8192 + e0 + i * NT + tid] = f2bf(c[i]);
            const float dec = __expf(SSL[sb]);
#pragma unroll
            for (int i = 0; i < 16; ++i) if (i < per) c[i] = dec * c[i] + SST[sb * 8192 + e0 + i * NT + tid]; }
        if (!lat) {
#pragma unroll
            for (int i = 0; i < 16; ++i) if (i < per) a.out[O_SSD + so + e0 + i * NT + tid] = c[i]; }
    }
}
__device__ __forceinline__ void ssd_out_phase(const Args& a, int layer, LAS unsigned char* lds, int tid_, int G) {
    int tid = tid_; asm volatile("" : "+v"(tid));
    const int lane = tid & 63, wave = __builtin_amdgcn_readfirstlane(tid >> 6), fr = lane & 15, fq = lane >> 4;
    const bf16_t* NAT = (const bf16_t*)(a.ws + WS_NAT); const bf16_t* TR = (const bf16_t*)(a.ws + WS_TR); const bf16_t* PROJ = (const bf16_t*)(a.ws + WS_PROJ);
    const bf16_t* CS = (const bf16_t*)(a.ws + WS_SSCS); float* YPRE = (float*)(a.ws + WS_YPRE); float* SSQ = (float*)(a.ws + WS_SSQ);
    LAS float* U = (LAS float*)(lds + 4096); LAS float* Wv = U + 128; LAS float* DT = U + 256; LAS float* EO = U + 384;
    for (int u = blockIdx.x; u < NCH * 8; u += G) {
        const int ch = u >> 3, hh = u & 7, grp = hh >> 2; int row0, seq0, L, lat, b, ci, nc; chunk_info(ch, row0, seq0, L, lat, b, ci, nc);
        const int t = wave * 16 + fr;
        bf16x8 cf[4];
#pragma unroll
        for (int ks = 0; ks < 4; ++ks) cf[ks] = *(const bf16x8*)(NAT + (size_t)(row0 + t) * NATP + N_XBC + 768 + grp * 128 + 32 * ks + 8 * fq);
        f32x4 ysum[4];
#pragma unroll
        for (int j = 0; j < 4; ++j) ysum[j] = (f32x4){0.f, 0.f, 0.f, 0.f};
#pragma unroll 1
        for (int dir = 0; dir < 2; ++dir) {
            const size_t sb = (size_t)(ch * 8 + hh) * 2 + dir;
            __syncthreads();
            if (wave == 0) {
                const SsdGate g = ssd_gates(a, layer, row0, hh, dir, lane);
                if (dir == 0) { U[lane] = -g.P0; U[lane + 64] = -g.P1; Wv[lane] = g.P0; Wv[lane + 64] = g.P1; EO[lane] = __expf(g.P0); EO[lane + 64] = __expf(g.P1); }
                else { const float E0 = g.P0 - g.la0, E1 = g.P1 - g.la1; U[lane] = E0; U[lane + 64] = E1; Wv[lane] = -E0; Wv[lane + 64] = -E1; EO[lane] = __expf(g.tot - E0); EO[lane + 64] = __expf(g.tot - E1); }
                DT[lane] = g.dt0; DT[lane + 64] = g.dt1;
            }
            __syncthreads();
            const float wt = Wv[t], eot = EO[t];
            f32x4 acc[4];
#pragma unroll
            for (int j = 0; j < 4; ++j) acc[j] = (f32x4){0.f, 0.f, 0.f, 0.f};
#pragma unroll
            for (int ks = 0; ks < 4; ++ks)
#pragma unroll
                for (int j = 0; j < 4; ++j) { const bf16x8 sf = *(const bf16x8*)(CS + sb * 8192 + (size_t)(16 * j + fr) * 128 + 32 * ks + 8 * fq); acc[j] = mfma16(sf, cf[ks], acc[j]); }
#pragma unroll
            for (int j = 0; j < 4; ++j) acc[j] *= eot;
            const int jlo = dir == 0 ? 0 : (wave >> 1), jhi = dir == 0 ? (wave >> 1) : 3;
            for (int jp = jlo; jp <= jhi; ++jp) {
                const int ta = 32 * jp + 8 * (fr >> 2) + (fr & 3);
                f32x4 sa = (f32x4){0.f, 0.f, 0.f, 0.f}, sb2 = (f32x4){0.f, 0.f, 0.f, 0.f};
#pragma unroll
                for (int ks = 0; ks < 4; ++ks) {
                    const bf16x8 ba = *(const bf16x8*)(NAT + (size_t)(row0 + ta) * NATP + N_XBC + 512 + grp * 128 + 32 * ks + 8 * fq);
                    const bf16x8 bb = *(const bf16x8*)(NAT + (size_t)(row0 + ta + 4) * NATP + N_XBC + 512 + grp * 128 + 32 * ks + 8 * fq);
                    sa = mfma16(ba, cf[ks], sa); sb2 = mfma16(bb, cf[ks], sb2); }
                float pa[4], pb[4];
#pragma unroll
                for (int i = 0; i < 4; ++i) { const int s0 = 32 * jp + 8 * fq + i, s1 = s0 + 4;
                    const bool ok0 = dir == 0 ? s0 <= t : s0 >= t, ok1 = dir == 0 ? s1 <= t : s1 >= t;
                    pa[i] = ok0 ? sa[i] * DT[s0] * __expf(U[s0] + wt) : 0.f; pb[i] = ok1 ? sb2[i] * DT[s1] * __expf(U[s1] + wt) : 0.f; }
                u32x4 pw; pw.x = pk2(pa[0], pa[1]); pw.y = pk2(pa[2], pa[3]); pw.z = pk2(pb[0], pb[1]); pw.w = pk2(pb[2], pb[3]);
                const bf16x8 pf = __builtin_bit_cast(bf16x8, pw);
#pragma unroll
                for (int j = 0; j < 4; ++j) { const bf16x8 xf = *(const bf16x8*)(TR + (size_t)(T_X + hh * 64 + 16 * j + fr) * M + row0 + 32 * jp + 8 * fq); acc[j] = mfma16(xf, pf, acc[j]); }
            }
#pragma unroll
            for (int j = 0; j < 4; ++j) ysum[j] += acc[j];
        }
        const float Dh = a.in[34][layer * 8 + hh]; float ss = 0.f;
#pragma unroll
        for (int j = 0; j < 4; ++j) { const int p = 16 * j + 4 * fq;
            const u32x2 xv = *(const u32x2*)(NAT + (size_t)(row0 + t) * NATP + N_XBC + hh * 64 + p), zv = *(const u32x2*)(PROJ + (size_t)(row0 + t) * PJ + P_Z + hh * 64 + p);
            f32x4 y; y[0] = (ysum[j][0] + bflo(xv.x) * Dh) * fsilu(bflo(zv.x)); y[1] = (ysum[j][1] + bfhi(xv.x) * Dh) * fsilu(bfhi(zv.x));
            y[2] = (ysum[j][2] + bflo(xv.y) * Dh) * fsilu(bflo(zv.y)); y[3] = (ysum[j][3] + bfhi(xv.y) * Dh) * fsilu(bfhi(zv.y));
            ss += (y[0] * y[0] + y[1] * y[1]) + (y[2] * y[2] + y[3] * y[3]);
            *(f32x4*)(YPRE + (size_t)(row0 + t) * 512 + hh * 64 + p) = y; }
        ss += __shfl_xor(ss, 16); ss += __shfl_xor(ss, 32);
        if (fq == 0) SSQ[(size_t)(row0 + t) * 8 + hh] = ss;
    }
}
__device__ __forceinline__ void ssd_fin_phase(const Args& a, int layer, int gw, int ngw, int lane_) {
    int lane = lane_; asm volatile("" : "+v"(lane));
    const float* YPRE = (const float*)(a.ws + WS_YPRE); const float* SSQ = (const float*)(a.ws + WS_SSQ); bf16_t* BR = (bf16_t*)(a.ws + WS_BR); const float* ng = a.in[35] + layer * 512;
    for (int row = gw; row < M; row += ngw) {
        float s = lane < 8 ? SSQ[(size_t)row * 8 + lane] : 0.f; s += __shfl_xor(s, 1); s += __shfl_xor(s, 2); s += __shfl_xor(s, 4); s = __shfl(s, 0);
        const float r = rsqrtf(s * (1.f / 512.f) + 1e-6f);
        const f32x4 y0 = *(const f32x4*)(YPRE + (size_t)row * 512 + 8 * lane), y1 = *(const f32x4*)(YPRE + (size_t)row * 512 + 8 * lane + 4);
        const f32x4 g0 = *(const f32x4*)(ng + 8 * lane), g1 = *(const f32x4*)(ng + 8 * lane + 4);
        *(u32x4*)(BR + (size_t)row * D + 1024 + 8 * lane) = pack8(y0 * r * g0, y1 * r * g1);
    }
}
}
namespace mk {
constexpr size_t WS_CK = WS_SSD_END;
constexpr size_t WS_CVT = AL(WS_CK + (size_t)16 * 512 * 512 * 2);
constexpr size_t WS_ATT_END = AL(WS_CVT + (size_t)16 * 512 * 512 * 2);

__device__ __forceinline__ void prologue_cache(const Args& a, int gw, int ngw, int lane) {
    bf16_t* CK = (bf16_t*)(a.ws + WS_CK); bf16_t* CVT = (bf16_t*)(a.ws + WS_CVT);
    for (size_t i = ((size_t)gw * 64 + lane) * 8; i < (size_t)16 * 512 * 512; i += (size_t)ngw * 64 * 8) {
        const f32x4 x0 = *(const f32x4*)(a.in[2] + i), x1 = *(const f32x4*)(a.in[2] + i + 4); *(u32x4*)(CK + i) = pack8(x0, x1); }
    for (size_t i = (size_t)gw * 64 + lane; i < (size_t)16 * 64 * 512; i += (size_t)ngw * 64) { const int c = i & 511, s8 = (i >> 9) & 63, bl = i >> 15;
        const float* src = a.in[3] + ((size_t)bl * 512 + 8 * s8) * 512 + c;
        u32x4 o; o.x = pk2(src[0], src[512]); o.y = pk2(src[1024], src[1536]); o.z = pk2(src[2048], src[2560]); o.w = pk2(src[3072], src[3584]);
        *(u32x4*)(CVT + ((size_t)bl * 512 + c) * 512 + 8 * s8) = o; }
}
struct AttState { float m, l; f32x4 o[4]; };
template <bool MASKED>
__device__ __forceinline__ void attn_group(AttState& st, const bf16x8 (&qf)[2], const bf16_t* kbase, size_t kp, const bf16_t* vt, size_t vp, int fr, int fq,
                                           const float* bias  , int kc0, int cq, int cs) {
    const int ra = 8 * (fr >> 2) + (fr & 3);
    f32x4 sa = (f32x4){0.f, 0.f, 0.f, 0.f}, sb = (f32x4){0.f, 0.f, 0.f, 0.f};
#pragma unroll
    for (int ks = 0; ks < 2; ++ks) { const bf16x8 ka = *(const bf16x8*)(kbase + (size_t)ra * kp + 32 * ks + 8 * fq), kb = *(const bf16x8*)(kbase + (size_t)(ra + 4) * kp + 32 * ks + 8 * fq);
        sa = mfma16(ka, qf[ks], sa); sb = mfma16(kb, qf[ks], sb); }
    float s[8]; float gm = -1e30f;
#pragma unroll
    for (int i = 0; i < 4; ++i) { s[i] = sa[i] * 0.125f; s[4 + i] = sb[i] * 0.125f; }
    if (MASKED) {
#pragma unroll
        for (int e = 0; e < 8; ++e) { const int kc = kc0 + 8 * fq + e; const bool ok = kc >= cs && kc < cs + 16; const int bi = min(max(kc - cq + 15, 0), 30); s[e] = ok ? s[e] + bias[bi] : -1e30f; }
    }
#pragma unroll
    for (int e = 0; e < 8; ++e) gm = fmaxf(gm, s[e]);
    gm = fmaxf(gm, __shfl_xor(gm, 16)); gm = fmaxf(gm, __shfl_xor(gm, 32));
    const float mn = fmaxf(st.m, gm), al = __expf(st.m - mn); st.m = mn;
    float p[8], ps = 0.f;
#pragma unroll
    for (int e = 0; e < 8; ++e) { p[e] = __expf(s[e] - mn); ps += p[e]; }
    st.l = st.l * al + ps;
    u32x4 pw; pw.x = pk2(p[0], p[1]); pw.y = pk2(p[2], p[3]); pw.z = pk2(p[4], p[5]); pw.w = pk2(p[6], p[7]);
    const bf16x8 pf = __builtin_bit_cast(bf16x8, pw);
#pragma unroll
    for (int j = 0; j < 4; ++j) { const bf16x8 vf = *(const bf16x8*)(vt + (size_t)(16 * j + fr) * vp + 8 * fq); st.o[j] = mfma16(vf, pf, st.o[j] * al); }
}
__device__ __forceinline__ void attn_phase(const Args& a, int layer, int gw_, int ngw, int lane_) {
    int lane = lane_, gw = gw_; asm volatile("" : "+v"(lane));
    const int fr = lane & 15, fq = lane >> 4;
    const bf16_t* PROJ = (const bf16_t*)(a.ws + WS_PROJ); const bf16_t* TR = (const bf16_t*)(a.ws + WS_TR); bf16_t* BR = (bf16_t*)(a.ws + WS_BR);
    const bf16_t* CK = (const bf16_t*)(a.ws + WS_CK); const bf16_t* CVT = (const bf16_t*)(a.ws + WS_CVT);
    for (int it = gw; it < 6144; it += ngw) {
        AttState st; st.m = -1e30f; st.l = 0.f;
#pragma unroll
        for (int j = 0; j < 4; ++j) st.o[j] = (f32x4){0.f, 0.f, 0.f, 0.f};
        int qrow, hh;
        if (it < 4096) {
            const int jq = it & 3, r = (it >> 2) & 31; hh = (it >> 7) & 7; const int b = it >> 10;
            const int seq0 = MP + b * 2048; qrow = seq0 + r * 64 + 16 * jq + fr;
            bf16x8 qf[2];
#pragma unroll
            for (int ks = 0; ks < 2; ++ks) qf[ks] = *(const bf16x8*)(PROJ + (size_t)qrow * PJ + P_Q + hh * 64 + 32 * ks + 8 * fq);
            const int rs = min(max(r - 4, 0), 24), cq = 16 * jq + fr, cs = min(max(cq - 8, 0), 48);
            const int kc0 = jq == 0 ? 0 : (jq == 1 ? 8 : (jq == 2 ? 24 : 32));
            const float* rpb = a.in[19] + ((size_t)layer * 8 + hh) * 15 * 31;
            for (int j = 0; j < 8; ++j) { const int kr = rs + j, tok0 = seq0 + kr * 64 + kc0;
                attn_group<true>(st, qf, PROJ + (size_t)tok0 * PJ + P_K + hh * 64, PJ, TR + (size_t)(T_V + hh * 64) * M + tok0, M, fr, fq, rpb + (kr - r + 7) * 31, kc0, cq, cs); }
            const size_t cb = ((size_t)b * DEPTH + layer) * 512;
            for (int g = 0; g < 16; ++g)
                attn_group<false>(st, qf, CK + (cb + 32 * g) * 512 + hh * 64, 512, CVT + (cb + hh * 64) * 512 + 32 * g, 512, fr, fq, nullptr, 0, 0, 0);
        } else {
            const int i2 = it - 4096, qt = i2 & 15; hh = (i2 >> 4) & 7; const int b = i2 >> 7, seq0 = b * 256; qrow = seq0 + 16 * qt + fr;
            bf16x8 qf[2];
#pragma unroll
            for (int ks = 0; ks < 2; ++ks) qf[ks] = *(const bf16x8*)(PROJ + (size_t)qrow * PJ + P_Q + hh * 64 + 32 * ks + 8 * fq);
            for (int g = 0; g < 8; ++g) { const int tok0 = seq0 + 32 * g;
                attn_group<false>(st, qf, PROJ + (size_t)tok0 * PJ + P_K + hh * 64, PJ, TR + (size_t)(T_V + hh * 64) * M + tok0, M, fr, fq, nullptr, 0, 0, 0); }
        }
        float l = st.l; l += __shfl_xor(l, 16); l += __shfl_xor(l, 32);
        const float rl = 1.f / l;
#pragma unroll
        for (int j = 0; j < 4; ++j) { u32x2 w; w.x = pk2(st.o[j][0] * rl, st.o[j][1] * rl); w.y = pk2(st.o[j][2] * rl, st.o[j][3] * rl);
            *(u32x2*)(BR + (size_t)qrow * D + hh * 64 + 16 * j + 4 * fq) = w; }
    }
}
}
namespace mk {
constexpr int S5K = 768;
constexpr size_t WS_S5W = WS_ATT_END;
constexpr size_t WS_S5WS = AL(WS_S5W + (size_t)DEPTH * 32 * 512 * S5K * 2);
constexpr size_t WS_S5AP = AL(WS_S5WS + (size_t)DEPTH * 32 * 256 * 512 * 2);
constexpr size_t WS_S5UP = AL(WS_S5AP + (size_t)DEPTH * 32 * 2 * 64 * 2 * 4);
constexpr size_t WS_S5SS = AL(WS_S5UP + (size_t)32 * 384 * 512 * 2);
constexpr size_t WS_S5HS = AL(WS_S5SS + (size_t)32 * 384 * 256 * 4);
constexpr size_t WS_S5_END = AL(WS_S5HS + (size_t)32 * 384 * 256 * 2);

__device__ __forceinline__ void s5_param_phase(const Args& a, LAS unsigned char* lds, int tid_, int G) {
    int tid = tid_; asm volatile("" : "+v"(tid));
    LAS float* PW = (LAS float*)lds; LAS float* BB = PW + 2 * 33 * 64 * 2; LAS float* CC = BB + 2 * 64 * 16 * 2; LAS float* KT = CC + 2 * 16 * 64 * 2;
    for (int task = blockIdx.x; task < DEPTH * 32; task += G) {
        const int layer = task >> 5, g = task & 31;
        const float* a_re = a.in[20] + layer * 4096; const float* a_im = a.in[21] + layer * 4096; const float* log_dt = a.in[22] + layer * 64;
        const float* b_re = a.in[23] + (size_t)layer * 65536; const float* b_im = a.in[24] + (size_t)layer * 65536; const float* c_re = a.in[25] + (size_t)layer * 65536; const float* c_im = a.in[26] + (size_t)layer * 65536;
        const float* s5d = a.in[27] + layer * 512;
        bf16_t* S5W = (bf16_t*)(a.ws + WS_S5W) + (size_t)layer * 32 * 512 * S5K; bf16_t* S5WS = (bf16_t*)(a.ws + WS_S5WS) + (size_t)layer * 32 * 256 * 512; float* S5AP = (float*)(a.ws + WS_S5AP) + (size_t)layer * 32 * 2 * 64 * 2;
        __syncthreads();
        if (tid < 128) { const int dir = tid >> 6, n = tid & 63, pi = (dir * 32 + g) * 64 + n;
            const float are = fminf(a_re[pi], -1e-4f), aim = a_im[pi], dt = expf(log_dt[dir * 32 + g]);
            const float mag = expf(dt * are), abr = mag * cosf(dt * aim), abi = mag * sinf(dt * aim);
            const float den = are * are + aim * aim, nr = abr - 1.f, cfr = (nr * are + abi * aim) / den, cfi = (abi * are - nr * aim) / den;
            float pr = 1.f, pim = 0.f;
            for (int p = 0; p <= 32; ++p) { PW[((dir * 33 + p) * 64 + n) * 2] = pr; PW[((dir * 33 + p) * 64 + n) * 2 + 1] = pim; const float t = pr * abr - pim * abi; pim = pr * abi + pim * abr; pr = t; }
            S5AP[((g * 2 + dir) * 64 + n) * 2] = PW[((dir * 33 + 32) * 64 + n) * 2]; S5AP[((g * 2 + dir) * 64 + n) * 2 + 1] = PW[((dir * 33 + 32) * 64 + n) * 2 + 1];
            for (int k = 0; k < 16; ++k) { const float br_ = b_re[(size_t)pi * 16 + k], bi_ = b_im[(size_t)pi * 16 + k];
                BB[((dir * 64 + n) * 16 + k) * 2] = cfr * br_ - cfi * bi_; BB[((dir * 64 + n) * 16 + k) * 2 + 1] = cfr * bi_ + cfi * br_; }
            for (int j = 0; j < 16; ++j) { CC[((dir * 64 + n) * 16 + j) * 2] = c_re[((size_t)(dir * 32 + g) * 16 + j) * 64 + n]; CC[((dir * 64 + n) * 16 + j) * 2 + 1] = c_im[((size_t)(dir * 32 + g) * 16 + j) * 64 + n]; }
        }
        __syncthreads();
        for (int e = tid; e < 2 * 32 * 256; e += NT) { const int j = e & 15, k = (e >> 4) & 15, tau = (e >> 8) & 31, dir = e >> 13; float s = 0.f;
            for (int n = 0; n < 64; ++n) { const float cr = CC[((dir * 64 + n) * 16 + j) * 2], ci = CC[((dir * 64 + n) * 16 + j) * 2 + 1], pr = PW[((dir * 33 + tau) * 64 + n) * 2], pim = PW[((dir * 33 + tau) * 64 + n) * 2 + 1];
                const float xr = cr * pr - ci * pim, xi = cr * pim + ci * pr, br_ = BB[((dir * 64 + n) * 16 + k) * 2], bi_ = BB[((dir * 64 + n) * 16 + k) * 2 + 1];
                s += xr * br_ - xi * bi_; }
            KT[e] = s; }
        __syncthreads();
        { const int t = tid >> 4, j = tid & 15; bf16_t* dst = S5W + ((size_t)g * 512 + tid) * S5K;
            for (int s = 0; s < 32; ++s) { float v[16];
#pragma unroll
                for (int k = 0; k < 16; ++k) { float x;
                    if (s < t) x = KT[((0 * 32 + (t - s)) * 16 + k) * 16 + j]; else if (s > t) x = KT[((1 * 32 + (s - t)) * 16 + k) * 16 + j];
                    else x = KT[((0 * 32 + 0) * 16 + k) * 16 + j] + KT[((1 * 32 + 0) * 16 + k) * 16 + j] + (k == j ? s5d[g * 16 + k] : 0.f);
                    v[k] = x; }
                u32x4 o0, o1; o0.x = pk2(v[0], v[1]); o0.y = pk2(v[2], v[3]); o0.z = pk2(v[4], v[5]); o0.w = pk2(v[6], v[7]); o1.x = pk2(v[8], v[9]); o1.y = pk2(v[10], v[11]); o1.z = pk2(v[12], v[13]); o1.w = pk2(v[14], v[15]);
                *(u32x4*)(dst + s * 16) = o0; *(u32x4*)(dst + s * 16 + 8) = o1; }
            for (int dir = 0; dir < 2; ++dir) { const int p = dir == 0 ? t + 1 : 32 - t;
                for (int n8 = 0; n8 < 8; ++n8) { float gr[8], gi[8];
#pragma unroll
                    for (int q = 0; q < 8; ++q) { const int n = n8 * 8 + q; const float cr = CC[((dir * 64 + n) * 16 + j) * 2], ci = CC[((dir * 64 + n) * 16 + j) * 2 + 1], pr = PW[((dir * 33 + p) * 64 + n) * 2], pim = PW[((dir * 33 + p) * 64 + n) * 2 + 1];
                        gr[q] = cr * pr - ci * pim; gi[q] = -(cr * pim + ci * pr); }
                    u32x4 o; o.x = pk2(gr[0], gr[1]); o.y = pk2(gr[2], gr[3]); o.z = pk2(gr[4], gr[5]); o.w = pk2(gr[6], gr[7]); *(u32x4*)(dst + 512 + dir * 128 + n8 * 8) = o;
                    o.x = pk2(gi[0], gi[1]); o.y = pk2(gi[2], gi[3]); o.z = pk2(gi[4], gi[5]); o.w = pk2(gi[6], gi[7]); *(u32x4*)(dst + 512 + dir * 128 + 64 + n8 * 8) = o; } }
        }
        if (tid < 256) { const int dir = tid >> 7, reim = (tid >> 6) & 1, n = tid & 63; bf16_t* dst = S5WS + ((size_t)g * 256 + tid) * 512;
            for (int s = 0; s < 32; ++s) { const int p = dir == 0 ? 31 - s : s; const float pr = PW[((dir * 33 + p) * 64 + n) * 2], pim = PW[((dir * 33 + p) * 64 + n) * 2 + 1]; float v[16];
#pragma unroll
                for (int k = 0; k < 16; ++k) { const float br_ = BB[((dir * 64 + n) * 16 + k) * 2], bi_ = BB[((dir * 64 + n) * 16 + k) * 2 + 1]; v[k] = reim == 0 ? pr * br_ - pim * bi_ : pr * bi_ + pim * br_; }
                u32x4 o0, o1; o0.x = pk2(v[0], v[1]); o0.y = pk2(v[2], v[3]); o0.z = pk2(v[4], v[5]); o0.w = pk2(v[6], v[7]); o1.x = pk2(v[8], v[9]); o1.y = pk2(v[10], v[11]); o1.z = pk2(v[12], v[13]); o1.w = pk2(v[14], v[15]);
                *(u32x4*)(dst + s * 16) = o0; *(u32x4*)(dst + s * 16 + 8) = o1; } }
    }
    __syncthreads();
}
__device__ __forceinline__ void s5_statein_phase(const Args& a, int layer, int gw, int ngw, int lane_) {
    int lane = lane_; asm volatile("" : "+v"(lane));
    const int fr = lane & 15, fq = lane >> 4;
    const bf16_t* UP = (const bf16_t*)(a.ws + WS_S5UP); const bf16_t* S5WS = (const bf16_t*)(a.ws + WS_S5WS) + (size_t)layer * 32 * 256 * 512; float* SS = (float*)(a.ws + WS_S5SS);
    for (int it = gw; it < 32 * 24; it += ngw) { const int g = it / 24, r = it % 24, og = r / 6, cq = r % 6;
        f32x4 acc[4][4];
#pragma unroll
        for (int i = 0; i < 4; ++i)
#pragma unroll
            for (int j = 0; j < 4; ++j) acc[i][j] = (f32x4){0.f, 0.f, 0.f, 0.f};
        const bf16_t* ap = S5WS + ((size_t)g * 256 + 64 * og + fr) * 512 + 8 * fq; const bf16_t* bp = UP + ((size_t)g * 384 + 64 * cq + fr) * 512 + 8 * fq;
#pragma unroll 2
        for (int ks = 0; ks < 16; ++ks) { bf16x8 af[4], bf[4];
#pragma unroll
            for (int i = 0; i < 4; ++i) { af[i] = *(const bf16x8*)(ap + (size_t)16 * i * 512 + 32 * ks); bf[i] = *(const bf16x8*)(bp + (size_t)16 * i * 512 + 32 * ks); }
#pragma unroll
            for (int i = 0; i < 4; ++i)
#pragma unroll
                for (int j = 0; j < 4; ++j) acc[i][j] = mfma16(af[i], bf[j], acc[i][j]); }
#pragma unroll
        for (int i = 0; i < 4; ++i)
#pragma unroll
            for (int j = 0; j < 4; ++j) *(f32x4*)(SS + ((size_t)g * 384 + 64 * cq + 16 * j + fr) * 256 + 64 * og + 16 * i + 4 * fq) = acc[i][j];
    }
}
__device__ __forceinline__ void s5_scan_phase(const Args& a, int layer, int gw, int ngw, int lane_) {
    int lane = lane_; asm volatile("" : "+v"(lane));
    const float* SS = (const float*)(a.ws + WS_S5SS); bf16_t* HS = (bf16_t*)(a.ws + WS_S5HS); const float* S5AP = (const float*)(a.ws + WS_S5AP) + (size_t)layer * 32 * 2 * 64 * 2;
    for (int task = gw; task < 1280; task += ngw) {
        int sq, g, dir; if (task < 256) { sq = 16 + (task >> 6); g = (task >> 1) & 31; dir = task & 1; } else { const int t2 = task - 256; sq = t2 >> 6; g = (t2 >> 1) & 31; dir = t2 & 1; }
        const int lat = sq >= 16, b = lat ? sq - 16 : sq, nc = lat ? 64 : 8, cg0 = lat ? 128 + b * 64 : b * 8;
        const float apr = S5AP[((g * 2 + dir) * 64 + lane) * 2], api = S5AP[((g * 2 + dir) * 64 + lane) * 2 + 1];
        float hr = 0.f, hi = 0.f;
        if (lat) { const size_t so = ((((size_t)b * DEPTH + layer) * 2 + dir) * 32 + g) * 64 + lane; hr = a.in[4][so]; hi = a.in[5][so]; }
        for (int s = 0; s < nc; ++s) { const int cg = cg0 + (dir ? nc - 1 - s : s); const size_t base = ((size_t)g * 384 + cg) * 256 + dir * 128;
            HS[base + lane] = f2bf(hr); HS[base + 64 + lane] = f2bf(hi);
            const float sr = SS[base + lane], si = SS[base + 64 + lane];
            const float t = apr * hr - api * hi + sr; hi = apr * hi + api * hr + si; hr = t; }
        if (!lat) { const size_t oo = ((((size_t)b * DEPTH + layer) * 2 + dir) * 32 + g) * 64 + lane; a.out[O_S5R + oo] = hr; a.out[O_S5I + oo] = hi; }
    }
}
__device__ __forceinline__ void s5_out_phase(const Args& a, int layer, int gw, int ngw, int lane_) {
    int lane = lane_; asm volatile("" : "+v"(lane));
    const int fr = lane & 15, fq = lane >> 4;
    const bf16_t* UP = (const bf16_t*)(a.ws + WS_S5UP); const bf16_t* S5W = (const bf16_t*)(a.ws + WS_S5W) + (size_t)layer * 32 * 512 * S5K; const bf16_t* HS = (const bf16_t*)(a.ws + WS_S5HS); bf16_t* ZB = (bf16_t*)(a.ws + WS_ZB);
    for (int it = gw; it < 32 * 48; it += ngw) { const int g = it / 48, r = it % 48, og = r / 6, cq = r % 6;
        f32x4 acc[4][4];
#pragma unroll
        for (int i = 0; i < 4; ++i)
#pragma unroll
            for (int j = 0; j < 4; ++j) acc[i][j] = (f32x4){0.f, 0.f, 0.f, 0.f};
        const bf16_t* ap = S5W + ((size_t)g * 512 + 64 * og + fr) * S5K + 8 * fq;
        const bf16_t* bp = UP + ((size_t)g * 384 + 64 * cq + fr) * 512 + 8 * fq; const bf16_t* hp = HS + ((size_t)g * 384 + 64 * cq + fr) * 256 + 8 * fq;
#pragma unroll 2
        for (int ks = 0; ks < 16; ++ks) { bf16x8 af[4], bf[4];
#pragma unroll
            for (int i = 0; i < 4; ++i) { af[i] = *(const bf16x8*)(ap + (size_t)16 * i * S5K + 32 * ks); bf[i] = *(const bf16x8*)(bp + (size_t)16 * i * 512 + 32 * ks); }
#pragma unroll
            for (int i = 0; i < 4; ++i)
#pragma unroll
                for (int j = 0; j < 4; ++j) acc[i][j] = mfma16(af[i], bf[j], acc[i][j]); }
#pragma unroll 2
        for (int ks = 0; ks < 8; ++ks) { bf16x8 af[4], bf[4];
#pragma unroll
            for (int i = 0; i < 4; ++i) { af[i] = *(const bf16x8*)(ap + (size_t)16 * i * S5K + 512 + 32 * ks); bf[i] = *(const bf16x8*)(hp + (size_t)16 * i * 256 + 32 * ks); }
#pragma unroll
            for (int i = 0; i < 4; ++i)
#pragma unroll
                for (int j = 0; j < 4; ++j) acc[i][j] = mfma16(af[i], bf[j], acc[i][j]); }
#pragma unroll
        for (int i = 0; i < 4; ++i)
#pragma unroll
            for (int j = 0; j < 4; ++j) { float z[4];
#pragma unroll
                for (int e = 0; e < 4; ++e) { const float x = acc[i][j][e]; const float th = 0.7978845608028654f * (x + 0.044715f * x * x * x); const float e2 = __expf(2.f * th); const float tnh = 1.f - 2.f * __builtin_amdgcn_rcpf(e2 + 1.f); z[e] = 0.5f * x * (1.f + tnh); }
                u32x2 w; w.x = pk2(z[0], z[1]); w.y = pk2(z[2], z[3]);
                *(u32x2*)(ZB + (size_t)(32 * (64 * cq + 16 * j + fr) + 4 * og + i) * 512 + g * 16 + 4 * fq) = w; }
    }
}
}
namespace mk { static_assert(WS_S5_END < (size_t)1780 * 1024 * 1024, "workspace map exceeds the guaranteed size"); }
namespace mk {
#ifndef PHMASK
#define PHMASK 0xfffff
#endif
#define PHM(k) ((PHMASK >> (k)) & 1)
#ifndef DUPMASK
#define DUPMASK 0
#endif
#define DUP(k) ((DUPMASK >> (k)) & 1)
constexpr int NPH = 12;
constexpr int PH_TOTAL = 1 + DEPTH * NPH;
__global__ void __launch_bounds__(NT, 2) mk_fwd(Args a) {
    extern __shared__ __attribute__((aligned(16))) unsigned char lds_raw[];
    LAS unsigned char* lds = (LAS unsigned char*)lds_raw;
#define TID ((int)threadIdx.x)
#define LANE ((int)(threadIdx.x & 63))
#define WAVE (__builtin_amdgcn_readfirstlane((int)(threadIdx.x >> 6)))
#define GW ((int)blockIdx.x * NWV + WAVE)
    const int G = gridDim.x, ngw = G * NWV;
    volatile LAS unsigned* ctlw = (volatile LAS unsigned*)(lds + LDS_CTL);
    if (TID < 4) ctlw[TID] = 0u;
    __syncthreads();
    XcdBarrier bar = xcd_barrier_post((unsigned*)(a.ws + WS_CTL), ctlw);
    const int lo = a.ph_lo, hi = a.ph_hi;
#define IN(k) (lo <= (k) && (k) < hi)
#define SEAM(k) do { if (IN(k) && IN((k) + 1)) xcd_barrier(bar); } while (0)
    unsigned char* ws = a.ws;
    bf16_t* H = (bf16_t*)(ws + WS_H); bf16_t* PROJ = (bf16_t*)(ws + WS_PROJ); float* SMALL = (float*)(ws + WS_SMALL); bf16_t* BR = (bf16_t*)(ws + WS_BR);
    bf16_t* MERGED = (bf16_t*)(ws + WS_MERGED); float* MACC = (float*)(ws + WS_MACC); bf16_t* ZB = (bf16_t*)(ws + WS_ZB); bf16_t* HID = PROJ;
    const float* MOD = (const float*)(ws + WS_MOD); float* X = a.out;
    if (PHM(0) && IN(0)) { prologue_convert(a, lds, GW, ngw, WAVE, LANE); prologue_cache(a, GW, ngw, LANE); __syncthreads(); prologue_ada(a, lds, TID); for (int r_ = 0; r_ < 1 + DUP(1); ++r_) s5_param_phase(a, lds, TID, G); }
    SEAM(0);
    for (int l = 0; l < DEPTH; ++l) {
        const int pb = 1 + l * NPH;
        const float* xp = l == 0 ? a.in[0] : X; const float* xs = l == 0 ? a.in[1] : X + (size_t)MP * D;
        const float* modl = MOD + (size_t)l * 5 * 6 * D;
        const bf16_t* wl = (const bf16_t*)(ws + WS_W) + (size_t)l * W_LAYER;
        if (PHM(1) && IN(pb + 0)) norm_phase(xp, xs, a.in[14] + l * D, modl, 0, D, H, GW, ngw, LANE);
        SEAM(pb + 0);
        if (PHM(2) && IN(pb + 1)) { Gemm g{H, wl + W_IN, M, NIN, D, D, 1, 0, 0}; StaticOrder S; S.init(M, NIN, G, blockIdx.x);
            EpiIn E{PROJ, SMALL, a.out, a.in[17] + l * 64, a.in[18] + l * 64, l}; gemm_phase(lds, g, S, E); }
        SEAM(pb + 1);
        if (PHM(3) && IN(pb + 2)) { for (int r_ = 0; r_ < 1 + DUP(0); ++r_) { prep_phase(a, l, lds, GW, ngw, WAVE, LANE, (bf16_t*)(a.ws + WS_S5UP)); __syncthreads(); } }
        SEAM(pb + 2);
        if (PHM(4) && IN(pb + 3)) { for (int r_ = 0; r_ < 1 + DUP(2); ++r_) attn_phase(a, l, GW, ngw, LANE); for (int r_ = 0; r_ < 1 + DUP(3); ++r_) { ml_states_phase(a, l, TID, G); ssd_states_phase(a, l, TID, G); s5_statein_phase(a, l, GW, ngw, LANE); } }
        SEAM(pb + 3);
        if (PHM(5) && IN(pb + 4)) { for (int r_ = 0; r_ < 1 + DUP(4); ++r_) { ml_scan_phase(a, l, TID, G); ssd_scan_phase(a, l, TID, G); s5_scan_phase(a, l, GW, ngw, LANE); } }
        SEAM(pb + 4);
        if (PHM(12) && IN(pb + 5)) { for (int r_ = 0; r_ < 1 + DUP(5); ++r_) ml_out_phase(a, l, lds, TID, G); for (int r_ = 0; r_ < 1 + DUP(6); ++r_) ssd_out_phase(a, l, lds, TID, G); for (int r_ = 0; r_ < 1 + DUP(7); ++r_) s5_out_phase(a, l, GW, ngw, LANE); }
        SEAM(pb + 5);
        if (PHM(6) && IN(pb + 6)) { Gemm g{ZB, wl + W_GLU, M, 512, 512, 512, 1, 0, 0}; StaticOrder S; S.init(M, 512, G, blockIdx.x);
            EpiGlu E{ZB, a.in[29] + l * 512, BR}; gemm_phase(lds, g, S, E); ssd_fin_phase(a, l, GW, ngw, LANE); }
        SEAM(pb + 6);
        if (PHM(7) && IN(pb + 7)) { Gemm g{BR, wl + W_BR, M, D, 512, D, 4, 512, (size_t)D * 512}; StaticOrder S; S.init(M, D, G, blockIdx.x, 4);
            EpiBranch E{PROJ, MACC, MERGED}; gemm_phase(lds, g, S, E); }
        SEAM(pb + 7);
        if (PHM(8) && IN(pb + 8)) { Gemm g{MERGED, wl + W_OUT, M, D, D, D, 1, 0, 0}; StaticOrder S; S.init(M, D, G, blockIdx.x);
            EpiResid E{xp, xs, modl, 2 * D, X}; gemm_phase(lds, g, S, E); }
        SEAM(pb + 8);
        if (PHM(9) && IN(pb + 9)) norm_phase(X, X + (size_t)MP * D, a.in[15] + l * D, modl, 3 * D, 4 * D, H, GW, ngw, LANE);
        SEAM(pb + 9);
        if (PHM(10) && IN(pb + 10)) { Gemm g{H, wl + W_1, M, DFF, D, D, 1, 0, 0}; StaticOrder S; S.init(M, DFF, G, blockIdx.x);
            EpiRelu2 E{HID, DFF}; gemm_phase(lds, g, S, E); }
        SEAM(pb + 10);
        if (PHM(11) && IN(pb + 11)) { Gemm g{HID, wl + W_2, M, D, DFF, DFF, 1, 0, 0}; StaticOrder S; S.init(M, D, G, blockIdx.x);
            EpiResid E{X, X + (size_t)MP * D, modl, 5 * D, X}; gemm_phase(lds, g, S, E); }
        SEAM(pb + 11);
    }
#undef IN
#undef SEAM
}
}
extern "C" void kernel_launch(void* const* d_in, const int* in_sizes, int n_in, void* d_out, int out_size, void* d_ws, size_t ws_size, hipStream_t stream) {
    static int grid = 0;
    if (grid == 0) {
        int dev = 0, cus = 0; (void)hipGetDevice(&dev); (void)hipDeviceGetAttribute(&cus, hipDeviceAttributeMultiprocessorCount, dev);
        (void)hipFuncSetAttribute((const void*)mk::mk_fwd, hipFuncAttributeMaxDynamicSharedMemorySize, mk::LDS_BYTES);
        int per_cu = 0; (void)hipOccupancyMaxActiveBlocksPerMultiprocessor(&per_cu, (const void*)mk::mk_fwd, mk::NT, mk::LDS_BYTES); (void)hipGetLastError();
        grid = cus > 0 ? cus : 256;
    }
    mk::Args a{}; for (int i = 0; i < 43; ++i) a.in[i] = (const float*)d_in[i];
    a.out = (float*)d_out; a.ws = (unsigned char*)d_ws; a.ph_lo = 0; a.ph_hi = mk::PH_TOTAL;
    (void)hipMemsetAsync(a.ws + mk::WS_CTL, 0, mk::CTL_BYTES, stream);
    hipLaunchKernelGGL(mk::mk_fwd, dim3(grid), dim3(mk::NT), mk::LDS_BYTES, stream, a);
}
```

```cpp
#define SAFE_GEMM 0
#define DUPMASK 0
#include <hip/hip_runtime.h>
#include <math.h>
namespace mk {
#define LAS __attribute__((address_space(3)))
typedef unsigned short bf16_t;
typedef short bf16x8 __attribute__((ext_vector_type(8)));
typedef float f32x4 __attribute__((ext_vector_type(4)));
typedef float f32x2 __attribute__((ext_vector_type(2)));
typedef unsigned u32x4 __attribute__((ext_vector_type(4)));
typedef unsigned u32x2 __attribute__((ext_vector_type(2)));
constexpr int NT = 512, NWV = 8;
constexpr int D = 2048, MP = 4096, MLAT = 8192, M = MP + MLAT, DEPTH = 4, DFF = 8192;
constexpr int PJ = 13824;
constexpr int NIN = 14080;
constexpr int P_Q = 0, P_K = 512, P_V = 1024, P_S5U = 1536, P_Z = 2048, P_XBC = 2560, P_MQ = 3584, P_MK = 4096, P_MV = 4608, P_MO = 5120, P_GATE = 5632;
constexpr int S_DT = 0, S_MI = 16, S_MF = 24;

typedef __bf16 bf16x2_t __attribute__((ext_vector_type(2)));
__device__ __forceinline__ unsigned pk2(float lo, float hi) { f32x2 v = {lo, hi}; bf16x2_t b = __builtin_convertvector(v, bf16x2_t); return __builtin_bit_cast(unsigned, b); }
__device__ __forceinline__ float bf2f(bf16_t v) { return __uint_as_float(((unsigned)v) << 16); }
__device__ __forceinline__ float bflo(unsigned w) { return __uint_as_float(w << 16); }
__device__ __forceinline__ float bfhi(unsigned w) { return __uint_as_float(w & 0xffff0000u); }
__device__ __forceinline__ bf16_t f2bf(float f) { return (bf16_t)(pk2(f, 0.f) & 0xffffu); }
__device__ __forceinline__ float fsigm(float x) { return __builtin_amdgcn_rcpf(1.f + __expf(-x)); }
__device__ __forceinline__ float fsilu(float x) { return x * fsigm(x); }
__device__ __forceinline__ int row_cvec(int row) { return row < MP ? 0 : 1 + (row - MP) / 2048; }

#define XB_TMO      128
#define XB_XCNT(j)  (256  + 64 * (j))
#define XB_XSUB(j)  (1280 + 64 * (j))
#define XB_XGEN(j)  (2304 + 64 * (j))
#define XB_TOP      3328
#define XB_TOPGEN   3392
#define XCD_BAR_WORDS 3456
#define XB_SPIN_CAP (1u << 18)
__device__ __forceinline__ unsigned xb_ld(unsigned* p)              { return __hip_atomic_load(p, __ATOMIC_RELAXED, __HIP_MEMORY_SCOPE_AGENT); }
__device__ __forceinline__ unsigned xb_add(unsigned* p, unsigned v) { return __hip_atomic_fetch_add(p, v, __ATOMIC_RELAXED, __HIP_MEMORY_SCOPE_AGENT); }
__device__ __forceinline__ unsigned xb_xcc_id() { return (unsigned)__builtin_amdgcn_s_getreg((3 << 11) | 20) & 0xFu; }
#define XB_SPIN(cond, bar) do { unsigned _sp = 0; while (cond) { __builtin_amdgcn_s_sleep(1); \
    if ((++_sp & 255u) == 0u) { if (xb_ld(&(bar)[XB_TMO])) break; if (_sp > XB_SPIN_CAP) { atomicAdd(&(bar)[XB_TMO], 1u); break; } } } } while (0)
struct XcdBarrier { unsigned* bar; unsigned x; volatile LAS unsigned* st; };
__device__ __forceinline__ XcdBarrier xcd_barrier_post(unsigned* bar, volatile LAS unsigned* st) {
    XcdBarrier b; b.bar = bar; b.x = xb_xcc_id(); b.st = st;
    if (threadIdx.x == 0) (void)xb_add(&bar[XB_XCNT(b.x)], 1u);
    return b;
}
__device__ __forceinline__ void xcd_barrier_complete(unsigned* bar, unsigned x, unsigned& nloc, unsigned& nx) {
    const unsigned G = gridDim.x * gridDim.y * gridDim.z;
    unsigned sum, cnt, mine, sp = 0u;
    for (;;) {
        sum = 0u; cnt = 0u; mine = 0u;
#pragma unroll
        for (unsigned j = 0; j < 16; ++j) { const unsigned c = xb_ld(&bar[XB_XCNT(j)]); sum += c; cnt += (c > 0u) ? 1u : 0u; mine = (j == x) ? c : mine; }
        if (sum == G) break;
        __builtin_amdgcn_s_sleep(1);
        if ((++sp & 255u) == 0u) { if (xb_ld(&bar[XB_TMO])) break; if (sp > XB_SPIN_CAP) { atomicAdd(&bar[XB_TMO], 1u); break; } }
    }
    nloc = mine > 0u ? mine : 1u; nx = cnt > 0u ? cnt : 1u;
}
__device__ __forceinline__ void xcd_barrier(const XcdBarrier& b) {
    asm volatile("s_waitcnt vmcnt(0)" ::: "memory");
    __syncthreads();
    if (threadIdx.x == 0) {
        unsigned* bar = b.bar;
        __builtin_amdgcn_s_waitcnt(0);
        unsigned nloc = b.st[0], nx = b.st[1];
        if (nloc == 0u) { xcd_barrier_complete(bar, b.x, nloc, nx); b.st[0] = nloc; b.st[1] = nx; }
        const unsigned old = xb_add(&bar[XB_XSUB(b.x)], 1u);
        const unsigned gen = old / nloc;
        if (old + 1u == (gen + 1u) * nloc) {
            __builtin_amdgcn_fence(__ATOMIC_RELEASE, "agent");
            asm volatile("s_waitcnt vmcnt(0)" ::: "memory");
            const unsigned og = xb_add(&bar[XB_TOP], 1u);
            const unsigned tg = og / nx;
            if (og + 1u == (tg + 1u) * nx) xb_add(&bar[XB_TOPGEN], 1u);
            else XB_SPIN(xb_ld(&bar[XB_TOPGEN]) == tg, bar);
            __builtin_amdgcn_fence(__ATOMIC_ACQUIRE, "agent");
            xb_add(&bar[XB_XGEN(b.x)], 1u);
            asm volatile("s_waitcnt vmcnt(0)" ::: "memory");
        } else {
            XB_SPIN(xb_ld(&bar[XB_XGEN(b.x)]) == gen, bar);
            __builtin_amdgcn_fence(__ATOMIC_ACQUIRE, "agent");
            asm volatile("s_waitcnt vmcnt(0)" ::: "memory");
        }
    }
    __syncthreads();
}

constexpr int BM = 256, BK = 64, HALF = 128, HTB = HALF * BK * 2, STAGE_BYTES = 8 * HTB, NXCD = 8, WGM = 8;
__host__ __device__ __forceinline__ int lds_byte(int r, int c) { const int st = (r >> 4) * 2 + (c >> 5), rr = r & 15, cc = c & 31, ob = rr * 64 + cc * 2; return st * 1024 + (ob ^ (((ob >> 9) & 1) << 5)); }
__host__ __device__ __forceinline__ void stage_rc(int b, int& R, int& C) { const int st = b / 1024, sb = b % 1024, swz = sb ^ (((sb >> 9) & 1) << 5); R = (st >> 1) * 16 + swz / 64; C = (st & 1) * 32 + (swz % 64) / 2; }
__host__ __device__ __forceinline__ int perm32(int rho) { const int n = rho >> 4, i = rho & 15; return 8 * (i >> 2) + 4 * n + (i & 3); }

struct Unit { int pm, pn, kz; };
struct Gemm { const bf16_t* A; const bf16_t* Bt; int M, N, K, lda, nkz; size_t a_kz, b_kz; };

struct StaticOrder {
    int nM, nN, nwg, G, c, nkz;
    __device__ void init(int M_, int N_, int G_, int c_, int nkz_ = 1) { nM = M_ / BM; nN = N_ / BM; nwg = nM * nN; G = G_; c = c_; nkz = nkz_; }
    __device__ bool next(int i, Unit& u) const {
        const int it = i / nkz; u.kz = i - it * nkz;
        const long L = (long)it * G + c; if (L >= nwg) return false;
        int wgid = (int)L; { const int q = nwg / NXCD, r = nwg % NXCD, xcd = wgid % NXCD, off = wgid / NXCD; wgid = (xcd < r ? xcd * (q + 1) : r * (q + 1) + (xcd - r) * q) + off; }
        const int nig = WGM * nN, gid = wgid / nig, fm = gid * WGM, gsz = (nM - fm) < WGM ? (nM - fm) : WGM;
        u.pm = fm + ((wgid % nig) % gsz); u.pn = (wgid % nig) / gsz; return true;
    }
};

template <class Epi>
__device__ __forceinline__ void gemm_phase(LAS unsigned char* lds, const Gemm g, const StaticOrder& S, const Epi& E) {
    int tid_ = threadIdx.x; asm volatile("" : "+v"(tid_));
    const int tid = tid_, wid = __builtin_amdgcn_readfirstlane(tid >> 6), lane = tid & 63, wr = wid >> 2, wc = wid & 3, fr = lane & 15, fq = lane >> 4;
    const int K = g.K, nt = K / BK;
    unsigned voffA[2], voffB[2];
#pragma unroll
    for (int i = 0; i < 2; ++i) { int R, C; stage_rc(tid * 16 + i * 8192, R, C); const int Rb = Epi::PERM ? ((R & ~31) + perm32(R & 31)) : R;
        voffA[i] = (unsigned)(R * g.lda + C) * 2u; voffB[i] = (unsigned)(Rb * K + C) * 2u; }
    const size_t kstep = (size_t)(BK * 2);
    const size_t hstepA = (size_t)HALF * g.lda * 2, hstepB = (size_t)HALF * K * 2;
    const size_t tstepA = 2 * hstepA, tstepB = 2 * hstepB;
    const unsigned ldsw = (unsigned)wid * 1024u;
    const int aoff = lds_byte(wr * 64 + fr, fq * 8), boff = lds_byte(wc * 32 + fr, fq * 8);
#define PG8_SA(b, h) (((b) * 2 + (h)) * HTB)
#define PG8_SB(b, h) ((4 + (b) * 2 + (h)) * HTB)
#define PG8_STAGE(bufoff, gbase, voff) do { _Pragma("unroll") for (int _i = 0; _i < 2; ++_i) \
        __builtin_amdgcn_global_load_lds((const unsigned*)((const char*)(gbase) + (voff)[_i]), (LAS unsigned*)(lds + (bufoff) + ldsw + _i * 8192), 16, 0, 0); } while (0)
#define PG8_LDA(dst, b, h) do { _Pragma("unroll") for (int m = 0; m < 4; ++m) _Pragma("unroll") for (int k = 0; k < 2; ++k) dst[m][k] = *(const LAS bf16x8*)(lds + PG8_SA(b, h) + aoff + m * 2048 + k * 1024); } while (0)
#define PG8_LDB(dst, b, h) do { _Pragma("unroll") for (int n = 0; n < 2; ++n) _Pragma("unroll") for (int k = 0; k < 2; ++k) dst[n][k] = *(const LAS bf16x8*)(lds + PG8_SB(b, h) + boff + n * 2048 + k * 1024); } while (0)
#define PG8_MMA(ai, bj, At, Bt) do { __builtin_amdgcn_s_setprio(1); _Pragma("unroll") for (int m = 0; m < 4; ++m) _Pragma("unroll") for (int n = 0; n < 2; ++n) _Pragma("unroll") for (int k = 0; k < 2; ++k) \
        acc[ai][bj][m][n] = __builtin_amdgcn_mfma_f32_16x16x32_bf16(Bt[n][k], At[m][k], acc[ai][bj][m][n], 0, 0, 0); __builtin_amdgcn_s_setprio(0); } while (0)
#if SAFE_GEMM == 1 || SAFE_GEMM == 3
#define PG8_WAIT_V(n) asm volatile("s_waitcnt vmcnt(0)" ::: "memory")
#else
#define PG8_WAIT_V(n) asm volatile("s_waitcnt vmcnt(" #n ")" ::: "memory")
#endif
#define PG8_WAIT_L(n) asm volatile("s_waitcnt lgkmcnt(" #n ")" ::: "memory")
#if SAFE_GEMM == 1
#define PG8_BAR do { asm volatile("s_waitcnt vmcnt(0) lgkmcnt(0)" ::: "memory"); __builtin_amdgcn_s_barrier(); asm volatile("" ::: "memory"); } while (0)
#elif SAFE_GEMM == 2
#define PG8_BAR asm volatile("s_barrier" ::: "memory")
#elif SAFE_GEMM == 4
#define PG8_BAR do { asm volatile("s_waitcnt lgkmcnt(0)" ::: "memory"); __builtin_amdgcn_s_barrier(); } while (0)
#else
#define PG8_BAR __builtin_amdgcn_s_barrier()
#endif
#define PG8_SCHED __builtin_amdgcn_sched_barrier(0)
    Unit cur, nxt; int ui = 0;
    if (!S.next(0, cur)) return;
    f32x4 acc[2][2][4][2];
#pragma unroll
    for (int a = 0; a < 2; ++a)
#pragma unroll
        for (int b = 0; b < 2; ++b)
#pragma unroll
            for (int m = 0; m < 4; ++m)
#pragma unroll
                for (int n = 0; n < 2; ++n) acc[a][b][m][n] = (f32x4){0.f, 0.f, 0.f, 0.f};
    bf16x8 At[4][2], B0[2][2], B1[2][2];
    const char* cA = (const char*)(g.A + (size_t)cur.kz * g.a_kz) + (size_t)cur.pm * tstepA; const char* cB = (const char*)(g.Bt + (size_t)cur.kz * g.b_kz) + (size_t)cur.pn * tstepB;
    PG8_STAGE(PG8_SB(0, 0), cB, voffB); PG8_STAGE(PG8_SA(0, 0), cA, voffA); PG8_STAGE(PG8_SB(0, 1), cB + hstepB, voffB); PG8_STAGE(PG8_SA(0, 1), cA + hstepA, voffA);
    if (wr == 1) PG8_BAR;
    PG8_WAIT_V(4); PG8_BAR;
    PG8_STAGE(PG8_SB(1, 0), cB + kstep, voffB); PG8_STAGE(PG8_SA(1, 0), cA + kstep, voffA); PG8_STAGE(PG8_SB(1, 1), cB + hstepB + kstep, voffB);
    PG8_WAIT_V(6); PG8_BAR;
    for (;;) {
        const bool has_next = S.next(ui + 1, nxt);
        const char* nA = has_next ? (const char*)(g.A + (size_t)nxt.kz * g.a_kz) + (size_t)nxt.pm * tstepA : cA;
        const char* nB = has_next ? (const char*)(g.Bt + (size_t)nxt.kz * g.b_kz) + (size_t)nxt.pn * tstepB : cB;
        for (int t = 0; t < nt; t += 2) {
            const bool last = (t == nt - 2);
            const char* a1 = cA + (size_t)(t + 1) * kstep;
            const char* a2 = last ? nA : cA + (size_t)(t + 2) * kstep; const char* b2 = last ? nB : cB + (size_t)(t + 2) * kstep;
            const char* a3 = a2 + kstep; const char* b3 = b2 + kstep;
            PG8_LDB(B0, 0, 0); PG8_SCHED; PG8_LDA(At, 0, 0); PG8_STAGE(PG8_SA(1, 1), a1 + hstepA, voffA);
            PG8_WAIT_L(8); PG8_BAR; PG8_WAIT_L(0); PG8_MMA(0, 0, At, B0); PG8_BAR; PG8_SCHED;
            PG8_LDB(B1, 0, 1); PG8_STAGE(PG8_SB(0, 0), b2, voffB);
            PG8_BAR; PG8_WAIT_L(0); PG8_MMA(0, 1, At, B1); PG8_BAR;
            PG8_LDA(At, 0, 1); PG8_STAGE(PG8_SA(0, 0), a2, voffA);
            PG8_BAR; PG8_WAIT_L(0); PG8_MMA(1, 0, At, B0); PG8_BAR; PG8_SCHED;
            PG8_STAGE(PG8_SB(0, 1), b2 + hstepB, voffB);
            PG8_WAIT_V(6); PG8_BAR; PG8_MMA(1, 1, At, B1); PG8_BAR;
            PG8_LDB(B0, 1, 0); PG8_SCHED; PG8_LDA(At, 1, 0); PG8_STAGE(PG8_SA(0, 1), a2 + hstepA, voffA);
            PG8_WAIT_L(8); PG8_BAR; PG8_WAIT_L(0); PG8_MMA(0, 0, At, B0); PG8_BAR; PG8_SCHED;
            PG8_LDB(B1, 1, 1); PG8_STAGE(PG8_SB(1, 0), b3, voffB);
            PG8_BAR; PG8_WAIT_L(0); PG8_MMA(0, 1, At, B1); PG8_BAR;
            PG8_LDA(At, 1, 1); PG8_STAGE(PG8_SA(1, 0), a3, voffA);
            PG8_BAR; PG8_WAIT_L(0); PG8_MMA(1, 0, At, B0); PG8_BAR; PG8_SCHED;
            PG8_STAGE(PG8_SB(1, 1), b3 + hstepB, voffB);
            PG8_WAIT_V(6); PG8_BAR; PG8_MMA(1, 1, At, B1); PG8_BAR;
        }
        E(acc, cur, wr, wc, fr, fq);
        if (!has_next) break;
        if (nxt.kz == 0) {
#pragma unroll
        for (int a = 0; a < 2; ++a)
#pragma unroll
            for (int b = 0; b < 2; ++b)
#pragma unroll
                for (int m = 0; m < 4; ++m)
#pragma unroll
                    for (int n = 0; n < 2; ++n) acc[a][b][m][n] = (f32x4){0.f, 0.f, 0.f, 0.f};
        }
        cur = nxt; cA = nA; cB = nB; ++ui;
    }
    PG8_WAIT_V(0);
    if (wr == 0) PG8_BAR;
    PG8_BAR;
#undef PG8_SA
#undef PG8_SB
#undef PG8_STAGE
#undef PG8_LDA
#undef PG8_LDB
#undef PG8_MMA
#undef PG8_WAIT_V
#undef PG8_WAIT_L
#undef PG8_BAR
#undef PG8_SCHED
}
}
namespace mk {
constexpr size_t O_YP = 0, O_YS = 8388608, O_NK = 25165824, O_NV = 33554432, O_S5R = 41943040, O_S5I = 42205184, O_SSD = 42467328,
                 O_MLC = 50855936, O_MLN = 59244544, O_MLM = 59310080;

__device__ __forceinline__ u32x4 pack8(const f32x4 a, const f32x4 b) { u32x4 w; w.x = pk2(a[0], a[1]); w.y = pk2(a[2], a[3]); w.z = pk2(b[0], b[1]); w.w = pk2(b[2], b[3]); return w; }

struct EpiIn {
    static constexpr bool PERM = true;
    bf16_t* proj; float* small; float* out; const float* qg; const float* kg; int layer;
    __device__ __forceinline__ void operator()(f32x4 (&acc)[2][2][4][2], const Unit& u, int wr, int wc, int fr, int fq) const {
        const int T = u.pn, rowb = u.pm * BM + wr * 64 + fr;
        if (T == 54) {
            if (wc == 0) {
#pragma unroll
                for (int ai = 0; ai < 2; ++ai)
#pragma unroll
                    for (int m = 0; m < 4; ++m) { float* sp = small + (size_t)(rowb + ai * HALF + m * 16) * 32 + 8 * fq; *(f32x4*)sp = acc[ai][0][m][0]; *(f32x4*)(sp + 4) = acc[ai][0][m][1]; }
            }
            return;
        }
        const int colb = T * 256 + 64 * wc + 8 * fq;
        if (T < 4) {
            const float* g = T < 2 ? qg : kg;
            f32x4 gv[2][2];
#pragma unroll
            for (int bj = 0; bj < 2; ++bj)
#pragma unroll
                for (int n = 0; n < 2; ++n) gv[bj][n] = *(const f32x4*)(g + 32 * bj + 8 * fq + 4 * n);
#pragma unroll
            for (int ai = 0; ai < 2; ++ai)
#pragma unroll
                for (int m = 0; m < 4; ++m) {
                    float ss = 0.f;
#pragma unroll
                    for (int bj = 0; bj < 2; ++bj)
#pragma unroll
                        for (int n = 0; n < 2; ++n) { const f32x4 x = acc[ai][bj][m][n]; ss += (x[0] * x[0] + x[1] * x[1]) + (x[2] * x[2] + x[3] * x[3]); }
                    ss += __shfl_xor(ss, 16); ss += __shfl_xor(ss, 32);
                    const float r = rsqrtf(ss * (1.f / 64.f) + 1e-6f);
                    const int row = rowb + ai * HALF + m * 16;
#pragma unroll
                    for (int bj = 0; bj < 2; ++bj) { const f32x4 v0 = acc[ai][bj][m][0] * r * gv[bj][0], v1 = acc[ai][bj][m][1] * r * gv[bj][1];
                        *(u32x4*)(proj + (size_t)row * PJ + colb + 32 * bj) = pack8(v0, v1);
                        if (T >= 2 && row < MP) { float* o = out + O_NK + ((size_t)((row >> 8) * DEPTH + layer) * 256 + (row & 255)) * 512 + (colb - 512) + 32 * bj; *(f32x4*)o = v0; *(f32x4*)(o + 4) = v1; } }
                }
        } else if (T < 6) {
#pragma unroll
            for (int ai = 0; ai < 2; ++ai)
#pragma unroll
                for (int m = 0; m < 4; ++m) { const int row = rowb + ai * HALF + m * 16;
#pragma unroll
                    for (int bj = 0; bj < 2; ++bj) { const f32x4 v0 = acc[ai][bj][m][0], v1 = acc[ai][bj][m][1];
                        *(u32x4*)(proj + (size_t)row * PJ + colb + 32 * bj) = pack8(v0, v1);
                        if (row < MP) { float* o = out + O_NV + ((size_t)((row >> 8) * DEPTH + layer) * 256 + (row & 255)) * 512 + (colb - 1024) + 32 * bj; *(f32x4*)o = v0; *(f32x4*)(o + 4) = v1; } } }
        } else if (T < 22) {
#pragma unroll
            for (int ai = 0; ai < 2; ++ai)
#pragma unroll
                for (int m = 0; m < 4; ++m) { const int row = rowb + ai * HALF + m * 16;
#pragma unroll
                    for (int bj = 0; bj < 2; ++bj) *(u32x4*)(proj + (size_t)row * PJ + colb + 32 * bj) = pack8(acc[ai][bj][m][0], acc[ai][bj][m][1]); }
        } else {
#pragma unroll
            for (int ai = 0; ai < 2; ++ai)
#pragma unroll
                for (int m = 0; m < 4; ++m) { const int row = rowb + ai * HALF + m * 16;
#pragma unroll
                    for (int bj = 0; bj < 2; ++bj) { f32x4 v0 = acc[ai][bj][m][0], v1 = acc[ai][bj][m][1];
#pragma unroll
                        for (int j = 0; j < 4; ++j) { v0[j] = fsigm(v0[j]); v1[j] = fsigm(v1[j]); }
                        *(u32x4*)(proj + (size_t)row * PJ + colb + 32 * bj) = pack8(v0, v1); } }
        }
    }
};
struct EpiRelu2 {
    static constexpr bool PERM = true;
    bf16_t* O; int ldo;
    __device__ __forceinline__ void operator()(f32x4 (&acc)[2][2][4][2], const Unit& u, int wr, int wc, int fr, int fq) const {
        const int rowb = u.pm * BM + wr * 64 + fr, colb = u.pn * 256 + 64 * wc + 8 * fq;
#pragma unroll
        for (int ai = 0; ai < 2; ++ai)
#pragma unroll
            for (int m = 0; m < 4; ++m) { const int row = rowb + ai * HALF + m * 16;
#pragma unroll
                for (int bj = 0; bj < 2; ++bj) { f32x4 v0 = acc[ai][bj][m][0], v1 = acc[ai][bj][m][1];
#pragma unroll
                    for (int j = 0; j < 4; ++j) { const float a = fmaxf(v0[j], 0.f), b = fmaxf(v1[j], 0.f); v0[j] = a * a; v1[j] = b * b; }
                    *(u32x4*)(O + (size_t)row * ldo + colb + 32 * bj) = pack8(v0, v1); } }
    }
};
struct EpiGlu {
    static constexpr bool PERM = true;
    const bf16_t* Z; const float* bias; bf16_t* br;
    __device__ __forceinline__ void operator()(f32x4 (&acc)[2][2][4][2], const Unit& u, int wr, int wc, int fr, int fq) const {
        const int rowb = u.pm * BM + wr * 64 + fr, colb = u.pn * 256 + 64 * wc + 8 * fq;
#pragma unroll
        for (int bj = 0; bj < 2; ++bj) { const int c = colb + 32 * bj; const f32x4 b0 = *(const f32x4*)(bias + c), b1 = *(const f32x4*)(bias + c + 4);
#pragma unroll
            for (int ai = 0; ai < 2; ++ai)
#pragma unroll
                for (int m = 0; m < 4; ++m) { const int row = rowb + ai * HALF + m * 16;
                    const u32x4 zz = *(const u32x4*)(Z + (size_t)row * 512 + c);
                    f32x4 v0 = acc[ai][bj][m][0] + b0, v1 = acc[ai][bj][m][1] + b1;
                    v0[0] = bflo(zz.x) * fsigm(v0[0]); v0[1] = bfhi(zz.x) * fsigm(v0[1]); v0[2] = bflo(zz.y) * fsigm(v0[2]); v0[3] = bfhi(zz.y) * fsigm(v0[3]);
                    v1[0] = bflo(zz.z) * fsigm(v1[0]); v1[1] = bfhi(zz.z) * fsigm(v1[1]); v1[2] = bflo(zz.w) * fsigm(v1[2]); v1[3] = bfhi(zz.w) * fsigm(v1[3]);
                    *(u32x4*)(br + (size_t)row * D + 512 + c) = pack8(v0, v1); } }
    }
};
struct EpiBranch {
    static constexpr bool PERM = true;
    const bf16_t* proj; bf16_t* merged;
    __device__ __forceinline__ void operator()(f32x4 (&acc)[2][2][4][2], const Unit& u, int wr, int wc, int fr, int fq) const {
        const int rowb = u.pm * BM + wr * 64 + fr, colb = u.pn * 256 + 64 * wc + 8 * fq, kz = u.kz;
#pragma unroll
        for (int ai = 0; ai < 2; ++ai)
#pragma unroll
            for (int m = 0; m < 4; ++m) { const int row = rowb + ai * HALF + m * 16;
#pragma unroll
                for (int bj = 0; bj < 2; ++bj) { const int c = colb + 32 * bj;
                    const u32x4 gg = *(const u32x4*)(proj + (size_t)row * PJ + P_GATE + kz * D + c);
                    float g[8] = {bflo(gg.x), bfhi(gg.x), bflo(gg.y), bfhi(gg.y), bflo(gg.z), bfhi(gg.z), bflo(gg.w), bfhi(gg.w)};
                    if (kz < 3) { const u32x4 hh = *(const u32x4*)(proj + (size_t)row * PJ + P_GATE + (kz + 1) * D + c);
                        const float h[8] = {bflo(hh.x), bfhi(hh.x), bflo(hh.y), bfhi(hh.y), bflo(hh.z), bfhi(hh.z), bflo(hh.w), bfhi(hh.w)};
#pragma unroll
                        for (int j = 0; j < 8; ++j) g[j] = g[j] * __builtin_amdgcn_rcpf(fmaxf(h[j], 1e-30f)); }
                    f32x4& v0 = acc[ai][bj][m][0]; f32x4& v1 = acc[ai][bj][m][1];
                    v0[0] *= g[0]; v0[1] *= g[1]; v0[2] *= g[2]; v0[3] *= g[3]; v1[0] *= g[4]; v1[1] *= g[5]; v1[2] *= g[6]; v1[3] *= g[7];
                    if (kz == 3) *(u32x4*)(merged + (size_t)row * D + c) = pack8(v0, v1); } }
    }
};
struct EpiResid {
    static constexpr bool PERM = false;
    const float* xp; const float* xs; const float* modl; int g_off; float* xout;
    __device__ __forceinline__ void operator()(f32x4 (&acc)[2][2][4][2], const Unit& u, int wr, int wc, int fr, int fq) const {
        const int row0 = u.pm * BM, rowb = row0 + wr * 64 + fr, colb = u.pn * 256 + wc * 32 + 4 * fq;
        const float* xin = row0 < MP ? xp : xs - (size_t)MP * D;
        const float* gate = modl + (size_t)row_cvec(row0) * 6 * D + g_off;
        f32x4 gv[2][2];
#pragma unroll
        for (int bj = 0; bj < 2; ++bj)
#pragma unroll
            for (int n = 0; n < 2; ++n) gv[bj][n] = *(const f32x4*)(gate + colb + bj * HALF + n * 16);
#pragma unroll
        for (int ai = 0; ai < 2; ++ai)
#pragma unroll
            for (int m = 0; m < 4; ++m) { const size_t ro = (size_t)(rowb + ai * HALF + m * 16) * D + colb;
#pragma unroll
                for (int bj = 0; bj < 2; ++bj)
#pragma unroll
                    for (int n = 0; n < 2; ++n) { const size_t o = ro + bj * HALF + n * 16; *(f32x4*)(xout + o) = *(const f32x4*)(xin + o) + gv[bj][n] * acc[ai][bj][m][n]; } }
    }
};
}
namespace mk {
constexpr size_t AL(size_t x) { return (x + 255) & ~(size_t)255; }
constexpr size_t WS_CTL = 0, CTL_BYTES = 65536;
constexpr size_t WS_MOD = WS_CTL + CTL_BYTES;
constexpr size_t WS_W = AL(WS_MOD + (size_t)DEPTH * 5 * 6 * D * 4);
constexpr size_t W_IN = 0, W_GLU = W_IN + (size_t)NIN * D, W_BR = W_GLU + 512 * 512, W_OUT = W_BR + (size_t)4 * D * 512, W_1 = W_OUT + (size_t)D * D, W_2 = W_1 + (size_t)DFF * D,
                 W_LAYER = W_2 + (size_t)D * DFF;
constexpr size_t WS_H = AL(WS_W + W_LAYER * 2 * DEPTH);
constexpr size_t WS_PROJ = AL(WS_H + (size_t)M * D * 2);
constexpr size_t WS_SMALL = AL(WS_PROJ + (size_t)M * PJ * 2);
constexpr size_t WS_BR = AL(WS_SMALL + (size_t)M * 32 * 4);
constexpr size_t WS_MERGED = AL(WS_BR + (size_t)M * D * 2);
constexpr size_t WS_MACC = AL(WS_MERGED + (size_t)M * D * 2);
constexpr size_t WS_ZB = AL(WS_MACC + (size_t)M * D * 4);
constexpr size_t WS_SCR = AL(WS_ZB + (size_t)M * 512 * 2);
constexpr int LDS_BYTES = 140 * 1024, LDS_CTL = LDS_BYTES - 256;

struct Args { const float* in[43]; float* out; unsigned char* ws; int ph_lo, ph_hi; };

__device__ __forceinline__ float wave_sum(float v) {
#pragma unroll
    for (int o = 1; o < 64; o <<= 1) v += __shfl_xor(v, o);
    return v;
}
#define LDS_WAIT() asm volatile("s_waitcnt lgkmcnt(0)" ::: "memory")

__device__ __forceinline__ void xpose_item(const float* W, int ldw, int k0, int sc, bf16_t* dst, int K, LAS float* scr, int lane, int mode) {
    const int j = lane & 31;
    const int col = mode == 1 ? (j < 16 ? 3584 + j : 5648 + (j - 16)) : sc + j;
#pragma unroll 8
    for (int i = 0; i < 32; ++i) { const int kk = 2 * i + (lane >> 5); scr[kk * 33 + j] = mode == 2 ? 0.f : W[(size_t)(k0 + kk) * ldw + col]; }
    LDS_WAIT(); asm volatile("" ::: "memory");
    const int c = lane & 7;
#pragma unroll
    for (int jj = 0; jj < 4; ++jj) { const int n = (lane >> 3) + 8 * jj; const LAS float* s = scr + (8 * c) * 33 + n;
        u32x4 o; o.x = pk2(s[0 * 33], s[1 * 33]); o.y = pk2(s[2 * 33], s[3 * 33]); o.z = pk2(s[4 * 33], s[5 * 33]); o.w = pk2(s[6 * 33], s[7 * 33]);
        *(u32x4*)(dst + (size_t)n * K + k0 + 8 * c) = o; }
    LDS_WAIT(); asm volatile("" ::: "memory");
}
__device__ __forceinline__ int hm_col(int grp) { const int T = grp >> 3, q8 = grp & 7; return 256 * T + 32 * (2 * (q8 & 3) + (q8 >> 2)); }

__device__ __forceinline__ void prologue_convert(const Args& a, LAS unsigned char* lds, int gw, int ngw, int wave, int lane) {
    LAS float* scr = (LAS float*)(lds + wave * 8704);
    bf16_t* WB = (bf16_t*)(a.ws + WS_W);
    constexpr int I_IN = 440 * 32, I_GLU = 16 * 8, I_BR = 4 * 64 * 8, I_OUT = 64 * 32, I_1 = 256 * 32, I_2 = 64 * 128, I_L = I_IN + I_GLU + I_BR + I_OUT + I_1 + I_2;
    for (int it = gw; it < I_L * DEPTH; it += ngw) {
        const int l = it / I_L; int r = it - l * I_L; bf16_t* wl = WB + (size_t)l * W_LAYER;
        if (r < I_IN) { const int kb = r / 440, grp = r % 440, T = grp >> 3; int sc = hm_col(grp), mode = 0;
            if (T == 54) mode = (grp & 7) == 0 ? 1 : 2; else if (T >= 22) sc += 32; else if (T >= 14) sc += 16;
            xpose_item(a.in[16] + (size_t)l * D * 13856, 13856, 64 * kb, sc, wl + W_IN + (size_t)(32 * grp) * D, D, scr, lane, mode); continue; } r -= I_IN;
        if (r < I_GLU) { const int kb = r / 16, grp = r % 16; xpose_item(a.in[28] + (size_t)l * 512 * 512, 512, 64 * kb, hm_col(grp), wl + W_GLU + (size_t)(32 * grp) * 512, 512, scr, lane, 0); continue; } r -= I_GLU;
        if (r < I_BR) { const int k = r / 512, r2 = r % 512, kb = r2 / 64, grp = r2 % 64;
            xpose_item(a.in[39] + ((size_t)l * 4 + k) * 512 * D, D, 64 * kb, hm_col(grp), wl + W_BR + (size_t)k * D * 512 + (size_t)(32 * grp) * 512, 512, scr, lane, 0); continue; } r -= I_BR;
        if (r < I_OUT) { const int kb = r / 64, grp = r % 64; xpose_item(a.in[40] + (size_t)l * D * D, D, 64 * kb, 32 * grp, wl + W_OUT + (size_t)(32 * grp) * D, D, scr, lane, 0); continue; } r -= I_OUT;
        if (r < I_1) { const int kb = r / 256, grp = r % 256; xpose_item(a.in[41] + (size_t)l * D * DFF, DFF, 64 * kb, hm_col(grp), wl + W_1 + (size_t)(32 * grp) * D, D, scr, lane, 0); continue; } r -= I_1;
        { const int kb = r / 64, grp = r % 64; xpose_item(a.in[42] + (size_t)l * DFF * D, D, 64 * kb, 32 * grp, wl + W_2 + (size_t)(32 * grp) * DFF, DFF, scr, lane, 0); }
    }
}
__device__ __forceinline__ void prologue_ada(const Args& a, LAS unsigned char* lds, int tid) {
    LAS float* sl = (LAS float*)lds;
    LAS float* red = (LAS float*)(lds + 40960);
    float* mod = (float*)(a.ws + WS_MOD);
    for (int i = tid; i < 5 * D; i += NT) { const int j = i / D, k = i % D; const float x = j == 0 ? a.in[11][k] : a.in[10][(j - 1) * D + k]; sl[i] = x / (1.f + __expf(-x)); }
    __syncthreads();
    const int ks = tid >> 6, c = tid & 63;
    for (int unit = blockIdx.x; unit < DEPTH * 6 * D / 64; unit += gridDim.x) {
        const int l = unit / (6 * D / 64), n0 = (unit % (6 * D / 64)) * 64;
        const float* w = a.in[12] + (size_t)l * D * 6 * D + n0 + c;
        float acc[5] = {0.f, 0.f, 0.f, 0.f, 0.f};
#pragma unroll 4
        for (int k = ks * 256; k < ks * 256 + 256; ++k) { const float wv = w[(size_t)k * 6 * D];
#pragma unroll
            for (int j = 0; j < 5; ++j) acc[j] += sl[j * D + k] * wv; }
#pragma unroll
        for (int j = 0; j < 5; ++j) red[(ks * 5 + j) * 64 + c] = acc[j];
        __syncthreads();
        if (tid < 320) { const int j = tid >> 6; float s = 0.f;
#pragma unroll
            for (int q = 0; q < 8; ++q) s += red[(q * 5 + j) * 64 + c];
            mod[((size_t)l * 5 + j) * 6 * D + n0 + c] = s + a.in[13][l * 6 * D + n0 + c]; }
        __syncthreads();
    }
}
__device__ __forceinline__ void norm_phase(const float* xp, const float* xs, const float* g, const float* modl, int sh_off, int sc_off, bf16_t* H, int gw, int ngw, int lane_) {
    int lane = lane_; asm volatile("" : "+v"(lane));
    for (int row = gw; row < M; row += ngw) {
        const float* x = row < MP ? xp + (size_t)row * D : xs + (size_t)(row - MP) * D;
        f32x4 v[8]; float ss = 0.f;
#pragma unroll
        for (int j = 0; j < 8; ++j) { v[j] = *(const f32x4*)(x + 4 * (lane + 64 * j)); ss += (v[j][0] * v[j][0] + v[j][1] * v[j][1]) + (v[j][2] * v[j][2] + v[j][3] * v[j][3]); }
        const float r = rsqrtf(wave_sum(ss) * (1.f / D) + 1e-6f);
        const float* md = modl + (size_t)row_cvec(row) * 6 * D;
#pragma unroll
        for (int j = 0; j < 8; ++j) { const int i = 4 * (lane + 64 * j);
            const f32x4 gg = *(const f32x4*)(g + i), sc = *(const f32x4*)(md + sc_off + i), sh = *(const f32x4*)(md + sh_off + i);
            const f32x4 o = v[j] * r * gg * (sc + 1.f) + sh;
            u32x2 w; w.x = pk2(o[0], o[1]); w.y = pk2(o[2], o[3]); *(u32x2*)(H + (size_t)row * D + i) = w; }
    }
}

}
namespace mk {
constexpr size_t WS_NAT = AL(WS_SCR);
constexpr int NATP = 2048, N_XBC = 0, N_Q = 1024, N_K = 1536;
constexpr size_t WS_TR = AL(WS_NAT + (size_t)M * NATP * 2);
constexpr int T_X = 0, T_B = 512, T_K = 768, T_MV = 1280, T_V = 1792, TRR = 2304;
constexpr int NCH = 96;
constexpr size_t WS_MLC = AL(WS_TR + (size_t)TRR * M * 2);
constexpr size_t WS_MLN = AL(WS_MLC + (size_t)NCH * 4 * 2 * 16384 * 4);
constexpr size_t WS_MLS = AL(WS_MLN + (size_t)NCH * 4 * 2 * 128 * 4);
constexpr size_t WS_MLCS = AL(WS_MLS + (size_t)NCH * 4 * 2 * 4 * 4);
constexpr size_t WS_MLNS = AL(WS_MLCS + (size_t)NCH * 4 * 2 * 16384 * 2);
constexpr size_t WS_MLMS = AL(WS_MLNS + (size_t)NCH * 4 * 2 * 128 * 4);
constexpr size_t WS_OPT_END = AL(WS_MLMS + (size_t)NCH * 4 * 2 * 4);

__device__ __forceinline__ f32x4 mfma16(bf16x8 a, bf16x8 b, f32x4 c) { return __builtin_amdgcn_mfma_f32_16x16x32_bf16(a, b, c, 0, 0, 0); }
__device__ __forceinline__ void chunk_info(int ch, int& row0, int& seq0, int& L, int& lat, int& b, int& ci, int& nc) {
    if (ch < 32) { b = ch >> 1; ci = ch & 1; nc = 2; seq0 = b * 256; L = 256; lat = 0; } else { const int c2 = ch - 32; b = c2 >> 4; ci = c2 & 15; nc = 16; seq0 = MP + b * 2048; L = 2048; lat = 1; }
    row0 = seq0 + ci * 128;
}
__device__ __forceinline__ float fast_exp(float x) { return __expf(x); }

__device__ __forceinline__ void prep_phase(const Args& a, int layer, LAS unsigned char* lds, int gw_, int ngw, int wave, int lane_, bf16_t* UPk) {
    int lane = lane_, gw = gw_; asm volatile("" : "+v"(lane));
    const bf16_t* PROJ = (const bf16_t*)(a.ws + WS_PROJ); bf16_t* NAT = (bf16_t*)(a.ws + WS_NAT); bf16_t* TR = (bf16_t*)(a.ws + WS_TR);
    LAS bf16_t* tile = (LAS bf16_t*)(lds + wave * 16896); LAS bf16_t* otile = tile + 68 * 64;
    const int c = lane & 7, r8 = lane >> 3;
    const float* cw = a.in[30] + layer * 5 * 1024; const float* cb = a.in[31] + layer * 1024;
    for (int u = gw; u < 56 * 192; u += ngw) {
        const int cg = u / 192, tt = u % 192, m0 = tt * 64;
        const int lat = m0 >= MP; const int seq0 = lat ? MP + ((m0 - MP) / 2048) * 2048 : (m0 / 256) * 256, L = lat ? 2048 : 256, t0 = m0 - seq0;
        int kind, src, natcol = -1, trrow = -1;
        if (cg < 16) { kind = 0; src = P_XBC + 64 * cg; natcol = N_XBC + 64 * cg; if (cg < 12) trrow = T_X + 64 * cg; }
        else if (cg < 24) { kind = 1; src = P_MQ + 64 * (cg - 16); natcol = N_Q + 64 * (cg - 16); }
        else if (cg < 32) { kind = 2; src = P_MK + 64 * (cg - 24); natcol = N_K + 64 * (cg - 24); trrow = T_K + 64 * (cg - 24); }
        else if (cg < 40) { kind = 3; src = P_MV + 64 * (cg - 32); trrow = T_MV + 64 * (cg - 32); }
        else if (cg < 48) { kind = 3; src = P_V + 64 * (cg - 40); trrow = T_V + 64 * (cg - 40); }
        else { kind = 4; src = P_S5U + 64 * (cg - 48); }
        const int roff = kind == 0 ? -2 : 0, nrows = kind == 0 ? 68 : 64;
#pragma unroll
        for (int i = 0; i < 9; ++i) { const int r = r8 + 8 * i; if (r < nrows) { const int t = t0 + r + roff; u32x4 v = {0u, 0u, 0u, 0u};
                if (t >= 0 && t < L) v = *(const u32x4*)(PROJ + (size_t)(seq0 + t) * PJ + src + 8 * c);
                *(LAS u32x4*)(tile + r * 64 + 8 * c) = v; } }
        LDS_WAIT(); asm volatile("" ::: "memory");
#define PREP_EMIT(i_, r_) do { if (natcol >= 0) *(u32x4*)(NAT + (size_t)(m0 + r8 + 8 * (i_)) * NATP + natcol + 8 * c) = (r_); if (trrow >= 0) *(LAS u32x4*)(otile + (r8 + 8 * (i_)) * 64 + 8 * c) = (r_); } while (0)
        if (kind == 0) {
            float w[5][8], bz[8];
#pragma unroll
            for (int e = 0; e < 8; ++e) { bz[e] = cb[64 * cg + 8 * c + e];
#pragma unroll
                for (int j = 0; j < 5; ++j) w[j][e] = cw[j * 1024 + 64 * cg + 8 * c + e]; }
#pragma unroll 2
            for (int i = 0; i < 8; ++i) { const int tk = r8 + 8 * i; float acc[8];
#pragma unroll
                for (int e = 0; e < 8; ++e) acc[e] = bz[e];
#pragma unroll
                for (int j = 0; j < 5; ++j) { const u32x4 v = *(const LAS u32x4*)(tile + (tk + j) * 64 + 8 * c);
                    acc[0] += bflo(v.x) * w[j][0]; acc[1] += bfhi(v.x) * w[j][1]; acc[2] += bflo(v.y) * w[j][2]; acc[3] += bfhi(v.y) * w[j][3];
                    acc[4] += bflo(v.z) * w[j][4]; acc[5] += bfhi(v.z) * w[j][5]; acc[6] += bflo(v.w) * w[j][6]; acc[7] += bfhi(v.w) * w[j][7]; }
#pragma unroll
                for (int e = 0; e < 8; ++e) acc[e] = fsilu(acc[e]);
                u32x4 rv; rv.x = pk2(acc[0], acc[1]); rv.y = pk2(acc[2], acc[3]); rv.z = pk2(acc[4], acc[5]); rv.w = pk2(acc[6], acc[7]); PREP_EMIT(i, rv); }
        } else if (kind == 4) {
#pragma unroll
            for (int i = 0; i < 8; ++i) { const int tk = r8 + 8 * i, m = m0 + tk; const u32x4 v = *(const LAS u32x4*)(tile + tk * 64 + 8 * c);
                *(u32x4*)(UPk + ((size_t)(4 * (cg - 48) + (c >> 1)) * 384 + (m >> 5)) * 512 + (m & 31) * 16 + 8 * (c & 1)) = v; }
        } else if (kind == 3 || !lat) {
            const float sc = kind == 2 ? 0.08838834764831845f : 1.f;
#pragma unroll
            for (int i = 0; i < 8; ++i) { const u32x4 v = *(const LAS u32x4*)(tile + (r8 + 8 * i) * 64 + 8 * c);
                u32x4 rv = v;
                if (kind == 2) { rv.x = pk2(bflo(v.x) * sc, bfhi(v.x) * sc); rv.y = pk2(bflo(v.y) * sc, bfhi(v.y) * sc); rv.z = pk2(bflo(v.z) * sc, bfhi(v.z) * sc); rv.w = pk2(bflo(v.w) * sc, bfhi(v.w) * sc); }
                PREP_EMIT(i, rv); }
        } else {
            const float sc = kind == 2 ? 0.08838834764831845f : 1.f; const int odd = cg & 1;
            float inv[8];
#pragma unroll
            for (int e = 0; e < 8; ++e) inv[e] = exp2f(-(float)(8 * (c & 3) + e) * (13.287712379549449f / 32.f));
#pragma unroll
            for (int i = 0; i < 8; ++i) { const int tk = r8 + 8 * i, t = t0 + tk; const float pos = odd ? (float)(t & 63) : (float)(t >> 6);
                const u32x4 vo = *(const LAS u32x4*)(tile + tk * 64 + 8 * c), vp = *(const LAS u32x4*)(tile + tk * 64 + 8 * (c ^ 4));
                float o[8], p[8], rr[8];
                o[0] = bflo(vo.x); o[1] = bfhi(vo.x); o[2] = bflo(vo.y); o[3] = bfhi(vo.y); o[4] = bflo(vo.z); o[5] = bfhi(vo.z); o[6] = bflo(vo.w); o[7] = bfhi(vo.w);
                p[0] = bflo(vp.x); p[1] = bfhi(vp.x); p[2] = bflo(vp.y); p[3] = bfhi(vp.y); p[4] = bflo(vp.z); p[5] = bfhi(vp.z); p[6] = bflo(vp.w); p[7] = bfhi(vp.w);
#pragma unroll
                for (int e = 0; e < 8; ++e) { const float ang = pos * inv[e], cs = __cosf(ang), sn = __sinf(ang);
                    rr[e] = (c < 4 ? o[e] * cs - p[e] * sn : p[e] * sn + o[e] * cs) * sc; }
                u32x4 rv; rv.x = pk2(rr[0], rr[1]); rv.y = pk2(rr[2], rr[3]); rv.z = pk2(rr[4], rr[5]); rv.w = pk2(rr[6], rr[7]); PREP_EMIT(i, rv); }
        }
        if (trrow >= 0) {
            LDS_WAIT(); asm volatile("" ::: "memory");
            bf16_t* dst = TR + (size_t)(trrow + lane) * M + m0;
#pragma unroll
            for (int j = 0; j < 8; ++j) { unsigned wv[4];
#pragma unroll
                for (int q = 0; q < 4; ++q) { const unsigned lo = otile[(8 * j + 2 * q) * 64 + lane], hi = otile[(8 * j + 2 * q + 1) * 64 + lane]; wv[q] = lo | (hi << 16); }
                u32x4 o; o.x = wv[0]; o.y = wv[1]; o.z = wv[2]; o.w = wv[3]; *(u32x4*)(dst + 8 * j) = o; }
        }
        LDS_WAIT(); asm volatile("" ::: "memory");
    }
}

struct MlGate { float lf0, lf1, ig0, ig1, P0, P1, tot; };
__device__ __forceinline__ float wave_incl_scan(float v, int lane) {
#pragma unroll
    for (int o = 1; o < 64; o <<= 1) { const float t = __shfl_up(v, o); if (lane >= o) v += t; }
    return v;
}
__device__ __forceinline__ float wave_max(float v) {
#pragma unroll
    for (int o = 1; o < 64; o <<= 1) v = fmaxf(v, __shfl_xor(v, o));
    return v;
}
__device__ __forceinline__ MlGate ml_gates(const Args& a, int layer, int row0, int hh, int dir, int lane) {
    const float* SMALL = (const float*)(a.ws + WS_SMALL);
    const float ib = a.in[36][layer * 8 + dir * 4 + hh], fb = a.in[37][layer * 8 + dir * 4 + hh];
    MlGate g;
    const float f0 = SMALL[(size_t)(row0 + lane) * 32 + S_MF + dir * 4 + hh] + fb, f1 = SMALL[(size_t)(row0 + lane + 64) * 32 + S_MF + dir * 4 + hh] + fb;
    g.ig0 = SMALL[(size_t)(row0 + lane) * 32 + S_MI + dir * 4 + hh] + ib; g.ig1 = SMALL[(size_t)(row0 + lane + 64) * 32 + S_MI + dir * 4 + hh] + ib;
    g.lf0 = fminf(f0, 0.f) - log1pf(__expf(-fabsf(f0))); g.lf1 = fminf(f1, 0.f) - log1pf(__expf(-fabsf(f1)));
    const float s0 = wave_incl_scan(g.lf0, lane); const float tot0 = __shfl(s0, 63);
    const float s1 = wave_incl_scan(g.lf1, lane) + tot0;
    g.P0 = s0; g.P1 = s1; g.tot = __shfl(s1, 63);
    return g;
}

__device__ __forceinline__ void ml_states_phase(const Args& a, int layer, int tid_, int G) {
    int tid = tid_; asm volatile("" : "+v"(tid));
    const int lane = tid & 63, wave = __builtin_amdgcn_readfirstlane(tid >> 6), fr = lane & 15, fq = lane >> 4;
    const bf16_t* TR = (const bf16_t*)(a.ws + WS_TR);
    float* MLC = (float*)(a.ws + WS_MLC); float* MLN = (float*)(a.ws + WS_MLN); float* MLS = (float*)(a.ws + WS_MLS);
    for (int u = blockIdx.x; u < NCH * 4; u += G) {
        const int ch = u >> 2, hh = u & 3; int row0, seq0, L, lat, b, ci, nc; chunk_info(ch, row0, seq0, L, lat, b, ci, nc);
#pragma unroll
        for (int dir = 0; dir < 2; ++dir) {
            const MlGate g = ml_gates(a, layer, row0, hh, dir, lane);
            const float w0 = (dir == 0 ? g.tot - g.P0 : g.P0 - g.lf0) + g.ig0, w1 = (dir == 0 ? g.tot - g.P1 : g.P1 - g.lf1) + g.ig1;
            const float mloc = wave_max(fmaxf(w0, w1));
            const float e0 = __expf(w0 - mloc), e1 = __expf(w1 - mloc);
            f32x4 acc[8];
#pragma unroll
            for (int j = 0; j < 8; ++j) acc[j] = (f32x4){0.f, 0.f, 0.f, 0.f};
            float nacc[8];
#pragma unroll
            for (int j = 0; j < 8; ++j) nacc[j] = 0.f;
            const bf16_t* vrow = TR + (size_t)(T_MV + hh * 128 + wave * 16 + fr) * M + row0 + 8 * fq;
#pragma unroll
            for (int ks = 0; ks < 4; ++ks) {
                const bf16x8 af = *(const bf16x8*)(vrow + 32 * ks);
                float ev[8];
#pragma unroll
                for (int j = 0; j < 8; ++j) { const int tok = 32 * ks + 8 * fq + j; const float x0 = __shfl(e0, tok & 63), x1 = __shfl(e1, tok & 63); ev[j] = tok < 64 ? x0 : x1; }
#pragma unroll
                for (int jt = 0; jt < 8; ++jt) {
                    const u32x4 kv = *(const u32x4*)(TR + (size_t)(T_K + hh * 128 + jt * 16 + fr) * M + row0 + 32 * ks + 8 * fq);
                    const float k0 = bflo(kv.x) * ev[0], k1 = bfhi(kv.x) * ev[1], k2 = bflo(kv.y) * ev[2], k3 = bfhi(kv.y) * ev[3], k4 = bflo(kv.z) * ev[4], k5 = bfhi(kv.z) * ev[5], k6 = bflo(kv.w) * ev[6], k7 = bfhi(kv.w) * ev[7];
                    if (wave == 0) nacc[jt] += ((k0 + k1) + (k2 + k3)) + ((k4 + k5) + (k6 + k7));
                    u32x4 kb; kb.x = pk2(k0, k1); kb.y = pk2(k2, k3); kb.z = pk2(k4, k5); kb.w = pk2(k6, k7);
                    acc[jt] = mfma16(af, __builtin_bit_cast(bf16x8, kb), acc[jt]);
                }
            }
            float* cdst = MLC + ((size_t)(ch * 4 + hh) * 2 + dir) * 16384;
#pragma unroll
            for (int jt = 0; jt < 8; ++jt)
#pragma unroll
                for (int i = 0; i < 4; ++i) cdst[(size_t)(wave * 16 + 4 * fq + i) * 128 + jt * 16 + fr] = acc[jt][i];
            if (wave == 0) {
#pragma unroll
                for (int jt = 0; jt < 8; ++jt) { float v = nacc[jt]; v += __shfl_xor(v, 16); v += __shfl_xor(v, 32); if (fq == 0) MLN[((size_t)(ch * 4 + hh) * 2 + dir) * 128 + jt * 16 + fr] = v; }
                if (lane == 0) { MLS[((size_t)(ch * 4 + hh) * 2 + dir) * 4 + 0] = mloc; MLS[((size_t)(ch * 4 + hh) * 2 + dir) * 4 + 1] = g.tot; }
            }
        }
    }
}
__device__ __forceinline__ void ml_scan_phase(const Args& a, int layer, int tid_, int G) {
    int tid = tid_; asm volatile("" : "+v"(tid));
    const float* MLC = (const float*)(a.ws + WS_MLC); const float* MLN = (const float*)(a.ws + WS_MLN); const float* MLS = (const float*)(a.ws + WS_MLS);
    bf16_t* CS = (bf16_t*)(a.ws + WS_MLCS); float* NS = (float*)(a.ws + WS_MLNS); float* MS = (float*)(a.ws + WS_MLMS);
    for (int task = blockIdx.x; task < 256; task += G) {
        int lat, b, hh, dir, part, nparts;
        if (task < 128) { lat = 1; part = task & 3; dir = (task >> 2) & 1; hh = (task >> 3) & 3; b = task >> 5; nparts = 4; }
        else { const int t2 = task - 128; lat = 0; part = 0; dir = t2 & 1; hh = (t2 >> 1) & 3; b = t2 >> 3; nparts = 1; }
        const int nc = lat ? 16 : 2, ch0 = lat ? 32 + b * 16 : b * 2;
        const int nel = 16384 / nparts, e0 = part * nel, per = nel / NT;
        float c[32]; float n = 0.f, m = 0.f;
        const size_t so = (((size_t)b * DEPTH + layer) * 2 + dir) * 4 + hh;
#pragma unroll
        for (int i = 0; i < 32; ++i) if (i < per) { const int e = e0 + i * NT + tid, vd = e >> 7, kd = e & 127; c[i] = lat ? a.in[7][(so * 128 + kd) * 128 + vd] : 0.f; }
        if (tid < 128) n = lat ? a.in[8][so * 128 + tid] : 0.f;
        m = lat ? a.in[9][so] : 0.f;
        for (int s = 0; s < nc; ++s) { const int ci = dir ? nc - 1 - s : s, ch = ch0 + ci; const size_t sb = (size_t)(ch * 4 + hh) * 2 + dir;
#pragma unroll
            for (int i = 0; i < 32; ++i) if (i < per) CS[sb * 16384 + e0 + i * NT + tid] = f2bf(c[i]);
            if (part == 0) { if (tid < 128) NS[sb * 128 + tid] = n; if (tid == 0) MS[sb] = m; }
            const float ml = MLS[sb * 4 + 0], bl = MLS[sb * 4 + 1];
            const float mn = fmaxf(bl + m, ml), fa = __expf(bl + m - mn), fb = __expf(ml - mn);
#pragma unroll
            for (int i = 0; i < 32; ++i) if (i < per) c[i] = fa * c[i] + fb * MLC[sb * 16384 + e0 + i * NT + tid];
            if (tid < 128) n = fa * n + fb * MLN[sb * 128 + tid];
            m = mn; }
        if (!lat) {
#pragma unroll
            for (int i = 0; i < 32; ++i) if (i < per) { const int e = e0 + i * NT + tid, vd = e >> 7, kd = e & 127; a.out[O_MLC + (so * 128 + kd) * 128 + vd] = c[i]; }
            if (tid < 128) a.out[O_MLN + so * 128 + tid] = n; if (tid == 0) a.out[O_MLM + so] = m; }
    }
}
__device__ __forceinline__ void ml_out_phase(const Args& a, int layer, LAS unsigned char* lds, int tid_, int G) {
    int tid = tid_; asm volatile("" : "+v"(tid));
    const int lane = tid & 63, wave = __builtin_amdgcn_readfirstlane(tid >> 6), fr = lane & 15, fq = lane >> 4;
    const bf16_t* NAT = (const bf16_t*)(a.ws + WS_NAT); const bf16_t* TR = (const bf16_t*)(a.ws + WS_TR); const bf16_t* PROJ = (const bf16_t*)(a.ws + WS_PROJ);
    const bf16_t* CS = (const bf16_t*)(a.ws + WS_MLCS); const float* NS = (const float*)(a.ws + WS_MLNS); const float* MS = (const float*)(a.ws + WS_MLMS);
    bf16_t* BR = (bf16_t*)(a.ws + WS_BR);
    LAS float* U = (LAS float*)lds; LAS float* Wv = U + 128; LAS float* SI = U + 256; LAS float* EM = U + 384; LAS float* NSs = U + 512;
    for (int u = blockIdx.x; u < NCH * 4; u += G) {
        const int ch = u >> 2, hh = u & 3; int row0, seq0, L, lat, b, ci, nc; chunk_info(ch, row0, seq0, L, lat, b, ci, nc);
        const int t = wave * 16 + fr;
        bf16x8 qf[4];
#pragma unroll
        for (int ks = 0; ks < 4; ++ks) qf[ks] = *(const bf16x8*)(NAT + (size_t)(row0 + t) * NATP + N_Q + hh * 128 + 32 * ks + 8 * fq);
        f32x4 hsum[8];
#pragma unroll
        for (int j = 0; j < 8; ++j) hsum[j] = (f32x4){0.f, 0.f, 0.f, 0.f};
#pragma unroll 1
        for (int dir = 0; dir < 2; ++dir) {
            const size_t sb = (size_t)(ch * 4 + hh) * 2 + dir;
            __syncthreads();
            if (wave == 0) {
                const MlGate g = ml_gates(a, layer, row0, hh, dir, lane); const float ms = MS[sb];
                float u0, u1, c0, c1, ai0, ai1;
                if (dir == 0) { u0 = g.ig0 - g.P0; u1 = g.ig1 - g.P1; c0 = g.P0; c1 = g.P1; ai0 = g.P0 + ms; ai1 = g.P1 + ms; }
                else { const float E0 = g.P0 - g.lf0, E1 = g.P1 - g.lf1; u0 = E0 + g.ig0; u1 = E1 + g.ig1; c0 = -E0; c1 = -E1; ai0 = g.tot - E0 + ms; ai1 = g.tot - E1 + ms; }
                float g0 = u0, g1 = u1;
                if (dir == 0) {
#pragma unroll
                    for (int o = 1; o < 64; o <<= 1) { const float x0 = __shfl_up(g0, o), x1 = __shfl_up(g1, o); if (lane >= o) { g0 = fmaxf(g0, x0); g1 = fmaxf(g1, x1); } }
                    g1 = fmaxf(g1, __shfl(g0, 63));
                } else {
#pragma unroll
                    for (int o = 1; o < 64; o <<= 1) { const float x0 = __shfl_down(g0, o), x1 = __shfl_down(g1, o); if (lane + o < 64) { g0 = fmaxf(g0, x0); g1 = fmaxf(g1, x1); } }
                    g0 = fmaxf(g0, __shfl(g1, 0));
                }
                const float mt0 = fmaxf(ai0, c0 + g0), mt1 = fmaxf(ai1, c1 + g1);
                U[lane] = u0; U[lane + 64] = u1; Wv[lane] = c0 - mt0; Wv[lane + 64] = c1 - mt1;
                SI[lane] = __expf(ai0 - mt0); SI[lane + 64] = __expf(ai1 - mt1); EM[lane] = __expf(-mt0); EM[lane + 64] = __expf(-mt1);
                NSs[lane] = NS[sb * 128 + lane]; NSs[lane + 64] = NS[sb * 128 + lane + 64];
            }
            __syncthreads();
            const float wt = Wv[t], sit = SI[t], emt = EM[t];
            f32x4 acc[8];
#pragma unroll
            for (int j = 0; j < 8; ++j) acc[j] = (f32x4){0.f, 0.f, 0.f, 0.f};
#pragma unroll
            for (int ks = 0; ks < 4; ++ks)
#pragma unroll
                for (int j = 0; j < 8; ++j) { const bf16x8 cf = *(const bf16x8*)(CS + sb * 16384 + (size_t)(16 * j + fr) * 128 + 32 * ks + 8 * fq); acc[j] = mfma16(cf, qf[ks], acc[j]); }
            float qn = 0.f;
#pragma unroll
            for (int ks = 0; ks < 4; ++ks) { const u32x4 qv = __builtin_bit_cast(u32x4, qf[ks]); const LAS float* nn = NSs + 32 * ks + 8 * fq;
                qn += bflo(qv.x) * nn[0] + bfhi(qv.x) * nn[1] + bflo(qv.y) * nn[2] + bfhi(qv.y) * nn[3] + bflo(qv.z) * nn[4] + bfhi(qv.z) * nn[5] + bflo(qv.w) * nn[6] + bfhi(qv.w) * nn[7]; }
            qn += __shfl_xor(qn, 16); qn += __shfl_xor(qn, 32);
#pragma unroll
            for (int j = 0; j < 8; ++j) acc[j] *= sit;
            float den = sit * qn;
            const int jlo = dir == 0 ? 0 : (wave >> 1), jhi = dir == 0 ? (wave >> 1) : 3;
            float psum = 0.f;
            for (int jp = jlo; jp <= jhi; ++jp) {
                const int ta = 32 * jp + 8 * (fr >> 2) + (fr & 3);
                f32x4 sa = (f32x4){0.f, 0.f, 0.f, 0.f}, sb2 = (f32x4){0.f, 0.f, 0.f, 0.f};
#pragma unroll
                for (int ks = 0; ks < 4; ++ks) {
                    const bf16x8 ka = *(const bf16x8*)(NAT + (size_t)(row0 + ta) * NATP + N_K + hh * 128 + 32 * ks + 8 * fq);
                    const bf16x8 kb = *(const bf16x8*)(NAT + (size_t)(row0 + ta + 4) * NATP + N_K + hh * 128 + 32 * ks + 8 * fq);
                    sa = mfma16(ka, qf[ks], sa); sb2 = mfma16(kb, qf[ks], sb2); }
                float pa[4], pb[4];
#pragma unroll
                for (int i = 0; i < 4; ++i) { const int s0 = 32 * jp + 8 * fq + i, s1 = s0 + 4;
                    const bool ok0 = dir == 0 ? s0 <= t : s0 >= t, ok1 = dir == 0 ? s1 <= t : s1 >= t;
                    pa[i] = ok0 ? sa[i] * __expf(U[s0] + wt) : 0.f; pb[i] = ok1 ? sb2[i] * __expf(U[s1] + wt) : 0.f;
                    psum += pa[i] + pb[i]; }
                u32x4 pw; pw.x = pk2(pa[0], pa[1]); pw.y = pk2(pa[2], pa[3]); pw.z = pk2(pb[0], pb[1]); pw.w = pk2(pb[2], pb[3]);
                const bf16x8 pf = __builtin_bit_cast(bf16x8, pw);
#pragma unroll
                for (int j = 0; j < 8; ++j) { const bf16x8 vf = *(const bf16x8*)(TR + (size_t)(T_MV + hh * 128 + 16 * j + fr) * M + row0 + 32 * jp + 8 * fq); acc[j] = mfma16(vf, pf, acc[j]); }
            }
            psum += __shfl_xor(psum, 16); psum += __shfl_xor(psum, 32);
            den += psum;
            const float rden = 1.f / fmaxf(fabsf(den), emt);
#pragma unroll
            for (int j = 0; j < 8; ++j) hsum[j] += acc[j] * rden;
        }
        float ss = 0.f;
#pragma unroll
        for (int j = 0; j < 8; ++j) ss += (hsum[j][0] * hsum[j][0] + hsum[j][1] * hsum[j][1]) + (hsum[j][2] * hsum[j][2] + hsum[j][3] * hsum[j][3]);
        ss += __shfl_xor(ss, 16); ss += __shfl_xor(ss, 32);
        const float r = rsqrtf(ss * (1.f / 128.f) + 1e-6f);
        const float* ng = a.in[38] + layer * 512 + hh * 128;
#pragma unroll
        for (int j = 0; j < 8; ++j) { const int vd = 16 * j + 4 * fq; const f32x4 gg = *(const f32x4*)(ng + vd);
            const u32x2 ov = *(const u32x2*)(PROJ + (size_t)(row0 + t) * PJ + P_MO + hh * 128 + vd);
            const float o0 = hsum[j][0] * r * gg[0] * fsigm(bflo(ov.x)), o1 = hsum[j][1] * r * gg[1] * fsigm(bfhi(ov.x)), o2 = hsum[j][2] * r * gg[2] * fsigm(bflo(ov.y)), o3 = hsum[j][3] * r * gg[3] * fsigm(bfhi(ov.y));
            u32x2 w; w.x = pk2(o0, o1); w.y = pk2(o2, o3); *(u32x2*)(BR + (size_t)(row0 + t) * D + 1536 + hh * 128 + vd) = w; }
    }
}
}
namespace mk {
constexpr size_t WS_SST = WS_OPT_END;
constexpr size_t WS_SSL = AL(WS_SST + (size_t)NCH * 8 * 2 * 8192 * 4);
constexpr size_t WS_SSCS = AL(WS_SSL + (size_t)NCH * 8 * 2 * 4);
constexpr size_t WS_YPRE = AL(WS_SSCS + (size_t)NCH * 8 * 2 * 8192 * 2);
constexpr size_t WS_SSQ = AL(WS_YPRE + (size_t)M * 512 * 4);
constexpr size_t WS_SSD_END = AL(WS_SSQ + (size_t)M * 8 * 4);

struct SsdGate { float dt0, dt1, la0, la1, P0, P1, tot; };
__device__ __forceinline__ SsdGate ssd_gates(const Args& a, int layer, int row0, int hh, int dir, int lane) {
    const float* SMALL = (const float*)(a.ws + WS_SMALL);
    const float bias = a.in[32][layer * 16 + dir * 8 + hh], A = -__expf(a.in[33][layer * 16 + dir * 8 + hh]);
    SsdGate g;
    const float x0 = SMALL[(size_t)(row0 + lane) * 32 + S_DT + dir * 8 + hh] + bias, x1 = SMALL[(size_t)(row0 + lane + 64) * 32 + S_DT + dir * 8 + hh] + bias;
    g.dt0 = fmaxf(x0, 0.f) + log1pf(__expf(-fabsf(x0))); g.dt1 = fmaxf(x1, 0.f) + log1pf(__expf(-fabsf(x1)));
    g.la0 = g.dt0 * A; g.la1 = g.dt1 * A;
    const float s0 = wave_incl_scan(g.la0, lane); const float t0 = __shfl(s0, 63);
    const float s1 = wave_incl_scan(g.la1, lane) + t0;
    g.P0 = s0; g.P1 = s1; g.tot = __shfl(s1, 63);
    return g;
}
__device__ __forceinline__ void ssd_states_phase(const Args& a, int layer, int tid_, int G) {
    int tid = tid_; asm volatile("" : "+v"(tid));
    const int lane = tid & 63, wave = __builtin_amdgcn_readfirstlane(tid >> 6), fr = lane & 15, fq = lane >> 4;
    const bf16_t* TR = (const bf16_t*)(a.ws + WS_TR); float* SST = (float*)(a.ws + WS_SST); float* SSL = (float*)(a.ws + WS_SSL);
    for (int u = blockIdx.x; u < NCH * 8; u += G) {
        const int ch = u >> 3, hh = u & 7, grp = hh >> 2; int row0, seq0, L, lat, b, ci, nc; chunk_info(ch, row0, seq0, L, lat, b, ci, nc);
#pragma unroll
        for (int dir = 0; dir < 2; ++dir) {
            const SsdGate g = ssd_gates(a, layer, row0, hh, dir, lane);
            const float w0 = g.dt0 * __expf(dir == 0 ? g.tot - g.P0 : g.P0 - g.la0), w1 = g.dt1 * __expf(dir == 0 ? g.tot - g.P1 : g.P1 - g.la1);
            f32x4 acc[4];
#pragma unroll
            for (int j = 0; j < 4; ++j) acc[j] = (f32x4){0.f, 0.f, 0.f, 0.f};
#pragma unroll
            for (int ks = 0; ks < 4; ++ks) {
                float ev[8];
#pragma unroll
                for (int j = 0; j < 8; ++j) { const int tok = 32 * ks + 8 * fq + j; const float y0 = __shfl(w0, tok & 63), y1 = __shfl(w1, tok & 63); ev[j] = tok < 64 ? y0 : y1; }
                const u32x4 bv = *(const u32x4*)(TR + (size_t)(T_B + grp * 128 + wave * 16 + fr) * M + row0 + 32 * ks + 8 * fq);
                u32x4 bw; bw.x = pk2(bflo(bv.x) * ev[0], bfhi(bv.x) * ev[1]); bw.y = pk2(bflo(bv.y) * ev[2], bfhi(bv.y) * ev[3]); bw.z = pk2(bflo(bv.z) * ev[4], bfhi(bv.z) * ev[5]); bw.w = pk2(bflo(bv.w) * ev[6], bfhi(bv.w) * ev[7]);
                const bf16x8 bf = __builtin_bit_cast(bf16x8, bw);
#pragma unroll
                for (int j = 0; j < 4; ++j) { const bf16x8 xf = *(const bf16x8*)(TR + (size_t)(T_X + hh * 64 + 16 * j + fr) * M + row0 + 32 * ks + 8 * fq); acc[j] = mfma16(xf, bf, acc[j]); }
            }
            float* dst = SST + ((size_t)(ch * 8 + hh) * 2 + dir) * 8192;
#pragma unroll
            for (int j = 0; j < 4; ++j)
#pragma unroll
                for (int i = 0; i < 4; ++i) dst[(size_t)(16 * j + 4 * fq + i) * 128 + wave * 16 + fr] = acc[j][i];
            if (tid == 0) SSL[(size_t)(ch * 8 + hh) * 2 + dir] = g.tot;
        }
    }
}
__device__ __forceinline__ void ssd_scan_phase(const Args& a, int layer, int tid_, int G) {
    int tid = tid_; asm volatile("" : "+v"(tid));
    const float* SST = (const float*)(a.ws + WS_SST); const float* SSL = (const float*)(a.ws + WS_SSL); bf16_t* CS = (bf16_t*)(a.ws + WS_SSCS);
    for (int task = blockIdx.x; task < 384; task += G) {
        int lat, b, hh, dir, part, nparts;
        if (task < 128) { lat = 1; part = task & 1; dir = (task >> 1) & 1; hh = (task >> 2) & 7; b = task >> 5; nparts = 2; }
        else { const int t2 = task - 128; lat = 0; part = 0; dir = t2 & 1; hh = (t2 >> 1) & 7; b = t2 >> 4; nparts = 1; }
        const int nc = lat ? 16 : 2, ch0 = lat ? 32 + b * 16 : b * 2;
        const int nel = 8192 / nparts, e0 = part * nel, per = nel / NT;
        float c[16];
        const size_t so = ((((size_t)b * DEPTH + layer) * 2 + dir) * 8 + hh) * 8192;
#pragma unroll
        for (int i = 0; i < 16; ++i) if (i < per) c[i] = lat ? a.in[6][so + e0 + i * NT + tid] : 0.f;
        for (int s = 0; s < nc; ++s) { const int ci = dir ? nc - 1 - s : s, ch = ch0 + ci; const size_t sb = (size_t)(ch * 8 + hh) * 2 + dir;
#pragma unroll
            for (int i = 0; i < 16; ++i) if (i < per) CS[sb * 8192 + e0 + i * NT + tid] = f2bf(c[i]);
            const float dec = __expf(SSL[sb]);
#pragma unroll
            for (int i = 0; i < 16; ++i) if (i < per) c[i] = dec * c[i] + SST[sb * 8192 + e0 + i * NT + tid]; }
        if (!lat) {
#pragma unroll
            for (int i = 0; i < 16; ++i) if (i < per) a.out[O_SSD + so + e0 + i * NT + tid] = c[i]; }
    }
}
__device__ __forceinline__ void ssd_out_phase(const Args& a, int layer, LAS unsigned char* lds, int tid_, int G) {
    int tid = tid_; asm volatile("" : "+v"(tid));
    const int lane = tid & 63, wave = __builtin_amdgcn_readfirstlane(tid >> 6), fr = lane & 15, fq = lane >> 4;
    const bf16_t* NAT = (const bf16_t*)(a.ws + WS_NAT); const bf16_t* TR = (const bf16_t*)(a.ws + WS_TR); const bf16_t* PROJ = (const bf16_t*)(a.ws + WS_PROJ);
    const bf16_t* CS = (const bf16_t*)(a.ws + WS_SSCS); float* YPRE = (float*)(a.ws + WS_YPRE); float* SSQ = (float*)(a.ws + WS_SSQ);
    LAS float* U = (LAS float*)(lds + 4096); LAS float* Wv = U + 128; LAS float* DT = U + 256; LAS float* EO = U + 384;
    for (int u = blockIdx.x; u < NCH * 8; u += G) {
        const int ch = u >> 3, hh = u & 7, grp = hh >> 2; int row0, seq0, L, lat, b, ci, nc; chunk_info(ch, row0, seq0, L, lat, b, ci, nc);
        const int t = wave * 16 + fr;
        bf16x8 cf[4];
#pragma unroll
        for (int ks = 0; ks < 4; ++ks) cf[ks] = *(const bf16x8*)(NAT + (size_t)(row0 + t) * NATP + N_XBC + 768 + grp * 128 + 32 * ks + 8 * fq);
        f32x4 ysum[4];
#pragma unroll
        for (int j = 0; j < 4; ++j) ysum[j] = (f32x4){0.f, 0.f, 0.f, 0.f};
#pragma unroll 1
        for (int dir = 0; dir < 2; ++dir) {
            const size_t sb = (size_t)(ch * 8 + hh) * 2 + dir;
            __syncthreads();
            if (wave == 0) {
                const SsdGate g = ssd_gates(a, layer, row0, hh, dir, lane);
                if (dir == 0) { U[lane] = -g.P0; U[lane + 64] = -g.P1; Wv[lane] = g.P0; Wv[lane + 64] = g.P1; EO[lane] = __expf(g.P0); EO[lane + 64] = __expf(g.P1); }
                else { const float E0 = g.P0 - g.la0, E1 = g.P1 - g.la1; U[lane] = E0; U[lane + 64] = E1; Wv[lane] = -E0; Wv[lane + 64] = -E1; EO[lane] = __expf(g.tot - E0); EO[lane + 64] = __expf(g.tot - E1); }
                DT[lane] = g.dt0; DT[lane + 64] = g.dt1;
            }
            __syncthreads();
            const float wt = Wv[t], eot = EO[t];
            f32x4 acc[4];
#pragma unroll
            for (int j = 0; j < 4; ++j) acc[j] = (f32x4){0.f, 0.f, 0.f, 0.f};
#pragma unroll
            for (int ks = 0; ks < 4; ++ks)
#pragma unroll
                for (int j = 0; j < 4; ++j) { const bf16x8 sf = *(const bf16x8*)(CS + sb * 8192 + (size_t)(16 * j + fr) * 128 + 32 * ks + 8 * fq); acc[j] = mfma16(sf, cf[ks], acc[j]); }
#pragma unroll
            for (int j = 0; j < 4; ++j) acc[j] *= eot;
            const int jlo = dir == 0 ? 0 : (wave >> 1), jhi = dir == 0 ? (wave >> 1) : 3;
            for (int jp = jlo; jp <= jhi; ++jp) {
                const int ta = 32 * jp + 8 * (fr >> 2) + (fr & 3);
                f32x4 sa = (f32x4){0.f, 0.f, 0.f, 0.f}, sb2 = (f32x4){0.f, 0.f, 0.f, 0.f};
#pragma unroll
                for (int ks = 0; ks < 4; ++ks) {
                    const bf16x8 ba = *(const bf16x8*)(NAT + (size_t)(row0 + ta) * NATP + N_XBC + 512 + grp * 128 + 32 * ks + 8 * fq);
                    const bf16x8 bb = *(const bf16x8*)(NAT + (size_t)(row0 + ta + 4) * NATP + N_XBC + 512 + grp * 128 + 32 * ks + 8 * fq);
                    sa = mfma16(ba, cf[ks], sa); sb2 = mfma16(bb, cf[ks], sb2); }
                float pa[4], pb[4];
#pragma unroll
                for (int i = 0; i < 4; ++i) { const int s0 = 32 * jp + 8 * fq + i, s1 = s0 + 4;
                    const bool ok0 = dir == 0 ? s0 <= t : s0 >= t, ok1 = dir == 0 ? s1 <= t : s1 >= t;
                    pa[i] = ok0 ? sa[i] * DT[s0] * __expf(U[s0] + wt) : 0.f; pb[i] = ok1 ? sb2[i] * DT[s1] * __expf(U[s1] + wt) : 0.f; }
                u32x4 pw; pw.x = pk2(pa[0], pa[1]); pw.y = pk2(pa[2], pa[3]); pw.z = pk2(pb[0], pb[1]); pw.w = pk2(pb[2], pb[3]);
                const bf16x8 pf = __builtin_bit_cast(bf16x8, pw);
#pragma unroll
                for (int j = 0; j < 4; ++j) { const bf16x8 xf = *(const bf16x8*)(TR + (size_t)(T_X + hh * 64 + 16 * j + fr) * M + row0 + 32 * jp + 8 * fq); acc[j] = mfma16(xf, pf, acc[j]); }
            }
#pragma unroll
            for (int j = 0; j < 4; ++j) ysum[j] += acc[j];
        }
        const float Dh = a.in[34][layer * 8 + hh]; float ss = 0.f;
#pragma unroll
        for (int j = 0; j < 4; ++j) { const int p = 16 * j + 4 * fq;
            const u32x2 xv = *(const u32x2*)(NAT + (size_t)(row0 + t) * NATP + N_XBC + hh * 64 + p), zv = *(const u32x2*)(PROJ + (size_t)(row0 + t) * PJ + P_Z + hh * 64 + p);
            f32x4 y; y[0] = (ysum[j][0] + bflo(xv.x) * Dh) * fsilu(bflo(zv.x)); y[1] = (ysum[j][1] + bfhi(xv.x) * Dh) * fsilu(bfhi(zv.x));
            y[2] = (ysum[j][2] + bflo(xv.y) * Dh) * fsilu(bflo(zv.y)); y[3] = (ysum[j][3] + bfhi(xv.y) * Dh) * fsilu(bfhi(zv.y));
            ss += (y[0] * y[0] + y[1] * y[1]) + (y[2] * y[2] + y[3] * y[3]);
            *(f32x4*)(YPRE + (size_t)(row0 + t) * 512 + hh * 64 + p) = y; }
        ss += __shfl_xor(ss, 16); ss += __shfl_xor(ss, 32);
        if (fq == 0) SSQ[(size_t)(row0 + t) * 8 + hh] = ss;
    }
}
__device__ __forceinline__ void ssd_fin_phase(const Args& a, int layer, int gw, int ngw, int lane_) {
    int lane = lane_; asm volatile("" : "+v"(lane));
    const float* YPRE = (const float*)(a.ws + WS_YPRE); const float* SSQ = (const float*)(a.ws + WS_SSQ); bf16_t* BR = (bf16_t*)(a.ws + WS_BR); const float* ng = a.in[35] + layer * 512;
    for (int row = gw; row < M; row += ngw) {
        float s = lane < 8 ? SSQ[(size_t)row * 8 + lane] : 0.f; s += __shfl_xor(s, 1); s += __shfl_xor(s, 2); s += __shfl_xor(s, 4); s = __shfl(s, 0);
        const float r = rsqrtf(s * (1.f / 512.f) + 1e-6f);
        const f32x4 y0 = *(const f32x4*)(YPRE + (size_t)row * 512 + 8 * lane), y1 = *(const f32x4*)(YPRE + (size_t)row * 512 + 8 * lane + 4);
        const f32x4 g0 = *(const f32x4*)(ng + 8 * lane), g1 = *(const f32x4*)(ng + 8 * lane + 4);
        *(u32x4*)(BR + (size_t)row * D + 1024 + 8 * lane) = pack8(y0 * r * g0, y1 * r * g1);
    }
}
}
namespace mk {
constexpr size_t WS_CK = WS_SSD_END;
constexpr size_t WS_CVT = AL(WS_CK + (size_t)16 * 512 * 512 * 2);
constexpr size_t WS_ATT_END = AL(WS_CVT + (size_t)16 * 512 * 512 * 2);

__device__ __forceinline__ void prologue_cache(const Args& a, int gw, int ngw, int lane) {
    bf16_t* CK = (bf16_t*)(a.ws + WS_CK); bf16_t* CVT = (bf16_t*)(a.ws + WS_CVT);
    for (size_t i = ((size_t)gw * 64 + lane) * 8; i < (size_t)16 * 512 * 512; i += (size_t)ngw * 64 * 8) {
        const f32x4 x0 = *(const f32x4*)(a.in[2] + i), x1 = *(const f32x4*)(a.in[2] + i + 4); *(u32x4*)(CK + i) = pack8(x0, x1); }
    for (size_t i = (size_t)gw * 64 + lane; i < (size_t)16 * 64 * 512; i += (size_t)ngw * 64) { const int c = i & 511, s8 = (i >> 9) & 63, bl = i >> 15;
        const float* src = a.in[3] + ((size_t)bl * 512 + 8 * s8) * 512 + c;
        u32x4 o; o.x = pk2(src[0], src[512]); o.y = pk2(src[1024], src[1536]); o.z = pk2(src[2048], src[2560]); o.w = pk2(src[3072], src[3584]);
        *(u32x4*)(CVT + ((size_t)bl * 512 + c) * 512 + 8 * s8) = o; }
}
struct AttState { float m, l; f32x4 o[4]; };
template <bool MASKED>
__device__ __forceinline__ void attn_group(AttState& st, const bf16x8 (&qf)[2], const bf16_t* kbase, size_t kp, const bf16_t* vt, size_t vp, int fr, int fq,
                                           const float* bias  , int kc0, int cq, int cs) {
    const int ra = 8 * (fr >> 2) + (fr & 3);
    f32x4 sa = (f32x4){0.f, 0.f, 0.f, 0.f}, sb = (f32x4){0.f, 0.f, 0.f, 0.f};
#pragma unroll
    for (int ks = 0; ks < 2; ++ks) { const bf16x8 ka = *(const bf16x8*)(kbase + (size_t)ra * kp + 32 * ks + 8 * fq), kb = *(const bf16x8*)(kbase + (size_t)(ra + 4) * kp + 32 * ks + 8 * fq);
        sa = mfma16(ka, qf[ks], sa); sb = mfma16(kb, qf[ks], sb); }
    float s[8]; float gm = -1e30f;
#pragma unroll
    for (int i = 0; i < 4; ++i) { s[i] = sa[i] * 0.125f; s[4 + i] = sb[i] * 0.125f; }
    if (MASKED) {
#pragma unroll
        for (int e = 0; e < 8; ++e) { const int kc = kc0 + 8 * fq + e; const bool ok = kc >= cs && kc < cs + 16; const int bi = min(max(kc - cq + 15, 0), 30); s[e] = ok ? s[e] + bias[bi] : -1e30f; }
    }
#pragma unroll
    for (int e = 0; e < 8; ++e) gm = fmaxf(gm, s[e]);
    gm = fmaxf(gm, __shfl_xor(gm, 16)); gm = fmaxf(gm, __shfl_xor(gm, 32));
    const float mn = fmaxf(st.m, gm), al = __expf(st.m - mn); st.m = mn;
    float p[8], ps = 0.f;
#pragma unroll
    for (int e = 0; e < 8; ++e) { p[e] = __expf(s[e] - mn); ps += p[e]; }
    st.l = st.l * al + ps;
    u32x4 pw; pw.x = pk2(p[0], p[1]); pw.y = pk2(p[2], p[3]); pw.z = pk2(p[4], p[5]); pw.w = pk2(p[6], p[7]);
    const bf16x8 pf = __builtin_bit_cast(bf16x8, pw);
#pragma unroll
    for (int j = 0; j < 4; ++j) { const bf16x8 vf = *(const bf16x8*)(vt + (size_t)(16 * j + fr) * vp + 8 * fq); st.o[j] = mfma16(vf, pf, st.o[j] * al); }
}
__device__ __forceinline__ void attn_phase(const Args& a, int layer, int gw_, int ngw, int lane_) {
    int lane = lane_, gw = gw_; asm volatile("" : "+v"(lane));
    const int fr = lane & 15, fq = lane >> 4;
    const bf16_t* PROJ = (const bf16_t*)(a.ws + WS_PROJ); const bf16_t* TR = (const bf16_t*)(a.ws + WS_TR); bf16_t* BR = (bf16_t*)(a.ws + WS_BR);
    const bf16_t* CK = (const bf16_t*)(a.ws + WS_CK); const bf16_t* CVT = (const bf16_t*)(a.ws + WS_CVT);
    for (int it = gw; it < 6144; it += ngw) {
        AttState st; st.m = -1e30f; st.l = 0.f;
#pragma unroll
        for (int j = 0; j < 4; ++j) st.o[j] = (f32x4){0.f, 0.f, 0.f, 0.f};
        int qrow, hh;
        if (it < 4096) {
            const int jq = it & 3, r = (it >> 2) & 31; hh = (it >> 7) & 7; const int b = it >> 10;
            const int seq0 = MP + b * 2048; qrow = seq0 + r * 64 + 16 * jq + fr;
            bf16x8 qf[2];
#pragma unroll
            for (int ks = 0; ks < 2; ++ks) qf[ks] = *(const bf16x8*)(PROJ + (size_t)qrow * PJ + P_Q + hh * 64 + 32 * ks + 8 * fq);
            const int rs = min(max(r - 4, 0), 24), cq = 16 * jq + fr, cs = min(max(cq - 8, 0), 48);
            const int kc0 = jq == 0 ? 0 : (jq == 1 ? 8 : (jq == 2 ? 24 : 32));
            const float* rpb = a.in[19] + ((size_t)layer * 8 + hh) * 15 * 31;
            for (int j = 0; j < 8; ++j) { const int kr = rs + j, tok0 = seq0 + kr * 64 + kc0;
                attn_group<true>(st, qf, PROJ + (size_t)tok0 * PJ + P_K + hh * 64, PJ, TR + (size_t)(T_V + hh * 64) * M + tok0, M, fr, fq, rpb + (kr - r + 7) * 31, kc0, cq, cs); }
            const size_t cb = ((size_t)b * DEPTH + layer) * 512;
            for (int g = 0; g < 16; ++g)
                attn_group<false>(st, qf, CK + (cb + 32 * g) * 512 + hh * 64, 512, CVT + (cb + hh * 64) * 512 + 32 * g, 512, fr, fq, nullptr, 0, 0, 0);
        } else {
            const int i2 = it - 4096, qt = i2 & 15; hh = (i2 >> 4) & 7; const int b = i2 >> 7, seq0 = b * 256; qrow = seq0 + 16 * qt + fr;
            bf16x8 qf[2];
#pragma unroll
            for (int ks = 0; ks < 2; ++ks) qf[ks] = *(const bf16x8*)(PROJ + (size_t)qrow * PJ + P_Q + hh * 64 + 32 * ks + 8 * fq);
            for (int g = 0; g < 8; ++g) { const int tok0 = seq0 + 32 * g;
                attn_group<false>(st, qf, PROJ + (size_t)tok0 * PJ + P_K + hh * 64, PJ, TR + (size_t)(T_V + hh * 64) * M + tok0, M, fr, fq, nullptr, 0, 0, 0); }
        }
        float l = st.l; l += __shfl_xor(l, 16); l += __shfl_xor(l, 32);
        const float rl = 1.f / l;
#pragma unroll
        for (int j = 0; j < 4; ++j) { u32x2 w; w.x = pk2(st.o[j][0] * rl, st.o[j][1] * rl); w.y = pk2(st.o[j][2] * rl, st.o[j][3] * rl);
            *(u32x2*)(BR + (size_t)qrow * D + hh * 64 + 16 * j + 4 * fq) = w; }
    }
}
}
namespace mk {
constexpr int S5K = 768;
constexpr size_t WS_S5W = WS_ATT_END;
constexpr size_t WS_S5WS = AL(WS_S5W + (size_t)DEPTH * 32 * 512 * S5K * 2);
constexpr size_t WS_S5AP = AL(WS_S5WS + (size_t)DEPTH * 32 * 256 * 512 * 2);
constexpr size_t WS_S5UP = AL(WS_S5AP + (size_t)DEPTH * 32 * 2 * 64 * 2 * 4);
constexpr size_t WS_S5SS = AL(WS_S5UP + (size_t)32 * 384 * 512 * 2);
constexpr size_t WS_S5HS = AL(WS_S5SS + (size_t)32 * 384 * 256 * 4);
constexpr size_t WS_S5_END = AL(WS_S5HS + (size_t)32 * 384 * 256 * 2);

__device__ __forceinline__ void s5_param_phase(const Args& a, LAS unsigned char* lds, int tid_, int G) {
    int tid = tid_; asm volatile("" : "+v"(tid));
    LAS float* PW = (LAS float*)lds; LAS float* BB = PW + 2 * 33 * 64 * 2; LAS float* CC = BB + 2 * 64 * 16 * 2; LAS float* KT = CC + 2 * 16 * 64 * 2;
    for (int task = blockIdx.x; task < DEPTH * 32; task += G) {
        const int layer = task >> 5, g = task & 31;
        const float* a_re = a.in[20] + layer * 4096; const float* a_im = a.in[21] + layer * 4096; const float* log_dt = a.in[22] + layer * 64;
        const float* b_re = a.in[23] + (size_t)layer * 65536; const float* b_im = a.in[24] + (size_t)layer * 65536; const float* c_re = a.in[25] + (size_t)layer * 65536; const float* c_im = a.in[26] + (size_t)layer * 65536;
        const float* s5d = a.in[27] + layer * 512;
        bf16_t* S5W = (bf16_t*)(a.ws + WS_S5W) + (size_t)layer * 32 * 512 * S5K; bf16_t* S5WS = (bf16_t*)(a.ws + WS_S5WS) + (size_t)layer * 32 * 256 * 512; float* S5AP = (float*)(a.ws + WS_S5AP) + (size_t)layer * 32 * 2 * 64 * 2;
        __syncthreads();
        if (tid < 128) { const int dir = tid >> 6, n = tid & 63, pi = (dir * 32 + g) * 64 + n;
            const float are = fminf(a_re[pi], -1e-4f), aim = a_im[pi], dt = expf(log_dt[dir * 32 + g]);
            const float mag = expf(dt * are), abr = mag * cosf(dt * aim), abi = mag * sinf(dt * aim);
            const float den = are * are + aim * aim, nr = abr - 1.f, cfr = (nr * are + abi * aim) / den, cfi = (abi * are - nr * aim) / den;
            float pr = 1.f, pim = 0.f;
            for (int p = 0; p <= 32; ++p) { PW[((dir * 33 + p) * 64 + n) * 2] = pr; PW[((dir * 33 + p) * 64 + n) * 2 + 1] = pim; const float t = pr * abr - pim * abi; pim = pr * abi + pim * abr; pr = t; }
            S5AP[((g * 2 + dir) * 64 + n) * 2] = PW[((dir * 33 + 32) * 64 + n) * 2]; S5AP[((g * 2 + dir) * 64 + n) * 2 + 1] = PW[((dir * 33 + 32) * 64 + n) * 2 + 1];
            for (int k = 0; k < 16; ++k) { const float br_ = b_re[(size_t)pi * 16 + k], bi_ = b_im[(size_t)pi * 16 + k];
                BB[((dir * 64 + n) * 16 + k) * 2] = cfr * br_ - cfi * bi_; BB[((dir * 64 + n) * 16 + k) * 2 + 1] = cfr * bi_ + cfi * br_; }
            for (int j = 0; j < 16; ++j) { CC[((dir * 64 + n) * 16 + j) * 2] = c_re[((size_t)(dir * 32 + g) * 16 + j) * 64 + n]; CC[((dir * 64 + n) * 16 + j) * 2 + 1] = c_im[((size_t)(dir * 32 + g) * 16 + j) * 64 + n]; }
        }
        __syncthreads();
        for (int e = tid; e < 2 * 32 * 256; e += NT) { const int j = e & 15, k = (e >> 4) & 15, tau = (e >> 8) & 31, dir = e >> 13; float s = 0.f;
            for (int n = 0; n < 64; ++n) { const float cr = CC[((dir * 64 + n) * 16 + j) * 2], ci = CC[((dir * 64 + n) * 16 + j) * 2 + 1], pr = PW[((dir * 33 + tau) * 64 + n) * 2], pim = PW[((dir * 33 + tau) * 64 + n) * 2 + 1];
                const float xr = cr * pr - ci * pim, xi = cr * pim + ci * pr, br_ = BB[((dir * 64 + n) * 16 + k) * 2], bi_ = BB[((dir * 64 + n) * 16 + k) * 2 + 1];
                s += xr * br_ - xi * bi_; }
            KT[e] = s; }
        __syncthreads();
        { const int t = tid >> 4, j = tid & 15; bf16_t* dst = S5W + ((size_t)g * 512 + tid) * S5K;
            for (int s = 0; s < 32; ++s) { float v[16];
#pragma unroll
                for (int k = 0; k < 16; ++k) { float x;
                    if (s < t) x = KT[((0 * 32 + (t - s)) * 16 + k) * 16 + j]; else if (s > t) x = KT[((1 * 32 + (s - t)) * 16 + k) * 16 + j];
                    else x = KT[((0 * 32 + 0) * 16 + k) * 16 + j] + KT[((1 * 32 + 0) * 16 + k) * 16 + j] + (k == j ? s5d[g * 16 + k] : 0.f);
                    v[k] = x; }
                u32x4 o0, o1; o0.x = pk2(v[0], v[1]); o0.y = pk2(v[2], v[3]); o0.z = pk2(v[4], v[5]); o0.w = pk2(v[6], v[7]); o1.x = pk2(v[8], v[9]); o1.y = pk2(v[10], v[11]); o1.z = pk2(v[12], v[13]); o1.w = pk2(v[14], v[15]);
                *(u32x4*)(dst + s * 16) = o0; *(u32x4*)(dst + s * 16 + 8) = o1; }
            for (int dir = 0; dir < 2; ++dir) { const int p = dir == 0 ? t + 1 : 32 - t;
                for (int n8 = 0; n8 < 8; ++n8) { float gr[8], gi[8];
#pragma unroll
                    for (int q = 0; q < 8; ++q) { const int n = n8 * 8 + q; const float cr = CC[((dir * 64 + n) * 16 + j) * 2], ci = CC[((dir * 64 + n) * 16 + j) * 2 + 1], pr = PW[((dir * 33 + p) * 64 + n) * 2], pim = PW[((dir * 33 + p) * 64 + n) * 2 + 1];
                        gr[q] = cr * pr - ci * pim; gi[q] = -(cr * pim + ci * pr); }
                    u32x4 o; o.x = pk2(gr[0], gr[1]); o.y = pk2(gr[2], gr[3]); o.z = pk2(gr[4], gr[5]); o.w = pk2(gr[6], gr[7]); *(u32x4*)(dst + 512 + dir * 128 + n8 * 8) = o;
                    o.x = pk2(gi[0], gi[1]); o.y = pk2(gi[2], gi[3]); o.z = pk2(gi[4], gi[5]); o.w = pk2(gi[6], gi[7]); *(u32x4*)(dst + 512 + dir * 128 + 64 + n8 * 8) = o; } }
        }
        if (tid < 256) { const int dir = tid >> 7, reim = (tid >> 6) & 1, n = tid & 63; bf16_t* dst = S5WS + ((size_t)g * 256 + tid) * 512;
            for (int s = 0; s < 32; ++s) { const int p = dir == 0 ? 31 - s : s; const float pr = PW[((dir * 33 + p) * 64 + n) * 2], pim = PW[((dir * 33 + p) * 64 + n) * 2 + 1]; float v[16];
#pragma unroll
                for (int k = 0; k < 16; ++k) { const float br_ = BB[((dir * 64 + n) * 16 + k) * 2], bi_ = BB[((dir * 64 + n) * 16 + k) * 2 + 1]; v[k] = reim == 0 ? pr * br_ - pim * bi_ : pr * bi_ + pim * br_; }
                u32x4 o0, o1; o0.x = pk2(v[0], v[1]); o0.y = pk2(v[2], v[3]); o0.z = pk2(v[4], v[5]); o0.w = pk2(v[6], v[7]); o1.x = pk2(v[8], v[9]); o1.y = pk2(v[10], v[11]); o1.z = pk2(v[12], v[13]); o1.w = pk2(v[14], v[15]);
                *(u32x4*)(dst + s * 16) = o0; *(u32x4*)(dst + s * 16 + 8) = o1; } }
    }
    __syncthreads();
}
__device__ __forceinline__ void s5_statein_phase(const Args& a, int layer, int gw, int ngw, int lane_) {
    int lane = lane_; asm volatile("" : "+v"(lane));
    const int fr = lane & 15, fq = lane >> 4;
    const bf16_t* UP = (const bf16_t*)(a.ws + WS_S5UP); const bf16_t* S5WS = (const bf16_t*)(a.ws + WS_S5WS) + (size_t)layer * 32 * 256 * 512; float* SS = (float*)(a.ws + WS_S5SS);
    for (int it = gw; it < 32 * 24; it += ngw) { const int g = it / 24, r = it % 24, og = r / 6, cq = r % 6;
        f32x4 acc[4][4];
#pragma unroll
        for (int i = 0; i < 4; ++i)
#pragma unroll
            for (int j = 0; j < 4; ++j) acc[i][j] = (f32x4){0.f, 0.f, 0.f, 0.f};
        const bf16_t* ap = S5WS + ((size_t)g * 256 + 64 * og + fr) * 512 + 8 * fq; const bf16_t* bp = UP + ((size_t)g * 384 + 64 * cq + fr) * 512 + 8 * fq;
#pragma unroll 2
        for (int ks = 0; ks < 16; ++ks) { bf16x8 af[4], bf[4];
#pragma unroll
            for (int i = 0; i < 4; ++i) { af[i] = *(const bf16x8*)(ap + (size_t)16 * i * 512 + 32 * ks); bf[i] = *(const bf16x8*)(bp + (size_t)16 * i * 512 + 32 * ks); }
#pragma unroll
            for (int i = 0; i < 4; ++i)
#pragma unroll
                for (int j = 0; j < 4; ++j) acc[i][j] = mfma16(af[i], bf[j], acc[i][j]); }
#pragma unroll
        for (int i = 0; i < 4; ++i)
#pragma unroll
            for (int j = 0; j < 4; ++j) *(f32x4*)(SS + ((size_t)g * 384 + 64 * cq + 16 * j + fr) * 256 + 64 * og + 16 * i + 4 * fq) = acc[i][j];
    }
}
__device__ __forceinline__ void s5_scan_phase(const Args& a, int layer, int gw, int ngw, int lane_) {
    int lane = lane_; asm volatile("" : "+v"(lane));
    const float* SS = (const float*)(a.ws + WS_S5SS); bf16_t* HS = (bf16_t*)(a.ws + WS_S5HS); const float* S5AP = (const float*)(a.ws + WS_S5AP) + (size_t)layer * 32 * 2 * 64 * 2;
    for (int task = gw; task < 1280; task += ngw) {
        int sq, g, dir; if (task < 256) { sq = 16 + (task >> 6); g = (task >> 1) & 31; dir = task & 1; } else { const int t2 = task - 256; sq = t2 >> 6; g = (t2 >> 1) & 31; dir = t2 & 1; }
        const int lat = sq >= 16, b = lat ? sq - 16 : sq, nc = lat ? 64 : 8, cg0 = lat ? 128 + b * 64 : b * 8;
        const float apr = S5AP[((g * 2 + dir) * 64 + lane) * 2], api = S5AP[((g * 2 + dir) * 64 + lane) * 2 + 1];
        float hr = 0.f, hi = 0.f;
        if (lat) { const size_t so = ((((size_t)b * DEPTH + layer) * 2 + dir) * 32 + g) * 64 + lane; hr = a.in[4][so]; hi = a.in[5][so]; }
        for (int s = 0; s < nc; ++s) { const int cg = cg0 + (dir ? nc - 1 - s : s); const size_t base = ((size_t)g * 384 + cg) * 256 + dir * 128;
            HS[base + lane] = f2bf(hr); HS[base + 64 + lane] = f2bf(hi);
            const float sr = SS[base + lane], si = SS[base + 64 + lane];
            const float t = apr * hr - api * hi + sr; hi = apr * hi + api * hr + si; hr = t; }
        if (!lat) { const size_t oo = ((((size_t)b * DEPTH + layer) * 2 + dir) * 32 + g) * 64 + lane; a.out[O_S5R + oo] = hr; a.out[O_S5I + oo] = hi; }
    }
}
__device__ __forceinline__ void s5_out_phase(const Args& a, int layer, int gw, int ngw, int lane_) {
    int lane = lane_; asm volatile("" : "+v"(lane));
    const int fr = lane & 15, fq = lane >> 4;
    const bf16_t* UP = (const bf16_t*)(a.ws + WS_S5UP); const bf16_t* S5W = (const bf16_t*)(a.ws + WS_S5W) + (size_t)layer * 32 * 512 * S5K; const bf16_t* HS = (const bf16_t*)(a.ws + WS_S5HS); bf16_t* ZB = (bf16_t*)(a.ws + WS_ZB);
    for (int it = gw; it < 32 * 48; it += ngw) { const int g = it / 48, r = it % 48, og = r / 6, cq = r % 6;
        f32x4 acc[4][4];
#pragma unroll
        for (int i = 0; i < 4; ++i)
#pragma unroll
            for (int j = 0; j < 4; ++j) acc[i][j] = (f32x4){0.f, 0.f, 0.f, 0.f};
        const bf16_t* ap = S5W + ((size_t)g * 512 + 64 * og + fr) * S5K + 8 * fq;
        const bf16_t* bp = UP + ((size_t)g * 384 + 64 * cq + fr) * 512 + 8 * fq; const bf16_t* hp = HS + ((size_t)g * 384 + 64 * cq + fr) * 256 + 8 * fq;
#pragma unroll 2
        for (int ks = 0; ks < 16; ++ks) { bf16x8 af[4], bf[4];
#pragma unroll
            for (int i = 0; i < 4; ++i) { af[i] = *(const bf16x8*)(ap + (size_t)16 * i * S5K + 32 * ks); bf[i] = *(const bf16x8*)(bp + (size_t)16 * i * 512 + 32 * ks); }
#pragma unroll
            for (int i = 0; i < 4; ++i)
#pragma unroll
                for (int j = 0; j < 4; ++j) acc[i][j] = mfma16(af[i], bf[j], acc[i][j]); }
#pragma unroll 2
        for (int ks = 0; ks < 8; ++ks) { bf16x8 af[4], bf[4];
#pragma unroll
            for (int i = 0; i < 4; ++i) { af[i] = *(const bf16x8*)(ap + (size_t)16 * i * S5K + 512 + 32 * ks); bf[i] = *(const bf16x8*)(hp + (size_t)16 * i * 256 + 32 * ks); }
#pragma unroll
            for (int i = 0; i < 4; ++i)
#pragma unroll
                for (int j = 0; j < 4; ++j) acc[i][j] = mfma16(af[i], bf[j], acc[i][j]); }
#pragma unroll
        for (int i = 0; i < 4; ++i)
#pragma unroll
            for (int j = 0; j < 4; ++j) { float z[4];
#pragma unroll
                for (int e = 0; e < 4; ++e) { const float x = acc[i][j][e]; const float th = 0.7978845608028654f * (x + 0.044715f * x * x * x); const float e2 = __expf(2.f * th); const float tnh = 1.f - 2.f * __builtin_amdgcn_rcpf(e2 + 1.f); z[e] = 0.5f * x * (1.f + tnh); }
                u32x2 w; w.x = pk2(z[0], z[1]); w.y = pk2(z[2], z[3]);
                *(u32x2*)(ZB + (size_t)(32 * (64 * cq + 16 * j + fr) + 4 * og + i) * 512 + g * 16 + 4 * fq) = w; }
    }
}
}
namespace mk { static_assert(WS_S5_END < (size_t)1780 * 1024 * 1024, "workspace map exceeds the guaranteed size"); }
namespace mk {
#ifndef PHMASK
#define PHMASK 0xfffff
#endif
#define PHM(k) ((PHMASK >> (k)) & 1)
#ifndef DUPMASK
#define DUPMASK 0
#endif
#define DUP(k) ((DUPMASK >> (k)) & 1)
constexpr int NPH = 12;
constexpr int PH_TOTAL = 1 + DEPTH * NPH;
__global__ void __launch_bounds__(NT, 2) mk_fwd(Args a) {
    extern __shared__ __attribute__((aligned(16))) unsigned char lds_raw[];
    LAS unsigned char* lds = (LAS unsigned char*)lds_raw;
#define TID ((int)threadIdx.x)
#define LANE ((int)(threadIdx.x & 63))
#define WAVE (__builtin_amdgcn_readfirstlane((int)(threadIdx.x >> 6)))
#define GW ((int)blockIdx.x * NWV + WAVE)
    const int G = gridDim.x, ngw = G * NWV;
    volatile LAS unsigned* ctlw = (volatile LAS unsigned*)(lds + LDS_CTL);
    if (TID < 4) ctlw[TID] = 0u;
    __syncthreads();
    XcdBarrier bar = xcd_barrier_post((unsigned*)(a.ws + WS_CTL), ctlw);
    const int lo = a.ph_lo, hi = a.ph_hi;
#define IN(k) (lo <= (k) && (k) < hi)
#define SEAM(k) do { if (IN(k) && IN((k) + 1)) xcd_barrier(bar); } while (0)
    unsigned char* ws = a.ws;
    bf16_t* H = (bf16_t*)(ws + WS_H); bf16_t* PROJ = (bf16_t*)(ws + WS_PROJ); float* SMALL = (float*)(ws + WS_SMALL); bf16_t* BR = (bf16_t*)(ws + WS_BR);
    bf16_t* MERGED = (bf16_t*)(ws + WS_MERGED); float* MACC = (float*)(ws + WS_MACC); bf16_t* ZB = (bf16_t*)(ws + WS_ZB); bf16_t* HID = PROJ;
    const float* MOD = (const float*)(ws + WS_MOD); float* X = a.out;
    if (PHM(0) && IN(0)) { for (int r_ = 0; r_ < 1 + DUP(8); ++r_) prologue_convert(a, lds, GW, ngw, WAVE, LANE); prologue_cache(a, GW, ngw, LANE); __syncthreads(); prologue_ada(a, lds, TID); for (int r_ = 0; r_ < 1 + DUP(1); ++r_) s5_param_phase(a, lds, TID, G); }
    SEAM(0);
    for (int l = 0; l < DEPTH; ++l) {
        const int pb = 1 + l * NPH;
        const float* xp = l == 0 ? a.in[0] : X; const float* xs = l == 0 ? a.in[1] : X + (size_t)MP * D;
        const float* modl = MOD + (size_t)l * 5 * 6 * D;
        const bf16_t* wl = (const bf16_t*)(ws + WS_W) + (size_t)l * W_LAYER;
        if (PHM(1) && IN(pb + 0)) for (int r_ = 0; r_ < 1 + DUP(11); ++r_) norm_phase(xp, xs, a.in[14] + l * D, modl, 0, D, H, GW, ngw, LANE);
        SEAM(pb + 0);
        if (PHM(2) && IN(pb + 1)) { Gemm g{H, wl + W_IN, M, NIN, D, D, 1, 0, 0}; StaticOrder S; S.init(M, NIN, G, blockIdx.x);
            EpiIn E{PROJ, SMALL, a.out, a.in[17] + l * 64, a.in[18] + l * 64, l}; for (int r_ = 0; r_ < 1 + DUP(9); ++r_) gemm_phase(lds, g, S, E); }
        SEAM(pb + 1);
        if (PHM(3) && IN(pb + 2)) { for (int r_ = 0; r_ < 1 + DUP(0); ++r_) { prep_phase(a, l, lds, GW, ngw, WAVE, LANE, (bf16_t*)(a.ws + WS_S5UP)); __syncthreads(); } }
        SEAM(pb + 2);
        if (PHM(4) && IN(pb + 3)) { for (int r_ = 0; r_ < 1 + DUP(2); ++r_) attn_phase(a, l, GW, ngw, LANE); for (int r_ = 0; r_ < 1 + DUP(3); ++r_) { ml_states_phase(a, l, TID, G); ssd_states_phase(a, l, TID, G); s5_statein_phase(a, l, GW, ngw, LANE); } }
        SEAM(pb + 3);
        if (PHM(5) && IN(pb + 4)) { for (int r_ = 0; r_ < 1 + DUP(4); ++r_) { ml_scan_phase(a, l, TID, G); ssd_scan_phase(a, l, TID, G); s5_scan_phase(a, l, GW, ngw, LANE); } }
        SEAM(pb + 4);
        if (PHM(12) && IN(pb + 5)) { for (int r_ = 0; r_ < 1 + DUP(5); ++r_) ml_out_phase(a, l, lds, TID, G); for (int r_ = 0; r_ < 1 + DUP(6); ++r_) ssd_out_phase(a, l, lds, TID, G); for (int r_ = 0; r_ < 1 + DUP(7); ++r_) s5_out_phase(a, l, GW, ngw, LANE); }
        SEAM(pb + 5);
        if (PHM(6) && IN(pb + 6)) { Gemm g{ZB, wl + W_GLU, M, 512, 512, 512, 1, 0, 0}; StaticOrder S; S.init(M, 512, G, blockIdx.x);
            EpiGlu E{ZB, a.in[29] + l * 512, BR}; gemm_phase(lds, g, S, E); ssd_fin_phase(a, l, GW, ngw, LANE); }
        SEAM(pb + 6);
        if (PHM(7) && IN(pb + 7)) { Gemm g{BR, wl + W_BR, M, D, 512, D, 4, 512, (size_t)D * 512}; StaticOrder S; S.init(M, D, G, blockIdx.x, 4);
            EpiBranch E{PROJ, MERGED}; for (int r_ = 0; r_ < 1 + DUP(12); ++r_) gemm_phase(lds, g, S, E); }
        SEAM(pb + 7);
        if (PHM(8) && IN(pb + 8)) { Gemm g{MERGED, wl + W_OUT, M, D, D, D, 1, 0, 0}; StaticOrder S; S.init(M, D, G, blockIdx.x);
            EpiResid E{xp, xs, modl, 2 * D, X}; gemm_phase(lds, g, S, E); }
        SEAM(pb + 8);
        if (PHM(9) && IN(pb + 9)) norm_phase(X, X + (size_t)MP * D, a.in[15] + l * D, modl, 3 * D, 4 * D, H, GW, ngw, LANE);
        SEAM(pb + 9);
        if (PHM(10) && IN(pb + 10)) { Gemm g{H, wl + W_1, M, DFF, D, D, 1, 0, 0}; StaticOrder S; S.init(M, DFF, G, blockIdx.x);
            EpiRelu2 E{HID, DFF}; for (int r_ = 0; r_ < 1 + DUP(10); ++r_) gemm_phase(lds, g, S, E); }
        SEAM(pb + 10);
        if (PHM(11) && IN(pb + 11)) { Gemm g{HID, wl + W_2, M, D, DFF, DFF, 1, 0, 0}; StaticOrder S; S.init(M, D, G, blockIdx.x);
            EpiResid E{X, X + (size_t)MP * D, modl, 5 * D, X}; gemm_phase(lds, g, S, E); }
        SEAM(pb + 11);
    }
#undef IN
#undef SEAM
}
}
extern "C" void kernel_launch(void* const* d_in, const int* in_sizes, int n_in, void* d_out, int out_size, void* d_ws, size_t ws_size, hipStream_t stream) {
    static int grid = 0;
    if (grid == 0) {
        int dev = 0, cus = 0; (void)hipGetDevice(&dev); (void)hipDeviceGetAttribute(&cus, hipDeviceAttributeMultiprocessorCount, dev);
        (void)hipFuncSetAttribute((const void*)mk::mk_fwd, hipFuncAttributeMaxDynamicSharedMemorySize, mk::LDS_BYTES);
        int per_cu = 0; (void)hipOccupancyMaxActiveBlocksPerMultiprocessor(&per_cu, (const void*)mk::mk_fwd, mk::NT, mk::LDS_BYTES); (void)hipGetLastError();
        grid = cus > 0 ? cus : 256;
    }
    mk::Args a{}; for (int i = 0; i < 43; ++i) a.in[i] = (const float*)d_in[i];
    a.out = (float*)d_out; a.ws = (unsigned char*)d_ws; a.ph_lo = 0; a.ph_hi = mk::PH_TOTAL;
    (void)hipMemsetAsync(a.ws + mk::WS_CTL, 0, mk::CTL_BYTES, stream);
    hipLaunchKernelGGL(mk::mk_fwd, dim3(grid), dim3(mk::NT), mk::LDS_BYTES, stream, a);
}
```

```cpp
#define SAFE_GEMM 0
#define DUPMASK 0
#include <hip/hip_runtime.h>
#include <math.h>
namespace mk {
#define LAS __attribute__((address_space(3)))
typedef unsigned short bf16_t;
typedef short bf16x8 __attribute__((ext_vector_type(8)));
typedef float f32x4 __attribute__((ext_vector_type(4)));
typedef float f32x2 __attribute__((ext_vector_type(2)));
typedef unsigned u32x4 __attribute__((ext_vector_type(4)));
typedef unsigned u32x2 __attribute__((ext_vector_type(2)));
constexpr int NT = 512, NWV = 8;
constexpr int D = 2048, MP = 4096, MLAT = 8192, M = MP + MLAT, DEPTH = 4, DFF = 8192;
constexpr int PJ = 13824;
constexpr int NIN = 14080;
constexpr int P_Q = 0, P_K = 512, P_V = 1024, P_S5U = 1536, P_Z = 2048, P_XBC = 2560, P_MQ = 3584, P_MK = 4096, P_MV = 4608, P_MO = 5120, P_GATE = 5632;
constexpr int S_DT = 0, S_MI = 16, S_MF = 24;

typedef __bf16 bf16x2_t __attribute__((ext_vector_type(2)));
__device__ __forceinline__ unsigned pk2(float lo, float hi) { f32x2 v = {lo, hi}; bf16x2_t b = __builtin_convertvector(v, bf16x2_t); return __builtin_bit_cast(unsigned, b); }
__device__ __forceinline__ float bf2f(bf16_t v) { return __uint_as_float(((unsigned)v) << 16); }
__device__ __forceinline__ float bflo(unsigned w) { return __uint_as_float(w << 16); }
__device__ __forceinline__ float bfhi(unsigned w) { return __uint_as_float(w & 0xffff0000u); }
__device__ __forceinline__ bf16_t f2bf(float f) { return (bf16_t)(pk2(f, 0.f) & 0xffffu); }
__device__ __forceinline__ float fsigm(float x) { return __builtin_amdgcn_rcpf(1.f + __expf(-x)); }
__device__ __forceinline__ float fsilu(float x) { return x * fsigm(x); }
__device__ __forceinline__ int row_cvec(int row) { return row < MP ? 0 : 1 + (row - MP) / 2048; }

#define XB_TMO      128
#define XB_XCNT(j)  (256  + 64 * (j))
#define XB_XSUB(j)  (1280 + 64 * (j))
#define XB_XGEN(j)  (2304 + 64 * (j))
#define XB_TOP      3328
#define XB_TOPGEN   3392
#define XCD_BAR_WORDS 3456
#define XB_SPIN_CAP (1u << 18)
__device__ __forceinline__ unsigned xb_ld(unsigned* p)              { return __hip_atomic_load(p, __ATOMIC_RELAXED, __HIP_MEMORY_SCOPE_AGENT); }
__device__ __forceinline__ unsigned xb_add(unsigned* p, unsigned v) { return __hip_atomic_fetch_add(p, v, __ATOMIC_RELAXED, __HIP_MEMORY_SCOPE_AGENT); }
__device__ __forceinline__ unsigned xb_xcc_id() { return (unsigned)__builtin_amdgcn_s_getreg((3 << 11) | 20) & 0xFu; }
#define XB_SPIN(cond, bar) do { unsigned _sp = 0; while (cond) { __builtin_amdgcn_s_sleep(1); \
    if ((++_sp & 255u) == 0u) { if (xb_ld(&(bar)[XB_TMO])) break; if (_sp > XB_SPIN_CAP) { atomicAdd(&(bar)[XB_TMO], 1u); break; } } } } while (0)
struct XcdBarrier { unsigned* bar; unsigned x; volatile LAS unsigned* st; };
__device__ __forceinline__ XcdBarrier xcd_barrier_post(unsigned* bar, volatile LAS unsigned* st) {
    XcdBarrier b; b.bar = bar; b.x = xb_xcc_id(); b.st = st;
    if (threadIdx.x == 0) (void)xb_add(&bar[XB_XCNT(b.x)], 1u);
    return b;
}
__device__ __forceinline__ void xcd_barrier_complete(unsigned* bar, unsigned x, unsigned& nloc, unsigned& nx) {
    const unsigned G = gridDim.x * gridDim.y * gridDim.z;
    unsigned sum, cnt, mine, sp = 0u;
    for (;;) {
        sum = 0u; cnt = 0u; mine = 0u;
#pragma unroll
        for (unsigned j = 0; j < 16; ++j) { const unsigned c = xb_ld(&bar[XB_XCNT(j)]); sum += c; cnt += (c > 0u) ? 1u : 0u; mine = (j == x) ? c : mine; }
        if (sum == G) break;
        __builtin_amdgcn_s_sleep(1);
        if ((++sp & 255u) == 0u) { if (xb_ld(&bar[XB_TMO])) break; if (sp > XB_SPIN_CAP) { atomicAdd(&bar[XB_TMO], 1u); break; } }
    }
    nloc = mine > 0u ? mine : 1u; nx = cnt > 0u ? cnt : 1u;
}
__device__ __forceinline__ void xcd_barrier(const XcdBarrier& b) {
    asm volatile("s_waitcnt vmcnt(0)" ::: "memory");
    __syncthreads();
    if (threadIdx.x == 0) {
        unsigned* bar = b.bar;
        __builtin_amdgcn_s_waitcnt(0);
        unsigned nloc = b.st[0], nx = b.st[1];
        if (nloc == 0u) { xcd_barrier_complete(bar, b.x, nloc, nx); b.st[0] = nloc; b.st[1] = nx; }
        const unsigned old = xb_add(&bar[XB_XSUB(b.x)], 1u);
        const unsigned gen = old / nloc;
        if (old + 1u == (gen + 1u) * nloc) {
            __builtin_amdgcn_fence(__ATOMIC_RELEASE, "agent");
            asm volatile("s_waitcnt vmcnt(0)" ::: "memory");
            const unsigned og = xb_add(&bar[XB_TOP], 1u);
            const unsigned tg = og / nx;
            if (og + 1u == (tg + 1u) * nx) xb_add(&bar[XB_TOPGEN], 1u);
            else XB_SPIN(xb_ld(&bar[XB_TOPGEN]) == tg, bar);
            __builtin_amdgcn_fence(__ATOMIC_ACQUIRE, "agent");
            xb_add(&bar[XB_XGEN(b.x)], 1u);
            asm volatile("s_waitcnt vmcnt(0)" ::: "memory");
        } else {
            XB_SPIN(xb_ld(&bar[XB_XGEN(b.x)]) == gen, bar);
            __builtin_amdgcn_fence(__ATOMIC_ACQUIRE, "agent");
            asm volatile("s_waitcnt vmcnt(0)" ::: "memory");
        }
    }
    __syncthreads();
}

#ifndef GEMM_SP2
#define GEMM_SP2 1
#endif
#ifndef GEMM_ALIGN
#define GEMM_ALIGN 1
#endif
constexpr int BM = 256, BK = 64, HALF = 128, HTB = HALF * BK * 2, STAGE_BYTES = 8 * HTB, NXCD = 8, WGM = 8;
__host__ __device__ __forceinline__ int lds_byte(int r, int c) { const int st = (r >> 4) * 2 + (c >> 5), rr = r & 15, cc = c & 31, ob = rr * 64 + cc * 2; return st * 1024 + (ob ^ (((ob >> 9) & 1) << 5)); }
__host__ __device__ __forceinline__ void stage_rc(int b, int& R, int& C) { const int st = b / 1024, sb = b % 1024, swz = sb ^ (((sb >> 9) & 1) << 5); R = (st >> 1) * 16 + swz / 64; C = (st & 1) * 32 + (swz % 64) / 2; }
__host__ __device__ __forceinline__ int perm32(int rho) { const int n = rho >> 4, i = rho & 15; return 8 * (i >> 2) + 4 * n + (i & 3); }

struct Unit { int pm, pn, kz; };
struct Gemm { const bf16_t* A; const bf16_t* Bt; int M, N, K, lda, nkz; size_t a_kz, b_kz; };

struct StaticOrder {
    int nM, nN, nwg, G, c, nkz;
    __device__ void init(int M_, int N_, int G_, int c_, int nkz_ = 1) { nM = M_ / BM; nN = N_ / BM; nwg = nM * nN; G = G_; c = c_; nkz = nkz_; }
    __device__ bool next(int i, Unit& u) const {
        const int it = i / nkz; u.kz = i - it * nkz;
        const long L = (long)it * G + c; if (L >= nwg) return false;
        int wgid = (int)L; { const int q = nwg / NXCD, r = nwg % NXCD, xcd = wgid % NXCD, off = wgid / NXCD; wgid = (xcd < r ? xcd * (q + 1) : r * (q + 1) + (xcd - r) * q) + off; }
        const int nig = WGM * nN, gid = wgid / nig, fm = gid * WGM, gsz = (nM - fm) < WGM ? (nM - fm) : WGM;
        u.pm = fm + ((wgid % nig) % gsz); u.pn = (wgid % nig) / gsz; return true;
    }
};

template <class Epi>
__device__ __forceinline__ void gemm_phase(LAS unsigned char* lds, const Gemm g, const StaticOrder& S, const Epi& E) {
    int tid_ = threadIdx.x; asm volatile("" : "+v"(tid_));
    const int tid = tid_, wid = __builtin_amdgcn_readfirstlane(tid >> 6), lane = tid & 63, wr = wid >> 2, wc = wid & 3, fr = lane & 15, fq = lane >> 4;
    const int K = g.K, nt = K / BK;
    unsigned voffA[2], voffB[2];
#pragma unroll
    for (int i = 0; i < 2; ++i) { int R, C; stage_rc(tid * 16 + i * 8192, R, C); const int Rb = Epi::PERM ? ((R & ~31) + perm32(R & 31)) : R;
        voffA[i] = (unsigned)(R * g.lda + C) * 2u; voffB[i] = (unsigned)(Rb * K + C) * 2u; }
    const size_t kstep = (size_t)(BK * 2);
    const size_t hstepA = (size_t)HALF * g.lda * 2, hstepB = (size_t)HALF * K * 2;
    const size_t tstepA = 2 * hstepA, tstepB = 2 * hstepB;
    const unsigned ldsw = (unsigned)wid * 1024u;
    const int aoff = lds_byte(wr * 64 + fr, fq * 8), boff = lds_byte(wc * 32 + fr, fq * 8);
#define PG8_SA(b, h) (((b) * 2 + (h)) * HTB)
#define PG8_SB(b, h) ((4 + (b) * 2 + (h)) * HTB)
#define PG8_STAGE(bufoff, gbase, voff) do { _Pragma("unroll") for (int _i = 0; _i < 2; ++_i) \
        __builtin_amdgcn_global_load_lds((const unsigned*)((const char*)(gbase) + (voff)[_i]), (LAS unsigned*)(lds + (bufoff) + ldsw + _i * 8192), 16, 0, 0); } while (0)
#define PG8_LDA(dst, b, h) do { _Pragma("unroll") for (int m = 0; m < 4; ++m) _Pragma("unroll") for (int k = 0; k < 2; ++k) dst[m][k] = *(const LAS bf16x8*)(lds + PG8_SA(b, h) + aoff + m * 2048 + k * 1024); } while (0)
#define PG8_LDB(dst, b, h) do { _Pragma("unroll") for (int n = 0; n < 2; ++n) _Pragma("unroll") for (int k = 0; k < 2; ++k) dst[n][k] = *(const LAS bf16x8*)(lds + PG8_SB(b, h) + boff + n * 2048 + k * 1024); } while (0)
#define PG8_MMA(ai, bj, At, Bt) do { __builtin_amdgcn_s_setprio(1); _Pragma("unroll") for (int m = 0; m < 4; ++m) _Pragma("unroll") for (int n = 0; n < 2; ++n) _Pragma("unroll") for (int k = 0; k < 2; ++k) \
        acc[ai][bj][m][n] = __builtin_amdgcn_mfma_f32_16x16x32_bf16(Bt[n][k], At[m][k], acc[ai][bj][m][n], 0, 0, 0); __builtin_amdgcn_s_setprio(0); } while (0)
#if SAFE_GEMM == 1 || SAFE_GEMM == 3
#define PG8_WAIT_V(n) asm volatile("s_waitcnt vmcnt(0)" ::: "memory")
#else
#define PG8_WAIT_V(n) asm volatile("s_waitcnt vmcnt(" #n ")" ::: "memory")
#endif
#define PG8_WAIT_L(n) asm volatile("s_waitcnt lgkmcnt(" #n ")" ::: "memory")
#if SAFE_GEMM == 1
#define PG8_BAR do { asm volatile("s_waitcnt vmcnt(0) lgkmcnt(0)" ::: "memory"); __builtin_amdgcn_s_barrier(); asm volatile("" ::: "memory"); } while (0)
#elif SAFE_GEMM == 2
#define PG8_BAR asm volatile("s_barrier" ::: "memory")
#elif SAFE_GEMM == 4
#define PG8_BAR do { asm volatile("s_waitcnt lgkmcnt(0)" ::: "memory"); __builtin_amdgcn_s_barrier(); } while (0)
#else
#define PG8_BAR __builtin_amdgcn_s_barrier()
#endif
#define PG8_SCHED __builtin_amdgcn_sched_barrier(0)
    Unit cur, nxt; int ui = 0;
    if (!S.next(0, cur)) return;
    f32x4 acc[2][2][4][2];
#pragma unroll
    for (int a = 0; a < 2; ++a)
#pragma unroll
        for (int b = 0; b < 2; ++b)
#pragma unroll
            for (int m = 0; m < 4; ++m)
#pragma unroll
                for (int n = 0; n < 2; ++n) acc[a][b][m][n] = (f32x4){0.f, 0.f, 0.f, 0.f};
    bf16x8 At[4][2], B0[2][2], B1[2][2];
    const char* cA = (const char*)(g.A + (size_t)cur.kz * g.a_kz) + (size_t)cur.pm * tstepA; const char* cB = (const char*)(g.Bt + (size_t)cur.kz * g.b_kz) + (size_t)cur.pn * tstepB;
#if GEMM_SP2
    PG8_STAGE(PG8_SB(0, 0), cB, voffB); PG8_STAGE(PG8_SB(0, 1), cB + hstepB, voffB); PG8_STAGE(PG8_SA(0, 0), cA, voffA); PG8_STAGE(PG8_SA(0, 1), cA + hstepA, voffA);
    if (wr == 1) PG8_BAR;
    PG8_WAIT_V(2); PG8_BAR;
    PG8_STAGE(PG8_SB(1, 0), cB + kstep, voffB); PG8_STAGE(PG8_SA(1, 0), cA + kstep, voffA); PG8_STAGE(PG8_SB(1, 1), cB + hstepB + kstep, voffB);
    PG8_WAIT_V(6); PG8_BAR;
#else
    PG8_STAGE(PG8_SB(0, 0), cB, voffB); PG8_STAGE(PG8_SA(0, 0), cA, voffA); PG8_STAGE(PG8_SB(0, 1), cB + hstepB, voffB); PG8_STAGE(PG8_SA(0, 1), cA + hstepA, voffA);
    if (wr == 1) PG8_BAR;
    PG8_WAIT_V(4); PG8_BAR;
    PG8_STAGE(PG8_SB(1, 0), cB + kstep, voffB); PG8_STAGE(PG8_SA(1, 0), cA + kstep, voffA); PG8_STAGE(PG8_SB(1, 1), cB + hstepB + kstep, voffB);
    PG8_WAIT_V(6); PG8_BAR;
#endif
    for (;;) {
        const bool has_next = S.next(ui + 1, nxt);
        const char* nA = has_next ? (const char*)(g.A + (size_t)nxt.kz * g.a_kz) + (size_t)nxt.pm * tstepA : cA;
        const char* nB = has_next ? (const char*)(g.Bt + (size_t)nxt.kz * g.b_kz) + (size_t)nxt.pn * tstepB : cB;
        for (int t = 0; t < nt; t += 2) {
            const bool last = (t == nt - 2);
            const char* a1 = cA + (size_t)(t + 1) * kstep;
            const char* a2 = last ? nA : cA + (size_t)(t + 2) * kstep; const char* b2 = last ? nB : cB + (size_t)(t + 2) * kstep;
            const char* a3 = a2 + kstep; const char* b3 = b2 + kstep;
#if GEMM_SP2
            PG8_LDB(B0, 0, 0); PG8_LDB(B1, 0, 1); PG8_SCHED; PG8_LDA(At, 0, 0); PG8_STAGE(PG8_SA(1, 1), a1 + hstepA, voffA);
            PG8_WAIT_V(8); PG8_WAIT_L(0); PG8_BAR; PG8_MMA(0, 0, At, B0); PG8_MMA(0, 1, At, B1); PG8_BAR; PG8_SCHED;
            PG8_LDA(At, 0, 1); PG8_STAGE(PG8_SB(0, 0), b2, voffB); PG8_STAGE(PG8_SB(0, 1), b2 + hstepB, voffB); PG8_STAGE(PG8_SA(0, 0), a2, voffA);
            PG8_WAIT_V(8); PG8_WAIT_L(0); PG8_BAR; PG8_MMA(1, 0, At, B0); PG8_MMA(1, 1, At, B1); PG8_BAR; PG8_SCHED;
            PG8_LDB(B0, 1, 0); PG8_LDB(B1, 1, 1); PG8_SCHED; PG8_LDA(At, 1, 0); PG8_STAGE(PG8_SA(0, 1), a2 + hstepA, voffA);
            PG8_WAIT_V(8); PG8_WAIT_L(0); PG8_BAR; PG8_MMA(0, 0, At, B0); PG8_MMA(0, 1, At, B1); PG8_BAR; PG8_SCHED;
            PG8_LDA(At, 1, 1); PG8_STAGE(PG8_SB(1, 0), b3, voffB); PG8_STAGE(PG8_SB(1, 1), b3 + hstepB, voffB); PG8_STAGE(PG8_SA(1, 0), a3, voffA);
            PG8_WAIT_V(8); PG8_WAIT_L(0); PG8_BAR; PG8_MMA(1, 0, At, B0); PG8_MMA(1, 1, At, B1); PG8_BAR; PG8_SCHED;
#else
            PG8_LDB(B0, 0, 0); PG8_SCHED; PG8_LDA(At, 0, 0); PG8_STAGE(PG8_SA(1, 1), a1 + hstepA, voffA);
            PG8_WAIT_L(8); PG8_BAR; PG8_WAIT_L(0); PG8_MMA(0, 0, At, B0); PG8_BAR; PG8_SCHED;
            PG8_LDB(B1, 0, 1); PG8_STAGE(PG8_SB(0, 0), b2, voffB);
            PG8_BAR; PG8_WAIT_L(0); PG8_MMA(0, 1, At, B1); PG8_BAR;
            PG8_LDA(At, 0, 1); PG8_STAGE(PG8_SA(0, 0), a2, voffA);
            PG8_BAR; PG8_WAIT_L(0); PG8_MMA(1, 0, At, B0); PG8_BAR; PG8_SCHED;
            PG8_STAGE(PG8_SB(0, 1), b2 + hstepB, voffB);
            PG8_WAIT_V(6); PG8_BAR; PG8_MMA(1, 1, At, B1); PG8_BAR;
            PG8_LDB(B0, 1, 0); PG8_SCHED; PG8_LDA(At, 1, 0); PG8_STAGE(PG8_SA(0, 1), a2 + hstepA, voffA);
            PG8_WAIT_L(8); PG8_BAR; PG8_WAIT_L(0); PG8_MMA(0, 0, At, B0); PG8_BAR; PG8_SCHED;
            PG8_LDB(B1, 1, 1); PG8_STAGE(PG8_SB(1, 0), b3, voffB);
            PG8_BAR; PG8_WAIT_L(0); PG8_MMA(0, 1, At, B1); PG8_BAR;
            PG8_LDA(At, 1, 1); PG8_STAGE(PG8_SA(1, 0), a3, voffA);
            PG8_BAR; PG8_WAIT_L(0); PG8_MMA(1, 0, At, B0); PG8_BAR; PG8_SCHED;
            PG8_STAGE(PG8_SB(1, 1), b3 + hstepB, voffB);
            PG8_WAIT_V(6); PG8_BAR; PG8_MMA(1, 1, At, B1); PG8_BAR;
#endif
        }
#if GEMM_ALIGN
        if (wr == 0) PG8_BAR;
#endif
        E(acc, cur, wr, wc, fr, fq);
        if (!has_next) break;
        if (nxt.kz == 0) {
#pragma unroll
        for (int a = 0; a < 2; ++a)
#pragma unroll
            for (int b = 0; b < 2; ++b)
#pragma unroll
                for (int m = 0; m < 4; ++m)
#pragma unroll
                    for (int n = 0; n < 2; ++n) acc[a][b][m][n] = (f32x4){0.f, 0.f, 0.f, 0.f};
        }
        cur = nxt; cA = nA; cB = nB; ++ui;
#if GEMM_ALIGN
        if (wr == 1) PG8_BAR;
#endif
    }
    PG8_WAIT_V(0);
#if !GEMM_ALIGN
    if (wr == 0) PG8_BAR;
#endif
    PG8_BAR;
#undef PG8_SA
#undef PG8_SB
#undef PG8_STAGE
#undef PG8_LDA
#undef PG8_LDB
#undef PG8_MMA
#undef PG8_WAIT_V
#undef PG8_WAIT_L
#undef PG8_BAR
#undef PG8_SCHED
}
}
namespace mk {
constexpr size_t O_YP = 0, O_YS = 8388608, O_NK = 25165824, O_NV = 33554432, O_S5R = 41943040, O_S5I = 42205184, O_SSD = 42467328,
                 O_MLC = 50855936, O_MLN = 59244544, O_MLM = 59310080;

__device__ __forceinline__ u32x4 pack8(const f32x4 a, const f32x4 b) { u32x4 w; w.x = pk2(a[0], a[1]); w.y = pk2(a[2], a[3]); w.z = pk2(b[0], b[1]); w.w = pk2(b[2], b[3]); return w; }

struct EpiIn {
    static constexpr bool PERM = true;
    bf16_t* proj; float* small; float* out; const float* qg; const float* kg; int layer;
    __device__ __forceinline__ void operator()(f32x4 (&acc)[2][2][4][2], const Unit& u, int wr, int wc, int fr, int fq) const {
        const int T = u.pn, rowb = u.pm * BM + wr * 64 + fr;
        if (T == 54) {
            if (wc == 0) {
#pragma unroll
                for (int ai = 0; ai < 2; ++ai)
#pragma unroll
                    for (int m = 0; m < 4; ++m) { float* sp = small + (size_t)(rowb + ai * HALF + m * 16) * 32 + 8 * fq; *(f32x4*)sp = acc[ai][0][m][0]; *(f32x4*)(sp + 4) = acc[ai][0][m][1]; }
            }
            return;
        }
        const int colb = T * 256 + 64 * wc + 8 * fq;
        if (T < 4) {
            const float* g = T < 2 ? qg : kg;
            f32x4 gv[2][2];
#pragma unroll
            for (int bj = 0; bj < 2; ++bj)
#pragma unroll
                for (int n = 0; n < 2; ++n) gv[bj][n] = *(const f32x4*)(g + 32 * bj + 8 * fq + 4 * n);
#pragma unroll
            for (int ai = 0; ai < 2; ++ai)
#pragma unroll
                for (int m = 0; m < 4; ++m) {
                    float ss = 0.f;
#pragma unroll
                    for (int bj = 0; bj < 2; ++bj)
#pragma unroll
                        for (int n = 0; n < 2; ++n) { const f32x4 x = acc[ai][bj][m][n]; ss += (x[0] * x[0] + x[1] * x[1]) + (x[2] * x[2] + x[3] * x[3]); }
                    ss += __shfl_xor(ss, 16); ss += __shfl_xor(ss, 32);
                    const float r = rsqrtf(ss * (1.f / 64.f) + 1e-6f);
                    const int row = rowb + ai * HALF + m * 16;
#pragma unroll
                    for (int bj = 0; bj < 2; ++bj) { const f32x4 v0 = acc[ai][bj][m][0] * r * gv[bj][0], v1 = acc[ai][bj][m][1] * r * gv[bj][1];
                        *(u32x4*)(proj + (size_t)row * PJ + colb + 32 * bj) = pack8(v0, v1);
                        if (T >= 2 && row < MP) { float* o = out + O_NK + ((size_t)((row >> 8) * DEPTH + layer) * 256 + (row & 255)) * 512 + (colb - 512) + 32 * bj; *(f32x4*)o = v0; *(f32x4*)(o + 4) = v1; } }
                }
        } else if (T < 6) {
#pragma unroll
            for (int ai = 0; ai < 2; ++ai)
#pragma unroll
                for (int m = 0; m < 4; ++m) { const int row = rowb + ai * HALF + m * 16;
#pragma unroll
                    for (int bj = 0; bj < 2; ++bj) { const f32x4 v0 = acc[ai][bj][m][0], v1 = acc[ai][bj][m][1];
                        *(u32x4*)(proj + (size_t)row * PJ + colb + 32 * bj) = pack8(v0, v1);
                        if (row < MP) { float* o = out + O_NV + ((size_t)((row >> 8) * DEPTH + layer) * 256 + (row & 255)) * 512 + (colb - 1024) + 32 * bj; *(f32x4*)o = v0; *(f32x4*)(o + 4) = v1; } } }
        } else if (T < 22) {
#pragma unroll
            for (int ai = 0; ai < 2; ++ai)
#pragma unroll
                for (int m = 0; m < 4; ++m) { const int row = rowb + ai * HALF + m * 16;
#pragma unroll
                    for (int bj = 0; bj < 2; ++bj) *(u32x4*)(proj + (size_t)row * PJ + colb + 32 * bj) = pack8(acc[ai][bj][m][0], acc[ai][bj][m][1]); }
        } else {
#pragma unroll
            for (int ai = 0; ai < 2; ++ai)
#pragma unroll
                for (int m = 0; m < 4; ++m) { const int row = rowb + ai * HALF + m * 16;
#pragma unroll
                    for (int bj = 0; bj < 2; ++bj) { f32x4 v0 = acc[ai][bj][m][0], v1 = acc[ai][bj][m][1];
#pragma unroll
                        for (int j = 0; j < 4; ++j) { v0[j] = fsigm(v0[j]); v1[j] = fsigm(v1[j]); }
                        *(u32x4*)(proj + (size_t)row * PJ + colb + 32 * bj) = pack8(v0, v1); } }
        }
    }
};
struct EpiRelu2 {
    static constexpr bool PERM = true;
    bf16_t* O; int ldo;
    __device__ __forceinline__ void operator()(f32x4 (&acc)[2][2][4][2], const Unit& u, int wr, int wc, int fr, int fq) const {
        const int rowb = u.pm * BM + wr * 64 + fr, colb = u.pn * 256 + 64 * wc + 8 * fq;
#pragma unroll
        for (int ai = 0; ai < 2; ++ai)
#pragma unroll
            for (int m = 0; m < 4; ++m) { const int row = rowb + ai * HALF + m * 16;
#pragma unroll
                for (int bj = 0; bj < 2; ++bj) { f32x4 v0 = acc[ai][bj][m][0], v1 = acc[ai][bj][m][1];
#pragma unroll
                    for (int j = 0; j < 4; ++j) { const float a = fmaxf(v0[j], 0.f), b = fmaxf(v1[j], 0.f); v0[j] = a * a; v1[j] = b * b; }
                    *(u32x4*)(O + (size_t)row * ldo + colb + 32 * bj) = pack8(v0, v1); } }
    }
};
struct EpiGlu {
    static constexpr bool PERM = true;
    const bf16_t* Z; const float* bias; bf16_t* br;
    __device__ __forceinline__ void operator()(f32x4 (&acc)[2][2][4][2], const Unit& u, int wr, int wc, int fr, int fq) const {
        const int rowb = u.pm * BM + wr * 64 + fr, colb = u.pn * 256 + 64 * wc + 8 * fq;
#pragma unroll
        for (int bj = 0; bj < 2; ++bj) { const int c = colb + 32 * bj; const f32x4 b0 = *(const f32x4*)(bias + c), b1 = *(const f32x4*)(bias + c + 4);
#pragma unroll
            for (int ai = 0; ai < 2; ++ai)
#pragma unroll
                for (int m = 0; m < 4; ++m) { const int row = rowb + ai * HALF + m * 16;
                    const u32x4 zz = *(const u32x4*)(Z + (size_t)row * 512 + c);
                    f32x4 v0 = acc[ai][bj][m][0] + b0, v1 = acc[ai][bj][m][1] + b1;
                    v0[0] = bflo(zz.x) * fsigm(v0[0]); v0[1] = bfhi(zz.x) * fsigm(v0[1]); v0[2] = bflo(zz.y) * fsigm(v0[2]); v0[3] = bfhi(zz.y) * fsigm(v0[3]);
                    v1[0] = bflo(zz.z) * fsigm(v1[0]); v1[1] = bfhi(zz.z) * fsigm(v1[1]); v1[2] = bflo(zz.w) * fsigm(v1[2]); v1[3] = bfhi(zz.w) * fsigm(v1[3]);
                    *(u32x4*)(br + (size_t)row * D + 512 + c) = pack8(v0, v1); } }
    }
};
struct EpiBranch {
    static constexpr bool PERM = true;
    const bf16_t* proj; bf16_t* merged;
    __device__ __forceinline__ void operator()(f32x4 (&acc)[2][2][4][2], const Unit& u, int wr, int wc, int fr, int fq) const {
        const int rowb = u.pm * BM + wr * 64 + fr, colb = u.pn * 256 + 64 * wc + 8 * fq, kz = u.kz;
#pragma unroll
        for (int ai = 0; ai < 2; ++ai)
#pragma unroll
            for (int m = 0; m < 4; ++m) { const int row = rowb + ai * HALF + m * 16;
#pragma unroll
                for (int bj = 0; bj < 2; ++bj) { const int c = colb + 32 * bj;
                    const u32x4 gg = *(const u32x4*)(proj + (size_t)row * PJ + P_GATE + kz * D + c);
                    float g[8] = {bflo(gg.x), bfhi(gg.x), bflo(gg.y), bfhi(gg.y), bflo(gg.z), bfhi(gg.z), bflo(gg.w), bfhi(gg.w)};
                    if (kz < 3) { const u32x4 hh = *(const u32x4*)(proj + (size_t)row * PJ + P_GATE + (kz + 1) * D + c);
                        const float h[8] = {bflo(hh.x), bfhi(hh.x), bflo(hh.y), bfhi(hh.y), bflo(hh.z), bfhi(hh.z), bflo(hh.w), bfhi(hh.w)};
#pragma unroll
                        for (int j = 0; j < 8; ++j) g[j] = g[j] * __builtin_amdgcn_rcpf(fmaxf(h[j], 1e-30f)); }
                    f32x4& v0 = acc[ai][bj][m][0]; f32x4& v1 = acc[ai][bj][m][1];
                    v0[0] *= g[0]; v0[1] *= g[1]; v0[2] *= g[2]; v0[3] *= g[3]; v1[0] *= g[4]; v1[1] *= g[5]; v1[2] *= g[6]; v1[3] *= g[7];
                    if (kz == 3) *(u32x4*)(merged + (size_t)row * D + c) = pack8(v0, v1); } }
    }
};
struct EpiResid {
    static constexpr bool PERM = false;
    const float* xp; const float* xs; const float* modl; int g_off; float* xout;
    __device__ __forceinline__ void operator()(f32x4 (&acc)[2][2][4][2], const Unit& u, int wr, int wc, int fr, int fq) const {
        const int row0 = u.pm * BM, rowb = row0 + wr * 64 + fr, colb = u.pn * 256 + wc * 32 + 4 * fq;
        const float* xin = row0 < MP ? xp : xs - (size_t)MP * D;
        const float* gate = modl + (size_t)row_cvec(row0) * 6 * D + g_off;
        f32x4 gv[2][2];
#pragma unroll
        for (int bj = 0; bj < 2; ++bj)
#pragma unroll
            for (int n = 0; n < 2; ++n) gv[bj][n] = *(const f32x4*)(gate + colb + bj * HALF + n * 16);
#pragma unroll
        for (int ai = 0; ai < 2; ++ai)
#pragma unroll
            for (int m = 0; m < 4; ++m) { const size_t ro = (size_t)(rowb + ai * HALF + m * 16) * D + colb;
#pragma unroll
                for (int bj = 0; bj < 2; ++bj)
#pragma unroll
                    for (int n = 0; n < 2; ++n) { const size_t o = ro + bj * HALF + n * 16; *(f32x4*)(xout + o) = *(const f32x4*)(xin + o) + gv[bj][n] * acc[ai][bj][m][n]; } }
    }
};
}
namespace mk {
constexpr size_t AL(size_t x) { return (x + 255) & ~(size_t)255; }
constexpr size_t WS_CTL = 0, CTL_BYTES = 65536;
constexpr size_t WS_MOD = WS_CTL + CTL_BYTES;
constexpr size_t WS_W = AL(WS_MOD + (size_t)DEPTH * 5 * 6 * D * 4);
constexpr size_t W_IN = 0, W_GLU = W_IN + (size_t)NIN * D, W_BR = W_GLU + 512 * 512, W_OUT = W_BR + (size_t)4 * D * 512, W_1 = W_OUT + (size_t)D * D, W_2 = W_1 + (size_t)DFF * D,
                 W_LAYER = W_2 + (size_t)D * DFF;
constexpr size_t WS_H = AL(WS_W + W_LAYER * 2 * DEPTH);
constexpr size_t WS_PROJ = AL(WS_H + (size_t)M * D * 2);
constexpr size_t WS_SMALL = AL(WS_PROJ + (size_t)M * PJ * 2);
constexpr size_t WS_BR = AL(WS_SMALL + (size_t)M * 32 * 4);
constexpr size_t WS_MERGED = AL(WS_BR + (size_t)M * D * 2);
constexpr size_t WS_MACC = AL(WS_MERGED + (size_t)M * D * 2);
constexpr size_t WS_ZB = AL(WS_MACC + (size_t)M * D * 4);
constexpr size_t WS_SCR = AL(WS_ZB + (size_t)M * 512 * 2);
constexpr int LDS_BYTES = 140 * 1024, LDS_CTL = LDS_BYTES - 256;

struct Args { const float* in[43]; float* out; unsigned char* ws; int ph_lo, ph_hi; };

__device__ __forceinline__ float wave_sum(float v) {
#pragma unroll
    for (int o = 1; o < 64; o <<= 1) v += __shfl_xor(v, o);
    return v;
}
#define LDS_WAIT() asm volatile("s_waitcnt lgkmcnt(0)" ::: "memory")

__device__ __forceinline__ void xpose_item(const float* W, int ldw, int k0, int sc, bf16_t* dst, int K, LAS float* scr, int lane, int mode) {
    const int j = lane & 31;
    const int col = mode == 1 ? (j < 16 ? 3584 + j : 5648 + (j - 16)) : sc + j;
#pragma unroll 8
    for (int i = 0; i < 32; ++i) { const int kk = 2 * i + (lane >> 5); scr[kk * 33 + j] = mode == 2 ? 0.f : W[(size_t)(k0 + kk) * ldw + col]; }
    LDS_WAIT(); asm volatile("" ::: "memory");
    const int c = lane & 7;
#pragma unroll
    for (int jj = 0; jj < 4; ++jj) { const int n = (lane >> 3) + 8 * jj; const LAS float* s = scr + (8 * c) * 33 + n;
        u32x4 o; o.x = pk2(s[0 * 33], s[1 * 33]); o.y = pk2(s[2 * 33], s[3 * 33]); o.z = pk2(s[4 * 33], s[5 * 33]); o.w = pk2(s[6 * 33], s[7 * 33]);
        *(u32x4*)(dst + (size_t)n * K + k0 + 8 * c) = o; }
    LDS_WAIT(); asm volatile("" ::: "memory");
}
__device__ __forceinline__ int hm_col(int grp) { const int T = grp >> 3, q8 = grp & 7; return 256 * T + 32 * (2 * (q8 & 3) + (q8 >> 2)); }

__device__ __forceinline__ void prologue_convert(const Args& a, LAS unsigned char* lds, int gw, int ngw, int wave, int lane) {
    LAS float* scr = (LAS float*)(lds + wave * 8704);
    bf16_t* WB = (bf16_t*)(a.ws + WS_W);
    constexpr int I_IN = 440 * 32, I_GLU = 16 * 8, I_BR = 4 * 64 * 8, I_OUT = 64 * 32, I_1 = 256 * 32, I_2 = 64 * 128, I_L = I_IN + I_GLU + I_BR + I_OUT + I_1 + I_2;
    for (int it = gw; it < I_L * DEPTH; it += ngw) {
        const int l = it / I_L; int r = it - l * I_L; bf16_t* wl = WB + (size_t)l * W_LAYER;
        if (r < I_IN) { const int kb = r / 440, grp = r % 440, T = grp >> 3; int sc = hm_col(grp), mode = 0;
            if (T == 54) mode = (grp & 7) == 0 ? 1 : 2; else if (T >= 22) sc += 32; else if (T >= 14) sc += 16;
            xpose_item(a.in[16] + (size_t)l * D * 13856, 13856, 64 * kb, sc, wl + W_IN + (size_t)(32 * grp) * D, D, scr, lane, mode); continue; } r -= I_IN;
        if (r < I_GLU) { const int kb = r / 16, grp = r % 16; xpose_item(a.in[28] + (size_t)l * 512 * 512, 512, 64 * kb, hm_col(grp), wl + W_GLU + (size_t)(32 * grp) * 512, 512, scr, lane, 0); continue; } r -= I_GLU;
        if (r < I_BR) { const int k = r / 512, r2 = r % 512, kb = r2 / 64, grp = r2 % 64;
            xpose_item(a.in[39] + ((size_t)l * 4 + k) * 512 * D, D, 64 * kb, hm_col(grp), wl + W_BR + (size_t)k * D * 512 + (size_t)(32 * grp) * 512, 512, scr, lane, 0); continue; } r -= I_BR;
        if (r < I_OUT) { const int kb = r / 64, grp = r % 64; xpose_item(a.in[40] + (size_t)l * D * D, D, 64 * kb, 32 * grp, wl + W_OUT + (size_t)(32 * grp) * D, D, scr, lane, 0); continue; } r -= I_OUT;
        if (r < I_1) { const int kb = r / 256, grp = r % 256; xpose_item(a.in[41] + (size_t)l * D * DFF, DFF, 64 * kb, hm_col(grp), wl + W_1 + (size_t)(32 * grp) * D, D, scr, lane, 0); continue; } r -= I_1;
        { const int kb = r / 64, grp = r % 64; xpose_item(a.in[42] + (size_t)l * DFF * D, D, 64 * kb, 32 * grp, wl + W_2 + (size_t)(32 * grp) * DFF, DFF, scr, lane, 0); }
    }
}
__device__ __forceinline__ void prologue_ada(const Args& a, LAS unsigned char* lds, int tid) {
    LAS float* sl = (LAS float*)lds;
    LAS float* red = (LAS float*)(lds + 40960);
    float* mod = (float*)(a.ws + WS_MOD);
    for (int i = tid; i < 5 * D; i += NT) { const int j = i / D, k = i % D; const float x = j == 0 ? a.in[11][k] : a.in[10][(j - 1) * D + k]; sl[i] = x / (1.f + __expf(-x)); }
    __syncthreads();
    const int ks = tid >> 6, c = tid & 63;
    for (int unit = blockIdx.x; unit < DEPTH * 6 * D / 64; unit += gridDim.x) {
        const int l = unit / (6 * D / 64), n0 = (unit % (6 * D / 64)) * 64;
        const float* w = a.in[12] + (size_t)l * D * 6 * D + n0 + c;
        float acc[5] = {0.f, 0.f, 0.f, 0.f, 0.f};
#pragma unroll 4
        for (int k = ks * 256; k < ks * 256 + 256; ++k) { const float wv = w[(size_t)k * 6 * D];
#pragma unroll
            for (int j = 0; j < 5; ++j) acc[j] += sl[j * D + k] * wv; }
#pragma unroll
        for (int j = 0; j < 5; ++j) red[(ks * 5 + j) * 64 + c] = acc[j];
        __syncthreads();
        if (tid < 320) { const int j = tid >> 6; float s = 0.f;
#pragma unroll
            for (int q = 0; q < 8; ++q) s += red[(q * 5 + j) * 64 + c];
            mod[((size_t)l * 5 + j) * 6 * D + n0 + c] = s + a.in[13][l * 6 * D + n0 + c]; }
        __syncthreads();
    }
}
__device__ __forceinline__ void norm_phase(const float* xp, const float* xs, const float* g, const float* modl, int sh_off, int sc_off, bf16_t* H, int gw, int ngw, int lane_) {
    int lane = lane_; asm volatile("" : "+v"(lane));
    for (int row = gw; row < M; row += ngw) {
        const float* x = row < MP ? xp + (size_t)row * D : xs + (size_t)(row - MP) * D;
        f32x4 v[8]; float ss = 0.f;
#pragma unroll
        for (int j = 0; j < 8; ++j) { v[j] = *(const f32x4*)(x + 4 * (lane + 64 * j)); ss += (v[j][0] * v[j][0] + v[j][1] * v[j][1]) + (v[j][2] * v[j][2] + v[j][3] * v[j][3]); }
        const float r = rsqrtf(wave_sum(ss) * (1.f / D) + 1e-6f);
        const float* md = modl + (size_t)row_cvec(row) * 6 * D;
#pragma unroll
        for (int j = 0; j < 8; ++j) { const int i = 4 * (lane + 64 * j);
            const f32x4 gg = *(const f32x4*)(g + i), sc = *(const f32x4*)(md + sc_off + i), sh = *(const f32x4*)(md + sh_off + i);
            const f32x4 o = v[j] * r * gg * (sc + 1.f) + sh;
            u32x2 w; w.x = pk2(o[0], o[1]); w.y = pk2(o[2], o[3]); *(u32x2*)(H + (size_t)row * D + i) = w; }
    }
}

}
namespace mk {
constexpr size_t WS_NAT = AL(WS_SCR);
constexpr int NATP = 2048, N_XBC = 0, N_Q = 1024, N_K = 1536;
constexpr size_t WS_TR = AL(WS_NAT + (size_t)M * NATP * 2);
constexpr int T_X = 0, T_B = 512, T_K = 768, T_MV = 1280, T_V = 1792, TRR = 2304;
constexpr int NCH = 96;
constexpr size_t WS_MLC = AL(WS_TR + (size_t)TRR * M * 2);
constexpr size_t WS_MLN = AL(WS_MLC + (size_t)NCH * 4 * 2 * 16384 * 4);
constexpr size_t WS_MLS = AL(WS_MLN + (size_t)NCH * 4 * 2 * 128 * 4);
constexpr size_t WS_MLCS = AL(WS_MLS + (size_t)NCH * 4 * 2 * 4 * 4);
constexpr size_t WS_MLNS = AL(WS_MLCS + (size_t)NCH * 4 * 2 * 16384 * 2);
constexpr size_t WS_MLMS = AL(WS_MLNS + (size_t)NCH * 4 * 2 * 128 * 4);
constexpr size_t WS_OPT_END = AL(WS_MLMS + (size_t)NCH * 4 * 2 * 4);

__device__ __forceinline__ f32x4 mfma16(bf16x8 a, bf16x8 b, f32x4 c) { return __builtin_amdgcn_mfma_f32_16x16x32_bf16(a, b, c, 0, 0, 0); }
__device__ __forceinline__ void chunk_info(int ch, int& row0, int& seq0, int& L, int& lat, int& b, int& ci, int& nc) {
    if (ch < 32) { b = ch >> 1; ci = ch & 1; nc = 2; seq0 = b * 256; L = 256; lat = 0; } else { const int c2 = ch - 32; b = c2 >> 4; ci = c2 & 15; nc = 16; seq0 = MP + b * 2048; L = 2048; lat = 1; }
    row0 = seq0 + ci * 128;
}
__device__ __forceinline__ float fast_exp(float x) { return __expf(x); }

__device__ __forceinline__ void prep_phase(const Args& a, int layer, LAS unsigned char* lds, int gw_, int ngw, int wave, int lane_, bf16_t* UPk) {
    int lane = lane_, gw = gw_; asm volatile("" : "+v"(lane));
    const bf16_t* PROJ = (const bf16_t*)(a.ws + WS_PROJ); bf16_t* NAT = (bf16_t*)(a.ws + WS_NAT); bf16_t* TR = (bf16_t*)(a.ws + WS_TR);
    LAS bf16_t* tile = (LAS bf16_t*)(lds + wave * 16896); LAS bf16_t* otile = tile + 68 * 64;
    const int c = lane & 7, r8 = lane >> 3;
    const float* cw = a.in[30] + layer * 5 * 1024; const float* cb = a.in[31] + layer * 1024;
    for (int u = gw; u < 56 * 192; u += ngw) {
        const int cg = u / 192, tt = u % 192, m0 = tt * 64;
        const int lat = m0 >= MP; const int seq0 = lat ? MP + ((m0 - MP) / 2048) * 2048 : (m0 / 256) * 256, L = lat ? 2048 : 256, t0 = m0 - seq0;
        int kind, src, natcol = -1, trrow = -1;
        if (cg < 16) { kind = 0; src = P_XBC + 64 * cg; natcol = N_XBC + 64 * cg; if (cg < 12) trrow = T_X + 64 * cg; }
        else if (cg < 24) { kind = 1; src = P_MQ + 64 * (cg - 16); natcol = N_Q + 64 * (cg - 16); }
        else if (cg < 32) { kind = 2; src = P_MK + 64 * (cg - 24); natcol = N_K + 64 * (cg - 24); trrow = T_K + 64 * (cg - 24); }
        else if (cg < 40) { kind = 3; src = P_MV + 64 * (cg - 32); trrow = T_MV + 64 * (cg - 32); }
        else if (cg < 48) { kind = 3; src = P_V + 64 * (cg - 40); trrow = T_V + 64 * (cg - 40); }
        else { kind = 4; src = P_S5U + 64 * (cg - 48); }
        const int roff = kind == 0 ? -2 : 0, nrows = kind == 0 ? 68 : 64;
#pragma unroll
        for (int i = 0; i < 9; ++i) { const int r = r8 + 8 * i; if (r < nrows) { const int t = t0 + r + roff; u32x4 v = {0u, 0u, 0u, 0u};
                if (t >= 0 && t < L) v = *(const u32x4*)(PROJ + (size_t)(seq0 + t) * PJ + src + 8 * c);
                *(LAS u32x4*)(tile + r * 64 + 8 * c) = v; } }
        LDS_WAIT(); asm volatile("" ::: "memory");
#define PREP_EMIT(i_, r_) do { if (natcol >= 0) *(u32x4*)(NAT + (size_t)(m0 + r8 + 8 * (i_)) * NATP + natcol + 8 * c) = (r_); if (trrow >= 0) *(LAS u32x4*)(otile + (r8 + 8 * (i_)) * 64 + 8 * c) = (r_); } while (0)
        if (kind == 0) {
            float w[5][8], bz[8];
#pragma unroll
            for (int e = 0; e < 8; ++e) { bz[e] = cb[64 * cg + 8 * c + e];
#pragma unroll
                for (int j = 0; j < 5; ++j) w[j][e] = cw[j * 1024 + 64 * cg + 8 * c + e]; }
#pragma unroll 2
            for (int i = 0; i < 8; ++i) { const int tk = r8 + 8 * i; float acc[8];
#pragma unroll
                for (int e = 0; e < 8; ++e) acc[e] = bz[e];
#pragma unroll
                for (int j = 0; j < 5; ++j) { const u32x4 v = *(const LAS u32x4*)(tile + (tk + j) * 64 + 8 * c);
                    acc[0] += bflo(v.x) * w[j][0]; acc[1] += bfhi(v.x) * w[j][1]; acc[2] += bflo(v.y) * w[j][2]; acc[3] += bfhi(v.y) * w[j][3];
                    acc[4] += bflo(v.z) * w[j][4]; acc[5] += bfhi(v.z) * w[j][5]; acc[6] += bflo(v.w) * w[j][6]; acc[7] += bfhi(v.w) * w[j][7]; }
#pragma unroll
                for (int e = 0; e < 8; ++e) acc[e] = fsilu(acc[e]);
                u32x4 rv; rv.x = pk2(acc[0], acc[1]); rv.y = pk2(acc[2], acc[3]); rv.z = pk2(acc[4], acc[5]); rv.w = pk2(acc[6], acc[7]); PREP_EMIT(i, rv); }
        } else if (kind == 4) {
#pragma unroll
            for (int i = 0; i < 8; ++i) { const int tk = r8 + 8 * i, m = m0 + tk; const u32x4 v = *(const LAS u32x4*)(tile + tk * 64 + 8 * c);
                *(u32x4*)(UPk + ((size_t)(4 * (cg - 48) + (c >> 1)) * 384 + (m >> 5)) * 512 + (m & 31) * 16 + 8 * (c & 1)) = v; }
        } else if (kind == 3 || !lat) {
            const float sc = kind == 2 ? 0.08838834764831845f : 1.f;
#pragma unroll
            for (int i = 0; i < 8; ++i) { const u32x4 v = *(const LAS u32x4*)(tile + (r8 + 8 * i) * 64 + 8 * c);
                u32x4 rv = v;
                if (kind == 2) { rv.x = pk2(bflo(v.x) * sc, bfhi(v.x) * sc); rv.y = pk2(bflo(v.y) * sc, bfhi(v.y) * sc); rv.z = pk2(bflo(v.z) * sc, bfhi(v.z) * sc); rv.w = pk2(bflo(v.w) * sc, bfhi(v.w) * sc); }
                PREP_EMIT(i, rv); }
        } else {
            const float sc = kind == 2 ? 0.08838834764831845f : 1.f; const int odd = cg & 1;
            float inv[8];
#pragma unroll
            for (int e = 0; e < 8; ++e) inv[e] = exp2f(-(float)(8 * (c & 3) + e) * (13.287712379549449f / 32.f));
#pragma unroll
            for (int i = 0; i < 8; ++i) { const int tk = r8 + 8 * i, t = t0 + tk; const float pos = odd ? (float)(t & 63) : (float)(t >> 6);
                const u32x4 vo = *(const LAS u32x4*)(tile + tk * 64 + 8 * c), vp = *(const LAS u32x4*)(tile + tk * 64 + 8 * (c ^ 4));
                float o[8], p[8], rr[8];
                o[0] = bflo(vo.x); o[1] = bfhi(vo.x); o[2] = bflo(vo.y); o[3] = bfhi(vo.y); o[4] = bflo(vo.z); o[5] = bfhi(vo.z); o[6] = bflo(vo.w); o[7] = bfhi(vo.w);
                p[0] = bflo(vp.x); p[1] = bfhi(vp.x); p[2] = bflo(vp.y); p[3] = bfhi(vp.y); p[4] = bflo(vp.z); p[5] = bfhi(vp.z); p[6] = bflo(vp.w); p[7] = bfhi(vp.w);
#pragma unroll
                for (int e = 0; e < 8; ++e) { const float ang = pos * inv[e], cs = __cosf(ang), sn = __sinf(ang);
                    rr[e] = (c < 4 ? o[e] * cs - p[e] * sn : p[e] * sn + o[e] * cs) * sc; }
                u32x4 rv; rv.x = pk2(rr[0], rr[1]); rv.y = pk2(rr[2], rr[3]); rv.z = pk2(rr[4], rr[5]); rv.w = pk2(rr[6], rr[7]); PREP_EMIT(i, rv); }
        }
        if (trrow >= 0) {
            LDS_WAIT(); asm volatile("" ::: "memory");
            bf16_t* dst = TR + (size_t)(trrow + lane) * M + m0;
#pragma unroll
            for (int j = 0; j < 8; ++j) { unsigned wv[4];
#pragma unroll
                for (int q = 0; q < 4; ++q) { const unsigned lo = otile[(8 * j + 2 * q) * 64 + lane], hi = otile[(8 * j + 2 * q + 1) * 64 + lane]; wv[q] = lo | (hi << 16); }
                u32x4 o; o.x = wv[0]; o.y = wv[1]; o.z = wv[2]; o.w = wv[3]; *(u32x4*)(dst + 8 * j) = o; }
        }
        LDS_WAIT(); asm volatile("" ::: "memory");
    }
}

struct MlGate { float lf0, lf1, ig0, ig1, P0, P1, tot; };
__device__ __forceinline__ float wave_incl_scan(float v, int lane) {
#pragma unroll
    for (int o = 1; o < 64; o <<= 1) { const float t = __shfl_up(v, o); if (lane >= o) v += t; }
    return v;
}
__device__ __forceinline__ float wave_max(float v) {
#pragma unroll
    for (int o = 1; o < 64; o <<= 1) v = fmaxf(v, __shfl_xor(v, o));
    return v;
}
__device__ __forceinline__ MlGate ml_gates(const Args& a, int layer, int row0, int hh, int dir, int lane) {
    const float* SMALL = (const float*)(a.ws + WS_SMALL);
    const float ib = a.in[36][layer * 8 + dir * 4 + hh], fb = a.in[37][layer * 8 + dir * 4 + hh];
    MlGate g;
    const float f0 = SMALL[(size_t)(row0 + lane) * 32 + S_MF + dir * 4 + hh] + fb, f1 = SMALL[(size_t)(row0 + lane + 64) * 32 + S_MF + dir * 4 + hh] + fb;
    g.ig0 = SMALL[(size_t)(row0 + lane) * 32 + S_MI + dir * 4 + hh] + ib; g.ig1 = SMALL[(size_t)(row0 + lane + 64) * 32 + S_MI + dir * 4 + hh] + ib;
    g.lf0 = fminf(f0, 0.f) - log1pf(__expf(-fabsf(f0))); g.lf1 = fminf(f1, 0.f) - log1pf(__expf(-fabsf(f1)));
    const float s0 = wave_incl_scan(g.lf0, lane); const float tot0 = __shfl(s0, 63);
    const float s1 = wave_incl_scan(g.lf1, lane) + tot0;
    g.P0 = s0; g.P1 = s1; g.tot = __shfl(s1, 63);
    return g;
}

__device__ __forceinline__ void ml_states_phase(const Args& a, int layer, int tid_, int G) {
    int tid = tid_; asm volatile("" : "+v"(tid));
    const int lane = tid & 63, wave = __builtin_amdgcn_readfirstlane(tid >> 6), fr = lane & 15, fq = lane >> 4;
    const bf16_t* TR = (const bf16_t*)(a.ws + WS_TR);
    float* MLC = (float*)(a.ws + WS_MLC); float* MLN = (float*)(a.ws + WS_MLN); float* MLS = (float*)(a.ws + WS_MLS);
    for (int u = blockIdx.x; u < NCH * 4; u += G) {
        const int ch = u >> 2, hh = u & 3; int row0, seq0, L, lat, b, ci, nc; chunk_info(ch, row0, seq0, L, lat, b, ci, nc);
#pragma unroll
        for (int dir = 0; dir < 2; ++dir) {
            const MlGate g = ml_gates(a, layer, row0, hh, dir, lane);
            const float w0 = (dir == 0 ? g.tot - g.P0 : g.P0 - g.lf0) + g.ig0, w1 = (dir == 0 ? g.tot - g.P1 : g.P1 - g.lf1) + g.ig1;
            const float mloc = wave_max(fmaxf(w0, w1));
            const float e0 = __expf(w0 - mloc), e1 = __expf(w1 - mloc);
            f32x4 acc[8];
#pragma unroll
            for (int j = 0; j < 8; ++j) acc[j] = (f32x4){0.f, 0.f, 0.f, 0.f};
            float nacc[8];
#pragma unroll
            for (int j = 0; j < 8; ++j) nacc[j] = 0.f;
            const bf16_t* vrow = TR + (size_t)(T_MV + hh * 128 + wave * 16 + fr) * M + row0 + 8 * fq;
#pragma unroll
            for (int ks = 0; ks < 4; ++ks) {
                const bf16x8 af = *(const bf16x8*)(vrow + 32 * ks);
                float ev[8];
#pragma unroll
                for (int j = 0; j < 8; ++j) { const int tok = 32 * ks + 8 * fq + j; const float x0 = __shfl(e0, tok & 63), x1 = __shfl(e1, tok & 63); ev[j] = tok < 64 ? x0 : x1; }
#pragma unroll
                for (int jt = 0; jt < 8; ++jt) {
                    const u32x4 kv = *(const u32x4*)(TR + (size_t)(T_K + hh * 128 + jt * 16 + fr) * M + row0 + 32 * ks + 8 * fq);
                    const float k0 = bflo(kv.x) * ev[0], k1 = bfhi(kv.x) * ev[1], k2 = bflo(kv.y) * ev[2], k3 = bfhi(kv.y) * ev[3], k4 = bflo(kv.z) * ev[4], k5 = bfhi(kv.z) * ev[5], k6 = bflo(kv.w) * ev[6], k7 = bfhi(kv.w) * ev[7];
                    if (wave == 0) nacc[jt] += ((k0 + k1) + (k2 + k3)) + ((k4 + k5) + (k6 + k7));
                    u32x4 kb; kb.x = pk2(k0, k1); kb.y = pk2(k2, k3); kb.z = pk2(k4, k5); kb.w = pk2(k6, k7);
                    acc[jt] = mfma16(af, __builtin_bit_cast(bf16x8, kb), acc[jt]);
                }
            }
            float* cdst = MLC + ((size_t)(ch * 4 + hh) * 2 + dir) * 16384;
#pragma unroll
            for (int jt = 0; jt < 8; ++jt)
#pragma unroll
                for (int i = 0; i < 4; ++i) cdst[(size_t)(wave * 16 + 4 * fq + i) * 128 + jt * 16 + fr] = acc[jt][i];
            if (wave == 0) {
#pragma unroll
                for (int jt = 0; jt < 8; ++jt) { float v = nacc[jt]; v += __shfl_xor(v, 16); v += __shfl_xor(v, 32); if (fq == 0) MLN[((size_t)(ch * 4 + hh) * 2 + dir) * 128 + jt * 16 + fr] = v; }
                if (lane == 0) { MLS[((size_t)(ch * 4 + hh) * 2 + dir) * 4 + 0] = mloc; MLS[((size_t)(ch * 4 + hh) * 2 + dir) * 4 + 1] = g.tot; }
            }
        }
    }
}
__device__ __forceinline__ void ml_scan_phase(const Args& a, int layer, int tid_, int G) {
    int tid = tid_; asm volatile("" : "+v"(tid));
    const float* MLC = (const float*)(a.ws + WS_MLC); const float* MLN = (const float*)(a.ws + WS_MLN); const float* MLS = (const float*)(a.ws + WS_MLS);
    bf16_t* CS = (bf16_t*)(a.ws + WS_MLCS); float* NS = (float*)(a.ws + WS_MLNS); float* MS = (float*)(a.ws + WS_MLMS);
    for (int task = blockIdx.x; task < 256; task += G) {
        int lat, b, hh, dir, part, nparts;
        if (task < 128) { lat = 1; part = task & 3; dir = (task >> 2) & 1; hh = (task >> 3) & 3; b = task >> 5; nparts = 4; }
        else { const int t2 = task - 128; lat = 0; part = 0; dir = t2 & 1; hh = (t2 >> 1) & 3; b = t2 >> 3; nparts = 1; }
        const int nc = lat ? 16 : 2, ch0 = lat ? 32 + b * 16 : b * 2;
        const int nel = 16384 / nparts, e0 = part * nel, per = nel / NT;
        float c[32]; float n = 0.f, m = 0.f;
        const size_t so = (((size_t)b * DEPTH + layer) * 2 + dir) * 4 + hh;
#pragma unroll
        for (int i = 0; i < 32; ++i) if (i < per) { const int e = e0 + i * NT + tid, vd = e >> 7, kd = e & 127; c[i] = lat ? a.in[7][(so * 128 + kd) * 128 + vd] : 0.f; }
        if (tid < 128) n = lat ? a.in[8][so * 128 + tid] : 0.f;
        m = lat ? a.in[9][so] : 0.f;
        for (int s = 0; s < nc; ++s) { const int ci = dir ? nc - 1 - s : s, ch = ch0 + ci; const size_t sb = (size_t)(ch * 4 + hh) * 2 + dir;
#pragma unroll
            for (int i = 0; i < 32; ++i) if (i < per) CS[sb * 16384 + e0 + i * NT + tid] = f2bf(c[i]);
            if (part == 0) { if (tid < 128) NS[sb * 128 + tid] = n; if (tid == 0) MS[sb] = m; }
            const float ml = MLS[sb * 4 + 0], bl = MLS[sb * 4 + 1];
            const float mn = fmaxf(bl + m, ml), fa = __expf(bl + m - mn), fb = __expf(ml - mn);
#pragma unroll
            for (int i = 0; i < 32; ++i) if (i < per) c[i] = fa * c[i] + fb * MLC[sb * 16384 + e0 + i * NT + tid];
            if (tid < 128) n = fa * n + fb * MLN[sb * 128 + tid];
            m = mn; }
        if (!lat) {
#pragma unroll
            for (int i = 0; i < 32; ++i) if (i < per) { const int e = e0 + i * NT + tid, vd = e >> 7, kd = e & 127; a.out[O_MLC + (so * 128 + kd) * 128 + vd] = c[i]; }
            if (tid < 128) a.out[O_MLN + so * 128 + tid] = n; if (tid == 0) a.out[O_MLM + so] = m; }
    }
}
__device__ __forceinline__ void ml_out_phase(const Args& a, int layer, LAS unsigned char* lds, int tid_, int G) {
    int tid = tid_; asm volatile("" : "+v"(tid));
    const int lane = tid & 63, wave = __builtin_amdgcn_readfirstlane(tid >> 6), fr = lane & 15, fq = lane >> 4;
    const bf16_t* NAT = (const bf16_t*)(a.ws + WS_NAT); const bf16_t* TR = (const bf16_t*)(a.ws + WS_TR); const bf16_t* PROJ = (const bf16_t*)(a.ws + WS_PROJ);
    const bf16_t* CS = (const bf16_t*)(a.ws + WS_MLCS); const float* NS = (const float*)(a.ws + WS_MLNS); const float* MS = (const float*)(a.ws + WS_MLMS);
    bf16_t* BR = (bf16_t*)(a.ws + WS_BR);
    LAS float* U = (LAS float*)lds; LAS float* Wv = U + 128; LAS float* SI = U + 256; LAS float* EM = U + 384; LAS float* NSs = U + 512;
    for (int u = blockIdx.x; u < NCH * 4; u += G) {
        const int ch = u >> 2, hh = u & 3; int row0, seq0, L, lat, b, ci, nc; chunk_info(ch, row0, seq0, L, lat, b, ci, nc);
        const int t = wave * 16 + fr;
        bf16x8 qf[4];
#pragma unroll
        for (int ks = 0; ks < 4; ++ks) qf[ks] = *(const bf16x8*)(NAT + (size_t)(row0 + t) * NATP + N_Q + hh * 128 + 32 * ks + 8 * fq);
        f32x4 hsum[8];
#pragma unroll
        for (int j = 0; j < 8; ++j) hsum[j] = (f32x4){0.f, 0.f, 0.f, 0.f};
#pragma unroll 1
        for (int dir = 0; dir < 2; ++dir) {
            const size_t sb = (size_t)(ch * 4 + hh) * 2 + dir;
            __syncthreads();
            if (wave == 0) {
                const MlGate g = ml_gates(a, layer, row0, hh, dir, lane); const float ms = MS[sb];
                float u0, u1, c0, c1, ai0, ai1;
                if (dir == 0) { u0 = g.ig0 - g.P0; u1 = g.ig1 - g.P1; c0 = g.P0; c1 = g.P1; ai0 = g.P0 + ms; ai1 = g.P1 + ms; }
                else { const float E0 = g.P0 - g.lf0, E1 = g.P1 - g.lf1; u0 = E0 + g.ig0; u1 = E1 + g.ig1; c0 = -E0; c1 = -E1; ai0 = g.tot - E0 + ms; ai1 = g.tot - E1 + ms; }
                float g0 = u0, g1 = u1;
                if (dir == 0) {
#pragma unroll
                    for (int o = 1; o < 64; o <<= 1) { const float x0 = __shfl_up(g0, o), x1 = __shfl_up(g1, o); if (lane >= o) { g0 = fmaxf(g0, x0); g1 = fmaxf(g1, x1); } }
                    g1 = fmaxf(g1, __shfl(g0, 63));
                } else {
#pragma unroll
                    for (int o = 1; o < 64; o <<= 1) { const float x0 = __shfl_down(g0, o), x1 = __shfl_down(g1, o); if (lane + o < 64) { g0 = fmaxf(g0, x0); g1 = fmaxf(g1, x1); } }
                    g0 = fmaxf(g0, __shfl(g1, 0));
                }
                const float mt0 = fmaxf(ai0, c0 + g0), mt1 = fmaxf(ai1, c1 + g1);
                U[lane] = u0; U[lane + 64] = u1; Wv[lane] = c0 - mt0; Wv[lane + 64] = c1 - mt1;
                SI[lane] = __expf(ai0 - mt0); SI[lane + 64] = __expf(ai1 - mt1); EM[lane] = __expf(-mt0); EM[lane + 64] = __expf(-mt1);
                NSs[lane] = NS[sb * 128 + lane]; NSs[lane + 64] = NS[sb * 128 + lane + 64];
            }
            __syncthreads();
            const float wt = Wv[t], sit = SI[t], emt = EM[t];
            f32x4 acc[8];
#pragma unroll
            for (int j = 0; j < 8; ++j) acc[j] = (f32x4){0.f, 0.f, 0.f, 0.f};
#pragma unroll
            for (int ks = 0; ks < 4; ++ks)
#pragma unroll
                for (int j = 0; j < 8; ++j) { const bf16x8 cf = *(const bf16x8*)(CS + sb * 16384 + (size_t)(16 * j + fr) * 128 + 32 * ks + 8 * fq); acc[j] = mfma16(cf, qf[ks], acc[j]); }
            float qn = 0.f;
#pragma unroll
            for (int ks = 0; ks < 4; ++ks) { const u32x4 qv = __builtin_bit_cast(u32x4, qf[ks]); const LAS float* nn = NSs + 32 * ks + 8 * fq;
                qn += bflo(qv.x) * nn[0] + bfhi(qv.x) * nn[1] + bflo(qv.y) * nn[2] + bfhi(qv.y) * nn[3] + bflo(qv.z) * nn[4] + bfhi(qv.z) * nn[5] + bflo(qv.w) * nn[6] + bfhi(qv.w) * nn[7]; }
            qn += __shfl_xor(qn, 16); qn += __shfl_xor(qn, 32);
#pragma unroll
            for (int j = 0; j < 8; ++j) acc[j] *= sit;
            float den = sit * qn;
            const int jlo = dir == 0 ? 0 : (wave >> 1), jhi = dir == 0 ? (wave >> 1) : 3;
            float psum = 0.f;
            for (int jp = jlo; jp <= jhi; ++jp) {
                const int ta = 32 * jp + 8 * (fr >> 2) + (fr & 3);
                f32x4 sa = (f32x4){0.f, 0.f, 0.f, 0.f}, sb2 = (f32x4){0.f, 0.f, 0.f, 0.f};
#pragma unroll
                for (int ks = 0; ks < 4; ++ks) {
                    const bf16x8 ka = *(const bf16x8*)(NAT + (size_t)(row0 + ta) * NATP + N_K + hh * 128 + 32 * ks + 8 * fq);
                    const bf16x8 kb = *(const bf16x8*)(NAT + (size_t)(row0 + ta + 4) * NATP + N_K + hh * 128 + 32 * ks + 8 * fq);
                    sa = mfma16(ka, qf[ks], sa); sb2 = mfma16(kb, qf[ks], sb2); }
                float pa[4], pb[4];
#pragma unroll
                for (int i = 0; i < 4; ++i) { const int s0 = 32 * jp + 8 * fq + i, s1 = s0 + 4;
                    const bool ok0 = dir == 0 ? s0 <= t : s0 >= t, ok1 = dir == 0 ? s1 <= t : s1 >= t;
                    pa[i] = ok0 ? sa[i] * __expf(U[s0] + wt) : 0.f; pb[i] = ok1 ? sb2[i] * __expf(U[s1] + wt) : 0.f;
                    psum += pa[i] + pb[i]; }
                u32x4 pw; pw.x = pk2(pa[0], pa[1]); pw.y = pk2(pa[2], pa[3]); pw.z = pk2(pb[0], pb[1]); pw.w = pk2(pb[2], pb[3]);
                const bf16x8 pf = __builtin_bit_cast(bf16x8, pw);
#pragma unroll
                for (int j = 0; j < 8; ++j) { const bf16x8 vf = *(const bf16x8*)(TR + (size_t)(T_MV + hh * 128 + 16 * j + fr) * M + row0 + 32 * jp + 8 * fq); acc[j] = mfma16(vf, pf, acc[j]); }
            }
            psum += __shfl_xor(psum, 16); psum += __shfl_xor(psum, 32);
            den += psum;
            const float rden = 1.f / fmaxf(fabsf(den), emt);
#pragma unroll
            for (int j = 0; j < 8; ++j) hsum[j] += acc[j] * rden;
        }
        float ss = 0.f;
#pragma unroll
        for (int j = 0; j < 8; ++j) ss += (hsum[j][0] * hsum[j][0] + hsum[j][1] * hsum[j][1]) + (hsum[j][2] * hsum[j][2] + hsum[j][3] * hsum[j][3]);
        ss += __shfl_xor(ss, 16); ss += __shfl_xor(ss, 32);
        const float r = rsqrtf(ss * (1.f / 128.f) + 1e-6f);
        const float* ng = a.in[38] + layer * 512 + hh * 128;
#pragma unroll
        for (int j = 0; j < 8; ++j) { const int vd = 16 * j + 4 * fq; const f32x4 gg = *(const f32x4*)(ng + vd);
            const u32x2 ov = *(const u32x2*)(PROJ + (size_t)(row0 + t) * PJ + P_MO + hh * 128 + vd);
            const float o0 = hsum[j][0] * r * gg[0] * fsigm(bflo(ov.x)), o1 = hsum[j][1] * r * gg[1] * fsigm(bfhi(ov.x)), o2 = hsum[j][2] * r * gg[2] * fsigm(bflo(ov.y)), o3 = hsum[j][3] * r * gg[3] * fsigm(bfhi(ov.y));
            u32x2 w; w.x = pk2(o0, o1); w.y = pk2(o2, o3); *(u32x2*)(BR + (size_t)(row0 + t) * D + 1536 + hh * 128 + vd) = w; }
    }
}
}
namespace mk {
constexpr size_t WS_SST = WS_OPT_END;
constexpr size_t WS_SSL = AL(WS_SST + (size_t)NCH * 8 * 2 * 8192 * 4);
constexpr size_t WS_SSCS = AL(WS_SSL + (size_t)NCH * 8 * 2 * 4);
constexpr size_t WS_YPRE = AL(WS_SSCS + (size_t)NCH * 8 * 2 * 8192 * 2);
constexpr size_t WS_SSQ = AL(WS_YPRE + (size_t)M * 512 * 4);
constexpr size_t WS_SSD_END = AL(WS_SSQ + (size_t)M * 8 * 4);

struct SsdGate { float dt0, dt1, la0, la1, P0, P1, tot; };
__device__ __forceinline__ SsdGate ssd_gates(const Args& a, int layer, int row0, int hh, int dir, int lane) {
    const float* SMALL = (const float*)(a.ws + WS_SMALL);
    const float bias = a.in[32][layer * 16 + dir * 8 + hh], A = -__expf(a.in[33][layer * 16 + dir * 8 + hh]);
    SsdGate g;
    const float x0 = SMALL[(size_t)(row0 + lane) * 32 + S_DT + dir * 8 + hh] + bias, x1 = SMALL[(size_t)(row0 + lane + 64) * 32 + S_DT + dir * 8 + hh] + bias;
    g.dt0 = fmaxf(x0, 0.f) + log1pf(__expf(-fabsf(x0))); g.dt1 = fmaxf(x1, 0.f) + log1pf(__expf(-fabsf(x1)));
    g.la0 = g.dt0 * A; g.la1 = g.dt1 * A;
    const float s0 = wave_incl_scan(g.la0, lane); const float t0 = __shfl(s0, 63);
    const float s1 = wave_incl_scan(g.la1, lane) + t0;
    g.P0 = s0; g.P1 = s1; g.tot = __shfl(s1, 63);
    return g;
}
__device__ __forceinline__ void ssd_states_phase(const Args& a, int layer, int tid_, int G) {
    int tid = tid_; asm volatile("" : "+v"(tid));
    const int lane = tid & 63, wave = __builtin_amdgcn_readfirstlane(tid >> 6), fr = lane & 15, fq = lane >> 4;
    const bf16_t* TR = (const bf16_t*)(a.ws + WS_TR); float* SST = (float*)(a.ws + WS_SST); float* SSL = (float*)(a.ws + WS_SSL);
    for (int u = blockIdx.x; u < NCH * 8; u += G) {
        const int ch = u >> 3, hh = u & 7, grp = hh >> 2; int row0, seq0, L, lat, b, ci, nc; chunk_info(ch, row0, seq0, L, lat, b, ci, nc);
#pragma unroll
        for (int dir = 0; dir < 2; ++dir) {
            const SsdGate g = ssd_gates(a, layer, row0, hh, dir, lane);
            const float w0 = g.dt0 * __expf(dir == 0 ? g.tot - g.P0 : g.P0 - g.la0), w1 = g.dt1 * __expf(dir == 0 ? g.tot - g.P1 : g.P1 - g.la1);
            f32x4 acc[4];
#pragma unroll
            for (int j = 0; j < 4; ++j) acc[j] = (f32x4){0.f, 0.f, 0.f, 0.f};
#pragma unroll
            for (int ks = 0; ks < 4; ++ks) {
                float ev[8];
#pragma unroll
                for (int j = 0; j < 8; ++j) { const int tok = 32 * ks + 8 * fq + j; const float y0 = __shfl(w0, tok & 63), y1 = __shfl(w1, tok & 63); ev[j] = tok < 64 ? y0 : y1; }
                const u32x4 bv = *(const u32x4*)(TR + (size_t)(T_B + grp * 128 + wave * 16 + fr) * M + row0 + 32 * ks + 8 * fq);
                u32x4 bw; bw.x = pk2(bflo(bv.x) * ev[0], bfhi(bv.x) * ev[1]); bw.y = pk2(bflo(bv.y) * ev[2], bfhi(bv.y) * ev[3]); bw.z = pk2(bflo(bv.z) * ev[4], bfhi(bv.z) * ev[5]); bw.w = pk2(bflo(bv.w) * ev[6], bfhi(bv.w) * ev[7]);
                const bf16x8 bf = __builtin_bit_cast(bf16x8, bw);
#pragma unroll
                for (int j = 0; j < 4; ++j) { const bf16x8 xf = *(const bf16x8*)(TR + (size_t)(T_X + hh * 64 + 16 * j + fr) * M + row0 + 32 * ks + 8 * fq); acc[j] = mfma16(xf, bf, acc[j]); }
            }
            float* dst = SST + ((size_t)(ch * 8 + hh) * 2 + dir) * 8192;
#pragma unroll
            for (int j = 0; j < 4; ++j)
#pragma unroll
                for (int i = 0; i < 4; ++i) dst[(size_t)(16 * j + 4 * fq + i) * 128 + wave * 16 + fr] = acc[j][i];
            if (tid == 0) SSL[(size_t)(ch * 8 + hh) * 2 + dir] = g.tot;
        }
    }
}
__device__ __forceinline__ void ssd_scan_phase(const Args& a, int layer, int tid_, int G) {
    int tid = tid_; asm volatile("" : "+v"(tid));
    const float* SST = (const float*)(a.ws + WS_SST); const float* SSL = (const float*)(a.ws + WS_SSL); bf16_t* CS = (bf16_t*)(a.ws + WS_SSCS);
    for (int task = blockIdx.x; task < 384; task += G) {
        int lat, b, hh, dir, part, nparts;
        if (task < 128) { lat = 1; part = task & 1; dir = (task >> 1) & 1; hh = (task >> 2) & 7; b = task >> 5; nparts = 2; }
        else { const int t2 = task - 128; lat = 0; part = 0; dir = t2 & 1; hh = (t2 >> 1) & 7; b = t2 >> 4; nparts = 1; }
        const int nc = lat ? 16 : 2, ch0 = lat ? 32 + b * 16 : b * 2;
        const int nel = 8192 / nparts, e0 = part * nel, per = nel / NT;
        float c[16];
        const size_t so = ((((size_t)b * DEPTH + layer) * 2 + dir) * 8 + hh) * 8192;
#pragma unroll
        for (int i = 0; i < 16; ++i) if (i < per) c[i] = lat ? a.in[6][so + e0 + i * NT + tid] : 0.f;
        for (int s = 0; s < nc; ++s) { const int ci = dir ? nc - 1 - s : s, ch = ch0 + ci; const size_t sb = (size_t)(ch * 8 + hh) * 2 + dir;
#pragma unroll
            for (int i = 0; i < 16; ++i) if (i < per) CS[sb * 8192 + e0 + i * NT + tid] = f2bf(c[i]);
            const float dec = __expf(SSL[sb]);
#pragma unroll
            for (int i = 0; i < 16; ++i) if (i < per) c[i] = dec * c[i] + SST[sb * 8192 + e0 + i * NT + tid]; }
        if (!lat) {
#pragma unroll
            for (int i = 0; i < 16; ++i) if (i < per) a.out[O_SSD + so + e0 + i * NT + tid] = c[i]; }
    }
}
__device__ __forceinline__ void ssd_out_phase(const Args& a, int layer, LAS unsigned char* lds, int tid_, int G) {
    int tid = tid_; asm volatile("" : "+v"(tid));
    const int lane = tid & 63, wave = __builtin_amdgcn_readfirstlane(tid >> 6), fr = lane & 15, fq = lane >> 4;
    const bf16_t* NAT = (const bf16_t*)(a.ws + WS_NAT); const bf16_t* TR = (const bf16_t*)(a.ws + WS_TR); const bf16_t* PROJ = (const bf16_t*)(a.ws + WS_PROJ);
    const bf16_t* CS = (const bf16_t*)(a.ws + WS_SSCS); float* YPRE = (float*)(a.ws + WS_YPRE); float* SSQ = (float*)(a.ws + WS_SSQ);
    LAS float* U = (LAS float*)(lds + 4096); LAS float* Wv = U + 128; LAS float* DT = U + 256; LAS float* EO = U + 384;
    for (int u = blockIdx.x; u < NCH * 8; u += G) {
        const int ch = u >> 3, hh = u & 7, grp = hh >> 2; int row0, seq0, L, lat, b, ci, nc; chunk_info(ch, row0, seq0, L, lat, b, ci, nc);
        const int t = wave * 16 + fr;
        bf16x8 cf[4];
#pragma unroll
        for (int ks = 0; ks < 4; ++ks) cf[ks] = *(const bf16x8*)(NAT + (size_t)(row0 + t) * NATP + N_XBC + 768 + grp * 128 + 32 * ks + 8 * fq);
        f32x4 ysum[4];
#pragma unroll
        for (int j = 0; j < 4; ++j) ysum[j] = (f32x4){0.f, 0.f, 0.f, 0.f};
#pragma unroll 1
        for (int dir = 0; dir < 2; ++dir) {
            const size_t sb = (size_t)(ch * 8 + hh) * 2 + dir;
            __syncthreads();
            if (wave == 0) {
                const SsdGate g = ssd_gates(a, layer, row0, hh, dir, lane);
                if (dir == 0) { U[lane] = -g.P0; U[lane + 64] = -g.P1; Wv[lane] = g.P0; Wv[lane + 64] = g.P1; EO[lane] = __expf(g.P0); EO[lane + 64] = __expf(g.P1); }
                else { const float E0 = g.P0 - g.la0, E1 = g.P1 - g.la1; U[lane] = E0; U[lane + 64] = E1; Wv[lane] = -E0; Wv[lane + 64] = -E1; EO[lane] = __expf(g.tot - E0); EO[lane + 64] = __expf(g.tot - E1); }
                DT[lane] = g.dt0; DT[lane + 64] = g.dt1;
            }
            __syncthreads();
            const float wt = Wv[t], eot = EO[t];
            f32x4 acc[4];
#pragma unroll
            for (int j = 0; j < 4; ++j) acc[j] = (f32x4){0.f, 0.f, 0.f, 0.f};
#pragma unroll
            for (int ks = 0; ks < 4; ++ks)
#pragma unroll
                for (int j = 0; j < 4; ++j) { const bf16x8 sf = *(const bf16x8*)(CS + sb * 8192 + (size_t)(16 * j + fr) * 128 + 32 * ks + 8 * fq); acc[j] = mfma16(sf, cf[ks], acc[j]); }
#pragma unroll
            for (int j = 0; j < 4; ++j) acc[j] *= eot;
            const int jlo = dir == 0 ? 0 : (wave >> 1), jhi = dir == 0 ? (wave >> 1) : 3;
            for (int jp = jlo; jp <= jhi; ++jp) {
                const int ta = 32 * jp + 8 * (fr >> 2) + (fr & 3);
                f32x4 sa = (f32x4){0.f, 0.f, 0.f, 0.f}, sb2 = (f32x4){0.f, 0.f, 0.f, 0.f};
#pragma unroll
                for (int ks = 0; ks < 4; ++ks) {
                    const bf16x8 ba = *(const bf16x8*)(NAT + (size_t)(row0 + ta) * NATP + N_XBC + 512 + grp * 128 + 32 * ks + 8 * fq);
                    const bf16x8 bb = *(const bf16x8*)(NAT + (size_t)(row0 + ta + 4) * NATP + N_XBC + 512 + grp * 128 + 32 * ks + 8 * fq);
                    sa = mfma16(ba, cf[ks], sa); sb2 = mfma16(bb, cf[ks], sb2); }
                float pa[4], pb[4];
#pragma unroll
                for (int i = 0; i < 4; ++i) { const int s0 = 32 * jp + 8 * fq + i, s1 = s0 + 4;
                    const bool ok0 = dir == 0 ? s0 <= t : s0 >= t, ok1 = dir == 0 ? s1 <= t : s1 >= t;
                    pa[i] = ok0 ? sa[i] * DT[s0] * __expf(U[s0] + wt) : 0.f; pb[i] = ok1 ? sb2[i] * DT[s1] * __expf(U[s1] + wt) : 0.f; }
                u32x4 pw; pw.x = pk2(pa[0], pa[1]); pw.y = pk2(pa[2], pa[3]); pw.z = pk2(pb[0], pb[1]); pw.w = pk2(pb[2], pb[3]);
                const bf16x8 pf = __builtin_bit_cast(bf16x8, pw);
#pragma unroll
                for (int j = 0; j < 4; ++j) { const bf16x8 xf = *(const bf16x8*)(TR + (size_t)(T_X + hh * 64 + 16 * j + fr) * M + row0 + 32 * jp + 8 * fq); acc[j] = mfma16(xf, pf, acc[j]); }
            }
#pragma unroll
            for (int j = 0; j < 4; ++j) ysum[j] += acc[j];
        }
        const float Dh = a.in[34][layer * 8 + hh]; float ss = 0.f;
#pragma unroll
        for (int j = 0; j < 4; ++j) { const int p = 16 * j + 4 * fq;
            const u32x2 xv = *(const u32x2*)(NAT + (size_t)(row0 + t) * NATP + N_XBC + hh * 64 + p), zv = *(const u32x2*)(PROJ + (size_t)(row0 + t) * PJ + P_Z + hh * 64 + p);
            f32x4 y; y[0] = (ysum[j][0] + bflo(xv.x) * Dh) * fsilu(bflo(zv.x)); y[1] = (ysum[j][1] + bfhi(xv.x) * Dh) * fsilu(bfhi(zv.x));
            y[2] = (ysum[j][2] + bflo(xv.y) * Dh) * fsilu(bflo(zv.y)); y[3] = (ysum[j][3] + bfhi(xv.y) * Dh) * fsilu(bfhi(zv.y));
            ss += (y[0] * y[0] + y[1] * y[1]) + (y[2] * y[2] + y[3] * y[3]);
            *(f32x4*)(YPRE + (size_t)(row0 + t) * 512 + hh * 64 + p) = y; }
        ss += __shfl_xor(ss, 16); ss += __shfl_xor(ss, 32);
        if (fq == 0) SSQ[(size_t)(row0 + t) * 8 + hh] = ss;
    }
}
__device__ __forceinline__ void ssd_fin_phase(const Args& a, int layer, int gw, int ngw, int lane_) {
    int lane = lane_; asm volatile("" : "+v"(lane));
    const float* YPRE = (const float*)(a.ws + WS_YPRE); const float* SSQ = (const float*)(a.ws + WS_SSQ); bf16_t* BR = (bf16_t*)(a.ws + WS_BR); const float* ng = a.in[35] + layer * 512;
    for (int row = gw; row < M; row += ngw) {
        float s = lane < 8 ? SSQ[(size_t)row * 8 + lane] : 0.f; s += __shfl_xor(s, 1); s += __shfl_xor(s, 2); s += __shfl_xor(s, 4); s = __shfl(s, 0);
        const float r = rsqrtf(s * (1.f / 512.f) + 1e-6f);
        const f32x4 y0 = *(const f32x4*)(YPRE + (size_t)row * 512 + 8 * lane), y1 = *(const f32x4*)(YPRE + (size_t)row * 512 + 8 * lane + 4);
        const f32x4 g0 = *(const f32x4*)(ng + 8 * lane), g1 = *(const f32x4*)(ng + 8 * lane + 4);
        *(u32x4*)(BR + (size_t)row * D + 1024 + 8 * lane) = pack8(y0 * r * g0, y1 * r * g1);
    }
}
}
namespace mk {
constexpr size_t WS_CK = WS_SSD_END;
constexpr size_t WS_CVT = AL(WS_CK + (size_t)16 * 512 * 512 * 2);
constexpr size_t WS_ATT_END = AL(WS_CVT + (size_t)16 * 512 * 512 * 2);

__device__ __forceinline__ void prologue_cache(const Args& a, int gw, int ngw, int lane) {
    bf16_t* CK = (bf16_t*)(a.ws + WS_CK); bf16_t* CVT = (bf16_t*)(a.ws + WS_CVT);
    for (size_t i = ((size_t)gw * 64 + lane) * 8; i < (size_t)16 * 512 * 512; i += (size_t)ngw * 64 * 8) {
        const f32x4 x0 = *(const f32x4*)(a.in[2] + i), x1 = *(const f32x4*)(a.in[2] + i + 4); *(u32x4*)(CK + i) = pack8(x0, x1); }
    for (size_t i = (size_t)gw * 64 + lane; i < (size_t)16 * 64 * 512; i += (size_t)ngw * 64) { const int c = i & 511, s8 = (i >> 9) & 63, bl = i >> 15;
        const float* src = a.in[3] + ((size_t)bl * 512 + 8 * s8) * 512 + c;
        u32x4 o; o.x = pk2(src[0], src[512]); o.y = pk2(src[1024], src[1536]); o.z = pk2(src[2048], src[2560]); o.w = pk2(src[3072], src[3584]);
        *(u32x4*)(CVT + ((size_t)bl * 512 + c) * 512 + 8 * s8) = o; }
}
struct AttState { float m, l; f32x4 o[4]; };
template <bool MASKED>
__device__ __forceinline__ void attn_group(AttState& st, const bf16x8 (&qf)[2], const bf16_t* kbase, size_t kp, const bf16_t* vt, size_t vp, int fr, int fq,
                                           const float* bias  , int kc0, int cq, int cs) {
    const int ra = 8 * (fr >> 2) + (fr & 3);
    f32x4 sa = (f32x4){0.f, 0.f, 0.f, 0.f}, sb = (f32x4){0.f, 0.f, 0.f, 0.f};
#pragma unroll
    for (int ks = 0; ks < 2; ++ks) { const bf16x8 ka = *(const bf16x8*)(kbase + (size_t)ra * kp + 32 * ks + 8 * fq), kb = *(const bf16x8*)(kbase + (size_t)(ra + 4) * kp + 32 * ks + 8 * fq);
        sa = mfma16(ka, qf[ks], sa); sb = mfma16(kb, qf[ks], sb); }
    float s[8]; float gm = -1e30f;
#pragma unroll
    for (int i = 0; i < 4; ++i) { s[i] = sa[i] * 0.125f; s[4 + i] = sb[i] * 0.125f; }
    if (MASKED) {
#pragma unroll
        for (int e = 0; e < 8; ++e) { const int kc = kc0 + 8 * fq + e; const bool ok = kc >= cs && kc < cs + 16; const int bi = min(max(kc - cq + 15, 0), 30); s[e] = ok ? s[e] + bias[bi] : -1e30f; }
    }
#pragma unroll
    for (int e = 0; e < 8; ++e) gm = fmaxf(gm, s[e]);
    gm = fmaxf(gm, __shfl_xor(gm, 16)); gm = fmaxf(gm, __shfl_xor(gm, 32));
    const float mn = fmaxf(st.m, gm), al = __expf(st.m - mn); st.m = mn;
    float p[8], ps = 0.f;
#pragma unroll
    for (int e = 0; e < 8; ++e) { p[e] = __expf(s[e] - mn); ps += p[e]; }
    st.l = st.l * al + ps;
    u32x4 pw; pw.x = pk2(p[0], p[1]); pw.y = pk2(p[2], p[3]); pw.z = pk2(p[4], p[5]); pw.w = pk2(p[6], p[7]);
    const bf16x8 pf = __builtin_bit_cast(bf16x8, pw);
#pragma unroll
    for (int j = 0; j < 4; ++j) { const bf16x8 vf = *(const bf16x8*)(vt + (size_t)(16 * j + fr) * vp + 8 * fq); st.o[j] = mfma16(vf, pf, st.o[j] * al); }
}
__device__ __forceinline__ void attn_phase(const Args& a, int layer, int gw_, int ngw, int lane_) {
    int lane = lane_, gw = gw_; asm volatile("" : "+v"(lane));
    const int fr = lane & 15, fq = lane >> 4;
    const bf16_t* PROJ = (const bf16_t*)(a.ws + WS_PROJ); const bf16_t* TR = (const bf16_t*)(a.ws + WS_TR); bf16_t* BR = (bf16_t*)(a.ws + WS_BR);
    const bf16_t* CK = (const bf16_t*)(a.ws + WS_CK); const bf16_t* CVT = (const bf16_t*)(a.ws + WS_CVT);
    for (int it = gw; it < 6144; it += ngw) {
        AttState st; st.m = -1e30f; st.l = 0.f;
#pragma unroll
        for (int j = 0; j < 4; ++j) st.o[j] = (f32x4){0.f, 0.f, 0.f, 0.f};
        int qrow, hh;
        if (it < 4096) {
            const int jq = it & 3, r = (it >> 2) & 31; hh = (it >> 7) & 7; const int b = it >> 10;
            const int seq0 = MP + b * 2048; qrow = seq0 + r * 64 + 16 * jq + fr;
            bf16x8 qf[2];
#pragma unroll
            for (int ks = 0; ks < 2; ++ks) qf[ks] = *(const bf16x8*)(PROJ + (size_t)qrow * PJ + P_Q + hh * 64 + 32 * ks + 8 * fq);
            const int rs = min(max(r - 4, 0), 24), cq = 16 * jq + fr, cs = min(max(cq - 8, 0), 48);
            const int kc0 = jq == 0 ? 0 : (jq == 1 ? 8 : (jq == 2 ? 24 : 32));
            const float* rpb = a.in[19] + ((size_t)layer * 8 + hh) * 15 * 31;
            for (int j = 0; j < 8; ++j) { const int kr = rs + j, tok0 = seq0 + kr * 64 + kc0;
                attn_group<true>(st, qf, PROJ + (size_t)tok0 * PJ + P_K + hh * 64, PJ, TR + (size_t)(T_V + hh * 64) * M + tok0, M, fr, fq, rpb + (kr - r + 7) * 31, kc0, cq, cs); }
            const size_t cb = ((size_t)b * DEPTH + layer) * 512;
            for (int g = 0; g < 16; ++g)
                attn_group<false>(st, qf, CK + (cb + 32 * g) * 512 + hh * 64, 512, CVT + (cb + hh * 64) * 512 + 32 * g, 512, fr, fq, nullptr, 0, 0, 0);
        } else {
            const int i2 = it - 4096, qt = i2 & 15; hh = (i2 >> 4) & 7; const int b = i2 >> 7, seq0 = b * 256; qrow = seq0 + 16 * qt + fr;
            bf16x8 qf[2];
#pragma unroll
            for (int ks = 0; ks < 2; ++ks) qf[ks] = *(const bf16x8*)(PROJ + (size_t)qrow * PJ + P_Q + hh * 64 + 32 * ks + 8 * fq);
            for (int g = 0; g < 8; ++g) { const int tok0 = seq0 + 32 * g;
                attn_group<false>(st, qf, PROJ + (size_t)tok0 * PJ + P_K + hh * 64, PJ, TR + (size_t)(T_V + hh * 64) * M + tok0, M, fr, fq, nullptr, 0, 0, 0); }
        }
        float l = st.l; l += __shfl_xor(l, 16); l += __shfl_xor(l, 32);
        const float rl = 1.f / l;
#pragma unroll
        for (int j = 0; j < 4; ++j) { u32x2 w; w.x = pk2(st.o[j][0] * rl, st.o[j][1] * rl); w.y = pk2(st.o[j][2] * rl, st.o[j][3] * rl);
            *(u32x2*)(BR + (size_t)qrow * D + hh * 64 + 16 * j + 4 * fq) = w; }
    }
}
}
namespace mk {
constexpr int S5K = 768;
constexpr size_t WS_S5W = WS_ATT_END;
constexpr size_t WS_S5WS = AL(WS_S5W + (size_t)DEPTH * 32 * 512 * S5K * 2);
constexpr size_t WS_S5AP = AL(WS_S5WS + (size_t)DEPTH * 32 * 256 * 512 * 2);
constexpr size_t WS_S5UP = AL(WS_S5AP + (size_t)DEPTH * 32 * 2 * 64 * 2 * 4);
constexpr size_t WS_S5SS = AL(WS_S5UP + (size_t)32 * 384 * 512 * 2);
constexpr size_t WS_S5HS = AL(WS_S5SS + (size_t)32 * 384 * 256 * 4);
constexpr size_t WS_S5_END = AL(WS_S5HS + (size_t)32 * 384 * 256 * 2);

__device__ __forceinline__ void s5_param_phase(const Args& a, LAS unsigned char* lds, int tid_, int G) {
    int tid = tid_; asm volatile("" : "+v"(tid));
    LAS float* PW = (LAS float*)lds; LAS float* BB = PW + 2 * 33 * 64 * 2; LAS float* CC = BB + 2 * 64 * 16 * 2; LAS float* KT = CC + 2 * 16 * 64 * 2;
    for (int task = blockIdx.x; task < DEPTH * 32; task += G) {
        const int layer = task >> 5, g = task & 31;
        const float* a_re = a.in[20] + layer * 4096; const float* a_im = a.in[21] + layer * 4096; const float* log_dt = a.in[22] + layer * 64;
        const float* b_re = a.in[23] + (size_t)layer * 65536; const float* b_im = a.in[24] + (size_t)layer * 65536; const float* c_re = a.in[25] + (size_t)layer * 65536; const float* c_im = a.in[26] + (size_t)layer * 65536;
        const float* s5d = a.in[27] + layer * 512;
        bf16_t* S5W = (bf16_t*)(a.ws + WS_S5W) + (size_t)layer * 32 * 512 * S5K; bf16_t* S5WS = (bf16_t*)(a.ws + WS_S5WS) + (size_t)layer * 32 * 256 * 512; float* S5AP = (float*)(a.ws + WS_S5AP) + (size_t)layer * 32 * 2 * 64 * 2;
        __syncthreads();
        if (tid < 128) { const int dir = tid >> 6, n = tid & 63, pi = (dir * 32 + g) * 64 + n;
            const float are = fminf(a_re[pi], -1e-4f), aim = a_im[pi], dt = expf(log_dt[dir * 32 + g]);
            const float mag = expf(dt * are), abr = mag * cosf(dt * aim), abi = mag * sinf(dt * aim);
            const float den = are * are + aim * aim, nr = abr - 1.f, cfr = (nr * are + abi * aim) / den, cfi = (abi * are - nr * aim) / den;
            float pr = 1.f, pim = 0.f;
            for (int p = 0; p <= 32; ++p) { PW[((dir * 33 + p) * 64 + n) * 2] = pr; PW[((dir * 33 + p) * 64 + n) * 2 + 1] = pim; const float t = pr * abr - pim * abi; pim = pr * abi + pim * abr; pr = t; }
            S5AP[((g * 2 + dir) * 64 + n) * 2] = PW[((dir * 33 + 32) * 64 + n) * 2]; S5AP[((g * 2 + dir) * 64 + n) * 2 + 1] = PW[((dir * 33 + 32) * 64 + n) * 2 + 1];
            for (int k = 0; k < 16; ++k) { const float br_ = b_re[(size_t)pi * 16 + k], bi_ = b_im[(size_t)pi * 16 + k];
                BB[((dir * 64 + n) * 16 + k) * 2] = cfr * br_ - cfi * bi_; BB[((dir * 64 + n) * 16 + k) * 2 + 1] = cfr * bi_ + cfi * br_; }
            for (int j = 0; j < 16; ++j) { CC[((dir * 64 + n) * 16 + j) * 2] = c_re[((size_t)(dir * 32 + g) * 16 + j) * 64 + n]; CC[((dir * 64 + n) * 16 + j) * 2 + 1] = c_im[((size_t)(dir * 32 + g) * 16 + j) * 64 + n]; }
        }
        __syncthreads();
        for (int e = tid; e < 2 * 32 * 256; e += NT) { const int j = e & 15, k = (e >> 4) & 15, tau = (e >> 8) & 31, dir = e >> 13; float s = 0.f;
            for (int n = 0; n < 64; ++n) { const float cr = CC[((dir * 64 + n) * 16 + j) * 2], ci = CC[((dir * 64 + n) * 16 + j) * 2 + 1], pr = PW[((dir * 33 + tau) * 64 + n) * 2], pim = PW[((dir * 33 + tau) * 64 + n) * 2 + 1];
                const float xr = cr * pr - ci * pim, xi = cr * pim + ci * pr, br_ = BB[((dir * 64 + n) * 16 + k) * 2], bi_ = BB[((dir * 64 + n) * 16 + k) * 2 + 1];
                s += xr * br_ - xi * bi_; }
            KT[e] = s; }
        __syncthreads();
        { const int t = tid >> 4, j = tid & 15; bf16_t* dst = S5W + ((size_t)g * 512 + tid) * S5K;
            for (int s = 0; s < 32; ++s) { float v[16];
#pragma unroll
                for (int k = 0; k < 16; ++k) { float x;
                    if (s < t) x = KT[((0 * 32 + (t - s)) * 16 + k) * 16 + j]; else if (s > t) x = KT[((1 * 32 + (s - t)) * 16 + k) * 16 + j];
                    else x = KT[((0 * 32 + 0) * 16 + k) * 16 + j] + KT[((1 * 32 + 0) * 16 + k) * 16 + j] + (k == j ? s5d[g * 16 + k] : 0.f);
                    v[k] = x; }
                u32x4 o0, o1; o0.x = pk2(v[0], v[1]); o0.y = pk2(v[2], v[3]); o0.z = pk2(v[4], v[5]); o0.w = pk2(v[6], v[7]); o1.x = pk2(v[8], v[9]); o1.y = pk2(v[10], v[11]); o1.z = pk2(v[12], v[13]); o1.w = pk2(v[14], v[15]);
                *(u32x4*)(dst + s * 16) = o0; *(u32x4*)(dst + s * 16 + 8) = o1; }
            for (int dir = 0; dir < 2; ++dir) { const int p = dir == 0 ? t + 1 : 32 - t;
                for (int n8 = 0; n8 < 8; ++n8) { float gr[8], gi[8];
#pragma unroll
                    for (int q = 0; q < 8; ++q) { const int n = n8 * 8 + q; const float cr = CC[((dir * 64 + n) * 16 + j) * 2], ci = CC[((dir * 64 + n) * 16 + j) * 2 + 1], pr = PW[((dir * 33 + p) * 64 + n) * 2], pim = PW[((dir * 33 + p) * 64 + n) * 2 + 1];
                        gr[q] = cr * pr - ci * pim; gi[q] = -(cr * pim + ci * pr); }
                    u32x4 o; o.x = pk2(gr[0], gr[1]); o.y = pk2(gr[2], gr[3]); o.z = pk2(gr[4], gr[5]); o.w = pk2(gr[6], gr[7]); *(u32x4*)(dst + 512 + dir * 128 + n8 * 8) = o;
                    o.x = pk2(gi[0], gi[1]); o.y = pk2(gi[2], gi[3]); o.z = pk2(gi[4], gi[5]); o.w = pk2(gi[6], gi[7]); *(u32x4*)(dst + 512 + dir * 128 + 64 + n8 * 8) = o; } }
        }
        if (tid < 256) { const int dir = tid >> 7, reim = (tid >> 6) & 1, n = tid & 63; bf16_t* dst = S5WS + ((size_t)g * 256 + tid) * 512;
            for (int s = 0; s < 32; ++s) { const int p = dir == 0 ? 31 - s : s; const float pr = PW[((dir * 33 + p) * 64 + n) * 2], pim = PW[((dir * 33 + p) * 64 + n) * 2 + 1]; float v[16];
#pragma unroll
                for (int k = 0; k < 16; ++k) { const float br_ = BB[((dir * 64 + n) * 16 + k) * 2], bi_ = BB[((dir * 64 + n) * 16 + k) * 2 + 1]; v[k] = reim == 0 ? pr * br_ - pim * bi_ : pr * bi_ + pim * br_; }
                u32x4 o0, o1; o0.x = pk2(v[0], v[1]); o0.y = pk2(v[2], v[3]); o0.z = pk2(v[4], v[5]); o0.w = pk2(v[6], v[7]); o1.x = pk2(v[8], v[9]); o1.y = pk2(v[10], v[11]); o1.z = pk2(v[12], v[13]); o1.w = pk2(v[14], v[15]);
                *(u32x4*)(dst + s * 16) = o0; *(u32x4*)(dst + s * 16 + 8) = o1; } }
    }
    __syncthreads();
}
__device__ __forceinline__ void s5_statein_phase(const Args& a, int layer, int gw, int ngw, int lane_) {
    int lane = lane_; asm volatile("" : "+v"(lane));
    const int fr = lane & 15, fq = lane >> 4;
    const bf16_t* UP = (const bf16_t*)(a.ws + WS_S5UP); const bf16_t* S5WS = (const bf16_t*)(a.ws + WS_S5WS) + (size_t)layer * 32 * 256 * 512; float* SS = (float*)(a.ws + WS_S5SS);
    for (int it = gw; it < 32 * 24; it += ngw) { const int g = it / 24, r = it % 24, og = r / 6, cq = r % 6;
        f32x4 acc[4][4];
#pragma unroll
        for (int i = 0; i < 4; ++i)
#pragma unroll
            for (int j = 0; j < 4; ++j) acc[i][j] = (f32x4){0.f, 0.f, 0.f, 0.f};
        const bf16_t* ap = S5WS + ((size_t)g * 256 + 64 * og + fr) * 512 + 8 * fq; const bf16_t* bp = UP + ((size_t)g * 384 + 64 * cq + fr) * 512 + 8 * fq;
#pragma unroll 2
        for (int ks = 0; ks < 16; ++ks) { bf16x8 af[4], bf[4];
#pragma unroll
            for (int i = 0; i < 4; ++i) { af[i] = *(const bf16x8*)(ap + (size_t)16 * i * 512 + 32 * ks); bf[i] = *(const bf16x8*)(bp + (size_t)16 * i * 512 + 32 * ks); }
#pragma unroll
            for (int i = 0; i < 4; ++i)
#pragma unroll
                for (int j = 0; j < 4; ++j) acc[i][j] = mfma16(af[i], bf[j], acc[i][j]); }
#pragma unroll
        for (int i = 0; i < 4; ++i)
#pragma unroll
            for (int j = 0; j < 4; ++j) *(f32x4*)(SS + ((size_t)g * 384 + 64 * cq + 16 * j + fr) * 256 + 64 * og + 16 * i + 4 * fq) = acc[i][j];
    }
}
__device__ __forceinline__ void s5_scan_phase(const Args& a, int layer, int gw, int ngw, int lane_) {
    int lane = lane_; asm volatile("" : "+v"(lane));
    const float* SS = (const float*)(a.ws + WS_S5SS); bf16_t* HS = (bf16_t*)(a.ws + WS_S5HS); const float* S5AP = (const float*)(a.ws + WS_S5AP) + (size_t)layer * 32 * 2 * 64 * 2;
    for (int task = gw; task < 1280; task += ngw) {
        int sq, g, dir; if (task < 256) { sq = 16 + (task >> 6); g = (task >> 1) & 31; dir = task & 1; } else { const int t2 = task - 256; sq = t2 >> 6; g = (t2 >> 1) & 31; dir = t2 & 1; }
        const int lat = sq >= 16, b = lat ? sq - 16 : sq, nc = lat ? 64 : 8, cg0 = lat ? 128 + b * 64 : b * 8;
        const float apr = S5AP[((g * 2 + dir) * 64 + lane) * 2], api = S5AP[((g * 2 + dir) * 64 + lane) * 2 + 1];
        float hr = 0.f, hi = 0.f;
        if (lat) { const size_t so = ((((size_t)b * DEPTH + layer) * 2 + dir) * 32 + g) * 64 + lane; hr = a.in[4][so]; hi = a.in[5][so]; }
        for (int s = 0; s < nc; ++s) { const int cg = cg0 + (dir ? nc - 1 - s : s); const size_t base = ((size_t)g * 384 + cg) * 256 + dir * 128;
            HS[base + lane] = f2bf(hr); HS[base + 64 + lane] = f2bf(hi);
            const float sr = SS[base + lane], si = SS[base + 64 + lane];
            const float t = apr * hr - api * hi + sr; hi = apr * hi + api * hr + si; hr = t; }
        if (!lat) { const size_t oo = ((((size_t)b * DEPTH + layer) * 2 + dir) * 32 + g) * 64 + lane; a.out[O_S5R + oo] = hr; a.out[O_S5I + oo] = hi; }
    }
}
__device__ __forceinline__ void s5_out_phase(const Args& a, int layer, int gw, int ngw, int lane_) {
    int lane = lane_; asm volatile("" : "+v"(lane));
    const int fr = lane & 15, fq = lane >> 4;
    const bf16_t* UP = (const bf16_t*)(a.ws + WS_S5UP); const bf16_t* S5W = (const bf16_t*)(a.ws + WS_S5W) + (size_t)layer * 32 * 512 * S5K; const bf16_t* HS = (const bf16_t*)(a.ws + WS_S5HS); bf16_t* ZB = (bf16_t*)(a.ws + WS_ZB);
    for (int it = gw; it < 32 * 48; it += ngw) { const int g = it / 48, r = it % 48, og = r / 6, cq = r % 6;
        f32x4 acc[4][4];
#pragma unroll
        for (int i = 0; i < 4; ++i)
#pragma unroll
            for (int j = 0; j < 4; ++j) acc[i][j] = (f32x4){0.f, 0.f, 0.f, 0.f};
        const bf16_t* ap = S5W + ((size_t)g * 512 + 64 * og + fr) * S5K + 8 * fq;
        const bf16_t* bp = UP + ((size_t)g * 384 + 64 * cq + fr) * 512 + 8 * fq; const bf16_t* hp = HS + ((size_t)g * 384 + 64 * cq + fr) * 256 + 8 * fq;
#pragma unroll 2
        for (int ks = 0; ks < 16; ++ks) { bf16x8 af[4], bf[4];
#pragma unroll
            for (int i = 0; i < 4; ++i) { af[i] = *(const bf16x8*)(ap + (size_t)16 * i * S5K + 32 * ks); bf[i] = *(const bf16x8*)(bp + (size_t)16 * i * 512 + 32 * ks); }
#pragma unroll
            for (int i = 0; i < 4; ++i)
#pragma unroll
                for (int j = 0; j < 4; ++j) acc[i][j] = mfma16(af[i], bf[j], acc[i][j]); }
#pragma unroll 2
        for (int ks = 0; ks < 8; ++ks) { bf16x8 af[4], bf[4];
#pragma unroll
            for (int i = 0; i < 4; ++i) { af[i] = *(const bf16x8*)(ap + (size_t)16 * i * S5K + 512 + 32 * ks); bf[i] = *(const bf16x8*)(hp + (size_t)16 * i * 256 + 32 * ks); }
#pragma unroll
            for (int i = 0; i < 4; ++i)
#pragma unroll
                for (int j = 0; j < 4; ++j) acc[i][j] = mfma16(af[i], bf[j], acc[i][j]); }
#pragma unroll
        for (int i = 0; i < 4; ++i)
#pragma unroll
            for (int j = 0; j < 4; ++j) { float z[4];
#pragma unroll
                for (int e = 0; e < 4; ++e) { const float x = acc[i][j][e]; const float th = 0.7978845608028654f * (x + 0.044715f * x * x * x); const float e2 = __expf(2.f * th); const float tnh = 1.f - 2.f * __builtin_amdgcn_rcpf(e2 + 1.f); z[e] = 0.5f * x * (1.f + tnh); }
                u32x2 w; w.x = pk2(z[0], z[1]); w.y = pk2(z[2], z[3]);
                *(u32x2*)(ZB + (size_t)(32 * (64 * cq + 16 * j + fr) + 4 * og + i) * 512 + g * 16 + 4 * fq) = w; }
    }
}
}
namespace mk { static_assert(WS_S5_END < (size_t)1780 * 1024 * 1024, "workspace map exceeds the guaranteed size"); }
namespace mk {
#ifndef PHMASK
#define PHMASK 0xfffff
#endif
#define PHM(k) ((PHMASK >> (k)) & 1)
#ifndef DUPMASK
#define DUPMASK 0
#endif
#define DUP(k) ((DUPMASK >> (k)) & 1)
constexpr int NPH = 12;
constexpr int PH_TOTAL = 1 + DEPTH * NPH;
__global__ void __launch_bounds__(NT, 2) mk_fwd(Args a) {
    extern __shared__ __attribute__((aligned(16))) unsigned char lds_raw[];
    LAS unsigned char* lds = (LAS unsigned char*)lds_raw;
#define TID ((int)threadIdx.x)
#define LANE ((int)(threadIdx.x & 63))
#define WAVE (__builtin_amdgcn_readfirstlane((int)(threadIdx.x >> 6)))
#define GW ((int)blockIdx.x * NWV + WAVE)
    const int G = gridDim.x, ngw = G * NWV;
    volatile LAS unsigned* ctlw = (volatile LAS unsigned*)(lds + LDS_CTL);
    if (TID < 4) ctlw[TID] = 0u;
    __syncthreads();
    XcdBarrier bar = xcd_barrier_post((unsigned*)(a.ws + WS_CTL), ctlw);
    const int lo = a.ph_lo, hi = a.ph_hi;
#define IN(k) (lo <= (k) && (k) < hi)
#define SEAM(k) do { if (IN(k) && IN((k) + 1)) xcd_barrier(bar); } while (0)
    unsigned char* ws = a.ws;
    bf16_t* H = (bf16_t*)(ws + WS_H); bf16_t* PROJ = (bf16_t*)(ws + WS_PROJ); float* SMALL = (float*)(ws + WS_SMALL); bf16_t* BR = (bf16_t*)(ws + WS_BR);
    bf16_t* MERGED = (bf16_t*)(ws + WS_MERGED); float* MACC = (float*)(ws + WS_MACC); bf16_t* ZB = (bf16_t*)(ws + WS_ZB); bf16_t* HID = PROJ;
    const float* MOD = (const float*)(ws + WS_MOD); float* X = a.out;
    if (PHM(0) && IN(0)) { for (int r_ = 0; r_ < 1 + DUP(8); ++r_) prologue_convert(a, lds, GW, ngw, WAVE, LANE); prologue_cache(a, GW, ngw, LANE); __syncthreads(); prologue_ada(a, lds, TID); for (int r_ = 0; r_ < 1 + DUP(1); ++r_) s5_param_phase(a, lds, TID, G); }
    SEAM(0);
    for (int l = 0; l < DEPTH; ++l) {
        const int pb = 1 + l * NPH;
        const float* xp = l == 0 ? a.in[0] : X; const float* xs = l == 0 ? a.in[1] : X + (size_t)MP * D;
        const float* modl = MOD + (size_t)l * 5 * 6 * D;
        const bf16_t* wl = (const bf16_t*)(ws + WS_W) + (size_t)l * W_LAYER;
        if (PHM(1) && IN(pb + 0)) for (int r_ = 0; r_ < 1 + DUP(11); ++r_) norm_phase(xp, xs, a.in[14] + l * D, modl, 0, D, H, GW, ngw, LANE);
        SEAM(pb + 0);
        if (PHM(2) && IN(pb + 1)) { Gemm g{H, wl + W_IN, M, NIN, D, D, 1, 0, 0}; StaticOrder S; S.init(M, NIN, G, blockIdx.x);
            EpiIn E{PROJ, SMALL, a.out, a.in[17] + l * 64, a.in[18] + l * 64, l}; for (int r_ = 0; r_ < 1 + DUP(9); ++r_) gemm_phase(lds, g, S, E); }
        SEAM(pb + 1);
        if (PHM(3) && IN(pb + 2)) { for (int r_ = 0; r_ < 1 + DUP(0); ++r_) { prep_phase(a, l, lds, GW, ngw, WAVE, LANE, (bf16_t*)(a.ws + WS_S5UP)); __syncthreads(); } }
        SEAM(pb + 2);
        if (PHM(4) && IN(pb + 3)) { for (int r_ = 0; r_ < 1 + DUP(2); ++r_) attn_phase(a, l, GW, ngw, LANE); for (int r_ = 0; r_ < 1 + DUP(3); ++r_) { ml_states_phase(a, l, TID, G); ssd_states_phase(a, l, TID, G); s5_statein_phase(a, l, GW, ngw, LANE); } }
        SEAM(pb + 3);
        if (PHM(5) && IN(pb + 4)) { for (int r_ = 0; r_ < 1 + DUP(4); ++r_) { ml_scan_phase(a, l, TID, G); ssd_scan_phase(a, l, TID, G); s5_scan_phase(a, l, GW, ngw, LANE); } }
        SEAM(pb + 4);
        if (PHM(12) && IN(pb + 5)) { for (int r_ = 0; r_ < 1 + DUP(5); ++r_) ml_out_phase(a, l, lds, TID, G); for (int r_ = 0; r_ < 1 + DUP(6); ++r_) ssd_out_phase(a, l, lds, TID, G); for (int r_ = 0; r_ < 1 + DUP(7); ++r_) s5_out_phase(a, l, GW, ngw, LANE); }
        SEAM(pb + 5);
        if (PHM(6) && IN(pb + 6)) { Gemm g{ZB, wl + W_GLU, M, 512, 512, 512, 1, 0, 0}; StaticOrder S; S.init(M, 512, G, blockIdx.x);
            EpiGlu E{ZB, a.in[29] + l * 512, BR}; gemm_phase(lds, g, S, E); ssd_fin_phase(a, l, GW, ngw, LANE); }
        SEAM(pb + 6);
        if (PHM(7) && IN(pb + 7)) { Gemm g{BR, wl + W_BR, M, D, 512, D, 4, 512, (size_t)D * 512}; StaticOrder S; S.init(M, D, G, blockIdx.x, 4);
            EpiBranch E{PROJ, MERGED}; for (int r_ = 0; r_ < 1 + DUP(12); ++r_) gemm_phase(lds, g, S, E); }
        SEAM(pb + 7);
        if (PHM(8) && IN(pb + 8)) { Gemm g{MERGED, wl + W_OUT, M, D, D, D, 1, 0, 0}; StaticOrder S; S.init(M, D, G, blockIdx.x);
            EpiResid E{xp, xs, modl, 2 * D, X}; gemm_phase(lds, g, S, E); }
        SEAM(pb + 8);
        if (PHM(9) && IN(pb + 9)) norm_phase(X, X + (size_t)MP * D, a.in[15] + l * D, modl, 3 * D, 4 * D, H, GW, ngw, LANE);
        SEAM(pb + 9);
        if (PHM(10) && IN(pb + 10)) { Gemm g{H, wl + W_1, M, DFF, D, D, 1, 0, 0}; StaticOrder S; S.init(M, DFF, G, blockIdx.x);
            EpiRelu2 E{HID, DFF}; for (int r_ = 0; r_ < 1 + DUP(10); ++r_) gemm_phase(lds, g, S, E); }
        SEAM(pb + 10);
        if (PHM(11) && IN(pb + 11)) { Gemm g{HID, wl + W_2, M, D, DFF, DFF, 1, 0, 0}; StaticOrder S; S.init(M, D, G, blockIdx.x);
            EpiResid E{X, X + (size_t)MP * D, modl, 5 * D, X}; gemm_phase(lds, g, S, E); }
        SEAM(pb + 11);
    }
#undef IN
#undef SEAM
}
}
extern "C" void kernel_launch(void* const* d_in, const int* in_sizes, int n_in, void* d_out, int out_size, void* d_ws, size_t ws_size, hipStream_t stream) {
    static int grid = 0;
    if (grid == 0) {
        int dev = 0, cus = 0; (void)hipGetDevice(&dev); (void)hipDeviceGetAttribute(&cus, hipDeviceAttributeMultiprocessorCount, dev);
        (void)hipFuncSetAttribute((const void*)mk::mk_fwd, hipFuncAttributeMaxDynamicSharedMemorySize, mk::LDS_BYTES);
        int per_cu = 0; (void)hipOccupancyMaxActiveBlocksPerMultiprocessor(&per_cu, (const void*)mk::mk_fwd, mk::NT, mk::LDS_BYTES); (void)hipGetLastError();
        grid = cus > 0 ? cus : 256;
    }
    mk::Args a{}; for (int i = 0; i < 43; ++i) a.in[i] = (const float*)d_in[i];
    a.out = (float*)d_out; a.ws = (unsigned char*)d_ws; a.ph_lo = 0; a.ph_hi = mk::PH_TOTAL;
    (void)hipMemsetAsync(a.ws + mk::WS_CTL, 0, mk::CTL_BYTES, stream);
    hipLaunchKernelGGL(mk::mk_fwd, dim3(grid), dim3(mk::NT), mk::LDS_BYTES, stream, a);
}
```

```cpp
#define SAFE_GEMM 0
#define DUPMASK 0
#include <hip/hip_runtime.h>
#include <math.h>
namespace mk {
#define LAS __attribute__((address_space(3)))
typedef unsigned short bf16_t;
typedef short bf16x8 __attribute__((ext_vector_type(8)));
typedef float f32x4 __attribute__((ext_vector_type(4)));
typedef float f32x2 __attribute__((ext_vector_type(2)));
typedef unsigned u32x4 __attribute__((ext_vector_type(4)));
typedef unsigned u32x2 __attribute__((ext_vector_type(2)));
constexpr int NT = 512, NWV = 8;
constexpr int D = 2048, MP = 4096, MLAT = 8192, M = MP + MLAT, DEPTH = 4, DFF = 8192;
constexpr int PJ = 13824;
constexpr int NIN = 14080;
constexpr int P_Q = 0, P_K = 512, P_V = 1024, P_S5U = 1536, P_Z = 2048, P_XBC = 2560, P_MQ = 3584, P_MK = 4096, P_MV = 4608, P_MO = 5120, P_GATE = 5632;
constexpr int S_DT = 0, S_MI = 16, S_MF = 24;

typedef __bf16 bf16x2_t __attribute__((ext_vector_type(2)));
__device__ __forceinline__ unsigned pk2(float lo, float hi) { f32x2 v = {lo, hi}; bf16x2_t b = __builtin_convertvector(v, bf16x2_t); return __builtin_bit_cast(unsigned, b); }
__device__ __forceinline__ float bf2f(bf16_t v) { return __uint_as_float(((unsigned)v) << 16); }
__device__ __forceinline__ float bflo(unsigned w) { return __uint_as_float(w << 16); }
__device__ __forceinline__ float bfhi(unsigned w) { return __uint_as_float(w & 0xffff0000u); }
__device__ __forceinline__ bf16_t f2bf(float f) { return (bf16_t)(pk2(f, 0.f) & 0xffffu); }
__device__ __forceinline__ float fsigm(float x) { return __builtin_amdgcn_rcpf(1.f + __expf(-x)); }
__device__ __forceinline__ float fsilu(float x) { return x * fsigm(x); }
__device__ __forceinline__ int row_cvec(int row) { return row < MP ? 0 : 1 + (row - MP) / 2048; }

#define XB_TMO      128
#define XB_XCNT(j)  (256  + 64 * (j))
#define XB_XSUB(j)  (1280 + 64 * (j))
#define XB_XGEN(j)  (2304 + 64 * (j))
#define XB_TOP      3328
#define XB_TOPGEN   3392
#define XCD_BAR_WORDS 3456
#define XB_SPIN_CAP (1u << 18)
__device__ __forceinline__ unsigned xb_ld(unsigned* p)              { return __hip_atomic_load(p, __ATOMIC_RELAXED, __HIP_MEMORY_SCOPE_AGENT); }
__device__ __forceinline__ unsigned xb_add(unsigned* p, unsigned v) { return __hip_atomic_fetch_add(p, v, __ATOMIC_RELAXED, __HIP_MEMORY_SCOPE_AGENT); }
__device__ __forceinline__ unsigned xb_xcc_id() { return (unsigned)__builtin_amdgcn_s_getreg((3 << 11) | 20) & 0xFu; }
#define XB_SPIN(cond, bar) do { unsigned _sp = 0; while (cond) { __builtin_amdgcn_s_sleep(1); \
    if ((++_sp & 255u) == 0u) { if (xb_ld(&(bar)[XB_TMO])) break; if (_sp > XB_SPIN_CAP) { atomicAdd(&(bar)[XB_TMO], 1u); break; } } } } while (0)
struct XcdBarrier { unsigned* bar; unsigned x; volatile LAS unsigned* st; };
__device__ __forceinline__ XcdBarrier xcd_barrier_post(unsigned* bar, volatile LAS unsigned* st) {
    XcdBarrier b; b.bar = bar; b.x = xb_xcc_id(); b.st = st;
    if (threadIdx.x == 0) (void)xb_add(&bar[XB_XCNT(b.x)], 1u);
    return b;
}
__device__ __forceinline__ void xcd_barrier_complete(unsigned* bar, unsigned x, unsigned& nloc, unsigned& nx) {
    const unsigned G = gridDim.x * gridDim.y * gridDim.z;
    unsigned sum, cnt, mine, sp = 0u;
    for (;;) {
        sum = 0u; cnt = 0u; mine = 0u;
#pragma unroll
        for (unsigned j = 0; j < 16; ++j) { const unsigned c = xb_ld(&bar[XB_XCNT(j)]); sum += c; cnt += (c > 0u) ? 1u : 0u; mine = (j == x) ? c : mine; }
        if (sum == G) break;
        __builtin_amdgcn_s_sleep(1);
        if ((++sp & 255u) == 0u) { if (xb_ld(&bar[XB_TMO])) break; if (sp > XB_SPIN_CAP) { atomicAdd(&bar[XB_TMO], 1u); break; } }
    }
    nloc = mine > 0u ? mine : 1u; nx = cnt > 0u ? cnt : 1u;
}
__device__ __forceinline__ void xcd_barrier(const XcdBarrier& b) {
    asm volatile("s_waitcnt vmcnt(0)" ::: "memory");
    __syncthreads();
    if (threadIdx.x == 0) {
        unsigned* bar = b.bar;
        __builtin_amdgcn_s_waitcnt(0);
        unsigned nloc = b.st[0], nx = b.st[1];
        if (nloc == 0u) { xcd_barrier_complete(bar, b.x, nloc, nx); b.st[0] = nloc; b.st[1] = nx; }
        const unsigned old = xb_add(&bar[XB_XSUB(b.x)], 1u);
        const unsigned gen = old / nloc;
        if (old + 1u == (gen + 1u) * nloc) {
            __builtin_amdgcn_fence(__ATOMIC_RELEASE, "agent");
            asm volatile("s_waitcnt vmcnt(0)" ::: "memory");
            const unsigned og = xb_add(&bar[XB_TOP], 1u);
            const unsigned tg = og / nx;
            if (og + 1u == (tg + 1u) * nx) xb_add(&bar[XB_TOPGEN], 1u);
            else XB_SPIN(xb_ld(&bar[XB_TOPGEN]) == tg, bar);
            __builtin_amdgcn_fence(__ATOMIC_ACQUIRE, "agent");
            xb_add(&bar[XB_XGEN(b.x)], 1u);
            asm volatile("s_waitcnt vmcnt(0)" ::: "memory");
        } else {
            XB_SPIN(xb_ld(&bar[XB_XGEN(b.x)]) == gen, bar);
            __builtin_amdgcn_fence(__ATOMIC_ACQUIRE, "agent");
            asm volatile("s_waitcnt vmcnt(0)" ::: "memory");
        }
    }
    __syncthreads();
}

#ifndef GEMM_SP2
#define GEMM_SP2 1
#endif
#ifndef GEMM_ALIGN
#define GEMM_ALIGN 1
#endif
constexpr int BM = 256, BK = 64, HALF = 128, HTB = HALF * BK * 2, STAGE_BYTES = 8 * HTB, NXCD = 8, WGM = 8;
__host__ __device__ __forceinline__ int lds_byte(int r, int c) { const int st = (r >> 4) * 2 + (c >> 5), rr = r & 15, cc = c & 31, ob = rr * 64 + cc * 2; return st * 1024 + (ob ^ (((ob >> 9) & 1) << 5)); }
__host__ __device__ __forceinline__ void stage_rc(int b, int& R, int& C) { const int st = b / 1024, sb = b % 1024, swz = sb ^ (((sb >> 9) & 1) << 5); R = (st >> 1) * 16 + swz / 64; C = (st & 1) * 32 + (swz % 64) / 2; }
__host__ __device__ __forceinline__ int perm32(int rho) { const int n = rho >> 4, i = rho & 15; return 8 * (i >> 2) + 4 * n + (i & 3); }

struct Unit { int pm, pn, kz, koff, nt; };
struct Gemm { const bf16_t* A; const bf16_t* Bt; int M, N, K, lda, nkz; size_t a_kz, b_kz; };

struct StaticOrder {
    int nM, nN, nwg, G, c, nkz;
    int ntk;
    __device__ void init(int M_, int N_, int G_, int c_, int nkz_ = 1, int K_ = 0) { nM = M_ / BM; nN = N_ / BM; nwg = nM * nN; G = G_; c = c_; nkz = nkz_; ntk = K_ / BK; }
    __device__ bool next(int i, Unit& u) const {
        const int it = i / nkz; u.kz = i - it * nkz; u.koff = 0; u.nt = ntk;
        const long L = (long)it * G + c; if (L >= nwg) return false;
        int wgid = (int)L; { const int q = nwg / NXCD, r = nwg % NXCD, xcd = wgid % NXCD, off = wgid / NXCD; wgid = (xcd < r ? xcd * (q + 1) : r * (q + 1) + (xcd - r) * q) + off; }
        const int nig = WGM * nN, gid = wgid / nig, fm = gid * WGM, gsz = (nM - fm) < WGM ? (nM - fm) : WGM;
        u.pm = fm + ((wgid % nig) % gsz); u.pn = (wgid % nig) / gsz; return true;
    }
};

struct SplitOrder {
    int c, ntk;
    __device__ void init(int c_, int K_) { c = c_; ntk = K_ / BK; }
    __device__ bool next(int i, Unit& u) const {
        const int xcd = c & 7, idx = c >> 3;
        if (i == 0) { u.pm = xcd * 4 + (idx >> 3); u.pn = idx & 7; u.kz = 0; u.koff = 0; u.nt = ntk; return true; }
        if (i == 1) { const int t = idx >> 1; u.pm = 32 + xcd * 2 + (t >> 3); u.pn = t & 7; u.kz = 0; u.nt = ntk >> 1; u.koff = (idx & 1) * (ntk >> 1) * BK; return true; }
        return false;
    }
};

template <class Epi, class Sched>
__device__ __forceinline__ void gemm_phase(LAS unsigned char* lds, const Gemm g, const Sched& S, const Epi& E) {
    int tid_ = threadIdx.x; asm volatile("" : "+v"(tid_));
    const int tid = tid_, wid = __builtin_amdgcn_readfirstlane(tid >> 6), lane = tid & 63, wr = wid >> 2, wc = wid & 3, fr = lane & 15, fq = lane >> 4;
    const int K = g.K;
    unsigned voffA[2], voffB[2];
#pragma unroll
    for (int i = 0; i < 2; ++i) { int R, C; stage_rc(tid * 16 + i * 8192, R, C); const int Rb = Epi::PERM ? ((R & ~31) + perm32(R & 31)) : R;
        voffA[i] = (unsigned)(R * g.lda + C) * 2u; voffB[i] = (unsigned)(Rb * K + C) * 2u; }
    const size_t kstep = (size_t)(BK * 2);
    const size_t hstepA = (size_t)HALF * g.lda * 2, hstepB = (size_t)HALF * K * 2;
    const size_t tstepA = 2 * hstepA, tstepB = 2 * hstepB;
    const unsigned ldsw = (unsigned)wid * 1024u;
    const int aoff = lds_byte(wr * 64 + fr, fq * 8), boff = lds_byte(wc * 32 + fr, fq * 8);
#define PG8_SA(b, h) (((b) * 2 + (h)) * HTB)
#define PG8_SB(b, h) ((4 + (b) * 2 + (h)) * HTB)
#define PG8_STAGE(bufoff, gbase, voff) do { _Pragma("unroll") for (int _i = 0; _i < 2; ++_i) \
        __builtin_amdgcn_global_load_lds((const unsigned*)((const char*)(gbase) + (voff)[_i]), (LAS unsigned*)(lds + (bufoff) + ldsw + _i * 8192), 16, 0, 0); } while (0)
#define PG8_LDA(dst, b, h) do { _Pragma("unroll") for (int m = 0; m < 4; ++m) _Pragma("unroll") for (int k = 0; k < 2; ++k) dst[m][k] = *(const LAS bf16x8*)(lds + PG8_SA(b, h) + aoff + m * 2048 + k * 1024); } while (0)
#define PG8_LDB(dst, b, h) do { _Pragma("unroll") for (int n = 0; n < 2; ++n) _Pragma("unroll") for (int k = 0; k < 2; ++k) dst[n][k] = *(const LAS bf16x8*)(lds + PG8_SB(b, h) + boff + n * 2048 + k * 1024); } while (0)
#define PG8_MMA(ai, bj, At, Bt) do { __builtin_amdgcn_s_setprio(1); _Pragma("unroll") for (int m = 0; m < 4; ++m) _Pragma("unroll") for (int n = 0; n < 2; ++n) _Pragma("unroll") for (int k = 0; k < 2; ++k) \
        acc[ai][bj][m][n] = __builtin_amdgcn_mfma_f32_16x16x32_bf16(Bt[n][k], At[m][k], acc[ai][bj][m][n], 0, 0, 0); __builtin_amdgcn_s_setprio(0); } while (0)
#if SAFE_GEMM == 1 || SAFE_GEMM == 3
#define PG8_WAIT_V(n) asm volatile("s_waitcnt vmcnt(0)" ::: "memory")
#else
#define PG8_WAIT_V(n) asm volatile("s_waitcnt vmcnt(" #n ")" ::: "memory")
#endif
#define PG8_WAIT_L(n) asm volatile("s_waitcnt lgkmcnt(" #n ")" ::: "memory")
#if SAFE_GEMM == 1
#define PG8_BAR do { asm volatile("s_waitcnt vmcnt(0) lgkmcnt(0)" ::: "memory"); __builtin_amdgcn_s_barrier(); asm volatile("" ::: "memory"); } while (0)
#elif SAFE_GEMM == 2
#define PG8_BAR asm volatile("s_barrier" ::: "memory")
#elif SAFE_GEMM == 4
#define PG8_BAR do { asm volatile("s_waitcnt lgkmcnt(0)" ::: "memory"); __builtin_amdgcn_s_barrier(); } while (0)
#else
#define PG8_BAR __builtin_amdgcn_s_barrier()
#endif
#define PG8_SCHED __builtin_amdgcn_sched_barrier(0)
    Unit cur, nxt; int ui = 0;
    if (!S.next(0, cur)) return;
    f32x4 acc[2][2][4][2];
#pragma unroll
    for (int a = 0; a < 2; ++a)
#pragma unroll
        for (int b = 0; b < 2; ++b)
#pragma unroll
            for (int m = 0; m < 4; ++m)
#pragma unroll
                for (int n = 0; n < 2; ++n) acc[a][b][m][n] = (f32x4){0.f, 0.f, 0.f, 0.f};
    bf16x8 At[4][2], B0[2][2], B1[2][2];
    const char* cA = (const char*)(g.A + (size_t)cur.kz * g.a_kz + cur.koff) + (size_t)cur.pm * tstepA; const char* cB = (const char*)(g.Bt + (size_t)cur.kz * g.b_kz + cur.koff) + (size_t)cur.pn * tstepB;
#if GEMM_SP2
    PG8_STAGE(PG8_SB(0, 0), cB, voffB); PG8_STAGE(PG8_SB(0, 1), cB + hstepB, voffB); PG8_STAGE(PG8_SA(0, 0), cA, voffA); PG8_STAGE(PG8_SA(0, 1), cA + hstepA, voffA);
    if (wr == 1) PG8_BAR;
    PG8_WAIT_V(2); PG8_BAR;
    PG8_STAGE(PG8_SB(1, 0), cB + kstep, voffB); PG8_STAGE(PG8_SA(1, 0), cA + kstep, voffA); PG8_STAGE(PG8_SB(1, 1), cB + hstepB + kstep, voffB);
    PG8_WAIT_V(6); PG8_BAR;
#else
    PG8_STAGE(PG8_SB(0, 0), cB, voffB); PG8_STAGE(PG8_SA(0, 0), cA, voffA); PG8_STAGE(PG8_SB(0, 1), cB + hstepB, voffB); PG8_STAGE(PG8_SA(0, 1), cA + hstepA, voffA);
    if (wr == 1) PG8_BAR;
    PG8_WAIT_V(4); PG8_BAR;
    PG8_STAGE(PG8_SB(1, 0), cB + kstep, voffB); PG8_STAGE(PG8_SA(1, 0), cA + kstep, voffA); PG8_STAGE(PG8_SB(1, 1), cB + hstepB + kstep, voffB);
    PG8_WAIT_V(6); PG8_BAR;
#endif
    for (;;) {
        const bool has_next = S.next(ui + 1, nxt);
        const char* nA = has_next ? (const char*)(g.A + (size_t)nxt.kz * g.a_kz + nxt.koff) + (size_t)nxt.pm * tstepA : cA;
        const char* nB = has_next ? (const char*)(g.Bt + (size_t)nxt.kz * g.b_kz + nxt.koff) + (size_t)nxt.pn * tstepB : cB;
        const int nt = cur.nt;
        for (int t = 0; t < nt; t += 2) {
            const bool last = (t == nt - 2);
            const char* a1 = cA + (size_t)(t + 1) * kstep;
            const char* a2 = last ? nA : cA + (size_t)(t + 2) * kstep; const char* b2 = last ? nB : cB + (size_t)(t + 2) * kstep;
            const char* a3 = a2 + kstep; const char* b3 = b2 + kstep;
#if GEMM_SP2
            PG8_LDB(B0, 0, 0); PG8_LDB(B1, 0, 1); PG8_SCHED; PG8_LDA(At, 0, 0); PG8_STAGE(PG8_SA(1, 1), a1 + hstepA, voffA);
            PG8_WAIT_V(8); PG8_WAIT_L(0); PG8_BAR; PG8_MMA(0, 0, At, B0); PG8_MMA(0, 1, At, B1); PG8_BAR; PG8_SCHED;
            PG8_LDA(At, 0, 1); PG8_STAGE(PG8_SB(0, 0), b2, voffB); PG8_STAGE(PG8_SB(0, 1), b2 + hstepB, voffB); PG8_STAGE(PG8_SA(0, 0), a2, voffA);
            PG8_WAIT_V(8); PG8_WAIT_L(0); PG8_BAR; PG8_MMA(1, 0, At, B0); PG8_MMA(1, 1, At, B1); PG8_BAR; PG8_SCHED;
            PG8_LDB(B0, 1, 0); PG8_LDB(B1, 1, 1); PG8_SCHED; PG8_LDA(At, 1, 0); PG8_STAGE(PG8_SA(0, 1), a2 + hstepA, voffA);
            PG8_WAIT_V(8); PG8_WAIT_L(0); PG8_BAR; PG8_MMA(0, 0, At, B0); PG8_MMA(0, 1, At, B1); PG8_BAR; PG8_SCHED;
            PG8_LDA(At, 1, 1); PG8_STAGE(PG8_SB(1, 0), b3, voffB); PG8_STAGE(PG8_SB(1, 1), b3 + hstepB, voffB); PG8_STAGE(PG8_SA(1, 0), a3, voffA);
            PG8_WAIT_V(8); PG8_WAIT_L(0); PG8_BAR; PG8_MMA(1, 0, At, B0); PG8_MMA(1, 1, At, B1); PG8_BAR; PG8_SCHED;
#else
            PG8_LDB(B0, 0, 0); PG8_SCHED; PG8_LDA(At, 0, 0); PG8_STAGE(PG8_SA(1, 1), a1 + hstepA, voffA);
            PG8_WAIT_L(8); PG8_BAR; PG8_WAIT_L(0); PG8_MMA(0, 0, At, B0); PG8_BAR; PG8_SCHED;
            PG8_LDB(B1, 0, 1); PG8_STAGE(PG8_SB(0, 0), b2, voffB);
            PG8_BAR; PG8_WAIT_L(0); PG8_MMA(0, 1, At, B1); PG8_BAR;
            PG8_LDA(At, 0, 1); PG8_STAGE(PG8_SA(0, 0), a2, voffA);
            PG8_BAR; PG8_WAIT_L(0); PG8_MMA(1, 0, At, B0); PG8_BAR; PG8_SCHED;
            PG8_STAGE(PG8_SB(0, 1), b2 + hstepB, voffB);
            PG8_WAIT_V(6); PG8_BAR; PG8_MMA(1, 1, At, B1); PG8_BAR;
            PG8_LDB(B0, 1, 0); PG8_SCHED; PG8_LDA(At, 1, 0); PG8_STAGE(PG8_SA(0, 1), a2 + hstepA, voffA);
            PG8_WAIT_L(8); PG8_BAR; PG8_WAIT_L(0); PG8_MMA(0, 0, At, B0); PG8_BAR; PG8_SCHED;
            PG8_LDB(B1, 1, 1); PG8_STAGE(PG8_SB(1, 0), b3, voffB);
            PG8_BAR; PG8_WAIT_L(0); PG8_MMA(0, 1, At, B1); PG8_BAR;
            PG8_LDA(At, 1, 1); PG8_STAGE(PG8_SA(1, 0), a3, voffA);
            PG8_BAR; PG8_WAIT_L(0); PG8_MMA(1, 0, At, B0); PG8_BAR; PG8_SCHED;
            PG8_STAGE(PG8_SB(1, 1), b3 + hstepB, voffB);
            PG8_WAIT_V(6); PG8_BAR; PG8_MMA(1, 1, At, B1); PG8_BAR;
#endif
        }
#if GEMM_ALIGN
        if (wr == 0) PG8_BAR;
#endif
        E(acc, cur, wr, wc, fr, fq);
        if (!has_next) break;
        if (nxt.kz == 0) {
#pragma unroll
        for (int a = 0; a < 2; ++a)
#pragma unroll
            for (int b = 0; b < 2; ++b)
#pragma unroll
                for (int m = 0; m < 4; ++m)
#pragma unroll
                    for (int n = 0; n < 2; ++n) acc[a][b][m][n] = (f32x4){0.f, 0.f, 0.f, 0.f};
        }
        cur = nxt; cA = nA; cB = nB; ++ui;
#if GEMM_ALIGN
        if (wr == 1) PG8_BAR;
#endif
    }
    PG8_WAIT_V(0);
#if !GEMM_ALIGN
    if (wr == 0) PG8_BAR;
#endif
    PG8_BAR;
#undef PG8_SA
#undef PG8_SB
#undef PG8_STAGE
#undef PG8_LDA
#undef PG8_LDB
#undef PG8_MMA
#undef PG8_WAIT_V
#undef PG8_WAIT_L
#undef PG8_BAR
#undef PG8_SCHED
}
}
namespace mk {
constexpr size_t O_YP = 0, O_YS = 8388608, O_NK = 25165824, O_NV = 33554432, O_S5R = 41943040, O_S5I = 42205184, O_SSD = 42467328,
                 O_MLC = 50855936, O_MLN = 59244544, O_MLM = 59310080;

__device__ __forceinline__ u32x4 pack8(const f32x4 a, const f32x4 b) { u32x4 w; w.x = pk2(a[0], a[1]); w.y = pk2(a[2], a[3]); w.z = pk2(b[0], b[1]); w.w = pk2(b[2], b[3]); return w; }

struct EpiIn {
    static constexpr bool PERM = true;
    bf16_t* proj; float* small; float* out; const float* qg; const float* kg; int layer;
    __device__ __forceinline__ void operator()(f32x4 (&acc)[2][2][4][2], const Unit& u, int wr, int wc, int fr, int fq) const {
        const int T = u.pn, rowb = u.pm * BM + wr * 64 + fr;
        if (T == 54) {
            if (wc == 0) {
#pragma unroll
                for (int ai = 0; ai < 2; ++ai)
#pragma unroll
                    for (int m = 0; m < 4; ++m) { float* sp = small + (size_t)(rowb + ai * HALF + m * 16) * 32 + 8 * fq; *(f32x4*)sp = acc[ai][0][m][0]; *(f32x4*)(sp + 4) = acc[ai][0][m][1]; }
            }
            return;
        }
        const int colb = T * 256 + 64 * wc + 8 * fq;
        if (T < 4) {
            const float* g = T < 2 ? qg : kg;
            f32x4 gv[2][2];
#pragma unroll
            for (int bj = 0; bj < 2; ++bj)
#pragma unroll
                for (int n = 0; n < 2; ++n) gv[bj][n] = *(const f32x4*)(g + 32 * bj + 8 * fq + 4 * n);
#pragma unroll
            for (int ai = 0; ai < 2; ++ai)
#pragma unroll
                for (int m = 0; m < 4; ++m) {
                    float ss = 0.f;
#pragma unroll
                    for (int bj = 0; bj < 2; ++bj)
#pragma unroll
                        for (int n = 0; n < 2; ++n) { const f32x4 x = acc[ai][bj][m][n]; ss += (x[0] * x[0] + x[1] * x[1]) + (x[2] * x[2] + x[3] * x[3]); }
                    ss += __shfl_xor(ss, 16); ss += __shfl_xor(ss, 32);
                    const float r = rsqrtf(ss * (1.f / 64.f) + 1e-6f);
                    const int row = rowb + ai * HALF + m * 16;
#pragma unroll
                    for (int bj = 0; bj < 2; ++bj) { const f32x4 v0 = acc[ai][bj][m][0] * r * gv[bj][0], v1 = acc[ai][bj][m][1] * r * gv[bj][1];
                        *(u32x4*)(proj + (size_t)row * PJ + colb + 32 * bj) = pack8(v0, v1);
                        if (T >= 2 && row < MP) { float* o = out + O_NK + ((size_t)((row >> 8) * DEPTH + layer) * 256 + (row & 255)) * 512 + (colb - 512) + 32 * bj; *(f32x4*)o = v0; *(f32x4*)(o + 4) = v1; } }
                }
        } else if (T < 6) {
#pragma unroll
            for (int ai = 0; ai < 2; ++ai)
#pragma unroll
                for (int m = 0; m < 4; ++m) { const int row = rowb + ai * HALF + m * 16;
#pragma unroll
                    for (int bj = 0; bj < 2; ++bj) { const f32x4 v0 = acc[ai][bj][m][0], v1 = acc[ai][bj][m][1];
                        *(u32x4*)(proj + (size_t)row * PJ + colb + 32 * bj) = pack8(v0, v1);
                        if (row < MP) { float* o = out + O_NV + ((size_t)((row >> 8) * DEPTH + layer) * 256 + (row & 255)) * 512 + (colb - 1024) + 32 * bj; *(f32x4*)o = v0; *(f32x4*)(o + 4) = v1; } } }
        } else if (T < 22) {
#pragma unroll
            for (int ai = 0; ai < 2; ++ai)
#pragma unroll
                for (int m = 0; m < 4; ++m) { const int row = rowb + ai * HALF + m * 16;
#pragma unroll
                    for (int bj = 0; bj < 2; ++bj) *(u32x4*)(proj + (size_t)row * PJ + colb + 32 * bj) = pack8(acc[ai][bj][m][0], acc[ai][bj][m][1]); }
        } else {
#pragma unroll
            for (int ai = 0; ai < 2; ++ai)
#pragma unroll
                for (int m = 0; m < 4; ++m) { const int row = rowb + ai * HALF + m * 16;
#pragma unroll
                    for (int bj = 0; bj < 2; ++bj) { f32x4 v0 = acc[ai][bj][m][0], v1 = acc[ai][bj][m][1];
#pragma unroll
                        for (int j = 0; j < 4; ++j) { v0[j] = fsigm(v0[j]); v1[j] = fsigm(v1[j]); }
                        *(u32x4*)(proj + (size_t)row * PJ + colb + 32 * bj) = pack8(v0, v1); } }
        }
    }
};
struct EpiRelu2 {
    static constexpr bool PERM = true;
    bf16_t* O; int ldo;
    __device__ __forceinline__ void operator()(f32x4 (&acc)[2][2][4][2], const Unit& u, int wr, int wc, int fr, int fq) const {
        const int rowb = u.pm * BM + wr * 64 + fr, colb = u.pn * 256 + 64 * wc + 8 * fq;
#pragma unroll
        for (int ai = 0; ai < 2; ++ai)
#pragma unroll
            for (int m = 0; m < 4; ++m) { const int row = rowb + ai * HALF + m * 16;
#pragma unroll
                for (int bj = 0; bj < 2; ++bj) { f32x4 v0 = acc[ai][bj][m][0], v1 = acc[ai][bj][m][1];
#pragma unroll
                    for (int j = 0; j < 4; ++j) { const float a = fmaxf(v0[j], 0.f), b = fmaxf(v1[j], 0.f); v0[j] = a * a; v1[j] = b * b; }
                    *(u32x4*)(O + (size_t)row * ldo + colb + 32 * bj) = pack8(v0, v1); } }
    }
};
struct EpiGlu {
    static constexpr bool PERM = true;
    const bf16_t* Z; const float* bias; bf16_t* br;
    __device__ __forceinline__ void operator()(f32x4 (&acc)[2][2][4][2], const Unit& u, int wr, int wc, int fr, int fq) const {
        const int rowb = u.pm * BM + wr * 64 + fr, colb = u.pn * 256 + 64 * wc + 8 * fq;
#pragma unroll
        for (int bj = 0; bj < 2; ++bj) { const int c = colb + 32 * bj; const f32x4 b0 = *(const f32x4*)(bias + c), b1 = *(const f32x4*)(bias + c + 4);
#pragma unroll
            for (int ai = 0; ai < 2; ++ai)
#pragma unroll
                for (int m = 0; m < 4; ++m) { const int row = rowb + ai * HALF + m * 16;
                    const u32x4 zz = *(const u32x4*)(Z + (size_t)row * 512 + c);
                    f32x4 v0 = acc[ai][bj][m][0] + b0, v1 = acc[ai][bj][m][1] + b1;
                    v0[0] = bflo(zz.x) * fsigm(v0[0]); v0[1] = bfhi(zz.x) * fsigm(v0[1]); v0[2] = bflo(zz.y) * fsigm(v0[2]); v0[3] = bfhi(zz.y) * fsigm(v0[3]);
                    v1[0] = bflo(zz.z) * fsigm(v1[0]); v1[1] = bfhi(zz.z) * fsigm(v1[1]); v1[2] = bflo(zz.w) * fsigm(v1[2]); v1[3] = bfhi(zz.w) * fsigm(v1[3]);
                    *(u32x4*)(br + (size_t)row * D + 512 + c) = pack8(v0, v1); } }
    }
};
struct EpiBranch {
    static constexpr bool PERM = true;
    const bf16_t* proj; bf16_t* merged;
    __device__ __forceinline__ void operator()(f32x4 (&acc)[2][2][4][2], const Unit& u, int wr, int wc, int fr, int fq) const {
        const int rowb = u.pm * BM + wr * 64 + fr, colb = u.pn * 256 + 64 * wc + 8 * fq, kz = u.kz;
#pragma unroll
        for (int ai = 0; ai < 2; ++ai)
#pragma unroll
            for (int m = 0; m < 4; ++m) { const int row = rowb + ai * HALF + m * 16;
#pragma unroll
                for (int bj = 0; bj < 2; ++bj) { const int c = colb + 32 * bj;
                    const u32x4 gg = *(const u32x4*)(proj + (size_t)row * PJ + P_GATE + kz * D + c);
                    float g[8] = {bflo(gg.x), bfhi(gg.x), bflo(gg.y), bfhi(gg.y), bflo(gg.z), bfhi(gg.z), bflo(gg.w), bfhi(gg.w)};
                    if (kz < 3) { const u32x4 hh = *(const u32x4*)(proj + (size_t)row * PJ + P_GATE + (kz + 1) * D + c);
                        const float h[8] = {bflo(hh.x), bfhi(hh.x), bflo(hh.y), bfhi(hh.y), bflo(hh.z), bfhi(hh.z), bflo(hh.w), bfhi(hh.w)};
#pragma unroll
                        for (int j = 0; j < 8; ++j) g[j] = g[j] * __builtin_amdgcn_rcpf(fmaxf(h[j], 1e-30f)); }
                    f32x4& v0 = acc[ai][bj][m][0]; f32x4& v1 = acc[ai][bj][m][1];
                    v0[0] *= g[0]; v0[1] *= g[1]; v0[2] *= g[2]; v0[3] *= g[3]; v1[0] *= g[4]; v1[1] *= g[5]; v1[2] *= g[6]; v1[3] *= g[7];
                    if (kz == 3) *(u32x4*)(merged + (size_t)row * D + c) = pack8(v0, v1); } }
    }
};
struct EpiResid {
    static constexpr bool PERM = false;
    const float* xp; const float* xs; const float* modl; int g_off; float* xout; float* part;
    __device__ __forceinline__ void operator()(f32x4 (&acc)[2][2][4][2], const Unit& u, int wr, int wc, int fr, int fq) const {
        if (part != nullptr && u.pm >= 32) {
            float* P = part + (size_t)((((u.pm - 32) * 8 + u.pn) * 2) + (u.koff != 0)) * 65536 + (size_t)(wr * 64 + fr) * 256 + wc * 32 + 4 * fq;
#pragma unroll
            for (int ai = 0; ai < 2; ++ai)
#pragma unroll
                for (int m = 0; m < 4; ++m)
#pragma unroll
                    for (int bj = 0; bj < 2; ++bj)
#pragma unroll
                        for (int n = 0; n < 2; ++n) *(f32x4*)(P + (size_t)(ai * HALF + m * 16) * 256 + bj * HALF + n * 16) = acc[ai][bj][m][n];
            return;
        }
        const int row0 = u.pm * BM, rowb = row0 + wr * 64 + fr, colb = u.pn * 256 + wc * 32 + 4 * fq;
        const float* xin = row0 < MP ? xp : xs - (size_t)MP * D;
        const float* gate = modl + (size_t)row_cvec(row0) * 6 * D + g_off;
        f32x4 gv[2][2];
#pragma unroll
        for (int bj = 0; bj < 2; ++bj)
#pragma unroll
            for (int n = 0; n < 2; ++n) gv[bj][n] = *(const f32x4*)(gate + colb + bj * HALF + n * 16);
#pragma unroll
        for (int ai = 0; ai < 2; ++ai)
#pragma unroll
            for (int m = 0; m < 4; ++m) { const size_t ro = (size_t)(rowb + ai * HALF + m * 16) * D + colb;
#pragma unroll
                for (int bj = 0; bj < 2; ++bj)
#pragma unroll
                    for (int n = 0; n < 2; ++n) { const size_t o = ro + bj * HALF + n * 16; *(f32x4*)(xout + o) = *(const f32x4*)(xin + o) + gv[bj][n] * acc[ai][bj][m][n]; } }
    }
};
}
namespace mk {
constexpr size_t AL(size_t x) { return (x + 255) & ~(size_t)255; }
constexpr size_t WS_CTL = 0, CTL_BYTES = 65536;
constexpr size_t WS_MOD = WS_CTL + CTL_BYTES;
constexpr size_t WS_W = AL(WS_MOD + (size_t)DEPTH * 5 * 6 * D * 4);
constexpr size_t W_IN = 0, W_GLU = W_IN + (size_t)NIN * D, W_BR = W_GLU + 512 * 512, W_OUT = W_BR + (size_t)4 * D * 512, W_1 = W_OUT + (size_t)D * D, W_2 = W_1 + (size_t)DFF * D,
                 W_LAYER = W_2 + (size_t)D * DFF;
constexpr size_t WS_H = AL(WS_W + W_LAYER * 2 * DEPTH);
constexpr size_t WS_PROJ = AL(WS_H + (size_t)M * D * 2);
constexpr size_t WS_SMALL = AL(WS_PROJ + (size_t)M * PJ * 2);
constexpr size_t WS_BR = AL(WS_SMALL + (size_t)M * 32 * 4);
constexpr size_t WS_MERGED = AL(WS_BR + (size_t)M * D * 2);
constexpr size_t WS_MACC = AL(WS_MERGED + (size_t)M * D * 2);
constexpr size_t WS_ZB = AL(WS_MACC + (size_t)M * D * 4);
constexpr size_t WS_SCR = AL(WS_ZB + (size_t)M * 512 * 2);
constexpr int LDS_BYTES = 140 * 1024, LDS_CTL = LDS_BYTES - 256;

struct Args { const float* in[43]; float* out; unsigned char* ws; int ph_lo, ph_hi; };

__device__ __forceinline__ float wave_sum(float v) {
#pragma unroll
    for (int o = 1; o < 64; o <<= 1) v += __shfl_xor(v, o);
    return v;
}
#define LDS_WAIT() asm volatile("s_waitcnt lgkmcnt(0)" ::: "memory")

__device__ __forceinline__ void xpose_item(const float* W, int ldw, int k0, int sc, bf16_t* dst, int K, LAS float* scr, int lane, int mode) {
    const int j = lane & 31;
    const int col = mode == 1 ? (j < 16 ? 3584 + j : 5648 + (j - 16)) : sc + j;
#pragma unroll 8
    for (int i = 0; i < 32; ++i) { const int kk = 2 * i + (lane >> 5); scr[kk * 33 + j] = mode == 2 ? 0.f : W[(size_t)(k0 + kk) * ldw + col]; }
    LDS_WAIT(); asm volatile("" ::: "memory");
    const int c = lane & 7;
#pragma unroll
    for (int jj = 0; jj < 4; ++jj) { const int n = (lane >> 3) + 8 * jj; const LAS float* s = scr + (8 * c) * 33 + n;
        u32x4 o; o.x = pk2(s[0 * 33], s[1 * 33]); o.y = pk2(s[2 * 33], s[3 * 33]); o.z = pk2(s[4 * 33], s[5 * 33]); o.w = pk2(s[6 * 33], s[7 * 33]);
        *(u32x4*)(dst + (size_t)n * K + k0 + 8 * c) = o; }
    LDS_WAIT(); asm volatile("" ::: "memory");
}
__device__ __forceinline__ int hm_col(int grp) { const int T = grp >> 3, q8 = grp & 7; return 256 * T + 32 * (2 * (q8 & 3) + (q8 >> 2)); }

__device__ __forceinline__ void prologue_convert(const Args& a, LAS unsigned char* lds, int gw, int ngw, int wave, int lane) {
    LAS float* scr = (LAS float*)(lds + wave * 8704);
    bf16_t* WB = (bf16_t*)(a.ws + WS_W);
    constexpr int I_IN = 440 * 32, I_GLU = 16 * 8, I_BR = 4 * 64 * 8, I_OUT = 64 * 32, I_1 = 256 * 32, I_2 = 64 * 128, I_L = I_IN + I_GLU + I_BR + I_OUT + I_1 + I_2;
    for (int it = gw; it < I_L * DEPTH; it += ngw) {
        const int l = it / I_L; int r = it - l * I_L; bf16_t* wl = WB + (size_t)l * W_LAYER;
        if (r < I_IN) { const int kb = r / 440, grp = r % 440, T = grp >> 3; int sc = hm_col(grp), mode = 0;
            if (T == 54) mode = (grp & 7) == 0 ? 1 : 2; else if (T >= 22) sc += 32; else if (T >= 14) sc += 16;
            xpose_item(a.in[16] + (size_t)l * D * 13856, 13856, 64 * kb, sc, wl + W_IN + (size_t)(32 * grp) * D, D, scr, lane, mode); continue; } r -= I_IN;
        if (r < I_GLU) { const int kb = r / 16, grp = r % 16; xpose_item(a.in[28] + (size_t)l * 512 * 512, 512, 64 * kb, hm_col(grp), wl + W_GLU + (size_t)(32 * grp) * 512, 512, scr, lane, 0); continue; } r -= I_GLU;
        if (r < I_BR) { const int k = r / 512, r2 = r % 512, kb = r2 / 64, grp = r2 % 64;
            xpose_item(a.in[39] + ((size_t)l * 4 + k) * 512 * D, D, 64 * kb, hm_col(grp), wl + W_BR + (size_t)k * D * 512 + (size_t)(32 * grp) * 512, 512, scr, lane, 0); continue; } r -= I_BR;
        if (r < I_OUT) { const int kb = r / 64, grp = r % 64; xpose_item(a.in[40] + (size_t)l * D * D, D, 64 * kb, 32 * grp, wl + W_OUT + (size_t)(32 * grp) * D, D, scr, lane, 0); continue; } r -= I_OUT;
        if (r < I_1) { const int kb = r / 256, grp = r % 256; xpose_item(a.in[41] + (size_t)l * D * DFF, DFF, 64 * kb, hm_col(grp), wl + W_1 + (size_t)(32 * grp) * D, D, scr, lane, 0); continue; } r -= I_1;
        { const int kb = r / 64, grp = r % 64; xpose_item(a.in[42] + (size_t)l * DFF * D, D, 64 * kb, 32 * grp, wl + W_2 + (size_t)(32 * grp) * DFF, DFF, scr, lane, 0); }
    }
}
__device__ __forceinline__ void prologue_ada(const Args& a, LAS unsigned char* lds, int tid) {
    LAS float* sl = (LAS float*)lds;
    LAS float* red = (LAS float*)(lds + 40960);
    float* mod = (float*)(a.ws + WS_MOD);
    for (int i = tid; i < 5 * D; i += NT) { const int j = i / D, k = i % D; const float x = j == 0 ? a.in[11][k] : a.in[10][(j - 1) * D + k]; sl[i] = x / (1.f + __expf(-x)); }
    __syncthreads();
    const int ks = tid >> 6, c = tid & 63;
    for (int unit = blockIdx.x; unit < DEPTH * 6 * D / 64; unit += gridDim.x) {
        const int l = unit / (6 * D / 64), n0 = (unit % (6 * D / 64)) * 64;
        const float* w = a.in[12] + (size_t)l * D * 6 * D + n0 + c;
        float acc[5] = {0.f, 0.f, 0.f, 0.f, 0.f};
#pragma unroll 4
        for (int k = ks * 256; k < ks * 256 + 256; ++k) { const float wv = w[(size_t)k * 6 * D];
#pragma unroll
            for (int j = 0; j < 5; ++j) acc[j] += sl[j * D + k] * wv; }
#pragma unroll
        for (int j = 0; j < 5; ++j) red[(ks * 5 + j) * 64 + c] = acc[j];
        __syncthreads();
        if (tid < 320) { const int j = tid >> 6; float s = 0.f;
#pragma unroll
            for (int q = 0; q < 8; ++q) s += red[(q * 5 + j) * 64 + c];
            mod[((size_t)l * 5 + j) * 6 * D + n0 + c] = s + a.in[13][l * 6 * D + n0 + c]; }
        __syncthreads();
    }
}
__device__ __forceinline__ void norm_phase(const float* xp, const float* xs, const float* g, const float* modl, int sh_off, int sc_off, bf16_t* H, int gw, int ngw, int lane_,
                                           const float* pend, const float* pmodl, int pg_off, float* xw, const float* xs_pend) {
    int lane = lane_; asm volatile("" : "+v"(lane));
    for (int row = gw; row < M; row += ngw) {
        const float* x = row < MP ? xp + (size_t)row * D : xs + (size_t)(row - MP) * D;
        if (pend != nullptr && row >= 8192) x = xs_pend + (size_t)(row - MP) * D;
        f32x4 v[8]; float ss = 0.f;
#pragma unroll
        for (int j = 0; j < 8; ++j) v[j] = *(const f32x4*)(x + 4 * (lane + 64 * j));
        if (pend != nullptr && row >= 8192) {
            const float* pg = pmodl + (size_t)row_cvec(row) * 6 * D + pg_off; const int pm = row >> 8, r = row & 255;
#pragma unroll
            for (int j = 0; j < 8; ++j) { const int col = 4 * (lane + 64 * j), pn = col >> 8, cc = col & 255;
                const float* P = pend + (size_t)(((pm - 32) * 8 + pn) * 2) * 65536 + (size_t)r * 256 + cc;
                const f32x4 pa = *(const f32x4*)P, pb = *(const f32x4*)(P + 65536), gg = *(const f32x4*)(pg + col);
                v[j] = v[j] + gg * (pa + pb); *(f32x4*)(xw + (size_t)row * D + col) = v[j]; }
        }
#pragma unroll
        for (int j = 0; j < 8; ++j) ss += (v[j][0] * v[j][0] + v[j][1] * v[j][1]) + (v[j][2] * v[j][2] + v[j][3] * v[j][3]);
        const float r = rsqrtf(wave_sum(ss) * (1.f / D) + 1e-6f);
        const float* md = modl + (size_t)row_cvec(row) * 6 * D;
#pragma unroll
        for (int j = 0; j < 8; ++j) { const int i = 4 * (lane + 64 * j);
            const f32x4 gg = *(const f32x4*)(g + i), sc = *(const f32x4*)(md + sc_off + i), sh = *(const f32x4*)(md + sh_off + i);
            const f32x4 o = v[j] * r * gg * (sc + 1.f) + sh;
            u32x2 w; w.x = pk2(o[0], o[1]); w.y = pk2(o[2], o[3]); *(u32x2*)(H + (size_t)row * D + i) = w; }
    }
}
__device__ __forceinline__ void final_fix_phase(const float* pend, const float* pmodl, int pg_off, float* X, int gw, int ngw, int lane_) {
    int lane = lane_; asm volatile("" : "+v"(lane));
    for (int row = 8192 + gw; row < M; row += ngw) {
        const float* pg = pmodl + (size_t)row_cvec(row) * 6 * D + pg_off; const int pm = row >> 8, r = row & 255;
#pragma unroll
        for (int j = 0; j < 8; ++j) { const int col = 4 * (lane + 64 * j), pn = col >> 8, cc = col & 255;
            const float* P = pend + (size_t)(((pm - 32) * 8 + pn) * 2) * 65536 + (size_t)r * 256 + cc;
            const f32x4 pa = *(const f32x4*)P, pb = *(const f32x4*)(P + 65536), gg = *(const f32x4*)(pg + col);
            float* xo = X + (size_t)row * D + col; *(f32x4*)xo = *(const f32x4*)xo + gg * (pa + pb); }
    }
}
}
namespace mk {
constexpr size_t WS_NAT = AL(WS_SCR);
constexpr int NATP = 2048, N_XBC = 0, N_Q = 1024, N_K = 1536;
constexpr size_t WS_TR = AL(WS_NAT + (size_t)M * NATP * 2);
constexpr int T_X = 0, T_B = 512, T_K = 768, T_MV = 1280, T_V = 1792, TRR = 2304;
constexpr int NCH = 96;
constexpr size_t WS_MLC = AL(WS_TR + (size_t)TRR * M * 2);
constexpr size_t WS_MLN = AL(WS_MLC + (size_t)NCH * 4 * 2 * 16384 * 4);
constexpr size_t WS_MLS = AL(WS_MLN + (size_t)NCH * 4 * 2 * 128 * 4);
constexpr size_t WS_MLCS = AL(WS_MLS + (size_t)NCH * 4 * 2 * 4 * 4);
constexpr size_t WS_MLNS = AL(WS_MLCS + (size_t)NCH * 4 * 2 * 16384 * 2);
constexpr size_t WS_MLMS = AL(WS_MLNS + (size_t)NCH * 4 * 2 * 128 * 4);
constexpr size_t WS_OPT_END = AL(WS_MLMS + (size_t)NCH * 4 * 2 * 4);

__device__ __forceinline__ f32x4 mfma16(bf16x8 a, bf16x8 b, f32x4 c) { return __builtin_amdgcn_mfma_f32_16x16x32_bf16(a, b, c, 0, 0, 0); }
__device__ __forceinline__ void chunk_info(int ch, int& row0, int& seq0, int& L, int& lat, int& b, int& ci, int& nc) {
    if (ch < 32) { b = ch >> 1; ci = ch & 1; nc = 2; seq0 = b * 256; L = 256; lat = 0; } else { const int c2 = ch - 32; b = c2 >> 4; ci = c2 & 15; nc = 16; seq0 = MP + b * 2048; L = 2048; lat = 1; }
    row0 = seq0 + ci * 128;
}
__device__ __forceinline__ float fast_exp(float x) { return __expf(x); }

__device__ __forceinline__ void prep_phase(const Args& a, int layer, LAS unsigned char* lds, int gw_, int ngw, int wave, int lane_, bf16_t* UPk) {
    int lane = lane_, gw = gw_; asm volatile("" : "+v"(lane));
    const bf16_t* PROJ = (const bf16_t*)(a.ws + WS_PROJ); bf16_t* NAT = (bf16_t*)(a.ws + WS_NAT); bf16_t* TR = (bf16_t*)(a.ws + WS_TR);
    LAS bf16_t* tile = (LAS bf16_t*)(lds + wave * 16896); LAS bf16_t* otile = tile + 68 * 64;
    const int c = lane & 7, r8 = lane >> 3;
    const float* cw = a.in[30] + layer * 5 * 1024; const float* cb = a.in[31] + layer * 1024;
    for (int u = gw; u < 56 * 192; u += ngw) {
        const int cg = u / 192, tt = u % 192, m0 = tt * 64;
        const int lat = m0 >= MP; const int seq0 = lat ? MP + ((m0 - MP) / 2048) * 2048 : (m0 / 256) * 256, L = lat ? 2048 : 256, t0 = m0 - seq0;
        int kind, src, natcol = -1, trrow = -1;
        if (cg < 16) { kind = 0; src = P_XBC + 64 * cg; natcol = N_XBC + 64 * cg; if (cg < 12) trrow = T_X + 64 * cg; }
        else if (cg < 24) { kind = 1; src = P_MQ + 64 * (cg - 16); natcol = N_Q + 64 * (cg - 16); }
        else if (cg < 32) { kind = 2; src = P_MK + 64 * (cg - 24); natcol = N_K + 64 * (cg - 24); trrow = T_K + 64 * (cg - 24); }
        else if (cg < 40) { kind = 3; src = P_MV + 64 * (cg - 32); trrow = T_MV + 64 * (cg - 32); }
        else if (cg < 48) { kind = 3; src = P_V + 64 * (cg - 40); trrow = T_V + 64 * (cg - 40); }
        else { kind = 4; src = P_S5U + 64 * (cg - 48); }
        const int roff = kind == 0 ? -2 : 0, nrows = kind == 0 ? 68 : 64;
#pragma unroll
        for (int i = 0; i < 9; ++i) { const int r = r8 + 8 * i; if (r < nrows) { const int t = t0 + r + roff; u32x4 v = {0u, 0u, 0u, 0u};
                if (t >= 0 && t < L) v = *(const u32x4*)(PROJ + (size_t)(seq0 + t) * PJ + src + 8 * c);
                *(LAS u32x4*)(tile + r * 64 + 8 * c) = v; } }
        LDS_WAIT(); asm volatile("" ::: "memory");
#define PREP_EMIT(i_, r_) do { if (natcol >= 0) *(u32x4*)(NAT + (size_t)(m0 + r8 + 8 * (i_)) * NATP + natcol + 8 * c) = (r_); if (trrow >= 0) *(LAS u32x4*)(otile + (r8 + 8 * (i_)) * 64 + 8 * c) = (r_); } while (0)
        if (kind == 0) {
            float w[5][8], bz[8];
#pragma unroll
            for (int e = 0; e < 8; ++e) { bz[e] = cb[64 * cg + 8 * c + e];
#pragma unroll
                for (int j = 0; j < 5; ++j) w[j][e] = cw[j * 1024 + 64 * cg + 8 * c + e]; }
#pragma unroll 2
            for (int i = 0; i < 8; ++i) { const int tk = r8 + 8 * i; float acc[8];
#pragma unroll
                for (int e = 0; e < 8; ++e) acc[e] = bz[e];
#pragma unroll
                for (int j = 0; j < 5; ++j) { const u32x4 v = *(const LAS u32x4*)(tile + (tk + j) * 64 + 8 * c);
                    acc[0] += bflo(v.x) * w[j][0]; acc[1] += bfhi(v.x) * w[j][1]; acc[2] += bflo(v.y) * w[j][2]; acc[3] += bfhi(v.y) * w[j][3];
                    acc[4] += bflo(v.z) * w[j][4]; acc[5] += bfhi(v.z) * w[j][5]; acc[6] += bflo(v.w) * w[j][6]; acc[7] += bfhi(v.w) * w[j][7]; }
#pragma unroll
                for (int e = 0; e < 8; ++e) acc[e] = fsilu(acc[e]);
                u32x4 rv; rv.x = pk2(acc[0], acc[1]); rv.y = pk2(acc[2], acc[3]); rv.z = pk2(acc[4], acc[5]); rv.w = pk2(acc[6], acc[7]); PREP_EMIT(i, rv); }
        } else if (kind == 4) {
#pragma unroll
            for (int i = 0; i < 8; ++i) { const int tk = r8 + 8 * i, m = m0 + tk; const u32x4 v = *(const LAS u32x4*)(tile + tk * 64 + 8 * c);
                *(u32x4*)(UPk + ((size_t)(4 * (cg - 48) + (c >> 1)) * 384 + (m >> 5)) * 512 + (m & 31) * 16 + 8 * (c & 1)) = v; }
        } else if (kind == 3 || !lat) {
            const float sc = kind == 2 ? 0.08838834764831845f : 1.f;
#pragma unroll
            for (int i = 0; i < 8; ++i) { const u32x4 v = *(const LAS u32x4*)(tile + (r8 + 8 * i) * 64 + 8 * c);
                u32x4 rv = v;
                if (kind == 2) { rv.x = pk2(bflo(v.x) * sc, bfhi(v.x) * sc); rv.y = pk2(bflo(v.y) * sc, bfhi(v.y) * sc); rv.z = pk2(bflo(v.z) * sc, bfhi(v.z) * sc); rv.w = pk2(bflo(v.w) * sc, bfhi(v.w) * sc); }
                PREP_EMIT(i, rv); }
        } else {
            const float sc = kind == 2 ? 0.08838834764831845f : 1.f; const int odd = cg & 1;
            float inv[8];
#pragma unroll
            for (int e = 0; e < 8; ++e) inv[e] = exp2f(-(float)(8 * (c & 3) + e) * (13.287712379549449f / 32.f));
#pragma unroll
            for (int i = 0; i < 8; ++i) { const int tk = r8 + 8 * i, t = t0 + tk; const float pos = odd ? (float)(t & 63) : (float)(t >> 6);
                const u32x4 vo = *(const LAS u32x4*)(tile + tk * 64 + 8 * c), vp = *(const LAS u32x4*)(tile + tk * 64 + 8 * (c ^ 4));
                float o[8], p[8], rr[8];
                o[0] = bflo(vo.x); o[1] = bfhi(vo.x); o[2] = bflo(vo.y); o[3] = bfhi(vo.y); o[4] = bflo(vo.z); o[5] = bfhi(vo.z); o[6] = bflo(vo.w); o[7] = bfhi(vo.w);
                p[0] = bflo(vp.x); p[1] = bfhi(vp.x); p[2] = bflo(vp.y); p[3] = bfhi(vp.y); p[4] = bflo(vp.z); p[5] = bfhi(vp.z); p[6] = bflo(vp.w); p[7] = bfhi(vp.w);
#pragma unroll
                for (int e = 0; e < 8; ++e) { const float ang = pos * inv[e], cs = __cosf(ang), sn = __sinf(ang);
                    rr[e] = (c < 4 ? o[e] * cs - p[e] * sn : p[e] * sn + o[e] * cs) * sc; }
                u32x4 rv; rv.x = pk2(rr[0], rr[1]); rv.y = pk2(rr[2], rr[3]); rv.z = pk2(rr[4], rr[5]); rv.w = pk2(rr[6], rr[7]); PREP_EMIT(i, rv); }
        }
        if (trrow >= 0) {
            LDS_WAIT(); asm volatile("" ::: "memory");
            bf16_t* dst = TR + (size_t)(trrow + lane) * M + m0;
#pragma unroll
            for (int j = 0; j < 8; ++j) { unsigned wv[4];
#pragma unroll
                for (int q = 0; q < 4; ++q) { const unsigned lo = otile[(8 * j + 2 * q) * 64 + lane], hi = otile[(8 * j + 2 * q + 1) * 64 + lane]; wv[q] = lo | (hi << 16); }
                u32x4 o; o.x = wv[0]; o.y = wv[1]; o.z = wv[2]; o.w = wv[3]; *(u32x4*)(dst + 8 * j) = o; }
        }
        LDS_WAIT(); asm volatile("" ::: "memory");
    }
}

struct MlGate { float lf0, lf1, ig0, ig1, P0, P1, tot; };
__device__ __forceinline__ float wave_incl_scan(float v, int lane) {
#pragma unroll
    for (int o = 1; o < 64; o <<= 1) { const float t = __shfl_up(v, o); if (lane >= o) v += t; }
    return v;
}
__device__ __forceinline__ float wave_max(float v) {
#pragma unroll
    for (int o = 1; o < 64; o <<= 1) v = fmaxf(v, __shfl_xor(v, o));
    return v;
}
__device__ __forceinline__ MlGate ml_gates(const Args& a, int layer, int row0, int hh, int dir, int lane) {
    const float* SMALL = (const float*)(a.ws + WS_SMALL);
    const float ib = a.in[36][layer * 8 + dir * 4 + hh], fb = a.in[37][layer * 8 + dir * 4 + hh];
    MlGate g;
    const float f0 = SMALL[(size_t)(row0 + lane) * 32 + S_MF + dir * 4 + hh] + fb, f1 = SMALL[(size_t)(row0 + lane + 64) * 32 + S_MF + dir * 4 + hh] + fb;
    g.ig0 = SMALL[(size_t)(row0 + lane) * 32 + S_MI + dir * 4 + hh] + ib; g.ig1 = SMALL[(size_t)(row0 + lane + 64) * 32 + S_MI + dir * 4 + hh] + ib;
    g.lf0 = fminf(f0, 0.f) - log1pf(__expf(-fabsf(f0))); g.lf1 = fminf(f1, 0.f) - log1pf(__expf(-fabsf(f1)));
    const float s0 = wave_incl_scan(g.lf0, lane); const float tot0 = __shfl(s0, 63);
    const float s1 = wave_incl_scan(g.lf1, lane) + tot0;
    g.P0 = s0; g.P1 = s1; g.tot = __shfl(s1, 63);
    return g;
}

__device__ __forceinline__ void ml_states_phase(const Args& a, int layer, int tid_, int G) {
    int tid = tid_; asm volatile("" : "+v"(tid));
    const int lane = tid & 63, wave = __builtin_amdgcn_readfirstlane(tid >> 6), fr = lane & 15, fq = lane >> 4;
    const bf16_t* TR = (const bf16_t*)(a.ws + WS_TR);
    float* MLC = (float*)(a.ws + WS_MLC); float* MLN = (float*)(a.ws + WS_MLN); float* MLS = (float*)(a.ws + WS_MLS);
    for (int u = blockIdx.x; u < NCH * 4; u += G) {
        const int ch = u >> 2, hh = u & 3; int row0, seq0, L, lat, b, ci, nc; chunk_info(ch, row0, seq0, L, lat, b, ci, nc);
#pragma unroll
        for (int dir = 0; dir < 2; ++dir) {
            const MlGate g = ml_gates(a, layer, row0, hh, dir, lane);
            const float w0 = (dir == 0 ? g.tot - g.P0 : g.P0 - g.lf0) + g.ig0, w1 = (dir == 0 ? g.tot - g.P1 : g.P1 - g.lf1) + g.ig1;
            const float mloc = wave_max(fmaxf(w0, w1));
            const float e0 = __expf(w0 - mloc), e1 = __expf(w1 - mloc);
            f32x4 acc[8];
#pragma unroll
            for (int j = 0; j < 8; ++j) acc[j] = (f32x4){0.f, 0.f, 0.f, 0.f};
            float nacc[8];
#pragma unroll
            for (int j = 0; j < 8; ++j) nacc[j] = 0.f;
            const bf16_t* vrow = TR + (size_t)(T_MV + hh * 128 + wave * 16 + fr) * M + row0 + 8 * fq;
#pragma unroll
            for (int ks = 0; ks < 4; ++ks) {
                const bf16x8 af = *(const bf16x8*)(vrow + 32 * ks);
                float ev[8];
#pragma unroll
                for (int j = 0; j < 8; ++j) { const int tok = 32 * ks + 8 * fq + j; const float x0 = __shfl(e0, tok & 63), x1 = __shfl(e1, tok & 63); ev[j] = tok < 64 ? x0 : x1; }
#pragma unroll
                for (int jt = 0; jt < 8; ++jt) {
                    const u32x4 kv = *(const u32x4*)(TR + (size_t)(T_K + hh * 128 + jt * 16 + fr) * M + row0 + 32 * ks + 8 * fq);
                    const float k0 = bflo(kv.x) * ev[0], k1 = bfhi(kv.x) * ev[1], k2 = bflo(kv.y) * ev[2], k3 = bfhi(kv.y) * ev[3], k4 = bflo(kv.z) * ev[4], k5 = bfhi(kv.z) * ev[5], k6 = bflo(kv.w) * ev[6], k7 = bfhi(kv.w) * ev[7];
                    if (wave == 0) nacc[jt] += ((k0 + k1) + (k2 + k3)) + ((k4 + k5) + (k6 + k7));
                    u32x4 kb; kb.x = pk2(k0, k1); kb.y = pk2(k2, k3); kb.z = pk2(k4, k5); kb.w = pk2(k6, k7);
                    acc[jt] = mfma16(af, __builtin_bit_cast(bf16x8, kb), acc[jt]);
                }
            }
            float* cdst = MLC + ((size_t)(ch * 4 + hh) * 2 + dir) * 16384;
#pragma unroll
            for (int jt = 0; jt < 8; ++jt)
#pragma unroll
                for (int i = 0; i < 4; ++i) cdst[(size_t)(wave * 16 + 4 * fq + i) * 128 + jt * 16 + fr] = acc[jt][i];
            if (wave == 0) {
#pragma unroll
                for (int jt = 0; jt < 8; ++jt) { float v = nacc[jt]; v += __shfl_xor(v, 16); v += __shfl_xor(v, 32); if (fq == 0) MLN[((size_t)(ch * 4 + hh) * 2 + dir) * 128 + jt * 16 + fr] = v; }
                if (lane == 0) { MLS[((size_t)(ch * 4 + hh) * 2 + dir) * 4 + 0] = mloc; MLS[((size_t)(ch * 4 + hh) * 2 + dir) * 4 + 1] = g.tot; }
            }
        }
    }
}
__device__ __forceinline__ void ml_scan_phase(const Args& a, int layer, int tid_, int G) {
    int tid = tid_; asm volatile("" : "+v"(tid));
    const float* MLC = (const float*)(a.ws + WS_MLC); const float* MLN = (const float*)(a.ws + WS_MLN); const float* MLS = (const float*)(a.ws + WS_MLS);
    bf16_t* CS = (bf16_t*)(a.ws + WS_MLCS); float* NS = (float*)(a.ws + WS_MLNS); float* MS = (float*)(a.ws + WS_MLMS);
    for (int task = blockIdx.x; task < 256; task += G) {
        int lat, b, hh, dir, part, nparts;
        if (task < 128) { lat = 1; part = task & 3; dir = (task >> 2) & 1; hh = (task >> 3) & 3; b = task >> 5; nparts = 4; }
        else { const int t2 = task - 128; lat = 0; part = 0; dir = t2 & 1; hh = (t2 >> 1) & 3; b = t2 >> 3; nparts = 1; }
        const int nc = lat ? 16 : 2, ch0 = lat ? 32 + b * 16 : b * 2;
        const int nel = 16384 / nparts, e0 = part * nel, per = nel / NT;
        float c[32]; float n = 0.f, m = 0.f;
        const size_t so = (((size_t)b * DEPTH + layer) * 2 + dir) * 4 + hh;
#pragma unroll
        for (int i = 0; i < 32; ++i) if (i < per) { const int e = e0 + i * NT + tid, vd = e >> 7, kd = e & 127; c[i] = lat ? a.in[7][(so * 128 + kd) * 128 + vd] : 0.f; }
        if (tid < 128) n = lat ? a.in[8][so * 128 + tid] : 0.f;
        m = lat ? a.in[9][so] : 0.f;
        for (int s = 0; s < nc; ++s) { const int ci = dir ? nc - 1 - s : s, ch = ch0 + ci; const size_t sb = (size_t)(ch * 4 + hh) * 2 + dir;
#pragma unroll
            for (int i = 0; i < 32; ++i) if (i < per) CS[sb * 16384 + e0 + i * NT + tid] = f2bf(c[i]);
            if (part == 0) { if (tid < 128) NS[sb * 128 + tid] = n; if (tid == 0) MS[sb] = m; }
            const float ml = MLS[sb * 4 + 0], bl = MLS[sb * 4 + 1];
            const float mn = fmaxf(bl + m, ml), fa = __expf(bl + m - mn), fb = __expf(ml - mn);
#pragma unroll
            for (int i = 0; i < 32; ++i) if (i < per) c[i] = fa * c[i] + fb * MLC[sb * 16384 + e0 + i * NT + tid];
            if (tid < 128) n = fa * n + fb * MLN[sb * 128 + tid];
            m = mn; }
        if (!lat) {
#pragma unroll
            for (int i = 0; i < 32; ++i) if (i < per) { const int e = e0 + i * NT + tid, vd = e >> 7, kd = e & 127; a.out[O_MLC + (so * 128 + kd) * 128 + vd] = c[i]; }
            if (tid < 128) a.out[O_MLN + so * 128 + tid] = n; if (tid == 0) a.out[O_MLM + so] = m; }
    }
}
__device__ __forceinline__ void ml_out_phase(const Args& a, int layer, LAS unsigned char* lds, int tid_, int G) {
    int tid = tid_; asm volatile("" : "+v"(tid));
    const int lane = tid & 63, wave = __builtin_amdgcn_readfirstlane(tid >> 6), fr = lane & 15, fq = lane >> 4;
    const bf16_t* NAT = (const bf16_t*)(a.ws + WS_NAT); const bf16_t* TR = (const bf16_t*)(a.ws + WS_TR); const bf16_t* PROJ = (const bf16_t*)(a.ws + WS_PROJ);
    const bf16_t* CS = (const bf16_t*)(a.ws + WS_MLCS); const float* NS = (const float*)(a.ws + WS_MLNS); const float* MS = (const float*)(a.ws + WS_MLMS);
    bf16_t* BR = (bf16_t*)(a.ws + WS_BR);
    LAS float* U = (LAS float*)lds; LAS float* Wv = U + 128; LAS float* SI = U + 256; LAS float* EM = U + 384; LAS float* NSs = U + 512;
    for (int u = blockIdx.x; u < NCH * 4; u += G) {
        const int ch = u >> 2, hh = u & 3; int row0, seq0, L, lat, b, ci, nc; chunk_info(ch, row0, seq0, L, lat, b, ci, nc);
        const int t = wave * 16 + fr;
        bf16x8 qf[4];
#pragma unroll
        for (int ks = 0; ks < 4; ++ks) qf[ks] = *(const bf16x8*)(NAT + (size_t)(row0 + t) * NATP + N_Q + hh * 128 + 32 * ks + 8 * fq);
        f32x4 hsum[8];
#pragma unroll
        for (int j = 0; j < 8; ++j) hsum[j] = (f32x4){0.f, 0.f, 0.f, 0.f};
#pragma unroll 1
        for (int dir = 0; dir < 2; ++dir) {
            const size_t sb = (size_t)(ch * 4 + hh) * 2 + dir;
            __syncthreads();
            if (wave == 0) {
                const MlGate g = ml_gates(a, layer, row0, hh, dir, lane); const float ms = MS[sb];
                float u0, u1, c0, c1, ai0, ai1;
                if (dir == 0) { u0 = g.ig0 - g.P0; u1 = g.ig1 - g.P1; c0 = g.P0; c1 = g.P1; ai0 = g.P0 + ms; ai1 = g.P1 + ms; }
                else { const float E0 = g.P0 - g.lf0, E1 = g.P1 - g.lf1; u0 = E0 + g.ig0; u1 = E1 + g.ig1; c0 = -E0; c1 = -E1; ai0 = g.tot - E0 + ms; ai1 = g.tot - E1 + ms; }
                float g0 = u0, g1 = u1;
                if (dir == 0) {
#pragma unroll
                    for (int o = 1; o < 64; o <<= 1) { const float x0 = __shfl_up(g0, o), x1 = __shfl_up(g1, o); if (lane >= o) { g0 = fmaxf(g0, x0); g1 = fmaxf(g1, x1); } }
                    g1 = fmaxf(g1, __shfl(g0, 63));
                } else {
#pragma unroll
                    for (int o = 1; o < 64; o <<= 1) { const float x0 = __shfl_down(g0, o), x1 = __shfl_down(g1, o); if (lane + o < 64) { g0 = fmaxf(g0, x0); g1 = fmaxf(g1, x1); } }
                    g0 = fmaxf(g0, __shfl(g1, 0));
                }
                const float mt0 = fmaxf(ai0, c0 + g0), mt1 = fmaxf(ai1, c1 + g1);
                U[lane] = u0; U[lane + 64] = u1; Wv[lane] = c0 - mt0; Wv[lane + 64] = c1 - mt1;
                SI[lane] = __expf(ai0 - mt0); SI[lane + 64] = __expf(ai1 - mt1); EM[lane] = __expf(-mt0); EM[lane + 64] = __expf(-mt1);
                NSs[lane] = NS[sb * 128 + lane]; NSs[lane + 64] = NS[sb * 128 + lane + 64];
            }
            __syncthreads();
            const float wt = Wv[t], sit = SI[t], emt = EM[t];
            f32x4 acc[8];
#pragma unroll
            for (int j = 0; j < 8; ++j) acc[j] = (f32x4){0.f, 0.f, 0.f, 0.f};
#pragma unroll
            for (int ks = 0; ks < 4; ++ks)
#pragma unroll
                for (int j = 0; j < 8; ++j) { const bf16x8 cf = *(const bf16x8*)(CS + sb * 16384 + (size_t)(16 * j + fr) * 128 + 32 * ks + 8 * fq); acc[j] = mfma16(cf, qf[ks], acc[j]); }
            float qn = 0.f;
#pragma unroll
            for (int ks = 0; ks < 4; ++ks) { const u32x4 qv = __builtin_bit_cast(u32x4, qf[ks]); const LAS float* nn = NSs + 32 * ks + 8 * fq;
                qn += bflo(qv.x) * nn[0] + bfhi(qv.x) * nn[1] + bflo(qv.y) * nn[2] + bfhi(qv.y) * nn[3] + bflo(qv.z) * nn[4] + bfhi(qv.z) * nn[5] + bflo(qv.w) * nn[6] + bfhi(qv.w) * nn[7]; }
            qn += __shfl_xor(qn, 16); qn += __shfl_xor(qn, 32);
#pragma unroll
            for (int j = 0; j < 8; ++j) acc[j] *= sit;
            float den = sit * qn;
            const int jlo = dir == 0 ? 0 : (wave >> 1), jhi = dir == 0 ? (wave >> 1) : 3;
            float psum = 0.f;
            for (int jp = jlo; jp <= jhi; ++jp) {
                const int ta = 32 * jp + 8 * (fr >> 2) + (fr & 3);
                f32x4 sa = (f32x4){0.f, 0.f, 0.f, 0.f}, sb2 = (f32x4){0.f, 0.f, 0.f, 0.f};
#pragma unroll
                for (int ks = 0; ks < 4; ++ks) {
                    const bf16x8 ka = *(const bf16x8*)(NAT + (size_t)(row0 + ta) * NATP + N_K + hh * 128 + 32 * ks + 8 * fq);
                    const bf16x8 kb = *(const bf16x8*)(NAT + (size_t)(row0 + ta + 4) * NATP + N_K + hh * 128 + 32 * ks + 8 * fq);
                    sa = mfma16(ka, qf[ks], sa); sb2 = mfma16(kb, qf[ks], sb2); }
                float pa[4], pb[4];
#pragma unroll
                for (int i = 0; i < 4; ++i) { const int s0 = 32 * jp + 8 * fq + i, s1 = s0 + 4;
                    const bool ok0 = dir == 0 ? s0 <= t : s0 >= t, ok1 = dir == 0 ? s1 <= t : s1 >= t;
                    pa[i] = ok0 ? sa[i] * __expf(U[s0] + wt) : 0.f; pb[i] = ok1 ? sb2[i] * __expf(U[s1] + wt) : 0.f;
                    psum += pa[i] + pb[i]; }
                u32x4 pw; pw.x = pk2(pa[0], pa[1]); pw.y = pk2(pa[2], pa[3]); pw.z = pk2(pb[0], pb[1]); pw.w = pk2(pb[2], pb[3]);
                const bf16x8 pf = __builtin_bit_cast(bf16x8, pw);
#pragma unroll
                for (int j = 0; j < 8; ++j) { const bf16x8 vf = *(const bf16x8*)(TR + (size_t)(T_MV + hh * 128 + 16 * j + fr) * M + row0 + 32 * jp + 8 * fq); acc[j] = mfma16(vf, pf, acc[j]); }
            }
            psum += __shfl_xor(psum, 16); psum += __shfl_xor(psum, 32);
            den += psum;
            const float rden = 1.f / fmaxf(fabsf(den), emt);
#pragma unroll
            for (int j = 0; j < 8; ++j) hsum[j] += acc[j] * rden;
        }
        float ss = 0.f;
#pragma unroll
        for (int j = 0; j < 8; ++j) ss += (hsum[j][0] * hsum[j][0] + hsum[j][1] * hsum[j][1]) + (hsum[j][2] * hsum[j][2] + hsum[j][3] * hsum[j][3]);
        ss += __shfl_xor(ss, 16); ss += __shfl_xor(ss, 32);
        const float r = rsqrtf(ss * (1.f / 128.f) + 1e-6f);
        const float* ng = a.in[38] + layer * 512 + hh * 128;
#pragma unroll
        for (int j = 0; j < 8; ++j) { const int vd = 16 * j + 4 * fq; const f32x4 gg = *(const f32x4*)(ng + vd);
            const u32x2 ov = *(const u32x2*)(PROJ + (size_t)(row0 + t) * PJ + P_MO + hh * 128 + vd);
            const float o0 = hsum[j][0] * r * gg[0] * fsigm(bflo(ov.x)), o1 = hsum[j][1] * r * gg[1] * fsigm(bfhi(ov.x)), o2 = hsum[j][2] * r * gg[2] * fsigm(bflo(ov.y)), o3 = hsum[j][3] * r * gg[3] * fsigm(bfhi(ov.y));
            u32x2 w; w.x = pk2(o0, o1); w.y = pk2(o2, o3); *(u32x2*)(BR + (size_t)(row0 + t) * D + 1536 + hh * 128 + vd) = w; }
    }
}
}
namespace mk {
constexpr size_t WS_SST = WS_OPT_END;
constexpr size_t WS_SSL = AL(WS_SST + (size_t)NCH * 8 * 2 * 8192 * 4);
constexpr size_t WS_SSCS = AL(WS_SSL + (size_t)NCH * 8 * 2 * 4);
constexpr size_t WS_YPRE = AL(WS_SSCS + (size_t)NCH * 8 * 2 * 8192 * 2);
constexpr size_t WS_SSQ = AL(WS_YPRE + (size_t)M * 512 * 4);
constexpr size_t WS_SSD_END = AL(WS_SSQ + (size_t)M * 8 * 4);

struct SsdGate { float dt0, dt1, la0, la1, P0, P1, tot; };
__device__ __forceinline__ SsdGate ssd_gates(const Args& a, int layer, int row0, int hh, int dir, int lane) {
    const float* SMALL = (const float*)(a.ws + WS_SMALL);
    const float bias = a.in[32][layer * 16 + dir * 8 + hh], A = -__expf(a.in[33][layer * 16 + dir * 8 + hh]);
    SsdGate g;
    const float x0 = SMALL[(size_t)(row0 + lane) * 32 + S_DT + dir * 8 + hh] + bias, x1 = SMALL[(size_t)(row0 + lane + 64) * 32 + S_DT + dir * 8 + hh] + bias;
    g.dt0 = fmaxf(x0, 0.f) + log1pf(__expf(-fabsf(x0))); g.dt1 = fmaxf(x1, 0.f) + log1pf(__expf(-fabsf(x1)));
    g.la0 = g.dt0 * A; g.la1 = g.dt1 * A;
    const float s0 = wave_incl_scan(g.la0, lane); const float t0 = __shfl(s0, 63);
    const float s1 = wave_incl_scan(g.la1, lane) + t0;
    g.P0 = s0; g.P1 = s1; g.tot = __shfl(s1, 63);
    return g;
}
__device__ __forceinline__ void ssd_states_phase(const Args& a, int layer, int tid_, int G) {
    int tid = tid_; asm volatile("" : "+v"(tid));
    const int lane = tid & 63, wave = __builtin_amdgcn_readfirstlane(tid >> 6), fr = lane & 15, fq = lane >> 4;
    const bf16_t* TR = (const bf16_t*)(a.ws + WS_TR); float* SST = (float*)(a.ws + WS_SST); float* SSL = (float*)(a.ws + WS_SSL);
    for (int u = blockIdx.x; u < NCH * 8; u += G) {
        const int ch = u >> 3, hh = u & 7, grp = hh >> 2; int row0, seq0, L, lat, b, ci, nc; chunk_info(ch, row0, seq0, L, lat, b, ci, nc);
#pragma unroll
        for (int dir = 0; dir < 2; ++dir) {
            const SsdGate g = ssd_gates(a, layer, row0, hh, dir, lane);
            const float w0 = g.dt0 * __expf(dir == 0 ? g.tot - g.P0 : g.P0 - g.la0), w1 = g.dt1 * __expf(dir == 0 ? g.tot - g.P1 : g.P1 - g.la1);
            f32x4 acc[4];
#pragma unroll
            for (int j = 0; j < 4; ++j) acc[j] = (f32x4){0.f, 0.f, 0.f, 0.f};
#pragma unroll
            for (int ks = 0; ks < 4; ++ks) {
                float ev[8];
#pragma unroll
                for (int j = 0; j < 8; ++j) { const int tok = 32 * ks + 8 * fq + j; const float y0 = __shfl(w0, tok & 63), y1 = __shfl(w1, tok & 63); ev[j] = tok < 64 ? y0 : y1; }
                const u32x4 bv = *(const u32x4*)(TR + (size_t)(T_B + grp * 128 + wave * 16 + fr) * M + row0 + 32 * ks + 8 * fq);
                u32x4 bw; bw.x = pk2(bflo(bv.x) * ev[0], bfhi(bv.x) * ev[1]); bw.y = pk2(bflo(bv.y) * ev[2], bfhi(bv.y) * ev[3]); bw.z = pk2(bflo(bv.z) * ev[4], bfhi(bv.z) * ev[5]); bw.w = pk2(bflo(bv.w) * ev[6], bfhi(bv.w) * ev[7]);
                const bf16x8 bf = __builtin_bit_cast(bf16x8, bw);
#pragma unroll
                for (int j = 0; j < 4; ++j) { const bf16x8 xf = *(const bf16x8*)(TR + (size_t)(T_X + hh * 64 + 16 * j + fr) * M + row0 + 32 * ks + 8 * fq); acc[j] = mfma16(xf, bf, acc[j]); }
            }
            float* dst = SST + ((size_t)(ch * 8 + hh) * 2 + dir) * 8192;
#pragma unroll
            for (int j = 0; j < 4; ++j)
#pragma unroll
                for (int i = 0; i < 4; ++i) dst[(size_t)(16 * j + 4 * fq + i) * 128 + wave * 16 + fr] = acc[j][i];
            if (tid == 0) SSL[(size_t)(ch * 8 + hh) * 2 + dir] = g.tot;
        }
    }
}
__device__ __forceinline__ void ssd_scan_phase(const Args& a, int layer, int tid_, int G) {
    int tid = tid_; asm volatile("" : "+v"(tid));
    const float* SST = (const float*)(a.ws + WS_SST); const float* SSL = (const float*)(a.ws + WS_SSL); bf16_t* CS = (bf16_t*)(a.ws + WS_SSCS);
    for (int task = blockIdx.x; task < 384; task += G) {
        int lat, b, hh, dir, part, nparts;
        if (task < 128) { lat = 1; part = task & 1; dir = (task >> 1) & 1; hh = (task >> 2) & 7; b = task >> 5; nparts = 2; }
        else { const int t2 = task - 128; lat = 0; part = 0; dir = t2 & 1; hh = (t2 >> 1) & 7; b = t2 >> 4; nparts = 1; }
        const int nc = lat ? 16 : 2, ch0 = lat ? 32 + b * 16 : b * 2;
        const int nel = 8192 / nparts, e0 = part * nel, per = nel / NT;
        float c[16];
        const size_t so = ((((size_t)b * DEPTH + layer) * 2 + dir) * 8 + hh) * 8192;
#pragma unroll
        for (int i = 0; i < 16; ++i) if (i < per) c[i] = lat ? a.in[6][so + e0 + i * NT + tid] : 0.f;
        for (int s = 0; s < nc; ++s) { const int ci = dir ? nc - 1 - s : s, ch = ch0 + ci; const size_t sb = (size_t)(ch * 8 + hh) * 2 + dir;
#pragma unroll
            for (int i = 0; i < 16; ++i) if (i < per) CS[sb * 8192 + e0 + i * NT + tid] = f2bf(c[i]);
            const float dec = __expf(SSL[sb]);
#pragma unroll
            for (int i = 0; i < 16; ++i) if (i < per) c[i] = dec * c[i] + SST[sb * 8192 + e0 + i * NT + tid]; }
        if (!lat) {
#pragma unroll
            for (int i = 0; i < 16; ++i) if (i < per) a.out[O_SSD + so + e0 + i * NT + tid] = c[i]; }
    }
}
__device__ __forceinline__ void ssd_out_phase(const Args& a, int layer, LAS unsigned char* lds, int tid_, int G) {
    int tid = tid_; asm volatile("" : "+v"(tid));
    const int lane = tid & 63, wave = __builtin_amdgcn_readfirstlane(tid >> 6), fr = lane & 15, fq = lane >> 4;
    const bf16_t* NAT = (const bf16_t*)(a.ws + WS_NAT); const bf16_t* TR = (const bf16_t*)(a.ws + WS_TR); const bf16_t* PROJ = (const bf16_t*)(a.ws + WS_PROJ);
    const bf16_t* CS = (const bf16_t*)(a.ws + WS_SSCS); float* YPRE = (float*)(a.ws + WS_YPRE); float* SSQ = (float*)(a.ws + WS_SSQ);
    LAS float* U = (LAS float*)(lds + 4096); LAS float* Wv = U + 128; LAS float* DT = U + 256; LAS float* EO = U + 384;
    for (int u = blockIdx.x; u < NCH * 8; u += G) {
        const int ch = u >> 3, hh = u & 7, grp = hh >> 2; int row0, seq0, L, lat, b, ci, nc; chunk_info(ch, row0, seq0, L, lat, b, ci, nc);
        const int t = wave * 16 + fr;
        bf16x8 cf[4];
#pragma unroll
        for (int ks = 0; ks < 4; ++ks) cf[ks] = *(const bf16x8*)(NAT + (size_t)(row0 + t) * NATP + N_XBC + 768 + grp * 128 + 32 * ks + 8 * fq);
        f32x4 ysum[4];
#pragma unroll
        for (int j = 0; j < 4; ++j) ysum[j] = (f32x4){0.f, 0.f, 0.f, 0.f};
#pragma unroll 1
        for (int dir = 0; dir < 2; ++dir) {
            const size_t sb = (size_t)(ch * 8 + hh) * 2 + dir;
            __syncthreads();
            if (wave == 0) {
                const SsdGate g = ssd_gates(a, layer, row0, hh, dir, lane);
                if (dir == 0) { U[lane] = -g.P0; U[lane + 64] = -g.P1; Wv[lane] = g.P0; Wv[lane + 64] = g.P1; EO[lane] = __expf(g.P0); EO[lane + 64] = __expf(g.P1); }
                else { const float E0 = g.P0 - g.la0, E1 = g.P1 - g.la1; U[lane] = E0; U[lane + 64] = E1; Wv[lane] = -E0; Wv[lane + 64] = -E1; EO[lane] = __expf(g.tot - E0); EO[lane + 64] = __expf(g.tot - E1); }
                DT[lane] = g.dt0; DT[lane + 64] = g.dt1;
            }
            __syncthreads();
            const float wt = Wv[t], eot = EO[t];
            f32x4 acc[4];
#pragma unroll
            for (int j = 0; j < 4; ++j) acc[j] = (f32x4){0.f, 0.f, 0.f, 0.f};
#pragma unroll
            for (int ks = 0; ks < 4; ++ks)
#pragma unroll
                for (int j = 0; j < 4; ++j) { const bf16x8 sf = *(const bf16x8*)(CS + sb * 8192 + (size_t)(16 * j + fr) * 128 + 32 * ks + 8 * fq); acc[j] = mfma16(sf, cf[ks], acc[j]); }
#pragma unroll
            for (int j = 0; j < 4; ++j) acc[j] *= eot;
            const int jlo = dir == 0 ? 0 : (wave >> 1), jhi = dir == 0 ? (wave >> 1) : 3;
            for (int jp = jlo; jp <= jhi; ++jp) {
                const int ta = 32 * jp + 8 * (fr >> 2) + (fr & 3);
                f32x4 sa = (f32x4){0.f, 0.f, 0.f, 0.f}, sb2 = (f32x4){0.f, 0.f, 0.f, 0.f};
#pragma unroll
                for (int ks = 0; ks < 4; ++ks) {
                    const bf16x8 ba = *(const bf16x8*)(NAT + (size_t)(row0 + ta) * NATP + N_XBC + 512 + grp * 128 + 32 * ks + 8 * fq);
                    const bf16x8 bb = *(const bf16x8*)(NAT + (size_t)(row0 + ta + 4) * NATP + N_XBC + 512 + grp * 128 + 32 * ks + 8 * fq);
                    sa = mfma16(ba, cf[ks], sa); sb2 = mfma16(bb, cf[ks], sb2); }
                float pa[4], pb[4];
#pragma unroll
                for (int i = 0; i < 4; ++i) { const int s0 = 32 * jp + 8 * fq + i, s1 = s0 + 4;
                    const bool ok0 = dir == 0 ? s0 <= t : s0 >= t, ok1 = dir == 0 ? s1 <= t : s1 >= t;
                    pa[i] = ok0 ? sa[i] * DT[s0] * __expf(U[s0] + wt) : 0.f; pb[i] = ok1 ? sb2[i] * DT[s1] * __expf(U[s1] + wt) : 0.f; }
                u32x4 pw; pw.x = pk2(pa[0], pa[1]); pw.y = pk2(pa[2], pa[3]); pw.z = pk2(pb[0], pb[1]); pw.w = pk2(pb[2], pb[3]);
                const bf16x8 pf = __builtin_bit_cast(bf16x8, pw);
#pragma unroll
                for (int j = 0; j < 4; ++j) { const bf16x8 xf = *(const bf16x8*)(TR + (size_t)(T_X + hh * 64 + 16 * j + fr) * M + row0 + 32 * jp + 8 * fq); acc[j] = mfma16(xf, pf, acc[j]); }
            }
#pragma unroll
            for (int j = 0; j < 4; ++j) ysum[j] += acc[j];
        }
        const float Dh = a.in[34][layer * 8 + hh]; float ss = 0.f;
#pragma unroll
        for (int j = 0; j < 4; ++j) { const int p = 16 * j + 4 * fq;
            const u32x2 xv = *(const u32x2*)(NAT + (size_t)(row0 + t) * NATP + N_XBC + hh * 64 + p), zv = *(const u32x2*)(PROJ + (size_t)(row0 + t) * PJ + P_Z + hh * 64 + p);
            f32x4 y; y[0] = (ysum[j][0] + bflo(xv.x) * Dh) * fsilu(bflo(zv.x)); y[1] = (ysum[j][1] + bfhi(xv.x) * Dh) * fsilu(bfhi(zv.x));
            y[2] = (ysum[j][2] + bflo(xv.y) * Dh) * fsilu(bflo(zv.y)); y[3] = (ysum[j][3] + bfhi(xv.y) * Dh) * fsilu(bfhi(zv.y));
            ss += (y[0] * y[0] + y[1] * y[1]) + (y[2] * y[2] + y[3] * y[3]);
            *(f32x4*)(YPRE + (size_t)(row0 + t) * 512 + hh * 64 + p) = y; }
        ss += __shfl_xor(ss, 16); ss += __shfl_xor(ss, 32);
        if (fq == 0) SSQ[(size_t)(row0 + t) * 8 + hh] = ss;
    }
}
__device__ __forceinline__ void ssd_fin_phase(const Args& a, int layer, int gw, int ngw, int lane_) {
    int lane = lane_; asm volatile("" : "+v"(lane));
    const float* YPRE = (const float*)(a.ws + WS_YPRE); const float* SSQ = (const float*)(a.ws + WS_SSQ); bf16_t* BR = (bf16_t*)(a.ws + WS_BR); const float* ng = a.in[35] + layer * 512;
    for (int row = gw; row < M; row += ngw) {
        float s = lane < 8 ? SSQ[(size_t)row * 8 + lane] : 0.f; s += __shfl_xor(s, 1); s += __shfl_xor(s, 2); s += __shfl_xor(s, 4); s = __shfl(s, 0);
        const float r = rsqrtf(s * (1.f / 512.f) + 1e-6f);
        const f32x4 y0 = *(const f32x4*)(YPRE + (size_t)row * 512 + 8 * lane), y1 = *(const f32x4*)(YPRE + (size_t)row * 512 + 8 * lane + 4);
        const f32x4 g0 = *(const f32x4*)(ng + 8 * lane), g1 = *(const f32x4*)(ng + 8 * lane + 4);
        *(u32x4*)(BR + (size_t)row * D + 1024 + 8 * lane) = pack8(y0 * r * g0, y1 * r * g1);
    }
}
}
namespace mk {
constexpr size_t WS_CK = WS_SSD_END;
constexpr size_t WS_CVT = AL(WS_CK + (size_t)16 * 512 * 512 * 2);
constexpr size_t WS_ATT_END = AL(WS_CVT + (size_t)16 * 512 * 512 * 2);

__device__ __forceinline__ void prologue_cache(const Args& a, int gw, int ngw, int lane) {
    bf16_t* CK = (bf16_t*)(a.ws + WS_CK); bf16_t* CVT = (bf16_t*)(a.ws + WS_CVT);
    for (size_t i = ((size_t)gw * 64 + lane) * 8; i < (size_t)16 * 512 * 512; i += (size_t)ngw * 64 * 8) {
        const f32x4 x0 = *(const f32x4*)(a.in[2] + i), x1 = *(const f32x4*)(a.in[2] + i + 4); *(u32x4*)(CK + i) = pack8(x0, x1); }
    for (size_t i = (size_t)gw * 64 + lane; i < (size_t)16 * 64 * 512; i += (size_t)ngw * 64) { const int c = i & 511, s8 = (i >> 9) & 63, bl = i >> 15;
        const float* src = a.in[3] + ((size_t)bl * 512 + 8 * s8) * 512 + c;
        u32x4 o; o.x = pk2(src[0], src[512]); o.y = pk2(src[1024], src[1536]); o.z = pk2(src[2048], src[2560]); o.w = pk2(src[3072], src[3584]);
        *(u32x4*)(CVT + ((size_t)bl * 512 + c) * 512 + 8 * s8) = o; }
}
struct AttState { float m, l; f32x4 o[4]; };
template <bool MASKED>
__device__ __forceinline__ void attn_group(AttState& st, const bf16x8 (&qf)[2], const bf16_t* kbase, size_t kp, const bf16_t* vt, size_t vp, int fr, int fq,
                                           const float* bias  , int kc0, int cq, int cs) {
    const int ra = 8 * (fr >> 2) + (fr & 3);
    f32x4 sa = (f32x4){0.f, 0.f, 0.f, 0.f}, sb = (f32x4){0.f, 0.f, 0.f, 0.f};
#pragma unroll
    for (int ks = 0; ks < 2; ++ks) { const bf16x8 ka = *(const bf16x8*)(kbase + (size_t)ra * kp + 32 * ks + 8 * fq), kb = *(const bf16x8*)(kbase + (size_t)(ra + 4) * kp + 32 * ks + 8 * fq);
        sa = mfma16(ka, qf[ks], sa); sb = mfma16(kb, qf[ks], sb); }
    float s[8]; float gm = -1e30f;
#pragma unroll
    for (int i = 0; i < 4; ++i) { s[i] = sa[i] * 0.125f; s[4 + i] = sb[i] * 0.125f; }
    if (MASKED) {
#pragma unroll
        for (int e = 0; e < 8; ++e) { const int kc = kc0 + 8 * fq + e; const bool ok = kc >= cs && kc < cs + 16; const int bi = min(max(kc - cq + 15, 0), 30); s[e] = ok ? s[e] + bias[bi] : -1e30f; }
    }
#pragma unroll
    for (int e = 0; e < 8; ++e) gm = fmaxf(gm, s[e]);
    gm = fmaxf(gm, __shfl_xor(gm, 16)); gm = fmaxf(gm, __shfl_xor(gm, 32));
    const float mn = fmaxf(st.m, gm), al = __expf(st.m - mn); st.m = mn;
    float p[8], ps = 0.f;
#pragma unroll
    for (int e = 0; e < 8; ++e) { p[e] = __expf(s[e] - mn); ps += p[e]; }
    st.l = st.l * al + ps;
    u32x4 pw; pw.x = pk2(p[0], p[1]); pw.y = pk2(p[2], p[3]); pw.z = pk2(p[4], p[5]); pw.w = pk2(p[6], p[7]);
    const bf16x8 pf = __builtin_bit_cast(bf16x8, pw);
#pragma unroll
    for (int j = 0; j < 4; ++j) { const bf16x8 vf = *(const bf16x8*)(vt + (size_t)(16 * j + fr) * vp + 8 * fq); st.o[j] = mfma16(vf, pf, st.o[j] * al); }
}
__device__ __forceinline__ void attn_phase(const Args& a, int layer, int gw_, int ngw, int lane_) {
    int lane = lane_, gw = gw_; asm volatile("" : "+v"(lane));
    const int fr = lane & 15, fq = lane >> 4;
    const bf16_t* PROJ = (const bf16_t*)(a.ws + WS_PROJ); const bf16_t* TR = (const bf16_t*)(a.ws + WS_TR); bf16_t* BR = (bf16_t*)(a.ws + WS_BR);
    const bf16_t* CK = (const bf16_t*)(a.ws + WS_CK); const bf16_t* CVT = (const bf16_t*)(a.ws + WS_CVT);
    for (int it = gw; it < 6144; it += ngw) {
        AttState st; st.m = -1e30f; st.l = 0.f;
#pragma unroll
        for (int j = 0; j < 4; ++j) st.o[j] = (f32x4){0.f, 0.f, 0.f, 0.f};
        int qrow, hh;
        if (it < 4096) {
            const int jq = it & 3, r = (it >> 2) & 31; hh = (it >> 7) & 7; const int b = it >> 10;
            const int seq0 = MP + b * 2048; qrow = seq0 + r * 64 + 16 * jq + fr;
            bf16x8 qf[2];
#pragma unroll
            for (int ks = 0; ks < 2; ++ks) qf[ks] = *(const bf16x8*)(PROJ + (size_t)qrow * PJ + P_Q + hh * 64 + 32 * ks + 8 * fq);
            const int rs = min(max(r - 4, 0), 24), cq = 16 * jq + fr, cs = min(max(cq - 8, 0), 48);
            const int kc0 = jq == 0 ? 0 : (jq == 1 ? 8 : (jq == 2 ? 24 : 32));
            const float* rpb = a.in[19] + ((size_t)layer * 8 + hh) * 15 * 31;
            for (int j = 0; j < 8; ++j) { const int kr = rs + j, tok0 = seq0 + kr * 64 + kc0;
                attn_group<true>(st, qf, PROJ + (size_t)tok0 * PJ + P_K + hh * 64, PJ, TR + (size_t)(T_V + hh * 64) * M + tok0, M, fr, fq, rpb + (kr - r + 7) * 31, kc0, cq, cs); }
            const size_t cb = ((size_t)b * DEPTH + layer) * 512;
            for (int g = 0; g < 16; ++g)
                attn_group<false>(st, qf, CK + (cb + 32 * g) * 512 + hh * 64, 512, CVT + (cb + hh * 64) * 512 + 32 * g, 512, fr, fq, nullptr, 0, 0, 0);
        } else {
            const int i2 = it - 4096, qt = i2 & 15; hh = (i2 >> 4) & 7; const int b = i2 >> 7, seq0 = b * 256; qrow = seq0 + 16 * qt + fr;
            bf16x8 qf[2];
#pragma unroll
            for (int ks = 0; ks < 2; ++ks) qf[ks] = *(const bf16x8*)(PROJ + (size_t)qrow * PJ + P_Q + hh * 64 + 32 * ks + 8 * fq);
            for (int g = 0; g < 8; ++g) { const int tok0 = seq0 + 32 * g;
                attn_group<false>(st, qf, PROJ + (size_t)tok0 * PJ + P_K + hh * 64, PJ, TR + (size_t)(T_V + hh * 64) * M + tok0, M, fr, fq, nullptr, 0, 0, 0); }
        }
        float l = st.l; l += __shfl_xor(l, 16); l += __shfl_xor(l, 32);
        const float rl = 1.f / l;
#pragma unroll
        for (int j = 0; j < 4; ++j) { u32x2 w; w.x = pk2(st.o[j][0] * rl, st.o[j][1] * rl); w.y = pk2(st.o[j][2] * rl, st.o[j][3] * rl);
            *(u32x2*)(BR + (size_t)qrow * D + hh * 64 + 16 * j + 4 * fq) = w; }
    }
}
}
namespace mk {
constexpr int S5K = 768;
constexpr size_t WS_S5W = WS_ATT_END;
constexpr size_t WS_S5WS = AL(WS_S5W + (size_t)DEPTH * 32 * 512 * S5K * 2);
constexpr size_t WS_S5AP = AL(WS_S5WS + (size_t)DEPTH * 32 * 256 * 512 * 2);
constexpr size_t WS_S5UP = AL(WS_S5AP + (size_t)DEPTH * 32 * 2 * 64 * 2 * 4);
constexpr size_t WS_S5SS = AL(WS_S5UP + (size_t)32 * 384 * 512 * 2);
constexpr size_t WS_S5HS = AL(WS_S5SS + (size_t)32 * 384 * 256 * 4);
constexpr size_t WS_S5_END = AL(WS_S5HS + (size_t)32 * 384 * 256 * 2);

__device__ __forceinline__ void s5_param_phase(const Args& a, LAS unsigned char* lds, int tid_, int G) {
    int tid = tid_; asm volatile("" : "+v"(tid));
    LAS float* PW = (LAS float*)lds; LAS float* BB = PW + 2 * 33 * 64 * 2; LAS float* CC = BB + 2 * 64 * 16 * 2; LAS float* KT = CC + 2 * 16 * 64 * 2;
    for (int task = blockIdx.x; task < DEPTH * 32; task += G) {
        const int layer = task >> 5, g = task & 31;
        const float* a_re = a.in[20] + layer * 4096; const float* a_im = a.in[21] + layer * 4096; const float* log_dt = a.in[22] + layer * 64;
        const float* b_re = a.in[23] + (size_t)layer * 65536; const float* b_im = a.in[24] + (size_t)layer * 65536; const float* c_re = a.in[25] + (size_t)layer * 65536; const float* c_im = a.in[26] + (size_t)layer * 65536;
        const float* s5d = a.in[27] + layer * 512;
        bf16_t* S5W = (bf16_t*)(a.ws + WS_S5W) + (size_t)layer * 32 * 512 * S5K; bf16_t* S5WS = (bf16_t*)(a.ws + WS_S5WS) + (size_t)layer * 32 * 256 * 512; float* S5AP = (float*)(a.ws + WS_S5AP) + (size_t)layer * 32 * 2 * 64 * 2;
        __syncthreads();
        if (tid < 128) { const int dir = tid >> 6, n = tid & 63, pi = (dir * 32 + g) * 64 + n;
            const float are = fminf(a_re[pi], -1e-4f), aim = a_im[pi], dt = expf(log_dt[dir * 32 + g]);
            const float mag = expf(dt * are), abr = mag * cosf(dt * aim), abi = mag * sinf(dt * aim);
            const float den = are * are + aim * aim, nr = abr - 1.f, cfr = (nr * are + abi * aim) / den, cfi = (abi * are - nr * aim) / den;
            float pr = 1.f, pim = 0.f;
            for (int p = 0; p <= 32; ++p) { PW[((dir * 33 + p) * 64 + n) * 2] = pr; PW[((dir * 33 + p) * 64 + n) * 2 + 1] = pim; const float t = pr * abr - pim * abi; pim = pr * abi + pim * abr; pr = t; }
            S5AP[((g * 2 + dir) * 64 + n) * 2] = PW[((dir * 33 + 32) * 64 + n) * 2]; S5AP[((g * 2 + dir) * 64 + n) * 2 + 1] = PW[((dir * 33 + 32) * 64 + n) * 2 + 1];
            for (int k = 0; k < 16; ++k) { const float br_ = b_re[(size_t)pi * 16 + k], bi_ = b_im[(size_t)pi * 16 + k];
                BB[((dir * 64 + n) * 16 + k) * 2] = cfr * br_ - cfi * bi_; BB[((dir * 64 + n) * 16 + k) * 2 + 1] = cfr * bi_ + cfi * br_; }
            for (int j = 0; j < 16; ++j) { CC[((dir * 64 + n) * 16 + j) * 2] = c_re[((size_t)(dir * 32 + g) * 16 + j) * 64 + n]; CC[((dir * 64 + n) * 16 + j) * 2 + 1] = c_im[((size_t)(dir * 32 + g) * 16 + j) * 64 + n]; }
        }
        __syncthreads();
        for (int e = tid; e < 2 * 32 * 256; e += NT) { const int j = e & 15, k = (e >> 4) & 15, tau = (e >> 8) & 31, dir = e >> 13; float s = 0.f;
            for (int n = 0; n < 64; ++n) { const float cr = CC[((dir * 64 + n) * 16 + j) * 2], ci = CC[((dir * 64 + n) * 16 + j) * 2 + 1], pr = PW[((dir * 33 + tau) * 64 + n) * 2], pim = PW[((dir * 33 + tau) * 64 + n) * 2 + 1];
                const float xr = cr * pr - ci * pim, xi = cr * pim + ci * pr, br_ = BB[((dir * 64 + n) * 16 + k) * 2], bi_ = BB[((dir * 64 + n) * 16 + k) * 2 + 1];
                s += xr * br_ - xi * bi_; }
            KT[e] = s; }
        __syncthreads();
        { const int t = tid >> 4, j = tid & 15; bf16_t* dst = S5W + ((size_t)g * 512 + tid) * S5K;
            for (int s = 0; s < 32; ++s) { float v[16];
#pragma unroll
                for (int k = 0; k < 16; ++k) { float x;
                    if (s < t) x = KT[((0 * 32 + (t - s)) * 16 + k) * 16 + j]; else if (s > t) x = KT[((1 * 32 + (s - t)) * 16 + k) * 16 + j];
                    else x = KT[((0 * 32 + 0) * 16 + k) * 16 + j] + KT[((1 * 32 + 0) * 16 + k) * 16 + j] + (k == j ? s5d[g * 16 + k] : 0.f);
                    v[k] = x; }
                u32x4 o0, o1; o0.x = pk2(v[0], v[1]); o0.y = pk2(v[2], v[3]); o0.z = pk2(v[4], v[5]); o0.w = pk2(v[6], v[7]); o1.x = pk2(v[8], v[9]); o1.y = pk2(v[10], v[11]); o1.z = pk2(v[12], v[13]); o1.w = pk2(v[14], v[15]);
                *(u32x4*)(dst + s * 16) = o0; *(u32x4*)(dst + s * 16 + 8) = o1; }
            for (int dir = 0; dir < 2; ++dir) { const int p = dir == 0 ? t + 1 : 32 - t;
                for (int n8 = 0; n8 < 8; ++n8) { float gr[8], gi[8];
#pragma unroll
                    for (int q = 0; q < 8; ++q) { const int n = n8 * 8 + q; const float cr = CC[((dir * 64 + n) * 16 + j) * 2], ci = CC[((dir * 64 + n) * 16 + j) * 2 + 1], pr = PW[((dir * 33 + p) * 64 + n) * 2], pim = PW[((dir * 33 + p) * 64 + n) * 2 + 1];
                        gr[q] = cr * pr - ci * pim; gi[q] = -(cr * pim + ci * pr); }
                    u32x4 o; o.x = pk2(gr[0], gr[1]); o.y = pk2(gr[2], gr[3]); o.z = pk2(gr[4], gr[5]); o.w = pk2(gr[6], gr[7]); *(u32x4*)(dst + 512 + dir * 128 + n8 * 8) = o;
                    o.x = pk2(gi[0], gi[1]); o.y = pk2(gi[2], gi[3]); o.z = pk2(gi[4], gi[5]); o.w = pk2(gi[6], gi[7]); *(u32x4*)(dst + 512 + dir * 128 + 64 + n8 * 8) = o; } }
        }
        if (tid < 256) { const int dir = tid >> 7, reim = (tid >> 6) & 1, n = tid & 63; bf16_t* dst = S5WS + ((size_t)g * 256 + tid) * 512;
            for (int s = 0; s < 32; ++s) { const int p = dir == 0 ? 31 - s : s; const float pr = PW[((dir * 33 + p) * 64 + n) * 2], pim = PW[((dir * 33 + p) * 64 + n) * 2 + 1]; float v[16];
#pragma unroll
                for (int k = 0; k < 16; ++k) { const float br_ = BB[((dir * 64 + n) * 16 + k) * 2], bi_ = BB[((dir * 64 + n) * 16 + k) * 2 + 1]; v[k] = reim == 0 ? pr * br_ - pim * bi_ : pr * bi_ + pim * br_; }
                u32x4 o0, o1; o0.x = pk2(v[0], v[1]); o0.y = pk2(v[2], v[3]); o0.z = pk2(v[4], v[5]); o0.w = pk2(v[6], v[7]); o1.x = pk2(v[8], v[9]); o1.y = pk2(v[10], v[11]); o1.z = pk2(v[12], v[13]); o1.w = pk2(v[14], v[15]);
                *(u32x4*)(dst + s * 16) = o0; *(u32x4*)(dst + s * 16 + 8) = o1; } }
    }
    __syncthreads();
}
__device__ __forceinline__ void s5_statein_phase(const Args& a, int layer, int gw, int ngw, int lane_) {
    int lane = lane_; asm volatile("" : "+v"(lane));
    const int fr = lane & 15, fq = lane >> 4;
    const bf16_t* UP = (const bf16_t*)(a.ws + WS_S5UP); const bf16_t* S5WS = (const bf16_t*)(a.ws + WS_S5WS) + (size_t)layer * 32 * 256 * 512; float* SS = (float*)(a.ws + WS_S5SS);
    for (int it = gw; it < 32 * 24; it += ngw) { const int g = it / 24, r = it % 24, og = r / 6, cq = r % 6;
        f32x4 acc[4][4];
#pragma unroll
        for (int i = 0; i < 4; ++i)
#pragma unroll
            for (int j = 0; j < 4; ++j) acc[i][j] = (f32x4){0.f, 0.f, 0.f, 0.f};
        const bf16_t* ap = S5WS + ((size_t)g * 256 + 64 * og + fr) * 512 + 8 * fq; const bf16_t* bp = UP + ((size_t)g * 384 + 64 * cq + fr) * 512 + 8 * fq;
#pragma unroll 2
        for (int ks = 0; ks < 16; ++ks) { bf16x8 af[4], bf[4];
#pragma unroll
            for (int i = 0; i < 4; ++i) { af[i] = *(const bf16x8*)(ap + (size_t)16 * i * 512 + 32 * ks); bf[i] = *(const bf16x8*)(bp + (size_t)16 * i * 512 + 32 * ks); }
#pragma unroll
            for (int i = 0; i < 4; ++i)
#pragma unroll
                for (int j = 0; j < 4; ++j) acc[i][j] = mfma16(af[i], bf[j], acc[i][j]); }
#pragma unroll
        for (int i = 0; i < 4; ++i)
#pragma unroll
            for (int j = 0; j < 4; ++j) *(f32x4*)(SS + ((size_t)g * 384 + 64 * cq + 16 * j + fr) * 256 + 64 * og + 16 * i + 4 * fq) = acc[i][j];
    }
}
__device__ __forceinline__ void s5_scan_phase(const Args& a, int layer, int gw, int ngw, int lane_) {
    int lane = lane_; asm volatile("" : "+v"(lane));
    const float* SS = (const float*)(a.ws + WS_S5SS); bf16_t* HS = (bf16_t*)(a.ws + WS_S5HS); const float* S5AP = (const float*)(a.ws + WS_S5AP) + (size_t)layer * 32 * 2 * 64 * 2;
    for (int task = gw; task < 1280; task += ngw) {
        int sq, g, dir; if (task < 256) { sq = 16 + (task >> 6); g = (task >> 1) & 31; dir = task & 1; } else { const int t2 = task - 256; sq = t2 >> 6; g = (t2 >> 1) & 31; dir = t2 & 1; }
        const int lat = sq >= 16, b = lat ? sq - 16 : sq, nc = lat ? 64 : 8, cg0 = lat ? 128 + b * 64 : b * 8;
        const float apr = S5AP[((g * 2 + dir) * 64 + lane) * 2], api = S5AP[((g * 2 + dir) * 64 + lane) * 2 + 1];
        float hr = 0.f, hi = 0.f;
        if (lat) { const size_t so = ((((size_t)b * DEPTH + layer) * 2 + dir) * 32 + g) * 64 + lane; hr = a.in[4][so]; hi = a.in[5][so]; }
        for (int s = 0; s < nc; ++s) { const int cg = cg0 + (dir ? nc - 1 - s : s); const size_t base = ((size_t)g * 384 + cg) * 256 + dir * 128;
            HS[base + lane] = f2bf(hr); HS[base + 64 + lane] = f2bf(hi);
            const float sr = SS[base + lane], si = SS[base + 64 + lane];
            const float t = apr * hr - api * hi + sr; hi = apr * hi + api * hr + si; hr = t; }
        if (!lat) { const size_t oo = ((((size_t)b * DEPTH + layer) * 2 + dir) * 32 + g) * 64 + lane; a.out[O_S5R + oo] = hr; a.out[O_S5I + oo] = hi; }
    }
}
__device__ __forceinline__ void s5_out_phase(const Args& a, int layer, int gw, int ngw, int lane_) {
    int lane = lane_; asm volatile("" : "+v"(lane));
    const int fr = lane & 15, fq = lane >> 4;
    const bf16_t* UP = (const bf16_t*)(a.ws + WS_S5UP); const bf16_t* S5W = (const bf16_t*)(a.ws + WS_S5W) + (size_t)layer * 32 * 512 * S5K; const bf16_t* HS = (const bf16_t*)(a.ws + WS_S5HS); bf16_t* ZB = (bf16_t*)(a.ws + WS_ZB);
    for (int it = gw; it < 32 * 48; it += ngw) { const int g = it / 48, r = it % 48, og = r / 6, cq = r % 6;
        f32x4 acc[4][4];
#pragma unroll
        for (int i = 0; i < 4; ++i)
#pragma unroll
            for (int j = 0; j < 4; ++j) acc[i][j] = (f32x4){0.f, 0.f, 0.f, 0.f};
        const bf16_t* ap = S5W + ((size_t)g * 512 + 64 * og + fr) * S5K + 8 * fq;
        const bf16_t* bp = UP + ((size_t)g * 384 + 64 * cq + fr) * 512 + 8 * fq; const bf16_t* hp = HS + ((size_t)g * 384 + 64 * cq + fr) * 256 + 8 * fq;
#pragma unroll 2
        for (int ks = 0; ks < 16; ++ks) { bf16x8 af[4], bf[4];
#pragma unroll
            for (int i = 0; i < 4; ++i) { af[i] = *(const bf16x8*)(ap + (size_t)16 * i * S5K + 32 * ks); bf[i] = *(const bf16x8*)(bp + (size_t)16 * i * 512 + 32 * ks); }
#pragma unroll
            for (int i = 0; i < 4; ++i)
#pragma unroll
                for (int j = 0; j < 4; ++j) acc[i][j] = mfma16(af[i], bf[j], acc[i][j]); }
#pragma unroll 2
        for (int ks = 0; ks < 8; ++ks) { bf16x8 af[4], bf[4];
#pragma unroll
            for (int i = 0; i < 4; ++i) { af[i] = *(const bf16x8*)(ap + (size_t)16 * i * S5K + 512 + 32 * ks); bf[i] = *(const bf16x8*)(hp + (size_t)16 * i * 256 + 32 * ks); }
#pragma unroll
            for (int i = 0; i < 4; ++i)
#pragma unroll
                for (int j = 0; j < 4; ++j) acc[i][j] = mfma16(af[i], bf[j], acc[i][j]); }
#pragma unroll
        for (int i = 0; i < 4; ++i)
#pragma unroll
            for (int j = 0; j < 4; ++j) { float z[4];
#pragma unroll
                for (int e = 0; e < 4; ++e) { const float x = acc[i][j][e]; const float th = 0.7978845608028654f * (x + 0.044715f * x * x * x); const float e2 = __expf(2.f * th); const float tnh = 1.f - 2.f * __builtin_amdgcn_rcpf(e2 + 1.f); z[e] = 0.5f * x * (1.f + tnh); }
                u32x2 w; w.x = pk2(z[0], z[1]); w.y = pk2(z[2], z[3]);
                *(u32x2*)(ZB + (size_t)(32 * (64 * cq + 16 * j + fr) + 4 * og + i) * 512 + g * 16 + 4 * fq) = w; }
    }
}
}
namespace mk { static_assert(WS_S5_END < (size_t)1780 * 1024 * 1024, "workspace map exceeds the guaranteed size"); }
namespace mk {
#ifndef PHMASK
#define PHMASK 0xfffff
#endif
#define PHM(k) ((PHMASK >> (k)) & 1)
#ifndef DUPMASK
#define DUPMASK 0
#endif
#define DUP(k) ((DUPMASK >> (k)) & 1)
constexpr int NPH = 12;
constexpr int PH_TOTAL = 2 + DEPTH * NPH;
__global__ void __launch_bounds__(NT, 2) mk_fwd(Args a) {
    extern __shared__ __attribute__((aligned(16))) unsigned char lds_raw[];
    LAS unsigned char* lds = (LAS unsigned char*)lds_raw;
#define TID ((int)threadIdx.x)
#define LANE ((int)(threadIdx.x & 63))
#define WAVE (__builtin_amdgcn_readfirstlane((int)(threadIdx.x >> 6)))
#define GW ((int)blockIdx.x * NWV + WAVE)
    const int G = gridDim.x, ngw = G * NWV;
    volatile LAS unsigned* ctlw = (volatile LAS unsigned*)(lds + LDS_CTL);
    if (TID < 4) ctlw[TID] = 0u;
    __syncthreads();
    XcdBarrier bar = xcd_barrier_post((unsigned*)(a.ws + WS_CTL), ctlw);
    const int lo = a.ph_lo, hi = a.ph_hi;
#define IN(k) (lo <= (k) && (k) < hi)
#define SEAM(k) do { if (IN(k) && IN((k) + 1)) xcd_barrier(bar); } while (0)
    unsigned char* ws = a.ws;
    bf16_t* H = (bf16_t*)(ws + WS_H); bf16_t* PROJ = (bf16_t*)(ws + WS_PROJ); float* SMALL = (float*)(ws + WS_SMALL); bf16_t* BR = (bf16_t*)(ws + WS_BR);
    bf16_t* MERGED = (bf16_t*)(ws + WS_MERGED); float* MACC = (float*)(ws + WS_MACC); bf16_t* ZB = (bf16_t*)(ws + WS_ZB); bf16_t* HID = PROJ;
    const float* MOD = (const float*)(ws + WS_MOD); float* X = a.out;
    if (PHM(0) && IN(0)) { for (int r_ = 0; r_ < 1 + DUP(8); ++r_) prologue_convert(a, lds, GW, ngw, WAVE, LANE); prologue_cache(a, GW, ngw, LANE); __syncthreads(); prologue_ada(a, lds, TID); for (int r_ = 0; r_ < 1 + DUP(1); ++r_) s5_param_phase(a, lds, TID, G); }
    SEAM(0);
    for (int l = 0; l < DEPTH; ++l) {
        const int pb = 1 + l * NPH;
        const float* xp = l == 0 ? a.in[0] : X; const float* xs = l == 0 ? a.in[1] : X + (size_t)MP * D;
        const float* modl = MOD + (size_t)l * 5 * 6 * D;
        const bf16_t* wl = (const bf16_t*)(ws + WS_W) + (size_t)l * W_LAYER;
        if (PHM(1) && IN(pb + 0)) norm_phase(xp, xs, a.in[14] + l * D, modl, 0, D, H, GW, ngw, LANE, l > 0 ? MACC : nullptr, modl - (size_t)5 * 6 * D, 5 * D, X, xs);
        SEAM(pb + 0);
        if (PHM(2) && IN(pb + 1)) { Gemm g{H, wl + W_IN, M, NIN, D, D, 1, 0, 0}; StaticOrder S; S.init(M, NIN, G, blockIdx.x, 1, D);
            EpiIn E{PROJ, SMALL, a.out, a.in[17] + l * 64, a.in[18] + l * 64, l}; for (int r_ = 0; r_ < 1 + DUP(9); ++r_) gemm_phase(lds, g, S, E); }
        SEAM(pb + 1);
        if (PHM(3) && IN(pb + 2)) { for (int r_ = 0; r_ < 1 + DUP(0); ++r_) { prep_phase(a, l, lds, GW, ngw, WAVE, LANE, (bf16_t*)(a.ws + WS_S5UP)); __syncthreads(); } }
        SEAM(pb + 2);
        if (PHM(4) && IN(pb + 3)) { for (int r_ = 0; r_ < 1 + DUP(2); ++r_) attn_phase(a, l, GW, ngw, LANE); for (int r_ = 0; r_ < 1 + DUP(3); ++r_) { ml_states_phase(a, l, TID, G); ssd_states_phase(a, l, TID, G); s5_statein_phase(a, l, GW, ngw, LANE); } }
        SEAM(pb + 3);
        if (PHM(5) && IN(pb + 4)) { for (int r_ = 0; r_ < 1 + DUP(4); ++r_) { ml_scan_phase(a, l, TID, G); ssd_scan_phase(a, l, TID, G); s5_scan_phase(a, l, GW, ngw, LANE); } }
        SEAM(pb + 4);
        if (PHM(12) && IN(pb + 5)) { for (int r_ = 0; r_ < 1 + DUP(5); ++r_) ml_out_phase(a, l, lds, TID, G); for (int r_ = 0; r_ < 1 + DUP(6); ++r_) ssd_out_phase(a, l, lds, TID, G); for (int r_ = 0; r_ < 1 + DUP(7); ++r_) s5_out_phase(a, l, GW, ngw, LANE); }
        SEAM(pb + 5);
        if (PHM(6) && IN(pb + 6)) { Gemm g{ZB, wl + W_GLU, M, 512, 512, 512, 1, 0, 0}; StaticOrder S; S.init(M, 512, G, blockIdx.x, 1, 512);
            EpiGlu E{ZB, a.in[29] + l * 512, BR}; gemm_phase(lds, g, S, E); ssd_fin_phase(a, l, GW, ngw, LANE); }
        SEAM(pb + 6);
        if (PHM(7) && IN(pb + 7)) { Gemm g{BR, wl + W_BR, M, D, 512, D, 4, 512, (size_t)D * 512}; StaticOrder S; S.init(M, D, G, blockIdx.x, 4, 512);
            EpiBranch E{PROJ, MERGED}; for (int r_ = 0; r_ < 1 + DUP(12); ++r_) gemm_phase(lds, g, S, E); }
        SEAM(pb + 7);
        if (PHM(8) && IN(pb + 8)) { Gemm g{MERGED, wl + W_OUT, M, D, D, D, 1, 0, 0}; SplitOrder S; S.init(blockIdx.x, D);
            EpiResid E{xp, xs, modl, 2 * D, X, MACC}; gemm_phase(lds, g, S, E); }
        SEAM(pb + 8);
        if (PHM(9) && IN(pb + 9)) norm_phase(X, X + (size_t)MP * D, a.in[15] + l * D, modl, 3 * D, 4 * D, H, GW, ngw, LANE, MACC, modl, 2 * D, X, xs);
        SEAM(pb + 9);
        if (PHM(10) && IN(pb + 10)) { Gemm g{H, wl + W_1, M, DFF, D, D, 1, 0, 0}; StaticOrder S; S.init(M, DFF, G, blockIdx.x, 1, D);
            EpiRelu2 E{HID, DFF}; for (int r_ = 0; r_ < 1 + DUP(10); ++r_) gemm_phase(lds, g, S, E); }
        SEAM(pb + 10);
        if (PHM(11) && IN(pb + 11)) { Gemm g{HID, wl + W_2, M, D, DFF, DFF, 1, 0, 0}; SplitOrder S; S.init(blockIdx.x, DFF);
            EpiResid E{X, X + (size_t)MP * D, modl, 5 * D, X, MACC}; gemm_phase(lds, g, S, E); }
        SEAM(pb + 11);
    }
    if (IN(1 + DEPTH * NPH)) final_fix_phase(MACC, MOD + (size_t)(DEPTH - 1) * 5 * 6 * D, 5 * D, X, GW, ngw, LANE);
#undef IN
#undef SEAM
}
}
extern "C" void kernel_launch(void* const* d_in, const int* in_sizes, int n_in, void* d_out, int out_size, void* d_ws, size_t ws_size, hipStream_t stream) {
    static int grid = 0;
    if (grid == 0) {
        int dev = 0, cus = 0; (void)hipGetDevice(&dev); (void)hipDeviceGetAttribute(&cus, hipDeviceAttributeMultiprocessorCount, dev);
        (void)hipFuncSetAttribute((const void*)mk::mk_fwd, hipFuncAttributeMaxDynamicSharedMemorySize, mk::LDS_BYTES);
        int per_cu = 0; (void)hipOccupancyMaxActiveBlocksPerMultiprocessor(&per_cu, (const void*)mk::mk_fwd, mk::NT, mk::LDS_BYTES); (void)hipGetLastError();
        grid = cus > 0 ? cus : 256;
    }
    mk::Args a{}; for (int i = 0; i < 43; ++i) a.in[i] = (const float*)d_in[i];
    a.out = (float*)d_out; a.ws = (unsigned char*)d_ws; a.ph_lo = 0; a.ph_hi = mk::PH_TOTAL;
    (void)hipMemsetAsync(a.ws + mk::WS_CTL, 0, mk::CTL_BYTES, stream);
    hipLaunchKernelGGL(mk::mk_fwd, dim3(grid), dim3(mk::NT), mk::LDS_BYTES, stream, a);
}
```

```cpp
#define SAFE_GEMM 0
#define DUPMASK 0
#include <hip/hip_runtime.h>
#include <math.h>
namespace mk {
#define LAS __attribute__((address_space(3)))
typedef unsigned short bf16_t;
typedef short bf16x8 __attribute__((ext_vector_type(8)));
typedef float f32x4 __attribute__((ext_vector_type(4)));
typedef float f32x2 __attribute__((ext_vector_type(2)));
typedef unsigned u32x4 __attribute__((ext_vector_type(4)));
typedef unsigned u32x2 __attribute__((ext_vector_type(2)));
constexpr int NT = 512, NWV = 8;
constexpr int D = 2048, MP = 4096, MLAT = 8192, M = MP + MLAT, DEPTH = 4, DFF = 8192;
constexpr int PJ = 13824;
constexpr int NIN = 14080;
constexpr int P_Q = 0, P_K = 512, P_V = 1024, P_S5U = 1536, P_Z = 2048, P_XBC = 2560, P_MQ = 3584, P_MK = 4096, P_MV = 4608, P_MO = 5120, P_GATE = 5632;
constexpr int S_DT = 0, S_MI = 16, S_MF = 24;

typedef __bf16 bf16x2_t __attribute__((ext_vector_type(2)));
__device__ __forceinline__ unsigned pk2(float lo, float hi) { f32x2 v = {lo, hi}; bf16x2_t b = __builtin_convertvector(v, bf16x2_t); return __builtin_bit_cast(unsigned, b); }
__device__ __forceinline__ float bf2f(bf16_t v) { return __uint_as_float(((unsigned)v) << 16); }
__device__ __forceinline__ float bflo(unsigned w) { return __uint_as_float(w << 16); }
__device__ __forceinline__ float bfhi(unsigned w) { return __uint_as_float(w & 0xffff0000u); }
__device__ __forceinline__ bf16_t f2bf(float f) { return (bf16_t)(pk2(f, 0.f) & 0xffffu); }
__device__ __forceinline__ float fsigm(float x) { return __builtin_amdgcn_rcpf(1.f + __expf(-x)); }
__device__ __forceinline__ float fsilu(float x) { return x * fsigm(x); }
__device__ __forceinline__ int row_cvec(int row) { return row < MP ? 0 : 1 + (row - MP) / 2048; }

#define XB_TMO      128
#define XB_XCNT(j)  (256  + 64 * (j))
#define XB_XSUB(j)  (1280 + 64 * (j))
#define XB_XGEN(j)  (2304 + 64 * (j))
#define XB_TOP      3328
#define XB_TOPGEN   3392
#define XCD_BAR_WORDS 3456
#define XB_SPIN_CAP (1u << 18)
__device__ __forceinline__ unsigned xb_ld(unsigned* p)              { return __hip_atomic_load(p, __ATOMIC_RELAXED, __HIP_MEMORY_SCOPE_AGENT); }
__device__ __forceinline__ unsigned xb_add(unsigned* p, unsigned v) { return __hip_atomic_fetch_add(p, v, __ATOMIC_RELAXED, __HIP_MEMORY_SCOPE_AGENT); }
__device__ __forceinline__ unsigned xb_xcc_id() { return (unsigned)__builtin_amdgcn_s_getreg((3 << 11) | 20) & 0xFu; }
#define XB_SPIN(cond, bar) do { unsigned _sp = 0; while (cond) { __builtin_amdgcn_s_sleep(1); \
    if ((++_sp & 255u) == 0u) { if (xb_ld(&(bar)[XB_TMO])) break; if (_sp > XB_SPIN_CAP) { atomicAdd(&(bar)[XB_TMO], 1u); break; } } } } while (0)
struct XcdBarrier { unsigned* bar; unsigned x; volatile LAS unsigned* st; };
__device__ __forceinline__ XcdBarrier xcd_barrier_post(unsigned* bar, volatile LAS unsigned* st) {
    XcdBarrier b; b.bar = bar; b.x = xb_xcc_id(); b.st = st;
    if (threadIdx.x == 0) (void)xb_add(&bar[XB_XCNT(b.x)], 1u);
    return b;
}
__device__ __forceinline__ void xcd_barrier_complete(unsigned* bar, unsigned x, unsigned& nloc, unsigned& nx) {
    const unsigned G = gridDim.x * gridDim.y * gridDim.z;
    unsigned sum, cnt, mine, sp = 0u;
    for (;;) {
        sum = 0u; cnt = 0u; mine = 0u;
#pragma unroll
        for (unsigned j = 0; j < 16; ++j) { const unsigned c = xb_ld(&bar[XB_XCNT(j)]); sum += c; cnt += (c > 0u) ? 1u : 0u; mine = (j == x) ? c : mine; }
        if (sum == G) break;
        __builtin_amdgcn_s_sleep(1);
        if ((++sp & 255u) == 0u) { if (xb_ld(&bar[XB_TMO])) break; if (sp > XB_SPIN_CAP) { atomicAdd(&bar[XB_TMO], 1u); break; } }
    }
    nloc = mine > 0u ? mine : 1u; nx = cnt > 0u ? cnt : 1u;
}
__device__ __forceinline__ void xcd_barrier(const XcdBarrier& b) {
    asm volatile("s_waitcnt vmcnt(0)" ::: "memory");
    __syncthreads();
    if (threadIdx.x == 0) {
        unsigned* bar = b.bar;
        __builtin_amdgcn_s_waitcnt(0);
        unsigned nloc = b.st[0], nx = b.st[1];
        if (nloc == 0u) { xcd_barrier_complete(bar, b.x, nloc, nx); b.st[0] = nloc; b.st[1] = nx; }
        const unsigned old = xb_add(&bar[XB_XSUB(b.x)], 1u);
        const unsigned gen = old / nloc;
        if (old + 1u == (gen + 1u) * nloc) {
            __builtin_amdgcn_fence(__ATOMIC_RELEASE, "agent");
            asm volatile("s_waitcnt vmcnt(0)" ::: "memory");
            const unsigned og = xb_add(&bar[XB_TOP], 1u);
            const unsigned tg = og / nx;
            if (og + 1u == (tg + 1u) * nx) xb_add(&bar[XB_TOPGEN], 1u);
            else XB_SPIN(xb_ld(&bar[XB_TOPGEN]) == tg, bar);
            __builtin_amdgcn_fence(__ATOMIC_ACQUIRE, "agent");
            xb_add(&bar[XB_XGEN(b.x)], 1u);
            asm volatile("s_waitcnt vmcnt(0)" ::: "memory");
        } else {
            XB_SPIN(xb_ld(&bar[XB_XGEN(b.x)]) == gen, bar);
            __builtin_amdgcn_fence(__ATOMIC_ACQUIRE, "agent");
            asm volatile("s_waitcnt vmcnt(0)" ::: "memory");
        }
    }
    __syncthreads();
}

#ifndef GEMM_SP2
#define GEMM_SP2 1
#endif
#ifndef GEMM_ALIGN
#define GEMM_ALIGN 1
#endif
constexpr int BM = 256, BK = 64, HALF = 128, HTB = HALF * BK * 2, STAGE_BYTES = 8 * HTB, NXCD = 8, WGM = 8;
__host__ __device__ __forceinline__ int lds_byte(int r, int c) { const int st = (r >> 4) * 2 + (c >> 5), rr = r & 15, cc = c & 31, ob = rr * 64 + cc * 2; return st * 1024 + (ob ^ (((ob >> 9) & 1) << 5)); }
__host__ __device__ __forceinline__ void stage_rc(int b, int& R, int& C) { const int st = b / 1024, sb = b % 1024, swz = sb ^ (((sb >> 9) & 1) << 5); R = (st >> 1) * 16 + swz / 64; C = (st & 1) * 32 + (swz % 64) / 2; }
__host__ __device__ __forceinline__ int perm32(int rho) { const int n = rho >> 4, i = rho & 15; return 8 * (i >> 2) + 4 * n + (i & 3); }

struct Unit { int pm, pn, kz, koff, nt; };
struct Gemm { const bf16_t* A; const bf16_t* Bt; int M, N, K, lda, nkz; size_t a_kz, b_kz; };

struct StaticOrder {
    int nM, nN, nwg, G, c, nkz;
    int ntk;
    __device__ void init(int M_, int N_, int G_, int c_, int nkz_ = 1, int K_ = 0) { nM = M_ / BM; nN = N_ / BM; nwg = nM * nN; G = G_; c = c_; nkz = nkz_; ntk = K_ / BK; }
    __device__ bool next(int i, Unit& u) const {
        const int it = i / nkz; u.kz = i - it * nkz; u.koff = 0; u.nt = ntk;
        const long L = (long)it * G + c; if (L >= nwg) return false;
        int wgid = (int)L; { const int q = nwg / NXCD, r = nwg % NXCD, xcd = wgid % NXCD, off = wgid / NXCD; wgid = (xcd < r ? xcd * (q + 1) : r * (q + 1) + (xcd - r) * q) + off; }
        const int nig = WGM * nN, gid = wgid / nig, fm = gid * WGM, gsz = (nM - fm) < WGM ? (nM - fm) : WGM;
        u.pm = fm + ((wgid % nig) % gsz); u.pn = (wgid % nig) / gsz; return true;
    }
};

struct SplitOrder {
    int c, ntk;
    __device__ void init(int c_, int K_) { c = c_; ntk = K_ / BK; }
    __device__ bool next(int i, Unit& u) const {
        const int xcd = c & 7, idx = c >> 3;
        if (i == 0) { u.pm = xcd * 4 + (idx >> 3); u.pn = idx & 7; u.kz = 0; u.koff = 0; u.nt = ntk; return true; }
        if (i == 1) { const int t = idx >> 1; u.pm = 32 + xcd * 2 + (t >> 3); u.pn = t & 7; u.kz = 0; u.nt = ntk >> 1; u.koff = (idx & 1) * (ntk >> 1) * BK; return true; }
        return false;
    }
};

template <class Epi, class Sched>
__device__ __forceinline__ void gemm_phase(LAS unsigned char* lds, const Gemm g, const Sched& S, const Epi& E) {
    int tid_ = threadIdx.x; asm volatile("" : "+v"(tid_));
    const int tid = tid_, wid = __builtin_amdgcn_readfirstlane(tid >> 6), lane = tid & 63, wr = wid >> 2, wc = wid & 3, fr = lane & 15, fq = lane >> 4;
    const int K = g.K;
    unsigned voffA[2], voffB[2];
#pragma unroll
    for (int i = 0; i < 2; ++i) { int R, C; stage_rc(tid * 16 + i * 8192, R, C); const int Rb = Epi::PERM ? ((R & ~31) + perm32(R & 31)) : R;
        voffA[i] = (unsigned)(R * g.lda + C) * 2u; voffB[i] = (unsigned)(Rb * K + C) * 2u; }
    const size_t kstep = (size_t)(BK * 2);
    const size_t hstepA = (size_t)HALF * g.lda * 2, hstepB = (size_t)HALF * K * 2;
    const size_t tstepA = 2 * hstepA, tstepB = 2 * hstepB;
    const unsigned ldsw = (unsigned)wid * 1024u;
    const int aoff = lds_byte(wr * 64 + fr, fq * 8), boff = lds_byte(wc * 32 + fr, fq * 8);
#define PG8_SA(b, h) (((b) * 2 + (h)) * HTB)
#define PG8_SB(b, h) ((4 + (b) * 2 + (h)) * HTB)
#define PG8_STAGE(bufoff, gbase, voff) do { _Pragma("unroll") for (int _i = 0; _i < 2; ++_i) \
        __builtin_amdgcn_global_load_lds((const unsigned*)((const char*)(gbase) + (voff)[_i]), (LAS unsigned*)(lds + (bufoff) + ldsw + _i * 8192), 16, 0, 0); } while (0)
#define PG8_LDA(dst, b, h) do { _Pragma("unroll") for (int m = 0; m < 4; ++m) _Pragma("unroll") for (int k = 0; k < 2; ++k) dst[m][k] = *(const LAS bf16x8*)(lds + PG8_SA(b, h) + aoff + m * 2048 + k * 1024); } while (0)
#define PG8_LDB(dst, b, h) do { _Pragma("unroll") for (int n = 0; n < 2; ++n) _Pragma("unroll") for (int k = 0; k < 2; ++k) dst[n][k] = *(const LAS bf16x8*)(lds + PG8_SB(b, h) + boff + n * 2048 + k * 1024); } while (0)
#define PG8_MMA(ai, bj, At, Bt) do { __builtin_amdgcn_s_setprio(1); _Pragma("unroll") for (int m = 0; m < 4; ++m) _Pragma("unroll") for (int n = 0; n < 2; ++n) _Pragma("unroll") for (int k = 0; k < 2; ++k) \
        acc[ai][bj][m][n] = __builtin_amdgcn_mfma_f32_16x16x32_bf16(Bt[n][k], At[m][k], acc[ai][bj][m][n], 0, 0, 0); __builtin_amdgcn_s_setprio(0); } while (0)
#if SAFE_GEMM == 1 || SAFE_GEMM == 3
#define PG8_WAIT_V(n) asm volatile("s_waitcnt vmcnt(0)" ::: "memory")
#else
#define PG8_WAIT_V(n) asm volatile("s_waitcnt vmcnt(" #n ")" ::: "memory")
#endif
#define PG8_WAIT_L(n) asm volatile("s_waitcnt lgkmcnt(" #n ")" ::: "memory")
#if SAFE_GEMM == 1
#define PG8_BAR do { asm volatile("s_waitcnt vmcnt(0) lgkmcnt(0)" ::: "memory"); __builtin_amdgcn_s_barrier(); asm volatile("" ::: "memory"); } while (0)
#elif SAFE_GEMM == 2
#define PG8_BAR asm volatile("s_barrier" ::: "memory")
#elif SAFE_GEMM == 4
#define PG8_BAR do { asm volatile("s_waitcnt lgkmcnt(0)" ::: "memory"); __builtin_amdgcn_s_barrier(); } while (0)
#else
#define PG8_BAR __builtin_amdgcn_s_barrier()
#endif
#define PG8_SCHED __builtin_amdgcn_sched_barrier(0)
    Unit cur, nxt; int ui = 0;
    if (!S.next(0, cur)) return;
    f32x4 acc[2][2][4][2];
#pragma unroll
    for (int a = 0; a < 2; ++a)
#pragma unroll
        for (int b = 0; b < 2; ++b)
#pragma unroll
            for (int m = 0; m < 4; ++m)
#pragma unroll
                for (int n = 0; n < 2; ++n) acc[a][b][m][n] = (f32x4){0.f, 0.f, 0.f, 0.f};
    bf16x8 At[4][2], B0[2][2], B1[2][2];
    const char* cA = (const char*)(g.A + (size_t)cur.kz * g.a_kz + cur.koff) + (size_t)cur.pm * tstepA; const char* cB = (const char*)(g.Bt + (size_t)cur.kz * g.b_kz + cur.koff) + (size_t)cur.pn * tstepB;
#if GEMM_SP2
    PG8_STAGE(PG8_SB(0, 0), cB, voffB); PG8_STAGE(PG8_SB(0, 1), cB + hstepB, voffB); PG8_STAGE(PG8_SA(0, 0), cA, voffA); PG8_STAGE(PG8_SA(0, 1), cA + hstepA, voffA);
    if (wr == 1) PG8_BAR;
    PG8_WAIT_V(2); PG8_BAR;
    PG8_STAGE(PG8_SB(1, 0), cB + kstep, voffB); PG8_STAGE(PG8_SA(1, 0), cA + kstep, voffA); PG8_STAGE(PG8_SB(1, 1), cB + hstepB + kstep, voffB);
    PG8_WAIT_V(6); PG8_BAR;
#else
    PG8_STAGE(PG8_SB(0, 0), cB, voffB); PG8_STAGE(PG8_SA(0, 0), cA, voffA); PG8_STAGE(PG8_SB(0, 1), cB + hstepB, voffB); PG8_STAGE(PG8_SA(0, 1), cA + hstepA, voffA);
    if (wr == 1) PG8_BAR;
    PG8_WAIT_V(4); PG8_BAR;
    PG8_STAGE(PG8_SB(1, 0), cB + kstep, voffB); PG8_STAGE(PG8_SA(1, 0), cA + kstep, voffA); PG8_STAGE(PG8_SB(1, 1), cB + hstepB + kstep, voffB);
    PG8_WAIT_V(6); PG8_BAR;
#endif
    for (;;) {
        const bool has_next = S.next(ui + 1, nxt);
        const char* nA = has_next ? (const char*)(g.A + (size_t)nxt.kz * g.a_kz + nxt.koff) + (size_t)nxt.pm * tstepA : cA;
        const char* nB = has_next ? (const char*)(g.Bt + (size_t)nxt.kz * g.b_kz + nxt.koff) + (size_t)nxt.pn * tstepB : cB;
        const int nt = cur.nt;
        for (int t = 0; t < nt; t += 2) {
            const bool last = (t == nt - 2);
            const char* a1 = cA + (size_t)(t + 1) * kstep;
            const char* a2 = last ? nA : cA + (size_t)(t + 2) * kstep; const char* b2 = last ? nB : cB + (size_t)(t + 2) * kstep;
            const char* a3 = a2 + kstep; const char* b3 = b2 + kstep;
#if GEMM_SP2
            PG8_LDB(B0, 0, 0); PG8_LDB(B1, 0, 1); PG8_SCHED; PG8_LDA(At, 0, 0); PG8_STAGE(PG8_SA(1, 1), a1 + hstepA, voffA);
            PG8_WAIT_V(8); PG8_WAIT_L(0); PG8_BAR; PG8_MMA(0, 0, At, B0); PG8_MMA(0, 1, At, B1); PG8_BAR; PG8_SCHED;
            PG8_LDA(At, 0, 1); PG8_STAGE(PG8_SB(0, 0), b2, voffB); PG8_STAGE(PG8_SB(0, 1), b2 + hstepB, voffB); PG8_STAGE(PG8_SA(0, 0), a2, voffA);
            PG8_WAIT_V(8); PG8_WAIT_L(0); PG8_BAR; PG8_MMA(1, 0, At, B0); PG8_MMA(1, 1, At, B1); PG8_BAR; PG8_SCHED;
            PG8_LDB(B0, 1, 0); PG8_LDB(B1, 1, 1); PG8_SCHED; PG8_LDA(At, 1, 0); PG8_STAGE(PG8_SA(0, 1), a2 + hstepA, voffA);
            PG8_WAIT_V(8); PG8_WAIT_L(0); PG8_BAR; PG8_MMA(0, 0, At, B0); PG8_MMA(0, 1, At, B1); PG8_BAR; PG8_SCHED;
            PG8_LDA(At, 1, 1); PG8_STAGE(PG8_SB(1, 0), b3, voffB); PG8_STAGE(PG8_SB(1, 1), b3 + hstepB, voffB); PG8_STAGE(PG8_SA(1, 0), a3, voffA);
            PG8_WAIT_V(8); PG8_WAIT_L(0); PG8_BAR; PG8_MMA(1, 0, At, B0); PG8_MMA(1, 1, At, B1); PG8_BAR; PG8_SCHED;
#else
            PG8_LDB(B0, 0, 0); PG8_SCHED; PG8_LDA(At, 0, 0); PG8_STAGE(PG8_SA(1, 1), a1 + hstepA, voffA);
            PG8_WAIT_L(8); PG8_BAR; PG8_WAIT_L(0); PG8_MMA(0, 0, At, B0); PG8_BAR; PG8_SCHED;
            PG8_LDB(B1, 0, 1); PG8_STAGE(PG8_SB(0, 0), b2, voffB);
            PG8_BAR; PG8_WAIT_L(0); PG8_MMA(0, 1, At, B1); PG8_BAR;
            PG8_LDA(At, 0, 1); PG8_STAGE(PG8_SA(0, 0), a2, voffA);
            PG8_BAR; PG8_WAIT_L(0); PG8_MMA(1, 0, At, B0); PG8_BAR; PG8_SCHED;
            PG8_STAGE(PG8_SB(0, 1), b2 + hstepB, voffB);
            PG8_WAIT_V(6); PG8_BAR; PG8_MMA(1, 1, At, B1); PG8_BAR;
            PG8_LDB(B0, 1, 0); PG8_SCHED; PG8_LDA(At, 1, 0); PG8_STAGE(PG8_SA(0, 1), a2 + hstepA, voffA);
            PG8_WAIT_L(8); PG8_BAR; PG8_WAIT_L(0); PG8_MMA(0, 0, At, B0); PG8_BAR; PG8_SCHED;
            PG8_LDB(B1, 1, 1); PG8_STAGE(PG8_SB(1, 0), b3, voffB);
            PG8_BAR; PG8_WAIT_L(0); PG8_MMA(0, 1, At, B1); PG8_BAR;
            PG8_LDA(At, 1, 1); PG8_STAGE(PG8_SA(1, 0), a3, voffA);
            PG8_BAR; PG8_WAIT_L(0); PG8_MMA(1, 0, At, B0); PG8_BAR; PG8_SCHED;
            PG8_STAGE(PG8_SB(1, 1), b3 + hstepB, voffB);
            PG8_WAIT_V(6); PG8_BAR; PG8_MMA(1, 1, At, B1); PG8_BAR;
#endif
        }
#if GEMM_ALIGN
        if (wr == 0) PG8_BAR;
#endif
        E(acc, cur, wr, wc, fr, fq);
        if (!has_next) break;
        if (nxt.kz == 0) {
#pragma unroll
        for (int a = 0; a < 2; ++a)
#pragma unroll
            for (int b = 0; b < 2; ++b)
#pragma unroll
                for (int m = 0; m < 4; ++m)
#pragma unroll
                    for (int n = 0; n < 2; ++n) acc[a][b][m][n] = (f32x4){0.f, 0.f, 0.f, 0.f};
        }
        cur = nxt; cA = nA; cB = nB; ++ui;
#if GEMM_ALIGN
        if (wr == 1) PG8_BAR;
#endif
    }
    PG8_WAIT_V(0);
#if !GEMM_ALIGN
    if (wr == 0) PG8_BAR;
#endif
    PG8_BAR;
#undef PG8_SA
#undef PG8_SB
#undef PG8_STAGE
#undef PG8_LDA
#undef PG8_LDB
#undef PG8_MMA
#undef PG8_WAIT_V
#undef PG8_WAIT_L
#undef PG8_BAR
#undef PG8_SCHED
}
}
namespace mk {
constexpr size_t O_YP = 0, O_YS = 8388608, O_NK = 25165824, O_NV = 33554432, O_S5R = 41943040, O_S5I = 42205184, O_SSD = 42467328,
                 O_MLC = 50855936, O_MLN = 59244544, O_MLM = 59310080;

__device__ __forceinline__ u32x4 pack8(const f32x4 a, const f32x4 b) { u32x4 w; w.x = pk2(a[0], a[1]); w.y = pk2(a[2], a[3]); w.z = pk2(b[0], b[1]); w.w = pk2(b[2], b[3]); return w; }

struct EpiIn {
    static constexpr bool PERM = true;
    bf16_t* proj; float* small; float* out; const float* qg; const float* kg; int layer;
    __device__ __forceinline__ void operator()(f32x4 (&acc)[2][2][4][2], const Unit& u, int wr, int wc, int fr, int fq) const {
        const int T = u.pn, rowb = u.pm * BM + wr * 64 + fr;
        if (T == 54) {
            if (wc == 0) {
#pragma unroll
                for (int ai = 0; ai < 2; ++ai)
#pragma unroll
                    for (int m = 0; m < 4; ++m) { float* sp = small + (size_t)(rowb + ai * HALF + m * 16) * 32 + 8 * fq; *(f32x4*)sp = acc[ai][0][m][0]; *(f32x4*)(sp + 4) = acc[ai][0][m][1]; }
            }
            return;
        }
        const int colb = T * 256 + 64 * wc + 8 * fq;
        if (T < 4) {
            const float* g = T < 2 ? qg : kg;
            f32x4 gv[2][2];
#pragma unroll
            for (int bj = 0; bj < 2; ++bj)
#pragma unroll
                for (int n = 0; n < 2; ++n) gv[bj][n] = *(const f32x4*)(g + 32 * bj + 8 * fq + 4 * n);
#pragma unroll
            for (int ai = 0; ai < 2; ++ai)
#pragma unroll
                for (int m = 0; m < 4; ++m) {
                    float ss = 0.f;
#pragma unroll
                    for (int bj = 0; bj < 2; ++bj)
#pragma unroll
                        for (int n = 0; n < 2; ++n) { const f32x4 x = acc[ai][bj][m][n]; ss += (x[0] * x[0] + x[1] * x[1]) + (x[2] * x[2] + x[3] * x[3]); }
                    ss += __shfl_xor(ss, 16); ss += __shfl_xor(ss, 32);
                    const float r = rsqrtf(ss * (1.f / 64.f) + 1e-6f);
                    const int row = rowb + ai * HALF + m * 16;
#pragma unroll
                    for (int bj = 0; bj < 2; ++bj) { const f32x4 v0 = acc[ai][bj][m][0] * r * gv[bj][0], v1 = acc[ai][bj][m][1] * r * gv[bj][1];
                        *(u32x4*)(proj + (size_t)row * PJ + colb + 32 * bj) = pack8(v0, v1);
                        if (T >= 2 && row < MP) { float* o = out + O_NK + ((size_t)((row >> 8) * DEPTH + layer) * 256 + (row & 255)) * 512 + (colb - 512) + 32 * bj; *(f32x4*)o = v0; *(f32x4*)(o + 4) = v1; } }
                }
        } else if (T < 6) {
#pragma unroll
            for (int ai = 0; ai < 2; ++ai)
#pragma unroll
                for (int m = 0; m < 4; ++m) { const int row = rowb + ai * HALF + m * 16;
#pragma unroll
                    for (int bj = 0; bj < 2; ++bj) { const f32x4 v0 = acc[ai][bj][m][0], v1 = acc[ai][bj][m][1];
                        *(u32x4*)(proj + (size_t)row * PJ + colb + 32 * bj) = pack8(v0, v1);
                        if (row < MP) { float* o = out + O_NV + ((size_t)((row >> 8) * DEPTH + layer) * 256 + (row & 255)) * 512 + (colb - 1024) + 32 * bj; *(f32x4*)o = v0; *(f32x4*)(o + 4) = v1; } } }
        } else if (T < 22) {
#pragma unroll
            for (int ai = 0; ai < 2; ++ai)
#pragma unroll
                for (int m = 0; m < 4; ++m) { const int row = rowb + ai * HALF + m * 16;
#pragma unroll
                    for (int bj = 0; bj < 2; ++bj) *(u32x4*)(proj + (size_t)row * PJ + colb + 32 * bj) = pack8(acc[ai][bj][m][0], acc[ai][bj][m][1]); }
        } else {
#pragma unroll
            for (int ai = 0; ai < 2; ++ai)
#pragma unroll
                for (int m = 0; m < 4; ++m) { const int row = rowb + ai * HALF + m * 16;
#pragma unroll
                    for (int bj = 0; bj < 2; ++bj) { f32x4 v0 = acc[ai][bj][m][0], v1 = acc[ai][bj][m][1];
#pragma unroll
                        for (int j = 0; j < 4; ++j) { v0[j] = fsigm(v0[j]); v1[j] = fsigm(v1[j]); }
                        *(u32x4*)(proj + (size_t)row * PJ + colb + 32 * bj) = pack8(v0, v1); } }
        }
    }
};
struct EpiRelu2 {
    static constexpr bool PERM = true;
    bf16_t* O; int ldo;
    __device__ __forceinline__ void operator()(f32x4 (&acc)[2][2][4][2], const Unit& u, int wr, int wc, int fr, int fq) const {
        const int rowb = u.pm * BM + wr * 64 + fr, colb = u.pn * 256 + 64 * wc + 8 * fq;
#pragma unroll
        for (int ai = 0; ai < 2; ++ai)
#pragma unroll
            for (int m = 0; m < 4; ++m) { const int row = rowb + ai * HALF + m * 16;
#pragma unroll
                for (int bj = 0; bj < 2; ++bj) { f32x4 v0 = acc[ai][bj][m][0], v1 = acc[ai][bj][m][1];
#pragma unroll
                    for (int j = 0; j < 4; ++j) { const float a = fmaxf(v0[j], 0.f), b = fmaxf(v1[j], 0.f); v0[j] = a * a; v1[j] = b * b; }
                    *(u32x4*)(O + (size_t)row * ldo + colb + 32 * bj) = pack8(v0, v1); } }
    }
};
struct EpiGlu {
    static constexpr bool PERM = true;
    const bf16_t* Z; const float* bias; bf16_t* br;
    __device__ __forceinline__ void operator()(f32x4 (&acc)[2][2][4][2], const Unit& u, int wr, int wc, int fr, int fq) const {
        const int rowb = u.pm * BM + wr * 64 + fr, colb = u.pn * 256 + 64 * wc + 8 * fq;
#pragma unroll
        for (int bj = 0; bj < 2; ++bj) { const int c = colb + 32 * bj; const f32x4 b0 = *(const f32x4*)(bias + c), b1 = *(const f32x4*)(bias + c + 4);
#pragma unroll
            for (int ai = 0; ai < 2; ++ai)
#pragma unroll
                for (int m = 0; m < 4; ++m) { const int row = rowb + ai * HALF + m * 16;
                    const u32x4 zz = *(const u32x4*)(Z + (size_t)row * 512 + c);
                    f32x4 v0 = acc[ai][bj][m][0] + b0, v1 = acc[ai][bj][m][1] + b1;
                    v0[0] = bflo(zz.x) * fsigm(v0[0]); v0[1] = bfhi(zz.x) * fsigm(v0[1]); v0[2] = bflo(zz.y) * fsigm(v0[2]); v0[3] = bfhi(zz.y) * fsigm(v0[3]);
                    v1[0] = bflo(zz.z) * fsigm(v1[0]); v1[1] = bfhi(zz.z) * fsigm(v1[1]); v1[2] = bflo(zz.w) * fsigm(v1[2]); v1[3] = bfhi(zz.w) * fsigm(v1[3]);
                    *(u32x4*)(br + (size_t)row * D + 512 + c) = pack8(v0, v1); } }
    }
};
struct EpiBranch {
    static constexpr bool PERM = true;
    const bf16_t* proj; bf16_t* merged;
    __device__ __forceinline__ void operator()(f32x4 (&acc)[2][2][4][2], const Unit& u, int wr, int wc, int fr, int fq) const {
        const int rowb = u.pm * BM + wr * 64 + fr, colb = u.pn * 256 + 64 * wc + 8 * fq, kz = u.kz;
#pragma unroll
        for (int ai = 0; ai < 2; ++ai)
#pragma unroll
            for (int m = 0; m < 4; ++m) { const int row = rowb + ai * HALF + m * 16;
#pragma unroll
                for (int bj = 0; bj < 2; ++bj) { const int c = colb + 32 * bj;
                    const u32x4 gg = *(const u32x4*)(proj + (size_t)row * PJ + P_GATE + kz * D + c);
                    float g[8] = {bflo(gg.x), bfhi(gg.x), bflo(gg.y), bfhi(gg.y), bflo(gg.z), bfhi(gg.z), bflo(gg.w), bfhi(gg.w)};
                    if (kz < 3) { const u32x4 hh = *(const u32x4*)(proj + (size_t)row * PJ + P_GATE + (kz + 1) * D + c);
                        const float h[8] = {bflo(hh.x), bfhi(hh.x), bflo(hh.y), bfhi(hh.y), bflo(hh.z), bfhi(hh.z), bflo(hh.w), bfhi(hh.w)};
#pragma unroll
                        for (int j = 0; j < 8; ++j) g[j] = g[j] * __builtin_amdgcn_rcpf(fmaxf(h[j], 1e-30f)); }
                    f32x4& v0 = acc[ai][bj][m][0]; f32x4& v1 = acc[ai][bj][m][1];
                    v0[0] *= g[0]; v0[1] *= g[1]; v0[2] *= g[2]; v0[3] *= g[3]; v1[0] *= g[4]; v1[1] *= g[5]; v1[2] *= g[6]; v1[3] *= g[7];
                    if (kz == 3) *(u32x4*)(merged + (size_t)row * D + c) = pack8(v0, v1); } }
    }
};
struct EpiResid {
    static constexpr bool PERM = false;
    const float* xp; const float* xs; const float* modl; int g_off; float* xout; float* part;
    __device__ __forceinline__ void operator()(f32x4 (&acc)[2][2][4][2], const Unit& u, int wr, int wc, int fr, int fq) const {
        if (part != nullptr && u.pm >= 32) {
            float* P = part + (size_t)((((u.pm - 32) * 8 + u.pn) * 2) + (u.koff != 0)) * 65536 + (size_t)(wr * 64 + fr) * 256 + wc * 32 + 4 * fq;
#pragma unroll
            for (int ai = 0; ai < 2; ++ai)
#pragma unroll
                for (int m = 0; m < 4; ++m)
#pragma unroll
                    for (int bj = 0; bj < 2; ++bj)
#pragma unroll
                        for (int n = 0; n < 2; ++n) *(f32x4*)(P + (size_t)(ai * HALF + m * 16) * 256 + bj * HALF + n * 16) = acc[ai][bj][m][n];
            return;
        }
        const int row0 = u.pm * BM, rowb = row0 + wr * 64 + fr, colb = u.pn * 256 + wc * 32 + 4 * fq;
        const float* xin = row0 < MP ? xp : xs - (size_t)MP * D;
        const float* gate = modl + (size_t)row_cvec(row0) * 6 * D + g_off;
        f32x4 gv[2][2];
#pragma unroll
        for (int bj = 0; bj < 2; ++bj)
#pragma unroll
            for (int n = 0; n < 2; ++n) gv[bj][n] = *(const f32x4*)(gate + colb + bj * HALF + n * 16);
#pragma unroll
        for (int ai = 0; ai < 2; ++ai)
#pragma unroll
            for (int m = 0; m < 4; ++m) { const size_t ro = (size_t)(rowb + ai * HALF + m * 16) * D + colb;
#pragma unroll
                for (int bj = 0; bj < 2; ++bj)
#pragma unroll
                    for (int n = 0; n < 2; ++n) { const size_t o = ro + bj * HALF + n * 16; *(f32x4*)(xout + o) = *(const f32x4*)(xin + o) + gv[bj][n] * acc[ai][bj][m][n]; } }
    }
};
}
namespace mk {
constexpr size_t AL(size_t x) { return (x + 255) & ~(size_t)255; }
constexpr size_t WS_CTL = 0, CTL_BYTES = 65536;
constexpr size_t WS_MOD = WS_CTL + CTL_BYTES;
constexpr size_t WS_W = AL(WS_MOD + (size_t)DEPTH * 5 * 6 * D * 4);
constexpr size_t W_IN = 0, W_GLU = W_IN + (size_t)NIN * D, W_BR = W_GLU + 512 * 512, W_OUT = W_BR + (size_t)4 * D * 512, W_1 = W_OUT + (size_t)D * D, W_2 = W_1 + (size_t)DFF * D,
                 W_LAYER = W_2 + (size_t)D * DFF;
constexpr size_t WS_H = AL(WS_W + W_LAYER * 2 * DEPTH);
constexpr size_t WS_PROJ = AL(WS_H + (size_t)M * D * 2);
constexpr size_t WS_SMALL = AL(WS_PROJ + (size_t)M * PJ * 2);
constexpr size_t WS_BR = AL(WS_SMALL + (size_t)M * 32 * 4);
constexpr size_t WS_MERGED = AL(WS_BR + (size_t)M * D * 2);
constexpr size_t WS_MACC = AL(WS_MERGED + (size_t)M * D * 2);
constexpr size_t WS_ZB = AL(WS_MACC + (size_t)M * D * 4);
constexpr size_t WS_SCR = AL(WS_ZB + (size_t)M * 512 * 2);
constexpr int LDS_BYTES = 140 * 1024, LDS_CTL = LDS_BYTES - 256;

struct Args { const float* in[43]; float* out; unsigned char* ws; int ph_lo, ph_hi; };

__device__ __forceinline__ float wave_sum(float v) {
#pragma unroll
    for (int o = 1; o < 64; o <<= 1) v += __shfl_xor(v, o);
    return v;
}
#define LDS_WAIT() asm volatile("s_waitcnt lgkmcnt(0)" ::: "memory")

__device__ __forceinline__ void xpose_item(const float* W, int ldw, int k0, int sc, bf16_t* dst, int K, LAS float* scr, int lane, int mode) {
    const int j = lane & 31;
    const int col = mode == 1 ? (j < 16 ? 3584 + j : 5648 + (j - 16)) : sc + j;
#pragma unroll 8
    for (int i = 0; i < 32; ++i) { const int kk = 2 * i + (lane >> 5); scr[kk * 33 + j] = mode == 2 ? 0.f : W[(size_t)(k0 + kk) * ldw + col]; }
    LDS_WAIT(); asm volatile("" ::: "memory");
    const int c = lane & 7;
#pragma unroll
    for (int jj = 0; jj < 4; ++jj) { const int n = (lane >> 3) + 8 * jj; const LAS float* s = scr + (8 * c) * 33 + n;
        u32x4 o; o.x = pk2(s[0 * 33], s[1 * 33]); o.y = pk2(s[2 * 33], s[3 * 33]); o.z = pk2(s[4 * 33], s[5 * 33]); o.w = pk2(s[6 * 33], s[7 * 33]);
        *(u32x4*)(dst + (size_t)n * K + k0 + 8 * c) = o; }
    LDS_WAIT(); asm volatile("" ::: "memory");
}
__device__ __forceinline__ int hm_col(int grp) { const int T = grp >> 3, q8 = grp & 7; return 256 * T + 32 * (2 * (q8 & 3) + (q8 >> 2)); }

__device__ __forceinline__ void prologue_convert(const Args& a, LAS unsigned char* lds, int gw, int ngw, int wave, int lane) {
    LAS float* scr = (LAS float*)(lds + wave * 8704);
    bf16_t* WB = (bf16_t*)(a.ws + WS_W);
    constexpr int I_IN = 440 * 32, I_GLU = 16 * 8, I_BR = 4 * 64 * 8, I_OUT = 64 * 32, I_1 = 256 * 32, I_2 = 64 * 128, I_L = I_IN + I_GLU + I_BR + I_OUT + I_1 + I_2;
    for (int it = gw; it < I_L * DEPTH; it += ngw) {
        const int l = it / I_L; int r = it - l * I_L; bf16_t* wl = WB + (size_t)l * W_LAYER;
        if (r < I_IN) { const int kb = r / 440, grp = r % 440, T = grp >> 3; int sc = hm_col(grp), mode = 0;
            if (T == 54) mode = (grp & 7) == 0 ? 1 : 2; else if (T >= 22) sc += 32; else if (T >= 14) sc += 16;
            xpose_item(a.in[16] + (size_t)l * D * 13856, 13856, 64 * kb, sc, wl + W_IN + (size_t)(32 * grp) * D, D, scr, lane, mode); continue; } r -= I_IN;
        if (r < I_GLU) { const int kb = r / 16, grp = r % 16; xpose_item(a.in[28] + (size_t)l * 512 * 512, 512, 64 * kb, hm_col(grp), wl + W_GLU + (size_t)(32 * grp) * 512, 512, scr, lane, 0); continue; } r -= I_GLU;
        if (r < I_BR) { const int k = r / 512, r2 = r % 512, kb = r2 / 64, grp = r2 % 64;
            xpose_item(a.in[39] + ((size_t)l * 4 + k) * 512 * D, D, 64 * kb, hm_col(grp), wl + W_BR + (size_t)k * D * 512 + (size_t)(32 * grp) * 512, 512, scr, lane, 0); continue; } r -= I_BR;
        if (r < I_OUT) { const int kb = r / 64, grp = r % 64; xpose_item(a.in[40] + (size_t)l * D * D, D, 64 * kb, 32 * grp, wl + W_OUT + (size_t)(32 * grp) * D, D, scr, lane, 0); continue; } r -= I_OUT;
        if (r < I_1) { const int kb = r / 256, grp = r % 256; xpose_item(a.in[41] + (size_t)l * D * DFF, DFF, 64 * kb, hm_col(grp), wl + W_1 + (size_t)(32 * grp) * D, D, scr, lane, 0); continue; } r -= I_1;
        { const int kb = r / 64, grp = r % 64; xpose_item(a.in[42] + (size_t)l * DFF * D, D, 64 * kb, 32 * grp, wl + W_2 + (size_t)(32 * grp) * DFF, DFF, scr, lane, 0); }
    }
}
__device__ __forceinline__ void prologue_ada(const Args& a, LAS unsigned char* lds, int tid) {
    LAS float* sl = (LAS float*)lds;
    LAS float* red = (LAS float*)(lds + 40960);
    float* mod = (float*)(a.ws + WS_MOD);
    for (int i = tid; i < 5 * D; i += NT) { const int j = i / D, k = i % D; const float x = j == 0 ? a.in[11][k] : a.in[10][(j - 1) * D + k]; sl[i] = x / (1.f + __expf(-x)); }
    __syncthreads();
    const int ks = tid >> 6, c = tid & 63;
    for (int unit = blockIdx.x; unit < DEPTH * 6 * D / 64; unit += gridDim.x) {
        const int l = unit / (6 * D / 64), n0 = (unit % (6 * D / 64)) * 64;
        const float* w = a.in[12] + (size_t)l * D * 6 * D + n0 + c;
        float acc[5] = {0.f, 0.f, 0.f, 0.f, 0.f};
#pragma unroll 4
        for (int k = ks * 256; k < ks * 256 + 256; ++k) { const float wv = w[(size_t)k * 6 * D];
#pragma unroll
            for (int j = 0; j < 5; ++j) acc[j] += sl[j * D + k] * wv; }
#pragma unroll
        for (int j = 0; j < 5; ++j) red[(ks * 5 + j) * 64 + c] = acc[j];
        __syncthreads();
        if (tid < 320) { const int j = tid >> 6; float s = 0.f;
#pragma unroll
            for (int q = 0; q < 8; ++q) s += red[(q * 5 + j) * 64 + c];
            mod[((size_t)l * 5 + j) * 6 * D + n0 + c] = s + a.in[13][l * 6 * D + n0 + c]; }
        __syncthreads();
    }
}
__device__ __forceinline__ void norm_phase(const float* xp, const float* xs, const float* g, const float* modl, int sh_off, int sc_off, bf16_t* H, int gw, int ngw, int lane_,
                                           const float* pend, const float* pmodl, int pg_off, float* xw, const float* xs_pend) {
    int lane = lane_; asm volatile("" : "+v"(lane));
    for (int row = gw; row < M; row += ngw) {
        const float* x = row < MP ? xp + (size_t)row * D : xs + (size_t)(row - MP) * D;
        if (pend != nullptr && row >= 8192) x = xs_pend + (size_t)(row - MP) * D;
        f32x4 v[8]; float ss = 0.f;
#pragma unroll
        for (int j = 0; j < 8; ++j) v[j] = *(const f32x4*)(x + 4 * (lane + 64 * j));
        if (pend != nullptr && row >= 8192) {
            const float* pg = pmodl + (size_t)row_cvec(row) * 6 * D + pg_off; const int pm = row >> 8, r = row & 255;
#pragma unroll
            for (int j = 0; j < 8; ++j) { const int col = 4 * (lane + 64 * j), pn = col >> 8, cc = col & 255;
                const float* P = pend + (size_t)(((pm - 32) * 8 + pn) * 2) * 65536 + (size_t)r * 256 + cc;
                const f32x4 pa = *(const f32x4*)P, pb = *(const f32x4*)(P + 65536), gg = *(const f32x4*)(pg + col);
                v[j] = v[j] + gg * (pa + pb); *(f32x4*)(xw + (size_t)row * D + col) = v[j]; }
        }
#pragma unroll
        for (int j = 0; j < 8; ++j) ss += (v[j][0] * v[j][0] + v[j][1] * v[j][1]) + (v[j][2] * v[j][2] + v[j][3] * v[j][3]);
        const float r = rsqrtf(wave_sum(ss) * (1.f / D) + 1e-6f);
        const float* md = modl + (size_t)row_cvec(row) * 6 * D;
#pragma unroll
        for (int j = 0; j < 8; ++j) { const int i = 4 * (lane + 64 * j);
            const f32x4 gg = *(const f32x4*)(g + i), sc = *(const f32x4*)(md + sc_off + i), sh = *(const f32x4*)(md + sh_off + i);
            const f32x4 o = v[j] * r * gg * (sc + 1.f) + sh;
            u32x2 w; w.x = pk2(o[0], o[1]); w.y = pk2(o[2], o[3]); *(u32x2*)(H + (size_t)row * D + i) = w; }
    }
}
__device__ __forceinline__ void final_fix_phase(const float* pend, const float* pmodl, int pg_off, float* X, int gw, int ngw, int lane_) {
    int lane = lane_; asm volatile("" : "+v"(lane));
    for (int row = 8192 + gw; row < M; row += ngw) {
        const float* pg = pmodl + (size_t)row_cvec(row) * 6 * D + pg_off; const int pm = row >> 8, r = row & 255;
#pragma unroll
        for (int j = 0; j < 8; ++j) { const int col = 4 * (lane + 64 * j), pn = col >> 8, cc = col & 255;
            const float* P = pend + (size_t)(((pm - 32) * 8 + pn) * 2) * 65536 + (size_t)r * 256 + cc;
            const f32x4 pa = *(const f32x4*)P, pb = *(const f32x4*)(P + 65536), gg = *(const f32x4*)(pg + col);
            float* xo = X + (size_t)row * D + col; *(f32x4*)xo = *(const f32x4*)xo + gg * (pa + pb); }
    }
}
}
namespace mk {
constexpr size_t WS_NAT = AL(WS_SCR);
constexpr int NATP = 2048, N_XBC = 0, N_Q = 1024, N_K = 1536;
constexpr size_t WS_TR = AL(WS_NAT + (size_t)M * NATP * 2);
constexpr int T_X = 0, T_B = 512, T_K = 768, T_MV = 1280, T_V = 1792, TRR = 2304;
constexpr int NCH = 96;
constexpr size_t WS_MLC = AL(WS_TR + (size_t)TRR * M * 2);
constexpr size_t WS_MLN = AL(WS_MLC + (size_t)NCH * 4 * 2 * 16384 * 4);
constexpr size_t WS_MLS = AL(WS_MLN + (size_t)NCH * 4 * 2 * 128 * 4);
constexpr size_t WS_MLCS = AL(WS_MLS + (size_t)NCH * 4 * 2 * 4 * 4);
constexpr size_t WS_MLNS = AL(WS_MLCS + (size_t)NCH * 4 * 2 * 16384 * 2);
constexpr size_t WS_MLMS = AL(WS_MLNS + (size_t)NCH * 4 * 2 * 128 * 4);
constexpr size_t WS_OPT_END = AL(WS_MLMS + (size_t)NCH * 4 * 2 * 4);

__device__ __forceinline__ f32x4 mfma16(bf16x8 a, bf16x8 b, f32x4 c) { return __builtin_amdgcn_mfma_f32_16x16x32_bf16(a, b, c, 0, 0, 0); }
__device__ __forceinline__ void chunk_info(int ch, int& row0, int& seq0, int& L, int& lat, int& b, int& ci, int& nc) {
    if (ch < 32) { b = ch >> 1; ci = ch & 1; nc = 2; seq0 = b * 256; L = 256; lat = 0; } else { const int c2 = ch - 32; b = c2 >> 4; ci = c2 & 15; nc = 16; seq0 = MP + b * 2048; L = 2048; lat = 1; }
    row0 = seq0 + ci * 128;
}
__device__ __forceinline__ float fast_exp(float x) { return __expf(x); }

__device__ __forceinline__ void prep_phase(const Args& a, int layer, LAS unsigned char* lds, int gw_, int ngw, int wave, int lane_, bf16_t* UPk) {
    int lane = lane_, gw = gw_; asm volatile("" : "+v"(lane));
    const bf16_t* PROJ = (const bf16_t*)(a.ws + WS_PROJ); bf16_t* NAT = (bf16_t*)(a.ws + WS_NAT); bf16_t* TR = (bf16_t*)(a.ws + WS_TR);
    LAS bf16_t* tile = (LAS bf16_t*)(lds + wave * 16896); LAS bf16_t* otile = tile + 68 * 64;
    const int c = lane & 7, r8 = lane >> 3;
    const float* cw = a.in[30] + layer * 5 * 1024; const float* cb = a.in[31] + layer * 1024;
    for (int u = gw; u < 56 * 192; u += ngw) {
        const int cg = u / 192, tt = u % 192, m0 = tt * 64;
        const int lat = m0 >= MP; const int seq0 = lat ? MP + ((m0 - MP) / 2048) * 2048 : (m0 / 256) * 256, L = lat ? 2048 : 256, t0 = m0 - seq0;
        int kind, src, natcol = -1, trrow = -1;
        if (cg < 16) { kind = 0; src = P_XBC + 64 * cg; natcol = N_XBC + 64 * cg; if (cg < 12) trrow = T_X + 64 * cg; }
        else if (cg < 24) { kind = 1; src = P_MQ + 64 * (cg - 16); natcol = N_Q + 64 * (cg - 16); }
        else if (cg < 32) { kind = 2; src = P_MK + 64 * (cg - 24); natcol = N_K + 64 * (cg - 24); trrow = T_K + 64 * (cg - 24); }
        else if (cg < 40) { kind = 3; src = P_MV + 64 * (cg - 32); trrow = T_MV + 64 * (cg - 32); }
        else if (cg < 48) { kind = 3; src = P_V + 64 * (cg - 40); trrow = T_V + 64 * (cg - 40); }
        else { kind = 4; src = P_S5U + 64 * (cg - 48); }
        const int roff = kind == 0 ? -2 : 0, nrows = kind == 0 ? 68 : 64;
#pragma unroll
        for (int i = 0; i < 9; ++i) { const int r = r8 + 8 * i; if (r < nrows) { const int t = t0 + r + roff; u32x4 v = {0u, 0u, 0u, 0u};
                if (t >= 0 && t < L) v = *(const u32x4*)(PROJ + (size_t)(seq0 + t) * PJ + src + 8 * c);
                *(LAS u32x4*)(tile + r * 64 + 8 * c) = v; } }
        LDS_WAIT(); asm volatile("" ::: "memory");
#define PREP_EMIT(i_, r_) do { if (natcol >= 0) *(u32x4*)(NAT + (size_t)(m0 + r8 + 8 * (i_)) * NATP + natcol + 8 * c) = (r_); if (trrow >= 0) *(LAS u32x4*)(otile + (r8 + 8 * (i_)) * 64 + 8 * c) = (r_); } while (0)
        if (kind == 0) {
            float w[5][8], bz[8];
#pragma unroll
            for (int e = 0; e < 8; ++e) { bz[e] = cb[64 * cg + 8 * c + e];
#pragma unroll
                for (int j = 0; j < 5; ++j) w[j][e] = cw[j * 1024 + 64 * cg + 8 * c + e]; }
#pragma unroll 2
            for (int i = 0; i < 8; ++i) { const int tk = r8 + 8 * i; float acc[8];
#pragma unroll
                for (int e = 0; e < 8; ++e) acc[e] = bz[e];
#pragma unroll
                for (int j = 0; j < 5; ++j) { const u32x4 v = *(const LAS u32x4*)(tile + (tk + j) * 64 + 8 * c);
                    acc[0] += bflo(v.x) * w[j][0]; acc[1] += bfhi(v.x) * w[j][1]; acc[2] += bflo(v.y) * w[j][2]; acc[3] += bfhi(v.y) * w[j][3];
                    acc[4] += bflo(v.z) * w[j][4]; acc[5] += bfhi(v.z) * w[j][5]; acc[6] += bflo(v.w) * w[j][6]; acc[7] += bfhi(v.w) * w[j][7]; }
#pragma unroll
                for (int e = 0; e < 8; ++e) acc[e] = fsilu(acc[e]);
                u32x4 rv; rv.x = pk2(acc[0], acc[1]); rv.y = pk2(acc[2], acc[3]); rv.z = pk2(acc[4], acc[5]); rv.w = pk2(acc[6], acc[7]); PREP_EMIT(i, rv); }
        } else if (kind == 4) {
#pragma unroll
            for (int i = 0; i < 8; ++i) { const int tk = r8 + 8 * i, m = m0 + tk; const u32x4 v = *(const LAS u32x4*)(tile + tk * 64 + 8 * c);
                *(u32x4*)(UPk + ((size_t)(4 * (cg - 48) + (c >> 1)) * 384 + (m >> 5)) * 512 + (m & 31) * 16 + 8 * (c & 1)) = v; }
        } else if (kind == 3 || !lat) {
            const float sc = kind == 2 ? 0.08838834764831845f : 1.f;
#pragma unroll
            for (int i = 0; i < 8; ++i) { const u32x4 v = *(const LAS u32x4*)(tile + (r8 + 8 * i) * 64 + 8 * c);
                u32x4 rv = v;
                if (kind == 2) { rv.x = pk2(bflo(v.x) * sc, bfhi(v.x) * sc); rv.y = pk2(bflo(v.y) * sc, bfhi(v.y) * sc); rv.z = pk2(bflo(v.z) * sc, bfhi(v.z) * sc); rv.w = pk2(bflo(v.w) * sc, bfhi(v.w) * sc); }
                PREP_EMIT(i, rv); }
        } else {
            const float sc = kind == 2 ? 0.08838834764831845f : 1.f; const int odd = cg & 1;
            float inv[8];
#pragma unroll
            for (int e = 0; e < 8; ++e) inv[e] = exp2f(-(float)(8 * (c & 3) + e) * (13.287712379549449f / 32.f));
#pragma unroll
            for (int i = 0; i < 8; ++i) { const int tk = r8 + 8 * i, t = t0 + tk; const float pos = odd ? (float)(t & 63) : (float)(t >> 6);
                const u32x4 vo = *(const LAS u32x4*)(tile + tk * 64 + 8 * c), vp = *(const LAS u32x4*)(tile + tk * 64 + 8 * (c ^ 4));
                float o[8], p[8], rr[8];
                o[0] = bflo(vo.x); o[1] = bfhi(vo.x); o[2] = bflo(vo.y); o[3] = bfhi(vo.y); o[4] = bflo(vo.z); o[5] = bfhi(vo.z); o[6] = bflo(vo.w); o[7] = bfhi(vo.w);
                p[0] = bflo(vp.x); p[1] = bfhi(vp.x); p[2] = bflo(vp.y); p[3] = bfhi(vp.y); p[4] = bflo(vp.z); p[5] = bfhi(vp.z); p[6] = bflo(vp.w); p[7] = bfhi(vp.w);
#pragma unroll
                for (int e = 0; e < 8; ++e) { const float ang = pos * inv[e], cs = __cosf(ang), sn = __sinf(ang);
                    rr[e] = (c < 4 ? o[e] * cs - p[e] * sn : p[e] * sn + o[e] * cs) * sc; }
                u32x4 rv; rv.x = pk2(rr[0], rr[1]); rv.y = pk2(rr[2], rr[3]); rv.z = pk2(rr[4], rr[5]); rv.w = pk2(rr[6], rr[7]); PREP_EMIT(i, rv); }
        }
        if (trrow >= 0) {
            LDS_WAIT(); asm volatile("" ::: "memory");
            bf16_t* dst = TR + (size_t)(trrow + lane) * M + m0;
#pragma unroll
            for (int j = 0; j < 8; ++j) { unsigned wv[4];
#pragma unroll
                for (int q = 0; q < 4; ++q) { const unsigned lo = otile[(8 * j + 2 * q) * 64 + lane], hi = otile[(8 * j + 2 * q + 1) * 64 + lane]; wv[q] = lo | (hi << 16); }
                u32x4 o; o.x = wv[0]; o.y = wv[1]; o.z = wv[2]; o.w = wv[3]; *(u32x4*)(dst + 8 * j) = o; }
        }
        LDS_WAIT(); asm volatile("" ::: "memory");
    }
}

struct MlGate { float lf0, lf1, ig0, ig1, P0, P1, tot; };
__device__ __forceinline__ float wave_incl_scan(float v, int lane) {
#pragma unroll
    for (int o = 1; o < 64; o <<= 1) { const float t = __shfl_up(v, o); if (lane >= o) v += t; }
    return v;
}
__device__ __forceinline__ float wave_max(float v) {
#pragma unroll
    for (int o = 1; o < 64; o <<= 1) v = fmaxf(v, __shfl_xor(v, o));
    return v;
}
__device__ __forceinline__ MlGate ml_gates(const Args& a, int layer, int row0, int hh, int dir, int lane) {
    const float* SMALL = (const float*)(a.ws + WS_SMALL);
    const float ib = a.in[36][layer * 8 + dir * 4 + hh], fb = a.in[37][layer * 8 + dir * 4 + hh];
    MlGate g;
    const float f0 = SMALL[(size_t)(row0 + lane) * 32 + S_MF + dir * 4 + hh] + fb, f1 = SMALL[(size_t)(row0 + lane + 64) * 32 + S_MF + dir * 4 + hh] + fb;
    g.ig0 = SMALL[(size_t)(row0 + lane) * 32 + S_MI + dir * 4 + hh] + ib; g.ig1 = SMALL[(size_t)(row0 + lane + 64) * 32 + S_MI + dir * 4 + hh] + ib;
    g.lf0 = fminf(f0, 0.f) - log1pf(__expf(-fabsf(f0))); g.lf1 = fminf(f1, 0.f) - log1pf(__expf(-fabsf(f1)));
    const float s0 = wave_incl_scan(g.lf0, lane); const float tot0 = __shfl(s0, 63);
    const float s1 = wave_incl_scan(g.lf1, lane) + tot0;
    g.P0 = s0; g.P1 = s1; g.tot = __shfl(s1, 63);
    return g;
}

__device__ __forceinline__ void ml_states_phase(const Args& a, int layer, int tid_, int G) {
    int tid = tid_; asm volatile("" : "+v"(tid));
    const int lane = tid & 63, wave = __builtin_amdgcn_readfirstlane(tid >> 6), fr = lane & 15, fq = lane >> 4;
    const bf16_t* TR = (const bf16_t*)(a.ws + WS_TR);
    float* MLC = (float*)(a.ws + WS_MLC); float* MLN = (float*)(a.ws + WS_MLN); float* MLS = (float*)(a.ws + WS_MLS);
    for (int u = blockIdx.x; u < NCH * 4; u += G) {
        const int ch = u >> 2, hh = u & 3; int row0, seq0, L, lat, b, ci, nc; chunk_info(ch, row0, seq0, L, lat, b, ci, nc);
#pragma unroll 1
        for (int dir = 0; dir < 2; ++dir) {
            const MlGate g = ml_gates(a, layer, row0, hh, dir, lane);
            const float w0 = (dir == 0 ? g.tot - g.P0 : g.P0 - g.lf0) + g.ig0, w1 = (dir == 0 ? g.tot - g.P1 : g.P1 - g.lf1) + g.ig1;
            const float mloc = wave_max(fmaxf(w0, w1));
            const float e0 = __expf(w0 - mloc), e1 = __expf(w1 - mloc);
            f32x4 acc[8];
#pragma unroll
            for (int j = 0; j < 8; ++j) acc[j] = (f32x4){0.f, 0.f, 0.f, 0.f};
            float nacc[8];
#pragma unroll
            for (int j = 0; j < 8; ++j) nacc[j] = 0.f;
            const bf16_t* vrow = TR + (size_t)(T_MV + hh * 128 + wave * 16 + fr) * M + row0 + 8 * fq;
#pragma unroll
            for (int ks = 0; ks < 4; ++ks) {
                const bf16x8 af = *(const bf16x8*)(vrow + 32 * ks);
                float ev[8];
#pragma unroll
                for (int j = 0; j < 8; ++j) { const int tok = 32 * ks + 8 * fq + j; const float x0 = __shfl(e0, tok & 63), x1 = __shfl(e1, tok & 63); ev[j] = tok < 64 ? x0 : x1; }
#pragma unroll
                for (int jt = 0; jt < 8; ++jt) {
                    const u32x4 kv = *(const u32x4*)(TR + (size_t)(T_K + hh * 128 + jt * 16 + fr) * M + row0 + 32 * ks + 8 * fq);
                    const float k0 = bflo(kv.x) * ev[0], k1 = bfhi(kv.x) * ev[1], k2 = bflo(kv.y) * ev[2], k3 = bfhi(kv.y) * ev[3], k4 = bflo(kv.z) * ev[4], k5 = bfhi(kv.z) * ev[5], k6 = bflo(kv.w) * ev[6], k7 = bfhi(kv.w) * ev[7];
                    if (wave == 0) nacc[jt] += ((k0 + k1) + (k2 + k3)) + ((k4 + k5) + (k6 + k7));
                    u32x4 kb; kb.x = pk2(k0, k1); kb.y = pk2(k2, k3); kb.z = pk2(k4, k5); kb.w = pk2(k6, k7);
                    acc[jt] = mfma16(af, __builtin_bit_cast(bf16x8, kb), acc[jt]);
                }
            }
            float* cdst = MLC + ((size_t)(ch * 4 + hh) * 2 + dir) * 16384;
#pragma unroll
            for (int jt = 0; jt < 8; ++jt)
#pragma unroll
                for (int i = 0; i < 4; ++i) cdst[(size_t)(wave * 16 + 4 * fq + i) * 128 + jt * 16 + fr] = acc[jt][i];
            if (wave == 0) {
#pragma unroll
                for (int jt = 0; jt < 8; ++jt) { float v = nacc[jt]; v += __shfl_xor(v, 16); v += __shfl_xor(v, 32); if (fq == 0) MLN[((size_t)(ch * 4 + hh) * 2 + dir) * 128 + jt * 16 + fr] = v; }
                if (lane == 0) { MLS[((size_t)(ch * 4 + hh) * 2 + dir) * 4 + 0] = mloc; MLS[((size_t)(ch * 4 + hh) * 2 + dir) * 4 + 1] = g.tot; }
            }
        }
    }
}
__device__ __forceinline__ void ml_scan_phase(const Args& a, int layer, int tid_, int G) {
    int tid = tid_; asm volatile("" : "+v"(tid));
    const float* MLC = (const float*)(a.ws + WS_MLC); const float* MLN = (const float*)(a.ws + WS_MLN); const float* MLS = (const float*)(a.ws + WS_MLS);
    bf16_t* CS = (bf16_t*)(a.ws + WS_MLCS); float* NS = (float*)(a.ws + WS_MLNS); float* MS = (float*)(a.ws + WS_MLMS);
    for (int task = blockIdx.x; task < 256; task += G) {
        int lat, b, hh, dir, part, nparts;
        if (task < 128) { lat = 1; part = task & 3; dir = (task >> 2) & 1; hh = (task >> 3) & 3; b = task >> 5; nparts = 4; }
        else { const int t2 = task - 128; lat = 0; part = 0; dir = t2 & 1; hh = (t2 >> 1) & 3; b = t2 >> 3; nparts = 1; }
        const int nc = lat ? 16 : 2, ch0 = lat ? 32 + b * 16 : b * 2;
        const int nel = 16384 / nparts, e0 = part * nel, per = nel / NT;
        float c[32]; float n = 0.f, m = 0.f;
        const size_t so = (((size_t)b * DEPTH + layer) * 2 + dir) * 4 + hh;
#pragma unroll
        for (int i = 0; i < 32; ++i) if (i < per) { const int e = e0 + i * NT + tid, vd = e >> 7, kd = e & 127; c[i] = lat ? a.in[7][(so * 128 + kd) * 128 + vd] : 0.f; }
        if (tid < 128) n = lat ? a.in[8][so * 128 + tid] : 0.f;
        m = lat ? a.in[9][so] : 0.f;
        float nx[32]; float nn = 0.f, nml = 0.f, nbl = 0.f;
        { const int ch = ch0 + (dir ? nc - 1 : 0); const size_t sb = (size_t)(ch * 4 + hh) * 2 + dir;
#pragma unroll
            for (int i = 0; i < 32; ++i) if (i < per) nx[i] = MLC[sb * 16384 + e0 + i * NT + tid];
            if (tid < 128) nn = MLN[sb * 128 + tid]; nml = MLS[sb * 4 + 0]; nbl = MLS[sb * 4 + 1]; }
        for (int s = 0; s < nc; ++s) { const int ci = dir ? nc - 1 - s : s, ch = ch0 + ci; const size_t sb = (size_t)(ch * 4 + hh) * 2 + dir;
            float cx[32];
#pragma unroll
            for (int i = 0; i < 32; ++i) if (i < per) cx[i] = nx[i];
            const float cn = nn, ml = nml, bl = nbl;
            if (s + 1 < nc) { const int ch2 = ch0 + (dir ? nc - 2 - s : s + 1); const size_t sb2 = (size_t)(ch2 * 4 + hh) * 2 + dir;
#pragma unroll
                for (int i = 0; i < 32; ++i) if (i < per) nx[i] = MLC[sb2 * 16384 + e0 + i * NT + tid];
                if (tid < 128) nn = MLN[sb2 * 128 + tid]; nml = MLS[sb2 * 4 + 0]; nbl = MLS[sb2 * 4 + 1]; }
#pragma unroll
            for (int i = 0; i < 32; ++i) if (i < per) CS[sb * 16384 + e0 + i * NT + tid] = f2bf(c[i]);
            if (part == 0) { if (tid < 128) NS[sb * 128 + tid] = n; if (tid == 0) MS[sb] = m; }
            const float mn = fmaxf(bl + m, ml), fa = __expf(bl + m - mn), fb = __expf(ml - mn);
#pragma unroll
            for (int i = 0; i < 32; ++i) if (i < per) c[i] = fa * c[i] + fb * cx[i];
            if (tid < 128) n = fa * n + fb * cn;
            m = mn; }
        if (!lat) {
#pragma unroll
            for (int i = 0; i < 32; ++i) if (i < per) { const int e = e0 + i * NT + tid, vd = e >> 7, kd = e & 127; a.out[O_MLC + (so * 128 + kd) * 128 + vd] = c[i]; }
            if (tid < 128) a.out[O_MLN + so * 128 + tid] = n; if (tid == 0) a.out[O_MLM + so] = m; }
    }
}
__device__ __forceinline__ void ml_out_phase(const Args& a, int layer, LAS unsigned char* lds, int tid_, int G) {
    int tid = tid_; asm volatile("" : "+v"(tid));
    const int lane = tid & 63, wave = __builtin_amdgcn_readfirstlane(tid >> 6), fr = lane & 15, fq = lane >> 4;
    const bf16_t* NAT = (const bf16_t*)(a.ws + WS_NAT); const bf16_t* TR = (const bf16_t*)(a.ws + WS_TR); const bf16_t* PROJ = (const bf16_t*)(a.ws + WS_PROJ);
    const bf16_t* CS = (const bf16_t*)(a.ws + WS_MLCS); const float* NS = (const float*)(a.ws + WS_MLNS); const float* MS = (const float*)(a.ws + WS_MLMS);
    bf16_t* BR = (bf16_t*)(a.ws + WS_BR);
    LAS float* U = (LAS float*)lds; LAS float* Wv = U + 128; LAS float* SI = U + 256; LAS float* EM = U + 384; LAS float* NSs = U + 512;
    for (int u = blockIdx.x; u < NCH * 4; u += G) {
        const int ch = u >> 2, hh = u & 3; int row0, seq0, L, lat, b, ci, nc; chunk_info(ch, row0, seq0, L, lat, b, ci, nc);
        const int t = wave * 16 + fr;
        bf16x8 qf[4];
#pragma unroll
        for (int ks = 0; ks < 4; ++ks) qf[ks] = *(const bf16x8*)(NAT + (size_t)(row0 + t) * NATP + N_Q + hh * 128 + 32 * ks + 8 * fq);
        f32x4 hsum[8];
#pragma unroll
        for (int j = 0; j < 8; ++j) hsum[j] = (f32x4){0.f, 0.f, 0.f, 0.f};
#pragma unroll 1
        for (int dir = 0; dir < 2; ++dir) {
            const size_t sb = (size_t)(ch * 4 + hh) * 2 + dir;
            __syncthreads();
            if (wave == 0) {
                const MlGate g = ml_gates(a, layer, row0, hh, dir, lane); const float ms = MS[sb];
                float u0, u1, c0, c1, ai0, ai1;
                if (dir == 0) { u0 = g.ig0 - g.P0; u1 = g.ig1 - g.P1; c0 = g.P0; c1 = g.P1; ai0 = g.P0 + ms; ai1 = g.P1 + ms; }
                else { const float E0 = g.P0 - g.lf0, E1 = g.P1 - g.lf1; u0 = E0 + g.ig0; u1 = E1 + g.ig1; c0 = -E0; c1 = -E1; ai0 = g.tot - E0 + ms; ai1 = g.tot - E1 + ms; }
                float g0 = u0, g1 = u1;
                if (dir == 0) {
#pragma unroll
                    for (int o = 1; o < 64; o <<= 1) { const float x0 = __shfl_up(g0, o), x1 = __shfl_up(g1, o); if (lane >= o) { g0 = fmaxf(g0, x0); g1 = fmaxf(g1, x1); } }
                    g1 = fmaxf(g1, __shfl(g0, 63));
                } else {
#pragma unroll
                    for (int o = 1; o < 64; o <<= 1) { const float x0 = __shfl_down(g0, o), x1 = __shfl_down(g1, o); if (lane + o < 64) { g0 = fmaxf(g0, x0); g1 = fmaxf(g1, x1); } }
                    g0 = fmaxf(g0, __shfl(g1, 0));
                }
                const float mt0 = fmaxf(ai0, c0 + g0), mt1 = fmaxf(ai1, c1 + g1);
                U[lane] = u0; U[lane + 64] = u1; Wv[lane] = c0 - mt0; Wv[lane + 64] = c1 - mt1;
                SI[lane] = __expf(ai0 - mt0); SI[lane + 64] = __expf(ai1 - mt1); EM[lane] = __expf(-mt0); EM[lane + 64] = __expf(-mt1);
                NSs[lane] = NS[sb * 128 + lane]; NSs[lane + 64] = NS[sb * 128 + lane + 64];
            }
            __syncthreads();
            const float wt = Wv[t], sit = SI[t], emt = EM[t];
            f32x4 acc[8];
#pragma unroll
            for (int j = 0; j < 8; ++j) acc[j] = (f32x4){0.f, 0.f, 0.f, 0.f};
#pragma unroll
            for (int ks = 0; ks < 4; ++ks)
#pragma unroll
                for (int j = 0; j < 8; ++j) { const bf16x8 cf = *(const bf16x8*)(CS + sb * 16384 + (size_t)(16 * j + fr) * 128 + 32 * ks + 8 * fq); acc[j] = mfma16(cf, qf[ks], acc[j]); }
            float qn = 0.f;
#pragma unroll
            for (int ks = 0; ks < 4; ++ks) { const u32x4 qv = __builtin_bit_cast(u32x4, qf[ks]); const LAS float* nn = NSs + 32 * ks + 8 * fq;
                qn += bflo(qv.x) * nn[0] + bfhi(qv.x) * nn[1] + bflo(qv.y) * nn[2] + bfhi(qv.y) * nn[3] + bflo(qv.z) * nn[4] + bfhi(qv.z) * nn[5] + bflo(qv.w) * nn[6] + bfhi(qv.w) * nn[7]; }
            qn += __shfl_xor(qn, 16); qn += __shfl_xor(qn, 32);
#pragma unroll
            for (int j = 0; j < 8; ++j) acc[j] *= sit;
            float den = sit * qn;
            const int jlo = dir == 0 ? 0 : (wave >> 1), jhi = dir == 0 ? (wave >> 1) : 3;
            float psum = 0.f;
            for (int jp = jlo; jp <= jhi; ++jp) {
                const int ta = 32 * jp + 8 * (fr >> 2) + (fr & 3);
                f32x4 sa = (f32x4){0.f, 0.f, 0.f, 0.f}, sb2 = (f32x4){0.f, 0.f, 0.f, 0.f};
#pragma unroll
                for (int ks = 0; ks < 4; ++ks) {
                    const bf16x8 ka = *(const bf16x8*)(NAT + (size_t)(row0 + ta) * NATP + N_K + hh * 128 + 32 * ks + 8 * fq);
                    const bf16x8 kb = *(const bf16x8*)(NAT + (size_t)(row0 + ta + 4) * NATP + N_K + hh * 128 + 32 * ks + 8 * fq);
                    sa = mfma16(ka, qf[ks], sa); sb2 = mfma16(kb, qf[ks], sb2); }
                float pa[4], pb[4];
#pragma unroll
                for (int i = 0; i < 4; ++i) { const int s0 = 32 * jp + 8 * fq + i, s1 = s0 + 4;
                    const bool ok0 = dir == 0 ? s0 <= t : s0 >= t, ok1 = dir == 0 ? s1 <= t : s1 >= t;
                    pa[i] = ok0 ? sa[i] * __expf(U[s0] + wt) : 0.f; pb[i] = ok1 ? sb2[i] * __expf(U[s1] + wt) : 0.f;
                    psum += pa[i] + pb[i]; }
                u32x4 pw; pw.x = pk2(pa[0], pa[1]); pw.y = pk2(pa[2], pa[3]); pw.z = pk2(pb[0], pb[1]); pw.w = pk2(pb[2], pb[3]);
                const bf16x8 pf = __builtin_bit_cast(bf16x8, pw);
#pragma unroll
                for (int j = 0; j < 8; ++j) { const bf16x8 vf = *(const bf16x8*)(TR + (size_t)(T_MV + hh * 128 + 16 * j + fr) * M + row0 + 32 * jp + 8 * fq); acc[j] = mfma16(vf, pf, acc[j]); }
            }
            psum += __shfl_xor(psum, 16); psum += __shfl_xor(psum, 32);
            den += psum;
            const float rden = 1.f / fmaxf(fabsf(den), emt);
#pragma unroll
            for (int j = 0; j < 8; ++j) hsum[j] += acc[j] * rden;
        }
        float ss = 0.f;
#pragma unroll
        for (int j = 0; j < 8; ++j) ss += (hsum[j][0] * hsum[j][0] + hsum[j][1] * hsum[j][1]) + (hsum[j][2] * hsum[j][2] + hsum[j][3] * hsum[j][3]);
        ss += __shfl_xor(ss, 16); ss += __shfl_xor(ss, 32);
        const float r = rsqrtf(ss * (1.f / 128.f) + 1e-6f);
        const float* ng = a.in[38] + layer * 512 + hh * 128;
#pragma unroll
        for (int j = 0; j < 8; ++j) { const int vd = 16 * j + 4 * fq; const f32x4 gg = *(const f32x4*)(ng + vd);
            const u32x2 ov = *(const u32x2*)(PROJ + (size_t)(row0 + t) * PJ + P_MO + hh * 128 + vd);
            const float o0 = hsum[j][0] * r * gg[0] * fsigm(bflo(ov.x)), o1 = hsum[j][1] * r * gg[1] * fsigm(bfhi(ov.x)), o2 = hsum[j][2] * r * gg[2] * fsigm(bflo(ov.y)), o3 = hsum[j][3] * r * gg[3] * fsigm(bfhi(ov.y));
            u32x2 w; w.x = pk2(o0, o1); w.y = pk2(o2, o3); *(u32x2*)(BR + (size_t)(row0 + t) * D + 1536 + hh * 128 + vd) = w; }
    }
}
}
namespace mk {
constexpr size_t WS_SST = WS_OPT_END;
constexpr size_t WS_SSL = AL(WS_SST + (size_t)NCH * 8 * 2 * 8192 * 4);
constexpr size_t WS_SSCS = AL(WS_SSL + (size_t)NCH * 8 * 2 * 4);
constexpr size_t WS_YPRE = AL(WS_SSCS + (size_t)NCH * 8 * 2 * 8192 * 2);
constexpr size_t WS_SSQ = AL(WS_YPRE + (size_t)M * 512 * 4);
constexpr size_t WS_SSD_END = AL(WS_SSQ + (size_t)M * 8 * 4);

struct SsdGate { float dt0, dt1, la0, la1, P0, P1, tot; };
__device__ __forceinline__ SsdGate ssd_gates(const Args& a, int layer, int row0, int hh, int dir, int lane) {
    const float* SMALL = (const float*)(a.ws + WS_SMALL);
    const float bias = a.in[32][layer * 16 + dir * 8 + hh], A = -__expf(a.in[33][layer * 16 + dir * 8 + hh]);
    SsdGate g;
    const float x0 = SMALL[(size_t)(row0 + lane) * 32 + S_DT + dir * 8 + hh] + bias, x1 = SMALL[(size_t)(row0 + lane + 64) * 32 + S_DT + dir * 8 + hh] + bias;
    g.dt0 = fmaxf(x0, 0.f) + log1pf(__expf(-fabsf(x0))); g.dt1 = fmaxf(x1, 0.f) + log1pf(__expf(-fabsf(x1)));
    g.la0 = g.dt0 * A; g.la1 = g.dt1 * A;
    const float s0 = wave_incl_scan(g.la0, lane); const float t0 = __shfl(s0, 63);
    const float s1 = wave_incl_scan(g.la1, lane) + t0;
    g.P0 = s0; g.P1 = s1; g.tot = __shfl(s1, 63);
    return g;
}
__device__ __forceinline__ void ssd_states_phase(const Args& a, int layer, int tid_, int G) {
    int tid = tid_; asm volatile("" : "+v"(tid));
    const int lane = tid & 63, wave = __builtin_amdgcn_readfirstlane(tid >> 6), fr = lane & 15, fq = lane >> 4;
    const bf16_t* TR = (const bf16_t*)(a.ws + WS_TR); float* SST = (float*)(a.ws + WS_SST); float* SSL = (float*)(a.ws + WS_SSL);
    for (int u = blockIdx.x; u < NCH * 8; u += G) {
        const int ch = u >> 3, hh = u & 7, grp = hh >> 2; int row0, seq0, L, lat, b, ci, nc; chunk_info(ch, row0, seq0, L, lat, b, ci, nc);
#pragma unroll 1
        for (int dir = 0; dir < 2; ++dir) {
            const SsdGate g = ssd_gates(a, layer, row0, hh, dir, lane);
            const float w0 = g.dt0 * __expf(dir == 0 ? g.tot - g.P0 : g.P0 - g.la0), w1 = g.dt1 * __expf(dir == 0 ? g.tot - g.P1 : g.P1 - g.la1);
            f32x4 acc[4];
#pragma unroll
            for (int j = 0; j < 4; ++j) acc[j] = (f32x4){0.f, 0.f, 0.f, 0.f};
#pragma unroll
            for (int ks = 0; ks < 4; ++ks) {
                float ev[8];
#pragma unroll
                for (int j = 0; j < 8; ++j) { const int tok = 32 * ks + 8 * fq + j; const float y0 = __shfl(w0, tok & 63), y1 = __shfl(w1, tok & 63); ev[j] = tok < 64 ? y0 : y1; }
                const u32x4 bv = *(const u32x4*)(TR + (size_t)(T_B + grp * 128 + wave * 16 + fr) * M + row0 + 32 * ks + 8 * fq);
                u32x4 bw; bw.x = pk2(bflo(bv.x) * ev[0], bfhi(bv.x) * ev[1]); bw.y = pk2(bflo(bv.y) * ev[2], bfhi(bv.y) * ev[3]); bw.z = pk2(bflo(bv.z) * ev[4], bfhi(bv.z) * ev[5]); bw.w = pk2(bflo(bv.w) * ev[6], bfhi(bv.w) * ev[7]);
                const bf16x8 bf = __builtin_bit_cast(bf16x8, bw);
#pragma unroll
                for (int j = 0; j < 4; ++j) { const bf16x8 xf = *(const bf16x8*)(TR + (size_t)(T_X + hh * 64 + 16 * j + fr) * M + row0 + 32 * ks + 8 * fq); acc[j] = mfma16(xf, bf, acc[j]); }
            }
            float* dst = SST + ((size_t)(ch * 8 + hh) * 2 + dir) * 8192;
#pragma unroll
            for (int j = 0; j < 4; ++j)
#pragma unroll
                for (int i = 0; i < 4; ++i) dst[(size_t)(16 * j + 4 * fq + i) * 128 + wave * 16 + fr] = acc[j][i];
            if (tid == 0) SSL[(size_t)(ch * 8 + hh) * 2 + dir] = g.tot;
        }
    }
}
__device__ __forceinline__ void ssd_scan_phase(const Args& a, int layer, int tid_, int G) {
    int tid = tid_; asm volatile("" : "+v"(tid));
    const float* SST = (const float*)(a.ws + WS_SST); const float* SSL = (const float*)(a.ws + WS_SSL); bf16_t* CS = (bf16_t*)(a.ws + WS_SSCS);
    for (int task = blockIdx.x; task < 384; task += G) {
        int lat, b, hh, dir, part, nparts;
        if (task < 128) { lat = 1; part = task & 1; dir = (task >> 1) & 1; hh = (task >> 2) & 7; b = task >> 5; nparts = 2; }
        else { const int t2 = task - 128; lat = 0; part = 0; dir = t2 & 1; hh = (t2 >> 1) & 7; b = t2 >> 4; nparts = 1; }
        const int nc = lat ? 16 : 2, ch0 = lat ? 32 + b * 16 : b * 2;
        const int nel = 8192 / nparts, e0 = part * nel, per = nel / NT;
        float c[16];
        const size_t so = ((((size_t)b * DEPTH + layer) * 2 + dir) * 8 + hh) * 8192;
#pragma unroll
        for (int i = 0; i < 16; ++i) if (i < per) c[i] = lat ? a.in[6][so + e0 + i * NT + tid] : 0.f;
        float nx[16]; float ntot;
        { const int ch = ch0 + (dir ? nc - 1 : 0); const size_t sb = (size_t)(ch * 8 + hh) * 2 + dir;
#pragma unroll
            for (int i = 0; i < 16; ++i) if (i < per) nx[i] = SST[sb * 8192 + e0 + i * NT + tid];
            ntot = SSL[sb]; }
        for (int s = 0; s < nc; ++s) { const int ci = dir ? nc - 1 - s : s, ch = ch0 + ci; const size_t sb = (size_t)(ch * 8 + hh) * 2 + dir;
            float cx[16];
#pragma unroll
            for (int i = 0; i < 16; ++i) if (i < per) cx[i] = nx[i];
            const float dec = __expf(ntot);
            if (s + 1 < nc) { const int ch2 = ch0 + (dir ? nc - 2 - s : s + 1); const size_t sb2 = (size_t)(ch2 * 8 + hh) * 2 + dir;
#pragma unroll
                for (int i = 0; i < 16; ++i) if (i < per) nx[i] = SST[sb2 * 8192 + e0 + i * NT + tid];
                ntot = SSL[sb2]; }
#pragma unroll
            for (int i = 0; i < 16; ++i) if (i < per) CS[sb * 8192 + e0 + i * NT + tid] = f2bf(c[i]);
#pragma unroll
            for (int i = 0; i < 16; ++i) if (i < per) c[i] = dec * c[i] + cx[i]; }
        if (!lat) {
#pragma unroll
            for (int i = 0; i < 16; ++i) if (i < per) a.out[O_SSD + so + e0 + i * NT + tid] = c[i]; }
    }
}
__device__ __forceinline__ void ssd_out_phase(const Args& a, int layer, LAS unsigned char* lds, int tid_, int G) {
    int tid = tid_; asm volatile("" : "+v"(tid));
    const int lane = tid & 63, wave = __builtin_amdgcn_readfirstlane(tid >> 6), fr = lane & 15, fq = lane >> 4;
    const bf16_t* NAT = (const bf16_t*)(a.ws + WS_NAT); const bf16_t* TR = (const bf16_t*)(a.ws + WS_TR); const bf16_t* PROJ = (const bf16_t*)(a.ws + WS_PROJ);
    const bf16_t* CS = (const bf16_t*)(a.ws + WS_SSCS); float* YPRE = (float*)(a.ws + WS_YPRE); float* SSQ = (float*)(a.ws + WS_SSQ);
    LAS float* U = (LAS float*)(lds + 4096); LAS float* Wv = U + 128; LAS float* DT = U + 256; LAS float* EO = U + 384;
    for (int u = blockIdx.x; u < NCH * 8; u += G) {
        const int ch = u >> 3, hh = u & 7, grp = hh >> 2; int row0, seq0, L, lat, b, ci, nc; chunk_info(ch, row0, seq0, L, lat, b, ci, nc);
        const int t = wave * 16 + fr;
        bf16x8 cf[4];
#pragma unroll
        for (int ks = 0; ks < 4; ++ks) cf[ks] = *(const bf16x8*)(NAT + (size_t)(row0 + t) * NATP + N_XBC + 768 + grp * 128 + 32 * ks + 8 * fq);
        f32x4 ysum[4];
#pragma unroll
        for (int j = 0; j < 4; ++j) ysum[j] = (f32x4){0.f, 0.f, 0.f, 0.f};
#pragma unroll 1
        for (int dir = 0; dir < 2; ++dir) {
            const size_t sb = (size_t)(ch * 8 + hh) * 2 + dir;
            __syncthreads();
            if (wave == 0) {
                const SsdGate g = ssd_gates(a, layer, row0, hh, dir, lane);
                if (dir == 0) { U[lane] = -g.P0; U[lane + 64] = -g.P1; Wv[lane] = g.P0; Wv[lane + 64] = g.P1; EO[lane] = __expf(g.P0); EO[lane + 64] = __expf(g.P1); }
                else { const float E0 = g.P0 - g.la0, E1 = g.P1 - g.la1; U[lane] = E0; U[lane + 64] = E1; Wv[lane] = -E0; Wv[lane + 64] = -E1; EO[lane] = __expf(g.tot - E0); EO[lane + 64] = __expf(g.tot - E1); }
                DT[lane] = g.dt0; DT[lane + 64] = g.dt1;
            }
            __syncthreads();
            const float wt = Wv[t], eot = EO[t];
            f32x4 acc[4];
#pragma unroll
            for (int j = 0; j < 4; ++j) acc[j] = (f32x4){0.f, 0.f, 0.f, 0.f};
#pragma unroll
            for (int ks = 0; ks < 4; ++ks)
#pragma unroll
                for (int j = 0; j < 4; ++j) { const bf16x8 sf = *(const bf16x8*)(CS + sb * 8192 + (size_t)(16 * j + fr) * 128 + 32 * ks + 8 * fq); acc[j] = mfma16(sf, cf[ks], acc[j]); }
#pragma unroll
            for (int j = 0; j < 4; ++j) acc[j] *= eot;
            const int jlo = dir == 0 ? 0 : (wave >> 1), jhi = dir == 0 ? (wave >> 1) : 3;
            for (int jp = jlo; jp <= jhi; ++jp) {
                const int ta = 32 * jp + 8 * (fr >> 2) + (fr & 3);
                f32x4 sa = (f32x4){0.f, 0.f, 0.f, 0.f}, sb2 = (f32x4){0.f, 0.f, 0.f, 0.f};
#pragma unroll
                for (int ks = 0; ks < 4; ++ks) {
                    const bf16x8 ba = *(const bf16x8*)(NAT + (size_t)(row0 + ta) * NATP + N_XBC + 512 + grp * 128 + 32 * ks + 8 * fq);
                    const bf16x8 bb = *(const bf16x8*)(NAT + (size_t)(row0 + ta + 4) * NATP + N_XBC + 512 + grp * 128 + 32 * ks + 8 * fq);
                    sa = mfma16(ba, cf[ks], sa); sb2 = mfma16(bb, cf[ks], sb2); }
                float pa[4], pb[4];
#pragma unroll
                for (int i = 0; i < 4; ++i) { const int s0 = 32 * jp + 8 * fq + i, s1 = s0 + 4;
                    const bool ok0 = dir == 0 ? s0 <= t : s0 >= t, ok1 = dir == 0 ? s1 <= t : s1 >= t;
                    pa[i] = ok0 ? sa[i] * DT[s0] * __expf(U[s0] + wt) : 0.f; pb[i] = ok1 ? sb2[i] * DT[s1] * __expf(U[s1] + wt) : 0.f; }
                u32x4 pw; pw.x = pk2(pa[0], pa[1]); pw.y = pk2(pa[2], pa[3]); pw.z = pk2(pb[0], pb[1]); pw.w = pk2(pb[2], pb[3]);
                const bf16x8 pf = __builtin_bit_cast(bf16x8, pw);
#pragma unroll
                for (int j = 0; j < 4; ++j) { const bf16x8 xf = *(const bf16x8*)(TR + (size_t)(T_X + hh * 64 + 16 * j + fr) * M + row0 + 32 * jp + 8 * fq); acc[j] = mfma16(xf, pf, acc[j]); }
            }
#pragma unroll
            for (int j = 0; j < 4; ++j) ysum[j] += acc[j];
        }
        const float Dh = a.in[34][layer * 8 + hh]; float ss = 0.f;
#pragma unroll
        for (int j = 0; j < 4; ++j) { const int p = 16 * j + 4 * fq;
            const u32x2 xv = *(const u32x2*)(NAT + (size_t)(row0 + t) * NATP + N_XBC + hh * 64 + p), zv = *(const u32x2*)(PROJ + (size_t)(row0 + t) * PJ + P_Z + hh * 64 + p);
            f32x4 y; y[0] = (ysum[j][0] + bflo(xv.x) * Dh) * fsilu(bflo(zv.x)); y[1] = (ysum[j][1] + bfhi(xv.x) * Dh) * fsilu(bfhi(zv.x));
            y[2] = (ysum[j][2] + bflo(xv.y) * Dh) * fsilu(bflo(zv.y)); y[3] = (ysum[j][3] + bfhi(xv.y) * Dh) * fsilu(bfhi(zv.y));
            ss += (y[0] * y[0] + y[1] * y[1]) + (y[2] * y[2] + y[3] * y[3]);
            *(f32x4*)(YPRE + (size_t)(row0 + t) * 512 + hh * 64 + p) = y; }
        ss += __shfl_xor(ss, 16); ss += __shfl_xor(ss, 32);
        if (fq == 0) SSQ[(size_t)(row0 + t) * 8 + hh] = ss;
    }
}
__device__ __forceinline__ void ssd_fin_phase(const Args& a, int layer, int gw, int ngw, int lane_) {
    int lane = lane_; asm volatile("" : "+v"(lane));
    const float* YPRE = (const float*)(a.ws + WS_YPRE); const float* SSQ = (const float*)(a.ws + WS_SSQ); bf16_t* BR = (bf16_t*)(a.ws + WS_BR); const float* ng = a.in[35] + layer * 512;
    for (int row = gw; row < M; row += ngw) {
        float s = lane < 8 ? SSQ[(size_t)row * 8 + lane] : 0.f; s += __shfl_xor(s, 1); s += __shfl_xor(s, 2); s += __shfl_xor(s, 4); s = __shfl(s, 0);
        const float r = rsqrtf(s * (1.f / 512.f) + 1e-6f);
        const f32x4 y0 = *(const f32x4*)(YPRE + (size_t)row * 512 + 8 * lane), y1 = *(const f32x4*)(YPRE + (size_t)row * 512 + 8 * lane + 4);
        const f32x4 g0 = *(const f32x4*)(ng + 8 * lane), g1 = *(const f32x4*)(ng + 8 * lane + 4);
        *(u32x4*)(BR + (size_t)row * D + 1024 + 8 * lane) = pack8(y0 * r * g0, y1 * r * g1);
    }
}
}
namespace mk {
constexpr size_t WS_CK = WS_SSD_END;
constexpr size_t WS_CVT = AL(WS_CK + (size_t)16 * 512 * 512 * 2);
constexpr size_t WS_ATT_END = AL(WS_CVT + (size_t)16 * 512 * 512 * 2);

__device__ __forceinline__ void prologue_cache(const Args& a, int gw, int ngw, int lane) {
    bf16_t* CK = (bf16_t*)(a.ws + WS_CK); bf16_t* CVT = (bf16_t*)(a.ws + WS_CVT);
    for (size_t i = ((size_t)gw * 64 + lane) * 8; i < (size_t)16 * 512 * 512; i += (size_t)ngw * 64 * 8) {
        const f32x4 x0 = *(const f32x4*)(a.in[2] + i), x1 = *(const f32x4*)(a.in[2] + i + 4); *(u32x4*)(CK + i) = pack8(x0, x1); }
    for (size_t i = (size_t)gw * 64 + lane; i < (size_t)16 * 64 * 512; i += (size_t)ngw * 64) { const int c = i & 511, s8 = (i >> 9) & 63, bl = i >> 15;
        const float* src = a.in[3] + ((size_t)bl * 512 + 8 * s8) * 512 + c;
        u32x4 o; o.x = pk2(src[0], src[512]); o.y = pk2(src[1024], src[1536]); o.z = pk2(src[2048], src[2560]); o.w = pk2(src[3072], src[3584]);
        *(u32x4*)(CVT + ((size_t)bl * 512 + c) * 512 + 8 * s8) = o; }
}
struct AttState { float m, l; f32x4 o[4]; };
struct AttFrags { bf16x8 k[4]; const bf16_t* vt; size_t vp; };
__device__ __forceinline__ void attn_load(AttFrags& f, const bf16_t* kbase, size_t kp, const bf16_t* vt, size_t vp, int fr, int fq) {
    const int ra = 8 * (fr >> 2) + (fr & 3);
#pragma unroll
    for (int ks = 0; ks < 2; ++ks) { f.k[ks] = *(const bf16x8*)(kbase + (size_t)ra * kp + 32 * ks + 8 * fq); f.k[2 + ks] = *(const bf16x8*)(kbase + (size_t)(ra + 4) * kp + 32 * ks + 8 * fq); }
    f.vt = vt + (size_t)fr * vp + 8 * fq; f.vp = vp;
}
template <bool MASKED>
__device__ __forceinline__ void attn_compute(AttState& st, const bf16x8 (&qf)[2], const AttFrags& f, int fq, const float* bias, int kc0, int cq, int cs) {
    bf16x8 vf[4];
#pragma unroll
    for (int j = 0; j < 4; ++j) vf[j] = *(const bf16x8*)(f.vt + (size_t)(16 * j) * f.vp);
    f32x4 sa = (f32x4){0.f, 0.f, 0.f, 0.f}, sb = (f32x4){0.f, 0.f, 0.f, 0.f};
#pragma unroll
    for (int ks = 0; ks < 2; ++ks) { sa = mfma16(f.k[ks], qf[ks], sa); sb = mfma16(f.k[2 + ks], qf[ks], sb); }
    float s[8]; float gm = -1e30f;
#pragma unroll
    for (int i = 0; i < 4; ++i) { s[i] = sa[i] * 0.125f; s[4 + i] = sb[i] * 0.125f; }
    if (MASKED) {
#pragma unroll
        for (int e = 0; e < 8; ++e) { const int kc = kc0 + 8 * fq + e; const bool ok = kc >= cs && kc < cs + 16; const int bi = min(max(kc - cq + 15, 0), 30); s[e] = ok ? s[e] + bias[bi] : -1e30f; }
    }
#pragma unroll
    for (int e = 0; e < 8; ++e) gm = fmaxf(gm, s[e]);
    gm = fmaxf(gm, __shfl_xor(gm, 16)); gm = fmaxf(gm, __shfl_xor(gm, 32));
    const float mn = fmaxf(st.m, gm), al = __expf(st.m - mn); st.m = mn;
    float p[8], ps = 0.f;
#pragma unroll
    for (int e = 0; e < 8; ++e) { p[e] = __expf(s[e] - mn); ps += p[e]; }
    st.l = st.l * al + ps;
    u32x4 pw; pw.x = pk2(p[0], p[1]); pw.y = pk2(p[2], p[3]); pw.z = pk2(p[4], p[5]); pw.w = pk2(p[6], p[7]);
    const bf16x8 pf = __builtin_bit_cast(bf16x8, pw);
#pragma unroll
    for (int j = 0; j < 4; ++j) st.o[j] = mfma16(vf[j], pf, st.o[j] * al);
}
__device__ __forceinline__ void attn_phase(const Args& a, int layer, int gw_, int ngw, int lane_) {
    int lane = lane_, gw = gw_; asm volatile("" : "+v"(lane));
    const int fr = lane & 15, fq = lane >> 4;
    const bf16_t* PROJ = (const bf16_t*)(a.ws + WS_PROJ); const bf16_t* TR = (const bf16_t*)(a.ws + WS_TR); bf16_t* BR = (bf16_t*)(a.ws + WS_BR);
    const bf16_t* CK = (const bf16_t*)(a.ws + WS_CK); const bf16_t* CVT = (const bf16_t*)(a.ws + WS_CVT);
    for (int it = gw; it < 6144; it += ngw) {
        AttState st; st.m = -1e30f; st.l = 0.f;
#pragma unroll
        for (int j = 0; j < 4; ++j) st.o[j] = (f32x4){0.f, 0.f, 0.f, 0.f};
        int qrow, hh; AttFrags fa, fb;
        if (it < 4096) {
            const int jq = it & 3, r = (it >> 2) & 31; hh = (it >> 7) & 7; const int b = it >> 10;
            const int seq0 = MP + b * 2048; qrow = seq0 + r * 64 + 16 * jq + fr;
            bf16x8 qf[2];
#pragma unroll
            for (int ks = 0; ks < 2; ++ks) qf[ks] = *(const bf16x8*)(PROJ + (size_t)qrow * PJ + P_Q + hh * 64 + 32 * ks + 8 * fq);
            const int rs = min(max(r - 4, 0), 24), cq = 16 * jq + fr, cs = min(max(cq - 8, 0), 48);
            const int kc0 = jq == 0 ? 0 : (jq == 1 ? 8 : (jq == 2 ? 24 : 32));
            const float* rpb = a.in[19] + ((size_t)layer * 8 + hh) * 15 * 31;
            const bf16_t* kw = PROJ + (size_t)(seq0 + rs * 64 + kc0) * PJ + P_K + hh * 64; const bf16_t* vw = TR + (size_t)(T_V + hh * 64) * M + seq0 + rs * 64 + kc0;
            const size_t cb = ((size_t)b * DEPTH + layer) * 512; const bf16_t* kc = CK + cb * 512 + hh * 64; const bf16_t* vc = CVT + (cb + hh * 64) * 512;
            attn_load(fa, kw, PJ, vw, M, fr, fq);
#pragma unroll 1
            for (int j = 0; j < 8; j += 2) {
                attn_load(fb, kw + (size_t)(j + 1) * 64 * PJ, PJ, vw + (j + 1) * 64, M, fr, fq);
                attn_compute<true>(st, qf, fa, fq, rpb + (rs + j - r + 7) * 31, kc0, cq, cs);
                if (j + 2 < 8) attn_load(fa, kw + (size_t)(j + 2) * 64 * PJ, PJ, vw + (j + 2) * 64, M, fr, fq); else attn_load(fa, kc, 512, vc, 512, fr, fq);
                attn_compute<true>(st, qf, fb, fq, rpb + (rs + j + 1 - r + 7) * 31, kc0, cq, cs);
            }
#pragma unroll 1
            for (int g = 0; g < 16; g += 2) {
                attn_load(fb, kc + (size_t)(32 * (g + 1)) * 512, 512, vc + 32 * (g + 1), 512, fr, fq);
                attn_compute<false>(st, qf, fa, fq, nullptr, 0, 0, 0);
                if (g + 2 < 16) attn_load(fa, kc + (size_t)(32 * (g + 2)) * 512, 512, vc + 32 * (g + 2), 512, fr, fq);
                attn_compute<false>(st, qf, fb, fq, nullptr, 0, 0, 0);
            }
        } else {
            const int i2 = it - 4096, qt = i2 & 15; hh = (i2 >> 4) & 7; const int b = i2 >> 7, seq0 = b * 256; qrow = seq0 + 16 * qt + fr;
            bf16x8 qf[2];
#pragma unroll
            for (int ks = 0; ks < 2; ++ks) qf[ks] = *(const bf16x8*)(PROJ + (size_t)qrow * PJ + P_Q + hh * 64 + 32 * ks + 8 * fq);
            const bf16_t* kp = PROJ + (size_t)seq0 * PJ + P_K + hh * 64; const bf16_t* vp = TR + (size_t)(T_V + hh * 64) * M + seq0;
            attn_load(fa, kp, PJ, vp, M, fr, fq);
#pragma unroll 1
            for (int g = 0; g < 8; g += 2) {
                attn_load(fb, kp + (size_t)(32 * (g + 1)) * PJ, PJ, vp + 32 * (g + 1), M, fr, fq);
                attn_compute<false>(st, qf, fa, fq, nullptr, 0, 0, 0);
                if (g + 2 < 8) attn_load(fa, kp + (size_t)(32 * (g + 2)) * PJ, PJ, vp + 32 * (g + 2), M, fr, fq);
                attn_compute<false>(st, qf, fb, fq, nullptr, 0, 0, 0);
            }
        }
        float l = st.l; l += __shfl_xor(l, 16); l += __shfl_xor(l, 32);
        const float rl = 1.f / l;
#pragma unroll
        for (int j = 0; j < 4; ++j) { u32x2 w; w.x = pk2(st.o[j][0] * rl, st.o[j][1] * rl); w.y = pk2(st.o[j][2] * rl, st.o[j][3] * rl);
            *(u32x2*)(BR + (size_t)qrow * D + hh * 64 + 16 * j + 4 * fq) = w; }
    }
}
}
namespace mk {
constexpr int S5K = 768;
constexpr size_t WS_S5W = WS_ATT_END;
constexpr size_t WS_S5WS = AL(WS_S5W + (size_t)DEPTH * 32 * 512 * S5K * 2);
constexpr size_t WS_S5AP = AL(WS_S5WS + (size_t)DEPTH * 32 * 256 * 512 * 2);
constexpr size_t WS_S5UP = AL(WS_S5AP + (size_t)DEPTH * 32 * 2 * 64 * 2 * 4);
constexpr size_t WS_S5SS = AL(WS_S5UP + (size_t)32 * 384 * 512 * 2);
constexpr size_t WS_S5HS = AL(WS_S5SS + (size_t)32 * 384 * 256 * 4);
constexpr size_t WS_S5_END = AL(WS_S5HS + (size_t)32 * 384 * 256 * 2);

__device__ __forceinline__ void s5_param_phase(const Args& a, LAS unsigned char* lds, int tid_, int G) {
    int tid = tid_; asm volatile("" : "+v"(tid));
    LAS float* PW = (LAS float*)lds; LAS float* BB = PW + 2 * 33 * 64 * 2; LAS float* CC = BB + 2 * 64 * 16 * 2; LAS float* KT = CC + 2 * 16 * 64 * 2;
    for (int task = blockIdx.x; task < DEPTH * 32; task += G) {
        const int layer = task >> 5, g = task & 31;
        const float* a_re = a.in[20] + layer * 4096; const float* a_im = a.in[21] + layer * 4096; const float* log_dt = a.in[22] + layer * 64;
        const float* b_re = a.in[23] + (size_t)layer * 65536; const float* b_im = a.in[24] + (size_t)layer * 65536; const float* c_re = a.in[25] + (size_t)layer * 65536; const float* c_im = a.in[26] + (size_t)layer * 65536;
        const float* s5d = a.in[27] + layer * 512;
        bf16_t* S5W = (bf16_t*)(a.ws + WS_S5W) + (size_t)layer * 32 * 512 * S5K; bf16_t* S5WS = (bf16_t*)(a.ws + WS_S5WS) + (size_t)layer * 32 * 256 * 512; float* S5AP = (float*)(a.ws + WS_S5AP) + (size_t)layer * 32 * 2 * 64 * 2;
        __syncthreads();
        if (tid < 128) { const int dir = tid >> 6, n = tid & 63, pi = (dir * 32 + g) * 64 + n;
            const float are = fminf(a_re[pi], -1e-4f), aim = a_im[pi], dt = expf(log_dt[dir * 32 + g]);
            const float mag = expf(dt * are), abr = mag * cosf(dt * aim), abi = mag * sinf(dt * aim);
            const float den = are * are + aim * aim, nr = abr - 1.f, cfr = (nr * are + abi * aim) / den, cfi = (abi * are - nr * aim) / den;
            float pr = 1.f, pim = 0.f;
            for (int p = 0; p <= 32; ++p) { PW[((dir * 33 + p) * 64 + n) * 2] = pr; PW[((dir * 33 + p) * 64 + n) * 2 + 1] = pim; const float t = pr * abr - pim * abi; pim = pr * abi + pim * abr; pr = t; }
            S5AP[((g * 2 + dir) * 64 + n) * 2] = PW[((dir * 33 + 32) * 64 + n) * 2]; S5AP[((g * 2 + dir) * 64 + n) * 2 + 1] = PW[((dir * 33 + 32) * 64 + n) * 2 + 1];
            for (int k = 0; k < 16; ++k) { const float br_ = b_re[(size_t)pi * 16 + k], bi_ = b_im[(size_t)pi * 16 + k];
                BB[((dir * 64 + n) * 16 + k) * 2] = cfr * br_ - cfi * bi_; BB[((dir * 64 + n) * 16 + k) * 2 + 1] = cfr * bi_ + cfi * br_; }
            for (int j = 0; j < 16; ++j) { CC[((dir * 64 + n) * 16 + j) * 2] = c_re[((size_t)(dir * 32 + g) * 16 + j) * 64 + n]; CC[((dir * 64 + n) * 16 + j) * 2 + 1] = c_im[((size_t)(dir * 32 + g) * 16 + j) * 64 + n]; }
        }
        __syncthreads();
        for (int e = tid; e < 2 * 32 * 256; e += NT) { const int j = e & 15, k = (e >> 4) & 15, tau = (e >> 8) & 31, dir = e >> 13; float s = 0.f;
            for (int n = 0; n < 64; ++n) { const float cr = CC[((dir * 64 + n) * 16 + j) * 2], ci = CC[((dir * 64 + n) * 16 + j) * 2 + 1], pr = PW[((dir * 33 + tau) * 64 + n) * 2], pim = PW[((dir * 33 + tau) * 64 + n) * 2 + 1];
                const float xr = cr * pr - ci * pim, xi = cr * pim + ci * pr, br_ = BB[((dir * 64 + n) * 16 + k) * 2], bi_ = BB[((dir * 64 + n) * 16 + k) * 2 + 1];
                s += xr * br_ - xi * bi_; }
            KT[e] = s; }
        __syncthreads();
        { const int t = tid >> 4, j = tid & 15; bf16_t* dst = S5W + ((size_t)g * 512 + tid) * S5K;
            for (int s = 0; s < 32; ++s) { float v[16];
#pragma unroll
                for (int k = 0; k < 16; ++k) { float x;
                    if (s < t) x = KT[((0 * 32 + (t - s)) * 16 + k) * 16 + j]; else if (s > t) x = KT[((1 * 32 + (s - t)) * 16 + k) * 16 + j];
                    else x = KT[((0 * 32 + 0) * 16 + k) * 16 + j] + KT[((1 * 32 + 0) * 16 + k) * 16 + j] + (k == j ? s5d[g * 16 + k] : 0.f);
                    v[k] = x; }
                u32x4 o0, o1; o0.x = pk2(v[0], v[1]); o0.y = pk2(v[2], v[3]); o0.z = pk2(v[4], v[5]); o0.w = pk2(v[6], v[7]); o1.x = pk2(v[8], v[9]); o1.y = pk2(v[10], v[11]); o1.z = pk2(v[12], v[13]); o1.w = pk2(v[14], v[15]);
                *(u32x4*)(dst + s * 16) = o0; *(u32x4*)(dst + s * 16 + 8) = o1; }
            for (int dir = 0; dir < 2; ++dir) { const int p = dir == 0 ? t + 1 : 32 - t;
                for (int n8 = 0; n8 < 8; ++n8) { float gr[8], gi[8];
#pragma unroll
                    for (int q = 0; q < 8; ++q) { const int n = n8 * 8 + q; const float cr = CC[((dir * 64 + n) * 16 + j) * 2], ci = CC[((dir * 64 + n) * 16 + j) * 2 + 1], pr = PW[((dir * 33 + p) * 64 + n) * 2], pim = PW[((dir * 33 + p) * 64 + n) * 2 + 1];
                        gr[q] = cr * pr - ci * pim; gi[q] = -(cr * pim + ci * pr); }
                    u32x4 o; o.x = pk2(gr[0], gr[1]); o.y = pk2(gr[2], gr[3]); o.z = pk2(gr[4], gr[5]); o.w = pk2(gr[6], gr[7]); *(u32x4*)(dst + 512 + dir * 128 + n8 * 8) = o;
                    o.x = pk2(gi[0], gi[1]); o.y = pk2(gi[2], gi[3]); o.z = pk2(gi[4], gi[5]); o.w = pk2(gi[6], gi[7]); *(u32x4*)(dst + 512 + dir * 128 + 64 + n8 * 8) = o; } }
        }
        if (tid < 256) { const int dir = tid >> 7, reim = (tid >> 6) & 1, n = tid & 63; bf16_t* dst = S5WS + ((size_t)g * 256 + tid) * 512;
            for (int s = 0; s < 32; ++s) { const int p = dir == 0 ? 31 - s : s; const float pr = PW[((dir * 33 + p) * 64 + n) * 2], pim = PW[((dir * 33 + p) * 64 + n) * 2 + 1]; float v[16];
#pragma unroll
                for (int k = 0; k < 16; ++k) { const float br_ = BB[((dir * 64 + n) * 16 + k) * 2], bi_ = BB[((dir * 64 + n) * 16 + k) * 2 + 1]; v[k] = reim == 0 ? pr * br_ - pim * bi_ : pr * bi_ + pim * br_; }
                u32x4 o0, o1; o0.x = pk2(v[0], v[1]); o0.y = pk2(v[2], v[3]); o0.z = pk2(v[4], v[5]); o0.w = pk2(v[6], v[7]); o1.x = pk2(v[8], v[9]); o1.y = pk2(v[10], v[11]); o1.z = pk2(v[12], v[13]); o1.w = pk2(v[14], v[15]);
                *(u32x4*)(dst + s * 16) = o0; *(u32x4*)(dst + s * 16 + 8) = o1; } }
    }
    __syncthreads();
}
__device__ __forceinline__ void s5_statein_phase(const Args& a, int layer, int gw, int ngw, int lane_) {
    int lane = lane_; asm volatile("" : "+v"(lane));
    const int fr = lane & 15, fq = lane >> 4;
    const bf16_t* UP = (const bf16_t*)(a.ws + WS_S5UP); const bf16_t* S5WS = (const bf16_t*)(a.ws + WS_S5WS) + (size_t)layer * 32 * 256 * 512; float* SS = (float*)(a.ws + WS_S5SS);
    for (int it = ngw - 1 - gw; it < 32 * 24; it += ngw) { const int g = it / 24, r = it % 24, og = r / 6, cq = r % 6;
        f32x4 acc[4][4];
#pragma unroll
        for (int i = 0; i < 4; ++i)
#pragma unroll
            for (int j = 0; j < 4; ++j) acc[i][j] = (f32x4){0.f, 0.f, 0.f, 0.f};
        const bf16_t* ap = S5WS + ((size_t)g * 256 + 64 * og + fr) * 512 + 8 * fq; const bf16_t* bp = UP + ((size_t)g * 384 + 64 * cq + fr) * 512 + 8 * fq;
#pragma unroll 2
        for (int ks = 0; ks < 16; ++ks) { bf16x8 af[4], bf[4];
#pragma unroll
            for (int i = 0; i < 4; ++i) { af[i] = *(const bf16x8*)(ap + (size_t)16 * i * 512 + 32 * ks); bf[i] = *(const bf16x8*)(bp + (size_t)16 * i * 512 + 32 * ks); }
#pragma unroll
            for (int i = 0; i < 4; ++i)
#pragma unroll
                for (int j = 0; j < 4; ++j) acc[i][j] = mfma16(af[i], bf[j], acc[i][j]); }
#pragma unroll
        for (int i = 0; i < 4; ++i)
#pragma unroll
            for (int j = 0; j < 4; ++j) *(f32x4*)(SS + ((size_t)g * 384 + 64 * cq + 16 * j + fr) * 256 + 64 * og + 16 * i + 4 * fq) = acc[i][j];
    }
}
__device__ __forceinline__ void s5_scan_phase(const Args& a, int layer, int gw, int ngw, int lane_) {
    int lane = lane_; asm volatile("" : "+v"(lane));
    const float* SS = (const float*)(a.ws + WS_S5SS); bf16_t* HS = (bf16_t*)(a.ws + WS_S5HS); const float* S5AP = (const float*)(a.ws + WS_S5AP) + (size_t)layer * 32 * 2 * 64 * 2;
    for (int task = gw; task < 1280; task += ngw) {
        int sq, g, dir; if (task < 256) { sq = 16 + (task >> 6); g = (task >> 1) & 31; dir = task & 1; } else { const int t2 = task - 256; sq = t2 >> 6; g = (t2 >> 1) & 31; dir = t2 & 1; }
        const int lat = sq >= 16, b = lat ? sq - 16 : sq, nc = lat ? 64 : 8, cg0 = lat ? 128 + b * 64 : b * 8;
        const float apr = S5AP[((g * 2 + dir) * 64 + lane) * 2], api = S5AP[((g * 2 + dir) * 64 + lane) * 2 + 1];
        float hr = 0.f, hi = 0.f;
        if (lat) { const size_t so = ((((size_t)b * DEPTH + layer) * 2 + dir) * 32 + g) * 64 + lane; hr = a.in[4][so]; hi = a.in[5][so]; }
        for (int s0 = 0; s0 < nc; s0 += 8) {
            float sr[8], si[8];
#pragma unroll
            for (int q = 0; q < 8; ++q) { const int cg = cg0 + (dir ? nc - 1 - (s0 + q) : s0 + q); const size_t base = ((size_t)g * 384 + cg) * 256 + dir * 128; sr[q] = SS[base + lane]; si[q] = SS[base + 64 + lane]; }
#pragma unroll
            for (int q = 0; q < 8; ++q) { const int cg = cg0 + (dir ? nc - 1 - (s0 + q) : s0 + q); const size_t base = ((size_t)g * 384 + cg) * 256 + dir * 128;
                HS[base + lane] = f2bf(hr); HS[base + 64 + lane] = f2bf(hi);
                const float t = apr * hr - api * hi + sr[q]; hi = apr * hi + api * hr + si[q]; hr = t; }
        }
        if (!lat) { const size_t oo = ((((size_t)b * DEPTH + layer) * 2 + dir) * 32 + g) * 64 + lane; a.out[O_S5R + oo] = hr; a.out[O_S5I + oo] = hi; }
    }
}
__device__ __forceinline__ void s5_out_phase(const Args& a, int layer, int gw, int ngw, int lane_) {
    int lane = lane_; asm volatile("" : "+v"(lane));
    const int fr = lane & 15, fq = lane >> 4;
    const bf16_t* UP = (const bf16_t*)(a.ws + WS_S5UP); const bf16_t* S5W = (const bf16_t*)(a.ws + WS_S5W) + (size_t)layer * 32 * 512 * S5K; const bf16_t* HS = (const bf16_t*)(a.ws + WS_S5HS); bf16_t* ZB = (bf16_t*)(a.ws + WS_ZB);
    for (int it = ngw - 1 - gw; it < 32 * 48; it += ngw) { const int g = it / 48, r = it % 48, og = r / 6, cq = r % 6;
        f32x4 acc[4][4];
#pragma unroll
        for (int i = 0; i < 4; ++i)
#pragma unroll
            for (int j = 0; j < 4; ++j) acc[i][j] = (f32x4){0.f, 0.f, 0.f, 0.f};
        const bf16_t* ap = S5W + ((size_t)g * 512 + 64 * og + fr) * S5K + 8 * fq;
        const bf16_t* bp = UP + ((size_t)g * 384 + 64 * cq + fr) * 512 + 8 * fq; const bf16_t* hp = HS + ((size_t)g * 384 + 64 * cq + fr) * 256 + 8 * fq;
#pragma unroll 2
        for (int ks = 0; ks < 16; ++ks) { bf16x8 af[4], bf[4];
#pragma unroll
            for (int i = 0; i < 4; ++i) { af[i] = *(const bf16x8*)(ap + (size_t)16 * i * S5K + 32 * ks); bf[i] = *(const bf16x8*)(bp + (size_t)16 * i * 512 + 32 * ks); }
#pragma unroll
            for (int i = 0; i < 4; ++i)
#pragma unroll
                for (int j = 0; j < 4; ++j) acc[i][j] = mfma16(af[i], bf[j], acc[i][j]); }
#pragma unroll 2
        for (int ks = 0; ks < 8; ++ks) { bf16x8 af[4], bf[4];
#pragma unroll
            for (int i = 0; i < 4; ++i) { af[i] = *(const bf16x8*)(ap + (size_t)16 * i * S5K + 512 + 32 * ks); bf[i] = *(const bf16x8*)(hp + (size_t)16 * i * 256 + 32 * ks); }
#pragma unroll
            for (int i = 0; i < 4; ++i)
#pragma unroll
                for (int j = 0; j < 4; ++j) acc[i][j] = mfma16(af[i], bf[j], acc[i][j]); }
#pragma unroll
        for (int i = 0; i < 4; ++i)
#pragma unroll
            for (int j = 0; j < 4; ++j) { float z[4];
#pragma unroll
                for (int e = 0; e < 4; ++e) { const float x = acc[i][j][e]; const float th = 0.7978845608028654f * (x + 0.044715f * x * x * x); const float e2 = __expf(2.f * th); const float tnh = 1.f - 2.f * __builtin_amdgcn_rcpf(e2 + 1.f); z[e] = 0.5f * x * (1.f + tnh); }
                u32x2 w; w.x = pk2(z[0], z[1]); w.y = pk2(z[2], z[3]);
                *(u32x2*)(ZB + (size_t)(32 * (64 * cq + 16 * j + fr) + 4 * og + i) * 512 + g * 16 + 4 * fq) = w; }
    }
}
}
namespace mk { static_assert(WS_S5_END < (size_t)1780 * 1024 * 1024, "workspace map exceeds the guaranteed size"); }
namespace mk {
#ifndef PHMASK
#define PHMASK 0xfffff
#endif
#define PHM(k) ((PHMASK >> (k)) & 1)
#ifndef DUPMASK
#define DUPMASK 0
#endif
#define DUP(k) ((DUPMASK >> (k)) & 1)
constexpr int NPH = 12;
constexpr int PH_TOTAL = 2 + DEPTH * NPH;
__global__ void __launch_bounds__(NT, 2) mk_fwd(Args a) {
    extern __shared__ __attribute__((aligned(16))) unsigned char lds_raw[];
    LAS unsigned char* lds = (LAS unsigned char*)lds_raw;
#define TID ((int)threadIdx.x)
#define LANE ((int)(threadIdx.x & 63))
#define WAVE (__builtin_amdgcn_readfirstlane((int)(threadIdx.x >> 6)))
#define GW ((int)blockIdx.x * NWV + WAVE)
    const int G = gridDim.x, ngw = G * NWV;
    volatile LAS unsigned* ctlw = (volatile LAS unsigned*)(lds + LDS_CTL);
    if (TID < 4) ctlw[TID] = 0u;
    __syncthreads();
    XcdBarrier bar = xcd_barrier_post((unsigned*)(a.ws + WS_CTL), ctlw);
    const int lo = a.ph_lo, hi = a.ph_hi;
#define IN(k) (lo <= (k) && (k) < hi)
#define SEAM(k) do { if (IN(k) && IN((k) + 1)) xcd_barrier(bar); } while (0)
    unsigned char* ws = a.ws;
    bf16_t* H = (bf16_t*)(ws + WS_H); bf16_t* PROJ = (bf16_t*)(ws + WS_PROJ); float* SMALL = (float*)(ws + WS_SMALL); bf16_t* BR = (bf16_t*)(ws + WS_BR);
    bf16_t* MERGED = (bf16_t*)(ws + WS_MERGED); float* MACC = (float*)(ws + WS_MACC); bf16_t* ZB = (bf16_t*)(ws + WS_ZB); bf16_t* HID = PROJ;
    const float* MOD = (const float*)(ws + WS_MOD); float* X = a.out;
    if (PHM(0) && IN(0)) { for (int r_ = 0; r_ < 1 + DUP(8); ++r_) prologue_convert(a, lds, GW, ngw, WAVE, LANE); prologue_cache(a, GW, ngw, LANE); __syncthreads(); prologue_ada(a, lds, TID); for (int r_ = 0; r_ < 1 + DUP(1); ++r_) s5_param_phase(a, lds, TID, G); }
    SEAM(0);
    for (int l = 0; l < DEPTH; ++l) {
        const int pb = 1 + l * NPH;
        const float* xp = l == 0 ? a.in[0] : X; const float* xs = l == 0 ? a.in[1] : X + (size_t)MP * D;
        const float* modl = MOD + (size_t)l * 5 * 6 * D;
        const bf16_t* wl = (const bf16_t*)(ws + WS_W) + (size_t)l * W_LAYER;
        if (PHM(1) && IN(pb + 0)) norm_phase(xp, xs, a.in[14] + l * D, modl, 0, D, H, GW, ngw, LANE, l > 0 ? MACC : nullptr, modl - (size_t)5 * 6 * D, 5 * D, X, xs);
        SEAM(pb + 0);
        if (PHM(2) && IN(pb + 1)) { Gemm g{H, wl + W_IN, M, NIN, D, D, 1, 0, 0}; StaticOrder S; S.init(M, NIN, G, blockIdx.x, 1, D);
            EpiIn E{PROJ, SMALL, a.out, a.in[17] + l * 64, a.in[18] + l * 64, l}; for (int r_ = 0; r_ < 1 + DUP(9); ++r_) gemm_phase(lds, g, S, E); }
        SEAM(pb + 1);
        if (PHM(3) && IN(pb + 2)) { for (int r_ = 0; r_ < 1 + DUP(0); ++r_) { prep_phase(a, l, lds, GW, ngw, WAVE, LANE, (bf16_t*)(a.ws + WS_S5UP)); __syncthreads(); } }
        SEAM(pb + 2);
        if (PHM(4) && IN(pb + 3)) { for (int r_ = 0; r_ < 1 + DUP(2); ++r_) attn_phase(a, l, GW, ngw, LANE); for (int r_ = 0; r_ < 1 + DUP(3); ++r_) { ml_states_phase(a, l, TID, G); ssd_states_phase(a, l, TID, G); s5_statein_phase(a, l, GW, ngw, LANE); } }
        SEAM(pb + 3);
        if (PHM(5) && IN(pb + 4)) { for (int r_ = 0; r_ < 1 + DUP(4); ++r_) { ml_scan_phase(a, l, TID, G); ssd_scan_phase(a, l, TID, G); s5_scan_phase(a, l, GW, ngw, LANE); } }
        SEAM(pb + 4);
        if (PHM(12) && IN(pb + 5)) { for (int r_ = 0; r_ < 1 + DUP(5); ++r_) ml_out_phase(a, l, lds, TID, G); for (int r_ = 0; r_ < 1 + DUP(6); ++r_) ssd_out_phase(a, l, lds, TID, G); for (int r_ = 0; r_ < 1 + DUP(7); ++r_) s5_out_phase(a, l, GW, ngw, LANE); }
        SEAM(pb + 5);
        if (PHM(6) && IN(pb + 6)) { Gemm g{ZB, wl + W_GLU, M, 512, 512, 512, 1, 0, 0}; StaticOrder S; S.init(M, 512, G, blockIdx.x, 1, 512);
            EpiGlu E{ZB, a.in[29] + l * 512, BR}; gemm_phase(lds, g, S, E); ssd_fin_phase(a, l, GW, ngw, LANE); }
        SEAM(pb + 6);
        if (PHM(7) && IN(pb + 7)) { Gemm g{BR, wl + W_BR, M, D, 512, D, 4, 512, (size_t)D * 512}; StaticOrder S; S.init(M, D, G, blockIdx.x, 4, 512);
            EpiBranch E{PROJ, MERGED}; for (int r_ = 0; r_ < 1 + DUP(12); ++r_) gemm_phase(lds, g, S, E); }
        SEAM(pb + 7);
        if (PHM(8) && IN(pb + 8)) { Gemm g{MERGED, wl + W_OUT, M, D, D, D, 1, 0, 0}; SplitOrder S; S.init(blockIdx.x, D);
            EpiResid E{xp, xs, modl, 2 * D, X, MACC}; gemm_phase(lds, g, S, E); }
        SEAM(pb + 8);
        if (PHM(9) && IN(pb + 9)) norm_phase(X, X + (size_t)MP * D, a.in[15] + l * D, modl, 3 * D, 4 * D, H, GW, ngw, LANE, MACC, modl, 2 * D, X, xs);
        SEAM(pb + 9);
        if (PHM(10) && IN(pb + 10)) { Gemm g{H, wl + W_1, M, DFF, D, D, 1, 0, 0}; StaticOrder S; S.init(M, DFF, G, blockIdx.x, 1, D);
            EpiRelu2 E{HID, DFF}; for (int r_ = 0; r_ < 1 + DUP(10); ++r_) gemm_phase(lds, g, S, E); }
        SEAM(pb + 10);
        if (PHM(11) && IN(pb + 11)) { Gemm g{HID, wl + W_2, M, D, DFF, DFF, 1, 0, 0}; SplitOrder S; S.init(blockIdx.x, DFF);
            EpiResid E{X, X + (size_t)MP * D, modl, 5 * D, X, MACC}; gemm_phase(lds, g, S, E); }
        SEAM(pb + 11);
    }
    if (IN(1 + DEPTH * NPH)) final_fix_phase(MACC, MOD + (size_t)(DEPTH - 1) * 5 * 6 * D, 5 * D, X, GW, ngw, LANE);
#undef IN
#undef SEAM
}
}
extern "C" void kernel_launch(void* const* d_in, const int* in_sizes, int n_in, void* d_out, int out_size, void* d_ws, size_t ws_size, hipStream_t stream) {
    static int grid = 0;
    if (grid == 0) {
        int dev = 0, cus = 0; (void)hipGetDevice(&dev); (void)hipDeviceGetAttribute(&cus, hipDeviceAttributeMultiprocessorCount, dev);
        (void)hipFuncSetAttribute((const void*)mk::mk_fwd, hipFuncAttributeMaxDynamicSharedMemorySize, mk::LDS_BYTES);
        int per_cu = 0; (void)hipOccupancyMaxActiveBlocksPerMultiprocessor(&per_cu, (const void*)mk::mk_fwd, mk::NT, mk::LDS_BYTES); (void)hipGetLastError();
        grid = cus > 0 ? cus : 256;
    }
    mk::Args a{}; for (int i = 0; i < 43; ++i) a.in[i] = (const float*)d_in[i];
    a.out = (float*)d_out; a.ws = (unsigned char*)d_ws; a.ph_lo = 0; a.ph_hi = mk::PH_TOTAL;
    (void)hipMemsetAsync(a.ws + mk::WS_CTL, 0, mk::CTL_BYTES, stream);
    hipLaunchKernelGGL(mk::mk_fwd, dim3(grid), dim3(mk::NT), mk::LDS_BYTES, stream, a);
}
```

```cpp
#define SAFE_GEMM 0
#define DUPMASK 0
#include <hip/hip_runtime.h>
#include <math.h>
namespace mk {
#define LAS __attribute__((address_space(3)))
typedef unsigned short bf16_t;
typedef short bf16x8 __attribute__((ext_vector_type(8)));
typedef float f32x4 __attribute__((ext_vector_type(4)));
typedef float f32x2 __attribute__((ext_vector_type(2)));
typedef unsigned u32x4 __attribute__((ext_vector_type(4)));
typedef unsigned u32x2 __attribute__((ext_vector_type(2)));
constexpr int NT = 512, NWV = 8;
constexpr int D = 2048, MP = 4096, MLAT = 8192, M = MP + MLAT, DEPTH = 4, DFF = 8192;
constexpr int PJ = 13824;
constexpr int NIN = 14080;
constexpr int P_Q = 0, P_K = 512, P_V = 1024, P_S5U = 1536, P_Z = 2048, P_XBC = 2560, P_MQ = 3584, P_MK = 4096, P_MV = 4608, P_MO = 5120, P_GATE = 5632;
constexpr int S_DT = 0, S_MI = 16, S_MF = 24;

typedef __bf16 bf16x2_t __attribute__((ext_vector_type(2)));
__device__ __forceinline__ unsigned pk2(float lo, float hi) { f32x2 v = {lo, hi}; bf16x2_t b = __builtin_convertvector(v, bf16x2_t); return __builtin_bit_cast(unsigned, b); }
__device__ __forceinline__ float bf2f(bf16_t v) { return __uint_as_float(((unsigned)v) << 16); }
__device__ __forceinline__ float bflo(unsigned w) { return __uint_as_float(w << 16); }
__device__ __forceinline__ float bfhi(unsigned w) { return __uint_as_float(w & 0xffff0000u); }
__device__ __forceinline__ bf16_t f2bf(float f) { return (bf16_t)(pk2(f, 0.f) & 0xffffu); }
__device__ __forceinline__ float fsigm(float x) { return __builtin_amdgcn_rcpf(1.f + __expf(-x)); }
__device__ __forceinline__ float fsilu(float x) { return x * fsigm(x); }
__device__ __forceinline__ int row_cvec(int row) { return row < MP ? 0 : 1 + (row - MP) / 2048; }

#define XB_TMO      128
#define XB_XCNT(j)  (256  + 64 * (j))
#define XB_XSUB(j)  (1280 + 64 * (j))
#define XB_XGEN(j)  (2304 + 64 * (j))
#define XB_TOP      3328
#define XB_TOPGEN   3392
#define XCD_BAR_WORDS 3456
#define XB_SPIN_CAP (1u << 18)
__device__ __forceinline__ unsigned xb_ld(unsigned* p)              { return __hip_atomic_load(p, __ATOMIC_RELAXED, __HIP_MEMORY_SCOPE_AGENT); }
__device__ __forceinline__ unsigned xb_add(unsigned* p, unsigned v) { return __hip_atomic_fetch_add(p, v, __ATOMIC_RELAXED, __HIP_MEMORY_SCOPE_AGENT); }
__device__ __forceinline__ unsigned xb_xcc_id() { return (unsigned)__builtin_amdgcn_s_getreg((3 << 11) | 20) & 0xFu; }
#define XB_SPIN(cond, bar) do { unsigned _sp = 0; while (cond) { __builtin_amdgcn_s_sleep(1); \
    if ((++_sp & 255u) == 0u) { if (xb_ld(&(bar)[XB_TMO])) break; if (_sp > XB_SPIN_CAP) { atomicAdd(&(bar)[XB_TMO], 1u); break; } } } } while (0)
struct XcdBarrier { unsigned* bar; unsigned x; volatile LAS unsigned* st; };
__device__ __forceinline__ XcdBarrier xcd_barrier_post(unsigned* bar, volatile LAS unsigned* st) {
    XcdBarrier b; b.bar = bar; b.x = xb_xcc_id(); b.st = st;
    if (threadIdx.x == 0) (void)xb_add(&bar[XB_XCNT(b.x)], 1u);
    return b;
}
__device__ __forceinline__ void xcd_barrier_complete(unsigned* bar, unsigned x, unsigned& nloc, unsigned& nx) {
    const unsigned G = gridDim.x * gridDim.y * gridDim.z;
    unsigned sum, cnt, mine, sp = 0u;
    for (;;) {
        sum = 0u; cnt = 0u; mine = 0u;
#pragma unroll
        for (unsigned j = 0; j < 16; ++j) { const unsigned c = xb_ld(&bar[XB_XCNT(j)]); sum += c; cnt += (c > 0u) ? 1u : 0u; mine = (j == x) ? c : mine; }
        if (sum == G) break;
        __builtin_amdgcn_s_sleep(1);
        if ((++sp & 255u) == 0u) { if (xb_ld(&bar[XB_TMO])) break; if (sp > XB_SPIN_CAP) { atomicAdd(&bar[XB_TMO], 1u); break; } }
    }
    nloc = mine > 0u ? mine : 1u; nx = cnt > 0u ? cnt : 1u;
}
__device__ __forceinline__ void xcd_barrier(const XcdBarrier& b) {
    asm volatile("s_waitcnt vmcnt(0)" ::: "memory");
    __syncthreads();
    if (threadIdx.x == 0) {
        unsigned* bar = b.bar;
        __builtin_amdgcn_s_waitcnt(0);
        unsigned nloc = b.st[0], nx = b.st[1];
        if (nloc == 0u) { xcd_barrier_complete(bar, b.x, nloc, nx); b.st[0] = nloc; b.st[1] = nx; }
        const unsigned old = xb_add(&bar[XB_XSUB(b.x)], 1u);
        const unsigned gen = old / nloc;
        if (old + 1u == (gen + 1u) * nloc) {
            __builtin_amdgcn_fence(__ATOMIC_RELEASE, "agent");
            asm volatile("s_waitcnt vmcnt(0)" ::: "memory");
            const unsigned og = xb_add(&bar[XB_TOP], 1u);
            const unsigned tg = og / nx;
            if (og + 1u == (tg + 1u) * nx) xb_add(&bar[XB_TOPGEN], 1u);
            else XB_SPIN(xb_ld(&bar[XB_TOPGEN]) == tg, bar);
            __builtin_amdgcn_fence(__ATOMIC_ACQUIRE, "agent");
            xb_add(&bar[XB_XGEN(b.x)], 1u);
            asm volatile("s_waitcnt vmcnt(0)" ::: "memory");
        } else {
            XB_SPIN(xb_ld(&bar[XB_XGEN(b.x)]) == gen, bar);
            __builtin_amdgcn_fence(__ATOMIC_ACQUIRE, "agent");
            asm volatile("s_waitcnt vmcnt(0)" ::: "memory");
        }
    }
    __syncthreads();
}

#ifndef GEMM_SP2
#define GEMM_SP2 1
#endif
#ifndef GEMM_ALIGN
#define GEMM_ALIGN 1
#endif
constexpr int BM = 256, BK = 64, HALF = 128, HTB = HALF * BK * 2, STAGE_BYTES = 8 * HTB, NXCD = 8, WGM = 8;
__host__ __device__ __forceinline__ int lds_byte(int r, int c) { const int st = (r >> 4) * 2 + (c >> 5), rr = r & 15, cc = c & 31, ob = rr * 64 + cc * 2; return st * 1024 + (ob ^ (((ob >> 9) & 1) << 5)); }
__host__ __device__ __forceinline__ void stage_rc(int b, int& R, int& C) { const int st = b / 1024, sb = b % 1024, swz = sb ^ (((sb >> 9) & 1) << 5); R = (st >> 1) * 16 + swz / 64; C = (st & 1) * 32 + (swz % 64) / 2; }
__host__ __device__ __forceinline__ int perm32(int rho) { const int n = rho >> 4, i = rho & 15; return 8 * (i >> 2) + 4 * n + (i & 3); }

struct Unit { int pm, pn, kz, koff, nt; };
struct Gemm { const bf16_t* A; const bf16_t* Bt; int M, N, K, lda, nkz; size_t a_kz, b_kz; };

struct StaticOrder {
    int nM, nN, nwg, G, c, nkz;
    int ntk;
    __device__ void init(int M_, int N_, int G_, int c_, int nkz_ = 1, int K_ = 0) { nM = M_ / BM; nN = N_ / BM; nwg = nM * nN; G = G_; c = c_; nkz = nkz_; ntk = K_ / BK; }
    __device__ bool next(int i, Unit& u) const {
        const int it = i / nkz; u.kz = i - it * nkz; u.koff = 0; u.nt = ntk;
        const long L = (long)it * G + c; if (L >= nwg) return false;
        int wgid = (int)L; { const int q = nwg / NXCD, r = nwg % NXCD, xcd = wgid % NXCD, off = wgid / NXCD; wgid = (xcd < r ? xcd * (q + 1) : r * (q + 1) + (xcd - r) * q) + off; }
        const int nig = WGM * nN, gid = wgid / nig, fm = gid * WGM, gsz = (nM - fm) < WGM ? (nM - fm) : WGM;
        u.pm = fm + ((wgid % nig) % gsz); u.pn = (wgid % nig) / gsz; return true;
    }
};

struct SplitOrder {
    int c, ntk;
    __device__ void init(int c_, int K_) { c = c_; ntk = K_ / BK; }
    __device__ bool next(int i, Unit& u) const {
        const int xcd = c & 7, idx = c >> 3;
        if (i == 0) { u.pm = xcd * 4 + (idx >> 3); u.pn = idx & 7; u.kz = 0; u.koff = 0; u.nt = ntk; return true; }
        if (i == 1) { const int t = idx >> 1; u.pm = 32 + xcd * 2 + (t >> 3); u.pn = t & 7; u.kz = 0; u.nt = ntk >> 1; u.koff = (idx & 1) * (ntk >> 1) * BK; return true; }
        return false;
    }
};

template <class Epi, class Sched>
__device__ __forceinline__ void gemm_phase(LAS unsigned char* lds, const Gemm g, const Sched& S, const Epi& E) {
    int tid_ = threadIdx.x; asm volatile("" : "+v"(tid_));
    const int tid = tid_, wid = __builtin_amdgcn_readfirstlane(tid >> 6), lane = tid & 63, wr = wid >> 2, wc = wid & 3, fr = lane & 15, fq = lane >> 4;
    const int K = g.K;
    unsigned voffA[2], voffB[2];
#pragma unroll
    for (int i = 0; i < 2; ++i) { int R, C; stage_rc(tid * 16 + i * 8192, R, C); const int Rb = Epi::PERM ? ((R & ~31) + perm32(R & 31)) : R;
        voffA[i] = (unsigned)(R * g.lda + C) * 2u; voffB[i] = (unsigned)(Rb * K + C) * 2u; }
    const size_t kstep = (size_t)(BK * 2);
    const size_t hstepA = (size_t)HALF * g.lda * 2, hstepB = (size_t)HALF * K * 2;
    const size_t tstepA = 2 * hstepA, tstepB = 2 * hstepB;
    const unsigned ldsw = (unsigned)wid * 1024u;
    const int aoff = lds_byte(wr * 64 + fr, fq * 8), boff = lds_byte(wc * 32 + fr, fq * 8);
#define PG8_SA(b, h) (((b) * 2 + (h)) * HTB)
#define PG8_SB(b, h) ((4 + (b) * 2 + (h)) * HTB)
#define PG8_STAGE(bufoff, gbase, voff) do { _Pragma("unroll") for (int _i = 0; _i < 2; ++_i) \
        __builtin_amdgcn_global_load_lds((const unsigned*)((const char*)(gbase) + (voff)[_i]), (LAS unsigned*)(lds + (bufoff) + ldsw + _i * 8192), 16, 0, 0); } while (0)
#define PG8_LDA(dst, b, h) do { _Pragma("unroll") for (int m = 0; m < 4; ++m) _Pragma("unroll") for (int k = 0; k < 2; ++k) dst[m][k] = *(const LAS bf16x8*)(lds + PG8_SA(b, h) + aoff + m * 2048 + k * 1024); } while (0)
#define PG8_LDB(dst, b, h) do { _Pragma("unroll") for (int n = 0; n < 2; ++n) _Pragma("unroll") for (int k = 0; k < 2; ++k) dst[n][k] = *(const LAS bf16x8*)(lds + PG8_SB(b, h) + boff + n * 2048 + k * 1024); } while (0)
#define PG8_MMA(ai, bj, At, Bt) do { __builtin_amdgcn_s_setprio(1); _Pragma("unroll") for (int m = 0; m < 4; ++m) _Pragma("unroll") for (int n = 0; n < 2; ++n) _Pragma("unroll") for (int k = 0; k < 2; ++k) \
        acc[ai][bj][m][n] = __builtin_amdgcn_mfma_f32_16x16x32_bf16(Bt[n][k], At[m][k], acc[ai][bj][m][n], 0, 0, 0); __builtin_amdgcn_s_setprio(0); } while (0)
#if SAFE_GEMM == 1 || SAFE_GEMM == 3
#define PG8_WAIT_V(n) asm volatile("s_waitcnt vmcnt(0)" ::: "memory")
#else
#define PG8_WAIT_V(n) asm volatile("s_waitcnt vmcnt(" #n ")" ::: "memory")
#endif
#define PG8_WAIT_L(n) asm volatile("s_waitcnt lgkmcnt(" #n ")" ::: "memory")
#if SAFE_GEMM == 1
#define PG8_BAR do { asm volatile("s_waitcnt vmcnt(0) lgkmcnt(0)" ::: "memory"); __builtin_amdgcn_s_barrier(); asm volatile("" ::: "memory"); } while (0)
#elif SAFE_GEMM == 2
#define PG8_BAR asm volatile("s_barrier" ::: "memory")
#elif SAFE_GEMM == 4
#define PG8_BAR do { asm volatile("s_waitcnt lgkmcnt(0)" ::: "memory"); __builtin_amdgcn_s_barrier(); } while (0)
#else
#define PG8_BAR __builtin_amdgcn_s_barrier()
#endif
#define PG8_SCHED __builtin_amdgcn_sched_barrier(0)
    Unit cur, nxt; int ui = 0;
    if (!S.next(0, cur)) return;
    f32x4 acc[2][2][4][2];
#pragma unroll
    for (int a = 0; a < 2; ++a)
#pragma unroll
        for (int b = 0; b < 2; ++b)
#pragma unroll
            for (int m = 0; m < 4; ++m)
#pragma unroll
                for (int n = 0; n < 2; ++n) acc[a][b][m][n] = (f32x4){0.f, 0.f, 0.f, 0.f};
    bf16x8 At[4][2], B0[2][2], B1[2][2];
    const char* cA = (const char*)(g.A + (size_t)cur.kz * g.a_kz + cur.koff) + (size_t)cur.pm * tstepA; const char* cB = (const char*)(g.Bt + (size_t)cur.kz * g.b_kz + cur.koff) + (size_t)cur.pn * tstepB;
#if GEMM_SP2
    PG8_STAGE(PG8_SB(0, 0), cB, voffB); PG8_STAGE(PG8_SB(0, 1), cB + hstepB, voffB); PG8_STAGE(PG8_SA(0, 0), cA, voffA); PG8_STAGE(PG8_SA(0, 1), cA + hstepA, voffA);
    if (wr == 1) PG8_BAR;
    PG8_WAIT_V(2); PG8_BAR;
    PG8_STAGE(PG8_SB(1, 0), cB + kstep, voffB); PG8_STAGE(PG8_SA(1, 0), cA + kstep, voffA); PG8_STAGE(PG8_SB(1, 1), cB + hstepB + kstep, voffB);
    PG8_WAIT_V(6); PG8_BAR;
#else
    PG8_STAGE(PG8_SB(0, 0), cB, voffB); PG8_STAGE(PG8_SA(0, 0), cA, voffA); PG8_STAGE(PG8_SB(0, 1), cB + hstepB, voffB); PG8_STAGE(PG8_SA(0, 1), cA + hstepA, voffA);
    if (wr == 1) PG8_BAR;
    PG8_WAIT_V(4); PG8_BAR;
    PG8_STAGE(PG8_SB(1, 0), cB + kstep, voffB); PG8_STAGE(PG8_SA(1, 0), cA + kstep, voffA); PG8_STAGE(PG8_SB(1, 1), cB + hstepB + kstep, voffB);
    PG8_WAIT_V(6); PG8_BAR;
#endif
    for (;;) {
        const bool has_next = S.next(ui + 1, nxt);
        const char* nA = has_next ? (const char*)(g.A + (size_t)nxt.kz * g.a_kz + nxt.koff) + (size_t)nxt.pm * tstepA : cA;
        const char* nB = has_next ? (const char*)(g.Bt + (size_t)nxt.kz * g.b_kz + nxt.koff) + (size_t)nxt.pn * tstepB : cB;
        const int nt = cur.nt;
        for (int t = 0; t < nt; t += 2) {
            const bool last = (t == nt - 2);
            const char* a1 = cA + (size_t)(t + 1) * kstep;
            const char* a2 = last ? nA : cA + (size_t)(t + 2) * kstep; const char* b2 = last ? nB : cB + (size_t)(t + 2) * kstep;
            const char* a3 = a2 + kstep; const char* b3 = b2 + kstep;
#if GEMM_SP2
            PG8_LDB(B0, 0, 0); PG8_LDB(B1, 0, 1); PG8_SCHED; PG8_LDA(At, 0, 0); PG8_STAGE(PG8_SA(1, 1), a1 + hstepA, voffA);
            PG8_WAIT_V(8); PG8_WAIT_L(0); PG8_BAR; PG8_MMA(0, 0, At, B0); PG8_MMA(0, 1, At, B1); PG8_BAR; PG8_SCHED;
            PG8_LDA(At, 0, 1); PG8_STAGE(PG8_SB(0, 0), b2, voffB); PG8_STAGE(PG8_SB(0, 1), b2 + hstepB, voffB); PG8_STAGE(PG8_SA(0, 0), a2, voffA);
            PG8_WAIT_V(8); PG8_WAIT_L(0); PG8_BAR; PG8_MMA(1, 0, At, B0); PG8_MMA(1, 1, At, B1); PG8_BAR; PG8_SCHED;
            PG8_LDB(B0, 1, 0); PG8_LDB(B1, 1, 1); PG8_SCHED; PG8_LDA(At, 1, 0); PG8_STAGE(PG8_SA(0, 1), a2 + hstepA, voffA);
            PG8_WAIT_V(8); PG8_WAIT_L(0); PG8_BAR; PG8_MMA(0, 0, At, B0); PG8_MMA(0, 1, At, B1); PG8_BAR; PG8_SCHED;
            PG8_LDA(At, 1, 1); PG8_STAGE(PG8_SB(1, 0), b3, voffB); PG8_STAGE(PG8_SB(1, 1), b3 + hstepB, voffB); PG8_STAGE(PG8_SA(1, 0), a3, voffA);
            PG8_WAIT_V(8); PG8_WAIT_L(0); PG8_BAR; PG8_MMA(1, 0, At, B0); PG8_MMA(1, 1, At, B1); PG8_BAR; PG8_SCHED;
#else
            PG8_LDB(B0, 0, 0); PG8_SCHED; PG8_LDA(At, 0, 0); PG8_STAGE(PG8_SA(1, 1), a1 + hstepA, voffA);
            PG8_WAIT_L(8); PG8_BAR; PG8_WAIT_L(0); PG8_MMA(0, 0, At, B0); PG8_BAR; PG8_SCHED;
            PG8_LDB(B1, 0, 1); PG8_STAGE(PG8_SB(0, 0), b2, voffB);
            PG8_BAR; PG8_WAIT_L(0); PG8_MMA(0, 1, At, B1); PG8_BAR;
            PG8_LDA(At, 0, 1); PG8_STAGE(PG8_SA(0, 0), a2, voffA);
            PG8_BAR; PG8_WAIT_L(0); PG8_MMA(1, 0, At, B0); PG8_BAR; PG8_SCHED;
            PG8_STAGE(PG8_SB(0, 1), b2 + hstepB, voffB);
            PG8_WAIT_V(6); PG8_BAR; PG8_MMA(1, 1, At, B1); PG8_BAR;
            PG8_LDB(B0, 1, 0); PG8_SCHED; PG8_LDA(At, 1, 0); PG8_STAGE(PG8_SA(0, 1), a2 + hstepA, voffA);
            PG8_WAIT_L(8); PG8_BAR; PG8_WAIT_L(0); PG8_MMA(0, 0, At, B0); PG8_BAR; PG8_SCHED;
            PG8_LDB(B1, 1, 1); PG8_STAGE(PG8_SB(1, 0), b3, voffB);
            PG8_BAR; PG8_WAIT_L(0); PG8_MMA(0, 1, At, B1); PG8_BAR;
            PG8_LDA(At, 1, 1); PG8_STAGE(PG8_SA(1, 0), a3, voffA);
            PG8_BAR; PG8_WAIT_L(0); PG8_MMA(1, 0, At, B0); PG8_BAR; PG8_SCHED;
            PG8_STAGE(PG8_SB(1, 1), b3 + hstepB, voffB);
            PG8_WAIT_V(6); PG8_BAR; PG8_MMA(1, 1, At, B1); PG8_BAR;
#endif
        }
#if GEMM_ALIGN
        if (wr == 0) PG8_BAR;
#endif
        E(acc, cur, wr, wc, fr, fq);
        if (!has_next) break;
        if (nxt.kz == 0) {
#pragma unroll
        for (int a = 0; a < 2; ++a)
#pragma unroll
            for (int b = 0; b < 2; ++b)
#pragma unroll
                for (int m = 0; m < 4; ++m)
#pragma unroll
                    for (int n = 0; n < 2; ++n) acc[a][b][m][n] = (f32x4){0.f, 0.f, 0.f, 0.f};
        }
        cur = nxt; cA = nA; cB = nB; ++ui;
#if GEMM_ALIGN
        if (wr == 1) PG8_BAR;
#endif
    }
    PG8_WAIT_V(0);
#if !GEMM_ALIGN
    if (wr == 0) PG8_BAR;
#endif
    PG8_BAR;
#undef PG8_SA
#undef PG8_SB
#undef PG8_STAGE
#undef PG8_LDA
#undef PG8_LDB
#undef PG8_MMA
#undef PG8_WAIT_V
#undef PG8_WAIT_L
#undef PG8_BAR
#undef PG8_SCHED
}
}
namespace mk {
constexpr size_t O_YP = 0, O_YS = 8388608, O_NK = 25165824, O_NV = 33554432, O_S5R = 41943040, O_S5I = 42205184, O_SSD = 42467328,
                 O_MLC = 50855936, O_MLN = 59244544, O_MLM = 59310080;

__device__ __forceinline__ u32x4 pack8(const f32x4 a, const f32x4 b) { u32x4 w; w.x = pk2(a[0], a[1]); w.y = pk2(a[2], a[3]); w.z = pk2(b[0], b[1]); w.w = pk2(b[2], b[3]); return w; }

struct EpiIn {
    static constexpr bool PERM = true;
    bf16_t* proj; float* small; float* out; const float* qg; const float* kg; int layer;
    __device__ __forceinline__ void operator()(f32x4 (&acc)[2][2][4][2], const Unit& u, int wr, int wc, int fr, int fq) const {
        const int T = u.pn, rowb = u.pm * BM + wr * 64 + fr;
        if (T == 54) {
            if (wc == 0) {
#pragma unroll
                for (int ai = 0; ai < 2; ++ai)
#pragma unroll
                    for (int m = 0; m < 4; ++m) { float* sp = small + (size_t)(rowb + ai * HALF + m * 16) * 32 + 8 * fq; *(f32x4*)sp = acc[ai][0][m][0]; *(f32x4*)(sp + 4) = acc[ai][0][m][1]; }
            }
            return;
        }
        const int colb = T * 256 + 64 * wc + 8 * fq;
        if (T < 4) {
            const float* g = T < 2 ? qg : kg;
            f32x4 gv[2][2];
#pragma unroll
            for (int bj = 0; bj < 2; ++bj)
#pragma unroll
                for (int n = 0; n < 2; ++n) gv[bj][n] = *(const f32x4*)(g + 32 * bj + 8 * fq + 4 * n);
#pragma unroll
            for (int ai = 0; ai < 2; ++ai)
#pragma unroll
                for (int m = 0; m < 4; ++m) {
                    float ss = 0.f;
#pragma unroll
                    for (int bj = 0; bj < 2; ++bj)
#pragma unroll
                        for (int n = 0; n < 2; ++n) { const f32x4 x = acc[ai][bj][m][n]; ss += (x[0] * x[0] + x[1] * x[1]) + (x[2] * x[2] + x[3] * x[3]); }
                    ss += __shfl_xor(ss, 16); ss += __shfl_xor(ss, 32);
                    const float r = rsqrtf(ss * (1.f / 64.f) + 1e-6f);
                    const int row = rowb + ai * HALF + m * 16;
#pragma unroll
                    for (int bj = 0; bj < 2; ++bj) { const f32x4 v0 = acc[ai][bj][m][0] * r * gv[bj][0], v1 = acc[ai][bj][m][1] * r * gv[bj][1];
                        *(u32x4*)(proj + (size_t)row * PJ + colb + 32 * bj) = pack8(v0, v1);
                        if (T >= 2 && row < MP) { float* o = out + O_NK + ((size_t)((row >> 8) * DEPTH + layer) * 256 + (row & 255)) * 512 + (colb - 512) + 32 * bj; *(f32x4*)o = v0; *(f32x4*)(o + 4) = v1; } }
                }
        } else if (T < 6) {
#pragma unroll
            for (int ai = 0; ai < 2; ++ai)
#pragma unroll
                for (int m = 0; m < 4; ++m) { const int row = rowb + ai * HALF + m * 16;
#pragma unroll
                    for (int bj = 0; bj < 2; ++bj) { const f32x4 v0 = acc[ai][bj][m][0], v1 = acc[ai][bj][m][1];
                        *(u32x4*)(proj + (size_t)row * PJ + colb + 32 * bj) = pack8(v0, v1);
                        if (row < MP) { float* o = out + O_NV + ((size_t)((row >> 8) * DEPTH + layer) * 256 + (row & 255)) * 512 + (colb - 1024) + 32 * bj; *(f32x4*)o = v0; *(f32x4*)(o + 4) = v1; } } }
        } else if (T < 22) {
#pragma unroll
            for (int ai = 0; ai < 2; ++ai)
#pragma unroll
                for (int m = 0; m < 4; ++m) { const int row = rowb + ai * HALF + m * 16;
#pragma unroll
                    for (int bj = 0; bj < 2; ++bj) *(u32x4*)(proj + (size_t)row * PJ + colb + 32 * bj) = pack8(acc[ai][bj][m][0], acc[ai][bj][m][1]); }
        } else {
#pragma unroll
            for (int ai = 0; ai < 2; ++ai)
#pragma unroll
                for (int m = 0; m < 4; ++m) { const int row = rowb + ai * HALF + m * 16;
#pragma unroll
                    for (int bj = 0; bj < 2; ++bj) { f32x4 v0 = acc[ai][bj][m][0], v1 = acc[ai][bj][m][1];
#pragma unroll
                        for (int j = 0; j < 4; ++j) { v0[j] = fsigm(v0[j]); v1[j] = fsigm(v1[j]); }
                        *(u32x4*)(proj + (size_t)row * PJ + colb + 32 * bj) = pack8(v0, v1); } }
        }
    }
};
struct EpiRelu2 {
    static constexpr bool PERM = true;
    bf16_t* O; int ldo;
    __device__ __forceinline__ void operator()(f32x4 (&acc)[2][2][4][2], const Unit& u, int wr, int wc, int fr, int fq) const {
        const int rowb = u.pm * BM + wr * 64 + fr, colb = u.pn * 256 + 64 * wc + 8 * fq;
#pragma unroll
        for (int ai = 0; ai < 2; ++ai)
#pragma unroll
            for (int m = 0; m < 4; ++m) { const int row = rowb + ai * HALF + m * 16;
#pragma unroll
                for (int bj = 0; bj < 2; ++bj) { f32x4 v0 = acc[ai][bj][m][0], v1 = acc[ai][bj][m][1];
#pragma unroll
                    for (int j = 0; j < 4; ++j) { const float a = fmaxf(v0[j], 0.f), b = fmaxf(v1[j], 0.f); v0[j] = a * a; v1[j] = b * b; }
                    *(u32x4*)(O + (size_t)row * ldo + colb + 32 * bj) = pack8(v0, v1); } }
    }
};
struct EpiGlu {
    static constexpr bool PERM = true;
    const bf16_t* Z; const float* bias; bf16_t* br;
    __device__ __forceinline__ void operator()(f32x4 (&acc)[2][2][4][2], const Unit& u, int wr, int wc, int fr, int fq) const {
        const int rowb = u.pm * BM + wr * 64 + fr, colb = u.pn * 256 + 64 * wc + 8 * fq;
#pragma unroll
        for (int bj = 0; bj < 2; ++bj) { const int c = colb + 32 * bj; const f32x4 b0 = *(const f32x4*)(bias + c), b1 = *(const f32x4*)(bias + c + 4);
#pragma unroll
            for (int ai = 0; ai < 2; ++ai)
#pragma unroll
                for (int m = 0; m < 4; ++m) { const int row = rowb + ai * HALF + m * 16;
                    const u32x4 zz = *(const u32x4*)(Z + (size_t)row * 512 + c);
                    f32x4 v0 = acc[ai][bj][m][0] + b0, v1 = acc[ai][bj][m][1] + b1;
                    v0[0] = bflo(zz.x) * fsigm(v0[0]); v0[1] = bfhi(zz.x) * fsigm(v0[1]); v0[2] = bflo(zz.y) * fsigm(v0[2]); v0[3] = bfhi(zz.y) * fsigm(v0[3]);
                    v1[0] = bflo(zz.z) * fsigm(v1[0]); v1[1] = bfhi(zz.z) * fsigm(v1[1]); v1[2] = bflo(zz.w) * fsigm(v1[2]); v1[3] = bfhi(zz.w) * fsigm(v1[3]);
                    *(u32x4*)(br + (size_t)row * D + 512 + c) = pack8(v0, v1); } }
    }
};
struct EpiBranch {
    static constexpr bool PERM = true;
    const bf16_t* proj; bf16_t* merged;
    __device__ __forceinline__ void operator()(f32x4 (&acc)[2][2][4][2], const Unit& u, int wr, int wc, int fr, int fq) const {
        const int rowb = u.pm * BM + wr * 64 + fr, colb = u.pn * 256 + 64 * wc + 8 * fq, kz = u.kz;
#pragma unroll
        for (int ai = 0; ai < 2; ++ai)
#pragma unroll
            for (int m = 0; m < 4; ++m) { const int row = rowb + ai * HALF + m * 16;
#pragma unroll
                for (int bj = 0; bj < 2; ++bj) { const int c = colb + 32 * bj;
                    const u32x4 gg = *(const u32x4*)(proj + (size_t)row * PJ + P_GATE + kz * D + c);
                    float g[8] = {bflo(gg.x), bfhi(gg.x), bflo(gg.y), bfhi(gg.y), bflo(gg.z), bfhi(gg.z), bflo(gg.w), bfhi(gg.w)};
                    if (kz < 3) { const u32x4 hh = *(const u32x4*)(proj + (size_t)row * PJ + P_GATE + (kz + 1) * D + c);
                        const float h[8] = {bflo(hh.x), bfhi(hh.x), bflo(hh.y), bfhi(hh.y), bflo(hh.z), bfhi(hh.z), bflo(hh.w), bfhi(hh.w)};
#pragma unroll
                        for (int j = 0; j < 8; ++j) g[j] = g[j] * __builtin_amdgcn_rcpf(fmaxf(h[j], 1e-30f)); }
                    f32x4& v0 = acc[ai][bj][m][0]; f32x4& v1 = acc[ai][bj][m][1];
                    v0[0] *= g[0]; v0[1] *= g[1]; v0[2] *= g[2]; v0[3] *= g[3]; v1[0] *= g[4]; v1[1] *= g[5]; v1[2] *= g[6]; v1[3] *= g[7];
                    if (kz == 3) *(u32x4*)(merged + (size_t)row * D + c) = pack8(v0, v1); } }
    }
};
struct EpiResid {
    static constexpr bool PERM = false;
    const float* xp; const float* xs; const float* modl; int g_off; float* xout; float* part;
    __device__ __forceinline__ void operator()(f32x4 (&acc)[2][2][4][2], const Unit& u, int wr, int wc, int fr, int fq) const {
        if (part != nullptr && u.pm >= 32) {
            float* P = part + (size_t)((((u.pm - 32) * 8 + u.pn) * 2) + (u.koff != 0)) * 65536 + (size_t)(wr * 64 + fr) * 256 + wc * 32 + 4 * fq;
#pragma unroll
            for (int ai = 0; ai < 2; ++ai)
#pragma unroll
                for (int m = 0; m < 4; ++m)
#pragma unroll
                    for (int bj = 0; bj < 2; ++bj)
#pragma unroll
                        for (int n = 0; n < 2; ++n) *(f32x4*)(P + (size_t)(ai * HALF + m * 16) * 256 + bj * HALF + n * 16) = acc[ai][bj][m][n];
            return;
        }
        const int row0 = u.pm * BM, rowb = row0 + wr * 64 + fr, colb = u.pn * 256 + wc * 32 + 4 * fq;
        const float* xin = row0 < MP ? xp : xs - (size_t)MP * D;
        const float* gate = modl + (size_t)row_cvec(row0) * 6 * D + g_off;
        f32x4 gv[2][2];
#pragma unroll
        for (int bj = 0; bj < 2; ++bj)
#pragma unroll
            for (int n = 0; n < 2; ++n) gv[bj][n] = *(const f32x4*)(gate + colb + bj * HALF + n * 16);
#pragma unroll
        for (int ai = 0; ai < 2; ++ai)
#pragma unroll
            for (int m = 0; m < 4; ++m) { const size_t ro = (size_t)(rowb + ai * HALF + m * 16) * D + colb;
#pragma unroll
                for (int bj = 0; bj < 2; ++bj)
#pragma unroll
                    for (int n = 0; n < 2; ++n) { const size_t o = ro + bj * HALF + n * 16; *(f32x4*)(xout + o) = *(const f32x4*)(xin + o) + gv[bj][n] * acc[ai][bj][m][n]; } }
    }
};
}
namespace mk {
constexpr size_t AL(size_t x) { return (x + 255) & ~(size_t)255; }
constexpr size_t WS_CTL = 0, CTL_BYTES = 65536;
constexpr size_t WS_MOD = WS_CTL + CTL_BYTES;
constexpr size_t WS_W = AL(WS_MOD + (size_t)DEPTH * 5 * 6 * D * 4);
constexpr size_t W_IN = 0, W_GLU = W_IN + (size_t)NIN * D, W_BR = W_GLU + 512 * 512, W_OUT = W_BR + (size_t)4 * D * 512, W_1 = W_OUT + (size_t)D * D, W_2 = W_1 + (size_t)DFF * D,
                 W_LAYER = W_2 + (size_t)D * DFF;
constexpr size_t WS_H = AL(WS_W + W_LAYER * 2 * DEPTH);
constexpr size_t WS_PROJ = AL(WS_H + (size_t)M * D * 2);
constexpr size_t WS_SMALL = AL(WS_PROJ + (size_t)M * PJ * 2);
constexpr size_t WS_BR = AL(WS_SMALL + (size_t)M * 32 * 4);
constexpr size_t WS_MERGED = AL(WS_BR + (size_t)M * D * 2);
constexpr size_t WS_MACC = AL(WS_MERGED + (size_t)M * D * 2);
constexpr size_t WS_ZB = AL(WS_MACC + (size_t)M * D * 4);
constexpr size_t WS_SCR = AL(WS_ZB + (size_t)M * 512 * 2);
constexpr int LDS_BYTES = 140 * 1024, LDS_CTL = LDS_BYTES - 256;

struct Args { const float* in[43]; float* out; unsigned char* ws; int ph_lo, ph_hi; };

__device__ __forceinline__ float wave_sum(float v) {
#pragma unroll
    for (int o = 1; o < 64; o <<= 1) v += __shfl_xor(v, o);
    return v;
}
#define LDS_WAIT() asm volatile("s_waitcnt lgkmcnt(0)" ::: "memory")

__device__ __forceinline__ void xpose_item(const float* W, int ldw, int k0, int sc, bf16_t* dst, int K, LAS float* scr, int lane, int mode) {
    const int n4 = (lane & 7) * 4;
    const int col = mode == 1 ? (n4 < 16 ? 3584 + n4 : 5648 + (n4 - 16)) : sc + n4;
#pragma unroll
    for (int i = 0; i < 8; ++i) { const int kk = (lane >> 3) + 8 * i; f32x4 v = (f32x4){0.f, 0.f, 0.f, 0.f}; if (mode != 2) v = *(const f32x4*)(W + (size_t)(k0 + kk) * ldw + col);
        scr[kk * 33 + n4] = v[0]; scr[kk * 33 + n4 + 1] = v[1]; scr[kk * 33 + n4 + 2] = v[2]; scr[kk * 33 + n4 + 3] = v[3]; }
    LDS_WAIT(); asm volatile("" ::: "memory");
    const int c = lane & 7;
#pragma unroll
    for (int jj = 0; jj < 4; ++jj) { const int n = (lane >> 3) + 8 * jj; const LAS float* s = scr + (8 * c) * 33 + n;
        u32x4 o; o.x = pk2(s[0 * 33], s[1 * 33]); o.y = pk2(s[2 * 33], s[3 * 33]); o.z = pk2(s[4 * 33], s[5 * 33]); o.w = pk2(s[6 * 33], s[7 * 33]);
        *(u32x4*)(dst + (size_t)n * K + k0 + 8 * c) = o; }
    LDS_WAIT(); asm volatile("" ::: "memory");
}
__device__ __forceinline__ int hm_col(int grp) { const int T = grp >> 3, q8 = grp & 7; return 256 * T + 32 * (2 * (q8 & 3) + (q8 >> 2)); }

__device__ __forceinline__ void prologue_convert(const Args& a, LAS unsigned char* lds, int it0, int it1, int wave, int lane) {
    LAS float* scr = (LAS float*)(lds + wave * 8704);
    bf16_t* WB = (bf16_t*)(a.ws + WS_W);
    constexpr int I_IN = 440 * 32, I_GLU = 16 * 8, I_BR = 4 * 64 * 8, I_OUT = 64 * 32, I_1 = 256 * 32, I_2 = 64 * 128, I_L = I_IN + I_GLU + I_BR + I_OUT + I_1 + I_2;
    for (int it = it0; it < it1 && it < I_L * DEPTH; ++it) {
        const int l = it / I_L; int r = it - l * I_L; bf16_t* wl = WB + (size_t)l * W_LAYER;
        if (r < I_IN) { const int kb = r / 440, grp = r % 440, T = grp >> 3; int sc = hm_col(grp), mode = 0;
            if (T == 54) mode = (grp & 7) == 0 ? 1 : 2; else if (T >= 22) sc += 32; else if (T >= 14) sc += 16;
            xpose_item(a.in[16] + (size_t)l * D * 13856, 13856, 64 * kb, sc, wl + W_IN + (size_t)(32 * grp) * D, D, scr, lane, mode); continue; } r -= I_IN;
        if (r < I_GLU) { const int kb = r / 16, grp = r % 16; xpose_item(a.in[28] + (size_t)l * 512 * 512, 512, 64 * kb, hm_col(grp), wl + W_GLU + (size_t)(32 * grp) * 512, 512, scr, lane, 0); continue; } r -= I_GLU;
        if (r < I_BR) { const int k = r / 512, r2 = r % 512, kb = r2 / 64, grp = r2 % 64;
            xpose_item(a.in[39] + ((size_t)l * 4 + k) * 512 * D, D, 64 * kb, hm_col(grp), wl + W_BR + (size_t)k * D * 512 + (size_t)(32 * grp) * 512, 512, scr, lane, 0); continue; } r -= I_BR;
        if (r < I_OUT) { const int kb = r / 64, grp = r % 64; xpose_item(a.in[40] + (size_t)l * D * D, D, 64 * kb, 32 * grp, wl + W_OUT + (size_t)(32 * grp) * D, D, scr, lane, 0); continue; } r -= I_OUT;
        if (r < I_1) { const int kb = r / 256, grp = r % 256; xpose_item(a.in[41] + (size_t)l * D * DFF, DFF, 64 * kb, hm_col(grp), wl + W_1 + (size_t)(32 * grp) * D, D, scr, lane, 0); continue; } r -= I_1;
        { const int kb = r / 64, grp = r % 64; xpose_item(a.in[42] + (size_t)l * DFF * D, D, 64 * kb, 32 * grp, wl + W_2 + (size_t)(32 * grp) * DFF, DFF, scr, lane, 0); }
    }
}
__device__ __forceinline__ void prologue_ada_unit(const Args& a, LAS unsigned char* lds, int tid, int unit) {
    LAS float* sl = (LAS float*)lds;
    LAS float* red = (LAS float*)(lds + 40960);
    float* mod = (float*)(a.ws + WS_MOD);
    for (int i = tid; i < 5 * D; i += NT) { const int j = i / D, k = i % D; const float x = j == 0 ? a.in[11][k] : a.in[10][(j - 1) * D + k]; sl[i] = x / (1.f + __expf(-x)); }
    __syncthreads();
    const int ks = tid >> 6, c = tid & 63;
    const int l = unit / (6 * D / 64), n0 = (unit % (6 * D / 64)) * 64;
    const float* w = a.in[12] + (size_t)l * D * 6 * D + n0 + c;
    float acc[5] = {0.f, 0.f, 0.f, 0.f, 0.f};
#pragma unroll 8
    for (int k = ks * 256; k < ks * 256 + 256; ++k) { const float wv = w[(size_t)k * 6 * D];
#pragma unroll
        for (int j = 0; j < 5; ++j) acc[j] += sl[j * D + k] * wv; }
#pragma unroll
    for (int j = 0; j < 5; ++j) red[(ks * 5 + j) * 64 + c] = acc[j];
    __syncthreads();
    if (tid < 320) { const int j = tid >> 6; float s = 0.f;
#pragma unroll
        for (int q = 0; q < 8; ++q) s += red[(q * 5 + j) * 64 + c];
        mod[((size_t)l * 5 + j) * 6 * D + n0 + c] = s + a.in[13][l * 6 * D + n0 + c]; }
}
constexpr int PRO_CONV_ITEMS = (440 * 32 + 16 * 8 + 4 * 64 * 8 + 64 * 32 + 256 * 32 + 64 * 128) * DEPTH;
constexpr int PRO_NCONV = (PRO_CONV_ITEMS + 63) / 64, PRO_NADA = DEPTH * 6 * D / 64, PRO_NCACHE = 64;
__device__ __forceinline__ void norm_phase(const float* xp, const float* xs, const float* g, const float* modl, int sh_off, int sc_off, bf16_t* H, int gw, int ngw, int lane_,
                                           const float* pend, const float* pmodl, int pg_off, float* xw, const float* xs_pend) {
    int lane = lane_; asm volatile("" : "+v"(lane));
    for (int row = gw; row < M; row += ngw) {
        const float* x = row < MP ? xp + (size_t)row * D : xs + (size_t)(row - MP) * D;
        if (pend != nullptr && row >= 8192) x = xs_pend + (size_t)(row - MP) * D;
        f32x4 v[8]; float ss = 0.f;
#pragma unroll
        for (int j = 0; j < 8; ++j) v[j] = *(const f32x4*)(x + 4 * (lane + 64 * j));
        if (pend != nullptr && row >= 8192) {
            const float* pg = pmodl + (size_t)row_cvec(row) * 6 * D + pg_off; const int pm = row >> 8, r = row & 255;
#pragma unroll
            for (int j = 0; j < 8; ++j) { const int col = 4 * (lane + 64 * j), pn = col >> 8, cc = col & 255;
                const float* P = pend + (size_t)(((pm - 32) * 8 + pn) * 2) * 65536 + (size_t)r * 256 + cc;
                const f32x4 pa = *(const f32x4*)P, pb = *(const f32x4*)(P + 65536), gg = *(const f32x4*)(pg + col);
                v[j] = v[j] + gg * (pa + pb); *(f32x4*)(xw + (size_t)row * D + col) = v[j]; }
        }
#pragma unroll
        for (int j = 0; j < 8; ++j) ss += (v[j][0] * v[j][0] + v[j][1] * v[j][1]) + (v[j][2] * v[j][2] + v[j][3] * v[j][3]);
        const float r = rsqrtf(wave_sum(ss) * (1.f / D) + 1e-6f);
        const float* md = modl + (size_t)row_cvec(row) * 6 * D;
#pragma unroll
        for (int j = 0; j < 8; ++j) { const int i = 4 * (lane + 64 * j);
            const f32x4 gg = *(const f32x4*)(g + i), sc = *(const f32x4*)(md + sc_off + i), sh = *(const f32x4*)(md + sh_off + i);
            const f32x4 o = v[j] * r * gg * (sc + 1.f) + sh;
            u32x2 w; w.x = pk2(o[0], o[1]); w.y = pk2(o[2], o[3]); *(u32x2*)(H + (size_t)row * D + i) = w; }
    }
}
__device__ __forceinline__ void final_fix_phase(const float* pend, const float* pmodl, int pg_off, float* X, int gw, int ngw, int lane_) {
    int lane = lane_; asm volatile("" : "+v"(lane));
    for (int row = 8192 + gw; row < M; row += ngw) {
        const float* pg = pmodl + (size_t)row_cvec(row) * 6 * D + pg_off; const int pm = row >> 8, r = row & 255;
#pragma unroll
        for (int j = 0; j < 8; ++j) { const int col = 4 * (lane + 64 * j), pn = col >> 8, cc = col & 255;
            const float* P = pend + (size_t)(((pm - 32) * 8 + pn) * 2) * 65536 + (size_t)r * 256 + cc;
            const f32x4 pa = *(const f32x4*)P, pb = *(const f32x4*)(P + 65536), gg = *(const f32x4*)(pg + col);
            float* xo = X + (size_t)row * D + col; *(f32x4*)xo = *(const f32x4*)xo + gg * (pa + pb); }
    }
}
}
namespace mk {
constexpr size_t WS_NAT = AL(WS_SCR);
constexpr int NATP = 2048, N_XBC = 0, N_Q = 1024, N_K = 1536;
constexpr size_t WS_TR = AL(WS_NAT + (size_t)M * NATP * 2);
constexpr int T_X = 0, T_B = 512, T_K = 768, T_MV = 1280, T_V = 1792, TRR = 2304;
constexpr int NCH = 96;
constexpr size_t WS_MLC = AL(WS_TR + (size_t)TRR * M * 2);
constexpr size_t WS_MLN = AL(WS_MLC + (size_t)NCH * 4 * 2 * 16384 * 4);
constexpr size_t WS_MLS = AL(WS_MLN + (size_t)NCH * 4 * 2 * 128 * 4);
constexpr size_t WS_MLCS = AL(WS_MLS + (size_t)NCH * 4 * 2 * 4 * 4);
constexpr size_t WS_MLNS = AL(WS_MLCS + (size_t)NCH * 4 * 2 * 16384 * 2);
constexpr size_t WS_MLMS = AL(WS_MLNS + (size_t)NCH * 4 * 2 * 128 * 4);
constexpr size_t WS_OPT_END = AL(WS_MLMS + (size_t)NCH * 4 * 2 * 4);

__device__ __forceinline__ f32x4 mfma16(bf16x8 a, bf16x8 b, f32x4 c) { return __builtin_amdgcn_mfma_f32_16x16x32_bf16(a, b, c, 0, 0, 0); }
__device__ __forceinline__ void chunk_info(int ch, int& row0, int& seq0, int& L, int& lat, int& b, int& ci, int& nc) {
    if (ch < 32) { b = ch >> 1; ci = ch & 1; nc = 2; seq0 = b * 256; L = 256; lat = 0; } else { const int c2 = ch - 32; b = c2 >> 4; ci = c2 & 15; nc = 16; seq0 = MP + b * 2048; L = 2048; lat = 1; }
    row0 = seq0 + ci * 128;
}
__device__ __forceinline__ float fast_exp(float x) { return __expf(x); }

__device__ __forceinline__ void prep_phase(const Args& a, int layer, LAS unsigned char* lds, int gw_, int ngw, int wave, int lane_, bf16_t* UPk) {
    int lane = lane_, gw = gw_; asm volatile("" : "+v"(lane));
    const bf16_t* PROJ = (const bf16_t*)(a.ws + WS_PROJ); bf16_t* NAT = (bf16_t*)(a.ws + WS_NAT); bf16_t* TR = (bf16_t*)(a.ws + WS_TR);
    LAS bf16_t* tile = (LAS bf16_t*)(lds + wave * 16896); LAS bf16_t* otile = tile + 68 * 64;
    const int c = lane & 7, r8 = lane >> 3;
    const float* cw = a.in[30] + layer * 5 * 1024; const float* cb = a.in[31] + layer * 1024;
    for (int u = gw; u < 56 * 192; u += ngw) {
        const int cg = u / 192, tt = u % 192, m0 = tt * 64;
        const int lat = m0 >= MP; const int seq0 = lat ? MP + ((m0 - MP) / 2048) * 2048 : (m0 / 256) * 256, L = lat ? 2048 : 256, t0 = m0 - seq0;
        int kind, src, natcol = -1, trrow = -1;
        if (cg < 16) { kind = 0; src = P_XBC + 64 * cg; natcol = N_XBC + 64 * cg; if (cg < 12) trrow = T_X + 64 * cg; }
        else if (cg < 24) { kind = 1; src = P_MQ + 64 * (cg - 16); natcol = N_Q + 64 * (cg - 16); }
        else if (cg < 32) { kind = 2; src = P_MK + 64 * (cg - 24); natcol = N_K + 64 * (cg - 24); trrow = T_K + 64 * (cg - 24); }
        else if (cg < 40) { kind = 3; src = P_MV + 64 * (cg - 32); trrow = T_MV + 64 * (cg - 32); }
        else if (cg < 48) { kind = 3; src = P_V + 64 * (cg - 40); trrow = T_V + 64 * (cg - 40); }
        else { kind = 4; src = P_S5U + 64 * (cg - 48); }
        const int roff = kind == 0 ? -2 : 0, nrows = kind == 0 ? 68 : 64;
#pragma unroll
        for (int i = 0; i < 9; ++i) { const int r = r8 + 8 * i; if (r < nrows) { const int t = t0 + r + roff; u32x4 v = {0u, 0u, 0u, 0u};
                if (t >= 0 && t < L) v = *(const u32x4*)(PROJ + (size_t)(seq0 + t) * PJ + src + 8 * c);
                *(LAS u32x4*)(tile + r * 64 + 8 * c) = v; } }
        LDS_WAIT(); asm volatile("" ::: "memory");
#define PREP_EMIT(i_, r_) do { if (natcol >= 0) *(u32x4*)(NAT + (size_t)(m0 + r8 + 8 * (i_)) * NATP + natcol + 8 * c) = (r_); if (trrow >= 0) *(LAS u32x4*)(otile + (r8 + 8 * (i_)) * 64 + 8 * c) = (r_); } while (0)
        if (kind == 0) {
            float w[5][8], bz[8];
#pragma unroll
            for (int e = 0; e < 8; ++e) { bz[e] = cb[64 * cg + 8 * c + e];
#pragma unroll
                for (int j = 0; j < 5; ++j) w[j][e] = cw[j * 1024 + 64 * cg + 8 * c + e]; }
#pragma unroll 2
            for (int i = 0; i < 8; ++i) { const int tk = r8 + 8 * i; float acc[8];
#pragma unroll
                for (int e = 0; e < 8; ++e) acc[e] = bz[e];
#pragma unroll
                for (int j = 0; j < 5; ++j) { const u32x4 v = *(const LAS u32x4*)(tile + (tk + j) * 64 + 8 * c);
                    acc[0] += bflo(v.x) * w[j][0]; acc[1] += bfhi(v.x) * w[j][1]; acc[2] += bflo(v.y) * w[j][2]; acc[3] += bfhi(v.y) * w[j][3];
                    acc[4] += bflo(v.z) * w[j][4]; acc[5] += bfhi(v.z) * w[j][5]; acc[6] += bflo(v.w) * w[j][6]; acc[7] += bfhi(v.w) * w[j][7]; }
#pragma unroll
                for (int e = 0; e < 8; ++e) acc[e] = fsilu(acc[e]);
                u32x4 rv; rv.x = pk2(acc[0], acc[1]); rv.y = pk2(acc[2], acc[3]); rv.z = pk2(acc[4], acc[5]); rv.w = pk2(acc[6], acc[7]); PREP_EMIT(i, rv); }
        } else if (kind == 4) {
#pragma unroll
            for (int i = 0; i < 8; ++i) { const int tk = r8 + 8 * i, m = m0 + tk; const u32x4 v = *(const LAS u32x4*)(tile + tk * 64 + 8 * c);
                *(u32x4*)(UPk + ((size_t)(4 * (cg - 48) + (c >> 1)) * 384 + (m >> 5)) * 512 + (m & 31) * 16 + 8 * (c & 1)) = v; }
        } else if (kind == 3 || !lat) {
            const float sc = kind == 2 ? 0.08838834764831845f : 1.f;
#pragma unroll
            for (int i = 0; i < 8; ++i) { const u32x4 v = *(const LAS u32x4*)(tile + (r8 + 8 * i) * 64 + 8 * c);
                u32x4 rv = v;
                if (kind == 2) { rv.x = pk2(bflo(v.x) * sc, bfhi(v.x) * sc); rv.y = pk2(bflo(v.y) * sc, bfhi(v.y) * sc); rv.z = pk2(bflo(v.z) * sc, bfhi(v.z) * sc); rv.w = pk2(bflo(v.w) * sc, bfhi(v.w) * sc); }
                PREP_EMIT(i, rv); }
        } else {
            const float sc = kind == 2 ? 0.08838834764831845f : 1.f; const int odd = cg & 1;
            float inv[8];
#pragma unroll
            for (int e = 0; e < 8; ++e) inv[e] = exp2f(-(float)(8 * (c & 3) + e) * (13.287712379549449f / 32.f));
#pragma unroll
            for (int i = 0; i < 8; ++i) { const int tk = r8 + 8 * i, t = t0 + tk; const float pos = odd ? (float)(t & 63) : (float)(t >> 6);
                const u32x4 vo = *(const LAS u32x4*)(tile + tk * 64 + 8 * c), vp = *(const LAS u32x4*)(tile + tk * 64 + 8 * (c ^ 4));
                float o[8], p[8], rr[8];
                o[0] = bflo(vo.x); o[1] = bfhi(vo.x); o[2] = bflo(vo.y); o[3] = bfhi(vo.y); o[4] = bflo(vo.z); o[5] = bfhi(vo.z); o[6] = bflo(vo.w); o[7] = bfhi(vo.w);
                p[0] = bflo(vp.x); p[1] = bfhi(vp.x); p[2] = bflo(vp.y); p[3] = bfhi(vp.y); p[4] = bflo(vp.z); p[5] = bfhi(vp.z); p[6] = bflo(vp.w); p[7] = bfhi(vp.w);
#pragma unroll
                for (int e = 0; e < 8; ++e) { const float ang = pos * inv[e], cs = __cosf(ang), sn = __sinf(ang);
                    rr[e] = (c < 4 ? o[e] * cs - p[e] * sn : p[e] * sn + o[e] * cs) * sc; }
                u32x4 rv; rv.x = pk2(rr[0], rr[1]); rv.y = pk2(rr[2], rr[3]); rv.z = pk2(rr[4], rr[5]); rv.w = pk2(rr[6], rr[7]); PREP_EMIT(i, rv); }
        }
        if (trrow >= 0) {
            LDS_WAIT(); asm volatile("" ::: "memory");
            bf16_t* dst = TR + (size_t)(trrow + lane) * M + m0;
#pragma unroll
            for (int j = 0; j < 8; ++j) { unsigned wv[4];
#pragma unroll
                for (int q = 0; q < 4; ++q) { const unsigned lo = otile[(8 * j + 2 * q) * 64 + lane], hi = otile[(8 * j + 2 * q + 1) * 64 + lane]; wv[q] = lo | (hi << 16); }
                u32x4 o; o.x = wv[0]; o.y = wv[1]; o.z = wv[2]; o.w = wv[3]; *(u32x4*)(dst + 8 * j) = o; }
        }
        LDS_WAIT(); asm volatile("" ::: "memory");
    }
}

struct MlGate { float lf0, lf1, ig0, ig1, P0, P1, tot; };
__device__ __forceinline__ float wave_incl_scan(float v, int lane) {
#pragma unroll
    for (int o = 1; o < 64; o <<= 1) { const float t = __shfl_up(v, o); if (lane >= o) v += t; }
    return v;
}
__device__ __forceinline__ float wave_max(float v) {
#pragma unroll
    for (int o = 1; o < 64; o <<= 1) v = fmaxf(v, __shfl_xor(v, o));
    return v;
}
__device__ __forceinline__ MlGate ml_gates(const Args& a, int layer, int row0, int hh, int dir, int lane) {
    const float* SMALL = (const float*)(a.ws + WS_SMALL);
    const float ib = a.in[36][layer * 8 + dir * 4 + hh], fb = a.in[37][layer * 8 + dir * 4 + hh];
    MlGate g;
    const float f0 = SMALL[(size_t)(row0 + lane) * 32 + S_MF + dir * 4 + hh] + fb, f1 = SMALL[(size_t)(row0 + lane + 64) * 32 + S_MF + dir * 4 + hh] + fb;
    g.ig0 = SMALL[(size_t)(row0 + lane) * 32 + S_MI + dir * 4 + hh] + ib; g.ig1 = SMALL[(size_t)(row0 + lane + 64) * 32 + S_MI + dir * 4 + hh] + ib;
    g.lf0 = fminf(f0, 0.f) - log1pf(__expf(-fabsf(f0))); g.lf1 = fminf(f1, 0.f) - log1pf(__expf(-fabsf(f1)));
    const float s0 = wave_incl_scan(g.lf0, lane); const float tot0 = __shfl(s0, 63);
    const float s1 = wave_incl_scan(g.lf1, lane) + tot0;
    g.P0 = s0; g.P1 = s1; g.tot = __shfl(s1, 63);
    return g;
}

__device__ __forceinline__ void ml_states_phase(const Args& a, int layer, int tid_, int G) {
    int tid = tid_; asm volatile("" : "+v"(tid));
    const int lane = tid & 63, wave = __builtin_amdgcn_readfirstlane(tid >> 6), fr = lane & 15, fq = lane >> 4;
    const bf16_t* TR = (const bf16_t*)(a.ws + WS_TR);
    float* MLC = (float*)(a.ws + WS_MLC); float* MLN = (float*)(a.ws + WS_MLN); float* MLS = (float*)(a.ws + WS_MLS);
    for (int u = blockIdx.x; u < NCH * 4; u += G) {
        const int ch = u >> 2, hh = u & 3; int row0, seq0, L, lat, b, ci, nc; chunk_info(ch, row0, seq0, L, lat, b, ci, nc);
#pragma unroll 1
        for (int dir = 0; dir < 2; ++dir) {
            const MlGate g = ml_gates(a, layer, row0, hh, dir, lane);
            const float w0 = (dir == 0 ? g.tot - g.P0 : g.P0 - g.lf0) + g.ig0, w1 = (dir == 0 ? g.tot - g.P1 : g.P1 - g.lf1) + g.ig1;
            const float mloc = wave_max(fmaxf(w0, w1));
            const float e0 = __expf(w0 - mloc), e1 = __expf(w1 - mloc);
            f32x4 acc[8];
#pragma unroll
            for (int j = 0; j < 8; ++j) acc[j] = (f32x4){0.f, 0.f, 0.f, 0.f};
            float nacc[8];
#pragma unroll
            for (int j = 0; j < 8; ++j) nacc[j] = 0.f;
            const bf16_t* vrow = TR + (size_t)(T_MV + hh * 128 + wave * 16 + fr) * M + row0 + 8 * fq;
#pragma unroll
            for (int ks = 0; ks < 4; ++ks) {
                const bf16x8 af = *(const bf16x8*)(vrow + 32 * ks);
                float ev[8];
#pragma unroll
                for (int j = 0; j < 8; ++j) { const int tok = 32 * ks + 8 * fq + j; const float x0 = __shfl(e0, tok & 63), x1 = __shfl(e1, tok & 63); ev[j] = tok < 64 ? x0 : x1; }
#pragma unroll
                for (int jt = 0; jt < 8; ++jt) {
                    const u32x4 kv = *(const u32x4*)(TR + (size_t)(T_K + hh * 128 + jt * 16 + fr) * M + row0 + 32 * ks + 8 * fq);
                    const float k0 = bflo(kv.x) * ev[0], k1 = bfhi(kv.x) * ev[1], k2 = bflo(kv.y) * ev[2], k3 = bfhi(kv.y) * ev[3], k4 = bflo(kv.z) * ev[4], k5 = bfhi(kv.z) * ev[5], k6 = bflo(kv.w) * ev[6], k7 = bfhi(kv.w) * ev[7];
                    if (wave == 0) nacc[jt] += ((k0 + k1) + (k2 + k3)) + ((k4 + k5) + (k6 + k7));
                    u32x4 kb; kb.x = pk2(k0, k1); kb.y = pk2(k2, k3); kb.z = pk2(k4, k5); kb.w = pk2(k6, k7);
                    acc[jt] = mfma16(af, __builtin_bit_cast(bf16x8, kb), acc[jt]);
                }
            }
            float* cdst = MLC + ((size_t)(ch * 4 + hh) * 2 + dir) * 16384;
#pragma unroll
            for (int jt = 0; jt < 8; ++jt)
#pragma unroll
                for (int i = 0; i < 4; ++i) cdst[(size_t)(wave * 16 + 4 * fq + i) * 128 + jt * 16 + fr] = acc[jt][i];
            if (wave == 0) {
#pragma unroll
                for (int jt = 0; jt < 8; ++jt) { float v = nacc[jt]; v += __shfl_xor(v, 16); v += __shfl_xor(v, 32); if (fq == 0) MLN[((size_t)(ch * 4 + hh) * 2 + dir) * 128 + jt * 16 + fr] = v; }
                if (lane == 0) { MLS[((size_t)(ch * 4 + hh) * 2 + dir) * 4 + 0] = mloc; MLS[((size_t)(ch * 4 + hh) * 2 + dir) * 4 + 1] = g.tot; }
            }
        }
    }
}
__device__ __forceinline__ void ml_scan_phase(const Args& a, int layer, int tid_, int G) {
    int tid = tid_; asm volatile("" : "+v"(tid));
    const float* MLC = (const float*)(a.ws + WS_MLC); const float* MLN = (const float*)(a.ws + WS_MLN); const float* MLS = (const float*)(a.ws + WS_MLS);
    bf16_t* CS = (bf16_t*)(a.ws + WS_MLCS); float* NS = (float*)(a.ws + WS_MLNS); float* MS = (float*)(a.ws + WS_MLMS);
    for (int task = blockIdx.x; task < 256; task += G) {
        int lat, b, hh, dir, part, nparts;
        if (task < 128) { lat = 1; part = task & 3; dir = (task >> 2) & 1; hh = (task >> 3) & 3; b = task >> 5; nparts = 4; }
        else { const int t2 = task - 128; lat = 0; part = 0; dir = t2 & 1; hh = (t2 >> 1) & 3; b = t2 >> 3; nparts = 1; }
        const int nc = lat ? 16 : 2, ch0 = lat ? 32 + b * 16 : b * 2;
        const int nel = 16384 / nparts, e0 = part * nel, per = nel / NT;
        float c[32]; float n = 0.f, m = 0.f;
        const size_t so = (((size_t)b * DEPTH + layer) * 2 + dir) * 4 + hh;
#pragma unroll
        for (int i = 0; i < 32; ++i) if (i < per) { const int e = e0 + i * NT + tid, vd = e >> 7, kd = e & 127; c[i] = lat ? a.in[7][(so * 128 + kd) * 128 + vd] : 0.f; }
        if (tid < 128) n = lat ? a.in[8][so * 128 + tid] : 0.f;
        m = lat ? a.in[9][so] : 0.f;
        float nx[32]; float nn = 0.f, nml = 0.f, nbl = 0.f;
        { const int ch = ch0 + (dir ? nc - 1 : 0); const size_t sb = (size_t)(ch * 4 + hh) * 2 + dir;
#pragma unroll
            for (int i = 0; i < 32; ++i) if (i < per) nx[i] = MLC[sb * 16384 + e0 + i * NT + tid];
            if (tid < 128) nn = MLN[sb * 128 + tid]; nml = MLS[sb * 4 + 0]; nbl = MLS[sb * 4 + 1]; }
        for (int s = 0; s < nc; ++s) { const int ci = dir ? nc - 1 - s : s, ch = ch0 + ci; const size_t sb = (size_t)(ch * 4 + hh) * 2 + dir;
            float cx[32];
#pragma unroll
            for (int i = 0; i < 32; ++i) if (i < per) cx[i] = nx[i];
            const float cn = nn, ml = nml, bl = nbl;
            if (s + 1 < nc) { const int ch2 = ch0 + (dir ? nc - 2 - s : s + 1); const size_t sb2 = (size_t)(ch2 * 4 + hh) * 2 + dir;
#pragma unroll
                for (int i = 0; i < 32; ++i) if (i < per) nx[i] = MLC[sb2 * 16384 + e0 + i * NT + tid];
                if (tid < 128) nn = MLN[sb2 * 128 + tid]; nml = MLS[sb2 * 4 + 0]; nbl = MLS[sb2 * 4 + 1]; }
#pragma unroll
            for (int i = 0; i < 32; ++i) if (i < per) CS[sb * 16384 + e0 + i * NT + tid] = f2bf(c[i]);
            if (part == 0) { if (tid < 128) NS[sb * 128 + tid] = n; if (tid == 0) MS[sb] = m; }
            const float mn = fmaxf(bl + m, ml), fa = __expf(bl + m - mn), fb = __expf(ml - mn);
#pragma unroll
            for (int i = 0; i < 32; ++i) if (i < per) c[i] = fa * c[i] + fb * cx[i];
            if (tid < 128) n = fa * n + fb * cn;
            m = mn; }
        if (!lat) {
#pragma unroll
            for (int i = 0; i < 32; ++i) if (i < per) { const int e = e0 + i * NT + tid, vd = e >> 7, kd = e & 127; a.out[O_MLC + (so * 128 + kd) * 128 + vd] = c[i]; }
            if (tid < 128) a.out[O_MLN + so * 128 + tid] = n; if (tid == 0) a.out[O_MLM + so] = m; }
    }
}
__device__ __forceinline__ void ml_out_phase(const Args& a, int layer, LAS unsigned char* lds, int tid_, int G) {
    int tid = tid_; asm volatile("" : "+v"(tid));
    const int lane = tid & 63, wave = __builtin_amdgcn_readfirstlane(tid >> 6), fr = lane & 15, fq = lane >> 4;
    const bf16_t* NAT = (const bf16_t*)(a.ws + WS_NAT); const bf16_t* TR = (const bf16_t*)(a.ws + WS_TR); const bf16_t* PROJ = (const bf16_t*)(a.ws + WS_PROJ);
    const bf16_t* CS = (const bf16_t*)(a.ws + WS_MLCS); const float* NS = (const float*)(a.ws + WS_MLNS); const float* MS = (const float*)(a.ws + WS_MLMS);
    bf16_t* BR = (bf16_t*)(a.ws + WS_BR);
    LAS float* U = (LAS float*)lds; LAS float* Wv = U + 128; LAS float* SI = U + 256; LAS float* EM = U + 384; LAS float* NSs = U + 512;
    for (int u = blockIdx.x; u < NCH * 4; u += G) {
        const int ch = u >> 2, hh = u & 3; int row0, seq0, L, lat, b, ci, nc; chunk_info(ch, row0, seq0, L, lat, b, ci, nc);
        const int t = wave * 16 + fr;
        bf16x8 qf[4];
#pragma unroll
        for (int ks = 0; ks < 4; ++ks) qf[ks] = *(const bf16x8*)(NAT + (size_t)(row0 + t) * NATP + N_Q + hh * 128 + 32 * ks + 8 * fq);
        f32x4 hsum[8];
#pragma unroll
        for (int j = 0; j < 8; ++j) hsum[j] = (f32x4){0.f, 0.f, 0.f, 0.f};
#pragma unroll 1
        for (int dir = 0; dir < 2; ++dir) {
            const size_t sb = (size_t)(ch * 4 + hh) * 2 + dir;
            __syncthreads();
            if (wave == 0) {
                const MlGate g = ml_gates(a, layer, row0, hh, dir, lane); const float ms = MS[sb];
                float u0, u1, c0, c1, ai0, ai1;
                if (dir == 0) { u0 = g.ig0 - g.P0; u1 = g.ig1 - g.P1; c0 = g.P0; c1 = g.P1; ai0 = g.P0 + ms; ai1 = g.P1 + ms; }
                else { const float E0 = g.P0 - g.lf0, E1 = g.P1 - g.lf1; u0 = E0 + g.ig0; u1 = E1 + g.ig1; c0 = -E0; c1 = -E1; ai0 = g.tot - E0 + ms; ai1 = g.tot - E1 + ms; }
                float g0 = u0, g1 = u1;
                if (dir == 0) {
#pragma unroll
                    for (int o = 1; o < 64; o <<= 1) { const float x0 = __shfl_up(g0, o), x1 = __shfl_up(g1, o); if (lane >= o) { g0 = fmaxf(g0, x0); g1 = fmaxf(g1, x1); } }
                    g1 = fmaxf(g1, __shfl(g0, 63));
                } else {
#pragma unroll
                    for (int o = 1; o < 64; o <<= 1) { const float x0 = __shfl_down(g0, o), x1 = __shfl_down(g1, o); if (lane + o < 64) { g0 = fmaxf(g0, x0); g1 = fmaxf(g1, x1); } }
                    g0 = fmaxf(g0, __shfl(g1, 0));
                }
                const float mt0 = fmaxf(ai0, c0 + g0), mt1 = fmaxf(ai1, c1 + g1);
                U[lane] = u0; U[lane + 64] = u1; Wv[lane] = c0 - mt0; Wv[lane + 64] = c1 - mt1;
                SI[lane] = __expf(ai0 - mt0); SI[lane + 64] = __expf(ai1 - mt1); EM[lane] = __expf(-mt0); EM[lane + 64] = __expf(-mt1);
                NSs[lane] = NS[sb * 128 + lane]; NSs[lane + 64] = NS[sb * 128 + lane + 64];
            }
            __syncthreads();
            const float wt = Wv[t], sit = SI[t], emt = EM[t];
            f32x4 acc[8];
#pragma unroll
            for (int j = 0; j < 8; ++j) acc[j] = (f32x4){0.f, 0.f, 0.f, 0.f};
#pragma unroll
            for (int ks = 0; ks < 4; ++ks)
#pragma unroll
                for (int j = 0; j < 8; ++j) { const bf16x8 cf = *(const bf16x8*)(CS + sb * 16384 + (size_t)(16 * j + fr) * 128 + 32 * ks + 8 * fq); acc[j] = mfma16(cf, qf[ks], acc[j]); }
            float qn = 0.f;
#pragma unroll
            for (int ks = 0; ks < 4; ++ks) { const u32x4 qv = __builtin_bit_cast(u32x4, qf[ks]); const LAS float* nn = NSs + 32 * ks + 8 * fq;
                qn += bflo(qv.x) * nn[0] + bfhi(qv.x) * nn[1] + bflo(qv.y) * nn[2] + bfhi(qv.y) * nn[3] + bflo(qv.z) * nn[4] + bfhi(qv.z) * nn[5] + bflo(qv.w) * nn[6] + bfhi(qv.w) * nn[7]; }
            qn += __shfl_xor(qn, 16); qn += __shfl_xor(qn, 32);
#pragma unroll
            for (int j = 0; j < 8; ++j) acc[j] *= sit;
            float den = sit * qn;
            const int jlo = dir == 0 ? 0 : (wave >> 1), jhi = dir == 0 ? (wave >> 1) : 3;
            float psum = 0.f;
            for (int jp = jlo; jp <= jhi; ++jp) {
                const int ta = 32 * jp + 8 * (fr >> 2) + (fr & 3);
                f32x4 sa = (f32x4){0.f, 0.f, 0.f, 0.f}, sb2 = (f32x4){0.f, 0.f, 0.f, 0.f};
#pragma unroll
                for (int ks = 0; ks < 4; ++ks) {
                    const bf16x8 ka = *(const bf16x8*)(NAT + (size_t)(row0 + ta) * NATP + N_K + hh * 128 + 32 * ks + 8 * fq);
                    const bf16x8 kb = *(const bf16x8*)(NAT + (size_t)(row0 + ta + 4) * NATP + N_K + hh * 128 + 32 * ks + 8 * fq);
                    sa = mfma16(ka, qf[ks], sa); sb2 = mfma16(kb, qf[ks], sb2); }
                float pa[4], pb[4];
#pragma unroll
                for (int i = 0; i < 4; ++i) { const int s0 = 32 * jp + 8 * fq + i, s1 = s0 + 4;
                    const bool ok0 = dir == 0 ? s0 <= t : s0 >= t, ok1 = dir == 0 ? s1 <= t : s1 >= t;
                    pa[i] = ok0 ? sa[i] * __expf(U[s0] + wt) : 0.f; pb[i] = ok1 ? sb2[i] * __expf(U[s1] + wt) : 0.f;
                    psum += pa[i] + pb[i]; }
                u32x4 pw; pw.x = pk2(pa[0], pa[1]); pw.y = pk2(pa[2], pa[3]); pw.z = pk2(pb[0], pb[1]); pw.w = pk2(pb[2], pb[3]);
                const bf16x8 pf = __builtin_bit_cast(bf16x8, pw);
#pragma unroll
                for (int j = 0; j < 8; ++j) { const bf16x8 vf = *(const bf16x8*)(TR + (size_t)(T_MV + hh * 128 + 16 * j + fr) * M + row0 + 32 * jp + 8 * fq); acc[j] = mfma16(vf, pf, acc[j]); }
            }
            psum += __shfl_xor(psum, 16); psum += __shfl_xor(psum, 32);
            den += psum;
            const float rden = 1.f / fmaxf(fabsf(den), emt);
#pragma unroll
            for (int j = 0; j < 8; ++j) hsum[j] += acc[j] * rden;
        }
        float ss = 0.f;
#pragma unroll
        for (int j = 0; j < 8; ++j) ss += (hsum[j][0] * hsum[j][0] + hsum[j][1] * hsum[j][1]) + (hsum[j][2] * hsum[j][2] + hsum[j][3] * hsum[j][3]);
        ss += __shfl_xor(ss, 16); ss += __shfl_xor(ss, 32);
        const float r = rsqrtf(ss * (1.f / 128.f) + 1e-6f);
        const float* ng = a.in[38] + layer * 512 + hh * 128;
#pragma unroll
        for (int j = 0; j < 8; ++j) { const int vd = 16 * j + 4 * fq; const f32x4 gg = *(const f32x4*)(ng + vd);
            const u32x2 ov = *(const u32x2*)(PROJ + (size_t)(row0 + t) * PJ + P_MO + hh * 128 + vd);
            const float o0 = hsum[j][0] * r * gg[0] * fsigm(bflo(ov.x)), o1 = hsum[j][1] * r * gg[1] * fsigm(bfhi(ov.x)), o2 = hsum[j][2] * r * gg[2] * fsigm(bflo(ov.y)), o3 = hsum[j][3] * r * gg[3] * fsigm(bfhi(ov.y));
            u32x2 w; w.x = pk2(o0, o1); w.y = pk2(o2, o3); *(u32x2*)(BR + (size_t)(row0 + t) * D + 1536 + hh * 128 + vd) = w; }
    }
}
}
namespace mk {
constexpr size_t WS_SST = WS_OPT_END;
constexpr size_t WS_SSL = AL(WS_SST + (size_t)NCH * 8 * 2 * 8192 * 4);
constexpr size_t WS_SSCS = AL(WS_SSL + (size_t)NCH * 8 * 2 * 4);
constexpr size_t WS_YPRE = AL(WS_SSCS + (size_t)NCH * 8 * 2 * 8192 * 2);
constexpr size_t WS_SSQ = AL(WS_YPRE + (size_t)M * 512 * 4);
constexpr size_t WS_SSD_END = AL(WS_SSQ + (size_t)M * 8 * 4);

struct SsdGate { float dt0, dt1, la0, la1, P0, P1, tot; };
__device__ __forceinline__ SsdGate ssd_gates(const Args& a, int layer, int row0, int hh, int dir, int lane) {
    const float* SMALL = (const float*)(a.ws + WS_SMALL);
    const float bias = a.in[32][layer * 16 + dir * 8 + hh], A = -__expf(a.in[33][layer * 16 + dir * 8 + hh]);
    SsdGate g;
    const float x0 = SMALL[(size_t)(row0 + lane) * 32 + S_DT + dir * 8 + hh] + bias, x1 = SMALL[(size_t)(row0 + lane + 64) * 32 + S_DT + dir * 8 + hh] + bias;
    g.dt0 = fmaxf(x0, 0.f) + log1pf(__expf(-fabsf(x0))); g.dt1 = fmaxf(x1, 0.f) + log1pf(__expf(-fabsf(x1)));
    g.la0 = g.dt0 * A; g.la1 = g.dt1 * A;
    const float s0 = wave_incl_scan(g.la0, lane); const float t0 = __shfl(s0, 63);
    const float s1 = wave_incl_scan(g.la1, lane) + t0;
    g.P0 = s0; g.P1 = s1; g.tot = __shfl(s1, 63);
    return g;
}
__device__ __forceinline__ void ssd_states_phase(const Args& a, int layer, int tid_, int G) {
    int tid = tid_; asm volatile("" : "+v"(tid));
    const int lane = tid & 63, wave = __builtin_amdgcn_readfirstlane(tid >> 6), fr = lane & 15, fq = lane >> 4;
    const bf16_t* TR = (const bf16_t*)(a.ws + WS_TR); float* SST = (float*)(a.ws + WS_SST); float* SSL = (float*)(a.ws + WS_SSL);
    for (int u = blockIdx.x; u < NCH * 8; u += G) {
        const int ch = u >> 3, hh = u & 7, grp = hh >> 2; int row0, seq0, L, lat, b, ci, nc; chunk_info(ch, row0, seq0, L, lat, b, ci, nc);
#pragma unroll 1
        for (int dir = 0; dir < 2; ++dir) {
            const SsdGate g = ssd_gates(a, layer, row0, hh, dir, lane);
            const float w0 = g.dt0 * __expf(dir == 0 ? g.tot - g.P0 : g.P0 - g.la0), w1 = g.dt1 * __expf(dir == 0 ? g.tot - g.P1 : g.P1 - g.la1);
            f32x4 acc[4];
#pragma unroll
            for (int j = 0; j < 4; ++j) acc[j] = (f32x4){0.f, 0.f, 0.f, 0.f};
#pragma unroll
            for (int ks = 0; ks < 4; ++ks) {
                float ev[8];
#pragma unroll
                for (int j = 0; j < 8; ++j) { const int tok = 32 * ks + 8 * fq + j; const float y0 = __shfl(w0, tok & 63), y1 = __shfl(w1, tok & 63); ev[j] = tok < 64 ? y0 : y1; }
                const u32x4 bv = *(const u32x4*)(TR + (size_t)(T_B + grp * 128 + wave * 16 + fr) * M + row0 + 32 * ks + 8 * fq);
                u32x4 bw; bw.x = pk2(bflo(bv.x) * ev[0], bfhi(bv.x) * ev[1]); bw.y = pk2(bflo(bv.y) * ev[2], bfhi(bv.y) * ev[3]); bw.z = pk2(bflo(bv.z) * ev[4], bfhi(bv.z) * ev[5]); bw.w = pk2(bflo(bv.w) * ev[6], bfhi(bv.w) * ev[7]);
                const bf16x8 bf = __builtin_bit_cast(bf16x8, bw);
#pragma unroll
                for (int j = 0; j < 4; ++j) { const bf16x8 xf = *(const bf16x8*)(TR + (size_t)(T_X + hh * 64 + 16 * j + fr) * M + row0 + 32 * ks + 8 * fq); acc[j] = mfma16(xf, bf, acc[j]); }
            }
            float* dst = SST + ((size_t)(ch * 8 + hh) * 2 + dir) * 8192;
#pragma unroll
            for (int j = 0; j < 4; ++j)
#pragma unroll
                for (int i = 0; i < 4; ++i) dst[(size_t)(16 * j + 4 * fq + i) * 128 + wave * 16 + fr] = acc[j][i];
            if (tid == 0) SSL[(size_t)(ch * 8 + hh) * 2 + dir] = g.tot;
        }
    }
}
__device__ __forceinline__ void ssd_scan_phase(const Args& a, int layer, int tid_, int G) {
    int tid = tid_; asm volatile("" : "+v"(tid));
    const float* SST = (const float*)(a.ws + WS_SST); const float* SSL = (const float*)(a.ws + WS_SSL); bf16_t* CS = (bf16_t*)(a.ws + WS_SSCS);
    for (int task = blockIdx.x; task < 384; task += G) {
        int lat, b, hh, dir, part, nparts;
        if (task < 128) { lat = 1; part = task & 1; dir = (task >> 1) & 1; hh = (task >> 2) & 7; b = task >> 5; nparts = 2; }
        else { const int t2 = task - 128; lat = 0; part = 0; dir = t2 & 1; hh = (t2 >> 1) & 7; b = t2 >> 4; nparts = 1; }
        const int nc = lat ? 16 : 2, ch0 = lat ? 32 + b * 16 : b * 2;
        const int nel = 8192 / nparts, e0 = part * nel, per = nel / NT;
        float c[16];
        const size_t so = ((((size_t)b * DEPTH + layer) * 2 + dir) * 8 + hh) * 8192;
#pragma unroll
        for (int i = 0; i < 16; ++i) if (i < per) c[i] = lat ? a.in[6][so + e0 + i * NT + tid] : 0.f;
        float nx[16]; float ntot;
        { const int ch = ch0 + (dir ? nc - 1 : 0); const size_t sb = (size_t)(ch * 8 + hh) * 2 + dir;
#pragma unroll
            for (int i = 0; i < 16; ++i) if (i < per) nx[i] = SST[sb * 8192 + e0 + i * NT + tid];
            ntot = SSL[sb]; }
        for (int s = 0; s < nc; ++s) { const int ci = dir ? nc - 1 - s : s, ch = ch0 + ci; const size_t sb = (size_t)(ch * 8 + hh) * 2 + dir;
            float cx[16];
#pragma unroll
            for (int i = 0; i < 16; ++i) if (i < per) cx[i] = nx[i];
            const float dec = __expf(ntot);
            if (s + 1 < nc) { const int ch2 = ch0 + (dir ? nc - 2 - s : s + 1); const size_t sb2 = (size_t)(ch2 * 8 + hh) * 2 + dir;
#pragma unroll
                for (int i = 0; i < 16; ++i) if (i < per) nx[i] = SST[sb2 * 8192 + e0 + i * NT + tid];
                ntot = SSL[sb2]; }
#pragma unroll
            for (int i = 0; i < 16; ++i) if (i < per) CS[sb * 8192 + e0 + i * NT + tid] = f2bf(c[i]);
#pragma unroll
            for (int i = 0; i < 16; ++i) if (i < per) c[i] = dec * c[i] + cx[i]; }
        if (!lat) {
#pragma unroll
            for (int i = 0; i < 16; ++i) if (i < per) a.out[O_SSD + so + e0 + i * NT + tid] = c[i]; }
    }
}
__device__ __forceinline__ void ssd_out_phase(const Args& a, int layer, LAS unsigned char* lds, int tid_, int G) {
    int tid = tid_; asm volatile("" : "+v"(tid));
    const int lane = tid & 63, wave = __builtin_amdgcn_readfirstlane(tid >> 6), fr = lane & 15, fq = lane >> 4;
    const bf16_t* NAT = (const bf16_t*)(a.ws + WS_NAT); const bf16_t* TR = (const bf16_t*)(a.ws + WS_TR); const bf16_t* PROJ = (const bf16_t*)(a.ws + WS_PROJ);
    const bf16_t* CS = (const bf16_t*)(a.ws + WS_SSCS); float* YPRE = (float*)(a.ws + WS_YPRE); float* SSQ = (float*)(a.ws + WS_SSQ);
    LAS float* U = (LAS float*)(lds + 4096); LAS float* Wv = U + 128; LAS float* DT = U + 256; LAS float* EO = U + 384;
    for (int u = blockIdx.x; u < NCH * 8; u += G) {
        const int ch = u >> 3, hh = u & 7, grp = hh >> 2; int row0, seq0, L, lat, b, ci, nc; chunk_info(ch, row0, seq0, L, lat, b, ci, nc);
        const int t = wave * 16 + fr;
        bf16x8 cf[4];
#pragma unroll
        for (int ks = 0; ks < 4; ++ks) cf[ks] = *(const bf16x8*)(NAT + (size_t)(row0 + t) * NATP + N_XBC + 768 + grp * 128 + 32 * ks + 8 * fq);
        f32x4 ysum[4];
#pragma unroll
        for (int j = 0; j < 4; ++j) ysum[j] = (f32x4){0.f, 0.f, 0.f, 0.f};
#pragma unroll 1
        for (int dir = 0; dir < 2; ++dir) {
            const size_t sb = (size_t)(ch * 8 + hh) * 2 + dir;
            __syncthreads();
            if (wave == 0) {
                const SsdGate g = ssd_gates(a, layer, row0, hh, dir, lane);
                if (dir == 0) { U[lane] = -g.P0; U[lane + 64] = -g.P1; Wv[lane] = g.P0; Wv[lane + 64] = g.P1; EO[lane] = __expf(g.P0); EO[lane + 64] = __expf(g.P1); }
                else { const float E0 = g.P0 - g.la0, E1 = g.P1 - g.la1; U[lane] = E0; U[lane + 64] = E1; Wv[lane] = -E0; Wv[lane + 64] = -E1; EO[lane] = __expf(g.tot - E0); EO[lane + 64] = __expf(g.tot - E1); }
                DT[lane] = g.dt0; DT[lane + 64] = g.dt1;
            }
            __syncthreads();
            const float wt = Wv[t], eot = EO[t];
            f32x4 acc[4];
#pragma unroll
            for (int j = 0; j < 4; ++j) acc[j] = (f32x4){0.f, 0.f, 0.f, 0.f};
#pragma unroll
            for (int ks = 0; ks < 4; ++ks)
#pragma unroll
                for (int j = 0; j < 4; ++j) { const bf16x8 sf = *(const bf16x8*)(CS + sb * 8192 + (size_t)(16 * j + fr) * 128 + 32 * ks + 8 * fq); acc[j] = mfma16(sf, cf[ks], acc[j]); }
#pragma unroll
            for (int j = 0; j < 4; ++j) acc[j] *= eot;
            const int jlo = dir == 0 ? 0 : (wave >> 1), jhi = dir == 0 ? (wave >> 1) : 3;
            for (int jp = jlo; jp <= jhi; ++jp) {
                const int ta = 32 * jp + 8 * (fr >> 2) + (fr & 3);
                f32x4 sa = (f32x4){0.f, 0.f, 0.f, 0.f}, sb2 = (f32x4){0.f, 0.f, 0.f, 0.f};
#pragma unroll
                for (int ks = 0; ks < 4; ++ks) {
                    const bf16x8 ba = *(const bf16x8*)(NAT + (size_t)(row0 + ta) * NATP + N_XBC + 512 + grp * 128 + 32 * ks + 8 * fq);
                    const bf16x8 bb = *(const bf16x8*)(NAT + (size_t)(row0 + ta + 4) * NATP + N_XBC + 512 + grp * 128 + 32 * ks + 8 * fq);
                    sa = mfma16(ba, cf[ks], sa); sb2 = mfma16(bb, cf[ks], sb2); }
                float pa[4], pb[4];
#pragma unroll
                for (int i = 0; i < 4; ++i) { const int s0 = 32 * jp + 8 * fq + i, s1 = s0 + 4;
                    const bool ok0 = dir == 0 ? s0 <= t : s0 >= t, ok1 = dir == 0 ? s1 <= t : s1 >= t;
                    pa[i] = ok0 ? sa[i] * DT[s0] * __expf(U[s0] + wt) : 0.f; pb[i] = ok1 ? sb2[i] * DT[s1] * __expf(U[s1] + wt) : 0.f; }
                u32x4 pw; pw.x = pk2(pa[0], pa[1]); pw.y = pk2(pa[2], pa[3]); pw.z = pk2(pb[0], pb[1]); pw.w = pk2(pb[2], pb[3]);
                const bf16x8 pf = __builtin_bit_cast(bf16x8, pw);
#pragma unroll
                for (int j = 0; j < 4; ++j) { const bf16x8 xf = *(const bf16x8*)(TR + (size_t)(T_X + hh * 64 + 16 * j + fr) * M + row0 + 32 * jp + 8 * fq); acc[j] = mfma16(xf, pf, acc[j]); }
            }
#pragma unroll
            for (int j = 0; j < 4; ++j) ysum[j] += acc[j];
        }
        const float Dh = a.in[34][layer * 8 + hh]; float ss = 0.f;
#pragma unroll
        for (int j = 0; j < 4; ++j) { const int p = 16 * j + 4 * fq;
            const u32x2 xv = *(const u32x2*)(NAT + (size_t)(row0 + t) * NATP + N_XBC + hh * 64 + p), zv = *(const u32x2*)(PROJ + (size_t)(row0 + t) * PJ + P_Z + hh * 64 + p);
            f32x4 y; y[0] = (ysum[j][0] + bflo(xv.x) * Dh) * fsilu(bflo(zv.x)); y[1] = (ysum[j][1] + bfhi(xv.x) * Dh) * fsilu(bfhi(zv.x));
            y[2] = (ysum[j][2] + bflo(xv.y) * Dh) * fsilu(bflo(zv.y)); y[3] = (ysum[j][3] + bfhi(xv.y) * Dh) * fsilu(bfhi(zv.y));
            ss += (y[0] * y[0] + y[1] * y[1]) + (y[2] * y[2] + y[3] * y[3]);
            *(f32x4*)(YPRE + (size_t)(row0 + t) * 512 + hh * 64 + p) = y; }
        ss += __shfl_xor(ss, 16); ss += __shfl_xor(ss, 32);
        if (fq == 0) SSQ[(size_t)(row0 + t) * 8 + hh] = ss;
    }
}
__device__ __forceinline__ void ssd_fin_phase(const Args& a, int layer, int gw, int ngw, int lane_) {
    int lane = lane_; asm volatile("" : "+v"(lane));
    const float* YPRE = (const float*)(a.ws + WS_YPRE); const float* SSQ = (const float*)(a.ws + WS_SSQ); bf16_t* BR = (bf16_t*)(a.ws + WS_BR); const float* ng = a.in[35] + layer * 512;
    for (int row = gw; row < M; row += ngw) {
        float s = lane < 8 ? SSQ[(size_t)row * 8 + lane] : 0.f; s += __shfl_xor(s, 1); s += __shfl_xor(s, 2); s += __shfl_xor(s, 4); s = __shfl(s, 0);
        const float r = rsqrtf(s * (1.f / 512.f) + 1e-6f);
        const f32x4 y0 = *(const f32x4*)(YPRE + (size_t)row * 512 + 8 * lane), y1 = *(const f32x4*)(YPRE + (size_t)row * 512 + 8 * lane + 4);
        const f32x4 g0 = *(const f32x4*)(ng + 8 * lane), g1 = *(const f32x4*)(ng + 8 * lane + 4);
        *(u32x4*)(BR + (size_t)row * D + 1024 + 8 * lane) = pack8(y0 * r * g0, y1 * r * g1);
    }
}
}
namespace mk {
constexpr size_t WS_CK = WS_SSD_END;
constexpr size_t WS_CVT = AL(WS_CK + (size_t)16 * 512 * 512 * 2);
constexpr size_t WS_ATT_END = AL(WS_CVT + (size_t)16 * 512 * 512 * 2);

__device__ __forceinline__ void prologue_cache(const Args& a, int gw, int ngw, int lane) {
    bf16_t* CK = (bf16_t*)(a.ws + WS_CK); bf16_t* CVT = (bf16_t*)(a.ws + WS_CVT);
    for (size_t i = ((size_t)gw * 64 + lane) * 8; i < (size_t)16 * 512 * 512; i += (size_t)ngw * 64 * 8) {
        const f32x4 x0 = *(const f32x4*)(a.in[2] + i), x1 = *(const f32x4*)(a.in[2] + i + 4); *(u32x4*)(CK + i) = pack8(x0, x1); }
    for (size_t i = (size_t)gw * 64 + lane; i < (size_t)16 * 64 * 512; i += (size_t)ngw * 64) { const int c = i & 511, s8 = (i >> 9) & 63, bl = i >> 15;
        const float* src = a.in[3] + ((size_t)bl * 512 + 8 * s8) * 512 + c;
        u32x4 o; o.x = pk2(src[0], src[512]); o.y = pk2(src[1024], src[1536]); o.z = pk2(src[2048], src[2560]); o.w = pk2(src[3072], src[3584]);
        *(u32x4*)(CVT + ((size_t)bl * 512 + c) * 512 + 8 * s8) = o; }
}
struct AttState { float m, l; f32x4 o[4]; };
struct AttFrags { bf16x8 k[4]; const bf16_t* vt; size_t vp; };
__device__ __forceinline__ void attn_load(AttFrags& f, const bf16_t* kbase, size_t kp, const bf16_t* vt, size_t vp, int fr, int fq) {
    const int ra = 8 * (fr >> 2) + (fr & 3);
#pragma unroll
    for (int ks = 0; ks < 2; ++ks) { f.k[ks] = *(const bf16x8*)(kbase + (size_t)ra * kp + 32 * ks + 8 * fq); f.k[2 + ks] = *(const bf16x8*)(kbase + (size_t)(ra + 4) * kp + 32 * ks + 8 * fq); }
    f.vt = vt + (size_t)fr * vp + 8 * fq; f.vp = vp;
}
template <bool MASKED>
__device__ __forceinline__ void attn_compute(AttState& st, const bf16x8 (&qf)[2], const AttFrags& f, int fq, const float* bias, int kc0, int cq, int cs) {
    bf16x8 vf[4];
#pragma unroll
    for (int j = 0; j < 4; ++j) vf[j] = *(const bf16x8*)(f.vt + (size_t)(16 * j) * f.vp);
    f32x4 sa = (f32x4){0.f, 0.f, 0.f, 0.f}, sb = (f32x4){0.f, 0.f, 0.f, 0.f};
#pragma unroll
    for (int ks = 0; ks < 2; ++ks) { sa = mfma16(f.k[ks], qf[ks], sa); sb = mfma16(f.k[2 + ks], qf[ks], sb); }
    float s[8]; float gm = -1e30f;
#pragma unroll
    for (int i = 0; i < 4; ++i) { s[i] = sa[i] * 0.125f; s[4 + i] = sb[i] * 0.125f; }
    if (MASKED) {
#pragma unroll
        for (int e = 0; e < 8; ++e) { const int kc = kc0 + 8 * fq + e; const bool ok = kc >= cs && kc < cs + 16; const int bi = min(max(kc - cq + 15, 0), 30); s[e] = ok ? s[e] + bias[bi] : -1e30f; }
    }
#pragma unroll
    for (int e = 0; e < 8; ++e) gm = fmaxf(gm, s[e]);
    gm = fmaxf(gm, __shfl_xor(gm, 16)); gm = fmaxf(gm, __shfl_xor(gm, 32));
    const float mn = fmaxf(st.m, gm), al = __expf(st.m - mn); st.m = mn;
    float p[8], ps = 0.f;
#pragma unroll
    for (int e = 0; e < 8; ++e) { p[e] = __expf(s[e] - mn); ps += p[e]; }
    st.l = st.l * al + ps;
    u32x4 pw; pw.x = pk2(p[0], p[1]); pw.y = pk2(p[2], p[3]); pw.z = pk2(p[4], p[5]); pw.w = pk2(p[6], p[7]);
    const bf16x8 pf = __builtin_bit_cast(bf16x8, pw);
#pragma unroll
    for (int j = 0; j < 4; ++j) st.o[j] = mfma16(vf[j], pf, st.o[j] * al);
}
__device__ __forceinline__ void attn_phase(const Args& a, int layer, int gw_, int ngw, int lane_) {
    int lane = lane_, gw = gw_; asm volatile("" : "+v"(lane));
    const int fr = lane & 15, fq = lane >> 4;
    const bf16_t* PROJ = (const bf16_t*)(a.ws + WS_PROJ); const bf16_t* TR = (const bf16_t*)(a.ws + WS_TR); bf16_t* BR = (bf16_t*)(a.ws + WS_BR);
    const bf16_t* CK = (const bf16_t*)(a.ws + WS_CK); const bf16_t* CVT = (const bf16_t*)(a.ws + WS_CVT);
    for (int it = gw; it < 6144; it += ngw) {
        AttState st; st.m = -1e30f; st.l = 0.f;
#pragma unroll
        for (int j = 0; j < 4; ++j) st.o[j] = (f32x4){0.f, 0.f, 0.f, 0.f};
        int qrow, hh; AttFrags fa, fb;
        if (it < 4096) {
            const int jq = it & 3, r = (it >> 2) & 31; hh = (it >> 7) & 7; const int b = it >> 10;
            const int seq0 = MP + b * 2048; qrow = seq0 + r * 64 + 16 * jq + fr;
            bf16x8 qf[2];
#pragma unroll
            for (int ks = 0; ks < 2; ++ks) qf[ks] = *(const bf16x8*)(PROJ + (size_t)qrow * PJ + P_Q + hh * 64 + 32 * ks + 8 * fq);
            const int rs = min(max(r - 4, 0), 24), cq = 16 * jq + fr, cs = min(max(cq - 8, 0), 48);
            const int kc0 = jq == 0 ? 0 : (jq == 1 ? 8 : (jq == 2 ? 24 : 32));
            const float* rpb = a.in[19] + ((size_t)layer * 8 + hh) * 15 * 31;
            const bf16_t* kw = PROJ + (size_t)(seq0 + rs * 64 + kc0) * PJ + P_K + hh * 64; const bf16_t* vw = TR + (size_t)(T_V + hh * 64) * M + seq0 + rs * 64 + kc0;
            const size_t cb = ((size_t)b * DEPTH + layer) * 512; const bf16_t* kc = CK + cb * 512 + hh * 64; const bf16_t* vc = CVT + (cb + hh * 64) * 512;
            attn_load(fa, kw, PJ, vw, M, fr, fq);
#pragma unroll 1
            for (int j = 0; j < 8; j += 2) {
                attn_load(fb, kw + (size_t)(j + 1) * 64 * PJ, PJ, vw + (j + 1) * 64, M, fr, fq);
                attn_compute<true>(st, qf, fa, fq, rpb + (rs + j - r + 7) * 31, kc0, cq, cs);
                if (j + 2 < 8) attn_load(fa, kw + (size_t)(j + 2) * 64 * PJ, PJ, vw + (j + 2) * 64, M, fr, fq); else attn_load(fa, kc, 512, vc, 512, fr, fq);
                attn_compute<true>(st, qf, fb, fq, rpb + (rs + j + 1 - r + 7) * 31, kc0, cq, cs);
            }
#pragma unroll 1
            for (int g = 0; g < 16; g += 2) {
                attn_load(fb, kc + (size_t)(32 * (g + 1)) * 512, 512, vc + 32 * (g + 1), 512, fr, fq);
                attn_compute<false>(st, qf, fa, fq, nullptr, 0, 0, 0);
                if (g + 2 < 16) attn_load(fa, kc + (size_t)(32 * (g + 2)) * 512, 512, vc + 32 * (g + 2), 512, fr, fq);
                attn_compute<false>(st, qf, fb, fq, nullptr, 0, 0, 0);
            }
        } else {
            const int i2 = it - 4096, qt = i2 & 15; hh = (i2 >> 4) & 7; const int b = i2 >> 7, seq0 = b * 256; qrow = seq0 + 16 * qt + fr;
            bf16x8 qf[2];
#pragma unroll
            for (int ks = 0; ks < 2; ++ks) qf[ks] = *(const bf16x8*)(PROJ + (size_t)qrow * PJ + P_Q + hh * 64 + 32 * ks + 8 * fq);
            const bf16_t* kp = PROJ + (size_t)seq0 * PJ + P_K + hh * 64; const bf16_t* vp = TR + (size_t)(T_V + hh * 64) * M + seq0;
            attn_load(fa, kp, PJ, vp, M, fr, fq);
#pragma unroll 1
            for (int g = 0; g < 8; g += 2) {
                attn_load(fb, kp + (size_t)(32 * (g + 1)) * PJ, PJ, vp + 32 * (g + 1), M, fr, fq);
                attn_compute<false>(st, qf, fa, fq, nullptr, 0, 0, 0);
                if (g + 2 < 8) attn_load(fa, kp + (size_t)(32 * (g + 2)) * PJ, PJ, vp + 32 * (g + 2), M, fr, fq);
                attn_compute<false>(st, qf, fb, fq, nullptr, 0, 0, 0);
            }
        }
        float l = st.l; l += __shfl_xor(l, 16); l += __shfl_xor(l, 32);
        const float rl = 1.f / l;
#pragma unroll
        for (int j = 0; j < 4; ++j) { u32x2 w; w.x = pk2(st.o[j][0] * rl, st.o[j][1] * rl); w.y = pk2(st.o[j][2] * rl, st.o[j][3] * rl);
            *(u32x2*)(BR + (size_t)qrow * D + hh * 64 + 16 * j + 4 * fq) = w; }
    }
}
}
namespace mk {
constexpr int S5K = 768;
constexpr size_t WS_S5W = WS_ATT_END;
constexpr size_t WS_S5WS = AL(WS_S5W + (size_t)DEPTH * 32 * 512 * S5K * 2);
constexpr size_t WS_S5AP = AL(WS_S5WS + (size_t)DEPTH * 32 * 256 * 512 * 2);
constexpr size_t WS_S5UP = AL(WS_S5AP + (size_t)DEPTH * 32 * 2 * 64 * 2 * 4);
constexpr size_t WS_S5SS = AL(WS_S5UP + (size_t)32 * 384 * 512 * 2);
constexpr size_t WS_S5HS = AL(WS_S5SS + (size_t)32 * 384 * 256 * 4);
constexpr size_t WS_S5_END = AL(WS_S5HS + (size_t)32 * 384 * 256 * 2);

__device__ __forceinline__ void s5_param_task(const Args& a, LAS unsigned char* lds, int tid_, int task) {
    int tid = tid_; asm volatile("" : "+v"(tid));
    LAS float* PW = (LAS float*)lds; LAS float* BB = PW + 2 * 33 * 64 * 2; LAS float* CC = BB + 2 * 64 * 16 * 2; LAS float* KT = CC + 2 * 16 * 64 * 2;
    {
        const int layer = task >> 5, g = task & 31;
        const float* a_re = a.in[20] + layer * 4096; const float* a_im = a.in[21] + layer * 4096; const float* log_dt = a.in[22] + layer * 64;
        const float* b_re = a.in[23] + (size_t)layer * 65536; const float* b_im = a.in[24] + (size_t)layer * 65536; const float* c_re = a.in[25] + (size_t)layer * 65536; const float* c_im = a.in[26] + (size_t)layer * 65536;
        const float* s5d = a.in[27] + layer * 512;
        bf16_t* S5W = (bf16_t*)(a.ws + WS_S5W) + (size_t)layer * 32 * 512 * S5K; bf16_t* S5WS = (bf16_t*)(a.ws + WS_S5WS) + (size_t)layer * 32 * 256 * 512; float* S5AP = (float*)(a.ws + WS_S5AP) + (size_t)layer * 32 * 2 * 64 * 2;
        __syncthreads();
        if (tid < 128) { const int dir = tid >> 6, n = tid & 63, pi = (dir * 32 + g) * 64 + n;
            const float are = fminf(a_re[pi], -1e-4f), aim = a_im[pi], dt = expf(log_dt[dir * 32 + g]);
            const float mag = expf(dt * are), abr = mag * cosf(dt * aim), abi = mag * sinf(dt * aim);
            const float den = are * are + aim * aim, nr = abr - 1.f, cfr = (nr * are + abi * aim) / den, cfi = (abi * are - nr * aim) / den;
            float pr = 1.f, pim = 0.f;
            for (int p = 0; p <= 32; ++p) { PW[((dir * 33 + p) * 64 + n) * 2] = pr; PW[((dir * 33 + p) * 64 + n) * 2 + 1] = pim; const float t = pr * abr - pim * abi; pim = pr * abi + pim * abr; pr = t; }
            S5AP[((g * 2 + dir) * 64 + n) * 2] = PW[((dir * 33 + 32) * 64 + n) * 2]; S5AP[((g * 2 + dir) * 64 + n) * 2 + 1] = PW[((dir * 33 + 32) * 64 + n) * 2 + 1];
            for (int k = 0; k < 16; ++k) { const float br_ = b_re[(size_t)pi * 16 + k], bi_ = b_im[(size_t)pi * 16 + k];
                BB[((dir * 64 + n) * 16 + k) * 2] = cfr * br_ - cfi * bi_; BB[((dir * 64 + n) * 16 + k) * 2 + 1] = cfr * bi_ + cfi * br_; }
            for (int j = 0; j < 16; ++j) { CC[((dir * 64 + n) * 16 + j) * 2] = c_re[((size_t)(dir * 32 + g) * 16 + j) * 64 + n]; CC[((dir * 64 + n) * 16 + j) * 2 + 1] = c_im[((size_t)(dir * 32 + g) * 16 + j) * 64 + n]; }
        }
        __syncthreads();
        for (int e = tid; e < 2 * 32 * 256; e += NT) { const int j = e & 15, k = (e >> 4) & 15, tau = (e >> 8) & 31, dir = e >> 13; float s = 0.f;
            for (int n = 0; n < 64; ++n) { const float cr = CC[((dir * 64 + n) * 16 + j) * 2], ci = CC[((dir * 64 + n) * 16 + j) * 2 + 1], pr = PW[((dir * 33 + tau) * 64 + n) * 2], pim = PW[((dir * 33 + tau) * 64 + n) * 2 + 1];
                const float xr = cr * pr - ci * pim, xi = cr * pim + ci * pr, br_ = BB[((dir * 64 + n) * 16 + k) * 2], bi_ = BB[((dir * 64 + n) * 16 + k) * 2 + 1];
                s += xr * br_ - xi * bi_; }
            KT[e] = s; }
        __syncthreads();
        { const int t = tid >> 4, j = tid & 15; bf16_t* dst = S5W + ((size_t)g * 512 + tid) * S5K;
            for (int s = 0; s < 32; ++s) { float v[16];
#pragma unroll
                for (int k = 0; k < 16; ++k) { float x;
                    if (s < t) x = KT[((0 * 32 + (t - s)) * 16 + k) * 16 + j]; else if (s > t) x = KT[((1 * 32 + (s - t)) * 16 + k) * 16 + j];
                    else x = KT[((0 * 32 + 0) * 16 + k) * 16 + j] + KT[((1 * 32 + 0) * 16 + k) * 16 + j] + (k == j ? s5d[g * 16 + k] : 0.f);
                    v[k] = x; }
                u32x4 o0, o1; o0.x = pk2(v[0], v[1]); o0.y = pk2(v[2], v[3]); o0.z = pk2(v[4], v[5]); o0.w = pk2(v[6], v[7]); o1.x = pk2(v[8], v[9]); o1.y = pk2(v[10], v[11]); o1.z = pk2(v[12], v[13]); o1.w = pk2(v[14], v[15]);
                *(u32x4*)(dst + s * 16) = o0; *(u32x4*)(dst + s * 16 + 8) = o1; }
            for (int dir = 0; dir < 2; ++dir) { const int p = dir == 0 ? t + 1 : 32 - t;
                for (int n8 = 0; n8 < 8; ++n8) { float gr[8], gi[8];
#pragma unroll
                    for (int q = 0; q < 8; ++q) { const int n = n8 * 8 + q; const float cr = CC[((dir * 64 + n) * 16 + j) * 2], ci = CC[((dir * 64 + n) * 16 + j) * 2 + 1], pr = PW[((dir * 33 + p) * 64 + n) * 2], pim = PW[((dir * 33 + p) * 64 + n) * 2 + 1];
                        gr[q] = cr * pr - ci * pim; gi[q] = -(cr * pim + ci * pr); }
                    u32x4 o; o.x = pk2(gr[0], gr[1]); o.y = pk2(gr[2], gr[3]); o.z = pk2(gr[4], gr[5]); o.w = pk2(gr[6], gr[7]); *(u32x4*)(dst + 512 + dir * 128 + n8 * 8) = o;
                    o.x = pk2(gi[0], gi[1]); o.y = pk2(gi[2], gi[3]); o.z = pk2(gi[4], gi[5]); o.w = pk2(gi[6], gi[7]); *(u32x4*)(dst + 512 + dir * 128 + 64 + n8 * 8) = o; } }
        }
        if (tid < 256) { const int dir = tid >> 7, reim = (tid >> 6) & 1, n = tid & 63; bf16_t* dst = S5WS + ((size_t)g * 256 + tid) * 512;
            for (int s = 0; s < 32; ++s) { const int p = dir == 0 ? 31 - s : s; const float pr = PW[((dir * 33 + p) * 64 + n) * 2], pim = PW[((dir * 33 + p) * 64 + n) * 2 + 1]; float v[16];
#pragma unroll
                for (int k = 0; k < 16; ++k) { const float br_ = BB[((dir * 64 + n) * 16 + k) * 2], bi_ = BB[((dir * 64 + n) * 16 + k) * 2 + 1]; v[k] = reim == 0 ? pr * br_ - pim * bi_ : pr * bi_ + pim * br_; }
                u32x4 o0, o1; o0.x = pk2(v[0], v[1]); o0.y = pk2(v[2], v[3]); o0.z = pk2(v[4], v[5]); o0.w = pk2(v[6], v[7]); o1.x = pk2(v[8], v[9]); o1.y = pk2(v[10], v[11]); o1.z = pk2(v[12], v[13]); o1.w = pk2(v[14], v[15]);
                *(u32x4*)(dst + s * 16) = o0; *(u32x4*)(dst + s * 16 + 8) = o1; } }
    }
    __syncthreads();
}
__device__ __forceinline__ void s5_statein_phase(const Args& a, int layer, int gw, int ngw, int lane_) {
    int lane = lane_; asm volatile("" : "+v"(lane));
    const int fr = lane & 15, fq = lane >> 4;
    const bf16_t* UP = (const bf16_t*)(a.ws + WS_S5UP); const bf16_t* S5WS = (const bf16_t*)(a.ws + WS_S5WS) + (size_t)layer * 32 * 256 * 512; float* SS = (float*)(a.ws + WS_S5SS);
    for (int it = ngw - 1 - gw; it < 32 * 24; it += ngw) { const int g = it / 24, r = it % 24, og = r / 6, cq = r % 6;
        f32x4 acc[4][4];
#pragma unroll
        for (int i = 0; i < 4; ++i)
#pragma unroll
            for (int j = 0; j < 4; ++j) acc[i][j] = (f32x4){0.f, 0.f, 0.f, 0.f};
        const bf16_t* ap = S5WS + ((size_t)g * 256 + 64 * og + fr) * 512 + 8 * fq; const bf16_t* bp = UP + ((size_t)g * 384 + 64 * cq + fr) * 512 + 8 * fq;
#pragma unroll 2
        for (int ks = 0; ks < 16; ++ks) { bf16x8 af[4], bf[4];
#pragma unroll
            for (int i = 0; i < 4; ++i) { af[i] = *(const bf16x8*)(ap + (size_t)16 * i * 512 + 32 * ks); bf[i] = *(const bf16x8*)(bp + (size_t)16 * i * 512 + 32 * ks); }
#pragma unroll
            for (int i = 0; i < 4; ++i)
#pragma unroll
                for (int j = 0; j < 4; ++j) acc[i][j] = mfma16(af[i], bf[j], acc[i][j]); }
#pragma unroll
        for (int i = 0; i < 4; ++i)
#pragma unroll
            for (int j = 0; j < 4; ++j) *(f32x4*)(SS + ((size_t)g * 384 + 64 * cq + 16 * j + fr) * 256 + 64 * og + 16 * i + 4 * fq) = acc[i][j];
    }
}
__device__ __forceinline__ void s5_scan_phase(const Args& a, int layer, int gw, int ngw, int lane_) {
    int lane = lane_; asm volatile("" : "+v"(lane));
    const float* SS = (const float*)(a.ws + WS_S5SS); bf16_t* HS = (bf16_t*)(a.ws + WS_S5HS); const float* S5AP = (const float*)(a.ws + WS_S5AP) + (size_t)layer * 32 * 2 * 64 * 2;
    for (int task = gw; task < 1280; task += ngw) {
        int sq, g, dir; if (task < 256) { sq = 16 + (task >> 6); g = (task >> 1) & 31; dir = task & 1; } else { const int t2 = task - 256; sq = t2 >> 6; g = (t2 >> 1) & 31; dir = t2 & 1; }
        const int lat = sq >= 16, b = lat ? sq - 16 : sq, nc = lat ? 64 : 8, cg0 = lat ? 128 + b * 64 : b * 8;
        const float apr = S5AP[((g * 2 + dir) * 64 + lane) * 2], api = S5AP[((g * 2 + dir) * 64 + lane) * 2 + 1];
        float hr = 0.f, hi = 0.f;
        if (lat) { const size_t so = ((((size_t)b * DEPTH + layer) * 2 + dir) * 32 + g) * 64 + lane; hr = a.in[4][so]; hi = a.in[5][so]; }
        for (int s0 = 0; s0 < nc; s0 += 8) {
            float sr[8], si[8];
#pragma unroll
            for (int q = 0; q < 8; ++q) { const int cg = cg0 + (dir ? nc - 1 - (s0 + q) : s0 + q); const size_t base = ((size_t)g * 384 + cg) * 256 + dir * 128; sr[q] = SS[base + lane]; si[q] = SS[base + 64 + lane]; }
#pragma unroll
            for (int q = 0; q < 8; ++q) { const int cg = cg0 + (dir ? nc - 1 - (s0 + q) : s0 + q); const size_t base = ((size_t)g * 384 + cg) * 256 + dir * 128;
                HS[base + lane] = f2bf(hr); HS[base + 64 + lane] = f2bf(hi);
                const float t = apr * hr - api * hi + sr[q]; hi = apr * hi + api * hr + si[q]; hr = t; }
        }
        if (!lat) { const size_t oo = ((((size_t)b * DEPTH + layer) * 2 + dir) * 32 + g) * 64 + lane; a.out[O_S5R + oo] = hr; a.out[O_S5I + oo] = hi; }
    }
}
__device__ __forceinline__ void s5_out_phase(const Args& a, int layer, int gw, int ngw, int lane_) {
    int lane = lane_; asm volatile("" : "+v"(lane));
    const int fr = lane & 15, fq = lane >> 4;
    const bf16_t* UP = (const bf16_t*)(a.ws + WS_S5UP); const bf16_t* S5W = (const bf16_t*)(a.ws + WS_S5W) + (size_t)layer * 32 * 512 * S5K; const bf16_t* HS = (const bf16_t*)(a.ws + WS_S5HS); bf16_t* ZB = (bf16_t*)(a.ws + WS_ZB);
    for (int it = ngw - 1 - gw; it < 32 * 48; it += ngw) { const int g = it / 48, r = it % 48, og = r / 6, cq = r % 6;
        f32x4 acc[4][4];
#pragma unroll
        for (int i = 0; i < 4; ++i)
#pragma unroll
            for (int j = 0; j < 4; ++j) acc[i][j] = (f32x4){0.f, 0.f, 0.f, 0.f};
        const bf16_t* ap = S5W + ((size_t)g * 512 + 64 * og + fr) * S5K + 8 * fq;
        const bf16_t* bp = UP + ((size_t)g * 384 + 64 * cq + fr) * 512 + 8 * fq; const bf16_t* hp = HS + ((size_t)g * 384 + 64 * cq + fr) * 256 + 8 * fq;
#pragma unroll 2
        for (int ks = 0; ks < 16; ++ks) { bf16x8 af[4], bf[4];
#pragma unroll
            for (int i = 0; i < 4; ++i) { af[i] = *(const bf16x8*)(ap + (size_t)16 * i * S5K + 32 * ks); bf[i] = *(const bf16x8*)(bp + (size_t)16 * i * 512 + 32 * ks); }
#pragma unroll
            for (int i = 0; i < 4; ++i)
#pragma unroll
                for (int j = 0; j < 4; ++j) acc[i][j] = mfma16(af[i], bf[j], acc[i][j]); }
#pragma unroll 2
        for (int ks = 0; ks < 8; ++ks) { bf16x8 af[4], bf[4];
#pragma unroll
            for (int i = 0; i < 4; ++i) { af[i] = *(const bf16x8*)(ap + (size_t)16 * i * S5K + 512 + 32 * ks); bf[i] = *(const bf16x8*)(hp + (size_t)16 * i * 256 + 32 * ks); }
#pragma unroll
            for (int i = 0; i < 4; ++i)
#pragma unroll
                for (int j = 0; j < 4; ++j) acc[i][j] = mfma16(af[i], bf[j], acc[i][j]); }
#pragma unroll
        for (int i = 0; i < 4; ++i)
#pragma unroll
            for (int j = 0; j < 4; ++j) { float z[4];
#pragma unroll
                for (int e = 0; e < 4; ++e) { const float x = acc[i][j][e]; const float th = 0.7978845608028654f * (x + 0.044715f * x * x * x); const float e2 = __expf(2.f * th); const float tnh = 1.f - 2.f * __builtin_amdgcn_rcpf(e2 + 1.f); z[e] = 0.5f * x * (1.f + tnh); }
                u32x2 w; w.x = pk2(z[0], z[1]); w.y = pk2(z[2], z[3]);
                *(u32x2*)(ZB + (size_t)(32 * (64 * cq + 16 * j + fr) + 4 * og + i) * 512 + g * 16 + 4 * fq) = w; }
    }
}
}
namespace mk { static_assert(WS_S5_END < (size_t)1780 * 1024 * 1024, "workspace map exceeds the guaranteed size"); }
namespace mk {
#ifndef PHMASK
#define PHMASK 0xfffff
#endif
#define PHM(k) ((PHMASK >> (k)) & 1)
#ifndef DUPMASK
#define DUPMASK 0
#endif
#define DUP(k) ((DUPMASK >> (k)) & 1)
constexpr int NPH = 12;
constexpr int PH_TOTAL = 2 + DEPTH * NPH;
__global__ void __launch_bounds__(NT, 2) mk_fwd(Args a) {
    extern __shared__ __attribute__((aligned(16))) unsigned char lds_raw[];
    LAS unsigned char* lds = (LAS unsigned char*)lds_raw;
#define TID ((int)threadIdx.x)
#define LANE ((int)(threadIdx.x & 63))
#define WAVE (__builtin_amdgcn_readfirstlane((int)(threadIdx.x >> 6)))
#define GW ((int)blockIdx.x * NWV + WAVE)
    const int G = gridDim.x, ngw = G * NWV;
    volatile LAS unsigned* ctlw = (volatile LAS unsigned*)(lds + LDS_CTL);
    if (TID < 4) ctlw[TID] = 0u;
    __syncthreads();
    XcdBarrier bar = xcd_barrier_post((unsigned*)(a.ws + WS_CTL), ctlw);
    const int lo = a.ph_lo, hi = a.ph_hi;
#define IN(k) (lo <= (k) && (k) < hi)
#define SEAM(k) do { if (IN(k) && IN((k) + 1)) xcd_barrier(bar); } while (0)
    unsigned char* ws = a.ws;
    bf16_t* H = (bf16_t*)(ws + WS_H); bf16_t* PROJ = (bf16_t*)(ws + WS_PROJ); float* SMALL = (float*)(ws + WS_SMALL); bf16_t* BR = (bf16_t*)(ws + WS_BR);
    bf16_t* MERGED = (bf16_t*)(ws + WS_MERGED); float* MACC = (float*)(ws + WS_MACC); bf16_t* ZB = (bf16_t*)(ws + WS_ZB); bf16_t* HID = PROJ;
    const float* MOD = (const float*)(ws + WS_MOD); float* X = a.out;
    if (PHM(0) && IN(0)) {
        unsigned* qhead = (unsigned*)(a.ws + WS_CTL) + 8192;
        volatile LAS unsigned* qitem = ctlw + 8;
        for (;;) {
            __syncthreads();
            if (TID == 0) qitem[0] = __hip_atomic_fetch_add(qhead, 1u, __ATOMIC_RELAXED, __HIP_MEMORY_SCOPE_AGENT);
            __syncthreads();
            int item = (int)qitem[0];
            if (item >= DEPTH * 32 + PRO_NCONV + PRO_NADA + PRO_NCACHE) break;
            if (item < DEPTH * 32) { s5_param_task(a, lds, TID, item); continue; } item -= DEPTH * 32;
            if (item < PRO_NCONV) { const int w0 = item * 64 + WAVE * 8; prologue_convert(a, lds, w0, w0 + 8, WAVE, LANE); continue; } item -= PRO_NCONV;
            if (item < PRO_NADA) { prologue_ada_unit(a, lds, TID, item); continue; } item -= PRO_NADA;
            prologue_cache(a, item * NWV + WAVE, PRO_NCACHE * NWV, LANE);
        }
    }
    SEAM(0);
    for (int l = 0; l < DEPTH; ++l) {
        const int pb = 1 + l * NPH;
        const float* xp = l == 0 ? a.in[0] : X; const float* xs = l == 0 ? a.in[1] : X + (size_t)MP * D;
        const float* modl = MOD + (size_t)l * 5 * 6 * D;
        const bf16_t* wl = (const bf16_t*)(ws + WS_W) + (size_t)l * W_LAYER;
        if (PHM(1) && IN(pb + 0)) norm_phase(xp, xs, a.in[14] + l * D, modl, 0, D, H, GW, ngw, LANE, l > 0 ? MACC : nullptr, modl - (size_t)5 * 6 * D, 5 * D, X, xs);
        SEAM(pb + 0);
        if (PHM(2) && IN(pb + 1)) { Gemm g{H, wl + W_IN, M, NIN, D, D, 1, 0, 0}; StaticOrder S; S.init(M, NIN, G, blockIdx.x, 1, D);
            EpiIn E{PROJ, SMALL, a.out, a.in[17] + l * 64, a.in[18] + l * 64, l}; for (int r_ = 0; r_ < 1 + DUP(9); ++r_) gemm_phase(lds, g, S, E); }
        SEAM(pb + 1);
        if (PHM(3) && IN(pb + 2)) { for (int r_ = 0; r_ < 1 + DUP(0); ++r_) { prep_phase(a, l, lds, GW, ngw, WAVE, LANE, (bf16_t*)(a.ws + WS_S5UP)); __syncthreads(); } }
        SEAM(pb + 2);
        if (PHM(4) && IN(pb + 3)) { for (int r_ = 0; r_ < 1 + DUP(2); ++r_) attn_phase(a, l, GW, ngw, LANE); for (int r_ = 0; r_ < 1 + DUP(3); ++r_) { ml_states_phase(a, l, TID, G); ssd_states_phase(a, l, TID, G); s5_statein_phase(a, l, GW, ngw, LANE); } }
        SEAM(pb + 3);
        if (PHM(5) && IN(pb + 4)) { for (int r_ = 0; r_ < 1 + DUP(4); ++r_) { ml_scan_phase(a, l, TID, G); ssd_scan_phase(a, l, TID, G); s5_scan_phase(a, l, GW, ngw, LANE); } }
        SEAM(pb + 4);
        if (PHM(12) && IN(pb + 5)) { for (int r_ = 0; r_ < 1 + DUP(5); ++r_) ml_out_phase(a, l, lds, TID, G); for (int r_ = 0; r_ < 1 + DUP(6); ++r_) ssd_out_phase(a, l, lds, TID, G); for (int r_ = 0; r_ < 1 + DUP(7); ++r_) s5_out_phase(a, l, GW, ngw, LANE); }
        SEAM(pb + 5);
        if (PHM(6) && IN(pb + 6)) { Gemm g{ZB, wl + W_GLU, M, 512, 512, 512, 1, 0, 0}; StaticOrder S; S.init(M, 512, G, blockIdx.x, 1, 512);
            EpiGlu E{ZB, a.in[29] + l * 512, BR}; gemm_phase(lds, g, S, E); ssd_fin_phase(a, l, GW, ngw, LANE); }
        SEAM(pb + 6);
        if (PHM(7) && IN(pb + 7)) { Gemm g{BR, wl + W_BR, M, D, 512, D, 4, 512, (size_t)D * 512}; StaticOrder S; S.init(M, D, G, blockIdx.x, 4, 512);
            EpiBranch E{PROJ, MERGED}; for (int r_ = 0; r_ < 1 + DUP(12); ++r_) gemm_phase(lds, g, S, E); }
        SEAM(pb + 7);
        if (PHM(8) && IN(pb + 8)) { Gemm g{MERGED, wl + W_OUT, M, D, D, D, 1, 0, 0}; SplitOrder S; S.init(blockIdx.x, D);
            EpiResid E{xp, xs, modl, 2 * D, X, MACC}; gemm_phase(lds, g, S, E); }
        SEAM(pb + 8);
        if (PHM(9) && IN(pb + 9)) norm_phase(X, X + (size_t)MP * D, a.in[15] + l * D, modl, 3 * D, 4 * D, H, GW, ngw, LANE, MACC, modl, 2 * D, X, xs);
        SEAM(pb + 9);
        if (PHM(10) && IN(pb + 10)) { Gemm g{H, wl + W_1, M, DFF, D, D, 1, 0, 0}; StaticOrder S; S.init(M, DFF, G, blockIdx.x, 1, D);
            EpiRelu2 E{HID, DFF}; for (int r_ = 0; r_ < 1 + DUP(10); ++r_) gemm_phase(lds, g, S, E); }
        SEAM(pb + 10);
        if (PHM(11) && IN(pb + 11)) { Gemm g{HID, wl + W_2, M, D, DFF, DFF, 1, 0, 0}; SplitOrder S; S.init(blockIdx.x, DFF);
            EpiResid E{X, X + (size_t)MP * D, modl, 5 * D, X, MACC}; gemm_phase(lds, g, S, E); }
        SEAM(pb + 11);
    }
    if (IN(1 + DEPTH * NPH)) final_fix_phase(MACC, MOD + (size_t)(DEPTH - 1) * 5 * 6 * D, 5 * D, X, GW, ngw, LANE);
#undef IN
#undef SEAM
}
}
extern "C" void kernel_launch(void* const* d_in, const int* in_sizes, int n_in, void* d_out, int out_size, void* d_ws, size_t ws_size, hipStream_t stream) {
    static int grid = 0;
    if (grid == 0) {
        int dev = 0, cus = 0; (void)hipGetDevice(&dev); (void)hipDeviceGetAttribute(&cus, hipDeviceAttributeMultiprocessorCount, dev);
        (void)hipFuncSetAttribute((const void*)mk::mk_fwd, hipFuncAttributeMaxDynamicSharedMemorySize, mk::LDS_BYTES);
        int per_cu = 0; (void)hipOccupancyMaxActiveBlocksPerMultiprocessor(&per_cu, (const void*)mk::mk_fwd, mk::NT, mk::LDS_BYTES); (void)hipGetLastError();
        grid = cus > 0 ? cus : 256;
    }
    mk::Args a{}; for (int i = 0; i < 43; ++i) a.in[i] = (const float*)d_in[i];
    a.out = (float*)d_out; a.ws = (unsigned char*)d_ws; a.ph_lo = 0; a.ph_hi = mk::PH_TOTAL;
    (void)hipMemsetAsync(a.ws + mk::WS_CTL, 0, mk::CTL_BYTES, stream);
    hipLaunchKernelGGL(mk::mk_fwd, dim3(grid), dim3(mk::NT), mk::LDS_BYTES, stream, a);
}
```

```cpp
#define SAFE_GEMM 0
#define DUPMASK 0
#include <hip/hip_runtime.h>
#include <math.h>
namespace mk {
#define LAS __attribute__((address_space(3)))
typedef unsigned short bf16_t;
typedef short bf16x8 __attribute__((ext_vector_type(8)));
typedef float f32x4 __attribute__((ext_vector_type(4)));
typedef float f32x2 __attribute__((ext_vector_type(2)));
typedef unsigned u32x4 __attribute__((ext_vector_type(4)));
typedef unsigned u32x2 __attribute__((ext_vector_type(2)));
constexpr int NT = 512, NWV = 8;
constexpr int D = 2048, MP = 4096, MLAT = 8192, M = MP + MLAT, DEPTH = 4, DFF = 8192;
constexpr int PJ = 13824;
constexpr int NIN = 14080;
constexpr int P_Q = 0, P_K = 512, P_V = 1024, P_S5U = 1536, P_Z = 2048, P_XBC = 2560, P_MQ = 3584, P_MK = 4096, P_MV = 4608, P_MO = 5120, P_GATE = 5632;
constexpr int S_DT = 0, S_MI = 16, S_MF = 24;

typedef __bf16 bf16x2_t __attribute__((ext_vector_type(2)));
__device__ __forceinline__ unsigned pk2(float lo, float hi) { f32x2 v = {lo, hi}; bf16x2_t b = __builtin_convertvector(v, bf16x2_t); return __builtin_bit_cast(unsigned, b); }
__device__ __forceinline__ float bf2f(bf16_t v) { return __uint_as_float(((unsigned)v) << 16); }
__device__ __forceinline__ float bflo(unsigned w) { return __uint_as_float(w << 16); }
__device__ __forceinline__ float bfhi(unsigned w) { return __uint_as_float(w & 0xffff0000u); }
__device__ __forceinline__ bf16_t f2bf(float f) { return (bf16_t)(pk2(f, 0.f) & 0xffffu); }
__device__ __forceinline__ float fsigm(float x) { return __builtin_amdgcn_rcpf(1.f + __expf(-x)); }
__device__ __forceinline__ float fsilu(float x) { return x * fsigm(x); }
__device__ __forceinline__ int row_cvec(int row) { return row < MP ? 0 : 1 + (row - MP) / 2048; }

#define XB_TMO      128
#define XB_XCNT(j)  (256  + 64 * (j))
#define XB_XSUB(j)  (1280 + 64 * (j))
#define XB_XGEN(j)  (2304 + 64 * (j))
#define XB_TOP      3328
#define XB_TOPGEN   3392
#define XCD_BAR_WORDS 3456
#define XB_SPIN_CAP (1u << 18)
__device__ __forceinline__ unsigned xb_ld(unsigned* p)              { return __hip_atomic_load(p, __ATOMIC_RELAXED, __HIP_MEMORY_SCOPE_AGENT); }
__device__ __forceinline__ unsigned xb_add(unsigned* p, unsigned v) { return __hip_atomic_fetch_add(p, v, __ATOMIC_RELAXED, __HIP_MEMORY_SCOPE_AGENT); }
__device__ __forceinline__ unsigned xb_xcc_id() { return (unsigned)__builtin_amdgcn_s_getreg((3 << 11) | 20) & 0xFu; }
#define XB_SPIN(cond, bar) do { unsigned _sp = 0; while (cond) { __builtin_amdgcn_s_sleep(1); \
    if ((++_sp & 255u) == 0u) { if (xb_ld(&(bar)[XB_TMO])) break; if (_sp > XB_SPIN_CAP) { atomicAdd(&(bar)[XB_TMO], 1u); break; } } } } while (0)
struct XcdBarrier { unsigned* bar; unsigned x; volatile LAS unsigned* st; };
__device__ __forceinline__ XcdBarrier xcd_barrier_post(unsigned* bar, volatile LAS unsigned* st) {
    XcdBarrier b; b.bar = bar; b.x = xb_xcc_id(); b.st = st;
    if (threadIdx.x == 0) (void)xb_add(&bar[XB_XCNT(b.x)], 1u);
    return b;
}
__device__ __forceinline__ void xcd_barrier_complete(unsigned* bar, unsigned x, unsigned& nloc, unsigned& nx) {
    const unsigned G = gridDim.x * gridDim.y * gridDim.z;
    unsigned sum, cnt, mine, sp = 0u;
    for (;;) {
        sum = 0u; cnt = 0u; mine = 0u;
#pragma unroll
        for (unsigned j = 0; j < 16; ++j) { const unsigned c = xb_ld(&bar[XB_XCNT(j)]); sum += c; cnt += (c > 0u) ? 1u : 0u; mine = (j == x) ? c : mine; }
        if (sum == G) break;
        __builtin_amdgcn_s_sleep(1);
        if ((++sp & 255u) == 0u) { if (xb_ld(&bar[XB_TMO])) break; if (sp > XB_SPIN_CAP) { atomicAdd(&bar[XB_TMO], 1u); break; } }
    }
    nloc = mine > 0u ? mine : 1u; nx = cnt > 0u ? cnt : 1u;
}
__device__ __forceinline__ void xcd_barrier(const XcdBarrier& b) {
    asm volatile("s_waitcnt vmcnt(0)" ::: "memory");
    __syncthreads();
    if (threadIdx.x == 0) {
        unsigned* bar = b.bar;
        __builtin_amdgcn_s_waitcnt(0);
        unsigned nloc = b.st[0], nx = b.st[1];
        if (nloc == 0u) { xcd_barrier_complete(bar, b.x, nloc, nx); b.st[0] = nloc; b.st[1] = nx; }
        const unsigned old = xb_add(&bar[XB_XSUB(b.x)], 1u);
        const unsigned gen = old / nloc;
        if (old + 1u == (gen + 1u) * nloc) {
            __builtin_amdgcn_fence(__ATOMIC_RELEASE, "agent");
            asm volatile("s_waitcnt vmcnt(0)" ::: "memory");
            const unsigned og = xb_add(&bar[XB_TOP], 1u);
            const unsigned tg = og / nx;
            if (og + 1u == (tg + 1u) * nx) xb_add(&bar[XB_TOPGEN], 1u);
            else XB_SPIN(xb_ld(&bar[XB_TOPGEN]) == tg, bar);
            __builtin_amdgcn_fence(__ATOMIC_ACQUIRE, "agent");
            xb_add(&bar[XB_XGEN(b.x)], 1u);
            asm volatile("s_waitcnt vmcnt(0)" ::: "memory");
        } else {
            XB_SPIN(xb_ld(&bar[XB_XGEN(b.x)]) == gen, bar);
            __builtin_amdgcn_fence(__ATOMIC_ACQUIRE, "agent");
            asm volatile("s_waitcnt vmcnt(0)" ::: "memory");
        }
    }
    __syncthreads();
}

#ifndef GEMM_SP2
#define GEMM_SP2 1
#endif
#ifndef GEMM_ALIGN
#define GEMM_ALIGN 1
#endif
constexpr int BM = 256, BK = 64, HALF = 128, HTB = HALF * BK * 2, STAGE_BYTES = 8 * HTB, NXCD = 8, WGM = 8;
__host__ __device__ __forceinline__ int lds_byte(int r, int c) { const int st = (r >> 4) * 2 + (c >> 5), rr = r & 15, cc = c & 31, ob = rr * 64 + cc * 2; return st * 1024 + (ob ^ (((ob >> 9) & 1) << 5)); }
__host__ __device__ __forceinline__ void stage_rc(int b, int& R, int& C) { const int st = b / 1024, sb = b % 1024, swz = sb ^ (((sb >> 9) & 1) << 5); R = (st >> 1) * 16 + swz / 64; C = (st & 1) * 32 + (swz % 64) / 2; }
__host__ __device__ __forceinline__ int perm32(int rho) { const int n = rho >> 4, i = rho & 15; return 8 * (i >> 2) + 4 * n + (i & 3); }

struct Unit { int pm, pn, kz, koff, nt; };
struct Gemm { const bf16_t* A; const bf16_t* Bt; int M, N, K, lda, nkz; size_t a_kz, b_kz; };

struct StaticOrder {
    int nM, nN, nwg, G, c, nkz;
    int ntk;
    __device__ void init(int M_, int N_, int G_, int c_, int nkz_ = 1, int K_ = 0) { nM = M_ / BM; nN = N_ / BM; nwg = nM * nN; G = G_; c = c_; nkz = nkz_; ntk = K_ / BK; }
    __device__ bool next(int i, Unit& u) const {
        const int it = i / nkz; u.kz = i - it * nkz; u.koff = 0; u.nt = ntk;
        const long L = (long)it * G + c; if (L >= nwg) return false;
        int wgid = (int)L; { const int q = nwg / NXCD, r = nwg % NXCD, xcd = wgid % NXCD, off = wgid / NXCD; wgid = (xcd < r ? xcd * (q + 1) : r * (q + 1) + (xcd - r) * q) + off; }
        const int nig = WGM * nN, gid = wgid / nig, fm = gid * WGM, gsz = (nM - fm) < WGM ? (nM - fm) : WGM;
        u.pm = fm + ((wgid % nig) % gsz); u.pn = (wgid % nig) / gsz; return true;
    }
};

struct SplitOrder {
    int c, ntk;
    __device__ void init(int c_, int K_) { c = c_; ntk = K_ / BK; }
    __device__ bool next(int i, Unit& u) const {
        const int xcd = c & 7, idx = c >> 3;
        if (i == 0) { u.pm = xcd * 4 + (idx >> 3); u.pn = idx & 7; u.kz = 0; u.koff = 0; u.nt = ntk; return true; }
        if (i == 1) { const int t = idx >> 1; u.pm = 32 + xcd * 2 + (t >> 3); u.pn = t & 7; u.kz = 0; u.nt = ntk >> 1; u.koff = (idx & 1) * (ntk >> 1) * BK; return true; }
        return false;
    }
};

template <class Epi, class Sched>
__device__ __forceinline__ void gemm_phase(LAS unsigned char* lds, const Gemm g, const Sched& S, const Epi& E) {
    int tid_ = threadIdx.x; asm volatile("" : "+v"(tid_));
    const int tid = tid_, wid = __builtin_amdgcn_readfirstlane(tid >> 6), lane = tid & 63, wr = wid >> 2, wc = wid & 3, fr = lane & 15, fq = lane >> 4;
    const int K = g.K;
    unsigned voffA[2], voffB[2];
#pragma unroll
    for (int i = 0; i < 2; ++i) { int R, C; stage_rc(tid * 16 + i * 8192, R, C); const int Rb = Epi::PERM ? ((R & ~31) + perm32(R & 31)) : R;
        voffA[i] = (unsigned)(R * g.lda + C) * 2u; voffB[i] = (unsigned)(Rb * K + C) * 2u; }
    const size_t kstep = (size_t)(BK * 2);
    const size_t hstepA = (size_t)HALF * g.lda * 2, hstepB = (size_t)HALF * K * 2;
    const size_t tstepA = 2 * hstepA, tstepB = 2 * hstepB;
    const unsigned ldsw = (unsigned)wid * 1024u;
    const int aoff = lds_byte(wr * 64 + fr, fq * 8), boff = lds_byte(wc * 32 + fr, fq * 8);
#define PG8_SA(b, h) (((b) * 2 + (h)) * HTB)
#define PG8_SB(b, h) ((4 + (b) * 2 + (h)) * HTB)
#define PG8_STAGE(bufoff, gbase, voff) do { _Pragma("unroll") for (int _i = 0; _i < 2; ++_i) \
        __builtin_amdgcn_global_load_lds((const unsigned*)((const char*)(gbase) + (voff)[_i]), (LAS unsigned*)(lds + (bufoff) + ldsw + _i * 8192), 16, 0, 0); } while (0)
#define PG8_LDA(dst, b, h) do { _Pragma("unroll") for (int m = 0; m < 4; ++m) _Pragma("unroll") for (int k = 0; k < 2; ++k) dst[m][k] = *(const LAS bf16x8*)(lds + PG8_SA(b, h) + aoff + m * 2048 + k * 1024); } while (0)
#define PG8_LDB(dst, b, h) do { _Pragma("unroll") for (int n = 0; n < 2; ++n) _Pragma("unroll") for (int k = 0; k < 2; ++k) dst[n][k] = *(const LAS bf16x8*)(lds + PG8_SB(b, h) + boff + n * 2048 + k * 1024); } while (0)
#define PG8_MMA(ai, bj, At, Bt) do { __builtin_amdgcn_s_setprio(1); _Pragma("unroll") for (int m = 0; m < 4; ++m) _Pragma("unroll") for (int n = 0; n < 2; ++n) _Pragma("unroll") for (int k = 0; k < 2; ++k) \
        acc[ai][bj][m][n] = __builtin_amdgcn_mfma_f32_16x16x32_bf16(Bt[n][k], At[m][k], acc[ai][bj][m][n], 0, 0, 0); __builtin_amdgcn_s_setprio(0); } while (0)
#if SAFE_GEMM == 1 || SAFE_GEMM == 3
#define PG8_WAIT_V(n) asm volatile("s_waitcnt vmcnt(0)" ::: "memory")
#else
#define PG8_WAIT_V(n) asm volatile("s_waitcnt vmcnt(" #n ")" ::: "memory")
#endif
#define PG8_WAIT_L(n) asm volatile("s_waitcnt lgkmcnt(" #n ")" ::: "memory")
#if SAFE_GEMM == 1
#define PG8_BAR do { asm volatile("s_waitcnt vmcnt(0) lgkmcnt(0)" ::: "memory"); __builtin_amdgcn_s_barrier(); asm volatile("" ::: "memory"); } while (0)
#elif SAFE_GEMM == 2
#define PG8_BAR asm volatile("s_barrier" ::: "memory")
#elif SAFE_GEMM == 4
#define PG8_BAR do { asm volatile("s_waitcnt lgkmcnt(0)" ::: "memory"); __builtin_amdgcn_s_barrier(); } while (0)
#else
#define PG8_BAR __builtin_amdgcn_s_barrier()
#endif
#define PG8_SCHED __builtin_amdgcn_sched_barrier(0)
    Unit cur, nxt; int ui = 0;
    if (!S.next(0, cur)) return;
    f32x4 acc[2][2][4][2];
#pragma unroll
    for (int a = 0; a < 2; ++a)
#pragma unroll
        for (int b = 0; b < 2; ++b)
#pragma unroll
            for (int m = 0; m < 4; ++m)
#pragma unroll
                for (int n = 0; n < 2; ++n) acc[a][b][m][n] = (f32x4){0.f, 0.f, 0.f, 0.f};
    bf16x8 At[4][2], B0[2][2], B1[2][2];
    const char* cA = (const char*)(g.A + (size_t)cur.kz * g.a_kz + cur.koff) + (size_t)cur.pm * tstepA; const char* cB = (const char*)(g.Bt + (size_t)cur.kz * g.b_kz + cur.koff) + (size_t)cur.pn * tstepB;
#if GEMM_SP2
    PG8_STAGE(PG8_SB(0, 0), cB, voffB); PG8_STAGE(PG8_SB(0, 1), cB + hstepB, voffB); PG8_STAGE(PG8_SA(0, 0), cA, voffA); PG8_STAGE(PG8_SA(0, 1), cA + hstepA, voffA);
    if (wr == 1) PG8_BAR;
    PG8_WAIT_V(2); PG8_BAR;
    PG8_STAGE(PG8_SB(1, 0), cB + kstep, voffB); PG8_STAGE(PG8_SA(1, 0), cA + kstep, voffA); PG8_STAGE(PG8_SB(1, 1), cB + hstepB + kstep, voffB);
    PG8_WAIT_V(6); PG8_BAR;
#else
    PG8_STAGE(PG8_SB(0, 0), cB, voffB); PG8_STAGE(PG8_SA(0, 0), cA, voffA); PG8_STAGE(PG8_SB(0, 1), cB + hstepB, voffB); PG8_STAGE(PG8_SA(0, 1), cA + hstepA, voffA);
    if (wr == 1) PG8_BAR;
    PG8_WAIT_V(4); PG8_BAR;
    PG8_STAGE(PG8_SB(1, 0), cB + kstep, voffB); PG8_STAGE(PG8_SA(1, 0), cA + kstep, voffA); PG8_STAGE(PG8_SB(1, 1), cB + hstepB + kstep, voffB);
    PG8_WAIT_V(6); PG8_BAR;
#endif
    for (;;) {
        const bool has_next = S.next(ui + 1, nxt);
        const char* nA = has_next ? (const char*)(g.A + (size_t)nxt.kz * g.a_kz + nxt.koff) + (size_t)nxt.pm * tstepA : cA;
        const char* nB = has_next ? (const char*)(g.Bt + (size_t)nxt.kz * g.b_kz + nxt.koff) + (size_t)nxt.pn * tstepB : cB;
        const int nt = cur.nt;
        for (int t = 0; t < nt; t += 2) {
            const bool last = (t == nt - 2);
            const char* a1 = cA + (size_t)(t + 1) * kstep;
            const char* a2 = last ? nA : cA + (size_t)(t + 2) * kstep; const char* b2 = last ? nB : cB + (size_t)(t + 2) * kstep;
            const char* a3 = a2 + kstep; const char* b3 = b2 + kstep;
#if GEMM_SP2
            PG8_LDB(B0, 0, 0); PG8_LDB(B1, 0, 1); PG8_SCHED; PG8_LDA(At, 0, 0); PG8_STAGE(PG8_SA(1, 1), a1 + hstepA, voffA);
            PG8_WAIT_V(8); PG8_WAIT_L(0); PG8_BAR; PG8_MMA(0, 0, At, B0); PG8_MMA(0, 1, At, B1); PG8_BAR; PG8_SCHED;
            PG8_LDA(At, 0, 1); PG8_STAGE(PG8_SB(0, 0), b2, voffB); PG8_STAGE(PG8_SB(0, 1), b2 + hstepB, voffB); PG8_STAGE(PG8_SA(0, 0), a2, voffA);
            PG8_WAIT_V(8); PG8_WAIT_L(0); PG8_BAR; PG8_MMA(1, 0, At, B0); PG8_MMA(1, 1, At, B1); PG8_BAR; PG8_SCHED;
            PG8_LDB(B0, 1, 0); PG8_LDB(B1, 1, 1); PG8_SCHED; PG8_LDA(At, 1, 0); PG8_STAGE(PG8_SA(0, 1), a2 + hstepA, voffA);
            PG8_WAIT_V(8); PG8_WAIT_L(0); PG8_BAR; PG8_MMA(0, 0, At, B0); PG8_MMA(0, 1, At, B1); PG8_BAR; PG8_SCHED;
            PG8_LDA(At, 1, 1); PG8_STAGE(PG8_SB(1, 0), b3, voffB); PG8_STAGE(PG8_SB(1, 1), b3 + hstepB, voffB); PG8_STAGE(PG8_SA(1, 0), a3, voffA);
            PG8_WAIT_V(8); PG8_WAIT_L(0); PG8_BAR; PG8_MMA(1, 0, At, B0); PG8_MMA(1, 1, At, B1); PG8_BAR; PG8_SCHED;
#else
            PG8_LDB(B0, 0, 0); PG8_SCHED; PG8_LDA(At, 0, 0); PG8_STAGE(PG8_SA(1, 1), a1 + hstepA, voffA);
            PG8_WAIT_L(8); PG8_BAR; PG8_WAIT_L(0); PG8_MMA(0, 0, At, B0); PG8_BAR; PG8_SCHED;
            PG8_LDB(B1, 0, 1); PG8_STAGE(PG8_SB(0, 0), b2, voffB);
            PG8_BAR; PG8_WAIT_L(0); PG8_MMA(0, 1, At, B1); PG8_BAR;
            PG8_LDA(At, 0, 1); PG8_STAGE(PG8_SA(0, 0), a2, voffA);
            PG8_BAR; PG8_WAIT_L(0); PG8_MMA(1, 0, At, B0); PG8_BAR; PG8_SCHED;
            PG8_STAGE(PG8_SB(0, 1), b2 + hstepB, voffB);
            PG8_WAIT_V(6); PG8_BAR; PG8_MMA(1, 1, At, B1); PG8_BAR;
            PG8_LDB(B0, 1, 0); PG8_SCHED; PG8_LDA(At, 1, 0); PG8_STAGE(PG8_SA(0, 1), a2 + hstepA, voffA);
            PG8_WAIT_L(8); PG8_BAR; PG8_WAIT_L(0); PG8_MMA(0, 0, At, B0); PG8_BAR; PG8_SCHED;
            PG8_LDB(B1, 1, 1); PG8_STAGE(PG8_SB(1, 0), b3, voffB);
            PG8_BAR; PG8_WAIT_L(0); PG8_MMA(0, 1, At, B1); PG8_BAR;
            PG8_LDA(At, 1, 1); PG8_STAGE(PG8_SA(1, 0), a3, voffA);
            PG8_BAR; PG8_WAIT_L(0); PG8_MMA(1, 0, At, B0); PG8_BAR; PG8_SCHED;
            PG8_STAGE(PG8_SB(1, 1), b3 + hstepB, voffB);
            PG8_WAIT_V(6); PG8_BAR; PG8_MMA(1, 1, At, B1); PG8_BAR;
#endif
        }
#if GEMM_ALIGN
        if (wr == 0) PG8_BAR;
#endif
        E(acc, cur, wr, wc, fr, fq);
        if (!has_next) break;
        if (nxt.kz == 0) {
#pragma unroll
        for (int a = 0; a < 2; ++a)
#pragma unroll
            for (int b = 0; b < 2; ++b)
#pragma unroll
                for (int m = 0; m < 4; ++m)
#pragma unroll
                    for (int n = 0; n < 2; ++n) acc[a][b][m][n] = (f32x4){0.f, 0.f, 0.f, 0.f};
        }
        cur = nxt; cA = nA; cB = nB; ++ui;
#if GEMM_ALIGN
        if (wr == 1) PG8_BAR;
#endif
    }
    PG8_WAIT_V(0);
#if !GEMM_ALIGN
    if (wr == 0) PG8_BAR;
#endif
    PG8_BAR;
#undef PG8_SA
#undef PG8_SB
#undef PG8_STAGE
#undef PG8_LDA
#undef PG8_LDB
#undef PG8_MMA
#undef PG8_WAIT_V
#undef PG8_WAIT_L
#undef PG8_BAR
#undef PG8_SCHED
}
}
namespace mk {
constexpr size_t O_YP = 0, O_YS = 8388608, O_NK = 25165824, O_NV = 33554432, O_S5R = 41943040, O_S5I = 42205184, O_SSD = 42467328,
                 O_MLC = 50855936, O_MLN = 59244544, O_MLM = 59310080;

__device__ __forceinline__ u32x4 pack8(const f32x4 a, const f32x4 b) { u32x4 w; w.x = pk2(a[0], a[1]); w.y = pk2(a[2], a[3]); w.z = pk2(b[0], b[1]); w.w = pk2(b[2], b[3]); return w; }

struct EpiIn {
    static constexpr bool PERM = true;
    bf16_t* proj; float* small; float* out; const float* qg; const float* kg; int layer;
    __device__ __forceinline__ void operator()(f32x4 (&acc)[2][2][4][2], const Unit& u, int wr, int wc, int fr, int fq) const {
        const int T = u.pn, rowb = u.pm * BM + wr * 64 + fr;
        if (T == 54) {
            if (wc == 0) {
#pragma unroll
                for (int ai = 0; ai < 2; ++ai)
#pragma unroll
                    for (int m = 0; m < 4; ++m) { float* sp = small + (size_t)(rowb + ai * HALF + m * 16) * 32 + 8 * fq; *(f32x4*)sp = acc[ai][0][m][0]; *(f32x4*)(sp + 4) = acc[ai][0][m][1]; }
            }
            return;
        }
        const int colb = T * 256 + 64 * wc + 8 * fq;
        if (T < 4) {
            const float* g = T < 2 ? qg : kg;
            f32x4 gv[2][2];
#pragma unroll
            for (int bj = 0; bj < 2; ++bj)
#pragma unroll
                for (int n = 0; n < 2; ++n) gv[bj][n] = *(const f32x4*)(g + 32 * bj + 8 * fq + 4 * n);
#pragma unroll
            for (int ai = 0; ai < 2; ++ai)
#pragma unroll
                for (int m = 0; m < 4; ++m) {
                    float ss = 0.f;
#pragma unroll
                    for (int bj = 0; bj < 2; ++bj)
#pragma unroll
                        for (int n = 0; n < 2; ++n) { const f32x4 x = acc[ai][bj][m][n]; ss += (x[0] * x[0] + x[1] * x[1]) + (x[2] * x[2] + x[3] * x[3]); }
                    ss += __shfl_xor(ss, 16); ss += __shfl_xor(ss, 32);
                    const float r = rsqrtf(ss * (1.f / 64.f) + 1e-6f);
                    const int row = rowb + ai * HALF + m * 16;
#pragma unroll
                    for (int bj = 0; bj < 2; ++bj) { const f32x4 v0 = acc[ai][bj][m][0] * r * gv[bj][0], v1 = acc[ai][bj][m][1] * r * gv[bj][1];
                        *(u32x4*)(proj + (size_t)row * PJ + colb + 32 * bj) = pack8(v0, v1);
                        if (T >= 2 && row < MP) { float* o = out + O_NK + ((size_t)((row >> 8) * DEPTH + layer) * 256 + (row & 255)) * 512 + (colb - 512) + 32 * bj; *(f32x4*)o = v0; *(f32x4*)(o + 4) = v1; } }
                }
        } else if (T < 6) {
#pragma unroll
            for (int ai = 0; ai < 2; ++ai)
#pragma unroll
                for (int m = 0; m < 4; ++m) { const int row = rowb + ai * HALF + m * 16;
#pragma unroll
                    for (int bj = 0; bj < 2; ++bj) { const f32x4 v0 = acc[ai][bj][m][0], v1 = acc[ai][bj][m][1];
                        *(u32x4*)(proj + (size_t)row * PJ + colb + 32 * bj) = pack8(v0, v1);
                        if (row < MP) { float* o = out + O_NV + ((size_t)((row >> 8) * DEPTH + layer) * 256 + (row & 255)) * 512 + (colb - 1024) + 32 * bj; *(f32x4*)o = v0; *(f32x4*)(o + 4) = v1; } } }
        } else if (T < 22) {
#pragma unroll
            for (int ai = 0; ai < 2; ++ai)
#pragma unroll
                for (int m = 0; m < 4; ++m) { const int row = rowb + ai * HALF + m * 16;
#pragma unroll
                    for (int bj = 0; bj < 2; ++bj) *(u32x4*)(proj + (size_t)row * PJ + colb + 32 * bj) = pack8(acc[ai][bj][m][0], acc[ai][bj][m][1]); }
        } else {
#pragma unroll
            for (int ai = 0; ai < 2; ++ai)
#pragma unroll
                for (int m = 0; m < 4; ++m) { const int row = rowb + ai * HALF + m * 16;
#pragma unroll
                    for (int bj = 0; bj < 2; ++bj) { f32x4 v0 = acc[ai][bj][m][0], v1 = acc[ai][bj][m][1];
#pragma unroll
                        for (int j = 0; j < 4; ++j) { v0[j] = fsigm(v0[j]); v1[j] = fsigm(v1[j]); }
                        *(u32x4*)(proj + (size_t)row * PJ + colb + 32 * bj) = pack8(v0, v1); } }
        }
    }
};
struct EpiRelu2 {
    static constexpr bool PERM = true;
    bf16_t* O; int ldo;
    __device__ __forceinline__ void operator()(f32x4 (&acc)[2][2][4][2], const Unit& u, int wr, int wc, int fr, int fq) const {
        const int rowb = u.pm * BM + wr * 64 + fr, colb = u.pn * 256 + 64 * wc + 8 * fq;
#pragma unroll
        for (int ai = 0; ai < 2; ++ai)
#pragma unroll
            for (int m = 0; m < 4; ++m) { const int row = rowb + ai * HALF + m * 16;
#pragma unroll
                for (int bj = 0; bj < 2; ++bj) { f32x4 v0 = acc[ai][bj][m][0], v1 = acc[ai][bj][m][1];
#pragma unroll
                    for (int j = 0; j < 4; ++j) { const float a = fmaxf(v0[j], 0.f), b = fmaxf(v1[j], 0.f); v0[j] = a * a; v1[j] = b * b; }
                    *(u32x4*)(O + (size_t)row * ldo + colb + 32 * bj) = pack8(v0, v1); } }
    }
};
struct EpiGlu {
    static constexpr bool PERM = true;
    const bf16_t* Z; const float* bias; bf16_t* br;
    __device__ __forceinline__ void operator()(f32x4 (&acc)[2][2][4][2], const Unit& u, int wr, int wc, int fr, int fq) const {
        const int rowb = u.pm * BM + wr * 64 + fr, colb = u.pn * 256 + 64 * wc + 8 * fq;
#pragma unroll
        for (int bj = 0; bj < 2; ++bj) { const int c = colb + 32 * bj; const f32x4 b0 = *(const f32x4*)(bias + c), b1 = *(const f32x4*)(bias + c + 4);
#pragma unroll
            for (int ai = 0; ai < 2; ++ai)
#pragma unroll
                for (int m = 0; m < 4; ++m) { const int row = rowb + ai * HALF + m * 16;
                    const u32x4 zz = *(const u32x4*)(Z + (size_t)row * 512 + c);
                    f32x4 v0 = acc[ai][bj][m][0] + b0, v1 = acc[ai][bj][m][1] + b1;
                    v0[0] = bflo(zz.x) * fsigm(v0[0]); v0[1] = bfhi(zz.x) * fsigm(v0[1]); v0[2] = bflo(zz.y) * fsigm(v0[2]); v0[3] = bfhi(zz.y) * fsigm(v0[3]);
                    v1[0] = bflo(zz.z) * fsigm(v1[0]); v1[1] = bfhi(zz.z) * fsigm(v1[1]); v1[2] = bflo(zz.w) * fsigm(v1[2]); v1[3] = bfhi(zz.w) * fsigm(v1[3]);
                    *(u32x4*)(br + (size_t)row * D + 512 + c) = pack8(v0, v1); } }
    }
};
struct EpiBranch {
    static constexpr bool PERM = true;
    const bf16_t* proj; bf16_t* merged;
    __device__ __forceinline__ void operator()(f32x4 (&acc)[2][2][4][2], const Unit& u, int wr, int wc, int fr, int fq) const {
        const int rowb = u.pm * BM + wr * 64 + fr, colb = u.pn * 256 + 64 * wc + 8 * fq, kz = u.kz;
#pragma unroll
        for (int ai = 0; ai < 2; ++ai)
#pragma unroll
            for (int m = 0; m < 4; ++m) { const int row = rowb + ai * HALF + m * 16;
#pragma unroll
                for (int bj = 0; bj < 2; ++bj) { const int c = colb + 32 * bj;
                    const u32x4 gg = *(const u32x4*)(proj + (size_t)row * PJ + P_GATE + kz * D + c);
                    float g[8] = {bflo(gg.x), bfhi(gg.x), bflo(gg.y), bfhi(gg.y), bflo(gg.z), bfhi(gg.z), bflo(gg.w), bfhi(gg.w)};
                    if (kz < 3) { const u32x4 hh = *(const u32x4*)(proj + (size_t)row * PJ + P_GATE + (kz + 1) * D + c);
                        const float h[8] = {bflo(hh.x), bfhi(hh.x), bflo(hh.y), bfhi(hh.y), bflo(hh.z), bfhi(hh.z), bflo(hh.w), bfhi(hh.w)};
#pragma unroll
                        for (int j = 0; j < 8; ++j) g[j] = g[j] * __builtin_amdgcn_rcpf(fmaxf(h[j], 1e-30f)); }
                    f32x4& v0 = acc[ai][bj][m][0]; f32x4& v1 = acc[ai][bj][m][1];
                    v0[0] *= g[0]; v0[1] *= g[1]; v0[2] *= g[2]; v0[3] *= g[3]; v1[0] *= g[4]; v1[1] *= g[5]; v1[2] *= g[6]; v1[3] *= g[7];
                    if (kz == 3) *(u32x4*)(merged + (size_t)row * D + c) = pack8(v0, v1); } }
    }
};
struct EpiResid {
    static constexpr bool PERM = false;
    const float* xp; const float* xs; const float* modl; int g_off; float* xout; float* part;
    __device__ __forceinline__ void operator()(f32x4 (&acc)[2][2][4][2], const Unit& u, int wr, int wc, int fr, int fq) const {
        if (part != nullptr && u.pm >= 32) {
            float* P = part + (size_t)((((u.pm - 32) * 8 + u.pn) * 2) + (u.koff != 0)) * 65536 + (size_t)(wr * 64 + fr) * 256 + wc * 32 + 4 * fq;
#pragma unroll
            for (int ai = 0; ai < 2; ++ai)
#pragma unroll
                for (int m = 0; m < 4; ++m)
#pragma unroll
                    for (int bj = 0; bj < 2; ++bj)
#pragma unroll
                        for (int n = 0; n < 2; ++n) *(f32x4*)(P + (size_t)(ai * HALF + m * 16) * 256 + bj * HALF + n * 16) = acc[ai][bj][m][n];
            return;
        }
        const int row0 = u.pm * BM, rowb = row0 + wr * 64 + fr, colb = u.pn * 256 + wc * 32 + 4 * fq;
        const float* xin = row0 < MP ? xp : xs - (size_t)MP * D;
        const float* gate = modl + (size_t)row_cvec(row0) * 6 * D + g_off;
        f32x4 gv[2][2];
#pragma unroll
        for (int bj = 0; bj < 2; ++bj)
#pragma unroll
            for (int n = 0; n < 2; ++n) gv[bj][n] = *(const f32x4*)(gate + colb + bj * HALF + n * 16);
#pragma unroll
        for (int ai = 0; ai < 2; ++ai)
#pragma unroll
            for (int m = 0; m < 4; ++m) { const size_t ro = (size_t)(rowb + ai * HALF + m * 16) * D + colb;
#pragma unroll
                for (int bj = 0; bj < 2; ++bj)
#pragma unroll
                    for (int n = 0; n < 2; ++n) { const size_t o = ro + bj * HALF + n * 16; *(f32x4*)(xout + o) = *(const f32x4*)(xin + o) + gv[bj][n] * acc[ai][bj][m][n]; } }
    }
};
}
namespace mk {
constexpr size_t AL(size_t x) { return (x + 255) & ~(size_t)255; }
constexpr size_t WS_CTL = 0, CTL_BYTES = 65536;
constexpr size_t WS_MOD = WS_CTL + CTL_BYTES;
constexpr size_t WS_W = AL(WS_MOD + (size_t)DEPTH * 5 * 6 * D * 4);
constexpr size_t W_IN = 0, W_GLU = W_IN + (size_t)NIN * D, W_BR = W_GLU + 512 * 512, W_OUT = W_BR + (size_t)4 * D * 512, W_1 = W_OUT + (size_t)D * D, W_2 = W_1 + (size_t)DFF * D,
                 W_LAYER = W_2 + (size_t)D * DFF;
constexpr size_t WS_H = AL(WS_W + W_LAYER * 2 * DEPTH);
constexpr size_t WS_PROJ = AL(WS_H + (size_t)M * D * 2);
constexpr size_t WS_SMALL = AL(WS_PROJ + (size_t)M * PJ * 2);
constexpr size_t WS_BR = AL(WS_SMALL + (size_t)M * 32 * 4);
constexpr size_t WS_MERGED = AL(WS_BR + (size_t)M * D * 2);
constexpr size_t WS_MACC = AL(WS_MERGED + (size_t)M * D * 2);
constexpr size_t WS_ZB = AL(WS_MACC + (size_t)M * D * 4);
constexpr size_t WS_SCR = AL(WS_ZB + (size_t)M * 512 * 2);
constexpr int LDS_BYTES = 140 * 1024, LDS_CTL = LDS_BYTES - 256;

struct Args { const float* in[43]; float* out; unsigned char* ws; int ph_lo, ph_hi; };

__device__ __forceinline__ float wave_sum(float v) {
#pragma unroll
    for (int o = 1; o < 64; o <<= 1) v += __shfl_xor(v, o);
    return v;
}
#define LDS_WAIT() asm volatile("s_waitcnt lgkmcnt(0)" ::: "memory")

__device__ __forceinline__ void xpose_item(const float* W, int ldw, int k0, int sc, bf16_t* dst, int K, LAS float* scr, int lane, int mode) {
    const int n4 = (lane & 7) * 4;
    const int col = mode == 1 ? (n4 < 16 ? 3584 + n4 : 5648 + (n4 - 16)) : sc + n4;
#pragma unroll
    for (int i = 0; i < 8; ++i) { const int kk = (lane >> 3) + 8 * i; f32x4 v = (f32x4){0.f, 0.f, 0.f, 0.f}; if (mode != 2) v = *(const f32x4*)(W + (size_t)(k0 + kk) * ldw + col);
        scr[kk * 33 + n4] = v[0]; scr[kk * 33 + n4 + 1] = v[1]; scr[kk * 33 + n4 + 2] = v[2]; scr[kk * 33 + n4 + 3] = v[3]; }
    LDS_WAIT(); asm volatile("" ::: "memory");
    const int c = lane & 7;
#pragma unroll
    for (int jj = 0; jj < 4; ++jj) { const int n = (lane >> 3) + 8 * jj; const LAS float* s = scr + (8 * c) * 33 + n;
        u32x4 o; o.x = pk2(s[0 * 33], s[1 * 33]); o.y = pk2(s[2 * 33], s[3 * 33]); o.z = pk2(s[4 * 33], s[5 * 33]); o.w = pk2(s[6 * 33], s[7 * 33]);
        *(u32x4*)(dst + (size_t)n * K + k0 + 8 * c) = o; }
    LDS_WAIT(); asm volatile("" ::: "memory");
}
__device__ __forceinline__ int hm_col(int grp) { const int T = grp >> 3, q8 = grp & 7; return 256 * T + 32 * (2 * (q8 & 3) + (q8 >> 2)); }

__device__ __forceinline__ void prologue_convert(const Args& a, LAS unsigned char* lds, int it0, int it1, int wave, int lane) {
    LAS float* scr = (LAS float*)(lds + wave * 8704);
    bf16_t* WB = (bf16_t*)(a.ws + WS_W);
    constexpr int I_IN = 440 * 32, I_GLU = 16 * 8, I_BR = 4 * 64 * 8, I_OUT = 64 * 32, I_1 = 256 * 32, I_2 = 64 * 128, I_L = I_IN + I_GLU + I_BR + I_OUT + I_1 + I_2;
    for (int it = it0; it < it1 && it < I_L * DEPTH; ++it) {
        const int l = it / I_L; int r = it - l * I_L; bf16_t* wl = WB + (size_t)l * W_LAYER;
        if (r < I_IN) { const int kb = r / 440, grp = r % 440, T = grp >> 3; int sc = hm_col(grp), mode = 0;
            if (T == 54) mode = (grp & 7) == 0 ? 1 : 2; else if (T >= 22) sc += 32; else if (T >= 14) sc += 16;
            xpose_item(a.in[16] + (size_t)l * D * 13856, 13856, 64 * kb, sc, wl + W_IN + (size_t)(32 * grp) * D, D, scr, lane, mode); continue; } r -= I_IN;
        if (r < I_GLU) { const int kb = r / 16, grp = r % 16; xpose_item(a.in[28] + (size_t)l * 512 * 512, 512, 64 * kb, hm_col(grp), wl + W_GLU + (size_t)(32 * grp) * 512, 512, scr, lane, 0); continue; } r -= I_GLU;
        if (r < I_BR) { const int k = r / 512, r2 = r % 512, kb = r2 / 64, grp = r2 % 64;
            xpose_item(a.in[39] + ((size_t)l * 4 + k) * 512 * D, D, 64 * kb, hm_col(grp), wl + W_BR + (size_t)k * D * 512 + (size_t)(32 * grp) * 512, 512, scr, lane, 0); continue; } r -= I_BR;
        if (r < I_OUT) { const int kb = r / 64, grp = r % 64; xpose_item(a.in[40] + (size_t)l * D * D, D, 64 * kb, 32 * grp, wl + W_OUT + (size_t)(32 * grp) * D, D, scr, lane, 0); continue; } r -= I_OUT;
        if (r < I_1) { const int kb = r / 256, grp = r % 256; xpose_item(a.in[41] + (size_t)l * D * DFF, DFF, 64 * kb, hm_col(grp), wl + W_1 + (size_t)(32 * grp) * D, D, scr, lane, 0); continue; } r -= I_1;
        { const int kb = r / 64, grp = r % 64; xpose_item(a.in[42] + (size_t)l * DFF * D, D, 64 * kb, 32 * grp, wl + W_2 + (size_t)(32 * grp) * DFF, DFF, scr, lane, 0); }
    }
}
__device__ __forceinline__ void prologue_ada_unit(const Args& a, LAS unsigned char* lds, int tid, int unit) {
    LAS float* sl = (LAS float*)lds;
    LAS float* red = (LAS float*)(lds + 40960);
    float* mod = (float*)(a.ws + WS_MOD);
    for (int i = tid; i < 5 * D; i += NT) { const int j = i / D, k = i % D; const float x = j == 0 ? a.in[11][k] : a.in[10][(j - 1) * D + k]; sl[i] = x / (1.f + __expf(-x)); }
    __syncthreads();
    const int ks = tid >> 6, c = tid & 63;
    const int l = unit / (6 * D / 64), n0 = (unit % (6 * D / 64)) * 64;
    const float* w = a.in[12] + (size_t)l * D * 6 * D + n0 + c;
    float acc[5] = {0.f, 0.f, 0.f, 0.f, 0.f};
#pragma unroll 8
    for (int k = ks * 256; k < ks * 256 + 256; ++k) { const float wv = w[(size_t)k * 6 * D];
#pragma unroll
        for (int j = 0; j < 5; ++j) acc[j] += sl[j * D + k] * wv; }
#pragma unroll
    for (int j = 0; j < 5; ++j) red[(ks * 5 + j) * 64 + c] = acc[j];
    __syncthreads();
    if (tid < 320) { const int j = tid >> 6; float s = 0.f;
#pragma unroll
        for (int q = 0; q < 8; ++q) s += red[(q * 5 + j) * 64 + c];
        mod[((size_t)l * 5 + j) * 6 * D + n0 + c] = s + a.in[13][l * 6 * D + n0 + c]; }
}
constexpr int PRO_CONV_ITEMS = (440 * 32 + 16 * 8 + 4 * 64 * 8 + 64 * 32 + 256 * 32 + 64 * 128) * DEPTH;
constexpr int PRO_NCONV = (PRO_CONV_ITEMS + 63) / 64, PRO_NADA = DEPTH * 6 * D / 64, PRO_NCACHE = 64;
__device__ __forceinline__ void norm_phase(const float* xp, const float* xs, const float* g, const float* modl, int sh_off, int sc_off, bf16_t* H, int gw, int ngw, int lane_,
                                           const float* pend, const float* pmodl, int pg_off, float* xw, const float* xs_pend) {
    int lane = lane_; asm volatile("" : "+v"(lane));
    for (int row = gw; row < M; row += ngw) {
        const float* x = row < MP ? xp + (size_t)row * D : xs + (size_t)(row - MP) * D;
        if (pend != nullptr && row >= 8192) x = xs_pend + (size_t)(row - MP) * D;
        f32x4 v[8]; float ss = 0.f;
#pragma unroll
        for (int j = 0; j < 8; ++j) v[j] = *(const f32x4*)(x + 4 * (lane + 64 * j));
        if (pend != nullptr && row >= 8192) {
            const float* pg = pmodl + (size_t)row_cvec(row) * 6 * D + pg_off; const int pm = row >> 8, r = row & 255;
#pragma unroll
            for (int j = 0; j < 8; ++j) { const int col = 4 * (lane + 64 * j), pn = col >> 8, cc = col & 255;
                const float* P = pend + (size_t)(((pm - 32) * 8 + pn) * 2) * 65536 + (size_t)r * 256 + cc;
                const f32x4 pa = *(const f32x4*)P, pb = *(const f32x4*)(P + 65536), gg = *(const f32x4*)(pg + col);
                v[j] = v[j] + gg * (pa + pb); *(f32x4*)(xw + (size_t)row * D + col) = v[j]; }
        }
#pragma unroll
        for (int j = 0; j < 8; ++j) ss += (v[j][0] * v[j][0] + v[j][1] * v[j][1]) + (v[j][2] * v[j][2] + v[j][3] * v[j][3]);
        const float r = rsqrtf(wave_sum(ss) * (1.f / D) + 1e-6f);
        const float* md = modl + (size_t)row_cvec(row) * 6 * D;
#pragma unroll
        for (int j = 0; j < 8; ++j) { const int i = 4 * (lane + 64 * j);
            const f32x4 gg = *(const f32x4*)(g + i), sc = *(const f32x4*)(md + sc_off + i), sh = *(const f32x4*)(md + sh_off + i);
            const f32x4 o = v[j] * r * gg * (sc + 1.f) + sh;
            u32x2 w; w.x = pk2(o[0], o[1]); w.y = pk2(o[2], o[3]); *(u32x2*)(H + (size_t)row * D + i) = w; }
    }
}
__device__ __forceinline__ void final_fix_phase(const float* pend, const float* pmodl, int pg_off, float* X, int gw, int ngw, int lane_) {
    int lane = lane_; asm volatile("" : "+v"(lane));
    for (int row = 8192 + gw; row < M; row += ngw) {
        const float* pg = pmodl + (size_t)row_cvec(row) * 6 * D + pg_off; const int pm = row >> 8, r = row & 255;
#pragma unroll
        for (int j = 0; j < 8; ++j) { const int col = 4 * (lane + 64 * j), pn = col >> 8, cc = col & 255;
            const float* P = pend + (size_t)(((pm - 32) * 8 + pn) * 2) * 65536 + (size_t)r * 256 + cc;
            const f32x4 pa = *(const f32x4*)P, pb = *(const f32x4*)(P + 65536), gg = *(const f32x4*)(pg + col);
            float* xo = X + (size_t)row * D + col; *(f32x4*)xo = *(const f32x4*)xo + gg * (pa + pb); }
    }
}
}
namespace mk {
constexpr size_t WS_NAT = AL(WS_SCR);
constexpr int NATP = 2048, N_XBC = 0, N_Q = 1024, N_K = 1536;
constexpr size_t WS_TR = AL(WS_NAT + (size_t)M * NATP * 2);
constexpr int T_X = 0, T_B = 512, T_K = 768, T_MV = 1280, T_V = 1792, TRR = 2304;
constexpr int NCH = 96;
constexpr size_t WS_MLC = AL(WS_TR + (size_t)TRR * M * 2);
constexpr size_t WS_MLN = AL(WS_MLC + (size_t)NCH * 4 * 2 * 16384 * 4);
constexpr size_t WS_MLS = AL(WS_MLN + (size_t)NCH * 4 * 2 * 128 * 4);
constexpr size_t WS_MLCS = AL(WS_MLS + (size_t)NCH * 4 * 2 * 4 * 4);
constexpr size_t WS_MLNS = AL(WS_MLCS + (size_t)NCH * 4 * 2 * 16384 * 2);
constexpr size_t WS_MLMS = AL(WS_MLNS + (size_t)NCH * 4 * 2 * 128 * 4);
constexpr size_t WS_OPT_END = AL(WS_MLMS + (size_t)NCH * 4 * 2 * 4);

__device__ __forceinline__ f32x4 mfma16(bf16x8 a, bf16x8 b, f32x4 c) { return __builtin_amdgcn_mfma_f32_16x16x32_bf16(a, b, c, 0, 0, 0); }
__device__ __forceinline__ void chunk_info(int ch, int& row0, int& seq0, int& L, int& lat, int& b, int& ci, int& nc) {
    if (ch < 32) { b = ch >> 1; ci = ch & 1; nc = 2; seq0 = b * 256; L = 256; lat = 0; } else { const int c2 = ch - 32; b = c2 >> 4; ci = c2 & 15; nc = 16; seq0 = MP + b * 2048; L = 2048; lat = 1; }
    row0 = seq0 + ci * 128;
}
__device__ __forceinline__ float fast_exp(float x) { return __expf(x); }

__device__ __forceinline__ void prep_phase(const Args& a, int layer, LAS unsigned char* lds, int gw_, int ngw, int wave, int lane_, bf16_t* UPk) {
    int lane = lane_, gw = gw_; asm volatile("" : "+v"(lane));
    const bf16_t* PROJ = (const bf16_t*)(a.ws + WS_PROJ); bf16_t* NAT = (bf16_t*)(a.ws + WS_NAT); bf16_t* TR = (bf16_t*)(a.ws + WS_TR);
    LAS bf16_t* tile = (LAS bf16_t*)(lds + wave * 16896); LAS bf16_t* otile = tile + 68 * 64;
    const int c = lane & 7, r8 = lane >> 3;
    const float* cw = a.in[30] + layer * 5 * 1024; const float* cb = a.in[31] + layer * 1024;
    for (int u = gw; u < 56 * 192; u += ngw) {
        const int cg = u / 192, tt = u % 192, m0 = tt * 64;
        const int lat = m0 >= MP; const int seq0 = lat ? MP + ((m0 - MP) / 2048) * 2048 : (m0 / 256) * 256, L = lat ? 2048 : 256, t0 = m0 - seq0;
        int kind, src, natcol = -1, trrow = -1;
        if (cg < 16) { kind = 0; src = P_XBC + 64 * cg; natcol = N_XBC + 64 * cg; if (cg < 12) trrow = T_X + 64 * cg; }
        else if (cg < 24) { kind = 1; src = P_MQ + 64 * (cg - 16); natcol = N_Q + 64 * (cg - 16); }
        else if (cg < 32) { kind = 2; src = P_MK + 64 * (cg - 24); natcol = N_K + 64 * (cg - 24); trrow = T_K + 64 * (cg - 24); }
        else if (cg < 40) { kind = 3; src = P_MV + 64 * (cg - 32); trrow = T_MV + 64 * (cg - 32); }
        else if (cg < 48) { kind = 3; src = P_V + 64 * (cg - 40); trrow = T_V + 64 * (cg - 40); }
        else { kind = 4; src = P_S5U + 64 * (cg - 48); }
        const int roff = kind == 0 ? -2 : 0, nrows = kind == 0 ? 68 : 64;
#pragma unroll
        for (int i = 0; i < 9; ++i) { const int r = r8 + 8 * i; if (r < nrows) { const int t = t0 + r + roff; u32x4 v = {0u, 0u, 0u, 0u};
                if (t >= 0 && t < L) v = *(const u32x4*)(PROJ + (size_t)(seq0 + t) * PJ + src + 8 * c);
                *(LAS u32x4*)(tile + r * 64 + 8 * c) = v; } }
        LDS_WAIT(); asm volatile("" ::: "memory");
#define PREP_EMIT(i_, r_) do { if (natcol >= 0) *(u32x4*)(NAT + (size_t)(m0 + r8 + 8 * (i_)) * NATP + natcol + 8 * c) = (r_); if (trrow >= 0) *(LAS u32x4*)(otile + (r8 + 8 * (i_)) * 64 + 8 * c) = (r_); } while (0)
        if (kind == 0) {
            float w[5][8], bz[8];
#pragma unroll
            for (int e = 0; e < 8; ++e) { bz[e] = cb[64 * cg + 8 * c + e];
#pragma unroll
                for (int j = 0; j < 5; ++j) w[j][e] = cw[j * 1024 + 64 * cg + 8 * c + e]; }
#pragma unroll 2
            for (int i = 0; i < 8; ++i) { const int tk = r8 + 8 * i; float acc[8];
#pragma unroll
                for (int e = 0; e < 8; ++e) acc[e] = bz[e];
#pragma unroll
                for (int j = 0; j < 5; ++j) { const u32x4 v = *(const LAS u32x4*)(tile + (tk + j) * 64 + 8 * c);
                    acc[0] += bflo(v.x) * w[j][0]; acc[1] += bfhi(v.x) * w[j][1]; acc[2] += bflo(v.y) * w[j][2]; acc[3] += bfhi(v.y) * w[j][3];
                    acc[4] += bflo(v.z) * w[j][4]; acc[5] += bfhi(v.z) * w[j][5]; acc[6] += bflo(v.w) * w[j][6]; acc[7] += bfhi(v.w) * w[j][7]; }
#pragma unroll
                for (int e = 0; e < 8; ++e) acc[e] = fsilu(acc[e]);
                u32x4 rv; rv.x = pk2(acc[0], acc[1]); rv.y = pk2(acc[2], acc[3]); rv.z = pk2(acc[4], acc[5]); rv.w = pk2(acc[6], acc[7]); PREP_EMIT(i, rv); }
        } else if (kind == 4) {
#pragma unroll
            for (int i = 0; i < 8; ++i) { const int tk = r8 + 8 * i, m = m0 + tk; const u32x4 v = *(const LAS u32x4*)(tile + tk * 64 + 8 * c);
                *(u32x4*)(UPk + ((size_t)(4 * (cg - 48) + (c >> 1)) * 384 + (m >> 5)) * 512 + (m & 31) * 16 + 8 * (c & 1)) = v; }
        } else if (kind == 3 || !lat) {
            const float sc = kind == 2 ? 0.08838834764831845f : 1.f;
#pragma unroll
            for (int i = 0; i < 8; ++i) { const u32x4 v = *(const LAS u32x4*)(tile + (r8 + 8 * i) * 64 + 8 * c);
                u32x4 rv = v;
                if (kind == 2) { rv.x = pk2(bflo(v.x) * sc, bfhi(v.x) * sc); rv.y = pk2(bflo(v.y) * sc, bfhi(v.y) * sc); rv.z = pk2(bflo(v.z) * sc, bfhi(v.z) * sc); rv.w = pk2(bflo(v.w) * sc, bfhi(v.w) * sc); }
                PREP_EMIT(i, rv); }
        } else {
            const float sc = kind == 2 ? 0.08838834764831845f : 1.f; const int odd = cg & 1;
            float inv[8];
#pragma unroll
            for (int e = 0; e < 8; ++e) inv[e] = exp2f(-(float)(8 * (c & 3) + e) * (13.287712379549449f / 32.f));
#pragma unroll
            for (int i = 0; i < 8; ++i) { const int tk = r8 + 8 * i, t = t0 + tk; const float pos = odd ? (float)(t & 63) : (float)(t >> 6);
                const u32x4 vo = *(const LAS u32x4*)(tile + tk * 64 + 8 * c), vp = *(const LAS u32x4*)(tile + tk * 64 + 8 * (c ^ 4));
                float o[8], p[8], rr[8];
                o[0] = bflo(vo.x); o[1] = bfhi(vo.x); o[2] = bflo(vo.y); o[3] = bfhi(vo.y); o[4] = bflo(vo.z); o[5] = bfhi(vo.z); o[6] = bflo(vo.w); o[7] = bfhi(vo.w);
                p[0] = bflo(vp.x); p[1] = bfhi(vp.x); p[2] = bflo(vp.y); p[3] = bfhi(vp.y); p[4] = bflo(vp.z); p[5] = bfhi(vp.z); p[6] = bflo(vp.w); p[7] = bfhi(vp.w);
#pragma unroll
                for (int e = 0; e < 8; ++e) { const float ang = pos * inv[e], cs = __cosf(ang), sn = __sinf(ang);
                    rr[e] = (c < 4 ? o[e] * cs - p[e] * sn : p[e] * sn + o[e] * cs) * sc; }
                u32x4 rv; rv.x = pk2(rr[0], rr[1]); rv.y = pk2(rr[2], rr[3]); rv.z = pk2(rr[4], rr[5]); rv.w = pk2(rr[6], rr[7]); PREP_EMIT(i, rv); }
        }
        if (trrow >= 0) {
            LDS_WAIT(); asm volatile("" ::: "memory");
            bf16_t* dst = TR + (size_t)(trrow + lane) * M + m0;
#pragma unroll
            for (int j = 0; j < 8; ++j) { unsigned wv[4];
#pragma unroll
                for (int q = 0; q < 4; ++q) { const unsigned lo = otile[(8 * j + 2 * q) * 64 + lane], hi = otile[(8 * j + 2 * q + 1) * 64 + lane]; wv[q] = lo | (hi << 16); }
                u32x4 o; o.x = wv[0]; o.y = wv[1]; o.z = wv[2]; o.w = wv[3]; *(u32x4*)(dst + 8 * j) = o; }
        }
        LDS_WAIT(); asm volatile("" ::: "memory");
    }
}

struct MlGate { float lf0, lf1, ig0, ig1, P0, P1, tot; };
__device__ __forceinline__ float wave_incl_scan(float v, int lane) {
#pragma unroll
    for (int o = 1; o < 64; o <<= 1) { const float t = __shfl_up(v, o); if (lane >= o) v += t; }
    return v;
}
__device__ __forceinline__ float wave_max(float v) {
#pragma unroll
    for (int o = 1; o < 64; o <<= 1) v = fmaxf(v, __shfl_xor(v, o));
    return v;
}
__device__ __forceinline__ MlGate ml_gates(const Args& a, int layer, int row0, int hh, int dir, int lane) {
    const float* SMALL = (const float*)(a.ws + WS_SMALL);
    const float ib = a.in[36][layer * 8 + dir * 4 + hh], fb = a.in[37][layer * 8 + dir * 4 + hh];
    MlGate g;
    const float f0 = SMALL[(size_t)(row0 + lane) * 32 + S_MF + dir * 4 + hh] + fb, f1 = SMALL[(size_t)(row0 + lane + 64) * 32 + S_MF + dir * 4 + hh] + fb;
    g.ig0 = SMALL[(size_t)(row0 + lane) * 32 + S_MI + dir * 4 + hh] + ib; g.ig1 = SMALL[(size_t)(row0 + lane + 64) * 32 + S_MI + dir * 4 + hh] + ib;
    g.lf0 = fminf(f0, 0.f) - log1pf(__expf(-fabsf(f0))); g.lf1 = fminf(f1, 0.f) - log1pf(__expf(-fabsf(f1)));
    const float s0 = wave_incl_scan(g.lf0, lane); const float tot0 = __shfl(s0, 63);
    const float s1 = wave_incl_scan(g.lf1, lane) + tot0;
    g.P0 = s0; g.P1 = s1; g.tot = __shfl(s1, 63);
    return g;
}

__device__ __forceinline__ void ml_states_phase(const Args& a, int layer, int tid_, int G) {
    int tid = tid_; asm volatile("" : "+v"(tid));
    const int lane = tid & 63, wave = __builtin_amdgcn_readfirstlane(tid >> 6), fr = lane & 15, fq = lane >> 4;
    const bf16_t* TR = (const bf16_t*)(a.ws + WS_TR);
    float* MLC = (float*)(a.ws + WS_MLC); float* MLN = (float*)(a.ws + WS_MLN); float* MLS = (float*)(a.ws + WS_MLS);
    for (int u = blockIdx.x; u < NCH * 4; u += G) {
        const int ch = u >> 2, hh = u & 3; int row0, seq0, L, lat, b, ci, nc; chunk_info(ch, row0, seq0, L, lat, b, ci, nc);
#pragma unroll 1
        for (int dir = 0; dir < 2; ++dir) {
            const MlGate g = ml_gates(a, layer, row0, hh, dir, lane);
            const float w0 = (dir == 0 ? g.tot - g.P0 : g.P0 - g.lf0) + g.ig0, w1 = (dir == 0 ? g.tot - g.P1 : g.P1 - g.lf1) + g.ig1;
            const float mloc = wave_max(fmaxf(w0, w1));
            const float e0 = __expf(w0 - mloc), e1 = __expf(w1 - mloc);
            f32x4 acc[8];
#pragma unroll
            for (int j = 0; j < 8; ++j) acc[j] = (f32x4){0.f, 0.f, 0.f, 0.f};
            float nacc[8];
#pragma unroll
            for (int j = 0; j < 8; ++j) nacc[j] = 0.f;
            const bf16_t* vrow = TR + (size_t)(T_MV + hh * 128 + wave * 16 + fr) * M + row0 + 8 * fq;
#pragma unroll
            for (int ks = 0; ks < 4; ++ks) {
                const bf16x8 af = *(const bf16x8*)(vrow + 32 * ks);
                float ev[8];
#pragma unroll
                for (int j = 0; j < 8; ++j) { const int tok = 32 * ks + 8 * fq + j; const float x0 = __shfl(e0, tok & 63), x1 = __shfl(e1, tok & 63); ev[j] = tok < 64 ? x0 : x1; }
#pragma unroll
                for (int jt = 0; jt < 8; ++jt) {
                    const u32x4 kv = *(const u32x4*)(TR + (size_t)(T_K + hh * 128 + jt * 16 + fr) * M + row0 + 32 * ks + 8 * fq);
                    const float k0 = bflo(kv.x) * ev[0], k1 = bfhi(kv.x) * ev[1], k2 = bflo(kv.y) * ev[2], k3 = bfhi(kv.y) * ev[3], k4 = bflo(kv.z) * ev[4], k5 = bfhi(kv.z) * ev[5], k6 = bflo(kv.w) * ev[6], k7 = bfhi(kv.w) * ev[7];
                    if (wave == 0) nacc[jt] += ((k0 + k1) + (k2 + k3)) + ((k4 + k5) + (k6 + k7));
                    u32x4 kb; kb.x = pk2(k0, k1); kb.y = pk2(k2, k3); kb.z = pk2(k4, k5); kb.w = pk2(k6, k7);
                    acc[jt] = mfma16(af, __builtin_bit_cast(bf16x8, kb), acc[jt]);
                }
            }
            float* cdst = MLC + ((size_t)(ch * 4 + hh) * 2 + dir) * 16384;
#pragma unroll
            for (int jt = 0; jt < 8; ++jt)
#pragma unroll
                for (int i = 0; i < 4; ++i) cdst[(size_t)(wave * 16 + 4 * fq + i) * 128 + jt * 16 + fr] = acc[jt][i];
            if (wave == 0) {
#pragma unroll
                for (int jt = 0; jt < 8; ++jt) { float v = nacc[jt]; v += __shfl_xor(v, 16); v += __shfl_xor(v, 32); if (fq == 0) MLN[((size_t)(ch * 4 + hh) * 2 + dir) * 128 + jt * 16 + fr] = v; }
                if (lane == 0) { MLS[((size_t)(ch * 4 + hh) * 2 + dir) * 4 + 0] = mloc; MLS[((size_t)(ch * 4 + hh) * 2 + dir) * 4 + 1] = g.tot; }
            }
        }
    }
}
__device__ __forceinline__ void ml_scan_phase(const Args& a, int layer, int tid_, int G) {
    int tid = tid_; asm volatile("" : "+v"(tid));
    const float* MLC = (const float*)(a.ws + WS_MLC); const float* MLN = (const float*)(a.ws + WS_MLN); const float* MLS = (const float*)(a.ws + WS_MLS);
    bf16_t* CS = (bf16_t*)(a.ws + WS_MLCS); float* NS = (float*)(a.ws + WS_MLNS); float* MS = (float*)(a.ws + WS_MLMS);
    for (int task = blockIdx.x; task < 256; task += G) {
        int lat, b, hh, dir, part, nparts;
        if (task < 128) { lat = 1; part = task & 3; dir = (task >> 2) & 1; hh = (task >> 3) & 3; b = task >> 5; nparts = 4; }
        else { const int t2 = task - 128; lat = 0; part = 0; dir = t2 & 1; hh = (t2 >> 1) & 3; b = t2 >> 3; nparts = 1; }
        const int nc = lat ? 16 : 2, ch0 = lat ? 32 + b * 16 : b * 2;
        const int nel = 16384 / nparts, e0 = part * nel, per = nel / NT;
        float c[32]; float n = 0.f, m = 0.f;
        const size_t so = (((size_t)b * DEPTH + layer) * 2 + dir) * 4 + hh;
#pragma unroll
        for (int i = 0; i < 32; ++i) if (i < per) { const int e = e0 + i * NT + tid, vd = e >> 7, kd = e & 127; c[i] = lat ? a.in[7][(so * 128 + kd) * 128 + vd] : 0.f; }
        if (tid < 128) n = lat ? a.in[8][so * 128 + tid] : 0.f;
        m = lat ? a.in[9][so] : 0.f;
        float nx[32]; float nn = 0.f, nml = 0.f, nbl = 0.f;
        { const int ch = ch0 + (dir ? nc - 1 : 0); const size_t sb = (size_t)(ch * 4 + hh) * 2 + dir;
#pragma unroll
            for (int i = 0; i < 32; ++i) if (i < per) nx[i] = MLC[sb * 16384 + e0 + i * NT + tid];
            if (tid < 128) nn = MLN[sb * 128 + tid]; nml = MLS[sb * 4 + 0]; nbl = MLS[sb * 4 + 1]; }
        for (int s = 0; s < nc; ++s) { const int ci = dir ? nc - 1 - s : s, ch = ch0 + ci; const size_t sb = (size_t)(ch * 4 + hh) * 2 + dir;
            float cx[32];
#pragma unroll
            for (int i = 0; i < 32; ++i) if (i < per) cx[i] = nx[i];
            const float cn = nn, ml = nml, bl = nbl;
            if (s + 1 < nc) { const int ch2 = ch0 + (dir ? nc - 2 - s : s + 1); const size_t sb2 = (size_t)(ch2 * 4 + hh) * 2 + dir;
#pragma unroll
                for (int i = 0; i < 32; ++i) if (i < per) nx[i] = MLC[sb2 * 16384 + e0 + i * NT + tid];
                if (tid < 128) nn = MLN[sb2 * 128 + tid]; nml = MLS[sb2 * 4 + 0]; nbl = MLS[sb2 * 4 + 1]; }
#pragma unroll
            for (int i = 0; i < 32; ++i) if (i < per) CS[sb * 16384 + e0 + i * NT + tid] = f2bf(c[i]);
            if (part == 0) { if (tid < 128) NS[sb * 128 + tid] = n; if (tid == 0) MS[sb] = m; }
            const float mn = fmaxf(bl + m, ml), fa = __expf(bl + m - mn), fb = __expf(ml - mn);
#pragma unroll
            for (int i = 0; i < 32; ++i) if (i < per) c[i] = fa * c[i] + fb * cx[i];
            if (tid < 128) n = fa * n + fb * cn;
            m = mn; }
        if (!lat) {
#pragma unroll
            for (int i = 0; i < 32; ++i) if (i < per) { const int e = e0 + i * NT + tid, vd = e >> 7, kd = e & 127; a.out[O_MLC + (so * 128 + kd) * 128 + vd] = c[i]; }
            if (tid < 128) a.out[O_MLN + so * 128 + tid] = n; if (tid == 0) a.out[O_MLM + so] = m; }
    }
}
__device__ __forceinline__ void ml_out_phase(const Args& a, int layer, int gw, int ngw, int lane_) {
    int lane = lane_; asm volatile("" : "+v"(lane));
    const int fr = lane & 15, fq = lane >> 4;
    const bf16_t* NAT = (const bf16_t*)(a.ws + WS_NAT); const bf16_t* TR = (const bf16_t*)(a.ws + WS_TR); const bf16_t* PROJ = (const bf16_t*)(a.ws + WS_PROJ);
    const bf16_t* CS = (const bf16_t*)(a.ws + WS_MLCS); const float* NS = (const float*)(a.ws + WS_MLNS); const float* MS = (const float*)(a.ws + WS_MLMS);
    bf16_t* BR = (bf16_t*)(a.ws + WS_BR);
    for (int it = gw; it < NCH * 4 * 8; it += ngw) {
        const int wv = it & 7, hh = (it >> 3) & 3, ch = it >> 5; int row0, seq0, L, lat, b, ci, nc; chunk_info(ch, row0, seq0, L, lat, b, ci, nc);
        const int t = wv * 16 + fr;
        bf16x8 qf[4];
#pragma unroll
        for (int ks = 0; ks < 4; ++ks) qf[ks] = *(const bf16x8*)(NAT + (size_t)(row0 + t) * NATP + N_Q + hh * 128 + 32 * ks + 8 * fq);
        f32x4 hsum[8];
#pragma unroll
        for (int j = 0; j < 8; ++j) hsum[j] = (f32x4){0.f, 0.f, 0.f, 0.f};
#pragma unroll 1
        for (int dir = 0; dir < 2; ++dir) {
            const size_t sb = (size_t)(ch * 4 + hh) * 2 + dir;
            const MlGate g = ml_gates(a, layer, row0, hh, dir, lane); const float ms = MS[sb];
            float u0, u1, c0, c1, ai0, ai1;
            if (dir == 0) { u0 = g.ig0 - g.P0; u1 = g.ig1 - g.P1; c0 = g.P0; c1 = g.P1; ai0 = g.P0 + ms; ai1 = g.P1 + ms; }
            else { const float E0 = g.P0 - g.lf0, E1 = g.P1 - g.lf1; u0 = E0 + g.ig0; u1 = E1 + g.ig1; c0 = -E0; c1 = -E1; ai0 = g.tot - E0 + ms; ai1 = g.tot - E1 + ms; }
            float g0 = u0, g1 = u1;
            if (dir == 0) {
#pragma unroll
                for (int o2 = 1; o2 < 64; o2 <<= 1) { const float x0 = __shfl_up(g0, o2), x1 = __shfl_up(g1, o2); if (lane >= o2) { g0 = fmaxf(g0, x0); g1 = fmaxf(g1, x1); } }
                g1 = fmaxf(g1, __shfl(g0, 63));
            } else {
#pragma unroll
                for (int o2 = 1; o2 < 64; o2 <<= 1) { const float x0 = __shfl_down(g0, o2), x1 = __shfl_down(g1, o2); if (lane + o2 < 64) { g0 = fmaxf(g0, x0); g1 = fmaxf(g1, x1); } }
                g0 = fmaxf(g0, __shfl(g1, 0));
            }
            const float mt0 = fmaxf(ai0, c0 + g0), mt1 = fmaxf(ai1, c1 + g1);
            const float w0 = c0 - mt0, w1 = c1 - mt1, si0 = __expf(ai0 - mt0), si1 = __expf(ai1 - mt1), em0 = __expf(-mt0), em1 = __expf(-mt1);
            const int tl = t & 63; const bool th = wv >= 4;
            const float wt = th ? __shfl(w1, tl) : __shfl(w0, tl), sit = th ? __shfl(si1, tl) : __shfl(si0, tl), emt = th ? __shfl(em1, tl) : __shfl(em0, tl);
            f32x4 acc[8];
#pragma unroll
            for (int j = 0; j < 8; ++j) acc[j] = (f32x4){0.f, 0.f, 0.f, 0.f};
#pragma unroll
            for (int ks = 0; ks < 4; ++ks)
#pragma unroll
                for (int j = 0; j < 8; ++j) { const bf16x8 cf = *(const bf16x8*)(CS + sb * 16384 + (size_t)(16 * j + fr) * 128 + 32 * ks + 8 * fq); acc[j] = mfma16(cf, qf[ks], acc[j]); }
            float qn = 0.f;
#pragma unroll
            for (int ks = 0; ks < 4; ++ks) { const u32x4 qv = __builtin_bit_cast(u32x4, qf[ks]); const float* nn = NS + sb * 128 + 32 * ks + 8 * fq; const f32x4 n0 = *(const f32x4*)nn, n1 = *(const f32x4*)(nn + 4);
                qn += bflo(qv.x) * n0[0] + bfhi(qv.x) * n0[1] + bflo(qv.y) * n0[2] + bfhi(qv.y) * n0[3] + bflo(qv.z) * n1[0] + bfhi(qv.z) * n1[1] + bflo(qv.w) * n1[2] + bfhi(qv.w) * n1[3]; }
            qn += __shfl_xor(qn, 16); qn += __shfl_xor(qn, 32);
#pragma unroll
            for (int j = 0; j < 8; ++j) acc[j] *= sit;
            float den = sit * qn;
            const int jlo = dir == 0 ? 0 : (wv >> 1), jhi = dir == 0 ? (wv >> 1) : 3;
            float psum = 0.f;
            for (int jp = jlo; jp <= jhi; ++jp) {
                const int ta = 32 * jp + 8 * (fr >> 2) + (fr & 3);
                f32x4 sa = (f32x4){0.f, 0.f, 0.f, 0.f}, sb2 = (f32x4){0.f, 0.f, 0.f, 0.f};
#pragma unroll
                for (int ks = 0; ks < 4; ++ks) {
                    const bf16x8 ka = *(const bf16x8*)(NAT + (size_t)(row0 + ta) * NATP + N_K + hh * 128 + 32 * ks + 8 * fq);
                    const bf16x8 kb = *(const bf16x8*)(NAT + (size_t)(row0 + ta + 4) * NATP + N_K + hh * 128 + 32 * ks + 8 * fq);
                    sa = mfma16(ka, qf[ks], sa); sb2 = mfma16(kb, qf[ks], sb2); }
                float pa[4], pb[4];
#pragma unroll
                for (int i = 0; i < 4; ++i) { const int s0 = 32 * jp + 8 * fq + i, s1 = s0 + 4;
                    const float us0 = jp < 2 ? __shfl(u0, s0 & 63) : __shfl(u1, s0 & 63), us1 = jp < 2 ? __shfl(u0, s1 & 63) : __shfl(u1, s1 & 63);
                    const bool ok0 = dir == 0 ? s0 <= t : s0 >= t, ok1 = dir == 0 ? s1 <= t : s1 >= t;
                    pa[i] = ok0 ? sa[i] * __expf(us0 + wt) : 0.f; pb[i] = ok1 ? sb2[i] * __expf(us1 + wt) : 0.f;
                    psum += pa[i] + pb[i]; }
                u32x4 pw; pw.x = pk2(pa[0], pa[1]); pw.y = pk2(pa[2], pa[3]); pw.z = pk2(pb[0], pb[1]); pw.w = pk2(pb[2], pb[3]);
                const bf16x8 pf = __builtin_bit_cast(bf16x8, pw);
#pragma unroll
                for (int j = 0; j < 8; ++j) { const bf16x8 vf = *(const bf16x8*)(TR + (size_t)(T_MV + hh * 128 + 16 * j + fr) * M + row0 + 32 * jp + 8 * fq); acc[j] = mfma16(vf, pf, acc[j]); }
            }
            psum += __shfl_xor(psum, 16); psum += __shfl_xor(psum, 32);
            den += psum;
            const float rden = 1.f / fmaxf(fabsf(den), emt);
#pragma unroll
            for (int j = 0; j < 8; ++j) hsum[j] += acc[j] * rden;
        }
        float ss = 0.f;
#pragma unroll
        for (int j = 0; j < 8; ++j) ss += (hsum[j][0] * hsum[j][0] + hsum[j][1] * hsum[j][1]) + (hsum[j][2] * hsum[j][2] + hsum[j][3] * hsum[j][3]);
        ss += __shfl_xor(ss, 16); ss += __shfl_xor(ss, 32);
        const float r = rsqrtf(ss * (1.f / 128.f) + 1e-6f);
        const float* ng = a.in[38] + layer * 512 + hh * 128;
#pragma unroll
        for (int j = 0; j < 8; ++j) { const int vd = 16 * j + 4 * fq; const f32x4 gg = *(const f32x4*)(ng + vd);
            const u32x2 ov = *(const u32x2*)(PROJ + (size_t)(row0 + t) * PJ + P_MO + hh * 128 + vd);
            const float o0 = hsum[j][0] * r * gg[0] * fsigm(bflo(ov.x)), o1 = hsum[j][1] * r * gg[1] * fsigm(bfhi(ov.x)), o2 = hsum[j][2] * r * gg[2] * fsigm(bflo(ov.y)), o3 = hsum[j][3] * r * gg[3] * fsigm(bfhi(ov.y));
            u32x2 w; w.x = pk2(o0, o1); w.y = pk2(o2, o3); *(u32x2*)(BR + (size_t)(row0 + t) * D + 1536 + hh * 128 + vd) = w; }
    }
}
}
namespace mk {
constexpr size_t WS_SST = WS_OPT_END;
constexpr size_t WS_SSL = AL(WS_SST + (size_t)NCH * 8 * 2 * 8192 * 4);
constexpr size_t WS_SSCS = AL(WS_SSL + (size_t)NCH * 8 * 2 * 4);
constexpr size_t WS_YPRE = AL(WS_SSCS + (size_t)NCH * 8 * 2 * 8192 * 2);
constexpr size_t WS_SSQ = AL(WS_YPRE + (size_t)M * 512 * 4);
constexpr size_t WS_SSD_END = AL(WS_SSQ + (size_t)M * 8 * 4);

struct SsdGate { float dt0, dt1, la0, la1, P0, P1, tot; };
__device__ __forceinline__ SsdGate ssd_gates(const Args& a, int layer, int row0, int hh, int dir, int lane) {
    const float* SMALL = (const float*)(a.ws + WS_SMALL);
    const float bias = a.in[32][layer * 16 + dir * 8 + hh], A = -__expf(a.in[33][layer * 16 + dir * 8 + hh]);
    SsdGate g;
    const float x0 = SMALL[(size_t)(row0 + lane) * 32 + S_DT + dir * 8 + hh] + bias, x1 = SMALL[(size_t)(row0 + lane + 64) * 32 + S_DT + dir * 8 + hh] + bias;
    g.dt0 = fmaxf(x0, 0.f) + log1pf(__expf(-fabsf(x0))); g.dt1 = fmaxf(x1, 0.f) + log1pf(__expf(-fabsf(x1)));
    g.la0 = g.dt0 * A; g.la1 = g.dt1 * A;
    const float s0 = wave_incl_scan(g.la0, lane); const float t0 = __shfl(s0, 63);
    const float s1 = wave_incl_scan(g.la1, lane) + t0;
    g.P0 = s0; g.P1 = s1; g.tot = __shfl(s1, 63);
    return g;
}
__device__ __forceinline__ void ssd_states_phase(const Args& a, int layer, int tid_, int G) {
    int tid = tid_; asm volatile("" : "+v"(tid));
    const int lane = tid & 63, wave = __builtin_amdgcn_readfirstlane(tid >> 6), fr = lane & 15, fq = lane >> 4;
    const bf16_t* TR = (const bf16_t*)(a.ws + WS_TR); float* SST = (float*)(a.ws + WS_SST); float* SSL = (float*)(a.ws + WS_SSL);
    for (int u = blockIdx.x; u < NCH * 8; u += G) {
        const int ch = u >> 3, hh = u & 7, grp = hh >> 2; int row0, seq0, L, lat, b, ci, nc; chunk_info(ch, row0, seq0, L, lat, b, ci, nc);
#pragma unroll 1
        for (int dir = 0; dir < 2; ++dir) {
            const SsdGate g = ssd_gates(a, layer, row0, hh, dir, lane);
            const float w0 = g.dt0 * __expf(dir == 0 ? g.tot - g.P0 : g.P0 - g.la0), w1 = g.dt1 * __expf(dir == 0 ? g.tot - g.P1 : g.P1 - g.la1);
            f32x4 acc[4];
#pragma unroll
            for (int j = 0; j < 4; ++j) acc[j] = (f32x4){0.f, 0.f, 0.f, 0.f};
#pragma unroll
            for (int ks = 0; ks < 4; ++ks) {
                float ev[8];
#pragma unroll
                for (int j = 0; j < 8; ++j) { const int tok = 32 * ks + 8 * fq + j; const float y0 = __shfl(w0, tok & 63), y1 = __shfl(w1, tok & 63); ev[j] = tok < 64 ? y0 : y1; }
                const u32x4 bv = *(const u32x4*)(TR + (size_t)(T_B + grp * 128 + wave * 16 + fr) * M + row0 + 32 * ks + 8 * fq);
                u32x4 bw; bw.x = pk2(bflo(bv.x) * ev[0], bfhi(bv.x) * ev[1]); bw.y = pk2(bflo(bv.y) * ev[2], bfhi(bv.y) * ev[3]); bw.z = pk2(bflo(bv.z) * ev[4], bfhi(bv.z) * ev[5]); bw.w = pk2(bflo(bv.w) * ev[6], bfhi(bv.w) * ev[7]);
                const bf16x8 bf = __builtin_bit_cast(bf16x8, bw);
#pragma unroll
                for (int j = 0; j < 4; ++j) { const bf16x8 xf = *(const bf16x8*)(TR + (size_t)(T_X + hh * 64 + 16 * j + fr) * M + row0 + 32 * ks + 8 * fq); acc[j] = mfma16(xf, bf, acc[j]); }
            }
            float* dst = SST + ((size_t)(ch * 8 + hh) * 2 + dir) * 8192;
#pragma unroll
            for (int j = 0; j < 4; ++j)
#pragma unroll
                for (int i = 0; i < 4; ++i) dst[(size_t)(16 * j + 4 * fq + i) * 128 + wave * 16 + fr] = acc[j][i];
            if (tid == 0) SSL[(size_t)(ch * 8 + hh) * 2 + dir] = g.tot;
        }
    }
}
__device__ __forceinline__ void ssd_scan_phase(const Args& a, int layer, int tid_, int G) {
    int tid = tid_; asm volatile("" : "+v"(tid));
    const float* SST = (const float*)(a.ws + WS_SST); const float* SSL = (const float*)(a.ws + WS_SSL); bf16_t* CS = (bf16_t*)(a.ws + WS_SSCS);
    for (int task = blockIdx.x; task < 384; task += G) {
        int lat, b, hh, dir, part, nparts;
        if (task < 128) { lat = 1; part = task & 1; dir = (task >> 1) & 1; hh = (task >> 2) & 7; b = task >> 5; nparts = 2; }
        else { const int t2 = task - 128; lat = 0; part = 0; dir = t2 & 1; hh = (t2 >> 1) & 7; b = t2 >> 4; nparts = 1; }
        const int nc = lat ? 16 : 2, ch0 = lat ? 32 + b * 16 : b * 2;
        const int nel = 8192 / nparts, e0 = part * nel, per = nel / NT;
        float c[16];
        const size_t so = ((((size_t)b * DEPTH + layer) * 2 + dir) * 8 + hh) * 8192;
#pragma unroll
        for (int i = 0; i < 16; ++i) if (i < per) c[i] = lat ? a.in[6][so + e0 + i * NT + tid] : 0.f;
        float nx[16]; float ntot;
        { const int ch = ch0 + (dir ? nc - 1 : 0); const size_t sb = (size_t)(ch * 8 + hh) * 2 + dir;
#pragma unroll
            for (int i = 0; i < 16; ++i) if (i < per) nx[i] = SST[sb * 8192 + e0 + i * NT + tid];
            ntot = SSL[sb]; }
        for (int s = 0; s < nc; ++s) { const int ci = dir ? nc - 1 - s : s, ch = ch0 + ci; const size_t sb = (size_t)(ch * 8 + hh) * 2 + dir;
            float cx[16];
#pragma unroll
            for (int i = 0; i < 16; ++i) if (i < per) cx[i] = nx[i];
            const float dec = __expf(ntot);
            if (s + 1 < nc) { const int ch2 = ch0 + (dir ? nc - 2 - s : s + 1); const size_t sb2 = (size_t)(ch2 * 8 + hh) * 2 + dir;
#pragma unroll
                for (int i = 0; i < 16; ++i) if (i < per) nx[i] = SST[sb2 * 8192 + e0 + i * NT + tid];
                ntot = SSL[sb2]; }
#pragma unroll
            for (int i = 0; i < 16; ++i) if (i < per) CS[sb * 8192 + e0 + i * NT + tid] = f2bf(c[i]);
#pragma unroll
            for (int i = 0; i < 16; ++i) if (i < per) c[i] = dec * c[i] + cx[i]; }
        if (!lat) {
#pragma unroll
            for (int i = 0; i < 16; ++i) if (i < per) a.out[O_SSD + so + e0 + i * NT + tid] = c[i]; }
    }
}
__device__ __forceinline__ void ssd_out_phase(const Args& a, int layer, int gw, int ngw, int lane_) {
    int lane = lane_; asm volatile("" : "+v"(lane));
    const int fr = lane & 15, fq = lane >> 4;
    const bf16_t* NAT = (const bf16_t*)(a.ws + WS_NAT); const bf16_t* TR = (const bf16_t*)(a.ws + WS_TR); const bf16_t* PROJ = (const bf16_t*)(a.ws + WS_PROJ);
    const bf16_t* CS = (const bf16_t*)(a.ws + WS_SSCS); float* YPRE = (float*)(a.ws + WS_YPRE); float* SSQ = (float*)(a.ws + WS_SSQ);
    for (int it = gw; it < NCH * 8 * 8; it += ngw) {
        const int wv = it & 7, hh = (it >> 3) & 7, ch = it >> 6, grp = hh >> 2; int row0, seq0, L, lat, b, ci, nc; chunk_info(ch, row0, seq0, L, lat, b, ci, nc);
        const int t = wv * 16 + fr;
        bf16x8 cf[4];
#pragma unroll
        for (int ks = 0; ks < 4; ++ks) cf[ks] = *(const bf16x8*)(NAT + (size_t)(row0 + t) * NATP + N_XBC + 768 + grp * 128 + 32 * ks + 8 * fq);
        f32x4 ysum[4];
#pragma unroll
        for (int j = 0; j < 4; ++j) ysum[j] = (f32x4){0.f, 0.f, 0.f, 0.f};
#pragma unroll 1
        for (int dir = 0; dir < 2; ++dir) {
            const size_t sb = (size_t)(ch * 8 + hh) * 2 + dir;
            const SsdGate g = ssd_gates(a, layer, row0, hh, dir, lane);
            float u0, u1, w0, w1, e0, e1;
            if (dir == 0) { u0 = -g.P0; u1 = -g.P1; w0 = g.P0; w1 = g.P1; e0 = __expf(g.P0); e1 = __expf(g.P1); }
            else { const float E0 = g.P0 - g.la0, E1 = g.P1 - g.la1; u0 = E0; u1 = E1; w0 = -E0; w1 = -E1; e0 = __expf(g.tot - E0); e1 = __expf(g.tot - E1); }
            const int tl = t & 63; const bool th = wv >= 4;
            const float wt = th ? __shfl(w1, tl) : __shfl(w0, tl), eot = th ? __shfl(e1, tl) : __shfl(e0, tl);
            f32x4 acc[4];
#pragma unroll
            for (int j = 0; j < 4; ++j) acc[j] = (f32x4){0.f, 0.f, 0.f, 0.f};
#pragma unroll
            for (int ks = 0; ks < 4; ++ks)
#pragma unroll
                for (int j = 0; j < 4; ++j) { const bf16x8 sf = *(const bf16x8*)(CS + sb * 8192 + (size_t)(16 * j + fr) * 128 + 32 * ks + 8 * fq); acc[j] = mfma16(sf, cf[ks], acc[j]); }
#pragma unroll
            for (int j = 0; j < 4; ++j) acc[j] *= eot;
            const int jlo = dir == 0 ? 0 : (wv >> 1), jhi = dir == 0 ? (wv >> 1) : 3;
            for (int jp = jlo; jp <= jhi; ++jp) {
                const int ta = 32 * jp + 8 * (fr >> 2) + (fr & 3);
                f32x4 sa = (f32x4){0.f, 0.f, 0.f, 0.f}, sb2 = (f32x4){0.f, 0.f, 0.f, 0.f};
#pragma unroll
                for (int ks = 0; ks < 4; ++ks) {
                    const bf16x8 ba = *(const bf16x8*)(NAT + (size_t)(row0 + ta) * NATP + N_XBC + 512 + grp * 128 + 32 * ks + 8 * fq);
                    const bf16x8 bb = *(const bf16x8*)(NAT + (size_t)(row0 + ta + 4) * NATP + N_XBC + 512 + grp * 128 + 32 * ks + 8 * fq);
                    sa = mfma16(ba, cf[ks], sa); sb2 = mfma16(bb, cf[ks], sb2); }
                float pa[4], pb[4];
#pragma unroll
                for (int i = 0; i < 4; ++i) { const int s0 = 32 * jp + 8 * fq + i, s1 = s0 + 4;
                    const float us0 = jp < 2 ? __shfl(u0, s0 & 63) : __shfl(u1, s0 & 63), us1 = jp < 2 ? __shfl(u0, s1 & 63) : __shfl(u1, s1 & 63);
                    const float d0 = jp < 2 ? __shfl(g.dt0, s0 & 63) : __shfl(g.dt1, s0 & 63), d1 = jp < 2 ? __shfl(g.dt0, s1 & 63) : __shfl(g.dt1, s1 & 63);
                    const bool ok0 = dir == 0 ? s0 <= t : s0 >= t, ok1 = dir == 0 ? s1 <= t : s1 >= t;
                    pa[i] = ok0 ? sa[i] * d0 * __expf(us0 + wt) : 0.f; pb[i] = ok1 ? sb2[i] * d1 * __expf(us1 + wt) : 0.f; }
                u32x4 pw; pw.x = pk2(pa[0], pa[1]); pw.y = pk2(pa[2], pa[3]); pw.z = pk2(pb[0], pb[1]); pw.w = pk2(pb[2], pb[3]);
                const bf16x8 pf = __builtin_bit_cast(bf16x8, pw);
#pragma unroll
                for (int j = 0; j < 4; ++j) { const bf16x8 xf = *(const bf16x8*)(TR + (size_t)(T_X + hh * 64 + 16 * j + fr) * M + row0 + 32 * jp + 8 * fq); acc[j] = mfma16(xf, pf, acc[j]); }
            }
#pragma unroll
            for (int j = 0; j < 4; ++j) ysum[j] += acc[j];
        }
        const float Dh = a.in[34][layer * 8 + hh]; float ss = 0.f;
#pragma unroll
        for (int j = 0; j < 4; ++j) { const int p = 16 * j + 4 * fq;
            const u32x2 xv = *(const u32x2*)(NAT + (size_t)(row0 + t) * NATP + N_XBC + hh * 64 + p), zv = *(const u32x2*)(PROJ + (size_t)(row0 + t) * PJ + P_Z + hh * 64 + p);
            f32x4 y; y[0] = (ysum[j][0] + bflo(xv.x) * Dh) * fsilu(bflo(zv.x)); y[1] = (ysum[j][1] + bfhi(xv.x) * Dh) * fsilu(bfhi(zv.x));
            y[2] = (ysum[j][2] + bflo(xv.y) * Dh) * fsilu(bflo(zv.y)); y[3] = (ysum[j][3] + bfhi(xv.y) * Dh) * fsilu(bfhi(zv.y));
            ss += (y[0] * y[0] + y[1] * y[1]) + (y[2] * y[2] + y[3] * y[3]);
            *(f32x4*)(YPRE + (size_t)(row0 + t) * 512 + hh * 64 + p) = y; }
        ss += __shfl_xor(ss, 16); ss += __shfl_xor(ss, 32);
        if (fq == 0) SSQ[(size_t)(row0 + t) * 8 + hh] = ss;
    }
}
__device__ __forceinline__ void ssd_fin_phase(const Args& a, int layer, int gw, int ngw, int lane_) {
    int lane = lane_; asm volatile("" : "+v"(lane));
    const float* YPRE = (const float*)(a.ws + WS_YPRE); const float* SSQ = (const float*)(a.ws + WS_SSQ); bf16_t* BR = (bf16_t*)(a.ws + WS_BR); const float* ng = a.in[35] + layer * 512;
    for (int row = gw; row < M; row += ngw) {
        float s = lane < 8 ? SSQ[(size_t)row * 8 + lane] : 0.f; s += __shfl_xor(s, 1); s += __shfl_xor(s, 2); s += __shfl_xor(s, 4); s = __shfl(s, 0);
        const float r = rsqrtf(s * (1.f / 512.f) + 1e-6f);
        const f32x4 y0 = *(const f32x4*)(YPRE + (size_t)row * 512 + 8 * lane), y1 = *(const f32x4*)(YPRE + (size_t)row * 512 + 8 * lane + 4);
        const f32x4 g0 = *(const f32x4*)(ng + 8 * lane), g1 = *(const f32x4*)(ng + 8 * lane + 4);
        *(u32x4*)(BR + (size_t)row * D + 1024 + 8 * lane) = pack8(y0 * r * g0, y1 * r * g1);
    }
}
}
namespace mk {
constexpr size_t WS_CK = WS_SSD_END;
constexpr size_t WS_CVT = AL(WS_CK + (size_t)16 * 512 * 512 * 2);
constexpr size_t WS_ATT_END = AL(WS_CVT + (size_t)16 * 512 * 512 * 2);

__device__ __forceinline__ void prologue_cache(const Args& a, int gw, int ngw, int lane) {
    bf16_t* CK = (bf16_t*)(a.ws + WS_CK); bf16_t* CVT = (bf16_t*)(a.ws + WS_CVT);
    for (size_t i = ((size_t)gw * 64 + lane) * 8; i < (size_t)16 * 512 * 512; i += (size_t)ngw * 64 * 8) {
        const f32x4 x0 = *(const f32x4*)(a.in[2] + i), x1 = *(const f32x4*)(a.in[2] + i + 4); *(u32x4*)(CK + i) = pack8(x0, x1); }
    for (size_t i = (size_t)gw * 64 + lane; i < (size_t)16 * 64 * 512; i += (size_t)ngw * 64) { const int c = i & 511, s8 = (i >> 9) & 63, bl = i >> 15;
        const float* src = a.in[3] + ((size_t)bl * 512 + 8 * s8) * 512 + c;
        u32x4 o; o.x = pk2(src[0], src[512]); o.y = pk2(src[1024], src[1536]); o.z = pk2(src[2048], src[2560]); o.w = pk2(src[3072], src[3584]);
        *(u32x4*)(CVT + ((size_t)bl * 512 + c) * 512 + 8 * s8) = o; }
}
struct AttState { float m, l; f32x4 o[4]; };
struct AttFrags { bf16x8 k[4]; const bf16_t* vt; size_t vp; };
__device__ __forceinline__ void attn_load(AttFrags& f, const bf16_t* kbase, size_t kp, const bf16_t* vt, size_t vp, int fr, int fq) {
    const int ra = 8 * (fr >> 2) + (fr & 3);
#pragma unroll
    for (int ks = 0; ks < 2; ++ks) { f.k[ks] = *(const bf16x8*)(kbase + (size_t)ra * kp + 32 * ks + 8 * fq); f.k[2 + ks] = *(const bf16x8*)(kbase + (size_t)(ra + 4) * kp + 32 * ks + 8 * fq); }
    f.vt = vt + (size_t)fr * vp + 8 * fq; f.vp = vp;
}
template <bool MASKED>
__device__ __forceinline__ void attn_compute(AttState& st, const bf16x8 (&qf)[2], const AttFrags& f, int fq, const float* bias, int kc0, int cq, int cs) {
    bf16x8 vf[4];
#pragma unroll
    for (int j = 0; j < 4; ++j) vf[j] = *(const bf16x8*)(f.vt + (size_t)(16 * j) * f.vp);
    f32x4 sa = (f32x4){0.f, 0.f, 0.f, 0.f}, sb = (f32x4){0.f, 0.f, 0.f, 0.f};
#pragma unroll
    for (int ks = 0; ks < 2; ++ks) { sa = mfma16(f.k[ks], qf[ks], sa); sb = mfma16(f.k[2 + ks], qf[ks], sb); }
    float s[8]; float gm = -1e30f;
#pragma unroll
    for (int i = 0; i < 4; ++i) { s[i] = sa[i] * 0.125f; s[4 + i] = sb[i] * 0.125f; }
    if (MASKED) {
#pragma unroll
        for (int e = 0; e < 8; ++e) { const int kc = kc0 + 8 * fq + e; const bool ok = kc >= cs && kc < cs + 16; const int bi = min(max(kc - cq + 15, 0), 30); s[e] = ok ? s[e] + bias[bi] : -1e30f; }
    }
#pragma unroll
    for (int e = 0; e < 8; ++e) gm = fmaxf(gm, s[e]);
    gm = fmaxf(gm, __shfl_xor(gm, 16)); gm = fmaxf(gm, __shfl_xor(gm, 32));
    const float mn = fmaxf(st.m, gm), al = __expf(st.m - mn); st.m = mn;
    float p[8], ps = 0.f;
#pragma unroll
    for (int e = 0; e < 8; ++e) { p[e] = __expf(s[e] - mn); ps += p[e]; }
    st.l = st.l * al + ps;
    u32x4 pw; pw.x = pk2(p[0], p[1]); pw.y = pk2(p[2], p[3]); pw.z = pk2(p[4], p[5]); pw.w = pk2(p[6], p[7]);
    const bf16x8 pf = __builtin_bit_cast(bf16x8, pw);
#pragma unroll
    for (int j = 0; j < 4; ++j) st.o[j] = mfma16(vf[j], pf, st.o[j] * al);
}
__device__ __forceinline__ void attn_phase(const Args& a, int layer, int gw_, int ngw, int lane_) {
    int lane = lane_, gw = gw_; asm volatile("" : "+v"(lane));
    const int fr = lane & 15, fq = lane >> 4;
    const bf16_t* PROJ = (const bf16_t*)(a.ws + WS_PROJ); const bf16_t* TR = (const bf16_t*)(a.ws + WS_TR); bf16_t* BR = (bf16_t*)(a.ws + WS_BR);
    const bf16_t* CK = (const bf16_t*)(a.ws + WS_CK); const bf16_t* CVT = (const bf16_t*)(a.ws + WS_CVT);
    for (int it = gw; it < 6144; it += ngw) {
        AttState st; st.m = -1e30f; st.l = 0.f;
#pragma unroll
        for (int j = 0; j < 4; ++j) st.o[j] = (f32x4){0.f, 0.f, 0.f, 0.f};
        int qrow, hh; AttFrags fa, fb;
        if (it < 4096) {
            const int jq = it & 3, r = (it >> 2) & 31; hh = (it >> 7) & 7; const int b = it >> 10;
            const int seq0 = MP + b * 2048; qrow = seq0 + r * 64 + 16 * jq + fr;
            bf16x8 qf[2];
#pragma unroll
            for (int ks = 0; ks < 2; ++ks) qf[ks] = *(const bf16x8*)(PROJ + (size_t)qrow * PJ + P_Q + hh * 64 + 32 * ks + 8 * fq);
            const int rs = min(max(r - 4, 0), 24), cq = 16 * jq + fr, cs = min(max(cq - 8, 0), 48);
            const int kc0 = jq == 0 ? 0 : (jq == 1 ? 8 : (jq == 2 ? 24 : 32));
            const float* rpb = a.in[19] + ((size_t)layer * 8 + hh) * 15 * 31;
            const bf16_t* kw = PROJ + (size_t)(seq0 + rs * 64 + kc0) * PJ + P_K + hh * 64; const bf16_t* vw = TR + (size_t)(T_V + hh * 64) * M + seq0 + rs * 64 + kc0;
            const size_t cb = ((size_t)b * DEPTH + layer) * 512; const bf16_t* kc = CK + cb * 512 + hh * 64; const bf16_t* vc = CVT + (cb + hh * 64) * 512;
            attn_load(fa, kw, PJ, vw, M, fr, fq);
#pragma unroll 1
            for (int j = 0; j < 8; j += 2) {
                attn_load(fb, kw + (size_t)(j + 1) * 64 * PJ, PJ, vw + (j + 1) * 64, M, fr, fq);
                attn_compute<true>(st, qf, fa, fq, rpb + (rs + j - r + 7) * 31, kc0, cq, cs);
                if (j + 2 < 8) attn_load(fa, kw + (size_t)(j + 2) * 64 * PJ, PJ, vw + (j + 2) * 64, M, fr, fq); else attn_load(fa, kc, 512, vc, 512, fr, fq);
                attn_compute<true>(st, qf, fb, fq, rpb + (rs + j + 1 - r + 7) * 31, kc0, cq, cs);
            }
#pragma unroll 1
            for (int g = 0; g < 16; g += 2) {
                attn_load(fb, kc + (size_t)(32 * (g + 1)) * 512, 512, vc + 32 * (g + 1), 512, fr, fq);
                attn_compute<false>(st, qf, fa, fq, nullptr, 0, 0, 0);
                if (g + 2 < 16) attn_load(fa, kc + (size_t)(32 * (g + 2)) * 512, 512, vc + 32 * (g + 2), 512, fr, fq);
                attn_compute<false>(st, qf, fb, fq, nullptr, 0, 0, 0);
            }
        } else {
            const int i2 = it - 4096, qt = i2 & 15; hh = (i2 >> 4) & 7; const int b = i2 >> 7, seq0 = b * 256; qrow = seq0 + 16 * qt + fr;
            bf16x8 qf[2];
#pragma unroll
            for (int ks = 0; ks < 2; ++ks) qf[ks] = *(const bf16x8*)(PROJ + (size_t)qrow * PJ + P_Q + hh * 64 + 32 * ks + 8 * fq);
            const bf16_t* kp = PROJ + (size_t)seq0 * PJ + P_K + hh * 64; const bf16_t* vp = TR + (size_t)(T_V + hh * 64) * M + seq0;
            attn_load(fa, kp, PJ, vp, M, fr, fq);
#pragma unroll 1
            for (int g = 0; g < 8; g += 2) {
                attn_load(fb, kp + (size_t)(32 * (g + 1)) * PJ, PJ, vp + 32 * (g + 1), M, fr, fq);
                attn_compute<false>(st, qf, fa, fq, nullptr, 0, 0, 0);
                if (g + 2 < 8) attn_load(fa, kp + (size_t)(32 * (g + 2)) * PJ, PJ, vp + 32 * (g + 2), M, fr, fq);
                attn_compute<false>(st, qf, fb, fq, nullptr, 0, 0, 0);
            }
        }
        float l = st.l; l += __shfl_xor(l, 16); l += __shfl_xor(l, 32);
        const float rl = 1.f / l;
#pragma unroll
        for (int j = 0; j < 4; ++j) { u32x2 w; w.x = pk2(st.o[j][0] * rl, st.o[j][1] * rl); w.y = pk2(st.o[j][2] * rl, st.o[j][3] * rl);
            *(u32x2*)(BR + (size_t)qrow * D + hh * 64 + 16 * j + 4 * fq) = w; }
    }
}
}
namespace mk {
constexpr int S5K = 768;
constexpr size_t WS_S5W = WS_ATT_END;
constexpr size_t WS_S5WS = AL(WS_S5W + (size_t)DEPTH * 32 * 512 * S5K * 2);
constexpr size_t WS_S5AP = AL(WS_S5WS + (size_t)DEPTH * 32 * 256 * 512 * 2);
constexpr size_t WS_S5UP = AL(WS_S5AP + (size_t)DEPTH * 32 * 2 * 64 * 2 * 4);
constexpr size_t WS_S5SS = AL(WS_S5UP + (size_t)32 * 384 * 512 * 2);
constexpr size_t WS_S5HS = AL(WS_S5SS + (size_t)32 * 384 * 256 * 4);
constexpr size_t WS_S5_END = AL(WS_S5HS + (size_t)32 * 384 * 256 * 2);

__device__ __forceinline__ void s5_param_task(const Args& a, LAS unsigned char* lds, int tid_, int task) {
    int tid = tid_; asm volatile("" : "+v"(tid));
    LAS float* PW = (LAS float*)lds; LAS float* BB = PW + 2 * 33 * 64 * 2; LAS float* CC = BB + 2 * 64 * 16 * 2; LAS float* KT = CC + 2 * 16 * 64 * 2;
    {
        const int layer = task >> 5, g = task & 31;
        const float* a_re = a.in[20] + layer * 4096; const float* a_im = a.in[21] + layer * 4096; const float* log_dt = a.in[22] + layer * 64;
        const float* b_re = a.in[23] + (size_t)layer * 65536; const float* b_im = a.in[24] + (size_t)layer * 65536; const float* c_re = a.in[25] + (size_t)layer * 65536; const float* c_im = a.in[26] + (size_t)layer * 65536;
        const float* s5d = a.in[27] + layer * 512;
        bf16_t* S5W = (bf16_t*)(a.ws + WS_S5W) + (size_t)layer * 32 * 512 * S5K; bf16_t* S5WS = (bf16_t*)(a.ws + WS_S5WS) + (size_t)layer * 32 * 256 * 512; float* S5AP = (float*)(a.ws + WS_S5AP) + (size_t)layer * 32 * 2 * 64 * 2;
        __syncthreads();
        if (tid < 128) { const int dir = tid >> 6, n = tid & 63, pi = (dir * 32 + g) * 64 + n;
            const float are = fminf(a_re[pi], -1e-4f), aim = a_im[pi], dt = expf(log_dt[dir * 32 + g]);
            const float mag = expf(dt * are), abr = mag * cosf(dt * aim), abi = mag * sinf(dt * aim);
            const float den = are * are + aim * aim, nr = abr - 1.f, cfr = (nr * are + abi * aim) / den, cfi = (abi * are - nr * aim) / den;
            float pr = 1.f, pim = 0.f;
            for (int p = 0; p <= 32; ++p) { PW[((dir * 33 + p) * 64 + n) * 2] = pr; PW[((dir * 33 + p) * 64 + n) * 2 + 1] = pim; const float t = pr * abr - pim * abi; pim = pr * abi + pim * abr; pr = t; }
            S5AP[((g * 2 + dir) * 64 + n) * 2] = PW[((dir * 33 + 32) * 64 + n) * 2]; S5AP[((g * 2 + dir) * 64 + n) * 2 + 1] = PW[((dir * 33 + 32) * 64 + n) * 2 + 1];
            for (int k = 0; k < 16; ++k) { const float br_ = b_re[(size_t)pi * 16 + k], bi_ = b_im[(size_t)pi * 16 + k];
                BB[((dir * 64 + n) * 16 + k) * 2] = cfr * br_ - cfi * bi_; BB[((dir * 64 + n) * 16 + k) * 2 + 1] = cfr * bi_ + cfi * br_; }
            for (int j = 0; j < 16; ++j) { CC[((dir * 64 + n) * 16 + j) * 2] = c_re[((size_t)(dir * 32 + g) * 16 + j) * 64 + n]; CC[((dir * 64 + n) * 16 + j) * 2 + 1] = c_im[((size_t)(dir * 32 + g) * 16 + j) * 64 + n]; }
        }
        __syncthreads();
        for (int e = tid; e < 2 * 32 * 256; e += NT) { const int j = e & 15, k = (e >> 4) & 15, tau = (e >> 8) & 31, dir = e >> 13; float s = 0.f;
            for (int n = 0; n < 64; ++n) { const float cr = CC[((dir * 64 + n) * 16 + j) * 2], ci = CC[((dir * 64 + n) * 16 + j) * 2 + 1], pr = PW[((dir * 33 + tau) * 64 + n) * 2], pim = PW[((dir * 33 + tau) * 64 + n) * 2 + 1];
                const float xr = cr * pr - ci * pim, xi = cr * pim + ci * pr, br_ = BB[((dir * 64 + n) * 16 + k) * 2], bi_ = BB[((dir * 64 + n) * 16 + k) * 2 + 1];
                s += xr * br_ - xi * bi_; }
            KT[e] = s; }
        __syncthreads();
        { const int t = tid >> 4, j = tid & 15; bf16_t* dst = S5W + ((size_t)g * 512 + tid) * S5K;
            for (int s = 0; s < 32; ++s) { float v[16];
#pragma unroll
                for (int k = 0; k < 16; ++k) { float x;
                    if (s < t) x = KT[((0 * 32 + (t - s)) * 16 + k) * 16 + j]; else if (s > t) x = KT[((1 * 32 + (s - t)) * 16 + k) * 16 + j];
                    else x = KT[((0 * 32 + 0) * 16 + k) * 16 + j] + KT[((1 * 32 + 0) * 16 + k) * 16 + j] + (k == j ? s5d[g * 16 + k] : 0.f);
                    v[k] = x; }
                u32x4 o0, o1; o0.x = pk2(v[0], v[1]); o0.y = pk2(v[2], v[3]); o0.z = pk2(v[4], v[5]); o0.w = pk2(v[6], v[7]); o1.x = pk2(v[8], v[9]); o1.y = pk2(v[10], v[11]); o1.z = pk2(v[12], v[13]); o1.w = pk2(v[14], v[15]);
                *(u32x4*)(dst + s * 16) = o0; *(u32x4*)(dst + s * 16 + 8) = o1; }
            for (int dir = 0; dir < 2; ++dir) { const int p = dir == 0 ? t + 1 : 32 - t;
                for (int n8 = 0; n8 < 8; ++n8) { float gr[8], gi[8];
#pragma unroll
                    for (int q = 0; q < 8; ++q) { const int n = n8 * 8 + q; const float cr = CC[((dir * 64 + n) * 16 + j) * 2], ci = CC[((dir * 64 + n) * 16 + j) * 2 + 1], pr = PW[((dir * 33 + p) * 64 + n) * 2], pim = PW[((dir * 33 + p) * 64 + n) * 2 + 1];
                        gr[q] = cr * pr - ci * pim; gi[q] = -(cr * pim + ci * pr); }
                    u32x4 o; o.x = pk2(gr[0], gr[1]); o.y = pk2(gr[2], gr[3]); o.z = pk2(gr[4], gr[5]); o.w = pk2(gr[6], gr[7]); *(u32x4*)(dst + 512 + dir * 128 + n8 * 8) = o;
                    o.x = pk2(gi[0], gi[1]); o.y = pk2(gi[2], gi[3]); o.z = pk2(gi[4], gi[5]); o.w = pk2(gi[6], gi[7]); *(u32x4*)(dst + 512 + dir * 128 + 64 + n8 * 8) = o; } }
        }
        if (tid < 256) { const int dir = tid >> 7, reim = (tid >> 6) & 1, n = tid & 63; bf16_t* dst = S5WS + ((size_t)g * 256 + tid) * 512;
            for (int s = 0; s < 32; ++s) { const int p = dir == 0 ? 31 - s : s; const float pr = PW[((dir * 33 + p) * 64 + n) * 2], pim = PW[((dir * 33 + p) * 64 + n) * 2 + 1]; float v[16];
#pragma unroll
                for (int k = 0; k < 16; ++k) { const float br_ = BB[((dir * 64 + n) * 16 + k) * 2], bi_ = BB[((dir * 64 + n) * 16 + k) * 2 + 1]; v[k] = reim == 0 ? pr * br_ - pim * bi_ : pr * bi_ + pim * br_; }
                u32x4 o0, o1; o0.x = pk2(v[0], v[1]); o0.y = pk2(v[2], v[3]); o0.z = pk2(v[4], v[5]); o0.w = pk2(v[6], v[7]); o1.x = pk2(v[8], v[9]); o1.y = pk2(v[10], v[11]); o1.z = pk2(v[12], v[13]); o1.w = pk2(v[14], v[15]);
                *(u32x4*)(dst + s * 16) = o0; *(u32x4*)(dst + s * 16 + 8) = o1; } }
    }
    __syncthreads();
}
__device__ __forceinline__ void s5_statein_phase(const Args& a, int layer, int gw, int ngw, int lane_) {
    int lane = lane_; asm volatile("" : "+v"(lane));
    const int fr = lane & 15, fq = lane >> 4;
    const bf16_t* UP = (const bf16_t*)(a.ws + WS_S5UP); const bf16_t* S5WS = (const bf16_t*)(a.ws + WS_S5WS) + (size_t)layer * 32 * 256 * 512; float* SS = (float*)(a.ws + WS_S5SS);
    for (int it = ngw - 1 - gw; it < 32 * 24; it += ngw) { const int g = it / 24, r = it % 24, og = r / 6, cq = r % 6;
        f32x4 acc[4][4];
#pragma unroll
        for (int i = 0; i < 4; ++i)
#pragma unroll
            for (int j = 0; j < 4; ++j) acc[i][j] = (f32x4){0.f, 0.f, 0.f, 0.f};
        const bf16_t* ap = S5WS + ((size_t)g * 256 + 64 * og + fr) * 512 + 8 * fq; const bf16_t* bp = UP + ((size_t)g * 384 + 64 * cq + fr) * 512 + 8 * fq;
#pragma unroll 2
        for (int ks = 0; ks < 16; ++ks) { bf16x8 af[4], bf[4];
#pragma unroll
            for (int i = 0; i < 4; ++i) { af[i] = *(const bf16x8*)(ap + (size_t)16 * i * 512 + 32 * ks); bf[i] = *(const bf16x8*)(bp + (size_t)16 * i * 512 + 32 * ks); }
#pragma unroll
            for (int i = 0; i < 4; ++i)
#pragma unroll
                for (int j = 0; j < 4; ++j) acc[i][j] = mfma16(af[i], bf[j], acc[i][j]); }
#pragma unroll
        for (int i = 0; i < 4; ++i)
#pragma unroll
            for (int j = 0; j < 4; ++j) *(f32x4*)(SS + ((size_t)g * 384 + 64 * cq + 16 * j + fr) * 256 + 64 * og + 16 * i + 4 * fq) = acc[i][j];
    }
}
__device__ __forceinline__ void s5_scan_phase(const Args& a, int layer, int gw, int ngw, int lane_) {
    int lane = lane_; asm volatile("" : "+v"(lane));
    const float* SS = (const float*)(a.ws + WS_S5SS); bf16_t* HS = (bf16_t*)(a.ws + WS_S5HS); const float* S5AP = (const float*)(a.ws + WS_S5AP) + (size_t)layer * 32 * 2 * 64 * 2;
    for (int task = gw; task < 1280; task += ngw) {
        int sq, g, dir; if (task < 256) { sq = 16 + (task >> 6); g = (task >> 1) & 31; dir = task & 1; } else { const int t2 = task - 256; sq = t2 >> 6; g = (t2 >> 1) & 31; dir = t2 & 1; }
        const int lat = sq >= 16, b = lat ? sq - 16 : sq, nc = lat ? 64 : 8, cg0 = lat ? 128 + b * 64 : b * 8;
        const float apr = S5AP[((g * 2 + dir) * 64 + lane) * 2], api = S5AP[((g * 2 + dir) * 64 + lane) * 2 + 1];
        float hr = 0.f, hi = 0.f;
        if (lat) { const size_t so = ((((size_t)b * DEPTH + layer) * 2 + dir) * 32 + g) * 64 + lane; hr = a.in[4][so]; hi = a.in[5][so]; }
        for (int s0 = 0; s0 < nc; s0 += 8) {
            float sr[8], si[8];
#pragma unroll
            for (int q = 0; q < 8; ++q) { const int cg = cg0 + (dir ? nc - 1 - (s0 + q) : s0 + q); const size_t base = ((size_t)g * 384 + cg) * 256 + dir * 128; sr[q] = SS[base + lane]; si[q] = SS[base + 64 + lane]; }
#pragma unroll
            for (int q = 0; q < 8; ++q) { const int cg = cg0 + (dir ? nc - 1 - (s0 + q) : s0 + q); const size_t base = ((size_t)g * 384 + cg) * 256 + dir * 128;
                HS[base + lane] = f2bf(hr); HS[base + 64 + lane] = f2bf(hi);
                const float t = apr * hr - api * hi + sr[q]; hi = apr * hi + api * hr + si[q]; hr = t; }
        }
        if (!lat) { const size_t oo = ((((size_t)b * DEPTH + layer) * 2 + dir) * 32 + g) * 64 + lane; a.out[O_S5R + oo] = hr; a.out[O_S5I + oo] = hi; }
    }
}
__device__ __forceinline__ void s5_out_phase(const Args& a, int layer, int gw, int ngw, int lane_) {
    int lane = lane_; asm volatile("" : "+v"(lane));
    const int fr = lane & 15, fq = lane >> 4;
    const bf16_t* UP = (const bf16_t*)(a.ws + WS_S5UP); const bf16_t* S5W = (const bf16_t*)(a.ws + WS_S5W) + (size_t)layer * 32 * 512 * S5K; const bf16_t* HS = (const bf16_t*)(a.ws + WS_S5HS); bf16_t* ZB = (bf16_t*)(a.ws + WS_ZB);
    for (int it = ngw - 1 - gw; it < 32 * 48; it += ngw) { const int g = it / 48, r = it % 48, og = r / 6, cq = r % 6;
        f32x4 acc[4][4];
#pragma unroll
        for (int i = 0; i < 4; ++i)
#pragma unroll
            for (int j = 0; j < 4; ++j) acc[i][j] = (f32x4){0.f, 0.f, 0.f, 0.f};
        const bf16_t* ap = S5W + ((size_t)g * 512 + 64 * og + fr) * S5K + 8 * fq;
        const bf16_t* bp = UP + ((size_t)g * 384 + 64 * cq + fr) * 512 + 8 * fq; const bf16_t* hp = HS + ((size_t)g * 384 + 64 * cq + fr) * 256 + 8 * fq;
#pragma unroll 2
        for (int ks = 0; ks < 16; ++ks) { bf16x8 af[4], bf[4];
#pragma unroll
            for (int i = 0; i < 4; ++i) { af[i] = *(const bf16x8*)(ap + (size_t)16 * i * S5K + 32 * ks); bf[i] = *(const bf16x8*)(bp + (size_t)16 * i * 512 + 32 * ks); }
#pragma unroll
            for (int i = 0; i < 4; ++i)
#pragma unroll
                for (int j = 0; j < 4; ++j) acc[i][j] = mfma16(af[i], bf[j], acc[i][j]); }
#pragma unroll 2
        for (int ks = 0; ks < 8; ++ks) { bf16x8 af[4], bf[4];
#pragma unroll
            for (int i = 0; i < 4; ++i) { af[i] = *(const bf16x8*)(ap + (size_t)16 * i * S5K + 512 + 32 * ks); bf[i] = *(const bf16x8*)(hp + (size_t)16 * i * 256 + 32 * ks); }
#pragma unroll
            for (int i = 0; i < 4; ++i)
#pragma unroll
                for (int j = 0; j < 4; ++j) acc[i][j] = mfma16(af[i], bf[j], acc[i][j]); }
#pragma unroll
        for (int i = 0; i < 4; ++i)
#pragma unroll
            for (int j = 0; j < 4; ++j) { float z[4];
#pragma unroll
                for (int e = 0; e < 4; ++e) { const float x = acc[i][j][e]; const float th = 0.7978845608028654f * (x + 0.044715f * x * x * x); const float e2 = __expf(2.f * th); const float tnh = 1.f - 2.f * __builtin_amdgcn_rcpf(e2 + 1.f); z[e] = 0.5f * x * (1.f + tnh); }
                u32x2 w; w.x = pk2(z[0], z[1]); w.y = pk2(z[2], z[3]);
                *(u32x2*)(ZB + (size_t)(32 * (64 * cq + 16 * j + fr) + 4 * og + i) * 512 + g * 16 + 4 * fq) = w; }
    }
}
}
namespace mk { static_assert(WS_S5_END < (size_t)1780 * 1024 * 1024, "workspace map exceeds the guaranteed size"); }
namespace mk {
#ifndef PHMASK
#define PHMASK 0xfffff
#endif
#define PHM(k) ((PHMASK >> (k)) & 1)
#ifndef DUPMASK
#define DUPMASK 0
#endif
#define DUP(k) ((DUPMASK >> (k)) & 1)
constexpr int NPH = 12;
constexpr int PH_TOTAL = 2 + DEPTH * NPH;
__global__ void __launch_bounds__(NT, 2) mk_fwd(Args a) {
    extern __shared__ __attribute__((aligned(16))) unsigned char lds_raw[];
    LAS unsigned char* lds = (LAS unsigned char*)lds_raw;
#define TID ((int)threadIdx.x)
#define LANE ((int)(threadIdx.x & 63))
#define WAVE (__builtin_amdgcn_readfirstlane((int)(threadIdx.x >> 6)))
#define GW ((int)blockIdx.x * NWV + WAVE)
    const int G = gridDim.x, ngw = G * NWV;
    volatile LAS unsigned* ctlw = (volatile LAS unsigned*)(lds + LDS_CTL);
    if (TID < 4) ctlw[TID] = 0u;
    __syncthreads();
    XcdBarrier bar = xcd_barrier_post((unsigned*)(a.ws + WS_CTL), ctlw);
    const int lo = a.ph_lo, hi = a.ph_hi;
#define IN(k) (lo <= (k) && (k) < hi)
#define SEAM(k) do { if (IN(k) && IN((k) + 1)) xcd_barrier(bar); } while (0)
    unsigned char* ws = a.ws;
    bf16_t* H = (bf16_t*)(ws + WS_H); bf16_t* PROJ = (bf16_t*)(ws + WS_PROJ); float* SMALL = (float*)(ws + WS_SMALL); bf16_t* BR = (bf16_t*)(ws + WS_BR);
    bf16_t* MERGED = (bf16_t*)(ws + WS_MERGED); float* MACC = (float*)(ws + WS_MACC); bf16_t* ZB = (bf16_t*)(ws + WS_ZB); bf16_t* HID = PROJ;
    const float* MOD = (const float*)(ws + WS_MOD); float* X = a.out;
    if (PHM(0) && IN(0)) {
        unsigned* qhead = (unsigned*)(a.ws + WS_CTL) + 8192;
        volatile LAS unsigned* qitem = ctlw + 8;
        for (;;) {
            __syncthreads();
            if (TID == 0) qitem[0] = __hip_atomic_fetch_add(qhead, 1u, __ATOMIC_RELAXED, __HIP_MEMORY_SCOPE_AGENT);
            __syncthreads();
            int item = (int)qitem[0];
            if (item >= DEPTH * 32 + PRO_NCONV + PRO_NADA + PRO_NCACHE) break;
            if (item < DEPTH * 32) { s5_param_task(a, lds, TID, item); continue; } item -= DEPTH * 32;
            if (item < PRO_NCONV) { const int w0 = item * 64 + WAVE * 8; prologue_convert(a, lds, w0, w0 + 8, WAVE, LANE); continue; } item -= PRO_NCONV;
            if (item < PRO_NADA) { prologue_ada_unit(a, lds, TID, item); continue; } item -= PRO_NADA;
            prologue_cache(a, item * NWV + WAVE, PRO_NCACHE * NWV, LANE);
        }
    }
    SEAM(0);
    for (int l = 0; l < DEPTH; ++l) {
        const int pb = 1 + l * NPH;
        const float* xp = l == 0 ? a.in[0] : X; const float* xs = l == 0 ? a.in[1] : X + (size_t)MP * D;
        const float* modl = MOD + (size_t)l * 5 * 6 * D;
        const bf16_t* wl = (const bf16_t*)(ws + WS_W) + (size_t)l * W_LAYER;
        if (PHM(1) && IN(pb + 0)) norm_phase(xp, xs, a.in[14] + l * D, modl, 0, D, H, GW, ngw, LANE, l > 0 ? MACC : nullptr, modl - (size_t)5 * 6 * D, 5 * D, X, xs);
        SEAM(pb + 0);
        if (PHM(2) && IN(pb + 1)) { Gemm g{H, wl + W_IN, M, NIN, D, D, 1, 0, 0}; StaticOrder S; S.init(M, NIN, G, blockIdx.x, 1, D);
            EpiIn E{PROJ, SMALL, a.out, a.in[17] + l * 64, a.in[18] + l * 64, l}; for (int r_ = 0; r_ < 1 + DUP(9); ++r_) gemm_phase(lds, g, S, E); }
        SEAM(pb + 1);
        if (PHM(3) && IN(pb + 2)) { for (int r_ = 0; r_ < 1 + DUP(0); ++r_) { prep_phase(a, l, lds, GW, ngw, WAVE, LANE, (bf16_t*)(a.ws + WS_S5UP)); __syncthreads(); } }
        SEAM(pb + 2);
        if (PHM(4) && IN(pb + 3)) { for (int r_ = 0; r_ < 1 + DUP(2); ++r_) attn_phase(a, l, GW, ngw, LANE); for (int r_ = 0; r_ < 1 + DUP(3); ++r_) { ml_states_phase(a, l, TID, G); ssd_states_phase(a, l, TID, G); s5_statein_phase(a, l, GW, ngw, LANE); } }
        SEAM(pb + 3);
        if (PHM(5) && IN(pb + 4)) { for (int r_ = 0; r_ < 1 + DUP(4); ++r_) { ml_scan_phase(a, l, TID, G); ssd_scan_phase(a, l, TID, G); s5_scan_phase(a, l, GW, ngw, LANE); } }
        SEAM(pb + 4);
        if (PHM(12) && IN(pb + 5)) { for (int r_ = 0; r_ < 1 + DUP(5); ++r_) ml_out_phase(a, l, GW, ngw, LANE); for (int r_ = 0; r_ < 1 + DUP(6); ++r_) ssd_out_phase(a, l, GW, ngw, LANE); for (int r_ = 0; r_ < 1 + DUP(7); ++r_) s5_out_phase(a, l, GW, ngw, LANE); }
        SEAM(pb + 5);
        if (PHM(6) && IN(pb + 6)) { Gemm g{ZB, wl + W_GLU, M, 512, 512, 512, 1, 0, 0}; StaticOrder S; S.init(M, 512, G, blockIdx.x, 1, 512);
            EpiGlu E{ZB, a.in[29] + l * 512, BR}; gemm_phase(lds, g, S, E); ssd_fin_phase(a, l, GW, ngw, LANE); }
        SEAM(pb + 6);
        if (PHM(7) && IN(pb + 7)) { Gemm g{BR, wl + W_BR, M, D, 512, D, 4, 512, (size_t)D * 512}; StaticOrder S; S.init(M, D, G, blockIdx.x, 4, 512);
            EpiBranch E{PROJ, MERGED}; for (int r_ = 0; r_ < 1 + DUP(12); ++r_) gemm_phase(lds, g, S, E); }
        SEAM(pb + 7);
        if (PHM(8) && IN(pb + 8)) { Gemm g{MERGED, wl + W_OUT, M, D, D, D, 1, 0, 0}; SplitOrder S; S.init(blockIdx.x, D);
            EpiResid E{xp, xs, modl, 2 * D, X, MACC}; gemm_phase(lds, g, S, E); }
        SEAM(pb + 8);
        if (PHM(9) && IN(pb + 9)) norm_phase(X, X + (size_t)MP * D, a.in[15] + l * D, modl, 3 * D, 4 * D, H, GW, ngw, LANE, MACC, modl, 2 * D, X, xs);
        SEAM(pb + 9);
        if (PHM(10) && IN(pb + 10)) { Gemm g{H, wl + W_1, M, DFF, D, D, 1, 0, 0}; StaticOrder S; S.init(M, DFF, G, blockIdx.x, 1, D);
            EpiRelu2 E{HID, DFF}; for (int r_ = 0; r_ < 1 + DUP(10); ++r_) gemm_phase(lds, g, S, E); }
        SEAM(pb + 10);
        if (PHM(11) && IN(pb + 11)) { Gemm g{HID, wl + W_2, M, D, DFF, DFF, 1, 0, 0}; SplitOrder S; S.init(blockIdx.x, DFF);
            EpiResid E{X, X + (size_t)MP * D, modl, 5 * D, X, MACC}; gemm_phase(lds, g, S, E); }
        SEAM(pb + 11);
    }
    if (IN(1 + DEPTH * NPH)) final_fix_phase(MACC, MOD + (size_t)(DEPTH - 1) * 5 * 6 * D, 5 * D, X, GW, ngw, LANE);
#undef IN
#undef SEAM
}
}
extern "C" void kernel_launch(void* const* d_in, const int* in_sizes, int n_in, void* d_out, int out_size, void* d_ws, size_t ws_size, hipStream_t stream) {
    static int grid = 0;
    if (grid == 0) {
        int dev = 0, cus = 0; (void)hipGetDevice(&dev); (void)hipDeviceGetAttribute(&cus, hipDeviceAttributeMultiprocessorCount, dev);
        (void)hipFuncSetAttribute((const void*)mk::mk_fwd, hipFuncAttributeMaxDynamicSharedMemorySize, mk::LDS_BYTES);
        int per_cu = 0; (void)hipOccupancyMaxActiveBlocksPerMultiprocessor(&per_cu, (const void*)mk::mk_fwd, mk::NT, mk::LDS_BYTES); (void)hipGetLastError();
        grid = cus > 0 ? cus : 256;
    }
    mk::Args a{}; for (int i = 0; i < 43; ++i) a.in[i] = (const float*)d_in[i];
    a.out = (float*)d_out; a.ws = (unsigned char*)d_ws; a.ph_lo = 0; a.ph_hi = mk::PH_TOTAL;
    (void)hipMemsetAsync(a.ws + mk::WS_CTL, 0, mk::CTL_BYTES, stream);
    hipLaunchKernelGGL(mk::mk_fwd, dim3(grid), dim3(mk::NT), mk::LDS_BYTES, stream, a);
}
```

```cpp
#define SAFE_GEMM 0
#define DUPMASK 0
#include <hip/hip_runtime.h>
#include <math.h>
namespace mk {
#define LAS __attribute__((address_space(3)))
typedef unsigned short bf16_t;
typedef short bf16x8 __attribute__((ext_vector_type(8)));
typedef float f32x4 __attribute__((ext_vector_type(4)));
typedef float f32x2 __attribute__((ext_vector_type(2)));
typedef unsigned u32x4 __attribute__((ext_vector_type(4)));
typedef unsigned u32x2 __attribute__((ext_vector_type(2)));
constexpr int NT = 512, NWV = 8;
constexpr int D = 2048, MP = 4096, MLAT = 8192, M = MP + MLAT, DEPTH = 4, DFF = 8192;
constexpr int PJ = 13824;
constexpr int NIN = 14080;
constexpr int P_Q = 0, P_K = 512, P_V = 1024, P_S5U = 1536, P_Z = 2048, P_XBC = 2560, P_MQ = 3584, P_MK = 4096, P_MV = 4608, P_MO = 5120, P_GATE = 5632;
constexpr int S_DT = 0, S_MI = 16, S_MF = 24;

typedef __bf16 bf16x2_t __attribute__((ext_vector_type(2)));
__device__ __forceinline__ unsigned pk2(float lo, float hi) { f32x2 v = {lo, hi}; bf16x2_t b = __builtin_convertvector(v, bf16x2_t); return __builtin_bit_cast(unsigned, b); }
__device__ __forceinline__ float bf2f(bf16_t v) { return __uint_as_float(((unsigned)v) << 16); }
__device__ __forceinline__ float bflo(unsigned w) { return __uint_as_float(w << 16); }
__device__ __forceinline__ float bfhi(unsigned w) { return __uint_as_float(w & 0xffff0000u); }
__device__ __forceinline__ bf16_t f2bf(float f) { return (bf16_t)(pk2(f, 0.f) & 0xffffu); }
__device__ __forceinline__ float fsigm(float x) { return __builtin_amdgcn_rcpf(1.f + __expf(-x)); }
__device__ __forceinline__ float fsilu(float x) { return x * fsigm(x); }
__device__ __forceinline__ int row_cvec(int row) { return row < MP ? 0 : 1 + (row - MP) / 2048; }

#define XB_TMO      128
#define XB_XCNT(j)  (256  + 64 * (j))
#define XB_XSUB(j)  (1280 + 64 * (j))
#define XB_XGEN(j)  (2304 + 64 * (j))
#define XB_TOP      3328
#define XB_TOPGEN   3392
#define XCD_BAR_WORDS 3456
#define XB_SPIN_CAP (1u << 18)
__device__ __forceinline__ unsigned xb_ld(unsigned* p)              { return __hip_atomic_load(p, __ATOMIC_RELAXED, __HIP_MEMORY_SCOPE_AGENT); }
__device__ __forceinline__ unsigned xb_add(unsigned* p, unsigned v) { return __hip_atomic_fetch_add(p, v, __ATOMIC_RELAXED, __HIP_MEMORY_SCOPE_AGENT); }
__device__ __forceinline__ unsigned xb_xcc_id() { return (unsigned)__builtin_amdgcn_s_getreg((3 << 11) | 20) & 0xFu; }
#define XB_SPIN(cond, bar) do { unsigned _sp = 0; while (cond) { __builtin_amdgcn_s_sleep(1); \
    if ((++_sp & 255u) == 0u) { if (xb_ld(&(bar)[XB_TMO])) break; if (_sp > XB_SPIN_CAP) { atomicAdd(&(bar)[XB_TMO], 1u); break; } } } } while (0)
struct XcdBarrier { unsigned* bar; unsigned x; volatile LAS unsigned* st; };
__device__ __forceinline__ XcdBarrier xcd_barrier_post(unsigned* bar, volatile LAS unsigned* st) {
    XcdBarrier b; b.bar = bar; b.x = xb_xcc_id(); b.st = st;
    if (threadIdx.x == 0) (void)xb_add(&bar[XB_XCNT(b.x)], 1u);
    return b;
}
__device__ __forceinline__ void xcd_barrier_complete(unsigned* bar, unsigned x, unsigned& nloc, unsigned& nx) {
    const unsigned G = gridDim.x * gridDim.y * gridDim.z;
    unsigned sum, cnt, mine, sp = 0u;
    for (;;) {
        sum = 0u; cnt = 0u; mine = 0u;
#pragma unroll
        for (unsigned j = 0; j < 16; ++j) { const unsigned c = xb_ld(&bar[XB_XCNT(j)]); sum += c; cnt += (c > 0u) ? 1u : 0u; mine = (j == x) ? c : mine; }
        if (sum == G) break;
        __builtin_amdgcn_s_sleep(1);
        if ((++sp & 255u) == 0u) { if (xb_ld(&bar[XB_TMO])) break; if (sp > XB_SPIN_CAP) { atomicAdd(&bar[XB_TMO], 1u); break; } }
    }
    nloc = mine > 0u ? mine : 1u; nx = cnt > 0u ? cnt : 1u;
}
__device__ __forceinline__ void xcd_barrier(const XcdBarrier& b) {
    asm volatile("s_waitcnt vmcnt(0)" ::: "memory");
    __syncthreads();
    if (threadIdx.x == 0) {
        unsigned* bar = b.bar;
        __builtin_amdgcn_s_waitcnt(0);
        unsigned nloc = b.st[0], nx = b.st[1];
        if (nloc == 0u) { xcd_barrier_complete(bar, b.x, nloc, nx); b.st[0] = nloc; b.st[1] = nx; }
        const unsigned old = xb_add(&bar[XB_XSUB(b.x)], 1u);
        const unsigned gen = old / nloc;
        if (old + 1u == (gen + 1u) * nloc) {
            __builtin_amdgcn_fence(__ATOMIC_RELEASE, "agent");
            asm volatile("s_waitcnt vmcnt(0)" ::: "memory");
            const unsigned og = xb_add(&bar[XB_TOP], 1u);
            const unsigned tg = og / nx;
            if (og + 1u == (tg + 1u) * nx) xb_add(&bar[XB_TOPGEN], 1u);
            else XB_SPIN(xb_ld(&bar[XB_TOPGEN]) == tg, bar);
            __builtin_amdgcn_fence(__ATOMIC_ACQUIRE, "agent");
            xb_add(&bar[XB_XGEN(b.x)], 1u);
            asm volatile("s_waitcnt vmcnt(0)" ::: "memory");
        } else {
            XB_SPIN(xb_ld(&bar[XB_XGEN(b.x)]) == gen, bar);
            __builtin_amdgcn_fence(__ATOMIC_ACQUIRE, "agent");
            asm volatile("s_waitcnt vmcnt(0)" ::: "memory");
        }
    }
    __syncthreads();
}

#ifndef GEMM_SP2
#define GEMM_SP2 1
#endif
#ifndef GEMM_ALIGN
#define GEMM_ALIGN 1
#endif
constexpr int BM = 256, BK = 64, HALF = 128, HTB = HALF * BK * 2, STAGE_BYTES = 8 * HTB, NXCD = 8, WGM = 8;
__host__ __device__ __forceinline__ int lds_byte(int r, int c) { const int st = (r >> 4) * 2 + (c >> 5), rr = r & 15, cc = c & 31, ob = rr * 64 + cc * 2; return st * 1024 + (ob ^ (((ob >> 9) & 1) << 5)); }
__host__ __device__ __forceinline__ void stage_rc(int b, int& R, int& C) { const int st = b / 1024, sb = b % 1024, swz = sb ^ (((sb >> 9) & 1) << 5); R = (st >> 1) * 16 + swz / 64; C = (st & 1) * 32 + (swz % 64) / 2; }
__host__ __device__ __forceinline__ int perm32(int rho) { const int n = rho >> 4, i = rho & 15; return 8 * (i >> 2) + 4 * n + (i & 3); }

struct Unit { int pm, pn, kz, koff, nt; };
struct Gemm { const bf16_t* A; const bf16_t* Bt; int M, N, K, lda, nkz; size_t a_kz, b_kz; };

struct StaticOrder {
    int nM, nN, nwg, G, c, nkz;
    int ntk;
    __device__ void init(int M_, int N_, int G_, int c_, int nkz_ = 1, int K_ = 0) { nM = M_ / BM; nN = N_ / BM; nwg = nM * nN; G = G_; c = c_; nkz = nkz_; ntk = K_ / BK; }
    __device__ bool next(int i, Unit& u) const {
        const int it = i / nkz; u.kz = i - it * nkz; u.koff = 0; u.nt = ntk;
        const long L = (long)it * G + c; if (L >= nwg) return false;
        int wgid = (int)L; { const int q = nwg / NXCD, r = nwg % NXCD, xcd = wgid % NXCD, off = wgid / NXCD; wgid = (xcd < r ? xcd * (q + 1) : r * (q + 1) + (xcd - r) * q) + off; }
        const int nig = WGM * nN, gid = wgid / nig, fm = gid * WGM, gsz = (nM - fm) < WGM ? (nM - fm) : WGM;
        u.pm = fm + ((wgid % nig) % gsz); u.pn = (wgid % nig) / gsz; return true;
    }
};

struct SplitOrder {
    int c, ntk;
    __device__ void init(int c_, int K_) { c = c_; ntk = K_ / BK; }
    __device__ bool next(int i, Unit& u) const {
        const int xcd = c & 7, idx = c >> 3;
        if (i == 0) { u.pm = xcd * 4 + (idx >> 3); u.pn = idx & 7; u.kz = 0; u.koff = 0; u.nt = ntk; return true; }
        if (i == 1) { const int t = idx >> 1; u.pm = 32 + xcd * 2 + (t >> 3); u.pn = t & 7; u.kz = 0; u.nt = ntk >> 1; u.koff = (idx & 1) * (ntk >> 1) * BK; return true; }
        return false;
    }
};

template <class Epi, class Sched>
__device__ __forceinline__ void gemm_phase(LAS unsigned char* lds, const Gemm g, const Sched& S, const Epi& E) {
    int tid_ = threadIdx.x; asm volatile("" : "+v"(tid_));
    const int tid = tid_, wid = __builtin_amdgcn_readfirstlane(tid >> 6), lane = tid & 63, wr = wid >> 2, wc = wid & 3, fr = lane & 15, fq = lane >> 4;
    const int K = g.K;
    unsigned voffA[2], voffB[2];
#pragma unroll
    for (int i = 0; i < 2; ++i) { int R, C; stage_rc(tid * 16 + i * 8192, R, C); const int Rb = Epi::PERM ? ((R & ~31) + perm32(R & 31)) : R;
        voffA[i] = (unsigned)(R * g.lda + C) * 2u; voffB[i] = (unsigned)(Rb * K + C) * 2u; }
    const size_t kstep = (size_t)(BK * 2);
    const size_t hstepA = (size_t)HALF * g.lda * 2, hstepB = (size_t)HALF * K * 2;
    const size_t tstepA = 2 * hstepA, tstepB = 2 * hstepB;
    const unsigned ldsw = (unsigned)wid * 1024u;
    const int aoff = lds_byte(wr * 64 + fr, fq * 8), boff = lds_byte(wc * 32 + fr, fq * 8);
#define PG8_SA(b, h) (((b) * 2 + (h)) * HTB)
#define PG8_SB(b, h) ((4 + (b) * 2 + (h)) * HTB)
#define PG8_STAGE(bufoff, gbase, voff) do { _Pragma("unroll") for (int _i = 0; _i < 2; ++_i) \
        __builtin_amdgcn_global_load_lds((const unsigned*)((const char*)(gbase) + (voff)[_i]), (LAS unsigned*)(lds + (bufoff) + ldsw + _i * 8192), 16, 0, 0); } while (0)
#define PG8_LDA(dst, b, h) do { _Pragma("unroll") for (int m = 0; m < 4; ++m) _Pragma("unroll") for (int k = 0; k < 2; ++k) dst[m][k] = *(const LAS bf16x8*)(lds + PG8_SA(b, h) + aoff + m * 2048 + k * 1024); } while (0)
#define PG8_LDB(dst, b, h) do { _Pragma("unroll") for (int n = 0; n < 2; ++n) _Pragma("unroll") for (int k = 0; k < 2; ++k) dst[n][k] = *(const LAS bf16x8*)(lds + PG8_SB(b, h) + boff + n * 2048 + k * 1024); } while (0)
#define PG8_MMA(ai, bj, At, Bt) do { __builtin_amdgcn_s_setprio(1); _Pragma("unroll") for (int m = 0; m < 4; ++m) _Pragma("unroll") for (int n = 0; n < 2; ++n) _Pragma("unroll") for (int k = 0; k < 2; ++k) \
        acc[ai][bj][m][n] = __builtin_amdgcn_mfma_f32_16x16x32_bf16(Bt[n][k], At[m][k], acc[ai][bj][m][n], 0, 0, 0); __builtin_amdgcn_s_setprio(0); } while (0)
#if SAFE_GEMM == 1 || SAFE_GEMM == 3
#define PG8_WAIT_V(n) asm volatile("s_waitcnt vmcnt(0)" ::: "memory")
#else
#define PG8_WAIT_V(n) asm volatile("s_waitcnt vmcnt(" #n ")" ::: "memory")
#endif
#define PG8_WAIT_L(n) asm volatile("s_waitcnt lgkmcnt(" #n ")" ::: "memory")
#if SAFE_GEMM == 1
#define PG8_BAR do { asm volatile("s_waitcnt vmcnt(0) lgkmcnt(0)" ::: "memory"); __builtin_amdgcn_s_barrier(); asm volatile("" ::: "memory"); } while (0)
#elif SAFE_GEMM == 2
#define PG8_BAR asm volatile("s_barrier" ::: "memory")
#elif SAFE_GEMM == 4
#define PG8_BAR do { asm volatile("s_waitcnt lgkmcnt(0)" ::: "memory"); __builtin_amdgcn_s_barrier(); } while (0)
#else
#define PG8_BAR __builtin_amdgcn_s_barrier()
#endif
#define PG8_SCHED __builtin_amdgcn_sched_barrier(0)
    Unit cur, nxt; int ui = 0;
    if (!S.next(0, cur)) return;
    f32x4 acc[2][2][4][2];
#pragma unroll
    for (int a = 0; a < 2; ++a)
#pragma unroll
        for (int b = 0; b < 2; ++b)
#pragma unroll
            for (int m = 0; m < 4; ++m)
#pragma unroll
                for (int n = 0; n < 2; ++n) acc[a][b][m][n] = (f32x4){0.f, 0.f, 0.f, 0.f};
    bf16x8 At[4][2], B0[2][2], B1[2][2];
    const char* cA = (const char*)(g.A + (size_t)cur.kz * g.a_kz + cur.koff) + (size_t)cur.pm * tstepA; const char* cB = (const char*)(g.Bt + (size_t)cur.kz * g.b_kz + cur.koff) + (size_t)cur.pn * tstepB;
#if GEMM_SP2
    PG8_STAGE(PG8_SB(0, 0), cB, voffB); PG8_STAGE(PG8_SB(0, 1), cB + hstepB, voffB); PG8_STAGE(PG8_SA(0, 0), cA, voffA); PG8_STAGE(PG8_SA(0, 1), cA + hstepA, voffA);
    if (wr == 1) PG8_BAR;
    PG8_WAIT_V(2); PG8_BAR;
    PG8_STAGE(PG8_SB(1, 0), cB + kstep, voffB); PG8_STAGE(PG8_SA(1, 0), cA + kstep, voffA); PG8_STAGE(PG8_SB(1, 1), cB + hstepB + kstep, voffB);
    PG8_WAIT_V(6); PG8_BAR;
#else
    PG8_STAGE(PG8_SB(0, 0), cB, voffB); PG8_STAGE(PG8_SA(0, 0), cA, voffA); PG8_STAGE(PG8_SB(0, 1), cB + hstepB, voffB); PG8_STAGE(PG8_SA(0, 1), cA + hstepA, voffA);
    if (wr == 1) PG8_BAR;
    PG8_WAIT_V(4); PG8_BAR;
    PG8_STAGE(PG8_SB(1, 0), cB + kstep, voffB); PG8_STAGE(PG8_SA(1, 0), cA + kstep, voffA); PG8_STAGE(PG8_SB(1, 1), cB + hstepB + kstep, voffB);
    PG8_WAIT_V(6); PG8_BAR;
#endif
    for (;;) {
        const bool has_next = S.next(ui + 1, nxt);
        const char* nA = has_next ? (const char*)(g.A + (size_t)nxt.kz * g.a_kz + nxt.koff) + (size_t)nxt.pm * tstepA : cA;
        const char* nB = has_next ? (const char*)(g.Bt + (size_t)nxt.kz * g.b_kz + nxt.koff) + (size_t)nxt.pn * tstepB : cB;
        const int nt = cur.nt;
        for (int t = 0; t < nt; t += 2) {
            const bool last = (t == nt - 2);
            const char* a1 = cA + (size_t)(t + 1) * kstep;
            const char* a2 = last ? nA : cA + (size_t)(t + 2) * kstep; const char* b2 = last ? nB : cB + (size_t)(t + 2) * kstep;
            const char* a3 = a2 + kstep; const char* b3 = b2 + kstep;
#if GEMM_SP2
            PG8_LDB(B0, 0, 0); PG8_LDB(B1, 0, 1); PG8_SCHED; PG8_LDA(At, 0, 0); PG8_STAGE(PG8_SA(1, 1), a1 + hstepA, voffA);
            PG8_WAIT_V(8); PG8_WAIT_L(0); PG8_BAR; PG8_MMA(0, 0, At, B0); PG8_MMA(0, 1, At, B1); PG8_BAR; PG8_SCHED;
            PG8_LDA(At, 0, 1); PG8_STAGE(PG8_SB(0, 0), b2, voffB); PG8_STAGE(PG8_SB(0, 1), b2 + hstepB, voffB); PG8_STAGE(PG8_SA(0, 0), a2, voffA);
            PG8_WAIT_V(8); PG8_WAIT_L(0); PG8_BAR; PG8_MMA(1, 0, At, B0); PG8_MMA(1, 1, At, B1); PG8_BAR; PG8_SCHED;
            PG8_LDB(B0, 1, 0); PG8_LDB(B1, 1, 1); PG8_SCHED; PG8_LDA(At, 1, 0); PG8_STAGE(PG8_SA(0, 1), a2 + hstepA, voffA);
            PG8_WAIT_V(8); PG8_WAIT_L(0); PG8_BAR; PG8_MMA(0, 0, At, B0); PG8_MMA(0, 1, At, B1); PG8_BAR; PG8_SCHED;
            PG8_LDA(At, 1, 1); PG8_STAGE(PG8_SB(1, 0), b3, voffB); PG8_STAGE(PG8_SB(1, 1), b3 + hstepB, voffB); PG8_STAGE(PG8_SA(1, 0), a3, voffA);
            PG8_WAIT_V(8); PG8_WAIT_L(0); PG8_BAR; PG8_MMA(1, 0, At, B0); PG8_MMA(1, 1, At, B1); PG8_BAR; PG8_SCHED;
#else
            PG8_LDB(B0, 0, 0); PG8_SCHED; PG8_LDA(At, 0, 0); PG8_STAGE(PG8_SA(1, 1), a1 + hstepA, voffA);
            PG8_WAIT_L(8); PG8_BAR; PG8_WAIT_L(0); PG8_MMA(0, 0, At, B0); PG8_BAR; PG8_SCHED;
            PG8_LDB(B1, 0, 1); PG8_STAGE(PG8_SB(0, 0), b2, voffB);
            PG8_BAR; PG8_WAIT_L(0); PG8_MMA(0, 1, At, B1); PG8_BAR;
            PG8_LDA(At, 0, 1); PG8_STAGE(PG8_SA(0, 0), a2, voffA);
            PG8_BAR; PG8_WAIT_L(0); PG8_MMA(1, 0, At, B0); PG8_BAR; PG8_SCHED;
            PG8_STAGE(PG8_SB(0, 1), b2 + hstepB, voffB);
            PG8_WAIT_V(6); PG8_BAR; PG8_MMA(1, 1, At, B1); PG8_BAR;
            PG8_LDB(B0, 1, 0); PG8_SCHED; PG8_LDA(At, 1, 0); PG8_STAGE(PG8_SA(0, 1), a2 + hstepA, voffA);
            PG8_WAIT_L(8); PG8_BAR; PG8_WAIT_L(0); PG8_MMA(0, 0, At, B0); PG8_BAR; PG8_SCHED;
            PG8_LDB(B1, 1, 1); PG8_STAGE(PG8_SB(1, 0), b3, voffB);
            PG8_BAR; PG8_WAIT_L(0); PG8_MMA(0, 1, At, B1); PG8_BAR;
            PG8_LDA(At, 1, 1); PG8_STAGE(PG8_SA(1, 0), a3, voffA);
            PG8_BAR; PG8_WAIT_L(0); PG8_MMA(1, 0, At, B0); PG8_BAR; PG8_SCHED;
            PG8_STAGE(PG8_SB(1, 1), b3 + hstepB, voffB);
            PG8_WAIT_V(6); PG8_BAR; PG8_MMA(1, 1, At, B1); PG8_BAR;
#endif
        }
#if GEMM_ALIGN
        if (wr == 0) PG8_BAR;
#endif
        E(acc, cur, wr, wc, fr, fq);
        if (!has_next) break;
        if (nxt.kz == 0) {
#pragma unroll
        for (int a = 0; a < 2; ++a)
#pragma unroll
            for (int b = 0; b < 2; ++b)
#pragma unroll
                for (int m = 0; m < 4; ++m)
#pragma unroll
                    for (int n = 0; n < 2; ++n) acc[a][b][m][n] = (f32x4){0.f, 0.f, 0.f, 0.f};
        }
        cur = nxt; cA = nA; cB = nB; ++ui;
#if GEMM_ALIGN
        if (wr == 1) PG8_BAR;
#endif
    }
    PG8_WAIT_V(0);
#if !GEMM_ALIGN
    if (wr == 0) PG8_BAR;
#endif
    PG8_BAR;
#undef PG8_SA
#undef PG8_SB
#undef PG8_STAGE
#undef PG8_LDA
#undef PG8_LDB
#undef PG8_MMA
#undef PG8_WAIT_V
#undef PG8_WAIT_L
#undef PG8_BAR
#undef PG8_SCHED
}
}
namespace mk {
constexpr size_t O_YP = 0, O_YS = 8388608, O_NK = 25165824, O_NV = 33554432, O_S5R = 41943040, O_S5I = 42205184, O_SSD = 42467328,
                 O_MLC = 50855936, O_MLN = 59244544, O_MLM = 59310080;

__device__ __forceinline__ u32x4 pack8(const f32x4 a, const f32x4 b) { u32x4 w; w.x = pk2(a[0], a[1]); w.y = pk2(a[2], a[3]); w.z = pk2(b[0], b[1]); w.w = pk2(b[2], b[3]); return w; }

struct EpiIn {
    static constexpr bool PERM = true;
    bf16_t* proj; float* small; float* out; const float* qg; const float* kg; int layer;
    __device__ __forceinline__ void operator()(f32x4 (&acc)[2][2][4][2], const Unit& u, int wr, int wc, int fr, int fq) const {
        const int T = u.pn, rowb = u.pm * BM + wr * 64 + fr;
        if (T == 54) {
            if (wc == 0) {
#pragma unroll
                for (int ai = 0; ai < 2; ++ai)
#pragma unroll
                    for (int m = 0; m < 4; ++m) { float* sp = small + (size_t)(rowb + ai * HALF + m * 16) * 32 + 8 * fq; *(f32x4*)sp = acc[ai][0][m][0]; *(f32x4*)(sp + 4) = acc[ai][0][m][1]; }
            }
            return;
        }
        const int colb = T * 256 + 64 * wc + 8 * fq;
        if (T < 4) {
            const float* g = T < 2 ? qg : kg;
            f32x4 gv[2][2];
#pragma unroll
            for (int bj = 0; bj < 2; ++bj)
#pragma unroll
                for (int n = 0; n < 2; ++n) gv[bj][n] = *(const f32x4*)(g + 32 * bj + 8 * fq + 4 * n);
#pragma unroll
            for (int ai = 0; ai < 2; ++ai)
#pragma unroll
                for (int m = 0; m < 4; ++m) {
                    float ss = 0.f;
#pragma unroll
                    for (int bj = 0; bj < 2; ++bj)
#pragma unroll
                        for (int n = 0; n < 2; ++n) { const f32x4 x = acc[ai][bj][m][n]; ss += (x[0] * x[0] + x[1] * x[1]) + (x[2] * x[2] + x[3] * x[3]); }
                    ss += __shfl_xor(ss, 16); ss += __shfl_xor(ss, 32);
                    const float r = rsqrtf(ss * (1.f / 64.f) + 1e-6f);
                    const int row = rowb + ai * HALF + m * 16;
#pragma unroll
                    for (int bj = 0; bj < 2; ++bj) { const f32x4 v0 = acc[ai][bj][m][0] * r * gv[bj][0], v1 = acc[ai][bj][m][1] * r * gv[bj][1];
                        *(u32x4*)(proj + (size_t)row * PJ + colb + 32 * bj) = pack8(v0, v1);
                        if (T >= 2 && row < MP) { float* o = out + O_NK + ((size_t)((row >> 8) * DEPTH + layer) * 256 + (row & 255)) * 512 + (colb - 512) + 32 * bj; *(f32x4*)o = v0; *(f32x4*)(o + 4) = v1; } }
                }
        } else if (T < 6) {
#pragma unroll
            for (int ai = 0; ai < 2; ++ai)
#pragma unroll
                for (int m = 0; m < 4; ++m) { const int row = rowb + ai * HALF + m * 16;
#pragma unroll
                    for (int bj = 0; bj < 2; ++bj) { const f32x4 v0 = acc[ai][bj][m][0], v1 = acc[ai][bj][m][1];
                        *(u32x4*)(proj + (size_t)row * PJ + colb + 32 * bj) = pack8(v0, v1);
                        if (row < MP) { float* o = out + O_NV + ((size_t)((row >> 8) * DEPTH + layer) * 256 + (row & 255)) * 512 + (colb - 1024) + 32 * bj; *(f32x4*)o = v0; *(f32x4*)(o + 4) = v1; } } }
        } else if (T < 22) {
#pragma unroll
            for (int ai = 0; ai < 2; ++ai)
#pragma unroll
                for (int m = 0; m < 4; ++m) { const int row = rowb + ai * HALF + m * 16;
#pragma unroll
                    for (int bj = 0; bj < 2; ++bj) *(u32x4*)(proj + (size_t)row * PJ + colb + 32 * bj) = pack8(acc[ai][bj][m][0], acc[ai][bj][m][1]); }
        } else {
#pragma unroll
            for (int ai = 0; ai < 2; ++ai)
#pragma unroll
                for (int m = 0; m < 4; ++m) { const int row = rowb + ai * HALF + m * 16;
#pragma unroll
                    for (int bj = 0; bj < 2; ++bj) { f32x4 v0 = acc[ai][bj][m][0], v1 = acc[ai][bj][m][1];
#pragma unroll
                        for (int j = 0; j < 4; ++j) { v0[j] = fsigm(v0[j]); v1[j] = fsigm(v1[j]); }
                        *(u32x4*)(proj + (size_t)row * PJ + colb + 32 * bj) = pack8(v0, v1); } }
        }
    }
};
struct EpiRelu2 {
    static constexpr bool PERM = true;
    bf16_t* O; int ldo;
    __device__ __forceinline__ void operator()(f32x4 (&acc)[2][2][4][2], const Unit& u, int wr, int wc, int fr, int fq) const {
        const int rowb = u.pm * BM + wr * 64 + fr, colb = u.pn * 256 + 64 * wc + 8 * fq;
#pragma unroll
        for (int ai = 0; ai < 2; ++ai)
#pragma unroll
            for (int m = 0; m < 4; ++m) { const int row = rowb + ai * HALF + m * 16;
#pragma unroll
                for (int bj = 0; bj < 2; ++bj) { f32x4 v0 = acc[ai][bj][m][0], v1 = acc[ai][bj][m][1];
#pragma unroll
                    for (int j = 0; j < 4; ++j) { const float a = fmaxf(v0[j], 0.f), b = fmaxf(v1[j], 0.f); v0[j] = a * a; v1[j] = b * b; }
                    *(u32x4*)(O + (size_t)row * ldo + colb + 32 * bj) = pack8(v0, v1); } }
    }
};
struct EpiGlu {
    static constexpr bool PERM = true;
    const bf16_t* Z; const float* bias; bf16_t* br;
    __device__ __forceinline__ void operator()(f32x4 (&acc)[2][2][4][2], const Unit& u, int wr, int wc, int fr, int fq) const {
        const int rowb = u.pm * BM + wr * 64 + fr, colb = u.pn * 256 + 64 * wc + 8 * fq;
#pragma unroll
        for (int bj = 0; bj < 2; ++bj) { const int c = colb + 32 * bj; const f32x4 b0 = *(const f32x4*)(bias + c), b1 = *(const f32x4*)(bias + c + 4);
#pragma unroll
            for (int ai = 0; ai < 2; ++ai)
#pragma unroll
                for (int m = 0; m < 4; ++m) { const int row = rowb + ai * HALF + m * 16;
                    const u32x4 zz = *(const u32x4*)(Z + (size_t)row * 512 + c);
                    f32x4 v0 = acc[ai][bj][m][0] + b0, v1 = acc[ai][bj][m][1] + b1;
                    v0[0] = bflo(zz.x) * fsigm(v0[0]); v0[1] = bfhi(zz.x) * fsigm(v0[1]); v0[2] = bflo(zz.y) * fsigm(v0[2]); v0[3] = bfhi(zz.y) * fsigm(v0[3]);
                    v1[0] = bflo(zz.z) * fsigm(v1[0]); v1[1] = bfhi(zz.z) * fsigm(v1[1]); v1[2] = bflo(zz.w) * fsigm(v1[2]); v1[3] = bfhi(zz.w) * fsigm(v1[3]);
                    *(u32x4*)(br + (size_t)row * D + 512 + c) = pack8(v0, v1); } }
    }
};
struct EpiBranch {
    static constexpr bool PERM = true;
    const bf16_t* proj; bf16_t* merged;
    __device__ __forceinline__ void operator()(f32x4 (&acc)[2][2][4][2], const Unit& u, int wr, int wc, int fr, int fq) const {
        const int rowb = u.pm * BM + wr * 64 + fr, colb = u.pn * 256 + 64 * wc + 8 * fq, kz = u.kz;
#pragma unroll
        for (int ai = 0; ai < 2; ++ai)
#pragma unroll
            for (int m = 0; m < 4; ++m) { const int row = rowb + ai * HALF + m * 16;
#pragma unroll
                for (int bj = 0; bj < 2; ++bj) { const int c = colb + 32 * bj;
                    const u32x4 gg = *(const u32x4*)(proj + (size_t)row * PJ + P_GATE + kz * D + c);
                    float g[8] = {bflo(gg.x), bfhi(gg.x), bflo(gg.y), bfhi(gg.y), bflo(gg.z), bfhi(gg.z), bflo(gg.w), bfhi(gg.w)};
                    if (kz < 3) { const u32x4 hh = *(const u32x4*)(proj + (size_t)row * PJ + P_GATE + (kz + 1) * D + c);
                        const float h[8] = {bflo(hh.x), bfhi(hh.x), bflo(hh.y), bfhi(hh.y), bflo(hh.z), bfhi(hh.z), bflo(hh.w), bfhi(hh.w)};
#pragma unroll
                        for (int j = 0; j < 8; ++j) g[j] = g[j] * __builtin_amdgcn_rcpf(fmaxf(h[j], 1e-30f)); }
                    f32x4& v0 = acc[ai][bj][m][0]; f32x4& v1 = acc[ai][bj][m][1];
                    v0[0] *= g[0]; v0[1] *= g[1]; v0[2] *= g[2]; v0[3] *= g[3]; v1[0] *= g[4]; v1[1] *= g[5]; v1[2] *= g[6]; v1[3] *= g[7];
                    if (kz == 3) *(u32x4*)(merged + (size_t)row * D + c) = pack8(v0, v1); } }
    }
};
struct EpiResid {
    static constexpr bool PERM = false;
    const float* xp; const float* xs; const float* modl; int g_off; float* xout; float* part;
    __device__ __forceinline__ void operator()(f32x4 (&acc)[2][2][4][2], const Unit& u, int wr, int wc, int fr, int fq) const {
        if (part != nullptr && u.pm >= 32) {
            float* P = part + (size_t)((((u.pm - 32) * 8 + u.pn) * 2) + (u.koff != 0)) * 65536 + (size_t)(wr * 64 + fr) * 256 + wc * 32 + 4 * fq;
#pragma unroll
            for (int ai = 0; ai < 2; ++ai)
#pragma unroll
                for (int m = 0; m < 4; ++m)
#pragma unroll
                    for (int bj = 0; bj < 2; ++bj)
#pragma unroll
                        for (int n = 0; n < 2; ++n) *(f32x4*)(P + (size_t)(ai * HALF + m * 16) * 256 + bj * HALF + n * 16) = acc[ai][bj][m][n];
            return;
        }
        const int row0 = u.pm * BM, rowb = row0 + wr * 64 + fr, colb = u.pn * 256 + wc * 32 + 4 * fq;
        const float* xin = row0 < MP ? xp : xs - (size_t)MP * D;
        const float* gate = modl + (size_t)row_cvec(row0) * 6 * D + g_off;
        f32x4 gv[2][2];
#pragma unroll
        for (int bj = 0; bj < 2; ++bj)
#pragma unroll
            for (int n = 0; n < 2; ++n) gv[bj][n] = *(const f32x4*)(gate + colb + bj * HALF + n * 16);
#pragma unroll
        for (int ai = 0; ai < 2; ++ai)
#pragma unroll
            for (int m = 0; m < 4; ++m) { const size_t ro = (size_t)(rowb + ai * HALF + m * 16) * D + colb;
#pragma unroll
                for (int bj = 0; bj < 2; ++bj)
#pragma unroll
                    for (int n = 0; n < 2; ++n) { const size_t o = ro + bj * HALF + n * 16; *(f32x4*)(xout + o) = *(const f32x4*)(xin + o) + gv[bj][n] * acc[ai][bj][m][n]; } }
    }
};
}
namespace mk {
constexpr size_t AL(size_t x) { return (x + 255) & ~(size_t)255; }
constexpr size_t WS_CTL = 0, CTL_BYTES = 65536;
constexpr size_t WS_MOD = WS_CTL + CTL_BYTES;
constexpr size_t WS_W = AL(WS_MOD + (size_t)DEPTH * 5 * 6 * D * 4);
constexpr size_t W_IN = 0, W_GLU = W_IN + (size_t)NIN * D, W_BR = W_GLU + 512 * 512, W_OUT = W_BR + (size_t)4 * D * 512, W_1 = W_OUT + (size_t)D * D, W_2 = W_1 + (size_t)DFF * D,
                 W_LAYER = W_2 + (size_t)D * DFF;
constexpr size_t WS_H = AL(WS_W + W_LAYER * 2 * DEPTH);
constexpr size_t WS_PROJ = AL(WS_H + (size_t)M * D * 2);
constexpr size_t WS_SMALL = AL(WS_PROJ + (size_t)M * PJ * 2);
constexpr size_t WS_BR = AL(WS_SMALL + (size_t)M * 32 * 4);
constexpr size_t WS_MERGED = AL(WS_BR + (size_t)M * D * 2);
constexpr size_t WS_MACC = AL(WS_MERGED + (size_t)M * D * 2);
constexpr size_t WS_ZB = AL(WS_MACC + (size_t)M * D * 4);
constexpr size_t WS_SCR = AL(WS_ZB + (size_t)M * 512 * 2);
constexpr int LDS_BYTES = 140 * 1024, LDS_CTL = LDS_BYTES - 256;

struct Args { const float* in[43]; float* out; unsigned char* ws; int ph_lo, ph_hi; };

__device__ __forceinline__ float wave_sum(float v) {
#pragma unroll
    for (int o = 1; o < 64; o <<= 1) v += __shfl_xor(v, o);
    return v;
}
#define LDS_WAIT() asm volatile("s_waitcnt lgkmcnt(0)" ::: "memory")

__device__ __forceinline__ void xpose_item(const float* W, int ldw, int k0, int sc, bf16_t* dst, int K, LAS float* scr, int lane, int mode) {
    const int n4 = (lane & 7) * 4;
    const int col = mode == 1 ? (n4 < 16 ? 3584 + n4 : 5648 + (n4 - 16)) : sc + n4;
#pragma unroll
    for (int i = 0; i < 8; ++i) { const int kk = (lane >> 3) + 8 * i; f32x4 v = (f32x4){0.f, 0.f, 0.f, 0.f}; if (mode != 2) v = *(const f32x4*)(W + (size_t)(k0 + kk) * ldw + col);
        scr[kk * 33 + n4] = v[0]; scr[kk * 33 + n4 + 1] = v[1]; scr[kk * 33 + n4 + 2] = v[2]; scr[kk * 33 + n4 + 3] = v[3]; }
    LDS_WAIT(); asm volatile("" ::: "memory");
    const int c = lane & 7;
#pragma unroll
    for (int jj = 0; jj < 4; ++jj) { const int n = (lane >> 3) + 8 * jj; const LAS float* s = scr + (8 * c) * 33 + n;
        u32x4 o; o.x = pk2(s[0 * 33], s[1 * 33]); o.y = pk2(s[2 * 33], s[3 * 33]); o.z = pk2(s[4 * 33], s[5 * 33]); o.w = pk2(s[6 * 33], s[7 * 33]);
        *(u32x4*)(dst + (size_t)n * K + k0 + 8 * c) = o; }
    LDS_WAIT(); asm volatile("" ::: "memory");
}
__device__ __forceinline__ int hm_col(int grp) { const int T = grp >> 3, q8 = grp & 7; return 256 * T + 32 * (2 * (q8 & 3) + (q8 >> 2)); }

__device__ __forceinline__ void prologue_convert(const Args& a, LAS unsigned char* lds, int it0, int it1, int wave, int lane) {
    LAS float* scr = (LAS float*)(lds + wave * 8704);
    bf16_t* WB = (bf16_t*)(a.ws + WS_W);
    constexpr int I_IN = 440 * 32, I_GLU = 16 * 8, I_BR = 4 * 64 * 8, I_OUT = 64 * 32, I_1 = 256 * 32, I_2 = 64 * 128, I_L = I_IN + I_GLU + I_BR + I_OUT + I_1 + I_2;
    for (int it = it0; it < it1; ++it) {
        const int l = it / I_L; int r = it - l * I_L; bf16_t* wl = WB + (size_t)l * W_LAYER;
        if (r < I_IN) { const int kb = r / 440, grp = r % 440, T = grp >> 3; int sc = hm_col(grp), mode = 0;
            if (T == 54) mode = (grp & 7) == 0 ? 1 : 2; else if (T >= 22) sc += 32; else if (T >= 14) sc += 16;
            xpose_item(a.in[16] + (size_t)l * D * 13856, 13856, 64 * kb, sc, wl + W_IN + (size_t)(32 * grp) * D, D, scr, lane, mode); continue; } r -= I_IN;
        if (r < I_GLU) { const int kb = r / 16, grp = r % 16; xpose_item(a.in[28] + (size_t)l * 512 * 512, 512, 64 * kb, hm_col(grp), wl + W_GLU + (size_t)(32 * grp) * 512, 512, scr, lane, 0); continue; } r -= I_GLU;
        if (r < I_BR) { const int k = r / 512, r2 = r % 512, kb = r2 / 64, grp = r2 % 64;
            xpose_item(a.in[39] + ((size_t)l * 4 + k) * 512 * D, D, 64 * kb, hm_col(grp), wl + W_BR + (size_t)k * D * 512 + (size_t)(32 * grp) * 512, 512, scr, lane, 0); continue; } r -= I_BR;
        if (r < I_OUT) { const int kb = r / 64, grp = r % 64; xpose_item(a.in[40] + (size_t)l * D * D, D, 64 * kb, 32 * grp, wl + W_OUT + (size_t)(32 * grp) * D, D, scr, lane, 0); continue; } r -= I_OUT;
        if (r < I_1) { const int kb = r / 256, grp = r % 256; xpose_item(a.in[41] + (size_t)l * D * DFF, DFF, 64 * kb, hm_col(grp), wl + W_1 + (size_t)(32 * grp) * D, D, scr, lane, 0); continue; } r -= I_1;
        { const int kb = r / 64, grp = r % 64; xpose_item(a.in[42] + (size_t)l * DFF * D, D, 64 * kb, 32 * grp, wl + W_2 + (size_t)(32 * grp) * DFF, DFF, scr, lane, 0); }
    }
}
__device__ __forceinline__ void prologue_ada_unit(const Args& a, LAS unsigned char* lds, int tid, int unit) {
    LAS float* sl = (LAS float*)lds;
    LAS float* red = (LAS float*)(lds + 40960);
    float* mod = (float*)(a.ws + WS_MOD);
    for (int i = tid; i < 5 * D; i += NT) { const int j = i / D, k = i % D; const float x = j == 0 ? a.in[11][k] : a.in[10][(j - 1) * D + k]; sl[i] = x / (1.f + __expf(-x)); }
    __syncthreads();
    const int ks = tid >> 6, c = tid & 63;
    const int l = unit / (6 * D / 64), n0 = (unit % (6 * D / 64)) * 64;
    const float* w = a.in[12] + (size_t)l * D * 6 * D + n0 + c;
    float acc[5] = {0.f, 0.f, 0.f, 0.f, 0.f};
#pragma unroll 8
    for (int k = ks * 256; k < ks * 256 + 256; ++k) { const float wv = w[(size_t)k * 6 * D];
#pragma unroll
        for (int j = 0; j < 5; ++j) acc[j] += sl[j * D + k] * wv; }
#pragma unroll
    for (int j = 0; j < 5; ++j) red[(ks * 5 + j) * 64 + c] = acc[j];
    __syncthreads();
    if (tid < 320) { const int j = tid >> 6; float s = 0.f;
#pragma unroll
        for (int q = 0; q < 8; ++q) s += red[(q * 5 + j) * 64 + c];
        mod[((size_t)l * 5 + j) * 6 * D + n0 + c] = s + a.in[13][l * 6 * D + n0 + c]; }
}
constexpr int PRO_CONV_L = 440 * 32 + 16 * 8 + 4 * 64 * 8 + 64 * 32 + 256 * 32 + 64 * 128;
constexpr int PRO_NCONV = (PRO_CONV_L + 63) / 64,
              PRO_NADA = DEPTH * 6 * D / 64, PRO_NCACHE = 64;
__device__ __forceinline__ void norm_phase(const float* xp, const float* xs, const float* g, const float* modl, int sh_off, int sc_off, bf16_t* H, int gw, int ngw, int lane_,
                                           const float* pend, const float* pmodl, int pg_off, float* xw, const float* xs_pend) {
    int lane = lane_; asm volatile("" : "+v"(lane));
    for (int row = gw; row < M; row += ngw) {
        const float* x = row < MP ? xp + (size_t)row * D : xs + (size_t)(row - MP) * D;
        if (pend != nullptr && row >= 8192) x = xs_pend + (size_t)(row - MP) * D;
        f32x4 v[8]; float ss = 0.f;
#pragma unroll
        for (int j = 0; j < 8; ++j) v[j] = *(const f32x4*)(x + 4 * (lane + 64 * j));
        if (pend != nullptr && row >= 8192) {
            const float* pg = pmodl + (size_t)row_cvec(row) * 6 * D + pg_off; const int pm = row >> 8, r = row & 255;
#pragma unroll
            for (int j = 0; j < 8; ++j) { const int col = 4 * (lane + 64 * j), pn = col >> 8, cc = col & 255;
                const float* P = pend + (size_t)(((pm - 32) * 8 + pn) * 2) * 65536 + (size_t)r * 256 + cc;
                const f32x4 pa = *(const f32x4*)P, pb = *(const f32x4*)(P + 65536), gg = *(const f32x4*)(pg + col);
                v[j] = v[j] + gg * (pa + pb); *(f32x4*)(xw + (size_t)row * D + col) = v[j]; }
        }
#pragma unroll
        for (int j = 0; j < 8; ++j) ss += (v[j][0] * v[j][0] + v[j][1] * v[j][1]) + (v[j][2] * v[j][2] + v[j][3] * v[j][3]);
        const float r = rsqrtf(wave_sum(ss) * (1.f / D) + 1e-6f);
        const float* md = modl + (size_t)row_cvec(row) * 6 * D;
#pragma unroll
        for (int j = 0; j < 8; ++j) { const int i = 4 * (lane + 64 * j);
            const f32x4 gg = *(const f32x4*)(g + i), sc = *(const f32x4*)(md + sc_off + i), sh = *(const f32x4*)(md + sh_off + i);
            const f32x4 o = v[j] * r * gg * (sc + 1.f) + sh;
            u32x2 w; w.x = pk2(o[0], o[1]); w.y = pk2(o[2], o[3]); *(u32x2*)(H + (size_t)row * D + i) = w; }
    }
}
__device__ __forceinline__ void final_fix_phase(const float* pend, const float* pmodl, int pg_off, float* X, int gw, int ngw, int lane_) {
    int lane = lane_; asm volatile("" : "+v"(lane));
    for (int row = 8192 + gw; row < M; row += ngw) {
        const float* pg = pmodl + (size_t)row_cvec(row) * 6 * D + pg_off; const int pm = row >> 8, r = row & 255;
#pragma unroll
        for (int j = 0; j < 8; ++j) { const int col = 4 * (lane + 64 * j), pn = col >> 8, cc = col & 255;
            const float* P = pend + (size_t)(((pm - 32) * 8 + pn) * 2) * 65536 + (size_t)r * 256 + cc;
            const f32x4 pa = *(const f32x4*)P, pb = *(const f32x4*)(P + 65536), gg = *(const f32x4*)(pg + col);
            float* xo = X + (size_t)row * D + col; *(f32x4*)xo = *(const f32x4*)xo + gg * (pa + pb); }
    }
}
__device__ __forceinline__ void conv_pull(const Args& a, LAS unsigned char* lds, volatile LAS unsigned* qitem, int layer, int maxb) {
    unsigned* qhead = (unsigned*)(a.ws + WS_CTL) + 8200 + layer;
    for (int n = 0; maxb < 0 || n < maxb; ++n) {
        __syncthreads();
        if (threadIdx.x == 0) qitem[0] = __hip_atomic_fetch_add(qhead, 1u, __ATOMIC_RELAXED, __HIP_MEMORY_SCOPE_AGENT);
        __syncthreads();
        const int item = (int)qitem[0];
        if (item >= PRO_NCONV) break;
        const int wave = __builtin_amdgcn_readfirstlane((int)(threadIdx.x >> 6));
        const int w0 = layer * PRO_CONV_L + item * 64 + wave * 8, wend = (layer + 1) * PRO_CONV_L;
        int lane = (int)(threadIdx.x & 63); asm volatile("" : "+v"(lane));
        prologue_convert(a, lds, w0, w0 + 8 < wend ? w0 + 8 : wend, wave, lane);
    }
    __syncthreads();
}
}
namespace mk {
constexpr size_t WS_NAT = AL(WS_SCR);
constexpr int NATP = 2048, N_XBC = 0, N_Q = 1024, N_K = 1536;
constexpr size_t WS_TR = AL(WS_NAT + (size_t)M * NATP * 2);
constexpr int T_X = 0, T_B = 512, T_K = 768, T_MV = 1280, T_V = 1792, TRR = 2304;
constexpr int NCH = 96;
constexpr size_t WS_MLC = AL(WS_TR + (size_t)TRR * M * 2);
constexpr size_t WS_MLN = AL(WS_MLC + (size_t)NCH * 4 * 2 * 16384 * 4);
constexpr size_t WS_MLS = AL(WS_MLN + (size_t)NCH * 4 * 2 * 128 * 4);
constexpr size_t WS_MLCS = AL(WS_MLS + (size_t)NCH * 4 * 2 * 4 * 4);
constexpr size_t WS_MLNS = AL(WS_MLCS + (size_t)NCH * 4 * 2 * 16384 * 2);
constexpr size_t WS_MLMS = AL(WS_MLNS + (size_t)NCH * 4 * 2 * 128 * 4);
constexpr size_t WS_OPT_END = AL(WS_MLMS + (size_t)NCH * 4 * 2 * 4);

__device__ __forceinline__ f32x4 mfma16(bf16x8 a, bf16x8 b, f32x4 c) { return __builtin_amdgcn_mfma_f32_16x16x32_bf16(a, b, c, 0, 0, 0); }
__device__ __forceinline__ void chunk_info(int ch, int& row0, int& seq0, int& L, int& lat, int& b, int& ci, int& nc) {
    if (ch < 32) { b = ch >> 1; ci = ch & 1; nc = 2; seq0 = b * 256; L = 256; lat = 0; } else { const int c2 = ch - 32; b = c2 >> 4; ci = c2 & 15; nc = 16; seq0 = MP + b * 2048; L = 2048; lat = 1; }
    row0 = seq0 + ci * 128;
}
__device__ __forceinline__ float fast_exp(float x) { return __expf(x); }

__device__ __forceinline__ void prep_phase(const Args& a, int layer, LAS unsigned char* lds, int gw_, int ngw, int wave, int lane_, bf16_t* UPk) {
    int lane = lane_, gw = gw_; asm volatile("" : "+v"(lane));
    const bf16_t* PROJ = (const bf16_t*)(a.ws + WS_PROJ); bf16_t* NAT = (bf16_t*)(a.ws + WS_NAT); bf16_t* TR = (bf16_t*)(a.ws + WS_TR);
    LAS bf16_t* tile = (LAS bf16_t*)(lds + wave * 16896); LAS bf16_t* otile = tile + 68 * 64;
    const int c = lane & 7, r8 = lane >> 3;
    const float* cw = a.in[30] + layer * 5 * 1024; const float* cb = a.in[31] + layer * 1024;
    for (int u = gw; u < 56 * 192; u += ngw) {
        const int cg = u / 192, tt = u % 192, m0 = tt * 64;
        const int lat = m0 >= MP; const int seq0 = lat ? MP + ((m0 - MP) / 2048) * 2048 : (m0 / 256) * 256, L = lat ? 2048 : 256, t0 = m0 - seq0;
        int kind, src, natcol = -1, trrow = -1;
        if (cg < 16) { kind = 0; src = P_XBC + 64 * cg; natcol = N_XBC + 64 * cg; if (cg < 12) trrow = T_X + 64 * cg; }
        else if (cg < 24) { kind = 1; src = P_MQ + 64 * (cg - 16); natcol = N_Q + 64 * (cg - 16); }
        else if (cg < 32) { kind = 2; src = P_MK + 64 * (cg - 24); natcol = N_K + 64 * (cg - 24); trrow = T_K + 64 * (cg - 24); }
        else if (cg < 40) { kind = 3; src = P_MV + 64 * (cg - 32); trrow = T_MV + 64 * (cg - 32); }
        else if (cg < 48) { kind = 3; src = P_V + 64 * (cg - 40); trrow = T_V + 64 * (cg - 40); }
        else { kind = 4; src = P_S5U + 64 * (cg - 48); }
        const int roff = kind == 0 ? -2 : 0, nrows = kind == 0 ? 68 : 64;
#pragma unroll
        for (int i = 0; i < 9; ++i) { const int r = r8 + 8 * i; if (r < nrows) { const int t = t0 + r + roff; u32x4 v = {0u, 0u, 0u, 0u};
                if (t >= 0 && t < L) v = *(const u32x4*)(PROJ + (size_t)(seq0 + t) * PJ + src + 8 * c);
                *(LAS u32x4*)(tile + r * 64 + 8 * c) = v; } }
        LDS_WAIT(); asm volatile("" ::: "memory");
#define PREP_EMIT(i_, r_) do { if (natcol >= 0) *(u32x4*)(NAT + (size_t)(m0 + r8 + 8 * (i_)) * NATP + natcol + 8 * c) = (r_); if (trrow >= 0) *(LAS u32x4*)(otile + (r8 + 8 * (i_)) * 64 + 8 * c) = (r_); } while (0)
        if (kind == 0) {
            float w[5][8], bz[8];
#pragma unroll
            for (int e = 0; e < 8; ++e) { bz[e] = cb[64 * cg + 8 * c + e];
#pragma unroll
                for (int j = 0; j < 5; ++j) w[j][e] = cw[j * 1024 + 64 * cg + 8 * c + e]; }
#pragma unroll 2
            for (int i = 0; i < 8; ++i) { const int tk = r8 + 8 * i; float acc[8];
#pragma unroll
                for (int e = 0; e < 8; ++e) acc[e] = bz[e];
#pragma unroll
                for (int j = 0; j < 5; ++j) { const u32x4 v = *(const LAS u32x4*)(tile + (tk + j) * 64 + 8 * c);
                    acc[0] += bflo(v.x) * w[j][0]; acc[1] += bfhi(v.x) * w[j][1]; acc[2] += bflo(v.y) * w[j][2]; acc[3] += bfhi(v.y) * w[j][3];
                    acc[4] += bflo(v.z) * w[j][4]; acc[5] += bfhi(v.z) * w[j][5]; acc[6] += bflo(v.w) * w[j][6]; acc[7] += bfhi(v.w) * w[j][7]; }
#pragma unroll
                for (int e = 0; e < 8; ++e) acc[e] = fsilu(acc[e]);
                u32x4 rv; rv.x = pk2(acc[0], acc[1]); rv.y = pk2(acc[2], acc[3]); rv.z = pk2(acc[4], acc[5]); rv.w = pk2(acc[6], acc[7]); PREP_EMIT(i, rv); }
        } else if (kind == 4) {
#pragma unroll
            for (int i = 0; i < 8; ++i) { const int tk = r8 + 8 * i, m = m0 + tk; const u32x4 v = *(const LAS u32x4*)(tile + tk * 64 + 8 * c);
                *(u32x4*)(UPk + ((size_t)(4 * (cg - 48) + (c >> 1)) * 384 + (m >> 5)) * 512 + (m & 31) * 16 + 8 * (c & 1)) = v; }
        } else if (kind == 3 || !lat) {
            const float sc = kind == 2 ? 0.08838834764831845f : 1.f;
#pragma unroll
            for (int i = 0; i < 8; ++i) { const u32x4 v = *(const LAS u32x4*)(tile + (r8 + 8 * i) * 64 + 8 * c);
                u32x4 rv = v;
                if (kind == 2) { rv.x = pk2(bflo(v.x) * sc, bfhi(v.x) * sc); rv.y = pk2(bflo(v.y) * sc, bfhi(v.y) * sc); rv.z = pk2(bflo(v.z) * sc, bfhi(v.z) * sc); rv.w = pk2(bflo(v.w) * sc, bfhi(v.w) * sc); }
                PREP_EMIT(i, rv); }
        } else {
            const float sc = kind == 2 ? 0.08838834764831845f : 1.f; const int odd = cg & 1;
            float inv[8];
#pragma unroll
            for (int e = 0; e < 8; ++e) inv[e] = exp2f(-(float)(8 * (c & 3) + e) * (13.287712379549449f / 32.f));
#pragma unroll
            for (int i = 0; i < 8; ++i) { const int tk = r8 + 8 * i, t = t0 + tk; const float pos = odd ? (float)(t & 63) : (float)(t >> 6);
                const u32x4 vo = *(const LAS u32x4*)(tile + tk * 64 + 8 * c), vp = *(const LAS u32x4*)(tile + tk * 64 + 8 * (c ^ 4));
                float o[8], p[8], rr[8];
                o[0] = bflo(vo.x); o[1] = bfhi(vo.x); o[2] = bflo(vo.y); o[3] = bfhi(vo.y); o[4] = bflo(vo.z); o[5] = bfhi(vo.z); o[6] = bflo(vo.w); o[7] = bfhi(vo.w);
                p[0] = bflo(vp.x); p[1] = bfhi(vp.x); p[2] = bflo(vp.y); p[3] = bfhi(vp.y); p[4] = bflo(vp.z); p[5] = bfhi(vp.z); p[6] = bflo(vp.w); p[7] = bfhi(vp.w);
#pragma unroll
                for (int e = 0; e < 8; ++e) { const float ang = pos * inv[e], cs = __cosf(ang), sn = __sinf(ang);
                    rr[e] = (c < 4 ? o[e] * cs - p[e] * sn : p[e] * sn + o[e] * cs) * sc; }
                u32x4 rv; rv.x = pk2(rr[0], rr[1]); rv.y = pk2(rr[2], rr[3]); rv.z = pk2(rr[4], rr[5]); rv.w = pk2(rr[6], rr[7]); PREP_EMIT(i, rv); }
        }
        if (trrow >= 0) {
            LDS_WAIT(); asm volatile("" ::: "memory");
            bf16_t* dst = TR + (size_t)(trrow + lane) * M + m0;
#pragma unroll
            for (int j = 0; j < 8; ++j) { unsigned wv[4];
#pragma unroll
                for (int q = 0; q < 4; ++q) { const unsigned lo = otile[(8 * j + 2 * q) * 64 + lane], hi = otile[(8 * j + 2 * q + 1) * 64 + lane]; wv[q] = lo | (hi << 16); }
                u32x4 o; o.x = wv[0]; o.y = wv[1]; o.z = wv[2]; o.w = wv[3]; *(u32x4*)(dst + 8 * j) = o; }
        }
        LDS_WAIT(); asm volatile("" ::: "memory");
    }
}

struct MlGate { float lf0, lf1, ig0, ig1, P0, P1, tot; };
__device__ __forceinline__ float wave_incl_scan(float v, int lane) {
#pragma unroll
    for (int o = 1; o < 64; o <<= 1) { const float t = __shfl_up(v, o); if (lane >= o) v += t; }
    return v;
}
__device__ __forceinline__ float wave_max(float v) {
#pragma unroll
    for (int o = 1; o < 64; o <<= 1) v = fmaxf(v, __shfl_xor(v, o));
    return v;
}
__device__ __forceinline__ MlGate ml_gates(const Args& a, int layer, int row0, int hh, int dir, int lane) {
    const float* SMALL = (const float*)(a.ws + WS_SMALL);
    const float ib = a.in[36][layer * 8 + dir * 4 + hh], fb = a.in[37][layer * 8 + dir * 4 + hh];
    MlGate g;
    const float f0 = SMALL[(size_t)(row0 + lane) * 32 + S_MF + dir * 4 + hh] + fb, f1 = SMALL[(size_t)(row0 + lane + 64) * 32 + S_MF + dir * 4 + hh] + fb;
    g.ig0 = SMALL[(size_t)(row0 + lane) * 32 + S_MI + dir * 4 + hh] + ib; g.ig1 = SMALL[(size_t)(row0 + lane + 64) * 32 + S_MI + dir * 4 + hh] + ib;
    g.lf0 = fminf(f0, 0.f) - log1pf(__expf(-fabsf(f0))); g.lf1 = fminf(f1, 0.f) - log1pf(__expf(-fabsf(f1)));
    const float s0 = wave_incl_scan(g.lf0, lane); const float tot0 = __shfl(s0, 63);
    const float s1 = wave_incl_scan(g.lf1, lane) + tot0;
    g.P0 = s0; g.P1 = s1; g.tot = __shfl(s1, 63);
    return g;
}

__device__ __forceinline__ void ml_states_phase(const Args& a, int layer, int tid_, int G) {
    int tid = tid_; asm volatile("" : "+v"(tid));
    const int lane = tid & 63, wave = __builtin_amdgcn_readfirstlane(tid >> 6), fr = lane & 15, fq = lane >> 4;
    const bf16_t* TR = (const bf16_t*)(a.ws + WS_TR);
    float* MLC = (float*)(a.ws + WS_MLC); float* MLN = (float*)(a.ws + WS_MLN); float* MLS = (float*)(a.ws + WS_MLS);
    for (int u = blockIdx.x; u < NCH * 4; u += G) {
        const int ch = u >> 2, hh = u & 3; int row0, seq0, L, lat, b, ci, nc; chunk_info(ch, row0, seq0, L, lat, b, ci, nc);
#pragma unroll 1
        for (int dir = 0; dir < 2; ++dir) {
            const MlGate g = ml_gates(a, layer, row0, hh, dir, lane);
            const float w0 = (dir == 0 ? g.tot - g.P0 : g.P0 - g.lf0) + g.ig0, w1 = (dir == 0 ? g.tot - g.P1 : g.P1 - g.lf1) + g.ig1;
            const float mloc = wave_max(fmaxf(w0, w1));
            const float e0 = __expf(w0 - mloc), e1 = __expf(w1 - mloc);
            f32x4 acc[8];
#pragma unroll
            for (int j = 0; j < 8; ++j) acc[j] = (f32x4){0.f, 0.f, 0.f, 0.f};
            float nacc[8];
#pragma unroll
            for (int j = 0; j < 8; ++j) nacc[j] = 0.f;
            const bf16_t* vrow = TR + (size_t)(T_MV + hh * 128 + wave * 16 + fr) * M + row0 + 8 * fq;
#pragma unroll
            for (int ks = 0; ks < 4; ++ks) {
                const bf16x8 af = *(const bf16x8*)(vrow + 32 * ks);
                float ev[8];
#pragma unroll
                for (int j = 0; j < 8; ++j) { const int tok = 32 * ks + 8 * fq + j; const float x0 = __shfl(e0, tok & 63), x1 = __shfl(e1, tok & 63); ev[j] = tok < 64 ? x0 : x1; }
#pragma unroll
                for (int jt = 0; jt < 8; ++jt) {
                    const u32x4 kv = *(const u32x4*)(TR + (size_t)(T_K + hh * 128 + jt * 16 + fr) * M + row0 + 32 * ks + 8 * fq);
                    const float k0 = bflo(kv.x) * ev[0], k1 = bfhi(kv.x) * ev[1], k2 = bflo(kv.y) * ev[2], k3 = bfhi(kv.y) * ev[3], k4 = bflo(kv.z) * ev[4], k5 = bfhi(kv.z) * ev[5], k6 = bflo(kv.w) * ev[6], k7 = bfhi(kv.w) * ev[7];
                    if (wave == 0) nacc[jt] += ((k0 + k1) + (k2 + k3)) + ((k4 + k5) + (k6 + k7));
                    u32x4 kb; kb.x = pk2(k0, k1); kb.y = pk2(k2, k3); kb.z = pk2(k4, k5); kb.w = pk2(k6, k7);
                    acc[jt] = mfma16(af, __builtin_bit_cast(bf16x8, kb), acc[jt]);
                }
            }
            float* cdst = MLC + ((size_t)(ch * 4 + hh) * 2 + dir) * 16384;
#pragma unroll
            for (int jt = 0; jt < 8; ++jt)
#pragma unroll
                for (int i = 0; i < 4; ++i) cdst[(size_t)(wave * 16 + 4 * fq + i) * 128 + jt * 16 + fr] = acc[jt][i];
            if (wave == 0) {
#pragma unroll
                for (int jt = 0; jt < 8; ++jt) { float v = nacc[jt]; v += __shfl_xor(v, 16); v += __shfl_xor(v, 32); if (fq == 0) MLN[((size_t)(ch * 4 + hh) * 2 + dir) * 128 + jt * 16 + fr] = v; }
                if (lane == 0) { MLS[((size_t)(ch * 4 + hh) * 2 + dir) * 4 + 0] = mloc; MLS[((size_t)(ch * 4 + hh) * 2 + dir) * 4 + 1] = g.tot; }
            }
        }
    }
}
__device__ __forceinline__ void ml_scan_phase(const Args& a, int layer, int tid_, int G) {
    int tid = tid_; asm volatile("" : "+v"(tid));
    const float* MLC = (const float*)(a.ws + WS_MLC); const float* MLN = (const float*)(a.ws + WS_MLN); const float* MLS = (const float*)(a.ws + WS_MLS);
    bf16_t* CS = (bf16_t*)(a.ws + WS_MLCS); float* NS = (float*)(a.ws + WS_MLNS); float* MS = (float*)(a.ws + WS_MLMS);
    for (int task = blockIdx.x; task < 256; task += G) {
        int lat, b, hh, dir, part, nparts;
        if (task < 128) { lat = 1; part = task & 3; dir = (task >> 2) & 1; hh = (task >> 3) & 3; b = task >> 5; nparts = 4; }
        else { const int t2 = task - 128; lat = 0; part = 0; dir = t2 & 1; hh = (t2 >> 1) & 3; b = t2 >> 3; nparts = 1; }
        const int nc = lat ? 16 : 2, ch0 = lat ? 32 + b * 16 : b * 2;
        const int nel = 16384 / nparts, e0 = part * nel, per = nel / NT;
        float c[32]; float n = 0.f, m = 0.f;
        const size_t so = (((size_t)b * DEPTH + layer) * 2 + dir) * 4 + hh;
#pragma unroll
        for (int i = 0; i < 32; ++i) if (i < per) { const int e = e0 + i * NT + tid, vd = e >> 7, kd = e & 127; c[i] = lat ? a.in[7][(so * 128 + kd) * 128 + vd] : 0.f; }
        if (tid < 128) n = lat ? a.in[8][so * 128 + tid] : 0.f;
        m = lat ? a.in[9][so] : 0.f;
        float nx[32]; float nn = 0.f, nml = 0.f, nbl = 0.f;
        { const int ch = ch0 + (dir ? nc - 1 : 0); const size_t sb = (size_t)(ch * 4 + hh) * 2 + dir;
#pragma unroll
            for (int i = 0; i < 32; ++i) if (i < per) nx[i] = MLC[sb * 16384 + e0 + i * NT + tid];
            if (tid < 128) nn = MLN[sb * 128 + tid]; nml = MLS[sb * 4 + 0]; nbl = MLS[sb * 4 + 1]; }
        for (int s = 0; s < nc; ++s) { const int ci = dir ? nc - 1 - s : s, ch = ch0 + ci; const size_t sb = (size_t)(ch * 4 + hh) * 2 + dir;
            float cx[32];
#pragma unroll
            for (int i = 0; i < 32; ++i) if (i < per) cx[i] = nx[i];
            const float cn = nn, ml = nml, bl = nbl;
            if (s + 1 < nc) { const int ch2 = ch0 + (dir ? nc - 2 - s : s + 1); const size_t sb2 = (size_t)(ch2 * 4 + hh) * 2 + dir;
#pragma unroll
                for (int i = 0; i < 32; ++i) if (i < per) nx[i] = MLC[sb2 * 16384 + e0 + i * NT + tid];
                if (tid < 128) nn = MLN[sb2 * 128 + tid]; nml = MLS[sb2 * 4 + 0]; nbl = MLS[sb2 * 4 + 1]; }
#pragma unroll
            for (int i = 0; i < 32; ++i) if (i < per) CS[sb * 16384 + e0 + i * NT + tid] = f2bf(c[i]);
            if (part == 0) { if (tid < 128) NS[sb * 128 + tid] = n; if (tid == 0) MS[sb] = m; }
            const float mn = fmaxf(bl + m, ml), fa = __expf(bl + m - mn), fb = __expf(ml - mn);
#pragma unroll
            for (int i = 0; i < 32; ++i) if (i < per) c[i] = fa * c[i] + fb * cx[i];
            if (tid < 128) n = fa * n + fb * cn;
            m = mn; }
        if (!lat) {
#pragma unroll
            for (int i = 0; i < 32; ++i) if (i < per) { const int e = e0 + i * NT + tid, vd = e >> 7, kd = e & 127; a.out[O_MLC + (so * 128 + kd) * 128 + vd] = c[i]; }
            if (tid < 128) a.out[O_MLN + so * 128 + tid] = n; if (tid == 0) a.out[O_MLM + so] = m; }
    }
}
__device__ __forceinline__ void ml_out_phase(const Args& a, int layer, int gw, int ngw, int lane_) {
    int lane = lane_; asm volatile("" : "+v"(lane));
    const int fr = lane & 15, fq = lane >> 4;
    const bf16_t* NAT = (const bf16_t*)(a.ws + WS_NAT); const bf16_t* TR = (const bf16_t*)(a.ws + WS_TR); const bf16_t* PROJ = (const bf16_t*)(a.ws + WS_PROJ);
    const bf16_t* CS = (const bf16_t*)(a.ws + WS_MLCS); const float* NS = (const float*)(a.ws + WS_MLNS); const float* MS = (const float*)(a.ws + WS_MLMS);
    bf16_t* BR = (bf16_t*)(a.ws + WS_BR);
    for (int it = gw; it < NCH * 4 * 8; it += ngw) {
        const int wv = it & 7, hh = (it >> 3) & 3, ch = it >> 5; int row0, seq0, L, lat, b, ci, nc; chunk_info(ch, row0, seq0, L, lat, b, ci, nc);
        const int t = wv * 16 + fr;
        bf16x8 qf[4];
#pragma unroll
        for (int ks = 0; ks < 4; ++ks) qf[ks] = *(const bf16x8*)(NAT + (size_t)(row0 + t) * NATP + N_Q + hh * 128 + 32 * ks + 8 * fq);
        f32x4 hsum[8];
#pragma unroll
        for (int j = 0; j < 8; ++j) hsum[j] = (f32x4){0.f, 0.f, 0.f, 0.f};
#pragma unroll
        for (int dir = 0; dir < 2; ++dir) {
            const size_t sb = (size_t)(ch * 4 + hh) * 2 + dir;
            const MlGate g = ml_gates(a, layer, row0, hh, dir, lane); const float ms = MS[sb];
            float u0, u1, c0, c1, ai0, ai1;
            if (dir == 0) { u0 = g.ig0 - g.P0; u1 = g.ig1 - g.P1; c0 = g.P0; c1 = g.P1; ai0 = g.P0 + ms; ai1 = g.P1 + ms; }
            else { const float E0 = g.P0 - g.lf0, E1 = g.P1 - g.lf1; u0 = E0 + g.ig0; u1 = E1 + g.ig1; c0 = -E0; c1 = -E1; ai0 = g.tot - E0 + ms; ai1 = g.tot - E1 + ms; }
            float g0 = u0, g1 = u1;
            if (dir == 0) {
#pragma unroll
                for (int o2 = 1; o2 < 64; o2 <<= 1) { const float x0 = __shfl_up(g0, o2), x1 = __shfl_up(g1, o2); if (lane >= o2) { g0 = fmaxf(g0, x0); g1 = fmaxf(g1, x1); } }
                g1 = fmaxf(g1, __shfl(g0, 63));
            } else {
#pragma unroll
                for (int o2 = 1; o2 < 64; o2 <<= 1) { const float x0 = __shfl_down(g0, o2), x1 = __shfl_down(g1, o2); if (lane + o2 < 64) { g0 = fmaxf(g0, x0); g1 = fmaxf(g1, x1); } }
                g0 = fmaxf(g0, __shfl(g1, 0));
            }
            const float mt0 = fmaxf(ai0, c0 + g0), mt1 = fmaxf(ai1, c1 + g1);
            const float w0 = c0 - mt0, w1 = c1 - mt1, si0 = __expf(ai0 - mt0), si1 = __expf(ai1 - mt1), em0 = __expf(-mt0), em1 = __expf(-mt1);
            const int tl = t & 63; const bool th = wv >= 4;
            const float wt = th ? __shfl(w1, tl) : __shfl(w0, tl), sit = th ? __shfl(si1, tl) : __shfl(si0, tl), emt = th ? __shfl(em1, tl) : __shfl(em0, tl);
            f32x4 acc[8];
#pragma unroll
            for (int j = 0; j < 8; ++j) acc[j] = (f32x4){0.f, 0.f, 0.f, 0.f};
#pragma unroll
            for (int ks = 0; ks < 4; ++ks)
#pragma unroll
                for (int j = 0; j < 8; ++j) { const bf16x8 cf = *(const bf16x8*)(CS + sb * 16384 + (size_t)(16 * j + fr) * 128 + 32 * ks + 8 * fq); acc[j] = mfma16(cf, qf[ks], acc[j]); }
            float qn = 0.f;
#pragma unroll
            for (int ks = 0; ks < 4; ++ks) { const u32x4 qv = __builtin_bit_cast(u32x4, qf[ks]); const float* nn = NS + sb * 128 + 32 * ks + 8 * fq; const f32x4 n0 = *(const f32x4*)nn, n1 = *(const f32x4*)(nn + 4);
                qn += bflo(qv.x) * n0[0] + bfhi(qv.x) * n0[1] + bflo(qv.y) * n0[2] + bfhi(qv.y) * n0[3] + bflo(qv.z) * n1[0] + bfhi(qv.z) * n1[1] + bflo(qv.w) * n1[2] + bfhi(qv.w) * n1[3]; }
            qn += __shfl_xor(qn, 16); qn += __shfl_xor(qn, 32);
#pragma unroll
            for (int j = 0; j < 8; ++j) acc[j] *= sit;
            float den = sit * qn;
            const int jlo = dir == 0 ? 0 : (wv >> 1), jhi = dir == 0 ? (wv >> 1) : 3;
            float psum = 0.f;
            for (int jp = jlo; jp <= jhi; ++jp) {
                const int ta = 32 * jp + 8 * (fr >> 2) + (fr & 3);
                f32x4 sa = (f32x4){0.f, 0.f, 0.f, 0.f}, sb2 = (f32x4){0.f, 0.f, 0.f, 0.f};
#pragma unroll
                for (int ks = 0; ks < 4; ++ks) {
                    const bf16x8 ka = *(const bf16x8*)(NAT + (size_t)(row0 + ta) * NATP + N_K + hh * 128 + 32 * ks + 8 * fq);
                    const bf16x8 kb = *(const bf16x8*)(NAT + (size_t)(row0 + ta + 4) * NATP + N_K + hh * 128 + 32 * ks + 8 * fq);
                    sa = mfma16(ka, qf[ks], sa); sb2 = mfma16(kb, qf[ks], sb2); }
                float pa[4], pb[4];
#pragma unroll
                for (int i = 0; i < 4; ++i) { const int s0 = 32 * jp + 8 * fq + i, s1 = s0 + 4;
                    const float us0 = jp < 2 ? __shfl(u0, s0 & 63) : __shfl(u1, s0 & 63), us1 = jp < 2 ? __shfl(u0, s1 & 63) : __shfl(u1, s1 & 63);
                    const bool ok0 = dir == 0 ? s0 <= t : s0 >= t, ok1 = dir == 0 ? s1 <= t : s1 >= t;
                    pa[i] = ok0 ? sa[i] * __expf(us0 + wt) : 0.f; pb[i] = ok1 ? sb2[i] * __expf(us1 + wt) : 0.f;
                    psum += pa[i] + pb[i]; }
                u32x4 pw; pw.x = pk2(pa[0], pa[1]); pw.y = pk2(pa[2], pa[3]); pw.z = pk2(pb[0], pb[1]); pw.w = pk2(pb[2], pb[3]);
                const bf16x8 pf = __builtin_bit_cast(bf16x8, pw);
#pragma unroll
                for (int j = 0; j < 8; ++j) { const bf16x8 vf = *(const bf16x8*)(TR + (size_t)(T_MV + hh * 128 + 16 * j + fr) * M + row0 + 32 * jp + 8 * fq); acc[j] = mfma16(vf, pf, acc[j]); }
            }
            psum += __shfl_xor(psum, 16); psum += __shfl_xor(psum, 32);
            den += psum;
            const float rden = 1.f / fmaxf(fabsf(den), emt);
#pragma unroll
            for (int j = 0; j < 8; ++j) hsum[j] += acc[j] * rden;
        }
        float ss = 0.f;
#pragma unroll
        for (int j = 0; j < 8; ++j) ss += (hsum[j][0] * hsum[j][0] + hsum[j][1] * hsum[j][1]) + (hsum[j][2] * hsum[j][2] + hsum[j][3] * hsum[j][3]);
        ss += __shfl_xor(ss, 16); ss += __shfl_xor(ss, 32);
        const float r = rsqrtf(ss * (1.f / 128.f) + 1e-6f);
        const float* ng = a.in[38] + layer * 512 + hh * 128;
#pragma unroll
        for (int j = 0; j < 8; ++j) { const int vd = 16 * j + 4 * fq; const f32x4 gg = *(const f32x4*)(ng + vd);
            const u32x2 ov = *(const u32x2*)(PROJ + (size_t)(row0 + t) * PJ + P_MO + hh * 128 + vd);
            const float o0 = hsum[j][0] * r * gg[0] * fsigm(bflo(ov.x)), o1 = hsum[j][1] * r * gg[1] * fsigm(bfhi(ov.x)), o2 = hsum[j][2] * r * gg[2] * fsigm(bflo(ov.y)), o3 = hsum[j][3] * r * gg[3] * fsigm(bfhi(ov.y));
            u32x2 w; w.x = pk2(o0, o1); w.y = pk2(o2, o3); *(u32x2*)(BR + (size_t)(row0 + t) * D + 1536 + hh * 128 + vd) = w; }
    }
}
}
namespace mk {
constexpr size_t WS_SST = WS_OPT_END;
constexpr size_t WS_SSL = AL(WS_SST + (size_t)NCH * 8 * 2 * 8192 * 4);
constexpr size_t WS_SSCS = AL(WS_SSL + (size_t)NCH * 8 * 2 * 4);
constexpr size_t WS_YPRE = AL(WS_SSCS + (size_t)NCH * 8 * 2 * 8192 * 2);
constexpr size_t WS_SSQ = AL(WS_YPRE + (size_t)M * 512 * 4);
constexpr size_t WS_SSD_END = AL(WS_SSQ + (size_t)M * 8 * 4);

struct SsdGate { float dt0, dt1, la0, la1, P0, P1, tot; };
__device__ __forceinline__ SsdGate ssd_gates(const Args& a, int layer, int row0, int hh, int dir, int lane) {
    const float* SMALL = (const float*)(a.ws + WS_SMALL);
    const float bias = a.in[32][layer * 16 + dir * 8 + hh], A = -__expf(a.in[33][layer * 16 + dir * 8 + hh]);
    SsdGate g;
    const float x0 = SMALL[(size_t)(row0 + lane) * 32 + S_DT + dir * 8 + hh] + bias, x1 = SMALL[(size_t)(row0 + lane + 64) * 32 + S_DT + dir * 8 + hh] + bias;
    g.dt0 = fmaxf(x0, 0.f) + log1pf(__expf(-fabsf(x0))); g.dt1 = fmaxf(x1, 0.f) + log1pf(__expf(-fabsf(x1)));
    g.la0 = g.dt0 * A; g.la1 = g.dt1 * A;
    const float s0 = wave_incl_scan(g.la0, lane); const float t0 = __shfl(s0, 63);
    const float s1 = wave_incl_scan(g.la1, lane) + t0;
    g.P0 = s0; g.P1 = s1; g.tot = __shfl(s1, 63);
    return g;
}
__device__ __forceinline__ void ssd_states_phase(const Args& a, int layer, int tid_, int G) {
    int tid = tid_; asm volatile("" : "+v"(tid));
    const int lane = tid & 63, wave = __builtin_amdgcn_readfirstlane(tid >> 6), fr = lane & 15, fq = lane >> 4;
    const bf16_t* TR = (const bf16_t*)(a.ws + WS_TR); float* SST = (float*)(a.ws + WS_SST); float* SSL = (float*)(a.ws + WS_SSL);
    for (int u = blockIdx.x; u < NCH * 8; u += G) {
        const int ch = u >> 3, hh = u & 7, grp = hh >> 2; int row0, seq0, L, lat, b, ci, nc; chunk_info(ch, row0, seq0, L, lat, b, ci, nc);
#pragma unroll 1
        for (int dir = 0; dir < 2; ++dir) {
            const SsdGate g = ssd_gates(a, layer, row0, hh, dir, lane);
            const float w0 = g.dt0 * __expf(dir == 0 ? g.tot - g.P0 : g.P0 - g.la0), w1 = g.dt1 * __expf(dir == 0 ? g.tot - g.P1 : g.P1 - g.la1);
            f32x4 acc[4];
#pragma unroll
            for (int j = 0; j < 4; ++j) acc[j] = (f32x4){0.f, 0.f, 0.f, 0.f};
#pragma unroll
            for (int ks = 0; ks < 4; ++ks) {
                float ev[8];
#pragma unroll
                for (int j = 0; j < 8; ++j) { const int tok = 32 * ks + 8 * fq + j; const float y0 = __shfl(w0, tok & 63), y1 = __shfl(w1, tok & 63); ev[j] = tok < 64 ? y0 : y1; }
                const u32x4 bv = *(const u32x4*)(TR + (size_t)(T_B + grp * 128 + wave * 16 + fr) * M + row0 + 32 * ks + 8 * fq);
                u32x4 bw; bw.x = pk2(bflo(bv.x) * ev[0], bfhi(bv.x) * ev[1]); bw.y = pk2(bflo(bv.y) * ev[2], bfhi(bv.y) * ev[3]); bw.z = pk2(bflo(bv.z) * ev[4], bfhi(bv.z) * ev[5]); bw.w = pk2(bflo(bv.w) * ev[6], bfhi(bv.w) * ev[7]);
                const bf16x8 bf = __builtin_bit_cast(bf16x8, bw);
#pragma unroll
                for (int j = 0; j < 4; ++j) { const bf16x8 xf = *(const bf16x8*)(TR + (size_t)(T_X + hh * 64 + 16 * j + fr) * M + row0 + 32 * ks + 8 * fq); acc[j] = mfma16(xf, bf, acc[j]); }
            }
            float* dst = SST + ((size_t)(ch * 8 + hh) * 2 + dir) * 8192;
#pragma unroll
            for (int j = 0; j < 4; ++j)
#pragma unroll
                for (int i = 0; i < 4; ++i) dst[(size_t)(16 * j + 4 * fq + i) * 128 + wave * 16 + fr] = acc[j][i];
            if (tid == 0) SSL[(size_t)(ch * 8 + hh) * 2 + dir] = g.tot;
        }
    }
}
__device__ __forceinline__ void ssd_scan_phase(const Args& a, int layer, int tid_, int G) {
    int tid = tid_; asm volatile("" : "+v"(tid));
    const float* SST = (const float*)(a.ws + WS_SST); const float* SSL = (const float*)(a.ws + WS_SSL); bf16_t* CS = (bf16_t*)(a.ws + WS_SSCS);
    for (int task = blockIdx.x; task < 384; task += G) {
        int lat, b, hh, dir, part, nparts;
        if (task < 128) { lat = 1; part = task & 1; dir = (task >> 1) & 1; hh = (task >> 2) & 7; b = task >> 5; nparts = 2; }
        else { const int t2 = task - 128; lat = 0; part = 0; dir = t2 & 1; hh = (t2 >> 1) & 7; b = t2 >> 4; nparts = 1; }
        const int nc = lat ? 16 : 2, ch0 = lat ? 32 + b * 16 : b * 2;
        const int nel = 8192 / nparts, e0 = part * nel, per = nel / NT;
        float c[16];
        const size_t so = ((((size_t)b * DEPTH + layer) * 2 + dir) * 8 + hh) * 8192;
#pragma unroll
        for (int i = 0; i < 16; ++i) if (i < per) c[i] = lat ? a.in[6][so + e0 + i * NT + tid] : 0.f;
        float nx[16]; float ntot;
        { const int ch = ch0 + (dir ? nc - 1 : 0); const size_t sb = (size_t)(ch * 8 + hh) * 2 + dir;
#pragma unroll
            for (int i = 0; i < 16; ++i) if (i < per) nx[i] = SST[sb * 8192 + e0 + i * NT + tid];
            ntot = SSL[sb]; }
        for (int s = 0; s < nc; ++s) { const int ci = dir ? nc - 1 - s : s, ch = ch0 + ci; const size_t sb = (size_t)(ch * 8 + hh) * 2 + dir;
            float cx[16];
#pragma unroll
            for (int i = 0; i < 16; ++i) if (i < per) cx[i] = nx[i];
            const float dec = __expf(ntot);
            if (s + 1 < nc) { const int ch2 = ch0 + (dir ? nc - 2 - s : s + 1); const size_t sb2 = (size_t)(ch2 * 8 + hh) * 2 + dir;
#pragma unroll
                for (int i = 0; i < 16; ++i) if (i < per) nx[i] = SST[sb2 * 8192 + e0 + i * NT + tid];
                ntot = SSL[sb2]; }
#pragma unroll
            for (int i = 0; i < 16; ++i) if (i < per) CS[sb * 8192 + e0 + i * NT + tid] = f2bf(c[i]);
#pragma unroll
            for (int i = 0; i < 16; ++i) if (i < per) c[i] = dec * c[i] + cx[i]; }
        if (!lat) {
#pragma unroll
            for (int i = 0; i < 16; ++i) if (i < per) a.out[O_SSD + so + e0 + i * NT + tid] = c[i]; }
    }
}
__device__ __forceinline__ void ssd_out_phase(const Args& a, int layer, int gw, int ngw, int lane_) {
    int lane = lane_; asm volatile("" : "+v"(lane));
    const int fr = lane & 15, fq = lane >> 4;
    const bf16_t* NAT = (const bf16_t*)(a.ws + WS_NAT); const bf16_t* TR = (const bf16_t*)(a.ws + WS_TR); const bf16_t* PROJ = (const bf16_t*)(a.ws + WS_PROJ);
    const bf16_t* CS = (const bf16_t*)(a.ws + WS_SSCS); float* YPRE = (float*)(a.ws + WS_YPRE); float* SSQ = (float*)(a.ws + WS_SSQ);
    for (int it = gw; it < NCH * 8 * 8; it += ngw) {
        const int wv = it & 7, hh = (it >> 3) & 7, ch = it >> 6, grp = hh >> 2; int row0, seq0, L, lat, b, ci, nc; chunk_info(ch, row0, seq0, L, lat, b, ci, nc);
        const int t = wv * 16 + fr;
        bf16x8 cf[4];
#pragma unroll
        for (int ks = 0; ks < 4; ++ks) cf[ks] = *(const bf16x8*)(NAT + (size_t)(row0 + t) * NATP + N_XBC + 768 + grp * 128 + 32 * ks + 8 * fq);
        f32x4 ysum[4];
#pragma unroll
        for (int j = 0; j < 4; ++j) ysum[j] = (f32x4){0.f, 0.f, 0.f, 0.f};
#pragma unroll
        for (int dir = 0; dir < 2; ++dir) {
            const size_t sb = (size_t)(ch * 8 + hh) * 2 + dir;
            const SsdGate g = ssd_gates(a, layer, row0, hh, dir, lane);
            float u0, u1, w0, w1, e0, e1;
            if (dir == 0) { u0 = -g.P0; u1 = -g.P1; w0 = g.P0; w1 = g.P1; e0 = __expf(g.P0); e1 = __expf(g.P1); }
            else { const float E0 = g.P0 - g.la0, E1 = g.P1 - g.la1; u0 = E0; u1 = E1; w0 = -E0; w1 = -E1; e0 = __expf(g.tot - E0); e1 = __expf(g.tot - E1); }
            const int tl = t & 63; const bool th = wv >= 4;
            const float wt = th ? __shfl(w1, tl) : __shfl(w0, tl), eot = th ? __shfl(e1, tl) : __shfl(e0, tl);
            f32x4 acc[4];
#pragma unroll
            for (int j = 0; j < 4; ++j) acc[j] = (f32x4){0.f, 0.f, 0.f, 0.f};
#pragma unroll
            for (int ks = 0; ks < 4; ++ks)
#pragma unroll
                for (int j = 0; j < 4; ++j) { const bf16x8 sf = *(const bf16x8*)(CS + sb * 8192 + (size_t)(16 * j + fr) * 128 + 32 * ks + 8 * fq); acc[j] = mfma16(sf, cf[ks], acc[j]); }
#pragma unroll
            for (int j = 0; j < 4; ++j) acc[j] *= eot;
            const int jlo = dir == 0 ? 0 : (wv >> 1), jhi = dir == 0 ? (wv >> 1) : 3;
            for (int jp = jlo; jp <= jhi; ++jp) {
                const int ta = 32 * jp + 8 * (fr >> 2) + (fr & 3);
                f32x4 sa = (f32x4){0.f, 0.f, 0.f, 0.f}, sb2 = (f32x4){0.f, 0.f, 0.f, 0.f};
#pragma unroll
                for (int ks = 0; ks < 4; ++ks) {
                    const bf16x8 ba = *(const bf16x8*)(NAT + (size_t)(row0 + ta) * NATP + N_XBC + 512 + grp * 128 + 32 * ks + 8 * fq);
                    const bf16x8 bb = *(const bf16x8*)(NAT + (size_t)(row0 + ta + 4) * NATP + N_XBC + 512 + grp * 128 + 32 * ks + 8 * fq);
                    sa = mfma16(ba, cf[ks], sa); sb2 = mfma16(bb, cf[ks], sb2); }
                float pa[4], pb[4];
#pragma unroll
                for (int i = 0; i < 4; ++i) { const int s0 = 32 * jp + 8 * fq + i, s1 = s0 + 4;
                    const float us0 = jp < 2 ? __shfl(u0, s0 & 63) : __shfl(u1, s0 & 63), us1 = jp < 2 ? __shfl(u0, s1 & 63) : __shfl(u1, s1 & 63);
                    const float d0 = jp < 2 ? __shfl(g.dt0, s0 & 63) : __shfl(g.dt1, s0 & 63), d1 = jp < 2 ? __shfl(g.dt0, s1 & 63) : __shfl(g.dt1, s1 & 63);
                    const bool ok0 = dir == 0 ? s0 <= t : s0 >= t, ok1 = dir == 0 ? s1 <= t : s1 >= t;
                    pa[i] = ok0 ? sa[i] * d0 * __expf(us0 + wt) : 0.f; pb[i] = ok1 ? sb2[i] * d1 * __expf(us1 + wt) : 0.f; }
                u32x4 pw; pw.x = pk2(pa[0], pa[1]); pw.y = pk2(pa[2], pa[3]); pw.z = pk2(pb[0], pb[1]); pw.w = pk2(pb[2], pb[3]);
                const bf16x8 pf = __builtin_bit_cast(bf16x8, pw);
#pragma unroll
                for (int j = 0; j < 4; ++j) { const bf16x8 xf = *(const bf16x8*)(TR + (size_t)(T_X + hh * 64 + 16 * j + fr) * M + row0 + 32 * jp + 8 * fq); acc[j] = mfma16(xf, pf, acc[j]); }
            }
#pragma unroll
            for (int j = 0; j < 4; ++j) ysum[j] += acc[j];
        }
        const float Dh = a.in[34][layer * 8 + hh]; float ss = 0.f;
#pragma unroll
        for (int j = 0; j < 4; ++j) { const int p = 16 * j + 4 * fq;
            const u32x2 xv = *(const u32x2*)(NAT + (size_t)(row0 + t) * NATP + N_XBC + hh * 64 + p), zv = *(const u32x2*)(PROJ + (size_t)(row0 + t) * PJ + P_Z + hh * 64 + p);
            f32x4 y; y[0] = (ysum[j][0] + bflo(xv.x) * Dh) * fsilu(bflo(zv.x)); y[1] = (ysum[j][1] + bfhi(xv.x) * Dh) * fsilu(bfhi(zv.x));
            y[2] = (ysum[j][2] + bflo(xv.y) * Dh) * fsilu(bflo(zv.y)); y[3] = (ysum[j][3] + bfhi(xv.y) * Dh) * fsilu(bfhi(zv.y));
            ss += (y[0] * y[0] + y[1] * y[1]) + (y[2] * y[2] + y[3] * y[3]);
            *(f32x4*)(YPRE + (size_t)(row0 + t) * 512 + hh * 64 + p) = y; }
        ss += __shfl_xor(ss, 16); ss += __shfl_xor(ss, 32);
        if (fq == 0) SSQ[(size_t)(row0 + t) * 8 + hh] = ss;
    }
}
__device__ __forceinline__ void ssd_fin_phase(const Args& a, int layer, int gw, int ngw, int lane_) {
    int lane = lane_; asm volatile("" : "+v"(lane));
    const float* YPRE = (const float*)(a.ws + WS_YPRE); const float* SSQ = (const float*)(a.ws + WS_SSQ); bf16_t* BR = (bf16_t*)(a.ws + WS_BR); const float* ng = a.in[35] + layer * 512;
    for (int row = gw; row < M; row += ngw) {
        float s = lane < 8 ? SSQ[(size_t)row * 8 + lane] : 0.f; s += __shfl_xor(s, 1); s += __shfl_xor(s, 2); s += __shfl_xor(s, 4); s = __shfl(s, 0);
        const float r = rsqrtf(s * (1.f / 512.f) + 1e-6f);
        const f32x4 y0 = *(const f32x4*)(YPRE + (size_t)row * 512 + 8 * lane), y1 = *(const f32x4*)(YPRE + (size_t)row * 512 + 8 * lane + 4);
        const f32x4 g0 = *(const f32x4*)(ng + 8 * lane), g1 = *(const f32x4*)(ng + 8 * lane + 4);
        *(u32x4*)(BR + (size_t)row * D + 1024 + 8 * lane) = pack8(y0 * r * g0, y1 * r * g1);
    }
}
}
namespace mk {
constexpr size_t WS_CK = WS_SSD_END;
constexpr size_t WS_CVT = AL(WS_CK + (size_t)16 * 512 * 512 * 2);
constexpr size_t WS_ATT_END = AL(WS_CVT + (size_t)16 * 512 * 512 * 2);

__device__ __forceinline__ void prologue_cache(const Args& a, int gw, int ngw, int lane) {
    bf16_t* CK = (bf16_t*)(a.ws + WS_CK); bf16_t* CVT = (bf16_t*)(a.ws + WS_CVT);
    for (size_t i = ((size_t)gw * 64 + lane) * 8; i < (size_t)16 * 512 * 512; i += (size_t)ngw * 64 * 8) {
        const f32x4 x0 = *(const f32x4*)(a.in[2] + i), x1 = *(const f32x4*)(a.in[2] + i + 4); *(u32x4*)(CK + i) = pack8(x0, x1); }
    for (size_t i = (size_t)gw * 64 + lane; i < (size_t)16 * 64 * 512; i += (size_t)ngw * 64) { const int c = i & 511, s8 = (i >> 9) & 63, bl = i >> 15;
        const float* src = a.in[3] + ((size_t)bl * 512 + 8 * s8) * 512 + c;
        u32x4 o; o.x = pk2(src[0], src[512]); o.y = pk2(src[1024], src[1536]); o.z = pk2(src[2048], src[2560]); o.w = pk2(src[3072], src[3584]);
        *(u32x4*)(CVT + ((size_t)bl * 512 + c) * 512 + 8 * s8) = o; }
}
struct AttState { float m, l; f32x4 o[4]; };
struct AttFrags { bf16x8 k[4]; const bf16_t* vt; size_t vp; };
__device__ __forceinline__ void attn_load(AttFrags& f, const bf16_t* kbase, size_t kp, const bf16_t* vt, size_t vp, int fr, int fq) {
    const int ra = 8 * (fr >> 2) + (fr & 3);
#pragma unroll
    for (int ks = 0; ks < 2; ++ks) { f.k[ks] = *(const bf16x8*)(kbase + (size_t)ra * kp + 32 * ks + 8 * fq); f.k[2 + ks] = *(const bf16x8*)(kbase + (size_t)(ra + 4) * kp + 32 * ks + 8 * fq); }
    f.vt = vt + (size_t)fr * vp + 8 * fq; f.vp = vp;
}
template <bool MASKED>
__device__ __forceinline__ void attn_compute(AttState& st, const bf16x8 (&qf)[2], const AttFrags& f, int fq, const float* bias, int kc0, int cq, int cs) {
    bf16x8 vf[4];
#pragma unroll
    for (int j = 0; j < 4; ++j) vf[j] = *(const bf16x8*)(f.vt + (size_t)(16 * j) * f.vp);
    f32x4 sa = (f32x4){0.f, 0.f, 0.f, 0.f}, sb = (f32x4){0.f, 0.f, 0.f, 0.f};
#pragma unroll
    for (int ks = 0; ks < 2; ++ks) { sa = mfma16(f.k[ks], qf[ks], sa); sb = mfma16(f.k[2 + ks], qf[ks], sb); }
    float s[8]; float gm = -1e30f;
#pragma unroll
    for (int i = 0; i < 4; ++i) { s[i] = sa[i] * 0.125f; s[4 + i] = sb[i] * 0.125f; }
    if (MASKED) {
#pragma unroll
        for (int e = 0; e < 8; ++e) { const int kc = kc0 + 8 * fq + e; const bool ok = kc >= cs && kc < cs + 16; const int bi = min(max(kc - cq + 15, 0), 30); s[e] = ok ? s[e] + bias[bi] : -1e30f; }
    }
#pragma unroll
    for (int e = 0; e < 8; ++e) gm = fmaxf(gm, s[e]);
    gm = fmaxf(gm, __shfl_xor(gm, 16)); gm = fmaxf(gm, __shfl_xor(gm, 32));
    const float mn = fmaxf(st.m, gm), al = __expf(st.m - mn); st.m = mn;
    float p[8], ps = 0.f;
#pragma unroll
    for (int e = 0; e < 8; ++e) { p[e] = __expf(s[e] - mn); ps += p[e]; }
    st.l = st.l * al + ps;
    u32x4 pw; pw.x = pk2(p[0], p[1]); pw.y = pk2(p[2], p[3]); pw.z = pk2(p[4], p[5]); pw.w = pk2(p[6], p[7]);
    const bf16x8 pf = __builtin_bit_cast(bf16x8, pw);
#pragma unroll
    for (int j = 0; j < 4; ++j) st.o[j] = mfma16(vf[j], pf, st.o[j] * al);
}
__device__ __forceinline__ void attn_compute2(AttState& s0, AttState& s1, const bf16x8 (&q0)[2], const bf16x8 (&q1)[2], const AttFrags& f, int fq) {
    bf16x8 vf[4];
#pragma unroll
    for (int j = 0; j < 4; ++j) vf[j] = *(const bf16x8*)(f.vt + (size_t)(16 * j) * f.vp);
    f32x4 a0 = (f32x4){0.f, 0.f, 0.f, 0.f}, b0 = a0, a1 = a0, b1 = a0;
#pragma unroll
    for (int ks = 0; ks < 2; ++ks) { a0 = mfma16(f.k[ks], q0[ks], a0); b0 = mfma16(f.k[2 + ks], q0[ks], b0); a1 = mfma16(f.k[ks], q1[ks], a1); b1 = mfma16(f.k[2 + ks], q1[ks], b1); }
    float x0[8], x1[8]; float g0 = -1e30f, g1 = -1e30f;
#pragma unroll
    for (int i = 0; i < 4; ++i) { x0[i] = a0[i] * 0.125f; x0[4 + i] = b0[i] * 0.125f; x1[i] = a1[i] * 0.125f; x1[4 + i] = b1[i] * 0.125f; }
#pragma unroll
    for (int e = 0; e < 8; ++e) { g0 = fmaxf(g0, x0[e]); g1 = fmaxf(g1, x1[e]); }
    g0 = fmaxf(g0, __shfl_xor(g0, 16)); g1 = fmaxf(g1, __shfl_xor(g1, 16)); g0 = fmaxf(g0, __shfl_xor(g0, 32)); g1 = fmaxf(g1, __shfl_xor(g1, 32));
    const float m0 = fmaxf(s0.m, g0), al0 = __expf(s0.m - m0), m1 = fmaxf(s1.m, g1), al1 = __expf(s1.m - m1); s0.m = m0; s1.m = m1;
    float p0 = 0.f, p1 = 0.f;
#pragma unroll
    for (int e = 0; e < 8; ++e) { x0[e] = __expf(x0[e] - m0); p0 += x0[e]; x1[e] = __expf(x1[e] - m1); p1 += x1[e]; }
    s0.l = s0.l * al0 + p0; s1.l = s1.l * al1 + p1;
    u32x4 w0, w1; w0.x = pk2(x0[0], x0[1]); w0.y = pk2(x0[2], x0[3]); w0.z = pk2(x0[4], x0[5]); w0.w = pk2(x0[6], x0[7]); w1.x = pk2(x1[0], x1[1]); w1.y = pk2(x1[2], x1[3]); w1.z = pk2(x1[4], x1[5]); w1.w = pk2(x1[6], x1[7]);
    const bf16x8 f0 = __builtin_bit_cast(bf16x8, w0), f1 = __builtin_bit_cast(bf16x8, w1);
#pragma unroll
    for (int j = 0; j < 4; ++j) { s0.o[j] = mfma16(vf[j], f0, s0.o[j] * al0); s1.o[j] = mfma16(vf[j], f1, s1.o[j] * al1); }
}
__device__ __forceinline__ void attn_store(const AttState& st, bf16_t* BR, int qrow, int hh, int fq) {
    float l = st.l; l += __shfl_xor(l, 16); l += __shfl_xor(l, 32);
    const float rl = 1.f / l;
#pragma unroll
    for (int j = 0; j < 4; ++j) { u32x2 w; w.x = pk2(st.o[j][0] * rl, st.o[j][1] * rl); w.y = pk2(st.o[j][2] * rl, st.o[j][3] * rl);
        *(u32x2*)(BR + (size_t)qrow * D + hh * 64 + 16 * j + 4 * fq) = w; }
}
__device__ __forceinline__ void attn_phase(const Args& a, int layer, int gw_, int ngw, int lane_) {
    int lane = lane_, gw = gw_; asm volatile("" : "+v"(lane));
    const int fr = lane & 15, fq = lane >> 4;
    const bf16_t* PROJ = (const bf16_t*)(a.ws + WS_PROJ); const bf16_t* TR = (const bf16_t*)(a.ws + WS_TR); bf16_t* BR = (bf16_t*)(a.ws + WS_BR);
    const bf16_t* CK = (const bf16_t*)(a.ws + WS_CK); const bf16_t* CVT = (const bf16_t*)(a.ws + WS_CVT);
    for (int it = gw; it < 3072; it += ngw) {
        AttState s0, s1; s0.m = -1e30f; s0.l = 0.f; s1.m = -1e30f; s1.l = 0.f;
#pragma unroll
        for (int j = 0; j < 4; ++j) { s0.o[j] = (f32x4){0.f, 0.f, 0.f, 0.f}; s1.o[j] = (f32x4){0.f, 0.f, 0.f, 0.f}; }
        AttFrags fa, fb; bf16x8 q0[2], q1[2];
        if (it < 2048) {
            const int jp = it & 1, r = (it >> 1) & 31, hh = (it >> 6) & 7, b = it >> 9;
            const int seq0 = MP + b * 2048, qrow = seq0 + r * 64 + 32 * jp + fr;
#pragma unroll
            for (int ks = 0; ks < 2; ++ks) { q0[ks] = *(const bf16x8*)(PROJ + (size_t)qrow * PJ + P_Q + hh * 64 + 32 * ks + 8 * fq); q1[ks] = *(const bf16x8*)(PROJ + (size_t)(qrow + 16) * PJ + P_Q + hh * 64 + 32 * ks + 8 * fq); }
            const int rs = min(max(r - 4, 0), 24);
            const float* rpb = a.in[19] + ((size_t)layer * 8 + hh) * 15 * 31;
            const size_t cb = ((size_t)b * DEPTH + layer) * 512; const bf16_t* kc = CK + cb * 512 + hh * 64; const bf16_t* vc = CVT + (cb + hh * 64) * 512;
#pragma unroll 1
            for (int qt = 0; qt < 2; ++qt) { const int jq = 2 * jp + qt, cq = 16 * jq + fr, cs = min(max(cq - 8, 0), 48), kc0 = jq == 0 ? 0 : (jq == 1 ? 8 : (jq == 2 ? 24 : 32));
                const bf16_t* kw = PROJ + (size_t)(seq0 + rs * 64 + kc0) * PJ + P_K + hh * 64; const bf16_t* vw = TR + (size_t)(T_V + hh * 64) * M + seq0 + rs * 64 + kc0;
                AttState& st = qt == 0 ? s0 : s1; const bf16x8 (&qf)[2] = qt == 0 ? q0 : q1;
                attn_load(fa, kw, PJ, vw, M, fr, fq);
#pragma unroll 1
                for (int j = 0; j < 8; j += 2) {
                    attn_load(fb, kw + (size_t)(j + 1) * 64 * PJ, PJ, vw + (j + 1) * 64, M, fr, fq);
                    attn_compute<true>(st, qf, fa, fq, rpb + (rs + j - r + 7) * 31, kc0, cq, cs);
                    if (j + 2 < 8) attn_load(fa, kw + (size_t)(j + 2) * 64 * PJ, PJ, vw + (j + 2) * 64, M, fr, fq);
                    attn_compute<true>(st, qf, fb, fq, rpb + (rs + j + 1 - r + 7) * 31, kc0, cq, cs);
                }
            }
            attn_load(fa, kc, 512, vc, 512, fr, fq);
#pragma unroll 1
            for (int g = 0; g < 16; g += 2) {
                attn_load(fb, kc + (size_t)(32 * (g + 1)) * 512, 512, vc + 32 * (g + 1), 512, fr, fq);
                attn_compute2(s0, s1, q0, q1, fa, fq);
                if (g + 2 < 16) attn_load(fa, kc + (size_t)(32 * (g + 2)) * 512, 512, vc + 32 * (g + 2), 512, fr, fq);
                attn_compute2(s0, s1, q0, q1, fb, fq);
            }
            attn_store(s0, BR, qrow, hh, fq); attn_store(s1, BR, qrow + 16, hh, fq);
        } else {
            const int i2 = it - 2048, qp = i2 & 7, hh = (i2 >> 3) & 7, b = i2 >> 6, seq0 = b * 256, qrow = seq0 + 32 * qp + fr;
#pragma unroll
            for (int ks = 0; ks < 2; ++ks) { q0[ks] = *(const bf16x8*)(PROJ + (size_t)qrow * PJ + P_Q + hh * 64 + 32 * ks + 8 * fq); q1[ks] = *(const bf16x8*)(PROJ + (size_t)(qrow + 16) * PJ + P_Q + hh * 64 + 32 * ks + 8 * fq); }
            const bf16_t* kp = PROJ + (size_t)seq0 * PJ + P_K + hh * 64; const bf16_t* vp = TR + (size_t)(T_V + hh * 64) * M + seq0;
            attn_load(fa, kp, PJ, vp, M, fr, fq);
#pragma unroll 1
            for (int g = 0; g < 8; g += 2) {
                attn_load(fb, kp + (size_t)(32 * (g + 1)) * PJ, PJ, vp + 32 * (g + 1), M, fr, fq);
                attn_compute2(s0, s1, q0, q1, fa, fq);
                if (g + 2 < 8) attn_load(fa, kp + (size_t)(32 * (g + 2)) * PJ, PJ, vp + 32 * (g + 2), M, fr, fq);
                attn_compute2(s0, s1, q0, q1, fb, fq);
            }
            attn_store(s0, BR, qrow, hh, fq); attn_store(s1, BR, qrow + 16, hh, fq);
        }
    }
}
}
namespace mk {
constexpr int S5K = 768;
constexpr size_t WS_S5W = WS_ATT_END;
constexpr size_t WS_S5WS = AL(WS_S5W + (size_t)DEPTH * 32 * 512 * S5K * 2);
constexpr size_t WS_S5AP = AL(WS_S5WS + (size_t)DEPTH * 32 * 256 * 512 * 2);
constexpr size_t WS_S5UP = AL(WS_S5AP + (size_t)DEPTH * 32 * 2 * 64 * 2 * 4);
constexpr size_t WS_S5SS = AL(WS_S5UP + (size_t)32 * 384 * 512 * 2);
constexpr size_t WS_S5HS = AL(WS_S5SS + (size_t)32 * 384 * 256 * 4);
constexpr size_t WS_S5_END = AL(WS_S5HS + (size_t)32 * 384 * 256 * 2);

__device__ __forceinline__ void s5_param_task(const Args& a, LAS unsigned char* lds, int tid_, int task) {
    int tid = tid_; asm volatile("" : "+v"(tid));
    LAS float* PW = (LAS float*)lds; LAS float* BB = PW + 2 * 33 * 64 * 2; LAS float* CC = BB + 2 * 64 * 16 * 2; LAS float* KT = CC + 2 * 16 * 64 * 2;
    {
        const int layer = task >> 5, g = task & 31;
        const float* a_re = a.in[20] + layer * 4096; const float* a_im = a.in[21] + layer * 4096; const float* log_dt = a.in[22] + layer * 64;
        const float* b_re = a.in[23] + (size_t)layer * 65536; const float* b_im = a.in[24] + (size_t)layer * 65536; const float* c_re = a.in[25] + (size_t)layer * 65536; const float* c_im = a.in[26] + (size_t)layer * 65536;
        const float* s5d = a.in[27] + layer * 512;
        bf16_t* S5W = (bf16_t*)(a.ws + WS_S5W) + (size_t)layer * 32 * 512 * S5K; bf16_t* S5WS = (bf16_t*)(a.ws + WS_S5WS) + (size_t)layer * 32 * 256 * 512; float* S5AP = (float*)(a.ws + WS_S5AP) + (size_t)layer * 32 * 2 * 64 * 2;
        __syncthreads();
        if (tid < 128) { const int dir = tid >> 6, n = tid & 63, pi = (dir * 32 + g) * 64 + n;
            const float are = fminf(a_re[pi], -1e-4f), aim = a_im[pi], dt = expf(log_dt[dir * 32 + g]);
            const float mag = expf(dt * are), abr = mag * cosf(dt * aim), abi = mag * sinf(dt * aim);
            const float den = are * are + aim * aim, nr = abr - 1.f, cfr = (nr * are + abi * aim) / den, cfi = (abi * are - nr * aim) / den;
            float pr = 1.f, pim = 0.f;
            for (int p = 0; p <= 32; ++p) { PW[((dir * 33 + p) * 64 + n) * 2] = pr; PW[((dir * 33 + p) * 64 + n) * 2 + 1] = pim; const float t = pr * abr - pim * abi; pim = pr * abi + pim * abr; pr = t; }
            S5AP[((g * 2 + dir) * 64 + n) * 2] = PW[((dir * 33 + 32) * 64 + n) * 2]; S5AP[((g * 2 + dir) * 64 + n) * 2 + 1] = PW[((dir * 33 + 32) * 64 + n) * 2 + 1];
            for (int k = 0; k < 16; ++k) { const float br_ = b_re[(size_t)pi * 16 + k], bi_ = b_im[(size_t)pi * 16 + k];
                BB[((dir * 64 + n) * 16 + k) * 2] = cfr * br_ - cfi * bi_; BB[((dir * 64 + n) * 16 + k) * 2 + 1] = cfr * bi_ + cfi * br_; }
            for (int j = 0; j < 16; ++j) { CC[((dir * 64 + n) * 16 + j) * 2] = c_re[((size_t)(dir * 32 + g) * 16 + j) * 64 + n]; CC[((dir * 64 + n) * 16 + j) * 2 + 1] = c_im[((size_t)(dir * 32 + g) * 16 + j) * 64 + n]; }
        }
        __syncthreads();
        for (int e = tid; e < 2 * 32 * 256; e += NT) { const int j = e & 15, k = (e >> 4) & 15, tau = (e >> 8) & 31, dir = e >> 13; float s = 0.f;
            for (int n = 0; n < 64; ++n) { const float cr = CC[((dir * 64 + n) * 16 + j) * 2], ci = CC[((dir * 64 + n) * 16 + j) * 2 + 1], pr = PW[((dir * 33 + tau) * 64 + n) * 2], pim = PW[((dir * 33 + tau) * 64 + n) * 2 + 1];
                const float xr = cr * pr - ci * pim, xi = cr * pim + ci * pr, br_ = BB[((dir * 64 + n) * 16 + k) * 2], bi_ = BB[((dir * 64 + n) * 16 + k) * 2 + 1];
                s += xr * br_ - xi * bi_; }
            KT[e] = s; }
        __syncthreads();
        { const int t = tid >> 4, j = tid & 15; bf16_t* dst = S5W + ((size_t)g * 512 + tid) * S5K;
            for (int s = 0; s < 32; ++s) { float v[16];
#pragma unroll
                for (int k = 0; k < 16; ++k) { float x;
                    if (s < t) x = KT[((0 * 32 + (t - s)) * 16 + k) * 16 + j]; else if (s > t) x = KT[((1 * 32 + (s - t)) * 16 + k) * 16 + j];
                    else x = KT[((0 * 32 + 0) * 16 + k) * 16 + j] + KT[((1 * 32 + 0) * 16 + k) * 16 + j] + (k == j ? s5d[g * 16 + k] : 0.f);
                    v[k] = x; }
                u32x4 o0, o1; o0.x = pk2(v[0], v[1]); o0.y = pk2(v[2], v[3]); o0.z = pk2(v[4], v[5]); o0.w = pk2(v[6], v[7]); o1.x = pk2(v[8], v[9]); o1.y = pk2(v[10], v[11]); o1.z = pk2(v[12], v[13]); o1.w = pk2(v[14], v[15]);
                *(u32x4*)(dst + s * 16) = o0; *(u32x4*)(dst + s * 16 + 8) = o1; }
            for (int dir = 0; dir < 2; ++dir) { const int p = dir == 0 ? t + 1 : 32 - t;
                for (int n8 = 0; n8 < 8; ++n8) { float gr[8], gi[8];
#pragma unroll
                    for (int q = 0; q < 8; ++q) { const int n = n8 * 8 + q; const float cr = CC[((dir * 64 + n) * 16 + j) * 2], ci = CC[((dir * 64 + n) * 16 + j) * 2 + 1], pr = PW[((dir * 33 + p) * 64 + n) * 2], pim = PW[((dir * 33 + p) * 64 + n) * 2 + 1];
                        gr[q] = cr * pr - ci * pim; gi[q] = -(cr * pim + ci * pr); }
                    u32x4 o; o.x = pk2(gr[0], gr[1]); o.y = pk2(gr[2], gr[3]); o.z = pk2(gr[4], gr[5]); o.w = pk2(gr[6], gr[7]); *(u32x4*)(dst + 512 + dir * 128 + n8 * 8) = o;
                    o.x = pk2(gi[0], gi[1]); o.y = pk2(gi[2], gi[3]); o.z = pk2(gi[4], gi[5]); o.w = pk2(gi[6], gi[7]); *(u32x4*)(dst + 512 + dir * 128 + 64 + n8 * 8) = o; } }
        }
        if (tid < 256) { const int dir = tid >> 7, reim = (tid >> 6) & 1, n = tid & 63; bf16_t* dst = S5WS + ((size_t)g * 256 + tid) * 512;
            for (int s = 0; s < 32; ++s) { const int p = dir == 0 ? 31 - s : s; const float pr = PW[((dir * 33 + p) * 64 + n) * 2], pim = PW[((dir * 33 + p) * 64 + n) * 2 + 1]; float v[16];
#pragma unroll
                for (int k = 0; k < 16; ++k) { const float br_ = BB[((dir * 64 + n) * 16 + k) * 2], bi_ = BB[((dir * 64 + n) * 16 + k) * 2 + 1]; v[k] = reim == 0 ? pr * br_ - pim * bi_ : pr * bi_ + pim * br_; }
                u32x4 o0, o1; o0.x = pk2(v[0], v[1]); o0.y = pk2(v[2], v[3]); o0.z = pk2(v[4], v[5]); o0.w = pk2(v[6], v[7]); o1.x = pk2(v[8], v[9]); o1.y = pk2(v[10], v[11]); o1.z = pk2(v[12], v[13]); o1.w = pk2(v[14], v[15]);
                *(u32x4*)(dst + s * 16) = o0; *(u32x4*)(dst + s * 16 + 8) = o1; } }
    }
    __syncthreads();
}
__device__ __forceinline__ void s5_statein_phase(const Args& a, int layer, int gw, int ngw, int lane_) {
    int lane = lane_; asm volatile("" : "+v"(lane));
    const int fr = lane & 15, fq = lane >> 4;
    const bf16_t* UP = (const bf16_t*)(a.ws + WS_S5UP); const bf16_t* S5WS = (const bf16_t*)(a.ws + WS_S5WS) + (size_t)layer * 32 * 256 * 512; float* SS = (float*)(a.ws + WS_S5SS);
    for (int it = ngw - 1 - gw; it < 32 * 24; it += ngw) { const int g = it / 24, r = it % 24, og = r / 6, cq = r % 6;
        f32x4 acc[4][4];
#pragma unroll
        for (int i = 0; i < 4; ++i)
#pragma unroll
            for (int j = 0; j < 4; ++j) acc[i][j] = (f32x4){0.f, 0.f, 0.f, 0.f};
        const bf16_t* ap = S5WS + ((size_t)g * 256 + 64 * og + fr) * 512 + 8 * fq; const bf16_t* bp = UP + ((size_t)g * 384 + 64 * cq + fr) * 512 + 8 * fq;
#pragma unroll 2
        for (int ks = 0; ks < 16; ++ks) { bf16x8 af[4], bf[4];
#pragma unroll
            for (int i = 0; i < 4; ++i) { af[i] = *(const bf16x8*)(ap + (size_t)16 * i * 512 + 32 * ks); bf[i] = *(const bf16x8*)(bp + (size_t)16 * i * 512 + 32 * ks); }
#pragma unroll
            for (int i = 0; i < 4; ++i)
#pragma unroll
                for (int j = 0; j < 4; ++j) acc[i][j] = mfma16(af[i], bf[j], acc[i][j]); }
#pragma unroll
        for (int i = 0; i < 4; ++i)
#pragma unroll
            for (int j = 0; j < 4; ++j) *(f32x4*)(SS + ((size_t)g * 384 + 64 * cq + 16 * j + fr) * 256 + 64 * og + 16 * i + 4 * fq) = acc[i][j];
    }
}
__device__ __forceinline__ void s5_scan_phase(const Args& a, int layer, int gw, int ngw, int lane_) {
    int lane = lane_; asm volatile("" : "+v"(lane));
    const float* SS = (const float*)(a.ws + WS_S5SS); bf16_t* HS = (bf16_t*)(a.ws + WS_S5HS); const float* S5AP = (const float*)(a.ws + WS_S5AP) + (size_t)layer * 32 * 2 * 64 * 2;
    for (int task = gw; task < 1280; task += ngw) {
        int sq, g, dir; if (task < 256) { sq = 16 + (task >> 6); g = (task >> 1) & 31; dir = task & 1; } else { const int t2 = task - 256; sq = t2 >> 6; g = (t2 >> 1) & 31; dir = t2 & 1; }
        const int lat = sq >= 16, b = lat ? sq - 16 : sq, nc = lat ? 64 : 8, cg0 = lat ? 128 + b * 64 : b * 8;
        const float apr = S5AP[((g * 2 + dir) * 64 + lane) * 2], api = S5AP[((g * 2 + dir) * 64 + lane) * 2 + 1];
        float hr = 0.f, hi = 0.f;
        if (lat) { const size_t so = ((((size_t)b * DEPTH + layer) * 2 + dir) * 32 + g) * 64 + lane; hr = a.in[4][so]; hi = a.in[5][so]; }
        for (int s0 = 0; s0 < nc; s0 += 8) {
            float sr[8], si[8];
#pragma unroll
            for (int q = 0; q < 8; ++q) { const int cg = cg0 + (dir ? nc - 1 - (s0 + q) : s0 + q); const size_t base = ((size_t)g * 384 + cg) * 256 + dir * 128; sr[q] = SS[base + lane]; si[q] = SS[base + 64 + lane]; }
#pragma unroll
            for (int q = 0; q < 8; ++q) { const int cg = cg0 + (dir ? nc - 1 - (s0 + q) : s0 + q); const size_t base = ((size_t)g * 384 + cg) * 256 + dir * 128;
                HS[base + lane] = f2bf(hr); HS[base + 64 + lane] = f2bf(hi);
                const float t = apr * hr - api * hi + sr[q]; hi = apr * hi + api * hr + si[q]; hr = t; }
        }
        if (!lat) { const size_t oo = ((((size_t)b * DEPTH + layer) * 2 + dir) * 32 + g) * 64 + lane; a.out[O_S5R + oo] = hr; a.out[O_S5I + oo] = hi; }
    }
}
__device__ __forceinline__ void s5_out_phase(const Args& a, int layer, int gw, int ngw, int lane_) {
    int lane = lane_; asm volatile("" : "+v"(lane));
    const int fr = lane & 15, fq = lane >> 4;
    const bf16_t* UP = (const bf16_t*)(a.ws + WS_S5UP); const bf16_t* S5W = (const bf16_t*)(a.ws + WS_S5W) + (size_t)layer * 32 * 512 * S5K; const bf16_t* HS = (const bf16_t*)(a.ws + WS_S5HS); bf16_t* ZB = (bf16_t*)(a.ws + WS_ZB);
    for (int it = ngw - 1 - gw; it < 32 * 48; it += ngw) { const int g = it / 48, r = it % 48, og = r / 6, cq = r % 6;
        f32x4 acc[4][4];
#pragma unroll
        for (int i = 0; i < 4; ++i)
#pragma unroll
            for (int j = 0; j < 4; ++j) acc[i][j] = (f32x4){0.f, 0.f, 0.f, 0.f};
        const bf16_t* ap = S5W + ((size_t)g * 512 + 64 * og + fr) * S5K + 8 * fq;
        const bf16_t* bp = UP + ((size_t)g * 384 + 64 * cq + fr) * 512 + 8 * fq; const bf16_t* hp = HS + ((size_t)g * 384 + 64 * cq + fr) * 256 + 8 * fq;
#pragma unroll 2
        for (int ks = 0; ks < 16; ++ks) { bf16x8 af[4], bf[4];
#pragma unroll
            for (int i = 0; i < 4; ++i) { af[i] = *(const bf16x8*)(ap + (size_t)16 * i * S5K + 32 * ks); bf[i] = *(const bf16x8*)(bp + (size_t)16 * i * 512 + 32 * ks); }
#pragma unroll
            for (int i = 0; i < 4; ++i)
#pragma unroll
                for (int j = 0; j < 4; ++j) acc[i][j] = mfma16(af[i], bf[j], acc[i][j]); }
#pragma unroll 2
        for (int ks = 0; ks < 8; ++ks) { bf16x8 af[4], bf[4];
#pragma unroll
            for (int i = 0; i < 4; ++i) { af[i] = *(const bf16x8*)(ap + (size_t)16 * i * S5K + 512 + 32 * ks); bf[i] = *(const bf16x8*)(hp + (size_t)16 * i * 256 + 32 * ks); }
#pragma unroll
            for (int i = 0; i < 4; ++i)
#pragma unroll
                for (int j = 0; j < 4; ++j) acc[i][j] = mfma16(af[i], bf[j], acc[i][j]); }
#pragma unroll
        for (int i = 0; i < 4; ++i)
#pragma unroll
            for (int j = 0; j < 4; ++j) { float z[4];
#pragma unroll
                for (int e = 0; e < 4; ++e) { const float x = acc[i][j][e]; const float th = 0.7978845608028654f * (x + 0.044715f * x * x * x); const float e2 = __expf(2.f * th); const float tnh = 1.f - 2.f * __builtin_amdgcn_rcpf(e2 + 1.f); z[e] = 0.5f * x * (1.f + tnh); }
                u32x2 w; w.x = pk2(z[0], z[1]); w.y = pk2(z[2], z[3]);
                *(u32x2*)(ZB + (size_t)(32 * (64 * cq + 16 * j + fr) + 4 * og + i) * 512 + g * 16 + 4 * fq) = w; }
    }
}
}
namespace mk { static_assert(WS_S5_END < (size_t)1780 * 1024 * 1024, "workspace map exceeds the guaranteed size"); }
namespace mk {
#ifndef PHMASK
#define PHMASK 0xfffff
#endif
#define PHM(k) ((PHMASK >> (k)) & 1)
#ifndef DUPMASK
#define DUPMASK 0
#endif
#define DUP(k) ((DUPMASK >> (k)) & 1)
constexpr int NPH = 12;
constexpr int PH_TOTAL = 2 + DEPTH * NPH;
__global__ void __launch_bounds__(NT, 2) mk_fwd(Args a) {
    extern __shared__ __attribute__((aligned(16))) unsigned char lds_raw[];
    LAS unsigned char* lds = (LAS unsigned char*)lds_raw;
#define TID ((int)threadIdx.x)
#define LANE ((int)(threadIdx.x & 63))
#define WAVE (__builtin_amdgcn_readfirstlane((int)(threadIdx.x >> 6)))
#define GW ((int)blockIdx.x * NWV + WAVE)
    const int G = gridDim.x, ngw = G * NWV;
    volatile LAS unsigned* ctlw = (volatile LAS unsigned*)(lds + LDS_CTL);
    if (TID < 4) ctlw[TID] = 0u;
    __syncthreads();
    XcdBarrier bar = xcd_barrier_post((unsigned*)(a.ws + WS_CTL), ctlw);
    const int lo = a.ph_lo, hi = a.ph_hi;
#define IN(k) (lo <= (k) && (k) < hi)
#define SEAM(k) do { if (IN(k) && IN((k) + 1)) { xcd_barrier(bar); if (DUP(13)) xcd_barrier(bar); } } while (0)
#define H ((bf16_t*)(a.ws + WS_H))
#define PROJ ((bf16_t*)(a.ws + WS_PROJ))
#define SMALL ((float*)(a.ws + WS_SMALL))
#define BR ((bf16_t*)(a.ws + WS_BR))
#define MERGED ((bf16_t*)(a.ws + WS_MERGED))
#define MACC ((float*)(a.ws + WS_MACC))
#define ZB ((bf16_t*)(a.ws + WS_ZB))
#define HID ((bf16_t*)(a.ws + WS_PROJ))
#define MOD ((const float*)(a.ws + WS_MOD))
#define X (a.out)
    if (PHM(0) && IN(0)) {
        for (int rep_ = 0; rep_ < 1 + DUP(17); ++rep_) {
        unsigned* qhead = (unsigned*)(a.ws + WS_CTL) + 8192 + 64 * rep_;
        volatile LAS unsigned* qitem = ctlw + 8;
        for (;;) {
            __syncthreads();
            if (TID == 0) qitem[0] = __hip_atomic_fetch_add(qhead, 1u, __ATOMIC_RELAXED, __HIP_MEMORY_SCOPE_AGENT);
            __syncthreads();
            int item = (int)qitem[0];
            if (item >= DEPTH * 32 + PRO_NADA + PRO_NCACHE) break;
            if (item < DEPTH * 32) { s5_param_task(a, lds, TID, item); continue; } item -= DEPTH * 32;
            if (item < PRO_NADA) { prologue_ada_unit(a, lds, TID, item); continue; } item -= PRO_NADA;
            prologue_cache(a, item * NWV + WAVE, PRO_NCACHE * NWV, LANE);
        }
        }
        conv_pull(a, lds, ctlw + 8, 0, -1);
    }
    SEAM(0);
    for (int l = 0; l < DEPTH; ++l) {
        const int pb = 1 + l * NPH;
#define xp (l == 0 ? a.in[0] : X)
#define xs (l == 0 ? a.in[1] : X + (size_t)MP * D)
#define modl (MOD + (size_t)l * 5 * 6 * D)
#define wl ((const bf16_t*)(a.ws + WS_W) + (size_t)l * W_LAYER)
        if (PHM(1) && IN(pb + 0) && l > 0) conv_pull(a, lds, ctlw + 8, l, -1);
        if (PHM(1) && IN(pb + 0)) norm_phase(xp, xs, a.in[14] + l * D, modl, 0, D, H, GW, ngw, LANE, l > 0 ? MACC : nullptr, modl - (size_t)5 * 6 * D, 5 * D, X, xs);
        SEAM(pb + 0);
        if (PHM(2) && IN(pb + 1)) { Gemm g{H, wl + W_IN, M, NIN, D, D, 1, 0, 0}; StaticOrder S; S.init(M, NIN, G, blockIdx.x, 1, D);
            EpiIn E{PROJ, SMALL, a.out, a.in[17] + l * 64, a.in[18] + l * 64, l}; for (int r_ = 0; r_ < 1 + DUP(9); ++r_) gemm_phase(lds, g, S, E);
            if (l + 1 < DEPTH && (int)blockIdx.x >= 80) conv_pull(a, lds, ctlw + 8, l + 1, 1); }
        SEAM(pb + 1);
        if (PHM(3) && IN(pb + 2)) { for (int r_ = 0; r_ < 1 + DUP(0); ++r_) { prep_phase(a, l, lds, GW, ngw, WAVE, LANE, (bf16_t*)(a.ws + WS_S5UP)); __syncthreads(); } }
        SEAM(pb + 2);
        if (PHM(4) && IN(pb + 3)) { for (int r_ = 0; r_ < 1 + DUP(2); ++r_) attn_phase(a, l, GW, ngw, LANE); for (int r_ = 0; r_ < 1 + DUP(3); ++r_) { ml_states_phase(a, l, TID, G); ssd_states_phase(a, l, TID, G); s5_statein_phase(a, l, GW, ngw, LANE); } }
        SEAM(pb + 3);
        if (PHM(5) && IN(pb + 4)) { for (int r_ = 0; r_ < 1 + DUP(4); ++r_) { ml_scan_phase(a, l, TID, G); ssd_scan_phase(a, l, TID, G); s5_scan_phase(a, l, GW, ngw, LANE); } }
        SEAM(pb + 4);
        if (PHM(12) && IN(pb + 5)) { for (int r_ = 0; r_ < 1 + DUP(5); ++r_) ml_out_phase(a, l, GW, ngw, LANE); for (int r_ = 0; r_ < 1 + DUP(6); ++r_) ssd_out_phase(a, l, GW, ngw, LANE); for (int r_ = 0; r_ < 1 + DUP(7); ++r_) s5_out_phase(a, l, GW, ngw, LANE); }
        SEAM(pb + 5);
        if (PHM(6) && IN(pb + 6)) { Gemm g{ZB, wl + W_GLU, M, 512, 512, 512, 1, 0, 0}; StaticOrder S; S.init(M, 512, G, blockIdx.x, 1, 512);
            EpiGlu E{ZB, a.in[29] + l * 512, BR}; for (int r_ = 0; r_ < 1 + DUP(16); ++r_) gemm_phase(lds, g, S, E); ssd_fin_phase(a, l, GW, ngw, LANE); }
        SEAM(pb + 6);
        if (PHM(7) && IN(pb + 7)) { Gemm g{BR, wl + W_BR, M, D, 512, D, 4, 512, (size_t)D * 512}; StaticOrder S; S.init(M, D, G, blockIdx.x, 4, 512);
            EpiBranch E{PROJ, MERGED}; for (int r_ = 0; r_ < 1 + DUP(12); ++r_) gemm_phase(lds, g, S, E);
            if (l + 1 < DEPTH && (int)blockIdx.x >= 128) conv_pull(a, lds, ctlw + 8, l + 1, 2); }
        SEAM(pb + 7);
        if (PHM(8) && IN(pb + 8)) { Gemm g{MERGED, wl + W_OUT, M, D, D, D, 1, 0, 0}; SplitOrder S; S.init(blockIdx.x, D);
            EpiResid E{xp, xs, modl, 2 * D, X, MACC}; if (DUP(14)) { EpiResid E2{xp, xs, modl, 2 * D, (float*)(a.ws + WS_PROJ), MACC}; gemm_phase(lds, g, S, E2); } gemm_phase(lds, g, S, E); }
        SEAM(pb + 8);
        if (PHM(9) && IN(pb + 9)) norm_phase(X, X + (size_t)MP * D, a.in[15] + l * D, modl, 3 * D, 4 * D, H, GW, ngw, LANE, MACC, modl, 2 * D, X, xs);
        SEAM(pb + 9);
        if (PHM(10) && IN(pb + 10)) { Gemm g{H, wl + W_1, M, DFF, D, D, 1, 0, 0}; StaticOrder S; S.init(M, DFF, G, blockIdx.x, 1, D);
            EpiRelu2 E{HID, DFF}; for (int r_ = 0; r_ < 1 + DUP(10); ++r_) gemm_phase(lds, g, S, E); }
        SEAM(pb + 10);
        if (PHM(11) && IN(pb + 11)) { Gemm g{HID, wl + W_2, M, D, DFF, DFF, 1, 0, 0}; SplitOrder S; S.init(blockIdx.x, DFF);
            EpiResid E{X, X + (size_t)MP * D, modl, 5 * D, X, MACC}; if (DUP(15)) { EpiResid E2{X, X + (size_t)MP * D, modl, 5 * D, (float*)(a.ws + WS_BR), MACC}; gemm_phase(lds, g, S, E2); } gemm_phase(lds, g, S, E); }
        SEAM(pb + 11);
    }
    if (IN(1 + DEPTH * NPH)) final_fix_phase(MACC, MOD + (size_t)(DEPTH - 1) * 5 * 6 * D, 5 * D, X, GW, ngw, LANE);
#undef IN
#undef SEAM
#undef H
#undef PROJ
#undef SMALL
#undef BR
#undef MERGED
#undef MACC
#undef ZB
#undef HID
#undef MOD
#undef X
#undef xp
#undef xs
#undef modl
#undef wl
}
}
extern "C" void kernel_launch(void* const* d_in, const int* in_sizes, int n_in, void* d_out, int out_size, void* d_ws, size_t ws_size, hipStream_t stream) {
    static int grid = 0;
    if (grid == 0) {
        int dev = 0, cus = 0; (void)hipGetDevice(&dev); (void)hipDeviceGetAttribute(&cus, hipDeviceAttributeMultiprocessorCount, dev);
        (void)hipFuncSetAttribute((const void*)mk::mk_fwd, hipFuncAttributeMaxDynamicSharedMemorySize, mk::LDS_BYTES);
        int per_cu = 0; (void)hipOccupancyMaxActiveBlocksPerMultiprocessor(&per_cu, (const void*)mk::mk_fwd, mk::NT, mk::LDS_BYTES); (void)hipGetLastError();
        (void)cus; grid = 256;
    }
    mk::Args a{}; for (int i = 0; i < 43; ++i) a.in[i] = (const float*)d_in[i];
    a.out = (float*)d_out; a.ws = (unsigned char*)d_ws; a.ph_lo = 0; a.ph_hi = mk::PH_TOTAL;
    (void)hipMemsetAsync(a.ws + mk::WS_CTL, 0, mk::CTL_BYTES, stream);
    hipLaunchKernelGGL(mk::mk_fwd, dim3(grid), dim3(mk::NT), mk::LDS_BYTES, stream, a);
}
```

```cpp
#define SAFE_GEMM 0
#define DUPMASK 0
#define TPROBE -1
#include <hip/hip_runtime.h>
#include <math.h>
namespace mk {
#define LAS __attribute__((address_space(3)))
typedef unsigned short bf16_t;
typedef short bf16x8 __attribute__((ext_vector_type(8)));
typedef float f32x4 __attribute__((ext_vector_type(4)));
typedef float f32x2 __attribute__((ext_vector_type(2)));
typedef unsigned u32x4 __attribute__((ext_vector_type(4)));
typedef unsigned u32x2 __attribute__((ext_vector_type(2)));
typedef int v4i32 __attribute__((ext_vector_type(4)));
typedef int v8i32 __attribute__((ext_vector_type(8)));
constexpr int NT = 512, NWV = 8;
constexpr int D = 2048, MP = 4096, MLAT = 8192, M = MP + MLAT, DEPTH = 4, DFF = 8192;
constexpr int PJ = 13824;
constexpr int NIN = 14080;
constexpr int P_Q = 0, P_K = 512, P_V = 1024, P_S5U = 1536, P_Z = 2048, P_XBC = 2560, P_MQ = 3584, P_MK = 4096, P_MV = 4608, P_MO = 5120, P_GATE = 5632;
constexpr int S_DT = 0, S_MI = 16, S_MF = 24;

typedef __bf16 bf16x2_t __attribute__((ext_vector_type(2)));
__device__ __forceinline__ unsigned pk2(float lo, float hi) { f32x2 v = {lo, hi}; bf16x2_t b = __builtin_convertvector(v, bf16x2_t); return __builtin_bit_cast(unsigned, b); }
__device__ __forceinline__ float bf2f(bf16_t v) { return __uint_as_float(((unsigned)v) << 16); }
__device__ __forceinline__ float bflo(unsigned w) { return __uint_as_float(w << 16); }
__device__ __forceinline__ float bfhi(unsigned w) { return __uint_as_float(w & 0xffff0000u); }
__device__ __forceinline__ bf16_t f2bf(float f) { return (bf16_t)(pk2(f, 0.f) & 0xffffu); }
__device__ __forceinline__ float fsigm(float x) { return __builtin_amdgcn_rcpf(1.f + __expf(-x)); }
__device__ __forceinline__ float fsilu(float x) { return x * fsigm(x); }
__device__ __forceinline__ int row_cvec(int row) { return row < MP ? 0 : 1 + (row - MP) / 2048; }

#define XB_TMO      128
#define XB_XCNT(j)  (256  + 64 * (j))
#define XB_XSUB(j)  (1280 + 64 * (j))
#define XB_XGEN(j)  (2304 + 64 * (j))
#define XB_TOP      3328
#define XB_TOPGEN   3392
#define XCD_BAR_WORDS 3456
#define XB_SPIN_CAP (1u << 18)
__device__ __forceinline__ unsigned xb_ld(unsigned* p)              { return __hip_atomic_load(p, __ATOMIC_RELAXED, __HIP_MEMORY_SCOPE_AGENT); }
__device__ __forceinline__ unsigned xb_add(unsigned* p, unsigned v) { return __hip_atomic_fetch_add(p, v, __ATOMIC_RELAXED, __HIP_MEMORY_SCOPE_AGENT); }
__device__ __forceinline__ unsigned xb_xcc_id() { return (unsigned)__builtin_amdgcn_s_getreg((3 << 11) | 20) & 0xFu; }
#define XB_SPIN(cond, bar) do { unsigned _sp = 0; while (cond) { __builtin_amdgcn_s_sleep(1); \
    if ((++_sp & 255u) == 0u) { if (xb_ld(&(bar)[XB_TMO])) break; if (_sp > XB_SPIN_CAP) { atomicAdd(&(bar)[XB_TMO], 1u); break; } } } } while (0)
struct XcdBarrier { unsigned* bar; unsigned x; volatile LAS unsigned* st; };
__device__ __forceinline__ XcdBarrier xcd_barrier_post(unsigned* bar, volatile LAS unsigned* st) {
    XcdBarrier b; b.bar = bar; b.x = xb_xcc_id(); b.st = st;
    if (threadIdx.x == 0) (void)xb_add(&bar[XB_XCNT(b.x)], 1u);
    return b;
}
__device__ __forceinline__ void xcd_barrier_complete(unsigned* bar, unsigned x, unsigned& nloc, unsigned& nx) {
    const unsigned G = gridDim.x * gridDim.y * gridDim.z;
    unsigned sum, cnt, mine, sp = 0u;
    for (;;) {
        sum = 0u; cnt = 0u; mine = 0u;
#pragma unroll
        for (unsigned j = 0; j < 16; ++j) { const unsigned c = xb_ld(&bar[XB_XCNT(j)]); sum += c; cnt += (c > 0u) ? 1u : 0u; mine = (j == x) ? c : mine; }
        if (sum == G) break;
        __builtin_amdgcn_s_sleep(1);
        if ((++sp & 255u) == 0u) { if (xb_ld(&bar[XB_TMO])) break; if (sp > XB_SPIN_CAP) { atomicAdd(&bar[XB_TMO], 1u); break; } }
    }
    nloc = mine > 0u ? mine : 1u; nx = cnt > 0u ? cnt : 1u;
}
__device__ __forceinline__ void xcd_barrier(const XcdBarrier& b) {
    asm volatile("s_waitcnt vmcnt(0)" ::: "memory");
    __syncthreads();
    if (threadIdx.x == 0) {
        unsigned* bar = b.bar;
        __builtin_amdgcn_s_waitcnt(0);
        unsigned nloc = b.st[0], nx = b.st[1];
        if (nloc == 0u) { xcd_barrier_complete(bar, b.x, nloc, nx); b.st[0] = nloc; b.st[1] = nx; }
        const unsigned old = xb_add(&bar[XB_XSUB(b.x)], 1u);
        const unsigned gen = old / nloc;
        if (old + 1u == (gen + 1u) * nloc) {
            __builtin_amdgcn_fence(__ATOMIC_RELEASE, "agent");
            asm volatile("s_waitcnt vmcnt(0)" ::: "memory");
            const unsigned og = xb_add(&bar[XB_TOP], 1u);
            const unsigned tg = og / nx;
            if (og + 1u == (tg + 1u) * nx) xb_add(&bar[XB_TOPGEN], 1u);
            else XB_SPIN(xb_ld(&bar[XB_TOPGEN]) == tg, bar);
            __builtin_amdgcn_fence(__ATOMIC_ACQUIRE, "agent");
            xb_add(&bar[XB_XGEN(b.x)], 1u);
            asm volatile("s_waitcnt vmcnt(0)" ::: "memory");
        } else {
            XB_SPIN(xb_ld(&bar[XB_XGEN(b.x)]) == gen, bar);
            __builtin_amdgcn_fence(__ATOMIC_ACQUIRE, "agent");
            asm volatile("s_waitcnt vmcnt(0)" ::: "memory");
        }
    }
    __syncthreads();
}

#ifndef GEMM_SP2
#define GEMM_SP2 1
#endif
#ifndef GEMM_ALIGN
#define GEMM_ALIGN 1
#endif
constexpr int BM = 256, BK = 64, HALF = 128, HTB = HALF * BK * 2, STAGE_BYTES = 8 * HTB, NXCD = 8, WGM = 8;
__host__ __device__ __forceinline__ int lds_byte(int r, int c) { const int st = (r >> 4) * 2 + (c >> 5), rr = r & 15, cc = c & 31, ob = rr * 64 + cc * 2; return st * 1024 + (ob ^ (((ob >> 9) & 1) << 5)); }
__host__ __device__ __forceinline__ void stage_rc(int b, int& R, int& C) { const int st = b / 1024, sb = b % 1024, swz = sb ^ (((sb >> 9) & 1) << 5); R = (st >> 1) * 16 + swz / 64; C = (st & 1) * 32 + (swz % 64) / 2; }
__host__ __device__ __forceinline__ int perm32(int rho) { const int n = rho >> 4, i = rho & 15; return 8 * (i >> 2) + 4 * n + (i & 3); }

struct Unit { int pm, pn, kz, koff, nt; };
struct Gemm { const bf16_t* A; const bf16_t* Bt; int M, N, K, lda, nkz; size_t a_kz, b_kz; };

struct StaticOrder {
    int nM, nN, nwg, G, c, nkz;
    int ntk;
    __device__ void init(int M_, int N_, int G_, int c_, int nkz_ = 1, int K_ = 0) { nM = M_ / BM; nN = N_ / BM; nwg = nM * nN; G = G_; c = c_; nkz = nkz_; ntk = K_ / BK; }
    __device__ bool next(int i, Unit& u) const {
        const int it = i / nkz; u.kz = i - it * nkz; u.koff = 0; u.nt = ntk;
        const long L = (long)it * G + c; if (L >= nwg) return false;
        int wgid = (int)L; { const int q = nwg / NXCD, r = nwg % NXCD, xcd = wgid % NXCD, off = wgid / NXCD; wgid = (xcd < r ? xcd * (q + 1) : r * (q + 1) + (xcd - r) * q) + off; }
        const int nig = WGM * nN, gid = wgid / nig, fm = gid * WGM, gsz = (nM - fm) < WGM ? (nM - fm) : WGM;
        u.pm = fm + ((wgid % nig) % gsz); u.pn = (wgid % nig) / gsz; return true;
    }
};

struct SplitOrder {
    int c, ntk;
    __device__ void init(int c_, int K_) { c = c_; ntk = K_ / BK; }
    __device__ bool next(int i, Unit& u) const {
        const int xcd = c & 7, idx = c >> 3;
        if (i == 0) { u.pm = xcd * 4 + (idx >> 3); u.pn = idx & 7; u.kz = 0; u.koff = 0; u.nt = ntk; return true; }
        if (i == 1) { const int t = idx >> 1; u.pm = 32 + xcd * 2 + (t >> 3); u.pn = t & 7; u.kz = 0; u.nt = ntk >> 1; u.koff = (idx & 1) * (ntk >> 1) * BK; return true; }
        return false;
    }
};

template <class Epi, class Sched>
__device__ __forceinline__ void gemm_phase(LAS unsigned char* lds, const Gemm g, const Sched& S, const Epi& E) {
    int tid_ = threadIdx.x; asm volatile("" : "+v"(tid_));
    const int tid = tid_, wid = __builtin_amdgcn_readfirstlane(tid >> 6), lane = tid & 63, wr = wid >> 2, wc = wid & 3, fr = lane & 15, fq = lane >> 4;
    const int K = g.K;
    unsigned voffA[2], voffB[2];
#pragma unroll
    for (int i = 0; i < 2; ++i) { int R, C; stage_rc(tid * 16 + i * 8192, R, C); const int Rb = Epi::PERM ? ((R & ~31) + perm32(R & 31)) : R;
        voffA[i] = (unsigned)(R * g.lda + C) * 2u; voffB[i] = (unsigned)(Rb * K + C) * 2u; }
    const size_t kstep = (size_t)(BK * 2);
    const size_t hstepA = (size_t)HALF * g.lda * 2, hstepB = (size_t)HALF * K * 2;
    const size_t tstepA = 2 * hstepA, tstepB = 2 * hstepB;
    const unsigned ldsw = (unsigned)wid * 1024u;
    const int aoff = lds_byte(wr * 64 + fr, fq * 8), boff = lds_byte(wc * 32 + fr, fq * 8);
#define PG8_SA(b, h) (((b) * 2 + (h)) * HTB)
#define PG8_SB(b, h) ((4 + (b) * 2 + (h)) * HTB)
#define PG8_STAGE(bufoff, gbase, voff) do { _Pragma("unroll") for (int _i = 0; _i < 2; ++_i) \
        __builtin_amdgcn_global_load_lds((const unsigned*)((const char*)(gbase) + (voff)[_i]), (LAS unsigned*)(lds + (bufoff) + ldsw + _i * 8192), 16, 0, 0); } while (0)
#define PG8_LDA(dst, b, h) do { if constexpr (Epi::FP8) { _Pragma("unroll") for (int m = 0; m < 4; ++m) dst##8[m] = __builtin_shufflevector(*(const LAS v4i32*)(lds + PG8_SA(b, h) + aoff + m * 2048), *(const LAS v4i32*)(lds + PG8_SA(b, h) + aoff + m * 2048 + 1024), 0, 1, 2, 3, 4, 5, 6, 7); } \
        else { _Pragma("unroll") for (int m = 0; m < 4; ++m) _Pragma("unroll") for (int k = 0; k < 2; ++k) dst[m][k] = *(const LAS bf16x8*)(lds + PG8_SA(b, h) + aoff + m * 2048 + k * 1024); } } while (0)
#define PG8_LDB(dst, b, h) do { if constexpr (Epi::FP8) { _Pragma("unroll") for (int n = 0; n < 2; ++n) dst##8[n] = __builtin_shufflevector(*(const LAS v4i32*)(lds + PG8_SB(b, h) + boff + n * 2048), *(const LAS v4i32*)(lds + PG8_SB(b, h) + boff + n * 2048 + 1024), 0, 1, 2, 3, 4, 5, 6, 7); } \
        else { _Pragma("unroll") for (int n = 0; n < 2; ++n) _Pragma("unroll") for (int k = 0; k < 2; ++k) dst[n][k] = *(const LAS bf16x8*)(lds + PG8_SB(b, h) + boff + n * 2048 + k * 1024); } } while (0)
#define PG8_MMA_BF16(ai, bj, At, Bt) do { __builtin_amdgcn_s_setprio(1); _Pragma("unroll") for (int m = 0; m < 4; ++m) _Pragma("unroll") for (int n = 0; n < 2; ++n) _Pragma("unroll") for (int k = 0; k < 2; ++k) \
        acc[ai][bj][m][n] = __builtin_amdgcn_mfma_f32_16x16x32_bf16(Bt[n][k], At[m][k], acc[ai][bj][m][n], 0, 0, 0); __builtin_amdgcn_s_setprio(0); } while (0)
#define PG8_MMA_FP8(ai, bj, At, Bt) do { __builtin_amdgcn_s_setprio(1); _Pragma("unroll") for (int m = 0; m < 4; ++m) _Pragma("unroll") for (int n = 0; n < 2; ++n) \
        asm volatile("v_mfma_scale_f32_16x16x128_f8f6f4 %0, %1, %2, %0, %3, %3 op_sel_hi:[0,0,0]" : "+v"(acc[ai][bj][m][n]) : "v"(Bt##8[n]), "v"(At##8[m]), "v"(f8scale)); __builtin_amdgcn_s_setprio(0); } while (0)
#define PG8_F8_SETTLE() do { if constexpr (Epi::FP8) asm volatile("s_nop 15\n\ts_nop 15" ::: "memory"); } while (0)
#define PG8_MMA(ai, bj, At, Bt) do { if constexpr (Epi::FP8) PG8_MMA_FP8(ai, bj, At, Bt); else PG8_MMA_BF16(ai, bj, At, Bt); } while (0)
#if SAFE_GEMM == 1 || SAFE_GEMM == 3
#define PG8_WAIT_V(n) asm volatile("s_waitcnt vmcnt(0)" ::: "memory")
#else
#define PG8_WAIT_V(n) asm volatile("s_waitcnt vmcnt(" #n ")" ::: "memory")
#endif
#define PG8_WAIT_L(n) asm volatile("s_waitcnt lgkmcnt(" #n ")" ::: "memory")
#if SAFE_GEMM == 1
#define PG8_BAR do { asm volatile("s_waitcnt vmcnt(0) lgkmcnt(0)" ::: "memory"); __builtin_amdgcn_s_barrier(); asm volatile("" ::: "memory"); } while (0)
#elif SAFE_GEMM == 2
#define PG8_BAR asm volatile("s_barrier" ::: "memory")
#elif SAFE_GEMM == 4
#define PG8_BAR do { asm volatile("s_waitcnt lgkmcnt(0)" ::: "memory"); __builtin_amdgcn_s_barrier(); } while (0)
#else
#define PG8_BAR __builtin_amdgcn_s_barrier()
#endif
#define PG8_SCHED __builtin_amdgcn_sched_barrier(0)
    Unit cur, nxt; int ui = 0;
    if (!S.next(0, cur)) return;
    f32x4 acc[2][2][4][2];
#pragma unroll
    for (int a = 0; a < 2; ++a)
#pragma unroll
        for (int b = 0; b < 2; ++b)
#pragma unroll
            for (int m = 0; m < 4; ++m)
#pragma unroll
                for (int n = 0; n < 2; ++n) acc[a][b][m][n] = (f32x4){0.f, 0.f, 0.f, 0.f};
    bf16x8 At[4][2], B0[2][2], B1[2][2]; v8i32 At8[4], B08[2], B18[2];
    int f8scale = 0x7f7f7f7f; asm volatile("" : "+v"(f8scale));
    const char* cA = (const char*)(g.A + (size_t)cur.kz * g.a_kz + cur.koff) + (size_t)cur.pm * tstepA; const char* cB = (const char*)(g.Bt + (size_t)cur.kz * g.b_kz + cur.koff) + (size_t)cur.pn * tstepB;
#if GEMM_SP2
    PG8_STAGE(PG8_SB(0, 0), cB, voffB); PG8_STAGE(PG8_SB(0, 1), cB + hstepB, voffB); PG8_STAGE(PG8_SA(0, 0), cA, voffA); PG8_STAGE(PG8_SA(0, 1), cA + hstepA, voffA);
    if (wr == 1) PG8_BAR;
    PG8_WAIT_V(2); PG8_BAR;
    PG8_STAGE(PG8_SB(1, 0), cB + kstep, voffB); PG8_STAGE(PG8_SA(1, 0), cA + kstep, voffA); PG8_STAGE(PG8_SB(1, 1), cB + hstepB + kstep, voffB);
    PG8_WAIT_V(6); PG8_BAR;
#else
    PG8_STAGE(PG8_SB(0, 0), cB, voffB); PG8_STAGE(PG8_SA(0, 0), cA, voffA); PG8_STAGE(PG8_SB(0, 1), cB + hstepB, voffB); PG8_STAGE(PG8_SA(0, 1), cA + hstepA, voffA);
    if (wr == 1) PG8_BAR;
    PG8_WAIT_V(4); PG8_BAR;
    PG8_STAGE(PG8_SB(1, 0), cB + kstep, voffB); PG8_STAGE(PG8_SA(1, 0), cA + kstep, voffA); PG8_STAGE(PG8_SB(1, 1), cB + hstepB + kstep, voffB);
    PG8_WAIT_V(6); PG8_BAR;
#endif
    for (;;) {
        const bool has_next = S.next(ui + 1, nxt);
        const char* nA = has_next ? (const char*)(g.A + (size_t)nxt.kz * g.a_kz + nxt.koff) + (size_t)nxt.pm * tstepA : cA;
        const char* nB = has_next ? (const char*)(g.Bt + (size_t)nxt.kz * g.b_kz + nxt.koff) + (size_t)nxt.pn * tstepB : cB;
        const int nt = cur.nt;
        for (int t = 0; t < nt; t += 2) {
            const bool last = (t == nt - 2);
            const char* a1 = cA + (size_t)(t + 1) * kstep;
            const char* a2 = last ? nA : cA + (size_t)(t + 2) * kstep; const char* b2 = last ? nB : cB + (size_t)(t + 2) * kstep;
            const char* a3 = a2 + kstep; const char* b3 = b2 + kstep;
#if GEMM_SP2
            PG8_LDB(B0, 0, 0); PG8_LDB(B1, 0, 1); PG8_SCHED; PG8_LDA(At, 0, 0); PG8_STAGE(PG8_SA(1, 1), a1 + hstepA, voffA);
            PG8_WAIT_V(8); PG8_WAIT_L(0); PG8_BAR; PG8_MMA(0, 0, At, B0); PG8_MMA(0, 1, At, B1); PG8_BAR; PG8_SCHED;
            PG8_LDA(At, 0, 1); PG8_STAGE(PG8_SB(0, 0), b2, voffB); PG8_STAGE(PG8_SB(0, 1), b2 + hstepB, voffB); PG8_STAGE(PG8_SA(0, 0), a2, voffA);
            PG8_WAIT_V(8); PG8_WAIT_L(0); PG8_BAR; PG8_MMA(1, 0, At, B0); PG8_MMA(1, 1, At, B1); PG8_BAR; PG8_SCHED;
            PG8_LDB(B0, 1, 0); PG8_LDB(B1, 1, 1); PG8_SCHED; PG8_LDA(At, 1, 0); PG8_STAGE(PG8_SA(0, 1), a2 + hstepA, voffA);
            PG8_WAIT_V(8); PG8_WAIT_L(0); PG8_BAR; PG8_MMA(0, 0, At, B0); PG8_MMA(0, 1, At, B1); PG8_BAR; PG8_SCHED;
            PG8_LDA(At, 1, 1); PG8_STAGE(PG8_SB(1, 0), b3, voffB); PG8_STAGE(PG8_SB(1, 1), b3 + hstepB, voffB); PG8_STAGE(PG8_SA(1, 0), a3, voffA);
            PG8_WAIT_V(8); PG8_WAIT_L(0); PG8_BAR; PG8_MMA(1, 0, At, B0); PG8_MMA(1, 1, At, B1); PG8_BAR; PG8_SCHED;
#else
            PG8_LDB(B0, 0, 0); PG8_SCHED; PG8_LDA(At, 0, 0); PG8_STAGE(PG8_SA(1, 1), a1 + hstepA, voffA);
            PG8_WAIT_L(8); PG8_BAR; PG8_WAIT_L(0); PG8_MMA(0, 0, At, B0); PG8_BAR; PG8_SCHED;
            PG8_LDB(B1, 0, 1); PG8_STAGE(PG8_SB(0, 0), b2, voffB);
            PG8_BAR; PG8_WAIT_L(0); PG8_MMA(0, 1, At, B1); PG8_BAR;
            PG8_LDA(At, 0, 1); PG8_STAGE(PG8_SA(0, 0), a2, voffA);
            PG8_BAR; PG8_WAIT_L(0); PG8_MMA(1, 0, At, B0); PG8_BAR; PG8_SCHED;
            PG8_STAGE(PG8_SB(0, 1), b2 + hstepB, voffB);
            PG8_WAIT_V(6); PG8_BAR; PG8_MMA(1, 1, At, B1); PG8_BAR;
            PG8_LDB(B0, 1, 0); PG8_SCHED; PG8_LDA(At, 1, 0); PG8_STAGE(PG8_SA(0, 1), a2 + hstepA, voffA);
            PG8_WAIT_L(8); PG8_BAR; PG8_WAIT_L(0); PG8_MMA(0, 0, At, B0); PG8_BAR; PG8_SCHED;
            PG8_LDB(B1, 1, 1); PG8_STAGE(PG8_SB(1, 0), b3, voffB);
            PG8_BAR; PG8_WAIT_L(0); PG8_MMA(0, 1, At, B1); PG8_BAR;
            PG8_LDA(At, 1, 1); PG8_STAGE(PG8_SA(1, 0), a3, voffA);
            PG8_BAR; PG8_WAIT_L(0); PG8_MMA(1, 0, At, B0); PG8_BAR; PG8_SCHED;
            PG8_STAGE(PG8_SB(1, 1), b3 + hstepB, voffB);
            PG8_WAIT_V(6); PG8_BAR; PG8_MMA(1, 1, At, B1); PG8_BAR;
#endif
        }
        PG8_F8_SETTLE();
#if GEMM_ALIGN
        if (wr == 0) PG8_BAR;
#endif
        E(acc, cur, wr, wc, fr, fq);
        if (!has_next) break;
        if (nxt.kz == 0) {
#pragma unroll
        for (int a = 0; a < 2; ++a)
#pragma unroll
            for (int b = 0; b < 2; ++b)
#pragma unroll
                for (int m = 0; m < 4; ++m)
#pragma unroll
                    for (int n = 0; n < 2; ++n) acc[a][b][m][n] = (f32x4){0.f, 0.f, 0.f, 0.f};
        }
        cur = nxt; cA = nA; cB = nB; ++ui;
#if GEMM_ALIGN
        if (wr == 1) PG8_BAR;
#endif
    }
    PG8_WAIT_V(0);
#if !GEMM_ALIGN
    if (wr == 0) PG8_BAR;
#endif
    PG8_BAR;
#undef PG8_SA
#undef PG8_SB
#undef PG8_STAGE
#undef PG8_LDA
#undef PG8_LDB
#undef PG8_MMA
#undef PG8_MMA_BF16
#undef PG8_MMA_FP8
#undef PG8_F8_SETTLE
#undef PG8_WAIT_V
#undef PG8_WAIT_L
#undef PG8_BAR
#undef PG8_SCHED
}
}
namespace mk {
constexpr size_t O_YP = 0, O_YS = 8388608, O_NK = 25165824, O_NV = 33554432, O_S5R = 41943040, O_S5I = 42205184, O_SSD = 42467328,
                 O_MLC = 50855936, O_MLN = 59244544, O_MLM = 59310080;

__device__ __forceinline__ u32x4 pack8(const f32x4 a, const f32x4 b) { u32x4 w; w.x = pk2(a[0], a[1]); w.y = pk2(a[2], a[3]); w.z = pk2(b[0], b[1]); w.w = pk2(b[2], b[3]); return w; }

template <bool F8> struct EpiInT {
    static constexpr bool PERM = true, FP8 = F8;
    bf16_t* proj; float* small; float* out; const float* qg; const float* kg; int layer;
    __device__ __forceinline__ void operator()(f32x4 (&acc)[2][2][4][2], const Unit& u, int wr, int wc, int fr, int fq) const {
        const int T = F8 ? 22 + u.pn : (u.pn == 22 ? 54 : u.pn), rowb = u.pm * BM + wr * 64 + fr;
        if (T == 54) {
            if (wc == 0) {
#pragma unroll
                for (int ai = 0; ai < 2; ++ai)
#pragma unroll
                    for (int m = 0; m < 4; ++m) { float* sp = small + (size_t)(rowb + ai * HALF + m * 16) * 32 + 8 * fq; *(f32x4*)sp = acc[ai][0][m][0]; *(f32x4*)(sp + 4) = acc[ai][0][m][1]; }
            }
            return;
        }
        const int colb = T * 256 + 64 * wc + 8 * fq;
        if (T < 4) {
            const float* g = T < 2 ? qg : kg;
            f32x4 gv[2][2];
#pragma unroll
            for (int bj = 0; bj < 2; ++bj)
#pragma unroll
                for (int n = 0; n < 2; ++n) gv[bj][n] = *(const f32x4*)(g + 32 * bj + 8 * fq + 4 * n);
#pragma unroll
            for (int ai = 0; ai < 2; ++ai)
#pragma unroll
                for (int m = 0; m < 4; ++m) {
                    float ss = 0.f;
#pragma unroll
                    for (int bj = 0; bj < 2; ++bj)
#pragma unroll
                        for (int n = 0; n < 2; ++n) { const f32x4 x = acc[ai][bj][m][n]; ss += (x[0] * x[0] + x[1] * x[1]) + (x[2] * x[2] + x[3] * x[3]); }
                    ss += __shfl_xor(ss, 16); ss += __shfl_xor(ss, 32);
                    const float r = rsqrtf(ss * (1.f / 64.f) + 1e-6f);
                    const int row = rowb + ai * HALF + m * 16;
#pragma unroll
                    for (int bj = 0; bj < 2; ++bj) { const f32x4 v0 = acc[ai][bj][m][0] * r * gv[bj][0], v1 = acc[ai][bj][m][1] * r * gv[bj][1];
                        *(u32x4*)(proj + (size_t)row * PJ + colb + 32 * bj) = pack8(v0, v1);
                        if (T >= 2 && row < MP) { float* o = out + O_NK + ((size_t)((row >> 8) * DEPTH + layer) * 256 + (row & 255)) * 512 + (colb - 512) + 32 * bj; *(f32x4*)o = v0; *(f32x4*)(o + 4) = v1; } }
                }
        } else if (T < 6) {
#pragma unroll
            for (int ai = 0; ai < 2; ++ai)
#pragma unroll
                for (int m = 0; m < 4; ++m) { const int row = rowb + ai * HALF + m * 16;
#pragma unroll
                    for (int bj = 0; bj < 2; ++bj) { const f32x4 v0 = acc[ai][bj][m][0], v1 = acc[ai][bj][m][1];
                        *(u32x4*)(proj + (size_t)row * PJ + colb + 32 * bj) = pack8(v0, v1);
                        if (row < MP) { float* o = out + O_NV + ((size_t)((row >> 8) * DEPTH + layer) * 256 + (row & 255)) * 512 + (colb - 1024) + 32 * bj; *(f32x4*)o = v0; *(f32x4*)(o + 4) = v1; } } }
        } else if (T < 22) {
#pragma unroll
            for (int ai = 0; ai < 2; ++ai)
#pragma unroll
                for (int m = 0; m < 4; ++m) { const int row = rowb + ai * HALF + m * 16;
#pragma unroll
                    for (int bj = 0; bj < 2; ++bj) *(u32x4*)(proj + (size_t)row * PJ + colb + 32 * bj) = pack8(acc[ai][bj][m][0], acc[ai][bj][m][1]); }
        } else {
#pragma unroll
            for (int ai = 0; ai < 2; ++ai)
#pragma unroll
                for (int m = 0; m < 4; ++m) { const int row = rowb + ai * HALF + m * 16;
#pragma unroll
                    for (int bj = 0; bj < 2; ++bj) { f32x4 v0 = acc[ai][bj][m][0], v1 = acc[ai][bj][m][1];
#pragma unroll
                        for (int j = 0; j < 4; ++j) { v0[j] = fsigm(v0[j]); v1[j] = fsigm(v1[j]); }
                        *(u32x4*)(proj + (size_t)row * PJ + colb + 32 * bj) = pack8(v0, v1); } }
        }
    }
};
struct EpiRelu2 {
    static constexpr bool PERM = true, FP8 = false;
    bf16_t* O; int ldo;
    __device__ __forceinline__ void operator()(f32x4 (&acc)[2][2][4][2], const Unit& u, int wr, int wc, int fr, int fq) const {
        const int rowb = u.pm * BM + wr * 64 + fr, colb = u.pn * 256 + 64 * wc + 8 * fq;
#pragma unroll
        for (int ai = 0; ai < 2; ++ai)
#pragma unroll
            for (int m = 0; m < 4; ++m) { const int row = rowb + ai * HALF + m * 16;
#pragma unroll
                for (int bj = 0; bj < 2; ++bj) { f32x4 v0 = acc[ai][bj][m][0], v1 = acc[ai][bj][m][1];
#pragma unroll
                    for (int j = 0; j < 4; ++j) { const float a = fmaxf(v0[j], 0.f), b = fmaxf(v1[j], 0.f); v0[j] = a * a; v1[j] = b * b; }
                    *(u32x4*)(O + (size_t)row * ldo + colb + 32 * bj) = pack8(v0, v1); } }
    }
};
struct EpiGlu {
    static constexpr bool PERM = true, FP8 = false;
    const bf16_t* Z; const float* bias; bf16_t* br;
    __device__ __forceinline__ void operator()(f32x4 (&acc)[2][2][4][2], const Unit& u, int wr, int wc, int fr, int fq) const {
        const int rowb = u.pm * BM + wr * 64 + fr, colb = u.pn * 256 + 64 * wc + 8 * fq;
#pragma unroll
        for (int bj = 0; bj < 2; ++bj) { const int c = colb + 32 * bj; const f32x4 b0 = *(const f32x4*)(bias + c), b1 = *(const f32x4*)(bias + c + 4);
#pragma unroll
            for (int ai = 0; ai < 2; ++ai)
#pragma unroll
                for (int m = 0; m < 4; ++m) { const int row = rowb + ai * HALF + m * 16;
                    const u32x4 zz = *(const u32x4*)(Z + (size_t)row * 512 + c);
                    f32x4 v0 = acc[ai][bj][m][0] + b0, v1 = acc[ai][bj][m][1] + b1;
                    v0[0] = bflo(zz.x) * fsigm(v0[0]); v0[1] = bfhi(zz.x) * fsigm(v0[1]); v0[2] = bflo(zz.y) * fsigm(v0[2]); v0[3] = bfhi(zz.y) * fsigm(v0[3]);
                    v1[0] = bflo(zz.z) * fsigm(v1[0]); v1[1] = bfhi(zz.z) * fsigm(v1[1]); v1[2] = bflo(zz.w) * fsigm(v1[2]); v1[3] = bfhi(zz.w) * fsigm(v1[3]);
                    *(u32x4*)(br + (size_t)row * D + 512 + c) = pack8(v0, v1); } }
    }
};
struct EpiBranch {
    static constexpr bool PERM = true, FP8 = false;
    const bf16_t* proj; bf16_t* merged;
    __device__ __forceinline__ void operator()(f32x4 (&acc)[2][2][4][2], const Unit& u, int wr, int wc, int fr, int fq) const {
        const int rowb = u.pm * BM + wr * 64 + fr, colb = u.pn * 256 + 64 * wc + 8 * fq, kz = u.kz;
#pragma unroll
        for (int ai = 0; ai < 2; ++ai)
#pragma unroll
            for (int m = 0; m < 4; ++m) { const int row = rowb + ai * HALF + m * 16;
#pragma unroll
                for (int bj = 0; bj < 2; ++bj) { const int c = colb + 32 * bj;
                    const u32x4 gg = *(const u32x4*)(proj + (size_t)row * PJ + P_GATE + kz * D + c);
                    float g[8] = {bflo(gg.x), bfhi(gg.x), bflo(gg.y), bfhi(gg.y), bflo(gg.z), bfhi(gg.z), bflo(gg.w), bfhi(gg.w)};
                    if (kz < 3) { const u32x4 hh = *(const u32x4*)(proj + (size_t)row * PJ + P_GATE + (kz + 1) * D + c);
                        const float h[8] = {bflo(hh.x), bfhi(hh.x), bflo(hh.y), bfhi(hh.y), bflo(hh.z), bfhi(hh.z), bflo(hh.w), bfhi(hh.w)};
#pragma unroll
                        for (int j = 0; j < 8; ++j) g[j] = g[j] * __builtin_amdgcn_rcpf(fmaxf(h[j], 1e-30f)); }
                    f32x4& v0 = acc[ai][bj][m][0]; f32x4& v1 = acc[ai][bj][m][1];
                    v0[0] *= g[0]; v0[1] *= g[1]; v0[2] *= g[2]; v0[3] *= g[3]; v1[0] *= g[4]; v1[1] *= g[5]; v1[2] *= g[6]; v1[3] *= g[7];
                    if (kz == 3) *(u32x4*)(merged + (size_t)row * D + c) = pack8(v0, v1); } }
    }
};
struct EpiResid {
    static constexpr bool PERM = false, FP8 = false;
    const float* xp; const float* xs; const float* modl; int g_off; float* xout; float* part;
    __device__ __forceinline__ void operator()(f32x4 (&acc)[2][2][4][2], const Unit& u, int wr, int wc, int fr, int fq) const {
        if (part != nullptr && u.pm >= 32) {
            float* P = part + (size_t)((((u.pm - 32) * 8 + u.pn) * 2) + (u.koff != 0)) * 65536 + (size_t)(wr * 64 + fr) * 256 + wc * 32 + 4 * fq;
#pragma unroll
            for (int ai = 0; ai < 2; ++ai)
#pragma unroll
                for (int m = 0; m < 4; ++m)
#pragma unroll
                    for (int bj = 0; bj < 2; ++bj)
#pragma unroll
                        for (int n = 0; n < 2; ++n) *(f32x4*)(P + (size_t)(ai * HALF + m * 16) * 256 + bj * HALF + n * 16) = acc[ai][bj][m][n];
            return;
        }
        const int row0 = u.pm * BM, rowb = row0 + wr * 64 + fr, colb = u.pn * 256 + wc * 32 + 4 * fq;
        const float* xin = row0 < MP ? xp : xs - (size_t)MP * D;
        const float* gate = modl + (size_t)row_cvec(row0) * 6 * D + g_off;
        f32x4 gv[2][2];
#pragma unroll
        for (int bj = 0; bj < 2; ++bj)
#pragma unroll
            for (int n = 0; n < 2; ++n) gv[bj][n] = *(const f32x4*)(gate + colb + bj * HALF + n * 16);
#pragma unroll
        for (int ai = 0; ai < 2; ++ai)
#pragma unroll
            for (int m = 0; m < 4; ++m) { const size_t ro = (size_t)(rowb + ai * HALF + m * 16) * D + colb;
#pragma unroll
                for (int bj = 0; bj < 2; ++bj)
#pragma unroll
                    for (int n = 0; n < 2; ++n) { const size_t o = ro + bj * HALF + n * 16; *(f32x4*)(xout + o) = *(const f32x4*)(xin + o) + gv[bj][n] * acc[ai][bj][m][n]; } }
    }
};
}
namespace mk {
constexpr size_t AL(size_t x) { return (x + 255) & ~(size_t)255; }
constexpr size_t WS_CTL = 0, CTL_BYTES = 65536;
constexpr size_t WS_MOD = WS_CTL + CTL_BYTES;
constexpr size_t WS_W = AL(WS_MOD + (size_t)DEPTH * 5 * 6 * D * 4);
constexpr size_t W_IN = 0, W_GLU = W_IN + (size_t)NIN * D, W_BR = W_GLU + 512 * 512, W_OUT = W_BR + (size_t)4 * D * 512, W_1 = W_OUT + (size_t)D * D, W_2 = W_1 + (size_t)DFF * D,
                 W_LAYER = W_2 + (size_t)D * DFF;
constexpr size_t W_IN8 = (size_t)5888 * D;
constexpr size_t WS_H = AL(WS_W + W_LAYER * 2 * DEPTH);
constexpr size_t WS_PROJ = AL(WS_H + (size_t)M * D * 2);
constexpr size_t WS_SMALL = AL(WS_PROJ + (size_t)M * PJ * 2);
constexpr size_t WS_BR = AL(WS_SMALL + (size_t)M * 32 * 4);
constexpr size_t WS_MERGED = AL(WS_BR + (size_t)M * D * 2);
constexpr size_t WS_MACC = AL(WS_MERGED + (size_t)M * D * 2);
constexpr size_t WS_ZB = AL(WS_MACC + (size_t)M * D * 4);
constexpr size_t WS_H8 = AL(WS_ZB + (size_t)M * 512 * 2);
constexpr size_t WS_SCR = AL(WS_H8 + (size_t)M * D);
constexpr int LDS_BYTES = 140 * 1024, LDS_CTL = LDS_BYTES - 256;

struct Args { const float* in[43]; float* out; unsigned char* ws; int ph_lo, ph_hi; };

__device__ __forceinline__ float wave_sum(float v) {
#pragma unroll
    for (int o = 1; o < 64; o <<= 1) v += __shfl_xor(v, o);
    return v;
}
#define LDS_WAIT() asm volatile("s_waitcnt lgkmcnt(0)" ::: "memory")

__device__ __forceinline__ void xpose_item(const float* W, int ldw, int k0, int sc, bf16_t* dst, int K, LAS float* scr, int lane, int mode, bool f8 = false) {
    const int n4 = (lane & 7) * 4;
    const int col = mode == 1 ? (n4 < 16 ? 3584 + n4 : 5648 + (n4 - 16)) : sc + n4;
#pragma unroll
    for (int i = 0; i < 8; ++i) { const int kk = (lane >> 3) + 8 * i; f32x4 v = (f32x4){0.f, 0.f, 0.f, 0.f}; if (mode != 2) v = *(const f32x4*)(W + (size_t)(k0 + kk) * ldw + col);
        scr[kk * 33 + n4] = v[0]; scr[kk * 33 + n4 + 1] = v[1]; scr[kk * 33 + n4 + 2] = v[2]; scr[kk * 33 + n4 + 3] = v[3]; }
    LDS_WAIT(); asm volatile("" ::: "memory");
    const int c = lane & 7;
#pragma unroll
    for (int jj = 0; jj < 4; ++jj) { const int n = (lane >> 3) + 8 * jj; const LAS float* s = scr + (8 * c) * 33 + n;
        if (f8) { unsigned w0 = 0u, w1 = 0u; w0 = __builtin_amdgcn_cvt_pk_fp8_f32(s[0 * 33], s[1 * 33], w0, false); w0 = __builtin_amdgcn_cvt_pk_fp8_f32(s[2 * 33], s[3 * 33], w0, true);
            w1 = __builtin_amdgcn_cvt_pk_fp8_f32(s[4 * 33], s[5 * 33], w1, false); w1 = __builtin_amdgcn_cvt_pk_fp8_f32(s[6 * 33], s[7 * 33], w1, true);
            u32x2 o8; o8.x = w0; o8.y = w1; *(u32x2*)((unsigned char*)dst + (size_t)n * K + k0 + 8 * c) = o8; }
        else { u32x4 o; o.x = pk2(s[0 * 33], s[1 * 33]); o.y = pk2(s[2 * 33], s[3 * 33]); o.z = pk2(s[4 * 33], s[5 * 33]); o.w = pk2(s[6 * 33], s[7 * 33]);
            *(u32x4*)(dst + (size_t)n * K + k0 + 8 * c) = o; } }
    LDS_WAIT(); asm volatile("" ::: "memory");
}
__device__ __forceinline__ int hm_col(int grp) { const int T = grp >> 3, q8 = grp & 7; return 256 * T + 32 * (2 * (q8 & 3) + (q8 >> 2)); }

__device__ __forceinline__ void prologue_convert(const Args& a, LAS unsigned char* lds, int it0, int it1, int wave, int lane) {
    LAS float* scr = (LAS float*)(lds + wave * 8704);
    bf16_t* WB = (bf16_t*)(a.ws + WS_W);
    constexpr int I_IN = 440 * 32, I_GLU = 16 * 8, I_BR = 4 * 64 * 8, I_OUT = 64 * 32, I_1 = 256 * 32, I_2 = 64 * 128, I_L = I_IN + I_GLU + I_BR + I_OUT + I_1 + I_2;
    for (int it = it0; it < it1; ++it) {
        const int l = it / I_L; int r = it - l * I_L; bf16_t* wl = WB + (size_t)l * W_LAYER;
        if (r < I_IN) { const int kb = r / 440, grp = r % 440, T = grp >> 3; int sc = hm_col(grp), mode = 0;
            if (T == 54) mode = (grp & 7) == 0 ? 1 : 2; else if (T >= 22) sc += 32; else if (T >= 14) sc += 16;
            if (T >= 22 && T < 54) xpose_item(a.in[16] + (size_t)l * D * 13856, 13856, 64 * kb, sc, (bf16_t*)((unsigned char*)(wl + W_IN8) + (size_t)(32 * (grp - 176)) * D), D, scr, lane, mode, true);
            else xpose_item(a.in[16] + (size_t)l * D * 13856, 13856, 64 * kb, sc, wl + W_IN + (size_t)(32 * (T == 54 ? grp - 256 : grp)) * D, D, scr, lane, mode);
            continue; } r -= I_IN;
        if (r < I_GLU) { const int kb = r / 16, grp = r % 16; xpose_item(a.in[28] + (size_t)l * 512 * 512, 512, 64 * kb, hm_col(grp), wl + W_GLU + (size_t)(32 * grp) * 512, 512, scr, lane, 0); continue; } r -= I_GLU;
        if (r < I_BR) { const int k = r / 512, r2 = r % 512, kb = r2 / 64, grp = r2 % 64;
            xpose_item(a.in[39] + ((size_t)l * 4 + k) * 512 * D, D, 64 * kb, hm_col(grp), wl + W_BR + (size_t)k * D * 512 + (size_t)(32 * grp) * 512, 512, scr, lane, 0); continue; } r -= I_BR;
        if (r < I_OUT) { const int kb = r / 64, grp = r % 64; xpose_item(a.in[40] + (size_t)l * D * D, D, 64 * kb, 32 * grp, wl + W_OUT + (size_t)(32 * grp) * D, D, scr, lane, 0); continue; } r -= I_OUT;
        if (r < I_1) { const int kb = r / 256, grp = r % 256; xpose_item(a.in[41] + (size_t)l * D * DFF, DFF, 64 * kb, hm_col(grp), wl + W_1 + (size_t)(32 * grp) * D, D, scr, lane, 0); continue; } r -= I_1;
        { const int kb = r / 64, grp = r % 64; xpose_item(a.in[42] + (size_t)l * DFF * D, D, 64 * kb, 32 * grp, wl + W_2 + (size_t)(32 * grp) * DFF, DFF, scr, lane, 0); }
    }
}
__device__ __forceinline__ void prologue_ada_unit(const Args& a, LAS unsigned char* lds, int tid, int unit) {
    LAS float* sl = (LAS float*)lds;
    LAS float* red = (LAS float*)(lds + 40960);
    float* mod = (float*)(a.ws + WS_MOD);
    for (int i = tid; i < 5 * D; i += NT) { const int j = i / D, k = i % D; const float x = j == 0 ? a.in[11][k] : a.in[10][(j - 1) * D + k]; sl[i] = x / (1.f + __expf(-x)); }
    __syncthreads();
    const int ks = tid >> 6, c = tid & 63;
    const int l = unit / (6 * D / 64), n0 = (unit % (6 * D / 64)) * 64;
    const float* w = a.in[12] + (size_t)l * D * 6 * D + n0 + c;
    float acc[5] = {0.f, 0.f, 0.f, 0.f, 0.f};
#pragma unroll 8
    for (int k = ks * 256; k < ks * 256 + 256; ++k) { const float wv = w[(size_t)k * 6 * D];
#pragma unroll
        for (int j = 0; j < 5; ++j) acc[j] += sl[j * D + k] * wv; }
#pragma unroll
    for (int j = 0; j < 5; ++j) red[(ks * 5 + j) * 64 + c] = acc[j];
    __syncthreads();
    if (tid < 320) { const int j = tid >> 6; float s = 0.f;
#pragma unroll
        for (int q = 0; q < 8; ++q) s += red[(q * 5 + j) * 64 + c];
        mod[((size_t)l * 5 + j) * 6 * D + n0 + c] = s + a.in[13][l * 6 * D + n0 + c]; }
}
constexpr int PRO_CONV_L = 440 * 32 + 16 * 8 + 4 * 64 * 8 + 64 * 32 + 256 * 32 + 64 * 128;
constexpr int PRO_NCONV = (PRO_CONV_L + 63) / 64,
              PRO_NADA = DEPTH * 6 * D / 64, PRO_NCACHE = 64;
__device__ __forceinline__ void norm_phase(const float* xp, const float* xs, const float* g, const float* modl, int sh_off, int sc_off, bf16_t* H, int gw, int ngw, int lane_,
                                           const float* pend, const float* pmodl, int pg_off, float* xw, const float* xs_pend, unsigned char* H8 = nullptr) {
    int lane = lane_; asm volatile("" : "+v"(lane));
    for (int row = gw; row < M; row += ngw) {
        const float* x = row < MP ? xp + (size_t)row * D : xs + (size_t)(row - MP) * D;
        if (pend != nullptr && row >= 8192) x = xs_pend + (size_t)(row - MP) * D;
        f32x4 v[8]; float ss = 0.f;
#pragma unroll
        for (int j = 0; j < 8; ++j) v[j] = *(const f32x4*)(x + 4 * (lane + 64 * j));
        if (pend != nullptr && row >= 8192) {
            const float* pg = pmodl + (size_t)row_cvec(row) * 6 * D + pg_off; const int pm = row >> 8, r = row & 255;
#pragma unroll
            for (int j = 0; j < 8; ++j) { const int col = 4 * (lane + 64 * j), pn = col >> 8, cc = col & 255;
                const float* P = pend + (size_t)(((pm - 32) * 8 + pn) * 2) * 65536 + (size_t)r * 256 + cc;
                const f32x4 pa = *(const f32x4*)P, pb = *(const f32x4*)(P + 65536), gg = *(const f32x4*)(pg + col);
                v[j] = v[j] + gg * (pa + pb); *(f32x4*)(xw + (size_t)row * D + col) = v[j]; }
        }
#pragma unroll
        for (int j = 0; j < 8; ++j) ss += (v[j][0] * v[j][0] + v[j][1] * v[j][1]) + (v[j][2] * v[j][2] + v[j][3] * v[j][3]);
        const float r = rsqrtf(wave_sum(ss) * (1.f / D) + 1e-6f);
        const float* md = modl + (size_t)row_cvec(row) * 6 * D;
#pragma unroll
        for (int j = 0; j < 8; ++j) { const int i = 4 * (lane + 64 * j);
            const f32x4 gg = *(const f32x4*)(g + i), sc = *(const f32x4*)(md + sc_off + i), sh = *(const f32x4*)(md + sh_off + i);
            const f32x4 o = v[j] * r * gg * (sc + 1.f) + sh;
            u32x2 w; w.x = pk2(o[0], o[1]); w.y = pk2(o[2], o[3]); *(u32x2*)(H + (size_t)row * D + i) = w;
            if (H8 != nullptr) { unsigned w8 = 0u; w8 = __builtin_amdgcn_cvt_pk_fp8_f32(o[0], o[1], w8, false); w8 = __builtin_amdgcn_cvt_pk_fp8_f32(o[2], o[3], w8, true); *(unsigned*)(H8 + (size_t)row * D + i) = w8; } }
    }
}
__device__ __forceinline__ void final_fix_phase(const float* pend, const float* pmodl, int pg_off, float* X, int gw, int ngw, int lane_) {
    int lane = lane_; asm volatile("" : "+v"(lane));
    for (int row = 8192 + gw; row < M; row += ngw) {
        const float* pg = pmodl + (size_t)row_cvec(row) * 6 * D + pg_off; const int pm = row >> 8, r = row & 255;
#pragma unroll
        for (int j = 0; j < 8; ++j) { const int col = 4 * (lane + 64 * j), pn = col >> 8, cc = col & 255;
            const float* P = pend + (size_t)(((pm - 32) * 8 + pn) * 2) * 65536 + (size_t)r * 256 + cc;
            const f32x4 pa = *(const f32x4*)P, pb = *(const f32x4*)(P + 65536), gg = *(const f32x4*)(pg + col);
            float* xo = X + (size_t)row * D + col; *(f32x4*)xo = *(const f32x4*)xo + gg * (pa + pb); }
    }
}
__device__ __forceinline__ void conv_pull(const Args& a, LAS unsigned char* lds, volatile LAS unsigned* qitem, int layer, int maxb) {
    unsigned* qhead = (unsigned*)(a.ws + WS_CTL) + 8200 + layer;
    for (int n = 0; maxb < 0 || n < maxb; ++n) {
        __syncthreads();
        if (threadIdx.x == 0) qitem[0] = __hip_atomic_fetch_add(qhead, 1u, __ATOMIC_RELAXED, __HIP_MEMORY_SCOPE_AGENT);
        __syncthreads();
        const int item = (int)qitem[0];
        if (item >= PRO_NCONV) break;
        const int wave = __builtin_amdgcn_readfirstlane((int)(threadIdx.x >> 6));
        const int w0 = layer * PRO_CONV_L + item * 64 + wave * 8, wend = (layer + 1) * PRO_CONV_L;
        int lane = (int)(threadIdx.x & 63); asm volatile("" : "+v"(lane));
        prologue_convert(a, lds, w0, w0 + 8 < wend ? w0 + 8 : wend, wave, lane);
    }
    __syncthreads();
}
}
namespace mk {
constexpr size_t WS_NAT = AL(WS_SCR);
constexpr int NATP = 2048, N_XBC = 0, N_Q = 1024, N_K = 1536;
constexpr size_t WS_TR = AL(WS_NAT + (size_t)M * NATP * 2);
constexpr int T_X = 0, T_B = 512, T_K = 768, T_MV = 1280, T_V = 1792, TRR = 2304;
constexpr int NCH = 96;
constexpr size_t WS_MLC = AL(WS_TR + (size_t)TRR * M * 2);
constexpr size_t WS_MLN = AL(WS_MLC + (size_t)NCH * 4 * 2 * 16384 * 4);
constexpr size_t WS_MLS = AL(WS_MLN + (size_t)NCH * 4 * 2 * 128 * 4);
constexpr size_t WS_MLCS = AL(WS_MLS + (size_t)NCH * 4 * 2 * 4 * 4);
constexpr size_t WS_MLNS = AL(WS_MLCS + (size_t)NCH * 4 * 2 * 16384 * 2);
constexpr size_t WS_MLMS = AL(WS_MLNS + (size_t)NCH * 4 * 2 * 128 * 4);
constexpr size_t WS_OPT_END = AL(WS_MLMS + (size_t)NCH * 4 * 2 * 4);

__device__ __forceinline__ f32x4 mfma16(bf16x8 a, bf16x8 b, f32x4 c) { return __builtin_amdgcn_mfma_f32_16x16x32_bf16(a, b, c, 0, 0, 0); }
__device__ __forceinline__ void chunk_info(int ch, int& row0, int& seq0, int& L, int& lat, int& b, int& ci, int& nc) {
    if (ch < 32) { b = ch >> 1; ci = ch & 1; nc = 2; seq0 = b * 256; L = 256; lat = 0; } else { const int c2 = ch - 32; b = c2 >> 4; ci = c2 & 15; nc = 16; seq0 = MP + b * 2048; L = 2048; lat = 1; }
    row0 = seq0 + ci * 128;
}
__device__ __forceinline__ float fast_exp(float x) { return __expf(x); }

__device__ __forceinline__ void prep_phase(const Args& a, int layer, LAS unsigned char* lds, int gw_, int ngw, int wave, int lane_, bf16_t* UPk) {
    int lane = lane_, gw = gw_; asm volatile("" : "+v"(lane));
    const bf16_t* PROJ = (const bf16_t*)(a.ws + WS_PROJ); bf16_t* NAT = (bf16_t*)(a.ws + WS_NAT); bf16_t* TR = (bf16_t*)(a.ws + WS_TR);
    LAS bf16_t* tile = (LAS bf16_t*)(lds + wave * 16896); LAS bf16_t* otile = tile + 68 * 64;
    const int c = lane & 7, r8 = lane >> 3;
    const float* cw = a.in[30] + layer * 5 * 1024; const float* cb = a.in[31] + layer * 1024;
    for (int u = gw; u < 56 * 192; u += ngw) {
        const int cg = u / 192, tt = u % 192, m0 = tt * 64;
        const int lat = m0 >= MP; const int seq0 = lat ? MP + ((m0 - MP) / 2048) * 2048 : (m0 / 256) * 256, L = lat ? 2048 : 256, t0 = m0 - seq0;
        int kind, src, natcol = -1, trrow = -1;
        if (cg < 16) { kind = 0; src = P_XBC + 64 * cg; natcol = N_XBC + 64 * cg; if (cg < 12) trrow = T_X + 64 * cg; }
        else if (cg < 24) { kind = 1; src = P_MQ + 64 * (cg - 16); natcol = N_Q + 64 * (cg - 16); }
        else if (cg < 32) { kind = 2; src = P_MK + 64 * (cg - 24); natcol = N_K + 64 * (cg - 24); trrow = T_K + 64 * (cg - 24); }
        else if (cg < 40) { kind = 3; src = P_MV + 64 * (cg - 32); trrow = T_MV + 64 * (cg - 32); }
        else if (cg < 48) { kind = 3; src = P_V + 64 * (cg - 40); trrow = T_V + 64 * (cg - 40); }
        else { kind = 4; src = P_S5U + 64 * (cg - 48); }
        const int roff = kind == 0 ? -2 : 0, nrows = kind == 0 ? 68 : 64;
#pragma unroll
        for (int i = 0; i < 9; ++i) { const int r = r8 + 8 * i; if (r < nrows) { const int t = t0 + r + roff; u32x4 v = {0u, 0u, 0u, 0u};
                if (t >= 0 && t < L) v = *(const u32x4*)(PROJ + (size_t)(seq0 + t) * PJ + src + 8 * c);
                *(LAS u32x4*)(tile + r * 64 + 8 * c) = v; } }
        LDS_WAIT(); asm volatile("" ::: "memory");
#define PREP_EMIT(i_, r_) do { if (natcol >= 0) *(u32x4*)(NAT + (size_t)(m0 + r8 + 8 * (i_)) * NATP + natcol + 8 * c) = (r_); if (trrow >= 0) *(LAS u32x4*)(otile + (r8 + 8 * (i_)) * 64 + 8 * c) = (r_); } while (0)
        if (kind == 0) {
            float w[5][8], bz[8];
#pragma unroll
            for (int e = 0; e < 8; ++e) { bz[e] = cb[64 * cg + 8 * c + e];
#pragma unroll
                for (int j = 0; j < 5; ++j) w[j][e] = cw[j * 1024 + 64 * cg + 8 * c + e]; }
#pragma unroll 2
            for (int i = 0; i < 8; ++i) { const int tk = r8 + 8 * i; float acc[8];
#pragma unroll
                for (int e = 0; e < 8; ++e) acc[e] = bz[e];
#pragma unroll
                for (int j = 0; j < 5; ++j) { const u32x4 v = *(const LAS u32x4*)(tile + (tk + j) * 64 + 8 * c);
                    acc[0] += bflo(v.x) * w[j][0]; acc[1] += bfhi(v.x) * w[j][1]; acc[2] += bflo(v.y) * w[j][2]; acc[3] += bfhi(v.y) * w[j][3];
                    acc[4] += bflo(v.z) * w[j][4]; acc[5] += bfhi(v.z) * w[j][5]; acc[6] += bflo(v.w) * w[j][6]; acc[7] += bfhi(v.w) * w[j][7]; }
#pragma unroll
                for (int e = 0; e < 8; ++e) acc[e] = fsilu(acc[e]);
                u32x4 rv; rv.x = pk2(acc[0], acc[1]); rv.y = pk2(acc[2], acc[3]); rv.z = pk2(acc[4], acc[5]); rv.w = pk2(acc[6], acc[7]); PREP_EMIT(i, rv); }
        } else if (kind == 4) {
#pragma unroll
            for (int i = 0; i < 8; ++i) { const int tk = r8 + 8 * i, m = m0 + tk; const u32x4 v = *(const LAS u32x4*)(tile + tk * 64 + 8 * c);
                *(u32x4*)(UPk + ((size_t)(4 * (cg - 48) + (c >> 1)) * 384 + (m >> 5)) * 512 + (m & 31) * 16 + 8 * (c & 1)) = v; }
        } else if (kind == 3 || !lat) {
            const float sc = kind == 2 ? 0.08838834764831845f : 1.f;
#pragma unroll
            for (int i = 0; i < 8; ++i) { const u32x4 v = *(const LAS u32x4*)(tile + (r8 + 8 * i) * 64 + 8 * c);
                u32x4 rv = v;
                if (kind == 2) { rv.x = pk2(bflo(v.x) * sc, bfhi(v.x) * sc); rv.y = pk2(bflo(v.y) * sc, bfhi(v.y) * sc); rv.z = pk2(bflo(v.z) * sc, bfhi(v.z) * sc); rv.w = pk2(bflo(v.w) * sc, bfhi(v.w) * sc); }
                PREP_EMIT(i, rv); }
        } else {
            const float sc = kind == 2 ? 0.08838834764831845f : 1.f; const int odd = cg & 1;
            float inv[8];
#pragma unroll
            for (int e = 0; e < 8; ++e) inv[e] = exp2f(-(float)(8 * (c & 3) + e) * (13.287712379549449f / 32.f));
#pragma unroll
            for (int i = 0; i < 8; ++i) { const int tk = r8 + 8 * i, t = t0 + tk; const float pos = odd ? (float)(t & 63) : (float)(t >> 6);
                const u32x4 vo = *(const LAS u32x4*)(tile + tk * 64 + 8 * c), vp = *(const LAS u32x4*)(tile + tk * 64 + 8 * (c ^ 4));
                float o[8], p[8], rr[8];
                o[0] = bflo(vo.x); o[1] = bfhi(vo.x); o[2] = bflo(vo.y); o[3] = bfhi(vo.y); o[4] = bflo(vo.z); o[5] = bfhi(vo.z); o[6] = bflo(vo.w); o[7] = bfhi(vo.w);
                p[0] = bflo(vp.x); p[1] = bfhi(vp.x); p[2] = bflo(vp.y); p[3] = bfhi(vp.y); p[4] = bflo(vp.z); p[5] = bfhi(vp.z); p[6] = bflo(vp.w); p[7] = bfhi(vp.w);
#pragma unroll
                for (int e = 0; e < 8; ++e) { const float ang = pos * inv[e], cs = __cosf(ang), sn = __sinf(ang);
                    rr[e] = (c < 4 ? o[e] * cs - p[e] * sn : p[e] * sn + o[e] * cs) * sc; }
                u32x4 rv; rv.x = pk2(rr[0], rr[1]); rv.y = pk2(rr[2], rr[3]); rv.z = pk2(rr[4], rr[5]); rv.w = pk2(rr[6], rr[7]); PREP_EMIT(i, rv); }
        }
        if (trrow >= 0) {
            LDS_WAIT(); asm volatile("" ::: "memory");
            bf16_t* dst = TR + (size_t)(trrow + lane) * M + m0;
#pragma unroll
            for (int j = 0; j < 8; ++j) { unsigned wv[4];
#pragma unroll
                for (int q = 0; q < 4; ++q) { const unsigned lo = otile[(8 * j + 2 * q) * 64 + lane], hi = otile[(8 * j + 2 * q + 1) * 64 + lane]; wv[q] = lo | (hi << 16); }
                u32x4 o; o.x = wv[0]; o.y = wv[1]; o.z = wv[2]; o.w = wv[3]; *(u32x4*)(dst + 8 * j) = o; }
        }
        LDS_WAIT(); asm volatile("" ::: "memory");
    }
}

struct MlGate { float lf0, lf1, ig0, ig1, P0, P1, tot; };
__device__ __forceinline__ float wave_incl_scan(float v, int lane) {
#pragma unroll
    for (int o = 1; o < 64; o <<= 1) { const float t = __shfl_up(v, o); if (lane >= o) v += t; }
    return v;
}
__device__ __forceinline__ float wave_max(float v) {
#pragma unroll
    for (int o = 1; o < 64; o <<= 1) v = fmaxf(v, __shfl_xor(v, o));
    return v;
}
__device__ __forceinline__ MlGate ml_gates(const Args& a, int layer, int row0, int hh, int dir, int lane) {
    const float* SMALL = (const float*)(a.ws + WS_SMALL);
    const float ib = a.in[36][layer * 8 + dir * 4 + hh], fb = a.in[37][layer * 8 + dir * 4 + hh];
    MlGate g;
    const float f0 = SMALL[(size_t)(row0 + lane) * 32 + S_MF + dir * 4 + hh] + fb, f1 = SMALL[(size_t)(row0 + lane + 64) * 32 + S_MF + dir * 4 + hh] + fb;
    g.ig0 = SMALL[(size_t)(row0 + lane) * 32 + S_MI + dir * 4 + hh] + ib; g.ig1 = SMALL[(size_t)(row0 + lane + 64) * 32 + S_MI + dir * 4 + hh] + ib;
    g.lf0 = fminf(f0, 0.f) - log1pf(__expf(-fabsf(f0))); g.lf1 = fminf(f1, 0.f) - log1pf(__expf(-fabsf(f1)));
    const float s0 = wave_incl_scan(g.lf0, lane); const float tot0 = __shfl(s0, 63);
    const float s1 = wave_incl_scan(g.lf1, lane) + tot0;
    g.P0 = s0; g.P1 = s1; g.tot = __shfl(s1, 63);
    return g;
}

__device__ __forceinline__ void ml_states_phase(const Args& a, int layer, int tid_, int G) {
    int tid = tid_; asm volatile("" : "+v"(tid));
    const int lane = tid & 63, wave = __builtin_amdgcn_readfirstlane(tid >> 6), fr = lane & 15, fq = lane >> 4;
    const bf16_t* TR = (const bf16_t*)(a.ws + WS_TR);
    float* MLC = (float*)(a.ws + WS_MLC); float* MLN = (float*)(a.ws + WS_MLN); float* MLS = (float*)(a.ws + WS_MLS);
    for (int u = blockIdx.x; u < NCH * 4; u += G) {
        const int ch = u >> 2, hh = u & 3; int row0, seq0, L, lat, b, ci, nc; chunk_info(ch, row0, seq0, L, lat, b, ci, nc);
#pragma unroll 1
        for (int dir = 0; dir < 2; ++dir) {
            const MlGate g = ml_gates(a, layer, row0, hh, dir, lane);
            const float w0 = (dir == 0 ? g.tot - g.P0 : g.P0 - g.lf0) + g.ig0, w1 = (dir == 0 ? g.tot - g.P1 : g.P1 - g.lf1) + g.ig1;
            const float mloc = wave_max(fmaxf(w0, w1));
            const float e0 = __expf(w0 - mloc), e1 = __expf(w1 - mloc);
            f32x4 acc[8];
#pragma unroll
            for (int j = 0; j < 8; ++j) acc[j] = (f32x4){0.f, 0.f, 0.f, 0.f};
            float nacc[8];
#pragma unroll
            for (int j = 0; j < 8; ++j) nacc[j] = 0.f;
            const bf16_t* vrow = TR + (size_t)(T_MV + hh * 128 + wave * 16 + fr) * M + row0 + 8 * fq;
#pragma unroll
            for (int ks = 0; ks < 4; ++ks) {
                const bf16x8 af = *(const bf16x8*)(vrow + 32 * ks);
                float ev[8];
#pragma unroll
                for (int j = 0; j < 8; ++j) { const int tok = 32 * ks + 8 * fq + j; const float x0 = __shfl(e0, tok & 63), x1 = __shfl(e1, tok & 63); ev[j] = tok < 64 ? x0 : x1; }
#pragma unroll
                for (int jt = 0; jt < 8; ++jt) {
                    const u32x4 kv = *(const u32x4*)(TR + (size_t)(T_K + hh * 128 + jt * 16 + fr) * M + row0 + 32 * ks + 8 * fq);
                    const float k0 = bflo(kv.x) * ev[0], k1 = bfhi(kv.x) * ev[1], k2 = bflo(kv.y) * ev[2], k3 = bfhi(kv.y) * ev[3], k4 = bflo(kv.z) * ev[4], k5 = bfhi(kv.z) * ev[5], k6 = bflo(kv.w) * ev[6], k7 = bfhi(kv.w) * ev[7];
                    if (wave == 0) nacc[jt] += ((k0 + k1) + (k2 + k3)) + ((k4 + k5) + (k6 + k7));
                    u32x4 kb; kb.x = pk2(k0, k1); kb.y = pk2(k2, k3); kb.z = pk2(k4, k5); kb.w = pk2(k6, k7);
                    acc[jt] = mfma16(af, __builtin_bit_cast(bf16x8, kb), acc[jt]);
                }
            }
            float* cdst = MLC + ((size_t)(ch * 4 + hh) * 2 + dir) * 16384;
#pragma unroll
            for (int jt = 0; jt < 8; ++jt)
#pragma unroll
                for (int i = 0; i < 4; ++i) cdst[(size_t)(wave * 16 + 4 * fq + i) * 128 + jt * 16 + fr] = acc[jt][i];
            if (wave == 0) {
#pragma unroll
                for (int jt = 0; jt < 8; ++jt) { float v = nacc[jt]; v += __shfl_xor(v, 16); v += __shfl_xor(v, 32); if (fq == 0) MLN[((size_t)(ch * 4 + hh) * 2 + dir) * 128 + jt * 16 + fr] = v; }
                if (lane == 0) { MLS[((size_t)(ch * 4 + hh) * 2 + dir) * 4 + 0] = mloc; MLS[((size_t)(ch * 4 + hh) * 2 + dir) * 4 + 1] = g.tot; }
            }
        }
    }
}
__device__ __forceinline__ void ml_scan_phase(const Args& a, int layer, int tid_, int G) {
    int tid = tid_; asm volatile("" : "+v"(tid));
    const float* MLC = (const float*)(a.ws + WS_MLC); const float* MLN = (const float*)(a.ws + WS_MLN); const float* MLS = (const float*)(a.ws + WS_MLS);
    bf16_t* CS = (bf16_t*)(a.ws + WS_MLCS); float* NS = (float*)(a.ws + WS_MLNS); float* MS = (float*)(a.ws + WS_MLMS);
    for (int task = blockIdx.x; task < 256; task += G) {
        int lat, b, hh, dir, part, nparts;
        if (task < 128) { lat = 1; part = task & 3; dir = (task >> 2) & 1; hh = (task >> 3) & 3; b = task >> 5; nparts = 4; }
        else { const int t2 = task - 128; lat = 0; part = 0; dir = t2 & 1; hh = (t2 >> 1) & 3; b = t2 >> 3; nparts = 1; }
        const int nc = lat ? 16 : 2, ch0 = lat ? 32 + b * 16 : b * 2;
        const int nel = 16384 / nparts, e0 = part * nel, per = nel / NT;
        float c[32]; float n = 0.f, m = 0.f;
        const size_t so = (((size_t)b * DEPTH + layer) * 2 + dir) * 4 + hh;
#pragma unroll
        for (int i = 0; i < 32; ++i) if (i < per) { const int e = e0 + i * NT + tid, vd = e >> 7, kd = e & 127; c[i] = lat ? a.in[7][(so * 128 + kd) * 128 + vd] : 0.f; }
        if (tid < 128) n = lat ? a.in[8][so * 128 + tid] : 0.f;
        m = lat ? a.in[9][so] : 0.f;
        float nx[32]; float nn = 0.f, nml = 0.f, nbl = 0.f;
        { const int ch = ch0 + (dir ? nc - 1 : 0); const size_t sb = (size_t)(ch * 4 + hh) * 2 + dir;
#pragma unroll
            for (int i = 0; i < 32; ++i) if (i < per) nx[i] = MLC[sb * 16384 + e0 + i * NT + tid];
            if (tid < 128) nn = MLN[sb * 128 + tid]; nml = MLS[sb * 4 + 0]; nbl = MLS[sb * 4 + 1]; }
        for (int s = 0; s < nc; ++s) { const int ci = dir ? nc - 1 - s : s, ch = ch0 + ci; const size_t sb = (size_t)(ch * 4 + hh) * 2 + dir;
            float cx[32];
#pragma unroll
            for (int i = 0; i < 32; ++i) if (i < per) cx[i] = nx[i];
            const float cn = nn, ml = nml, bl = nbl;
            if (s + 1 < nc) { const int ch2 = ch0 + (dir ? nc - 2 - s : s + 1); const size_t sb2 = (size_t)(ch2 * 4 + hh) * 2 + dir;
#pragma unroll
                for (int i = 0; i < 32; ++i) if (i < per) nx[i] = MLC[sb2 * 16384 + e0 + i * NT + tid];
                if (tid < 128) nn = MLN[sb2 * 128 + tid]; nml = MLS[sb2 * 4 + 0]; nbl = MLS[sb2 * 4 + 1]; }
#pragma unroll
            for (int i = 0; i < 32; ++i) if (i < per) CS[sb * 16384 + e0 + i * NT + tid] = f2bf(c[i]);
            if (part == 0) { if (tid < 128) NS[sb * 128 + tid] = n; if (tid == 0) MS[sb] = m; }
            const float mn = fmaxf(bl + m, ml), fa = __expf(bl + m - mn), fb = __expf(ml - mn);
#pragma unroll
            for (int i = 0; i < 32; ++i) if (i < per) c[i] = fa * c[i] + fb * cx[i];
            if (tid < 128) n = fa * n + fb * cn;
            m = mn; }
        if (!lat) {
#pragma unroll
            for (int i = 0; i < 32; ++i) if (i < per) { const int e = e0 + i * NT + tid, vd = e >> 7, kd = e & 127; a.out[O_MLC + (so * 128 + kd) * 128 + vd] = c[i]; }
            if (tid < 128) a.out[O_MLN + so * 128 + tid] = n; if (tid == 0) a.out[O_MLM + so] = m; }
    }
}
__device__ __forceinline__ void ml_out_phase(const Args& a, int layer, int gw, int ngw, int lane_) {
    int lane = lane_; asm volatile("" : "+v"(lane));
    const int fr = lane & 15, fq = lane >> 4;
    const bf16_t* NAT = (const bf16_t*)(a.ws + WS_NAT); const bf16_t* TR = (const bf16_t*)(a.ws + WS_TR); const bf16_t* PROJ = (const bf16_t*)(a.ws + WS_PROJ);
    const bf16_t* CS = (const bf16_t*)(a.ws + WS_MLCS); const float* NS = (const float*)(a.ws + WS_MLNS); const float* MS = (const float*)(a.ws + WS_MLMS);
    bf16_t* BR = (bf16_t*)(a.ws + WS_BR);
    for (int it = gw; it < NCH * 4 * 8; it += ngw) {
        const int wv = it & 7, hh = (it >> 3) & 3, ch = it >> 5; int row0, seq0, L, lat, b, ci, nc; chunk_info(ch, row0, seq0, L, lat, b, ci, nc);
        const int t = wv * 16 + fr;
        bf16x8 qf[4];
#pragma unroll
        for (int ks = 0; ks < 4; ++ks) qf[ks] = *(const bf16x8*)(NAT + (size_t)(row0 + t) * NATP + N_Q + hh * 128 + 32 * ks + 8 * fq);
        f32x4 hsum[8];
#pragma unroll
        for (int j = 0; j < 8; ++j) hsum[j] = (f32x4){0.f, 0.f, 0.f, 0.f};
#pragma unroll
        for (int dir = 0; dir < 2; ++dir) {
            const size_t sb = (size_t)(ch * 4 + hh) * 2 + dir;
            const MlGate g = ml_gates(a, layer, row0, hh, dir, lane); const float ms = MS[sb];
            float u0, u1, c0, c1, ai0, ai1;
            if (dir == 0) { u0 = g.ig0 - g.P0; u1 = g.ig1 - g.P1; c0 = g.P0; c1 = g.P1; ai0 = g.P0 + ms; ai1 = g.P1 + ms; }
            else { const float E0 = g.P0 - g.lf0, E1 = g.P1 - g.lf1; u0 = E0 + g.ig0; u1 = E1 + g.ig1; c0 = -E0; c1 = -E1; ai0 = g.tot - E0 + ms; ai1 = g.tot - E1 + ms; }
            float g0 = u0, g1 = u1;
            if (dir == 0) {
#pragma unroll
                for (int o2 = 1; o2 < 64; o2 <<= 1) { const float x0 = __shfl_up(g0, o2), x1 = __shfl_up(g1, o2); if (lane >= o2) { g0 = fmaxf(g0, x0); g1 = fmaxf(g1, x1); } }
                g1 = fmaxf(g1, __shfl(g0, 63));
            } else {
#pragma unroll
                for (int o2 = 1; o2 < 64; o2 <<= 1) { const float x0 = __shfl_down(g0, o2), x1 = __shfl_down(g1, o2); if (lane + o2 < 64) { g0 = fmaxf(g0, x0); g1 = fmaxf(g1, x1); } }
                g0 = fmaxf(g0, __shfl(g1, 0));
            }
            const float mt0 = fmaxf(ai0, c0 + g0), mt1 = fmaxf(ai1, c1 + g1);
            const float w0 = c0 - mt0, w1 = c1 - mt1, si0 = __expf(ai0 - mt0), si1 = __expf(ai1 - mt1), em0 = __expf(-mt0), em1 = __expf(-mt1);
            const int tl = t & 63; const bool th = wv >= 4;
            const float wt = th ? __shfl(w1, tl) : __shfl(w0, tl), sit = th ? __shfl(si1, tl) : __shfl(si0, tl), emt = th ? __shfl(em1, tl) : __shfl(em0, tl);
            f32x4 acc[8];
#pragma unroll
            for (int j = 0; j < 8; ++j) acc[j] = (f32x4){0.f, 0.f, 0.f, 0.f};
#pragma unroll
            for (int ks = 0; ks < 4; ++ks)
#pragma unroll
                for (int j = 0; j < 8; ++j) { const bf16x8 cf = *(const bf16x8*)(CS + sb * 16384 + (size_t)(16 * j + fr) * 128 + 32 * ks + 8 * fq); acc[j] = mfma16(cf, qf[ks], acc[j]); }
            float qn = 0.f;
#pragma unroll
            for (int ks = 0; ks < 4; ++ks) { const u32x4 qv = __builtin_bit_cast(u32x4, qf[ks]); const float* nn = NS + sb * 128 + 32 * ks + 8 * fq; const f32x4 n0 = *(const f32x4*)nn, n1 = *(const f32x4*)(nn + 4);
                qn += bflo(qv.x) * n0[0] + bfhi(qv.x) * n0[1] + bflo(qv.y) * n0[2] + bfhi(qv.y) * n0[3] + bflo(qv.z) * n1[0] + bfhi(qv.z) * n1[1] + bflo(qv.w) * n1[2] + bfhi(qv.w) * n1[3]; }
            qn += __shfl_xor(qn, 16); qn += __shfl_xor(qn, 32);
#pragma unroll
            for (int j = 0; j < 8; ++j) acc[j] *= sit;
            float den = sit * qn;
            const int jlo = dir == 0 ? 0 : (wv >> 1), jhi = dir == 0 ? (wv >> 1) : 3;
            float psum = 0.f;
            for (int jp = jlo; jp <= jhi; ++jp) {
                const int ta = 32 * jp + 8 * (fr >> 2) + (fr & 3);
                f32x4 sa = (f32x4){0.f, 0.f, 0.f, 0.f}, sb2 = (f32x4){0.f, 0.f, 0.f, 0.f};
#pragma unroll
                for (int ks = 0; ks < 4; ++ks) {
                    const bf16x8 ka = *(const bf16x8*)(NAT + (size_t)(row0 + ta) * NATP + N_K + hh * 128 + 32 * ks + 8 * fq);
                    const bf16x8 kb = *(const bf16x8*)(NAT + (size_t)(row0 + ta + 4) * NATP + N_K + hh * 128 + 32 * ks + 8 * fq);
                    sa = mfma16(ka, qf[ks], sa); sb2 = mfma16(kb, qf[ks], sb2); }
                float pa[4], pb[4];
#pragma unroll
                for (int i = 0; i < 4; ++i) { const int s0 = 32 * jp + 8 * fq + i, s1 = s0 + 4;
                    const float us0 = jp < 2 ? __shfl(u0, s0 & 63) : __shfl(u1, s0 & 63), us1 = jp < 2 ? __shfl(u0, s1 & 63) : __shfl(u1, s1 & 63);
                    const bool ok0 = dir == 0 ? s0 <= t : s0 >= t, ok1 = dir == 0 ? s1 <= t : s1 >= t;
                    pa[i] = ok0 ? sa[i] * __expf(us0 + wt) : 0.f; pb[i] = ok1 ? sb2[i] * __expf(us1 + wt) : 0.f;
                    psum += pa[i] + pb[i]; }
                u32x4 pw; pw.x = pk2(pa[0], pa[1]); pw.y = pk2(pa[2], pa[3]); pw.z = pk2(pb[0], pb[1]); pw.w = pk2(pb[2], pb[3]);
                const bf16x8 pf = __builtin_bit_cast(bf16x8, pw);
#pragma unroll
                for (int j = 0; j < 8; ++j) { const bf16x8 vf = *(const bf16x8*)(TR + (size_t)(T_MV + hh * 128 + 16 * j + fr) * M + row0 + 32 * jp + 8 * fq); acc[j] = mfma16(vf, pf, acc[j]); }
            }
            psum += __shfl_xor(psum, 16); psum += __shfl_xor(psum, 32);
            den += psum;
            const float rden = 1.f / fmaxf(fabsf(den), emt);
#pragma unroll
            for (int j = 0; j < 8; ++j) hsum[j] += acc[j] * rden;
        }
        float ss = 0.f;
#pragma unroll
        for (int j = 0; j < 8; ++j) ss += (hsum[j][0] * hsum[j][0] + hsum[j][1] * hsum[j][1]) + (hsum[j][2] * hsum[j][2] + hsum[j][3] * hsum[j][3]);
        ss += __shfl_xor(ss, 16); ss += __shfl_xor(ss, 32);
        const float r = rsqrtf(ss * (1.f / 128.f) + 1e-6f);
        const float* ng = a.in[38] + layer * 512 + hh * 128;
#pragma unroll
        for (int j = 0; j < 8; ++j) { const int vd = 16 * j + 4 * fq; const f32x4 gg = *(const f32x4*)(ng + vd);
            const u32x2 ov = *(const u32x2*)(PROJ + (size_t)(row0 + t) * PJ + P_MO + hh * 128 + vd);
            const float o0 = hsum[j][0] * r * gg[0] * fsigm(bflo(ov.x)), o1 = hsum[j][1] * r * gg[1] * fsigm(bfhi(ov.x)), o2 = hsum[j][2] * r * gg[2] * fsigm(bflo(ov.y)), o3 = hsum[j][3] * r * gg[3] * fsigm(bfhi(ov.y));
            u32x2 w; w.x = pk2(o0, o1); w.y = pk2(o2, o3); *(u32x2*)(BR + (size_t)(row0 + t) * D + 1536 + hh * 128 + vd) = w; }
    }
}
}
namespace mk {
constexpr size_t WS_SST = WS_OPT_END;
constexpr size_t WS_SSL = AL(WS_SST + (size_t)NCH * 8 * 2 * 8192 * 4);
constexpr size_t WS_SSCS = AL(WS_SSL + (size_t)NCH * 8 * 2 * 4);
constexpr size_t WS_YPRE = AL(WS_SSCS + (size_t)NCH * 8 * 2 * 8192 * 2);
constexpr size_t WS_SSQ = AL(WS_YPRE + (size_t)M * 512 * 4);
constexpr size_t WS_SSD_END = AL(WS_SSQ + (size_t)M * 8 * 4);

struct SsdGate { float dt0, dt1, la0, la1, P0, P1, tot; };
__device__ __forceinline__ SsdGate ssd_gates(const Args& a, int layer, int row0, int hh, int dir, int lane) {
    const float* SMALL = (const float*)(a.ws + WS_SMALL);
    const float bias = a.in[32][layer * 16 + dir * 8 + hh], A = -__expf(a.in[33][layer * 16 + dir * 8 + hh]);
    SsdGate g;
    const float x0 = SMALL[(size_t)(row0 + lane) * 32 + S_DT + dir * 8 + hh] + bias, x1 = SMALL[(size_t)(row0 + lane + 64) * 32 + S_DT + dir * 8 + hh] + bias;
    g.dt0 = fmaxf(x0, 0.f) + log1pf(__expf(-fabsf(x0))); g.dt1 = fmaxf(x1, 0.f) + log1pf(__expf(-fabsf(x1)));
    g.la0 = g.dt0 * A; g.la1 = g.dt1 * A;
    const float s0 = wave_incl_scan(g.la0, lane); const float t0 = __shfl(s0, 63);
    const float s1 = wave_incl_scan(g.la1, lane) + t0;
    g.P0 = s0; g.P1 = s1; g.tot = __shfl(s1, 63);
    return g;
}
__device__ __forceinline__ void ssd_states_phase(const Args& a, int layer, int tid_, int G) {
    int tid = tid_; asm volatile("" : "+v"(tid));
    const int lane = tid & 63, wave = __builtin_amdgcn_readfirstlane(tid >> 6), fr = lane & 15, fq = lane >> 4;
    const bf16_t* TR = (const bf16_t*)(a.ws + WS_TR); float* SST = (float*)(a.ws + WS_SST); float* SSL = (float*)(a.ws + WS_SSL);
    for (int u = blockIdx.x; u < NCH * 8; u += G) {
        const int ch = u >> 3, hh = u & 7, grp = hh >> 2; int row0, seq0, L, lat, b, ci, nc; chunk_info(ch, row0, seq0, L, lat, b, ci, nc);
#pragma unroll 1
        for (int dir = 0; dir < 2; ++dir) {
            const SsdGate g = ssd_gates(a, layer, row0, hh, dir, lane);
            const float w0 = g.dt0 * __expf(dir == 0 ? g.tot - g.P0 : g.P0 - g.la0), w1 = g.dt1 * __expf(dir == 0 ? g.tot - g.P1 : g.P1 - g.la1);
            f32x4 acc[4];
#pragma unroll
            for (int j = 0; j < 4; ++j) acc[j] = (f32x4){0.f, 0.f, 0.f, 0.f};
#pragma unroll
            for (int ks = 0; ks < 4; ++ks) {
                float ev[8];
#pragma unroll
                for (int j = 0; j < 8; ++j) { const int tok = 32 * ks + 8 * fq + j; const float y0 = __shfl(w0, tok & 63), y1 = __shfl(w1, tok & 63); ev[j] = tok < 64 ? y0 : y1; }
                const u32x4 bv = *(const u32x4*)(TR + (size_t)(T_B + grp * 128 + wave * 16 + fr) * M + row0 + 32 * ks + 8 * fq);
                u32x4 bw; bw.x = pk2(bflo(bv.x) * ev[0], bfhi(bv.x) * ev[1]); bw.y = pk2(bflo(bv.y) * ev[2], bfhi(bv.y) * ev[3]); bw.z = pk2(bflo(bv.z) * ev[4], bfhi(bv.z) * ev[5]); bw.w = pk2(bflo(bv.w) * ev[6], bfhi(bv.w) * ev[7]);
                const bf16x8 bf = __builtin_bit_cast(bf16x8, bw);
#pragma unroll
                for (int j = 0; j < 4; ++j) { const bf16x8 xf = *(const bf16x8*)(TR + (size_t)(T_X + hh * 64 + 16 * j + fr) * M + row0 + 32 * ks + 8 * fq); acc[j] = mfma16(xf, bf, acc[j]); }
            }
            float* dst = SST + ((size_t)(ch * 8 + hh) * 2 + dir) * 8192;
#pragma unroll
            for (int j = 0; j < 4; ++j)
#pragma unroll
                for (int i = 0; i < 4; ++i) dst[(size_t)(16 * j + 4 * fq + i) * 128 + wave * 16 + fr] = acc[j][i];
            if (tid == 0) SSL[(size_t)(ch * 8 + hh) * 2 + dir] = g.tot;
        }
    }
}
__device__ __forceinline__ void ssd_scan_phase(const Args& a, int layer, int tid_, int G) {
    int tid = tid_; asm volatile("" : "+v"(tid));
    const float* SST = (const float*)(a.ws + WS_SST); const float* SSL = (const float*)(a.ws + WS_SSL); bf16_t* CS = (bf16_t*)(a.ws + WS_SSCS);
    for (int task = blockIdx.x; task < 384; task += G) {
        int lat, b, hh, dir, part, nparts;
        if (task < 128) { lat = 1; part = task & 1; dir = (task >> 1) & 1; hh = (task >> 2) & 7; b = task >> 5; nparts = 2; }
        else { const int t2 = task - 128; lat = 0; part = 0; dir = t2 & 1; hh = (t2 >> 1) & 7; b = t2 >> 4; nparts = 1; }
        const int nc = lat ? 16 : 2, ch0 = lat ? 32 + b * 16 : b * 2;
        const int nel = 8192 / nparts, e0 = part * nel, per = nel / NT;
        float c[16];
        const size_t so = ((((size_t)b * DEPTH + layer) * 2 + dir) * 8 + hh) * 8192;
#pragma unroll
        for (int i = 0; i < 16; ++i) if (i < per) c[i] = lat ? a.in[6][so + e0 + i * NT + tid] : 0.f;
        float nx[16]; float ntot;
        { const int ch = ch0 + (dir ? nc - 1 : 0); const size_t sb = (size_t)(ch * 8 + hh) * 2 + dir;
#pragma unroll
            for (int i = 0; i < 16; ++i) if (i < per) nx[i] = SST[sb * 8192 + e0 + i * NT + tid];
            ntot = SSL[sb]; }
        for (int s = 0; s < nc; ++s) { const int ci = dir ? nc - 1 - s : s, ch = ch0 + ci; const size_t sb = (size_t)(ch * 8 + hh) * 2 + dir;
            float cx[16];
#pragma unroll
            for (int i = 0; i < 16; ++i) if (i < per) cx[i] = nx[i];
            const float dec = __expf(ntot);
            if (s + 1 < nc) { const int ch2 = ch0 + (dir ? nc - 2 - s : s + 1); const size_t sb2 = (size_t)(ch2 * 8 + hh) * 2 + dir;
#pragma unroll
                for (int i = 0; i < 16; ++i) if (i < per) nx[i] = SST[sb2 * 8192 + e0 + i * NT + tid];
                ntot = SSL[sb2]; }
#pragma unroll
            for (int i = 0; i < 16; ++i) if (i < per) CS[sb * 8192 + e0 + i * NT + tid] = f2bf(c[i]);
#pragma unroll
            for (int i = 0; i < 16; ++i) if (i < per) c[i] = dec * c[i] + cx[i]; }
        if (!lat) {
#pragma unroll
            for (int i = 0; i < 16; ++i) if (i < per) a.out[O_SSD + so + e0 + i * NT + tid] = c[i]; }
    }
}
__device__ __forceinline__ void ssd_out_phase(const Args& a, int layer, int gw, int ngw, int lane_) {
    int lane = lane_; asm volatile("" : "+v"(lane));
    const int fr = lane & 15, fq = lane >> 4;
    const bf16_t* NAT = (const bf16_t*)(a.ws + WS_NAT); const bf16_t* TR = (const bf16_t*)(a.ws + WS_TR); const bf16_t* PROJ = (const bf16_t*)(a.ws + WS_PROJ);
    const bf16_t* CS = (const bf16_t*)(a.ws + WS_SSCS); float* YPRE = (float*)(a.ws + WS_YPRE); float* SSQ = (float*)(a.ws + WS_SSQ);
    for (int it = gw; it < NCH * 8 * 8; it += ngw) {
        const int wv = it & 7, hh = (it >> 3) & 7, ch = it >> 6, grp = hh >> 2; int row0, seq0, L, lat, b, ci, nc; chunk_info(ch, row0, seq0, L, lat, b, ci, nc);
        const int t = wv * 16 + fr;
        bf16x8 cf[4];
#pragma unroll
        for (int ks = 0; ks < 4; ++ks) cf[ks] = *(const bf16x8*)(NAT + (size_t)(row0 + t) * NATP + N_XBC + 768 + grp * 128 + 32 * ks + 8 * fq);
        f32x4 ysum[4];
#pragma unroll
        for (int j = 0; j < 4; ++j) ysum[j] = (f32x4){0.f, 0.f, 0.f, 0.f};
#pragma unroll
        for (int dir = 0; dir < 2; ++dir) {
            const size_t sb = (size_t)(ch * 8 + hh) * 2 + dir;
            const SsdGate g = ssd_gates(a, layer, row0, hh, dir, lane);
            float u0, u1, w0, w1, e0, e1;
            if (dir == 0) { u0 = -g.P0; u1 = -g.P1; w0 = g.P0; w1 = g.P1; e0 = __expf(g.P0); e1 = __expf(g.P1); }
            else { const float E0 = g.P0 - g.la0, E1 = g.P1 - g.la1; u0 = E0; u1 = E1; w0 = -E0; w1 = -E1; e0 = __expf(g.tot - E0); e1 = __expf(g.tot - E1); }
            const int tl = t & 63; const bool th = wv >= 4;
            const float wt = th ? __shfl(w1, tl) : __shfl(w0, tl), eot = th ? __shfl(e1, tl) : __shfl(e0, tl);
            f32x4 acc[4];
#pragma unroll
            for (int j = 0; j < 4; ++j) acc[j] = (f32x4){0.f, 0.f, 0.f, 0.f};
#pragma unroll
            for (int ks = 0; ks < 4; ++ks)
#pragma unroll
                for (int j = 0; j < 4; ++j) { const bf16x8 sf = *(const bf16x8*)(CS + sb * 8192 + (size_t)(16 * j + fr) * 128 + 32 * ks + 8 * fq); acc[j] = mfma16(sf, cf[ks], acc[j]); }
#pragma unroll
            for (int j = 0; j < 4; ++j) acc[j] *= eot;
            const int jlo = dir == 0 ? 0 : (wv >> 1), jhi = dir == 0 ? (wv >> 1) : 3;
            for (int jp = jlo; jp <= jhi; ++jp) {
                const int ta = 32 * jp + 8 * (fr >> 2) + (fr & 3);
                f32x4 sa = (f32x4){0.f, 0.f, 0.f, 0.f}, sb2 = (f32x4){0.f, 0.f, 0.f, 0.f};
#pragma unroll
                for (int ks = 0; ks < 4; ++ks) {
                    const bf16x8 ba = *(const bf16x8*)(NAT + (size_t)(row0 + ta) * NATP + N_XBC + 512 + grp * 128 + 32 * ks + 8 * fq);
                    const bf16x8 bb = *(const bf16x8*)(NAT + (size_t)(row0 + ta + 4) * NATP + N_XBC + 512 + grp * 128 + 32 * ks + 8 * fq);
                    sa = mfma16(ba, cf[ks], sa); sb2 = mfma16(bb, cf[ks], sb2); }
                float pa[4], pb[4];
#pragma unroll
                for (int i = 0; i < 4; ++i) { const int s0 = 32 * jp + 8 * fq + i, s1 = s0 + 4;
                    const float us0 = jp < 2 ? __shfl(u0, s0 & 63) : __shfl(u1, s0 & 63), us1 = jp < 2 ? __shfl(u0, s1 & 63) : __shfl(u1, s1 & 63);
                    const float d0 = jp < 2 ? __shfl(g.dt0, s0 & 63) : __shfl(g.dt1, s0 & 63), d1 = jp < 2 ? __shfl(g.dt0, s1 & 63) : __shfl(g.dt1, s1 & 63);
                    const bool ok0 = dir == 0 ? s0 <= t : s0 >= t, ok1 = dir == 0 ? s1 <= t : s1 >= t;
                    pa[i] = ok0 ? sa[i] * d0 * __expf(us0 + wt) : 0.f; pb[i] = ok1 ? sb2[i] * d1 * __expf(us1 + wt) : 0.f; }
                u32x4 pw; pw.x = pk2(pa[0], pa[1]); pw.y = pk2(pa[2], pa[3]); pw.z = pk2(pb[0], pb[1]); pw.w = pk2(pb[2], pb[3]);
                const bf16x8 pf = __builtin_bit_cast(bf16x8, pw);
#pragma unroll
                for (int j = 0; j < 4; ++j) { const bf16x8 xf = *(const bf16x8*)(TR + (size_t)(T_X + hh * 64 + 16 * j + fr) * M + row0 + 32 * jp + 8 * fq); acc[j] = mfma16(xf, pf, acc[j]); }
            }
#pragma unroll
            for (int j = 0; j < 4; ++j) ysum[j] += acc[j];
        }
        const float Dh = a.in[34][layer * 8 + hh]; float ss = 0.f;
#pragma unroll
        for (int j = 0; j < 4; ++j) { const int p = 16 * j + 4 * fq;
            const u32x2 xv = *(const u32x2*)(NAT + (size_t)(row0 + t) * NATP + N_XBC + hh * 64 + p), zv = *(const u32x2*)(PROJ + (size_t)(row0 + t) * PJ + P_Z + hh * 64 + p);
            f32x4 y; y[0] = (ysum[j][0] + bflo(xv.x) * Dh) * fsilu(bflo(zv.x)); y[1] = (ysum[j][1] + bfhi(xv.x) * Dh) * fsilu(bfhi(zv.x));
            y[2] = (ysum[j][2] + bflo(xv.y) * Dh) * fsilu(bflo(zv.y)); y[3] = (ysum[j][3] + bfhi(xv.y) * Dh) * fsilu(bfhi(zv.y));
            ss += (y[0] * y[0] + y[1] * y[1]) + (y[2] * y[2] + y[3] * y[3]);
            *(f32x4*)(YPRE + (size_t)(row0 + t) * 512 + hh * 64 + p) = y; }
        ss += __shfl_xor(ss, 16); ss += __shfl_xor(ss, 32);
        if (fq == 0) SSQ[(size_t)(row0 + t) * 8 + hh] = ss;
    }
}
__device__ __forceinline__ void ssd_fin_phase(const Args& a, int layer, int gw, int ngw, int lane_) {
    int lane = lane_; asm volatile("" : "+v"(lane));
    const float* YPRE = (const float*)(a.ws + WS_YPRE); const float* SSQ = (const float*)(a.ws + WS_SSQ); bf16_t* BR = (bf16_t*)(a.ws + WS_BR); const float* ng = a.in[35] + layer * 512;
    for (int row = gw; row < M; row += ngw) {
        float s = lane < 8 ? SSQ[(size_t)row * 8 + lane] : 0.f; s += __shfl_xor(s, 1); s += __shfl_xor(s, 2); s += __shfl_xor(s, 4); s = __shfl(s, 0);
        const float r = rsqrtf(s * (1.f / 512.f) + 1e-6f);
        const f32x4 y0 = *(const f32x4*)(YPRE + (size_t)row * 512 + 8 * lane), y1 = *(const f32x4*)(YPRE + (size_t)row * 512 + 8 * lane + 4);
        const f32x4 g0 = *(const f32x4*)(ng + 8 * lane), g1 = *(const f32x4*)(ng + 8 * lane + 4);
        *(u32x4*)(BR + (size_t)row * D + 1024 + 8 * lane) = pack8(y0 * r * g0, y1 * r * g1);
    }
}
}
namespace mk {
constexpr size_t WS_CK = WS_SSD_END;
constexpr size_t WS_CVT = AL(WS_CK + (size_t)16 * 512 * 512 * 2);
constexpr size_t WS_ATT_END = AL(WS_CVT + (size_t)16 * 512 * 512 * 2);

__device__ __forceinline__ void prologue_cache(const Args& a, int gw, int ngw, int lane) {
    bf16_t* CK = (bf16_t*)(a.ws + WS_CK); bf16_t* CVT = (bf16_t*)(a.ws + WS_CVT);
    for (size_t i = ((size_t)gw * 64 + lane) * 8; i < (size_t)16 * 512 * 512; i += (size_t)ngw * 64 * 8) {
        const f32x4 x0 = *(const f32x4*)(a.in[2] + i), x1 = *(const f32x4*)(a.in[2] + i + 4); *(u32x4*)(CK + i) = pack8(x0, x1); }
    for (size_t i = (size_t)gw * 64 + lane; i < (size_t)16 * 64 * 512; i += (size_t)ngw * 64) { const int c = i & 511, s8 = (i >> 9) & 63, bl = i >> 15;
        const float* src = a.in[3] + ((size_t)bl * 512 + 8 * s8) * 512 + c;
        u32x4 o; o.x = pk2(src[0], src[512]); o.y = pk2(src[1024], src[1536]); o.z = pk2(src[2048], src[2560]); o.w = pk2(src[3072], src[3584]);
        *(u32x4*)(CVT + ((size_t)bl * 512 + c) * 512 + 8 * s8) = o; }
}
struct AttState { float m, l; f32x4 o[4]; };
struct AttFrags { bf16x8 k[4]; const bf16_t* vt; size_t vp; };
__device__ __forceinline__ void attn_load(AttFrags& f, const bf16_t* kbase, size_t kp, const bf16_t* vt, size_t vp, int fr, int fq) {
    const int ra = 8 * (fr >> 2) + (fr & 3);
#pragma unroll
    for (int ks = 0; ks < 2; ++ks) { f.k[ks] = *(const bf16x8*)(kbase + (size_t)ra * kp + 32 * ks + 8 * fq); f.k[2 + ks] = *(const bf16x8*)(kbase + (size_t)(ra + 4) * kp + 32 * ks + 8 * fq); }
    f.vt = vt + (size_t)fr * vp + 8 * fq; f.vp = vp;
}
template <bool MASKED>
__device__ __forceinline__ void attn_compute(AttState& st, const bf16x8 (&qf)[2], const AttFrags& f, int fq, const float* bias, int kc0, int cq, int cs) {
    bf16x8 vf[4];
#pragma unroll
    for (int j = 0; j < 4; ++j) vf[j] = *(const bf16x8*)(f.vt + (size_t)(16 * j) * f.vp);
    f32x4 sa = (f32x4){0.f, 0.f, 0.f, 0.f}, sb = (f32x4){0.f, 0.f, 0.f, 0.f};
#pragma unroll
    for (int ks = 0; ks < 2; ++ks) { sa = mfma16(f.k[ks], qf[ks], sa); sb = mfma16(f.k[2 + ks], qf[ks], sb); }
    float s[8]; float gm = -1e30f;
#pragma unroll
    for (int i = 0; i < 4; ++i) { s[i] = sa[i] * 0.125f; s[4 + i] = sb[i] * 0.125f; }
    if (MASKED) {
#pragma unroll
        for (int e = 0; e < 8; ++e) { const int kc = kc0 + 8 * fq + e; const bool ok = kc >= cs && kc < cs + 16; const int bi = min(max(kc - cq + 15, 0), 30); s[e] = ok ? s[e] + bias[bi] : -1e30f; }
    }
#pragma unroll
    for (int e = 0; e < 8; ++e) gm = fmaxf(gm, s[e]);
    gm = fmaxf(gm, __shfl_xor(gm, 16)); gm = fmaxf(gm, __shfl_xor(gm, 32));
    const float mn = fmaxf(st.m, gm), al = __expf(st.m - mn); st.m = mn;
    float p[8], ps = 0.f;
#pragma unroll
    for (int e = 0; e < 8; ++e) { p[e] = __expf(s[e] - mn); ps += p[e]; }
    st.l = st.l * al + ps;
    u32x4 pw; pw.x = pk2(p[0], p[1]); pw.y = pk2(p[2], p[3]); pw.z = pk2(p[4], p[5]); pw.w = pk2(p[6], p[7]);
    const bf16x8 pf = __builtin_bit_cast(bf16x8, pw);
#pragma unroll
    for (int j = 0; j < 4; ++j) st.o[j] = mfma16(vf[j], pf, st.o[j] * al);
}
__device__ __forceinline__ void attn_compute2(AttState& s0, AttState& s1, const bf16x8 (&q0)[2], const bf16x8 (&q1)[2], const AttFrags& f, int fq) {
    bf16x8 vf[4];
#pragma unroll
    for (int j = 0; j < 4; ++j) vf[j] = *(const bf16x8*)(f.vt + (size_t)(16 * j) * f.vp);
    f32x4 a0 = (f32x4){0.f, 0.f, 0.f, 0.f}, b0 = a0, a1 = a0, b1 = a0;
#pragma unroll
    for (int ks = 0; ks < 2; ++ks) { a0 = mfma16(f.k[ks], q0[ks], a0); b0 = mfma16(f.k[2 + ks], q0[ks], b0); a1 = mfma16(f.k[ks], q1[ks], a1); b1 = mfma16(f.k[2 + ks], q1[ks], b1); }
    float x0[8], x1[8]; float g0 = -1e30f, g1 = -1e30f;
#pragma unroll
    for (int i = 0; i < 4; ++i) { x0[i] = a0[i] * 0.125f; x0[4 + i] = b0[i] * 0.125f; x1[i] = a1[i] * 0.125f; x1[4 + i] = b1[i] * 0.125f; }
#pragma unroll
    for (int e = 0; e < 8; ++e) { g0 = fmaxf(g0, x0[e]); g1 = fmaxf(g1, x1[e]); }
    g0 = fmaxf(g0, __shfl_xor(g0, 16)); g1 = fmaxf(g1, __shfl_xor(g1, 16)); g0 = fmaxf(g0, __shfl_xor(g0, 32)); g1 = fmaxf(g1, __shfl_xor(g1, 32));
    const float m0 = fmaxf(s0.m, g0), al0 = __expf(s0.m - m0), m1 = fmaxf(s1.m, g1), al1 = __expf(s1.m - m1); s0.m = m0; s1.m = m1;
    float p0 = 0.f, p1 = 0.f;
#pragma unroll
    for (int e = 0; e < 8; ++e) { x0[e] = __expf(x0[e] - m0); p0 += x0[e]; x1[e] = __expf(x1[e] - m1); p1 += x1[e]; }
    s0.l = s0.l * al0 + p0; s1.l = s1.l * al1 + p1;
    u32x4 w0, w1; w0.x = pk2(x0[0], x0[1]); w0.y = pk2(x0[2], x0[3]); w0.z = pk2(x0[4], x0[5]); w0.w = pk2(x0[6], x0[7]); w1.x = pk2(x1[0], x1[1]); w1.y = pk2(x1[2], x1[3]); w1.z = pk2(x1[4], x1[5]); w1.w = pk2(x1[6], x1[7]);
    const bf16x8 f0 = __builtin_bit_cast(bf16x8, w0), f1 = __builtin_bit_cast(bf16x8, w1);
#pragma unroll
    for (int j = 0; j < 4; ++j) { s0.o[j] = mfma16(vf[j], f0, s0.o[j] * al0); s1.o[j] = mfma16(vf[j], f1, s1.o[j] * al1); }
}
__device__ __forceinline__ void attn_store(const AttState& st, bf16_t* BR, int qrow, int hh, int fq) {
    float l = st.l; l += __shfl_xor(l, 16); l += __shfl_xor(l, 32);
    const float rl = 1.f / l;
#pragma unroll
    for (int j = 0; j < 4; ++j) { u32x2 w; w.x = pk2(st.o[j][0] * rl, st.o[j][1] * rl); w.y = pk2(st.o[j][2] * rl, st.o[j][3] * rl);
        *(u32x2*)(BR + (size_t)qrow * D + hh * 64 + 16 * j + 4 * fq) = w; }
}
__device__ __forceinline__ void attn_phase(const Args& a, int layer, int gw_, int ngw, int lane_) {
    int lane = lane_, gw = gw_; asm volatile("" : "+v"(lane));
    const int fr = lane & 15, fq = lane >> 4;
    const bf16_t* PROJ = (const bf16_t*)(a.ws + WS_PROJ); const bf16_t* TR = (const bf16_t*)(a.ws + WS_TR); bf16_t* BR = (bf16_t*)(a.ws + WS_BR);
    const bf16_t* CK = (const bf16_t*)(a.ws + WS_CK); const bf16_t* CVT = (const bf16_t*)(a.ws + WS_CVT);
    for (int it = gw; it < 3072; it += ngw) {
        AttState s0, s1; s0.m = -1e30f; s0.l = 0.f; s1.m = -1e30f; s1.l = 0.f;
#pragma unroll
        for (int j = 0; j < 4; ++j) { s0.o[j] = (f32x4){0.f, 0.f, 0.f, 0.f}; s1.o[j] = (f32x4){0.f, 0.f, 0.f, 0.f}; }
        AttFrags fa, fb; bf16x8 q0[2], q1[2];
        if (it < 2048) {
            const int jp = it & 1, r = (it >> 1) & 31, hh = (it >> 6) & 7, b = it >> 9;
            const int seq0 = MP + b * 2048, qrow = seq0 + r * 64 + 32 * jp + fr;
#pragma unroll
            for (int ks = 0; ks < 2; ++ks) { q0[ks] = *(const bf16x8*)(PROJ + (size_t)qrow * PJ + P_Q + hh * 64 + 32 * ks + 8 * fq); q1[ks] = *(const bf16x8*)(PROJ + (size_t)(qrow + 16) * PJ + P_Q + hh * 64 + 32 * ks + 8 * fq); }
            const int rs = min(max(r - 4, 0), 24);
            const float* rpb = a.in[19] + ((size_t)layer * 8 + hh) * 15 * 31;
            const size_t cb = ((size_t)b * DEPTH + layer) * 512; const bf16_t* kc = CK + cb * 512 + hh * 64; const bf16_t* vc = CVT + (cb + hh * 64) * 512;
#pragma unroll 1
            for (int qt = 0; qt < 2; ++qt) { const int jq = 2 * jp + qt, cq = 16 * jq + fr, cs = min(max(cq - 8, 0), 48), kc0 = jq == 0 ? 0 : (jq == 1 ? 8 : (jq == 2 ? 24 : 32));
                const bf16_t* kw = PROJ + (size_t)(seq0 + rs * 64 + kc0) * PJ + P_K + hh * 64; const bf16_t* vw = TR + (size_t)(T_V + hh * 64) * M + seq0 + rs * 64 + kc0;
                AttState& st = qt == 0 ? s0 : s1; const bf16x8 (&qf)[2] = qt == 0 ? q0 : q1;
                attn_load(fa, kw, PJ, vw, M, fr, fq);
#pragma unroll 1
                for (int j = 0; j < 8; j += 2) {
                    attn_load(fb, kw + (size_t)(j + 1) * 64 * PJ, PJ, vw + (j + 1) * 64, M, fr, fq);
                    attn_compute<true>(st, qf, fa, fq, rpb + (rs + j - r + 7) * 31, kc0, cq, cs);
                    if (j + 2 < 8) attn_load(fa, kw + (size_t)(j + 2) * 64 * PJ, PJ, vw + (j + 2) * 64, M, fr, fq);
                    attn_compute<true>(st, qf, fb, fq, rpb + (rs + j + 1 - r + 7) * 31, kc0, cq, cs);
                }
            }
            attn_load(fa, kc, 512, vc, 512, fr, fq);
#pragma unroll 1
            for (int g = 0; g < 16; g += 2) {
                attn_load(fb, kc + (size_t)(32 * (g + 1)) * 512, 512, vc + 32 * (g + 1), 512, fr, fq);
                attn_compute2(s0, s1, q0, q1, fa, fq);
                if (g + 2 < 16) attn_load(fa, kc + (size_t)(32 * (g + 2)) * 512, 512, vc + 32 * (g + 2), 512, fr, fq);
                attn_compute2(s0, s1, q0, q1, fb, fq);
            }
            attn_store(s0, BR, qrow, hh, fq); attn_store(s1, BR, qrow + 16, hh, fq);
        } else {
            const int i2 = it - 2048, qp = i2 & 7, hh = (i2 >> 3) & 7, b = i2 >> 6, seq0 = b * 256, qrow = seq0 + 32 * qp + fr;
#pragma unroll
            for (int ks = 0; ks < 2; ++ks) { q0[ks] = *(const bf16x8*)(PROJ + (size_t)qrow * PJ + P_Q + hh * 64 + 32 * ks + 8 * fq); q1[ks] = *(const bf16x8*)(PROJ + (size_t)(qrow + 16) * PJ + P_Q + hh * 64 + 32 * ks + 8 * fq); }
            const bf16_t* kp = PROJ + (size_t)seq0 * PJ + P_K + hh * 64; const bf16_t* vp = TR + (size_t)(T_V + hh * 64) * M + seq0;
            attn_load(fa, kp, PJ, vp, M, fr, fq);
#pragma unroll 1
            for (int g = 0; g < 8; g += 2) {
                attn_load(fb, kp + (size_t)(32 * (g + 1)) * PJ, PJ, vp + 32 * (g + 1), M, fr, fq);
                attn_compute2(s0, s1, q0, q1, fa, fq);
                if (g + 2 < 8) attn_load(fa, kp + (size_t)(32 * (g + 2)) * PJ, PJ, vp + 32 * (g + 2), M, fr, fq);
                attn_compute2(s0, s1, q0, q1, fb, fq);
            }
            attn_store(s0, BR, qrow, hh, fq); attn_store(s1, BR, qrow + 16, hh, fq);
        }
    }
}
}
namespace mk {
constexpr int S5K = 768;
constexpr size_t WS_S5W = WS_ATT_END;
constexpr size_t WS_S5WS = AL(WS_S5W + (size_t)DEPTH * 32 * 512 * S5K * 2);
constexpr size_t WS_S5AP = AL(WS_S5WS + (size_t)DEPTH * 32 * 256 * 512 * 2);
constexpr size_t WS_S5UP = AL(WS_S5AP + (size_t)DEPTH * 32 * 2 * 64 * 2 * 4);
constexpr size_t WS_S5SS = AL(WS_S5UP + (size_t)32 * 384 * 512 * 2);
constexpr size_t WS_S5HS = AL(WS_S5SS + (size_t)32 * 384 * 256 * 4);
constexpr size_t WS_S5_END = AL(WS_S5HS + (size_t)32 * 384 * 256 * 2);

__device__ __forceinline__ void s5_param_task(const Args& a, LAS unsigned char* lds, int tid_, int task) {
    int tid = tid_; asm volatile("" : "+v"(tid));
    LAS float* PW = (LAS float*)lds; LAS float* BB = PW + 2 * 33 * 64 * 2; LAS float* CC = BB + 2 * 64 * 16 * 2; LAS float* KT = CC + 2 * 16 * 64 * 2;
    {
        const int layer = task >> 5, g = task & 31;
        const float* a_re = a.in[20] + layer * 4096; const float* a_im = a.in[21] + layer * 4096; const float* log_dt = a.in[22] + layer * 64;
        const float* b_re = a.in[23] + (size_t)layer * 65536; const float* b_im = a.in[24] + (size_t)layer * 65536; const float* c_re = a.in[25] + (size_t)layer * 65536; const float* c_im = a.in[26] + (size_t)layer * 65536;
        const float* s5d = a.in[27] + layer * 512;
        bf16_t* S5W = (bf16_t*)(a.ws + WS_S5W) + (size_t)layer * 32 * 512 * S5K; bf16_t* S5WS = (bf16_t*)(a.ws + WS_S5WS) + (size_t)layer * 32 * 256 * 512; float* S5AP = (float*)(a.ws + WS_S5AP) + (size_t)layer * 32 * 2 * 64 * 2;
        __syncthreads();
        if (tid < 128) { const int dir = tid >> 6, n = tid & 63, pi = (dir * 32 + g) * 64 + n;
            const float are = fminf(a_re[pi], -1e-4f), aim = a_im[pi], dt = expf(log_dt[dir * 32 + g]);
            const float mag = expf(dt * are), abr = mag * cosf(dt * aim), abi = mag * sinf(dt * aim);
            const float den = are * are + aim * aim, nr = abr - 1.f, cfr = (nr * are + abi * aim) / den, cfi = (abi * are - nr * aim) / den;
            float pr = 1.f, pim = 0.f;
            for (int p = 0; p <= 32; ++p) { PW[((dir * 33 + p) * 64 + n) * 2] = pr; PW[((dir * 33 + p) * 64 + n) * 2 + 1] = pim; const float t = pr * abr - pim * abi; pim = pr * abi + pim * abr; pr = t; }
            S5AP[((g * 2 + dir) * 64 + n) * 2] = PW[((dir * 33 + 32) * 64 + n) * 2]; S5AP[((g * 2 + dir) * 64 + n) * 2 + 1] = PW[((dir * 33 + 32) * 64 + n) * 2 + 1];
            for (int k = 0; k < 16; ++k) { const float br_ = b_re[(size_t)pi * 16 + k], bi_ = b_im[(size_t)pi * 16 + k];
                BB[((dir * 64 + n) * 16 + k) * 2] = cfr * br_ - cfi * bi_; BB[((dir * 64 + n) * 16 + k) * 2 + 1] = cfr * bi_ + cfi * br_; }
            for (int j = 0; j < 16; ++j) { CC[((dir * 64 + n) * 16 + j) * 2] = c_re[((size_t)(dir * 32 + g) * 16 + j) * 64 + n]; CC[((dir * 64 + n) * 16 + j) * 2 + 1] = c_im[((size_t)(dir * 32 + g) * 16 + j) * 64 + n]; }
        }
        __syncthreads();
        for (int e = tid; e < 2 * 32 * 256; e += NT) { const int j = e & 15, k = (e >> 4) & 15, tau = (e >> 8) & 31, dir = e >> 13; float s = 0.f;
            for (int n = 0; n < 64; ++n) { const float cr = CC[((dir * 64 + n) * 16 + j) * 2], ci = CC[((dir * 64 + n) * 16 + j) * 2 + 1], pr = PW[((dir * 33 + tau) * 64 + n) * 2], pim = PW[((dir * 33 + tau) * 64 + n) * 2 + 1];
                const float xr = cr * pr - ci * pim, xi = cr * pim + ci * pr, br_ = BB[((dir * 64 + n) * 16 + k) * 2], bi_ = BB[((dir * 64 + n) * 16 + k) * 2 + 1];
                s += xr * br_ - xi * bi_; }
            KT[e] = s; }
        __syncthreads();
        { const int t = tid >> 4, j = tid & 15; bf16_t* dst = S5W + ((size_t)g * 512 + tid) * S5K;
            for (int s = 0; s < 32; ++s) { float v[16];
#pragma unroll
                for (int k = 0; k < 16; ++k) { float x;
                    if (s < t) x = KT[((0 * 32 + (t - s)) * 16 + k) * 16 + j]; else if (s > t) x = KT[((1 * 32 + (s - t)) * 16 + k) * 16 + j];
                    else x = KT[((0 * 32 + 0) * 16 + k) * 16 + j] + KT[((1 * 32 + 0) * 16 + k) * 16 + j] + (k == j ? s5d[g * 16 + k] : 0.f);
                    v[k] = x; }
                u32x4 o0, o1; o0.x = pk2(v[0], v[1]); o0.y = pk2(v[2], v[3]); o0.z = pk2(v[4], v[5]); o0.w = pk2(v[6], v[7]); o1.x = pk2(v[8], v[9]); o1.y = pk2(v[10], v[11]); o1.z = pk2(v[12], v[13]); o1.w = pk2(v[14], v[15]);
                *(u32x4*)(dst + s * 16) = o0; *(u32x4*)(dst + s * 16 + 8) = o1; }
            for (int dir = 0; dir < 2; ++dir) { const int p = dir == 0 ? t + 1 : 32 - t;
                for (int n8 = 0; n8 < 8; ++n8) { float gr[8], gi[8];
#pragma unroll
                    for (int q = 0; q < 8; ++q) { const int n = n8 * 8 + q; const float cr = CC[((dir * 64 + n) * 16 + j) * 2], ci = CC[((dir * 64 + n) * 16 + j) * 2 + 1], pr = PW[((dir * 33 + p) * 64 + n) * 2], pim = PW[((dir * 33 + p) * 64 + n) * 2 + 1];
                        gr[q] = cr * pr - ci * pim; gi[q] = -(cr * pim + ci * pr); }
                    u32x4 o; o.x = pk2(gr[0], gr[1]); o.y = pk2(gr[2], gr[3]); o.z = pk2(gr[4], gr[5]); o.w = pk2(gr[6], gr[7]); *(u32x4*)(dst + 512 + dir * 128 + n8 * 8) = o;
                    o.x = pk2(gi[0], gi[1]); o.y = pk2(gi[2], gi[3]); o.z = pk2(gi[4], gi[5]); o.w = pk2(gi[6], gi[7]); *(u32x4*)(dst + 512 + dir * 128 + 64 + n8 * 8) = o; } }
        }
        if (tid < 256) { const int dir = tid >> 7, reim = (tid >> 6) & 1, n = tid & 63; bf16_t* dst = S5WS + ((size_t)g * 256 + tid) * 512;
            for (int s = 0; s < 32; ++s) { const int p = dir == 0 ? 31 - s : s; const float pr = PW[((dir * 33 + p) * 64 + n) * 2], pim = PW[((dir * 33 + p) * 64 + n) * 2 + 1]; float v[16];
#pragma unroll
                for (int k = 0; k < 16; ++k) { const float br_ = BB[((dir * 64 + n) * 16 + k) * 2], bi_ = BB[((dir * 64 + n) * 16 + k) * 2 + 1]; v[k] = reim == 0 ? pr * br_ - pim * bi_ : pr * bi_ + pim * br_; }
                u32x4 o0, o1; o0.x = pk2(v[0], v[1]); o0.y = pk2(v[2], v[3]); o0.z = pk2(v[4], v[5]); o0.w = pk2(v[6], v[7]); o1.x = pk2(v[8], v[9]); o1.y = pk2(v[10], v[11]); o1.z = pk2(v[12], v[13]); o1.w = pk2(v[14], v[15]);
                *(u32x4*)(dst + s * 16) = o0; *(u32x4*)(dst + s * 16 + 8) = o1; } }
    }
    __syncthreads();
}
__device__ __forceinline__ void s5_statein_phase(const Args& a, int layer, int gw, int ngw, int lane_) {
    int lane = lane_; asm volatile("" : "+v"(lane));
    const int fr = lane & 15, fq = lane >> 4;
    const bf16_t* UP = (const bf16_t*)(a.ws + WS_S5UP); const bf16_t* S5WS = (const bf16_t*)(a.ws + WS_S5WS) + (size_t)layer * 32 * 256 * 512; float* SS = (float*)(a.ws + WS_S5SS);
    for (int it = ngw - 1 - gw; it < 32 * 24; it += ngw) { const int g = it / 24, r = it % 24, og = r / 6, cq = r % 6;
        f32x4 acc[4][4];
#pragma unroll
        for (int i = 0; i < 4; ++i)
#pragma unroll
            for (int j = 0; j < 4; ++j) acc[i][j] = (f32x4){0.f, 0.f, 0.f, 0.f};
        const bf16_t* ap = S5WS + ((size_t)g * 256 + 64 * og + fr) * 512 + 8 * fq; const bf16_t* bp = UP + ((size_t)g * 384 + 64 * cq + fr) * 512 + 8 * fq;
#pragma unroll 2
        for (int ks = 0; ks < 16; ++ks) { bf16x8 af[4], bf[4];
#pragma unroll
            for (int i = 0; i < 4; ++i) { af[i] = *(const bf16x8*)(ap + (size_t)16 * i * 512 + 32 * ks); bf[i] = *(const bf16x8*)(bp + (size_t)16 * i * 512 + 32 * ks); }
#pragma unroll
            for (int i = 0; i < 4; ++i)
#pragma unroll
                for (int j = 0; j < 4; ++j) acc[i][j] = mfma16(af[i], bf[j], acc[i][j]); }
#pragma unroll
        for (int i = 0; i < 4; ++i)
#pragma unroll
            for (int j = 0; j < 4; ++j) *(f32x4*)(SS + ((size_t)g * 384 + 64 * cq + 16 * j + fr) * 256 + 64 * og + 16 * i + 4 * fq) = acc[i][j];
    }
}
__device__ __forceinline__ void s5_scan_phase(const Args& a, int layer, int gw, int ngw, int lane_) {
    int lane = lane_; asm volatile("" : "+v"(lane));
    const float* SS = (const float*)(a.ws + WS_S5SS); bf16_t* HS = (bf16_t*)(a.ws + WS_S5HS); const float* S5AP = (const float*)(a.ws + WS_S5AP) + (size_t)layer * 32 * 2 * 64 * 2;
    for (int task = gw; task < 1280; task += ngw) {
        int sq, g, dir; if (task < 256) { sq = 16 + (task >> 6); g = (task >> 1) & 31; dir = task & 1; } else { const int t2 = task - 256; sq = t2 >> 6; g = (t2 >> 1) & 31; dir = t2 & 1; }
        const int lat = sq >= 16, b = lat ? sq - 16 : sq, nc = lat ? 64 : 8, cg0 = lat ? 128 + b * 64 : b * 8;
        const float apr = S5AP[((g * 2 + dir) * 64 + lane) * 2], api = S5AP[((g * 2 + dir) * 64 + lane) * 2 + 1];
        float hr = 0.f, hi = 0.f;
        if (lat) { const size_t so = ((((size_t)b * DEPTH + layer) * 2 + dir) * 32 + g) * 64 + lane; hr = a.in[4][so]; hi = a.in[5][so]; }
        for (int s0 = 0; s0 < nc; s0 += 8) {
            float sr[8], si[8];
#pragma unroll
            for (int q = 0; q < 8; ++q) { const int cg = cg0 + (dir ? nc - 1 - (s0 + q) : s0 + q); const size_t base = ((size_t)g * 384 + cg) * 256 + dir * 128; sr[q] = SS[base + lane]; si[q] = SS[base + 64 + lane]; }
#pragma unroll
            for (int q = 0; q < 8; ++q) { const int cg = cg0 + (dir ? nc - 1 - (s0 + q) : s0 + q); const size_t base = ((size_t)g * 384 + cg) * 256 + dir * 128;
                HS[base + lane] = f2bf(hr); HS[base + 64 + lane] = f2bf(hi);
                const float t = apr * hr - api * hi + sr[q]; hi = apr * hi + api * hr + si[q]; hr = t; }
        }
        if (!lat) { const size_t oo = ((((size_t)b * DEPTH + layer) * 2 + dir) * 32 + g) * 64 + lane; a.out[O_S5R + oo] = hr; a.out[O_S5I + oo] = hi; }
    }
}
__device__ __forceinline__ void s5_out_phase(const Args& a, int layer, int gw, int ngw, int lane_) {
    int lane = lane_; asm volatile("" : "+v"(lane));
    const int fr = lane & 15, fq = lane >> 4;
    const bf16_t* UP = (const bf16_t*)(a.ws + WS_S5UP); const bf16_t* S5W = (const bf16_t*)(a.ws + WS_S5W) + (size_t)layer * 32 * 512 * S5K; const bf16_t* HS = (const bf16_t*)(a.ws + WS_S5HS); bf16_t* ZB = (bf16_t*)(a.ws + WS_ZB);
    for (int it = ngw - 1 - gw; it < 32 * 48; it += ngw) { const int g = it / 48, r = it % 48, og = r / 6, cq = r % 6;
        f32x4 acc[4][4];
#pragma unroll
        for (int i = 0; i < 4; ++i)
#pragma unroll
            for (int j = 0; j < 4; ++j) acc[i][j] = (f32x4){0.f, 0.f, 0.f, 0.f};
        const bf16_t* ap = S5W + ((size_t)g * 512 + 64 * og + fr) * S5K + 8 * fq;
        const bf16_t* bp = UP + ((size_t)g * 384 + 64 * cq + fr) * 512 + 8 * fq; const bf16_t* hp = HS + ((size_t)g * 384 + 64 * cq + fr) * 256 + 8 * fq;
#pragma unroll 2
        for (int ks = 0; ks < 16; ++ks) { bf16x8 af[4], bf[4];
#pragma unroll
            for (int i = 0; i < 4; ++i) { af[i] = *(const bf16x8*)(ap + (size_t)16 * i * S5K + 32 * ks); bf[i] = *(const bf16x8*)(bp + (size_t)16 * i * 512 + 32 * ks); }
#pragma unroll
            for (int i = 0; i < 4; ++i)
#pragma unroll
                for (int j = 0; j < 4; ++j) acc[i][j] = mfma16(af[i], bf[j], acc[i][j]); }
#pragma unroll 2
        for (int ks = 0; ks < 8; ++ks) { bf16x8 af[4], bf[4];
#pragma unroll
            for (int i = 0; i < 4; ++i) { af[i] = *(const bf16x8*)(ap + (size_t)16 * i * S5K + 512 + 32 * ks); bf[i] = *(const bf16x8*)(hp + (size_t)16 * i * 256 + 32 * ks); }
#pragma unroll
            for (int i = 0; i < 4; ++i)
#pragma unroll
                for (int j = 0; j < 4; ++j) acc[i][j] = mfma16(af[i], bf[j], acc[i][j]); }
#pragma unroll
        for (int i = 0; i < 4; ++i)
#pragma unroll
            for (int j = 0; j < 4; ++j) { float z[4];
#pragma unroll
                for (int e = 0; e < 4; ++e) { const float x = acc[i][j][e]; const float th = 0.7978845608028654f * (x + 0.044715f * x * x * x); const float e2 = __expf(2.f * th); const float tnh = 1.f - 2.f * __builtin_amdgcn_rcpf(e2 + 1.f); z[e] = 0.5f * x * (1.f + tnh); }
                u32x2 w; w.x = pk2(z[0], z[1]); w.y = pk2(z[2], z[3]);
                *(u32x2*)(ZB + (size_t)(32 * (64 * cq + 16 * j + fr) + 4 * og + i) * 512 + g * 16 + 4 * fq) = w; }
    }
}
}
namespace mk { static_assert(WS_S5_END < (size_t)1780 * 1024 * 1024, "workspace map exceeds the guaranteed size"); }
namespace mk {
#ifndef PHMASK
#define PHMASK 0xfffff
#endif
#define PHM(k) ((PHMASK >> (k)) & 1)
#ifndef DUPMASK
#define DUPMASK 0
#endif
#define DUP(k) ((DUPMASK >> (k)) & 1)
constexpr int NPH = 12;
constexpr int PH_TOTAL = 2 + DEPTH * NPH;
__global__ void __launch_bounds__(NT, 2) mk_fwd(Args a) {
    extern __shared__ __attribute__((aligned(16))) unsigned char lds_raw[];
    LAS unsigned char* lds = (LAS unsigned char*)lds_raw;
#define TID ((int)threadIdx.x)
#define LANE ((int)(threadIdx.x & 63))
#define WAVE (__builtin_amdgcn_readfirstlane((int)(threadIdx.x >> 6)))
#define GW ((int)blockIdx.x * NWV + WAVE)
    const int G = gridDim.x, ngw = G * NWV;
    volatile LAS unsigned* ctlw = (volatile LAS unsigned*)(lds + LDS_CTL);
    if (TID < 64) ctlw[TID] = 0u;
    __syncthreads();
    XcdBarrier bar = xcd_barrier_post((unsigned*)(a.ws + WS_CTL), ctlw);
    if (TPROBE >= 0 && TID == 0) { const unsigned long long t_ = wall_clock64(); ctlw[16] = (unsigned)t_; ctlw[17] = (unsigned)(t_ >> 32); }
    const int lo = a.ph_lo, hi = a.ph_hi;
#define IN(k) (lo <= (k) && (k) < hi)
#ifndef TPROBE
#define TPROBE -1
#endif
#define TSTAMP(kind) do { if (TPROBE >= 0 && blockIdx.x == 0 && TID == 0) { const unsigned long long t_ = wall_clock64(); const unsigned long long p_ = ((unsigned long long)ctlw[17] << 32) | ctlw[16]; \
    volatile LAS float* ta_ = (volatile LAS float*)(ctlw + 24); ta_[kind] = ta_[kind] + (float)(t_ - p_); ctlw[16] = (unsigned)t_; ctlw[17] = (unsigned)(t_ >> 32); } } while (0)
#define SEAM(k) do { if (IN(k) && IN((k) + 1)) { xcd_barrier(bar); if (DUP(13)) xcd_barrier(bar); TSTAMP((k) == 0 ? 0 : 1 + ((k) - 1) % NPH); } } while (0)
#define H ((bf16_t*)(a.ws + WS_H))
#define PROJ ((bf16_t*)(a.ws + WS_PROJ))
#define SMALL ((float*)(a.ws + WS_SMALL))
#define BR ((bf16_t*)(a.ws + WS_BR))
#define MERGED ((bf16_t*)(a.ws + WS_MERGED))
#define MACC ((float*)(a.ws + WS_MACC))
#define ZB ((bf16_t*)(a.ws + WS_ZB))
#define HID ((bf16_t*)(a.ws + WS_PROJ))
#define MOD ((const float*)(a.ws + WS_MOD))
#define X (a.out)
    if (PHM(0) && IN(0)) {
        for (int rep_ = 0; rep_ < 1 + DUP(17); ++rep_) {
        unsigned* qhead = (unsigned*)(a.ws + WS_CTL) + 8192 + 64 * rep_;
        volatile LAS unsigned* qitem = ctlw + 8;
        for (;;) {
            __syncthreads();
            if (TID == 0) qitem[0] = __hip_atomic_fetch_add(qhead, 1u, __ATOMIC_RELAXED, __HIP_MEMORY_SCOPE_AGENT);
            __syncthreads();
            int item = (int)qitem[0];
            if (item >= DEPTH * 32 + PRO_NADA + PRO_NCACHE) break;
            if (item < DEPTH * 32) { s5_param_task(a, lds, TID, item); continue; } item -= DEPTH * 32;
            if (item < PRO_NADA) { prologue_ada_unit(a, lds, TID, item); continue; } item -= PRO_NADA;
            prologue_cache(a, item * NWV + WAVE, PRO_NCACHE * NWV, LANE);
        }
        }
        conv_pull(a, lds, ctlw + 8, 0, -1);
    }
    SEAM(0);
    for (int l = 0; l < DEPTH; ++l) {
        const int pb = 1 + l * NPH;
#define xp (l == 0 ? a.in[0] : X)
#define xs (l == 0 ? a.in[1] : X + (size_t)MP * D)
#define modl (MOD + (size_t)l * 5 * 6 * D)
#define wl ((const bf16_t*)(a.ws + WS_W) + (size_t)l * W_LAYER)
        if (PHM(1) && IN(pb + 0) && l > 0) conv_pull(a, lds, ctlw + 8, l, -1);
        if (PHM(1) && IN(pb + 0)) norm_phase(xp, xs, a.in[14] + l * D, modl, 0, D, H, GW, ngw, LANE, l > 0 ? MACC : nullptr, modl - (size_t)5 * 6 * D, 5 * D, X, xs, a.ws + WS_H8);
        SEAM(pb + 0);
        if (PHM(2) && IN(pb + 1)) {
            { Gemm g8{(const bf16_t*)(a.ws + WS_H8), wl + W_IN8, M, 8192, 1024, 1024, 1, 0, 0}; StaticOrder S; S.init(M, 8192, G, blockIdx.x, 1, 1024);
              EpiInT<true> E{PROJ, SMALL, a.out, a.in[17] + l * 64, a.in[18] + l * 64, l}; gemm_phase(lds, g8, S, E); }
            { Gemm g{H, wl + W_IN, M, 5888, D, D, 1, 0, 0}; StaticOrder S; S.init(M, 5888, G, blockIdx.x, 1, D);
              EpiInT<false> E{PROJ, SMALL, a.out, a.in[17] + l * 64, a.in[18] + l * 64, l}; gemm_phase(lds, g, S, E); }
            if (l + 1 < DEPTH && (int)blockIdx.x >= 80) conv_pull(a, lds, ctlw + 8, l + 1, 1); }
        SEAM(pb + 1);
        if (PHM(3) && IN(pb + 2)) { for (int r_ = 0; r_ < 1 + DUP(0); ++r_) { prep_phase(a, l, lds, GW, ngw, WAVE, LANE, (bf16_t*)(a.ws + WS_S5UP)); __syncthreads(); } }
        SEAM(pb + 2);
        if (PHM(4) && IN(pb + 3)) { for (int r_ = 0; r_ < 1 + DUP(2); ++r_) attn_phase(a, l, GW, ngw, LANE); for (int r_ = 0; r_ < 1 + DUP(3); ++r_) { ml_states_phase(a, l, TID, G); ssd_states_phase(a, l, TID, G); s5_statein_phase(a, l, GW, ngw, LANE); } }
        SEAM(pb + 3);
        if (PHM(5) && IN(pb + 4)) { for (int r_ = 0; r_ < 1 + DUP(4); ++r_) { ml_scan_phase(a, l, TID, G); ssd_scan_phase(a, l, TID, G); s5_scan_phase(a, l, GW, ngw, LANE); } }
        SEAM(pb + 4);
        if (PHM(12) && IN(pb + 5)) { for (int r_ = 0; r_ < 1 + DUP(5); ++r_) ml_out_phase(a, l, GW, ngw, LANE); for (int r_ = 0; r_ < 1 + DUP(6); ++r_) ssd_out_phase(a, l, GW, ngw, LANE); for (int r_ = 0; r_ < 1 + DUP(7); ++r_) s5_out_phase(a, l, GW, ngw, LANE); }
        SEAM(pb + 5);
        if (PHM(6) && IN(pb + 6)) { Gemm g{ZB, wl + W_GLU, M, 512, 512, 512, 1, 0, 0}; StaticOrder S; S.init(M, 512, G, blockIdx.x, 1, 512);
            EpiGlu E{ZB, a.in[29] + l * 512, BR}; for (int r_ = 0; r_ < 1 + DUP(16); ++r_) gemm_phase(lds, g, S, E); ssd_fin_phase(a, l, GW, ngw, LANE); }
        SEAM(pb + 6);
        if (PHM(7) && IN(pb + 7)) { Gemm g{BR, wl + W_BR, M, D, 512, D, 4, 512, (size_t)D * 512}; StaticOrder S; S.init(M, D, G, blockIdx.x, 4, 512);
            EpiBranch E{PROJ, MERGED}; for (int r_ = 0; r_ < 1 + DUP(12); ++r_) gemm_phase(lds, g, S, E);
            if (l + 1 < DEPTH && (int)blockIdx.x >= 128) conv_pull(a, lds, ctlw + 8, l + 1, 2); }
        SEAM(pb + 7);
        if (PHM(8) && IN(pb + 8)) { Gemm g{MERGED, wl + W_OUT, M, D, D, D, 1, 0, 0}; SplitOrder S; S.init(blockIdx.x, D);
            EpiResid E{xp, xs, modl, 2 * D, X, MACC}; if (DUP(14)) { EpiResid E2{xp, xs, modl, 2 * D, (float*)(a.ws + WS_PROJ), MACC}; gemm_phase(lds, g, S, E2); } gemm_phase(lds, g, S, E); }
        SEAM(pb + 8);
        if (PHM(9) && IN(pb + 9)) norm_phase(X, X + (size_t)MP * D, a.in[15] + l * D, modl, 3 * D, 4 * D, H, GW, ngw, LANE, MACC, modl, 2 * D, X, xs);
        SEAM(pb + 9);
        if (PHM(10) && IN(pb + 10)) { Gemm g{H, wl + W_1, M, DFF, D, D, 1, 0, 0}; StaticOrder S; S.init(M, DFF, G, blockIdx.x, 1, D);
            EpiRelu2 E{HID, DFF}; for (int r_ = 0; r_ < 1 + DUP(10); ++r_) gemm_phase(lds, g, S, E); }
        SEAM(pb + 10);
        if (PHM(11) && IN(pb + 11)) { Gemm g{HID, wl + W_2, M, D, DFF, DFF, 1, 0, 0}; SplitOrder S; S.init(blockIdx.x, DFF);
            EpiResid E{X, X + (size_t)MP * D, modl, 5 * D, X, MACC}; if (DUP(15)) { EpiResid E2{X, X + (size_t)MP * D, modl, 5 * D, (float*)(a.ws + WS_BR), MACC}; gemm_phase(lds, g, S, E2); } gemm_phase(lds, g, S, E); }
        SEAM(pb + 11);
    }
    if (IN(1 + DEPTH * NPH)) final_fix_phase(MACC, MOD + (size_t)(DEPTH - 1) * 5 * 6 * D, 5 * D, X, GW, ngw, LANE);
    if (TPROBE >= 0) { xcd_barrier(bar); TSTAMP(13); if (blockIdx.x == 0 && TID == 0) { volatile LAS float* ta_ = (volatile LAS float*)(ctlw + 24); float tot_ = 0.f; for (int q_ = 0; q_ < 14; ++q_) tot_ += ta_[q_]; a.out[0] = (TPROBE == 99 ? tot_ : ta_[TPROBE]) * 10.f; } }
#undef IN
#undef SEAM
#undef H
#undef PROJ
#undef SMALL
#undef BR
#undef MERGED
#undef MACC
#undef ZB
#undef HID
#undef MOD
#undef X
#undef xp
#undef xs
#undef modl
#undef wl
}
}
extern "C" void kernel_launch(void* const* d_in, const int* in_sizes, int n_in, void* d_out, int out_size, void* d_ws, size_t ws_size, hipStream_t stream) {
    static int grid = 0;
    if (grid == 0) {
        int dev = 0, cus = 0; (void)hipGetDevice(&dev); (void)hipDeviceGetAttribute(&cus, hipDeviceAttributeMultiprocessorCount, dev);
        (void)hipFuncSetAttribute((const void*)mk::mk_fwd, hipFuncAttributeMaxDynamicSharedMemorySize, mk::LDS_BYTES);
        int per_cu = 0; (void)hipOccupancyMaxActiveBlocksPerMultiprocessor(&per_cu, (const void*)mk::mk_fwd, mk::NT, mk::LDS_BYTES); (void)hipGetLastError();
        (void)cus; grid = 256;
    }
    mk::Args a{}; for (int i = 0; i < 43; ++i) a.in[i] = (const float*)d_in[i];
    a.out = (float*)d_out; a.ws = (unsigned char*)d_ws; a.ph_lo = 0; a.ph_hi = mk::PH_TOTAL;
    (void)hipMemsetAsync(a.ws + mk::WS_CTL, 0, mk::CTL_BYTES, stream);
    hipLaunchKernelGGL(mk::mk_fwd, dim3(grid), dim3(mk::NT), mk::LDS_BYTES, stream, a);
}
```

```cpp
#define SAFE_GEMM 0
#define DUPMASK 0
#define TPROBE -1
#include <hip/hip_runtime.h>
#include <math.h>
namespace mk {
#define LAS __attribute__((address_space(3)))
typedef unsigned short bf16_t;
typedef short bf16x8 __attribute__((ext_vector_type(8)));
typedef float f32x4 __attribute__((ext_vector_type(4)));
typedef float f32x2 __attribute__((ext_vector_type(2)));
typedef unsigned u32x4 __attribute__((ext_vector_type(4)));
typedef unsigned u32x2 __attribute__((ext_vector_type(2)));
typedef int v4i32 __attribute__((ext_vector_type(4)));
typedef int v8i32 __attribute__((ext_vector_type(8)));
constexpr int NT = 512, NWV = 8;
constexpr int D = 2048, MP = 4096, MLAT = 8192, M = MP + MLAT, DEPTH = 4, DFF = 8192;
constexpr int PJ = 13824;
constexpr int NIN = 14080;
constexpr int P_Q = 0, P_K = 512, P_V = 1024, P_S5U = 1536, P_Z = 2048, P_XBC = 2560, P_MQ = 3584, P_MK = 4096, P_MV = 4608, P_MO = 5120, P_GATE = 5632;
constexpr int S_DT = 0, S_MI = 16, S_MF = 24;

typedef __bf16 bf16x2_t __attribute__((ext_vector_type(2)));
__device__ __forceinline__ unsigned pk2(float lo, float hi) { f32x2 v = {lo, hi}; bf16x2_t b = __builtin_convertvector(v, bf16x2_t); return __builtin_bit_cast(unsigned, b); }
__device__ __forceinline__ float bf2f(bf16_t v) { return __uint_as_float(((unsigned)v) << 16); }
__device__ __forceinline__ float bflo(unsigned w) { return __uint_as_float(w << 16); }
__device__ __forceinline__ float bfhi(unsigned w) { return __uint_as_float(w & 0xffff0000u); }
__device__ __forceinline__ bf16_t f2bf(float f) { return (bf16_t)(pk2(f, 0.f) & 0xffffu); }
__device__ __forceinline__ float fsigm(float x) { return __builtin_amdgcn_rcpf(1.f + __expf(-x)); }
__device__ __forceinline__ float fsilu(float x) { return x * fsigm(x); }
__device__ __forceinline__ int row_cvec(int row) { return row < MP ? 0 : 1 + (row - MP) / 2048; }

#define XB_TMO      128
#define XB_XCNT(j)  (256  + 64 * (j))
#define XB_XSUB(j)  (1280 + 64 * (j))
#define XB_XGEN(j)  (2304 + 64 * (j))
#define XB_TOP      3328
#define XB_TOPGEN   3392
#define XCD_BAR_WORDS 3456
#define XB_SPIN_CAP (1u << 18)
__device__ __forceinline__ unsigned xb_ld(unsigned* p)              { return __hip_atomic_load(p, __ATOMIC_RELAXED, __HIP_MEMORY_SCOPE_AGENT); }
__device__ __forceinline__ unsigned xb_add(unsigned* p, unsigned v) { return __hip_atomic_fetch_add(p, v, __ATOMIC_RELAXED, __HIP_MEMORY_SCOPE_AGENT); }
__device__ __forceinline__ unsigned xb_xcc_id() { return (unsigned)__builtin_amdgcn_s_getreg((3 << 11) | 20) & 0xFu; }
#define XB_SPIN(cond, bar) do { unsigned _sp = 0; while (cond) { __builtin_amdgcn_s_sleep(1); \
    if ((++_sp & 255u) == 0u) { if (xb_ld(&(bar)[XB_TMO])) break; if (_sp > XB_SPIN_CAP) { atomicAdd(&(bar)[XB_TMO], 1u); break; } } } } while (0)
struct XcdBarrier { unsigned* bar; unsigned x; volatile LAS unsigned* st; };
__device__ __forceinline__ XcdBarrier xcd_barrier_post(unsigned* bar, volatile LAS unsigned* st) {
    XcdBarrier b; b.bar = bar; b.x = xb_xcc_id(); b.st = st;
    if (threadIdx.x == 0) (void)xb_add(&bar[XB_XCNT(b.x)], 1u);
    return b;
}
__device__ __forceinline__ void xcd_barrier_complete(unsigned* bar, unsigned x, unsigned& nloc, unsigned& nx) {
    const unsigned G = gridDim.x * gridDim.y * gridDim.z;
    unsigned sum, cnt, mine, sp = 0u;
    for (;;) {
        sum = 0u; cnt = 0u; mine = 0u;
#pragma unroll
        for (unsigned j = 0; j < 16; ++j) { const unsigned c = xb_ld(&bar[XB_XCNT(j)]); sum += c; cnt += (c > 0u) ? 1u : 0u; mine = (j == x) ? c : mine; }
        if (sum == G) break;
        __builtin_amdgcn_s_sleep(1);
        if ((++sp & 255u) == 0u) { if (xb_ld(&bar[XB_TMO])) break; if (sp > XB_SPIN_CAP) { atomicAdd(&bar[XB_TMO], 1u); break; } }
    }
    nloc = mine > 0u ? mine : 1u; nx = cnt > 0u ? cnt : 1u;
}
__device__ __forceinline__ void xcd_barrier(const XcdBarrier& b) {
    asm volatile("s_waitcnt vmcnt(0)" ::: "memory");
    __syncthreads();
    if (threadIdx.x == 0) {
        unsigned* bar = b.bar;
        __builtin_amdgcn_s_waitcnt(0);
        unsigned nloc = b.st[0], nx = b.st[1];
        if (nloc == 0u) { xcd_barrier_complete(bar, b.x, nloc, nx); b.st[0] = nloc; b.st[1] = nx; }
        const unsigned old = xb_add(&bar[XB_XSUB(b.x)], 1u);
        const unsigned gen = old / nloc;
        if (old + 1u == (gen + 1u) * nloc) {
            __builtin_amdgcn_fence(__ATOMIC_RELEASE, "agent");
            asm volatile("s_waitcnt vmcnt(0)" ::: "memory");
            const unsigned og = xb_add(&bar[XB_TOP], 1u);
            const unsigned tg = og / nx;
            if (og + 1u == (tg + 1u) * nx) xb_add(&bar[XB_TOPGEN], 1u);
            else XB_SPIN(xb_ld(&bar[XB_TOPGEN]) == tg, bar);
            __builtin_amdgcn_fence(__ATOMIC_ACQUIRE, "agent");
            xb_add(&bar[XB_XGEN(b.x)], 1u);
            asm volatile("s_waitcnt vmcnt(0)" ::: "memory");
        } else {
            XB_SPIN(xb_ld(&bar[XB_XGEN(b.x)]) == gen, bar);
            __builtin_amdgcn_fence(__ATOMIC_ACQUIRE, "agent");
            asm volatile("s_waitcnt vmcnt(0)" ::: "memory");
        }
    }
    __syncthreads();
}

#ifndef GEMM_SP2
#define GEMM_SP2 1
#endif
#ifndef GEMM_ALIGN
#define GEMM_ALIGN 1
#endif
constexpr int BM = 256, BK = 64, HALF = 128, HTB = HALF * BK * 2, STAGE_BYTES = 8 * HTB, NXCD = 8, WGM = 8;
__host__ __device__ __forceinline__ int lds_byte(int r, int c) { const int st = (r >> 4) * 2 + (c >> 5), rr = r & 15, cc = c & 31, ob = rr * 64 + cc * 2; return st * 1024 + (ob ^ (((ob >> 9) & 1) << 5)); }
__host__ __device__ __forceinline__ void stage_rc(int b, int& R, int& C) { const int st = b / 1024, sb = b % 1024, swz = sb ^ (((sb >> 9) & 1) << 5); R = (st >> 1) * 16 + swz / 64; C = (st & 1) * 32 + (swz % 64) / 2; }
__host__ __device__ __forceinline__ int perm32(int rho) { const int n = rho >> 4, i = rho & 15; return 8 * (i >> 2) + 4 * n + (i & 3); }

struct Unit { int pm, pn, kz, koff, nt; };
struct Gemm { const bf16_t* A; const bf16_t* Bt; int M, N, K, lda, nkz; size_t a_kz, b_kz; };

struct StaticOrder {
    int nM, nN, nwg, G, c, nkz;
    int ntk;
    __device__ void init(int M_, int N_, int G_, int c_, int nkz_ = 1, int K_ = 0) { nM = M_ / BM; nN = N_ / BM; nwg = nM * nN; G = G_; c = c_; nkz = nkz_; ntk = K_ / BK; }
    __device__ bool next(int i, Unit& u) const {
        const int it = i / nkz; u.kz = i - it * nkz; u.koff = 0; u.nt = ntk;
        const long L = (long)it * G + c; if (L >= nwg) return false;
        int wgid = (int)L; { const int q = nwg / NXCD, r = nwg % NXCD, xcd = wgid % NXCD, off = wgid / NXCD; wgid = (xcd < r ? xcd * (q + 1) : r * (q + 1) + (xcd - r) * q) + off; }
        const int nig = WGM * nN, gid = wgid / nig, fm = gid * WGM, gsz = (nM - fm) < WGM ? (nM - fm) : WGM;
        u.pm = fm + ((wgid % nig) % gsz); u.pn = (wgid % nig) / gsz; return true;
    }
};

struct SplitOrder {
    int c, ntk;
    __device__ void init(int c_, int K_) { c = c_; ntk = K_ / BK; }
    __device__ bool next(int i, Unit& u) const {
        const int xcd = c & 7, idx = c >> 3;
        if (i == 0) { u.pm = xcd * 4 + (idx >> 3); u.pn = idx & 7; u.kz = 0; u.koff = 0; u.nt = ntk; return true; }
        if (i == 1) { const int t = idx >> 1; u.pm = 32 + xcd * 2 + (t >> 3); u.pn = t & 7; u.kz = 0; u.nt = ntk >> 1; u.koff = (idx & 1) * (ntk >> 1) * BK; return true; }
        return false;
    }
};

template <class Epi, class Sched>
__device__ __forceinline__ void gemm_phase(LAS unsigned char* lds, const Gemm g, const Sched& S, const Epi& E) {
    int tid_ = threadIdx.x; asm volatile("" : "+v"(tid_));
    const int tid = tid_, wid = __builtin_amdgcn_readfirstlane(tid >> 6), lane = tid & 63, wr = wid >> 2, wc = wid & 3, fr = lane & 15, fq = lane >> 4;
    const int K = g.K;
    unsigned voffA[2], voffB[2];
#pragma unroll
    for (int i = 0; i < 2; ++i) { int R, C; stage_rc(tid * 16 + i * 8192, R, C); const int Rb = Epi::PERM ? ((R & ~31) + perm32(R & 31)) : R;
        voffA[i] = (unsigned)(R * g.lda + C) * 2u; voffB[i] = (unsigned)(Rb * K + C) * 2u; }
    const size_t kstep = (size_t)(BK * 2);
    const size_t hstepA = (size_t)HALF * g.lda * 2, hstepB = (size_t)HALF * K * 2;
    const size_t tstepA = 2 * hstepA, tstepB = 2 * hstepB;
    const unsigned ldsw = (unsigned)wid * 1024u;
    const int aoff = lds_byte(wr * 64 + fr, fq * 8), boff = lds_byte(wc * 32 + fr, fq * 8);
#define PG8_SA(b, h) (((b) * 2 + (h)) * HTB)
#define PG8_SB(b, h) ((4 + (b) * 2 + (h)) * HTB)
#define PG8_STAGE(bufoff, gbase, voff) do { _Pragma("unroll") for (int _i = 0; _i < 2; ++_i) \
        __builtin_amdgcn_global_load_lds((const unsigned*)((const char*)(gbase) + (voff)[_i]), (LAS unsigned*)(lds + (bufoff) + ldsw + _i * 8192), 16, 0, 0); } while (0)
#define PG8_LDA(dst, b, h) do { if constexpr (Epi::MODE == 1) { _Pragma("unroll") for (int m = 0; m < 4; ++m) dst##8[m] = __builtin_shufflevector(*(const LAS v4i32*)(lds + PG8_SA(b, h) + aoff + m * 2048), *(const LAS v4i32*)(lds + PG8_SA(b, h) + aoff + m * 2048 + 1024), 0, 1, 2, 3, 4, 5, 6, 7); } \
        else { _Pragma("unroll") for (int m = 0; m < 4; ++m) _Pragma("unroll") for (int k = 0; k < 2; ++k) dst[m][k] = *(const LAS bf16x8*)(lds + PG8_SA(b, h) + aoff + m * 2048 + k * 1024); } } while (0)
#define PG8_LDB(dst, b, h) do { if constexpr (Epi::MODE == 1) { _Pragma("unroll") for (int n = 0; n < 2; ++n) dst##8[n] = __builtin_shufflevector(*(const LAS v4i32*)(lds + PG8_SB(b, h) + boff + n * 2048), *(const LAS v4i32*)(lds + PG8_SB(b, h) + boff + n * 2048 + 1024), 0, 1, 2, 3, 4, 5, 6, 7); } \
        else { _Pragma("unroll") for (int n = 0; n < 2; ++n) _Pragma("unroll") for (int k = 0; k < 2; ++k) dst[n][k] = *(const LAS bf16x8*)(lds + PG8_SB(b, h) + boff + n * 2048 + k * 1024); } } while (0)
#define PG8_MMA_BF16(ai, bj, At, Bt) do { __builtin_amdgcn_s_setprio(1); _Pragma("unroll") for (int m = 0; m < 4; ++m) _Pragma("unroll") for (int n = 0; n < 2; ++n) _Pragma("unroll") for (int k = 0; k < 2; ++k) \
        acc[ai][bj][m][n] = __builtin_amdgcn_mfma_f32_16x16x32_bf16(Bt[n][k], At[m][k], acc[ai][bj][m][n], 0, 0, 0); __builtin_amdgcn_s_setprio(0); } while (0)
#define PG8_MMA_FP8(ai, bj, At, Bt) do { __builtin_amdgcn_s_setprio(1); _Pragma("unroll") for (int m = 0; m < 4; ++m) _Pragma("unroll") for (int n = 0; n < 2; ++n) \
        asm volatile("v_mfma_scale_f32_16x16x128_f8f6f4 %0, %1, %2, %0, %3, %3 op_sel_hi:[0,0,0]" : "+v"(acc[ai][bj][m][n]) : "v"(Bt##8[n]), "v"(At##8[m]), "v"(f8scale)); __builtin_amdgcn_s_setprio(0); } while (0)
#define PG8_F8_SETTLE() do { if constexpr (Epi::MODE == 1) asm volatile("s_nop 15\n\ts_nop 15" ::: "memory"); } while (0)
#define PG8_MMA_I8(ai, bj, At, Bt) do { __builtin_amdgcn_s_setprio(1); _Pragma("unroll") for (int m = 0; m < 4; ++m) _Pragma("unroll") for (int n = 0; n < 2; ++n) _Pragma("unroll") for (int k = 0; k < 2; ++k) \
        acc[ai][bj][m][n] = __builtin_bit_cast(f32x4, __builtin_amdgcn_mfma_i32_16x16x64_i8(__builtin_bit_cast(v4i32, Bt[n][k]), __builtin_bit_cast(v4i32, At[m][k]), __builtin_bit_cast(v4i32, acc[ai][bj][m][n]), 0, 0, 0)); __builtin_amdgcn_s_setprio(0); } while (0)
#define PG8_MMA(ai, bj, At, Bt) do { if constexpr (Epi::MODE == 1) PG8_MMA_FP8(ai, bj, At, Bt); else if constexpr (Epi::MODE == 2) PG8_MMA_I8(ai, bj, At, Bt); else PG8_MMA_BF16(ai, bj, At, Bt); } while (0)
#if SAFE_GEMM == 1 || SAFE_GEMM == 3
#define PG8_WAIT_V(n) asm volatile("s_waitcnt vmcnt(0)" ::: "memory")
#else
#define PG8_WAIT_V(n) asm volatile("s_waitcnt vmcnt(" #n ")" ::: "memory")
#endif
#define PG8_WAIT_L(n) asm volatile("s_waitcnt lgkmcnt(" #n ")" ::: "memory")
#if SAFE_GEMM == 1
#define PG8_BAR do { asm volatile("s_waitcnt vmcnt(0) lgkmcnt(0)" ::: "memory"); __builtin_amdgcn_s_barrier(); asm volatile("" ::: "memory"); } while (0)
#elif SAFE_GEMM == 2
#define PG8_BAR asm volatile("s_barrier" ::: "memory")
#elif SAFE_GEMM == 4
#define PG8_BAR do { asm volatile("s_waitcnt lgkmcnt(0)" ::: "memory"); __builtin_amdgcn_s_barrier(); } while (0)
#else
#define PG8_BAR __builtin_amdgcn_s_barrier()
#endif
#define PG8_SCHED __builtin_amdgcn_sched_barrier(0)
    Unit cur, nxt; int ui = 0;
    if (!S.next(0, cur)) return;
    f32x4 acc[2][2][4][2];
#pragma unroll
    for (int a = 0; a < 2; ++a)
#pragma unroll
        for (int b = 0; b < 2; ++b)
#pragma unroll
            for (int m = 0; m < 4; ++m)
#pragma unroll
                for (int n = 0; n < 2; ++n) acc[a][b][m][n] = (f32x4){0.f, 0.f, 0.f, 0.f};
    bf16x8 At[4][2], B0[2][2], B1[2][2]; v8i32 At8[4], B08[2], B18[2];
    int f8scale = 0x7f7f7f7f; asm volatile("" : "+v"(f8scale));
    const char* cA = (const char*)(g.A + (size_t)cur.kz * g.a_kz + cur.koff) + (size_t)cur.pm * tstepA; const char* cB = (const char*)(g.Bt + (size_t)cur.kz * g.b_kz + cur.koff) + (size_t)cur.pn * tstepB;
#if GEMM_SP2
    PG8_STAGE(PG8_SB(0, 0), cB, voffB); PG8_STAGE(PG8_SB(0, 1), cB + hstepB, voffB); PG8_STAGE(PG8_SA(0, 0), cA, voffA); PG8_STAGE(PG8_SA(0, 1), cA + hstepA, voffA);
    if (wr == 1) PG8_BAR;
    PG8_WAIT_V(2); PG8_BAR;
    PG8_STAGE(PG8_SB(1, 0), cB + kstep, voffB); PG8_STAGE(PG8_SA(1, 0), cA + kstep, voffA); PG8_STAGE(PG8_SB(1, 1), cB + hstepB + kstep, voffB);
    PG8_WAIT_V(6); PG8_BAR;
#else
    PG8_STAGE(PG8_SB(0, 0), cB, voffB); PG8_STAGE(PG8_SA(0, 0), cA, voffA); PG8_STAGE(PG8_SB(0, 1), cB + hstepB, voffB); PG8_STAGE(PG8_SA(0, 1), cA + hstepA, voffA);
    if (wr == 1) PG8_BAR;
    PG8_WAIT_V(4); PG8_BAR;
    PG8_STAGE(PG8_SB(1, 0), cB + kstep, voffB); PG8_STAGE(PG8_SA(1, 0), cA + kstep, voffA); PG8_STAGE(PG8_SB(1, 1), cB + hstepB + kstep, voffB);
    PG8_WAIT_V(6); PG8_BAR;
#endif
    for (;;) {
        const bool has_next = S.next(ui + 1, nxt);
        const char* nA = has_next ? (const char*)(g.A + (size_t)nxt.kz * g.a_kz + nxt.koff) + (size_t)nxt.pm * tstepA : cA;
        const char* nB = has_next ? (const char*)(g.Bt + (size_t)nxt.kz * g.b_kz + nxt.koff) + (size_t)nxt.pn * tstepB : cB;
        const int nt = cur.nt;
        for (int t = 0; t < nt; t += 2) {
            const bool last = (t == nt - 2);
            const char* a1 = cA + (size_t)(t + 1) * kstep;
            const char* a2 = last ? nA : cA + (size_t)(t + 2) * kstep; const char* b2 = last ? nB : cB + (size_t)(t + 2) * kstep;
            const char* a3 = a2 + kstep; const char* b3 = b2 + kstep;
#if GEMM_SP2
            PG8_LDB(B0, 0, 0); PG8_LDB(B1, 0, 1); PG8_SCHED; PG8_LDA(At, 0, 0); PG8_STAGE(PG8_SA(1, 1), a1 + hstepA, voffA);
            PG8_WAIT_V(8); PG8_WAIT_L(0); PG8_BAR; PG8_MMA(0, 0, At, B0); PG8_MMA(0, 1, At, B1); PG8_BAR; PG8_SCHED;
            PG8_LDA(At, 0, 1); PG8_STAGE(PG8_SB(0, 0), b2, voffB); PG8_STAGE(PG8_SB(0, 1), b2 + hstepB, voffB); PG8_STAGE(PG8_SA(0, 0), a2, voffA);
            PG8_WAIT_V(8); PG8_WAIT_L(0); PG8_BAR; PG8_MMA(1, 0, At, B0); PG8_MMA(1, 1, At, B1); PG8_BAR; PG8_SCHED;
            PG8_LDB(B0, 1, 0); PG8_LDB(B1, 1, 1); PG8_SCHED; PG8_LDA(At, 1, 0); PG8_STAGE(PG8_SA(0, 1), a2 + hstepA, voffA);
            PG8_WAIT_V(8); PG8_WAIT_L(0); PG8_BAR; PG8_MMA(0, 0, At, B0); PG8_MMA(0, 1, At, B1); PG8_BAR; PG8_SCHED;
            PG8_LDA(At, 1, 1); PG8_STAGE(PG8_SB(1, 0), b3, voffB); PG8_STAGE(PG8_SB(1, 1), b3 + hstepB, voffB); PG8_STAGE(PG8_SA(1, 0), a3, voffA);
            PG8_WAIT_V(8); PG8_WAIT_L(0); PG8_BAR; PG8_MMA(1, 0, At, B0); PG8_MMA(1, 1, At, B1); PG8_BAR; PG8_SCHED;
#else
            PG8_LDB(B0, 0, 0); PG8_SCHED; PG8_LDA(At, 0, 0); PG8_STAGE(PG8_SA(1, 1), a1 + hstepA, voffA);
            PG8_WAIT_L(8); PG8_BAR; PG8_WAIT_L(0); PG8_MMA(0, 0, At, B0); PG8_BAR; PG8_SCHED;
            PG8_LDB(B1, 0, 1); PG8_STAGE(PG8_SB(0, 0), b2, voffB);
            PG8_BAR; PG8_WAIT_L(0); PG8_MMA(0, 1, At, B1); PG8_BAR;
            PG8_LDA(At, 0, 1); PG8_STAGE(PG8_SA(0, 0), a2, voffA);
            PG8_BAR; PG8_WAIT_L(0); PG8_MMA(1, 0, At, B0); PG8_BAR; PG8_SCHED;
            PG8_STAGE(PG8_SB(0, 1), b2 + hstepB, voffB);
            PG8_WAIT_V(6); PG8_BAR; PG8_MMA(1, 1, At, B1); PG8_BAR;
            PG8_LDB(B0, 1, 0); PG8_SCHED; PG8_LDA(At, 1, 0); PG8_STAGE(PG8_SA(0, 1), a2 + hstepA, voffA);
            PG8_WAIT_L(8); PG8_BAR; PG8_WAIT_L(0); PG8_MMA(0, 0, At, B0); PG8_BAR; PG8_SCHED;
            PG8_LDB(B1, 1, 1); PG8_STAGE(PG8_SB(1, 0), b3, voffB);
            PG8_BAR; PG8_WAIT_L(0); PG8_MMA(0, 1, At, B1); PG8_BAR;
            PG8_LDA(At, 1, 1); PG8_STAGE(PG8_SA(1, 0), a3, voffA);
            PG8_BAR; PG8_WAIT_L(0); PG8_MMA(1, 0, At, B0); PG8_BAR; PG8_SCHED;
            PG8_STAGE(PG8_SB(1, 1), b3 + hstepB, voffB);
            PG8_WAIT_V(6); PG8_BAR; PG8_MMA(1, 1, At, B1); PG8_BAR;
#endif
        }
        PG8_F8_SETTLE();
#if GEMM_ALIGN
        if (wr == 0) PG8_BAR;
#endif
        E(acc, cur, wr, wc, fr, fq);
        if (!has_next) break;
        if (nxt.kz == 0) {
#pragma unroll
        for (int a = 0; a < 2; ++a)
#pragma unroll
            for (int b = 0; b < 2; ++b)
#pragma unroll
                for (int m = 0; m < 4; ++m)
#pragma unroll
                    for (int n = 0; n < 2; ++n) acc[a][b][m][n] = (f32x4){0.f, 0.f, 0.f, 0.f};
        }
        cur = nxt; cA = nA; cB = nB; ++ui;
#if GEMM_ALIGN
        if (wr == 1) PG8_BAR;
#endif
    }
    PG8_WAIT_V(0);
#if !GEMM_ALIGN
    if (wr == 0) PG8_BAR;
#endif
    PG8_BAR;
#undef PG8_SA
#undef PG8_SB
#undef PG8_STAGE
#undef PG8_LDA
#undef PG8_LDB
#undef PG8_MMA
#undef PG8_MMA_BF16
#undef PG8_MMA_FP8
#undef PG8_MMA_I8
#undef PG8_F8_SETTLE
#undef PG8_WAIT_V
#undef PG8_WAIT_L
#undef PG8_BAR
#undef PG8_SCHED
}
}
namespace mk {
constexpr size_t O_YP = 0, O_YS = 8388608, O_NK = 25165824, O_NV = 33554432, O_S5R = 41943040, O_S5I = 42205184, O_SSD = 42467328,
                 O_MLC = 50855936, O_MLN = 59244544, O_MLM = 59310080;

__device__ __forceinline__ u32x4 pack8(const f32x4 a, const f32x4 b) { u32x4 w; w.x = pk2(a[0], a[1]); w.y = pk2(a[2], a[3]); w.z = pk2(b[0], b[1]); w.w = pk2(b[2], b[3]); return w; }

template <bool F8> struct EpiInT {
    static constexpr bool PERM = true; static constexpr int MODE = F8 ? 1 : 0;
    bf16_t* proj; float* small; float* out; const float* qg; const float* kg; int layer;
    __device__ __forceinline__ void operator()(f32x4 (&acc)[2][2][4][2], const Unit& u, int wr, int wc, int fr, int fq) const {
        const int T = F8 ? 22 + u.pn : (u.pn == 22 ? 54 : u.pn), rowb = u.pm * BM + wr * 64 + fr;
        if (T == 54) {
            if (wc == 0) {
#pragma unroll
                for (int ai = 0; ai < 2; ++ai)
#pragma unroll
                    for (int m = 0; m < 4; ++m) { float* sp = small + (size_t)(rowb + ai * HALF + m * 16) * 32 + 8 * fq; *(f32x4*)sp = acc[ai][0][m][0]; *(f32x4*)(sp + 4) = acc[ai][0][m][1]; }
            }
            return;
        }
        const int colb = T * 256 + 64 * wc + 8 * fq;
        if (T < 4) {
            const float* g = T < 2 ? qg : kg;
            f32x4 gv[2][2];
#pragma unroll
            for (int bj = 0; bj < 2; ++bj)
#pragma unroll
                for (int n = 0; n < 2; ++n) gv[bj][n] = *(const f32x4*)(g + 32 * bj + 8 * fq + 4 * n);
#pragma unroll
            for (int ai = 0; ai < 2; ++ai)
#pragma unroll
                for (int m = 0; m < 4; ++m) {
                    float ss = 0.f;
#pragma unroll
                    for (int bj = 0; bj < 2; ++bj)
#pragma unroll
                        for (int n = 0; n < 2; ++n) { const f32x4 x = acc[ai][bj][m][n]; ss += (x[0] * x[0] + x[1] * x[1]) + (x[2] * x[2] + x[3] * x[3]); }
                    ss += __shfl_xor(ss, 16); ss += __shfl_xor(ss, 32);
                    const float r = rsqrtf(ss * (1.f / 64.f) + 1e-6f);
                    const int row = rowb + ai * HALF + m * 16;
#pragma unroll
                    for (int bj = 0; bj < 2; ++bj) { const f32x4 v0 = acc[ai][bj][m][0] * r * gv[bj][0], v1 = acc[ai][bj][m][1] * r * gv[bj][1];
                        *(u32x4*)(proj + (size_t)row * PJ + colb + 32 * bj) = pack8(v0, v1);
                        if (T >= 2 && row < MP) { float* o = out + O_NK + ((size_t)((row >> 8) * DEPTH + layer) * 256 + (row & 255)) * 512 + (colb - 512) + 32 * bj; *(f32x4*)o = v0; *(f32x4*)(o + 4) = v1; } }
                }
        } else if (T < 6) {
#pragma unroll
            for (int ai = 0; ai < 2; ++ai)
#pragma unroll
                for (int m = 0; m < 4; ++m) { const int row = rowb + ai * HALF + m * 16;
#pragma unroll
                    for (int bj = 0; bj < 2; ++bj) { const f32x4 v0 = acc[ai][bj][m][0], v1 = acc[ai][bj][m][1];
                        *(u32x4*)(proj + (size_t)row * PJ + colb + 32 * bj) = pack8(v0, v1);
                        if (row < MP) { float* o = out + O_NV + ((size_t)((row >> 8) * DEPTH + layer) * 256 + (row & 255)) * 512 + (colb - 1024) + 32 * bj; *(f32x4*)o = v0; *(f32x4*)(o + 4) = v1; } } }
        } else if (T < 22) {
#pragma unroll
            for (int ai = 0; ai < 2; ++ai)
#pragma unroll
                for (int m = 0; m < 4; ++m) { const int row = rowb + ai * HALF + m * 16;
#pragma unroll
                    for (int bj = 0; bj < 2; ++bj) *(u32x4*)(proj + (size_t)row * PJ + colb + 32 * bj) = pack8(acc[ai][bj][m][0], acc[ai][bj][m][1]); }
        } else {
#pragma unroll
            for (int ai = 0; ai < 2; ++ai)
#pragma unroll
                for (int m = 0; m < 4; ++m) { const int row = rowb + ai * HALF + m * 16;
#pragma unroll
                    for (int bj = 0; bj < 2; ++bj) { f32x4 v0 = acc[ai][bj][m][0], v1 = acc[ai][bj][m][1];
#pragma unroll
                        for (int j = 0; j < 4; ++j) { v0[j] = fsigm(v0[j]); v1[j] = fsigm(v1[j]); }
                        *(u32x4*)(proj + (size_t)row * PJ + colb + 32 * bj) = pack8(v0, v1); } }
        }
    }
};
struct EpiRelu2 {
    static constexpr bool PERM = true; static constexpr int MODE = 2;
    bf16_t* O; int ldo; const float* rsc; const float* cmx;
    __device__ __forceinline__ void operator()(f32x4 (&acc)[2][2][4][2], const Unit& u, int wr, int wc, int fr, int fq) const {
        const int rowb = u.pm * BM + wr * 64 + fr, colb = u.pn * 256 + 64 * wc + 8 * fq;
        {   f32x4 cs[2][2];
#pragma unroll
            for (int bj = 0; bj < 2; ++bj)
#pragma unroll
                for (int n = 0; n < 2; ++n) cs[bj][n] = *(const f32x4*)(cmx + u.pn * 256 + 128 * bj + 32 * wc + 8 * fq + 4 * n) * (1.f / 127.f);
#pragma unroll
            for (int ai = 0; ai < 2; ++ai)
#pragma unroll
                for (int m = 0; m < 4; ++m) { const float rs = rsc[rowb + ai * HALF + m * 16];
#pragma unroll
                    for (int bj = 0; bj < 2; ++bj)
#pragma unroll
                        for (int n = 0; n < 2; ++n) { const v4i32 iv = __builtin_bit_cast(v4i32, acc[ai][bj][m][n]); f32x4 fv; fv[0] = (float)iv[0]; fv[1] = (float)iv[1]; fv[2] = (float)iv[2]; fv[3] = (float)iv[3];
                            acc[ai][bj][m][n] = fv * cs[bj][n] * rs; } }
        }
#pragma unroll
        for (int ai = 0; ai < 2; ++ai)
#pragma unroll
            for (int m = 0; m < 4; ++m) { const int row = rowb + ai * HALF + m * 16;
#pragma unroll
                for (int bj = 0; bj < 2; ++bj) { f32x4 v0 = acc[ai][bj][m][0], v1 = acc[ai][bj][m][1];
#pragma unroll
                    for (int j = 0; j < 4; ++j) { const float a = fmaxf(v0[j], 0.f), b = fmaxf(v1[j], 0.f); v0[j] = a * a; v1[j] = b * b; }
                    *(u32x4*)(O + (size_t)row * ldo + colb + 32 * bj) = pack8(v0, v1); } }
    }
};
struct EpiGlu {
    static constexpr bool PERM = true; static constexpr int MODE = 0;
    const bf16_t* Z; const float* bias; bf16_t* br;
    __device__ __forceinline__ void operator()(f32x4 (&acc)[2][2][4][2], const Unit& u, int wr, int wc, int fr, int fq) const {
        const int rowb = u.pm * BM + wr * 64 + fr, colb = u.pn * 256 + 64 * wc + 8 * fq;
#pragma unroll
        for (int bj = 0; bj < 2; ++bj) { const int c = colb + 32 * bj; const f32x4 b0 = *(const f32x4*)(bias + c), b1 = *(const f32x4*)(bias + c + 4);
#pragma unroll
            for (int ai = 0; ai < 2; ++ai)
#pragma unroll
                for (int m = 0; m < 4; ++m) { const int row = rowb + ai * HALF + m * 16;
                    const u32x4 zz = *(const u32x4*)(Z + (size_t)row * 512 + c);
                    f32x4 v0 = acc[ai][bj][m][0] + b0, v1 = acc[ai][bj][m][1] + b1;
                    v0[0] = bflo(zz.x) * fsigm(v0[0]); v0[1] = bfhi(zz.x) * fsigm(v0[1]); v0[2] = bflo(zz.y) * fsigm(v0[2]); v0[3] = bfhi(zz.y) * fsigm(v0[3]);
                    v1[0] = bflo(zz.z) * fsigm(v1[0]); v1[1] = bfhi(zz.z) * fsigm(v1[1]); v1[2] = bflo(zz.w) * fsigm(v1[2]); v1[3] = bfhi(zz.w) * fsigm(v1[3]);
                    *(u32x4*)(br + (size_t)row * D + 512 + c) = pack8(v0, v1); } }
    }
};
struct EpiBranch {
    static constexpr bool PERM = true; static constexpr int MODE = 0;
    const bf16_t* proj; bf16_t* merged;
    __device__ __forceinline__ void operator()(f32x4 (&acc)[2][2][4][2], const Unit& u, int wr, int wc, int fr, int fq) const {
        const int rowb = u.pm * BM + wr * 64 + fr, colb = u.pn * 256 + 64 * wc + 8 * fq, kz = u.kz;
#pragma unroll
        for (int ai = 0; ai < 2; ++ai)
#pragma unroll
            for (int m = 0; m < 4; ++m) { const int row = rowb + ai * HALF + m * 16;
#pragma unroll
                for (int bj = 0; bj < 2; ++bj) { const int c = colb + 32 * bj;
                    const u32x4 gg = *(const u32x4*)(proj + (size_t)row * PJ + P_GATE + kz * D + c);
                    float g[8] = {bflo(gg.x), bfhi(gg.x), bflo(gg.y), bfhi(gg.y), bflo(gg.z), bfhi(gg.z), bflo(gg.w), bfhi(gg.w)};
                    if (kz < 3) { const u32x4 hh = *(const u32x4*)(proj + (size_t)row * PJ + P_GATE + (kz + 1) * D + c);
                        const float h[8] = {bflo(hh.x), bfhi(hh.x), bflo(hh.y), bfhi(hh.y), bflo(hh.z), bfhi(hh.z), bflo(hh.w), bfhi(hh.w)};
#pragma unroll
                        for (int j = 0; j < 8; ++j) g[j] = g[j] * __builtin_amdgcn_rcpf(fmaxf(h[j], 1e-30f)); }
                    f32x4& v0 = acc[ai][bj][m][0]; f32x4& v1 = acc[ai][bj][m][1];
                    v0[0] *= g[0]; v0[1] *= g[1]; v0[2] *= g[2]; v0[3] *= g[3]; v1[0] *= g[4]; v1[1] *= g[5]; v1[2] *= g[6]; v1[3] *= g[7];
                    if (kz == 3) *(u32x4*)(merged + (size_t)row * D + c) = pack8(v0, v1); } }
    }
};
struct EpiResid {
    static constexpr bool PERM = false; static constexpr int MODE = 0;
    const float* xp; const float* xs; const float* modl; int g_off; float* xout; float* part;
    __device__ __forceinline__ void operator()(f32x4 (&acc)[2][2][4][2], const Unit& u, int wr, int wc, int fr, int fq) const {
        if (part != nullptr && u.pm >= 32) {
            float* P = part + (size_t)((((u.pm - 32) * 8 + u.pn) * 2) + (u.koff != 0)) * 65536 + (size_t)(wr * 64 + fr) * 256 + wc * 32 + 4 * fq;
#pragma unroll
            for (int ai = 0; ai < 2; ++ai)
#pragma unroll
                for (int m = 0; m < 4; ++m)
#pragma unroll
                    for (int bj = 0; bj < 2; ++bj)
#pragma unroll
                        for (int n = 0; n < 2; ++n) *(f32x4*)(P + (size_t)(ai * HALF + m * 16) * 256 + bj * HALF + n * 16) = acc[ai][bj][m][n];
            return;
        }
        const int row0 = u.pm * BM, rowb = row0 + wr * 64 + fr, colb = u.pn * 256 + wc * 32 + 4 * fq;
        const float* xin = row0 < MP ? xp : xs - (size_t)MP * D;
        const float* gate = modl + (size_t)row_cvec(row0) * 6 * D + g_off;
        f32x4 gv[2][2];
#pragma unroll
        for (int bj = 0; bj < 2; ++bj)
#pragma unroll
            for (int n = 0; n < 2; ++n) gv[bj][n] = *(const f32x4*)(gate + colb + bj * HALF + n * 16);
#pragma unroll
        for (int ai = 0; ai < 2; ++ai)
#pragma unroll
            for (int m = 0; m < 4; ++m) { const size_t ro = (size_t)(rowb + ai * HALF + m * 16) * D + colb;
#pragma unroll
                for (int bj = 0; bj < 2; ++bj)
#pragma unroll
                    for (int n = 0; n < 2; ++n) { const size_t o = ro + bj * HALF + n * 16; *(f32x4*)(xout + o) = *(const f32x4*)(xin + o) + gv[bj][n] * acc[ai][bj][m][n]; } }
    }
};
}
namespace mk {
constexpr size_t AL(size_t x) { return (x + 255) & ~(size_t)255; }
constexpr size_t WS_CTL = 0, CTL_BYTES = 36864 + DEPTH * 8192 * 4;
constexpr size_t WS_MOD = WS_CTL + CTL_BYTES;
constexpr size_t WS_W = AL(WS_MOD + (size_t)DEPTH * 5 * 6 * D * 4);
constexpr size_t W_IN = 0, W_GLU = W_IN + (size_t)NIN * D, W_BR = W_GLU + 512 * 512, W_OUT = W_BR + (size_t)4 * D * 512, W_1 = W_OUT + (size_t)D * D, W_2 = W_1 + (size_t)DFF * D,
                 W_LAYER = W_2 + (size_t)D * DFF;
constexpr size_t W_IN8 = (size_t)5888 * D;
constexpr size_t WS_H = AL(WS_W + W_LAYER * 2 * DEPTH);
constexpr size_t WS_PROJ = AL(WS_H + (size_t)M * D * 2);
constexpr size_t WS_SMALL = AL(WS_PROJ + (size_t)M * PJ * 2);
constexpr size_t WS_BR = AL(WS_SMALL + (size_t)M * 32 * 4);
constexpr size_t WS_MERGED = AL(WS_BR + (size_t)M * D * 2);
constexpr size_t WS_MACC = AL(WS_MERGED + (size_t)M * D * 2);
constexpr size_t WS_ZB = AL(WS_MACC + (size_t)M * D * 4);
constexpr size_t WS_H8 = AL(WS_ZB + (size_t)M * 512 * 2);
constexpr size_t WS_RSC = AL(WS_H8 + (size_t)M * D);
constexpr size_t WS_WSC = WS_CTL + 36864;
constexpr size_t WS_SCR = AL(WS_RSC + (size_t)M * 4);
constexpr int LDS_BYTES = 140 * 1024, LDS_CTL = LDS_BYTES - 256;

struct Args { const float* in[43]; float* out; unsigned char* ws; int ph_lo, ph_hi; };

__device__ __forceinline__ float wave_sum(float v) {
#pragma unroll
    for (int o = 1; o < 64; o <<= 1) v += __shfl_xor(v, o);
    return v;
}
#define LDS_WAIT() asm volatile("s_waitcnt lgkmcnt(0)" ::: "memory")

__device__ __forceinline__ void xpose_item(const float* W, int ldw, int k0, int sc, bf16_t* dst, int K, LAS float* scr, int lane, int mode, bool f8 = false, const float* cmax = nullptr) {
    const int n4 = (lane & 7) * 4;
    const int col = mode == 1 ? (n4 < 16 ? 3584 + n4 : 5648 + (n4 - 16)) : sc + n4;
#pragma unroll
    for (int i = 0; i < 8; ++i) { const int kk = (lane >> 3) + 8 * i; f32x4 v = (f32x4){0.f, 0.f, 0.f, 0.f}; if (mode != 2) v = *(const f32x4*)(W + (size_t)(k0 + kk) * ldw + col);
        if (cmax != nullptr) { const f32x4 cm = *(const f32x4*)(cmax + n4);
#pragma unroll
            for (int e = 0; e < 4; ++e) v[e] = rintf(v[e] * (cm[e] > 0.f ? 127.f / cm[e] : 0.f)); }
        scr[kk * 33 + n4] = v[0]; scr[kk * 33 + n4 + 1] = v[1]; scr[kk * 33 + n4 + 2] = v[2]; scr[kk * 33 + n4 + 3] = v[3]; }
    LDS_WAIT(); asm volatile("" ::: "memory");
    const int c = lane & 7;
#pragma unroll
    for (int jj = 0; jj < 4; ++jj) { const int n = (lane >> 3) + 8 * jj; const LAS float* s = scr + (8 * c) * 33 + n;
        if (cmax != nullptr) { const unsigned w0 = ((unsigned)(int)s[0 * 33] & 0xffu) | (((unsigned)(int)s[1 * 33] & 0xffu) << 8) | (((unsigned)(int)s[2 * 33] & 0xffu) << 16) | (((unsigned)(int)s[3 * 33] & 0xffu) << 24);
            const unsigned w1 = ((unsigned)(int)s[4 * 33] & 0xffu) | (((unsigned)(int)s[5 * 33] & 0xffu) << 8) | (((unsigned)(int)s[6 * 33] & 0xffu) << 16) | (((unsigned)(int)s[7 * 33] & 0xffu) << 24);
            u32x2 o8; o8.x = w0; o8.y = w1; *(u32x2*)((unsigned char*)dst + (size_t)n * K + k0 + 8 * c) = o8; }
        else if (f8) { unsigned w0 = 0u, w1 = 0u; w0 = __builtin_amdgcn_cvt_pk_fp8_f32(s[0 * 33], s[1 * 33], w0, false); w0 = __builtin_amdgcn_cvt_pk_fp8_f32(s[2 * 33], s[3 * 33], w0, true);
            w1 = __builtin_amdgcn_cvt_pk_fp8_f32(s[4 * 33], s[5 * 33], w1, false); w1 = __builtin_amdgcn_cvt_pk_fp8_f32(s[6 * 33], s[7 * 33], w1, true);
            u32x2 o8; o8.x = w0; o8.y = w1; *(u32x2*)((unsigned char*)dst + (size_t)n * K + k0 + 8 * c) = o8; }
        else { u32x4 o; o.x = pk2(s[0 * 33], s[1 * 33]); o.y = pk2(s[2 * 33], s[3 * 33]); o.z = pk2(s[4 * 33], s[5 * 33]); o.w = pk2(s[6 * 33], s[7 * 33]);
            *(u32x4*)(dst + (size_t)n * K + k0 + 8 * c) = o; } }
    LDS_WAIT(); asm volatile("" ::: "memory");
}
__device__ __forceinline__ void xpose_q8_group(const float* W, int ldw, int K, int sc, unsigned char* dst, float* csc, LAS float* scr, int lane, int mode) {
    const int n4 = (lane & 7) * 4, kk0 = lane >> 3;
    const int col = mode == 1 ? (n4 < 16 ? 3584 + n4 : 5648 + (n4 - 16)) : sc + n4;
    f32x4 mx = (f32x4){0.f, 0.f, 0.f, 0.f};
    if (mode != 2) {
#pragma unroll 8
        for (int k = kk0; k < K; k += 8) { const f32x4 v = *(const f32x4*)(W + (size_t)k * ldw + col); mx[0] = fmaxf(mx[0], fabsf(v[0])); mx[1] = fmaxf(mx[1], fabsf(v[1])); mx[2] = fmaxf(mx[2], fabsf(v[2])); mx[3] = fmaxf(mx[3], fabsf(v[3])); }
    }
    f32x4 inv, scl;
#pragma unroll
    for (int e = 0; e < 4; ++e) { float x = mx[e]; x = fmaxf(x, __shfl_xor(x, 8)); x = fmaxf(x, __shfl_xor(x, 16)); x = fmaxf(x, __shfl_xor(x, 32)); scl[e] = x > 0.f ? x * (1.f / 127.f) : 1.f; inv[e] = x > 0.f ? 127.f / x : 0.f; }
    if (kk0 == 0) *(f32x4*)(csc + n4) = scl;
    for (int k0 = 0; k0 < K; k0 += 64) {
#pragma unroll
        for (int i = 0; i < 8; ++i) { const int kk = kk0 + 8 * i; f32x4 v = (f32x4){0.f, 0.f, 0.f, 0.f}; if (mode != 2) v = *(const f32x4*)(W + (size_t)(k0 + kk) * ldw + col);
            scr[kk * 33 + n4] = rintf(v[0] * inv[0]); scr[kk * 33 + n4 + 1] = rintf(v[1] * inv[1]); scr[kk * 33 + n4 + 2] = rintf(v[2] * inv[2]); scr[kk * 33 + n4 + 3] = rintf(v[3] * inv[3]); }
        LDS_WAIT(); asm volatile("" ::: "memory");
        const int c = lane & 7;
#pragma unroll
        for (int jj = 0; jj < 4; ++jj) { const int n = (lane >> 3) + 8 * jj; const LAS float* s = scr + (8 * c) * 33 + n;
            const unsigned w0 = ((unsigned)(int)s[0 * 33] & 0xffu) | (((unsigned)(int)s[1 * 33] & 0xffu) << 8) | (((unsigned)(int)s[2 * 33] & 0xffu) << 16) | (((unsigned)(int)s[3 * 33] & 0xffu) << 24);
            const unsigned w1 = ((unsigned)(int)s[4 * 33] & 0xffu) | (((unsigned)(int)s[5 * 33] & 0xffu) << 8) | (((unsigned)(int)s[6 * 33] & 0xffu) << 16) | (((unsigned)(int)s[7 * 33] & 0xffu) << 24);
            u32x2 o8; o8.x = w0; o8.y = w1; *(u32x2*)(dst + (size_t)n * K + k0 + 8 * c) = o8; }
        LDS_WAIT(); asm volatile("" ::: "memory");
    }
}
__device__ __forceinline__ int hm_col(int grp) { const int T = grp >> 3, q8 = grp & 7; return 256 * T + 32 * (2 * (q8 & 3) + (q8 >> 2)); }

constexpr int CM_ITEMS = DEPTH * 256 * 8;
__device__ __forceinline__ void colmax_item(const Args& a, unsigned* cmx, int item, int lane) {
    const int slab = item & 7, grp = (item >> 3) & 255, l = item >> 11;
    const int n4 = (lane & 7) * 4, kk0 = lane >> 3, col = hm_col(grp) + n4;
    const float* W = a.in[41] + (size_t)l * D * DFF + (size_t)(slab * 256) * DFF;
    f32x4 mx = (f32x4){0.f, 0.f, 0.f, 0.f};
#pragma unroll 8
    for (int k = kk0; k < 256; k += 8) { const f32x4 v = *(const f32x4*)(W + (size_t)k * DFF + col); mx[0] = fmaxf(mx[0], fabsf(v[0])); mx[1] = fmaxf(mx[1], fabsf(v[1])); mx[2] = fmaxf(mx[2], fabsf(v[2])); mx[3] = fmaxf(mx[3], fabsf(v[3])); }
#pragma unroll
    for (int e = 0; e < 4; ++e) { float x = mx[e]; x = fmaxf(x, __shfl_xor(x, 8)); x = fmaxf(x, __shfl_xor(x, 16)); x = fmaxf(x, __shfl_xor(x, 32)); mx[e] = x; }
    if (kk0 == 0) {
#pragma unroll
        for (int e = 0; e < 4; ++e) atomicMax(cmx + (size_t)l * DFF + 32 * grp + n4 + e, __float_as_uint(mx[e])); }
}
constexpr int CV_NQ8 = 0;
constexpr int CV_IN = 440 * 32, CV_GLU = 16 * 8, CV_BR = 4 * 64 * 8, CV_OUT = 64 * 32, CV_1 = 256 * 32, CV_2 = 64 * 128, CV_REST = CV_IN + CV_GLU + CV_BR + CV_OUT + CV_1 + CV_2;
__device__ __forceinline__ void convert_q8(const Args& a, LAS unsigned char* lds, int l, int grp, int wave, int lane) {
    LAS float* scr = (LAS float*)(lds + wave * 8704);
    bf16_t* wl = (bf16_t*)(a.ws + WS_W) + (size_t)l * W_LAYER; float* wsc = (float*)(a.ws + WS_WSC) + (size_t)l * (NIN + DFF);
    const int T = grp >> 3; int sc = hm_col(grp), mode = 0;
    if (T == 54) mode = (grp & 7) == 0 ? 1 : 2; else if (T >= 22) sc += 32; else if (T >= 14) sc += 16;
    xpose_q8_group(a.in[16] + (size_t)l * D * 13856, 13856, D, sc, (unsigned char*)(wl + W_IN) + (size_t)(32 * grp) * D, wsc + 32 * grp, scr, lane, mode);
}
__device__ __forceinline__ void convert_rest(const Args& a, LAS unsigned char* lds, int l, int r0, int r1, int wave, int lane) {
    LAS float* scr = (LAS float*)(lds + wave * 8704);
    bf16_t* wl = (bf16_t*)(a.ws + WS_W) + (size_t)l * W_LAYER;
    for (int it = r0; it < r1; ++it) { int r = it;
        if (r < CV_IN) { const int kb = r / 440, grp = r % 440, T = grp >> 3; int sc = hm_col(grp), mode = 0;
            if (T == 54) mode = (grp & 7) == 0 ? 1 : 2; else if (T >= 22) sc += 32; else if (T >= 14) sc += 16;
            if (T >= 22 && T < 54) xpose_item(a.in[16] + (size_t)l * D * 13856, 13856, 64 * kb, sc, (bf16_t*)((unsigned char*)(wl + W_IN8) + (size_t)(32 * (grp - 176)) * D), D, scr, lane, mode, true);
            else xpose_item(a.in[16] + (size_t)l * D * 13856, 13856, 64 * kb, sc, wl + W_IN + (size_t)(32 * (T == 54 ? grp - 256 : grp)) * D, D, scr, lane, mode);
            continue; } r -= CV_IN;
        if (r < CV_GLU) { const int kb = r / 16, grp = r % 16; xpose_item(a.in[28] + (size_t)l * 512 * 512, 512, 64 * kb, hm_col(grp), wl + W_GLU + (size_t)(32 * grp) * 512, 512, scr, lane, 0); continue; } r -= CV_GLU;
        if (r < CV_BR) { const int k = r / 512, r2 = r % 512, kb = r2 / 64, grp = r2 % 64;
            xpose_item(a.in[39] + ((size_t)l * 4 + k) * 512 * D, D, 64 * kb, hm_col(grp), wl + W_BR + (size_t)k * D * 512 + (size_t)(32 * grp) * 512, 512, scr, lane, 0); continue; } r -= CV_BR;
        if (r < CV_OUT) { const int kb = r / 64, grp = r % 64; xpose_item(a.in[40] + (size_t)l * D * D, D, 64 * kb, 32 * grp, wl + W_OUT + (size_t)(32 * grp) * D, D, scr, lane, 0); continue; } r -= CV_OUT;
        if (r < CV_1) { const int kb = r / 256, grp = r % 256;
            xpose_item(a.in[41] + (size_t)l * D * DFF, DFF, 64 * kb, hm_col(grp), (bf16_t*)((unsigned char*)(wl + W_1) + (size_t)(32 * grp) * D), D, scr, lane, 0, false, (const float*)(a.ws + WS_WSC) + (size_t)l * DFF + 32 * grp); continue; } r -= CV_1;
        { const int kb = r / 64, grp = r % 64; xpose_item(a.in[42] + (size_t)l * DFF * D, D, 64 * kb, 32 * grp, wl + W_2 + (size_t)(32 * grp) * DFF, DFF, scr, lane, 0); }
    }
}
__device__ __forceinline__ void prologue_ada_unit(const Args& a, LAS unsigned char* lds, int tid, int unit) {
    LAS float* sl = (LAS float*)lds;
    LAS float* red = (LAS float*)(lds + 40960);
    float* mod = (float*)(a.ws + WS_MOD);
    for (int i = tid; i < 5 * D; i += NT) { const int j = i / D, k = i % D; const float x = j == 0 ? a.in[11][k] : a.in[10][(j - 1) * D + k]; sl[i] = x / (1.f + __expf(-x)); }
    __syncthreads();
    const int ks = tid >> 6, c = tid & 63;
    const int l = unit / (6 * D / 64), n0 = (unit % (6 * D / 64)) * 64;
    const float* w = a.in[12] + (size_t)l * D * 6 * D + n0 + c;
    float acc[5] = {0.f, 0.f, 0.f, 0.f, 0.f};
#pragma unroll 8
    for (int k = ks * 256; k < ks * 256 + 256; ++k) { const float wv = w[(size_t)k * 6 * D];
#pragma unroll
        for (int j = 0; j < 5; ++j) acc[j] += sl[j * D + k] * wv; }
#pragma unroll
    for (int j = 0; j < 5; ++j) red[(ks * 5 + j) * 64 + c] = acc[j];
    __syncthreads();
    if (tid < 320) { const int j = tid >> 6; float s = 0.f;
#pragma unroll
        for (int q = 0; q < 8; ++q) s += red[(q * 5 + j) * 64 + c];
        mod[((size_t)l * 5 + j) * 6 * D + n0 + c] = s + a.in[13][l * 6 * D + n0 + c]; }
}
constexpr int PRO_NQ8B = CV_NQ8 / 8, PRO_NCONV = PRO_NQ8B + (CV_REST + 63) / 64,
              PRO_NADA = DEPTH * 6 * D / 64, PRO_NCACHE = 64;
__device__ __forceinline__ void norm_phase(const float* xp, const float* xs, const float* g, const float* modl, int sh_off, int sc_off, bf16_t* H, int gw, int ngw, int lane_,
                                           const float* pend, const float* pmodl, int pg_off, float* xw, const float* xs_pend, unsigned char* F8c = nullptr, unsigned char* Q8 = nullptr, float* rsc = nullptr) {
    int lane = lane_; asm volatile("" : "+v"(lane));
    for (int row = gw; row < M; row += ngw) {
        const float* x = row < MP ? xp + (size_t)row * D : xs + (size_t)(row - MP) * D;
        if (pend != nullptr && row >= 8192) x = xs_pend + (size_t)(row - MP) * D;
        f32x4 v[8]; float ss = 0.f;
#pragma unroll
        for (int j = 0; j < 8; ++j) v[j] = *(const f32x4*)(x + 4 * (lane + 64 * j));
        if (pend != nullptr && row >= 8192) {
            const float* pg = pmodl + (size_t)row_cvec(row) * 6 * D + pg_off; const int pm = row >> 8, r = row & 255;
#pragma unroll
            for (int j = 0; j < 8; ++j) { const int col = 4 * (lane + 64 * j), pn = col >> 8, cc = col & 255;
                const float* P = pend + (size_t)(((pm - 32) * 8 + pn) * 2) * 65536 + (size_t)r * 256 + cc;
                const f32x4 pa = *(const f32x4*)P, pb = *(const f32x4*)(P + 65536), gg = *(const f32x4*)(pg + col);
                v[j] = v[j] + gg * (pa + pb); *(f32x4*)(xw + (size_t)row * D + col) = v[j]; }
        }
#pragma unroll
        for (int j = 0; j < 8; ++j) ss += (v[j][0] * v[j][0] + v[j][1] * v[j][1]) + (v[j][2] * v[j][2] + v[j][3] * v[j][3]);
        const float r = rsqrtf(wave_sum(ss) * (1.f / D) + 1e-6f);
        const float* md = modl + (size_t)row_cvec(row) * 6 * D;
        float amax = 0.f;
#pragma unroll
        for (int j = 0; j < 8; ++j) { const int i = 4 * (lane + 64 * j);
            const f32x4 gg = *(const f32x4*)(g + i), sc = *(const f32x4*)(md + sc_off + i), sh = *(const f32x4*)(md + sh_off + i);
            const f32x4 o = v[j] * r * gg * (sc + 1.f) + sh; v[j] = o;
            amax = fmaxf(amax, fmaxf(fmaxf(fabsf(o[0]), fabsf(o[1])), fmaxf(fabsf(o[2]), fabsf(o[3])))); }
        if (Q8 == nullptr) {
#pragma unroll
            for (int j = 0; j < 8; ++j) { const int i = 4 * (lane + 64 * j); u32x2 w; w.x = pk2(v[j][0], v[j][1]); w.y = pk2(v[j][2], v[j][3]); *(u32x2*)(H + (size_t)row * D + i) = w;
                if (F8c != nullptr) { unsigned w8 = 0u; w8 = __builtin_amdgcn_cvt_pk_fp8_f32(v[j][0], v[j][1], w8, false); w8 = __builtin_amdgcn_cvt_pk_fp8_f32(v[j][2], v[j][3], w8, true); *(unsigned*)(F8c + (size_t)row * D + i) = w8; } }
        } else {
#pragma unroll
            for (int o2 = 1; o2 < 64; o2 <<= 1) amax = fmaxf(amax, __shfl_xor(amax, o2));
            const float inv = amax > 0.f ? 127.f / amax : 0.f;
            if (lane == 0) rsc[row] = amax > 0.f ? amax * (1.f / 127.f) : 1.f;
#pragma unroll
            for (int j = 0; j < 8; ++j) { const int i = 4 * (lane + 64 * j);
                const unsigned w = ((unsigned)(int)rintf(v[j][0] * inv) & 0xffu) | (((unsigned)(int)rintf(v[j][1] * inv) & 0xffu) << 8) | (((unsigned)(int)rintf(v[j][2] * inv) & 0xffu) << 16) | (((unsigned)(int)rintf(v[j][3] * inv) & 0xffu) << 24);
                *(unsigned*)(Q8 + (size_t)row * D + i) = w; }
        }
    }
}
__device__ __forceinline__ void final_fix_phase(const float* pend, const float* pmodl, int pg_off, float* X, int gw, int ngw, int lane_) {
    int lane = lane_; asm volatile("" : "+v"(lane));
    for (int row = 8192 + gw; row < M; row += ngw) {
        const float* pg = pmodl + (size_t)row_cvec(row) * 6 * D + pg_off; const int pm = row >> 8, r = row & 255;
#pragma unroll
        for (int j = 0; j < 8; ++j) { const int col = 4 * (lane + 64 * j), pn = col >> 8, cc = col & 255;
            const float* P = pend + (size_t)(((pm - 32) * 8 + pn) * 2) * 65536 + (size_t)r * 256 + cc;
            const f32x4 pa = *(const f32x4*)P, pb = *(const f32x4*)(P + 65536), gg = *(const f32x4*)(pg + col);
            float* xo = X + (size_t)row * D + col; *(f32x4*)xo = *(const f32x4*)xo + gg * (pa + pb); }
    }
}
__device__ __forceinline__ void conv_pull(const Args& a, LAS unsigned char* lds, volatile LAS unsigned* qitem, int layer, int maxb) {
    unsigned* qhead = (unsigned*)(a.ws + WS_CTL) + 8200 + layer;
    for (int n = 0; maxb < 0 || n < maxb; ++n) {
        __syncthreads();
        if (threadIdx.x == 0) qitem[0] = __hip_atomic_fetch_add(qhead, 1u, __ATOMIC_RELAXED, __HIP_MEMORY_SCOPE_AGENT);
        __syncthreads();
        const int item = (int)qitem[0];
        if (item >= PRO_NCONV) break;
        const int wave = __builtin_amdgcn_readfirstlane((int)(threadIdx.x >> 6));
        int lane = (int)(threadIdx.x & 63); asm volatile("" : "+v"(lane));
        { const int w0 = (item - PRO_NQ8B) * 64 + wave * 8; convert_rest(a, lds, layer, w0, w0 + 8 < CV_REST ? w0 + 8 : CV_REST, wave, lane); }
    }
    __syncthreads();
}
}
namespace mk {
constexpr size_t WS_NAT = AL(WS_SCR);
constexpr int NATP = 2048, N_XBC = 0, N_Q = 1024, N_K = 1536;
constexpr size_t WS_TR = AL(WS_NAT + (size_t)M * NATP * 2);
constexpr int T_X = 0, T_B = 512, T_K = 768, T_MV = 1280, T_V = 1792, TRR = 2304;
constexpr int NCH = 96;
constexpr size_t WS_MLC = AL(WS_TR + (size_t)TRR * M * 2);
constexpr size_t WS_MLN = AL(WS_MLC + (size_t)NCH * 4 * 2 * 16384 * 4);
constexpr size_t WS_MLS = AL(WS_MLN + (size_t)NCH * 4 * 2 * 128 * 4);
constexpr size_t WS_MLCS = AL(WS_MLS + (size_t)NCH * 4 * 2 * 4 * 4);
constexpr size_t WS_MLNS = AL(WS_MLCS + (size_t)NCH * 4 * 2 * 16384 * 2);
constexpr size_t WS_MLMS = AL(WS_MLNS + (size_t)NCH * 4 * 2 * 128 * 4);
constexpr size_t WS_OPT_END = AL(WS_MLMS + (size_t)NCH * 4 * 2 * 4);

__device__ __forceinline__ f32x4 mfma16(bf16x8 a, bf16x8 b, f32x4 c) { return __builtin_amdgcn_mfma_f32_16x16x32_bf16(a, b, c, 0, 0, 0); }
__device__ __forceinline__ void chunk_info(int ch, int& row0, int& seq0, int& L, int& lat, int& b, int& ci, int& nc) {
    if (ch < 32) { b = ch >> 1; ci = ch & 1; nc = 2; seq0 = b * 256; L = 256; lat = 0; } else { const int c2 = ch - 32; b = c2 >> 4; ci = c2 & 15; nc = 16; seq0 = MP + b * 2048; L = 2048; lat = 1; }
    row0 = seq0 + ci * 128;
}
__device__ __forceinline__ float fast_exp(float x) { return __expf(x); }

__device__ __forceinline__ void prep_phase(const Args& a, int layer, LAS unsigned char* lds, int gw_, int ngw, int wave, int lane_, bf16_t* UPk) {
    int lane = lane_, gw = gw_; asm volatile("" : "+v"(lane));
    const bf16_t* PROJ = (const bf16_t*)(a.ws + WS_PROJ); bf16_t* NAT = (bf16_t*)(a.ws + WS_NAT); bf16_t* TR = (bf16_t*)(a.ws + WS_TR);
    LAS bf16_t* tile = (LAS bf16_t*)(lds + wave * 16896); LAS bf16_t* otile = tile + 68 * 64;
    const int c = lane & 7, r8 = lane >> 3;
    const float* cw = a.in[30] + layer * 5 * 1024; const float* cb = a.in[31] + layer * 1024;
    for (int u = gw; u < 56 * 192; u += ngw) {
        const int cg = u / 192, tt = u % 192, m0 = tt * 64;
        const int lat = m0 >= MP; const int seq0 = lat ? MP + ((m0 - MP) / 2048) * 2048 : (m0 / 256) * 256, L = lat ? 2048 : 256, t0 = m0 - seq0;
        int kind, src, natcol = -1, trrow = -1;
        if (cg < 16) { kind = 0; src = P_XBC + 64 * cg; natcol = N_XBC + 64 * cg; if (cg < 12) trrow = T_X + 64 * cg; }
        else if (cg < 24) { kind = 1; src = P_MQ + 64 * (cg - 16); natcol = N_Q + 64 * (cg - 16); }
        else if (cg < 32) { kind = 2; src = P_MK + 64 * (cg - 24); natcol = N_K + 64 * (cg - 24); trrow = T_K + 64 * (cg - 24); }
        else if (cg < 40) { kind = 3; src = P_MV + 64 * (cg - 32); trrow = T_MV + 64 * (cg - 32); }
        else if (cg < 48) { kind = 3; src = P_V + 64 * (cg - 40); trrow = T_V + 64 * (cg - 40); }
        else { kind = 4; src = P_S5U + 64 * (cg - 48); }
        const int roff = kind == 0 ? -2 : 0, nrows = kind == 0 ? 68 : 64;
#pragma unroll
        for (int i = 0; i < 9; ++i) { const int r = r8 + 8 * i; if (r < nrows) { const int t = t0 + r + roff; u32x4 v = {0u, 0u, 0u, 0u};
                if (t >= 0 && t < L) v = *(const u32x4*)(PROJ + (size_t)(seq0 + t) * PJ + src + 8 * c);
                *(LAS u32x4*)(tile + r * 64 + 8 * c) = v; } }
        LDS_WAIT(); asm volatile("" ::: "memory");
#define PREP_EMIT(i_, r_) do { if (natcol >= 0) *(u32x4*)(NAT + (size_t)(m0 + r8 + 8 * (i_)) * NATP + natcol + 8 * c) = (r_); if (trrow >= 0) *(LAS u32x4*)(otile + (r8 + 8 * (i_)) * 64 + 8 * c) = (r_); } while (0)
        if (kind == 0) {
            float w[5][8], bz[8];
#pragma unroll
            for (int e = 0; e < 8; ++e) { bz[e] = cb[64 * cg + 8 * c + e];
#pragma unroll
                for (int j = 0; j < 5; ++j) w[j][e] = cw[j * 1024 + 64 * cg + 8 * c + e]; }
#pragma unroll 2
            for (int i = 0; i < 8; ++i) { const int tk = r8 + 8 * i; float acc[8];
#pragma unroll
                for (int e = 0; e < 8; ++e) acc[e] = bz[e];
#pragma unroll
                for (int j = 0; j < 5; ++j) { const u32x4 v = *(const LAS u32x4*)(tile + (tk + j) * 64 + 8 * c);
                    acc[0] += bflo(v.x) * w[j][0]; acc[1] += bfhi(v.x) * w[j][1]; acc[2] += bflo(v.y) * w[j][2]; acc[3] += bfhi(v.y) * w[j][3];
                    acc[4] += bflo(v.z) * w[j][4]; acc[5] += bfhi(v.z) * w[j][5]; acc[6] += bflo(v.w) * w[j][6]; acc[7] += bfhi(v.w) * w[j][7]; }
#pragma unroll
                for (int e = 0; e < 8; ++e) acc[e] = fsilu(acc[e]);
                u32x4 rv; rv.x = pk2(acc[0], acc[1]); rv.y = pk2(acc[2], acc[3]); rv.z = pk2(acc[4], acc[5]); rv.w = pk2(acc[6], acc[7]); PREP_EMIT(i, rv); }
        } else if (kind == 4) {
#pragma unroll
            for (int i = 0; i < 8; ++i) { const int tk = r8 + 8 * i, m = m0 + tk; const u32x4 v = *(const LAS u32x4*)(tile + tk * 64 + 8 * c);
                *(u32x4*)(UPk + ((size_t)(4 * (cg - 48) + (c >> 1)) * 384 + (m >> 5)) * 512 + (m & 31) * 16 + 8 * (c & 1)) = v; }
        } else if (kind == 3 || !lat) {
            const float sc = kind == 2 ? 0.08838834764831845f : 1.f;
#pragma unroll
            for (int i = 0; i < 8; ++i) { const u32x4 v = *(const LAS u32x4*)(tile + (r8 + 8 * i) * 64 + 8 * c);
                u32x4 rv = v;
                if (kind == 2) { rv.x = pk2(bflo(v.x) * sc, bfhi(v.x) * sc); rv.y = pk2(bflo(v.y) * sc, bfhi(v.y) * sc); rv.z = pk2(bflo(v.z) * sc, bfhi(v.z) * sc); rv.w = pk2(bflo(v.w) * sc, bfhi(v.w) * sc); }
                PREP_EMIT(i, rv); }
        } else {
            const float sc = kind == 2 ? 0.08838834764831845f : 1.f; const int odd = cg & 1;
            float inv[8];
#pragma unroll
            for (int e = 0; e < 8; ++e) inv[e] = exp2f(-(float)(8 * (c & 3) + e) * (13.287712379549449f / 32.f));
#pragma unroll
            for (int i = 0; i < 8; ++i) { const int tk = r8 + 8 * i, t = t0 + tk; const float pos = odd ? (float)(t & 63) : (float)(t >> 6);
                const u32x4 vo = *(const LAS u32x4*)(tile + tk * 64 + 8 * c), vp = *(const LAS u32x4*)(tile + tk * 64 + 8 * (c ^ 4));
                float o[8], p[8], rr[8];
                o[0] = bflo(vo.x); o[1] = bfhi(vo.x); o[2] = bflo(vo.y); o[3] = bfhi(vo.y); o[4] = bflo(vo.z); o[5] = bfhi(vo.z); o[6] = bflo(vo.w); o[7] = bfhi(vo.w);
                p[0] = bflo(vp.x); p[1] = bfhi(vp.x); p[2] = bflo(vp.y); p[3] = bfhi(vp.y); p[4] = bflo(vp.z); p[5] = bfhi(vp.z); p[6] = bflo(vp.w); p[7] = bfhi(vp.w);
#pragma unroll
                for (int e = 0; e < 8; ++e) { const float ang = pos * inv[e], cs = __cosf(ang), sn = __sinf(ang);
                    rr[e] = (c < 4 ? o[e] * cs - p[e] * sn : p[e] * sn + o[e] * cs) * sc; }
                u32x4 rv; rv.x = pk2(rr[0], rr[1]); rv.y = pk2(rr[2], rr[3]); rv.z = pk2(rr[4], rr[5]); rv.w = pk2(rr[6], rr[7]); PREP_EMIT(i, rv); }
        }
        if (trrow >= 0) {
            LDS_WAIT(); asm volatile("" ::: "memory");
            bf16_t* dst = TR + (size_t)(trrow + lane) * M + m0;
#pragma unroll
            for (int j = 0; j < 8; ++j) { unsigned wv[4];
#pragma unroll
                for (int q = 0; q < 4; ++q) { const unsigned lo = otile[(8 * j + 2 * q) * 64 + lane], hi = otile[(8 * j + 2 * q + 1) * 64 + lane]; wv[q] = lo | (hi << 16); }
                u32x4 o; o.x = wv[0]; o.y = wv[1]; o.z = wv[2]; o.w = wv[3]; *(u32x4*)(dst + 8 * j) = o; }
        }
        LDS_WAIT(); asm volatile("" ::: "memory");
    }
}

struct MlGate { float lf0, lf1, ig0, ig1, P0, P1, tot; };
__device__ __forceinline__ float wave_incl_scan(float v, int lane) {
#pragma unroll
    for (int o = 1; o < 64; o <<= 1) { const float t = __shfl_up(v, o); if (lane >= o) v += t; }
    return v;
}
__device__ __forceinline__ float wave_max(float v) {
#pragma unroll
    for (int o = 1; o < 64; o <<= 1) v = fmaxf(v, __shfl_xor(v, o));
    return v;
}
__device__ __forceinline__ MlGate ml_gates(const Args& a, int layer, int row0, int hh, int dir, int lane) {
    const float* SMALL = (const float*)(a.ws + WS_SMALL);
    const float ib = a.in[36][layer * 8 + dir * 4 + hh], fb = a.in[37][layer * 8 + dir * 4 + hh];
    MlGate g;
    const float f0 = SMALL[(size_t)(row0 + lane) * 32 + S_MF + dir * 4 + hh] + fb, f1 = SMALL[(size_t)(row0 + lane + 64) * 32 + S_MF + dir * 4 + hh] + fb;
    g.ig0 = SMALL[(size_t)(row0 + lane) * 32 + S_MI + dir * 4 + hh] + ib; g.ig1 = SMALL[(size_t)(row0 + lane + 64) * 32 + S_MI + dir * 4 + hh] + ib;
    g.lf0 = fminf(f0, 0.f) - log1pf(__expf(-fabsf(f0))); g.lf1 = fminf(f1, 0.f) - log1pf(__expf(-fabsf(f1)));
    const float s0 = wave_incl_scan(g.lf0, lane); const float tot0 = __shfl(s0, 63);
    const float s1 = wave_incl_scan(g.lf1, lane) + tot0;
    g.P0 = s0; g.P1 = s1; g.tot = __shfl(s1, 63);
    return g;
}

__device__ __forceinline__ void ml_states_phase(const Args& a, int layer, int tid_, int G) {
    int tid = tid_; asm volatile("" : "+v"(tid));
    const int lane = tid & 63, wave = __builtin_amdgcn_readfirstlane(tid >> 6), fr = lane & 15, fq = lane >> 4;
    const bf16_t* TR = (const bf16_t*)(a.ws + WS_TR);
    float* MLC = (float*)(a.ws + WS_MLC); float* MLN = (float*)(a.ws + WS_MLN); float* MLS = (float*)(a.ws + WS_MLS);
    for (int u = blockIdx.x; u < NCH * 4; u += G) {
        const int ch = u >> 2, hh = u & 3; int row0, seq0, L, lat, b, ci, nc; chunk_info(ch, row0, seq0, L, lat, b, ci, nc);
#pragma unroll 1
        for (int dir = 0; dir < 2; ++dir) {
            const MlGate g = ml_gates(a, layer, row0, hh, dir, lane);
            const float w0 = (dir == 0 ? g.tot - g.P0 : g.P0 - g.lf0) + g.ig0, w1 = (dir == 0 ? g.tot - g.P1 : g.P1 - g.lf1) + g.ig1;
            const float mloc = wave_max(fmaxf(w0, w1));
            const float e0 = __expf(w0 - mloc), e1 = __expf(w1 - mloc);
            f32x4 acc[8];
#pragma unroll
            for (int j = 0; j < 8; ++j) acc[j] = (f32x4){0.f, 0.f, 0.f, 0.f};
            float nacc[8];
#pragma unroll
            for (int j = 0; j < 8; ++j) nacc[j] = 0.f;
            const bf16_t* vrow = TR + (size_t)(T_MV + hh * 128 + wave * 16 + fr) * M + row0 + 8 * fq;
#pragma unroll
            for (int ks = 0; ks < 4; ++ks) {
                const bf16x8 af = *(const bf16x8*)(vrow + 32 * ks);
                float ev[8];
#pragma unroll
                for (int j = 0; j < 8; ++j) { const int tok = 32 * ks + 8 * fq + j; const float x0 = __shfl(e0, tok & 63), x1 = __shfl(e1, tok & 63); ev[j] = tok < 64 ? x0 : x1; }
#pragma unroll
                for (int jt = 0; jt < 8; ++jt) {
                    const u32x4 kv = *(const u32x4*)(TR + (size_t)(T_K + hh * 128 + jt * 16 + fr) * M + row0 + 32 * ks + 8 * fq);
                    const float k0 = bflo(kv.x) * ev[0], k1 = bfhi(kv.x) * ev[1], k2 = bflo(kv.y) * ev[2], k3 = bfhi(kv.y) * ev[3], k4 = bflo(kv.z) * ev[4], k5 = bfhi(kv.z) * ev[5], k6 = bflo(kv.w) * ev[6], k7 = bfhi(kv.w) * ev[7];
                    if (wave == 0) nacc[jt] += ((k0 + k1) + (k2 + k3)) + ((k4 + k5) + (k6 + k7));
                    u32x4 kb; kb.x = pk2(k0, k1); kb.y = pk2(k2, k3); kb.z = pk2(k4, k5); kb.w = pk2(k6, k7);
                    acc[jt] = mfma16(af, __builtin_bit_cast(bf16x8, kb), acc[jt]);
                }
            }
            float* cdst = MLC + ((size_t)(ch * 4 + hh) * 2 + dir) * 16384;
#pragma unroll
            for (int jt = 0; jt < 8; ++jt)
#pragma unroll
                for (int i = 0; i < 4; ++i) cdst[(size_t)(wave * 16 + 4 * fq + i) * 128 + jt * 16 + fr] = acc[jt][i];
            if (wave == 0) {
#pragma unroll
                for (int jt = 0; jt < 8; ++jt) { float v = nacc[jt]; v += __shfl_xor(v, 16); v += __shfl_xor(v, 32); if (fq == 0) MLN[((size_t)(ch * 4 + hh) * 2 + dir) * 128 + jt * 16 + fr] = v; }
                if (lane == 0) { MLS[((size_t)(ch * 4 + hh) * 2 + dir) * 4 + 0] = mloc; MLS[((size_t)(ch * 4 + hh) * 2 + dir) * 4 + 1] = g.tot; }
            }
        }
    }
}
__device__ __forceinline__ void ml_scan_phase(const Args& a, int layer, int tid_, int G) {
    int tid = tid_; asm volatile("" : "+v"(tid));
    const float* MLC = (const float*)(a.ws + WS_MLC); const float* MLN = (const float*)(a.ws + WS_MLN); const float* MLS = (const float*)(a.ws + WS_MLS);
    bf16_t* CS = (bf16_t*)(a.ws + WS_MLCS); float* NS = (float*)(a.ws + WS_MLNS); float* MS = (float*)(a.ws + WS_MLMS);
    for (int task = blockIdx.x; task < 256; task += G) {
        int lat, b, hh, dir, part, nparts;
        if (task < 128) { lat = 1; part = task & 3; dir = (task >> 2) & 1; hh = (task >> 3) & 3; b = task >> 5; nparts = 4; }
        else { const int t2 = task - 128; lat = 0; part = 0; dir = t2 & 1; hh = (t2 >> 1) & 3; b = t2 >> 3; nparts = 1; }
        const int nc = lat ? 16 : 2, ch0 = lat ? 32 + b * 16 : b * 2;
        const int nel = 16384 / nparts, e0 = part * nel, per = nel / NT;
        float c[32]; float n = 0.f, m = 0.f;
        const size_t so = (((size_t)b * DEPTH + layer) * 2 + dir) * 4 + hh;
#pragma unroll
        for (int i = 0; i < 32; ++i) if (i < per) { const int e = e0 + i * NT + tid, vd = e >> 7, kd = e & 127; c[i] = lat ? a.in[7][(so * 128 + kd) * 128 + vd] : 0.f; }
        if (tid < 128) n = lat ? a.in[8][so * 128 + tid] : 0.f;
        m = lat ? a.in[9][so] : 0.f;
        float nx[32]; float nn = 0.f, nml = 0.f, nbl = 0.f;
        { const int ch = ch0 + (dir ? nc - 1 : 0); const size_t sb = (size_t)(ch * 4 + hh) * 2 + dir;
#pragma unroll
            for (int i = 0; i < 32; ++i) if (i < per) nx[i] = MLC[sb * 16384 + e0 + i * NT + tid];
            if (tid < 128) nn = MLN[sb * 128 + tid]; nml = MLS[sb * 4 + 0]; nbl = MLS[sb * 4 + 1]; }
        for (int s = 0; s < nc; ++s) { const int ci = dir ? nc - 1 - s : s, ch = ch0 + ci; const size_t sb = (size_t)(ch * 4 + hh) * 2 + dir;
            float cx[32];
#pragma unroll
            for (int i = 0; i < 32; ++i) if (i < per) cx[i] = nx[i];
            const float cn = nn, ml = nml, bl = nbl;
            if (s + 1 < nc) { const int ch2 = ch0 + (dir ? nc - 2 - s : s + 1); const size_t sb2 = (size_t)(ch2 * 4 + hh) * 2 + dir;
#pragma unroll
                for (int i = 0; i < 32; ++i) if (i < per) nx[i] = MLC[sb2 * 16384 + e0 + i * NT + tid];
                if (tid < 128) nn = MLN[sb2 * 128 + tid]; nml = MLS[sb2 * 4 + 0]; nbl = MLS[sb2 * 4 + 1]; }
#pragma unroll
            for (int i = 0; i < 32; ++i) if (i < per) CS[sb * 16384 + e0 + i * NT + tid] = f2bf(c[i]);
            if (part == 0) { if (tid < 128) NS[sb * 128 + tid] = n; if (tid == 0) MS[sb] = m; }
            const float mn = fmaxf(bl + m, ml), fa = __expf(bl + m - mn), fb = __expf(ml - mn);
#pragma unroll
            for (int i = 0; i < 32; ++i) if (i < per) c[i] = fa * c[i] + fb * cx[i];
            if (tid < 128) n = fa * n + fb * cn;
            m = mn; }
        if (!lat) {
#pragma unroll
            for (int i = 0; i < 32; ++i) if (i < per) { const int e = e0 + i * NT + tid, vd = e >> 7, kd = e & 127; a.out[O_MLC + (so * 128 + kd) * 128 + vd] = c[i]; }
            if (tid < 128) a.out[O_MLN + so * 128 + tid] = n; if (tid == 0) a.out[O_MLM + so] = m; }
    }
}
__device__ __forceinline__ void ml_out_phase(const Args& a, int layer, int gw, int ngw, int lane_) {
    int lane = lane_; asm volatile("" : "+v"(lane));
    const int fr = lane & 15, fq = lane >> 4;
    const bf16_t* NAT = (const bf16_t*)(a.ws + WS_NAT); const bf16_t* TR = (const bf16_t*)(a.ws + WS_TR); const bf16_t* PROJ = (const bf16_t*)(a.ws + WS_PROJ);
    const bf16_t* CS = (const bf16_t*)(a.ws + WS_MLCS); const float* NS = (const float*)(a.ws + WS_MLNS); const float* MS = (const float*)(a.ws + WS_MLMS);
    bf16_t* BR = (bf16_t*)(a.ws + WS_BR);
    for (int it = gw; it < NCH * 4 * 8; it += ngw) {
        const int wv = it & 7, hh = (it >> 3) & 3, ch = it >> 5; int row0, seq0, L, lat, b, ci, nc; chunk_info(ch, row0, seq0, L, lat, b, ci, nc);
        const int t = wv * 16 + fr;
        bf16x8 qf[4];
#pragma unroll
        for (int ks = 0; ks < 4; ++ks) qf[ks] = *(const bf16x8*)(NAT + (size_t)(row0 + t) * NATP + N_Q + hh * 128 + 32 * ks + 8 * fq);
        f32x4 hsum[8];
#pragma unroll
        for (int j = 0; j < 8; ++j) hsum[j] = (f32x4){0.f, 0.f, 0.f, 0.f};
#pragma unroll
        for (int dir = 0; dir < 2; ++dir) {
            const size_t sb = (size_t)(ch * 4 + hh) * 2 + dir;
            const MlGate g = ml_gates(a, layer, row0, hh, dir, lane); const float ms = MS[sb];
            float u0, u1, c0, c1, ai0, ai1;
            if (dir == 0) { u0 = g.ig0 - g.P0; u1 = g.ig1 - g.P1; c0 = g.P0; c1 = g.P1; ai0 = g.P0 + ms; ai1 = g.P1 + ms; }
            else { const float E0 = g.P0 - g.lf0, E1 = g.P1 - g.lf1; u0 = E0 + g.ig0; u1 = E1 + g.ig1; c0 = -E0; c1 = -E1; ai0 = g.tot - E0 + ms; ai1 = g.tot - E1 + ms; }
            float g0 = u0, g1 = u1;
            if (dir == 0) {
#pragma unroll
                for (int o2 = 1; o2 < 64; o2 <<= 1) { const float x0 = __shfl_up(g0, o2), x1 = __shfl_up(g1, o2); if (lane >= o2) { g0 = fmaxf(g0, x0); g1 = fmaxf(g1, x1); } }
                g1 = fmaxf(g1, __shfl(g0, 63));
            } else {
#pragma unroll
                for (int o2 = 1; o2 < 64; o2 <<= 1) { const float x0 = __shfl_down(g0, o2), x1 = __shfl_down(g1, o2); if (lane + o2 < 64) { g0 = fmaxf(g0, x0); g1 = fmaxf(g1, x1); } }
                g0 = fmaxf(g0, __shfl(g1, 0));
            }
            const float mt0 = fmaxf(ai0, c0 + g0), mt1 = fmaxf(ai1, c1 + g1);
            const float w0 = c0 - mt0, w1 = c1 - mt1, si0 = __expf(ai0 - mt0), si1 = __expf(ai1 - mt1), em0 = __expf(-mt0), em1 = __expf(-mt1);
            const int tl = t & 63; const bool th = wv >= 4;
            const float wt = th ? __shfl(w1, tl) : __shfl(w0, tl), sit = th ? __shfl(si1, tl) : __shfl(si0, tl), emt = th ? __shfl(em1, tl) : __shfl(em0, tl);
            f32x4 acc[8];
#pragma unroll
            for (int j = 0; j < 8; ++j) acc[j] = (f32x4){0.f, 0.f, 0.f, 0.f};
#pragma unroll
            for (int ks = 0; ks < 4; ++ks)
#pragma unroll
                for (int j = 0; j < 8; ++j) { const bf16x8 cf = *(const bf16x8*)(CS + sb * 16384 + (size_t)(16 * j + fr) * 128 + 32 * ks + 8 * fq); acc[j] = mfma16(cf, qf[ks], acc[j]); }
            float qn = 0.f;
#pragma unroll
            for (int ks = 0; ks < 4; ++ks) { const u32x4 qv = __builtin_bit_cast(u32x4, qf[ks]); const float* nn = NS + sb * 128 + 32 * ks + 8 * fq; const f32x4 n0 = *(const f32x4*)nn, n1 = *(const f32x4*)(nn + 4);
                qn += bflo(qv.x) * n0[0] + bfhi(qv.x) * n0[1] + bflo(qv.y) * n0[2] + bfhi(qv.y) * n0[3] + bflo(qv.z) * n1[0] + bfhi(qv.z) * n1[1] + bflo(qv.w) * n1[2] + bfhi(qv.w) * n1[3]; }
            qn += __shfl_xor(qn, 16); qn += __shfl_xor(qn, 32);
#pragma unroll
            for (int j = 0; j < 8; ++j) acc[j] *= sit;
            float den = sit * qn;
            const int jlo = dir == 0 ? 0 : (wv >> 1), jhi = dir == 0 ? (wv >> 1) : 3;
            float psum = 0.f;
            for (int jp = jlo; jp <= jhi; ++jp) {
                const int ta = 32 * jp + 8 * (fr >> 2) + (fr & 3);
                f32x4 sa = (f32x4){0.f, 0.f, 0.f, 0.f}, sb2 = (f32x4){0.f, 0.f, 0.f, 0.f};
#pragma unroll
                for (int ks = 0; ks < 4; ++ks) {
                    const bf16x8 ka = *(const bf16x8*)(NAT + (size_t)(row0 + ta) * NATP + N_K + hh * 128 + 32 * ks + 8 * fq);
                    const bf16x8 kb = *(const bf16x8*)(NAT + (size_t)(row0 + ta + 4) * NATP + N_K + hh * 128 + 32 * ks + 8 * fq);
                    sa = mfma16(ka, qf[ks], sa); sb2 = mfma16(kb, qf[ks], sb2); }
                float pa[4], pb[4];
#pragma unroll
                for (int i = 0; i < 4; ++i) { const int s0 = 32 * jp + 8 * fq + i, s1 = s0 + 4;
                    const float us0 = jp < 2 ? __shfl(u0, s0 & 63) : __shfl(u1, s0 & 63), us1 = jp < 2 ? __shfl(u0, s1 & 63) : __shfl(u1, s1 & 63);
                    const bool ok0 = dir == 0 ? s0 <= t : s0 >= t, ok1 = dir == 0 ? s1 <= t : s1 >= t;
                    pa[i] = ok0 ? sa[i] * __expf(us0 + wt) : 0.f; pb[i] = ok1 ? sb2[i] * __expf(us1 + wt) : 0.f;
                    psum += pa[i] + pb[i]; }
                u32x4 pw; pw.x = pk2(pa[0], pa[1]); pw.y = pk2(pa[2], pa[3]); pw.z = pk2(pb[0], pb[1]); pw.w = pk2(pb[2], pb[3]);
                const bf16x8 pf = __builtin_bit_cast(bf16x8, pw);
#pragma unroll
                for (int j = 0; j < 8; ++j) { const bf16x8 vf = *(const bf16x8*)(TR + (size_t)(T_MV + hh * 128 + 16 * j + fr) * M + row0 + 32 * jp + 8 * fq); acc[j] = mfma16(vf, pf, acc[j]); }
            }
            psum += __shfl_xor(psum, 16); psum += __shfl_xor(psum, 32);
            den += psum;
            const float rden = 1.f / fmaxf(fabsf(den), emt);
#pragma unroll
            for (int j = 0; j < 8; ++j) hsum[j] += acc[j] * rden;
        }
        float ss = 0.f;
#pragma unroll
        for (int j = 0; j < 8; ++j) ss += (hsum[j][0] * hsum[j][0] + hsum[j][1] * hsum[j][1]) + (hsum[j][2] * hsum[j][2] + hsum[j][3] * hsum[j][3]);
        ss += __shfl_xor(ss, 16); ss += __shfl_xor(ss, 32);
        const float r = rsqrtf(ss * (1.f / 128.f) + 1e-6f);
        const float* ng = a.in[38] + layer * 512 + hh * 128;
#pragma unroll
        for (int j = 0; j < 8; ++j) { const int vd = 16 * j + 4 * fq; const f32x4 gg = *(const f32x4*)(ng + vd);
            const u32x2 ov = *(const u32x2*)(PROJ + (size_t)(row0 + t) * PJ + P_MO + hh * 128 + vd);
            const float o0 = hsum[j][0] * r * gg[0] * fsigm(bflo(ov.x)), o1 = hsum[j][1] * r * gg[1] * fsigm(bfhi(ov.x)), o2 = hsum[j][2] * r * gg[2] * fsigm(bflo(ov.y)), o3 = hsum[j][3] * r * gg[3] * fsigm(bfhi(ov.y));
            u32x2 w; w.x = pk2(o0, o1); w.y = pk2(o2, o3); *(u32x2*)(BR + (size_t)(row0 + t) * D + 1536 + hh * 128 + vd) = w; }
    }
}
}
namespace mk {
constexpr size_t WS_SST = WS_OPT_END;
constexpr size_t WS_SSL = AL(WS_SST + (size_t)NCH * 8 * 2 * 8192 * 4);
constexpr size_t WS_SSCS = AL(WS_SSL + (size_t)NCH * 8 * 2 * 4);
constexpr size_t WS_YPRE = AL(WS_SSCS + (size_t)NCH * 8 * 2 * 8192 * 2);
constexpr size_t WS_SSQ = AL(WS_YPRE + (size_t)M * 512 * 4);
constexpr size_t WS_SSD_END = AL(WS_SSQ + (size_t)M * 8 * 4);

struct SsdGate { float dt0, dt1, la0, la1, P0, P1, tot; };
__device__ __forceinline__ SsdGate ssd_gates(const Args& a, int layer, int row0, int hh, int dir, int lane) {
    const float* SMALL = (const float*)(a.ws + WS_SMALL);
    const float bias = a.in[32][layer * 16 + dir * 8 + hh], A = -__expf(a.in[33][layer * 16 + dir * 8 + hh]);
    SsdGate g;
    const float x0 = SMALL[(size_t)(row0 + lane) * 32 + S_DT + dir * 8 + hh] + bias, x1 = SMALL[(size_t)(row0 + lane + 64) * 32 + S_DT + dir * 8 + hh] + bias;
    g.dt0 = fmaxf(x0, 0.f) + log1pf(__expf(-fabsf(x0))); g.dt1 = fmaxf(x1, 0.f) + log1pf(__expf(-fabsf(x1)));
    g.la0 = g.dt0 * A; g.la1 = g.dt1 * A;
    const float s0 = wave_incl_scan(g.la0, lane); const float t0 = __shfl(s0, 63);
    const float s1 = wave_incl_scan(g.la1, lane) + t0;
    g.P0 = s0; g.P1 = s1; g.tot = __shfl(s1, 63);
    return g;
}
__device__ __forceinline__ void ssd_states_phase(const Args& a, int layer, int tid_, int G) {
    int tid = tid_; asm volatile("" : "+v"(tid));
    const int lane = tid & 63, wave = __builtin_amdgcn_readfirstlane(tid >> 6), fr = lane & 15, fq = lane >> 4;
    const bf16_t* TR = (const bf16_t*)(a.ws + WS_TR); float* SST = (float*)(a.ws + WS_SST); float* SSL = (float*)(a.ws + WS_SSL);
    for (int u = blockIdx.x; u < NCH * 8; u += G) {
        const int ch = u >> 3, hh = u & 7, grp = hh >> 2; int row0, seq0, L, lat, b, ci, nc; chunk_info(ch, row0, seq0, L, lat, b, ci, nc);
#pragma unroll 1
        for (int dir = 0; dir < 2; ++dir) {
            const SsdGate g = ssd_gates(a, layer, row0, hh, dir, lane);
            const float w0 = g.dt0 * __expf(dir == 0 ? g.tot - g.P0 : g.P0 - g.la0), w1 = g.dt1 * __expf(dir == 0 ? g.tot - g.P1 : g.P1 - g.la1);
            f32x4 acc[4];
#pragma unroll
            for (int j = 0; j < 4; ++j) acc[j] = (f32x4){0.f, 0.f, 0.f, 0.f};
#pragma unroll
            for (int ks = 0; ks < 4; ++ks) {
                float ev[8];
#pragma unroll
                for (int j = 0; j < 8; ++j) { const int tok = 32 * ks + 8 * fq + j; const float y0 = __shfl(w0, tok & 63), y1 = __shfl(w1, tok & 63); ev[j] = tok < 64 ? y0 : y1; }
                const u32x4 bv = *(const u32x4*)(TR + (size_t)(T_B + grp * 128 + wave * 16 + fr) * M + row0 + 32 * ks + 8 * fq);
                u32x4 bw; bw.x = pk2(bflo(bv.x) * ev[0], bfhi(bv.x) * ev[1]); bw.y = pk2(bflo(bv.y) * ev[2], bfhi(bv.y) * ev[3]); bw.z = pk2(bflo(bv.z) * ev[4], bfhi(bv.z) * ev[5]); bw.w = pk2(bflo(bv.w) * ev[6], bfhi(bv.w) * ev[7]);
                const bf16x8 bf = __builtin_bit_cast(bf16x8, bw);
#pragma unroll
                for (int j = 0; j < 4; ++j) { const bf16x8 xf = *(const bf16x8*)(TR + (size_t)(T_X + hh * 64 + 16 * j + fr) * M + row0 + 32 * ks + 8 * fq); acc[j] = mfma16(xf, bf, acc[j]); }
            }
            float* dst = SST + ((size_t)(ch * 8 + hh) * 2 + dir) * 8192;
#pragma unroll
            for (int j = 0; j < 4; ++j)
#pragma unroll
                for (int i = 0; i < 4; ++i) dst[(size_t)(16 * j + 4 * fq + i) * 128 + wave * 16 + fr] = acc[j][i];
            if (tid == 0) SSL[(size_t)(ch * 8 + hh) * 2 + dir] = g.tot;
        }
    }
}
__device__ __forceinline__ void ssd_scan_phase(const Args& a, int layer, int tid_, int G) {
    int tid = tid_; asm volatile("" : "+v"(tid));
    const float* SST = (const float*)(a.ws + WS_SST); const float* SSL = (const float*)(a.ws + WS_SSL); bf16_t* CS = (bf16_t*)(a.ws + WS_SSCS);
    for (int task = blockIdx.x; task < 384; task += G) {
        int lat, b, hh, dir, part, nparts;
        if (task < 128) { lat = 1; part = task & 1; dir = (task >> 1) & 1; hh = (task >> 2) & 7; b = task >> 5; nparts = 2; }
        else { const int t2 = task - 128; lat = 0; part = 0; dir = t2 & 1; hh = (t2 >> 1) & 7; b = t2 >> 4; nparts = 1; }
        const int nc = lat ? 16 : 2, ch0 = lat ? 32 + b * 16 : b * 2;
        const int nel = 8192 / nparts, e0 = part * nel, per = nel / NT;
        float c[16];
        const size_t so = ((((size_t)b * DEPTH + layer) * 2 + dir) * 8 + hh) * 8192;
#pragma unroll
        for (int i = 0; i < 16; ++i) if (i < per) c[i] = lat ? a.in[6][so + e0 + i * NT + tid] : 0.f;
        float nx[16]; float ntot;
        { const int ch = ch0 + (dir ? nc - 1 : 0); const size_t sb = (size_t)(ch * 8 + hh) * 2 + dir;
#pragma unroll
            for (int i = 0; i < 16; ++i) if (i < per) nx[i] = SST[sb * 8192 + e0 + i * NT + tid];
            ntot = SSL[sb]; }
        for (int s = 0; s < nc; ++s) { const int ci = dir ? nc - 1 - s : s, ch = ch0 + ci; const size_t sb = (size_t)(ch * 8 + hh) * 2 + dir;
            float cx[16];
#pragma unroll
            for (int i = 0; i < 16; ++i) if (i < per) cx[i] = nx[i];
            const float dec = __expf(ntot);
            if (s + 1 < nc) { const int ch2 = ch0 + (dir ? nc - 2 - s : s + 1); const size_t sb2 = (size_t)(ch2 * 8 + hh) * 2 + dir;
#pragma unroll
                for (int i = 0; i < 16; ++i) if (i < per) nx[i] = SST[sb2 * 8192 + e0 + i * NT + tid];
                ntot = SSL[sb2]; }
#pragma unroll
            for (int i = 0; i < 16; ++i) if (i < per) CS[sb * 8192 + e0 + i * NT + tid] = f2bf(c[i]);
#pragma unroll
            for (int i = 0; i < 16; ++i) if (i < per) c[i] = dec * c[i] + cx[i]; }
        if (!lat) {
#pragma unroll
            for (int i = 0; i < 16; ++i) if (i < per) a.out[O_SSD + so + e0 + i * NT + tid] = c[i]; }
    }
}
__device__ __forceinline__ void ssd_out_phase(const Args& a, int layer, int gw, int ngw, int lane_) {
    int lane = lane_; asm volatile("" : "+v"(lane));
    const int fr = lane & 15, fq = lane >> 4;
    const bf16_t* NAT = (const bf16_t*)(a.ws + WS_NAT); const bf16_t* TR = (const bf16_t*)(a.ws + WS_TR); const bf16_t* PROJ = (const bf16_t*)(a.ws + WS_PROJ);
    const bf16_t* CS = (const bf16_t*)(a.ws + WS_SSCS); float* YPRE = (float*)(a.ws + WS_YPRE); float* SSQ = (float*)(a.ws + WS_SSQ);
    for (int it = gw; it < NCH * 8 * 8; it += ngw) {
        const int wv = it & 7, hh = (it >> 3) & 7, ch = it >> 6, grp = hh >> 2; int row0, seq0, L, lat, b, ci, nc; chunk_info(ch, row0, seq0, L, lat, b, ci, nc);
        const int t = wv * 16 + fr;
        bf16x8 cf[4];
#pragma unroll
        for (int ks = 0; ks < 4; ++ks) cf[ks] = *(const bf16x8*)(NAT + (size_t)(row0 + t) * NATP + N_XBC + 768 + grp * 128 + 32 * ks + 8 * fq);
        f32x4 ysum[4];
#pragma unroll
        for (int j = 0; j < 4; ++j) ysum[j] = (f32x4){0.f, 0.f, 0.f, 0.f};
#pragma unroll
        for (int dir = 0; dir < 2; ++dir) {
            const size_t sb = (size_t)(ch * 8 + hh) * 2 + dir;
            const SsdGate g = ssd_gates(a, layer, row0, hh, dir, lane);
            float u0, u1, w0, w1, e0, e1;
            if (dir == 0) { u0 = -g.P0; u1 = -g.P1; w0 = g.P0; w1 = g.P1; e0 = __expf(g.P0); e1 = __expf(g.P1); }
            else { const float E0 = g.P0 - g.la0, E1 = g.P1 - g.la1; u0 = E0; u1 = E1; w0 = -E0; w1 = -E1; e0 = __expf(g.tot - E0); e1 = __expf(g.tot - E1); }
            const int tl = t & 63; const bool th = wv >= 4;
            const float wt = th ? __shfl(w1, tl) : __shfl(w0, tl), eot = th ? __shfl(e1, tl) : __shfl(e0, tl);
            f32x4 acc[4];
#pragma unroll
            for (int j = 0; j < 4; ++j) acc[j] = (f32x4){0.f, 0.f, 0.f, 0.f};
#pragma unroll
            for (int ks = 0; ks < 4; ++ks)
#pragma unroll
                for (int j = 0; j < 4; ++j) { const bf16x8 sf = *(const bf16x8*)(CS + sb * 8192 + (size_t)(16 * j + fr) * 128 + 32 * ks + 8 * fq); acc[j] = mfma16(sf, cf[ks], acc[j]); }
#pragma unroll
            for (int j = 0; j < 4; ++j) acc[j] *= eot;
            const int jlo = dir == 0 ? 0 : (wv >> 1), jhi = dir == 0 ? (wv >> 1) : 3;
            for (int jp = jlo; jp <= jhi; ++jp) {
                const int ta = 32 * jp + 8 * (fr >> 2) + (fr & 3);
                f32x4 sa = (f32x4){0.f, 0.f, 0.f, 0.f}, sb2 = (f32x4){0.f, 0.f, 0.f, 0.f};
#pragma unroll
                for (int ks = 0; ks < 4; ++ks) {
                    const bf16x8 ba = *(const bf16x8*)(NAT + (size_t)(row0 + ta) * NATP + N_XBC + 512 + grp * 128 + 32 * ks + 8 * fq);
                    const bf16x8 bb = *(const bf16x8*)(NAT + (size_t)(row0 + ta + 4) * NATP + N_XBC + 512 + grp * 128 + 32 * ks + 8 * fq);
                    sa = mfma16(ba, cf[ks], sa); sb2 = mfma16(bb, cf[ks], sb2); }
                float pa[4], pb[4];
#pragma unroll
                for (int i = 0; i < 4; ++i) { const int s0 = 32 * jp + 8 * fq + i, s1 = s0 + 4;
                    const float us0 = jp < 2 ? __shfl(u0, s0 & 63) : __shfl(u1, s0 & 63), us1 = jp < 2 ? __shfl(u0, s1 & 63) : __shfl(u1, s1 & 63);
                    const float d0 = jp < 2 ? __shfl(g.dt0, s0 & 63) : __shfl(g.dt1, s0 & 63), d1 = jp < 2 ? __shfl(g.dt0, s1 & 63) : __shfl(g.dt1, s1 & 63);
                    const bool ok0 = dir == 0 ? s0 <= t : s0 >= t, ok1 = dir == 0 ? s1 <= t : s1 >= t;
                    pa[i] = ok0 ? sa[i] * d0 * __expf(us0 + wt) : 0.f; pb[i] = ok1 ? sb2[i] * d1 * __expf(us1 + wt) : 0.f; }
                u32x4 pw; pw.x = pk2(pa[0], pa[1]); pw.y = pk2(pa[2], pa[3]); pw.z = pk2(pb[0], pb[1]); pw.w = pk2(pb[2], pb[3]);
                const bf16x8 pf = __builtin_bit_cast(bf16x8, pw);
#pragma unroll
                for (int j = 0; j < 4; ++j) { const bf16x8 xf = *(const bf16x8*)(TR + (size_t)(T_X + hh * 64 + 16 * j + fr) * M + row0 + 32 * jp + 8 * fq); acc[j] = mfma16(xf, pf, acc[j]); }
            }
#pragma unroll
            for (int j = 0; j < 4; ++j) ysum[j] += acc[j];
        }
        const float Dh = a.in[34][layer * 8 + hh]; float ss = 0.f;
#pragma unroll
        for (int j = 0; j < 4; ++j) { const int p = 16 * j + 4 * fq;
            const u32x2 xv = *(const u32x2*)(NAT + (size_t)(row0 + t) * NATP + N_XBC + hh * 64 + p), zv = *(const u32x2*)(PROJ + (size_t)(row0 + t) * PJ + P_Z + hh * 64 + p);
            f32x4 y; y[0] = (ysum[j][0] + bflo(xv.x) * Dh) * fsilu(bflo(zv.x)); y[1] = (ysum[j][1] + bfhi(xv.x) * Dh) * fsilu(bfhi(zv.x));
            y[2] = (ysum[j][2] + bflo(xv.y) * Dh) * fsilu(bflo(zv.y)); y[3] = (ysum[j][3] + bfhi(xv.y) * Dh) * fsilu(bfhi(zv.y));
            ss += (y[0] * y[0] + y[1] * y[1]) + (y[2] * y[2] + y[3] * y[3]);
            *(f32x4*)(YPRE + (size_t)(row0 + t) * 512 + hh * 64 + p) = y; }
        ss += __shfl_xor(ss, 16); ss += __shfl_xor(ss, 32);
        if (fq == 0) SSQ[(size_t)(row0 + t) * 8 + hh] = ss;
    }
}
__device__ __forceinline__ void ssd_fin_phase(const Args& a, int layer, int gw, int ngw, int lane_) {
    int lane = lane_; asm volatile("" : "+v"(lane));
    const float* YPRE = (const float*)(a.ws + WS_YPRE); const float* SSQ = (const float*)(a.ws + WS_SSQ); bf16_t* BR = (bf16_t*)(a.ws + WS_BR); const float* ng = a.in[35] + layer * 512;
    for (int row = gw; row < M; row += ngw) {
        float s = lane < 8 ? SSQ[(size_t)row * 8 + lane] : 0.f; s += __shfl_xor(s, 1); s += __shfl_xor(s, 2); s += __shfl_xor(s, 4); s = __shfl(s, 0);
        const float r = rsqrtf(s * (1.f / 512.f) + 1e-6f);
        const f32x4 y0 = *(const f32x4*)(YPRE + (size_t)row * 512 + 8 * lane), y1 = *(const f32x4*)(YPRE + (size_t)row * 512 + 8 * lane + 4);
        const f32x4 g0 = *(const f32x4*)(ng + 8 * lane), g1 = *(const f32x4*)(ng + 8 * lane + 4);
        *(u32x4*)(BR + (size_t)row * D + 1024 + 8 * lane) = pack8(y0 * r * g0, y1 * r * g1);
    }
}
}
namespace mk {
constexpr size_t WS_CK = WS_SSD_END;
constexpr size_t WS_CVT = AL(WS_CK + (size_t)16 * 512 * 512 * 2);
constexpr size_t WS_ATT_END = AL(WS_CVT + (size_t)16 * 512 * 512 * 2);

__device__ __forceinline__ void prologue_cache(const Args& a, int gw, int ngw, int lane) {
    bf16_t* CK = (bf16_t*)(a.ws + WS_CK); bf16_t* CVT = (bf16_t*)(a.ws + WS_CVT);
    for (size_t i = ((size_t)gw * 64 + lane) * 8; i < (size_t)16 * 512 * 512; i += (size_t)ngw * 64 * 8) {
        const f32x4 x0 = *(const f32x4*)(a.in[2] + i), x1 = *(const f32x4*)(a.in[2] + i + 4); *(u32x4*)(CK + i) = pack8(x0, x1); }
    for (size_t i = (size_t)gw * 64 + lane; i < (size_t)16 * 64 * 512; i += (size_t)ngw * 64) { const int c = i & 511, s8 = (i >> 9) & 63, bl = i >> 15;
        const float* src = a.in[3] + ((size_t)bl * 512 + 8 * s8) * 512 + c;
        u32x4 o; o.x = pk2(src[0], src[512]); o.y = pk2(src[1024], src[1536]); o.z = pk2(src[2048], src[2560]); o.w = pk2(src[3072], src[3584]);
        *(u32x4*)(CVT + ((size_t)bl * 512 + c) * 512 + 8 * s8) = o; }
}
struct AttState { float m, l; f32x4 o[4]; };
struct AttFrags { bf16x8 k[4]; const bf16_t* vt; size_t vp; };
__device__ __forceinline__ void attn_load(AttFrags& f, const bf16_t* kbase, size_t kp, const bf16_t* vt, size_t vp, int fr, int fq) {
    const int ra = 8 * (fr >> 2) + (fr & 3);
#pragma unroll
    for (int ks = 0; ks < 2; ++ks) { f.k[ks] = *(const bf16x8*)(kbase + (size_t)ra * kp + 32 * ks + 8 * fq); f.k[2 + ks] = *(const bf16x8*)(kbase + (size_t)(ra + 4) * kp + 32 * ks + 8 * fq); }
    f.vt = vt + (size_t)fr * vp + 8 * fq; f.vp = vp;
}
template <bool MASKED>
__device__ __forceinline__ void attn_compute(AttState& st, const bf16x8 (&qf)[2], const AttFrags& f, int fq, const float* bias, int kc0, int cq, int cs) {
    bf16x8 vf[4];
#pragma unroll
    for (int j = 0; j < 4; ++j) vf[j] = *(const bf16x8*)(f.vt + (size_t)(16 * j) * f.vp);
    f32x4 sa = (f32x4){0.f, 0.f, 0.f, 0.f}, sb = (f32x4){0.f, 0.f, 0.f, 0.f};
#pragma unroll
    for (int ks = 0; ks < 2; ++ks) { sa = mfma16(f.k[ks], qf[ks], sa); sb = mfma16(f.k[2 + ks], qf[ks], sb); }
    float s[8]; float gm = -1e30f;
#pragma unroll
    for (int i = 0; i < 4; ++i) { s[i] = sa[i] * 0.125f; s[4 + i] = sb[i] * 0.125f; }
    if (MASKED) {
#pragma unroll
        for (int e = 0; e < 8; ++e) { const int kc = kc0 + 8 * fq + e; const bool ok = kc >= cs && kc < cs + 16; const int bi = min(max(kc - cq + 15, 0), 30); s[e] = ok ? s[e] + bias[bi] : -1e30f; }
    }
#pragma unroll
    for (int e = 0; e < 8; ++e) gm = fmaxf(gm, s[e]);
    gm = fmaxf(gm, __shfl_xor(gm, 16)); gm = fmaxf(gm, __shfl_xor(gm, 32));
    const float mn = fmaxf(st.m, gm), al = __expf(st.m - mn); st.m = mn;
    float p[8], ps = 0.f;
#pragma unroll
    for (int e = 0; e < 8; ++e) { p[e] = __expf(s[e] - mn); ps += p[e]; }
    st.l = st.l * al + ps;
    u32x4 pw; pw.x = pk2(p[0], p[1]); pw.y = pk2(p[2], p[3]); pw.z = pk2(p[4], p[5]); pw.w = pk2(p[6], p[7]);
    const bf16x8 pf = __builtin_bit_cast(bf16x8, pw);
#pragma unroll
    for (int j = 0; j < 4; ++j) st.o[j] = mfma16(vf[j], pf, st.o[j] * al);
}
__device__ __forceinline__ void attn_compute2(AttState& s0, AttState& s1, const bf16x8 (&q0)[2], const bf16x8 (&q1)[2], const AttFrags& f, int fq) {
    bf16x8 vf[4];
#pragma unroll
    for (int j = 0; j < 4; ++j) vf[j] = *(const bf16x8*)(f.vt + (size_t)(16 * j) * f.vp);
    f32x4 a0 = (f32x4){0.f, 0.f, 0.f, 0.f}, b0 = a0, a1 = a0, b1 = a0;
#pragma unroll
    for (int ks = 0; ks < 2; ++ks) { a0 = mfma16(f.k[ks], q0[ks], a0); b0 = mfma16(f.k[2 + ks], q0[ks], b0); a1 = mfma16(f.k[ks], q1[ks], a1); b1 = mfma16(f.k[2 + ks], q1[ks], b1); }
    float x0[8], x1[8]; float g0 = -1e30f, g1 = -1e30f;
#pragma unroll
    for (int i = 0; i < 4; ++i) { x0[i] = a0[i] * 0.125f; x0[4 + i] = b0[i] * 0.125f; x1[i] = a1[i] * 0.125f; x1[4 + i] = b1[i] * 0.125f; }
#pragma unroll
    for (int e = 0; e < 8; ++e) { g0 = fmaxf(g0, x0[e]); g1 = fmaxf(g1, x1[e]); }
    g0 = fmaxf(g0, __shfl_xor(g0, 16)); g1 = fmaxf(g1, __shfl_xor(g1, 16)); g0 = fmaxf(g0, __shfl_xor(g0, 32)); g1 = fmaxf(g1, __shfl_xor(g1, 32));
    const float m0 = fmaxf(s0.m, g0), al0 = __expf(s0.m - m0), m1 = fmaxf(s1.m, g1), al1 = __expf(s1.m - m1); s0.m = m0; s1.m = m1;
    float p0 = 0.f, p1 = 0.f;
#pragma unroll
    for (int e = 0; e < 8; ++e) { x0[e] = __expf(x0[e] - m0); p0 += x0[e]; x1[e] = __expf(x1[e] - m1); p1 += x1[e]; }
    s0.l = s0.l * al0 + p0; s1.l = s1.l * al1 + p1;
    u32x4 w0, w1; w0.x = pk2(x0[0], x0[1]); w0.y = pk2(x0[2], x0[3]); w0.z = pk2(x0[4], x0[5]); w0.w = pk2(x0[6], x0[7]); w1.x = pk2(x1[0], x1[1]); w1.y = pk2(x1[2], x1[3]); w1.z = pk2(x1[4], x1[5]); w1.w = pk2(x1[6], x1[7]);
    const bf16x8 f0 = __builtin_bit_cast(bf16x8, w0), f1 = __builtin_bit_cast(bf16x8, w1);
#pragma unroll
    for (int j = 0; j < 4; ++j) { s0.o[j] = mfma16(vf[j], f0, s0.o[j] * al0); s1.o[j] = mfma16(vf[j], f1, s1.o[j] * al1); }
}
__device__ __forceinline__ void attn_store(const AttState& st, bf16_t* BR, int qrow, int hh, int fq) {
    float l = st.l; l += __shfl_xor(l, 16); l += __shfl_xor(l, 32);
    const float rl = 1.f / l;
#pragma unroll
    for (int j = 0; j < 4; ++j) { u32x2 w; w.x = pk2(st.o[j][0] * rl, st.o[j][1] * rl); w.y = pk2(st.o[j][2] * rl, st.o[j][3] * rl);
        *(u32x2*)(BR + (size_t)qrow * D + hh * 64 + 16 * j + 4 * fq) = w; }
}
__device__ __forceinline__ void attn_phase(const Args& a, int layer, int gw_, int ngw, int lane_) {
    int lane = lane_, gw = gw_; asm volatile("" : "+v"(lane));
    const int fr = lane & 15, fq = lane >> 4;
    const bf16_t* PROJ = (const bf16_t*)(a.ws + WS_PROJ); const bf16_t* TR = (const bf16_t*)(a.ws + WS_TR); bf16_t* BR = (bf16_t*)(a.ws + WS_BR);
    const bf16_t* CK = (const bf16_t*)(a.ws + WS_CK); const bf16_t* CVT = (const bf16_t*)(a.ws + WS_CVT);
    for (int it = gw; it < 3072; it += ngw) {
        AttState s0, s1; s0.m = -1e30f; s0.l = 0.f; s1.m = -1e30f; s1.l = 0.f;
#pragma unroll
        for (int j = 0; j < 4; ++j) { s0.o[j] = (f32x4){0.f, 0.f, 0.f, 0.f}; s1.o[j] = (f32x4){0.f, 0.f, 0.f, 0.f}; }
        AttFrags fa, fb; bf16x8 q0[2], q1[2];
        if (it < 2048) {
            const int jp = it & 1, r = (it >> 1) & 31, hh = (it >> 6) & 7, b = it >> 9;
            const int seq0 = MP + b * 2048, qrow = seq0 + r * 64 + 32 * jp + fr;
#pragma unroll
            for (int ks = 0; ks < 2; ++ks) { q0[ks] = *(const bf16x8*)(PROJ + (size_t)qrow * PJ + P_Q + hh * 64 + 32 * ks + 8 * fq); q1[ks] = *(const bf16x8*)(PROJ + (size_t)(qrow + 16) * PJ + P_Q + hh * 64 + 32 * ks + 8 * fq); }
            const int rs = min(max(r - 4, 0), 24);
            const float* rpb = a.in[19] + ((size_t)layer * 8 + hh) * 15 * 31;
            const size_t cb = ((size_t)b * DEPTH + layer) * 512; const bf16_t* kc = CK + cb * 512 + hh * 64; const bf16_t* vc = CVT + (cb + hh * 64) * 512;
#pragma unroll 1
            for (int qt = 0; qt < 2; ++qt) { const int jq = 2 * jp + qt, cq = 16 * jq + fr, cs = min(max(cq - 8, 0), 48), kc0 = jq == 0 ? 0 : (jq == 1 ? 8 : (jq == 2 ? 24 : 32));
                const bf16_t* kw = PROJ + (size_t)(seq0 + rs * 64 + kc0) * PJ + P_K + hh * 64; const bf16_t* vw = TR + (size_t)(T_V + hh * 64) * M + seq0 + rs * 64 + kc0;
                AttState& st = qt == 0 ? s0 : s1; const bf16x8 (&qf)[2] = qt == 0 ? q0 : q1;
                attn_load(fa, kw, PJ, vw, M, fr, fq);
#pragma unroll 1
                for (int j = 0; j < 8; j += 2) {
                    attn_load(fb, kw + (size_t)(j + 1) * 64 * PJ, PJ, vw + (j + 1) * 64, M, fr, fq);
                    attn_compute<true>(st, qf, fa, fq, rpb + (rs + j - r + 7) * 31, kc0, cq, cs);
                    if (j + 2 < 8) attn_load(fa, kw + (size_t)(j + 2) * 64 * PJ, PJ, vw + (j + 2) * 64, M, fr, fq);
                    attn_compute<true>(st, qf, fb, fq, rpb + (rs + j + 1 - r + 7) * 31, kc0, cq, cs);
                }
            }
            attn_load(fa, kc, 512, vc, 512, fr, fq);
#pragma unroll 1
            for (int g = 0; g < 16; g += 2) {
                attn_load(fb, kc + (size_t)(32 * (g + 1)) * 512, 512, vc + 32 * (g + 1), 512, fr, fq);
                attn_compute2(s0, s1, q0, q1, fa, fq);
                if (g + 2 < 16) attn_load(fa, kc + (size_t)(32 * (g + 2)) * 512, 512, vc + 32 * (g + 2), 512, fr, fq);
                attn_compute2(s0, s1, q0, q1, fb, fq);
            }
            attn_store(s0, BR, qrow, hh, fq); attn_store(s1, BR, qrow + 16, hh, fq);
        } else {
            const int i2 = it - 2048, qp = i2 & 7, hh = (i2 >> 3) & 7, b = i2 >> 6, seq0 = b * 256, qrow = seq0 + 32 * qp + fr;
#pragma unroll
            for (int ks = 0; ks < 2; ++ks) { q0[ks] = *(const bf16x8*)(PROJ + (size_t)qrow * PJ + P_Q + hh * 64 + 32 * ks + 8 * fq); q1[ks] = *(const bf16x8*)(PROJ + (size_t)(qrow + 16) * PJ + P_Q + hh * 64 + 32 * ks + 8 * fq); }
            const bf16_t* kp = PROJ + (size_t)seq0 * PJ + P_K + hh * 64; const bf16_t* vp = TR + (size_t)(T_V + hh * 64) * M + seq0;
            attn_load(fa, kp, PJ, vp, M, fr, fq);
#pragma unroll 1
            for (int g = 0; g < 8; g += 2) {
                attn_load(fb, kp + (size_t)(32 * (g + 1)) * PJ, PJ, vp + 32 * (g + 1), M, fr, fq);
                attn_compute2(s0, s1, q0, q1, fa, fq);
                if (g + 2 < 8) attn_load(fa, kp + (size_t)(32 * (g + 2)) * PJ, PJ, vp + 32 * (g + 2), M, fr, fq);
                attn_compute2(s0, s1, q0, q1, fb, fq);
            }
            attn_store(s0, BR, qrow, hh, fq); attn_store(s1, BR, qrow + 16, hh, fq);
        }
    }
}
}
namespace mk {
constexpr int S5K = 768;
constexpr size_t WS_S5W = WS_ATT_END;
constexpr size_t WS_S5WS = AL(WS_S5W + (size_t)DEPTH * 32 * 512 * S5K * 2);
constexpr size_t WS_S5AP = AL(WS_S5WS + (size_t)DEPTH * 32 * 256 * 512 * 2);
constexpr size_t WS_S5UP = AL(WS_S5AP + (size_t)DEPTH * 32 * 2 * 64 * 2 * 4);
constexpr size_t WS_S5SS = AL(WS_S5UP + (size_t)32 * 384 * 512 * 2);
constexpr size_t WS_S5HS = AL(WS_S5SS + (size_t)32 * 384 * 256 * 4);
constexpr size_t WS_S5_END = AL(WS_S5HS + (size_t)32 * 384 * 256 * 2);

__device__ __forceinline__ void s5_param_task(const Args& a, LAS unsigned char* lds, int tid_, int task) {
    int tid = tid_; asm volatile("" : "+v"(tid));
    LAS float* PW = (LAS float*)lds; LAS float* BB = PW + 2 * 33 * 64 * 2; LAS float* CC = BB + 2 * 64 * 16 * 2; LAS float* KT = CC + 2 * 16 * 64 * 2;
    {
        const int layer = task >> 5, g = task & 31;
        const float* a_re = a.in[20] + layer * 4096; const float* a_im = a.in[21] + layer * 4096; const float* log_dt = a.in[22] + layer * 64;
        const float* b_re = a.in[23] + (size_t)layer * 65536; const float* b_im = a.in[24] + (size_t)layer * 65536; const float* c_re = a.in[25] + (size_t)layer * 65536; const float* c_im = a.in[26] + (size_t)layer * 65536;
        const float* s5d = a.in[27] + layer * 512;
        bf16_t* S5W = (bf16_t*)(a.ws + WS_S5W) + (size_t)layer * 32 * 512 * S5K; bf16_t* S5WS = (bf16_t*)(a.ws + WS_S5WS) + (size_t)layer * 32 * 256 * 512; float* S5AP = (float*)(a.ws + WS_S5AP) + (size_t)layer * 32 * 2 * 64 * 2;
        __syncthreads();
        if (tid < 128) { const int dir = tid >> 6, n = tid & 63, pi = (dir * 32 + g) * 64 + n;
            const float are = fminf(a_re[pi], -1e-4f), aim = a_im[pi], dt = expf(log_dt[dir * 32 + g]);
            const float mag = expf(dt * are), abr = mag * cosf(dt * aim), abi = mag * sinf(dt * aim);
            const float den = are * are + aim * aim, nr = abr - 1.f, cfr = (nr * are + abi * aim) / den, cfi = (abi * are - nr * aim) / den;
            float pr = 1.f, pim = 0.f;
            for (int p = 0; p <= 32; ++p) { PW[((dir * 33 + p) * 64 + n) * 2] = pr; PW[((dir * 33 + p) * 64 + n) * 2 + 1] = pim; const float t = pr * abr - pim * abi; pim = pr * abi + pim * abr; pr = t; }
            S5AP[((g * 2 + dir) * 64 + n) * 2] = PW[((dir * 33 + 32) * 64 + n) * 2]; S5AP[((g * 2 + dir) * 64 + n) * 2 + 1] = PW[((dir * 33 + 32) * 64 + n) * 2 + 1];
            for (int k = 0; k < 16; ++k) { const float br_ = b_re[(size_t)pi * 16 + k], bi_ = b_im[(size_t)pi * 16 + k];
                BB[((dir * 64 + n) * 16 + k) * 2] = cfr * br_ - cfi * bi_; BB[((dir * 64 + n) * 16 + k) * 2 + 1] = cfr * bi_ + cfi * br_; }
            for (int j = 0; j < 16; ++j) { CC[((dir * 64 + n) * 16 + j) * 2] = c_re[((size_t)(dir * 32 + g) * 16 + j) * 64 + n]; CC[((dir * 64 + n) * 16 + j) * 2 + 1] = c_im[((size_t)(dir * 32 + g) * 16 + j) * 64 + n]; }
        }
        __syncthreads();
        for (int e = tid; e < 2 * 32 * 256; e += NT) { const int j = e & 15, k = (e >> 4) & 15, tau = (e >> 8) & 31, dir = e >> 13; float s = 0.f;
            for (int n = 0; n < 64; ++n) { const float cr = CC[((dir * 64 + n) * 16 + j) * 2], ci = CC[((dir * 64 + n) * 16 + j) * 2 + 1], pr = PW[((dir * 33 + tau) * 64 + n) * 2], pim = PW[((dir * 33 + tau) * 64 + n) * 2 + 1];
                const float xr = cr * pr - ci * pim, xi = cr * pim + ci * pr, br_ = BB[((dir * 64 + n) * 16 + k) * 2], bi_ = BB[((dir * 64 + n) * 16 + k) * 2 + 1];
                s += xr * br_ - xi * bi_; }
            KT[e] = s; }
        __syncthreads();
        { const int t = tid >> 4, j = tid & 15; bf16_t* dst = S5W + ((size_t)g * 512 + tid) * S5K;
            for (int s = 0; s < 32; ++s) { float v[16];
#pragma unroll
                for (int k = 0; k < 16; ++k) { float x;
                    if (s < t) x = KT[((0 * 32 + (t - s)) * 16 + k) * 16 + j]; else if (s > t) x = KT[((1 * 32 + (s - t)) * 16 + k) * 16 + j];
                    else x = KT[((0 * 32 + 0) * 16 + k) * 16 + j] + KT[((1 * 32 + 0) * 16 + k) * 16 + j] + (k == j ? s5d[g * 16 + k] : 0.f);
                    v[k] = x; }
                u32x4 o0, o1; o0.x = pk2(v[0], v[1]); o0.y = pk2(v[2], v[3]); o0.z = pk2(v[4], v[5]); o0.w = pk2(v[6], v[7]); o1.x = pk2(v[8], v[9]); o1.y = pk2(v[10], v[11]); o1.z = pk2(v[12], v[13]); o1.w = pk2(v[14], v[15]);
                *(u32x4*)(dst + s * 16) = o0; *(u32x4*)(dst + s * 16 + 8) = o1; }
            for (int dir = 0; dir < 2; ++dir) { const int p = dir == 0 ? t + 1 : 32 - t;
                for (int n8 = 0; n8 < 8; ++n8) { float gr[8], gi[8];
#pragma unroll
                    for (int q = 0; q < 8; ++q) { const int n = n8 * 8 + q; const float cr = CC[((dir * 64 + n) * 16 + j) * 2], ci = CC[((dir * 64 + n) * 16 + j) * 2 + 1], pr = PW[((dir * 33 + p) * 64 + n) * 2], pim = PW[((dir * 33 + p) * 64 + n) * 2 + 1];
                        gr[q] = cr * pr - ci * pim; gi[q] = -(cr * pim + ci * pr); }
                    u32x4 o; o.x = pk2(gr[0], gr[1]); o.y = pk2(gr[2], gr[3]); o.z = pk2(gr[4], gr[5]); o.w = pk2(gr[6], gr[7]); *(u32x4*)(dst + 512 + dir * 128 + n8 * 8) = o;
                    o.x = pk2(gi[0], gi[1]); o.y = pk2(gi[2], gi[3]); o.z = pk2(gi[4], gi[5]); o.w = pk2(gi[6], gi[7]); *(u32x4*)(dst + 512 + dir * 128 + 64 + n8 * 8) = o; } }
        }
        if (tid < 256) { const int dir = tid >> 7, reim = (tid >> 6) & 1, n = tid & 63; bf16_t* dst = S5WS + ((size_t)g * 256 + tid) * 512;
            for (int s = 0; s < 32; ++s) { const int p = dir == 0 ? 31 - s : s; const float pr = PW[((dir * 33 + p) * 64 + n) * 2], pim = PW[((dir * 33 + p) * 64 + n) * 2 + 1]; float v[16];
#pragma unroll
                for (int k = 0; k < 16; ++k) { const float br_ = BB[((dir * 64 + n) * 16 + k) * 2], bi_ = BB[((dir * 64 + n) * 16 + k) * 2 + 1]; v[k] = reim == 0 ? pr * br_ - pim * bi_ : pr * bi_ + pim * br_; }
                u32x4 o0, o1; o0.x = pk2(v[0], v[1]); o0.y = pk2(v[2], v[3]); o0.z = pk2(v[4], v[5]); o0.w = pk2(v[6], v[7]); o1.x = pk2(v[8], v[9]); o1.y = pk2(v[10], v[11]); o1.z = pk2(v[12], v[13]); o1.w = pk2(v[14], v[15]);
                *(u32x4*)(dst + s * 16) = o0; *(u32x4*)(dst + s * 16 + 8) = o1; } }
    }
    __syncthreads();
}
__device__ __forceinline__ void s5_statein_phase(const Args& a, int layer, int gw, int ngw, int lane_) {
    int lane = lane_; asm volatile("" : "+v"(lane));
    const int fr = lane & 15, fq = lane >> 4;
    const bf16_t* UP = (const bf16_t*)(a.ws + WS_S5UP); const bf16_t* S5WS = (const bf16_t*)(a.ws + WS_S5WS) + (size_t)layer * 32 * 256 * 512; float* SS = (float*)(a.ws + WS_S5SS);
    for (int it = ngw - 1 - gw; it < 32 * 24; it += ngw) { const int g = it / 24, r = it % 24, og = r / 6, cq = r % 6;
        f32x4 acc[4][4];
#pragma unroll
        for (int i = 0; i < 4; ++i)
#pragma unroll
            for (int j = 0; j < 4; ++j) acc[i][j] = (f32x4){0.f, 0.f, 0.f, 0.f};
        const bf16_t* ap = S5WS + ((size_t)g * 256 + 64 * og + fr) * 512 + 8 * fq; const bf16_t* bp = UP + ((size_t)g * 384 + 64 * cq + fr) * 512 + 8 * fq;
#pragma unroll 2
        for (int ks = 0; ks < 16; ++ks) { bf16x8 af[4], bf[4];
#pragma unroll
            for (int i = 0; i < 4; ++i) { af[i] = *(const bf16x8*)(ap + (size_t)16 * i * 512 + 32 * ks); bf[i] = *(const bf16x8*)(bp + (size_t)16 * i * 512 + 32 * ks); }
#pragma unroll
            for (int i = 0; i < 4; ++i)
#pragma unroll
                for (int j = 0; j < 4; ++j) acc[i][j] = mfma16(af[i], bf[j], acc[i][j]); }
#pragma unroll
        for (int i = 0; i < 4; ++i)
#pragma unroll
            for (int j = 0; j < 4; ++j) *(f32x4*)(SS + ((size_t)g * 384 + 64 * cq + 16 * j + fr) * 256 + 64 * og + 16 * i + 4 * fq) = acc[i][j];
    }
}
__device__ __forceinline__ void s5_scan_phase(const Args& a, int layer, int gw, int ngw, int lane_) {
    int lane = lane_; asm volatile("" : "+v"(lane));
    const float* SS = (const float*)(a.ws + WS_S5SS); bf16_t* HS = (bf16_t*)(a.ws + WS_S5HS); const float* S5AP = (const float*)(a.ws + WS_S5AP) + (size_t)layer * 32 * 2 * 64 * 2;
    for (int task = gw; task < 1280; task += ngw) {
        int sq, g, dir; if (task < 256) { sq = 16 + (task >> 6); g = (task >> 1) & 31; dir = task & 1; } else { const int t2 = task - 256; sq = t2 >> 6; g = (t2 >> 1) & 31; dir = t2 & 1; }
        const int lat = sq >= 16, b = lat ? sq - 16 : sq, nc = lat ? 64 : 8, cg0 = lat ? 128 + b * 64 : b * 8;
        const float apr = S5AP[((g * 2 + dir) * 64 + lane) * 2], api = S5AP[((g * 2 + dir) * 64 + lane) * 2 + 1];
        float hr = 0.f, hi = 0.f;
        if (lat) { const size_t so = ((((size_t)b * DEPTH + layer) * 2 + dir) * 32 + g) * 64 + lane; hr = a.in[4][so]; hi = a.in[5][so]; }
        for (int s0 = 0; s0 < nc; s0 += 8) {
            float sr[8], si[8];
#pragma unroll
            for (int q = 0; q < 8; ++q) { const int cg = cg0 + (dir ? nc - 1 - (s0 + q) : s0 + q); const size_t base = ((size_t)g * 384 + cg) * 256 + dir * 128; sr[q] = SS[base + lane]; si[q] = SS[base + 64 + lane]; }
#pragma unroll
            for (int q = 0; q < 8; ++q) { const int cg = cg0 + (dir ? nc - 1 - (s0 + q) : s0 + q); const size_t base = ((size_t)g * 384 + cg) * 256 + dir * 128;
                HS[base + lane] = f2bf(hr); HS[base + 64 + lane] = f2bf(hi);
                const float t = apr * hr - api * hi + sr[q]; hi = apr * hi + api * hr + si[q]; hr = t; }
        }
        if (!lat) { const size_t oo = ((((size_t)b * DEPTH + layer) * 2 + dir) * 32 + g) * 64 + lane; a.out[O_S5R + oo] = hr; a.out[O_S5I + oo] = hi; }
    }
}
__device__ __forceinline__ void s5_out_phase(const Args& a, int layer, int gw, int ngw, int lane_) {
    int lane = lane_; asm volatile("" : "+v"(lane));
    const int fr = lane & 15, fq = lane >> 4;
    const bf16_t* UP = (const bf16_t*)(a.ws + WS_S5UP); const bf16_t* S5W = (const bf16_t*)(a.ws + WS_S5W) + (size_t)layer * 32 * 512 * S5K; const bf16_t* HS = (const bf16_t*)(a.ws + WS_S5HS); bf16_t* ZB = (bf16_t*)(a.ws + WS_ZB);
    for (int it = ngw - 1 - gw; it < 32 * 48; it += ngw) { const int g = it / 48, r = it % 48, og = r / 6, cq = r % 6;
        f32x4 acc[4][4];
#pragma unroll
        for (int i = 0; i < 4; ++i)
#pragma unroll
            for (int j = 0; j < 4; ++j) acc[i][j] = (f32x4){0.f, 0.f, 0.f, 0.f};
        const bf16_t* ap = S5W + ((size_t)g * 512 + 64 * og + fr) * S5K + 8 * fq;
        const bf16_t* bp = UP + ((size_t)g * 384 + 64 * cq + fr) * 512 + 8 * fq; const bf16_t* hp = HS + ((size_t)g * 384 + 64 * cq + fr) * 256 + 8 * fq;
#pragma unroll 2
        for (int ks = 0; ks < 16; ++ks) { bf16x8 af[4], bf[4];
#pragma unroll
            for (int i = 0; i < 4; ++i) { af[i] = *(const bf16x8*)(ap + (size_t)16 * i * S5K + 32 * ks); bf[i] = *(const bf16x8*)(bp + (size_t)16 * i * 512 + 32 * ks); }
#pragma unroll
            for (int i = 0; i < 4; ++i)
#pragma unroll
                for (int j = 0; j < 4; ++j) acc[i][j] = mfma16(af[i], bf[j], acc[i][j]); }
#pragma unroll 2
        for (int ks = 0; ks < 8; ++ks) { bf16x8 af[4], bf[4];
#pragma unroll
            for (int i = 0; i < 4; ++i) { af[i] = *(const bf16x8*)(ap + (size_t)16 * i * S5K + 512 + 32 * ks); bf[i] = *(const bf16x8*)(hp + (size_t)16 * i * 256 + 32 * ks); }
#pragma unroll
            for (int i = 0; i < 4; ++i)
#pragma unroll
                for (int j = 0; j < 4; ++j) acc[i][j] = mfma16(af[i], bf[j], acc[i][j]); }
#pragma unroll
        for (int i = 0; i < 4; ++i)
#pragma unroll
            for (int j = 0; j < 4; ++j) { float z[4];
#pragma unroll
                for (int e = 0; e < 4; ++e) { const float x = acc[i][j][e]; const float th = 0.7978845608028654f * (x + 0.044715f * x * x * x); const float e2 = __expf(2.f * th); const float tnh = 1.f - 2.f * __builtin_amdgcn_rcpf(e2 + 1.f); z[e] = 0.5f * x * (1.f + tnh); }
                u32x2 w; w.x = pk2(z[0], z[1]); w.y = pk2(z[2], z[3]);
                *(u32x2*)(ZB + (size_t)(32 * (64 * cq + 16 * j + fr) + 4 * og + i) * 512 + g * 16 + 4 * fq) = w; }
    }
}
}
namespace mk { static_assert(WS_S5_END < (size_t)1780 * 1024 * 1024, "workspace map exceeds the guaranteed size"); }
namespace mk {
#ifndef PHMASK
#define PHMASK 0xfffff
#endif
#define PHM(k) ((PHMASK >> (k)) & 1)
#ifndef DUPMASK
#define DUPMASK 0
#endif
#define DUP(k) ((DUPMASK >> (k)) & 1)
constexpr int NPH = 12;
constexpr int PH_TOTAL = 2 + DEPTH * NPH;
__global__ void __launch_bounds__(NT, 2) mk_fwd(Args a) {
    extern __shared__ __attribute__((aligned(16))) unsigned char lds_raw[];
    LAS unsigned char* lds = (LAS unsigned char*)lds_raw;
#define TID ((int)threadIdx.x)
#define LANE ((int)(threadIdx.x & 63))
#define WAVE (__builtin_amdgcn_readfirstlane((int)(threadIdx.x >> 6)))
#define GW ((int)blockIdx.x * NWV + WAVE)
    const int G = gridDim.x, ngw = G * NWV;
    volatile LAS unsigned* ctlw = (volatile LAS unsigned*)(lds + LDS_CTL);
    if (TID < 64) ctlw[TID] = 0u;
    __syncthreads();
    XcdBarrier bar = xcd_barrier_post((unsigned*)(a.ws + WS_CTL), ctlw);
    if (TPROBE >= 0 && TID == 0) { const unsigned long long t_ = wall_clock64(); ctlw[16] = (unsigned)t_; ctlw[17] = (unsigned)(t_ >> 32); }
    const int lo = a.ph_lo, hi = a.ph_hi;
#define IN(k) (lo <= (k) && (k) < hi)
#ifndef TPROBE
#define TPROBE -1
#endif
#define TSTAMP(kind) do { if (TPROBE >= 0 && blockIdx.x == 0 && TID == 0) { const unsigned long long t_ = wall_clock64(); const unsigned long long p_ = ((unsigned long long)ctlw[17] << 32) | ctlw[16]; \
    volatile LAS float* ta_ = (volatile LAS float*)(ctlw + 24); ta_[kind] = ta_[kind] + (float)(t_ - p_); ctlw[16] = (unsigned)t_; ctlw[17] = (unsigned)(t_ >> 32); } } while (0)
#define SEAM(k) do { if (IN(k) && IN((k) + 1)) { xcd_barrier(bar); if (DUP(13)) xcd_barrier(bar); TSTAMP((k) == 0 ? 0 : 1 + ((k) - 1) % NPH); } } while (0)
#define H ((bf16_t*)(a.ws + WS_H))
#define PROJ ((bf16_t*)(a.ws + WS_PROJ))
#define SMALL ((float*)(a.ws + WS_SMALL))
#define BR ((bf16_t*)(a.ws + WS_BR))
#define MERGED ((bf16_t*)(a.ws + WS_MERGED))
#define MACC ((float*)(a.ws + WS_MACC))
#define ZB ((bf16_t*)(a.ws + WS_ZB))
#define HID ((bf16_t*)(a.ws + WS_PROJ))
#define MOD ((const float*)(a.ws + WS_MOD))
#define X (a.out)
    if (PHM(0) && IN(0)) {
        for (int it = GW; it < CM_ITEMS; it += ngw) colmax_item(a, (unsigned*)(a.ws + WS_WSC), it, LANE);
        xcd_barrier(bar);
        for (int rep_ = 0; rep_ < 1 + DUP(17); ++rep_) {
        unsigned* qhead = (unsigned*)(a.ws + WS_CTL) + 8192 + 64 * rep_;
        volatile LAS unsigned* qitem = ctlw + 8;
        for (;;) {
            __syncthreads();
            if (TID == 0) qitem[0] = __hip_atomic_fetch_add(qhead, 1u, __ATOMIC_RELAXED, __HIP_MEMORY_SCOPE_AGENT);
            __syncthreads();
            int item = (int)qitem[0];
            if (item >= DEPTH * 32 + PRO_NADA + PRO_NCACHE) break;
            if (item < DEPTH * 32) { s5_param_task(a, lds, TID, item); continue; } item -= DEPTH * 32;
            if (item < PRO_NADA) { prologue_ada_unit(a, lds, TID, item); continue; } item -= PRO_NADA;
            prologue_cache(a, item * NWV + WAVE, PRO_NCACHE * NWV, LANE);
        }
        }
        conv_pull(a, lds, ctlw + 8, 0, -1);
    }
    SEAM(0);
    for (int l = 0; l < DEPTH; ++l) {
        const int pb = 1 + l * NPH;
#define xp (l == 0 ? a.in[0] : X)
#define xs (l == 0 ? a.in[1] : X + (size_t)MP * D)
#define modl (MOD + (size_t)l * 5 * 6 * D)
#define wl ((const bf16_t*)(a.ws + WS_W) + (size_t)l * W_LAYER)
        if (PHM(1) && IN(pb + 0) && l > 0) conv_pull(a, lds, ctlw + 8, l, -1);
        if (PHM(1) && IN(pb + 0)) norm_phase(xp, xs, a.in[14] + l * D, modl, 0, D, H, GW, ngw, LANE, l > 0 ? MACC : nullptr, modl - (size_t)5 * 6 * D, 5 * D, X, xs, a.ws + WS_H8);
        SEAM(pb + 0);
        if (PHM(2) && IN(pb + 1)) {
            { Gemm g8{(const bf16_t*)(a.ws + WS_H8), wl + W_IN8, M, 8192, 1024, 1024, 1, 0, 0}; StaticOrder S; S.init(M, 8192, G, blockIdx.x, 1, 1024);
              EpiInT<true> E{PROJ, SMALL, a.out, a.in[17] + l * 64, a.in[18] + l * 64, l}; gemm_phase(lds, g8, S, E); }
            { Gemm g{H, wl + W_IN, M, 5888, D, D, 1, 0, 0}; StaticOrder S; S.init(M, 5888, G, blockIdx.x, 1, D);
              EpiInT<false> E{PROJ, SMALL, a.out, a.in[17] + l * 64, a.in[18] + l * 64, l}; gemm_phase(lds, g, S, E); }
            if (l + 1 < DEPTH && (int)blockIdx.x >= 80) conv_pull(a, lds, ctlw + 8, l + 1, 1); }
        SEAM(pb + 1);
        if (PHM(3) && IN(pb + 2)) { for (int r_ = 0; r_ < 1 + DUP(0); ++r_) { prep_phase(a, l, lds, GW, ngw, WAVE, LANE, (bf16_t*)(a.ws + WS_S5UP)); __syncthreads(); } }
        SEAM(pb + 2);
        if (PHM(4) && IN(pb + 3)) { for (int r_ = 0; r_ < 1 + DUP(2); ++r_) attn_phase(a, l, GW, ngw, LANE); for (int r_ = 0; r_ < 1 + DUP(3); ++r_) { ml_states_phase(a, l, TID, G); ssd_states_phase(a, l, TID, G); s5_statein_phase(a, l, GW, ngw, LANE); } }
        SEAM(pb + 3);
        if (PHM(5) && IN(pb + 4)) { for (int r_ = 0; r_ < 1 + DUP(4); ++r_) { ml_scan_phase(a, l, TID, G); ssd_scan_phase(a, l, TID, G); s5_scan_phase(a, l, GW, ngw, LANE); } }
        SEAM(pb + 4);
        if (PHM(12) && IN(pb + 5)) { for (int r_ = 0; r_ < 1 + DUP(5); ++r_) ml_out_phase(a, l, GW, ngw, LANE); for (int r_ = 0; r_ < 1 + DUP(6); ++r_) ssd_out_phase(a, l, GW, ngw, LANE); for (int r_ = 0; r_ < 1 + DUP(7); ++r_) s5_out_phase(a, l, GW, ngw, LANE); }
        SEAM(pb + 5);
        if (PHM(6) && IN(pb + 6)) { Gemm g{ZB, wl + W_GLU, M, 512, 512, 512, 1, 0, 0}; StaticOrder S; S.init(M, 512, G, blockIdx.x, 1, 512);
            EpiGlu E{ZB, a.in[29] + l * 512, BR}; for (int r_ = 0; r_ < 1 + DUP(16); ++r_) gemm_phase(lds, g, S, E); ssd_fin_phase(a, l, GW, ngw, LANE); }
        SEAM(pb + 6);
        if (PHM(7) && IN(pb + 7)) { Gemm g{BR, wl + W_BR, M, D, 512, D, 4, 512, (size_t)D * 512}; StaticOrder S; S.init(M, D, G, blockIdx.x, 4, 512);
            EpiBranch E{PROJ, MERGED}; for (int r_ = 0; r_ < 1 + DUP(12); ++r_) gemm_phase(lds, g, S, E);
            if (l + 1 < DEPTH && (int)blockIdx.x >= 128) conv_pull(a, lds, ctlw + 8, l + 1, 2); }
        SEAM(pb + 7);
        if (PHM(8) && IN(pb + 8)) { Gemm g{MERGED, wl + W_OUT, M, D, D, D, 1, 0, 0}; SplitOrder S; S.init(blockIdx.x, D);
            EpiResid E{xp, xs, modl, 2 * D, X, MACC}; if (DUP(14)) { EpiResid E2{xp, xs, modl, 2 * D, (float*)(a.ws + WS_PROJ), MACC}; gemm_phase(lds, g, S, E2); } gemm_phase(lds, g, S, E); }
        SEAM(pb + 8);
        if (PHM(9) && IN(pb + 9)) norm_phase(X, X + (size_t)MP * D, a.in[15] + l * D, modl, 3 * D, 4 * D, H, GW, ngw, LANE, MACC, modl, 2 * D, X, xs, nullptr, a.ws + WS_H8, (float*)(a.ws + WS_RSC));
        SEAM(pb + 9);
        if (PHM(10) && IN(pb + 10)) { Gemm g{(const bf16_t*)(a.ws + WS_H8), wl + W_1, M, DFF, 1024, 1024, 1, 0, 0}; StaticOrder S; S.init(M, DFF, G, blockIdx.x, 1, 1024);
            EpiRelu2 E{HID, DFF, (const float*)(a.ws + WS_RSC), (const float*)(a.ws + WS_WSC) + (size_t)l * DFF}; for (int r_ = 0; r_ < 1 + DUP(10); ++r_) gemm_phase(lds, g, S, E); }
        SEAM(pb + 10);
        if (PHM(11) && IN(pb + 11)) { Gemm g{HID, wl + W_2, M, D, DFF, DFF, 1, 0, 0}; SplitOrder S; S.init(blockIdx.x, DFF);
            EpiResid E{X, X + (size_t)MP * D, modl, 5 * D, X, MACC}; if (DUP(15)) { EpiResid E2{X, X + (size_t)MP * D, modl, 5 * D, (float*)(a.ws + WS_BR), MACC}; gemm_phase(lds, g, S, E2); } gemm_phase(lds, g, S, E); }
        SEAM(pb + 11);
    }
    if (IN(1 + DEPTH * NPH)) final_fix_phase(MACC, MOD + (size_t)(DEPTH - 1) * 5 * 6 * D, 5 * D, X, GW, ngw, LANE);
    if (TPROBE >= 0) { xcd_barrier(bar); TSTAMP(13); if (blockIdx.x == 0 && TID == 0) { volatile LAS float* ta_ = (volatile LAS float*)(ctlw + 24); float tot_ = 0.f; for (int q_ = 0; q_ < 14; ++q_) tot_ += ta_[q_]; a.out[0] = (TPROBE == 99 ? tot_ : ta_[TPROBE]) * 10.f; } }
#undef IN
#undef SEAM
#undef H
#undef PROJ
#undef SMALL
#undef BR
#undef MERGED
#undef MACC
#undef ZB
#undef HID
#undef MOD
#undef X
#undef xp
#undef xs
#undef modl
#undef wl
}
}
extern "C" void kernel_launch(void* const* d_in, const int* in_sizes, int n_in, void* d_out, int out_size, void* d_ws, size_t ws_size, hipStream_t stream) {
    static int grid = 0;
    if (grid == 0) {
        int dev = 0, cus = 0; (void)hipGetDevice(&dev); (void)hipDeviceGetAttribute(&cus, hipDeviceAttributeMultiprocessorCount, dev);
        (void)hipFuncSetAttribute((const void*)mk::mk_fwd, hipFuncAttributeMaxDynamicSharedMemorySize, mk::LDS_BYTES);
        int per_cu = 0; (void)hipOccupancyMaxActiveBlocksPerMultiprocessor(&per_cu, (const void*)mk::mk_fwd, mk::NT, mk::LDS_BYTES); (void)hipGetLastError();
        (void)cus; grid = 256;
    }
    mk::Args a{}; for (int i = 0; i < 43; ++i) a.in[i] = (const float*)d_in[i];
    a.out = (float*)d_out; a.ws = (unsigned char*)d_ws; a.ph_lo = 0; a.ph_hi = mk::PH_TOTAL;
    (void)hipMemsetAsync(a.ws + mk::WS_CTL, 0, mk::CTL_BYTES, stream);
    hipLaunchKernelGGL(mk::mk_fwd, dim3(grid), dim3(mk::NT), mk::LDS_BYTES, stream, a);
}
```

```cpp
#define SAFE_GEMM 0
#define DUPMASK 0
#define TPROBE -1
#include <hip/hip_runtime.h>
#include <math.h>
namespace mk {
#define LAS __attribute__((address_space(3)))
typedef unsigned short bf16_t;
typedef short bf16x8 __attribute__((ext_vector_type(8)));
typedef float f32x4 __attribute__((ext_vector_type(4)));
typedef float f32x2 __attribute__((ext_vector_type(2)));
typedef unsigned u32x4 __attribute__((ext_vector_type(4)));
typedef unsigned u32x2 __attribute__((ext_vector_type(2)));
typedef int v4i32 __attribute__((ext_vector_type(4)));
typedef int v8i32 __attribute__((ext_vector_type(8)));
constexpr int NT = 512, NWV = 8;
constexpr int D = 2048, MP = 4096, MLAT = 8192, M = MP + MLAT, DEPTH = 4, DFF = 8192;
constexpr int PJ = 13824;
constexpr int NIN = 14080;
constexpr int P_Q = 0, P_K = 512, P_V = 1024, P_S5U = 1536, P_Z = 2048, P_XBC = 2560, P_MQ = 3584, P_MK = 4096, P_MV = 4608, P_MO = 5120, P_GATE = 5632;
constexpr int S_DT = 0, S_MI = 16, S_MF = 24;

typedef __bf16 bf16x2_t __attribute__((ext_vector_type(2)));
__device__ __forceinline__ unsigned pk2(float lo, float hi) { f32x2 v = {lo, hi}; bf16x2_t b = __builtin_convertvector(v, bf16x2_t); return __builtin_bit_cast(unsigned, b); }
__device__ __forceinline__ float bf2f(bf16_t v) { return __uint_as_float(((unsigned)v) << 16); }
__device__ __forceinline__ float bflo(unsigned w) { return __uint_as_float(w << 16); }
__device__ __forceinline__ float bfhi(unsigned w) { return __uint_as_float(w & 0xffff0000u); }
__device__ __forceinline__ bf16_t f2bf(float f) { return (bf16_t)(pk2(f, 0.f) & 0xffffu); }
__device__ __forceinline__ float fsigm(float x) { return __builtin_amdgcn_rcpf(1.f + __expf(-x)); }
__device__ __forceinline__ float fsilu(float x) { return x * fsigm(x); }
__device__ __forceinline__ int row_cvec(int row) { return row < MP ? 0 : 1 + (row - MP) / 2048; }

#define XB_TMO      128
#define XB_XCNT(j)  (256  + 64 * (j))
#define XB_XSUB(j)  (1280 + 64 * (j))
#define XB_XGEN(j)  (2304 + 64 * (j))
#define XB_TOP      3328
#define XB_TOPGEN   3392
#define XCD_BAR_WORDS 3456
#define XB_SPIN_CAP (1u << 18)
__device__ __forceinline__ unsigned xb_ld(unsigned* p)              { return __hip_atomic_load(p, __ATOMIC_RELAXED, __HIP_MEMORY_SCOPE_AGENT); }
__device__ __forceinline__ unsigned xb_add(unsigned* p, unsigned v) { return __hip_atomic_fetch_add(p, v, __ATOMIC_RELAXED, __HIP_MEMORY_SCOPE_AGENT); }
__device__ __forceinline__ unsigned xb_xcc_id() { return (unsigned)__builtin_amdgcn_s_getreg((3 << 11) | 20) & 0xFu; }
#define XB_SPIN(cond, bar) do { unsigned _sp = 0; while (cond) { __builtin_amdgcn_s_sleep(1); \
    if ((++_sp & 255u) == 0u) { if (xb_ld(&(bar)[XB_TMO])) break; if (_sp > XB_SPIN_CAP) { atomicAdd(&(bar)[XB_TMO], 1u); break; } } } } while (0)
struct XcdBarrier { unsigned* bar; unsigned x; volatile LAS unsigned* st; };
__device__ __forceinline__ XcdBarrier xcd_barrier_post(unsigned* bar, volatile LAS unsigned* st) {
    XcdBarrier b; b.bar = bar; b.x = xb_xcc_id(); b.st = st;
    if (threadIdx.x == 0) (void)xb_add(&bar[XB_XCNT(b.x)], 1u);
    return b;
}
__device__ __forceinline__ void xcd_barrier_complete(unsigned* bar, unsigned x, unsigned& nloc, unsigned& nx) {
    const unsigned G = gridDim.x * gridDim.y * gridDim.z;
    unsigned sum, cnt, mine, sp = 0u;
    for (;;) {
        sum = 0u; cnt = 0u; mine = 0u;
#pragma unroll
        for (unsigned j = 0; j < 16; ++j) { const unsigned c = xb_ld(&bar[XB_XCNT(j)]); sum += c; cnt += (c > 0u) ? 1u : 0u; mine = (j == x) ? c : mine; }
        if (sum == G) break;
        __builtin_amdgcn_s_sleep(1);
        if ((++sp & 255u) == 0u) { if (xb_ld(&bar[XB_TMO])) break; if (sp > XB_SPIN_CAP) { atomicAdd(&bar[XB_TMO], 1u); break; } }
    }
    nloc = mine > 0u ? mine : 1u; nx = cnt > 0u ? cnt : 1u;
}
__device__ __forceinline__ void xcd_barrier(const XcdBarrier& b) {
    asm volatile("s_waitcnt vmcnt(0)" ::: "memory");
    __syncthreads();
    if (threadIdx.x == 0) {
        unsigned* bar = b.bar;
        __builtin_amdgcn_s_waitcnt(0);
        unsigned nloc = b.st[0], nx = b.st[1];
        if (nloc == 0u) { xcd_barrier_complete(bar, b.x, nloc, nx); b.st[0] = nloc; b.st[1] = nx; }
        const unsigned old = xb_add(&bar[XB_XSUB(b.x)], 1u);
        const unsigned gen = old / nloc;
        if (old + 1u == (gen + 1u) * nloc) {
            __builtin_amdgcn_fence(__ATOMIC_RELEASE, "agent");
            asm volatile("s_waitcnt vmcnt(0)" ::: "memory");
            const unsigned og = xb_add(&bar[XB_TOP], 1u);
            const unsigned tg = og / nx;
            if (og + 1u == (tg + 1u) * nx) xb_add(&bar[XB_TOPGEN], 1u);
            else XB_SPIN(xb_ld(&bar[XB_TOPGEN]) == tg, bar);
            __builtin_amdgcn_fence(__ATOMIC_ACQUIRE, "agent");
            xb_add(&bar[XB_XGEN(b.x)], 1u);
            asm volatile("s_waitcnt vmcnt(0)" ::: "memory");
        } else {
            XB_SPIN(xb_ld(&bar[XB_XGEN(b.x)]) == gen, bar);
            __builtin_amdgcn_fence(__ATOMIC_ACQUIRE, "agent");
            asm volatile("s_waitcnt vmcnt(0)" ::: "memory");
        }
    }
    __syncthreads();
}

#ifndef GEMM_SP2
#define GEMM_SP2 1
#endif
#ifndef GEMM_ALIGN
#define GEMM_ALIGN 1
#endif
constexpr int BM = 256, BK = 64, HALF = 128, HTB = HALF * BK * 2, STAGE_BYTES = 8 * HTB, NXCD = 8, WGM = 8;
__host__ __device__ __forceinline__ int lds_byte(int r, int c) { const int st = (r >> 4) * 2 + (c >> 5), rr = r & 15, cc = c & 31, ob = rr * 64 + cc * 2; return st * 1024 + (ob ^ (((ob >> 9) & 1) << 5)); }
__host__ __device__ __forceinline__ void stage_rc(int b, int& R, int& C) { const int st = b / 1024, sb = b % 1024, swz = sb ^ (((sb >> 9) & 1) << 5); R = (st >> 1) * 16 + swz / 64; C = (st & 1) * 32 + (swz % 64) / 2; }
__host__ __device__ __forceinline__ int perm32(int rho) { const int n = rho >> 4, i = rho & 15; return 8 * (i >> 2) + 4 * n + (i & 3); }

struct Unit { int pm, pn, kz, koff, nt; };
struct Gemm { const bf16_t* A; const bf16_t* Bt; int M, N, K, lda, nkz; size_t a_kz, b_kz; };

struct StaticOrder {
    int nM, nN, nwg, G, c, nkz;
    int ntk;
    __device__ void init(int M_, int N_, int G_, int c_, int nkz_ = 1, int K_ = 0) { nM = M_ / BM; nN = N_ / BM; nwg = nM * nN; G = G_; c = c_; nkz = nkz_; ntk = K_ / BK; }
    __device__ bool next(int i, Unit& u) const {
        const int it = i / nkz; u.kz = i - it * nkz; u.koff = 0; u.nt = ntk;
        const long L = (long)it * G + c; if (L >= nwg) return false;
        int wgid = (int)L; { const int q = nwg / NXCD, r = nwg % NXCD, xcd = wgid % NXCD, off = wgid / NXCD; wgid = (xcd < r ? xcd * (q + 1) : r * (q + 1) + (xcd - r) * q) + off; }
        const int nig = WGM * nN, gid = wgid / nig, fm = gid * WGM, gsz = (nM - fm) < WGM ? (nM - fm) : WGM;
        u.pm = fm + ((wgid % nig) % gsz); u.pn = (wgid % nig) / gsz; return true;
    }
};

struct SplitOrder {
    int c, ntk;
    __device__ void init(int c_, int K_) { c = c_; ntk = K_ / BK; }
    __device__ bool next(int i, Unit& u) const {
        const int xcd = c & 7, idx = c >> 3;
        if (i == 0) { u.pm = xcd * 4 + (idx >> 3); u.pn = idx & 7; u.kz = 0; u.koff = 0; u.nt = ntk; return true; }
        if (i == 1) { const int t = idx >> 1; u.pm = 32 + xcd * 2 + (t >> 3); u.pn = t & 7; u.kz = 0; u.nt = ntk >> 1; u.koff = (idx & 1) * (ntk >> 1) * BK; return true; }
        return false;
    }
};

template <class Epi, class Sched>
__device__ __forceinline__ void gemm_phase(LAS unsigned char* lds, const Gemm g, const Sched& S, const Epi& E) {
    int tid_ = threadIdx.x; asm volatile("" : "+v"(tid_));
    const int tid = tid_, wid = __builtin_amdgcn_readfirstlane(tid >> 6), lane = tid & 63, wr = wid >> 2, wc = wid & 3, fr = lane & 15, fq = lane >> 4;
    const int K = g.K;
    unsigned voffA[2], voffB[2];
#pragma unroll
    for (int i = 0; i < 2; ++i) { int R, C; stage_rc(tid * 16 + i * 8192, R, C); const int Rb = Epi::PERM ? ((R & ~31) + perm32(R & 31)) : R;
        voffA[i] = (unsigned)(R * g.lda + C) * 2u; voffB[i] = (unsigned)(Rb * K + C) * 2u; }
    const size_t kstep = (size_t)(BK * 2);
    const size_t hstepA = (size_t)HALF * g.lda * 2, hstepB = (size_t)HALF * K * 2;
    const size_t tstepA = 2 * hstepA, tstepB = 2 * hstepB;
    const unsigned ldsw = (unsigned)wid * 1024u;
    const int aoff = lds_byte(wr * 64 + fr, fq * 8), boff = lds_byte(wc * 32 + fr, fq * 8);
#define PG8_SA(b, h) (((b) * 2 + (h)) * HTB)
#define PG8_SB(b, h) ((4 + (b) * 2 + (h)) * HTB)
#define PG8_STAGE(bufoff, gbase, voff) do { _Pragma("unroll") for (int _i = 0; _i < 2; ++_i) \
        __builtin_amdgcn_global_load_lds((const unsigned*)((const char*)(gbase) + (voff)[_i]), (LAS unsigned*)(lds + (bufoff) + ldsw + _i * 8192), 16, 0, 0); } while (0)
#define PG8_LDA(dst, b, h) do { if constexpr (Epi::MODE == 1) { _Pragma("unroll") for (int m = 0; m < 4; ++m) dst##8[m] = __builtin_shufflevector(*(const LAS v4i32*)(lds + PG8_SA(b, h) + aoff + m * 2048), *(const LAS v4i32*)(lds + PG8_SA(b, h) + aoff + m * 2048 + 1024), 0, 1, 2, 3, 4, 5, 6, 7); } \
        else { _Pragma("unroll") for (int m = 0; m < 4; ++m) _Pragma("unroll") for (int k = 0; k < 2; ++k) dst[m][k] = *(const LAS bf16x8*)(lds + PG8_SA(b, h) + aoff + m * 2048 + k * 1024); } } while (0)
#define PG8_LDB(dst, b, h) do { if constexpr (Epi::MODE == 1) { _Pragma("unroll") for (int n = 0; n < 2; ++n) dst##8[n] = __builtin_shufflevector(*(const LAS v4i32*)(lds + PG8_SB(b, h) + boff + n * 2048), *(const LAS v4i32*)(lds + PG8_SB(b, h) + boff + n * 2048 + 1024), 0, 1, 2, 3, 4, 5, 6, 7); } \
        else { _Pragma("unroll") for (int n = 0; n < 2; ++n) _Pragma("unroll") for (int k = 0; k < 2; ++k) dst[n][k] = *(const LAS bf16x8*)(lds + PG8_SB(b, h) + boff + n * 2048 + k * 1024); } } while (0)
#define PG8_MMA_BF16(ai, bj, At, Bt) do { __builtin_amdgcn_s_setprio(1); _Pragma("unroll") for (int m = 0; m < 4; ++m) _Pragma("unroll") for (int n = 0; n < 2; ++n) _Pragma("unroll") for (int k = 0; k < 2; ++k) \
        acc[ai][bj][m][n] = __builtin_amdgcn_mfma_f32_16x16x32_bf16(Bt[n][k], At[m][k], acc[ai][bj][m][n], 0, 0, 0); __builtin_amdgcn_s_setprio(0); } while (0)
#define PG8_MMA_FP8(ai, bj, At, Bt) do { __builtin_amdgcn_s_setprio(1); _Pragma("unroll") for (int m = 0; m < 4; ++m) _Pragma("unroll") for (int n = 0; n < 2; ++n) \
        asm volatile("v_mfma_scale_f32_16x16x128_f8f6f4 %0, %1, %2, %0, %3, %3 op_sel_hi:[0,0,0]" : "+v"(acc[ai][bj][m][n]) : "v"(Bt##8[n]), "v"(At##8[m]), "v"(f8scale)); __builtin_amdgcn_s_setprio(0); } while (0)
#define PG8_F8_SETTLE() do { if constexpr (Epi::MODE == 1) asm volatile("s_nop 15\n\ts_nop 15" ::: "memory"); } while (0)
#define PG8_MMA_I8(ai, bj, At, Bt) do { __builtin_amdgcn_s_setprio(1); _Pragma("unroll") for (int m = 0; m < 4; ++m) _Pragma("unroll") for (int n = 0; n < 2; ++n) _Pragma("unroll") for (int k = 0; k < 2; ++k) \
        acc[ai][bj][m][n] = __builtin_bit_cast(f32x4, __builtin_amdgcn_mfma_i32_16x16x64_i8(__builtin_bit_cast(v4i32, Bt[n][k]), __builtin_bit_cast(v4i32, At[m][k]), __builtin_bit_cast(v4i32, acc[ai][bj][m][n]), 0, 0, 0)); __builtin_amdgcn_s_setprio(0); } while (0)
#define PG8_MMA(ai, bj, At, Bt) do { if constexpr (Epi::MODE == 1) PG8_MMA_FP8(ai, bj, At, Bt); else if constexpr (Epi::MODE == 2) PG8_MMA_I8(ai, bj, At, Bt); else PG8_MMA_BF16(ai, bj, At, Bt); } while (0)
#if SAFE_GEMM == 1 || SAFE_GEMM == 3
#define PG8_WAIT_V(n) asm volatile("s_waitcnt vmcnt(0)" ::: "memory")
#else
#define PG8_WAIT_V(n) asm volatile("s_waitcnt vmcnt(" #n ")" ::: "memory")
#endif
#define PG8_WAIT_L(n) asm volatile("s_waitcnt lgkmcnt(" #n ")" ::: "memory")
#if SAFE_GEMM == 1
#define PG8_BAR do { asm volatile("s_waitcnt vmcnt(0) lgkmcnt(0)" ::: "memory"); __builtin_amdgcn_s_barrier(); asm volatile("" ::: "memory"); } while (0)
#elif SAFE_GEMM == 2
#define PG8_BAR asm volatile("s_barrier" ::: "memory")
#elif SAFE_GEMM == 4
#define PG8_BAR do { asm volatile("s_waitcnt lgkmcnt(0)" ::: "memory"); __builtin_amdgcn_s_barrier(); } while (0)
#else
#define PG8_BAR __builtin_amdgcn_s_barrier()
#endif
#define PG8_SCHED __builtin_amdgcn_sched_barrier(0)
    Unit cur, nxt; int ui = 0;
    if (!S.next(0, cur)) return;
    f32x4 acc[2][2][4][2];
#pragma unroll
    for (int a = 0; a < 2; ++a)
#pragma unroll
        for (int b = 0; b < 2; ++b)
#pragma unroll
            for (int m = 0; m < 4; ++m)
#pragma unroll
                for (int n = 0; n < 2; ++n) acc[a][b][m][n] = (f32x4){0.f, 0.f, 0.f, 0.f};
    bf16x8 At[4][2], B0[2][2], B1[2][2]; v8i32 At8[4], B08[2], B18[2];
    int f8scale = 0x7f7f7f7f; asm volatile("" : "+v"(f8scale));
    const char* cA = (const char*)(g.A + (size_t)cur.kz * g.a_kz + cur.koff) + (size_t)cur.pm * tstepA; const char* cB = (const char*)(g.Bt + (size_t)cur.kz * g.b_kz + cur.koff) + (size_t)cur.pn * tstepB;
#if GEMM_SP2
    PG8_STAGE(PG8_SB(0, 0), cB, voffB); PG8_STAGE(PG8_SB(0, 1), cB + hstepB, voffB); PG8_STAGE(PG8_SA(0, 0), cA, voffA); PG8_STAGE(PG8_SA(0, 1), cA + hstepA, voffA);
    if (wr == 1) PG8_BAR;
    PG8_WAIT_V(2); PG8_BAR;
    PG8_STAGE(PG8_SB(1, 0), cB + kstep, voffB); PG8_STAGE(PG8_SA(1, 0), cA + kstep, voffA); PG8_STAGE(PG8_SB(1, 1), cB + hstepB + kstep, voffB);
    PG8_WAIT_V(6); PG8_BAR;
#else
    PG8_STAGE(PG8_SB(0, 0), cB, voffB); PG8_STAGE(PG8_SA(0, 0), cA, voffA); PG8_STAGE(PG8_SB(0, 1), cB + hstepB, voffB); PG8_STAGE(PG8_SA(0, 1), cA + hstepA, voffA);
    if (wr == 1) PG8_BAR;
    PG8_WAIT_V(4); PG8_BAR;
    PG8_STAGE(PG8_SB(1, 0), cB + kstep, voffB); PG8_STAGE(PG8_SA(1, 0), cA + kstep, voffA); PG8_STAGE(PG8_SB(1, 1), cB + hstepB + kstep, voffB);
    PG8_WAIT_V(6); PG8_BAR;
#endif
    for (;;) {
        const bool has_next = S.next(ui + 1, nxt);
        const char* nA = has_next ? (const char*)(g.A + (size_t)nxt.kz * g.a_kz + nxt.koff) + (size_t)nxt.pm * tstepA : cA;
        const char* nB = has_next ? (const char*)(g.Bt + (size_t)nxt.kz * g.b_kz + nxt.koff) + (size_t)nxt.pn * tstepB : cB;
        const int nt = cur.nt;
        for (int t = 0; t < nt; t += 2) {
            const bool last = (t == nt - 2);
            const char* a1 = cA + (size_t)(t + 1) * kstep;
            const char* a2 = last ? nA : cA + (size_t)(t + 2) * kstep; const char* b2 = last ? nB : cB + (size_t)(t + 2) * kstep;
            const char* a3 = a2 + kstep; const char* b3 = b2 + kstep;
#if GEMM_SP2
            PG8_LDB(B0, 0, 0); PG8_LDB(B1, 0, 1); PG8_SCHED; PG8_LDA(At, 0, 0); PG8_STAGE(PG8_SA(1, 1), a1 + hstepA, voffA);
            PG8_WAIT_V(8); PG8_WAIT_L(0); PG8_BAR; PG8_MMA(0, 0, At, B0); PG8_MMA(0, 1, At, B1); PG8_BAR; PG8_SCHED;
            PG8_LDA(At, 0, 1); PG8_STAGE(PG8_SB(0, 0), b2, voffB); PG8_STAGE(PG8_SB(0, 1), b2 + hstepB, voffB); PG8_STAGE(PG8_SA(0, 0), a2, voffA);
            PG8_WAIT_V(8); PG8_WAIT_L(0); PG8_BAR; PG8_MMA(1, 0, At, B0); PG8_MMA(1, 1, At, B1); PG8_BAR; PG8_SCHED;
            PG8_LDB(B0, 1, 0); PG8_LDB(B1, 1, 1); PG8_SCHED; PG8_LDA(At, 1, 0); PG8_STAGE(PG8_SA(0, 1), a2 + hstepA, voffA);
            PG8_WAIT_V(8); PG8_WAIT_L(0); PG8_BAR; PG8_MMA(0, 0, At, B0); PG8_MMA(0, 1, At, B1); PG8_BAR; PG8_SCHED;
            PG8_LDA(At, 1, 1); PG8_STAGE(PG8_SB(1, 0), b3, voffB); PG8_STAGE(PG8_SB(1, 1), b3 + hstepB, voffB); PG8_STAGE(PG8_SA(1, 0), a3, voffA);
            PG8_WAIT_V(8); PG8_WAIT_L(0); PG8_BAR; PG8_MMA(1, 0, At, B0); PG8_MMA(1, 1, At, B1); PG8_BAR; PG8_SCHED;
#else
            PG8_LDB(B0, 0, 0); PG8_SCHED; PG8_LDA(At, 0, 0); PG8_STAGE(PG8_SA(1, 1), a1 + hstepA, voffA);
            PG8_WAIT_L(8); PG8_BAR; PG8_WAIT_L(0); PG8_MMA(0, 0, At, B0); PG8_BAR; PG8_SCHED;
            PG8_LDB(B1, 0, 1); PG8_STAGE(PG8_SB(0, 0), b2, voffB);
            PG8_BAR; PG8_WAIT_L(0); PG8_MMA(0, 1, At, B1); PG8_BAR;
            PG8_LDA(At, 0, 1); PG8_STAGE(PG8_SA(0, 0), a2, voffA);
            PG8_BAR; PG8_WAIT_L(0); PG8_MMA(1, 0, At, B0); PG8_BAR; PG8_SCHED;
            PG8_STAGE(PG8_SB(0, 1), b2 + hstepB, voffB);
            PG8_WAIT_V(6); PG8_BAR; PG8_MMA(1, 1, At, B1); PG8_BAR;
            PG8_LDB(B0, 1, 0); PG8_SCHED; PG8_LDA(At, 1, 0); PG8_STAGE(PG8_SA(0, 1), a2 + hstepA, voffA);
            PG8_WAIT_L(8); PG8_BAR; PG8_WAIT_L(0); PG8_MMA(0, 0, At, B0); PG8_BAR; PG8_SCHED;
            PG8_LDB(B1, 1, 1); PG8_STAGE(PG8_SB(1, 0), b3, voffB);
            PG8_BAR; PG8_WAIT_L(0); PG8_MMA(0, 1, At, B1); PG8_BAR;
            PG8_LDA(At, 1, 1); PG8_STAGE(PG8_SA(1, 0), a3, voffA);
            PG8_BAR; PG8_WAIT_L(0); PG8_MMA(1, 0, At, B0); PG8_BAR; PG8_SCHED;
            PG8_STAGE(PG8_SB(1, 1), b3 + hstepB, voffB);
            PG8_WAIT_V(6); PG8_BAR; PG8_MMA(1, 1, At, B1); PG8_BAR;
#endif
        }
        PG8_F8_SETTLE();
#if GEMM_ALIGN
        if (wr == 0) PG8_BAR;
#endif
        E(acc, cur, wr, wc, fr, fq);
        if (!has_next) break;
        if (nxt.kz == 0) {
#pragma unroll
        for (int a = 0; a < 2; ++a)
#pragma unroll
            for (int b = 0; b < 2; ++b)
#pragma unroll
                for (int m = 0; m < 4; ++m)
#pragma unroll
                    for (int n = 0; n < 2; ++n) acc[a][b][m][n] = (f32x4){0.f, 0.f, 0.f, 0.f};
        }
        cur = nxt; cA = nA; cB = nB; ++ui;
#if GEMM_ALIGN
        if (wr == 1) PG8_BAR;
#endif
    }
    PG8_WAIT_V(0);
#if !GEMM_ALIGN
    if (wr == 0) PG8_BAR;
#endif
    PG8_BAR;
#undef PG8_SA
#undef PG8_SB
#undef PG8_STAGE
#undef PG8_LDA
#undef PG8_LDB
#undef PG8_MMA
#undef PG8_MMA_BF16
#undef PG8_MMA_FP8
#undef PG8_MMA_I8
#undef PG8_F8_SETTLE
#undef PG8_WAIT_V
#undef PG8_WAIT_L
#undef PG8_BAR
#undef PG8_SCHED
}
}
namespace mk {
constexpr size_t O_YP = 0, O_YS = 8388608, O_NK = 25165824, O_NV = 33554432, O_S5R = 41943040, O_S5I = 42205184, O_SSD = 42467328,
                 O_MLC = 50855936, O_MLN = 59244544, O_MLM = 59310080;

__device__ __forceinline__ u32x4 pack8(const f32x4 a, const f32x4 b) { u32x4 w; w.x = pk2(a[0], a[1]); w.y = pk2(a[2], a[3]); w.z = pk2(b[0], b[1]); w.w = pk2(b[2], b[3]); return w; }

template <bool F8> struct EpiInT {
    static constexpr bool PERM = true; static constexpr int MODE = F8 ? 1 : 0;
    bf16_t* proj; float* small; float* out; const float* qg; const float* kg; int layer;
    __device__ __forceinline__ void operator()(f32x4 (&acc)[2][2][4][2], const Unit& u, int wr, int wc, int fr, int fq) const {
        const int T = F8 ? 22 + u.pn : (u.pn == 22 ? 54 : u.pn), rowb = u.pm * BM + wr * 64 + fr;
        if (T == 54) {
            if (wc == 0) {
#pragma unroll
                for (int ai = 0; ai < 2; ++ai)
#pragma unroll
                    for (int m = 0; m < 4; ++m) { float* sp = small + (size_t)(rowb + ai * HALF + m * 16) * 32 + 8 * fq; *(f32x4*)sp = acc[ai][0][m][0]; *(f32x4*)(sp + 4) = acc[ai][0][m][1]; }
            }
            return;
        }
        const int colb = T * 256 + 64 * wc + 8 * fq;
        if (T < 4) {
            const float* g = T < 2 ? qg : kg;
            f32x4 gv[2][2];
#pragma unroll
            for (int bj = 0; bj < 2; ++bj)
#pragma unroll
                for (int n = 0; n < 2; ++n) gv[bj][n] = *(const f32x4*)(g + 32 * bj + 8 * fq + 4 * n);
#pragma unroll
            for (int ai = 0; ai < 2; ++ai)
#pragma unroll
                for (int m = 0; m < 4; ++m) {
                    float ss = 0.f;
#pragma unroll
                    for (int bj = 0; bj < 2; ++bj)
#pragma unroll
                        for (int n = 0; n < 2; ++n) { const f32x4 x = acc[ai][bj][m][n]; ss += (x[0] * x[0] + x[1] * x[1]) + (x[2] * x[2] + x[3] * x[3]); }
                    ss += __shfl_xor(ss, 16); ss += __shfl_xor(ss, 32);
                    const float r = rsqrtf(ss * (1.f / 64.f) + 1e-6f);
                    const int row = rowb + ai * HALF + m * 16;
#pragma unroll
                    for (int bj = 0; bj < 2; ++bj) { const f32x4 v0 = acc[ai][bj][m][0] * r * gv[bj][0], v1 = acc[ai][bj][m][1] * r * gv[bj][1];
                        *(u32x4*)(proj + (size_t)row * PJ + colb + 32 * bj) = pack8(v0, v1);
                        if (T >= 2 && row < MP) { float* o = out + O_NK + ((size_t)((row >> 8) * DEPTH + layer) * 256 + (row & 255)) * 512 + (colb - 512) + 32 * bj; *(f32x4*)o = v0; *(f32x4*)(o + 4) = v1; } }
                }
        } else if (T < 6) {
#pragma unroll
            for (int ai = 0; ai < 2; ++ai)
#pragma unroll
                for (int m = 0; m < 4; ++m) { const int row = rowb + ai * HALF + m * 16;
#pragma unroll
                    for (int bj = 0; bj < 2; ++bj) { const f32x4 v0 = acc[ai][bj][m][0], v1 = acc[ai][bj][m][1];
                        *(u32x4*)(proj + (size_t)row * PJ + colb + 32 * bj) = pack8(v0, v1);
                        if (row < MP) { float* o = out + O_NV + ((size_t)((row >> 8) * DEPTH + layer) * 256 + (row & 255)) * 512 + (colb - 1024) + 32 * bj; *(f32x4*)o = v0; *(f32x4*)(o + 4) = v1; } } }
        } else if (T < 22) {
#pragma unroll
            for (int ai = 0; ai < 2; ++ai)
#pragma unroll
                for (int m = 0; m < 4; ++m) { const int row = rowb + ai * HALF + m * 16;
#pragma unroll
                    for (int bj = 0; bj < 2; ++bj) *(u32x4*)(proj + (size_t)row * PJ + colb + 32 * bj) = pack8(acc[ai][bj][m][0], acc[ai][bj][m][1]); }
        } else {
#pragma unroll
            for (int ai = 0; ai < 2; ++ai)
#pragma unroll
                for (int m = 0; m < 4; ++m) { const int row = rowb + ai * HALF + m * 16;
#pragma unroll
                    for (int bj = 0; bj < 2; ++bj) { f32x4 v0 = acc[ai][bj][m][0], v1 = acc[ai][bj][m][1];
#pragma unroll
                        for (int j = 0; j < 4; ++j) { v0[j] = fsigm(v0[j]); v1[j] = fsigm(v1[j]); }
                        *(u32x4*)(proj + (size_t)row * PJ + colb + 32 * bj) = pack8(v0, v1); } }
        }
    }
};
struct EpiRelu2 {
    static constexpr bool PERM = true; static constexpr int MODE = 2;
    bf16_t* O; int ldo; const float* rsc; const float* cmx;
    __device__ __forceinline__ void operator()(f32x4 (&acc)[2][2][4][2], const Unit& u, int wr, int wc, int fr, int fq) const {
        const int rowb = u.pm * BM + wr * 64 + fr, colb = u.pn * 256 + 64 * wc + 8 * fq;
        {   f32x4 cs[2][2];
#pragma unroll
            for (int bj = 0; bj < 2; ++bj)
#pragma unroll
                for (int n = 0; n < 2; ++n) cs[bj][n] = *(const f32x4*)(cmx + u.pn * 256 + 128 * bj + 32 * wc + 8 * fq + 4 * n) * (1.f / 127.f);
#pragma unroll
            for (int ai = 0; ai < 2; ++ai)
#pragma unroll
                for (int m = 0; m < 4; ++m) { const float rs = rsc[rowb + ai * HALF + m * 16];
#pragma unroll
                    for (int bj = 0; bj < 2; ++bj)
#pragma unroll
                        for (int n = 0; n < 2; ++n) { const v4i32 iv = __builtin_bit_cast(v4i32, acc[ai][bj][m][n]); f32x4 fv; fv[0] = (float)iv[0]; fv[1] = (float)iv[1]; fv[2] = (float)iv[2]; fv[3] = (float)iv[3];
                            acc[ai][bj][m][n] = fv * cs[bj][n] * rs; } }
        }
#pragma unroll
        for (int ai = 0; ai < 2; ++ai)
#pragma unroll
            for (int m = 0; m < 4; ++m) { const int row = rowb + ai * HALF + m * 16;
#pragma unroll
                for (int bj = 0; bj < 2; ++bj) { f32x4 v0 = acc[ai][bj][m][0], v1 = acc[ai][bj][m][1];
#pragma unroll
                    for (int j = 0; j < 4; ++j) { const float a = fmaxf(v0[j], 0.f), b = fmaxf(v1[j], 0.f); v0[j] = a * a; v1[j] = b * b; }
                    *(u32x4*)(O + (size_t)row * ldo + colb + 32 * bj) = pack8(v0, v1); } }
    }
};
struct EpiGlu {
    static constexpr bool PERM = true; static constexpr int MODE = 0;
    const bf16_t* Z; const float* bias; bf16_t* br;
    __device__ __forceinline__ void operator()(f32x4 (&acc)[2][2][4][2], const Unit& u, int wr, int wc, int fr, int fq) const {
        const int rowb = u.pm * BM + wr * 64 + fr, colb = u.pn * 256 + 64 * wc + 8 * fq;
#pragma unroll
        for (int bj = 0; bj < 2; ++bj) { const int c = colb + 32 * bj; const f32x4 b0 = *(const f32x4*)(bias + c), b1 = *(const f32x4*)(bias + c + 4);
#pragma unroll
            for (int ai = 0; ai < 2; ++ai)
#pragma unroll
                for (int m = 0; m < 4; ++m) { const int row = rowb + ai * HALF + m * 16;
                    const u32x4 zz = *(const u32x4*)(Z + (size_t)row * 512 + c);
                    f32x4 v0 = acc[ai][bj][m][0] + b0, v1 = acc[ai][bj][m][1] + b1;
                    v0[0] = bflo(zz.x) * fsigm(v0[0]); v0[1] = bfhi(zz.x) * fsigm(v0[1]); v0[2] = bflo(zz.y) * fsigm(v0[2]); v0[3] = bfhi(zz.y) * fsigm(v0[3]);
                    v1[0] = bflo(zz.z) * fsigm(v1[0]); v1[1] = bfhi(zz.z) * fsigm(v1[1]); v1[2] = bflo(zz.w) * fsigm(v1[2]); v1[3] = bfhi(zz.w) * fsigm(v1[3]);
                    *(u32x4*)(br + (size_t)row * D + 512 + c) = pack8(v0, v1); } }
    }
};
struct EpiBranch {
    static constexpr bool PERM = true; static constexpr int MODE = 0;
    const bf16_t* proj; bf16_t* merged;
    __device__ __forceinline__ void operator()(f32x4 (&acc)[2][2][4][2], const Unit& u, int wr, int wc, int fr, int fq) const {
        const int rowb = u.pm * BM + wr * 64 + fr, colb = u.pn * 256 + 64 * wc + 8 * fq, kz = u.kz;
#pragma unroll
        for (int ai = 0; ai < 2; ++ai)
#pragma unroll
            for (int m = 0; m < 4; ++m) { const int row = rowb + ai * HALF + m * 16;
#pragma unroll
                for (int bj = 0; bj < 2; ++bj) { const int c = colb + 32 * bj;
                    const u32x4 gg = *(const u32x4*)(proj + (size_t)row * PJ + P_GATE + kz * D + c);
                    float g[8] = {bflo(gg.x), bfhi(gg.x), bflo(gg.y), bfhi(gg.y), bflo(gg.z), bfhi(gg.z), bflo(gg.w), bfhi(gg.w)};
                    if (kz < 3) { const u32x4 hh = *(const u32x4*)(proj + (size_t)row * PJ + P_GATE + (kz + 1) * D + c);
                        const float h[8] = {bflo(hh.x), bfhi(hh.x), bflo(hh.y), bfhi(hh.y), bflo(hh.z), bfhi(hh.z), bflo(hh.w), bfhi(hh.w)};
#pragma unroll
                        for (int j = 0; j < 8; ++j) g[j] = g[j] * __builtin_amdgcn_rcpf(fmaxf(h[j], 1e-30f)); }
                    f32x4& v0 = acc[ai][bj][m][0]; f32x4& v1 = acc[ai][bj][m][1];
                    v0[0] *= g[0]; v0[1] *= g[1]; v0[2] *= g[2]; v0[3] *= g[3]; v1[0] *= g[4]; v1[1] *= g[5]; v1[2] *= g[6]; v1[3] *= g[7];
                    if (kz == 3) *(u32x4*)(merged + (size_t)row * D + c) = pack8(v0, v1); } }
    }
};
struct EpiResid {
    static constexpr bool PERM = false; static constexpr int MODE = 0;
    const float* xp; const float* xs; const float* modl; int g_off; float* xout; float* part;
    __device__ __forceinline__ void operator()(f32x4 (&acc)[2][2][4][2], const Unit& u, int wr, int wc, int fr, int fq) const {
        if (part != nullptr && u.pm >= 32) {
            float* P = part + (size_t)((((u.pm - 32) * 8 + u.pn) * 2) + (u.koff != 0)) * 65536 + (size_t)(wr * 64 + fr) * 256 + wc * 32 + 4 * fq;
#pragma unroll
            for (int ai = 0; ai < 2; ++ai)
#pragma unroll
                for (int m = 0; m < 4; ++m)
#pragma unroll
                    for (int bj = 0; bj < 2; ++bj)
#pragma unroll
                        for (int n = 0; n < 2; ++n) *(f32x4*)(P + (size_t)(ai * HALF + m * 16) * 256 + bj * HALF + n * 16) = acc[ai][bj][m][n];
            return;
        }
        const int row0 = u.pm * BM, rowb = row0 + wr * 64 + fr, colb = u.pn * 256 + wc * 32 + 4 * fq;
        const float* xin = row0 < MP ? xp : xs - (size_t)MP * D;
        const float* gate = modl + (size_t)row_cvec(row0) * 6 * D + g_off;
        f32x4 gv[2][2];
#pragma unroll
        for (int bj = 0; bj < 2; ++bj)
#pragma unroll
            for (int n = 0; n < 2; ++n) gv[bj][n] = *(const f32x4*)(gate + colb + bj * HALF + n * 16);
#pragma unroll
        for (int ai = 0; ai < 2; ++ai)
#pragma unroll
            for (int m = 0; m < 4; ++m) { const size_t ro = (size_t)(rowb + ai * HALF + m * 16) * D + colb;
#pragma unroll
                for (int bj = 0; bj < 2; ++bj)
#pragma unroll
                    for (int n = 0; n < 2; ++n) { const size_t o = ro + bj * HALF + n * 16; *(f32x4*)(xout + o) = *(const f32x4*)(xin + o) + gv[bj][n] * acc[ai][bj][m][n]; } }
    }
};
}
namespace mk {
constexpr size_t AL(size_t x) { return (x + 255) & ~(size_t)255; }
constexpr size_t WS_CTL = 0, CTL_BYTES = 36864 + DEPTH * 8192 * 4;
constexpr size_t WS_MOD = WS_CTL + CTL_BYTES;
constexpr size_t WS_W = AL(WS_MOD + (size_t)DEPTH * 5 * 6 * D * 4);
constexpr size_t W_IN = 0, W_GLU = W_IN + (size_t)NIN * D, W_BR = W_GLU + 512 * 512, W_OUT = W_BR + (size_t)4 * D * 512, W_1 = W_OUT + (size_t)D * D, W_2 = W_1 + (size_t)DFF * D,
                 W_LAYER = W_2 + (size_t)D * DFF;
constexpr size_t W_IN8 = (size_t)5888 * D;
constexpr size_t WS_H = AL(WS_W + W_LAYER * 2 * DEPTH);
constexpr size_t WS_PROJ = AL(WS_H + (size_t)M * D * 2);
constexpr size_t WS_SMALL = AL(WS_PROJ + (size_t)M * PJ * 2);
constexpr size_t WS_BR = AL(WS_SMALL + (size_t)M * 32 * 4);
constexpr size_t WS_MERGED = AL(WS_BR + (size_t)M * D * 2);
constexpr size_t WS_MACC = AL(WS_MERGED + (size_t)M * D * 2);
constexpr size_t WS_ZB = AL(WS_MACC + (size_t)M * D * 4);
constexpr size_t WS_H8 = AL(WS_ZB + (size_t)M * 512 * 2);
constexpr size_t WS_RSC = AL(WS_H8 + (size_t)M * D);
constexpr size_t WS_WSC = WS_CTL + 36864;
constexpr size_t WS_SCR = AL(WS_RSC + (size_t)M * 4);
constexpr int LDS_BYTES = 140 * 1024, LDS_CTL = LDS_BYTES - 256;

struct Args { const float* in[43]; float* out; unsigned char* ws; int ph_lo, ph_hi; };

__device__ __forceinline__ float wave_sum(float v) {
#pragma unroll
    for (int o = 1; o < 64; o <<= 1) v += __shfl_xor(v, o);
    return v;
}
#define LDS_WAIT() asm volatile("s_waitcnt lgkmcnt(0)" ::: "memory")

__device__ __forceinline__ void xpose_item(const float* W, int ldw, int k0, int sc, bf16_t* dst, int K, LAS float* scr, int lane, int mode, bool f8 = false, const float* cmax = nullptr) {
    const int n4 = (lane & 7) * 4;
    const int col = mode == 1 ? (n4 < 16 ? 3584 + n4 : 5648 + (n4 - 16)) : sc + n4;
#pragma unroll
    for (int i = 0; i < 8; ++i) { const int kk = (lane >> 3) + 8 * i; f32x4 v = (f32x4){0.f, 0.f, 0.f, 0.f}; if (mode != 2) v = *(const f32x4*)(W + (size_t)(k0 + kk) * ldw + col);
        if (cmax != nullptr) { const f32x4 cm = *(const f32x4*)(cmax + n4);
#pragma unroll
            for (int e = 0; e < 4; ++e) v[e] = rintf(v[e] * (cm[e] > 0.f ? 127.f / cm[e] : 0.f)); }
        scr[kk * 33 + n4] = v[0]; scr[kk * 33 + n4 + 1] = v[1]; scr[kk * 33 + n4 + 2] = v[2]; scr[kk * 33 + n4 + 3] = v[3]; }
    LDS_WAIT(); asm volatile("" ::: "memory");
    const int c = lane & 7;
#pragma unroll
    for (int jj = 0; jj < 4; ++jj) { const int n = (lane >> 3) + 8 * jj; const LAS float* s = scr + (8 * c) * 33 + n;
        if (cmax != nullptr) { const unsigned w0 = ((unsigned)(int)s[0 * 33] & 0xffu) | (((unsigned)(int)s[1 * 33] & 0xffu) << 8) | (((unsigned)(int)s[2 * 33] & 0xffu) << 16) | (((unsigned)(int)s[3 * 33] & 0xffu) << 24);
            const unsigned w1 = ((unsigned)(int)s[4 * 33] & 0xffu) | (((unsigned)(int)s[5 * 33] & 0xffu) << 8) | (((unsigned)(int)s[6 * 33] & 0xffu) << 16) | (((unsigned)(int)s[7 * 33] & 0xffu) << 24);
            u32x2 o8; o8.x = w0; o8.y = w1; *(u32x2*)((unsigned char*)dst + (size_t)n * K + k0 + 8 * c) = o8; }
        else if (f8) { unsigned w0 = 0u, w1 = 0u; w0 = __builtin_amdgcn_cvt_pk_fp8_f32(s[0 * 33], s[1 * 33], w0, false); w0 = __builtin_amdgcn_cvt_pk_fp8_f32(s[2 * 33], s[3 * 33], w0, true);
            w1 = __builtin_amdgcn_cvt_pk_fp8_f32(s[4 * 33], s[5 * 33], w1, false); w1 = __builtin_amdgcn_cvt_pk_fp8_f32(s[6 * 33], s[7 * 33], w1, true);
            u32x2 o8; o8.x = w0; o8.y = w1; *(u32x2*)((unsigned char*)dst + (size_t)n * K + k0 + 8 * c) = o8; }
        else { u32x4 o; o.x = pk2(s[0 * 33], s[1 * 33]); o.y = pk2(s[2 * 33], s[3 * 33]); o.z = pk2(s[4 * 33], s[5 * 33]); o.w = pk2(s[6 * 33], s[7 * 33]);
            *(u32x4*)(dst + (size_t)n * K + k0 + 8 * c) = o; } }
    LDS_WAIT(); asm volatile("" ::: "memory");
}
__device__ __forceinline__ void xpose_q8_group(const float* W, int ldw, int K, int sc, unsigned char* dst, float* csc, LAS float* scr, int lane, int mode) {
    const int n4 = (lane & 7) * 4, kk0 = lane >> 3;
    const int col = mode == 1 ? (n4 < 16 ? 3584 + n4 : 5648 + (n4 - 16)) : sc + n4;
    f32x4 mx = (f32x4){0.f, 0.f, 0.f, 0.f};
    if (mode != 2) {
#pragma unroll 8
        for (int k = kk0; k < K; k += 8) { const f32x4 v = *(const f32x4*)(W + (size_t)k * ldw + col); mx[0] = fmaxf(mx[0], fabsf(v[0])); mx[1] = fmaxf(mx[1], fabsf(v[1])); mx[2] = fmaxf(mx[2], fabsf(v[2])); mx[3] = fmaxf(mx[3], fabsf(v[3])); }
    }
    f32x4 inv, scl;
#pragma unroll
    for (int e = 0; e < 4; ++e) { float x = mx[e]; x = fmaxf(x, __shfl_xor(x, 8)); x = fmaxf(x, __shfl_xor(x, 16)); x = fmaxf(x, __shfl_xor(x, 32)); scl[e] = x > 0.f ? x * (1.f / 127.f) : 1.f; inv[e] = x > 0.f ? 127.f / x : 0.f; }
    if (kk0 == 0) *(f32x4*)(csc + n4) = scl;
    for (int k0 = 0; k0 < K; k0 += 64) {
#pragma unroll
        for (int i = 0; i < 8; ++i) { const int kk = kk0 + 8 * i; f32x4 v = (f32x4){0.f, 0.f, 0.f, 0.f}; if (mode != 2) v = *(const f32x4*)(W + (size_t)(k0 + kk) * ldw + col);
            scr[kk * 33 + n4] = rintf(v[0] * inv[0]); scr[kk * 33 + n4 + 1] = rintf(v[1] * inv[1]); scr[kk * 33 + n4 + 2] = rintf(v[2] * inv[2]); scr[kk * 33 + n4 + 3] = rintf(v[3] * inv[3]); }
        LDS_WAIT(); asm volatile("" ::: "memory");
        const int c = lane & 7;
#pragma unroll
        for (int jj = 0; jj < 4; ++jj) { const int n = (lane >> 3) + 8 * jj; const LAS float* s = scr + (8 * c) * 33 + n;
            const unsigned w0 = ((unsigned)(int)s[0 * 33] & 0xffu) | (((unsigned)(int)s[1 * 33] & 0xffu) << 8) | (((unsigned)(int)s[2 * 33] & 0xffu) << 16) | (((unsigned)(int)s[3 * 33] & 0xffu) << 24);
            const unsigned w1 = ((unsigned)(int)s[4 * 33] & 0xffu) | (((unsigned)(int)s[5 * 33] & 0xffu) << 8) | (((unsigned)(int)s[6 * 33] & 0xffu) << 16) | (((unsigned)(int)s[7 * 33] & 0xffu) << 24);
            u32x2 o8; o8.x = w0; o8.y = w1; *(u32x2*)(dst + (size_t)n * K + k0 + 8 * c) = o8; }
        LDS_WAIT(); asm volatile("" ::: "memory");
    }
}
__device__ __forceinline__ int hm_col(int grp) { const int T = grp >> 3, q8 = grp & 7; return 256 * T + 32 * (2 * (q8 & 3) + (q8 >> 2)); }

constexpr int CM_ITEMS = DEPTH * 256 * 8;
__device__ __forceinline__ void colmax_item(const Args& a, unsigned* cmx, int item, int lane) {
    const int slab = item & 7, grp = (item >> 3) & 255, l = item >> 11;
    const int n4 = (lane & 7) * 4, kk0 = lane >> 3, col = hm_col(grp) + n4;
    const float* W = a.in[41] + (size_t)l * D * DFF + (size_t)(slab * 256) * DFF;
    f32x4 mx = (f32x4){0.f, 0.f, 0.f, 0.f};
#pragma unroll 8
    for (int k = kk0; k < 256; k += 8) { const f32x4 v = *(const f32x4*)(W + (size_t)k * DFF + col); mx[0] = fmaxf(mx[0], fabsf(v[0])); mx[1] = fmaxf(mx[1], fabsf(v[1])); mx[2] = fmaxf(mx[2], fabsf(v[2])); mx[3] = fmaxf(mx[3], fabsf(v[3])); }
#pragma unroll
    for (int e = 0; e < 4; ++e) { float x = mx[e]; x = fmaxf(x, __shfl_xor(x, 8)); x = fmaxf(x, __shfl_xor(x, 16)); x = fmaxf(x, __shfl_xor(x, 32)); mx[e] = x; }
    if (kk0 == 0) {
#pragma unroll
        for (int e = 0; e < 4; ++e) atomicMax(cmx + (size_t)l * DFF + 32 * grp + n4 + e, __float_as_uint(mx[e])); }
}
constexpr int CV_NQ8 = 0;
constexpr int CV_IN = 440 * 32, CV_GLU = 16 * 8, CV_BR = 4 * 64 * 8, CV_OUT = 64 * 32, CV_1 = 256 * 32, CV_2 = 64 * 128, CV_REST = CV_IN + CV_GLU + CV_BR + CV_OUT + CV_1 + CV_2;
__device__ __forceinline__ void convert_q8(const Args& a, LAS unsigned char* lds, int l, int grp, int wave, int lane) {
    LAS float* scr = (LAS float*)(lds + wave * 8704);
    bf16_t* wl = (bf16_t*)(a.ws + WS_W) + (size_t)l * W_LAYER; float* wsc = (float*)(a.ws + WS_WSC) + (size_t)l * (NIN + DFF);
    const int T = grp >> 3; int sc = hm_col(grp), mode = 0;
    if (T == 54) mode = (grp & 7) == 0 ? 1 : 2; else if (T >= 22) sc += 32; else if (T >= 14) sc += 16;
    xpose_q8_group(a.in[16] + (size_t)l * D * 13856, 13856, D, sc, (unsigned char*)(wl + W_IN) + (size_t)(32 * grp) * D, wsc + 32 * grp, scr, lane, mode);
}
__device__ __forceinline__ void convert_rest(const Args& a, LAS unsigned char* lds, int l, int r0, int r1, int wave, int lane) {
    LAS float* scr = (LAS float*)(lds + wave * 8704);
    bf16_t* wl = (bf16_t*)(a.ws + WS_W) + (size_t)l * W_LAYER;
    for (int it = r0; it < r1; ++it) { int r = it;
        if (r < CV_IN) { const int kb = r / 440, grp = r % 440, T = grp >> 3; int sc = hm_col(grp), mode = 0;
            if (T == 54) mode = (grp & 7) == 0 ? 1 : 2; else if (T >= 22) sc += 32; else if (T >= 14) sc += 16;
            if (T >= 22 && T < 54) xpose_item(a.in[16] + (size_t)l * D * 13856, 13856, 64 * kb, sc, (bf16_t*)((unsigned char*)(wl + W_IN8) + (size_t)(32 * (grp - 176)) * D), D, scr, lane, mode, true);
            else xpose_item(a.in[16] + (size_t)l * D * 13856, 13856, 64 * kb, sc, wl + W_IN + (size_t)(32 * (T == 54 ? grp - 256 : grp)) * D, D, scr, lane, mode);
            continue; } r -= CV_IN;
        if (r < CV_GLU) { const int kb = r / 16, grp = r % 16; xpose_item(a.in[28] + (size_t)l * 512 * 512, 512, 64 * kb, hm_col(grp), wl + W_GLU + (size_t)(32 * grp) * 512, 512, scr, lane, 0); continue; } r -= CV_GLU;
        if (r < CV_BR) { const int k = r / 512, r2 = r % 512, kb = r2 / 64, grp = r2 % 64;
            xpose_item(a.in[39] + ((size_t)l * 4 + k) * 512 * D, D, 64 * kb, hm_col(grp), wl + W_BR + (size_t)k * D * 512 + (size_t)(32 * grp) * 512, 512, scr, lane, 0); continue; } r -= CV_BR;
        if (r < CV_OUT) { const int kb = r / 64, grp = r % 64; xpose_item(a.in[40] + (size_t)l * D * D, D, 64 * kb, 32 * grp, wl + W_OUT + (size_t)(32 * grp) * D, D, scr, lane, 0); continue; } r -= CV_OUT;
        if (r < CV_1) { const int kb = r / 256, grp = r % 256;
            xpose_item(a.in[41] + (size_t)l * D * DFF, DFF, 64 * kb, hm_col(grp), (bf16_t*)((unsigned char*)(wl + W_1) + (size_t)(32 * grp) * D), D, scr, lane, 0, false, (const float*)(a.ws + WS_WSC) + (size_t)l * DFF + 32 * grp); continue; } r -= CV_1;
        { const int kb = r / 64, grp = r % 64; xpose_item(a.in[42] + (size_t)l * DFF * D, D, 64 * kb, 32 * grp, wl + W_2 + (size_t)(32 * grp) * DFF, DFF, scr, lane, 0); }
    }
}
__device__ __forceinline__ void prologue_ada_unit(const Args& a, LAS unsigned char* lds, int tid, int unit) {
    LAS float* sl = (LAS float*)lds;
    LAS float* red = (LAS float*)(lds + 40960);
    float* mod = (float*)(a.ws + WS_MOD);
    for (int i = tid; i < 5 * D; i += NT) { const int j = i / D, k = i % D; const float x = j == 0 ? a.in[11][k] : a.in[10][(j - 1) * D + k]; sl[i] = x / (1.f + __expf(-x)); }
    __syncthreads();
    const int ks = tid >> 6, c = tid & 63;
    const int l = unit / (6 * D / 64), n0 = (unit % (6 * D / 64)) * 64;
    const float* w = a.in[12] + (size_t)l * D * 6 * D + n0 + c;
    float acc[5] = {0.f, 0.f, 0.f, 0.f, 0.f};
#pragma unroll 8
    for (int k = ks * 256; k < ks * 256 + 256; ++k) { const float wv = w[(size_t)k * 6 * D];
#pragma unroll
        for (int j = 0; j < 5; ++j) acc[j] += sl[j * D + k] * wv; }
#pragma unroll
    for (int j = 0; j < 5; ++j) red[(ks * 5 + j) * 64 + c] = acc[j];
    __syncthreads();
    if (tid < 320) { const int j = tid >> 6; float s = 0.f;
#pragma unroll
        for (int q = 0; q < 8; ++q) s += red[(q * 5 + j) * 64 + c];
        mod[((size_t)l * 5 + j) * 6 * D + n0 + c] = s + a.in[13][l * 6 * D + n0 + c]; }
}
constexpr int PRO_NQ8B = CV_NQ8 / 8, PRO_NCONV = PRO_NQ8B + (CV_REST + 63) / 64,
              PRO_NADA = DEPTH * 6 * D / 64, PRO_NCACHE = 64;
__device__ __forceinline__ void norm_phase(const float* xp, const float* xs, const float* g, const float* modl, int sh_off, int sc_off, bf16_t* H, int gw, int ngw, int lane_,
                                           const float* pend, const float* pmodl, int pg_off, float* xw, const float* xs_pend, unsigned char* F8c = nullptr, unsigned char* Q8 = nullptr, float* rsc = nullptr) {
    int lane = lane_; asm volatile("" : "+v"(lane));
    for (int row = gw; row < M; row += ngw) {
        const float* x = row < MP ? xp + (size_t)row * D : xs + (size_t)(row - MP) * D;
        if (pend != nullptr && row >= 8192) x = xs_pend + (size_t)(row - MP) * D;
        f32x4 v[8]; float ss = 0.f;
#pragma unroll
        for (int j = 0; j < 8; ++j) v[j] = *(const f32x4*)(x + 4 * (lane + 64 * j));
        if (pend != nullptr && row >= 8192) {
            const float* pg = pmodl + (size_t)row_cvec(row) * 6 * D + pg_off; const int pm = row >> 8, r = row & 255;
#pragma unroll
            for (int j = 0; j < 8; ++j) { const int col = 4 * (lane + 64 * j), pn = col >> 8, cc = col & 255;
                const float* P = pend + (size_t)(((pm - 32) * 8 + pn) * 2) * 65536 + (size_t)r * 256 + cc;
                const f32x4 pa = *(const f32x4*)P, pb = *(const f32x4*)(P + 65536), gg = *(const f32x4*)(pg + col);
                v[j] = v[j] + gg * (pa + pb); *(f32x4*)(xw + (size_t)row * D + col) = v[j]; }
        }
#pragma unroll
        for (int j = 0; j < 8; ++j) ss += (v[j][0] * v[j][0] + v[j][1] * v[j][1]) + (v[j][2] * v[j][2] + v[j][3] * v[j][3]);
        const float r = rsqrtf(wave_sum(ss) * (1.f / D) + 1e-6f);
        const float* md = modl + (size_t)row_cvec(row) * 6 * D;
        float amax = 0.f;
#pragma unroll
        for (int j = 0; j < 8; ++j) { const int i = 4 * (lane + 64 * j);
            const f32x4 gg = *(const f32x4*)(g + i), sc = *(const f32x4*)(md + sc_off + i), sh = *(const f32x4*)(md + sh_off + i);
            const f32x4 o = v[j] * r * gg * (sc + 1.f) + sh; v[j] = o;
            amax = fmaxf(amax, fmaxf(fmaxf(fabsf(o[0]), fabsf(o[1])), fmaxf(fabsf(o[2]), fabsf(o[3])))); }
        if (Q8 == nullptr) {
#pragma unroll
            for (int j = 0; j < 8; ++j) { const int i = 4 * (lane + 64 * j); u32x2 w; w.x = pk2(v[j][0], v[j][1]); w.y = pk2(v[j][2], v[j][3]); *(u32x2*)(H + (size_t)row * D + i) = w;
                if (F8c != nullptr) { unsigned w8 = 0u; w8 = __builtin_amdgcn_cvt_pk_fp8_f32(v[j][0], v[j][1], w8, false); w8 = __builtin_amdgcn_cvt_pk_fp8_f32(v[j][2], v[j][3], w8, true); *(unsigned*)(F8c + (size_t)row * D + i) = w8; } }
        } else {
#pragma unroll
            for (int o2 = 1; o2 < 64; o2 <<= 1) amax = fmaxf(amax, __shfl_xor(amax, o2));
            const float inv = amax > 0.f ? 127.f / amax : 0.f;
            if (lane == 0) rsc[row] = amax > 0.f ? amax * (1.f / 127.f) : 1.f;
#pragma unroll
            for (int j = 0; j < 8; ++j) { const int i = 4 * (lane + 64 * j);
                const unsigned w = ((unsigned)(int)rintf(v[j][0] * inv) & 0xffu) | (((unsigned)(int)rintf(v[j][1] * inv) & 0xffu) << 8) | (((unsigned)(int)rintf(v[j][2] * inv) & 0xffu) << 16) | (((unsigned)(int)rintf(v[j][3] * inv) & 0xffu) << 24);
                *(unsigned*)(Q8 + (size_t)row * D + i) = w; }
        }
    }
}
__device__ __forceinline__ void final_fix_phase(const float* pend, const float* pmodl, int pg_off, float* X, int gw, int ngw, int lane_) {
    int lane = lane_; asm volatile("" : "+v"(lane));
    for (int row = 8192 + gw; row < M; row += ngw) {
        const float* pg = pmodl + (size_t)row_cvec(row) * 6 * D + pg_off; const int pm = row >> 8, r = row & 255;
#pragma unroll
        for (int j = 0; j < 8; ++j) { const int col = 4 * (lane + 64 * j), pn = col >> 8, cc = col & 255;
            const float* P = pend + (size_t)(((pm - 32) * 8 + pn) * 2) * 65536 + (size_t)r * 256 + cc;
            const f32x4 pa = *(const f32x4*)P, pb = *(const f32x4*)(P + 65536), gg = *(const f32x4*)(pg + col);
            float* xo = X + (size_t)row * D + col; *(f32x4*)xo = *(const f32x4*)xo + gg * (pa + pb); }
    }
}
__device__ __forceinline__ void conv_pull(const Args& a, LAS unsigned char* lds, volatile LAS unsigned* qitem, int layer, int maxb) {
    unsigned* qhead = (unsigned*)(a.ws + WS_CTL) + 8200 + layer;
    for (int n = 0; maxb < 0 || n < maxb; ++n) {
        __syncthreads();
        if (threadIdx.x == 0) qitem[0] = __hip_atomic_fetch_add(qhead, 1u, __ATOMIC_RELAXED, __HIP_MEMORY_SCOPE_AGENT);
        __syncthreads();
        const int item = (int)qitem[0];
        if (item >= PRO_NCONV) break;
        const int wave = __builtin_amdgcn_readfirstlane((int)(threadIdx.x >> 6));
        int lane = (int)(threadIdx.x & 63); asm volatile("" : "+v"(lane));
        { const int w0 = (item - PRO_NQ8B) * 64 + wave * 8; convert_rest(a, lds, layer, w0, w0 + 8 < CV_REST ? w0 + 8 : CV_REST, wave, lane); }
    }
    __syncthreads();
}
}
namespace mk {
constexpr size_t WS_NAT = AL(WS_SCR);
constexpr int NATP = 2048, N_XBC = 0, N_Q = 1024, N_K = 1536;
constexpr size_t WS_TR = AL(WS_NAT + (size_t)M * NATP * 2);
constexpr int T_X = 0, T_B = 512, T_K = 768, T_MV = 1280, T_V = 1792, TRR = 2304;
constexpr int NCH = 96;
constexpr size_t WS_MLC = AL(WS_TR + (size_t)TRR * M * 2);
constexpr size_t WS_MLN = AL(WS_MLC + (size_t)NCH * 4 * 2 * 16384 * 4);
constexpr size_t WS_MLS = AL(WS_MLN + (size_t)NCH * 4 * 2 * 128 * 4);
constexpr size_t WS_MLCS = AL(WS_MLS + (size_t)NCH * 4 * 2 * 4 * 4);
constexpr size_t WS_MLNS = AL(WS_MLCS + (size_t)NCH * 4 * 2 * 16384 * 2);
constexpr size_t WS_MLMS = AL(WS_MLNS + (size_t)NCH * 4 * 2 * 128 * 4);
constexpr size_t WS_OPT_END = AL(WS_MLMS + (size_t)NCH * 4 * 2 * 4);

__device__ __forceinline__ f32x4 mfma16(bf16x8 a, bf16x8 b, f32x4 c) { return __builtin_amdgcn_mfma_f32_16x16x32_bf16(a, b, c, 0, 0, 0); }
__device__ __forceinline__ void chunk_info(int ch, int& row0, int& seq0, int& L, int& lat, int& b, int& ci, int& nc) {
    if (ch < 32) { b = ch >> 1; ci = ch & 1; nc = 2; seq0 = b * 256; L = 256; lat = 0; } else { const int c2 = ch - 32; b = c2 >> 4; ci = c2 & 15; nc = 16; seq0 = MP + b * 2048; L = 2048; lat = 1; }
    row0 = seq0 + ci * 128;
}
__device__ __forceinline__ float fast_exp(float x) { return __expf(x); }

__device__ __forceinline__ void prep_phase(const Args& a, int layer, LAS unsigned char* lds, int gw_, int ngw, int wave, int lane_, bf16_t* UPk) {
    int lane = lane_, gw = gw_; asm volatile("" : "+v"(lane));
    const bf16_t* PROJ = (const bf16_t*)(a.ws + WS_PROJ); bf16_t* NAT = (bf16_t*)(a.ws + WS_NAT); bf16_t* TR = (bf16_t*)(a.ws + WS_TR);
    LAS bf16_t* tile = (LAS bf16_t*)(lds + wave * 16896); LAS bf16_t* otile = tile + 68 * 64;
    const int c = lane & 7, r8 = lane >> 3;
    const float* cw = a.in[30] + layer * 5 * 1024; const float* cb = a.in[31] + layer * 1024;
    for (int u = gw; u < 56 * 192; u += ngw) {
        const int cg = u / 192, tt = u % 192, m0 = tt * 64;
        const int lat = m0 >= MP; const int seq0 = lat ? MP + ((m0 - MP) / 2048) * 2048 : (m0 / 256) * 256, L = lat ? 2048 : 256, t0 = m0 - seq0;
        int kind, src, natcol = -1, trrow = -1;
        if (cg < 16) { kind = 0; src = P_XBC + 64 * cg; natcol = N_XBC + 64 * cg; if (cg < 12) trrow = T_X + 64 * cg; }
        else if (cg < 24) { kind = 1; src = P_MQ + 64 * (cg - 16); natcol = N_Q + 64 * (cg - 16); }
        else if (cg < 32) { kind = 2; src = P_MK + 64 * (cg - 24); natcol = N_K + 64 * (cg - 24); trrow = T_K + 64 * (cg - 24); }
        else if (cg < 40) { kind = 3; src = P_MV + 64 * (cg - 32); trrow = T_MV + 64 * (cg - 32); }
        else if (cg < 48) { kind = 3; src = P_V + 64 * (cg - 40); trrow = T_V + 64 * (cg - 40); }
        else { kind = 4; src = P_S5U + 64 * (cg - 48); }
        const int roff = kind == 0 ? -2 : 0, nrows = kind == 0 ? 68 : 64;
#pragma unroll
        for (int i = 0; i < 9; ++i) { const int r = r8 + 8 * i; if (r < nrows) { const int t = t0 + r + roff; u32x4 v = {0u, 0u, 0u, 0u};
                if (t >= 0 && t < L) v = *(const u32x4*)(PROJ + (size_t)(seq0 + t) * PJ + src + 8 * c);
                *(LAS u32x4*)(tile + r * 64 + 8 * c) = v; } }
        LDS_WAIT(); asm volatile("" ::: "memory");
#define PREP_EMIT(i_, r_) do { if (natcol >= 0) *(u32x4*)(NAT + (size_t)(m0 + r8 + 8 * (i_)) * NATP + natcol + 8 * c) = (r_); if (trrow >= 0) *(LAS u32x4*)(otile + (r8 + 8 * (i_)) * 64 + 8 * c) = (r_); } while (0)
        if (kind == 0) {
            float w[5][8], bz[8];
#pragma unroll
            for (int e = 0; e < 8; ++e) { bz[e] = cb[64 * cg + 8 * c + e];
#pragma unroll
                for (int j = 0; j < 5; ++j) w[j][e] = cw[j * 1024 + 64 * cg + 8 * c + e]; }
#pragma unroll 2
            for (int i = 0; i < 8; ++i) { const int tk = r8 + 8 * i; float acc[8];
#pragma unroll
                for (int e = 0; e < 8; ++e) acc[e] = bz[e];
#pragma unroll
                for (int j = 0; j < 5; ++j) { const u32x4 v = *(const LAS u32x4*)(tile + (tk + j) * 64 + 8 * c);
                    acc[0] += bflo(v.x) * w[j][0]; acc[1] += bfhi(v.x) * w[j][1]; acc[2] += bflo(v.y) * w[j][2]; acc[3] += bfhi(v.y) * w[j][3];
                    acc[4] += bflo(v.z) * w[j][4]; acc[5] += bfhi(v.z) * w[j][5]; acc[6] += bflo(v.w) * w[j][6]; acc[7] += bfhi(v.w) * w[j][7]; }
#pragma unroll
                for (int e = 0; e < 8; ++e) acc[e] = fsilu(acc[e]);
                u32x4 rv; rv.x = pk2(acc[0], acc[1]); rv.y = pk2(acc[2], acc[3]); rv.z = pk2(acc[4], acc[5]); rv.w = pk2(acc[6], acc[7]); PREP_EMIT(i, rv); }
        } else if (kind == 4) {
#pragma unroll
            for (int i = 0; i < 8; ++i) { const int tk = r8 + 8 * i, m = m0 + tk; const u32x4 v = *(const LAS u32x4*)(tile + tk * 64 + 8 * c);
                *(u32x4*)(UPk + ((size_t)(4 * (cg - 48) + (c >> 1)) * 384 + (m >> 5)) * 512 + (m & 31) * 16 + 8 * (c & 1)) = v; }
        } else if (kind == 3 || !lat) {
            const float sc = kind == 2 ? 0.08838834764831845f : 1.f;
#pragma unroll
            for (int i = 0; i < 8; ++i) { const u32x4 v = *(const LAS u32x4*)(tile + (r8 + 8 * i) * 64 + 8 * c);
                u32x4 rv = v;
                if (kind == 2) { rv.x = pk2(bflo(v.x) * sc, bfhi(v.x) * sc); rv.y = pk2(bflo(v.y) * sc, bfhi(v.y) * sc); rv.z = pk2(bflo(v.z) * sc, bfhi(v.z) * sc); rv.w = pk2(bflo(v.w) * sc, bfhi(v.w) * sc); }
                PREP_EMIT(i, rv); }
        } else {
            const float sc = kind == 2 ? 0.08838834764831845f : 1.f; const int odd = cg & 1;
            float inv[8];
#pragma unroll
            for (int e = 0; e < 8; ++e) inv[e] = exp2f(-(float)(8 * (c & 3) + e) * (13.287712379549449f / 32.f));
#pragma unroll
            for (int i = 0; i < 8; ++i) { const int tk = r8 + 8 * i, t = t0 + tk; const float pos = odd ? (float)(t & 63) : (float)(t >> 6);
                const u32x4 vo = *(const LAS u32x4*)(tile + tk * 64 + 8 * c), vp = *(const LAS u32x4*)(tile + tk * 64 + 8 * (c ^ 4));
                float o[8], p[8], rr[8];
                o[0] = bflo(vo.x); o[1] = bfhi(vo.x); o[2] = bflo(vo.y); o[3] = bfhi(vo.y); o[4] = bflo(vo.z); o[5] = bfhi(vo.z); o[6] = bflo(vo.w); o[7] = bfhi(vo.w);
                p[0] = bflo(vp.x); p[1] = bfhi(vp.x); p[2] = bflo(vp.y); p[3] = bfhi(vp.y); p[4] = bflo(vp.z); p[5] = bfhi(vp.z); p[6] = bflo(vp.w); p[7] = bfhi(vp.w);
#pragma unroll
                for (int e = 0; e < 8; ++e) { const float ang = pos * inv[e], cs = __cosf(ang), sn = __sinf(ang);
                    rr[e] = (c < 4 ? o[e] * cs - p[e] * sn : p[e] * sn + o[e] * cs) * sc; }
                u32x4 rv; rv.x = pk2(rr[0], rr[1]); rv.y = pk2(rr[2], rr[3]); rv.z = pk2(rr[4], rr[5]); rv.w = pk2(rr[6], rr[7]); PREP_EMIT(i, rv); }
        }
        if (trrow >= 0) {
            LDS_WAIT(); asm volatile("" ::: "memory");
            bf16_t* dst = TR + (size_t)(trrow + lane) * M + m0;
#pragma unroll
            for (int j = 0; j < 8; ++j) { unsigned wv[4];
#pragma unroll
                for (int q = 0; q < 4; ++q) { const unsigned lo = otile[(8 * j + 2 * q) * 64 + lane], hi = otile[(8 * j + 2 * q + 1) * 64 + lane]; wv[q] = lo | (hi << 16); }
                u32x4 o; o.x = wv[0]; o.y = wv[1]; o.z = wv[2]; o.w = wv[3]; *(u32x4*)(dst + 8 * j) = o; }
        }
        LDS_WAIT(); asm volatile("" ::: "memory");
    }
}

struct MlGate { float lf0, lf1, ig0, ig1, P0, P1, tot; };
__device__ __forceinline__ float wave_incl_scan(float v, int lane) {
#pragma unroll
    for (int o = 1; o < 64; o <<= 1) { const float t = __shfl_up(v, o); if (lane >= o) v += t; }
    return v;
}
__device__ __forceinline__ float wave_max(float v) {
#pragma unroll
    for (int o = 1; o < 64; o <<= 1) v = fmaxf(v, __shfl_xor(v, o));
    return v;
}
__device__ __forceinline__ MlGate ml_gates(const Args& a, int layer, int row0, int hh, int dir, int lane) {
    const float* SMALL = (const float*)(a.ws + WS_SMALL);
    const float ib = a.in[36][layer * 8 + dir * 4 + hh], fb = a.in[37][layer * 8 + dir * 4 + hh];
    MlGate g;
    const float f0 = SMALL[(size_t)(row0 + lane) * 32 + S_MF + dir * 4 + hh] + fb, f1 = SMALL[(size_t)(row0 + lane + 64) * 32 + S_MF + dir * 4 + hh] + fb;
    g.ig0 = SMALL[(size_t)(row0 + lane) * 32 + S_MI + dir * 4 + hh] + ib; g.ig1 = SMALL[(size_t)(row0 + lane + 64) * 32 + S_MI + dir * 4 + hh] + ib;
    g.lf0 = fminf(f0, 0.f) - log1pf(__expf(-fabsf(f0))); g.lf1 = fminf(f1, 0.f) - log1pf(__expf(-fabsf(f1)));
    const float s0 = wave_incl_scan(g.lf0, lane); const float tot0 = __shfl(s0, 63);
    const float s1 = wave_incl_scan(g.lf1, lane) + tot0;
    g.P0 = s0; g.P1 = s1; g.tot = __shfl(s1, 63);
    return g;
}

__device__ __forceinline__ void ml_states_phase(const Args& a, int layer, int tid_, int G) {
    int tid = tid_; asm volatile("" : "+v"(tid));
    const int lane = tid & 63, wave = __builtin_amdgcn_readfirstlane(tid >> 6), fr = lane & 15, fq = lane >> 4;
    const bf16_t* TR = (const bf16_t*)(a.ws + WS_TR);
    float* MLC = (float*)(a.ws + WS_MLC); float* MLN = (float*)(a.ws + WS_MLN); float* MLS = (float*)(a.ws + WS_MLS);
    for (int u = blockIdx.x; u < NCH * 4; u += G) {
        const int ch = u >> 2, hh = u & 3; int row0, seq0, L, lat, b, ci, nc; chunk_info(ch, row0, seq0, L, lat, b, ci, nc);
#pragma unroll 1
        for (int dir = 0; dir < 2; ++dir) {
            const MlGate g = ml_gates(a, layer, row0, hh, dir, lane);
            const float w0 = (dir == 0 ? g.tot - g.P0 : g.P0 - g.lf0) + g.ig0, w1 = (dir == 0 ? g.tot - g.P1 : g.P1 - g.lf1) + g.ig1;
            const float mloc = wave_max(fmaxf(w0, w1));
            const float e0 = __expf(w0 - mloc), e1 = __expf(w1 - mloc);
            f32x4 acc[8];
#pragma unroll
            for (int j = 0; j < 8; ++j) acc[j] = (f32x4){0.f, 0.f, 0.f, 0.f};
            float nacc[8];
#pragma unroll
            for (int j = 0; j < 8; ++j) nacc[j] = 0.f;
            const bf16_t* vrow = TR + (size_t)(T_MV + hh * 128 + wave * 16 + fr) * M + row0 + 8 * fq;
#pragma unroll
            for (int ks = 0; ks < 4; ++ks) {
                const bf16x8 af = *(const bf16x8*)(vrow + 32 * ks);
                float ev[8];
#pragma unroll
                for (int j = 0; j < 8; ++j) { const int tok = 32 * ks + 8 * fq + j; const float x0 = __shfl(e0, tok & 63), x1 = __shfl(e1, tok & 63); ev[j] = tok < 64 ? x0 : x1; }
#pragma unroll
                for (int jt = 0; jt < 8; ++jt) {
                    const u32x4 kv = *(const u32x4*)(TR + (size_t)(T_K + hh * 128 + jt * 16 + fr) * M + row0 + 32 * ks + 8 * fq);
                    const float k0 = bflo(kv.x) * ev[0], k1 = bfhi(kv.x) * ev[1], k2 = bflo(kv.y) * ev[2], k3 = bfhi(kv.y) * ev[3], k4 = bflo(kv.z) * ev[4], k5 = bfhi(kv.z) * ev[5], k6 = bflo(kv.w) * ev[6], k7 = bfhi(kv.w) * ev[7];
                    if (wave == 0) nacc[jt] += ((k0 + k1) + (k2 + k3)) + ((k4 + k5) + (k6 + k7));
                    u32x4 kb; kb.x = pk2(k0, k1); kb.y = pk2(k2, k3); kb.z = pk2(k4, k5); kb.w = pk2(k6, k7);
                    acc[jt] = mfma16(af, __builtin_bit_cast(bf16x8, kb), acc[jt]);
                }
            }
            float* cdst = MLC + ((size_t)(ch * 4 + hh) * 2 + dir) * 16384;
#pragma unroll
            for (int jt = 0; jt < 8; ++jt)
#pragma unroll
                for (int i = 0; i < 4; ++i) cdst[(size_t)(wave * 16 + 4 * fq + i) * 128 + jt * 16 + fr] = acc[jt][i];
            if (wave == 0) {
#pragma unroll
                for (int jt = 0; jt < 8; ++jt) { float v = nacc[jt]; v += __shfl_xor(v, 16); v += __shfl_xor(v, 32); if (fq == 0) MLN[((size_t)(ch * 4 + hh) * 2 + dir) * 128 + jt * 16 + fr] = v; }
                if (lane == 0) { MLS[((size_t)(ch * 4 + hh) * 2 + dir) * 4 + 0] = mloc; MLS[((size_t)(ch * 4 + hh) * 2 + dir) * 4 + 1] = g.tot; }
            }
        }
    }
}
__device__ __forceinline__ void ml_scan_phase(const Args& a, int layer, int tid_, int G) {
    int tid = tid_; asm volatile("" : "+v"(tid));
    const float* MLC = (const float*)(a.ws + WS_MLC); const float* MLN = (const float*)(a.ws + WS_MLN); const float* MLS = (const float*)(a.ws + WS_MLS);
    bf16_t* CS = (bf16_t*)(a.ws + WS_MLCS); float* NS = (float*)(a.ws + WS_MLNS); float* MS = (float*)(a.ws + WS_MLMS);
    for (int task = blockIdx.x; task < 256; task += G) {
        int lat, b, hh, dir, part, nparts;
        if (task < 128) { lat = 1; part = task & 3; dir = (task >> 2) & 1; hh = (task >> 3) & 3; b = task >> 5; nparts = 4; }
        else { const int t2 = task - 128; lat = 0; part = 0; dir = t2 & 1; hh = (t2 >> 1) & 3; b = t2 >> 3; nparts = 1; }
        const int nc = lat ? 16 : 2, ch0 = lat ? 32 + b * 16 : b * 2;
        const int nel = 16384 / nparts, e0 = part * nel, per = nel / NT;
        float c[32]; float n = 0.f, m = 0.f;
        const size_t so = (((size_t)b * DEPTH + layer) * 2 + dir) * 4 + hh;
#pragma unroll
        for (int i = 0; i < 32; ++i) if (i < per) { const int e = e0 + i * NT + tid, vd = e >> 7, kd = e & 127; c[i] = lat ? a.in[7][(so * 128 + kd) * 128 + vd] : 0.f; }
        if (tid < 128) n = lat ? a.in[8][so * 128 + tid] : 0.f;
        m = lat ? a.in[9][so] : 0.f;
        float nx[32]; float nn = 0.f, nml = 0.f, nbl = 0.f;
        { const int ch = ch0 + (dir ? nc - 1 : 0); const size_t sb = (size_t)(ch * 4 + hh) * 2 + dir;
#pragma unroll
            for (int i = 0; i < 32; ++i) if (i < per) nx[i] = MLC[sb * 16384 + e0 + i * NT + tid];
            if (tid < 128) nn = MLN[sb * 128 + tid]; nml = MLS[sb * 4 + 0]; nbl = MLS[sb * 4 + 1]; }
        for (int s = 0; s < nc; ++s) { const int ci = dir ? nc - 1 - s : s, ch = ch0 + ci; const size_t sb = (size_t)(ch * 4 + hh) * 2 + dir;
            float cx[32];
#pragma unroll
            for (int i = 0; i < 32; ++i) if (i < per) cx[i] = nx[i];
            const float cn = nn, ml = nml, bl = nbl;
            if (s + 1 < nc) { const int ch2 = ch0 + (dir ? nc - 2 - s : s + 1); const size_t sb2 = (size_t)(ch2 * 4 + hh) * 2 + dir;
#pragma unroll
                for (int i = 0; i < 32; ++i) if (i < per) nx[i] = MLC[sb2 * 16384 + e0 + i * NT + tid];
                if (tid < 128) nn = MLN[sb2 * 128 + tid]; nml = MLS[sb2 * 4 + 0]; nbl = MLS[sb2 * 4 + 1]; }
#pragma unroll
            for (int i = 0; i < 32; ++i) if (i < per) CS[sb * 16384 + e0 + i * NT + tid] = f2bf(c[i]);
            if (part == 0) { if (tid < 128) NS[sb * 128 + tid] = n; if (tid == 0) MS[sb] = m; }
            const float mn = fmaxf(bl + m, ml), fa = __expf(bl + m - mn), fb = __expf(ml - mn);
#pragma unroll
            for (int i = 0; i < 32; ++i) if (i < per) c[i] = fa * c[i] + fb * cx[i];
            if (tid < 128) n = fa * n + fb * cn;
            m = mn; }
        if (!lat) {
#pragma unroll
            for (int i = 0; i < 32; ++i) if (i < per) { const int e = e0 + i * NT + tid, vd = e >> 7, kd = e & 127; a.out[O_MLC + (so * 128 + kd) * 128 + vd] = c[i]; }
            if (tid < 128) a.out[O_MLN + so * 128 + tid] = n; if (tid == 0) a.out[O_MLM + so] = m; }
    }
}
__device__ __forceinline__ void ml_out_phase(const Args& a, int layer, int gw, int ngw, int lane_) {
    int lane = lane_; asm volatile("" : "+v"(lane));
    const int fr = lane & 15, fq = lane >> 4;
    const bf16_t* NAT = (const bf16_t*)(a.ws + WS_NAT); const bf16_t* TR = (const bf16_t*)(a.ws + WS_TR); const bf16_t* PROJ = (const bf16_t*)(a.ws + WS_PROJ);
    const bf16_t* CS = (const bf16_t*)(a.ws + WS_MLCS); const float* NS = (const float*)(a.ws + WS_MLNS); const float* MS = (const float*)(a.ws + WS_MLMS);
    bf16_t* BR = (bf16_t*)(a.ws + WS_BR);
    for (int it = gw; it < NCH * 4 * 8; it += ngw) {
        const int wv = it & 7, hh = (it >> 3) & 3, ch = it >> 5; int row0, seq0, L, lat, b, ci, nc; chunk_info(ch, row0, seq0, L, lat, b, ci, nc);
        const int t = wv * 16 + fr;
        bf16x8 qf[4];
#pragma unroll
        for (int ks = 0; ks < 4; ++ks) qf[ks] = *(const bf16x8*)(NAT + (size_t)(row0 + t) * NATP + N_Q + hh * 128 + 32 * ks + 8 * fq);
        f32x4 hsum[8];
#pragma unroll
        for (int j = 0; j < 8; ++j) hsum[j] = (f32x4){0.f, 0.f, 0.f, 0.f};
#pragma unroll
        for (int dir = 0; dir < 2; ++dir) {
            const size_t sb = (size_t)(ch * 4 + hh) * 2 + dir;
            const MlGate g = ml_gates(a, layer, row0, hh, dir, lane); const float ms = MS[sb];
            float u0, u1, c0, c1, ai0, ai1;
            if (dir == 0) { u0 = g.ig0 - g.P0; u1 = g.ig1 - g.P1; c0 = g.P0; c1 = g.P1; ai0 = g.P0 + ms; ai1 = g.P1 + ms; }
            else { const float E0 = g.P0 - g.lf0, E1 = g.P1 - g.lf1; u0 = E0 + g.ig0; u1 = E1 + g.ig1; c0 = -E0; c1 = -E1; ai0 = g.tot - E0 + ms; ai1 = g.tot - E1 + ms; }
            float g0 = u0, g1 = u1;
            if (dir == 0) {
#pragma unroll
                for (int o2 = 1; o2 < 64; o2 <<= 1) { const float x0 = __shfl_up(g0, o2), x1 = __shfl_up(g1, o2); if (lane >= o2) { g0 = fmaxf(g0, x0); g1 = fmaxf(g1, x1); } }
                g1 = fmaxf(g1, __shfl(g0, 63));
            } else {
#pragma unroll
                for (int o2 = 1; o2 < 64; o2 <<= 1) { const float x0 = __shfl_down(g0, o2), x1 = __shfl_down(g1, o2); if (lane + o2 < 64) { g0 = fmaxf(g0, x0); g1 = fmaxf(g1, x1); } }
                g0 = fmaxf(g0, __shfl(g1, 0));
            }
            const float mt0 = fmaxf(ai0, c0 + g0), mt1 = fmaxf(ai1, c1 + g1);
            const float w0 = c0 - mt0, w1 = c1 - mt1, si0 = __expf(ai0 - mt0), si1 = __expf(ai1 - mt1), em0 = __expf(-mt0), em1 = __expf(-mt1);
            const int tl = t & 63; const bool th = wv >= 4;
            const float wt = th ? __shfl(w1, tl) : __shfl(w0, tl), sit = th ? __shfl(si1, tl) : __shfl(si0, tl), emt = th ? __shfl(em1, tl) : __shfl(em0, tl);
            f32x4 acc[8];
#pragma unroll
            for (int j = 0; j < 8; ++j) acc[j] = (f32x4){0.f, 0.f, 0.f, 0.f};
#pragma unroll
            for (int ks = 0; ks < 4; ++ks)
#pragma unroll
                for (int j = 0; j < 8; ++j) { const bf16x8 cf = *(const bf16x8*)(CS + sb * 16384 + (size_t)(16 * j + fr) * 128 + 32 * ks + 8 * fq); acc[j] = mfma16(cf, qf[ks], acc[j]); }
            float qn = 0.f;
#pragma unroll
            for (int ks = 0; ks < 4; ++ks) { const u32x4 qv = __builtin_bit_cast(u32x4, qf[ks]); const float* nn = NS + sb * 128 + 32 * ks + 8 * fq; const f32x4 n0 = *(const f32x4*)nn, n1 = *(const f32x4*)(nn + 4);
                qn += bflo(qv.x) * n0[0] + bfhi(qv.x) * n0[1] + bflo(qv.y) * n0[2] + bfhi(qv.y) * n0[3] + bflo(qv.z) * n1[0] + bfhi(qv.z) * n1[1] + bflo(qv.w) * n1[2] + bfhi(qv.w) * n1[3]; }
            qn += __shfl_xor(qn, 16); qn += __shfl_xor(qn, 32);
#pragma unroll
            for (int j = 0; j < 8; ++j) acc[j] *= sit;
            float den = sit * qn;
            const int jlo = dir == 0 ? 0 : (wv >> 1), jhi = dir == 0 ? (wv >> 1) : 3;
            float psum = 0.f;
            for (int jp = jlo; jp <= jhi; ++jp) {
                const int ta = 32 * jp + 8 * (fr >> 2) + (fr & 3);
                f32x4 sa = (f32x4){0.f, 0.f, 0.f, 0.f}, sb2 = (f32x4){0.f, 0.f, 0.f, 0.f};
#pragma unroll
                for (int ks = 0; ks < 4; ++ks) {
                    const bf16x8 ka = *(const bf16x8*)(NAT + (size_t)(row0 + ta) * NATP + N_K + hh * 128 + 32 * ks + 8 * fq);
                    const bf16x8 kb = *(const bf16x8*)(NAT + (size_t)(row0 + ta + 4) * NATP + N_K + hh * 128 + 32 * ks + 8 * fq);
                    sa = mfma16(ka, qf[ks], sa); sb2 = mfma16(kb, qf[ks], sb2); }
                float pa[4], pb[4];
#pragma unroll
                for (int i = 0; i < 4; ++i) { const int s0 = 32 * jp + 8 * fq + i, s1 = s0 + 4;
                    const float us0 = jp < 2 ? __shfl(u0, s0 & 63) : __shfl(u1, s0 & 63), us1 = jp < 2 ? __shfl(u0, s1 & 63) : __shfl(u1, s1 & 63);
                    const bool ok0 = dir == 0 ? s0 <= t : s0 >= t, ok1 = dir == 0 ? s1 <= t : s1 >= t;
                    pa[i] = ok0 ? sa[i] * __expf(us0 + wt) : 0.f; pb[i] = ok1 ? sb2[i] * __expf(us1 + wt) : 0.f;
                    psum += pa[i] + pb[i]; }
                u32x4 pw; pw.x = pk2(pa[0], pa[1]); pw.y = pk2(pa[2], pa[3]); pw.z = pk2(pb[0], pb[1]); pw.w = pk2(pb[2], pb[3]);
                const bf16x8 pf = __builtin_bit_cast(bf16x8, pw);
#pragma unroll
                for (int j = 0; j < 8; ++j) { const bf16x8 vf = *(const bf16x8*)(TR + (size_t)(T_MV + hh * 128 + 16 * j + fr) * M + row0 + 32 * jp + 8 * fq); acc[j] = mfma16(vf, pf, acc[j]); }
            }
            psum += __shfl_xor(psum, 16); psum += __shfl_xor(psum, 32);
            den += psum;
            const float rden = 1.f / fmaxf(fabsf(den), emt);
#pragma unroll
            for (int j = 0; j < 8; ++j) hsum[j] += acc[j] * rden;
        }
        float ss = 0.f;
#pragma unroll
        for (int j = 0; j < 8; ++j) ss += (hsum[j][0] * hsum[j][0] + hsum[j][1] * hsum[j][1]) + (hsum[j][2] * hsum[j][2] + hsum[j][3] * hsum[j][3]);
        ss += __shfl_xor(ss, 16); ss += __shfl_xor(ss, 32);
        const float r = rsqrtf(ss * (1.f / 128.f) + 1e-6f);
        const float* ng = a.in[38] + layer * 512 + hh * 128;
#pragma unroll
        for (int j = 0; j < 8; ++j) { const int vd = 16 * j + 4 * fq; const f32x4 gg = *(const f32x4*)(ng + vd);
            const u32x2 ov = *(const u32x2*)(PROJ + (size_t)(row0 + t) * PJ + P_MO + hh * 128 + vd);
            const float o0 = hsum[j][0] * r * gg[0] * fsigm(bflo(ov.x)), o1 = hsum[j][1] * r * gg[1] * fsigm(bfhi(ov.x)), o2 = hsum[j][2] * r * gg[2] * fsigm(bflo(ov.y)), o3 = hsum[j][3] * r * gg[3] * fsigm(bfhi(ov.y));
            u32x2 w; w.x = pk2(o0, o1); w.y = pk2(o2, o3); *(u32x2*)(BR + (size_t)(row0 + t) * D + 1536 + hh * 128 + vd) = w; }
    }
}
}
namespace mk {
constexpr size_t WS_SST = WS_OPT_END;
constexpr size_t WS_SSL = AL(WS_SST + (size_t)NCH * 8 * 2 * 8192 * 4);
constexpr size_t WS_SSCS = AL(WS_SSL + (size_t)NCH * 8 * 2 * 4);
constexpr size_t WS_YPRE = AL(WS_SSCS + (size_t)NCH * 8 * 2 * 8192 * 2);
constexpr size_t WS_SSQ = AL(WS_YPRE + (size_t)M * 512 * 4);
constexpr size_t WS_SSD_END = AL(WS_SSQ + (size_t)M * 8 * 4);

struct SsdGate { float dt0, dt1, la0, la1, P0, P1, tot; };
__device__ __forceinline__ SsdGate ssd_gates(const Args& a, int layer, int row0, int hh, int dir, int lane) {
    const float* SMALL = (const float*)(a.ws + WS_SMALL);
    const float bias = a.in[32][layer * 16 + dir * 8 + hh], A = -__expf(a.in[33][layer * 16 + dir * 8 + hh]);
    SsdGate g;
    const float x0 = SMALL[(size_t)(row0 + lane) * 32 + S_DT + dir * 8 + hh] + bias, x1 = SMALL[(size_t)(row0 + lane + 64) * 32 + S_DT + dir * 8 + hh] + bias;
    g.dt0 = fmaxf(x0, 0.f) + log1pf(__expf(-fabsf(x0))); g.dt1 = fmaxf(x1, 0.f) + log1pf(__expf(-fabsf(x1)));
    g.la0 = g.dt0 * A; g.la1 = g.dt1 * A;
    const float s0 = wave_incl_scan(g.la0, lane); const float t0 = __shfl(s0, 63);
    const float s1 = wave_incl_scan(g.la1, lane) + t0;
    g.P0 = s0; g.P1 = s1; g.tot = __shfl(s1, 63);
    return g;
}
__device__ __forceinline__ void ssd_states_phase(const Args& a, int layer, int tid_, int G) {
    int tid = tid_; asm volatile("" : "+v"(tid));
    const int lane = tid & 63, wave = __builtin_amdgcn_readfirstlane(tid >> 6), fr = lane & 15, fq = lane >> 4;
    const bf16_t* TR = (const bf16_t*)(a.ws + WS_TR); float* SST = (float*)(a.ws + WS_SST); float* SSL = (float*)(a.ws + WS_SSL);
    for (int u = blockIdx.x; u < NCH * 8; u += G) {
        const int ch = u >> 3, hh = u & 7, grp = hh >> 2; int row0, seq0, L, lat, b, ci, nc; chunk_info(ch, row0, seq0, L, lat, b, ci, nc);
#pragma unroll 1
        for (int dir = 0; dir < 2; ++dir) {
            const SsdGate g = ssd_gates(a, layer, row0, hh, dir, lane);
            const float w0 = g.dt0 * __expf(dir == 0 ? g.tot - g.P0 : g.P0 - g.la0), w1 = g.dt1 * __expf(dir == 0 ? g.tot - g.P1 : g.P1 - g.la1);
            f32x4 acc[4];
#pragma unroll
            for (int j = 0; j < 4; ++j) acc[j] = (f32x4){0.f, 0.f, 0.f, 0.f};
#pragma unroll
            for (int ks = 0; ks < 4; ++ks) {
                float ev[8];
#pragma unroll
                for (int j = 0; j < 8; ++j) { const int tok = 32 * ks + 8 * fq + j; const float y0 = __shfl(w0, tok & 63), y1 = __shfl(w1, tok & 63); ev[j] = tok < 64 ? y0 : y1; }
                const u32x4 bv = *(const u32x4*)(TR + (size_t)(T_B + grp * 128 + wave * 16 + fr) * M + row0 + 32 * ks + 8 * fq);
                u32x4 bw; bw.x = pk2(bflo(bv.x) * ev[0], bfhi(bv.x) * ev[1]); bw.y = pk2(bflo(bv.y) * ev[2], bfhi(bv.y) * ev[3]); bw.z = pk2(bflo(bv.z) * ev[4], bfhi(bv.z) * ev[5]); bw.w = pk2(bflo(bv.w) * ev[6], bfhi(bv.w) * ev[7]);
                const bf16x8 bf = __builtin_bit_cast(bf16x8, bw);
#pragma unroll
                for (int j = 0; j < 4; ++j) { const bf16x8 xf = *(const bf16x8*)(TR + (size_t)(T_X + hh * 64 + 16 * j + fr) * M + row0 + 32 * ks + 8 * fq); acc[j] = mfma16(xf, bf, acc[j]); }
            }
            float* dst = SST + ((size_t)(ch * 8 + hh) * 2 + dir) * 8192;
#pragma unroll
            for (int j = 0; j < 4; ++j)
#pragma unroll
                for (int i = 0; i < 4; ++i) dst[(size_t)(16 * j + 4 * fq + i) * 128 + wave * 16 + fr] = acc[j][i];
            if (tid == 0) SSL[(size_t)(ch * 8 + hh) * 2 + dir] = g.tot;
        }
    }
}
__device__ __forceinline__ void ssd_scan_phase(const Args& a, int layer, int tid_, int G) {
    int tid = tid_; asm volatile("" : "+v"(tid));
    const float* SST = (const float*)(a.ws + WS_SST); const float* SSL = (const float*)(a.ws + WS_SSL); bf16_t* CS = (bf16_t*)(a.ws + WS_SSCS);
    for (int task = blockIdx.x; task < 384; task += G) {
        int lat, b, hh, dir, part, nparts;
        if (task < 128) { lat = 1; part = task & 1; dir = (task >> 1) & 1; hh = (task >> 2) & 7; b = task >> 5; nparts = 2; }
        else { const int t2 = task - 128; lat = 0; part = 0; dir = t2 & 1; hh = (t2 >> 1) & 7; b = t2 >> 4; nparts = 1; }
        const int nc = lat ? 16 : 2, ch0 = lat ? 32 + b * 16 : b * 2;
        const int nel = 8192 / nparts, e0 = part * nel, per = nel / NT;
        float c[16];
        const size_t so = ((((size_t)b * DEPTH + layer) * 2 + dir) * 8 + hh) * 8192;
#pragma unroll
        for (int i = 0; i < 16; ++i) if (i < per) c[i] = lat ? a.in[6][so + e0 + i * NT + tid] : 0.f;
        float nx[16]; float ntot;
        { const int ch = ch0 + (dir ? nc - 1 : 0); const size_t sb = (size_t)(ch * 8 + hh) * 2 + dir;
#pragma unroll
            for (int i = 0; i < 16; ++i) if (i < per) nx[i] = SST[sb * 8192 + e0 + i * NT + tid];
            ntot = SSL[sb]; }
        for (int s = 0; s < nc; ++s) { const int ci = dir ? nc - 1 - s : s, ch = ch0 + ci; const size_t sb = (size_t)(ch * 8 + hh) * 2 + dir;
            float cx[16];
#pragma unroll
            for (int i = 0; i < 16; ++i) if (i < per) cx[i] = nx[i];
            const float dec = __expf(ntot);
            if (s + 1 < nc) { const int ch2 = ch0 + (dir ? nc - 2 - s : s + 1); const size_t sb2 = (size_t)(ch2 * 8 + hh) * 2 + dir;
#pragma unroll
                for (int i = 0; i < 16; ++i) if (i < per) nx[i] = SST[sb2 * 8192 + e0 + i * NT + tid];
                ntot = SSL[sb2]; }
#pragma unroll
            for (int i = 0; i < 16; ++i) if (i < per) CS[sb * 8192 + e0 + i * NT + tid] = f2bf(c[i]);
#pragma unroll
            for (int i = 0; i < 16; ++i) if (i < per) c[i] = dec * c[i] + cx[i]; }
        if (!lat) {
#pragma unroll
            for (int i = 0; i < 16; ++i) if (i < per) a.out[O_SSD + so + e0 + i * NT + tid] = c[i]; }
    }
}
__device__ __forceinline__ void ssd_out_phase(const Args& a, int layer, int gw, int ngw, int lane_) {
    int lane = lane_; asm volatile("" : "+v"(lane));
    const int fr = lane & 15, fq = lane >> 4;
    const bf16_t* NAT = (const bf16_t*)(a.ws + WS_NAT); const bf16_t* TR = (const bf16_t*)(a.ws + WS_TR); const bf16_t* PROJ = (const bf16_t*)(a.ws + WS_PROJ);
    const bf16_t* CS = (const bf16_t*)(a.ws + WS_SSCS); float* YPRE = (float*)(a.ws + WS_YPRE); float* SSQ = (float*)(a.ws + WS_SSQ);
    for (int it = gw; it < NCH * 8 * 8; it += ngw) {
        const int wv = it & 7, hh = (it >> 3) & 7, ch = it >> 6, grp = hh >> 2; int row0, seq0, L, lat, b, ci, nc; chunk_info(ch, row0, seq0, L, lat, b, ci, nc);
        const int t = wv * 16 + fr;
        bf16x8 cf[4];
#pragma unroll
        for (int ks = 0; ks < 4; ++ks) cf[ks] = *(const bf16x8*)(NAT + (size_t)(row0 + t) * NATP + N_XBC + 768 + grp * 128 + 32 * ks + 8 * fq);
        f32x4 ysum[4];
#pragma unroll
        for (int j = 0; j < 4; ++j) ysum[j] = (f32x4){0.f, 0.f, 0.f, 0.f};
#pragma unroll
        for (int dir = 0; dir < 2; ++dir) {
            const size_t sb = (size_t)(ch * 8 + hh) * 2 + dir;
            const SsdGate g = ssd_gates(a, layer, row0, hh, dir, lane);
            float u0, u1, w0, w1, e0, e1;
            if (dir == 0) { u0 = -g.P0; u1 = -g.P1; w0 = g.P0; w1 = g.P1; e0 = __expf(g.P0); e1 = __expf(g.P1); }
            else { const float E0 = g.P0 - g.la0, E1 = g.P1 - g.la1; u0 = E0; u1 = E1; w0 = -E0; w1 = -E1; e0 = __expf(g.tot - E0); e1 = __expf(g.tot - E1); }
            const int tl = t & 63; const bool th = wv >= 4;
            const float wt = th ? __shfl(w1, tl) : __shfl(w0, tl), eot = th ? __shfl(e1, tl) : __shfl(e0, tl);
            f32x4 acc[4];
#pragma unroll
            for (int j = 0; j < 4; ++j) acc[j] = (f32x4){0.f, 0.f, 0.f, 0.f};
#pragma unroll
            for (int ks = 0; ks < 4; ++ks)
#pragma unroll
                for (int j = 0; j < 4; ++j) { const bf16x8 sf = *(const bf16x8*)(CS + sb * 8192 + (size_t)(16 * j + fr) * 128 + 32 * ks + 8 * fq); acc[j] = mfma16(sf, cf[ks], acc[j]); }
#pragma unroll
            for (int j = 0; j < 4; ++j) acc[j] *= eot;
            const int jlo = dir == 0 ? 0 : (wv >> 1), jhi = dir == 0 ? (wv >> 1) : 3;
            for (int jp = jlo; jp <= jhi; ++jp) {
                const int ta = 32 * jp + 8 * (fr >> 2) + (fr & 3);
                f32x4 sa = (f32x4){0.f, 0.f, 0.f, 0.f}, sb2 = (f32x4){0.f, 0.f, 0.f, 0.f};
#pragma unroll
                for (int ks = 0; ks < 4; ++ks) {
                    const bf16x8 ba = *(const bf16x8*)(NAT + (size_t)(row0 + ta) * NATP + N_XBC + 512 + grp * 128 + 32 * ks + 8 * fq);
                    const bf16x8 bb = *(const bf16x8*)(NAT + (size_t)(row0 + ta + 4) * NATP + N_XBC + 512 + grp * 128 + 32 * ks + 8 * fq);
                    sa = mfma16(ba, cf[ks], sa); sb2 = mfma16(bb, cf[ks], sb2); }
                float pa[4], pb[4];
#pragma unroll
                for (int i = 0; i < 4; ++i) { const int s0 = 32 * jp + 8 * fq + i, s1 = s0 + 4;
                    const float us0 = jp < 2 ? __shfl(u0, s0 & 63) : __shfl(u1, s0 & 63), us1 = jp < 2 ? __shfl(u0, s1 & 63) : __shfl(u1, s1 & 63);
                    const float d0 = jp < 2 ? __shfl(g.dt0, s0 & 63) : __shfl(g.dt1, s0 & 63), d1 = jp < 2 ? __shfl(g.dt0, s1 & 63) : __shfl(g.dt1, s1 & 63);
                    const bool ok0 = dir == 0 ? s0 <= t : s0 >= t, ok1 = dir == 0 ? s1 <= t : s1 >= t;
                    pa[i] = ok0 ? sa[i] * d0 * __expf(us0 + wt) : 0.f; pb[i] = ok1 ? sb2[i] * d1 * __expf(us1 + wt) : 0.f; }
                u32x4 pw; pw.x = pk2(pa[0], pa[1]); pw.y = pk2(pa[2], pa[3]); pw.z = pk2(pb[0], pb[1]); pw.w = pk2(pb[2], pb[3]);
                const bf16x8 pf = __builtin_bit_cast(bf16x8, pw);
#pragma unroll
                for (int j = 0; j < 4; ++j) { const bf16x8 xf = *(const bf16x8*)(TR + (size_t)(T_X + hh * 64 + 16 * j + fr) * M + row0 + 32 * jp + 8 * fq); acc[j] = mfma16(xf, pf, acc[j]); }
            }
#pragma unroll
            for (int j = 0; j < 4; ++j) ysum[j] += acc[j];
        }
        const float Dh = a.in[34][layer * 8 + hh]; float ss = 0.f;
#pragma unroll
        for (int j = 0; j < 4; ++j) { const int p = 16 * j + 4 * fq;
            const u32x2 xv = *(const u32x2*)(NAT + (size_t)(row0 + t) * NATP + N_XBC + hh * 64 + p), zv = *(const u32x2*)(PROJ + (size_t)(row0 + t) * PJ + P_Z + hh * 64 + p);
            f32x4 y; y[0] = (ysum[j][0] + bflo(xv.x) * Dh) * fsilu(bflo(zv.x)); y[1] = (ysum[j][1] + bfhi(xv.x) * Dh) * fsilu(bfhi(zv.x));
            y[2] = (ysum[j][2] + bflo(xv.y) * Dh) * fsilu(bflo(zv.y)); y[3] = (ysum[j][3] + bfhi(xv.y) * Dh) * fsilu(bfhi(zv.y));
            ss += (y[0] * y[0] + y[1] * y[1]) + (y[2] * y[2] + y[3] * y[3]);
            *(f32x4*)(YPRE + (size_t)(row0 + t) * 512 + hh * 64 + p) = y; }
        ss += __shfl_xor(ss, 16); ss += __shfl_xor(ss, 32);
        if (fq == 0) SSQ[(size_t)(row0 + t) * 8 + hh] = ss;
    }
}
__device__ __forceinline__ void ssd_fin_phase(const Args& a, int layer, int gw, int ngw, int lane_) {
    int lane = lane_; asm volatile("" : "+v"(lane));
    const float* YPRE = (const float*)(a.ws + WS_YPRE); const float* SSQ = (const float*)(a.ws + WS_SSQ); bf16_t* BR = (bf16_t*)(a.ws + WS_BR); const float* ng = a.in[35] + layer * 512;
    for (int row = gw; row < M; row += ngw) {
        float s = lane < 8 ? SSQ[(size_t)row * 8 + lane] : 0.f; s += __shfl_xor(s, 1); s += __shfl_xor(s, 2); s += __shfl_xor(s, 4); s = __shfl(s, 0);
        const float r = rsqrtf(s * (1.f / 512.f) + 1e-6f);
        const f32x4 y0 = *(const f32x4*)(YPRE + (size_t)row * 512 + 8 * lane), y1 = *(const f32x4*)(YPRE + (size_t)row * 512 + 8 * lane + 4);
        const f32x4 g0 = *(const f32x4*)(ng + 8 * lane), g1 = *(const f32x4*)(ng + 8 * lane + 4);
        *(u32x4*)(BR + (size_t)row * D + 1024 + 8 * lane) = pack8(y0 * r * g0, y1 * r * g1);
    }
}
}
namespace mk {
constexpr size_t WS_CK = WS_SSD_END;
constexpr size_t WS_CVT = AL(WS_CK + (size_t)16 * 512 * 512 * 2);
constexpr size_t WS_ATT_END = AL(WS_CVT + (size_t)16 * 512 * 512 * 2);

__device__ __forceinline__ void prologue_cache(const Args& a, int gw, int ngw, int lane) {
    bf16_t* CK = (bf16_t*)(a.ws + WS_CK); bf16_t* CVT = (bf16_t*)(a.ws + WS_CVT);
    for (size_t i = ((size_t)gw * 64 + lane) * 8; i < (size_t)16 * 512 * 512; i += (size_t)ngw * 64 * 8) {
        const f32x4 x0 = *(const f32x4*)(a.in[2] + i), x1 = *(const f32x4*)(a.in[2] + i + 4); *(u32x4*)(CK + i) = pack8(x0, x1); }
    for (size_t i = (size_t)gw * 64 + lane; i < (size_t)16 * 64 * 512; i += (size_t)ngw * 64) { const int c = i & 511, s8 = (i >> 9) & 63, bl = i >> 15;
        const float* src = a.in[3] + ((size_t)bl * 512 + 8 * s8) * 512 + c;
        u32x4 o; o.x = pk2(src[0], src[512]); o.y = pk2(src[1024], src[1536]); o.z = pk2(src[2048], src[2560]); o.w = pk2(src[3072], src[3584]);
        *(u32x4*)(CVT + ((size_t)bl * 512 + c) * 512 + 8 * s8) = o; }
}
struct AttState { float m, l; f32x4 o[4]; };
struct AttFrags { bf16x8 k[4]; const bf16_t* vt; size_t vp; };
__device__ __forceinline__ void attn_load(AttFrags& f, const bf16_t* kbase, size_t kp, const bf16_t* vt, size_t vp, int fr, int fq) {
    const int ra = 8 * (fr >> 2) + (fr & 3);
#pragma unroll
    for (int ks = 0; ks < 2; ++ks) { f.k[ks] = *(const bf16x8*)(kbase + (size_t)ra * kp + 32 * ks + 8 * fq); f.k[2 + ks] = *(const bf16x8*)(kbase + (size_t)(ra + 4) * kp + 32 * ks + 8 * fq); }
    f.vt = vt + (size_t)fr * vp + 8 * fq; f.vp = vp;
}
template <bool MASKED>
__device__ __forceinline__ void attn_compute(AttState& st, const bf16x8 (&qf)[2], const AttFrags& f, int fq, const float* bias, int kc0, int cq, int cs) {
    bf16x8 vf[4];
#pragma unroll
    for (int j = 0; j < 4; ++j) vf[j] = *(const bf16x8*)(f.vt + (size_t)(16 * j) * f.vp);
    f32x4 sa = (f32x4){0.f, 0.f, 0.f, 0.f}, sb = (f32x4){0.f, 0.f, 0.f, 0.f};
#pragma unroll
    for (int ks = 0; ks < 2; ++ks) { sa = mfma16(f.k[ks], qf[ks], sa); sb = mfma16(f.k[2 + ks], qf[ks], sb); }
    float s[8]; float gm = -1e30f;
#pragma unroll
    for (int i = 0; i < 4; ++i) { s[i] = sa[i] * 0.125f; s[4 + i] = sb[i] * 0.125f; }
    if (MASKED) {
#pragma unroll
        for (int e = 0; e < 8; ++e) { const int kc = kc0 + 8 * fq + e; const bool ok = kc >= cs && kc < cs + 16; const int bi = min(max(kc - cq + 15, 0), 30); s[e] = ok ? s[e] + bias[bi] : -1e30f; }
    }
#pragma unroll
    for (int e = 0; e < 8; ++e) gm = fmaxf(gm, s[e]);
    gm = fmaxf(gm, __shfl_xor(gm, 16)); gm = fmaxf(gm, __shfl_xor(gm, 32));
    const float mn = fmaxf(st.m, gm), al = __expf(st.m - mn); st.m = mn;
    float p[8], ps = 0.f;
#pragma unroll
    for (int e = 0; e < 8; ++e) { p[e] = __expf(s[e] - mn); ps += p[e]; }
    st.l = st.l * al + ps;
    u32x4 pw; pw.x = pk2(p[0], p[1]); pw.y = pk2(p[2], p[3]); pw.z = pk2(p[4], p[5]); pw.w = pk2(p[6], p[7]);
    const bf16x8 pf = __builtin_bit_cast(bf16x8, pw);
#pragma unroll
    for (int j = 0; j < 4; ++j) st.o[j] = mfma16(vf[j], pf, st.o[j] * al);
}
__device__ __forceinline__ void attn_compute2(AttState& s0, AttState& s1, const bf16x8 (&q0)[2], const bf16x8 (&q1)[2], const AttFrags& f, int fq) {
    bf16x8 vf[4];
#pragma unroll
    for (int j = 0; j < 4; ++j) vf[j] = *(const bf16x8*)(f.vt + (size_t)(16 * j) * f.vp);
    f32x4 a0 = (f32x4){0.f, 0.f, 0.f, 0.f}, b0 = a0, a1 = a0, b1 = a0;
#pragma unroll
    for (int ks = 0; ks < 2; ++ks) { a0 = mfma16(f.k[ks], q0[ks], a0); b0 = mfma16(f.k[2 + ks], q0[ks], b0); a1 = mfma16(f.k[ks], q1[ks], a1); b1 = mfma16(f.k[2 + ks], q1[ks], b1); }
    float x0[8], x1[8]; float g0 = -1e30f, g1 = -1e30f;
#pragma unroll
    for (int i = 0; i < 4; ++i) { x0[i] = a0[i] * 0.125f; x0[4 + i] = b0[i] * 0.125f; x1[i] = a1[i] * 0.125f; x1[4 + i] = b1[i] * 0.125f; }
#pragma unroll
    for (int e = 0; e < 8; ++e) { g0 = fmaxf(g0, x0[e]); g1 = fmaxf(g1, x1[e]); }
    g0 = fmaxf(g0, __shfl_xor(g0, 16)); g1 = fmaxf(g1, __shfl_xor(g1, 16)); g0 = fmaxf(g0, __shfl_xor(g0, 32)); g1 = fmaxf(g1, __shfl_xor(g1, 32));
    const float m0 = fmaxf(s0.m, g0), al0 = __expf(s0.m - m0), m1 = fmaxf(s1.m, g1), al1 = __expf(s1.m - m1); s0.m = m0; s1.m = m1;
    float p0 = 0.f, p1 = 0.f;
#pragma unroll
    for (int e = 0; e < 8; ++e) { x0[e] = __expf(x0[e] - m0); p0 += x0[e]; x1[e] = __expf(x1[e] - m1); p1 += x1[e]; }
    s0.l = s0.l * al0 + p0; s1.l = s1.l * al1 + p1;
    u32x4 w0, w1; w0.x = pk2(x0[0], x0[1]); w0.y = pk2(x0[2], x0[3]); w0.z = pk2(x0[4], x0[5]); w0.w = pk2(x0[6], x0[7]); w1.x = pk2(x1[0], x1[1]); w1.y = pk2(x1[2], x1[3]); w1.z = pk2(x1[4], x1[5]); w1.w = pk2(x1[6], x1[7]);
    const bf16x8 f0 = __builtin_bit_cast(bf16x8, w0), f1 = __builtin_bit_cast(bf16x8, w1);
#pragma unroll
    for (int j = 0; j < 4; ++j) { s0.o[j] = mfma16(vf[j], f0, s0.o[j] * al0); s1.o[j] = mfma16(vf[j], f1, s1.o[j] * al1); }
}
__device__ __forceinline__ void attn_store(const AttState& st, bf16_t* BR, int qrow, int hh, int fq) {
    float l = st.l; l += __shfl_xor(l, 16); l += __shfl_xor(l, 32);
    const float rl = 1.f / l;
#pragma unroll
    for (int j = 0; j < 4; ++j) { u32x2 w; w.x = pk2(st.o[j][0] * rl, st.o[j][1] * rl); w.y = pk2(st.o[j][2] * rl, st.o[j][3] * rl);
        *(u32x2*)(BR + (size_t)qrow * D + hh * 64 + 16 * j + 4 * fq) = w; }
}
__device__ __forceinline__ void attn_phase(const Args& a, int layer, int gw_, int ngw, int lane_) {
    int lane = lane_, gw = gw_; asm volatile("" : "+v"(lane));
    const int fr = lane & 15, fq = lane >> 4;
    const bf16_t* PROJ = (const bf16_t*)(a.ws + WS_PROJ); const bf16_t* TR = (const bf16_t*)(a.ws + WS_TR); bf16_t* BR = (bf16_t*)(a.ws + WS_BR);
    const bf16_t* CK = (const bf16_t*)(a.ws + WS_CK); const bf16_t* CVT = (const bf16_t*)(a.ws + WS_CVT);
    for (int it = gw; it < 3072; it += ngw) {
        AttState s0, s1; s0.m = -1e30f; s0.l = 0.f; s1.m = -1e30f; s1.l = 0.f;
#pragma unroll
        for (int j = 0; j < 4; ++j) { s0.o[j] = (f32x4){0.f, 0.f, 0.f, 0.f}; s1.o[j] = (f32x4){0.f, 0.f, 0.f, 0.f}; }
        AttFrags fa, fb; bf16x8 q0[2], q1[2];
        if (it < 2048) {
            const int jp = it & 1, r = (it >> 1) & 31, hh = (it >> 6) & 7, b = it >> 9;
            const int seq0 = MP + b * 2048, qrow = seq0 + r * 64 + 32 * jp + fr;
#pragma unroll
            for (int ks = 0; ks < 2; ++ks) { q0[ks] = *(const bf16x8*)(PROJ + (size_t)qrow * PJ + P_Q + hh * 64 + 32 * ks + 8 * fq); q1[ks] = *(const bf16x8*)(PROJ + (size_t)(qrow + 16) * PJ + P_Q + hh * 64 + 32 * ks + 8 * fq); }
            const int rs = min(max(r - 4, 0), 24);
            const float* rpb = a.in[19] + ((size_t)layer * 8 + hh) * 15 * 31;
            const size_t cb = ((size_t)b * DEPTH + layer) * 512; const bf16_t* kc = CK + cb * 512 + hh * 64; const bf16_t* vc = CVT + (cb + hh * 64) * 512;
#pragma unroll 1
            for (int qt = 0; qt < 2; ++qt) { const int jq = 2 * jp + qt, cq = 16 * jq + fr, cs = min(max(cq - 8, 0), 48), kc0 = jq == 0 ? 0 : (jq == 1 ? 8 : (jq == 2 ? 24 : 32));
                const bf16_t* kw = PROJ + (size_t)(seq0 + rs * 64 + kc0) * PJ + P_K + hh * 64; const bf16_t* vw = TR + (size_t)(T_V + hh * 64) * M + seq0 + rs * 64 + kc0;
                AttState& st = qt == 0 ? s0 : s1; const bf16x8 (&qf)[2] = qt == 0 ? q0 : q1;
                attn_load(fa, kw, PJ, vw, M, fr, fq);
#pragma unroll 1
                for (int j = 0; j < 8; j += 2) {
                    attn_load(fb, kw + (size_t)(j + 1) * 64 * PJ, PJ, vw + (j + 1) * 64, M, fr, fq);
                    attn_compute<true>(st, qf, fa, fq, rpb + (rs + j - r + 7) * 31, kc0, cq, cs);
                    if (j + 2 < 8) attn_load(fa, kw + (size_t)(j + 2) * 64 * PJ, PJ, vw + (j + 2) * 64, M, fr, fq);
                    attn_compute<true>(st, qf, fb, fq, rpb + (rs + j + 1 - r + 7) * 31, kc0, cq, cs);
                }
            }
            attn_load(fa, kc, 512, vc, 512, fr, fq);
#pragma unroll 1
            for (int g = 0; g < 16; g += 2) {
                attn_load(fb, kc + (size_t)(32 * (g + 1)) * 512, 512, vc + 32 * (g + 1), 512, fr, fq);
                attn_compute2(s0, s1, q0, q1, fa, fq);
                if (g + 2 < 16) attn_load(fa, kc + (size_t)(32 * (g + 2)) * 512, 512, vc + 32 * (g + 2), 512, fr, fq);
                attn_compute2(s0, s1, q0, q1, fb, fq);
            }
            attn_store(s0, BR, qrow, hh, fq); attn_store(s1, BR, qrow + 16, hh, fq);
        } else {
            const int i2 = it - 2048, qp = i2 & 7, hh = (i2 >> 3) & 7, b = i2 >> 6, seq0 = b * 256, qrow = seq0 + 32 * qp + fr;
#pragma unroll
            for (int ks = 0; ks < 2; ++ks) { q0[ks] = *(const bf16x8*)(PROJ + (size_t)qrow * PJ + P_Q + hh * 64 + 32 * ks + 8 * fq); q1[ks] = *(const bf16x8*)(PROJ + (size_t)(qrow + 16) * PJ + P_Q + hh * 64 + 32 * ks + 8 * fq); }
            const bf16_t* kp = PROJ + (size_t)seq0 * PJ + P_K + hh * 64; const bf16_t* vp = TR + (size_t)(T_V + hh * 64) * M + seq0;
            attn_load(fa, kp, PJ, vp, M, fr, fq);
#pragma unroll 1
            for (int g = 0; g < 8; g += 2) {
                attn_load(fb, kp + (size_t)(32 * (g + 1)) * PJ, PJ, vp + 32 * (g + 1), M, fr, fq);
                attn_compute2(s0, s1, q0, q1, fa, fq);
                if (g + 2 < 8) attn_load(fa, kp + (size_t)(32 * (g + 2)) * PJ, PJ, vp + 32 * (g + 2), M, fr, fq);
                attn_compute2(s0, s1, q0, q1, fb, fq);
            }
            attn_store(s0, BR, qrow, hh, fq); attn_store(s1, BR, qrow + 16, hh, fq);
        }
    }
}
}
namespace mk {
constexpr int S5K = 768;
constexpr size_t WS_S5W = WS_ATT_END;
constexpr size_t WS_S5WS = AL(WS_S5W + (size_t)DEPTH * 32 * 512 * S5K * 2);
constexpr size_t WS_S5AP = AL(WS_S5WS + (size_t)DEPTH * 32 * 256 * 512 * 2);
constexpr size_t WS_S5UP = AL(WS_S5AP + (size_t)DEPTH * 32 * 2 * 64 * 2 * 4);
constexpr size_t WS_S5SS = AL(WS_S5UP + (size_t)32 * 384 * 512 * 2);
constexpr size_t WS_S5HS = AL(WS_S5SS + (size_t)32 * 384 * 256 * 4);
constexpr size_t WS_S5_END = AL(WS_S5HS + (size_t)32 * 384 * 256 * 2);

__device__ __forceinline__ void s5_param_task(const Args& a, LAS unsigned char* lds, int tid_, int task) {
    int tid = tid_; asm volatile("" : "+v"(tid));
    LAS float* PW = (LAS float*)lds; LAS float* BB = PW + 2 * 33 * 64 * 2; LAS float* CC = BB + 2 * 64 * 16 * 2; LAS float* KT = CC + 2 * 16 * 64 * 2;
    {
        const int layer = task >> 5, g = task & 31;
        const float* a_re = a.in[20] + layer * 4096; const float* a_im = a.in[21] + layer * 4096; const float* log_dt = a.in[22] + layer * 64;
        const float* b_re = a.in[23] + (size_t)layer * 65536; const float* b_im = a.in[24] + (size_t)layer * 65536; const float* c_re = a.in[25] + (size_t)layer * 65536; const float* c_im = a.in[26] + (size_t)layer * 65536;
        const float* s5d = a.in[27] + layer * 512;
        bf16_t* S5W = (bf16_t*)(a.ws + WS_S5W) + (size_t)layer * 32 * 512 * S5K; bf16_t* S5WS = (bf16_t*)(a.ws + WS_S5WS) + (size_t)layer * 32 * 256 * 512; float* S5AP = (float*)(a.ws + WS_S5AP) + (size_t)layer * 32 * 2 * 64 * 2;
        __syncthreads();
        if (tid < 128) { const int dir = tid >> 6, n = tid & 63, pi = (dir * 32 + g) * 64 + n;
            const float are = fminf(a_re[pi], -1e-4f), aim = a_im[pi], dt = expf(log_dt[dir * 32 + g]);
            const float mag = expf(dt * are), abr = mag * cosf(dt * aim), abi = mag * sinf(dt * aim);
            const float den = are * are + aim * aim, nr = abr - 1.f, cfr = (nr * are + abi * aim) / den, cfi = (abi * are - nr * aim) / den;
            float pr = 1.f, pim = 0.f;
            for (int p = 0; p <= 32; ++p) { PW[((dir * 33 + p) * 64 + n) * 2] = pr; PW[((dir * 33 + p) * 64 + n) * 2 + 1] = pim; const float t = pr * abr - pim * abi; pim = pr * abi + pim * abr; pr = t; }
            S5AP[((g * 2 + dir) * 64 + n) * 2] = PW[((dir * 33 + 32) * 64 + n) * 2]; S5AP[((g * 2 + dir) * 64 + n) * 2 + 1] = PW[((dir * 33 + 32) * 64 + n) * 2 + 1];
            for (int k = 0; k < 16; ++k) { const float br_ = b_re[(size_t)pi * 16 + k], bi_ = b_im[(size_t)pi * 16 + k];
                BB[((dir * 64 + n) * 16 + k) * 2] = cfr * br_ - cfi * bi_; BB[((dir * 64 + n) * 16 + k) * 2 + 1] = cfr * bi_ + cfi * br_; }
            for (int j = 0; j < 16; ++j) { CC[((dir * 64 + n) * 16 + j) * 2] = c_re[((size_t)(dir * 32 + g) * 16 + j) * 64 + n]; CC[((dir * 64 + n) * 16 + j) * 2 + 1] = c_im[((size_t)(dir * 32 + g) * 16 + j) * 64 + n]; }
        }
        __syncthreads();
        { const int lane = tid & 63, wave = tid >> 6, r16 = lane & 15, q4 = lane >> 4;
          for (int pt = wave; pt < 64; pt += NWV) { const int dir = pt >> 5, tau = pt & 31; f32x4 acc = (f32x4){0.f, 0.f, 0.f, 0.f};
#pragma unroll 4
            for (int ks = 0; ks < 16; ++ks) { const int n = 4 * ks + q4;
                const float cr = CC[((dir * 64 + n) * 16 + r16) * 2], ci = CC[((dir * 64 + n) * 16 + r16) * 2 + 1], pr = PW[((dir * 33 + tau) * 64 + n) * 2], pim = PW[((dir * 33 + tau) * 64 + n) * 2 + 1];
                const float xr = cr * pr - ci * pim, xi = cr * pim + ci * pr, br_ = BB[((dir * 64 + n) * 16 + r16) * 2], bi_ = BB[((dir * 64 + n) * 16 + r16) * 2 + 1];
                acc = __builtin_amdgcn_mfma_f32_16x16x4f32(xr, br_, acc, 0, 0, 0); acc = __builtin_amdgcn_mfma_f32_16x16x4f32(-xi, bi_, acc, 0, 0, 0); }
#pragma unroll
            for (int i = 0; i < 4; ++i) KT[((dir * 32 + tau) * 16 + r16) * 16 + 4 * q4 + i] = acc[i]; } }
        __syncthreads();
        { const int t = tid >> 4, j = tid & 15; bf16_t* dst = S5W + ((size_t)g * 512 + tid) * S5K;
            for (int s = 0; s < 32; ++s) { float v[16];
#pragma unroll
                for (int k = 0; k < 16; ++k) { float x;
                    if (s < t) x = KT[((0 * 32 + (t - s)) * 16 + k) * 16 + j]; else if (s > t) x = KT[((1 * 32 + (s - t)) * 16 + k) * 16 + j];
                    else x = KT[((0 * 32 + 0) * 16 + k) * 16 + j] + KT[((1 * 32 + 0) * 16 + k) * 16 + j] + (k == j ? s5d[g * 16 + k] : 0.f);
                    v[k] = x; }
                u32x4 o0, o1; o0.x = pk2(v[0], v[1]); o0.y = pk2(v[2], v[3]); o0.z = pk2(v[4], v[5]); o0.w = pk2(v[6], v[7]); o1.x = pk2(v[8], v[9]); o1.y = pk2(v[10], v[11]); o1.z = pk2(v[12], v[13]); o1.w = pk2(v[14], v[15]);
                *(u32x4*)(dst + s * 16) = o0; *(u32x4*)(dst + s * 16 + 8) = o1; }
            for (int dir = 0; dir < 2; ++dir) { const int p = dir == 0 ? t + 1 : 32 - t;
                for (int n8 = 0; n8 < 8; ++n8) { float gr[8], gi[8];
#pragma unroll
                    for (int q = 0; q < 8; ++q) { const int n = n8 * 8 + q; const float cr = CC[((dir * 64 + n) * 16 + j) * 2], ci = CC[((dir * 64 + n) * 16 + j) * 2 + 1], pr = PW[((dir * 33 + p) * 64 + n) * 2], pim = PW[((dir * 33 + p) * 64 + n) * 2 + 1];
                        gr[q] = cr * pr - ci * pim; gi[q] = -(cr * pim + ci * pr); }
                    u32x4 o; o.x = pk2(gr[0], gr[1]); o.y = pk2(gr[2], gr[3]); o.z = pk2(gr[4], gr[5]); o.w = pk2(gr[6], gr[7]); *(u32x4*)(dst + 512 + dir * 128 + n8 * 8) = o;
                    o.x = pk2(gi[0], gi[1]); o.y = pk2(gi[2], gi[3]); o.z = pk2(gi[4], gi[5]); o.w = pk2(gi[6], gi[7]); *(u32x4*)(dst + 512 + dir * 128 + 64 + n8 * 8) = o; } }
        }
        if (tid < 256) { const int dir = tid >> 7, reim = (tid >> 6) & 1, n = tid & 63; bf16_t* dst = S5WS + ((size_t)g * 256 + tid) * 512;
            for (int s = 0; s < 32; ++s) { const int p = dir == 0 ? 31 - s : s; const float pr = PW[((dir * 33 + p) * 64 + n) * 2], pim = PW[((dir * 33 + p) * 64 + n) * 2 + 1]; float v[16];
#pragma unroll
                for (int k = 0; k < 16; ++k) { const float br_ = BB[((dir * 64 + n) * 16 + k) * 2], bi_ = BB[((dir * 64 + n) * 16 + k) * 2 + 1]; v[k] = reim == 0 ? pr * br_ - pim * bi_ : pr * bi_ + pim * br_; }
                u32x4 o0, o1; o0.x = pk2(v[0], v[1]); o0.y = pk2(v[2], v[3]); o0.z = pk2(v[4], v[5]); o0.w = pk2(v[6], v[7]); o1.x = pk2(v[8], v[9]); o1.y = pk2(v[10], v[11]); o1.z = pk2(v[12], v[13]); o1.w = pk2(v[14], v[15]);
                *(u32x4*)(dst + s * 16) = o0; *(u32x4*)(dst + s * 16 + 8) = o1; } }
    }
    __syncthreads();
}
__device__ __forceinline__ void s5_statein_phase(const Args& a, int layer, int gw, int ngw, int lane_) {
    int lane = lane_; asm volatile("" : "+v"(lane));
    const int fr = lane & 15, fq = lane >> 4;
    const bf16_t* UP = (const bf16_t*)(a.ws + WS_S5UP); const bf16_t* S5WS = (const bf16_t*)(a.ws + WS_S5WS) + (size_t)layer * 32 * 256 * 512; float* SS = (float*)(a.ws + WS_S5SS);
    for (int it = ngw - 1 - gw; it < 32 * 24; it += ngw) { const int g = it / 24, r = it % 24, og = r / 6, cq = r % 6;
        f32x4 acc[4][4];
#pragma unroll
        for (int i = 0; i < 4; ++i)
#pragma unroll
            for (int j = 0; j < 4; ++j) acc[i][j] = (f32x4){0.f, 0.f, 0.f, 0.f};
        const bf16_t* ap = S5WS + ((size_t)g * 256 + 64 * og + fr) * 512 + 8 * fq; const bf16_t* bp = UP + ((size_t)g * 384 + 64 * cq + fr) * 512 + 8 * fq;
#pragma unroll 2
        for (int ks = 0; ks < 16; ++ks) { bf16x8 af[4], bf[4];
#pragma unroll
            for (int i = 0; i < 4; ++i) { af[i] = *(const bf16x8*)(ap + (size_t)16 * i * 512 + 32 * ks); bf[i] = *(const bf16x8*)(bp + (size_t)16 * i * 512 + 32 * ks); }
#pragma unroll
            for (int i = 0; i < 4; ++i)
#pragma unroll
                for (int j = 0; j < 4; ++j) acc[i][j] = mfma16(af[i], bf[j], acc[i][j]); }
#pragma unroll
        for (int i = 0; i < 4; ++i)
#pragma unroll
            for (int j = 0; j < 4; ++j) *(f32x4*)(SS + ((size_t)g * 384 + 64 * cq + 16 * j + fr) * 256 + 64 * og + 16 * i + 4 * fq) = acc[i][j];
    }
}
__device__ __forceinline__ void s5_scan_phase(const Args& a, int layer, int gw, int ngw, int lane_) {
    int lane = lane_; asm volatile("" : "+v"(lane));
    const float* SS = (const float*)(a.ws + WS_S5SS); bf16_t* HS = (bf16_t*)(a.ws + WS_S5HS); const float* S5AP = (const float*)(a.ws + WS_S5AP) + (size_t)layer * 32 * 2 * 64 * 2;
    for (int task = gw; task < 1280; task += ngw) {
        int sq, g, dir; if (task < 256) { sq = 16 + (task >> 6); g = (task >> 1) & 31; dir = task & 1; } else { const int t2 = task - 256; sq = t2 >> 6; g = (t2 >> 1) & 31; dir = t2 & 1; }
        const int lat = sq >= 16, b = lat ? sq - 16 : sq, nc = lat ? 64 : 8, cg0 = lat ? 128 + b * 64 : b * 8;
        const float apr = S5AP[((g * 2 + dir) * 64 + lane) * 2], api = S5AP[((g * 2 + dir) * 64 + lane) * 2 + 1];
        float hr = 0.f, hi = 0.f;
        if (lat) { const size_t so = ((((size_t)b * DEPTH + layer) * 2 + dir) * 32 + g) * 64 + lane; hr = a.in[4][so]; hi = a.in[5][so]; }
        for (int s0 = 0; s0 < nc; s0 += 8) {
            float sr[8], si[8];
#pragma unroll
            for (int q = 0; q < 8; ++q) { const int cg = cg0 + (dir ? nc - 1 - (s0 + q) : s0 + q); const size_t base = ((size_t)g * 384 + cg) * 256 + dir * 128; sr[q] = SS[base + lane]; si[q] = SS[base + 64 + lane]; }
#pragma unroll
            for (int q = 0; q < 8; ++q) { const int cg = cg0 + (dir ? nc - 1 - (s0 + q) : s0 + q); const size_t base = ((size_t)g * 384 + cg) * 256 + dir * 128;
                HS[base + lane] = f2bf(hr); HS[base + 64 + lane] = f2bf(hi);
                const float t = apr * hr - api * hi + sr[q]; hi = apr * hi + api * hr + si[q]; hr = t; }
        }
        if (!lat) { const size_t oo = ((((size_t)b * DEPTH + layer) * 2 + dir) * 32 + g) * 64 + lane; a.out[O_S5R + oo] = hr; a.out[O_S5I + oo] = hi; }
    }
}
__device__ __forceinline__ void s5_out_phase(const Args& a, int layer, int gw, int ngw, int lane_) {
    int lane = lane_; asm volatile("" : "+v"(lane));
    const int fr = lane & 15, fq = lane >> 4;
    const bf16_t* UP = (const bf16_t*)(a.ws + WS_S5UP); const bf16_t* S5W = (const bf16_t*)(a.ws + WS_S5W) + (size_t)layer * 32 * 512 * S5K; const bf16_t* HS = (const bf16_t*)(a.ws + WS_S5HS); bf16_t* ZB = (bf16_t*)(a.ws + WS_ZB);
    for (int it = ngw - 1 - gw; it < 32 * 48; it += ngw) { const int g = it / 48, r = it % 48, og = r / 6, cq = r % 6;
        f32x4 acc[4][4];
#pragma unroll
        for (int i = 0; i < 4; ++i)
#pragma unroll
            for (int j = 0; j < 4; ++j) acc[i][j] = (f32x4){0.f, 0.f, 0.f, 0.f};
        const bf16_t* ap = S5W + ((size_t)g * 512 + 64 * og + fr) * S5K + 8 * fq;
        const bf16_t* bp = UP + ((size_t)g * 384 + 64 * cq + fr) * 512 + 8 * fq; const bf16_t* hp = HS + ((size_t)g * 384 + 64 * cq + fr) * 256 + 8 * fq;
#pragma unroll 2
        for (int ks = 0; ks < 16; ++ks) { bf16x8 af[4], bf[4];
#pragma unroll
            for (int i = 0; i < 4; ++i) { af[i] = *(const bf16x8*)(ap + (size_t)16 * i * S5K + 32 * ks); bf[i] = *(const bf16x8*)(bp + (size_t)16 * i * 512 + 32 * ks); }
#pragma unroll
            for (int i = 0; i < 4; ++i)
#pragma unroll
                for (int j = 0; j < 4; ++j) acc[i][j] = mfma16(af[i], bf[j], acc[i][j]); }
#pragma unroll 2
        for (int ks = 0; ks < 8; ++ks) { bf16x8 af[4], bf[4];
#pragma unroll
            for (int i = 0; i < 4; ++i) { af[i] = *(const bf16x8*)(ap + (size_t)16 * i * S5K + 512 + 32 * ks); bf[i] = *(const bf16x8*)(hp + (size_t)16 * i * 256 + 32 * ks); }
#pragma unroll
            for (int i = 0; i < 4; ++i)
#pragma unroll
                for (int j = 0; j < 4; ++j) acc[i][j] = mfma16(af[i], bf[j], acc[i][j]); }
#pragma unroll
        for (int i = 0; i < 4; ++i)
#pragma unroll
            for (int j = 0; j < 4; ++j) { float z[4];
#pragma unroll
                for (int e = 0; e < 4; ++e) { const float x = acc[i][j][e]; const float th = 0.7978845608028654f * (x + 0.044715f * x * x * x); const float e2 = __expf(2.f * th); const float tnh = 1.f - 2.f * __builtin_amdgcn_rcpf(e2 + 1.f); z[e] = 0.5f * x * (1.f + tnh); }
                u32x2 w; w.x = pk2(z[0], z[1]); w.y = pk2(z[2], z[3]);
                *(u32x2*)(ZB + (size_t)(32 * (64 * cq + 16 * j + fr) + 4 * og + i) * 512 + g * 16 + 4 * fq) = w; }
    }
}
}
namespace mk { static_assert(WS_S5_END < (size_t)1780 * 1024 * 1024, "workspace map exceeds the guaranteed size"); }
namespace mk {
#ifndef PHMASK
#define PHMASK 0xfffff
#endif
#define PHM(k) ((PHMASK >> (k)) & 1)
#ifndef DUPMASK
#define DUPMASK 0
#endif
#define DUP(k) ((DUPMASK >> (k)) & 1)
constexpr int NPH = 12;
constexpr int PH_TOTAL = 2 + DEPTH * NPH;
__global__ void __launch_bounds__(NT, 2) mk_fwd(Args a) {
    extern __shared__ __attribute__((aligned(16))) unsigned char lds_raw[];
    LAS unsigned char* lds = (LAS unsigned char*)lds_raw;
#define TID ((int)threadIdx.x)
#define LANE ((int)(threadIdx.x & 63))
#define WAVE (__builtin_amdgcn_readfirstlane((int)(threadIdx.x >> 6)))
#define GW ((int)blockIdx.x * NWV + WAVE)
    const int G = gridDim.x, ngw = G * NWV;
    volatile LAS unsigned* ctlw = (volatile LAS unsigned*)(lds + LDS_CTL);
    if (TID < 64) ctlw[TID] = 0u;
    __syncthreads();
    XcdBarrier bar = xcd_barrier_post((unsigned*)(a.ws + WS_CTL), ctlw);
    if (TPROBE >= 0 && TID == 0) { const unsigned long long t_ = wall_clock64(); ctlw[16] = (unsigned)t_; ctlw[17] = (unsigned)(t_ >> 32); }
    const int lo = a.ph_lo, hi = a.ph_hi;
#define IN(k) (lo <= (k) && (k) < hi)
#ifndef TPROBE
#define TPROBE -1
#endif
#define TSTAMP(kind) do { if (TPROBE >= 0 && blockIdx.x == 0 && TID == 0) { const unsigned long long t_ = wall_clock64(); const unsigned long long p_ = ((unsigned long long)ctlw[17] << 32) | ctlw[16]; \
    volatile LAS float* ta_ = (volatile LAS float*)(ctlw + 24); ta_[kind] = ta_[kind] + (float)(t_ - p_); ctlw[16] = (unsigned)t_; ctlw[17] = (unsigned)(t_ >> 32); } } while (0)
#define SEAM(k) do { if (IN(k) && IN((k) + 1)) { xcd_barrier(bar); if (DUP(13)) xcd_barrier(bar); TSTAMP((k) == 0 ? 0 : 1 + ((k) - 1) % NPH); } } while (0)
#define H ((bf16_t*)(a.ws + WS_H))
#define PROJ ((bf16_t*)(a.ws + WS_PROJ))
#define SMALL ((float*)(a.ws + WS_SMALL))
#define BR ((bf16_t*)(a.ws + WS_BR))
#define MERGED ((bf16_t*)(a.ws + WS_MERGED))
#define MACC ((float*)(a.ws + WS_MACC))
#define ZB ((bf16_t*)(a.ws + WS_ZB))
#define HID ((bf16_t*)(a.ws + WS_PROJ))
#define MOD ((const float*)(a.ws + WS_MOD))
#define X (a.out)
    if (PHM(0) && IN(0)) {
        for (int it = GW; it < CM_ITEMS; it += ngw) colmax_item(a, (unsigned*)(a.ws + WS_WSC), it, LANE);
        xcd_barrier(bar);
        for (int rep_ = 0; rep_ < 1 + DUP(17); ++rep_) {
        unsigned* qhead = (unsigned*)(a.ws + WS_CTL) + 8192 + 64 * rep_;
        volatile LAS unsigned* qitem = ctlw + 8;
        for (;;) {
            __syncthreads();
            if (TID == 0) qitem[0] = __hip_atomic_fetch_add(qhead, 1u, __ATOMIC_RELAXED, __HIP_MEMORY_SCOPE_AGENT);
            __syncthreads();
            int item = (int)qitem[0];
            if (item >= DEPTH * 32 + PRO_NADA + PRO_NCACHE) break;
            if (item < DEPTH * 32) { s5_param_task(a, lds, TID, item); continue; } item -= DEPTH * 32;
            if (item < PRO_NADA) { prologue_ada_unit(a, lds, TID, item); continue; } item -= PRO_NADA;
            prologue_cache(a, item * NWV + WAVE, PRO_NCACHE * NWV, LANE);
        }
        }
        conv_pull(a, lds, ctlw + 8, 0, -1);
    }
    SEAM(0);
    for (int l = 0; l < DEPTH; ++l) {
        const int pb = 1 + l * NPH;
#define xp (l == 0 ? a.in[0] : X)
#define xs (l == 0 ? a.in[1] : X + (size_t)MP * D)
#define modl (MOD + (size_t)l * 5 * 6 * D)
#define wl ((const bf16_t*)(a.ws + WS_W) + (size_t)l * W_LAYER)
        if (PHM(1) && IN(pb + 0) && l > 0) conv_pull(a, lds, ctlw + 8, l, -1);
        if (PHM(1) && IN(pb + 0)) norm_phase(xp, xs, a.in[14] + l * D, modl, 0, D, H, GW, ngw, LANE, l > 0 ? MACC : nullptr, modl - (size_t)5 * 6 * D, 5 * D, X, xs, a.ws + WS_H8);
        SEAM(pb + 0);
        if (PHM(2) && IN(pb + 1)) {
            { Gemm g8{(const bf16_t*)(a.ws + WS_H8), wl + W_IN8, M, 8192, 1024, 1024, 1, 0, 0}; StaticOrder S; S.init(M, 8192, G, blockIdx.x, 1, 1024);
              EpiInT<true> E{PROJ, SMALL, a.out, a.in[17] + l * 64, a.in[18] + l * 64, l}; gemm_phase(lds, g8, S, E); }
            { Gemm g{H, wl + W_IN, M, 5888, D, D, 1, 0, 0}; StaticOrder S; S.init(M, 5888, G, blockIdx.x, 1, D);
              EpiInT<false> E{PROJ, SMALL, a.out, a.in[17] + l * 64, a.in[18] + l * 64, l}; gemm_phase(lds, g, S, E); }
            if (l + 1 < DEPTH && (int)blockIdx.x >= 80) conv_pull(a, lds, ctlw + 8, l + 1, 1); }
        SEAM(pb + 1);
        if (PHM(3) && IN(pb + 2)) { for (int r_ = 0; r_ < 1 + DUP(0); ++r_) { prep_phase(a, l, lds, GW, ngw, WAVE, LANE, (bf16_t*)(a.ws + WS_S5UP)); __syncthreads(); } }
        SEAM(pb + 2);
        if (PHM(4) && IN(pb + 3)) { for (int r_ = 0; r_ < 1 + DUP(2); ++r_) attn_phase(a, l, GW, ngw, LANE); for (int r_ = 0; r_ < 1 + DUP(3); ++r_) { ml_states_phase(a, l, TID, G); ssd_states_phase(a, l, TID, G); s5_statein_phase(a, l, GW, ngw, LANE); } }
        SEAM(pb + 3);
        if (PHM(5) && IN(pb + 4)) { for (int r_ = 0; r_ < 1 + DUP(4); ++r_) { ml_scan_phase(a, l, TID, G); ssd_scan_phase(a, l, TID, G); s5_scan_phase(a, l, GW, ngw, LANE); } }
        SEAM(pb + 4);
        if (PHM(12) && IN(pb + 5)) { for (int r_ = 0; r_ < 1 + DUP(5); ++r_) ml_out_phase(a, l, GW, ngw, LANE); for (int r_ = 0; r_ < 1 + DUP(6); ++r_) ssd_out_phase(a, l, GW, ngw, LANE); for (int r_ = 0; r_ < 1 + DUP(7); ++r_) s5_out_phase(a, l, GW, ngw, LANE); }
        SEAM(pb + 5);
        if (PHM(6) && IN(pb + 6)) { Gemm g{ZB, wl + W_GLU, M, 512, 512, 512, 1, 0, 0}; StaticOrder S; S.init(M, 512, G, blockIdx.x, 1, 512);
            EpiGlu E{ZB, a.in[29] + l * 512, BR}; for (int r_ = 0; r_ < 1 + DUP(16); ++r_) gemm_phase(lds, g, S, E); ssd_fin_phase(a, l, GW, ngw, LANE); }
        SEAM(pb + 6);
        if (PHM(7) && IN(pb + 7)) { Gemm g{BR, wl + W_BR, M, D, 512, D, 4, 512, (size_t)D * 512}; StaticOrder S; S.init(M, D, G, blockIdx.x, 4, 512);
            EpiBranch E{PROJ, MERGED}; for (int r_ = 0; r_ < 1 + DUP(12); ++r_) gemm_phase(lds, g, S, E);
            if (l + 1 < DEPTH && (int)blockIdx.x >= 128) conv_pull(a, lds, ctlw + 8, l + 1, 2); }
        SEAM(pb + 7);
        if (PHM(8) && IN(pb + 8)) { Gemm g{MERGED, wl + W_OUT, M, D, D, D, 1, 0, 0}; SplitOrder S; S.init(blockIdx.x, D);
            EpiResid E{xp, xs, modl, 2 * D, X, MACC}; if (DUP(14)) { EpiResid E2{xp, xs, modl, 2 * D, (float*)(a.ws + WS_PROJ), MACC}; gemm_phase(lds, g, S, E2); } gemm_phase(lds, g, S, E); }
        SEAM(pb + 8);
        if (PHM(9) && IN(pb + 9)) norm_phase(X, X + (size_t)MP * D, a.in[15] + l * D, modl, 3 * D, 4 * D, H, GW, ngw, LANE, MACC, modl, 2 * D, X, xs, nullptr, a.ws + WS_H8, (float*)(a.ws + WS_RSC));
        SEAM(pb + 9);
        if (PHM(10) && IN(pb + 10)) { Gemm g{(const bf16_t*)(a.ws + WS_H8), wl + W_1, M, DFF, 1024, 1024, 1, 0, 0}; StaticOrder S; S.init(M, DFF, G, blockIdx.x, 1, 1024);
            EpiRelu2 E{HID, DFF, (const float*)(a.ws + WS_RSC), (const float*)(a.ws + WS_WSC) + (size_t)l * DFF}; for (int r_ = 0; r_ < 1 + DUP(10); ++r_) gemm_phase(lds, g, S, E); }
        SEAM(pb + 10);
        if (PHM(11) && IN(pb + 11)) { Gemm g{HID, wl + W_2, M, D, DFF, DFF, 1, 0, 0}; SplitOrder S; S.init(blockIdx.x, DFF);
            EpiResid E{X, X + (size_t)MP * D, modl, 5 * D, X, MACC}; if (DUP(15)) { EpiResid E2{X, X + (size_t)MP * D, modl, 5 * D, (float*)(a.ws + WS_BR), MACC}; gemm_phase(lds, g, S, E2); } gemm_phase(lds, g, S, E); }
        SEAM(pb + 11);
    }
    if (IN(1 + DEPTH * NPH)) final_fix_phase(MACC, MOD + (size_t)(DEPTH - 1) * 5 * 6 * D, 5 * D, X, GW, ngw, LANE);
    if (TPROBE >= 0) { xcd_barrier(bar); TSTAMP(13); if (blockIdx.x == 0 && TID == 0) { volatile LAS float* ta_ = (volatile LAS float*)(ctlw + 24); float tot_ = 0.f; for (int q_ = 0; q_ < 14; ++q_) tot_ += ta_[q_]; a.out[0] = (TPROBE == 99 ? tot_ : ta_[TPROBE]) * 10.f; } }
#undef IN
#undef SEAM
#undef H
#undef PROJ
#undef SMALL
#undef BR
#undef MERGED
#undef MACC
#undef ZB
#undef HID
#undef MOD
#undef X
#undef xp
#undef xs
#undef modl
#undef wl
}
}
extern "C" void kernel_launch(void* const* d_in, const int* in_sizes, int n_in, void* d_out, int out_size, void* d_ws, size_t ws_size, hipStream_t stream) {
    static int grid = 0;
    if (grid == 0) {
        int dev = 0, cus = 0; (void)hipGetDevice(&dev); (void)hipDeviceGetAttribute(&cus, hipDeviceAttributeMultiprocessorCount, dev);
        (void)hipFuncSetAttribute((const void*)mk::mk_fwd, hipFuncAttributeMaxDynamicSharedMemorySize, mk::LDS_BYTES);
        int per_cu = 0; (void)hipOccupancyMaxActiveBlocksPerMultiprocessor(&per_cu, (const void*)mk::mk_fwd, mk::NT, mk::LDS_BYTES); (void)hipGetLastError();
        (void)cus; grid = 256;
    }
    mk::Args a{}; for (int i = 0; i < 43; ++i) a.in[i] = (const float*)d_in[i];
    a.out = (float*)d_out; a.ws = (unsigned char*)d_ws; a.ph_lo = 0; a.ph_hi = mk::PH_TOTAL;
    (void)hipMemsetAsync(a.ws + mk::WS_CTL, 0, mk::CTL_BYTES, stream);
    hipLaunchKernelGGL(mk::mk_fwd, dim3(grid), dim3(mk::NT), mk::LDS_BYTES, stream, a);
}
```

```cpp
#define SAFE_GEMM 0
#define DUPMASK 0
#define TPROBE -1
#define NREP 1
#define WQMASK 0
#define PPASS 1000
#include <hip/hip_runtime.h>
#include <math.h>
namespace mk {
#define LAS __attribute__((address_space(3)))
typedef unsigned short bf16_t;
typedef short bf16x8 __attribute__((ext_vector_type(8)));
typedef float f32x4 __attribute__((ext_vector_type(4)));
typedef float f32x2 __attribute__((ext_vector_type(2)));
typedef unsigned u32x4 __attribute__((ext_vector_type(4)));
typedef unsigned u32x2 __attribute__((ext_vector_type(2)));
typedef int v4i32 __attribute__((ext_vector_type(4)));
typedef int v8i32 __attribute__((ext_vector_type(8)));
constexpr int NT = 512, NWV = 8;
constexpr int D = 2048, MP = 4096, MLAT = 8192, M = MP + MLAT, DEPTH = 4, DFF = 8192;
constexpr int PJ = 13824;
constexpr int NIN = 14080;
constexpr int P_Q = 0, P_K = 512, P_V = 1024, P_S5U = 1536, P_Z = 2048, P_XBC = 2560, P_MQ = 3584, P_MK = 4096, P_MV = 4608, P_MO = 5120, P_GATE = 5632;
constexpr int S_DT = 0, S_MI = 16, S_MF = 24;

typedef __bf16 bf16x2_t __attribute__((ext_vector_type(2)));
__device__ __forceinline__ unsigned pk2(float lo, float hi) { f32x2 v = {lo, hi}; bf16x2_t b = __builtin_convertvector(v, bf16x2_t); return __builtin_bit_cast(unsigned, b); }
__device__ __forceinline__ float bf2f(bf16_t v) { return __uint_as_float(((unsigned)v) << 16); }
__device__ __forceinline__ float bflo(unsigned w) { return __uint_as_float(w << 16); }
__device__ __forceinline__ float bfhi(unsigned w) { return __uint_as_float(w & 0xffff0000u); }
__device__ __forceinline__ bf16_t f2bf(float f) { return (bf16_t)(pk2(f, 0.f) & 0xffffu); }
__device__ __forceinline__ float fsigm(float x) { return __builtin_amdgcn_rcpf(1.f + __expf(-x)); }
__device__ __forceinline__ float fsilu(float x) { return x * fsigm(x); }
__device__ __forceinline__ int row_cvec(int row) { return row < MP ? 0 : 1 + (row - MP) / 2048; }

constexpr int NT8 = 41, NTB = 14;
__host__ __device__ __forceinline__ int tile_of_i8(int i) { return i < 32 ? 22 + i : (i < 34 ? i - 32 : (i < 36 ? 8 + (i - 34) : (i == 36 ? 13 : (i < 39 ? 14 + (i - 37) : 20 + (i - 39))))); }
__host__ __device__ __forceinline__ int tile_of_bf(int i) { return i < 6 ? 2 + i : (i < 9 ? 10 + (i - 6) : (i < 11 ? 16 + (i - 9) : (i < 13 ? 18 + (i - 11) : 54))); }
__host__ __device__ __forceinline__ int i8_index_of(int T) { return T >= 22 && T < 54 ? T - 22 : (T < 2 ? 32 + T : (T == 8 || T == 9 ? 34 + (T - 8) : (T == 13 ? 36 : (T == 14 || T == 15 ? 37 + (T - 14) : (T == 20 || T == 21 ? 39 + (T - 20) : -1))))); }
__host__ __device__ __forceinline__ int bf_index_of(int T) { return T >= 2 && T < 8 ? T - 2 : (T >= 10 && T < 13 ? 6 + (T - 10) : (T == 16 || T == 17 ? 9 + (T - 16) : (T == 18 || T == 19 ? 11 + (T - 18) : (T == 54 ? 13 : -1)))); }
__host__ __device__ __forceinline__ int win_col(int grp) { const int T = grp >> 3, q8 = grp & 7; int sc = 256 * T + 32 * (2 * (q8 & 3) + (q8 >> 2)); if (T >= 22) sc += 32; else if (T >= 14) sc += 16; return sc; }

#define XB_TMO      128
#define XB_XCNT(j)  (256  + 64 * (j))
#define XB_XSUB(j)  (1280 + 64 * (j))
#define XB_XGEN(j)  (2304 + 64 * (j))
#define XB_TOP      3328
#define XB_TOPGEN   3392
#define XCD_BAR_WORDS 3456
#define XB_SPIN_CAP (1u << 18)
__device__ __forceinline__ unsigned xb_ld(unsigned* p)              { return __hip_atomic_load(p, __ATOMIC_RELAXED, __HIP_MEMORY_SCOPE_AGENT); }
__device__ __forceinline__ unsigned xb_add(unsigned* p, unsigned v) { return __hip_atomic_fetch_add(p, v, __ATOMIC_RELAXED, __HIP_MEMORY_SCOPE_AGENT); }
#define MK_SWAP(op, a, b) asm volatile("s_nop 1\n\t" op " %0, %1\n\ts_nop 1" : "+v"(a), "+v"(b))
__device__ __forceinline__ float xmax16(float x) { float a = x, b = x; MK_SWAP("v_permlane16_swap_b32", a, b); return fmaxf(a, b); }
__device__ __forceinline__ float xmax32(float x) { float a = x, b = x; MK_SWAP("v_permlane32_swap_b32", a, b); return fmaxf(a, b); }
__device__ __forceinline__ float xsum16(float x) { float a = x, b = x; MK_SWAP("v_permlane16_swap_b32", a, b); return a + b; }
__device__ __forceinline__ float xsum32(float x) { float a = x, b = x; MK_SWAP("v_permlane32_swap_b32", a, b); return a + b; }
__device__ __forceinline__ unsigned xb_xcc_id() { return (unsigned)__builtin_amdgcn_s_getreg((3 << 11) | 20) & 0xFu; }
#define XB_SPIN(cond, bar) do { unsigned _sp = 0; while (cond) { __builtin_amdgcn_s_sleep(1); \
    if ((++_sp & 255u) == 0u) { if (xb_ld(&(bar)[XB_TMO])) break; if (_sp > XB_SPIN_CAP) { atomicAdd(&(bar)[XB_TMO], 1u); break; } } } } while (0)
struct XcdBarrier { unsigned* bar; unsigned x; volatile LAS unsigned* st; };
__device__ __forceinline__ XcdBarrier xcd_barrier_post(unsigned* bar, volatile LAS unsigned* st) {
    XcdBarrier b; b.bar = bar; b.x = xb_xcc_id(); b.st = st;
    if (threadIdx.x == 0) (void)xb_add(&bar[XB_XCNT(b.x)], 1u);
    return b;
}
__device__ __forceinline__ void xcd_barrier_complete(unsigned* bar, unsigned x, unsigned& nloc, unsigned& nx) {
    const unsigned G = gridDim.x * gridDim.y * gridDim.z;
    unsigned sum, cnt, mine, sp = 0u;
    for (;;) {
        sum = 0u; cnt = 0u; mine = 0u;
#pragma unroll
        for (unsigned j = 0; j < 16; ++j) { const unsigned c = xb_ld(&bar[XB_XCNT(j)]); sum += c; cnt += (c > 0u) ? 1u : 0u; mine = (j == x) ? c : mine; }
        if (sum == G) break;
        __builtin_amdgcn_s_sleep(1);
        if ((++sp & 255u) == 0u) { if (xb_ld(&bar[XB_TMO])) break; if (sp > XB_SPIN_CAP) { atomicAdd(&bar[XB_TMO], 1u); break; } }
    }
    nloc = mine > 0u ? mine : 1u; nx = cnt > 0u ? cnt : 1u;
}
__device__ __forceinline__ void xcd_barrier(const XcdBarrier& b) {
    asm volatile("s_waitcnt vmcnt(0)" ::: "memory");
    __syncthreads();
    if (threadIdx.x == 0) {
        unsigned* bar = b.bar;
        __builtin_amdgcn_s_waitcnt(0);
        unsigned nloc = b.st[0], nx = b.st[1];
        if (nloc == 0u) { xcd_barrier_complete(bar, b.x, nloc, nx); b.st[0] = nloc; b.st[1] = nx; }
        const unsigned old = xb_add(&bar[XB_XSUB(b.x)], 1u);
        const unsigned gen = old / nloc;
        if (old + 1u == (gen + 1u) * nloc) {
            __builtin_amdgcn_fence(__ATOMIC_RELEASE, "agent");
            asm volatile("s_waitcnt vmcnt(0)" ::: "memory");
            const unsigned og = xb_add(&bar[XB_TOP], 1u);
            const unsigned tg = og / nx;
            if (og + 1u == (tg + 1u) * nx) xb_add(&bar[XB_TOPGEN], 1u);
            else XB_SPIN(xb_ld(&bar[XB_TOPGEN]) == tg, bar);
            __builtin_amdgcn_fence(__ATOMIC_ACQUIRE, "agent");
            xb_add(&bar[XB_XGEN(b.x)], 1u);
            asm volatile("s_waitcnt vmcnt(0)" ::: "memory");
        } else {
            XB_SPIN(xb_ld(&bar[XB_XGEN(b.x)]) == gen, bar);
            __builtin_amdgcn_fence(__ATOMIC_ACQUIRE, "agent");
            asm volatile("s_waitcnt vmcnt(0)" ::: "memory");
        }
    }
    __syncthreads();
}

#ifndef GEMM_SP2
#define GEMM_SP2 1
#endif
#ifndef GEMM_ALIGN
#define GEMM_ALIGN 1
#endif
constexpr int BM = 256, BK = 64, HALF = 128, HTB = HALF * BK * 2, STAGE_BYTES = 8 * HTB, NXCD = 8, WGM = 8;
__host__ __device__ __forceinline__ int lds_byte(int r, int c) { const int st = (r >> 4) * 2 + (c >> 5), rr = r & 15, cc = c & 31, ob = rr * 64 + cc * 2; return st * 1024 + (ob ^ (((ob >> 9) & 1) << 5)); }
__host__ __device__ __forceinline__ void stage_rc(int b, int& R, int& C) { const int st = b / 1024, sb = b % 1024, swz = sb ^ (((sb >> 9) & 1) << 5); R = (st >> 1) * 16 + swz / 64; C = (st & 1) * 32 + (swz % 64) / 2; }
__host__ __device__ __forceinline__ int perm32(int rho) { const int n = rho >> 4, i = rho & 15; return 8 * (i >> 2) + 4 * n + (i & 3); }

struct Unit { int pm, pn, kz, koff, nt; };
struct Gemm { const bf16_t* A; const bf16_t* Bt; int M, N, K, lda, nkz; size_t a_kz, b_kz; int tm = 0; };

struct StaticOrder {
    int nM, nN, nwg, G, c, nkz;
    int ntk;
    __device__ void init(int M_, int N_, int G_, int c_, int nkz_ = 1, int K_ = 0) { nM = M_ / BM; nN = N_ / BM; nwg = nM * nN; G = G_; c = c_; nkz = nkz_; ntk = K_ / BK; }
    __device__ bool next(int i, Unit& u) const {
        const int it = i / nkz; u.kz = i - it * nkz; u.koff = 0; u.nt = ntk;
        const long L = (long)it * G + c; if (L >= nwg) return false;
        int wgid = (int)L; { const int q = nwg / NXCD, r = nwg % NXCD, xcd = wgid % NXCD, off = wgid / NXCD; wgid = (xcd < r ? xcd * (q + 1) : r * (q + 1) + (xcd - r) * q) + off; }
        const int nig = WGM * nN, gid = wgid / nig, fm = gid * WGM, gsz = (nM - fm) < WGM ? (nM - fm) : WGM;
        u.pm = fm + ((wgid % nig) % gsz); u.pn = (wgid % nig) / gsz; return true;
    }
};

struct SplitOrder {
    int c, ntk;
    __device__ void init(int c_, int K_) { c = c_; ntk = K_ / BK; }
    __device__ bool next(int i, Unit& u) const {
        const int xcd = c & 7, idx = c >> 3;
        if (i == 1) { u.pm = xcd * 4 + (idx >> 3); u.pn = idx & 7; u.kz = 0; u.koff = 0; u.nt = ntk; return true; }
        if (i == 0) { const int t = idx >> 1; u.pm = 32 + xcd * 2 + (t >> 3); u.pn = t & 7; u.kz = 0; u.nt = ntk >> 1; u.koff = (idx & 1) * (ntk >> 1) * BK; return true; }
        return false;
    }
};

template <class Epi, class Sched>
__device__ __forceinline__ void gemm_phase(LAS unsigned char* lds, const Gemm g, const Sched& S, const Epi& E) {
    int tid_ = threadIdx.x; asm volatile("" : "+v"(tid_));
    const int tid = tid_, wid = __builtin_amdgcn_readfirstlane(tid >> 6), lane = tid & 63, wr = wid >> 2, wc = wid & 3, fr = lane & 15, fq = lane >> 4;
    const int K = g.K;
    unsigned voffA[2], voffB[2];
#pragma unroll
    for (int i = 0; i < 2; ++i) { int R, C; stage_rc(tid * 16 + i * 8192, R, C); const int Rb = Epi::PERM ? ((R & ~31) + perm32(R & 31)) : R;
        voffA[i] = (unsigned)(R * (g.tm ? BK : g.lda) + C) * 2u; voffB[i] = (unsigned)(Rb * (g.tm ? BK : K) + C) * 2u; }
    const size_t kstep = g.tm ? (size_t)(BM * BK * 2) : (size_t)(BK * 2); const size_t kmul = g.tm ? (size_t)BM : (size_t)1;
    const size_t hstepA = (size_t)HALF * (g.tm ? BK : g.lda) * 2, hstepB = (size_t)HALF * (g.tm ? BK : K) * 2;
    const size_t tstepA = g.tm ? (size_t)K * BM * 2 : 2 * hstepA, tstepB = (size_t)K * BM * 2;
    const unsigned ldsw = (unsigned)wid * 1024u;
    const int aoff = lds_byte(wr * 64 + fr, fq * 8), boff = lds_byte(wc * 32 + fr, fq * 8);
#define PG8_SA(b, h) (((b) * 2 + (h)) * HTB)
#define PG8_SB(b, h) ((4 + (b) * 2 + (h)) * HTB)
#define PG8_STAGE(bufoff, gbase, voff) do { _Pragma("unroll") for (int _i = 0; _i < 2; ++_i) \
        __builtin_amdgcn_global_load_lds((const unsigned*)((const char*)(gbase) + (voff)[_i]), (LAS unsigned*)(lds + (bufoff) + ldsw + _i * 8192), 16, 0, 0); } while (0)
#define PG8_LDA(dst, b, h) do { if constexpr (Epi::MODE == 1) { _Pragma("unroll") for (int m = 0; m < 4; ++m) dst##8[m] = __builtin_shufflevector(*(const LAS v4i32*)(lds + PG8_SA(b, h) + aoff + m * 2048), *(const LAS v4i32*)(lds + PG8_SA(b, h) + aoff + m * 2048 + 1024), 0, 1, 2, 3, 4, 5, 6, 7); } \
        else { _Pragma("unroll") for (int m = 0; m < 4; ++m) _Pragma("unroll") for (int k = 0; k < 2; ++k) dst[m][k] = *(const LAS bf16x8*)(lds + PG8_SA(b, h) + aoff + m * 2048 + k * 1024); } } while (0)
#define PG8_LDB(dst, b, h) do { if constexpr (Epi::MODE == 1) { _Pragma("unroll") for (int n = 0; n < 2; ++n) dst##8[n] = __builtin_shufflevector(*(const LAS v4i32*)(lds + PG8_SB(b, h) + boff + n * 2048), *(const LAS v4i32*)(lds + PG8_SB(b, h) + boff + n * 2048 + 1024), 0, 1, 2, 3, 4, 5, 6, 7); } \
        else { _Pragma("unroll") for (int n = 0; n < 2; ++n) _Pragma("unroll") for (int k = 0; k < 2; ++k) dst[n][k] = *(const LAS bf16x8*)(lds + PG8_SB(b, h) + boff + n * 2048 + k * 1024); } } while (0)
#define PG8_MMA_BF16(ai, bj, At, Bt) do { __builtin_amdgcn_s_setprio(1); _Pragma("unroll") for (int m = 0; m < 4; ++m) _Pragma("unroll") for (int n = 0; n < 2; ++n) _Pragma("unroll") for (int k = 0; k < 2; ++k) \
        acc[ai][bj][m][n] = __builtin_amdgcn_mfma_f32_16x16x32_bf16(Bt[n][k], At[m][k], acc[ai][bj][m][n], 0, 0, 0); __builtin_amdgcn_s_setprio(0); } while (0)
#define PG8_MMA_FP8(ai, bj, At, Bt) do { __builtin_amdgcn_s_setprio(1); _Pragma("unroll") for (int m = 0; m < 4; ++m) _Pragma("unroll") for (int n = 0; n < 2; ++n) \
        asm volatile("v_mfma_scale_f32_16x16x128_f8f6f4 %0, %1, %2, %0, %3, %3 op_sel_hi:[0,0,0]" : "+v"(acc[ai][bj][m][n]) : "v"(Bt##8[n]), "v"(At##8[m]), "v"(f8scale)); __builtin_amdgcn_s_setprio(0); } while (0)
#define PG8_F8_SETTLE() do { if constexpr (Epi::MODE == 1) asm volatile("s_nop 15\n\ts_nop 15" ::: "memory"); } while (0)
#define PG8_MMA_I8(ai, bj, At, Bt) do { __builtin_amdgcn_s_setprio(1); _Pragma("unroll") for (int m = 0; m < 4; ++m) _Pragma("unroll") for (int n = 0; n < 2; ++n) _Pragma("unroll") for (int k = 0; k < 2; ++k) \
        acc[ai][bj][m][n] = __builtin_bit_cast(f32x4, __builtin_amdgcn_mfma_i32_16x16x64_i8(__builtin_bit_cast(v4i32, Bt[n][k]), __builtin_bit_cast(v4i32, At[m][k]), __builtin_bit_cast(v4i32, acc[ai][bj][m][n]), 0, 0, 0)); __builtin_amdgcn_s_setprio(0); } while (0)
#define PG8_MMA(ai, bj, At, Bt) do { if constexpr (Epi::MODE == 1) PG8_MMA_FP8(ai, bj, At, Bt); else if constexpr (Epi::MODE == 2) PG8_MMA_I8(ai, bj, At, Bt); else PG8_MMA_BF16(ai, bj, At, Bt); } while (0)
#if SAFE_GEMM == 1 || SAFE_GEMM == 3
#define PG8_WAIT_V(n) asm volatile("s_waitcnt vmcnt(0)" ::: "memory")
#else
#define PG8_WAIT_V(n) asm volatile("s_waitcnt vmcnt(" #n ")" ::: "memory")
#endif
#define PG8_WAIT_L(n) asm volatile("s_waitcnt lgkmcnt(" #n ")" ::: "memory")
#if SAFE_GEMM == 1
#define PG8_BAR do { asm volatile("s_waitcnt vmcnt(0) lgkmcnt(0)" ::: "memory"); __builtin_amdgcn_s_barrier(); asm volatile("" ::: "memory"); } while (0)
#elif SAFE_GEMM == 2
#define PG8_BAR asm volatile("s_barrier" ::: "memory")
#elif SAFE_GEMM == 4
#define PG8_BAR do { asm volatile("s_waitcnt lgkmcnt(0)" ::: "memory"); __builtin_amdgcn_s_barrier(); } while (0)
#else
#define PG8_BAR __builtin_amdgcn_s_barrier()
#endif
#define PG8_SCHED __builtin_amdgcn_sched_barrier(0)
    Unit cur, nxt; int ui = 0;
    if (!S.next(0, cur)) return;
    f32x4 acc[2][2][4][2];
#pragma unroll
    for (int a = 0; a < 2; ++a)
#pragma unroll
        for (int b = 0; b < 2; ++b)
#pragma unroll
            for (int m = 0; m < 4; ++m)
#pragma unroll
                for (int n = 0; n < 2; ++n) acc[a][b][m][n] = (f32x4){0.f, 0.f, 0.f, 0.f};
    bf16x8 At[4][2], B0[2][2], B1[2][2]; v8i32 At8[4], B08[2], B18[2];
    int f8scale = 0x7f7f7f7f; asm volatile("" : "+v"(f8scale));
    const char* cA = (const char*)(g.A + (size_t)cur.kz * g.a_kz + (size_t)cur.koff * kmul) + (size_t)cur.pm * tstepA; const char* cB = (const char*)(g.Bt + (size_t)cur.kz * g.b_kz + (size_t)cur.koff * kmul) + (size_t)cur.pn * tstepB;
#if GEMM_SP2
    PG8_STAGE(PG8_SB(0, 0), cB, voffB); PG8_STAGE(PG8_SB(0, 1), cB + hstepB, voffB); PG8_STAGE(PG8_SA(0, 0), cA, voffA); PG8_STAGE(PG8_SA(0, 1), cA + hstepA, voffA);
    if (wr == 1) PG8_BAR;
    PG8_WAIT_V(2); PG8_BAR;
    PG8_STAGE(PG8_SB(1, 0), cB + kstep, voffB); PG8_STAGE(PG8_SA(1, 0), cA + kstep, voffA); PG8_STAGE(PG8_SB(1, 1), cB + hstepB + kstep, voffB);
    PG8_WAIT_V(6); PG8_BAR;
#else
    PG8_STAGE(PG8_SB(0, 0), cB, voffB); PG8_STAGE(PG8_SA(0, 0), cA, voffA); PG8_STAGE(PG8_SB(0, 1), cB + hstepB, voffB); PG8_STAGE(PG8_SA(0, 1), cA + hstepA, voffA);
    if (wr == 1) PG8_BAR;
    PG8_WAIT_V(4); PG8_BAR;
    PG8_STAGE(PG8_SB(1, 0), cB + kstep, voffB); PG8_STAGE(PG8_SA(1, 0), cA + kstep, voffA); PG8_STAGE(PG8_SB(1, 1), cB + hstepB + kstep, voffB);
    PG8_WAIT_V(6); PG8_BAR;
#endif
    for (;;) {
        const bool has_next = S.next(ui + 1, nxt);
        const char* nA = has_next ? (const char*)(g.A + (size_t)nxt.kz * g.a_kz + (size_t)nxt.koff * kmul) + (size_t)nxt.pm * tstepA : cA;
        const char* nB = has_next ? (const char*)(g.Bt + (size_t)nxt.kz * g.b_kz + (size_t)nxt.koff * kmul) + (size_t)nxt.pn * tstepB : cB;
        const int nt = cur.nt;
        for (int t = 0; t < nt; t += 2) {
            const bool last = (t == nt - 2);
            const char* a1 = cA + (size_t)(t + 1) * kstep;
            const char* a2 = last ? nA : cA + (size_t)(t + 2) * kstep; const char* b2 = last ? nB : cB + (size_t)(t + 2) * kstep;
            const char* a3 = a2 + kstep; const char* b3 = b2 + kstep;
#if GEMM_SP2
            PG8_LDB(B0, 0, 0); PG8_LDB(B1, 0, 1); PG8_SCHED; PG8_LDA(At, 0, 0); PG8_STAGE(PG8_SA(1, 1), a1 + hstepA, voffA);
            PG8_WAIT_V(8); PG8_WAIT_L(0); PG8_BAR; PG8_MMA(0, 0, At, B0); PG8_MMA(0, 1, At, B1); PG8_BAR; PG8_SCHED;
            PG8_LDA(At, 0, 1); PG8_STAGE(PG8_SB(0, 0), b2, voffB); PG8_STAGE(PG8_SB(0, 1), b2 + hstepB, voffB); PG8_STAGE(PG8_SA(0, 0), a2, voffA);
            PG8_WAIT_V(8); PG8_WAIT_L(0); PG8_BAR; PG8_MMA(1, 0, At, B0); PG8_MMA(1, 1, At, B1); PG8_BAR; PG8_SCHED;
            PG8_LDB(B0, 1, 0); PG8_LDB(B1, 1, 1); PG8_SCHED; PG8_LDA(At, 1, 0); PG8_STAGE(PG8_SA(0, 1), a2 + hstepA, voffA);
            PG8_WAIT_V(8); PG8_WAIT_L(0); PG8_BAR; PG8_MMA(0, 0, At, B0); PG8_MMA(0, 1, At, B1); PG8_BAR; PG8_SCHED;
            PG8_LDA(At, 1, 1); PG8_STAGE(PG8_SB(1, 0), b3, voffB); PG8_STAGE(PG8_SB(1, 1), b3 + hstepB, voffB); PG8_STAGE(PG8_SA(1, 0), a3, voffA);
            PG8_WAIT_V(8); PG8_WAIT_L(0); PG8_BAR; PG8_MMA(1, 0, At, B0); PG8_MMA(1, 1, At, B1); PG8_BAR; PG8_SCHED;
#else
            PG8_LDB(B0, 0, 0); PG8_SCHED; PG8_LDA(At, 0, 0); PG8_STAGE(PG8_SA(1, 1), a1 + hstepA, voffA);
            PG8_WAIT_L(8); PG8_BAR; PG8_WAIT_L(0); PG8_MMA(0, 0, At, B0); PG8_BAR; PG8_SCHED;
            PG8_LDB(B1, 0, 1); PG8_STAGE(PG8_SB(0, 0), b2, voffB);
            PG8_BAR; PG8_WAIT_L(0); PG8_MMA(0, 1, At, B1); PG8_BAR;
            PG8_LDA(At, 0, 1); PG8_STAGE(PG8_SA(0, 0), a2, voffA);
            PG8_BAR; PG8_WAIT_L(0); PG8_MMA(1, 0, At, B0); PG8_BAR; PG8_SCHED;
            PG8_STAGE(PG8_SB(0, 1), b2 + hstepB, voffB);
            PG8_WAIT_V(6); PG8_BAR; PG8_MMA(1, 1, At, B1); PG8_BAR;
            PG8_LDB(B0, 1, 0); PG8_SCHED; PG8_LDA(At, 1, 0); PG8_STAGE(PG8_SA(0, 1), a2 + hstepA, voffA);
            PG8_WAIT_L(8); PG8_BAR; PG8_WAIT_L(0); PG8_MMA(0, 0, At, B0); PG8_BAR; PG8_SCHED;
            PG8_LDB(B1, 1, 1); PG8_STAGE(PG8_SB(1, 0), b3, voffB);
            PG8_BAR; PG8_WAIT_L(0); PG8_MMA(0, 1, At, B1); PG8_BAR;
            PG8_LDA(At, 1, 1); PG8_STAGE(PG8_SA(1, 0), a3, voffA);
            PG8_BAR; PG8_WAIT_L(0); PG8_MMA(1, 0, At, B0); PG8_BAR; PG8_SCHED;
            PG8_STAGE(PG8_SB(1, 1), b3 + hstepB, voffB);
            PG8_WAIT_V(6); PG8_BAR; PG8_MMA(1, 1, At, B1); PG8_BAR;
#endif
        }
        PG8_F8_SETTLE();
#if GEMM_ALIGN
        if (wr == 0) PG8_BAR;
#endif
        E(acc, cur, wr, wc, fr, fq);
        if (!has_next) break;
        if (nxt.kz == 0) {
#pragma unroll
        for (int a = 0; a < 2; ++a)
#pragma unroll
            for (int b = 0; b < 2; ++b)
#pragma unroll
                for (int m = 0; m < 4; ++m)
#pragma unroll
                    for (int n = 0; n < 2; ++n) acc[a][b][m][n] = (f32x4){0.f, 0.f, 0.f, 0.f};
        }
        cur = nxt; cA = nA; cB = nB; ++ui;
#if GEMM_ALIGN
        if (wr == 1) PG8_BAR;
#endif
    }
    PG8_WAIT_V(0);
#if !GEMM_ALIGN
    if (wr == 0) PG8_BAR;
#endif
    PG8_BAR;
#undef PG8_SA
#undef PG8_SB
#undef PG8_STAGE
#undef PG8_LDA
#undef PG8_LDB
#undef PG8_MMA
#undef PG8_MMA_BF16
#undef PG8_MMA_FP8
#undef PG8_MMA_I8
#undef PG8_F8_SETTLE
#undef PG8_WAIT_V
#undef PG8_WAIT_L
#undef PG8_BAR
#undef PG8_SCHED
}
}
namespace mk {
constexpr size_t O_YP = 0, O_YS = 8388608, O_NK = 25165824, O_NV = 33554432, O_S5R = 41943040, O_S5I = 42205184, O_SSD = 42467328,
                 O_MLC = 50855936, O_MLN = 59244544, O_MLM = 59310080;

__device__ __forceinline__ u32x4 pack8(const f32x4 a, const f32x4 b) { u32x4 w; w.x = pk2(a[0], a[1]); w.y = pk2(a[2], a[3]); w.z = pk2(b[0], b[1]); w.w = pk2(b[2], b[3]); return w; }

template <bool F8> struct EpiInT {
    static constexpr bool PERM = true; static constexpr int MODE = F8 ? 1 : 0;
    bf16_t* proj; float* small; float* out; const float* qg; const float* kg; int layer; bf16_t* up;
    __device__ __forceinline__ void operator()(f32x4 (&acc)[2][2][4][2], const Unit& u, int wr, int wc, int fr, int fq) const {
        const int T = F8 ? 22 + u.pn : (u.pn == 22 ? 54 : u.pn), rowb = u.pm * BM + wr * 64 + fr;
        if (T == 54) {
            if (wc == 0) {
#pragma unroll
                for (int ai = 0; ai < 2; ++ai)
#pragma unroll
                    for (int m = 0; m < 4; ++m) { float* sp = small + (size_t)(rowb + ai * HALF + m * 16) * 32 + 8 * fq; *(f32x4*)sp = acc[ai][0][m][0]; *(f32x4*)(sp + 4) = acc[ai][0][m][1]; }
            }
            return;
        }
        const int colb = T * 256 + 64 * wc + 8 * fq;
        if (T < 4) {
            const float* g = T < 2 ? qg : kg;
            f32x4 gv[2][2];
#pragma unroll
            for (int bj = 0; bj < 2; ++bj)
#pragma unroll
                for (int n = 0; n < 2; ++n) gv[bj][n] = *(const f32x4*)(g + 32 * bj + 8 * fq + 4 * n);
#pragma unroll
            for (int ai = 0; ai < 2; ++ai)
#pragma unroll
                for (int m = 0; m < 4; ++m) {
                    float ss = 0.f;
#pragma unroll
                    for (int bj = 0; bj < 2; ++bj)
#pragma unroll
                        for (int n = 0; n < 2; ++n) { const f32x4 x = acc[ai][bj][m][n]; ss += (x[0] * x[0] + x[1] * x[1]) + (x[2] * x[2] + x[3] * x[3]); }
                    ss += __shfl_xor(ss, 16); ss += __shfl_xor(ss, 32);
                    const float r = rsqrtf(ss * (1.f / 64.f) + 1e-6f) * (T < 2 ? 0.18033688f : 1.f);
                    const int row = rowb + ai * HALF + m * 16;
#pragma unroll
                    for (int bj = 0; bj < 2; ++bj) { const f32x4 v0 = acc[ai][bj][m][0] * r * gv[bj][0], v1 = acc[ai][bj][m][1] * r * gv[bj][1];
                        *(u32x4*)(proj + (size_t)row * PJ + colb + 32 * bj) = pack8(v0, v1);
                        if (T >= 2 && row < MP) { float* o = out + O_NK + ((size_t)((row >> 8) * DEPTH + layer) * 256 + (row & 255)) * 512 + (colb - 512) + 32 * bj; *(f32x4*)o = v0; *(f32x4*)(o + 4) = v1; } }
                }
        } else if (T < 6) {
#pragma unroll
            for (int ai = 0; ai < 2; ++ai)
#pragma unroll
                for (int m = 0; m < 4; ++m) { const int row = rowb + ai * HALF + m * 16;
#pragma unroll
                    for (int bj = 0; bj < 2; ++bj) { const f32x4 v0 = acc[ai][bj][m][0], v1 = acc[ai][bj][m][1];
                        *(u32x4*)(proj + (size_t)row * PJ + colb + 32 * bj) = pack8(v0, v1);
                        if (row < MP) { float* o = out + O_NV + ((size_t)((row >> 8) * DEPTH + layer) * 256 + (row & 255)) * 512 + (colb - 1024) + 32 * bj; *(f32x4*)o = v0; *(f32x4*)(o + 4) = v1; } } }
        } else if (T < 22) {
#pragma unroll
            for (int ai = 0; ai < 2; ++ai)
#pragma unroll
                for (int m = 0; m < 4; ++m) { const int row = rowb + ai * HALF + m * 16;
#pragma unroll
                    for (int bj = 0; bj < 2; ++bj) {
                        if (T == 6 || T == 7) { const int cu = colb + 32 * bj - P_S5U;
                            *(u32x4*)(up + ((size_t)(cu >> 4) * 384 + (row >> 5)) * 512 + (row & 31) * 16 + (cu & 15)) = pack8(acc[ai][bj][m][0], acc[ai][bj][m][1]); }
                        else *(u32x4*)(proj + (size_t)row * PJ + colb + 32 * bj) = pack8(acc[ai][bj][m][0], acc[ai][bj][m][1]); } }
        } else {
#pragma unroll
            for (int ai = 0; ai < 2; ++ai)
#pragma unroll
                for (int m = 0; m < 4; ++m) { const int row = rowb + ai * HALF + m * 16;
#pragma unroll
                    for (int bj = 0; bj < 2; ++bj) { f32x4 v0 = acc[ai][bj][m][0], v1 = acc[ai][bj][m][1];
#pragma unroll
                        for (int j = 0; j < 4; ++j) { v0[j] = fsigm(v0[j]); v1[j] = fsigm(v1[j]); }
                        unsigned w0 = 0u, w1 = 0u;
                        w0 = __builtin_amdgcn_cvt_pk_u8_f32(fmaxf(v0[0] * 255.f + 0.5f, 1.f), 0, w0); w0 = __builtin_amdgcn_cvt_pk_u8_f32(fmaxf(v0[1] * 255.f + 0.5f, 1.f), 1, w0);
                        w0 = __builtin_amdgcn_cvt_pk_u8_f32(fmaxf(v0[2] * 255.f + 0.5f, 1.f), 2, w0); w0 = __builtin_amdgcn_cvt_pk_u8_f32(fmaxf(v0[3] * 255.f + 0.5f, 1.f), 3, w0);
                        w1 = __builtin_amdgcn_cvt_pk_u8_f32(fmaxf(v1[0] * 255.f + 0.5f, 1.f), 0, w1); w1 = __builtin_amdgcn_cvt_pk_u8_f32(fmaxf(v1[1] * 255.f + 0.5f, 1.f), 1, w1);
                        w1 = __builtin_amdgcn_cvt_pk_u8_f32(fmaxf(v1[2] * 255.f + 0.5f, 1.f), 2, w1); w1 = __builtin_amdgcn_cvt_pk_u8_f32(fmaxf(v1[3] * 255.f + 0.5f, 1.f), 3, w1);
                        u32x2 o8; o8.x = w0; o8.y = w1; *(u32x2*)((unsigned char*)(proj + (size_t)row * PJ + P_GATE) + (colb - P_GATE) + 32 * bj) = o8; } }
        }
    }
};
struct EpiRelu2 {
    static constexpr bool PERM = true; static constexpr int MODE = 2;
    bf16_t* O; int ldo; const float* rsc; const float* cmx;
    __device__ __forceinline__ void operator()(f32x4 (&acc)[2][2][4][2], const Unit& u, int wr, int wc, int fr, int fq) const {
        const int rowb = u.pm * BM + wr * 64 + fr, colb = u.pn * 256 + 64 * wc + 8 * fq;
        {   f32x4 cs[2][2];
#pragma unroll
            for (int bj = 0; bj < 2; ++bj)
#pragma unroll
                for (int n = 0; n < 2; ++n) cs[bj][n] = *(const f32x4*)(cmx + u.pn * 256 + 128 * bj + 32 * wc + 8 * fq + 4 * n) * (1.f / 127.f);
#pragma unroll
            for (int ai = 0; ai < 2; ++ai)
#pragma unroll
                for (int m = 0; m < 4; ++m) { const float rs = rsc[rowb + ai * HALF + m * 16];
#pragma unroll
                    for (int bj = 0; bj < 2; ++bj)
#pragma unroll
                        for (int n = 0; n < 2; ++n) { const v4i32 iv = __builtin_bit_cast(v4i32, acc[ai][bj][m][n]); f32x4 fv; fv[0] = (float)iv[0]; fv[1] = (float)iv[1]; fv[2] = (float)iv[2]; fv[3] = (float)iv[3];
                            acc[ai][bj][m][n] = fv * cs[bj][n] * rs; } }
        }
#pragma unroll
        for (int ai = 0; ai < 2; ++ai)
#pragma unroll
            for (int m = 0; m < 4; ++m) { const int row = rowb + ai * HALF + m * 16;
#pragma unroll
                for (int bj = 0; bj < 2; ++bj) { f32x4 v0 = acc[ai][bj][m][0], v1 = acc[ai][bj][m][1];
#pragma unroll
                    for (int j = 0; j < 4; ++j) { const float a = fmaxf(v0[j], 0.f), b = fmaxf(v1[j], 0.f); v0[j] = a * a; v1[j] = b * b; }
                    { const int col = colb + 32 * bj;
                        *(u32x4*)(O + (((size_t)(row >> 8) * (ldo >> 6) + (col >> 6)) * 256 + (row & 255)) * 64 + (col & 63)) = pack8(v0, v1); } } }
    }
};
struct EpiGlu {
    static constexpr bool PERM = true; static constexpr int MODE = 0;
    const bf16_t* Z; const float* bias; bf16_t* br;
    __device__ __forceinline__ void operator()(f32x4 (&acc)[2][2][4][2], const Unit& u, int wr, int wc, int fr, int fq) const {
        const int rowb = u.pm * BM + wr * 64 + fr, colb = u.pn * 256 + 64 * wc + 8 * fq;
#pragma unroll
        for (int bj = 0; bj < 2; ++bj) { const int c = colb + 32 * bj; const f32x4 b0 = *(const f32x4*)(bias + c), b1 = *(const f32x4*)(bias + c + 4);
#pragma unroll
            for (int ai = 0; ai < 2; ++ai)
#pragma unroll
                for (int m = 0; m < 4; ++m) { const int row = rowb + ai * HALF + m * 16;
                    const u32x4 zz = *(const u32x4*)(Z + (size_t)row * 512 + c);
                    f32x4 v0 = acc[ai][bj][m][0] + b0, v1 = acc[ai][bj][m][1] + b1;
                    v0[0] = bflo(zz.x) * fsigm(v0[0]); v0[1] = bfhi(zz.x) * fsigm(v0[1]); v0[2] = bflo(zz.y) * fsigm(v0[2]); v0[3] = bfhi(zz.y) * fsigm(v0[3]);
                    v1[0] = bflo(zz.z) * fsigm(v1[0]); v1[1] = bfhi(zz.z) * fsigm(v1[1]); v1[2] = bflo(zz.w) * fsigm(v1[2]); v1[3] = bfhi(zz.w) * fsigm(v1[3]);
                    *(u32x4*)(br + (size_t)row * D + 512 + c) = pack8(v0, v1); } }
    }
};
struct EpiBranch {
    static constexpr bool PERM = true; static constexpr int MODE = 0;
    const bf16_t* proj; bf16_t* merged;
    __device__ __forceinline__ void operator()(f32x4 (&acc)[2][2][4][2], const Unit& u, int wr, int wc, int fr, int fq) const {
        const int rowb = u.pm * BM + wr * 64 + fr, colb = u.pn * 256 + 64 * wc + 8 * fq, kz = u.kz;
#pragma unroll
        for (int ai = 0; ai < 2; ++ai)
#pragma unroll
            for (int m = 0; m < 4; ++m) { const int row = rowb + ai * HALF + m * 16;
#pragma unroll
                for (int bj = 0; bj < 2; ++bj) { const int c = colb + 32 * bj;
                    const unsigned char* gp = (const unsigned char*)(proj + (size_t)row * PJ + P_GATE) + kz * D + c;
                    const u32x2 gg = *(const u32x2*)gp;
                    float g[8] = {(float)(gg.x & 0xffu) - 0.5f, (float)((gg.x >> 8) & 0xffu) - 0.5f, (float)((gg.x >> 16) & 0xffu) - 0.5f, (float)(gg.x >> 24) - 0.5f,
                                  (float)(gg.y & 0xffu) - 0.5f, (float)((gg.y >> 8) & 0xffu) - 0.5f, (float)((gg.y >> 16) & 0xffu) - 0.5f, (float)(gg.y >> 24) - 0.5f};
                    if (kz < 3) { const u32x2 hh = *(const u32x2*)(gp + D);
                        const float h[8] = {(float)(hh.x & 0xffu) - 0.5f, (float)((hh.x >> 8) & 0xffu) - 0.5f, (float)((hh.x >> 16) & 0xffu) - 0.5f, (float)(hh.x >> 24) - 0.5f,
                                            (float)(hh.y & 0xffu) - 0.5f, (float)((hh.y >> 8) & 0xffu) - 0.5f, (float)((hh.y >> 16) & 0xffu) - 0.5f, (float)(hh.y >> 24) - 0.5f};
#pragma unroll
                        for (int j = 0; j < 8; ++j) g[j] = g[j] * __builtin_amdgcn_rcpf(h[j]); }
                    else {
#pragma unroll
                        for (int j = 0; j < 8; ++j) g[j] *= (1.f / 255.f); }
                    f32x4& v0 = acc[ai][bj][m][0]; f32x4& v1 = acc[ai][bj][m][1];
                    v0[0] *= g[0]; v0[1] *= g[1]; v0[2] *= g[2]; v0[3] *= g[3]; v1[0] *= g[4]; v1[1] *= g[5]; v1[2] *= g[6]; v1[3] *= g[7];
                    if (kz == 3) *(u32x4*)(merged + (size_t)row * D + c) = pack8(v0, v1); } }
    }
};
struct EpiResid {
    static constexpr bool PERM = false; static constexpr int MODE = 0;
    const float* xp; const float* xs; const float* modl; int g_off; float* xout; float* part;
    __device__ __forceinline__ void operator()(f32x4 (&acc)[2][2][4][2], const Unit& u, int wr, int wc, int fr, int fq) const {
        if (part != nullptr && u.pm >= 32) {
            bf16_t* P = (bf16_t*)part + (size_t)((((u.pm - 32) * 8 + u.pn) * 2) + (u.koff != 0)) * 65536 + (size_t)(wr * 64 + fr) * 256 + wc * 32 + 4 * fq;
#pragma unroll
            for (int ai = 0; ai < 2; ++ai)
#pragma unroll
                for (int m = 0; m < 4; ++m)
#pragma unroll
                    for (int bj = 0; bj < 2; ++bj)
#pragma unroll
                        for (int n = 0; n < 2; ++n) { const f32x4 t = acc[ai][bj][m][n]; u32x2 w; w.x = pk2(t[0], t[1]); w.y = pk2(t[2], t[3]); *(u32x2*)(P + (size_t)(ai * HALF + m * 16) * 256 + bj * HALF + n * 16) = w; }
            return;
        }
        const int row0 = u.pm * BM, rowb = row0 + wr * 64 + fr, colb = u.pn * 256 + wc * 32 + 4 * fq;
        const float* xin = row0 < MP ? xp : xs - (size_t)MP * D;
        const float* gate = modl + (size_t)row_cvec(row0) * 6 * D + g_off;
        f32x4 gv[2][2];
#pragma unroll
        for (int bj = 0; bj < 2; ++bj)
#pragma unroll
            for (int n = 0; n < 2; ++n) gv[bj][n] = *(const f32x4*)(gate + colb + bj * HALF + n * 16);
#pragma unroll
        for (int ai = 0; ai < 2; ++ai)
#pragma unroll
            for (int m = 0; m < 4; ++m) { const size_t ro = (size_t)(rowb + ai * HALF + m * 16) * D + colb;
#pragma unroll
                for (int bj = 0; bj < 2; ++bj)
#pragma unroll
                    for (int n = 0; n < 2; ++n) { const size_t o = ro + bj * HALF + n * 16; *(f32x4*)(xout + o) = *(const f32x4*)(xin + o) + gv[bj][n] * acc[ai][bj][m][n]; } }
    }
};
}
namespace mk {
constexpr size_t AL(size_t x) { return (x + 255) & ~(size_t)255; }
constexpr size_t WS_CTL = 0, CTL_BYTES = 36864 + DEPTH * 8192 * 4;
constexpr size_t WS_MOD = WS_CTL + CTL_BYTES;
constexpr size_t WS_W = AL(WS_MOD + (size_t)DEPTH * 5 * 6 * D * 4);
constexpr int NTB_ROWS = 14 * 256, NT8_ROWS = 41 * 256;
constexpr size_t W_IN = 0, W_GLU = W_IN + (size_t)NIN * D, W_BR = W_GLU + 512 * 512, W_OUT = W_BR + (size_t)4 * D * 512, W_1 = W_OUT + (size_t)D * D, W_2 = W_1 + (size_t)DFF * D,
                 W_LAYER = W_2 + (size_t)D * DFF;
constexpr size_t W_IN8 = (size_t)5888 * D;
constexpr size_t WS_H = AL(WS_W + W_LAYER * 2 * DEPTH);
constexpr size_t WS_PROJ = AL(WS_H + (size_t)M * D * 2);
constexpr size_t WS_SMALL = AL(WS_PROJ + (size_t)M * PJ * 2);
constexpr size_t WS_BR = AL(WS_SMALL + (size_t)M * 32 * 4);
constexpr size_t WS_MERGED = AL(WS_BR + (size_t)M * D * 2);
constexpr size_t WS_MACC = AL(WS_MERGED + (size_t)M * D * 2);
constexpr size_t WS_ZB = AL(WS_MACC + (size_t)M * D * 4);
constexpr size_t WS_H8 = AL(WS_ZB + (size_t)M * 512 * 2);
constexpr size_t WS_RSC = AL(WS_H8 + (size_t)M * D);
constexpr size_t WS_WSC = WS_CTL + 36864;
constexpr size_t WS_SCR = AL(WS_RSC + (size_t)M * 4);
constexpr int LDS_BYTES = 140 * 1024, LDS_CTL = LDS_BYTES - 256;

struct Args { const float* in[43]; float* out; unsigned char* ws; int ph_lo, ph_hi; };

__device__ __forceinline__ float wave_sum(float v) {
#pragma unroll
    for (int o = 1; o < 64; o <<= 1) v += __shfl_xor(v, o);
    return v;
}
#define LDS_WAIT() asm volatile("s_waitcnt lgkmcnt(0)" ::: "memory")

__device__ __forceinline__ void xpose_item(const float* W, int ldw, int k0, int sc, bf16_t* dst, int K, LAS float* scr, int lane, int mode, bool f8 = false, const float* cmax = nullptr, int kd = -1) {
    const int n4 = (lane & 7) * 4;
    const int col = mode == 1 ? (n4 < 16 ? 3584 + n4 : 5648 + (n4 - 16)) : sc + n4;
#pragma unroll
    for (int i = 0; i < 8; ++i) { const int kk = (lane >> 3) + 8 * i; f32x4 v = (f32x4){0.f, 0.f, 0.f, 0.f}; if (mode != 2) v = *(const f32x4*)(W + (size_t)(k0 + kk) * ldw + col);
        if (cmax != nullptr) { const f32x4 cm = *(const f32x4*)(cmax + n4);
#pragma unroll
            for (int e = 0; e < 4; ++e) v[e] = rintf(v[e] * (cm[e] > 0.f ? 127.f / cm[e] : 0.f)); }
        scr[kk * 33 + n4] = v[0]; scr[kk * 33 + n4 + 1] = v[1]; scr[kk * 33 + n4 + 2] = v[2]; scr[kk * 33 + n4 + 3] = v[3]; }
    LDS_WAIT(); asm volatile("" ::: "memory");
    const int c = lane & 7;
#pragma unroll
    for (int jj = 0; jj < 4; ++jj) { const int n = (lane >> 3) + 8 * jj; const LAS float* s = scr + (8 * c) * 33 + n;
        if (cmax != nullptr) { const unsigned w0 = ((unsigned)(int)s[0 * 33] & 0xffu) | (((unsigned)(int)s[1 * 33] & 0xffu) << 8) | (((unsigned)(int)s[2 * 33] & 0xffu) << 16) | (((unsigned)(int)s[3 * 33] & 0xffu) << 24);
            const unsigned w1 = ((unsigned)(int)s[4 * 33] & 0xffu) | (((unsigned)(int)s[5 * 33] & 0xffu) << 8) | (((unsigned)(int)s[6 * 33] & 0xffu) << 16) | (((unsigned)(int)s[7 * 33] & 0xffu) << 24);
            u32x2 o8; o8.x = w0; o8.y = w1; *(u32x2*)((unsigned char*)dst + (size_t)n * K + k0 + 8 * c) = o8; }
        else if (f8) { unsigned w0 = 0u, w1 = 0u; w0 = __builtin_amdgcn_cvt_pk_fp8_f32(s[0 * 33], s[1 * 33], w0, false); w0 = __builtin_amdgcn_cvt_pk_fp8_f32(s[2 * 33], s[3 * 33], w0, true);
            w1 = __builtin_amdgcn_cvt_pk_fp8_f32(s[4 * 33], s[5 * 33], w1, false); w1 = __builtin_amdgcn_cvt_pk_fp8_f32(s[6 * 33], s[7 * 33], w1, true);
            u32x2 o8; o8.x = w0; o8.y = w1; *(u32x2*)((unsigned char*)dst + (size_t)n * K + k0 + 8 * c) = o8; }
        else { u32x4 o; o.x = pk2(s[0 * 33], s[1 * 33]); o.y = pk2(s[2 * 33], s[3 * 33]); o.z = pk2(s[4 * 33], s[5 * 33]); o.w = pk2(s[6 * 33], s[7 * 33]);
            *(u32x4*)(dst + (size_t)n * K + (kd >= 0 ? kd : k0) + 8 * c) = o; } }
    LDS_WAIT(); asm volatile("" ::: "memory");
}
__device__ __forceinline__ void xpose_q8_group(const float* W, int ldw, int K, int sc, unsigned char* dst, float* csc, LAS float* scr, int lane, int mode) {
    const int n4 = (lane & 7) * 4, kk0 = lane >> 3;
    const int col = mode == 1 ? (n4 < 16 ? 3584 + n4 : 5648 + (n4 - 16)) : sc + n4;
    f32x4 mx = (f32x4){0.f, 0.f, 0.f, 0.f};
    if (mode != 2) {
#pragma unroll 8
        for (int k = kk0; k < K; k += 8) { const f32x4 v = *(const f32x4*)(W + (size_t)k * ldw + col); mx[0] = fmaxf(mx[0], fabsf(v[0])); mx[1] = fmaxf(mx[1], fabsf(v[1])); mx[2] = fmaxf(mx[2], fabsf(v[2])); mx[3] = fmaxf(mx[3], fabsf(v[3])); }
    }
    f32x4 inv, scl;
#pragma unroll
    for (int e = 0; e < 4; ++e) { float x = mx[e]; x = fmaxf(x, __shfl_xor(x, 8)); x = fmaxf(x, __shfl_xor(x, 16)); x = fmaxf(x, __shfl_xor(x, 32)); scl[e] = x > 0.f ? x * (1.f / 127.f) : 1.f; inv[e] = x > 0.f ? 127.f / x : 0.f; }
    if (kk0 == 0) *(f32x4*)(csc + n4) = scl;
    for (int k0 = 0; k0 < K; k0 += 64) {
#pragma unroll
        for (int i = 0; i < 8; ++i) { const int kk = kk0 + 8 * i; f32x4 v = (f32x4){0.f, 0.f, 0.f, 0.f}; if (mode != 2) v = *(const f32x4*)(W + (size_t)(k0 + kk) * ldw + col);
            scr[kk * 33 + n4] = rintf(v[0] * inv[0]); scr[kk * 33 + n4 + 1] = rintf(v[1] * inv[1]); scr[kk * 33 + n4 + 2] = rintf(v[2] * inv[2]); scr[kk * 33 + n4 + 3] = rintf(v[3] * inv[3]); }
        LDS_WAIT(); asm volatile("" ::: "memory");
        const int c = lane & 7;
#pragma unroll
        for (int jj = 0; jj < 4; ++jj) { const int n = (lane >> 3) + 8 * jj; const LAS float* s = scr + (8 * c) * 33 + n;
            const unsigned w0 = ((unsigned)(int)s[0 * 33] & 0xffu) | (((unsigned)(int)s[1 * 33] & 0xffu) << 8) | (((unsigned)(int)s[2 * 33] & 0xffu) << 16) | (((unsigned)(int)s[3 * 33] & 0xffu) << 24);
            const unsigned w1 = ((unsigned)(int)s[4 * 33] & 0xffu) | (((unsigned)(int)s[5 * 33] & 0xffu) << 8) | (((unsigned)(int)s[6 * 33] & 0xffu) << 16) | (((unsigned)(int)s[7 * 33] & 0xffu) << 24);
            u32x2 o8; o8.x = w0; o8.y = w1; *(u32x2*)(dst + (size_t)n * K + k0 + 8 * c) = o8; }
        LDS_WAIT(); asm volatile("" ::: "memory");
    }
}
__device__ __forceinline__ int hm_col(int grp) { const int T = grp >> 3, q8 = grp & 7; return 256 * T + 32 * (2 * (q8 & 3) + (q8 >> 2)); }

constexpr int CM_ITEMS = DEPTH * 256 * 8, CM_ITEMS_IN = DEPTH * (NT8 * 8) * 8;
constexpr size_t CMX_IN_OFF = (size_t)DEPTH * 8192;
__device__ __forceinline__ void colmax_item(const Args& a, unsigned* cmx, int item, int lane) {
    const int slab = item & 7, grp = (item >> 3) & 255, l = item >> 11;
    const int n4 = (lane & 7) * 4, kk0 = lane >> 3, col = hm_col(grp) + n4;
    const float* W = a.in[41] + (size_t)l * D * DFF + (size_t)(slab * 256) * DFF;
    f32x4 mx = (f32x4){0.f, 0.f, 0.f, 0.f};
#pragma unroll 8
    for (int k = kk0; k < 256; k += 8) { const f32x4 v = *(const f32x4*)(W + (size_t)k * DFF + col); mx[0] = fmaxf(mx[0], fabsf(v[0])); mx[1] = fmaxf(mx[1], fabsf(v[1])); mx[2] = fmaxf(mx[2], fabsf(v[2])); mx[3] = fmaxf(mx[3], fabsf(v[3])); }
#pragma unroll
    for (int e = 0; e < 4; ++e) { float x = mx[e]; x = fmaxf(x, __shfl_xor(x, 8)); x = fmaxf(x, __shfl_xor(x, 16)); x = fmaxf(x, __shfl_xor(x, 32)); mx[e] = x; }
    if (kk0 == 0) {
#pragma unroll
        for (int e = 0; e < 4; ++e) atomicMax(cmx + (size_t)l * DFF + 32 * grp + n4 + e, __float_as_uint(mx[e])); }
}
__device__ __forceinline__ void colmax_in_item(const Args& a, unsigned* cmx, int item, int lane) {
    const int slab = item & 7, r = item >> 3, gi = r % (NT8 * 8), l = r / (NT8 * 8);
    const int n4 = (lane & 7) * 4, kk0 = lane >> 3, col = win_col(tile_of_i8(gi >> 3) * 8 + (gi & 7)) + n4;
    const float* W = a.in[16] + (size_t)l * D * 13856 + (size_t)(slab * 256) * 13856;
    f32x4 mx = (f32x4){0.f, 0.f, 0.f, 0.f};
#pragma unroll 8
    for (int k = kk0; k < 256; k += 8) { const f32x4 v = *(const f32x4*)(W + (size_t)k * 13856 + col); mx[0] = fmaxf(mx[0], fabsf(v[0])); mx[1] = fmaxf(mx[1], fabsf(v[1])); mx[2] = fmaxf(mx[2], fabsf(v[2])); mx[3] = fmaxf(mx[3], fabsf(v[3])); }
#pragma unroll
    for (int e = 0; e < 4; ++e) { float x = mx[e]; x = fmaxf(x, __shfl_xor(x, 8)); x = fmaxf(x, __shfl_xor(x, 16)); x = fmaxf(x, __shfl_xor(x, 32)); mx[e] = x; }
    if (kk0 == 0) {
#pragma unroll
        for (int e = 0; e < 4; ++e) atomicMax(cmx + CMX_IN_OFF + (size_t)l * NT8_ROWS + 32 * gi + n4 + e, __float_as_uint(mx[e])); }
}
constexpr int CV_NQ8 = 0;
constexpr int CV_IN = 440 * 32, CV_GLU = 16 * 8, CV_BR = 4 * 64 * 8, CV_OUT = 64 * 32, CV_1 = 256 * 32, CV_2 = 64 * 128, CV_REST = CV_IN + CV_GLU + CV_BR + CV_OUT + CV_1 + CV_2;
__device__ __forceinline__ void convert_q8(const Args& a, LAS unsigned char* lds, int l, int grp, int wave, int lane) {
    LAS float* scr = (LAS float*)(lds + wave * 8704);
    bf16_t* wl = (bf16_t*)(a.ws + WS_W) + (size_t)l * W_LAYER; float* wsc = (float*)(a.ws + WS_WSC) + (size_t)l * (NIN + DFF);
    const int T = grp >> 3; int sc = hm_col(grp), mode = 0;
    if (T == 54) mode = (grp & 7) == 0 ? 1 : 2; else if (T >= 22) sc += 32; else if (T >= 14) sc += 16;
    xpose_q8_group(a.in[16] + (size_t)l * D * 13856, 13856, D, sc, (unsigned char*)(wl + W_IN) + (size_t)(32 * grp) * D, wsc + 32 * grp, scr, lane, mode);
}
__device__ __forceinline__ void convert_rest(const Args& a, LAS unsigned char* lds, int l, int r0, int r1, int wave, int lane) {
    LAS float* scr = (LAS float*)(lds + wave * 8704);
    bf16_t* wl = (bf16_t*)(a.ws + WS_W) + (size_t)l * W_LAYER;
    for (int it = r0; it < r1; ++it) { int r = it;
        if (r < CV_IN) { const int kb = r / 440, grp = r % 440, T = grp >> 3; const int sc = win_col(grp); const int mode = T == 54 ? ((grp & 7) == 0 ? 1 : 2) : 0;
            if (T >= 22 && T < 54) xpose_item(a.in[16] + (size_t)l * D * 13856, 13856, 64 * kb, sc, (bf16_t*)((unsigned char*)(wl + W_IN8) + (size_t)(32 * (grp - 176)) * D), D, scr, lane, mode, true);
            else xpose_item(a.in[16] + (size_t)l * D * 13856, 13856, 64 * kb, sc, wl + W_IN + (size_t)(32 * (T == 54 ? grp - 256 : grp)) * D, D, scr, lane, mode);
            continue; } r -= CV_IN;
        if (r < CV_GLU) { const int kb = r / 16, grp = r % 16; xpose_item(a.in[28] + (size_t)l * 512 * 512, 512, 64 * kb, hm_col(grp), wl + W_GLU + (size_t)(32 * grp) * 512, 512, scr, lane, 0); continue; } r -= CV_GLU;
        if (r < CV_BR) { const int k = r / 512, r2 = r % 512, kb = r2 / 64, grp = r2 % 64;
            xpose_item(a.in[39] + ((size_t)l * 4 + k) * 512 * D, D, 64 * kb, hm_col(grp), wl + W_BR + (size_t)k * D * 512 + (size_t)(32 * grp) * 512, 512, scr, lane, 0); continue; } r -= CV_BR;
        if (r < CV_OUT) { const int kb = r / 64, grp = r % 64; xpose_item(a.in[40] + (size_t)l * D * D, D, 64 * kb, 32 * grp, wl + W_OUT + (size_t)(32 * grp) * D, D, scr, lane, 0); continue; } r -= CV_OUT;
        if (r < CV_1) { const int kb = r / 256, grp = r % 256;
            xpose_item(a.in[41] + (size_t)l * D * DFF, DFF, 64 * kb, hm_col(grp), (bf16_t*)((unsigned char*)(wl + W_1) + (size_t)(32 * grp) * D), D, scr, lane, 0, false, (const float*)(a.ws + WS_WSC) + (size_t)l * DFF + 32 * grp); continue; } r -= CV_1;
        { const int kb = r / 64, grp = r % 64;
          xpose_item(a.in[42] + (size_t)l * DFF * D, D, 64 * kb, 32 * grp, wl + W_2 + ((size_t)(grp >> 3) * (DFF / 64) + kb) * 16384 + (size_t)((grp & 7) * 32) * 64, 64, scr, lane, 0, false, nullptr, 0); }
    }
}
__device__ __forceinline__ void prologue_ada_unit(const Args& a, LAS unsigned char* lds, int tid, int unit) {
    LAS float* sl = (LAS float*)lds;
    LAS float* red = (LAS float*)(lds + 40960);
    float* mod = (float*)(a.ws + WS_MOD);
    for (int i = tid; i < 5 * D; i += NT) { const int j = i / D, k = i % D; const float x = j == 0 ? a.in[11][k] : a.in[10][(j - 1) * D + k]; sl[i] = x / (1.f + __expf(-x)); }
    __syncthreads();
    const int ks = tid >> 6, c = tid & 63;
    const int l = unit / (6 * D / 64), n0 = (unit % (6 * D / 64)) * 64;
    const float* w = a.in[12] + (size_t)l * D * 6 * D + n0 + c;
    float acc[5] = {0.f, 0.f, 0.f, 0.f, 0.f};
#pragma unroll 8
    for (int k = ks * 256; k < ks * 256 + 256; ++k) { const float wv = w[(size_t)k * 6 * D];
#pragma unroll
        for (int j = 0; j < 5; ++j) acc[j] += sl[j * D + k] * wv; }
#pragma unroll
    for (int j = 0; j < 5; ++j) red[(ks * 5 + j) * 64 + c] = acc[j];
    __syncthreads();
    if (tid < 320) { const int j = tid >> 6; float s = 0.f;
#pragma unroll
        for (int q = 0; q < 8; ++q) s += red[(q * 5 + j) * 64 + c];
        mod[((size_t)l * 5 + j) * 6 * D + n0 + c] = s + a.in[13][l * 6 * D + n0 + c]; }
}
constexpr int PRO_NQ8B = CV_NQ8 / 8, PRO_NCONV = PRO_NQ8B + (CV_REST + 63) / 64,
              PRO_NADA = DEPTH * 6 * D / 64, PRO_NCACHE = 64;
__device__ __forceinline__ void norm_phase(const float* xp, const float* xs, const float* g, const float* modl, int sh_off, int sc_off, bf16_t* H, int gw, int ngw, int lane_,
                                           const float* pend, const float* pmodl, int pg_off, float* xw, const float* xs_pend, unsigned char* F8c = nullptr, unsigned char* Q8 = nullptr, float* rsc = nullptr) {
    int lane = lane_; asm volatile("" : "+v"(lane));
    for (int row = gw; row < M; row += ngw) {
        const float* x = row < MP ? xp + (size_t)row * D : xs + (size_t)(row - MP) * D;
        if (pend != nullptr && row >= 8192) x = xs_pend + (size_t)(row - MP) * D;
        f32x4 v[8]; float ss = 0.f;
#pragma unroll
        for (int j = 0; j < 8; ++j) v[j] = *(const f32x4*)(x + 4 * (lane + 64 * j));
        if (pend != nullptr && row >= 8192) {
            const float* pg = pmodl + (size_t)row_cvec(row) * 6 * D + pg_off; const int pm = row >> 8, r = row & 255;
#pragma unroll
            for (int j = 0; j < 8; ++j) { const int col = 4 * (lane + 64 * j), pn = col >> 8, cc = col & 255;
                const bf16_t* P = (const bf16_t*)pend + (size_t)(((pm - 32) * 8 + pn) * 2) * 65536 + (size_t)r * 256 + cc;
                const u32x2 qa = *(const u32x2*)P, qb = *(const u32x2*)(P + 65536); const f32x4 gg = *(const f32x4*)(pg + col);
                const f32x4 pa = (f32x4){bflo(qa.x), bfhi(qa.x), bflo(qa.y), bfhi(qa.y)}, pb = (f32x4){bflo(qb.x), bfhi(qb.x), bflo(qb.y), bfhi(qb.y)};
                v[j] = v[j] + gg * (pa + pb); *(f32x4*)(xw + (size_t)row * D + col) = v[j]; }
        }
#pragma unroll
        for (int j = 0; j < 8; ++j) ss += (v[j][0] * v[j][0] + v[j][1] * v[j][1]) + (v[j][2] * v[j][2] + v[j][3] * v[j][3]);
        const float r = rsqrtf(wave_sum(ss) * (1.f / D) + 1e-6f);
        const float* md = modl + (size_t)row_cvec(row) * 6 * D;
        float amax = 0.f;
#pragma unroll
        for (int j = 0; j < 8; ++j) { const int i = 4 * (lane + 64 * j);
            const f32x4 gg = *(const f32x4*)(g + i), sc = *(const f32x4*)(md + sc_off + i), sh = *(const f32x4*)(md + sh_off + i);
            const f32x4 o = v[j] * r * gg * (sc + 1.f) + sh; v[j] = o;
            amax = fmaxf(amax, fmaxf(fmaxf(fabsf(o[0]), fabsf(o[1])), fmaxf(fabsf(o[2]), fabsf(o[3])))); }
        if (H != nullptr) {
#pragma unroll
            for (int j = 0; j < 8; ++j) { const int i = 4 * (lane + 64 * j); u32x2 w; w.x = pk2(v[j][0], v[j][1]); w.y = pk2(v[j][2], v[j][3]); *(u32x2*)(H + (size_t)row * D + i) = w;
                if (F8c != nullptr) { unsigned w8 = 0u; w8 = __builtin_amdgcn_cvt_pk_fp8_f32(v[j][0], v[j][1], w8, false); w8 = __builtin_amdgcn_cvt_pk_fp8_f32(v[j][2], v[j][3], w8, true); *(unsigned*)(F8c + (size_t)row * D + i) = w8; } }
        }
        if (Q8 != nullptr) {
#pragma unroll
            for (int o2 = 1; o2 < 64; o2 <<= 1) amax = fmaxf(amax, __shfl_xor(amax, o2));
            const float inv = amax > 0.f ? 127.f / amax : 0.f;
            if (lane == 0) rsc[row] = amax > 0.f ? amax * (1.f / 127.f) : 1.f;
#pragma unroll
            for (int j = 0; j < 8; ++j) { const int i = 4 * (lane + 64 * j);
                const unsigned w = ((unsigned)(int)rintf(v[j][0] * inv) & 0xffu) | (((unsigned)(int)rintf(v[j][1] * inv) & 0xffu) << 8) | (((unsigned)(int)rintf(v[j][2] * inv) & 0xffu) << 16) | (((unsigned)(int)rintf(v[j][3] * inv) & 0xffu) << 24);
                *(unsigned*)(Q8 + (size_t)row * D + i) = w; }
        }
    }
}
__device__ __forceinline__ void final_fix_phase(const float* pend, const float* pmodl, int pg_off, float* X, int gw, int ngw, int lane_) {
    int lane = lane_; asm volatile("" : "+v"(lane));
    for (int row = 8192 + gw; row < M; row += ngw) {
        const float* pg = pmodl + (size_t)row_cvec(row) * 6 * D + pg_off; const int pm = row >> 8, r = row & 255;
#pragma unroll
        for (int j = 0; j < 8; ++j) { const int col = 4 * (lane + 64 * j), pn = col >> 8, cc = col & 255;
            const bf16_t* P = (const bf16_t*)pend + (size_t)(((pm - 32) * 8 + pn) * 2) * 65536 + (size_t)r * 256 + cc;
            const u32x2 qa = *(const u32x2*)P, qb = *(const u32x2*)(P + 65536); const f32x4 gg = *(const f32x4*)(pg + col);
            const f32x4 pa = (f32x4){bflo(qa.x), bfhi(qa.x), bflo(qa.y), bfhi(qa.y)}, pb = (f32x4){bflo(qb.x), bfhi(qb.x), bflo(qb.y), bfhi(qb.y)};
            float* xo = X + (size_t)row * D + col; *(f32x4*)xo = *(const f32x4*)xo + gg * (pa + pb); }
    }
}
constexpr int WQ_BASE = 3584;
#ifndef WQMASK
#define WQMASK 127
#endif
struct WaveQ { unsigned* h; int n, my, s, sh, dyn; };
__device__ __forceinline__ WaveQ waveq_init(const Args& a, int layer, int q, int n, int sh, int off = 0) {
    WaveQ Q; Q.h = (unsigned*)(a.ws + WS_CTL) + WQ_BASE + (layer * 8 + q) * 128; Q.n = n; Q.s = 0; Q.sh = sh; Q.dyn = (WQMASK >> q) & 1;
    if (Q.dyn) Q.my = (int)(xb_xcc_id() & 7u);
    else { const int gw = (int)blockIdx.x * 8 + __builtin_amdgcn_readfirstlane((int)(threadIdx.x >> 6)), ngw = (int)gridDim.x * 8; Q.my = gw - off; }
    return Q;
}
__device__ __forceinline__ int waveq_next(WaveQ& Q, int lane) {
    if (!Q.dyn) { for (;;) { const int it = Q.my + Q.s * (int)gridDim.x * 8; ++Q.s; if (it >= Q.n) return -1; if (it >= 0) return it; } }
    while (Q.s < 8) {
        const int x = (Q.my + Q.s) & 7;
        unsigned v = 0; if (lane == 0) v = __hip_atomic_fetch_add(Q.h + x * 16, 1u, __ATOMIC_RELAXED, __HIP_MEMORY_SCOPE_AGENT);
        v = (unsigned)__builtin_amdgcn_readfirstlane((int)v);
        const int it = (int)(((((v >> Q.sh) << 3) + (unsigned)x) << Q.sh) | (v & ((1u << Q.sh) - 1u)));
        if (it < Q.n) return it;
        ++Q.s;
    }
    return -1;
}
__device__ __forceinline__ void conv_pull(const Args& a, LAS unsigned char* lds, volatile LAS unsigned* qitem, int layer, int maxb, int qoff = 0) {
    unsigned* qhead = (unsigned*)(a.ws + WS_CTL) + 8200 + qoff + layer;
    for (int n = 0; maxb < 0 || n < maxb; ++n) {
        __syncthreads();
        if (threadIdx.x == 0) qitem[0] = __hip_atomic_fetch_add(qhead, 1u, __ATOMIC_RELAXED, __HIP_MEMORY_SCOPE_AGENT);
        __syncthreads();
        const int item = (int)qitem[0];
        if (item >= PRO_NCONV) break;
        const int wave = __builtin_amdgcn_readfirstlane((int)(threadIdx.x >> 6));
        int lane = (int)(threadIdx.x & 63); asm volatile("" : "+v"(lane));
        { const int w0 = (item - PRO_NQ8B) * 64 + wave * 8; convert_rest(a, lds, layer, w0, w0 + 8 < CV_REST ? w0 + 8 : CV_REST, wave, lane); }
    }
    __syncthreads();
}
}
namespace mk {
constexpr size_t WS_NAT = AL(WS_SCR);
constexpr int NATP = 2048, N_XBC = 0, N_Q = 1024, N_K = 1536;
constexpr size_t WS_TR = AL(WS_NAT + (size_t)M * NATP * 2);
constexpr int T_X = 0, T_B = 512, T_K = 768, T_MV = 1280, T_V = 1792, TRR = 2304;
constexpr int NCH = 96;
constexpr size_t WS_MLC = AL(WS_TR + (size_t)TRR * M * 2);
constexpr size_t WS_MLN = AL(WS_MLC + (size_t)NCH * 4 * 2 * 16384 * 4);
constexpr size_t WS_MLS = AL(WS_MLN + (size_t)NCH * 4 * 2 * 128 * 4);
constexpr size_t WS_MLCS = AL(WS_MLS + (size_t)NCH * 4 * 2 * 4 * 4);
constexpr size_t WS_MLNS = AL(WS_MLCS + (size_t)NCH * 4 * 2 * 16384 * 2);
constexpr size_t WS_MLMS = AL(WS_MLNS + (size_t)NCH * 4 * 2 * 128 * 4);
constexpr size_t WS_OPT_END = AL(WS_MLMS + (size_t)NCH * 4 * 2 * 4);

__device__ __forceinline__ f32x4 mfma16(bf16x8 a, bf16x8 b, f32x4 c) { return __builtin_amdgcn_mfma_f32_16x16x32_bf16(a, b, c, 0, 0, 0); }
__device__ __forceinline__ void chunk_info(int ch, int& row0, int& seq0, int& L, int& lat, int& b, int& ci, int& nc) {
    if (ch < 32) { b = ch >> 1; ci = ch & 1; nc = 2; seq0 = b * 256; L = 256; lat = 0; } else { const int c2 = ch - 32; b = c2 >> 4; ci = c2 & 15; nc = 16; seq0 = MP + b * 2048; L = 2048; lat = 1; }
    row0 = seq0 + ci * 128;
}
__device__ __forceinline__ float fast_exp(float x) { return __expf(x); }

__device__ __forceinline__ void prep_phase(const Args& a, int layer, LAS unsigned char* lds, int gw_, int ngw, int wave, int lane_, bf16_t* UPk) {
    int lane = lane_, gw = gw_; asm volatile("" : "+v"(lane));
    const bf16_t* PROJ = (const bf16_t*)(a.ws + WS_PROJ); bf16_t* NAT = (bf16_t*)(a.ws + WS_NAT); bf16_t* TR = (bf16_t*)(a.ws + WS_TR);
    LAS bf16_t* tile = (LAS bf16_t*)(lds + wave * 16896); LAS bf16_t* otile = tile + 68 * 64;
    const int c = lane & 7, r8 = lane >> 3;
    const float* cw = a.in[30] + layer * 5 * 1024; const float* cb = a.in[31] + layer * 1024;
    for (int u = gw; u < 48 * 192; u += ngw) {
        const int cg = u / 192, tt = u % 192, m0 = tt * 64;
        const int lat = m0 >= MP; const int seq0 = lat ? MP + ((m0 - MP) / 2048) * 2048 : (m0 / 256) * 256, L = lat ? 2048 : 256, t0 = m0 - seq0;
        int kind, src, natcol = -1, trrow = -1;
        if (cg < 16) { kind = 0; src = P_XBC + 64 * cg; natcol = N_XBC + 64 * cg; if (cg < 12) trrow = T_X + 64 * cg; }
        else if (cg < 24) { kind = 1; src = P_MQ + 64 * (cg - 16); natcol = N_Q + 64 * (cg - 16); }
        else if (cg < 32) { kind = 2; src = P_MK + 64 * (cg - 24); natcol = N_K + 64 * (cg - 24); trrow = T_K + 64 * (cg - 24); }
        else if (cg < 40) { kind = 3; src = P_MV + 64 * (cg - 32); trrow = T_MV + 64 * (cg - 32); }
        else if (cg < 48) { kind = 3; src = P_V + 64 * (cg - 40); trrow = T_V + 64 * (cg - 40); }
        else { kind = 4; src = P_S5U + 64 * (cg - 48); }
        const int roff = kind == 0 ? -2 : 0, nrows = kind == 0 ? 68 : 64;
#pragma unroll
        for (int i = 0; i < 9; ++i) { const int r = r8 + 8 * i; if (r < nrows) { const int t = t0 + r + roff; u32x4 v = {0u, 0u, 0u, 0u};
                if (t >= 0 && t < L) v = *(const u32x4*)(PROJ + (size_t)(seq0 + t) * PJ + src + 8 * c);
                *(LAS u32x4*)(tile + r * 64 + 8 * c) = v; } }
        LDS_WAIT(); asm volatile("" ::: "memory");
#define PREP_EMIT(i_, r_) do { if (natcol >= 0) *(u32x4*)(NAT + (size_t)(m0 + r8 + 8 * (i_)) * NATP + natcol + 8 * c) = (r_); if (trrow >= 0) *(LAS u32x4*)(otile + (r8 + 8 * (i_)) * 64 + 8 * c) = (r_); } while (0)
        if (kind == 0) {
            float w[5][8], bz[8];
#pragma unroll
            for (int e = 0; e < 8; ++e) { bz[e] = cb[64 * cg + 8 * c + e];
#pragma unroll
                for (int j = 0; j < 5; ++j) w[j][e] = cw[j * 1024 + 64 * cg + 8 * c + e]; }
#pragma unroll 2
            for (int i = 0; i < 8; ++i) { const int tk = r8 + 8 * i; float acc[8];
#pragma unroll
                for (int e = 0; e < 8; ++e) acc[e] = bz[e];
#pragma unroll
                for (int j = 0; j < 5; ++j) { const u32x4 v = *(const LAS u32x4*)(tile + (tk + j) * 64 + 8 * c);
                    acc[0] += bflo(v.x) * w[j][0]; acc[1] += bfhi(v.x) * w[j][1]; acc[2] += bflo(v.y) * w[j][2]; acc[3] += bfhi(v.y) * w[j][3];
                    acc[4] += bflo(v.z) * w[j][4]; acc[5] += bfhi(v.z) * w[j][5]; acc[6] += bflo(v.w) * w[j][6]; acc[7] += bfhi(v.w) * w[j][7]; }
#pragma unroll
                for (int e = 0; e < 8; ++e) acc[e] = fsilu(acc[e]);
                u32x4 rv; rv.x = pk2(acc[0], acc[1]); rv.y = pk2(acc[2], acc[3]); rv.z = pk2(acc[4], acc[5]); rv.w = pk2(acc[6], acc[7]); PREP_EMIT(i, rv); }
        } else if (kind == 4) {
#pragma unroll
            for (int i = 0; i < 8; ++i) { const int tk = r8 + 8 * i, m = m0 + tk; const u32x4 v = *(const LAS u32x4*)(tile + tk * 64 + 8 * c);
                *(u32x4*)(UPk + ((size_t)(4 * (cg - 48) + (c >> 1)) * 384 + (m >> 5)) * 512 + (m & 31) * 16 + 8 * (c & 1)) = v; }
        } else if (kind == 3 || !lat) {
            const float sc = kind == 2 ? 0.08838834764831845f : 1.f;
#pragma unroll
            for (int i = 0; i < 8; ++i) { const u32x4 v = *(const LAS u32x4*)(tile + (r8 + 8 * i) * 64 + 8 * c);
                u32x4 rv = v;
                if (kind == 2) { rv.x = pk2(bflo(v.x) * sc, bfhi(v.x) * sc); rv.y = pk2(bflo(v.y) * sc, bfhi(v.y) * sc); rv.z = pk2(bflo(v.z) * sc, bfhi(v.z) * sc); rv.w = pk2(bflo(v.w) * sc, bfhi(v.w) * sc); }
                PREP_EMIT(i, rv); }
        } else {
            const float sc = kind == 2 ? 0.08838834764831845f : 1.f; const int odd = cg & 1;
            float inv[8];
#pragma unroll
            for (int e = 0; e < 8; ++e) inv[e] = exp2f(-(float)(8 * (c & 3) + e) * (13.287712379549449f / 32.f));
#pragma unroll
            for (int i = 0; i < 8; ++i) { const int tk = r8 + 8 * i, t = t0 + tk; const float pos = odd ? (float)(t & 63) : (float)(t >> 6);
                const u32x4 vo = *(const LAS u32x4*)(tile + tk * 64 + 8 * c), vp = *(const LAS u32x4*)(tile + tk * 64 + 8 * (c ^ 4));
                float o[8], p[8], rr[8];
                o[0] = bflo(vo.x); o[1] = bfhi(vo.x); o[2] = bflo(vo.y); o[3] = bfhi(vo.y); o[4] = bflo(vo.z); o[5] = bfhi(vo.z); o[6] = bflo(vo.w); o[7] = bfhi(vo.w);
                p[0] = bflo(vp.x); p[1] = bfhi(vp.x); p[2] = bflo(vp.y); p[3] = bfhi(vp.y); p[4] = bflo(vp.z); p[5] = bfhi(vp.z); p[6] = bflo(vp.w); p[7] = bfhi(vp.w);
#pragma unroll
                for (int e = 0; e < 8; ++e) { const float ang = pos * inv[e], cs = __cosf(ang), sn = __sinf(ang);
                    rr[e] = (c < 4 ? o[e] * cs - p[e] * sn : p[e] * sn + o[e] * cs) * sc; }
                u32x4 rv; rv.x = pk2(rr[0], rr[1]); rv.y = pk2(rr[2], rr[3]); rv.z = pk2(rr[4], rr[5]); rv.w = pk2(rr[6], rr[7]); PREP_EMIT(i, rv); }
        }
        if (trrow >= 0) {
            LDS_WAIT(); asm volatile("" ::: "memory");
            bf16_t* dst = TR + (size_t)(trrow + lane) * M + m0;
#pragma unroll
            for (int j = 0; j < 8; ++j) { unsigned wv[4];
#pragma unroll
                for (int q = 0; q < 4; ++q) { const unsigned lo = otile[(8 * j + 2 * q) * 64 + lane], hi = otile[(8 * j + 2 * q + 1) * 64 + lane]; wv[q] = lo | (hi << 16); }
                u32x4 o; o.x = wv[0]; o.y = wv[1]; o.z = wv[2]; o.w = wv[3]; *(u32x4*)(dst + 8 * j) = o; }
        }
        LDS_WAIT(); asm volatile("" ::: "memory");
    }
}

struct MlGate { float lf0, lf1, ig0, ig1, P0, P1, tot; };
__device__ __forceinline__ float wave_incl_scan(float v, int lane) {
#pragma unroll
    for (int o = 1; o < 64; o <<= 1) { const float t = __shfl_up(v, o); if (lane >= o) v += t; }
    return v;
}
__device__ __forceinline__ float wave_max(float v) {
#pragma unroll
    for (int o = 1; o < 64; o <<= 1) v = fmaxf(v, __shfl_xor(v, o));
    return v;
}
__device__ __forceinline__ MlGate ml_gates(const Args& a, int layer, int row0, int hh, int dir, int lane) {
    const float* SMALL = (const float*)(a.ws + WS_SMALL);
    const float ib = a.in[36][layer * 8 + dir * 4 + hh], fb = a.in[37][layer * 8 + dir * 4 + hh];
    MlGate g;
    const float f0 = SMALL[(size_t)(row0 + lane) * 32 + S_MF + dir * 4 + hh] + fb, f1 = SMALL[(size_t)(row0 + lane + 64) * 32 + S_MF + dir * 4 + hh] + fb;
    g.ig0 = SMALL[(size_t)(row0 + lane) * 32 + S_MI + dir * 4 + hh] + ib; g.ig1 = SMALL[(size_t)(row0 + lane + 64) * 32 + S_MI + dir * 4 + hh] + ib;
    g.lf0 = fminf(f0, 0.f) - log1pf(__expf(-fabsf(f0))); g.lf1 = fminf(f1, 0.f) - log1pf(__expf(-fabsf(f1)));
    const float s0 = wave_incl_scan(g.lf0, lane); const float tot0 = __shfl(s0, 63);
    const float s1 = wave_incl_scan(g.lf1, lane) + tot0;
    g.P0 = s0; g.P1 = s1; g.tot = __shfl(s1, 63);
    return g;
}

__device__ __forceinline__ void ml_states_phase(const Args& a, int layer, int tid_, int G) {
    int tid = tid_; asm volatile("" : "+v"(tid));
    const int lane = tid & 63, wave = __builtin_amdgcn_readfirstlane(tid >> 6), fr = lane & 15, fq = lane >> 4;
    const bf16_t* TR = (const bf16_t*)(a.ws + WS_TR);
    bf16_t* MLC = (bf16_t*)(a.ws + WS_MLC); float* MLN = (float*)(a.ws + WS_MLN); float* MLS = (float*)(a.ws + WS_MLS);
    WaveQ Q = waveq_init(a, layer, 1, NCH * 4 * 4, 3, 3072);
    for (int it; (it = waveq_next(Q, lane)) >= 0; ) {
        const int u = it >> 2, wp = it & 3;
        const int ch = u >> 2, hh = u & 3; int row0, seq0, L, lat, b, ci, nc; chunk_info(ch, row0, seq0, L, lat, b, ci, nc);
#pragma unroll 1
        for (int dir = 0; dir < 2; ++dir) {
            const MlGate g = ml_gates(a, layer, row0, hh, dir, lane);
            const float w0 = (dir == 0 ? g.tot - g.P0 : g.P0 - g.lf0) + g.ig0, w1 = (dir == 0 ? g.tot - g.P1 : g.P1 - g.lf1) + g.ig1;
            const float mloc = wave_max(fmaxf(w0, w1));
            const float e0 = __expf(w0 - mloc), e1 = __expf(w1 - mloc);
            f32x4 acc[2][8];
#pragma unroll
            for (int q = 0; q < 2; ++q)
#pragma unroll
                for (int j = 0; j < 8; ++j) acc[q][j] = (f32x4){0.f, 0.f, 0.f, 0.f};
            float nacc[8];
#pragma unroll
            for (int j = 0; j < 8; ++j) nacc[j] = 0.f;
            const bf16_t* vrow = TR + (size_t)(T_MV + hh * 128 + wp * 32 + fr) * M + row0 + 8 * fq;
#pragma unroll
            for (int ks = 0; ks < 4; ++ks) {
                const bf16x8 af0 = *(const bf16x8*)(vrow + 32 * ks), af1 = *(const bf16x8*)(vrow + (size_t)16 * M + 32 * ks);
                float ev[8];
#pragma unroll
                for (int j = 0; j < 8; ++j) { const int tok = 32 * ks + 8 * fq + j; const float x0 = __shfl(e0, tok & 63), x1 = __shfl(e1, tok & 63); ev[j] = tok < 64 ? x0 : x1; }
#pragma unroll
                for (int jt = 0; jt < 8; ++jt) {
                    const u32x4 kv = *(const u32x4*)(TR + (size_t)(T_K + hh * 128 + jt * 16 + fr) * M + row0 + 32 * ks + 8 * fq);
                    const float k0 = bflo(kv.x) * ev[0], k1 = bfhi(kv.x) * ev[1], k2 = bflo(kv.y) * ev[2], k3 = bfhi(kv.y) * ev[3], k4 = bflo(kv.z) * ev[4], k5 = bfhi(kv.z) * ev[5], k6 = bflo(kv.w) * ev[6], k7 = bfhi(kv.w) * ev[7];
                    if (wp == 0) nacc[jt] += ((k0 + k1) + (k2 + k3)) + ((k4 + k5) + (k6 + k7));
                    u32x4 kb; kb.x = pk2(k0, k1); kb.y = pk2(k2, k3); kb.z = pk2(k4, k5); kb.w = pk2(k6, k7);
                    const bf16x8 kf = __builtin_bit_cast(bf16x8, kb);
                    acc[0][jt] = mfma16(kf, af0, acc[0][jt]); acc[1][jt] = mfma16(kf, af1, acc[1][jt]);
                }
            }
#pragma unroll
            for (int q = 0; q < 2; ++q) { bf16_t* cdst = MLC + ((size_t)(ch * 4 + hh) * 2 + dir) * 16384 + (size_t)(wp * 32 + 16 * q + fr) * 128 + 4 * fq;
#pragma unroll
                for (int jt = 0; jt < 8; ++jt) { u32x2 w; w.x = pk2(acc[q][jt][0], acc[q][jt][1]); w.y = pk2(acc[q][jt][2], acc[q][jt][3]); *(u32x2*)(cdst + jt * 16) = w; } }
            if (wp == 0) {
#pragma unroll
                for (int jt = 0; jt < 8; ++jt) { float v = nacc[jt]; v += __shfl_xor(v, 16); v += __shfl_xor(v, 32); if (fq == 0) MLN[((size_t)(ch * 4 + hh) * 2 + dir) * 128 + jt * 16 + fr] = v; }
                if (lane == 0) { MLS[((size_t)(ch * 4 + hh) * 2 + dir) * 4 + 0] = mloc; MLS[((size_t)(ch * 4 + hh) * 2 + dir) * 4 + 1] = g.tot; }
            }
        }
    }
}
template <int PER, int NB>
__device__ __forceinline__ void ml_scan_task(const Args& a, int layer, int tid, int lat, int b, int hh, int dir, int part) {
    const unsigned* MLC = (const unsigned*)(a.ws + WS_MLC); const float* MLN = (const float*)(a.ws + WS_MLN); const float* MLS = (const float*)(a.ws + WS_MLS);
    unsigned* CS = (unsigned*)(a.ws + WS_MLCS); float* NS = (float*)(a.ws + WS_MLNS); float* MS = (float*)(a.ws + WS_MLMS);
    const int nc = lat ? 16 : 2, ch0 = lat ? 32 + b * 16 : b * 2, e0 = part * PER * NT;
    float c[PER]; float n = 0.f, m = 0.f;
    const size_t so = (((size_t)b * DEPTH + layer) * 2 + dir) * 4 + hh;
#pragma unroll
    for (int i = 0; i < PER; ++i) { const int e = e0 + 2 * ((i >> 1) * NT + tid) + (i & 1), vd = e >> 7, kd = e & 127; c[i] = lat ? a.in[7][(so * 128 + kd) * 128 + vd] : 0.f; }
    if (tid < 128) n = lat ? a.in[8][so * 128 + tid] : 0.f;
    m = lat ? a.in[9][so] : 0.f;
    for (int s0 = 0; s0 < nc; s0 += NB) {
        unsigned w[NB][PER / 2]; float cn[NB], ml[NB], bl[NB];
#pragma unroll
        for (int q = 0; q < NB; ++q) { const int ci = dir ? nc - 1 - (s0 + q) : s0 + q; const size_t sb = (size_t)((ch0 + ci) * 4 + hh) * 2 + dir;
#pragma unroll
            for (int p = 0; p < PER / 2; ++p) w[q][p] = MLC[(sb * 16384 + e0) / 2 + p * NT + tid];
            cn[q] = tid < 128 ? MLN[sb * 128 + tid] : 0.f; ml[q] = MLS[sb * 4 + 0]; bl[q] = MLS[sb * 4 + 1]; }
#pragma unroll
        for (int q = 0; q < NB; ++q) { const int ci = dir ? nc - 1 - (s0 + q) : s0 + q; const size_t sb = (size_t)((ch0 + ci) * 4 + hh) * 2 + dir;
#pragma unroll
            for (int p = 0; p < PER / 2; ++p) CS[(sb * 16384 + e0) / 2 + p * NT + tid] = pk2(c[2 * p], c[2 * p + 1]);
            if (part == 0) { if (tid < 128) NS[sb * 128 + tid] = n; if (tid == 0) MS[sb] = m; }
            const float mn = fmaxf(bl[q] + m, ml[q]), fa = __expf(bl[q] + m - mn), fb = __expf(ml[q] - mn);
#pragma unroll
            for (int p = 0; p < PER / 2; ++p) { c[2 * p] = fa * c[2 * p] + fb * bflo(w[q][p]); c[2 * p + 1] = fa * c[2 * p + 1] + fb * bfhi(w[q][p]); }
            if (tid < 128) n = fa * n + fb * cn[q];
            m = mn; }
    }
    if (!lat) {
#pragma unroll
        for (int i = 0; i < PER; ++i) { const int e = e0 + 2 * ((i >> 1) * NT + tid) + (i & 1), vd = e >> 7, kd = e & 127; a.out[O_MLC + (so * 128 + kd) * 128 + vd] = c[i]; }
        if (tid < 128) a.out[O_MLN + so * 128 + tid] = n; if (tid == 0) a.out[O_MLM + so] = m; }
}
__device__ __forceinline__ void ml_scan_phase(const Args& a, int layer, int tid_, int G) {
    int tid = tid_; asm volatile("" : "+v"(tid));
    for (int task = blockIdx.x; task < 256; task += G) {
        if (task < 128) ml_scan_task<8, 8>(a, layer, tid, 1, task >> 5, (task >> 3) & 3, (task >> 2) & 1, task & 3);
        else { const int t2 = task - 128; ml_scan_task<32, 2>(a, layer, tid, 0, t2 >> 3, (t2 >> 1) & 3, t2 & 1, 0); }
    }
}
__device__ __forceinline__ void ml_out_phase(const Args& a, int layer, LAS unsigned char* lds, int gw, int ngw, int lane_) {
    int lane = lane_; asm volatile("" : "+v"(lane));
    LAS f32x4* stash = (LAS f32x4*)(lds + (size_t)__builtin_amdgcn_readfirstlane((int)(threadIdx.x >> 6)) * 16384) + lane;
    const int fr = lane & 15, fq = lane >> 4;
    const bf16_t* NAT = (const bf16_t*)(a.ws + WS_NAT); const bf16_t* TR = (const bf16_t*)(a.ws + WS_TR); const bf16_t* PROJ = (const bf16_t*)(a.ws + WS_PROJ);
    const bf16_t* CS = (const bf16_t*)(a.ws + WS_MLCS); const float* NS = (const float*)(a.ws + WS_MLNS); const float* MS = (const float*)(a.ws + WS_MLMS);
    bf16_t* BR = (bf16_t*)(a.ws + WS_BR);
    WaveQ Q = waveq_init(a, layer, 4, NCH * 4 * 4, 3, 0);
    for (int it; (it = waveq_next(Q, lane)) >= 0; ) {
        const int mp = it & 3, hh = (it >> 2) & 3, ch = it >> 4; int row0, seq0, L, lat, b, ci, nc; chunk_info(ch, row0, seq0, L, lat, b, ci, nc);
        const int t0 = mp * 32 + fr;
        int qoff = (row0 + t0) * NATP + N_Q + hh * 128 + 8 * fq;
#define MLQ(q, ks) (*(const bf16x8*)(NAT + qoff + (q) * 16 * NATP + 32 * (ks)))
        f32x4 hsum[2][8];
#pragma unroll
        for (int dir = 0; dir < 2; ++dir) {
            const size_t sb = (size_t)(ch * 4 + hh) * 2 + dir;
            const MlGate g = ml_gates(a, layer, row0, hh, dir, lane); const float ms = MS[sb];
            float u0, u1, c0, c1, ai0, ai1;
            if (dir == 0) { u0 = g.ig0 - g.P0; u1 = g.ig1 - g.P1; c0 = g.P0; c1 = g.P1; ai0 = g.P0 + ms; ai1 = g.P1 + ms; }
            else { const float E0 = g.P0 - g.lf0, E1 = g.P1 - g.lf1; u0 = E0 + g.ig0; u1 = E1 + g.ig1; c0 = -E0; c1 = -E1; ai0 = g.tot - E0 + ms; ai1 = g.tot - E1 + ms; }
            float g0 = u0, g1 = u1;
            if (dir == 0) {
#pragma unroll
                for (int o2 = 1; o2 < 64; o2 <<= 1) { const float x0 = __shfl_up(g0, o2), x1 = __shfl_up(g1, o2); if (lane >= o2) { g0 = fmaxf(g0, x0); g1 = fmaxf(g1, x1); } }
                g1 = fmaxf(g1, __shfl(g0, 63));
            } else {
#pragma unroll
                for (int o2 = 1; o2 < 64; o2 <<= 1) { const float x0 = __shfl_down(g0, o2), x1 = __shfl_down(g1, o2); if (lane + o2 < 64) { g0 = fmaxf(g0, x0); g1 = fmaxf(g1, x1); } }
                g0 = fmaxf(g0, __shfl(g1, 0));
            }
            const float mt0 = fmaxf(ai0, c0 + g0), mt1 = fmaxf(ai1, c1 + g1);
            const float w0 = c0 - mt0, w1 = c1 - mt1, si0 = __expf(ai0 - mt0), si1 = __expf(ai1 - mt1), em0 = __expf(-mt0), em1 = __expf(-mt1);
            const bool th = mp >= 2; float wt[2], sit[2], emt[2];
#pragma unroll
            for (int q = 0; q < 2; ++q) { const int tl = (t0 + 16 * q) & 63; wt[q] = th ? __shfl(w1, tl) : __shfl(w0, tl); sit[q] = th ? __shfl(si1, tl) : __shfl(si0, tl); emt[q] = th ? __shfl(em1, tl) : __shfl(em0, tl); }
            f32x4 acc[2][8];
#pragma unroll
            for (int q = 0; q < 2; ++q)
#pragma unroll
                for (int j = 0; j < 8; ++j) acc[q][j] = (f32x4){0.f, 0.f, 0.f, 0.f};
            float qn[2] = {0.f, 0.f};
            asm volatile("" : "+v"(qoff));
#pragma unroll
            for (int ks = 0; ks < 4; ++ks) { const bf16x8 qk[2] = {MLQ(0, ks), MLQ(1, ks)};
#pragma unroll
                for (int j = 0; j < 8; ++j) { const bf16x8 cf = *(const bf16x8*)(CS + sb * 16384 + (size_t)(16 * j + fr) * 128 + 32 * ks + 8 * fq); acc[0][j] = mfma16(cf, qk[0], acc[0][j]); acc[1][j] = mfma16(cf, qk[1], acc[1][j]); }
                const float* nn = NS + sb * 128 + 32 * ks + 8 * fq; const f32x4 n0 = *(const f32x4*)nn, n1 = *(const f32x4*)(nn + 4);
#pragma unroll
                for (int q = 0; q < 2; ++q) { const u32x4 qv = __builtin_bit_cast(u32x4, qk[q]);
                    qn[q] += bflo(qv.x) * n0[0] + bfhi(qv.x) * n0[1] + bflo(qv.y) * n0[2] + bfhi(qv.y) * n0[3] + bflo(qv.z) * n1[0] + bfhi(qv.z) * n1[1] + bflo(qv.w) * n1[2] + bfhi(qv.w) * n1[3]; } }
            float den[2], psum[2];
#pragma unroll
            for (int q = 0; q < 2; ++q) { qn[q] += __shfl_xor(qn[q], 16); qn[q] += __shfl_xor(qn[q], 32);
#pragma unroll
                for (int j = 0; j < 8; ++j) acc[q][j] *= sit[q];
                den[q] = sit[q] * qn[q]; psum[q] = 0.f; }
            const int jlo = dir == 0 ? 0 : mp, jhi = dir == 0 ? mp : 3;
            for (int jp = jlo; jp <= jhi; ++jp) {
                const int ta = 32 * jp + 8 * (fr >> 2) + (fr & 3);
                f32x4 sa[2], sc[2];
#pragma unroll
                for (int q = 0; q < 2; ++q) { sa[q] = (f32x4){0.f, 0.f, 0.f, 0.f}; sc[q] = (f32x4){0.f, 0.f, 0.f, 0.f}; }
                asm volatile("" : "+v"(qoff));
#pragma unroll
                for (int ks = 0; ks < 4; ++ks) {
                    const bf16x8 ka = *(const bf16x8*)(NAT + (size_t)(row0 + ta) * NATP + N_K + hh * 128 + 32 * ks + 8 * fq);
                    const bf16x8 kb = *(const bf16x8*)(NAT + (size_t)(row0 + ta + 4) * NATP + N_K + hh * 128 + 32 * ks + 8 * fq);
                    const bf16x8 q0 = MLQ(0, ks), q1 = MLQ(1, ks);
                    sa[0] = mfma16(ka, q0, sa[0]); sc[0] = mfma16(kb, q0, sc[0]); sa[1] = mfma16(ka, q1, sa[1]); sc[1] = mfma16(kb, q1, sc[1]);
                    if (ks & 1) __builtin_amdgcn_sched_barrier(0); }
                float us0[4], us1[4];
#pragma unroll
                for (int i = 0; i < 4; ++i) { const int s0 = 32 * jp + 8 * fq + i, s1 = s0 + 4;
                    us0[i] = jp < 2 ? __shfl(u0, s0 & 63) : __shfl(u1, s0 & 63); us1[i] = jp < 2 ? __shfl(u0, s1 & 63) : __shfl(u1, s1 & 63); }
                bf16x8 pf[2];
#pragma unroll
                for (int q = 0; q < 2; ++q) { const int t = t0 + 16 * q; float pa[4], pb[4];
#pragma unroll
                    for (int i = 0; i < 4; ++i) { const int s0 = 32 * jp + 8 * fq + i, s1 = s0 + 4;
                        const bool ok0 = dir == 0 ? s0 <= t : s0 >= t, ok1 = dir == 0 ? s1 <= t : s1 >= t;
                        pa[i] = ok0 ? sa[q][i] * __expf(us0[i] + wt[q]) : 0.f; pb[i] = ok1 ? sc[q][i] * __expf(us1[i] + wt[q]) : 0.f;
                        psum[q] += pa[i] + pb[i]; }
                    u32x4 pw; pw.x = pk2(pa[0], pa[1]); pw.y = pk2(pa[2], pa[3]); pw.z = pk2(pb[0], pb[1]); pw.w = pk2(pb[2], pb[3]);
                    pf[q] = __builtin_bit_cast(bf16x8, pw); }
#pragma unroll
                for (int j = 0; j < 8; ++j) { const bf16x8 vf = *(const bf16x8*)(TR + (size_t)(T_MV + hh * 128 + 16 * j + fr) * M + row0 + 32 * jp + 8 * fq); acc[0][j] = mfma16(vf, pf[0], acc[0][j]); acc[1][j] = mfma16(vf, pf[1], acc[1][j]); }
            }
#pragma unroll
            for (int q = 0; q < 2; ++q) { psum[q] += __shfl_xor(psum[q], 16); psum[q] += __shfl_xor(psum[q], 32);
                den[q] += psum[q];
                const float rden = 1.f / fmaxf(fabsf(den[q]), emt[q]);
#pragma unroll
                for (int j = 0; j < 8; ++j) { if (dir == 0) stash[(q * 8 + j) * 64] = acc[q][j] * rden; else hsum[q][j] = stash[(q * 8 + j) * 64] + acc[q][j] * rden; } }
        }
        const float* ng = a.in[38] + layer * 512 + hh * 128;
#pragma unroll
        for (int q = 0; q < 2; ++q) { const int t = t0 + 16 * q; float ss = 0.f;
#pragma unroll
            for (int j = 0; j < 8; ++j) ss += (hsum[q][j][0] * hsum[q][j][0] + hsum[q][j][1] * hsum[q][j][1]) + (hsum[q][j][2] * hsum[q][j][2] + hsum[q][j][3] * hsum[q][j][3]);
            ss += __shfl_xor(ss, 16); ss += __shfl_xor(ss, 32);
            const float r = rsqrtf(ss * (1.f / 128.f) + 1e-6f);
#pragma unroll
            for (int j = 0; j < 8; ++j) { const int vd = 16 * j + 4 * fq; const f32x4 gg = *(const f32x4*)(ng + vd);
                const u32x2 ov = *(const u32x2*)(PROJ + (size_t)(row0 + t) * PJ + P_MO + hh * 128 + vd);
                const float o0 = hsum[q][j][0] * r * gg[0] * fsigm(bflo(ov.x)), o1 = hsum[q][j][1] * r * gg[1] * fsigm(bfhi(ov.x)), o2 = hsum[q][j][2] * r * gg[2] * fsigm(bflo(ov.y)), o3 = hsum[q][j][3] * r * gg[3] * fsigm(bfhi(ov.y));
                u32x2 w; w.x = pk2(o0, o1); w.y = pk2(o2, o3); *(u32x2*)(BR + (size_t)(row0 + t) * D + 1536 + hh * 128 + vd) = w; } }
    }
}
#undef MLQ
}
namespace mk {
constexpr size_t WS_SST = WS_OPT_END;
constexpr size_t WS_SSL = AL(WS_SST + (size_t)NCH * 8 * 2 * 8192 * 4);
constexpr size_t WS_SSCS = AL(WS_SSL + (size_t)NCH * 8 * 2 * 4);
constexpr size_t WS_YPRE = AL(WS_SSCS + (size_t)NCH * 8 * 2 * 8192 * 2);
constexpr size_t WS_SSQ = AL(WS_YPRE + (size_t)M * 512 * 4);
constexpr size_t WS_SSD_END = AL(WS_SSQ + (size_t)M * 8 * 4);

struct SsdGate { float dt0, dt1, la0, la1, P0, P1, tot; };
__device__ __forceinline__ SsdGate ssd_gates(const Args& a, int layer, int row0, int hh, int dir, int lane) {
    const float* SMALL = (const float*)(a.ws + WS_SMALL);
    const float bias = a.in[32][layer * 16 + dir * 8 + hh], A = -__expf(a.in[33][layer * 16 + dir * 8 + hh]);
    SsdGate g;
    const float x0 = SMALL[(size_t)(row0 + lane) * 32 + S_DT + dir * 8 + hh] + bias, x1 = SMALL[(size_t)(row0 + lane + 64) * 32 + S_DT + dir * 8 + hh] + bias;
    g.dt0 = fmaxf(x0, 0.f) + log1pf(__expf(-fabsf(x0))); g.dt1 = fmaxf(x1, 0.f) + log1pf(__expf(-fabsf(x1)));
    g.la0 = g.dt0 * A; g.la1 = g.dt1 * A;
    const float s0 = wave_incl_scan(g.la0, lane); const float t0 = __shfl(s0, 63);
    const float s1 = wave_incl_scan(g.la1, lane) + t0;
    g.P0 = s0; g.P1 = s1; g.tot = __shfl(s1, 63);
    return g;
}
__device__ __forceinline__ void ssd_states_phase(const Args& a, int layer, int tid_, int G) {
    int tid = tid_; asm volatile("" : "+v"(tid));
    const int lane = tid & 63, wave = __builtin_amdgcn_readfirstlane(tid >> 6), fr = lane & 15, fq = lane >> 4;
    const bf16_t* TR = (const bf16_t*)(a.ws + WS_TR); bf16_t* SST = (bf16_t*)(a.ws + WS_SST); float* SSL = (float*)(a.ws + WS_SSL);
    WaveQ Q = waveq_init(a, layer, 2, NCH * 8 * 4, 3, 3072 + 1536 + 768);
    for (int it; (it = waveq_next(Q, lane)) >= 0; ) {
        const int u = it >> 2, wp = it & 3;
        const int ch = u >> 3, hh = u & 7, grp = hh >> 2; int row0, seq0, L, lat, b, ci, nc; chunk_info(ch, row0, seq0, L, lat, b, ci, nc);
#pragma unroll 1
        for (int dir = 0; dir < 2; ++dir) {
            const SsdGate g = ssd_gates(a, layer, row0, hh, dir, lane);
            const float w0 = g.dt0 * __expf(dir == 0 ? g.tot - g.P0 : g.P0 - g.la0), w1 = g.dt1 * __expf(dir == 0 ? g.tot - g.P1 : g.P1 - g.la1);
            f32x4 acc[2][4];
#pragma unroll
            for (int q = 0; q < 2; ++q)
#pragma unroll
                for (int j = 0; j < 4; ++j) acc[q][j] = (f32x4){0.f, 0.f, 0.f, 0.f};
#pragma unroll
            for (int ks = 0; ks < 4; ++ks) {
                float ev[8];
#pragma unroll
                for (int j = 0; j < 8; ++j) { const int tok = 32 * ks + 8 * fq + j; const float y0 = __shfl(w0, tok & 63), y1 = __shfl(w1, tok & 63); ev[j] = tok < 64 ? y0 : y1; }
                bf16x8 bf[2];
#pragma unroll
                for (int q = 0; q < 2; ++q) { const u32x4 bv = *(const u32x4*)(TR + (size_t)(T_B + grp * 128 + wp * 32 + 16 * q + fr) * M + row0 + 32 * ks + 8 * fq);
                    u32x4 bw; bw.x = pk2(bflo(bv.x) * ev[0], bfhi(bv.x) * ev[1]); bw.y = pk2(bflo(bv.y) * ev[2], bfhi(bv.y) * ev[3]); bw.z = pk2(bflo(bv.z) * ev[4], bfhi(bv.z) * ev[5]); bw.w = pk2(bflo(bv.w) * ev[6], bfhi(bv.w) * ev[7]);
                    bf[q] = __builtin_bit_cast(bf16x8, bw); }
#pragma unroll
                for (int j = 0; j < 4; ++j) { const bf16x8 xf = *(const bf16x8*)(TR + (size_t)(T_X + hh * 64 + 16 * j + fr) * M + row0 + 32 * ks + 8 * fq); acc[0][j] = mfma16(bf[0], xf, acc[0][j]); acc[1][j] = mfma16(bf[1], xf, acc[1][j]); }
            }
#pragma unroll
            for (int q = 0; q < 2; ++q) { bf16_t* dst = SST + ((size_t)(ch * 8 + hh) * 2 + dir) * 8192 + (size_t)fr * 128 + wp * 32 + 16 * q + 4 * fq;
#pragma unroll
                for (int j = 0; j < 4; ++j) { u32x2 w; w.x = pk2(acc[q][j][0], acc[q][j][1]); w.y = pk2(acc[q][j][2], acc[q][j][3]); *(u32x2*)(dst + (size_t)(16 * j) * 128) = w; } }
            if (wp == 0 && lane == 0) SSL[(size_t)(ch * 8 + hh) * 2 + dir] = g.tot;
        }
    }
}
template <int PER, int NB>
__device__ __forceinline__ void ssd_scan_task(const Args& a, int layer, int tid, int lat, int b, int hh, int dir, int part) {
    const unsigned* SST = (const unsigned*)(a.ws + WS_SST); const float* SSL = (const float*)(a.ws + WS_SSL); unsigned* CS = (unsigned*)(a.ws + WS_SSCS);
    const int nc = lat ? 16 : 2, ch0 = lat ? 32 + b * 16 : b * 2, e0 = part * PER * NT;
    float c[PER];
    const size_t so = ((((size_t)b * DEPTH + layer) * 2 + dir) * 8 + hh) * 8192;
#pragma unroll
    for (int i = 0; i < PER; ++i) c[i] = lat ? a.in[6][so + e0 + 2 * ((i >> 1) * NT + tid) + (i & 1)] : 0.f;
    for (int s0 = 0; s0 < nc; s0 += NB) {
        unsigned w[NB][PER / 2]; float nt[NB];
#pragma unroll
        for (int q = 0; q < NB; ++q) { const int ci = dir ? nc - 1 - (s0 + q) : s0 + q; const size_t sb = (size_t)((ch0 + ci) * 8 + hh) * 2 + dir;
#pragma unroll
            for (int p = 0; p < PER / 2; ++p) w[q][p] = SST[(sb * 8192 + e0) / 2 + p * NT + tid];
            nt[q] = SSL[sb]; }
#pragma unroll
        for (int q = 0; q < NB; ++q) { const int ci = dir ? nc - 1 - (s0 + q) : s0 + q; const size_t sb = (size_t)((ch0 + ci) * 8 + hh) * 2 + dir;
            const float dec = __expf(nt[q]);
#pragma unroll
            for (int p = 0; p < PER / 2; ++p) { CS[(sb * 8192 + e0) / 2 + p * NT + tid] = pk2(c[2 * p], c[2 * p + 1]); c[2 * p] = dec * c[2 * p] + bflo(w[q][p]); c[2 * p + 1] = dec * c[2 * p + 1] + bfhi(w[q][p]); } }
    }
    if (!lat) {
#pragma unroll
        for (int i = 0; i < PER; ++i) a.out[O_SSD + so + e0 + 2 * ((i >> 1) * NT + tid) + (i & 1)] = c[i]; }
}
__device__ __forceinline__ void ssd_scan_phase(const Args& a, int layer, int tid_, int G) {
    int tid = tid_; asm volatile("" : "+v"(tid));
    for (int task_ = blockIdx.x; task_ < 384; task_ += G) {
        const int task = task_ < 256 ? (task_ + 128) & 255 : task_;
        if (task < 128) ssd_scan_task<8, 8>(a, layer, tid, 1, task >> 5, (task >> 2) & 7, (task >> 1) & 1, task & 1);
        else { const int t2 = task - 128; ssd_scan_task<16, 2>(a, layer, tid, 0, t2 >> 4, (t2 >> 1) & 7, t2 & 1, 0); }
    }
}
__device__ __forceinline__ void ssd_out_phase(const Args& a, int layer, int gw, int ngw, int lane_) {
    int lane = lane_; asm volatile("" : "+v"(lane));
    const int fr = lane & 15, fq = lane >> 4;
    const bf16_t* NAT = (const bf16_t*)(a.ws + WS_NAT); const bf16_t* TR = (const bf16_t*)(a.ws + WS_TR); const bf16_t* PROJ = (const bf16_t*)(a.ws + WS_PROJ);
    const bf16_t* CS = (const bf16_t*)(a.ws + WS_SSCS); float* YPRE = (float*)(a.ws + WS_YPRE); float* SSQ = (float*)(a.ws + WS_SSQ);
    WaveQ Q = waveq_init(a, layer, 5, NCH * 8 * 4, 3, NCH * 4 * 4 + 32 * 48);
    for (int it; (it = waveq_next(Q, lane)) >= 0; ) {
        const int mp = it & 3, hh = (it >> 2) & 7, ch = it >> 5, grp = hh >> 2; int row0, seq0, L, lat, b, ci, nc; chunk_info(ch, row0, seq0, L, lat, b, ci, nc);
        const int t0 = mp * 32 + fr;
        bf16x8 cf[2][4];
#pragma unroll
        for (int q = 0; q < 2; ++q)
#pragma unroll
            for (int ks = 0; ks < 4; ++ks) cf[q][ks] = *(const bf16x8*)(NAT + (size_t)(row0 + t0 + 16 * q) * NATP + N_XBC + 768 + grp * 128 + 32 * ks + 8 * fq);
        f32x4 ysum[2][4];
#pragma unroll
        for (int q = 0; q < 2; ++q)
#pragma unroll
            for (int j = 0; j < 4; ++j) ysum[q][j] = (f32x4){0.f, 0.f, 0.f, 0.f};
#pragma unroll
        for (int dir = 0; dir < 2; ++dir) {
            const size_t sb = (size_t)(ch * 8 + hh) * 2 + dir;
            const SsdGate g = ssd_gates(a, layer, row0, hh, dir, lane);
            float u0, u1, w0, w1, e0, e1;
            if (dir == 0) { u0 = -g.P0; u1 = -g.P1; w0 = g.P0; w1 = g.P1; e0 = __expf(g.P0); e1 = __expf(g.P1); }
            else { const float E0 = g.P0 - g.la0, E1 = g.P1 - g.la1; u0 = E0; u1 = E1; w0 = -E0; w1 = -E1; e0 = __expf(g.tot - E0); e1 = __expf(g.tot - E1); }
            const bool th = mp >= 2; float wt[2], eot[2];
#pragma unroll
            for (int q = 0; q < 2; ++q) { const int tl = (t0 + 16 * q) & 63; wt[q] = th ? __shfl(w1, tl) : __shfl(w0, tl); eot[q] = th ? __shfl(e1, tl) : __shfl(e0, tl); }
            f32x4 acc[2][4];
#pragma unroll
            for (int q = 0; q < 2; ++q)
#pragma unroll
                for (int j = 0; j < 4; ++j) acc[q][j] = (f32x4){0.f, 0.f, 0.f, 0.f};
#pragma unroll
            for (int ks = 0; ks < 4; ++ks)
#pragma unroll
                for (int j = 0; j < 4; ++j) { const bf16x8 sf = *(const bf16x8*)(CS + sb * 8192 + (size_t)(16 * j + fr) * 128 + 32 * ks + 8 * fq); acc[0][j] = mfma16(sf, cf[0][ks], acc[0][j]); acc[1][j] = mfma16(sf, cf[1][ks], acc[1][j]); }
#pragma unroll
            for (int q = 0; q < 2; ++q)
#pragma unroll
                for (int j = 0; j < 4; ++j) acc[q][j] *= eot[q];
            const int jlo = dir == 0 ? 0 : mp, jhi = dir == 0 ? mp : 3;
            for (int jp = jlo; jp <= jhi; ++jp) {
                const int ta = 32 * jp + 8 * (fr >> 2) + (fr & 3);
                f32x4 sa[2], sc[2];
#pragma unroll
                for (int q = 0; q < 2; ++q) { sa[q] = (f32x4){0.f, 0.f, 0.f, 0.f}; sc[q] = (f32x4){0.f, 0.f, 0.f, 0.f}; }
#pragma unroll
                for (int ks = 0; ks < 4; ++ks) {
                    const bf16x8 ba = *(const bf16x8*)(NAT + (size_t)(row0 + ta) * NATP + N_XBC + 512 + grp * 128 + 32 * ks + 8 * fq);
                    const bf16x8 bb = *(const bf16x8*)(NAT + (size_t)(row0 + ta + 4) * NATP + N_XBC + 512 + grp * 128 + 32 * ks + 8 * fq);
                    sa[0] = mfma16(ba, cf[0][ks], sa[0]); sc[0] = mfma16(bb, cf[0][ks], sc[0]); sa[1] = mfma16(ba, cf[1][ks], sa[1]); sc[1] = mfma16(bb, cf[1][ks], sc[1]); }
                float us0[4], us1[4], d0[4], d1[4];
#pragma unroll
                for (int i = 0; i < 4; ++i) { const int s0 = 32 * jp + 8 * fq + i, s1 = s0 + 4;
                    us0[i] = jp < 2 ? __shfl(u0, s0 & 63) : __shfl(u1, s0 & 63); us1[i] = jp < 2 ? __shfl(u0, s1 & 63) : __shfl(u1, s1 & 63);
                    d0[i] = jp < 2 ? __shfl(g.dt0, s0 & 63) : __shfl(g.dt1, s0 & 63); d1[i] = jp < 2 ? __shfl(g.dt0, s1 & 63) : __shfl(g.dt1, s1 & 63); }
                bf16x8 pf[2];
#pragma unroll
                for (int q = 0; q < 2; ++q) { const int t = t0 + 16 * q; float pa[4], pb[4];
#pragma unroll
                    for (int i = 0; i < 4; ++i) { const int s0 = 32 * jp + 8 * fq + i, s1 = s0 + 4;
                        const bool ok0 = dir == 0 ? s0 <= t : s0 >= t, ok1 = dir == 0 ? s1 <= t : s1 >= t;
                        pa[i] = ok0 ? sa[q][i] * d0[i] * __expf(us0[i] + wt[q]) : 0.f; pb[i] = ok1 ? sc[q][i] * d1[i] * __expf(us1[i] + wt[q]) : 0.f; }
                    u32x4 pw; pw.x = pk2(pa[0], pa[1]); pw.y = pk2(pa[2], pa[3]); pw.z = pk2(pb[0], pb[1]); pw.w = pk2(pb[2], pb[3]);
                    pf[q] = __builtin_bit_cast(bf16x8, pw); }
#pragma unroll
                for (int j = 0; j < 4; ++j) { const bf16x8 xf = *(const bf16x8*)(TR + (size_t)(T_X + hh * 64 + 16 * j + fr) * M + row0 + 32 * jp + 8 * fq); acc[0][j] = mfma16(xf, pf[0], acc[0][j]); acc[1][j] = mfma16(xf, pf[1], acc[1][j]); }
            }
#pragma unroll
            for (int q = 0; q < 2; ++q)
#pragma unroll
                for (int j = 0; j < 4; ++j) ysum[q][j] += acc[q][j];
        }
        const float Dh = a.in[34][layer * 8 + hh];
#pragma unroll
        for (int q = 0; q < 2; ++q) { const int t = t0 + 16 * q; float ss = 0.f;
#pragma unroll
            for (int j = 0; j < 4; ++j) { const int p = 16 * j + 4 * fq;
                const u32x2 xv = *(const u32x2*)(NAT + (size_t)(row0 + t) * NATP + N_XBC + hh * 64 + p), zv = *(const u32x2*)(PROJ + (size_t)(row0 + t) * PJ + P_Z + hh * 64 + p);
                f32x4 y; y[0] = (ysum[q][j][0] + bflo(xv.x) * Dh) * fsilu(bflo(zv.x)); y[1] = (ysum[q][j][1] + bfhi(xv.x) * Dh) * fsilu(bfhi(zv.x));
                y[2] = (ysum[q][j][2] + bflo(xv.y) * Dh) * fsilu(bflo(zv.y)); y[3] = (ysum[q][j][3] + bfhi(xv.y) * Dh) * fsilu(bfhi(zv.y));
                ss += (y[0] * y[0] + y[1] * y[1]) + (y[2] * y[2] + y[3] * y[3]);
                { u32x2 yw; yw.x = pk2(y[0], y[1]); yw.y = pk2(y[2], y[3]); *(u32x2*)((bf16_t*)YPRE + (size_t)(row0 + t) * 512 + hh * 64 + p) = yw; } }
            ss += __shfl_xor(ss, 16); ss += __shfl_xor(ss, 32);
            if (fq == 0) SSQ[(size_t)(row0 + t) * 8 + hh] = ss; }
    }
}
__device__ __forceinline__ void ssd_fin_phase(const Args& a, int layer, int gw, int ngw, int lane_) {
    int lane = lane_; asm volatile("" : "+v"(lane));
    const float* YPRE = (const float*)(a.ws + WS_YPRE); const float* SSQ = (const float*)(a.ws + WS_SSQ); bf16_t* BR = (bf16_t*)(a.ws + WS_BR); const float* ng = a.in[35] + layer * 512;
    for (int row = gw; row < M; row += ngw) {
        float s = lane < 8 ? SSQ[(size_t)row * 8 + lane] : 0.f; s += __shfl_xor(s, 1); s += __shfl_xor(s, 2); s += __shfl_xor(s, 4); s = __shfl(s, 0);
        const float r = rsqrtf(s * (1.f / 512.f) + 1e-6f);
        const u32x4 yq = *(const u32x4*)((const bf16_t*)YPRE + (size_t)row * 512 + 8 * lane);
        const f32x4 y0 = (f32x4){bflo(yq.x), bfhi(yq.x), bflo(yq.y), bfhi(yq.y)}, y1 = (f32x4){bflo(yq.z), bfhi(yq.z), bflo(yq.w), bfhi(yq.w)};
        const f32x4 g0 = *(const f32x4*)(ng + 8 * lane), g1 = *(const f32x4*)(ng + 8 * lane + 4);
        *(u32x4*)(BR + (size_t)row * D + 1024 + 8 * lane) = pack8(y0 * r * g0, y1 * r * g1);
    }
}
}
namespace mk {
constexpr size_t WS_CK = WS_SSD_END;
constexpr size_t WS_CVT = AL(WS_CK + (size_t)16 * 512 * 512 * 2);
constexpr size_t WS_ATT_END = AL(WS_CVT + (size_t)16 * 512 * 512 * 2);

__device__ __forceinline__ void prologue_cache(const Args& a, int gw, int ngw, int lane) {
    bf16_t* CK = (bf16_t*)(a.ws + WS_CK); bf16_t* CVT = (bf16_t*)(a.ws + WS_CVT);
    for (size_t i = ((size_t)gw * 64 + lane) * 8; i < (size_t)16 * 512 * 512; i += (size_t)ngw * 64 * 8) {
        const f32x4 x0 = *(const f32x4*)(a.in[2] + i), x1 = *(const f32x4*)(a.in[2] + i + 4); *(u32x4*)(CK + i) = pack8(x0, x1); }
    for (size_t i = (size_t)gw * 64 + lane; i < (size_t)16 * 64 * 512; i += (size_t)ngw * 64) { const int c = i & 511, s8 = (i >> 9) & 63, bl = i >> 15;
        const float* src = a.in[3] + ((size_t)bl * 512 + 8 * s8) * 512 + c;
        u32x4 o; o.x = pk2(src[0], src[512]); o.y = pk2(src[1024], src[1536]); o.z = pk2(src[2048], src[2560]); o.w = pk2(src[3072], src[3584]);
        *(u32x4*)(CVT + ((size_t)bl * 512 + c) * 512 + 8 * s8) = o; }
}
struct AttState { float m, l; f32x4 o[4]; };
struct AttFrags { bf16x8 k[4]; const bf16_t* vt; size_t vp; };
__device__ __forceinline__ void attn_load(AttFrags& f, const bf16_t* kbase, size_t kp, const bf16_t* vt, size_t vp, int fr, int fq) {
    const int ra = 8 * (fr >> 2) + (fr & 3);
#pragma unroll
    for (int ks = 0; ks < 2; ++ks) { f.k[ks] = *(const bf16x8*)(kbase + (size_t)ra * kp + 32 * ks + 8 * fq); f.k[2 + ks] = *(const bf16x8*)(kbase + (size_t)(ra + 4) * kp + 32 * ks + 8 * fq); }
    f.vt = vt + (size_t)fr * vp + 8 * fq; f.vp = vp;
}
template <bool MASKED>
__device__ __forceinline__ void attn_compute(AttState& st, const bf16x8 (&qf)[2], const AttFrags& f, int fq, const float* bias, int kc0, int cq, int cs) {
    bf16x8 vf[4];
#pragma unroll
    for (int j = 0; j < 4; ++j) vf[j] = *(const bf16x8*)(f.vt + (size_t)(16 * j) * f.vp);
    f32x4 sa = (f32x4){0.f, 0.f, 0.f, 0.f}, sb = (f32x4){0.f, 0.f, 0.f, 0.f};
#pragma unroll
    for (int ks = 0; ks < 2; ++ks) { sa = mfma16(f.k[ks], qf[ks], sa); sb = mfma16(f.k[2 + ks], qf[ks], sb); }
    float s[8]; float gm = -1e30f;
#pragma unroll
    for (int i = 0; i < 4; ++i) { s[i] = sa[i]; s[4 + i] = sb[i]; }
    if (MASKED) {
#pragma unroll
        for (int e = 0; e < 8; ++e) { const int kc = kc0 + 8 * fq + e; const bool ok = kc >= cs && kc < cs + 16; const int bi = min(max(kc - cq + 15, 0), 30); s[e] = ok ? s[e] + bias[bi] * 1.44269504f : -1e30f; }
    }
#pragma unroll
    for (int e = 0; e < 8; ++e) gm = fmaxf(gm, s[e]);
    gm = fmaxf(gm, __shfl_xor(gm, 16)); gm = fmaxf(gm, __shfl_xor(gm, 32));
    const float mn = fmaxf(st.m, gm), al = __builtin_amdgcn_exp2f(st.m - mn); st.m = mn;
    float p[8], ps = 0.f;
#pragma unroll
    for (int e = 0; e < 8; ++e) { p[e] = __builtin_amdgcn_exp2f(s[e] - mn); ps += p[e]; }
    st.l = st.l * al + ps;
    u32x4 pw; pw.x = pk2(p[0], p[1]); pw.y = pk2(p[2], p[3]); pw.z = pk2(p[4], p[5]); pw.w = pk2(p[6], p[7]);
    const bf16x8 pf = __builtin_bit_cast(bf16x8, pw);
#pragma unroll
    for (int j = 0; j < 4; ++j) st.o[j] = mfma16(vf[j], pf, st.o[j] * al);
}
__device__ __forceinline__ void attn_compute2(AttState& s0, AttState& s1, const bf16x8 (&q0)[2], const bf16x8 (&q1)[2], const AttFrags& f, int fq) {
    bf16x8 vf[4];
#pragma unroll
    for (int j = 0; j < 4; ++j) vf[j] = *(const bf16x8*)(f.vt + (size_t)(16 * j) * f.vp);
    f32x4 a0 = (f32x4){0.f, 0.f, 0.f, 0.f}, b0 = a0, a1 = a0, b1 = a0;
#pragma unroll
    for (int ks = 0; ks < 2; ++ks) { a0 = mfma16(f.k[ks], q0[ks], a0); b0 = mfma16(f.k[2 + ks], q0[ks], b0); a1 = mfma16(f.k[ks], q1[ks], a1); b1 = mfma16(f.k[2 + ks], q1[ks], b1); }
    float x0[8], x1[8]; float g0 = -1e30f, g1 = -1e30f;
#pragma unroll
    for (int i = 0; i < 4; ++i) { x0[i] = a0[i]; x0[4 + i] = b0[i]; x1[i] = a1[i]; x1[4 + i] = b1[i]; }
#pragma unroll
    for (int e = 0; e < 8; ++e) { g0 = fmaxf(g0, x0[e]); g1 = fmaxf(g1, x1[e]); }
    g0 = fmaxf(g0, __shfl_xor(g0, 16)); g1 = fmaxf(g1, __shfl_xor(g1, 16)); g0 = fmaxf(g0, __shfl_xor(g0, 32)); g1 = fmaxf(g1, __shfl_xor(g1, 32));
    const float m0 = fmaxf(s0.m, g0), al0 = __builtin_amdgcn_exp2f(s0.m - m0), m1 = fmaxf(s1.m, g1), al1 = __builtin_amdgcn_exp2f(s1.m - m1); s0.m = m0; s1.m = m1;
    float p0 = 0.f, p1 = 0.f;
#pragma unroll
    for (int e = 0; e < 8; ++e) { x0[e] = __builtin_amdgcn_exp2f(x0[e] - m0); p0 += x0[e]; x1[e] = __builtin_amdgcn_exp2f(x1[e] - m1); p1 += x1[e]; }
    s0.l = s0.l * al0 + p0; s1.l = s1.l * al1 + p1;
    u32x4 w0, w1; w0.x = pk2(x0[0], x0[1]); w0.y = pk2(x0[2], x0[3]); w0.z = pk2(x0[4], x0[5]); w0.w = pk2(x0[6], x0[7]); w1.x = pk2(x1[0], x1[1]); w1.y = pk2(x1[2], x1[3]); w1.z = pk2(x1[4], x1[5]); w1.w = pk2(x1[6], x1[7]);
    const bf16x8 f0 = __builtin_bit_cast(bf16x8, w0), f1 = __builtin_bit_cast(bf16x8, w1);
#pragma unroll
    for (int j = 0; j < 4; ++j) { s0.o[j] = mfma16(vf[j], f0, s0.o[j] * al0); s1.o[j] = mfma16(vf[j], f1, s1.o[j] * al1); }
}
__device__ __forceinline__ void attn_store(const AttState& st, bf16_t* BR, int qrow, int hh, int fq) {
    float l = st.l; l += __shfl_xor(l, 16); l += __shfl_xor(l, 32);
    const float rl = 1.f / l;
#pragma unroll
    for (int j = 0; j < 4; ++j) { u32x2 w; w.x = pk2(st.o[j][0] * rl, st.o[j][1] * rl); w.y = pk2(st.o[j][2] * rl, st.o[j][3] * rl);
        *(u32x2*)(BR + (size_t)qrow * D + hh * 64 + 16 * j + 4 * fq) = w; }
}
__device__ __forceinline__ void attn_phase(const Args& a, int layer, int gw_, int ngw, int lane_) {
    int lane = lane_, gw = gw_; asm volatile("" : "+v"(lane));
    const int fr = lane & 15, fq = lane >> 4;
    const bf16_t* PROJ = (const bf16_t*)(a.ws + WS_PROJ); const bf16_t* TR = (const bf16_t*)(a.ws + WS_TR); bf16_t* BR = (bf16_t*)(a.ws + WS_BR);
    const bf16_t* CK = (const bf16_t*)(a.ws + WS_CK); const bf16_t* CVT = (const bf16_t*)(a.ws + WS_CVT);
    WaveQ Q = waveq_init(a, layer, 0, 3072, 3);
    for (int it_; (it_ = waveq_next(Q, lane)) >= 0; ) {
        int it;
        { const int blk = (it_ & 2047) >> 3, w = it_ & 7, x = blk & 7, sl = (blk >> 3) * 8 + w;
          it = it_ < 2048 ? (x + 8 * (sl >> 6)) * 64 + (sl & 63) : 2048 + (x + 8 * (sl >> 3)) * 8 + (sl & 7); }
        AttState s0, s1; s0.m = -1e30f; s0.l = 0.f; s1.m = -1e30f; s1.l = 0.f;
#pragma unroll
        for (int j = 0; j < 4; ++j) { s0.o[j] = (f32x4){0.f, 0.f, 0.f, 0.f}; s1.o[j] = (f32x4){0.f, 0.f, 0.f, 0.f}; }
        AttFrags fa, fb; bf16x8 q0[2], q1[2];
        if (it < 2048) {
            const int jp = it & 1, r = (it >> 1) & 31, hh = (it >> 6) & 7, b = it >> 9;
            const int seq0 = MP + b * 2048, qrow = seq0 + r * 64 + 32 * jp + fr;
#pragma unroll
            for (int ks = 0; ks < 2; ++ks) { q0[ks] = *(const bf16x8*)(PROJ + (size_t)qrow * PJ + P_Q + hh * 64 + 32 * ks + 8 * fq); q1[ks] = *(const bf16x8*)(PROJ + (size_t)(qrow + 16) * PJ + P_Q + hh * 64 + 32 * ks + 8 * fq); }
            const int rs = min(max(r - 4, 0), 24);
            const float* rpb = a.in[19] + ((size_t)layer * 8 + hh) * 15 * 31;
            const size_t cb = ((size_t)b * DEPTH + layer) * 512; const bf16_t* kc = CK + cb * 512 + hh * 64; const bf16_t* vc = CVT + (cb + hh * 64) * 512;
#pragma unroll 1
            for (int qt = 0; qt < 2; ++qt) { const int jq = 2 * jp + qt, cq = 16 * jq + fr, cs = min(max(cq - 8, 0), 48), kc0 = jq == 0 ? 0 : (jq == 1 ? 8 : (jq == 2 ? 24 : 32));
                const bf16_t* kw = PROJ + (size_t)(seq0 + rs * 64 + kc0) * PJ + P_K + hh * 64; const bf16_t* vw = TR + (size_t)(T_V + hh * 64) * M + seq0 + rs * 64 + kc0;
                AttState& st = qt == 0 ? s0 : s1; const bf16x8 (&qf)[2] = qt == 0 ? q0 : q1;
                attn_load(fa, kw, PJ, vw, M, fr, fq);
#pragma unroll 1
                for (int j = 0; j < 8; j += 2) {
                    attn_load(fb, kw + (size_t)(j + 1) * 64 * PJ, PJ, vw + (j + 1) * 64, M, fr, fq);
                    attn_compute<true>(st, qf, fa, fq, rpb + (rs + j - r + 7) * 31, kc0, cq, cs);
                    if (j + 2 < 8) attn_load(fa, kw + (size_t)(j + 2) * 64 * PJ, PJ, vw + (j + 2) * 64, M, fr, fq);
                    attn_compute<true>(st, qf, fb, fq, rpb + (rs + j + 1 - r + 7) * 31, kc0, cq, cs);
                }
            }
            attn_load(fa, kc, 512, vc, 512, fr, fq);
#pragma unroll 1
            for (int g = 0; g < 16; g += 2) {
                attn_load(fb, kc + (size_t)(32 * (g + 1)) * 512, 512, vc + 32 * (g + 1), 512, fr, fq);
                attn_compute2(s0, s1, q0, q1, fa, fq);
                if (g + 2 < 16) attn_load(fa, kc + (size_t)(32 * (g + 2)) * 512, 512, vc + 32 * (g + 2), 512, fr, fq);
                attn_compute2(s0, s1, q0, q1, fb, fq);
            }
            attn_store(s0, BR, qrow, hh, fq); attn_store(s1, BR, qrow + 16, hh, fq);
        } else {
            const int i2 = it - 2048, qp = i2 & 7, hh = (i2 >> 3) & 7, b = i2 >> 6, seq0 = b * 256, qrow = seq0 + 32 * qp + fr;
#pragma unroll
            for (int ks = 0; ks < 2; ++ks) { q0[ks] = *(const bf16x8*)(PROJ + (size_t)qrow * PJ + P_Q + hh * 64 + 32 * ks + 8 * fq); q1[ks] = *(const bf16x8*)(PROJ + (size_t)(qrow + 16) * PJ + P_Q + hh * 64 + 32 * ks + 8 * fq); }
            const bf16_t* kp = PROJ + (size_t)seq0 * PJ + P_K + hh * 64; const bf16_t* vp = TR + (size_t)(T_V + hh * 64) * M + seq0;
            attn_load(fa, kp, PJ, vp, M, fr, fq);
#pragma unroll 1
            for (int g = 0; g < 8; g += 2) {
                attn_load(fb, kp + (size_t)(32 * (g + 1)) * PJ, PJ, vp + 32 * (g + 1), M, fr, fq);
                attn_compute2(s0, s1, q0, q1, fa, fq);
                if (g + 2 < 8) attn_load(fa, kp + (size_t)(32 * (g + 2)) * PJ, PJ, vp + 32 * (g + 2), M, fr, fq);
                attn_compute2(s0, s1, q0, q1, fb, fq);
            }
            attn_store(s0, BR, qrow, hh, fq); attn_store(s1, BR, qrow + 16, hh, fq);
        }
    }
}
}
namespace mk {
constexpr int S5K = 768;
constexpr size_t WS_S5W = WS_ATT_END;
constexpr size_t WS_S5WS = AL(WS_S5W + (size_t)DEPTH * 32 * 512 * S5K * 2);
constexpr size_t WS_S5AP = AL(WS_S5WS + (size_t)DEPTH * 32 * 256 * 512 * 2);
constexpr size_t WS_S5UP = AL(WS_S5AP + (size_t)DEPTH * 32 * 2 * 64 * 2 * 4);
constexpr size_t WS_S5SS = AL(WS_S5UP + (size_t)32 * 384 * 512 * 2);
constexpr size_t WS_S5HS = AL(WS_S5SS + (size_t)32 * 384 * 256 * 4);
constexpr size_t WS_S5_END = AL(WS_S5HS + (size_t)32 * 384 * 256 * 2);

__device__ __forceinline__ void s5_param_task(const Args& a, LAS unsigned char* lds, int tid_, int task) {
    int tid = tid_; asm volatile("" : "+v"(tid));
    LAS float* PW = (LAS float*)lds; LAS float* BB = PW + 2 * 33 * 64 * 2; LAS float* CC = BB + 2 * 64 * 16 * 2; LAS float* KT = CC + 2 * 16 * 64 * 2;
    {
        const int layer = task >> 5, g = task & 31;
        const float* a_re = a.in[20] + layer * 4096; const float* a_im = a.in[21] + layer * 4096; const float* log_dt = a.in[22] + layer * 64;
        const float* b_re = a.in[23] + (size_t)layer * 65536; const float* b_im = a.in[24] + (size_t)layer * 65536; const float* c_re = a.in[25] + (size_t)layer * 65536; const float* c_im = a.in[26] + (size_t)layer * 65536;
        const float* s5d = a.in[27] + layer * 512;
        bf16_t* S5W = (bf16_t*)(a.ws + WS_S5W) + (size_t)layer * 32 * 512 * S5K; bf16_t* S5WS = (bf16_t*)(a.ws + WS_S5WS) + (size_t)layer * 32 * 256 * 512; float* S5AP = (float*)(a.ws + WS_S5AP) + (size_t)layer * 32 * 2 * 64 * 2;
        __syncthreads();
        if (tid < 128) { const int dir = tid >> 6, n = tid & 63, pi = (dir * 32 + g) * 64 + n;
            const float are = fminf(a_re[pi], -1e-4f), aim = a_im[pi], dt = expf(log_dt[dir * 32 + g]);
            const float mag = expf(dt * are), abr = mag * cosf(dt * aim), abi = mag * sinf(dt * aim);
            const float den = are * are + aim * aim, nr = abr - 1.f, cfr = (nr * are + abi * aim) / den, cfi = (abi * are - nr * aim) / den;
            float pr = 1.f, pim = 0.f;
            for (int p = 0; p <= 32; ++p) { PW[((dir * 33 + p) * 64 + n) * 2] = pr; PW[((dir * 33 + p) * 64 + n) * 2 + 1] = pim; const float t = pr * abr - pim * abi; pim = pr * abi + pim * abr; pr = t; }
            S5AP[((g * 2 + dir) * 64 + n) * 2] = PW[((dir * 33 + 32) * 64 + n) * 2]; S5AP[((g * 2 + dir) * 64 + n) * 2 + 1] = PW[((dir * 33 + 32) * 64 + n) * 2 + 1];
            for (int k = 0; k < 16; ++k) { const float br_ = b_re[(size_t)pi * 16 + k], bi_ = b_im[(size_t)pi * 16 + k];
                BB[((dir * 64 + n) * 16 + k) * 2] = cfr * br_ - cfi * bi_; BB[((dir * 64 + n) * 16 + k) * 2 + 1] = cfr * bi_ + cfi * br_; }
            for (int j = 0; j < 16; ++j) { CC[((dir * 64 + n) * 16 + j) * 2] = c_re[((size_t)(dir * 32 + g) * 16 + j) * 64 + n]; CC[((dir * 64 + n) * 16 + j) * 2 + 1] = c_im[((size_t)(dir * 32 + g) * 16 + j) * 64 + n]; }
        }
        __syncthreads();
        { const int lane = tid & 63, wave = tid >> 6, r16 = lane & 15, q4 = lane >> 4;
          for (int pt = wave; pt < 64; pt += NWV) { const int dir = pt >> 5, tau = pt & 31; f32x4 acc = (f32x4){0.f, 0.f, 0.f, 0.f};
#pragma unroll 4
            for (int ks = 0; ks < 16; ++ks) { const int n = 4 * ks + q4;
                const float cr = CC[((dir * 64 + n) * 16 + r16) * 2], ci = CC[((dir * 64 + n) * 16 + r16) * 2 + 1], pr = PW[((dir * 33 + tau) * 64 + n) * 2], pim = PW[((dir * 33 + tau) * 64 + n) * 2 + 1];
                const float xr = cr * pr - ci * pim, xi = cr * pim + ci * pr, br_ = BB[((dir * 64 + n) * 16 + r16) * 2], bi_ = BB[((dir * 64 + n) * 16 + r16) * 2 + 1];
                acc = __builtin_amdgcn_mfma_f32_16x16x4f32(xr, br_, acc, 0, 0, 0); acc = __builtin_amdgcn_mfma_f32_16x16x4f32(-xi, bi_, acc, 0, 0, 0); }
#pragma unroll
            for (int i = 0; i < 4; ++i) KT[((dir * 32 + tau) * 16 + r16) * 16 + 4 * q4 + i] = acc[i]; } }
        __syncthreads();
        { const int t = tid >> 4, j = tid & 15; bf16_t* dst = S5W + ((size_t)g * 512 + tid) * S5K;
            for (int s = 0; s < 32; ++s) { float v[16];
#pragma unroll
                for (int k = 0; k < 16; ++k) { float x;
                    if (s < t) x = KT[((0 * 32 + (t - s)) * 16 + k) * 16 + j]; else if (s > t) x = KT[((1 * 32 + (s - t)) * 16 + k) * 16 + j];
                    else x = KT[((0 * 32 + 0) * 16 + k) * 16 + j] + KT[((1 * 32 + 0) * 16 + k) * 16 + j] + (k == j ? s5d[g * 16 + k] : 0.f);
                    v[k] = x; }
                u32x4 o0, o1; o0.x = pk2(v[0], v[1]); o0.y = pk2(v[2], v[3]); o0.z = pk2(v[4], v[5]); o0.w = pk2(v[6], v[7]); o1.x = pk2(v[8], v[9]); o1.y = pk2(v[10], v[11]); o1.z = pk2(v[12], v[13]); o1.w = pk2(v[14], v[15]);
                *(u32x4*)(dst + s * 16) = o0; *(u32x4*)(dst + s * 16 + 8) = o1; }
            for (int dir = 0; dir < 2; ++dir) { const int p = dir == 0 ? t + 1 : 32 - t;
                for (int n8 = 0; n8 < 8; ++n8) { float gr[8], gi[8];
#pragma unroll
                    for (int q = 0; q < 8; ++q) { const int n = n8 * 8 + q; const float cr = CC[((dir * 64 + n) * 16 + j) * 2], ci = CC[((dir * 64 + n) * 16 + j) * 2 + 1], pr = PW[((dir * 33 + p) * 64 + n) * 2], pim = PW[((dir * 33 + p) * 64 + n) * 2 + 1];
                        gr[q] = cr * pr - ci * pim; gi[q] = -(cr * pim + ci * pr); }
                    u32x4 o; o.x = pk2(gr[0], gr[1]); o.y = pk2(gr[2], gr[3]); o.z = pk2(gr[4], gr[5]); o.w = pk2(gr[6], gr[7]); *(u32x4*)(dst + 512 + dir * 128 + n8 * 8) = o;
                    o.x = pk2(gi[0], gi[1]); o.y = pk2(gi[2], gi[3]); o.z = pk2(gi[4], gi[5]); o.w = pk2(gi[6], gi[7]); *(u32x4*)(dst + 512 + dir * 128 + 64 + n8 * 8) = o; } }
        }
        if (tid < 256) { const int dir = tid >> 7, reim = (tid >> 6) & 1, n = tid & 63; bf16_t* dst = S5WS + ((size_t)g * 256 + tid) * 512;
            for (int s = 0; s < 32; ++s) { const int p = dir == 0 ? 31 - s : s; const float pr = PW[((dir * 33 + p) * 64 + n) * 2], pim = PW[((dir * 33 + p) * 64 + n) * 2 + 1]; float v[16];
#pragma unroll
                for (int k = 0; k < 16; ++k) { const float br_ = BB[((dir * 64 + n) * 16 + k) * 2], bi_ = BB[((dir * 64 + n) * 16 + k) * 2 + 1]; v[k] = reim == 0 ? pr * br_ - pim * bi_ : pr * bi_ + pim * br_; }
                u32x4 o0, o1; o0.x = pk2(v[0], v[1]); o0.y = pk2(v[2], v[3]); o0.z = pk2(v[4], v[5]); o0.w = pk2(v[6], v[7]); o1.x = pk2(v[8], v[9]); o1.y = pk2(v[10], v[11]); o1.z = pk2(v[12], v[13]); o1.w = pk2(v[14], v[15]);
                *(u32x4*)(dst + s * 16) = o0; *(u32x4*)(dst + s * 16 + 8) = o1; } }
    }
    __syncthreads();
}
__device__ __forceinline__ void s5_statein_phase(const Args& a, int layer, int gw, int ngw, int lane_) {
    int lane = lane_; asm volatile("" : "+v"(lane));
    const int fr = lane & 15, fq = lane >> 4;
    const bf16_t* UP = (const bf16_t*)(a.ws + WS_S5UP); const bf16_t* S5WS = (const bf16_t*)(a.ws + WS_S5WS) + (size_t)layer * 32 * 256 * 512; float* SS = (float*)(a.ws + WS_S5SS);
    WaveQ Q = waveq_init(a, layer, 3, 32 * 24, 3, 3072 + 1536);
    for (int it; (it = waveq_next(Q, lane)) >= 0; ) {
        const int c_ = it + 4608, blk = (c_ & 2047) >> 3, sl = ((blk - 64) >> 3) * 8 + (c_ & 7);
        const int g = (blk & 7) + 8 * (sl / 24), r = sl % 24, og = r / 6, cq = r % 6;
        f32x4 acc[4][4];
#pragma unroll
        for (int i = 0; i < 4; ++i)
#pragma unroll
            for (int j = 0; j < 4; ++j) acc[i][j] = (f32x4){0.f, 0.f, 0.f, 0.f};
        const bf16_t* ap = S5WS + ((size_t)g * 256 + 64 * og + fr) * 512 + 8 * fq; const bf16_t* bp = UP + ((size_t)g * 384 + 64 * cq + fr) * 512 + 8 * fq;
#pragma unroll 2
        for (int ks = 0; ks < 16; ++ks) { bf16x8 af[4], bf[4];
#pragma unroll
            for (int i = 0; i < 4; ++i) { af[i] = *(const bf16x8*)(ap + (size_t)16 * i * 512 + 32 * ks); bf[i] = *(const bf16x8*)(bp + (size_t)16 * i * 512 + 32 * ks); }
#pragma unroll
            for (int i = 0; i < 4; ++i)
#pragma unroll
                for (int j = 0; j < 4; ++j) acc[i][j] = mfma16(af[i], bf[j], acc[i][j]); }
#pragma unroll
        for (int i = 0; i < 4; ++i)
#pragma unroll
            for (int j = 0; j < 4; ++j) *(f32x4*)(SS + ((size_t)g * 384 + 64 * cq + 16 * j + fr) * 256 + 64 * og + 16 * i + 4 * fq) = acc[i][j];
    }
}
__device__ __forceinline__ void s5_scan_phase(const Args& a, int layer, int gw, int ngw, int lane_) {
    int lane = lane_; asm volatile("" : "+v"(lane));
    const float* SS = (const float*)(a.ws + WS_S5SS); bf16_t* HS = (bf16_t*)(a.ws + WS_S5HS); const float* S5AP = (const float*)(a.ws + WS_S5AP) + (size_t)layer * 32 * 2 * 64 * 2;
    for (int task = gw; task < 1280; task += ngw) {
        int sq, g, dir; if (task < 256) { sq = 16 + (task >> 6); g = (task >> 1) & 31; dir = task & 1; } else { const int t2 = task - 256; sq = t2 >> 6; g = (t2 >> 1) & 31; dir = t2 & 1; }
        const int lat = sq >= 16, b = lat ? sq - 16 : sq, nc = lat ? 64 : 8, cg0 = lat ? 128 + b * 64 : b * 8;
        const float apr = S5AP[((g * 2 + dir) * 64 + lane) * 2], api = S5AP[((g * 2 + dir) * 64 + lane) * 2 + 1];
        float hr = 0.f, hi = 0.f;
        if (lat) { const size_t so = ((((size_t)b * DEPTH + layer) * 2 + dir) * 32 + g) * 64 + lane; hr = a.in[4][so]; hi = a.in[5][so]; }
        for (int s0 = 0; s0 < nc; s0 += 8) {
            float sr[8], si[8];
#pragma unroll
            for (int q = 0; q < 8; ++q) { const int cg = cg0 + (dir ? nc - 1 - (s0 + q) : s0 + q); const size_t base = ((size_t)g * 384 + cg) * 256 + dir * 128; sr[q] = SS[base + lane]; si[q] = SS[base + 64 + lane]; }
#pragma unroll
            for (int q = 0; q < 8; ++q) { const int cg = cg0 + (dir ? nc - 1 - (s0 + q) : s0 + q); const size_t base = ((size_t)g * 384 + cg) * 256 + dir * 128;
                HS[base + lane] = f2bf(hr); HS[base + 64 + lane] = f2bf(hi);
                const float t = apr * hr - api * hi + sr[q]; hi = apr * hi + api * hr + si[q]; hr = t; }
        }
        if (!lat) { const size_t oo = ((((size_t)b * DEPTH + layer) * 2 + dir) * 32 + g) * 64 + lane; a.out[O_S5R + oo] = hr; a.out[O_S5I + oo] = hi; }
    }
}
__device__ __forceinline__ void s5_out_phase(const Args& a, int layer, int gw, int ngw, int lane_) {
    int lane = lane_; asm volatile("" : "+v"(lane));
    const int fr = lane & 15, fq = lane >> 4;
    const bf16_t* UP = (const bf16_t*)(a.ws + WS_S5UP); const bf16_t* S5W = (const bf16_t*)(a.ws + WS_S5W) + (size_t)layer * 32 * 512 * S5K; const bf16_t* HS = (const bf16_t*)(a.ws + WS_S5HS); bf16_t* ZB = (bf16_t*)(a.ws + WS_ZB);
    WaveQ Q = waveq_init(a, layer, 6, 32 * 48, 3, NCH * 4 * 4);
    for (int it; (it = waveq_next(Q, lane)) >= 0; ) {
        const int c_ = it + 1536, blk = (c_ & 2047) >> 3, sl = blk >= 192 ? ((blk - 192) >> 3) * 8 + (c_ & 7) : 64 + (blk >> 3) * 8 + (c_ & 7);
        const int g = (blk & 7) + 8 * (sl / 48), r = sl % 48, og = r / 6, cq = r % 6;
        f32x4 acc[4][4];
#pragma unroll
        for (int i = 0; i < 4; ++i)
#pragma unroll
            for (int j = 0; j < 4; ++j) acc[i][j] = (f32x4){0.f, 0.f, 0.f, 0.f};
        const bf16_t* ap = S5W + ((size_t)g * 512 + 64 * og + fr) * S5K + 8 * fq;
        const bf16_t* bp = UP + ((size_t)g * 384 + 64 * cq + fr) * 512 + 8 * fq; const bf16_t* hp = HS + ((size_t)g * 384 + 64 * cq + fr) * 256 + 8 * fq;
#pragma unroll 2
        for (int ks = 0; ks < 16; ++ks) { bf16x8 af[4], bf[4];
#pragma unroll
            for (int i = 0; i < 4; ++i) { af[i] = *(const bf16x8*)(ap + (size_t)16 * i * S5K + 32 * ks); bf[i] = *(const bf16x8*)(bp + (size_t)16 * i * 512 + 32 * ks); }
#pragma unroll
            for (int i = 0; i < 4; ++i)
#pragma unroll
                for (int j = 0; j < 4; ++j) acc[i][j] = mfma16(af[i], bf[j], acc[i][j]); }
#pragma unroll 2
        for (int ks = 0; ks < 8; ++ks) { bf16x8 af[4], bf[4];
#pragma unroll
            for (int i = 0; i < 4; ++i) { af[i] = *(const bf16x8*)(ap + (size_t)16 * i * S5K + 512 + 32 * ks); bf[i] = *(const bf16x8*)(hp + (size_t)16 * i * 256 + 32 * ks); }
#pragma unroll
            for (int i = 0; i < 4; ++i)
#pragma unroll
                for (int j = 0; j < 4; ++j) acc[i][j] = mfma16(af[i], bf[j], acc[i][j]); }
#pragma unroll
        for (int i = 0; i < 4; ++i)
#pragma unroll
            for (int j = 0; j < 4; ++j) { float z[4];
#pragma unroll
                for (int e = 0; e < 4; ++e) { const float x = acc[i][j][e]; const float th = 0.7978845608028654f * (x + 0.044715f * x * x * x); const float e2 = __expf(2.f * th); const float tnh = 1.f - 2.f * __builtin_amdgcn_rcpf(e2 + 1.f); z[e] = 0.5f * x * (1.f + tnh); }
                u32x2 w; w.x = pk2(z[0], z[1]); w.y = pk2(z[2], z[3]);
                *(u32x2*)(ZB + (size_t)(32 * (64 * cq + 16 * j + fr) + 4 * og + i) * 512 + g * 16 + 4 * fq) = w; }
    }
}
}
namespace mk { static_assert(WS_S5_END < (size_t)1780 * 1024 * 1024, "workspace map exceeds the guaranteed size"); }
namespace mk {
#ifndef PHMASK
#define PHMASK 0xfffff
#endif
#define PHM(k) ((PHMASK >> (k)) & 1)
#ifndef DUPMASK
#define DUPMASK 0
#endif
#define DUP(k) ((DUPMASK >> (k)) & 1)
constexpr int NPH = 12;
constexpr int PH_TOTAL = 2 + DEPTH * NPH;
__global__ void __launch_bounds__(NT, 2) mk_fwd(Args a) {
    extern __shared__ __attribute__((aligned(16))) unsigned char lds_raw[];
    LAS unsigned char* lds = (LAS unsigned char*)lds_raw;
#define TID ((int)threadIdx.x)
#define LANE ((int)(threadIdx.x & 63))
#define WAVE (__builtin_amdgcn_readfirstlane((int)(threadIdx.x >> 6)))
#define GW ((int)blockIdx.x * NWV + WAVE)
    const int G = gridDim.x, ngw = G * NWV;
    volatile LAS unsigned* ctlw = (volatile LAS unsigned*)(lds + LDS_CTL);
    if (TID < 64) ctlw[TID] = 0u;
    __syncthreads();
    XcdBarrier bar = xcd_barrier_post((unsigned*)(a.ws + WS_CTL), ctlw);
    if (TPROBE >= 0 && TID == 0) { const unsigned long long t_ = wall_clock64(); ctlw[16] = (unsigned)t_; ctlw[17] = (unsigned)(t_ >> 32); }
    const int lo = a.ph_lo; int hi = a.ph_hi;
#define IN(k) (lo <= (k) && (k) < hi)
#ifndef TPROBE
#define TPROBE -1
#endif
#define TSTAMP(kind) do { if (TPROBE >= 0 && blockIdx.x == 0 && TID == 0) { const unsigned long long t_ = wall_clock64(); const unsigned long long p_ = ((unsigned long long)ctlw[17] << 32) | ctlw[16]; \
    volatile LAS float* ta_ = (volatile LAS float*)(ctlw + 24); ta_[kind] = ta_[kind] + (float)(t_ - p_); ctlw[16] = (unsigned)t_; ctlw[17] = (unsigned)(t_ >> 32); } } while (0)
#define SEAM(k) do { if (IN(k) && IN((k) + 1)) { xcd_barrier(bar); if (DUP(13)) xcd_barrier(bar); TSTAMP((k) == 0 ? 0 : 1 + ((k) - 1) % NPH); } } while (0)
#define H ((bf16_t*)(a.ws + WS_H))
#define PROJ ((bf16_t*)(a.ws + WS_PROJ))
#define SMALL ((float*)(a.ws + WS_SMALL))
#define BR ((bf16_t*)(a.ws + WS_BR))
#define MERGED ((bf16_t*)(a.ws + WS_MERGED))
#define MACC ((float*)(a.ws + WS_MACC))
#define ZB ((bf16_t*)(a.ws + WS_ZB))
#define HID ((bf16_t*)(a.ws + WS_PROJ))
#define MOD ((const float*)(a.ws + WS_MOD))
#define X (a.out)
    if (PHM(0) && IN(0)) {
        for (int it = GW; it < CM_ITEMS / DEPTH; it += ngw) colmax_item(a, (unsigned*)(a.ws + WS_WSC), it, LANE);
        xcd_barrier(bar);
        for (int rep_ = 0; rep_ < 1 + DUP(17); ++rep_) {
        unsigned* qhead = (unsigned*)(a.ws + WS_CTL) + 8192 + 64 * rep_;
        volatile LAS unsigned* qitem = ctlw + 8;
        for (;;) {
            __syncthreads();
            if (TID == 0) qitem[0] = __hip_atomic_fetch_add(qhead, 1u, __ATOMIC_RELAXED, __HIP_MEMORY_SCOPE_AGENT);
            __syncthreads();
            int item = (int)qitem[0];
            if (item >= DEPTH * 32 + PRO_NADA + PRO_NCACHE) break;
            if (item < DEPTH * 32) { s5_param_task(a, lds, TID, item); continue; } item -= DEPTH * 32;
            if (item < PRO_NADA) { prologue_ada_unit(a, lds, TID, item); continue; } item -= PRO_NADA;
            prologue_cache(a, item * NWV + WAVE, PRO_NCACHE * NWV, LANE);
        }
        }
        conv_pull(a, lds, ctlw + 8, 0, -1);
        if (DUP(20)) conv_pull(a, lds, ctlw + 8, 0, -1, 16);
    }
    SEAM(0);
#ifndef NREP
#define NREP 1
#endif
#ifndef PPASS
#define PPASS 1000
#endif
    for (int rep_ = 0; rep_ < NREP; ++rep_) {
    if (rep_ > 0) xcd_barrier(bar);
    hi = (NREP == 2 && rep_ == 0 && 1 + PPASS < a.ph_hi) ? 1 + PPASS : a.ph_hi;
    for (int l = 0; l < DEPTH; ++l) {
        const int pb = 1 + l * NPH;
#define xp (l == 0 ? a.in[0] : X)
#define xs (l == 0 ? a.in[1] : X + (size_t)MP * D)
#define modl (MOD + (size_t)l * 5 * 6 * D)
#define wl ((const bf16_t*)(a.ws + WS_W) + (size_t)l * W_LAYER)
        if (PHM(1) && IN(pb + 0) && l > 0) conv_pull(a, lds, ctlw + 8, l, -1);
        if (PHM(1) && IN(pb + 0)) for (int r_ = 0; r_ < 1 + DUP(11); ++r_) norm_phase(xp, xs, a.in[14] + l * D, modl, 0, D, H, GW, ngw, LANE, l > 0 ? MACC : nullptr, modl - (size_t)5 * 6 * D, 5 * D, X, xs, a.ws + WS_H8);
        SEAM(pb + 0);
        if (PHM(2) && IN(pb + 1)) {
            { Gemm g{H, wl + W_IN, M, 5888, D, D, 1, 0, 0}; StaticOrder S; S.init(M, 5888, G, blockIdx.x, 1, D);
              EpiInT<false> E{PROJ, SMALL, a.out, a.in[17] + l * 64, a.in[18] + l * 64, l, (bf16_t*)(a.ws + WS_S5UP)}; for (int r_ = 0; r_ < 1 + DUP(18); ++r_) gemm_phase(lds, g, S, E); }
            if (l + 1 < DEPTH && (int)blockIdx.x >= 80) {
                int ln_ = LANE; asm volatile("" : "+v"(ln_));
                for (int it = ((int)blockIdx.x - 80) * NWV + WAVE; it < CM_ITEMS / DEPTH; it += 176 * NWV) colmax_item(a, (unsigned*)(a.ws + WS_WSC), (l + 1) * (CM_ITEMS / DEPTH) + it, ln_);
                conv_pull(a, lds, ctlw + 8, l + 1, 1); } }
        SEAM(pb + 1);
        if (PHM(3) && IN(pb + 2)) { for (int r_ = 0; r_ < 1 + DUP(0); ++r_) { prep_phase(a, l, lds, GW, ngw, WAVE, LANE, (bf16_t*)(a.ws + WS_S5UP)); __syncthreads(); } }
        SEAM(pb + 2);
        if (PHM(4) && IN(pb + 3)) { for (int r_ = 0; r_ < 1 + DUP(2); ++r_) attn_phase(a, l, GW, ngw, LANE); for (int r_ = 0; r_ < 1 + DUP(3); ++r_) { ml_states_phase(a, l, TID, G); ssd_states_phase(a, l, TID, G); s5_statein_phase(a, l, GW, ngw, LANE); } }
        SEAM(pb + 3);
        if (PHM(5) && IN(pb + 4)) { for (int r_ = 0; r_ < 1 + DUP(4); ++r_) { ml_scan_phase(a, l, TID, G); ssd_scan_phase(a, l, TID, G); s5_scan_phase(a, l, GW, ngw, LANE); } }
        SEAM(pb + 4);
        if (PHM(12) && IN(pb + 5)) { for (int r_ = 0; r_ < 1 + DUP(5); ++r_) ml_out_phase(a, l, lds, GW, ngw, LANE); for (int r_ = 0; r_ < 1 + DUP(6); ++r_) ssd_out_phase(a, l, GW, ngw, LANE); for (int r_ = 0; r_ < 1 + DUP(7); ++r_) s5_out_phase(a, l, GW, ngw, LANE); }
        SEAM(pb + 5);
        if (PHM(6) && IN(pb + 6)) { Gemm g{ZB, wl + W_GLU, M, 512, 512, 512, 1, 0, 0}; StaticOrder S; S.init(M, 512, G, blockIdx.x, 1, 512);
            EpiGlu E{ZB, a.in[29] + l * 512, BR}; for (int r_ = 0; r_ < 1 + DUP(16); ++r_) gemm_phase(lds, g, S, E); for (int r_ = 0; r_ < 1 + DUP(16); ++r_) ssd_fin_phase(a, l, GW, ngw, LANE); }
        if (PHM(6) && IN(pb + 6)) {
            { Gemm g8{(const bf16_t*)(a.ws + WS_H8), wl + W_IN8, M, 8192, 1024, 1024, 1, 0, 0}; StaticOrder S; S.init(M, 8192, G, blockIdx.x, 1, 1024);
              EpiInT<true> E{PROJ, SMALL, a.out, a.in[17] + l * 64, a.in[18] + l * 64, l, (bf16_t*)(a.ws + WS_S5UP)}; for (int r_ = 0; r_ < 1 + DUP(9); ++r_) gemm_phase(lds, g8, S, E); }
        }
        SEAM(pb + 6);
        if (PHM(7) && IN(pb + 7)) { Gemm g{BR, wl + W_BR, M, D, 512, D, 4, 512, (size_t)D * 512}; StaticOrder S; S.init(M, D, G, blockIdx.x, 4, 512);
            EpiBranch E{PROJ, MERGED}; for (int r_ = 0; r_ < 1 + DUP(12); ++r_) gemm_phase(lds, g, S, E);
            if (l + 1 < DEPTH && (int)blockIdx.x >= 128) conv_pull(a, lds, ctlw + 8, l + 1, 4); }
        SEAM(pb + 7);
        if (PHM(8) && IN(pb + 8)) { Gemm g{MERGED, wl + W_OUT, M, D, D, D, 1, 0, 0}; SplitOrder S; S.init(blockIdx.x, D);
            EpiResid E{xp, xs, modl, 2 * D, X, MACC}; if (DUP(14)) { EpiResid E2{xp, xs, modl, 2 * D, (float*)(a.ws + WS_PROJ), MACC}; gemm_phase(lds, g, S, E2); } gemm_phase(lds, g, S, E); }
        SEAM(pb + 8);
        if (PHM(9) && IN(pb + 9)) for (int r_ = 0; r_ < 1 + DUP(19); ++r_) norm_phase(X, X + (size_t)MP * D, a.in[15] + l * D, modl, 3 * D, 4 * D, nullptr, GW, ngw, LANE, MACC, modl, 2 * D, X, xs, nullptr, a.ws + WS_H8, (float*)(a.ws + WS_RSC));
        SEAM(pb + 9);
        if (PHM(10) && IN(pb + 10)) { Gemm g{(const bf16_t*)(a.ws + WS_H8), wl + W_1, M, DFF, 1024, 1024, 1, 0, 0}; StaticOrder S; S.init(M, DFF, G, blockIdx.x, 1, 1024);
            EpiRelu2 E{HID, DFF, (const float*)(a.ws + WS_RSC), (const float*)(a.ws + WS_WSC) + (size_t)l * DFF}; for (int r_ = 0; r_ < 1 + DUP(10); ++r_) gemm_phase(lds, g, S, E); }
        SEAM(pb + 10);
        if (PHM(11) && IN(pb + 11)) { Gemm g{HID, wl + W_2, M, D, DFF, DFF, 1, 0, 0, 1}; SplitOrder S; S.init(blockIdx.x, DFF);
            EpiResid E{X, X + (size_t)MP * D, modl, 5 * D, X, MACC}; if (DUP(15)) { EpiResid E2{X, X + (size_t)MP * D, modl, 5 * D, (float*)(a.ws + WS_BR), MACC}; gemm_phase(lds, g, S, E2); } gemm_phase(lds, g, S, E); }
        SEAM(pb + 11);
    }
    if (IN(1 + DEPTH * NPH)) final_fix_phase(MACC, MOD + (size_t)(DEPTH - 1) * 5 * 6 * D, 5 * D, X, GW, ngw, LANE);
    }
    if (TPROBE >= 0) { xcd_barrier(bar); TSTAMP(13); if (blockIdx.x == 0 && TID == 0) { volatile LAS float* ta_ = (volatile LAS float*)(ctlw + 24); float tot_ = 0.f; for (int q_ = 0; q_ < 14; ++q_) tot_ += ta_[q_]; a.out[0] = (TPROBE == 99 ? tot_ : ta_[TPROBE]) * 10.f; } }
#undef IN
#undef SEAM
#undef H
#undef PROJ
#undef SMALL
#undef BR
#undef MERGED
#undef MACC
#undef ZB
#undef HID
#undef MOD
#undef X
#undef xp
#undef xs
#undef modl
#undef wl
}
}
extern "C" void kernel_launch(void* const* d_in, const int* in_sizes, int n_in, void* d_out, int out_size, void* d_ws, size_t ws_size, hipStream_t stream) {
    static int grid = 0;
    if (grid == 0) {
        int dev = 0, cus = 0; (void)hipGetDevice(&dev); (void)hipDeviceGetAttribute(&cus, hipDeviceAttributeMultiprocessorCount, dev);
        (void)hipFuncSetAttribute((const void*)mk::mk_fwd, hipFuncAttributeMaxDynamicSharedMemorySize, mk::LDS_BYTES);
        int per_cu = 0; (void)hipOccupancyMaxActiveBlocksPerMultiprocessor(&per_cu, (const void*)mk::mk_fwd, mk::NT, mk::LDS_BYTES); (void)hipGetLastError();
        (void)cus; grid = 256;
    }
    mk::Args a{}; for (int i = 0; i < 43; ++i) a.in[i] = (const float*)d_in[i];
    a.out = (float*)d_out; a.ws = (unsigned char*)d_ws; a.ph_lo = 0; a.ph_hi = mk::PH_TOTAL;
    (void)hipMemsetAsync(a.ws + mk::WS_CTL, 0, mk::CTL_BYTES, stream);
    hipLaunchKernelGGL(mk::mk_fwd, dim3(grid), dim3(mk::NT), mk::LDS_BYTES, stream, a);
}
```

```cpp
#define SAFE_GEMM 0
#define DUPMASK 0
#define TPROBE -1
#define NREP 1
#define WQMASK 0
#define PPASS 1000
#include <hip/hip_runtime.h>
#include <math.h>
namespace mk {
#define LAS __attribute__((address_space(3)))
typedef unsigned short bf16_t;
typedef short bf16x8 __attribute__((ext_vector_type(8)));
typedef float f32x4 __attribute__((ext_vector_type(4)));
typedef float f32x2 __attribute__((ext_vector_type(2)));
typedef unsigned u32x4 __attribute__((ext_vector_type(4)));
typedef unsigned u32x2 __attribute__((ext_vector_type(2)));
typedef int v4i32 __attribute__((ext_vector_type(4)));
typedef int v8i32 __attribute__((ext_vector_type(8)));
constexpr int NT = 512, NWV = 8;
constexpr int D = 2048, MP = 4096, MLAT = 8192, M = MP + MLAT, DEPTH = 4, DFF = 8192;
constexpr int PJ = 13824;
constexpr int NIN = 14080;
constexpr int P_Q = 0, P_K = 512, P_V = 1024, P_S5U = 1536, P_Z = 2048, P_XBC = 2560, P_MQ = 3584, P_MK = 4096, P_MV = 4608, P_MO = 5120, P_GATE = 5632;
constexpr int S_DT = 0, S_MI = 16, S_MF = 24;

typedef __bf16 bf16x2_t __attribute__((ext_vector_type(2)));
__device__ __forceinline__ unsigned pk2(float lo, float hi) { f32x2 v = {lo, hi}; bf16x2_t b = __builtin_convertvector(v, bf16x2_t); return __builtin_bit_cast(unsigned, b); }
__device__ __forceinline__ float bf2f(bf16_t v) { return __uint_as_float(((unsigned)v) << 16); }
__device__ __forceinline__ float bflo(unsigned w) { return __uint_as_float(w << 16); }
__device__ __forceinline__ float bfhi(unsigned w) { return __uint_as_float(w & 0xffff0000u); }
__device__ __forceinline__ bf16_t f2bf(float f) { return (bf16_t)(pk2(f, 0.f) & 0xffffu); }
__device__ __forceinline__ float fsigm(float x) { return __builtin_amdgcn_rcpf(1.f + __expf(-x)); }
__device__ __forceinline__ float fsilu(float x) { return x * fsigm(x); }
__device__ __forceinline__ int row_cvec(int row) { return row < MP ? 0 : 1 + (row - MP) / 2048; }

constexpr int NT8 = 41, NTB = 14;
__host__ __device__ __forceinline__ int tile_of_i8(int i) { return i < 32 ? 22 + i : (i < 34 ? i - 32 : (i < 36 ? 8 + (i - 34) : (i == 36 ? 13 : (i < 39 ? 14 + (i - 37) : 20 + (i - 39))))); }
__host__ __device__ __forceinline__ int tile_of_bf(int i) { return i < 6 ? 2 + i : (i < 9 ? 10 + (i - 6) : (i < 11 ? 16 + (i - 9) : (i < 13 ? 18 + (i - 11) : 54))); }
__host__ __device__ __forceinline__ int i8_index_of(int T) { return T >= 22 && T < 54 ? T - 22 : (T < 2 ? 32 + T : (T == 8 || T == 9 ? 34 + (T - 8) : (T == 13 ? 36 : (T == 14 || T == 15 ? 37 + (T - 14) : (T == 20 || T == 21 ? 39 + (T - 20) : -1))))); }
__host__ __device__ __forceinline__ int bf_index_of(int T) { return T >= 2 && T < 8 ? T - 2 : (T >= 10 && T < 13 ? 6 + (T - 10) : (T == 16 || T == 17 ? 9 + (T - 16) : (T == 18 || T == 19 ? 11 + (T - 18) : (T == 54 ? 13 : -1)))); }
__host__ __device__ __forceinline__ int win_col(int grp) { const int T = grp >> 3, q8 = grp & 7; int sc = 256 * T + 32 * (2 * (q8 & 3) + (q8 >> 2)); if (T >= 22) sc += 32; else if (T >= 14) sc += 16; return sc; }

#define XB_TMO      128
#define XB_XCNT(j)  (256  + 64 * (j))
#define XB_XSUB(j)  (1280 + 64 * (j))
#define XB_XGEN(j)  (2304 + 64 * (j))
#define XB_TOP      3328
#define XB_TOPGEN   3392
#define XCD_BAR_WORDS 3456
#define XB_SPIN_CAP (1u << 18)
__device__ __forceinline__ unsigned xb_ld(unsigned* p)              { return __hip_atomic_load(p, __ATOMIC_RELAXED, __HIP_MEMORY_SCOPE_AGENT); }
__device__ __forceinline__ unsigned xb_add(unsigned* p, unsigned v) { return __hip_atomic_fetch_add(p, v, __ATOMIC_RELAXED, __HIP_MEMORY_SCOPE_AGENT); }
#define MK_SWAP(op, a, b) asm volatile("s_nop 1\n\t" op " %0, %1\n\ts_nop 1" : "+v"(a), "+v"(b))
__device__ __forceinline__ float xmax16(float x) { float a = x, b = x; MK_SWAP("v_permlane16_swap_b32", a, b); return fmaxf(a, b); }
__device__ __forceinline__ float xmax32(float x) { float a = x, b = x; MK_SWAP("v_permlane32_swap_b32", a, b); return fmaxf(a, b); }
__device__ __forceinline__ float xsum16(float x) { float a = x, b = x; MK_SWAP("v_permlane16_swap_b32", a, b); return a + b; }
__device__ __forceinline__ float xsum32(float x) { float a = x, b = x; MK_SWAP("v_permlane32_swap_b32", a, b); return a + b; }
__device__ __forceinline__ unsigned xb_xcc_id() { return (unsigned)__builtin_amdgcn_s_getreg((3 << 11) | 20) & 0xFu; }
#define XB_SPIN(cond, bar) do { unsigned _sp = 0; while (cond) { __builtin_amdgcn_s_sleep(1); \
    if ((++_sp & 255u) == 0u) { if (xb_ld(&(bar)[XB_TMO])) break; if (_sp > XB_SPIN_CAP) { atomicAdd(&(bar)[XB_TMO], 1u); break; } } } } while (0)
struct XcdBarrier { unsigned* bar; unsigned x; volatile LAS unsigned* st; };
__device__ __forceinline__ XcdBarrier xcd_barrier_post(unsigned* bar, volatile LAS unsigned* st) {
    XcdBarrier b; b.bar = bar; b.x = xb_xcc_id(); b.st = st;
    if (threadIdx.x == 0) (void)xb_add(&bar[XB_XCNT(b.x)], 1u);
    return b;
}
__device__ __forceinline__ void xcd_barrier_complete(unsigned* bar, unsigned x, unsigned& nloc, unsigned& nx) {
    const unsigned G = gridDim.x * gridDim.y * gridDim.z;
    unsigned sum, cnt, mine, sp = 0u;
    for (;;) {
        sum = 0u; cnt = 0u; mine = 0u;
#pragma unroll
        for (unsigned j = 0; j < 16; ++j) { const unsigned c = xb_ld(&bar[XB_XCNT(j)]); sum += c; cnt += (c > 0u) ? 1u : 0u; mine = (j == x) ? c : mine; }
        if (sum == G) break;
        __builtin_amdgcn_s_sleep(1);
        if ((++sp & 255u) == 0u) { if (xb_ld(&bar[XB_TMO])) break; if (sp > XB_SPIN_CAP) { atomicAdd(&bar[XB_TMO], 1u); break; } }
    }
    nloc = mine > 0u ? mine : 1u; nx = cnt > 0u ? cnt : 1u;
}
__device__ __forceinline__ void xcd_barrier(const XcdBarrier& b) {
    asm volatile("s_waitcnt vmcnt(0)" ::: "memory");
    __syncthreads();
    if (threadIdx.x == 0) {
        unsigned* bar = b.bar;
        __builtin_amdgcn_s_waitcnt(0);
        unsigned nloc = b.st[0], nx = b.st[1];
        if (nloc == 0u) { xcd_barrier_complete(bar, b.x, nloc, nx); b.st[0] = nloc; b.st[1] = nx; }
        const unsigned old = xb_add(&bar[XB_XSUB(b.x)], 1u);
        const unsigned gen = old / nloc;
        if (old + 1u == (gen + 1u) * nloc) {
            __builtin_amdgcn_fence(__ATOMIC_RELEASE, "agent");
            asm volatile("s_waitcnt vmcnt(0)" ::: "memory");
            const unsigned og = xb_add(&bar[XB_TOP], 1u);
            const unsigned tg = og / nx;
            if (og + 1u == (tg + 1u) * nx) xb_add(&bar[XB_TOPGEN], 1u);
            else XB_SPIN(xb_ld(&bar[XB_TOPGEN]) == tg, bar);
            __builtin_amdgcn_fence(__ATOMIC_ACQUIRE, "agent");
            xb_add(&bar[XB_XGEN(b.x)], 1u);
            asm volatile("s_waitcnt vmcnt(0)" ::: "memory");
        } else {
            XB_SPIN(xb_ld(&bar[XB_XGEN(b.x)]) == gen, bar);
            __builtin_amdgcn_fence(__ATOMIC_ACQUIRE, "agent");
            asm volatile("s_waitcnt vmcnt(0)" ::: "memory");
        }
    }
    __syncthreads();
}

#ifndef GEMM_SP2
#define GEMM_SP2 1
#endif
#ifndef GEMM_ALIGN
#define GEMM_ALIGN 1
#endif
constexpr int BM = 256, BK = 64, HALF = 128, HTB = HALF * BK * 2, STAGE_BYTES = 8 * HTB, NXCD = 8, WGM = 8;
__host__ __device__ __forceinline__ int lds_byte(int r, int c) { const int st = (r >> 4) * 2 + (c >> 5), rr = r & 15, cc = c & 31, ob = rr * 64 + cc * 2; return st * 1024 + (ob ^ (((ob >> 9) & 1) << 5)); }
__host__ __device__ __forceinline__ void stage_rc(int b, int& R, int& C) { const int st = b / 1024, sb = b % 1024, swz = sb ^ (((sb >> 9) & 1) << 5); R = (st >> 1) * 16 + swz / 64; C = (st & 1) * 32 + (swz % 64) / 2; }
__host__ __device__ __forceinline__ int perm32(int rho) { const int n = rho >> 4, i = rho & 15; return 8 * (i >> 2) + 4 * n + (i & 3); }

struct Unit { int pm, pn, kz, koff, nt; };
struct Gemm { const bf16_t* A; const bf16_t* Bt; int M, N, K, lda, nkz; size_t a_kz, b_kz; int tm = 0; };

struct StaticOrder {
    int nM, nN, nwg, G, c, nkz;
    int ntk;
    __device__ void init(int M_, int N_, int G_, int c_, int nkz_ = 1, int K_ = 0) { nM = M_ / BM; nN = N_ / BM; nwg = nM * nN; G = G_; c = c_; nkz = nkz_; ntk = K_ / BK; }
    __device__ bool next(int i, Unit& u) const {
        const int it = i / nkz; u.kz = i - it * nkz; u.koff = 0; u.nt = ntk;
        const long L = (long)it * G + c; if (L >= nwg) return false;
        int wgid = (int)L; { const int q = nwg / NXCD, r = nwg % NXCD, xcd = wgid % NXCD, off = wgid / NXCD; wgid = (xcd < r ? xcd * (q + 1) : r * (q + 1) + (xcd - r) * q) + off; }
        const int nig = WGM * nN, gid = wgid / nig, fm = gid * WGM, gsz = (nM - fm) < WGM ? (nM - fm) : WGM;
        u.pm = fm + ((wgid % nig) % gsz); u.pn = (wgid % nig) / gsz; return true;
    }
};

struct SplitOrder {
    int c, ntk;
    __device__ void init(int c_, int K_) { c = c_; ntk = K_ / BK; }
    __device__ bool next(int i, Unit& u) const {
        const int xcd = c & 7, idx = c >> 3;
        if (i == 1) { u.pm = xcd * 4 + (idx >> 3); u.pn = idx & 7; u.kz = 0; u.koff = 0; u.nt = ntk; return true; }
        if (i == 0) { const int t = idx >> 1; u.pm = 32 + xcd * 2 + (t >> 3); u.pn = t & 7; u.kz = 0; u.nt = ntk >> 1; u.koff = (idx & 1) * (ntk >> 1) * BK; return true; }
        return false;
    }
};

template <class Epi, class Sched>
__device__ __forceinline__ void gemm_phase(LAS unsigned char* lds, const Gemm g, const Sched& S, const Epi& E) {
    int tid_ = threadIdx.x; asm volatile("" : "+v"(tid_));
    const int tid = tid_, wid = __builtin_amdgcn_readfirstlane(tid >> 6), lane = tid & 63, wr = wid >> 2, wc = wid & 3, fr = lane & 15, fq = lane >> 4;
    const int K = g.K;
    unsigned voffA[2], voffB[2];
#pragma unroll
    for (int i = 0; i < 2; ++i) { int R, C; stage_rc(tid * 16 + i * 8192, R, C); const int Rb = Epi::PERM ? ((R & ~31) + perm32(R & 31)) : R;
        voffA[i] = (unsigned)(R * (g.tm ? BK : g.lda) + C) * 2u; voffB[i] = (unsigned)(Rb * (g.tm ? BK : K) + C) * 2u; }
    const size_t kstep = g.tm ? (size_t)(BM * BK * 2) : (size_t)(BK * 2); const size_t kmul = g.tm ? (size_t)BM : (size_t)1;
    const size_t hstepA = (size_t)HALF * (g.tm ? BK : g.lda) * 2, hstepB = (size_t)HALF * (g.tm ? BK : K) * 2;
    const size_t tstepA = g.tm ? (size_t)K * BM * 2 : 2 * hstepA, tstepB = (size_t)K * BM * 2;
    const unsigned ldsw = (unsigned)wid * 1024u;
    const int aoff = lds_byte(wr * 64 + fr, fq * 8), boff = lds_byte(wc * 32 + fr, fq * 8);
#define PG8_SA(b, h) (((b) * 2 + (h)) * HTB)
#define PG8_SB(b, h) ((4 + (b) * 2 + (h)) * HTB)
#define PG8_STAGE(bufoff, gbase, voff) do { _Pragma("unroll") for (int _i = 0; _i < 2; ++_i) \
        __builtin_amdgcn_global_load_lds((const unsigned*)((const char*)(gbase) + (voff)[_i]), (LAS unsigned*)(lds + (bufoff) + ldsw + _i * 8192), 16, 0, 0); } while (0)
#define PG8_LDA(dst, b, h) do { if constexpr (Epi::MODE == 1) { _Pragma("unroll") for (int m = 0; m < 4; ++m) dst##8[m] = __builtin_shufflevector(*(const LAS v4i32*)(lds + PG8_SA(b, h) + aoff + m * 2048), *(const LAS v4i32*)(lds + PG8_SA(b, h) + aoff + m * 2048 + 1024), 0, 1, 2, 3, 4, 5, 6, 7); } \
        else { _Pragma("unroll") for (int m = 0; m < 4; ++m) _Pragma("unroll") for (int k = 0; k < 2; ++k) dst[m][k] = *(const LAS bf16x8*)(lds + PG8_SA(b, h) + aoff + m * 2048 + k * 1024); } } while (0)
#define PG8_LDB(dst, b, h) do { if constexpr (Epi::MODE == 1) { _Pragma("unroll") for (int n = 0; n < 2; ++n) dst##8[n] = __builtin_shufflevector(*(const LAS v4i32*)(lds + PG8_SB(b, h) + boff + n * 2048), *(const LAS v4i32*)(lds + PG8_SB(b, h) + boff + n * 2048 + 1024), 0, 1, 2, 3, 4, 5, 6, 7); } \
        else { _Pragma("unroll") for (int n = 0; n < 2; ++n) _Pragma("unroll") for (int k = 0; k < 2; ++k) dst[n][k] = *(const LAS bf16x8*)(lds + PG8_SB(b, h) + boff + n * 2048 + k * 1024); } } while (0)
#define PG8_MMA_BF16(ai, bj, At, Bt) do { __builtin_amdgcn_s_setprio(1); _Pragma("unroll") for (int m = 0; m < 4; ++m) _Pragma("unroll") for (int n = 0; n < 2; ++n) _Pragma("unroll") for (int k = 0; k < 2; ++k) \
        acc[ai][bj][m][n] = __builtin_amdgcn_mfma_f32_16x16x32_bf16(Bt[n][k], At[m][k], acc[ai][bj][m][n], 0, 0, 0); __builtin_amdgcn_s_setprio(0); } while (0)
#define PG8_MMA_FP8(ai, bj, At, Bt) do { __builtin_amdgcn_s_setprio(1); _Pragma("unroll") for (int m = 0; m < 4; ++m) _Pragma("unroll") for (int n = 0; n < 2; ++n) \
        asm volatile("v_mfma_scale_f32_16x16x128_f8f6f4 %0, %1, %2, %0, %3, %3 op_sel_hi:[0,0,0]" : "+v"(acc[ai][bj][m][n]) : "v"(Bt##8[n]), "v"(At##8[m]), "v"(f8scale)); __builtin_amdgcn_s_setprio(0); } while (0)
#define PG8_F8_SETTLE() do { if constexpr (Epi::MODE == 1) asm volatile("s_nop 15\n\ts_nop 15" ::: "memory"); } while (0)
#define PG8_MMA_I8(ai, bj, At, Bt) do { __builtin_amdgcn_s_setprio(1); _Pragma("unroll") for (int m = 0; m < 4; ++m) _Pragma("unroll") for (int n = 0; n < 2; ++n) _Pragma("unroll") for (int k = 0; k < 2; ++k) \
        acc[ai][bj][m][n] = __builtin_bit_cast(f32x4, __builtin_amdgcn_mfma_i32_16x16x64_i8(__builtin_bit_cast(v4i32, Bt[n][k]), __builtin_bit_cast(v4i32, At[m][k]), __builtin_bit_cast(v4i32, acc[ai][bj][m][n]), 0, 0, 0)); __builtin_amdgcn_s_setprio(0); } while (0)
#define PG8_MMA(ai, bj, At, Bt) do { if constexpr (Epi::MODE == 1) PG8_MMA_FP8(ai, bj, At, Bt); else if constexpr (Epi::MODE == 2) PG8_MMA_I8(ai, bj, At, Bt); else PG8_MMA_BF16(ai, bj, At, Bt); } while (0)
#if SAFE_GEMM == 1 || SAFE_GEMM == 3
#define PG8_WAIT_V(n) asm volatile("s_waitcnt vmcnt(0)" ::: "memory")
#else
#define PG8_WAIT_V(n) asm volatile("s_waitcnt vmcnt(" #n ")" ::: "memory")
#endif
#define PG8_WAIT_L(n) asm volatile("s_waitcnt lgkmcnt(" #n ")" ::: "memory")
#if SAFE_GEMM == 1
#define PG8_BAR do { asm volatile("s_waitcnt vmcnt(0) lgkmcnt(0)" ::: "memory"); __builtin_amdgcn_s_barrier(); asm volatile("" ::: "memory"); } while (0)
#elif SAFE_GEMM == 2
#define PG8_BAR asm volatile("s_barrier" ::: "memory")
#elif SAFE_GEMM == 4
#define PG8_BAR do { asm volatile("s_waitcnt lgkmcnt(0)" ::: "memory"); __builtin_amdgcn_s_barrier(); } while (0)
#else
#define PG8_BAR __builtin_amdgcn_s_barrier()
#endif
#define PG8_SCHED __builtin_amdgcn_sched_barrier(0)
    Unit cur, nxt; int ui = 0;
    if (!S.next(0, cur)) return;
    f32x4 acc[2][2][4][2];
#pragma unroll
    for (int a = 0; a < 2; ++a)
#pragma unroll
        for (int b = 0; b < 2; ++b)
#pragma unroll
            for (int m = 0; m < 4; ++m)
#pragma unroll
                for (int n = 0; n < 2; ++n) acc[a][b][m][n] = (f32x4){0.f, 0.f, 0.f, 0.f};
    bf16x8 At[4][2], B0[2][2], B1[2][2]; v8i32 At8[4], B08[2], B18[2];
    int f8scale = 0x7f7f7f7f; asm volatile("" : "+v"(f8scale));
    const char* cA = (const char*)(g.A + (size_t)cur.kz * g.a_kz + (size_t)cur.koff * kmul) + (size_t)cur.pm * tstepA; const char* cB = (const char*)(g.Bt + (size_t)cur.kz * g.b_kz + (size_t)cur.koff * kmul) + (size_t)cur.pn * tstepB;
#if GEMM_SP2
    PG8_STAGE(PG8_SB(0, 0), cB, voffB); PG8_STAGE(PG8_SB(0, 1), cB + hstepB, voffB); PG8_STAGE(PG8_SA(0, 0), cA, voffA); PG8_STAGE(PG8_SA(0, 1), cA + hstepA, voffA);
    if (wr == 1) PG8_BAR;
    PG8_WAIT_V(2); PG8_BAR;
    PG8_STAGE(PG8_SB(1, 0), cB + kstep, voffB); PG8_STAGE(PG8_SA(1, 0), cA + kstep, voffA); PG8_STAGE(PG8_SB(1, 1), cB + hstepB + kstep, voffB);
    PG8_WAIT_V(6); PG8_BAR;
#else
    PG8_STAGE(PG8_SB(0, 0), cB, voffB); PG8_STAGE(PG8_SA(0, 0), cA, voffA); PG8_STAGE(PG8_SB(0, 1), cB + hstepB, voffB); PG8_STAGE(PG8_SA(0, 1), cA + hstepA, voffA);
    if (wr == 1) PG8_BAR;
    PG8_WAIT_V(4); PG8_BAR;
    PG8_STAGE(PG8_SB(1, 0), cB + kstep, voffB); PG8_STAGE(PG8_SA(1, 0), cA + kstep, voffA); PG8_STAGE(PG8_SB(1, 1), cB + hstepB + kstep, voffB);
    PG8_WAIT_V(6); PG8_BAR;
#endif
    for (;;) {
        const bool has_next = S.next(ui + 1, nxt);
        const char* nA = has_next ? (const char*)(g.A + (size_t)nxt.kz * g.a_kz + (size_t)nxt.koff * kmul) + (size_t)nxt.pm * tstepA : cA;
        const char* nB = has_next ? (const char*)(g.Bt + (size_t)nxt.kz * g.b_kz + (size_t)nxt.koff * kmul) + (size_t)nxt.pn * tstepB : cB;
        const int nt = cur.nt;
        for (int t = 0; t < nt; t += 2) {
            const bool last = (t == nt - 2);
            const char* a1 = cA + (size_t)(t + 1) * kstep;
            const char* a2 = last ? nA : cA + (size_t)(t + 2) * kstep; const char* b2 = last ? nB : cB + (size_t)(t + 2) * kstep;
            const char* a3 = a2 + kstep; const char* b3 = b2 + kstep;
#if GEMM_SP2
            PG8_LDB(B0, 0, 0); PG8_LDB(B1, 0, 1); PG8_SCHED; PG8_LDA(At, 0, 0); PG8_STAGE(PG8_SA(1, 1), a1 + hstepA, voffA);
            PG8_WAIT_V(8); PG8_WAIT_L(0); PG8_BAR; PG8_MMA(0, 0, At, B0); PG8_MMA(0, 1, At, B1); PG8_BAR; PG8_SCHED;
            PG8_LDA(At, 0, 1); PG8_STAGE(PG8_SB(0, 0), b2, voffB); PG8_STAGE(PG8_SB(0, 1), b2 + hstepB, voffB); PG8_STAGE(PG8_SA(0, 0), a2, voffA);
            PG8_WAIT_V(8); PG8_WAIT_L(0); PG8_BAR; PG8_MMA(1, 0, At, B0); PG8_MMA(1, 1, At, B1); PG8_BAR; PG8_SCHED;
            PG8_LDB(B0, 1, 0); PG8_LDB(B1, 1, 1); PG8_SCHED; PG8_LDA(At, 1, 0); PG8_STAGE(PG8_SA(0, 1), a2 + hstepA, voffA);
            PG8_WAIT_V(8); PG8_WAIT_L(0); PG8_BAR; PG8_MMA(0, 0, At, B0); PG8_MMA(0, 1, At, B1); PG8_BAR; PG8_SCHED;
            PG8_LDA(At, 1, 1); PG8_STAGE(PG8_SB(1, 0), b3, voffB); PG8_STAGE(PG8_SB(1, 1), b3 + hstepB, voffB); PG8_STAGE(PG8_SA(1, 0), a3, voffA);
            PG8_WAIT_V(8); PG8_WAIT_L(0); PG8_BAR; PG8_MMA(1, 0, At, B0); PG8_MMA(1, 1, At, B1); PG8_BAR; PG8_SCHED;
#else
            PG8_LDB(B0, 0, 0); PG8_SCHED; PG8_LDA(At, 0, 0); PG8_STAGE(PG8_SA(1, 1), a1 + hstepA, voffA);
            PG8_WAIT_L(8); PG8_BAR; PG8_WAIT_L(0); PG8_MMA(0, 0, At, B0); PG8_BAR; PG8_SCHED;
            PG8_LDB(B1, 0, 1); PG8_STAGE(PG8_SB(0, 0), b2, voffB);
            PG8_BAR; PG8_WAIT_L(0); PG8_MMA(0, 1, At, B1); PG8_BAR;
            PG8_LDA(At, 0, 1); PG8_STAGE(PG8_SA(0, 0), a2, voffA);
            PG8_BAR; PG8_WAIT_L(0); PG8_MMA(1, 0, At, B0); PG8_BAR; PG8_SCHED;
            PG8_STAGE(PG8_SB(0, 1), b2 + hstepB, voffB);
            PG8_WAIT_V(6); PG8_BAR; PG8_MMA(1, 1, At, B1); PG8_BAR;
            PG8_LDB(B0, 1, 0); PG8_SCHED; PG8_LDA(At, 1, 0); PG8_STAGE(PG8_SA(0, 1), a2 + hstepA, voffA);
            PG8_WAIT_L(8); PG8_BAR; PG8_WAIT_L(0); PG8_MMA(0, 0, At, B0); PG8_BAR; PG8_SCHED;
            PG8_LDB(B1, 1, 1); PG8_STAGE(PG8_SB(1, 0), b3, voffB);
            PG8_BAR; PG8_WAIT_L(0); PG8_MMA(0, 1, At, B1); PG8_BAR;
            PG8_LDA(At, 1, 1); PG8_STAGE(PG8_SA(1, 0), a3, voffA);
            PG8_BAR; PG8_WAIT_L(0); PG8_MMA(1, 0, At, B0); PG8_BAR; PG8_SCHED;
            PG8_STAGE(PG8_SB(1, 1), b3 + hstepB, voffB);
            PG8_WAIT_V(6); PG8_BAR; PG8_MMA(1, 1, At, B1); PG8_BAR;
#endif
        }
        PG8_F8_SETTLE();
#if GEMM_ALIGN
        if (wr == 0) PG8_BAR;
#endif
        E(acc, cur, wr, wc, fr, fq);
        if (!has_next) break;
        if (nxt.kz == 0) {
#pragma unroll
        for (int a = 0; a < 2; ++a)
#pragma unroll
            for (int b = 0; b < 2; ++b)
#pragma unroll
                for (int m = 0; m < 4; ++m)
#pragma unroll
                    for (int n = 0; n < 2; ++n) acc[a][b][m][n] = (f32x4){0.f, 0.f, 0.f, 0.f};
        }
        cur = nxt; cA = nA; cB = nB; ++ui;
#if GEMM_ALIGN
        if (wr == 1) PG8_BAR;
#endif
    }
    PG8_WAIT_V(0);
#if !GEMM_ALIGN
    if (wr == 0) PG8_BAR;
#endif
    PG8_BAR;
#undef PG8_SA
#undef PG8_SB
#undef PG8_STAGE
#undef PG8_LDA
#undef PG8_LDB
#undef PG8_MMA
#undef PG8_MMA_BF16
#undef PG8_MMA_FP8
#undef PG8_MMA_I8
#undef PG8_F8_SETTLE
#undef PG8_WAIT_V
#undef PG8_WAIT_L
#undef PG8_BAR
#undef PG8_SCHED
}
}
namespace mk {
constexpr size_t O_YP = 0, O_YS = 8388608, O_NK = 25165824, O_NV = 33554432, O_S5R = 41943040, O_S5I = 42205184, O_SSD = 42467328,
                 O_MLC = 50855936, O_MLN = 59244544, O_MLM = 59310080;

__device__ __forceinline__ u32x4 pack8(const f32x4 a, const f32x4 b) { u32x4 w; w.x = pk2(a[0], a[1]); w.y = pk2(a[2], a[3]); w.z = pk2(b[0], b[1]); w.w = pk2(b[2], b[3]); return w; }

template <bool F8> struct EpiInT {
    static constexpr bool PERM = true; static constexpr int MODE = F8 ? 1 : 0;
    bf16_t* proj; float* small; float* out; const float* qg; const float* kg; int layer; bf16_t* up;
    __device__ __forceinline__ void operator()(f32x4 (&acc)[2][2][4][2], const Unit& u, int wr, int wc, int fr, int fq) const {
        const int T = F8 ? 22 + u.pn : (u.pn == 22 ? 54 : u.pn), rowb = u.pm * BM + wr * 64 + fr;
        if (T == 54) {
            if (wc == 0) {
#pragma unroll
                for (int ai = 0; ai < 2; ++ai)
#pragma unroll
                    for (int m = 0; m < 4; ++m) { float* sp = small + (size_t)(rowb + ai * HALF + m * 16) * 32 + 8 * fq; *(f32x4*)sp = acc[ai][0][m][0]; *(f32x4*)(sp + 4) = acc[ai][0][m][1]; }
            }
            return;
        }
        const int colb = T * 256 + 64 * wc + 8 * fq;
        if (T < 4) {
            const float* g = T < 2 ? qg : kg;
            f32x4 gv[2][2];
#pragma unroll
            for (int bj = 0; bj < 2; ++bj)
#pragma unroll
                for (int n = 0; n < 2; ++n) gv[bj][n] = *(const f32x4*)(g + 32 * bj + 8 * fq + 4 * n);
#pragma unroll
            for (int ai = 0; ai < 2; ++ai)
#pragma unroll
                for (int m = 0; m < 4; ++m) {
                    float ss = 0.f;
#pragma unroll
                    for (int bj = 0; bj < 2; ++bj)
#pragma unroll
                        for (int n = 0; n < 2; ++n) { const f32x4 x = acc[ai][bj][m][n]; ss += (x[0] * x[0] + x[1] * x[1]) + (x[2] * x[2] + x[3] * x[3]); }
                    ss += __shfl_xor(ss, 16); ss += __shfl_xor(ss, 32);
                    const float r = rsqrtf(ss * (1.f / 64.f) + 1e-6f) * (T < 2 ? 0.18033688f : 1.f);
                    const int row = rowb + ai * HALF + m * 16;
#pragma unroll
                    for (int bj = 0; bj < 2; ++bj) { const f32x4 v0 = acc[ai][bj][m][0] * r * gv[bj][0], v1 = acc[ai][bj][m][1] * r * gv[bj][1];
                        *(u32x4*)(proj + (size_t)row * PJ + colb + 32 * bj) = pack8(v0, v1);
                        if (T >= 2 && row < MP) { float* o = out + O_NK + ((size_t)((row >> 8) * DEPTH + layer) * 256 + (row & 255)) * 512 + (colb - 512) + 32 * bj; *(f32x4*)o = v0; *(f32x4*)(o + 4) = v1; } }
                }
        } else if (T < 6) {
#pragma unroll
            for (int ai = 0; ai < 2; ++ai)
#pragma unroll
                for (int m = 0; m < 4; ++m) { const int row = rowb + ai * HALF + m * 16;
#pragma unroll
                    for (int bj = 0; bj < 2; ++bj) { const f32x4 v0 = acc[ai][bj][m][0], v1 = acc[ai][bj][m][1];
                        *(u32x4*)(proj + (size_t)row * PJ + colb + 32 * bj) = pack8(v0, v1);
                        if (row < MP) { float* o = out + O_NV + ((size_t)((row >> 8) * DEPTH + layer) * 256 + (row & 255)) * 512 + (colb - 1024) + 32 * bj; *(f32x4*)o = v0; *(f32x4*)(o + 4) = v1; } } }
        } else if (T < 22) {
#pragma unroll
            for (int ai = 0; ai < 2; ++ai)
#pragma unroll
                for (int m = 0; m < 4; ++m) { const int row = rowb + ai * HALF + m * 16;
#pragma unroll
                    for (int bj = 0; bj < 2; ++bj) {
                        if (T == 6 || T == 7) { const int cu = colb + 32 * bj - P_S5U;
                            *(u32x4*)(up + ((size_t)(cu >> 4) * 384 + (row >> 5)) * 512 + (row & 31) * 16 + (cu & 15)) = pack8(acc[ai][bj][m][0], acc[ai][bj][m][1]); }
                        else *(u32x4*)(proj + (size_t)row * PJ + colb + 32 * bj) = pack8(acc[ai][bj][m][0], acc[ai][bj][m][1]); } }
        } else {
#pragma unroll
            for (int ai = 0; ai < 2; ++ai)
#pragma unroll
                for (int m = 0; m < 4; ++m) { const int row = rowb + ai * HALF + m * 16;
#pragma unroll
                    for (int bj = 0; bj < 2; ++bj) { f32x4 v0 = acc[ai][bj][m][0], v1 = acc[ai][bj][m][1];
#pragma unroll
                        for (int j = 0; j < 4; ++j) { v0[j] = fsigm(v0[j]); v1[j] = fsigm(v1[j]); }
                        unsigned w0 = 0u, w1 = 0u;
                        w0 = __builtin_amdgcn_cvt_pk_u8_f32(fmaxf(v0[0] * 255.f + 0.5f, 1.f), 0, w0); w0 = __builtin_amdgcn_cvt_pk_u8_f32(fmaxf(v0[1] * 255.f + 0.5f, 1.f), 1, w0);
                        w0 = __builtin_amdgcn_cvt_pk_u8_f32(fmaxf(v0[2] * 255.f + 0.5f, 1.f), 2, w0); w0 = __builtin_amdgcn_cvt_pk_u8_f32(fmaxf(v0[3] * 255.f + 0.5f, 1.f), 3, w0);
                        w1 = __builtin_amdgcn_cvt_pk_u8_f32(fmaxf(v1[0] * 255.f + 0.5f, 1.f), 0, w1); w1 = __builtin_amdgcn_cvt_pk_u8_f32(fmaxf(v1[1] * 255.f + 0.5f, 1.f), 1, w1);
                        w1 = __builtin_amdgcn_cvt_pk_u8_f32(fmaxf(v1[2] * 255.f + 0.5f, 1.f), 2, w1); w1 = __builtin_amdgcn_cvt_pk_u8_f32(fmaxf(v1[3] * 255.f + 0.5f, 1.f), 3, w1);
                        u32x2 o8; o8.x = w0; o8.y = w1; *(u32x2*)((unsigned char*)(proj + (size_t)row * PJ + P_GATE) + (colb - P_GATE) + 32 * bj) = o8; } }
        }
    }
};
struct EpiRelu2 {
    static constexpr bool PERM = true; static constexpr int MODE = 2;
    bf16_t* O; int ldo; const float* rsc; const float* cmx;
    __device__ __forceinline__ void operator()(f32x4 (&acc)[2][2][4][2], const Unit& u, int wr, int wc, int fr, int fq) const {
        const int rowb = u.pm * BM + wr * 64 + fr, colb = u.pn * 256 + 64 * wc + 8 * fq;
        {   f32x4 cs[2][2];
#pragma unroll
            for (int bj = 0; bj < 2; ++bj)
#pragma unroll
                for (int n = 0; n < 2; ++n) cs[bj][n] = *(const f32x4*)(cmx + u.pn * 256 + 128 * bj + 32 * wc + 8 * fq + 4 * n) * (1.f / 127.f);
#pragma unroll
            for (int ai = 0; ai < 2; ++ai)
#pragma unroll
                for (int m = 0; m < 4; ++m) { const float rs = rsc[rowb + ai * HALF + m * 16];
#pragma unroll
                    for (int bj = 0; bj < 2; ++bj)
#pragma unroll
                        for (int n = 0; n < 2; ++n) { const v4i32 iv = __builtin_bit_cast(v4i32, acc[ai][bj][m][n]); f32x4 fv; fv[0] = (float)iv[0]; fv[1] = (float)iv[1]; fv[2] = (float)iv[2]; fv[3] = (float)iv[3];
                            acc[ai][bj][m][n] = fv * cs[bj][n] * rs; } }
        }
#pragma unroll
        for (int ai = 0; ai < 2; ++ai)
#pragma unroll
            for (int m = 0; m < 4; ++m) { const int row = rowb + ai * HALF + m * 16;
#pragma unroll
                for (int bj = 0; bj < 2; ++bj) { f32x4 v0 = acc[ai][bj][m][0], v1 = acc[ai][bj][m][1];
#pragma unroll
                    for (int j = 0; j < 4; ++j) { const float a = fmaxf(v0[j], 0.f), b = fmaxf(v1[j], 0.f); v0[j] = a * a; v1[j] = b * b; }
                    { const int col = colb + 32 * bj;
                        *(u32x4*)(O + (((size_t)(row >> 8) * (ldo >> 6) + (col >> 6)) * 256 + (row & 255)) * 64 + (col & 63)) = pack8(v0, v1); } } }
    }
};
struct EpiGlu {
    static constexpr bool PERM = true; static constexpr int MODE = 0;
    const bf16_t* Z; const float* bias; bf16_t* br;
    __device__ __forceinline__ void operator()(f32x4 (&acc)[2][2][4][2], const Unit& u, int wr, int wc, int fr, int fq) const {
        const int rowb = u.pm * BM + wr * 64 + fr, colb = u.pn * 256 + 64 * wc + 8 * fq;
#pragma unroll
        for (int bj = 0; bj < 2; ++bj) { const int c = colb + 32 * bj; const f32x4 b0 = *(const f32x4*)(bias + c), b1 = *(const f32x4*)(bias + c + 4);
#pragma unroll
            for (int ai = 0; ai < 2; ++ai)
#pragma unroll
                for (int m = 0; m < 4; ++m) { const int row = rowb + ai * HALF + m * 16;
                    const u32x4 zz = *(const u32x4*)(Z + (size_t)row * 512 + c);
                    f32x4 v0 = acc[ai][bj][m][0] + b0, v1 = acc[ai][bj][m][1] + b1;
                    v0[0] = bflo(zz.x) * fsigm(v0[0]); v0[1] = bfhi(zz.x) * fsigm(v0[1]); v0[2] = bflo(zz.y) * fsigm(v0[2]); v0[3] = bfhi(zz.y) * fsigm(v0[3]);
                    v1[0] = bflo(zz.z) * fsigm(v1[0]); v1[1] = bfhi(zz.z) * fsigm(v1[1]); v1[2] = bflo(zz.w) * fsigm(v1[2]); v1[3] = bfhi(zz.w) * fsigm(v1[3]);
                    *(u32x4*)(br + (size_t)row * D + 512 + c) = pack8(v0, v1); } }
    }
};
struct EpiBranch {
    static constexpr bool PERM = true; static constexpr int MODE = 0;
    const bf16_t* proj; bf16_t* merged;
    __device__ __forceinline__ void operator()(f32x4 (&acc)[2][2][4][2], const Unit& u, int wr, int wc, int fr, int fq) const {
        const int rowb = u.pm * BM + wr * 64 + fr, colb = u.pn * 256 + 64 * wc + 8 * fq, kz = u.kz;
#pragma unroll
        for (int ai = 0; ai < 2; ++ai)
#pragma unroll
            for (int m = 0; m < 4; ++m) { const int row = rowb + ai * HALF + m * 16;
#pragma unroll
                for (int bj = 0; bj < 2; ++bj) { const int c = colb + 32 * bj;
                    const unsigned char* gp = (const unsigned char*)(proj + (size_t)row * PJ + P_GATE) + kz * D + c;
                    const u32x2 gg = *(const u32x2*)gp;
                    float g[8] = {(float)(gg.x & 0xffu) - 0.5f, (float)((gg.x >> 8) & 0xffu) - 0.5f, (float)((gg.x >> 16) & 0xffu) - 0.5f, (float)(gg.x >> 24) - 0.5f,
                                  (float)(gg.y & 0xffu) - 0.5f, (float)((gg.y >> 8) & 0xffu) - 0.5f, (float)((gg.y >> 16) & 0xffu) - 0.5f, (float)(gg.y >> 24) - 0.5f};
                    if (kz < 3) { const u32x2 hh = *(const u32x2*)(gp + D);
                        const float h[8] = {(float)(hh.x & 0xffu) - 0.5f, (float)((hh.x >> 8) & 0xffu) - 0.5f, (float)((hh.x >> 16) & 0xffu) - 0.5f, (float)(hh.x >> 24) - 0.5f,
                                            (float)(hh.y & 0xffu) - 0.5f, (float)((hh.y >> 8) & 0xffu) - 0.5f, (float)((hh.y >> 16) & 0xffu) - 0.5f, (float)(hh.y >> 24) - 0.5f};
#pragma unroll
                        for (int j = 0; j < 8; ++j) g[j] = g[j] * __builtin_amdgcn_rcpf(h[j]); }
                    else {
#pragma unroll
                        for (int j = 0; j < 8; ++j) g[j] *= (1.f / 255.f); }
                    f32x4& v0 = acc[ai][bj][m][0]; f32x4& v1 = acc[ai][bj][m][1];
                    v0[0] *= g[0]; v0[1] *= g[1]; v0[2] *= g[2]; v0[3] *= g[3]; v1[0] *= g[4]; v1[1] *= g[5]; v1[2] *= g[6]; v1[3] *= g[7];
                    if (kz == 3) *(u32x4*)(merged + (size_t)row * D + c) = pack8(v0, v1); } }
    }
};
struct EpiResid {
    static constexpr bool PERM = false; static constexpr int MODE = 0;
    const float* xp; const float* xs; const float* modl; int g_off; float* xout; float* part;
    __device__ __forceinline__ void operator()(f32x4 (&acc)[2][2][4][2], const Unit& u, int wr, int wc, int fr, int fq) const {
        if (part != nullptr && u.pm >= 32) {
            bf16_t* P = (bf16_t*)part + (size_t)((((u.pm - 32) * 8 + u.pn) * 2) + (u.koff != 0)) * 65536 + (size_t)(wr * 64 + fr) * 256 + wc * 32 + 4 * fq;
#pragma unroll
            for (int ai = 0; ai < 2; ++ai)
#pragma unroll
                for (int m = 0; m < 4; ++m)
#pragma unroll
                    for (int bj = 0; bj < 2; ++bj)
#pragma unroll
                        for (int n = 0; n < 2; ++n) { const f32x4 t = acc[ai][bj][m][n]; u32x2 w; w.x = pk2(t[0], t[1]); w.y = pk2(t[2], t[3]); *(u32x2*)(P + (size_t)(ai * HALF + m * 16) * 256 + bj * HALF + n * 16) = w; }
            return;
        }
        const int row0 = u.pm * BM, rowb = row0 + wr * 64 + fr, colb = u.pn * 256 + wc * 32 + 4 * fq;
        const float* xin = row0 < MP ? xp : xs - (size_t)MP * D;
        const float* gate = modl + (size_t)row_cvec(row0) * 6 * D + g_off;
        f32x4 gv[2][2];
#pragma unroll
        for (int bj = 0; bj < 2; ++bj)
#pragma unroll
            for (int n = 0; n < 2; ++n) gv[bj][n] = *(const f32x4*)(gate + colb + bj * HALF + n * 16);
#pragma unroll
        for (int ai = 0; ai < 2; ++ai)
#pragma unroll
            for (int m = 0; m < 4; ++m) { const size_t ro = (size_t)(rowb + ai * HALF + m * 16) * D + colb;
#pragma unroll
                for (int bj = 0; bj < 2; ++bj)
#pragma unroll
                    for (int n = 0; n < 2; ++n) { const size_t o = ro + bj * HALF + n * 16; *(f32x4*)(xout + o) = *(const f32x4*)(xin + o) + gv[bj][n] * acc[ai][bj][m][n]; } }
    }
};
}
namespace mk {
constexpr size_t AL(size_t x) { return (x + 255) & ~(size_t)255; }
constexpr size_t WS_CTL = 0, CTL_BYTES = 36864 + DEPTH * 8192 * 4;
constexpr size_t WS_MOD = WS_CTL + CTL_BYTES;
constexpr size_t WS_W = AL(WS_MOD + (size_t)DEPTH * 5 * 6 * D * 4);
constexpr int NTB_ROWS = 14 * 256, NT8_ROWS = 41 * 256;
constexpr size_t W_IN = 0, W_GLU = W_IN + (size_t)NIN * D, W_BR = W_GLU + 512 * 512, W_OUT = W_BR + (size_t)4 * D * 512, W_1 = W_OUT + (size_t)D * D, W_2 = W_1 + (size_t)DFF * D,
                 W_LAYER = W_2 + (size_t)D * DFF;
constexpr size_t W_IN8 = (size_t)5888 * D;
constexpr size_t WS_H = AL(WS_W + W_LAYER * 2 * DEPTH);
constexpr size_t WS_PROJ = AL(WS_H + (size_t)M * D * 2);
constexpr size_t WS_SMALL = AL(WS_PROJ + (size_t)M * PJ * 2);
constexpr size_t WS_BR = AL(WS_SMALL + (size_t)M * 32 * 4);
constexpr size_t WS_MERGED = AL(WS_BR + (size_t)M * D * 2);
constexpr size_t WS_MACC = AL(WS_MERGED + (size_t)M * D * 2);
constexpr size_t WS_ZB = AL(WS_MACC + (size_t)M * D * 4);
constexpr size_t WS_H8 = AL(WS_ZB + (size_t)M * 512 * 2);
constexpr size_t WS_RSC = AL(WS_H8 + (size_t)M * D);
constexpr size_t WS_WSC = WS_CTL + 36864;
constexpr size_t WS_SCR = AL(WS_RSC + (size_t)M * 4);
constexpr int LDS_BYTES = 140 * 1024, LDS_CTL = LDS_BYTES - 256;

struct Args { const float* in[43]; float* out; unsigned char* ws; int ph_lo, ph_hi; };

__device__ __forceinline__ float wave_sum(float v) {
#pragma unroll
    for (int o = 1; o < 64; o <<= 1) v += __shfl_xor(v, o);
    return v;
}
#define LDS_WAIT() asm volatile("s_waitcnt lgkmcnt(0)" ::: "memory")

__device__ __forceinline__ void xpose_item(const float* W, int ldw, int k0, int sc, bf16_t* dst, int K, LAS float* scr, int lane, int mode, bool f8 = false, const float* cmax = nullptr, int kd = -1) {
    const int n4 = (lane & 7) * 4;
    const int col = mode == 1 ? (n4 < 16 ? 3584 + n4 : 5648 + (n4 - 16)) : sc + n4;
#pragma unroll
    for (int i = 0; i < 8; ++i) { const int kk = (lane >> 3) + 8 * i; f32x4 v = (f32x4){0.f, 0.f, 0.f, 0.f}; if (mode != 2) v = __builtin_nontemporal_load((const f32x4*)(W + (size_t)(k0 + kk) * ldw + col));
        if (cmax != nullptr) { const f32x4 cm = *(const f32x4*)(cmax + n4);
#pragma unroll
            for (int e = 0; e < 4; ++e) v[e] = rintf(v[e] * (cm[e] > 0.f ? 127.f / cm[e] : 0.f)); }
        scr[kk * 33 + n4] = v[0]; scr[kk * 33 + n4 + 1] = v[1]; scr[kk * 33 + n4 + 2] = v[2]; scr[kk * 33 + n4 + 3] = v[3]; }
    LDS_WAIT(); asm volatile("" ::: "memory");
    const int c = lane & 7;
#pragma unroll
    for (int jj = 0; jj < 4; ++jj) { const int n = (lane >> 3) + 8 * jj; const LAS float* s = scr + (8 * c) * 33 + n;
        if (cmax != nullptr) { const unsigned w0 = ((unsigned)(int)s[0 * 33] & 0xffu) | (((unsigned)(int)s[1 * 33] & 0xffu) << 8) | (((unsigned)(int)s[2 * 33] & 0xffu) << 16) | (((unsigned)(int)s[3 * 33] & 0xffu) << 24);
            const unsigned w1 = ((unsigned)(int)s[4 * 33] & 0xffu) | (((unsigned)(int)s[5 * 33] & 0xffu) << 8) | (((unsigned)(int)s[6 * 33] & 0xffu) << 16) | (((unsigned)(int)s[7 * 33] & 0xffu) << 24);
            u32x2 o8; o8.x = w0; o8.y = w1; *(u32x2*)((unsigned char*)dst + (size_t)n * K + k0 + 8 * c) = o8; }
        else if (f8) { unsigned w0 = 0u, w1 = 0u; w0 = __builtin_amdgcn_cvt_pk_fp8_f32(s[0 * 33], s[1 * 33], w0, false); w0 = __builtin_amdgcn_cvt_pk_fp8_f32(s[2 * 33], s[3 * 33], w0, true);
            w1 = __builtin_amdgcn_cvt_pk_fp8_f32(s[4 * 33], s[5 * 33], w1, false); w1 = __builtin_amdgcn_cvt_pk_fp8_f32(s[6 * 33], s[7 * 33], w1, true);
            u32x2 o8; o8.x = w0; o8.y = w1; *(u32x2*)((unsigned char*)dst + (size_t)n * K + k0 + 8 * c) = o8; }
        else { u32x4 o; o.x = pk2(s[0 * 33], s[1 * 33]); o.y = pk2(s[2 * 33], s[3 * 33]); o.z = pk2(s[4 * 33], s[5 * 33]); o.w = pk2(s[6 * 33], s[7 * 33]);
            *(u32x4*)(dst + (size_t)n * K + (kd >= 0 ? kd : k0) + 8 * c) = o; } }
    LDS_WAIT(); asm volatile("" ::: "memory");
}
__device__ __forceinline__ void xpose_q8_group(const float* W, int ldw, int K, int sc, unsigned char* dst, float* csc, LAS float* scr, int lane, int mode) {
    const int n4 = (lane & 7) * 4, kk0 = lane >> 3;
    const int col = mode == 1 ? (n4 < 16 ? 3584 + n4 : 5648 + (n4 - 16)) : sc + n4;
    f32x4 mx = (f32x4){0.f, 0.f, 0.f, 0.f};
    if (mode != 2) {
#pragma unroll 8
        for (int k = kk0; k < K; k += 8) { const f32x4 v = *(const f32x4*)(W + (size_t)k * ldw + col); mx[0] = fmaxf(mx[0], fabsf(v[0])); mx[1] = fmaxf(mx[1], fabsf(v[1])); mx[2] = fmaxf(mx[2], fabsf(v[2])); mx[3] = fmaxf(mx[3], fabsf(v[3])); }
    }
    f32x4 inv, scl;
#pragma unroll
    for (int e = 0; e < 4; ++e) { float x = mx[e]; x = fmaxf(x, __shfl_xor(x, 8)); x = fmaxf(x, __shfl_xor(x, 16)); x = fmaxf(x, __shfl_xor(x, 32)); scl[e] = x > 0.f ? x * (1.f / 127.f) : 1.f; inv[e] = x > 0.f ? 127.f / x : 0.f; }
    if (kk0 == 0) *(f32x4*)(csc + n4) = scl;
    for (int k0 = 0; k0 < K; k0 += 64) {
#pragma unroll
        for (int i = 0; i < 8; ++i) { const int kk = kk0 + 8 * i; f32x4 v = (f32x4){0.f, 0.f, 0.f, 0.f}; if (mode != 2) v = *(const f32x4*)(W + (size_t)(k0 + kk) * ldw + col);
            scr[kk * 33 + n4] = rintf(v[0] * inv[0]); scr[kk * 33 + n4 + 1] = rintf(v[1] * inv[1]); scr[kk * 33 + n4 + 2] = rintf(v[2] * inv[2]); scr[kk * 33 + n4 + 3] = rintf(v[3] * inv[3]); }
        LDS_WAIT(); asm volatile("" ::: "memory");
        const int c = lane & 7;
#pragma unroll
        for (int jj = 0; jj < 4; ++jj) { const int n = (lane >> 3) + 8 * jj; const LAS float* s = scr + (8 * c) * 33 + n;
            const unsigned w0 = ((unsigned)(int)s[0 * 33] & 0xffu) | (((unsigned)(int)s[1 * 33] & 0xffu) << 8) | (((unsigned)(int)s[2 * 33] & 0xffu) << 16) | (((unsigned)(int)s[3 * 33] & 0xffu) << 24);
            const unsigned w1 = ((unsigned)(int)s[4 * 33] & 0xffu) | (((unsigned)(int)s[5 * 33] & 0xffu) << 8) | (((unsigned)(int)s[6 * 33] & 0xffu) << 16) | (((unsigned)(int)s[7 * 33] & 0xffu) << 24);
            u32x2 o8; o8.x = w0; o8.y = w1; *(u32x2*)(dst + (size_t)n * K + k0 + 8 * c) = o8; }
        LDS_WAIT(); asm volatile("" ::: "memory");
    }
}
__device__ __forceinline__ int hm_col(int grp) { const int T = grp >> 3, q8 = grp & 7; return 256 * T + 32 * (2 * (q8 & 3) + (q8 >> 2)); }

constexpr int CM_ITEMS = DEPTH * 256 * 8, CM_ITEMS_IN = DEPTH * (NT8 * 8) * 8;
constexpr size_t CMX_IN_OFF = (size_t)DEPTH * 8192;
__device__ __forceinline__ void colmax_item(const Args& a, unsigned* cmx, int item, int lane) {
    const int slab = item & 7, grp = (item >> 3) & 255, l = item >> 11;
    const int n4 = (lane & 7) * 4, kk0 = lane >> 3, col = hm_col(grp) + n4;
    const float* W = a.in[41] + (size_t)l * D * DFF + (size_t)(slab * 256) * DFF;
    f32x4 mx = (f32x4){0.f, 0.f, 0.f, 0.f};
#pragma unroll 8
    for (int k = kk0; k < 256; k += 8) { const f32x4 v = *(const f32x4*)(W + (size_t)k * DFF + col); mx[0] = fmaxf(mx[0], fabsf(v[0])); mx[1] = fmaxf(mx[1], fabsf(v[1])); mx[2] = fmaxf(mx[2], fabsf(v[2])); mx[3] = fmaxf(mx[3], fabsf(v[3])); }
#pragma unroll
    for (int e = 0; e < 4; ++e) { float x = mx[e]; x = fmaxf(x, __shfl_xor(x, 8)); x = fmaxf(x, __shfl_xor(x, 16)); x = fmaxf(x, __shfl_xor(x, 32)); mx[e] = x; }
    if (kk0 == 0) {
#pragma unroll
        for (int e = 0; e < 4; ++e) atomicMax(cmx + (size_t)l * DFF + 32 * grp + n4 + e, __float_as_uint(mx[e])); }
}
__device__ __forceinline__ void colmax_in_item(const Args& a, unsigned* cmx, int item, int lane) {
    const int slab = item & 7, r = item >> 3, gi = r % (NT8 * 8), l = r / (NT8 * 8);
    const int n4 = (lane & 7) * 4, kk0 = lane >> 3, col = win_col(tile_of_i8(gi >> 3) * 8 + (gi & 7)) + n4;
    const float* W = a.in[16] + (size_t)l * D * 13856 + (size_t)(slab * 256) * 13856;
    f32x4 mx = (f32x4){0.f, 0.f, 0.f, 0.f};
#pragma unroll 8
    for (int k = kk0; k < 256; k += 8) { const f32x4 v = *(const f32x4*)(W + (size_t)k * 13856 + col); mx[0] = fmaxf(mx[0], fabsf(v[0])); mx[1] = fmaxf(mx[1], fabsf(v[1])); mx[2] = fmaxf(mx[2], fabsf(v[2])); mx[3] = fmaxf(mx[3], fabsf(v[3])); }
#pragma unroll
    for (int e = 0; e < 4; ++e) { float x = mx[e]; x = fmaxf(x, __shfl_xor(x, 8)); x = fmaxf(x, __shfl_xor(x, 16)); x = fmaxf(x, __shfl_xor(x, 32)); mx[e] = x; }
    if (kk0 == 0) {
#pragma unroll
        for (int e = 0; e < 4; ++e) atomicMax(cmx + CMX_IN_OFF + (size_t)l * NT8_ROWS + 32 * gi + n4 + e, __float_as_uint(mx[e])); }
}
constexpr int CV_NQ8 = 0;
constexpr int CV_IN = 440 * 32, CV_GLU = 16 * 8, CV_BR = 4 * 64 * 8, CV_OUT = 64 * 32, CV_1 = 256 * 32, CV_2 = 64 * 128, CV_REST = CV_IN + CV_GLU + CV_BR + CV_OUT + CV_1 + CV_2;
__device__ __forceinline__ void convert_q8(const Args& a, LAS unsigned char* lds, int l, int grp, int wave, int lane) {
    LAS float* scr = (LAS float*)(lds + wave * 8704);
    bf16_t* wl = (bf16_t*)(a.ws + WS_W) + (size_t)l * W_LAYER; float* wsc = (float*)(a.ws + WS_WSC) + (size_t)l * (NIN + DFF);
    const int T = grp >> 3; int sc = hm_col(grp), mode = 0;
    if (T == 54) mode = (grp & 7) == 0 ? 1 : 2; else if (T >= 22) sc += 32; else if (T >= 14) sc += 16;
    xpose_q8_group(a.in[16] + (size_t)l * D * 13856, 13856, D, sc, (unsigned char*)(wl + W_IN) + (size_t)(32 * grp) * D, wsc + 32 * grp, scr, lane, mode);
}
__device__ __forceinline__ void convert_rest(const Args& a, LAS unsigned char* lds, int l, int r0, int r1, int wave, int lane) {
    LAS float* scr = (LAS float*)(lds + wave * 8704);
    bf16_t* wl = (bf16_t*)(a.ws + WS_W) + (size_t)l * W_LAYER;
    for (int it = r0; it < r1; ++it) { int r = it;
        if (r < CV_IN) { const int kb = r / 440, grp = r % 440, T = grp >> 3; const int sc = win_col(grp); const int mode = T == 54 ? ((grp & 7) == 0 ? 1 : 2) : 0;
            if (T >= 22 && T < 54) xpose_item(a.in[16] + (size_t)l * D * 13856, 13856, 64 * kb, sc, (bf16_t*)((unsigned char*)(wl + W_IN8) + (size_t)(32 * (grp - 176)) * D), D, scr, lane, mode, true);
            else xpose_item(a.in[16] + (size_t)l * D * 13856, 13856, 64 * kb, sc, wl + W_IN + (size_t)(32 * (T == 54 ? grp - 256 : grp)) * D, D, scr, lane, mode);
            continue; } r -= CV_IN;
        if (r < CV_GLU) { const int kb = r / 16, grp = r % 16; xpose_item(a.in[28] + (size_t)l * 512 * 512, 512, 64 * kb, hm_col(grp), wl + W_GLU + (size_t)(32 * grp) * 512, 512, scr, lane, 0); continue; } r -= CV_GLU;
        if (r < CV_BR) { const int k = r / 512, r2 = r % 512, kb = r2 / 64, grp = r2 % 64;
            xpose_item(a.in[39] + ((size_t)l * 4 + k) * 512 * D, D, 64 * kb, hm_col(grp), wl + W_BR + (size_t)k * D * 512 + (size_t)(32 * grp) * 512, 512, scr, lane, 0); continue; } r -= CV_BR;
        if (r < CV_OUT) { const int kb = r / 64, grp = r % 64; xpose_item(a.in[40] + (size_t)l * D * D, D, 64 * kb, 32 * grp, wl + W_OUT + (size_t)(32 * grp) * D, D, scr, lane, 0); continue; } r -= CV_OUT;
        if (r < CV_1) { const int kb = r / 256, grp = r % 256;
            xpose_item(a.in[41] + (size_t)l * D * DFF, DFF, 64 * kb, hm_col(grp), (bf16_t*)((unsigned char*)(wl + W_1) + (size_t)(32 * grp) * D), D, scr, lane, 0, false, (const float*)(a.ws + WS_WSC) + (size_t)l * DFF + 32 * grp); continue; } r -= CV_1;
        { const int kb = r / 64, grp = r % 64;
          xpose_item(a.in[42] + (size_t)l * DFF * D, D, 64 * kb, 32 * grp, wl + W_2 + ((size_t)(grp >> 3) * (DFF / 64) + kb) * 16384 + (size_t)((grp & 7) * 32) * 64, 64, scr, lane, 0, false, nullptr, 0); }
    }
}
__device__ __forceinline__ void prologue_ada_unit(const Args& a, LAS unsigned char* lds, int tid, int unit) {
    LAS float* sl = (LAS float*)lds;
    LAS float* red = (LAS float*)(lds + 40960);
    float* mod = (float*)(a.ws + WS_MOD);
    for (int i = tid; i < 5 * D; i += NT) { const int j = i / D, k = i % D; const float x = j == 0 ? a.in[11][k] : a.in[10][(j - 1) * D + k]; sl[i] = x / (1.f + __expf(-x)); }
    __syncthreads();
    const int ks = tid >> 6, c = tid & 63;
    const int l = unit / (6 * D / 64), n0 = (unit % (6 * D / 64)) * 64;
    const float* w = a.in[12] + (size_t)l * D * 6 * D + n0 + c;
    float acc[5] = {0.f, 0.f, 0.f, 0.f, 0.f};
#pragma unroll 8
    for (int k = ks * 256; k < ks * 256 + 256; ++k) { const float wv = __builtin_nontemporal_load(w + (size_t)k * 6 * D);
#pragma unroll
        for (int j = 0; j < 5; ++j) acc[j] += sl[j * D + k] * wv; }
#pragma unroll
    for (int j = 0; j < 5; ++j) red[(ks * 5 + j) * 64 + c] = acc[j];
    __syncthreads();
    if (tid < 320) { const int j = tid >> 6; float s = 0.f;
#pragma unroll
        for (int q = 0; q < 8; ++q) s += red[(q * 5 + j) * 64 + c];
        mod[((size_t)l * 5 + j) * 6 * D + n0 + c] = s + a.in[13][l * 6 * D + n0 + c]; }
}
constexpr int PRO_NQ8B = CV_NQ8 / 8, PRO_NCONV = PRO_NQ8B + (CV_REST + 63) / 64,
              PRO_NADA = DEPTH * 6 * D / 64, PRO_NCACHE = 64;
__device__ __forceinline__ void norm_phase(const float* xp, const float* xs, const float* g, const float* modl, int sh_off, int sc_off, bf16_t* H, int gw, int ngw, int lane_,
                                           const float* pend, const float* pmodl, int pg_off, float* xw, const float* xs_pend, unsigned char* F8c = nullptr, unsigned char* Q8 = nullptr, float* rsc = nullptr) {
    int lane = lane_; asm volatile("" : "+v"(lane));
    for (int row = gw; row < M; row += ngw) {
        const float* x = row < MP ? xp + (size_t)row * D : xs + (size_t)(row - MP) * D;
        if (pend != nullptr && row >= 8192) x = xs_pend + (size_t)(row - MP) * D;
        f32x4 v[8]; float ss = 0.f;
#pragma unroll
        for (int j = 0; j < 8; ++j) v[j] = *(const f32x4*)(x + 4 * (lane + 64 * j));
        if (pend != nullptr && row >= 8192) {
            const float* pg = pmodl + (size_t)row_cvec(row) * 6 * D + pg_off; const int pm = row >> 8, r = row & 255;
#pragma unroll
            for (int j = 0; j < 8; ++j) { const int col = 4 * (lane + 64 * j), pn = col >> 8, cc = col & 255;
                const bf16_t* P = (const bf16_t*)pend + (size_t)(((pm - 32) * 8 + pn) * 2) * 65536 + (size_t)r * 256 + cc;
                const u32x2 qa = *(const u32x2*)P, qb = *(const u32x2*)(P + 65536); const f32x4 gg = *(const f32x4*)(pg + col);
                const f32x4 pa = (f32x4){bflo(qa.x), bfhi(qa.x), bflo(qa.y), bfhi(qa.y)}, pb = (f32x4){bflo(qb.x), bfhi(qb.x), bflo(qb.y), bfhi(qb.y)};
                v[j] = v[j] + gg * (pa + pb); *(f32x4*)(xw + (size_t)row * D + col) = v[j]; }
        }
#pragma unroll
        for (int j = 0; j < 8; ++j) ss += (v[j][0] * v[j][0] + v[j][1] * v[j][1]) + (v[j][2] * v[j][2] + v[j][3] * v[j][3]);
        const float r = rsqrtf(wave_sum(ss) * (1.f / D) + 1e-6f);
        const float* md = modl + (size_t)row_cvec(row) * 6 * D;
        float amax = 0.f;
#pragma unroll
        for (int j = 0; j < 8; ++j) { const int i = 4 * (lane + 64 * j);
            const f32x4 gg = *(const f32x4*)(g + i), sc = *(const f32x4*)(md + sc_off + i), sh = *(const f32x4*)(md + sh_off + i);
            const f32x4 o = v[j] * r * gg * (sc + 1.f) + sh; v[j] = o;
            amax = fmaxf(amax, fmaxf(fmaxf(fabsf(o[0]), fabsf(o[1])), fmaxf(fabsf(o[2]), fabsf(o[3])))); }
        if (H != nullptr) {
#pragma unroll
            for (int j = 0; j < 8; ++j) { const int i = 4 * (lane + 64 * j); u32x2 w; w.x = pk2(v[j][0], v[j][1]); w.y = pk2(v[j][2], v[j][3]); *(u32x2*)(H + (size_t)row * D + i) = w;
                if (F8c != nullptr) { unsigned w8 = 0u; w8 = __builtin_amdgcn_cvt_pk_fp8_f32(v[j][0], v[j][1], w8, false); w8 = __builtin_amdgcn_cvt_pk_fp8_f32(v[j][2], v[j][3], w8, true); *(unsigned*)(F8c + (size_t)row * D + i) = w8; } }
        }
        if (Q8 != nullptr) {
#pragma unroll
            for (int o2 = 1; o2 < 64; o2 <<= 1) amax = fmaxf(amax, __shfl_xor(amax, o2));
            const float inv = amax > 0.f ? 127.f / amax : 0.f;
            if (lane == 0) rsc[row] = amax > 0.f ? amax * (1.f / 127.f) : 1.f;
#pragma unroll
            for (int j = 0; j < 8; ++j) { const int i = 4 * (lane + 64 * j);
                const unsigned w = ((unsigned)(int)rintf(v[j][0] * inv) & 0xffu) | (((unsigned)(int)rintf(v[j][1] * inv) & 0xffu) << 8) | (((unsigned)(int)rintf(v[j][2] * inv) & 0xffu) << 16) | (((unsigned)(int)rintf(v[j][3] * inv) & 0xffu) << 24);
                *(unsigned*)(Q8 + (size_t)row * D + i) = w; }
        }
    }
}
__device__ __forceinline__ void final_fix_phase(const float* pend, const float* pmodl, int pg_off, float* X, int gw, int ngw, int lane_) {
    int lane = lane_; asm volatile("" : "+v"(lane));
    for (int row = 8192 + gw; row < M; row += ngw) {
        const float* pg = pmodl + (size_t)row_cvec(row) * 6 * D + pg_off; const int pm = row >> 8, r = row & 255;
#pragma unroll
        for (int j = 0; j < 8; ++j) { const int col = 4 * (lane + 64 * j), pn = col >> 8, cc = col & 255;
            const bf16_t* P = (const bf16_t*)pend + (size_t)(((pm - 32) * 8 + pn) * 2) * 65536 + (size_t)r * 256 + cc;
            const u32x2 qa = *(const u32x2*)P, qb = *(const u32x2*)(P + 65536); const f32x4 gg = *(const f32x4*)(pg + col);
            const f32x4 pa = (f32x4){bflo(qa.x), bfhi(qa.x), bflo(qa.y), bfhi(qa.y)}, pb = (f32x4){bflo(qb.x), bfhi(qb.x), bflo(qb.y), bfhi(qb.y)};
            float* xo = X + (size_t)row * D + col; *(f32x4*)xo = *(const f32x4*)xo + gg * (pa + pb); }
    }
}
constexpr int WQ_BASE = 3584;
#ifndef WQMASK
#define WQMASK 127
#endif
struct WaveQ { unsigned* h; int n, my, s, sh, dyn; };
__device__ __forceinline__ WaveQ waveq_init(const Args& a, int layer, int q, int n, int sh, int off = 0) {
    WaveQ Q; Q.h = (unsigned*)(a.ws + WS_CTL) + WQ_BASE + (layer * 8 + q) * 128; Q.n = n; Q.s = 0; Q.sh = sh; Q.dyn = (WQMASK >> q) & 1;
    if (Q.dyn) Q.my = (int)(xb_xcc_id() & 7u);
    else { const int gw = (int)blockIdx.x * 8 + __builtin_amdgcn_readfirstlane((int)(threadIdx.x >> 6)), ngw = (int)gridDim.x * 8; Q.my = gw - off; }
    return Q;
}
__device__ __forceinline__ int waveq_next(WaveQ& Q, int lane) {
    if (!Q.dyn) { for (;;) { const int it = Q.my + Q.s * (int)gridDim.x * 8; ++Q.s; if (it >= Q.n) return -1; if (it >= 0) return it; } }
    while (Q.s < 8) {
        const int x = (Q.my + Q.s) & 7;
        unsigned v = 0; if (lane == 0) v = __hip_atomic_fetch_add(Q.h + x * 16, 1u, __ATOMIC_RELAXED, __HIP_MEMORY_SCOPE_AGENT);
        v = (unsigned)__builtin_amdgcn_readfirstlane((int)v);
        const int it = (int)(((((v >> Q.sh) << 3) + (unsigned)x) << Q.sh) | (v & ((1u << Q.sh) - 1u)));
        if (it < Q.n) return it;
        ++Q.s;
    }
    return -1;
}
__device__ __forceinline__ void conv_pull(const Args& a, LAS unsigned char* lds, volatile LAS unsigned* qitem, int layer, int maxb, int qoff = 0) {
    unsigned* qhead = (unsigned*)(a.ws + WS_CTL) + 8200 + qoff + layer;
    for (int n = 0; maxb < 0 || n < maxb; ++n) {
        __syncthreads();
        if (threadIdx.x == 0) qitem[0] = __hip_atomic_fetch_add(qhead, 1u, __ATOMIC_RELAXED, __HIP_MEMORY_SCOPE_AGENT);
        __syncthreads();
        const int item = (int)qitem[0];
        if (item >= PRO_NCONV) break;
        const int wave = __builtin_amdgcn_readfirstlane((int)(threadIdx.x >> 6));
        int lane = (int)(threadIdx.x & 63); asm volatile("" : "+v"(lane));
        { const int w0 = (item - PRO_NQ8B) * 64 + wave * 8; convert_rest(a, lds, layer, w0, w0 + 8 < CV_REST ? w0 + 8 : CV_REST, wave, lane); }
    }
    __syncthreads();
}
}
namespace mk {
constexpr size_t WS_NAT = AL(WS_SCR);
constexpr int NATP = 2048, N_XBC = 0, N_Q = 1024, N_K = 1536;
constexpr size_t WS_TR = AL(WS_NAT + (size_t)M * NATP * 2);
constexpr int T_X = 0, T_B = 512, T_K = 768, T_MV = 1280, T_V = 1792, TRR = 2304;
constexpr int NCH = 96;
constexpr size_t WS_MLC = AL(WS_TR + (size_t)TRR * M * 2);
constexpr size_t WS_MLN = AL(WS_MLC + (size_t)NCH * 4 * 2 * 16384 * 4);
constexpr size_t WS_MLS = AL(WS_MLN + (size_t)NCH * 4 * 2 * 128 * 4);
constexpr size_t WS_MLCS = AL(WS_MLS + (size_t)NCH * 4 * 2 * 4 * 4);
constexpr size_t WS_MLNS = AL(WS_MLCS + (size_t)NCH * 4 * 2 * 16384 * 2);
constexpr size_t WS_MLMS = AL(WS_MLNS + (size_t)NCH * 4 * 2 * 128 * 4);
constexpr size_t WS_OPT_END = AL(WS_MLMS + (size_t)NCH * 4 * 2 * 4);

__device__ __forceinline__ f32x4 mfma16(bf16x8 a, bf16x8 b, f32x4 c) { return __builtin_amdgcn_mfma_f32_16x16x32_bf16(a, b, c, 0, 0, 0); }
__device__ __forceinline__ void chunk_info(int ch, int& row0, int& seq0, int& L, int& lat, int& b, int& ci, int& nc) {
    if (ch < 32) { b = ch >> 1; ci = ch & 1; nc = 2; seq0 = b * 256; L = 256; lat = 0; } else { const int c2 = ch - 32; b = c2 >> 4; ci = c2 & 15; nc = 16; seq0 = MP + b * 2048; L = 2048; lat = 1; }
    row0 = seq0 + ci * 128;
}
__device__ __forceinline__ float fast_exp(float x) { return __expf(x); }

__device__ __forceinline__ void prep_phase(const Args& a, int layer, LAS unsigned char* lds, int gw_, int ngw, int wave, int lane_, bf16_t* UPk) {
    int lane = lane_, gw = gw_; asm volatile("" : "+v"(lane));
    const bf16_t* PROJ = (const bf16_t*)(a.ws + WS_PROJ); bf16_t* NAT = (bf16_t*)(a.ws + WS_NAT); bf16_t* TR = (bf16_t*)(a.ws + WS_TR);
    LAS bf16_t* tile = (LAS bf16_t*)(lds + wave * 16896); LAS bf16_t* otile = tile + 68 * 64;
    const int c = lane & 7, r8 = lane >> 3;
    const float* cw = a.in[30] + layer * 5 * 1024; const float* cb = a.in[31] + layer * 1024;
    for (int u = gw; u < 48 * 192; u += ngw) {
        const int cg = u / 192, tt = u % 192, m0 = tt * 64;
        const int lat = m0 >= MP; const int seq0 = lat ? MP + ((m0 - MP) / 2048) * 2048 : (m0 / 256) * 256, L = lat ? 2048 : 256, t0 = m0 - seq0;
        int kind, src, natcol = -1, trrow = -1;
        if (cg < 16) { kind = 0; src = P_XBC + 64 * cg; natcol = N_XBC + 64 * cg; if (cg < 12) trrow = T_X + 64 * cg; }
        else if (cg < 24) { kind = 1; src = P_MQ + 64 * (cg - 16); natcol = N_Q + 64 * (cg - 16); }
        else if (cg < 32) { kind = 2; src = P_MK + 64 * (cg - 24); natcol = N_K + 64 * (cg - 24); trrow = T_K + 64 * (cg - 24); }
        else if (cg < 40) { kind = 3; src = P_MV + 64 * (cg - 32); trrow = T_MV + 64 * (cg - 32); }
        else if (cg < 48) { kind = 3; src = P_V + 64 * (cg - 40); trrow = T_V + 64 * (cg - 40); }
        else { kind = 4; src = P_S5U + 64 * (cg - 48); }
        const int roff = kind == 0 ? -2 : 0, nrows = kind == 0 ? 68 : 64;
#pragma unroll
        for (int i = 0; i < 9; ++i) { const int r = r8 + 8 * i; if (r < nrows) { const int t = t0 + r + roff; u32x4 v = {0u, 0u, 0u, 0u};
                if (t >= 0 && t < L) v = *(const u32x4*)(PROJ + (size_t)(seq0 + t) * PJ + src + 8 * c);
                *(LAS u32x4*)(tile + r * 64 + 8 * c) = v; } }
        LDS_WAIT(); asm volatile("" ::: "memory");
#define PREP_EMIT(i_, r_) do { if (natcol >= 0) *(u32x4*)(NAT + (size_t)(m0 + r8 + 8 * (i_)) * NATP + natcol + 8 * c) = (r_); if (trrow >= 0) *(LAS u32x4*)(otile + (r8 + 8 * (i_)) * 64 + 8 * c) = (r_); } while (0)
        if (kind == 0) {
            float w[5][8], bz[8];
#pragma unroll
            for (int e = 0; e < 8; ++e) { bz[e] = cb[64 * cg + 8 * c + e];
#pragma unroll
                for (int j = 0; j < 5; ++j) w[j][e] = cw[j * 1024 + 64 * cg + 8 * c + e]; }
#pragma unroll 2
            for (int i = 0; i < 8; ++i) { const int tk = r8 + 8 * i; float acc[8];
#pragma unroll
                for (int e = 0; e < 8; ++e) acc[e] = bz[e];
#pragma unroll
                for (int j = 0; j < 5; ++j) { const u32x4 v = *(const LAS u32x4*)(tile + (tk + j) * 64 + 8 * c);
                    acc[0] += bflo(v.x) * w[j][0]; acc[1] += bfhi(v.x) * w[j][1]; acc[2] += bflo(v.y) * w[j][2]; acc[3] += bfhi(v.y) * w[j][3];
                    acc[4] += bflo(v.z) * w[j][4]; acc[5] += bfhi(v.z) * w[j][5]; acc[6] += bflo(v.w) * w[j][6]; acc[7] += bfhi(v.w) * w[j][7]; }
#pragma unroll
                for (int e = 0; e < 8; ++e) acc[e] = fsilu(acc[e]);
                u32x4 rv; rv.x = pk2(acc[0], acc[1]); rv.y = pk2(acc[2], acc[3]); rv.z = pk2(acc[4], acc[5]); rv.w = pk2(acc[6], acc[7]); PREP_EMIT(i, rv); }
        } else if (kind == 4) {
#pragma unroll
            for (int i = 0; i < 8; ++i) { const int tk = r8 + 8 * i, m = m0 + tk; const u32x4 v = *(const LAS u32x4*)(tile + tk * 64 + 8 * c);
                *(u32x4*)(UPk + ((size_t)(4 * (cg - 48) + (c >> 1)) * 384 + (m >> 5)) * 512 + (m & 31) * 16 + 8 * (c & 1)) = v; }
        } else if (kind == 3 || !lat) {
            const float sc = kind == 2 ? 0.08838834764831845f : 1.f;
#pragma unroll
            for (int i = 0; i < 8; ++i) { const u32x4 v = *(const LAS u32x4*)(tile + (r8 + 8 * i) * 64 + 8 * c);
                u32x4 rv = v;
                if (kind == 2) { rv.x = pk2(bflo(v.x) * sc, bfhi(v.x) * sc); rv.y = pk2(bflo(v.y) * sc, bfhi(v.y) * sc); rv.z = pk2(bflo(v.z) * sc, bfhi(v.z) * sc); rv.w = pk2(bflo(v.w) * sc, bfhi(v.w) * sc); }
                PREP_EMIT(i, rv); }
        } else {
            const float sc = kind == 2 ? 0.08838834764831845f : 1.f; const int odd = cg & 1;
            float inv[8];
#pragma unroll
            for (int e = 0; e < 8; ++e) inv[e] = exp2f(-(float)(8 * (c & 3) + e) * (13.287712379549449f / 32.f));
#pragma unroll
            for (int i = 0; i < 8; ++i) { const int tk = r8 + 8 * i, t = t0 + tk; const float pos = odd ? (float)(t & 63) : (float)(t >> 6);
                const u32x4 vo = *(const LAS u32x4*)(tile + tk * 64 + 8 * c), vp = *(const LAS u32x4*)(tile + tk * 64 + 8 * (c ^ 4));
                float o[8], p[8], rr[8];
                o[0] = bflo(vo.x); o[1] = bfhi(vo.x); o[2] = bflo(vo.y); o[3] = bfhi(vo.y); o[4] = bflo(vo.z); o[5] = bfhi(vo.z); o[6] = bflo(vo.w); o[7] = bfhi(vo.w);
                p[0] = bflo(vp.x); p[1] = bfhi(vp.x); p[2] = bflo(vp.y); p[3] = bfhi(vp.y); p[4] = bflo(vp.z); p[5] = bfhi(vp.z); p[6] = bflo(vp.w); p[7] = bfhi(vp.w);
#pragma unroll
                for (int e = 0; e < 8; ++e) { const float ang = pos * inv[e], cs = __cosf(ang), sn = __sinf(ang);
                    rr[e] = (c < 4 ? o[e] * cs - p[e] * sn : p[e] * sn + o[e] * cs) * sc; }
                u32x4 rv; rv.x = pk2(rr[0], rr[1]); rv.y = pk2(rr[2], rr[3]); rv.z = pk2(rr[4], rr[5]); rv.w = pk2(rr[6], rr[7]); PREP_EMIT(i, rv); }
        }
        if (trrow >= 0) {
            LDS_WAIT(); asm volatile("" ::: "memory");
            bf16_t* dst = TR + (size_t)(trrow + lane) * M + m0;
#pragma unroll
            for (int j = 0; j < 8; ++j) { unsigned wv[4];
#pragma unroll
                for (int q = 0; q < 4; ++q) { const unsigned lo = otile[(8 * j + 2 * q) * 64 + lane], hi = otile[(8 * j + 2 * q + 1) * 64 + lane]; wv[q] = lo | (hi << 16); }
                u32x4 o; o.x = wv[0]; o.y = wv[1]; o.z = wv[2]; o.w = wv[3]; *(u32x4*)(dst + 8 * j) = o; }
        }
        LDS_WAIT(); asm volatile("" ::: "memory");
    }
}

struct MlGate { float lf0, lf1, ig0, ig1, P0, P1, tot; };
__device__ __forceinline__ float wave_incl_scan(float v, int lane) {
#pragma unroll
    for (int o = 1; o < 64; o <<= 1) { const float t = __shfl_up(v, o); if (lane >= o) v += t; }
    return v;
}
__device__ __forceinline__ float wave_max(float v) {
#pragma unroll
    for (int o = 1; o < 64; o <<= 1) v = fmaxf(v, __shfl_xor(v, o));
    return v;
}
__device__ __forceinline__ MlGate ml_gates(const Args& a, int layer, int row0, int hh, int dir, int lane) {
    const float* SMALL = (const float*)(a.ws + WS_SMALL);
    const float ib = a.in[36][layer * 8 + dir * 4 + hh], fb = a.in[37][layer * 8 + dir * 4 + hh];
    MlGate g;
    const float f0 = SMALL[(size_t)(row0 + lane) * 32 + S_MF + dir * 4 + hh] + fb, f1 = SMALL[(size_t)(row0 + lane + 64) * 32 + S_MF + dir * 4 + hh] + fb;
    g.ig0 = SMALL[(size_t)(row0 + lane) * 32 + S_MI + dir * 4 + hh] + ib; g.ig1 = SMALL[(size_t)(row0 + lane + 64) * 32 + S_MI + dir * 4 + hh] + ib;
    g.lf0 = fminf(f0, 0.f) - log1pf(__expf(-fabsf(f0))); g.lf1 = fminf(f1, 0.f) - log1pf(__expf(-fabsf(f1)));
    const float s0 = wave_incl_scan(g.lf0, lane); const float tot0 = __shfl(s0, 63);
    const float s1 = wave_incl_scan(g.lf1, lane) + tot0;
    g.P0 = s0; g.P1 = s1; g.tot = __shfl(s1, 63);
    return g;
}

__device__ __forceinline__ void ml_states_phase(const Args& a, int layer, int tid_, int G) {
    int tid = tid_; asm volatile("" : "+v"(tid));
    const int lane = tid & 63, wave = __builtin_amdgcn_readfirstlane(tid >> 6), fr = lane & 15, fq = lane >> 4;
    const bf16_t* TR = (const bf16_t*)(a.ws + WS_TR);
    bf16_t* MLC = (bf16_t*)(a.ws + WS_MLC); float* MLN = (float*)(a.ws + WS_MLN); float* MLS = (float*)(a.ws + WS_MLS);
    WaveQ Q = waveq_init(a, layer, 1, NCH * 4 * 4, 3, 3072);
    for (int it; (it = waveq_next(Q, lane)) >= 0; ) {
        const int u = it >> 2, wp = it & 3;
        const int ch = u >> 2, hh = u & 3; int row0, seq0, L, lat, b, ci, nc; chunk_info(ch, row0, seq0, L, lat, b, ci, nc);
#pragma unroll 1
        for (int dir = 0; dir < 2; ++dir) {
            const MlGate g = ml_gates(a, layer, row0, hh, dir, lane);
            const float w0 = (dir == 0 ? g.tot - g.P0 : g.P0 - g.lf0) + g.ig0, w1 = (dir == 0 ? g.tot - g.P1 : g.P1 - g.lf1) + g.ig1;
            const float mloc = wave_max(fmaxf(w0, w1));
            const float e0 = __expf(w0 - mloc), e1 = __expf(w1 - mloc);
            f32x4 acc[2][8];
#pragma unroll
            for (int q = 0; q < 2; ++q)
#pragma unroll
                for (int j = 0; j < 8; ++j) acc[q][j] = (f32x4){0.f, 0.f, 0.f, 0.f};
            float nacc[8];
#pragma unroll
            for (int j = 0; j < 8; ++j) nacc[j] = 0.f;
            const bf16_t* vrow = TR + (size_t)(T_MV + hh * 128 + wp * 32 + fr) * M + row0 + 8 * fq;
#pragma unroll
            for (int ks = 0; ks < 4; ++ks) {
                const bf16x8 af0 = *(const bf16x8*)(vrow + 32 * ks), af1 = *(const bf16x8*)(vrow + (size_t)16 * M + 32 * ks);
                float ev[8];
#pragma unroll
                for (int j = 0; j < 8; ++j) { const int tok = 32 * ks + 8 * fq + j; const float x0 = __shfl(e0, tok & 63), x1 = __shfl(e1, tok & 63); ev[j] = tok < 64 ? x0 : x1; }
#pragma unroll
                for (int jt = 0; jt < 8; ++jt) {
                    const u32x4 kv = *(const u32x4*)(TR + (size_t)(T_K + hh * 128 + jt * 16 + fr) * M + row0 + 32 * ks + 8 * fq);
                    const float k0 = bflo(kv.x) * ev[0], k1 = bfhi(kv.x) * ev[1], k2 = bflo(kv.y) * ev[2], k3 = bfhi(kv.y) * ev[3], k4 = bflo(kv.z) * ev[4], k5 = bfhi(kv.z) * ev[5], k6 = bflo(kv.w) * ev[6], k7 = bfhi(kv.w) * ev[7];
                    if (wp == 0) nacc[jt] += ((k0 + k1) + (k2 + k3)) + ((k4 + k5) + (k6 + k7));
                    u32x4 kb; kb.x = pk2(k0, k1); kb.y = pk2(k2, k3); kb.z = pk2(k4, k5); kb.w = pk2(k6, k7);
                    const bf16x8 kf = __builtin_bit_cast(bf16x8, kb);
                    acc[0][jt] = mfma16(kf, af0, acc[0][jt]); acc[1][jt] = mfma16(kf, af1, acc[1][jt]);
                }
            }
#pragma unroll
            for (int q = 0; q < 2; ++q) { bf16_t* cdst = MLC + ((size_t)(ch * 4 + hh) * 2 + dir) * 16384 + (size_t)(wp * 32 + 16 * q + fr) * 128 + 4 * fq;
#pragma unroll
                for (int jt = 0; jt < 8; ++jt) { u32x2 w; w.x = pk2(acc[q][jt][0], acc[q][jt][1]); w.y = pk2(acc[q][jt][2], acc[q][jt][3]); *(u32x2*)(cdst + jt * 16) = w; } }
            if (wp == 0) {
#pragma unroll
                for (int jt = 0; jt < 8; ++jt) { float v = nacc[jt]; v += __shfl_xor(v, 16); v += __shfl_xor(v, 32); if (fq == 0) MLN[((size_t)(ch * 4 + hh) * 2 + dir) * 128 + jt * 16 + fr] = v; }
                if (lane == 0) { MLS[((size_t)(ch * 4 + hh) * 2 + dir) * 4 + 0] = mloc; MLS[((size_t)(ch * 4 + hh) * 2 + dir) * 4 + 1] = g.tot; }
            }
        }
    }
}
template <int PER, int NB>
__device__ __forceinline__ void ml_scan_task(const Args& a, int layer, int tid, int lat, int b, int hh, int dir, int part) {
    const unsigned* MLC = (const unsigned*)(a.ws + WS_MLC); const float* MLN = (const float*)(a.ws + WS_MLN); const float* MLS = (const float*)(a.ws + WS_MLS);
    unsigned* CS = (unsigned*)(a.ws + WS_MLCS); float* NS = (float*)(a.ws + WS_MLNS); float* MS = (float*)(a.ws + WS_MLMS);
    const int nc = lat ? 16 : 2, ch0 = lat ? 32 + b * 16 : b * 2, e0 = part * PER * NT;
    float c[PER]; float n = 0.f, m = 0.f;
    const size_t so = (((size_t)b * DEPTH + layer) * 2 + dir) * 4 + hh;
#pragma unroll
    for (int i = 0; i < PER; ++i) { const int e = e0 + 2 * ((i >> 1) * NT + tid) + (i & 1), vd = e >> 7, kd = e & 127; c[i] = lat ? a.in[7][(so * 128 + kd) * 128 + vd] : 0.f; }
    if (tid < 128) n = lat ? a.in[8][so * 128 + tid] : 0.f;
    m = lat ? a.in[9][so] : 0.f;
    for (int s0 = 0; s0 < nc; s0 += NB) {
        unsigned w[NB][PER / 2]; float cn[NB], ml[NB], bl[NB];
#pragma unroll
        for (int q = 0; q < NB; ++q) { const int ci = dir ? nc - 1 - (s0 + q) : s0 + q; const size_t sb = (size_t)((ch0 + ci) * 4 + hh) * 2 + dir;
#pragma unroll
            for (int p = 0; p < PER / 2; ++p) w[q][p] = MLC[(sb * 16384 + e0) / 2 + p * NT + tid];
            cn[q] = tid < 128 ? MLN[sb * 128 + tid] : 0.f; ml[q] = MLS[sb * 4 + 0]; bl[q] = MLS[sb * 4 + 1]; }
#pragma unroll
        for (int q = 0; q < NB; ++q) { const int ci = dir ? nc - 1 - (s0 + q) : s0 + q; const size_t sb = (size_t)((ch0 + ci) * 4 + hh) * 2 + dir;
#pragma unroll
            for (int p = 0; p < PER / 2; ++p) CS[(sb * 16384 + e0) / 2 + p * NT + tid] = pk2(c[2 * p], c[2 * p + 1]);
            if (part == 0) { if (tid < 128) NS[sb * 128 + tid] = n; if (tid == 0) MS[sb] = m; }
            const float mn = fmaxf(bl[q] + m, ml[q]), fa = __expf(bl[q] + m - mn), fb = __expf(ml[q] - mn);
#pragma unroll
            for (int p = 0; p < PER / 2; ++p) { c[2 * p] = fa * c[2 * p] + fb * bflo(w[q][p]); c[2 * p + 1] = fa * c[2 * p + 1] + fb * bfhi(w[q][p]); }
            if (tid < 128) n = fa * n + fb * cn[q];
            m = mn; }
    }
    if (!lat) {
#pragma unroll
        for (int i = 0; i < PER; ++i) { const int e = e0 + 2 * ((i >> 1) * NT + tid) + (i & 1), vd = e >> 7, kd = e & 127; a.out[O_MLC + (so * 128 + kd) * 128 + vd] = c[i]; }
        if (tid < 128) a.out[O_MLN + so * 128 + tid] = n; if (tid == 0) a.out[O_MLM + so] = m; }
}
__device__ __forceinline__ void ml_scan_phase(const Args& a, int layer, int tid_, int G) {
    int tid = tid_; asm volatile("" : "+v"(tid));
    for (int task = blockIdx.x; task < 256; task += G) {
        if (task < 128) ml_scan_task<8, 8>(a, layer, tid, 1, task >> 5, (task >> 3) & 3, (task >> 2) & 1, task & 3);
        else { const int t2 = task - 128; ml_scan_task<32, 2>(a, layer, tid, 0, t2 >> 3, (t2 >> 1) & 3, t2 & 1, 0); }
    }
}
__device__ __forceinline__ void ml_out_phase(const Args& a, int layer, LAS unsigned char* lds, int gw, int ngw, int lane_) {
    int lane = lane_; asm volatile("" : "+v"(lane));
    LAS f32x4* stash = (LAS f32x4*)(lds + (size_t)__builtin_amdgcn_readfirstlane((int)(threadIdx.x >> 6)) * 16384) + lane;
    const int fr = lane & 15, fq = lane >> 4;
    const bf16_t* NAT = (const bf16_t*)(a.ws + WS_NAT); const bf16_t* TR = (const bf16_t*)(a.ws + WS_TR); const bf16_t* PROJ = (const bf16_t*)(a.ws + WS_PROJ);
    const bf16_t* CS = (const bf16_t*)(a.ws + WS_MLCS); const float* NS = (const float*)(a.ws + WS_MLNS); const float* MS = (const float*)(a.ws + WS_MLMS);
    bf16_t* BR = (bf16_t*)(a.ws + WS_BR);
    WaveQ Q = waveq_init(a, layer, 4, NCH * 4 * 4, 3, 0);
    for (int it; (it = waveq_next(Q, lane)) >= 0; ) {
        const int mp = it & 3, hh = (it >> 2) & 3, ch = it >> 4; int row0, seq0, L, lat, b, ci, nc; chunk_info(ch, row0, seq0, L, lat, b, ci, nc);
        const int t0 = mp * 32 + fr;
        int qoff = (row0 + t0) * NATP + N_Q + hh * 128 + 8 * fq;
#define MLQ(q, ks) (*(const bf16x8*)(NAT + qoff + (q) * 16 * NATP + 32 * (ks)))
        f32x4 hsum[2][8];
#pragma unroll
        for (int dir = 0; dir < 2; ++dir) {
            const size_t sb = (size_t)(ch * 4 + hh) * 2 + dir;
            const MlGate g = ml_gates(a, layer, row0, hh, dir, lane); const float ms = MS[sb];
            float u0, u1, c0, c1, ai0, ai1;
            if (dir == 0) { u0 = g.ig0 - g.P0; u1 = g.ig1 - g.P1; c0 = g.P0; c1 = g.P1; ai0 = g.P0 + ms; ai1 = g.P1 + ms; }
            else { const float E0 = g.P0 - g.lf0, E1 = g.P1 - g.lf1; u0 = E0 + g.ig0; u1 = E1 + g.ig1; c0 = -E0; c1 = -E1; ai0 = g.tot - E0 + ms; ai1 = g.tot - E1 + ms; }
            float g0 = u0, g1 = u1;
            if (dir == 0) {
#pragma unroll
                for (int o2 = 1; o2 < 64; o2 <<= 1) { const float x0 = __shfl_up(g0, o2), x1 = __shfl_up(g1, o2); if (lane >= o2) { g0 = fmaxf(g0, x0); g1 = fmaxf(g1, x1); } }
                g1 = fmaxf(g1, __shfl(g0, 63));
            } else {
#pragma unroll
                for (int o2 = 1; o2 < 64; o2 <<= 1) { const float x0 = __shfl_down(g0, o2), x1 = __shfl_down(g1, o2); if (lane + o2 < 64) { g0 = fmaxf(g0, x0); g1 = fmaxf(g1, x1); } }
                g0 = fmaxf(g0, __shfl(g1, 0));
            }
            const float mt0 = fmaxf(ai0, c0 + g0), mt1 = fmaxf(ai1, c1 + g1);
            const float w0 = c0 - mt0, w1 = c1 - mt1, si0 = __expf(ai0 - mt0), si1 = __expf(ai1 - mt1), em0 = __expf(-mt0), em1 = __expf(-mt1);
            const bool th = mp >= 2; float wt[2], sit[2], emt[2];
#pragma unroll
            for (int q = 0; q < 2; ++q) { const int tl = (t0 + 16 * q) & 63; wt[q] = th ? __shfl(w1, tl) : __shfl(w0, tl); sit[q] = th ? __shfl(si1, tl) : __shfl(si0, tl); emt[q] = th ? __shfl(em1, tl) : __shfl(em0, tl); }
            f32x4 acc[2][8];
#pragma unroll
            for (int q = 0; q < 2; ++q)
#pragma unroll
                for (int j = 0; j < 8; ++j) acc[q][j] = (f32x4){0.f, 0.f, 0.f, 0.f};
            float qn[2] = {0.f, 0.f};
            asm volatile("" : "+v"(qoff));
#pragma unroll
            for (int ks = 0; ks < 4; ++ks) { const bf16x8 qk[2] = {MLQ(0, ks), MLQ(1, ks)};
#pragma unroll
                for (int j = 0; j < 8; ++j) { const bf16x8 cf = *(const bf16x8*)(CS + sb * 16384 + (size_t)(16 * j + fr) * 128 + 32 * ks + 8 * fq); acc[0][j] = mfma16(cf, qk[0], acc[0][j]); acc[1][j] = mfma16(cf, qk[1], acc[1][j]); }
                const float* nn = NS + sb * 128 + 32 * ks + 8 * fq; const f32x4 n0 = *(const f32x4*)nn, n1 = *(const f32x4*)(nn + 4);
#pragma unroll
                for (int q = 0; q < 2; ++q) { const u32x4 qv = __builtin_bit_cast(u32x4, qk[q]);
                    qn[q] += bflo(qv.x) * n0[0] + bfhi(qv.x) * n0[1] + bflo(qv.y) * n0[2] + bfhi(qv.y) * n0[3] + bflo(qv.z) * n1[0] + bfhi(qv.z) * n1[1] + bflo(qv.w) * n1[2] + bfhi(qv.w) * n1[3]; } }
            float den[2], psum[2];
#pragma unroll
            for (int q = 0; q < 2; ++q) { qn[q] += __shfl_xor(qn[q], 16); qn[q] += __shfl_xor(qn[q], 32);
#pragma unroll
                for (int j = 0; j < 8; ++j) acc[q][j] *= sit[q];
                den[q] = sit[q] * qn[q]; psum[q] = 0.f; }
            const int jlo = dir == 0 ? 0 : mp, jhi = dir == 0 ? mp : 3;
            for (int jp = jlo; jp <= jhi; ++jp) {
                const int ta = 32 * jp + 8 * (fr >> 2) + (fr & 3);
                f32x4 sa[2], sc[2];
#pragma unroll
                for (int q = 0; q < 2; ++q) { sa[q] = (f32x4){0.f, 0.f, 0.f, 0.f}; sc[q] = (f32x4){0.f, 0.f, 0.f, 0.f}; }
                asm volatile("" : "+v"(qoff));
#pragma unroll
                for (int ks = 0; ks < 4; ++ks) {
                    const bf16x8 ka = *(const bf16x8*)(NAT + (size_t)(row0 + ta) * NATP + N_K + hh * 128 + 32 * ks + 8 * fq);
                    const bf16x8 kb = *(const bf16x8*)(NAT + (size_t)(row0 + ta + 4) * NATP + N_K + hh * 128 + 32 * ks + 8 * fq);
                    const bf16x8 q0 = MLQ(0, ks), q1 = MLQ(1, ks);
                    sa[0] = mfma16(ka, q0, sa[0]); sc[0] = mfma16(kb, q0, sc[0]); sa[1] = mfma16(ka, q1, sa[1]); sc[1] = mfma16(kb, q1, sc[1]);
                    if (ks & 1) __builtin_amdgcn_sched_barrier(0); }
                float us0[4], us1[4];
#pragma unroll
                for (int i = 0; i < 4; ++i) { const int s0 = 32 * jp + 8 * fq + i, s1 = s0 + 4;
                    us0[i] = jp < 2 ? __shfl(u0, s0 & 63) : __shfl(u1, s0 & 63); us1[i] = jp < 2 ? __shfl(u0, s1 & 63) : __shfl(u1, s1 & 63); }
                bf16x8 pf[2];
#pragma unroll
                for (int q = 0; q < 2; ++q) { const int t = t0 + 16 * q; float pa[4], pb[4];
#pragma unroll
                    for (int i = 0; i < 4; ++i) { const int s0 = 32 * jp + 8 * fq + i, s1 = s0 + 4;
                        const bool ok0 = dir == 0 ? s0 <= t : s0 >= t, ok1 = dir == 0 ? s1 <= t : s1 >= t;
                        pa[i] = ok0 ? sa[q][i] * __expf(us0[i] + wt[q]) : 0.f; pb[i] = ok1 ? sc[q][i] * __expf(us1[i] + wt[q]) : 0.f;
                        psum[q] += pa[i] + pb[i]; }
                    u32x4 pw; pw.x = pk2(pa[0], pa[1]); pw.y = pk2(pa[2], pa[3]); pw.z = pk2(pb[0], pb[1]); pw.w = pk2(pb[2], pb[3]);
                    pf[q] = __builtin_bit_cast(bf16x8, pw); }
#pragma unroll
                for (int j = 0; j < 8; ++j) { const bf16x8 vf = *(const bf16x8*)(TR + (size_t)(T_MV + hh * 128 + 16 * j + fr) * M + row0 + 32 * jp + 8 * fq); acc[0][j] = mfma16(vf, pf[0], acc[0][j]); acc[1][j] = mfma16(vf, pf[1], acc[1][j]); }
            }
#pragma unroll
            for (int q = 0; q < 2; ++q) { psum[q] += __shfl_xor(psum[q], 16); psum[q] += __shfl_xor(psum[q], 32);
                den[q] += psum[q];
                const float rden = 1.f / fmaxf(fabsf(den[q]), emt[q]);
#pragma unroll
                for (int j = 0; j < 8; ++j) { if (dir == 0) stash[(q * 8 + j) * 64] = acc[q][j] * rden; else hsum[q][j] = stash[(q * 8 + j) * 64] + acc[q][j] * rden; } }
        }
        const float* ng = a.in[38] + layer * 512 + hh * 128;
#pragma unroll
        for (int q = 0; q < 2; ++q) { const int t = t0 + 16 * q; float ss = 0.f;
#pragma unroll
            for (int j = 0; j < 8; ++j) ss += (hsum[q][j][0] * hsum[q][j][0] + hsum[q][j][1] * hsum[q][j][1]) + (hsum[q][j][2] * hsum[q][j][2] + hsum[q][j][3] * hsum[q][j][3]);
            ss += __shfl_xor(ss, 16); ss += __shfl_xor(ss, 32);
            const float r = rsqrtf(ss * (1.f / 128.f) + 1e-6f);
#pragma unroll
            for (int j = 0; j < 8; ++j) { const int vd = 16 * j + 4 * fq; const f32x4 gg = *(const f32x4*)(ng + vd);
                const u32x2 ov = *(const u32x2*)(PROJ + (size_t)(row0 + t) * PJ + P_MO + hh * 128 + vd);
                const float o0 = hsum[q][j][0] * r * gg[0] * fsigm(bflo(ov.x)), o1 = hsum[q][j][1] * r * gg[1] * fsigm(bfhi(ov.x)), o2 = hsum[q][j][2] * r * gg[2] * fsigm(bflo(ov.y)), o3 = hsum[q][j][3] * r * gg[3] * fsigm(bfhi(ov.y));
                u32x2 w; w.x = pk2(o0, o1); w.y = pk2(o2, o3); *(u32x2*)(BR + (size_t)(row0 + t) * D + 1536 + hh * 128 + vd) = w; } }
    }
}
#undef MLQ
}
namespace mk {
constexpr size_t WS_SST = WS_OPT_END;
constexpr size_t WS_SSL = AL(WS_SST + (size_t)NCH * 8 * 2 * 8192 * 4);
constexpr size_t WS_SSCS = AL(WS_SSL + (size_t)NCH * 8 * 2 * 4);
constexpr size_t WS_YPRE = AL(WS_SSCS + (size_t)NCH * 8 * 2 * 8192 * 2);
constexpr size_t WS_SSQ = AL(WS_YPRE + (size_t)M * 512 * 4);
constexpr size_t WS_SSD_END = AL(WS_SSQ + (size_t)M * 8 * 4);

struct SsdGate { float dt0, dt1, la0, la1, P0, P1, tot; };
__device__ __forceinline__ SsdGate ssd_gates(const Args& a, int layer, int row0, int hh, int dir, int lane) {
    const float* SMALL = (const float*)(a.ws + WS_SMALL);
    const float bias = a.in[32][layer * 16 + dir * 8 + hh], A = -__expf(a.in[33][layer * 16 + dir * 8 + hh]);
    SsdGate g;
    const float x0 = SMALL[(size_t)(row0 + lane) * 32 + S_DT + dir * 8 + hh] + bias, x1 = SMALL[(size_t)(row0 + lane + 64) * 32 + S_DT + dir * 8 + hh] + bias;
    g.dt0 = fmaxf(x0, 0.f) + log1pf(__expf(-fabsf(x0))); g.dt1 = fmaxf(x1, 0.f) + log1pf(__expf(-fabsf(x1)));
    g.la0 = g.dt0 * A; g.la1 = g.dt1 * A;
    const float s0 = wave_incl_scan(g.la0, lane); const float t0 = __shfl(s0, 63);
    const float s1 = wave_incl_scan(g.la1, lane) + t0;
    g.P0 = s0; g.P1 = s1; g.tot = __shfl(s1, 63);
    return g;
}
__device__ __forceinline__ void ssd_states_phase(const Args& a, int layer, int tid_, int G) {
    int tid = tid_; asm volatile("" : "+v"(tid));
    const int lane = tid & 63, wave = __builtin_amdgcn_readfirstlane(tid >> 6), fr = lane & 15, fq = lane >> 4;
    const bf16_t* TR = (const bf16_t*)(a.ws + WS_TR); bf16_t* SST = (bf16_t*)(a.ws + WS_SST); float* SSL = (float*)(a.ws + WS_SSL);
    WaveQ Q = waveq_init(a, layer, 2, NCH * 8 * 4, 3, 3072 + 1536 + 768);
    for (int it; (it = waveq_next(Q, lane)) >= 0; ) {
        const int u = it >> 2, wp = it & 3;
        const int ch = u >> 3, hh = u & 7, grp = hh >> 2; int row0, seq0, L, lat, b, ci, nc; chunk_info(ch, row0, seq0, L, lat, b, ci, nc);
#pragma unroll 1
        for (int dir = 0; dir < 2; ++dir) {
            const SsdGate g = ssd_gates(a, layer, row0, hh, dir, lane);
            const float w0 = g.dt0 * __expf(dir == 0 ? g.tot - g.P0 : g.P0 - g.la0), w1 = g.dt1 * __expf(dir == 0 ? g.tot - g.P1 : g.P1 - g.la1);
            f32x4 acc[2][4];
#pragma unroll
            for (int q = 0; q < 2; ++q)
#pragma unroll
                for (int j = 0; j < 4; ++j) acc[q][j] = (f32x4){0.f, 0.f, 0.f, 0.f};
#pragma unroll
            for (int ks = 0; ks < 4; ++ks) {
                float ev[8];
#pragma unroll
                for (int j = 0; j < 8; ++j) { const int tok = 32 * ks + 8 * fq + j; const float y0 = __shfl(w0, tok & 63), y1 = __shfl(w1, tok & 63); ev[j] = tok < 64 ? y0 : y1; }
                bf16x8 bf[2];
#pragma unroll
                for (int q = 0; q < 2; ++q) { const u32x4 bv = *(const u32x4*)(TR + (size_t)(T_B + grp * 128 + wp * 32 + 16 * q + fr) * M + row0 + 32 * ks + 8 * fq);
                    u32x4 bw; bw.x = pk2(bflo(bv.x) * ev[0], bfhi(bv.x) * ev[1]); bw.y = pk2(bflo(bv.y) * ev[2], bfhi(bv.y) * ev[3]); bw.z = pk2(bflo(bv.z) * ev[4], bfhi(bv.z) * ev[5]); bw.w = pk2(bflo(bv.w) * ev[6], bfhi(bv.w) * ev[7]);
                    bf[q] = __builtin_bit_cast(bf16x8, bw); }
#pragma unroll
                for (int j = 0; j < 4; ++j) { const bf16x8 xf = *(const bf16x8*)(TR + (size_t)(T_X + hh * 64 + 16 * j + fr) * M + row0 + 32 * ks + 8 * fq); acc[0][j] = mfma16(bf[0], xf, acc[0][j]); acc[1][j] = mfma16(bf[1], xf, acc[1][j]); }
            }
#pragma unroll
            for (int q = 0; q < 2; ++q) { bf16_t* dst = SST + ((size_t)(ch * 8 + hh) * 2 + dir) * 8192 + (size_t)fr * 128 + wp * 32 + 16 * q + 4 * fq;
#pragma unroll
                for (int j = 0; j < 4; ++j) { u32x2 w; w.x = pk2(acc[q][j][0], acc[q][j][1]); w.y = pk2(acc[q][j][2], acc[q][j][3]); *(u32x2*)(dst + (size_t)(16 * j) * 128) = w; } }
            if (wp == 0 && lane == 0) SSL[(size_t)(ch * 8 + hh) * 2 + dir] = g.tot;
        }
    }
}
template <int PER, int NB>
__device__ __forceinline__ void ssd_scan_task(const Args& a, int layer, int tid, int lat, int b, int hh, int dir, int part) {
    const unsigned* SST = (const unsigned*)(a.ws + WS_SST); const float* SSL = (const float*)(a.ws + WS_SSL); unsigned* CS = (unsigned*)(a.ws + WS_SSCS);
    const int nc = lat ? 16 : 2, ch0 = lat ? 32 + b * 16 : b * 2, e0 = part * PER * NT;
    float c[PER];
    const size_t so = ((((size_t)b * DEPTH + layer) * 2 + dir) * 8 + hh) * 8192;
#pragma unroll
    for (int i = 0; i < PER; ++i) c[i] = lat ? a.in[6][so + e0 + 2 * ((i >> 1) * NT + tid) + (i & 1)] : 0.f;
    for (int s0 = 0; s0 < nc; s0 += NB) {
        unsigned w[NB][PER / 2]; float nt[NB];
#pragma unroll
        for (int q = 0; q < NB; ++q) { const int ci = dir ? nc - 1 - (s0 + q) : s0 + q; const size_t sb = (size_t)((ch0 + ci) * 8 + hh) * 2 + dir;
#pragma unroll
            for (int p = 0; p < PER / 2; ++p) w[q][p] = SST[(sb * 8192 + e0) / 2 + p * NT + tid];
            nt[q] = SSL[sb]; }
#pragma unroll
        for (int q = 0; q < NB; ++q) { const int ci = dir ? nc - 1 - (s0 + q) : s0 + q; const size_t sb = (size_t)((ch0 + ci) * 8 + hh) * 2 + dir;
            const float dec = __expf(nt[q]);
#pragma unroll
            for (int p = 0; p < PER / 2; ++p) { CS[(sb * 8192 + e0) / 2 + p * NT + tid] = pk2(c[2 * p], c[2 * p + 1]); c[2 * p] = dec * c[2 * p] + bflo(w[q][p]); c[2 * p + 1] = dec * c[2 * p + 1] + bfhi(w[q][p]); } }
    }
    if (!lat) {
#pragma unroll
        for (int i = 0; i < PER; ++i) a.out[O_SSD + so + e0 + 2 * ((i >> 1) * NT + tid) + (i & 1)] = c[i]; }
}
__device__ __forceinline__ void ssd_scan_phase(const Args& a, int layer, int tid_, int G) {
    int tid = tid_; asm volatile("" : "+v"(tid));
    for (int task_ = blockIdx.x; task_ < 384; task_ += G) {
        const int task = task_ < 256 ? (task_ + 128) & 255 : task_;
        if (task < 128) ssd_scan_task<8, 8>(a, layer, tid, 1, task >> 5, (task >> 2) & 7, (task >> 1) & 1, task & 1);
        else { const int t2 = task - 128; ssd_scan_task<16, 2>(a, layer, tid, 0, t2 >> 4, (t2 >> 1) & 7, t2 & 1, 0); }
    }
}
__device__ __forceinline__ void ssd_out_phase(const Args& a, int layer, int gw, int ngw, int lane_) {
    int lane = lane_; asm volatile("" : "+v"(lane));
    const int fr = lane & 15, fq = lane >> 4;
    const bf16_t* NAT = (const bf16_t*)(a.ws + WS_NAT); const bf16_t* TR = (const bf16_t*)(a.ws + WS_TR); const bf16_t* PROJ = (const bf16_t*)(a.ws + WS_PROJ);
    const bf16_t* CS = (const bf16_t*)(a.ws + WS_SSCS); float* YPRE = (float*)(a.ws + WS_YPRE); float* SSQ = (float*)(a.ws + WS_SSQ);
    WaveQ Q = waveq_init(a, layer, 5, NCH * 8 * 4, 3, NCH * 4 * 4 + 32 * 48);
    for (int it; (it = waveq_next(Q, lane)) >= 0; ) {
        const int mp = it & 3, hh = (it >> 2) & 7, ch = it >> 5, grp = hh >> 2; int row0, seq0, L, lat, b, ci, nc; chunk_info(ch, row0, seq0, L, lat, b, ci, nc);
        const int t0 = mp * 32 + fr;
        bf16x8 cf[2][4];
#pragma unroll
        for (int q = 0; q < 2; ++q)
#pragma unroll
            for (int ks = 0; ks < 4; ++ks) cf[q][ks] = *(const bf16x8*)(NAT + (size_t)(row0 + t0 + 16 * q) * NATP + N_XBC + 768 + grp * 128 + 32 * ks + 8 * fq);
        f32x4 ysum[2][4];
#pragma unroll
        for (int q = 0; q < 2; ++q)
#pragma unroll
            for (int j = 0; j < 4; ++j) ysum[q][j] = (f32x4){0.f, 0.f, 0.f, 0.f};
#pragma unroll
        for (int dir = 0; dir < 2; ++dir) {
            const size_t sb = (size_t)(ch * 8 + hh) * 2 + dir;
            const SsdGate g = ssd_gates(a, layer, row0, hh, dir, lane);
            float u0, u1, w0, w1, e0, e1;
            if (dir == 0) { u0 = -g.P0; u1 = -g.P1; w0 = g.P0; w1 = g.P1; e0 = __expf(g.P0); e1 = __expf(g.P1); }
            else { const float E0 = g.P0 - g.la0, E1 = g.P1 - g.la1; u0 = E0; u1 = E1; w0 = -E0; w1 = -E1; e0 = __expf(g.tot - E0); e1 = __expf(g.tot - E1); }
            const bool th = mp >= 2; float wt[2], eot[2];
#pragma unroll
            for (int q = 0; q < 2; ++q) { const int tl = (t0 + 16 * q) & 63; wt[q] = th ? __shfl(w1, tl) : __shfl(w0, tl); eot[q] = th ? __shfl(e1, tl) : __shfl(e0, tl); }
            f32x4 acc[2][4];
#pragma unroll
            for (int q = 0; q < 2; ++q)
#pragma unroll
                for (int j = 0; j < 4; ++j) acc[q][j] = (f32x4){0.f, 0.f, 0.f, 0.f};
#pragma unroll
            for (int ks = 0; ks < 4; ++ks)
#pragma unroll
                for (int j = 0; j < 4; ++j) { const bf16x8 sf = *(const bf16x8*)(CS + sb * 8192 + (size_t)(16 * j + fr) * 128 + 32 * ks + 8 * fq); acc[0][j] = mfma16(sf, cf[0][ks], acc[0][j]); acc[1][j] = mfma16(sf, cf[1][ks], acc[1][j]); }
#pragma unroll
            for (int q = 0; q < 2; ++q)
#pragma unroll
                for (int j = 0; j < 4; ++j) acc[q][j] *= eot[q];
            const int jlo = dir == 0 ? 0 : mp, jhi = dir == 0 ? mp : 3;
            for (int jp = jlo; jp <= jhi; ++jp) {
                const int ta = 32 * jp + 8 * (fr >> 2) + (fr & 3);
                f32x4 sa[2], sc[2];
#pragma unroll
                for (int q = 0; q < 2; ++q) { sa[q] = (f32x4){0.f, 0.f, 0.f, 0.f}; sc[q] = (f32x4){0.f, 0.f, 0.f, 0.f}; }
#pragma unroll
                for (int ks = 0; ks < 4; ++ks) {
                    const bf16x8 ba = *(const bf16x8*)(NAT + (size_t)(row0 + ta) * NATP + N_XBC + 512 + grp * 128 + 32 * ks + 8 * fq);
                    const bf16x8 bb = *(const bf16x8*)(NAT + (size_t)(row0 + ta + 4) * NATP + N_XBC + 512 + grp * 128 + 32 * ks + 8 * fq);
                    sa[0] = mfma16(ba, cf[0][ks], sa[0]); sc[0] = mfma16(bb, cf[0][ks], sc[0]); sa[1] = mfma16(ba, cf[1][ks], sa[1]); sc[1] = mfma16(bb, cf[1][ks], sc[1]); }
                float us0[4], us1[4], d0[4], d1[4];
#pragma unroll
                for (int i = 0; i < 4; ++i) { const int s0 = 32 * jp + 8 * fq + i, s1 = s0 + 4;
                    us0[i] = jp < 2 ? __shfl(u0, s0 & 63) : __shfl(u1, s0 & 63); us1[i] = jp < 2 ? __shfl(u0, s1 & 63) : __shfl(u1, s1 & 63);
                    d0[i] = jp < 2 ? __shfl(g.dt0, s0 & 63) : __shfl(g.dt1, s0 & 63); d1[i] = jp < 2 ? __shfl(g.dt0, s1 & 63) : __shfl(g.dt1, s1 & 63); }
                bf16x8 pf[2];
#pragma unroll
                for (int q = 0; q < 2; ++q) { const int t = t0 + 16 * q; float pa[4], pb[4];
#pragma unroll
                    for (int i = 0; i < 4; ++i) { const int s0 = 32 * jp + 8 * fq + i, s1 = s0 + 4;
                        const bool ok0 = dir == 0 ? s0 <= t : s0 >= t, ok1 = dir == 0 ? s1 <= t : s1 >= t;
                        pa[i] = ok0 ? sa[q][i] * d0[i] * __expf(us0[i] + wt[q]) : 0.f; pb[i] = ok1 ? sc[q][i] * d1[i] * __expf(us1[i] + wt[q]) : 0.f; }
                    u32x4 pw; pw.x = pk2(pa[0], pa[1]); pw.y = pk2(pa[2], pa[3]); pw.z = pk2(pb[0], pb[1]); pw.w = pk2(pb[2], pb[3]);
                    pf[q] = __builtin_bit_cast(bf16x8, pw); }
#pragma unroll
                for (int j = 0; j < 4; ++j) { const bf16x8 xf = *(const bf16x8*)(TR + (size_t)(T_X + hh * 64 + 16 * j + fr) * M + row0 + 32 * jp + 8 * fq); acc[0][j] = mfma16(xf, pf[0], acc[0][j]); acc[1][j] = mfma16(xf, pf[1], acc[1][j]); }
            }
#pragma unroll
            for (int q = 0; q < 2; ++q)
#pragma unroll
                for (int j = 0; j < 4; ++j) ysum[q][j] += acc[q][j];
        }
        const float Dh = a.in[34][layer * 8 + hh];
#pragma unroll
        for (int q = 0; q < 2; ++q) { const int t = t0 + 16 * q; float ss = 0.f;
#pragma unroll
            for (int j = 0; j < 4; ++j) { const int p = 16 * j + 4 * fq;
                const u32x2 xv = *(const u32x2*)(NAT + (size_t)(row0 + t) * NATP + N_XBC + hh * 64 + p), zv = *(const u32x2*)(PROJ + (size_t)(row0 + t) * PJ + P_Z + hh * 64 + p);
                f32x4 y; y[0] = (ysum[q][j][0] + bflo(xv.x) * Dh) * fsilu(bflo(zv.x)); y[1] = (ysum[q][j][1] + bfhi(xv.x) * Dh) * fsilu(bfhi(zv.x));
                y[2] = (ysum[q][j][2] + bflo(xv.y) * Dh) * fsilu(bflo(zv.y)); y[3] = (ysum[q][j][3] + bfhi(xv.y) * Dh) * fsilu(bfhi(zv.y));
                ss += (y[0] * y[0] + y[1] * y[1]) + (y[2] * y[2] + y[3] * y[3]);
                { u32x2 yw; yw.x = pk2(y[0], y[1]); yw.y = pk2(y[2], y[3]); *(u32x2*)((bf16_t*)YPRE + (size_t)(row0 + t) * 512 + hh * 64 + p) = yw; } }
            ss += __shfl_xor(ss, 16); ss += __shfl_xor(ss, 32);
            if (fq == 0) SSQ[(size_t)(row0 + t) * 8 + hh] = ss; }
    }
}
__device__ __forceinline__ void ssd_fin_phase(const Args& a, int layer, int gw, int ngw, int lane_) {
    int lane = lane_; asm volatile("" : "+v"(lane));
    const float* YPRE = (const float*)(a.ws + WS_YPRE); const float* SSQ = (const float*)(a.ws + WS_SSQ); bf16_t* BR = (bf16_t*)(a.ws + WS_BR); const float* ng = a.in[35] + layer * 512;
    for (int row = gw; row < M; row += ngw) {
        float s = lane < 8 ? SSQ[(size_t)row * 8 + lane] : 0.f; s += __shfl_xor(s, 1); s += __shfl_xor(s, 2); s += __shfl_xor(s, 4); s = __shfl(s, 0);
        const float r = rsqrtf(s * (1.f / 512.f) + 1e-6f);
        const u32x4 yq = *(const u32x4*)((const bf16_t*)YPRE + (size_t)row * 512 + 8 * lane);
        const f32x4 y0 = (f32x4){bflo(yq.x), bfhi(yq.x), bflo(yq.y), bfhi(yq.y)}, y1 = (f32x4){bflo(yq.z), bfhi(yq.z), bflo(yq.w), bfhi(yq.w)};
        const f32x4 g0 = *(const f32x4*)(ng + 8 * lane), g1 = *(const f32x4*)(ng + 8 * lane + 4);
        *(u32x4*)(BR + (size_t)row * D + 1024 + 8 * lane) = pack8(y0 * r * g0, y1 * r * g1);
    }
}
}
namespace mk {
constexpr size_t WS_CK = WS_SSD_END;
constexpr size_t WS_CVT = AL(WS_CK + (size_t)16 * 512 * 512 * 2);
constexpr size_t WS_ATT_END = AL(WS_CVT + (size_t)16 * 512 * 512 * 2);

__device__ __forceinline__ void prologue_cache(const Args& a, int gw, int ngw, int lane) {
    bf16_t* CK = (bf16_t*)(a.ws + WS_CK); bf16_t* CVT = (bf16_t*)(a.ws + WS_CVT);
    for (size_t i = ((size_t)gw * 64 + lane) * 8; i < (size_t)16 * 512 * 512; i += (size_t)ngw * 64 * 8) {
        const f32x4 x0 = *(const f32x4*)(a.in[2] + i), x1 = *(const f32x4*)(a.in[2] + i + 4); *(u32x4*)(CK + i) = pack8(x0, x1); }
    for (size_t i = (size_t)gw * 64 + lane; i < (size_t)16 * 64 * 512; i += (size_t)ngw * 64) { const int c = i & 511, s8 = (i >> 9) & 63, bl = i >> 15;
        const float* src = a.in[3] + ((size_t)bl * 512 + 8 * s8) * 512 + c;
        u32x4 o; o.x = pk2(src[0], src[512]); o.y = pk2(src[1024], src[1536]); o.z = pk2(src[2048], src[2560]); o.w = pk2(src[3072], src[3584]);
        *(u32x4*)(CVT + ((size_t)bl * 512 + c) * 512 + 8 * s8) = o; }
}
struct AttState { float m, l; f32x4 o[4]; };
struct AttFrags { bf16x8 k[4]; const bf16_t* vt; size_t vp; };
__device__ __forceinline__ void attn_load(AttFrags& f, const bf16_t* kbase, size_t kp, const bf16_t* vt, size_t vp, int fr, int fq) {
    const int ra = 8 * (fr >> 2) + (fr & 3);
#pragma unroll
    for (int ks = 0; ks < 2; ++ks) { f.k[ks] = *(const bf16x8*)(kbase + (size_t)ra * kp + 32 * ks + 8 * fq); f.k[2 + ks] = *(const bf16x8*)(kbase + (size_t)(ra + 4) * kp + 32 * ks + 8 * fq); }
    f.vt = vt + (size_t)fr * vp + 8 * fq; f.vp = vp;
}
template <bool MASKED>
__device__ __forceinline__ void attn_compute(AttState& st, const bf16x8 (&qf)[2], const AttFrags& f, int fq, const float* bias, int kc0, int cq, int cs) {
    bf16x8 vf[4];
#pragma unroll
    for (int j = 0; j < 4; ++j) vf[j] = *(const bf16x8*)(f.vt + (size_t)(16 * j) * f.vp);
    f32x4 sa = (f32x4){0.f, 0.f, 0.f, 0.f}, sb = (f32x4){0.f, 0.f, 0.f, 0.f};
#pragma unroll
    for (int ks = 0; ks < 2; ++ks) { sa = mfma16(f.k[ks], qf[ks], sa); sb = mfma16(f.k[2 + ks], qf[ks], sb); }
    float s[8]; float gm = -1e30f;
#pragma unroll
    for (int i = 0; i < 4; ++i) { s[i] = sa[i]; s[4 + i] = sb[i]; }
    if (MASKED) {
#pragma unroll
        for (int e = 0; e < 8; ++e) { const int kc = kc0 + 8 * fq + e; const bool ok = kc >= cs && kc < cs + 16; const int bi = min(max(kc - cq + 15, 0), 30); s[e] = ok ? s[e] + bias[bi] * 1.44269504f : -1e30f; }
    }
#pragma unroll
    for (int e = 0; e < 8; ++e) gm = fmaxf(gm, s[e]);
    gm = fmaxf(gm, __shfl_xor(gm, 16)); gm = fmaxf(gm, __shfl_xor(gm, 32));
    const float mn = fmaxf(st.m, gm), al = __builtin_amdgcn_exp2f(st.m - mn); st.m = mn;
    float p[8], ps = 0.f;
#pragma unroll
    for (int e = 0; e < 8; ++e) { p[e] = __builtin_amdgcn_exp2f(s[e] - mn); ps += p[e]; }
    st.l = st.l * al + ps;
    u32x4 pw; pw.x = pk2(p[0], p[1]); pw.y = pk2(p[2], p[3]); pw.z = pk2(p[4], p[5]); pw.w = pk2(p[6], p[7]);
    const bf16x8 pf = __builtin_bit_cast(bf16x8, pw);
#pragma unroll
    for (int j = 0; j < 4; ++j) st.o[j] = mfma16(vf[j], pf, st.o[j] * al);
}
__device__ __forceinline__ void attn_compute2(AttState& s0, AttState& s1, const bf16x8 (&q0)[2], const bf16x8 (&q1)[2], const AttFrags& f, int fq) {
    bf16x8 vf[4];
#pragma unroll
    for (int j = 0; j < 4; ++j) vf[j] = *(const bf16x8*)(f.vt + (size_t)(16 * j) * f.vp);
    f32x4 a0 = (f32x4){0.f, 0.f, 0.f, 0.f}, b0 = a0, a1 = a0, b1 = a0;
#pragma unroll
    for (int ks = 0; ks < 2; ++ks) { a0 = mfma16(f.k[ks], q0[ks], a0); b0 = mfma16(f.k[2 + ks], q0[ks], b0); a1 = mfma16(f.k[ks], q1[ks], a1); b1 = mfma16(f.k[2 + ks], q1[ks], b1); }
    float x0[8], x1[8]; float g0 = -1e30f, g1 = -1e30f;
#pragma unroll
    for (int i = 0; i < 4; ++i) { x0[i] = a0[i]; x0[4 + i] = b0[i]; x1[i] = a1[i]; x1[4 + i] = b1[i]; }
#pragma unroll
    for (int e = 0; e < 8; ++e) { g0 = fmaxf(g0, x0[e]); g1 = fmaxf(g1, x1[e]); }
    g0 = fmaxf(g0, __shfl_xor(g0, 16)); g1 = fmaxf(g1, __shfl_xor(g1, 16)); g0 = fmaxf(g0, __shfl_xor(g0, 32)); g1 = fmaxf(g1, __shfl_xor(g1, 32));
    const float m0 = fmaxf(s0.m, g0), al0 = __builtin_amdgcn_exp2f(s0.m - m0), m1 = fmaxf(s1.m, g1), al1 = __builtin_amdgcn_exp2f(s1.m - m1); s0.m = m0; s1.m = m1;
    float p0 = 0.f, p1 = 0.f;
#pragma unroll
    for (int e = 0; e < 8; ++e) { x0[e] = __builtin_amdgcn_exp2f(x0[e] - m0); p0 += x0[e]; x1[e] = __builtin_amdgcn_exp2f(x1[e] - m1); p1 += x1[e]; }
    s0.l = s0.l * al0 + p0; s1.l = s1.l * al1 + p1;
    u32x4 w0, w1; w0.x = pk2(x0[0], x0[1]); w0.y = pk2(x0[2], x0[3]); w0.z = pk2(x0[4], x0[5]); w0.w = pk2(x0[6], x0[7]); w1.x = pk2(x1[0], x1[1]); w1.y = pk2(x1[2], x1[3]); w1.z = pk2(x1[4], x1[5]); w1.w = pk2(x1[6], x1[7]);
    const bf16x8 f0 = __builtin_bit_cast(bf16x8, w0), f1 = __builtin_bit_cast(bf16x8, w1);
#pragma unroll
    for (int j = 0; j < 4; ++j) { s0.o[j] = mfma16(vf[j], f0, s0.o[j] * al0); s1.o[j] = mfma16(vf[j], f1, s1.o[j] * al1); }
}
__device__ __forceinline__ void attn_store(const AttState& st, bf16_t* BR, int qrow, int hh, int fq) {
    float l = st.l; l += __shfl_xor(l, 16); l += __shfl_xor(l, 32);
    const float rl = 1.f / l;
#pragma unroll
    for (int j = 0; j < 4; ++j) { u32x2 w; w.x = pk2(st.o[j][0] * rl, st.o[j][1] * rl); w.y = pk2(st.o[j][2] * rl, st.o[j][3] * rl);
        *(u32x2*)(BR + (size_t)qrow * D + hh * 64 + 16 * j + 4 * fq) = w; }
}
__device__ __forceinline__ void attn_phase(const Args& a, int layer, int gw_, int ngw, int lane_) {
    int lane = lane_, gw = gw_; asm volatile("" : "+v"(lane));
    const int fr = lane & 15, fq = lane >> 4;
    const bf16_t* PROJ = (const bf16_t*)(a.ws + WS_PROJ); const bf16_t* TR = (const bf16_t*)(a.ws + WS_TR); bf16_t* BR = (bf16_t*)(a.ws + WS_BR);
    const bf16_t* CK = (const bf16_t*)(a.ws + WS_CK); const bf16_t* CVT = (const bf16_t*)(a.ws + WS_CVT);
    WaveQ Q = waveq_init(a, layer, 0, 3072, 3);
    for (int it_; (it_ = waveq_next(Q, lane)) >= 0; ) {
        int it;
        { const int blk = (it_ & 2047) >> 3, w = it_ & 7, x = blk & 7, sl = (blk >> 3) * 8 + w;
          it = it_ < 2048 ? (x + 8 * (sl >> 6)) * 64 + (sl & 63) : 2048 + (x + 8 * (sl >> 3)) * 8 + (sl & 7); }
        AttState s0, s1; s0.m = -1e30f; s0.l = 0.f; s1.m = -1e30f; s1.l = 0.f;
#pragma unroll
        for (int j = 0; j < 4; ++j) { s0.o[j] = (f32x4){0.f, 0.f, 0.f, 0.f}; s1.o[j] = (f32x4){0.f, 0.f, 0.f, 0.f}; }
        AttFrags fa, fb; bf16x8 q0[2], q1[2];
        if (it < 2048) {
            const int jp = it & 1, r = (it >> 1) & 31, hh = (it >> 6) & 7, b = it >> 9;
            const int seq0 = MP + b * 2048, qrow = seq0 + r * 64 + 32 * jp + fr;
#pragma unroll
            for (int ks = 0; ks < 2; ++ks) { q0[ks] = *(const bf16x8*)(PROJ + (size_t)qrow * PJ + P_Q + hh * 64 + 32 * ks + 8 * fq); q1[ks] = *(const bf16x8*)(PROJ + (size_t)(qrow + 16) * PJ + P_Q + hh * 64 + 32 * ks + 8 * fq); }
            const int rs = min(max(r - 4, 0), 24);
            const float* rpb = a.in[19] + ((size_t)layer * 8 + hh) * 15 * 31;
            const size_t cb = ((size_t)b * DEPTH + layer) * 512; const bf16_t* kc = CK + cb * 512 + hh * 64; const bf16_t* vc = CVT + (cb + hh * 64) * 512;
#pragma unroll 1
            for (int qt = 0; qt < 2; ++qt) { const int jq = 2 * jp + qt, cq = 16 * jq + fr, cs = min(max(cq - 8, 0), 48), kc0 = jq == 0 ? 0 : (jq == 1 ? 8 : (jq == 2 ? 24 : 32));
                const bf16_t* kw = PROJ + (size_t)(seq0 + rs * 64 + kc0) * PJ + P_K + hh * 64; const bf16_t* vw = TR + (size_t)(T_V + hh * 64) * M + seq0 + rs * 64 + kc0;
                AttState& st = qt == 0 ? s0 : s1; const bf16x8 (&qf)[2] = qt == 0 ? q0 : q1;
                attn_load(fa, kw, PJ, vw, M, fr, fq);
#pragma unroll 1
                for (int j = 0; j < 8; j += 2) {
                    attn_load(fb, kw + (size_t)(j + 1) * 64 * PJ, PJ, vw + (j + 1) * 64, M, fr, fq);
                    attn_compute<true>(st, qf, fa, fq, rpb + (rs + j - r + 7) * 31, kc0, cq, cs);
                    if (j + 2 < 8) attn_load(fa, kw + (size_t)(j + 2) * 64 * PJ, PJ, vw + (j + 2) * 64, M, fr, fq);
                    attn_compute<true>(st, qf, fb, fq, rpb + (rs + j + 1 - r + 7) * 31, kc0, cq, cs);
                }
            }
            attn_load(fa, kc, 512, vc, 512, fr, fq);
#pragma unroll 1
            for (int g = 0; g < 16; g += 2) {
                attn_load(fb, kc + (size_t)(32 * (g + 1)) * 512, 512, vc + 32 * (g + 1), 512, fr, fq);
                attn_compute2(s0, s1, q0, q1, fa, fq);
                if (g + 2 < 16) attn_load(fa, kc + (size_t)(32 * (g + 2)) * 512, 512, vc + 32 * (g + 2), 512, fr, fq);
                attn_compute2(s0, s1, q0, q1, fb, fq);
            }
            attn_store(s0, BR, qrow, hh, fq); attn_store(s1, BR, qrow + 16, hh, fq);
        } else {
            const int i2 = it - 2048, qp = i2 & 7, hh = (i2 >> 3) & 7, b = i2 >> 6, seq0 = b * 256, qrow = seq0 + 32 * qp + fr;
#pragma unroll
            for (int ks = 0; ks < 2; ++ks) { q0[ks] = *(const bf16x8*)(PROJ + (size_t)qrow * PJ + P_Q + hh * 64 + 32 * ks + 8 * fq); q1[ks] = *(const bf16x8*)(PROJ + (size_t)(qrow + 16) * PJ + P_Q + hh * 64 + 32 * ks + 8 * fq); }
            const bf16_t* kp = PROJ + (size_t)seq0 * PJ + P_K + hh * 64; const bf16_t* vp = TR + (size_t)(T_V + hh * 64) * M + seq0;
            attn_load(fa, kp, PJ, vp, M, fr, fq);
#pragma unroll 1
            for (int g = 0; g < 8; g += 2) {
                attn_load(fb, kp + (size_t)(32 * (g + 1)) * PJ, PJ, vp + 32 * (g + 1), M, fr, fq);
                attn_compute2(s0, s1, q0, q1, fa, fq);
                if (g + 2 < 8) attn_load(fa, kp + (size_t)(32 * (g + 2)) * PJ, PJ, vp + 32 * (g + 2), M, fr, fq);
                attn_compute2(s0, s1, q0, q1, fb, fq);
            }
            attn_store(s0, BR, qrow, hh, fq); attn_store(s1, BR, qrow + 16, hh, fq);
        }
    }
}
}
namespace mk {
constexpr int S5K = 768;
constexpr size_t WS_S5W = WS_ATT_END;
constexpr size_t WS_S5WS = AL(WS_S5W + (size_t)DEPTH * 32 * 512 * S5K * 2);
constexpr size_t WS_S5AP = AL(WS_S5WS + (size_t)DEPTH * 32 * 256 * 512 * 2);
constexpr size_t WS_S5UP = AL(WS_S5AP + (size_t)DEPTH * 32 * 2 * 64 * 2 * 4);
constexpr size_t WS_S5SS = AL(WS_S5UP + (size_t)32 * 384 * 512 * 2);
constexpr size_t WS_S5HS = AL(WS_S5SS + (size_t)32 * 384 * 256 * 4);
constexpr size_t WS_S5_END = AL(WS_S5HS + (size_t)32 * 384 * 256 * 2);

__device__ __forceinline__ void s5_param_task(const Args& a, LAS unsigned char* lds, int tid_, int task) {
    int tid = tid_; asm volatile("" : "+v"(tid));
    LAS float* PW = (LAS float*)lds; LAS float* BB = PW + 2 * 33 * 64 * 2; LAS float* CC = BB + 2 * 64 * 16 * 2; LAS float* KT = CC + 2 * 16 * 64 * 2;
    {
        const int layer = task >> 5, g = task & 31;
        const float* a_re = a.in[20] + layer * 4096; const float* a_im = a.in[21] + layer * 4096; const float* log_dt = a.in[22] + layer * 64;
        const float* b_re = a.in[23] + (size_t)layer * 65536; const float* b_im = a.in[24] + (size_t)layer * 65536; const float* c_re = a.in[25] + (size_t)layer * 65536; const float* c_im = a.in[26] + (size_t)layer * 65536;
        const float* s5d = a.in[27] + layer * 512;
        bf16_t* S5W = (bf16_t*)(a.ws + WS_S5W) + (size_t)layer * 32 * 512 * S5K; bf16_t* S5WS = (bf16_t*)(a.ws + WS_S5WS) + (size_t)layer * 32 * 256 * 512; float* S5AP = (float*)(a.ws + WS_S5AP) + (size_t)layer * 32 * 2 * 64 * 2;
        __syncthreads();
        if (tid < 128) { const int dir = tid >> 6, n = tid & 63, pi = (dir * 32 + g) * 64 + n;
            const float are = fminf(a_re[pi], -1e-4f), aim = a_im[pi], dt = expf(log_dt[dir * 32 + g]);
            const float mag = expf(dt * are), abr = mag * cosf(dt * aim), abi = mag * sinf(dt * aim);
            const float den = are * are + aim * aim, nr = abr - 1.f, cfr = (nr * are + abi * aim) / den, cfi = (abi * are - nr * aim) / den;
            float pr = 1.f, pim = 0.f;
            for (int p = 0; p <= 32; ++p) { PW[((dir * 33 + p) * 64 + n) * 2] = pr; PW[((dir * 33 + p) * 64 + n) * 2 + 1] = pim; const float t = pr * abr - pim * abi; pim = pr * abi + pim * abr; pr = t; }
            S5AP[((g * 2 + dir) * 64 + n) * 2] = PW[((dir * 33 + 32) * 64 + n) * 2]; S5AP[((g * 2 + dir) * 64 + n) * 2 + 1] = PW[((dir * 33 + 32) * 64 + n) * 2 + 1];
            for (int k = 0; k < 16; ++k) { const float br_ = b_re[(size_t)pi * 16 + k], bi_ = b_im[(size_t)pi * 16 + k];
                BB[((dir * 64 + n) * 16 + k) * 2] = cfr * br_ - cfi * bi_; BB[((dir * 64 + n) * 16 + k) * 2 + 1] = cfr * bi_ + cfi * br_; }
            for (int j = 0; j < 16; ++j) { CC[((dir * 64 + n) * 16 + j) * 2] = c_re[((size_t)(dir * 32 + g) * 16 + j) * 64 + n]; CC[((dir * 64 + n) * 16 + j) * 2 + 1] = c_im[((size_t)(dir * 32 + g) * 16 + j) * 64 + n]; }
        }
        __syncthreads();
        { const int lane = tid & 63, wave = tid >> 6, r16 = lane & 15, q4 = lane >> 4;
          for (int pt = wave; pt < 64; pt += NWV) { const int dir = pt >> 5, tau = pt & 31; f32x4 acc = (f32x4){0.f, 0.f, 0.f, 0.f};
#pragma unroll 4
            for (int ks = 0; ks < 16; ++ks) { const int n = 4 * ks + q4;
                const float cr = CC[((dir * 64 + n) * 16 + r16) * 2], ci = CC[((dir * 64 + n) * 16 + r16) * 2 + 1], pr = PW[((dir * 33 + tau) * 64 + n) * 2], pim = PW[((dir * 33 + tau) * 64 + n) * 2 + 1];
                const float xr = cr * pr - ci * pim, xi = cr * pim + ci * pr, br_ = BB[((dir * 64 + n) * 16 + r16) * 2], bi_ = BB[((dir * 64 + n) * 16 + r16) * 2 + 1];
                acc = __builtin_amdgcn_mfma_f32_16x16x4f32(xr, br_, acc, 0, 0, 0); acc = __builtin_amdgcn_mfma_f32_16x16x4f32(-xi, bi_, acc, 0, 0, 0); }
#pragma unroll
            for (int i = 0; i < 4; ++i) KT[((dir * 32 + tau) * 16 + r16) * 16 + 4 * q4 + i] = acc[i]; } }
        __syncthreads();
        { const int t = tid >> 4, j = tid & 15; bf16_t* dst = S5W + ((size_t)g * 512 + tid) * S5K;
            for (int s = 0; s < 32; ++s) { float v[16];
#pragma unroll
                for (int k = 0; k < 16; ++k) { float x;
                    if (s < t) x = KT[((0 * 32 + (t - s)) * 16 + k) * 16 + j]; else if (s > t) x = KT[((1 * 32 + (s - t)) * 16 + k) * 16 + j];
                    else x = KT[((0 * 32 + 0) * 16 + k) * 16 + j] + KT[((1 * 32 + 0) * 16 + k) * 16 + j] + (k == j ? s5d[g * 16 + k] : 0.f);
                    v[k] = x; }
                u32x4 o0, o1; o0.x = pk2(v[0], v[1]); o0.y = pk2(v[2], v[3]); o0.z = pk2(v[4], v[5]); o0.w = pk2(v[6], v[7]); o1.x = pk2(v[8], v[9]); o1.y = pk2(v[10], v[11]); o1.z = pk2(v[12], v[13]); o1.w = pk2(v[14], v[15]);
                *(u32x4*)(dst + s * 16) = o0; *(u32x4*)(dst + s * 16 + 8) = o1; }
            for (int dir = 0; dir < 2; ++dir) { const int p = dir == 0 ? t + 1 : 32 - t;
                for (int n8 = 0; n8 < 8; ++n8) { float gr[8], gi[8];
#pragma unroll
                    for (int q = 0; q < 8; ++q) { const int n = n8 * 8 + q; const float cr = CC[((dir * 64 + n) * 16 + j) * 2], ci = CC[((dir * 64 + n) * 16 + j) * 2 + 1], pr = PW[((dir * 33 + p) * 64 + n) * 2], pim = PW[((dir * 33 + p) * 64 + n) * 2 + 1];
                        gr[q] = cr * pr - ci * pim; gi[q] = -(cr * pim + ci * pr); }
                    u32x4 o; o.x = pk2(gr[0], gr[1]); o.y = pk2(gr[2], gr[3]); o.z = pk2(gr[4], gr[5]); o.w = pk2(gr[6], gr[7]); *(u32x4*)(dst + 512 + dir * 128 + n8 * 8) = o;
                    o.x = pk2(gi[0], gi[1]); o.y = pk2(gi[2], gi[3]); o.z = pk2(gi[4], gi[5]); o.w = pk2(gi[6], gi[7]); *(u32x4*)(dst + 512 + dir * 128 + 64 + n8 * 8) = o; } }
        }
        if (tid < 256) { const int dir = tid >> 7, reim = (tid >> 6) & 1, n = tid & 63; bf16_t* dst = S5WS + ((size_t)g * 256 + tid) * 512;
            for (int s = 0; s < 32; ++s) { const int p = dir == 0 ? 31 - s : s; const float pr = PW[((dir * 33 + p) * 64 + n) * 2], pim = PW[((dir * 33 + p) * 64 + n) * 2 + 1]; float v[16];
#pragma unroll
                for (int k = 0; k < 16; ++k) { const float br_ = BB[((dir * 64 + n) * 16 + k) * 2], bi_ = BB[((dir * 64 + n) * 16 + k) * 2 + 1]; v[k] = reim == 0 ? pr * br_ - pim * bi_ : pr * bi_ + pim * br_; }
                u32x4 o0, o1; o0.x = pk2(v[0], v[1]); o0.y = pk2(v[2], v[3]); o0.z = pk2(v[4], v[5]); o0.w = pk2(v[6], v[7]); o1.x = pk2(v[8], v[9]); o1.y = pk2(v[10], v[11]); o1.z = pk2(v[12], v[13]); o1.w = pk2(v[14], v[15]);
                *(u32x4*)(dst + s * 16) = o0; *(u32x4*)(dst + s * 16 + 8) = o1; } }
    }
    __syncthreads();
}
__device__ __forceinline__ void s5_statein_phase(const Args& a, int layer, int gw, int ngw, int lane_) {
    int lane = lane_; asm volatile("" : "+v"(lane));
    const int fr = lane & 15, fq = lane >> 4;
    const bf16_t* UP = (const bf16_t*)(a.ws + WS_S5UP); const bf16_t* S5WS = (const bf16_t*)(a.ws + WS_S5WS) + (size_t)layer * 32 * 256 * 512; float* SS = (float*)(a.ws + WS_S5SS);
    WaveQ Q = waveq_init(a, layer, 3, 32 * 24, 3, 3072 + 1536);
    for (int it; (it = waveq_next(Q, lane)) >= 0; ) {
        const int c_ = it + 4608, blk = (c_ & 2047) >> 3, sl = ((blk - 64) >> 3) * 8 + (c_ & 7);
        const int g = (blk & 7) + 8 * (sl / 24), r = sl % 24, og = r / 6, cq = r % 6;
        f32x4 acc[4][4];
#pragma unroll
        for (int i = 0; i < 4; ++i)
#pragma unroll
            for (int j = 0; j < 4; ++j) acc[i][j] = (f32x4){0.f, 0.f, 0.f, 0.f};
        const bf16_t* ap = S5WS + ((size_t)g * 256 + 64 * og + fr) * 512 + 8 * fq; const bf16_t* bp = UP + ((size_t)g * 384 + 64 * cq + fr) * 512 + 8 * fq;
#pragma unroll 2
        for (int ks = 0; ks < 16; ++ks) { bf16x8 af[4], bf[4];
#pragma unroll
            for (int i = 0; i < 4; ++i) { af[i] = *(const bf16x8*)(ap + (size_t)16 * i * 512 + 32 * ks); bf[i] = *(const bf16x8*)(bp + (size_t)16 * i * 512 + 32 * ks); }
#pragma unroll
            for (int i = 0; i < 4; ++i)
#pragma unroll
                for (int j = 0; j < 4; ++j) acc[i][j] = mfma16(af[i], bf[j], acc[i][j]); }
#pragma unroll
        for (int i = 0; i < 4; ++i)
#pragma unroll
            for (int j = 0; j < 4; ++j) *(f32x4*)(SS + ((size_t)g * 384 + 64 * cq + 16 * j + fr) * 256 + 64 * og + 16 * i + 4 * fq) = acc[i][j];
    }
}
__device__ __forceinline__ void s5_scan_phase(const Args& a, int layer, int gw, int ngw, int lane_) {
    int lane = lane_; asm volatile("" : "+v"(lane));
    const float* SS = (const float*)(a.ws + WS_S5SS); bf16_t* HS = (bf16_t*)(a.ws + WS_S5HS); const float* S5AP = (const float*)(a.ws + WS_S5AP) + (size_t)layer * 32 * 2 * 64 * 2;
    for (int task = gw; task < 1280; task += ngw) {
        int sq, g, dir; if (task < 256) { sq = 16 + (task >> 6); g = (task >> 1) & 31; dir = task & 1; } else { const int t2 = task - 256; sq = t2 >> 6; g = (t2 >> 1) & 31; dir = t2 & 1; }
        const int lat = sq >= 16, b = lat ? sq - 16 : sq, nc = lat ? 64 : 8, cg0 = lat ? 128 + b * 64 : b * 8;
        const float apr = S5AP[((g * 2 + dir) * 64 + lane) * 2], api = S5AP[((g * 2 + dir) * 64 + lane) * 2 + 1];
        float hr = 0.f, hi = 0.f;
        if (lat) { const size_t so = ((((size_t)b * DEPTH + layer) * 2 + dir) * 32 + g) * 64 + lane; hr = a.in[4][so]; hi = a.in[5][so]; }
        for (int s0 = 0; s0 < nc; s0 += 8) {
            float sr[8], si[8];
#pragma unroll
            for (int q = 0; q < 8; ++q) { const int cg = cg0 + (dir ? nc - 1 - (s0 + q) : s0 + q); const size_t base = ((size_t)g * 384 + cg) * 256 + dir * 128; sr[q] = SS[base + lane]; si[q] = SS[base + 64 + lane]; }
#pragma unroll
            for (int q = 0; q < 8; ++q) { const int cg = cg0 + (dir ? nc - 1 - (s0 + q) : s0 + q); const size_t base = ((size_t)g * 384 + cg) * 256 + dir * 128;
                HS[base + lane] = f2bf(hr); HS[base + 64 + lane] = f2bf(hi);
                const float t = apr * hr - api * hi + sr[q]; hi = apr * hi + api * hr + si[q]; hr = t; }
        }
        if (!lat) { const size_t oo = ((((size_t)b * DEPTH + layer) * 2 + dir) * 32 + g) * 64 + lane; a.out[O_S5R + oo] = hr; a.out[O_S5I + oo] = hi; }
    }
}
__device__ __forceinline__ void s5_out_phase(const Args& a, int layer, int gw, int ngw, int lane_) {
    int lane = lane_; asm volatile("" : "+v"(lane));
    const int fr = lane & 15, fq = lane >> 4;
    const bf16_t* UP = (const bf16_t*)(a.ws + WS_S5UP); const bf16_t* S5W = (const bf16_t*)(a.ws + WS_S5W) + (size_t)layer * 32 * 512 * S5K; const bf16_t* HS = (const bf16_t*)(a.ws + WS_S5HS); bf16_t* ZB = (bf16_t*)(a.ws + WS_ZB);
    WaveQ Q = waveq_init(a, layer, 6, 32 * 48, 3, NCH * 4 * 4);
    for (int it; (it = waveq_next(Q, lane)) >= 0; ) {
        const int c_ = it + 1536, blk = (c_ & 2047) >> 3, sl = blk >= 192 ? ((blk - 192) >> 3) * 8 + (c_ & 7) : 64 + (blk >> 3) * 8 + (c_ & 7);
        const int g = (blk & 7) + 8 * (sl / 48), r = sl % 48, og = r / 6, cq = r % 6;
        f32x4 acc[4][4];
#pragma unroll
        for (int i = 0; i < 4; ++i)
#pragma unroll
            for (int j = 0; j < 4; ++j) acc[i][j] = (f32x4){0.f, 0.f, 0.f, 0.f};
        const bf16_t* ap = S5W + ((size_t)g * 512 + 64 * og + fr) * S5K + 8 * fq;
        const bf16_t* bp = UP + ((size_t)g * 384 + 64 * cq + fr) * 512 + 8 * fq; const bf16_t* hp = HS + ((size_t)g * 384 + 64 * cq + fr) * 256 + 8 * fq;
#pragma unroll 2
        for (int ks = 0; ks < 16; ++ks) { bf16x8 af[4], bf[4];
#pragma unroll
            for (int i = 0; i < 4; ++i) { af[i] = *(const bf16x8*)(ap + (size_t)16 * i * S5K + 32 * ks); bf[i] = *(const bf16x8*)(bp + (size_t)16 * i * 512 + 32 * ks); }
#pragma unroll
            for (int i = 0; i < 4; ++i)
#pragma unroll
                for (int j = 0; j < 4; ++j) acc[i][j] = mfma16(af[i], bf[j], acc[i][j]); }
#pragma unroll 2
        for (int ks = 0; ks < 8; ++ks) { bf16x8 af[4], bf[4];
#pragma unroll
            for (int i = 0; i < 4; ++i) { af[i] = *(const bf16x8*)(ap + (size_t)16 * i * S5K + 512 + 32 * ks); bf[i] = *(const bf16x8*)(hp + (size_t)16 * i * 256 + 32 * ks); }
#pragma unroll
            for (int i = 0; i < 4; ++i)
#pragma unroll
                for (int j = 0; j < 4; ++j) acc[i][j] = mfma16(af[i], bf[j], acc[i][j]); }
#pragma unroll
        for (int i = 0; i < 4; ++i)
#pragma unroll
            for (int j = 0; j < 4; ++j) { float z[4];
#pragma unroll
                for (int e = 0; e < 4; ++e) { const float x = acc[i][j][e]; const float th = 0.7978845608028654f * (x + 0.044715f * x * x * x); const float e2 = __expf(2.f * th); const float tnh = 1.f - 2.f * __builtin_amdgcn_rcpf(e2 + 1.f); z[e] = 0.5f * x * (1.f + tnh); }
                u32x2 w; w.x = pk2(z[0], z[1]); w.y = pk2(z[2], z[3]);
                *(u32x2*)(ZB + (size_t)(32 * (64 * cq + 16 * j + fr) + 4 * og + i) * 512 + g * 16 + 4 * fq) = w; }
    }
}
}
namespace mk { static_assert(WS_S5_END < (size_t)1780 * 1024 * 1024, "workspace map exceeds the guaranteed size"); }
namespace mk {
#ifndef PHMASK
#define PHMASK 0xfffff
#endif
#define PHM(k) ((PHMASK >> (k)) & 1)
#ifndef DUPMASK
#define DUPMASK 0
#endif
#define DUP(k) ((DUPMASK >> (k)) & 1)
constexpr int NPH = 12;
constexpr int PH_TOTAL = 2 + DEPTH * NPH;
__global__ void __launch_bounds__(NT, 2) mk_fwd(Args a) {
    extern __shared__ __attribute__((aligned(16))) unsigned char lds_raw[];
    LAS unsigned char* lds = (LAS unsigned char*)lds_raw;
#define TID ((int)threadIdx.x)
#define LANE ((int)(threadIdx.x & 63))
#define WAVE (__builtin_amdgcn_readfirstlane((int)(threadIdx.x >> 6)))
#define GW ((int)blockIdx.x * NWV + WAVE)
    const int G = gridDim.x, ngw = G * NWV;
    volatile LAS unsigned* ctlw = (volatile LAS unsigned*)(lds + LDS_CTL);
    if (TID < 64) ctlw[TID] = 0u;
    __syncthreads();
    XcdBarrier bar = xcd_barrier_post((unsigned*)(a.ws + WS_CTL), ctlw);
    if (TPROBE >= 0 && TID == 0) { const unsigned long long t_ = wall_clock64(); ctlw[16] = (unsigned)t_; ctlw[17] = (unsigned)(t_ >> 32); }
    const int lo = a.ph_lo; int hi = a.ph_hi;
#define IN(k) (lo <= (k) && (k) < hi)
#ifndef TPROBE
#define TPROBE -1
#endif
#define TSTAMP(kind) do { if (TPROBE >= 0 && blockIdx.x == 0 && TID == 0) { const unsigned long long t_ = wall_clock64(); const unsigned long long p_ = ((unsigned long long)ctlw[17] << 32) | ctlw[16]; \
    volatile LAS float* ta_ = (volatile LAS float*)(ctlw + 24); ta_[kind] = ta_[kind] + (float)(t_ - p_); ctlw[16] = (unsigned)t_; ctlw[17] = (unsigned)(t_ >> 32); } } while (0)
#define SEAM(k) do { if (IN(k) && IN((k) + 1)) { xcd_barrier(bar); if (DUP(13)) xcd_barrier(bar); TSTAMP((k) == 0 ? 0 : 1 + ((k) - 1) % NPH); } } while (0)
#define H ((bf16_t*)(a.ws + WS_H))
#define PROJ ((bf16_t*)(a.ws + WS_PROJ))
#define SMALL ((float*)(a.ws + WS_SMALL))
#define BR ((bf16_t*)(a.ws + WS_BR))
#define MERGED ((bf16_t*)(a.ws + WS_MERGED))
#define MACC ((float*)(a.ws + WS_MACC))
#define ZB ((bf16_t*)(a.ws + WS_ZB))
#define HID ((bf16_t*)(a.ws + WS_PROJ))
#define MOD ((const float*)(a.ws + WS_MOD))
#define X (a.out)
    if (PHM(0) && IN(0)) {
        for (int it = GW; it < CM_ITEMS / DEPTH; it += ngw) colmax_item(a, (unsigned*)(a.ws + WS_WSC), it, LANE);
        xcd_barrier(bar);
        for (int rep_ = 0; rep_ < 1 + DUP(17); ++rep_) {
        unsigned* qhead = (unsigned*)(a.ws + WS_CTL) + 8192 + 64 * rep_;
        volatile LAS unsigned* qitem = ctlw + 8;
        for (;;) {
            __syncthreads();
            if (TID == 0) qitem[0] = __hip_atomic_fetch_add(qhead, 1u, __ATOMIC_RELAXED, __HIP_MEMORY_SCOPE_AGENT);
            __syncthreads();
            int item = (int)qitem[0];
            if (item >= DEPTH * 32 + PRO_NADA + PRO_NCACHE) break;
            if (item < DEPTH * 32) { s5_param_task(a, lds, TID, item); continue; } item -= DEPTH * 32;
            if (item < PRO_NADA) { prologue_ada_unit(a, lds, TID, item); continue; } item -= PRO_NADA;
            prologue_cache(a, item * NWV + WAVE, PRO_NCACHE * NWV, LANE);
        }
        }
        conv_pull(a, lds, ctlw + 8, 0, -1);
        if (DUP(20)) conv_pull(a, lds, ctlw + 8, 0, -1, 16);
    }
    SEAM(0);
#ifndef NREP
#define NREP 1
#endif
#ifndef PPASS
#define PPASS 1000
#endif
    for (int rep_ = 0; rep_ < NREP; ++rep_) {
    if (rep_ > 0) xcd_barrier(bar);
    hi = (NREP == 2 && rep_ == 0 && 1 + PPASS < a.ph_hi) ? 1 + PPASS : a.ph_hi;
    for (int l = 0; l < DEPTH; ++l) {
        const int pb = 1 + l * NPH;
#define xp (l == 0 ? a.in[0] : X)
#define xs (l == 0 ? a.in[1] : X + (size_t)MP * D)
#define modl (MOD + (size_t)l * 5 * 6 * D)
#define wl ((const bf16_t*)(a.ws + WS_W) + (size_t)l * W_LAYER)
        if (PHM(1) && IN(pb + 0) && l > 0) conv_pull(a, lds, ctlw + 8, l, -1);
        if (PHM(1) && IN(pb + 0)) for (int r_ = 0; r_ < 1 + DUP(11); ++r_) norm_phase(xp, xs, a.in[14] + l * D, modl, 0, D, H, GW, ngw, LANE, l > 0 ? MACC : nullptr, modl - (size_t)5 * 6 * D, 5 * D, X, xs, a.ws + WS_H8);
        SEAM(pb + 0);
        if (PHM(2) && IN(pb + 1)) {
            { Gemm g{H, wl + W_IN, M, 5888, D, D, 1, 0, 0}; StaticOrder S; S.init(M, 5888, G, blockIdx.x, 1, D);
              EpiInT<false> E{PROJ, SMALL, a.out, a.in[17] + l * 64, a.in[18] + l * 64, l, (bf16_t*)(a.ws + WS_S5UP)}; for (int r_ = 0; r_ < 1 + DUP(18); ++r_) gemm_phase(lds, g, S, E); }
            if (l + 1 < DEPTH && (int)blockIdx.x >= 80) {
                int ln_ = LANE; asm volatile("" : "+v"(ln_));
                for (int it = ((int)blockIdx.x - 80) * NWV + WAVE; it < CM_ITEMS / DEPTH; it += 176 * NWV) colmax_item(a, (unsigned*)(a.ws + WS_WSC), (l + 1) * (CM_ITEMS / DEPTH) + it, ln_);
                conv_pull(a, lds, ctlw + 8, l + 1, 1); } }
        SEAM(pb + 1);
        if (PHM(3) && IN(pb + 2)) { for (int r_ = 0; r_ < 1 + DUP(0); ++r_) { prep_phase(a, l, lds, GW, ngw, WAVE, LANE, (bf16_t*)(a.ws + WS_S5UP)); __syncthreads(); } }
        SEAM(pb + 2);
        if (PHM(4) && IN(pb + 3)) { for (int r_ = 0; r_ < 1 + DUP(2); ++r_) attn_phase(a, l, GW, ngw, LANE); for (int r_ = 0; r_ < 1 + DUP(3); ++r_) { ml_states_phase(a, l, TID, G); ssd_states_phase(a, l, TID, G); s5_statein_phase(a, l, GW, ngw, LANE); } }
        SEAM(pb + 3);
        if (PHM(5) && IN(pb + 4)) { for (int r_ = 0; r_ < 1 + DUP(4); ++r_) { ml_scan_phase(a, l, TID, G); ssd_scan_phase(a, l, TID, G); s5_scan_phase(a, l, GW, ngw, LANE); } }
        SEAM(pb + 4);
        if (PHM(12) && IN(pb + 5)) { for (int r_ = 0; r_ < 1 + DUP(5); ++r_) ml_out_phase(a, l, lds, GW, ngw, LANE); for (int r_ = 0; r_ < 1 + DUP(6); ++r_) ssd_out_phase(a, l, GW, ngw, LANE); for (int r_ = 0; r_ < 1 + DUP(7); ++r_) s5_out_phase(a, l, GW, ngw, LANE); }
        SEAM(pb + 5);
        if (PHM(6) && IN(pb + 6)) {
            { Gemm g8{(const bf16_t*)(a.ws + WS_H8), wl + W_IN8, M, 8192, 1024, 1024, 1, 0, 0}; StaticOrder S; S.init(M, 8192, G, blockIdx.x, 1, 1024);
              EpiInT<true> E{PROJ, SMALL, a.out, a.in[17] + l * 64, a.in[18] + l * 64, l, (bf16_t*)(a.ws + WS_S5UP)}; for (int r_ = 0; r_ < 1 + DUP(9); ++r_) gemm_phase(lds, g8, S, E); }
        }
        if (PHM(6) && IN(pb + 6)) { Gemm g{ZB, wl + W_GLU, M, 512, 512, 512, 1, 0, 0}; StaticOrder S; S.init(M, 512, G, blockIdx.x, 1, 512);
            EpiGlu E{ZB, a.in[29] + l * 512, BR}; for (int r_ = 0; r_ < 1 + DUP(16); ++r_) gemm_phase(lds, g, S, E); for (int r_ = 0; r_ < 1 + DUP(16); ++r_) ssd_fin_phase(a, l, GW, ngw, LANE); }
        SEAM(pb + 6);
        if (PHM(7) && IN(pb + 7)) { Gemm g{BR, wl + W_BR, M, D, 512, D, 4, 512, (size_t)D * 512}; StaticOrder S; S.init(M, D, G, blockIdx.x, 4, 512);
            EpiBranch E{PROJ, MERGED}; for (int r_ = 0; r_ < 1 + DUP(12); ++r_) gemm_phase(lds, g, S, E);
            if (l + 1 < DEPTH && (int)blockIdx.x >= 128) conv_pull(a, lds, ctlw + 8, l + 1, 4); }
        SEAM(pb + 7);
        if (PHM(8) && IN(pb + 8)) { Gemm g{MERGED, wl + W_OUT, M, D, D, D, 1, 0, 0}; SplitOrder S; S.init(blockIdx.x, D);
            EpiResid E{xp, xs, modl, 2 * D, X, MACC}; if (DUP(14)) { EpiResid E2{xp, xs, modl, 2 * D, (float*)(a.ws + WS_PROJ), MACC}; gemm_phase(lds, g, S, E2); } gemm_phase(lds, g, S, E); }
        SEAM(pb + 8);
        if (PHM(9) && IN(pb + 9)) for (int r_ = 0; r_ < 1 + DUP(19); ++r_) norm_phase(X, X + (size_t)MP * D, a.in[15] + l * D, modl, 3 * D, 4 * D, nullptr, GW, ngw, LANE, MACC, modl, 2 * D, X, xs, nullptr, a.ws + WS_H8, (float*)(a.ws + WS_RSC));
        SEAM(pb + 9);
        if (PHM(10) && IN(pb + 10)) { Gemm g{(const bf16_t*)(a.ws + WS_H8), wl + W_1, M, DFF, 1024, 1024, 1, 0, 0}; StaticOrder S; S.init(M, DFF, G, blockIdx.x, 1, 1024);
            EpiRelu2 E{HID, DFF, (const float*)(a.ws + WS_RSC), (const float*)(a.ws + WS_WSC) + (size_t)l * DFF}; for (int r_ = 0; r_ < 1 + DUP(10); ++r_) gemm_phase(lds, g, S, E); }
        SEAM(pb + 10);
        if (PHM(11) && IN(pb + 11)) { Gemm g{HID, wl + W_2, M, D, DFF, DFF, 1, 0, 0, 1}; SplitOrder S; S.init(blockIdx.x, DFF);
            EpiResid E{X, X + (size_t)MP * D, modl, 5 * D, X, MACC}; if (DUP(15)) { EpiResid E2{X, X + (size_t)MP * D, modl, 5 * D, (float*)(a.ws + WS_BR), MACC}; gemm_phase(lds, g, S, E2); } gemm_phase(lds, g, S, E); }
        SEAM(pb + 11);
    }
    if (IN(1 + DEPTH * NPH)) final_fix_phase(MACC, MOD + (size_t)(DEPTH - 1) * 5 * 6 * D, 5 * D, X, GW, ngw, LANE);
    }
    if (TPROBE >= 0) { xcd_barrier(bar); TSTAMP(13); if (blockIdx.x == 0 && TID == 0) { volatile LAS float* ta_ = (volatile LAS float*)(ctlw + 24); float tot_ = 0.f; for (int q_ = 0; q_ < 14; ++q_) tot_ += ta_[q_]; a.out[0] = (TPROBE == 99 ? tot_ : ta_[TPROBE]) * 10.f; } }
#undef IN
#undef SEAM
#undef H
#undef PROJ
#undef SMALL
#undef BR
#undef MERGED
#undef MACC
#undef ZB
#undef HID
#undef MOD
#undef X
#undef xp
#undef xs
#undef modl
#undef wl
}
}
extern "C" void kernel_launch(void* const* d_in, const int* in_sizes, int n_in, void* d_out, int out_size, void* d_ws, size_t ws_size, hipStream_t stream) {
    static int grid = 0;
    if (grid == 0) {
        int dev = 0, cus = 0; (void)hipGetDevice(&dev); (void)hipDeviceGetAttribute(&cus, hipDeviceAttributeMultiprocessorCount, dev);
        (void)hipFuncSetAttribute((const void*)mk::mk_fwd, hipFuncAttributeMaxDynamicSharedMemorySize, mk::LDS_BYTES);
        int per_cu = 0; (void)hipOccupancyMaxActiveBlocksPerMultiprocessor(&per_cu, (const void*)mk::mk_fwd, mk::NT, mk::LDS_BYTES); (void)hipGetLastError();
        (void)cus; grid = 256;
    }
    mk::Args a{}; for (int i = 0; i < 43; ++i) a.in[i] = (const float*)d_in[i];
    a.out = (float*)d_out; a.ws = (unsigned char*)d_ws; a.ph_lo = 0; a.ph_hi = mk::PH_TOTAL;
    (void)hipMemsetAsync(a.ws + mk::WS_CTL, 0, mk::CTL_BYTES, stream);
    hipLaunchKernelGGL(mk::mk_fwd, dim3(grid), dim3(mk::NT), mk::LDS_BYTES, stream, a);
}
```

```cpp
#define SAFE_GEMM 0
#define DUPMASK 0
#define TPROBE -1
#define NREP 1
#define WQMASK 0
#define PPASS 1000
#include <hip/hip_runtime.h>
#include <math.h>
namespace mk {
#define LAS __attribute__((address_space(3)))
typedef unsigned short bf16_t;
typedef short bf16x8 __attribute__((ext_vector_type(8)));
typedef float f32x4 __attribute__((ext_vector_type(4)));
typedef float f32x2 __attribute__((ext_vector_type(2)));
typedef unsigned u32x4 __attribute__((ext_vector_type(4)));
typedef unsigned u32x2 __attribute__((ext_vector_type(2)));
typedef int v4i32 __attribute__((ext_vector_type(4)));
typedef int v8i32 __attribute__((ext_vector_type(8)));
constexpr int NT = 512, NWV = 8;
constexpr int D = 2048, MP = 4096, MLAT = 8192, M = MP + MLAT, DEPTH = 4, DFF = 8192;
constexpr int PJ = 13824;
constexpr int NIN = 14080;
constexpr int P_Q = 0, P_K = 512, P_V = 1024, P_S5U = 1536, P_Z = 2048, P_XBC = 2560, P_MQ = 3584, P_MK = 4096, P_MV = 4608, P_MO = 5120, P_GATE = 5632;
constexpr int S_DT = 0, S_MI = 16, S_MF = 24;

typedef __bf16 bf16x2_t __attribute__((ext_vector_type(2)));
__device__ __forceinline__ unsigned pk2(float lo, float hi) { f32x2 v = {lo, hi}; bf16x2_t b = __builtin_convertvector(v, bf16x2_t); return __builtin_bit_cast(unsigned, b); }
__device__ __forceinline__ float bf2f(bf16_t v) { return __uint_as_float(((unsigned)v) << 16); }
__device__ __forceinline__ float bflo(unsigned w) { return __uint_as_float(w << 16); }
__device__ __forceinline__ float bfhi(unsigned w) { return __uint_as_float(w & 0xffff0000u); }
__device__ __forceinline__ bf16_t f2bf(float f) { return (bf16_t)(pk2(f, 0.f) & 0xffffu); }
__device__ __forceinline__ float fsigm(float x) { return __builtin_amdgcn_rcpf(1.f + __expf(-x)); }
__device__ __forceinline__ float fsilu(float x) { return x * fsigm(x); }
__device__ __forceinline__ int row_cvec(int row) { return row < MP ? 0 : 1 + (row - MP) / 2048; }

constexpr int NT8 = 41, NTB = 14;
__host__ __device__ __forceinline__ int tile_of_i8(int i) { return i < 32 ? 22 + i : (i < 34 ? i - 32 : (i < 36 ? 8 + (i - 34) : (i == 36 ? 13 : (i < 39 ? 14 + (i - 37) : 20 + (i - 39))))); }
__host__ __device__ __forceinline__ int tile_of_bf(int i) { return i < 6 ? 2 + i : (i < 9 ? 10 + (i - 6) : (i < 11 ? 16 + (i - 9) : (i < 13 ? 18 + (i - 11) : 54))); }
__host__ __device__ __forceinline__ int i8_index_of(int T) { return T >= 22 && T < 54 ? T - 22 : (T < 2 ? 32 + T : (T == 8 || T == 9 ? 34 + (T - 8) : (T == 13 ? 36 : (T == 14 || T == 15 ? 37 + (T - 14) : (T == 20 || T == 21 ? 39 + (T - 20) : -1))))); }
__host__ __device__ __forceinline__ int bf_index_of(int T) { return T >= 2 && T < 8 ? T - 2 : (T >= 10 && T < 13 ? 6 + (T - 10) : (T == 16 || T == 17 ? 9 + (T - 16) : (T == 18 || T == 19 ? 11 + (T - 18) : (T == 54 ? 13 : -1)))); }
__host__ __device__ __forceinline__ int win_col(int grp) { const int T = grp >> 3, q8 = grp & 7; int sc = 256 * T + 32 * (2 * (q8 & 3) + (q8 >> 2)); if (T >= 22) sc += 32; else if (T >= 14) sc += 16; return sc; }

#define XB_TMO      128
#define XB_XCNT(j)  (256  + 64 * (j))
#define XB_XSUB(j)  (1280 + 64 * (j))
#define XB_XGEN(j)  (2304 + 64 * (j))
#define XB_TOP      3328
#define XB_TOPGEN   3392
#define XCD_BAR_WORDS 3456
#define XB_SPIN_CAP (1u << 18)
__device__ __forceinline__ unsigned xb_ld(unsigned* p)              { return __hip_atomic_load(p, __ATOMIC_RELAXED, __HIP_MEMORY_SCOPE_AGENT); }
__device__ __forceinline__ unsigned xb_add(unsigned* p, unsigned v) { return __hip_atomic_fetch_add(p, v, __ATOMIC_RELAXED, __HIP_MEMORY_SCOPE_AGENT); }
#define MK_SWAP(op, a, b) asm volatile("s_nop 1\n\t" op " %0, %1\n\ts_nop 1" : "+v"(a), "+v"(b))
__device__ __forceinline__ float xmax16(float x) { float a = x, b = x; MK_SWAP("v_permlane16_swap_b32", a, b); return fmaxf(a, b); }
__device__ __forceinline__ float xmax32(float x) { float a = x, b = x; MK_SWAP("v_permlane32_swap_b32", a, b); return fmaxf(a, b); }
__device__ __forceinline__ float xsum16(float x) { float a = x, b = x; MK_SWAP("v_permlane16_swap_b32", a, b); return a + b; }
__device__ __forceinline__ float xsum32(float x) { float a = x, b = x; MK_SWAP("v_permlane32_swap_b32", a, b); return a + b; }
__device__ __forceinline__ unsigned xb_xcc_id() { return (unsigned)__builtin_amdgcn_s_getreg((3 << 11) | 20) & 0xFu; }
#define XB_SPIN(cond, bar) do { unsigned _sp = 0; while (cond) { __builtin_amdgcn_s_sleep(1); \
    if ((++_sp & 255u) == 0u) { if (xb_ld(&(bar)[XB_TMO])) break; if (_sp > XB_SPIN_CAP) { atomicAdd(&(bar)[XB_TMO], 1u); break; } } } } while (0)
struct XcdBarrier { unsigned* bar; unsigned x; volatile LAS unsigned* st; };
__device__ __forceinline__ XcdBarrier xcd_barrier_post(unsigned* bar, volatile LAS unsigned* st) {
    XcdBarrier b; b.bar = bar; b.x = xb_xcc_id(); b.st = st;
    if (threadIdx.x == 0) (void)xb_add(&bar[XB_XCNT(b.x)], 1u);
    return b;
}
__device__ __forceinline__ void xcd_barrier_complete(unsigned* bar, unsigned x, unsigned& nloc, unsigned& nx) {
    const unsigned G = gridDim.x * gridDim.y * gridDim.z;
    unsigned sum, cnt, mine, sp = 0u;
    for (;;) {
        sum = 0u; cnt = 0u; mine = 0u;
#pragma unroll
        for (unsigned j = 0; j < 16; ++j) { const unsigned c = xb_ld(&bar[XB_XCNT(j)]); sum += c; cnt += (c > 0u) ? 1u : 0u; mine = (j == x) ? c : mine; }
        if (sum == G) break;
        __builtin_amdgcn_s_sleep(1);
        if ((++sp & 255u) == 0u) { if (xb_ld(&bar[XB_TMO])) break; if (sp > XB_SPIN_CAP) { atomicAdd(&bar[XB_TMO], 1u); break; } }
    }
    nloc = mine > 0u ? mine : 1u; nx = cnt > 0u ? cnt : 1u;
}
__device__ __forceinline__ void xcd_barrier(const XcdBarrier& b) {
    asm volatile("s_waitcnt vmcnt(0)" ::: "memory");
    __syncthreads();
    if (threadIdx.x == 0) {
        unsigned* bar = b.bar;
        __builtin_amdgcn_s_waitcnt(0);
        unsigned nloc = b.st[0], nx = b.st[1];
        if (nloc == 0u) { xcd_barrier_complete(bar, b.x, nloc, nx); b.st[0] = nloc; b.st[1] = nx; }
        const unsigned old = xb_add(&bar[XB_XSUB(b.x)], 1u);
        const unsigned gen = old / nloc;
        if (old + 1u == (gen + 1u) * nloc) {
            __builtin_amdgcn_fence(__ATOMIC_RELEASE, "agent");
            asm volatile("s_waitcnt vmcnt(0)" ::: "memory");
            const unsigned og = xb_add(&bar[XB_TOP], 1u);
            const unsigned tg = og / nx;
            if (og + 1u == (tg + 1u) * nx) xb_add(&bar[XB_TOPGEN], 1u);
            else XB_SPIN(xb_ld(&bar[XB_TOPGEN]) == tg, bar);
            __builtin_amdgcn_fence(__ATOMIC_ACQUIRE, "agent");
            xb_add(&bar[XB_XGEN(b.x)], 1u);
            asm volatile("s_waitcnt vmcnt(0)" ::: "memory");
        } else {
            XB_SPIN(xb_ld(&bar[XB_XGEN(b.x)]) == gen, bar);
            __builtin_amdgcn_fence(__ATOMIC_ACQUIRE, "agent");
            asm volatile("s_waitcnt vmcnt(0)" ::: "memory");
        }
    }
    __syncthreads();
}

#ifndef GEMM_SP2
#define GEMM_SP2 1
#endif
#ifndef GEMM_ALIGN
#define GEMM_ALIGN 1
#endif
constexpr int BM = 256, BK = 64, HALF = 128, HTB = HALF * BK * 2, STAGE_BYTES = 8 * HTB, NXCD = 8, WGM = 8;
__host__ __device__ __forceinline__ int lds_byte(int r, int c) { const int st = (r >> 4) * 2 + (c >> 5), rr = r & 15, cc = c & 31, ob = rr * 64 + cc * 2; return st * 1024 + (ob ^ (((ob >> 9) & 1) << 5)); }
__host__ __device__ __forceinline__ void stage_rc(int b, int& R, int& C) { const int st = b / 1024, sb = b % 1024, swz = sb ^ (((sb >> 9) & 1) << 5); R = (st >> 1) * 16 + swz / 64; C = (st & 1) * 32 + (swz % 64) / 2; }
__host__ __device__ __forceinline__ int perm32(int rho) { const int n = rho >> 4, i = rho & 15; return 8 * (i >> 2) + 4 * n + (i & 3); }

struct Unit { int pm, pn, kz, koff, nt; };
struct Gemm { const bf16_t* A; const bf16_t* Bt; int M, N, K, lda, nkz; size_t a_kz, b_kz; int tm = 0; };

struct StaticOrder {
    int nM, nN, nwg, G, c, nkz;
    int ntk;
    __device__ void init(int M_, int N_, int G_, int c_, int nkz_ = 1, int K_ = 0) { nM = M_ / BM; nN = N_ / BM; nwg = nM * nN; G = G_; c = c_; nkz = nkz_; ntk = K_ / BK; }
    __device__ bool next(int i, Unit& u) const {
        const int it = i / nkz; u.kz = i - it * nkz; u.koff = 0; u.nt = ntk;
        const long L = (long)it * G + c; if (L >= nwg) return false;
        int wgid = (int)L; { const int q = nwg / NXCD, r = nwg % NXCD, xcd = wgid % NXCD, off = wgid / NXCD; wgid = (xcd < r ? xcd * (q + 1) : r * (q + 1) + (xcd - r) * q) + off; }
        const int nig = WGM * nN, gid = wgid / nig, fm = gid * WGM, gsz = (nM - fm) < WGM ? (nM - fm) : WGM;
        u.pm = fm + ((wgid % nig) % gsz); u.pn = (wgid % nig) / gsz; return true;
    }
};

struct SplitOrder {
    int c, ntk;
    __device__ void init(int c_, int K_) { c = c_; ntk = K_ / BK; }
    __device__ bool next(int i, Unit& u) const {
        const int xcd = c & 7, idx = c >> 3;
        if (i == 1) { u.pm = xcd * 4 + (idx >> 3); u.pn = idx & 7; u.kz = 0; u.koff = 0; u.nt = ntk; return true; }
        if (i == 0) { const int t = idx >> 1; u.pm = 32 + xcd * 2 + (t >> 3); u.pn = t & 7; u.kz = 0; u.nt = ntk >> 1; u.koff = (idx & 1) * (ntk >> 1) * BK; return true; }
        return false;
    }
};

template <class Epi, class Sched>
__device__ __forceinline__ void gemm_phase(LAS unsigned char* lds, const Gemm g, const Sched& S, const Epi& E) {
    int tid_ = threadIdx.x; asm volatile("" : "+v"(tid_));
    const int tid = tid_, wid = __builtin_amdgcn_readfirstlane(tid >> 6), lane = tid & 63, wr = wid >> 2, wc = wid & 3, fr = lane & 15, fq = lane >> 4;
    const int K = g.K;
    unsigned voffA[2], voffB[2];
#pragma unroll
    for (int i = 0; i < 2; ++i) { int R, C; stage_rc(tid * 16 + i * 8192, R, C); const int Rb = Epi::PERM ? ((R & ~31) + perm32(R & 31)) : R;
        voffA[i] = (unsigned)(R * (g.tm ? BK : g.lda) + C) * 2u; voffB[i] = (unsigned)(Rb * (g.tm ? BK : K) + C) * 2u; }
    const size_t kstep = g.tm ? (size_t)(BM * BK * 2) : (size_t)(BK * 2); const size_t kmul = g.tm ? (size_t)BM : (size_t)1;
    const size_t hstepA = (size_t)HALF * (g.tm ? BK : g.lda) * 2, hstepB = (size_t)HALF * (g.tm ? BK : K) * 2;
    const size_t tstepA = g.tm ? (size_t)K * BM * 2 : 2 * hstepA, tstepB = (size_t)K * BM * 2;
    const unsigned ldsw = (unsigned)wid * 1024u;
    const int aoff = lds_byte(wr * 64 + fr, fq * 8), boff = lds_byte(wc * 32 + fr, fq * 8);
#define PG8_SA(b, h) (((b) * 2 + (h)) * HTB)
#define PG8_SB(b, h) ((4 + (b) * 2 + (h)) * HTB)
#define PG8_STAGE(bufoff, gbase, voff) do { _Pragma("unroll") for (int _i = 0; _i < 2; ++_i) \
        __builtin_amdgcn_global_load_lds((const unsigned*)((const char*)(gbase) + (voff)[_i]), (LAS unsigned*)(lds + (bufoff) + ldsw + _i * 8192), 16, 0, 0); } while (0)
#define PG8_LDA(dst, b, h) do { if constexpr (Epi::MODE == 1) { _Pragma("unroll") for (int m = 0; m < 4; ++m) dst##8[m] = __builtin_shufflevector(*(const LAS v4i32*)(lds + PG8_SA(b, h) + aoff + m * 2048), *(const LAS v4i32*)(lds + PG8_SA(b, h) + aoff + m * 2048 + 1024), 0, 1, 2, 3, 4, 5, 6, 7); } \
        else { _Pragma("unroll") for (int m = 0; m < 4; ++m) _Pragma("unroll") for (int k = 0; k < 2; ++k) dst[m][k] = *(const LAS bf16x8*)(lds + PG8_SA(b, h) + aoff + m * 2048 + k * 1024); } } while (0)
#define PG8_LDB(dst, b, h) do { if constexpr (Epi::MODE == 1) { _Pragma("unroll") for (int n = 0; n < 2; ++n) dst##8[n] = __builtin_shufflevector(*(const LAS v4i32*)(lds + PG8_SB(b, h) + boff + n * 2048), *(const LAS v4i32*)(lds + PG8_SB(b, h) + boff + n * 2048 + 1024), 0, 1, 2, 3, 4, 5, 6, 7); } \
        else { _Pragma("unroll") for (int n = 0; n < 2; ++n) _Pragma("unroll") for (int k = 0; k < 2; ++k) dst[n][k] = *(const LAS bf16x8*)(lds + PG8_SB(b, h) + boff + n * 2048 + k * 1024); } } while (0)
#define PG8_MMA_BF16(ai, bj, At, Bt) do { __builtin_amdgcn_s_setprio(1); _Pragma("unroll") for (int m = 0; m < 4; ++m) _Pragma("unroll") for (int n = 0; n < 2; ++n) _Pragma("unroll") for (int k = 0; k < 2; ++k) \
        acc[ai][bj][m][n] = __builtin_amdgcn_mfma_f32_16x16x32_bf16(Bt[n][k], At[m][k], acc[ai][bj][m][n], 0, 0, 0); __builtin_amdgcn_s_setprio(0); } while (0)
#define PG8_MMA_FP8(ai, bj, At, Bt) do { __builtin_amdgcn_s_setprio(1); _Pragma("unroll") for (int m = 0; m < 4; ++m) _Pragma("unroll") for (int n = 0; n < 2; ++n) \
        asm volatile("v_mfma_scale_f32_16x16x128_f8f6f4 %0, %1, %2, %0, %3, %3 op_sel_hi:[0,0,0]" : "+v"(acc[ai][bj][m][n]) : "v"(Bt##8[n]), "v"(At##8[m]), "v"(f8scale)); __builtin_amdgcn_s_setprio(0); } while (0)
#define PG8_F8_SETTLE() do { if constexpr (Epi::MODE == 1) asm volatile("s_nop 15\n\ts_nop 15" ::: "memory"); } while (0)
#define PG8_MMA_I8(ai, bj, At, Bt) do { __builtin_amdgcn_s_setprio(1); _Pragma("unroll") for (int m = 0; m < 4; ++m) _Pragma("unroll") for (int n = 0; n < 2; ++n) _Pragma("unroll") for (int k = 0; k < 2; ++k) \
        acc[ai][bj][m][n] = __builtin_bit_cast(f32x4, __builtin_amdgcn_mfma_i32_16x16x64_i8(__builtin_bit_cast(v4i32, Bt[n][k]), __builtin_bit_cast(v4i32, At[m][k]), __builtin_bit_cast(v4i32, acc[ai][bj][m][n]), 0, 0, 0)); __builtin_amdgcn_s_setprio(0); } while (0)
#define PG8_MMA(ai, bj, At, Bt) do { if constexpr (Epi::MODE == 1) PG8_MMA_FP8(ai, bj, At, Bt); else if constexpr (Epi::MODE == 2) PG8_MMA_I8(ai, bj, At, Bt); else PG8_MMA_BF16(ai, bj, At, Bt); } while (0)
#if SAFE_GEMM == 1 || SAFE_GEMM == 3
#define PG8_WAIT_V(n) asm volatile("s_waitcnt vmcnt(0)" ::: "memory")
#else
#define PG8_WAIT_V(n) asm volatile("s_waitcnt vmcnt(" #n ")" ::: "memory")
#endif
#define PG8_WAIT_L(n) asm volatile("s_waitcnt lgkmcnt(" #n ")" ::: "memory")
#if SAFE_GEMM == 1
#define PG8_BAR do { asm volatile("s_waitcnt vmcnt(0) lgkmcnt(0)" ::: "memory"); __builtin_amdgcn_s_barrier(); asm volatile("" ::: "memory"); } while (0)
#elif SAFE_GEMM == 2
#define PG8_BAR asm volatile("s_barrier" ::: "memory")
#elif SAFE_GEMM == 4
#define PG8_BAR do { asm volatile("s_waitcnt lgkmcnt(0)" ::: "memory"); __builtin_amdgcn_s_barrier(); } while (0)
#else
#define PG8_BAR __builtin_amdgcn_s_barrier()
#endif
#define PG8_SCHED __builtin_amdgcn_sched_barrier(0)
    Unit cur, nxt; int ui = 0;
    if (!S.next(0, cur)) return;
    f32x4 acc[2][2][4][2];
#pragma unroll
    for (int a = 0; a < 2; ++a)
#pragma unroll
        for (int b = 0; b < 2; ++b)
#pragma unroll
            for (int m = 0; m < 4; ++m)
#pragma unroll
                for (int n = 0; n < 2; ++n) acc[a][b][m][n] = (f32x4){0.f, 0.f, 0.f, 0.f};
    bf16x8 At[4][2], B0[2][2], B1[2][2]; v8i32 At8[4], B08[2], B18[2];
    int f8scale = 0x7f7f7f7f; asm volatile("" : "+v"(f8scale));
    const char* cA = (const char*)(g.A + (size_t)cur.kz * g.a_kz + (size_t)cur.koff * kmul) + (size_t)cur.pm * tstepA; const char* cB = (const char*)(g.Bt + (size_t)cur.kz * g.b_kz + (size_t)cur.koff * kmul) + (size_t)cur.pn * tstepB;
#if GEMM_SP2
    PG8_STAGE(PG8_SB(0, 0), cB, voffB); PG8_STAGE(PG8_SB(0, 1), cB + hstepB, voffB); PG8_STAGE(PG8_SA(0, 0), cA, voffA); PG8_STAGE(PG8_SA(0, 1), cA + hstepA, voffA);
    if (wr == 1) PG8_BAR;
    PG8_WAIT_V(2); PG8_BAR;
    PG8_STAGE(PG8_SB(1, 0), cB + kstep, voffB); PG8_STAGE(PG8_SA(1, 0), cA + kstep, voffA); PG8_STAGE(PG8_SB(1, 1), cB + hstepB + kstep, voffB);
    PG8_WAIT_V(6); PG8_BAR;
#else
    PG8_STAGE(PG8_SB(0, 0), cB, voffB); PG8_STAGE(PG8_SA(0, 0), cA, voffA); PG8_STAGE(PG8_SB(0, 1), cB + hstepB, voffB); PG8_STAGE(PG8_SA(0, 1), cA + hstepA, voffA);
    if (wr == 1) PG8_BAR;
    PG8_WAIT_V(4); PG8_BAR;
    PG8_STAGE(PG8_SB(1, 0), cB + kstep, voffB); PG8_STAGE(PG8_SA(1, 0), cA + kstep, voffA); PG8_STAGE(PG8_SB(1, 1), cB + hstepB + kstep, voffB);
    PG8_WAIT_V(6); PG8_BAR;
#endif
    for (;;) {
        const bool has_next = S.next(ui + 1, nxt);
        const char* nA = has_next ? (const char*)(g.A + (size_t)nxt.kz * g.a_kz + (size_t)nxt.koff * kmul) + (size_t)nxt.pm * tstepA : cA;
        const char* nB = has_next ? (const char*)(g.Bt + (size_t)nxt.kz * g.b_kz + (size_t)nxt.koff * kmul) + (size_t)nxt.pn * tstepB : cB;
        const int nt = cur.nt;
        for (int t = 0; t < nt; t += 2) {
            const bool last = (t == nt - 2);
            const char* a1 = cA + (size_t)(t + 1) * kstep;
            const char* a2 = last ? nA : cA + (size_t)(t + 2) * kstep; const char* b2 = last ? nB : cB + (size_t)(t + 2) * kstep;
            const char* a3 = a2 + kstep; const char* b3 = b2 + kstep;
#if GEMM_SP2
            PG8_LDB(B0, 0, 0); PG8_LDB(B1, 0, 1); PG8_SCHED; PG8_LDA(At, 0, 0); PG8_STAGE(PG8_SA(1, 1), a1 + hstepA, voffA);
            PG8_WAIT_V(8); PG8_WAIT_L(0); PG8_BAR; PG8_MMA(0, 0, At, B0); PG8_MMA(0, 1, At, B1); PG8_BAR; PG8_SCHED;
            PG8_LDA(At, 0, 1); PG8_STAGE(PG8_SB(0, 0), b2, voffB); PG8_STAGE(PG8_SB(0, 1), b2 + hstepB, voffB); PG8_STAGE(PG8_SA(0, 0), a2, voffA);
            PG8_WAIT_V(8); PG8_WAIT_L(0); PG8_BAR; PG8_MMA(1, 0, At, B0); PG8_MMA(1, 1, At, B1); PG8_BAR; PG8_SCHED;
            PG8_LDB(B0, 1, 0); PG8_LDB(B1, 1, 1); PG8_SCHED; PG8_LDA(At, 1, 0); PG8_STAGE(PG8_SA(0, 1), a2 + hstepA, voffA);
            PG8_WAIT_V(8); PG8_WAIT_L(0); PG8_BAR; PG8_MMA(0, 0, At, B0); PG8_MMA(0, 1, At, B1); PG8_BAR; PG8_SCHED;
            PG8_LDA(At, 1, 1); PG8_STAGE(PG8_SB(1, 0), b3, voffB); PG8_STAGE(PG8_SB(1, 1), b3 + hstepB, voffB); PG8_STAGE(PG8_SA(1, 0), a3, voffA);
            PG8_WAIT_V(8); PG8_WAIT_L(0); PG8_BAR; PG8_MMA(1, 0, At, B0); PG8_MMA(1, 1, At, B1); PG8_BAR; PG8_SCHED;
#else
            PG8_LDB(B0, 0, 0); PG8_SCHED; PG8_LDA(At, 0, 0); PG8_STAGE(PG8_SA(1, 1), a1 + hstepA, voffA);
            PG8_WAIT_L(8); PG8_BAR; PG8_WAIT_L(0); PG8_MMA(0, 0, At, B0); PG8_BAR; PG8_SCHED;
            PG8_LDB(B1, 0, 1); PG8_STAGE(PG8_SB(0, 0), b2, voffB);
            PG8_BAR; PG8_WAIT_L(0); PG8_MMA(0, 1, At, B1); PG8_BAR;
            PG8_LDA(At, 0, 1); PG8_STAGE(PG8_SA(0, 0), a2, voffA);
            PG8_BAR; PG8_WAIT_L(0); PG8_MMA(1, 0, At, B0); PG8_BAR; PG8_SCHED;
            PG8_STAGE(PG8_SB(0, 1), b2 + hstepB, voffB);
            PG8_WAIT_V(6); PG8_BAR; PG8_MMA(1, 1, At, B1); PG8_BAR;
            PG8_LDB(B0, 1, 0); PG8_SCHED; PG8_LDA(At, 1, 0); PG8_STAGE(PG8_SA(0, 1), a2 + hstepA, voffA);
            PG8_WAIT_L(8); PG8_BAR; PG8_WAIT_L(0); PG8_MMA(0, 0, At, B0); PG8_BAR; PG8_SCHED;
            PG8_LDB(B1, 1, 1); PG8_STAGE(PG8_SB(1, 0), b3, voffB);
            PG8_BAR; PG8_WAIT_L(0); PG8_MMA(0, 1, At, B1); PG8_BAR;
            PG8_LDA(At, 1, 1); PG8_STAGE(PG8_SA(1, 0), a3, voffA);
            PG8_BAR; PG8_WAIT_L(0); PG8_MMA(1, 0, At, B0); PG8_BAR; PG8_SCHED;
            PG8_STAGE(PG8_SB(1, 1), b3 + hstepB, voffB);
            PG8_WAIT_V(6); PG8_BAR; PG8_MMA(1, 1, At, B1); PG8_BAR;
#endif
        }
        PG8_F8_SETTLE();
#if GEMM_ALIGN
        if (wr == 0) PG8_BAR;
#endif
        E(acc, cur, wr, wc, fr, fq);
        if (!has_next) break;
        if (nxt.kz == 0) {
#pragma unroll
        for (int a = 0; a < 2; ++a)
#pragma unroll
            for (int b = 0; b < 2; ++b)
#pragma unroll
                for (int m = 0; m < 4; ++m)
#pragma unroll
                    for (int n = 0; n < 2; ++n) acc[a][b][m][n] = (f32x4){0.f, 0.f, 0.f, 0.f};
        }
        cur = nxt; cA = nA; cB = nB; ++ui;
#if GEMM_ALIGN
        if (wr == 1) PG8_BAR;
#endif
    }
    PG8_WAIT_V(0);
#if !GEMM_ALIGN
    if (wr == 0) PG8_BAR;
#endif
    PG8_BAR;
#undef PG8_SA
#undef PG8_SB
#undef PG8_STAGE
#undef PG8_LDA
#undef PG8_LDB
#undef PG8_MMA
#undef PG8_MMA_BF16
#undef PG8_MMA_FP8
#undef PG8_MMA_I8
#undef PG8_F8_SETTLE
#undef PG8_WAIT_V
#undef PG8_WAIT_L
#undef PG8_BAR
#undef PG8_SCHED
}
}
namespace mk {
constexpr size_t O_YP = 0, O_YS = 8388608, O_NK = 25165824, O_NV = 33554432, O_S5R = 41943040, O_S5I = 42205184, O_SSD = 42467328,
                 O_MLC = 50855936, O_MLN = 59244544, O_MLM = 59310080;

__device__ __forceinline__ u32x4 pack8(const f32x4 a, const f32x4 b) { u32x4 w; w.x = pk2(a[0], a[1]); w.y = pk2(a[2], a[3]); w.z = pk2(b[0], b[1]); w.w = pk2(b[2], b[3]); return w; }

template <bool F8> struct EpiInT {
    static constexpr bool PERM = true; static constexpr int MODE = F8 ? 1 : 0;
    bf16_t* proj; float* small; float* out; const float* qg; const float* kg; int layer; bf16_t* up;
    __device__ __forceinline__ void operator()(f32x4 (&acc)[2][2][4][2], const Unit& u, int wr, int wc, int fr, int fq) const {
        const int T = F8 ? 22 + u.pn : (u.pn == 22 ? 54 : u.pn), rowb = u.pm * BM + wr * 64 + fr;
        if (T == 54) {
            if (wc == 0) {
#pragma unroll
                for (int ai = 0; ai < 2; ++ai)
#pragma unroll
                    for (int m = 0; m < 4; ++m) { float* sp = small + (size_t)(rowb + ai * HALF + m * 16) * 32 + 8 * fq; *(f32x4*)sp = acc[ai][0][m][0]; *(f32x4*)(sp + 4) = acc[ai][0][m][1]; }
            }
            return;
        }
        const int colb = T * 256 + 64 * wc + 8 * fq;
        if (T < 4) {
            const float* g = T < 2 ? qg : kg;
            f32x4 gv[2][2];
#pragma unroll
            for (int bj = 0; bj < 2; ++bj)
#pragma unroll
                for (int n = 0; n < 2; ++n) gv[bj][n] = *(const f32x4*)(g + 32 * bj + 8 * fq + 4 * n);
#pragma unroll
            for (int ai = 0; ai < 2; ++ai)
#pragma unroll
                for (int m = 0; m < 4; ++m) {
                    float ss = 0.f;
#pragma unroll
                    for (int bj = 0; bj < 2; ++bj)
#pragma unroll
                        for (int n = 0; n < 2; ++n) { const f32x4 x = acc[ai][bj][m][n]; ss += (x[0] * x[0] + x[1] * x[1]) + (x[2] * x[2] + x[3] * x[3]); }
                    ss += __shfl_xor(ss, 16); ss += __shfl_xor(ss, 32);
                    const float r = rsqrtf(ss * (1.f / 64.f) + 1e-6f) * (T < 2 ? 0.18033688f : 1.f);
                    const int row = rowb + ai * HALF + m * 16;
#pragma unroll
                    for (int bj = 0; bj < 2; ++bj) { const f32x4 v0 = acc[ai][bj][m][0] * r * gv[bj][0], v1 = acc[ai][bj][m][1] * r * gv[bj][1];
                        *(u32x4*)(proj + (size_t)row * PJ + colb + 32 * bj) = pack8(v0, v1);
                        if (T >= 2 && row < MP) { float* o = out + O_NK + ((size_t)((row >> 8) * DEPTH + layer) * 256 + (row & 255)) * 512 + (colb - 512) + 32 * bj; *(f32x4*)o = v0; *(f32x4*)(o + 4) = v1; } }
                }
        } else if (T < 6) {
#pragma unroll
            for (int ai = 0; ai < 2; ++ai)
#pragma unroll
                for (int m = 0; m < 4; ++m) { const int row = rowb + ai * HALF + m * 16;
#pragma unroll
                    for (int bj = 0; bj < 2; ++bj) { const f32x4 v0 = acc[ai][bj][m][0], v1 = acc[ai][bj][m][1];
                        *(u32x4*)(proj + (size_t)row * PJ + colb + 32 * bj) = pack8(v0, v1);
                        if (row < MP) { float* o = out + O_NV + ((size_t)((row >> 8) * DEPTH + layer) * 256 + (row & 255)) * 512 + (colb - 1024) + 32 * bj; *(f32x4*)o = v0; *(f32x4*)(o + 4) = v1; } } }
        } else if (T < 22) {
#pragma unroll
            for (int ai = 0; ai < 2; ++ai)
#pragma unroll
                for (int m = 0; m < 4; ++m) { const int row = rowb + ai * HALF + m * 16;
#pragma unroll
                    for (int bj = 0; bj < 2; ++bj) {
                        if (T == 6 || T == 7) { const int cu = colb + 32 * bj - P_S5U;
                            *(u32x4*)(up + ((size_t)(cu >> 4) * 384 + (row >> 5)) * 512 + (row & 31) * 16 + (cu & 15)) = pack8(acc[ai][bj][m][0], acc[ai][bj][m][1]); }
                        else *(u32x4*)(proj + (size_t)row * PJ + colb + 32 * bj) = pack8(acc[ai][bj][m][0], acc[ai][bj][m][1]); } }
        } else {
#pragma unroll
            for (int ai = 0; ai < 2; ++ai)
#pragma unroll
                for (int m = 0; m < 4; ++m) { const int row = rowb + ai * HALF + m * 16;
#pragma unroll
                    for (int bj = 0; bj < 2; ++bj) { f32x4 v0 = acc[ai][bj][m][0], v1 = acc[ai][bj][m][1];
#pragma unroll
                        for (int j = 0; j < 4; ++j) { v0[j] = fsigm(v0[j]); v1[j] = fsigm(v1[j]); }
                        unsigned w0 = 0u, w1 = 0u;
                        w0 = __builtin_amdgcn_cvt_pk_u8_f32(fmaxf(v0[0] * 255.f + 0.5f, 1.f), 0, w0); w0 = __builtin_amdgcn_cvt_pk_u8_f32(fmaxf(v0[1] * 255.f + 0.5f, 1.f), 1, w0);
                        w0 = __builtin_amdgcn_cvt_pk_u8_f32(fmaxf(v0[2] * 255.f + 0.5f, 1.f), 2, w0); w0 = __builtin_amdgcn_cvt_pk_u8_f32(fmaxf(v0[3] * 255.f + 0.5f, 1.f), 3, w0);
                        w1 = __builtin_amdgcn_cvt_pk_u8_f32(fmaxf(v1[0] * 255.f + 0.5f, 1.f), 0, w1); w1 = __builtin_amdgcn_cvt_pk_u8_f32(fmaxf(v1[1] * 255.f + 0.5f, 1.f), 1, w1);
                        w1 = __builtin_amdgcn_cvt_pk_u8_f32(fmaxf(v1[2] * 255.f + 0.5f, 1.f), 2, w1); w1 = __builtin_amdgcn_cvt_pk_u8_f32(fmaxf(v1[3] * 255.f + 0.5f, 1.f), 3, w1);
                        u32x2 o8; o8.x = w0; o8.y = w1; *(u32x2*)((unsigned char*)(proj + (size_t)row * PJ + P_GATE) + (colb - P_GATE) + 32 * bj) = o8; } }
        }
    }
};
struct EpiRelu2 {
    static constexpr bool PERM = true; static constexpr int MODE = 2;
    bf16_t* O; int ldo; const float* rsc; const float* cmx;
    __device__ __forceinline__ void operator()(f32x4 (&acc)[2][2][4][2], const Unit& u, int wr, int wc, int fr, int fq) const {
        const int rowb = u.pm * BM + wr * 64 + fr, colb = u.pn * 256 + 64 * wc + 8 * fq;
        {   f32x4 cs[2][2];
#pragma unroll
            for (int bj = 0; bj < 2; ++bj)
#pragma unroll
                for (int n = 0; n < 2; ++n) cs[bj][n] = *(const f32x4*)(cmx + u.pn * 256 + 128 * bj + 32 * wc + 8 * fq + 4 * n) * (1.f / 127.f);
#pragma unroll
            for (int ai = 0; ai < 2; ++ai)
#pragma unroll
                for (int m = 0; m < 4; ++m) { const float rs = rsc[rowb + ai * HALF + m * 16];
#pragma unroll
                    for (int bj = 0; bj < 2; ++bj)
#pragma unroll
                        for (int n = 0; n < 2; ++n) { const v4i32 iv = __builtin_bit_cast(v4i32, acc[ai][bj][m][n]); f32x4 fv; fv[0] = (float)iv[0]; fv[1] = (float)iv[1]; fv[2] = (float)iv[2]; fv[3] = (float)iv[3];
                            acc[ai][bj][m][n] = fv * cs[bj][n] * rs; } }
        }
#pragma unroll
        for (int ai = 0; ai < 2; ++ai)
#pragma unroll
            for (int m = 0; m < 4; ++m) { const int row = rowb + ai * HALF + m * 16;
#pragma unroll
                for (int bj = 0; bj < 2; ++bj) { f32x4 v0 = acc[ai][bj][m][0], v1 = acc[ai][bj][m][1];
#pragma unroll
                    for (int j = 0; j < 4; ++j) { const float a = fmaxf(v0[j], 0.f), b = fmaxf(v1[j], 0.f); v0[j] = a * a; v1[j] = b * b; }
                    { const int col = colb + 32 * bj;
                        *(u32x4*)(O + (((size_t)(row >> 8) * (ldo >> 6) + (col >> 6)) * 256 + (row & 255)) * 64 + (col & 63)) = pack8(v0, v1); } } }
    }
};
struct EpiGlu {
    static constexpr bool PERM = true; static constexpr int MODE = 0;
    const bf16_t* Z; const float* bias; bf16_t* br;
    __device__ __forceinline__ void operator()(f32x4 (&acc)[2][2][4][2], const Unit& u, int wr, int wc, int fr, int fq) const {
        const int rowb = u.pm * BM + wr * 64 + fr, colb = u.pn * 256 + 64 * wc + 8 * fq;
#pragma unroll
        for (int bj = 0; bj < 2; ++bj) { const int c = colb + 32 * bj; const f32x4 b0 = *(const f32x4*)(bias + c), b1 = *(const f32x4*)(bias + c + 4);
#pragma unroll
            for (int ai = 0; ai < 2; ++ai)
#pragma unroll
                for (int m = 0; m < 4; ++m) { const int row = rowb + ai * HALF + m * 16;
                    const u32x4 zz = *(const u32x4*)(Z + (size_t)row * 512 + c);
                    f32x4 v0 = acc[ai][bj][m][0] + b0, v1 = acc[ai][bj][m][1] + b1;
                    v0[0] = bflo(zz.x) * fsigm(v0[0]); v0[1] = bfhi(zz.x) * fsigm(v0[1]); v0[2] = bflo(zz.y) * fsigm(v0[2]); v0[3] = bfhi(zz.y) * fsigm(v0[3]);
                    v1[0] = bflo(zz.z) * fsigm(v1[0]); v1[1] = bfhi(zz.z) * fsigm(v1[1]); v1[2] = bflo(zz.w) * fsigm(v1[2]); v1[3] = bfhi(zz.w) * fsigm(v1[3]);
                    *(u32x4*)(br + (size_t)row * D + 512 + c) = pack8(v0, v1); } }
    }
};
struct EpiBranch {
    static constexpr bool PERM = true; static constexpr int MODE = 0;
    const bf16_t* proj; bf16_t* merged;
    __device__ __forceinline__ void operator()(f32x4 (&acc)[2][2][4][2], const Unit& u, int wr, int wc, int fr, int fq) const {
        const int rowb = u.pm * BM + wr * 64 + fr, colb = u.pn * 256 + 64 * wc + 8 * fq, kz = u.kz;
#pragma unroll
        for (int ai = 0; ai < 2; ++ai)
#pragma unroll
            for (int m = 0; m < 4; ++m) { const int row = rowb + ai * HALF + m * 16;
#pragma unroll
                for (int bj = 0; bj < 2; ++bj) { const int c = colb + 32 * bj;
                    const unsigned char* gp = (const unsigned char*)(proj + (size_t)row * PJ + P_GATE) + kz * D + c;
                    const u32x2 gg = *(const u32x2*)gp;
                    float g[8] = {(float)(gg.x & 0xffu) - 0.5f, (float)((gg.x >> 8) & 0xffu) - 0.5f, (float)((gg.x >> 16) & 0xffu) - 0.5f, (float)(gg.x >> 24) - 0.5f,
                                  (float)(gg.y & 0xffu) - 0.5f, (float)((gg.y >> 8) & 0xffu) - 0.5f, (float)((gg.y >> 16) & 0xffu) - 0.5f, (float)(gg.y >> 24) - 0.5f};
                    if (kz < 3) { const u32x2 hh = *(const u32x2*)(gp + D);
                        const float h[8] = {(float)(hh.x & 0xffu) - 0.5f, (float)((hh.x >> 8) & 0xffu) - 0.5f, (float)((hh.x >> 16) & 0xffu) - 0.5f, (float)(hh.x >> 24) - 0.5f,
                                            (float)(hh.y & 0xffu) - 0.5f, (float)((hh.y >> 8) & 0xffu) - 0.5f, (float)((hh.y >> 16) & 0xffu) - 0.5f, (float)(hh.y >> 24) - 0.5f};
#pragma unroll
                        for (int j = 0; j < 8; ++j) g[j] = g[j] * __builtin_amdgcn_rcpf(h[j]); }
                    else {
#pragma unroll
                        for (int j = 0; j < 8; ++j) g[j] *= (1.f / 255.f); }
                    f32x4& v0 = acc[ai][bj][m][0]; f32x4& v1 = acc[ai][bj][m][1];
                    v0[0] *= g[0]; v0[1] *= g[1]; v0[2] *= g[2]; v0[3] *= g[3]; v1[0] *= g[4]; v1[1] *= g[5]; v1[2] *= g[6]; v1[3] *= g[7];
                    if (kz == 3) *(u32x4*)(merged + (size_t)row * D + c) = pack8(v0, v1); } }
    }
};
struct EpiResid {
    static constexpr bool PERM = false; static constexpr int MODE = 0;
    const float* xp; const float* xs; const float* modl; int g_off; float* xout; float* part;
    __device__ __forceinline__ void operator()(f32x4 (&acc)[2][2][4][2], const Unit& u, int wr, int wc, int fr, int fq) const {
        if (part != nullptr && u.pm >= 32) {
            bf16_t* P = (bf16_t*)part + (size_t)((((u.pm - 32) * 8 + u.pn) * 2) + (u.koff != 0)) * 65536 + (size_t)(wr * 64 + fr) * 256 + wc * 32 + 4 * fq;
#pragma unroll
            for (int ai = 0; ai < 2; ++ai)
#pragma unroll
                for (int m = 0; m < 4; ++m)
#pragma unroll
                    for (int bj = 0; bj < 2; ++bj)
#pragma unroll
                        for (int n = 0; n < 2; ++n) { const f32x4 t = acc[ai][bj][m][n]; u32x2 w; w.x = pk2(t[0], t[1]); w.y = pk2(t[2], t[3]); *(u32x2*)(P + (size_t)(ai * HALF + m * 16) * 256 + bj * HALF + n * 16) = w; }
            return;
        }
        const int row0 = u.pm * BM, rowb = row0 + wr * 64 + fr, colb = u.pn * 256 + wc * 32 + 4 * fq;
        const float* xin = row0 < MP ? xp : xs - (size_t)MP * D;
        const float* gate = modl + (size_t)row_cvec(row0) * 6 * D + g_off;
        f32x4 gv[2][2];
#pragma unroll
        for (int bj = 0; bj < 2; ++bj)
#pragma unroll
            for (int n = 0; n < 2; ++n) gv[bj][n] = *(const f32x4*)(gate + colb + bj * HALF + n * 16);
#pragma unroll
        for (int ai = 0; ai < 2; ++ai)
#pragma unroll
            for (int m = 0; m < 4; ++m) { const size_t ro = (size_t)(rowb + ai * HALF + m * 16) * D + colb;
#pragma unroll
                for (int bj = 0; bj < 2; ++bj)
#pragma unroll
                    for (int n = 0; n < 2; ++n) { const size_t o = ro + bj * HALF + n * 16; *(f32x4*)(xout + o) = *(const f32x4*)(xin + o) + gv[bj][n] * acc[ai][bj][m][n]; } }
    }
};
}
namespace mk {
constexpr size_t AL(size_t x) { return (x + 255) & ~(size_t)255; }
constexpr size_t WS_CTL = 0, CTL_BYTES = 36864 + DEPTH * 8192 * 4;
constexpr size_t WS_MOD = WS_CTL + CTL_BYTES;
constexpr size_t WS_W = AL(WS_MOD + (size_t)DEPTH * 5 * 6 * D * 4);
constexpr int NTB_ROWS = 14 * 256, NT8_ROWS = 41 * 256;
constexpr size_t W_IN = 0, W_GLU = W_IN + (size_t)NIN * D, W_BR = W_GLU + 512 * 512, W_OUT = W_BR + (size_t)4 * D * 512, W_1 = W_OUT + (size_t)D * D, W_2 = W_1 + (size_t)DFF * D,
                 W_LAYER = W_2 + (size_t)D * DFF;
constexpr size_t W_IN8 = (size_t)5888 * D;
constexpr size_t WS_H = AL(WS_W + W_LAYER * 2 * DEPTH);
constexpr size_t WS_PROJ = AL(WS_H + (size_t)M * D * 2);
constexpr size_t WS_SMALL = AL(WS_PROJ + (size_t)M * PJ * 2);
constexpr size_t WS_BR = AL(WS_SMALL + (size_t)M * 32 * 4);
constexpr size_t WS_MERGED = AL(WS_BR + (size_t)M * D * 2);
constexpr size_t WS_MACC = AL(WS_MERGED + (size_t)M * D * 2);
constexpr size_t WS_ZB = AL(WS_MACC + (size_t)M * D * 4);
constexpr size_t WS_H8 = AL(WS_ZB + (size_t)M * 512 * 2);
constexpr size_t WS_RSC = AL(WS_H8 + (size_t)M * D);
constexpr size_t WS_WSC = WS_CTL + 36864;
constexpr size_t WS_SCR = AL(WS_RSC + (size_t)M * 4);
constexpr int LDS_BYTES = 140 * 1024, LDS_CTL = LDS_BYTES - 256;

struct Args { const float* in[43]; float* out; unsigned char* ws; int ph_lo, ph_hi; };

__device__ __forceinline__ float wave_sum(float v) {
#pragma unroll
    for (int o = 1; o < 64; o <<= 1) v += __shfl_xor(v, o);
    return v;
}
#define LDS_WAIT() asm volatile("s_waitcnt lgkmcnt(0)" ::: "memory")

__device__ __forceinline__ void xpose_item(const float* W, int ldw, int k0, int sc, bf16_t* dst, int K, LAS float* scr, int lane, int mode, bool f8 = false, const float* cmax = nullptr, int kd = -1) {
    const int n4 = (lane & 7) * 4;
    const int col = mode == 1 ? (n4 < 16 ? 3584 + n4 : 5648 + (n4 - 16)) : sc + n4;
#pragma unroll
    for (int i = 0; i < 8; ++i) { const int kk = (lane >> 3) + 8 * i; f32x4 v = (f32x4){0.f, 0.f, 0.f, 0.f}; if (mode != 2) v = *(const f32x4*)(W + (size_t)(k0 + kk) * ldw + col);
        if (cmax != nullptr) { const f32x4 cm = *(const f32x4*)(cmax + n4);
#pragma unroll
            for (int e = 0; e < 4; ++e) v[e] = rintf(v[e] * (cm[e] > 0.f ? 127.f / cm[e] : 0.f)); }
        scr[kk * 33 + n4] = v[0]; scr[kk * 33 + n4 + 1] = v[1]; scr[kk * 33 + n4 + 2] = v[2]; scr[kk * 33 + n4 + 3] = v[3]; }
    LDS_WAIT(); asm volatile("" ::: "memory");
    const int c = lane & 7;
#pragma unroll
    for (int jj = 0; jj < 4; ++jj) { const int n = (lane >> 3) + 8 * jj; const LAS float* s = scr + (8 * c) * 33 + n;
        if (cmax != nullptr) { const unsigned w0 = ((unsigned)(int)s[0 * 33] & 0xffu) | (((unsigned)(int)s[1 * 33] & 0xffu) << 8) | (((unsigned)(int)s[2 * 33] & 0xffu) << 16) | (((unsigned)(int)s[3 * 33] & 0xffu) << 24);
            const unsigned w1 = ((unsigned)(int)s[4 * 33] & 0xffu) | (((unsigned)(int)s[5 * 33] & 0xffu) << 8) | (((unsigned)(int)s[6 * 33] & 0xffu) << 16) | (((unsigned)(int)s[7 * 33] & 0xffu) << 24);
            u32x2 o8; o8.x = w0; o8.y = w1; *(u32x2*)((unsigned char*)dst + (size_t)n * K + k0 + 8 * c) = o8; }
        else if (f8) { unsigned w0 = 0u, w1 = 0u; w0 = __builtin_amdgcn_cvt_pk_fp8_f32(s[0 * 33], s[1 * 33], w0, false); w0 = __builtin_amdgcn_cvt_pk_fp8_f32(s[2 * 33], s[3 * 33], w0, true);
            w1 = __builtin_amdgcn_cvt_pk_fp8_f32(s[4 * 33], s[5 * 33], w1, false); w1 = __builtin_amdgcn_cvt_pk_fp8_f32(s[6 * 33], s[7 * 33], w1, true);
            u32x2 o8; o8.x = w0; o8.y = w1; *(u32x2*)((unsigned char*)dst + (size_t)n * K + k0 + 8 * c) = o8; }
        else { u32x4 o; o.x = pk2(s[0 * 33], s[1 * 33]); o.y = pk2(s[2 * 33], s[3 * 33]); o.z = pk2(s[4 * 33], s[5 * 33]); o.w = pk2(s[6 * 33], s[7 * 33]);
            *(u32x4*)(dst + (size_t)n * K + (kd >= 0 ? kd : k0) + 8 * c) = o; } }
    LDS_WAIT(); asm volatile("" ::: "memory");
}
__device__ __forceinline__ void xpose_q8_group(const float* W, int ldw, int K, int sc, unsigned char* dst, float* csc, LAS float* scr, int lane, int mode) {
    const int n4 = (lane & 7) * 4, kk0 = lane >> 3;
    const int col = mode == 1 ? (n4 < 16 ? 3584 + n4 : 5648 + (n4 - 16)) : sc + n4;
    f32x4 mx = (f32x4){0.f, 0.f, 0.f, 0.f};
    if (mode != 2) {
#pragma unroll 8
        for (int k = kk0; k < K; k += 8) { const f32x4 v = *(const f32x4*)(W + (size_t)k * ldw + col); mx[0] = fmaxf(mx[0], fabsf(v[0])); mx[1] = fmaxf(mx[1], fabsf(v[1])); mx[2] = fmaxf(mx[2], fabsf(v[2])); mx[3] = fmaxf(mx[3], fabsf(v[3])); }
    }
    f32x4 inv, scl;
#pragma unroll
    for (int e = 0; e < 4; ++e) { float x = mx[e]; x = fmaxf(x, __shfl_xor(x, 8)); x = fmaxf(x, __shfl_xor(x, 16)); x = fmaxf(x, __shfl_xor(x, 32)); scl[e] = x > 0.f ? x * (1.f / 127.f) : 1.f; inv[e] = x > 0.f ? 127.f / x : 0.f; }
    if (kk0 == 0) *(f32x4*)(csc + n4) = scl;
    for (int k0 = 0; k0 < K; k0 += 64) {
#pragma unroll
        for (int i = 0; i < 8; ++i) { const int kk = kk0 + 8 * i; f32x4 v = (f32x4){0.f, 0.f, 0.f, 0.f}; if (mode != 2) v = *(const f32x4*)(W + (size_t)(k0 + kk) * ldw + col);
            scr[kk * 33 + n4] = rintf(v[0] * inv[0]); scr[kk * 33 + n4 + 1] = rintf(v[1] * inv[1]); scr[kk * 33 + n4 + 2] = rintf(v[2] * inv[2]); scr[kk * 33 + n4 + 3] = rintf(v[3] * inv[3]); }
        LDS_WAIT(); asm volatile("" ::: "memory");
        const int c = lane & 7;
#pragma unroll
        for (int jj = 0; jj < 4; ++jj) { const int n = (lane >> 3) + 8 * jj; const LAS float* s = scr + (8 * c) * 33 + n;
            const unsigned w0 = ((unsigned)(int)s[0 * 33] & 0xffu) | (((unsigned)(int)s[1 * 33] & 0xffu) << 8) | (((unsigned)(int)s[2 * 33] & 0xffu) << 16) | (((unsigned)(int)s[3 * 33] & 0xffu) << 24);
            const unsigned w1 = ((unsigned)(int)s[4 * 33] & 0xffu) | (((unsigned)(int)s[5 * 33] & 0xffu) << 8) | (((unsigned)(int)s[6 * 33] & 0xffu) << 16) | (((unsigned)(int)s[7 * 33] & 0xffu) << 24);
            u32x2 o8; o8.x = w0; o8.y = w1; *(u32x2*)(dst + (size_t)n * K + k0 + 8 * c) = o8; }
        LDS_WAIT(); asm volatile("" ::: "memory");
    }
}
__device__ __forceinline__ int hm_col(int grp) { const int T = grp >> 3, q8 = grp & 7; return 256 * T + 32 * (2 * (q8 & 3) + (q8 >> 2)); }

constexpr int CM_ITEMS = DEPTH * 256 * 8, CM_ITEMS_IN = DEPTH * (NT8 * 8) * 8;
constexpr size_t CMX_IN_OFF = (size_t)DEPTH * 8192;
__device__ __forceinline__ void colmax_item(const Args& a, unsigned* cmx, int item, int lane) {
    const int slab = item & 7, grp = (item >> 3) & 255, l = item >> 11;
    const int n4 = (lane & 7) * 4, kk0 = lane >> 3, col = hm_col(grp) + n4;
    const float* W = a.in[41] + (size_t)l * D * DFF + (size_t)(slab * 256) * DFF;
    f32x4 mx = (f32x4){0.f, 0.f, 0.f, 0.f};
#pragma unroll 8
    for (int k = kk0; k < 256; k += 8) { const f32x4 v = *(const f32x4*)(W + (size_t)k * DFF + col); mx[0] = fmaxf(mx[0], fabsf(v[0])); mx[1] = fmaxf(mx[1], fabsf(v[1])); mx[2] = fmaxf(mx[2], fabsf(v[2])); mx[3] = fmaxf(mx[3], fabsf(v[3])); }
#pragma unroll
    for (int e = 0; e < 4; ++e) { float x = mx[e]; x = fmaxf(x, __shfl_xor(x, 8)); x = fmaxf(x, __shfl_xor(x, 16)); x = fmaxf(x, __shfl_xor(x, 32)); mx[e] = x; }
    if (kk0 == 0) {
#pragma unroll
        for (int e = 0; e < 4; ++e) atomicMax(cmx + (size_t)l * DFF + 32 * grp + n4 + e, __float_as_uint(mx[e])); }
}
__device__ __forceinline__ void colmax_in_item(const Args& a, unsigned* cmx, int item, int lane) {
    const int slab = item & 7, r = item >> 3, gi = r % (NT8 * 8), l = r / (NT8 * 8);
    const int n4 = (lane & 7) * 4, kk0 = lane >> 3, col = win_col(tile_of_i8(gi >> 3) * 8 + (gi & 7)) + n4;
    const float* W = a.in[16] + (size_t)l * D * 13856 + (size_t)(slab * 256) * 13856;
    f32x4 mx = (f32x4){0.f, 0.f, 0.f, 0.f};
#pragma unroll 8
    for (int k = kk0; k < 256; k += 8) { const f32x4 v = *(const f32x4*)(W + (size_t)k * 13856 + col); mx[0] = fmaxf(mx[0], fabsf(v[0])); mx[1] = fmaxf(mx[1], fabsf(v[1])); mx[2] = fmaxf(mx[2], fabsf(v[2])); mx[3] = fmaxf(mx[3], fabsf(v[3])); }
#pragma unroll
    for (int e = 0; e < 4; ++e) { float x = mx[e]; x = fmaxf(x, __shfl_xor(x, 8)); x = fmaxf(x, __shfl_xor(x, 16)); x = fmaxf(x, __shfl_xor(x, 32)); mx[e] = x; }
    if (kk0 == 0) {
#pragma unroll
        for (int e = 0; e < 4; ++e) atomicMax(cmx + CMX_IN_OFF + (size_t)l * NT8_ROWS + 32 * gi + n4 + e, __float_as_uint(mx[e])); }
}
constexpr int CV_NQ8 = 0;
constexpr int CV_IN = 440 * 32, CV_GLU = 16 * 8, CV_BR = 4 * 64 * 8, CV_OUT = 64 * 32, CV_1 = 256 * 32, CV_2 = 64 * 128, CV_REST = CV_IN + CV_GLU + CV_BR + CV_OUT + CV_1 + CV_2;
__device__ __forceinline__ void convert_q8(const Args& a, LAS unsigned char* lds, int l, int grp, int wave, int lane) {
    LAS float* scr = (LAS float*)(lds + wave * 8704);
    bf16_t* wl = (bf16_t*)(a.ws + WS_W) + (size_t)l * W_LAYER; float* wsc = (float*)(a.ws + WS_WSC) + (size_t)l * (NIN + DFF);
    const int T = grp >> 3; int sc = hm_col(grp), mode = 0;
    if (T == 54) mode = (grp & 7) == 0 ? 1 : 2; else if (T >= 22) sc += 32; else if (T >= 14) sc += 16;
    xpose_q8_group(a.in[16] + (size_t)l * D * 13856, 13856, D, sc, (unsigned char*)(wl + W_IN) + (size_t)(32 * grp) * D, wsc + 32 * grp, scr, lane, mode);
}
__device__ __forceinline__ void convert_rest(const Args& a, LAS unsigned char* lds, int l, int r0, int r1, int wave, int lane) {
    LAS float* scr = (LAS float*)(lds + wave * 8704);
    bf16_t* wl = (bf16_t*)(a.ws + WS_W) + (size_t)l * W_LAYER;
    for (int it = r0; it < r1; ++it) { int r = it;
        if (r < CV_IN) { const int kb = r / 440, grp = r % 440, T = grp >> 3; const int sc = win_col(grp); const int mode = T == 54 ? ((grp & 7) == 0 ? 1 : 2) : 0;
            if (T >= 22 && T < 54) xpose_item(a.in[16] + (size_t)l * D * 13856, 13856, 64 * kb, sc, (bf16_t*)((unsigned char*)(wl + W_IN8) + (size_t)(32 * (grp - 176)) * D), D, scr, lane, mode, true);
            else xpose_item(a.in[16] + (size_t)l * D * 13856, 13856, 64 * kb, sc, wl + W_IN + (size_t)(32 * (T == 54 ? grp - 256 : grp)) * D, D, scr, lane, mode);
            continue; } r -= CV_IN;
        if (r < CV_GLU) { const int kb = r / 16, grp = r % 16; xpose_item(a.in[28] + (size_t)l * 512 * 512, 512, 64 * kb, hm_col(grp), wl + W_GLU + (size_t)(32 * grp) * 512, 512, scr, lane, 0); continue; } r -= CV_GLU;
        if (r < CV_BR) { const int k = r / 512, r2 = r % 512, kb = r2 / 64, grp = r2 % 64;
            xpose_item(a.in[39] + ((size_t)l * 4 + k) * 512 * D, D, 64 * kb, hm_col(grp), wl + W_BR + (size_t)k * D * 512 + (size_t)(32 * grp) * 512, 512, scr, lane, 0); continue; } r -= CV_BR;
        if (r < CV_OUT) { const int kb = r / 64, grp = r % 64; xpose_item(a.in[40] + (size_t)l * D * D, D, 64 * kb, 32 * grp, wl + W_OUT + (size_t)(32 * grp) * D, D, scr, lane, 0); continue; } r -= CV_OUT;
        if (r < CV_1) { const int kb = r / 256, grp = r % 256;
            xpose_item(a.in[41] + (size_t)l * D * DFF, DFF, 64 * kb, hm_col(grp), (bf16_t*)((unsigned char*)(wl + W_1) + (size_t)(32 * grp) * D), D, scr, lane, 0, false, (const float*)(a.ws + WS_WSC) + (size_t)l * DFF + 32 * grp); continue; } r -= CV_1;
        { const int kb = r / 64, grp = r % 64;
          xpose_item(a.in[42] + (size_t)l * DFF * D, D, 64 * kb, 32 * grp, wl + W_2 + ((size_t)(grp >> 3) * (DFF / 64) + kb) * 16384 + (size_t)((grp & 7) * 32) * 64, 64, scr, lane, 0, false, nullptr, 0); }
    }
}
__device__ __forceinline__ void prologue_ada_unit(const Args& a, LAS unsigned char* lds, int tid, int unit) {
    LAS float* sl = (LAS float*)lds;
    LAS float* red = (LAS float*)(lds + 40960);
    float* mod = (float*)(a.ws + WS_MOD);
    for (int i = tid; i < 5 * D; i += NT) { const int j = i / D, k = i % D; const float x = j == 0 ? a.in[11][k] : a.in[10][(j - 1) * D + k]; sl[i] = x / (1.f + __expf(-x)); }
    __syncthreads();
    const int ks = tid >> 6, c = tid & 63;
    const int l = unit / (6 * D / 64), n0 = (unit % (6 * D / 64)) * 64;
    const float* w = a.in[12] + (size_t)l * D * 6 * D + n0 + c;
    float acc[5] = {0.f, 0.f, 0.f, 0.f, 0.f};
#pragma unroll 8
    for (int k = ks * 256; k < ks * 256 + 256; ++k) { const float wv = w[(size_t)k * 6 * D];
#pragma unroll
        for (int j = 0; j < 5; ++j) acc[j] += sl[j * D + k] * wv; }
#pragma unroll
    for (int j = 0; j < 5; ++j) red[(ks * 5 + j) * 64 + c] = acc[j];
    __syncthreads();
    if (tid < 320) { const int j = tid >> 6; float s = 0.f;
#pragma unroll
        for (int q = 0; q < 8; ++q) s += red[(q * 5 + j) * 64 + c];
        mod[((size_t)l * 5 + j) * 6 * D + n0 + c] = s + a.in[13][l * 6 * D + n0 + c]; }
}
constexpr int PRO_NQ8B = CV_NQ8 / 8, PRO_NCONV = PRO_NQ8B + (CV_REST + 63) / 64,
              PRO_NADA = DEPTH * 6 * D / 64, PRO_NCACHE = 64;
__device__ __forceinline__ void norm_phase(const float* xp, const float* xs, const float* g, const float* modl, int sh_off, int sc_off, bf16_t* H, int gw, int ngw, int lane_,
                                           const float* pend, const float* pmodl, int pg_off, float* xw, const float* xs_pend, unsigned char* F8c = nullptr, unsigned char* Q8 = nullptr, float* rsc = nullptr) {
    int lane = lane_; asm volatile("" : "+v"(lane));
    for (int row = gw; row < M; row += ngw) {
        const float* x = row < MP ? xp + (size_t)row * D : xs + (size_t)(row - MP) * D;
        if (pend != nullptr && row >= 8192) x = xs_pend + (size_t)(row - MP) * D;
        f32x4 v[8]; float ss = 0.f;
#pragma unroll
        for (int j = 0; j < 8; ++j) v[j] = *(const f32x4*)(x + 4 * (lane + 64 * j));
        if (pend != nullptr && row >= 8192) {
            const float* pg = pmodl + (size_t)row_cvec(row) * 6 * D + pg_off; const int pm = row >> 8, r = row & 255;
#pragma unroll
            for (int j = 0; j < 8; ++j) { const int col = 4 * (lane + 64 * j), pn = col >> 8, cc = col & 255;
                const bf16_t* P = (const bf16_t*)pend + (size_t)(((pm - 32) * 8 + pn) * 2) * 65536 + (size_t)r * 256 + cc;
                const u32x2 qa = *(const u32x2*)P, qb = *(const u32x2*)(P + 65536); const f32x4 gg = *(const f32x4*)(pg + col);
                const f32x4 pa = (f32x4){bflo(qa.x), bfhi(qa.x), bflo(qa.y), bfhi(qa.y)}, pb = (f32x4){bflo(qb.x), bfhi(qb.x), bflo(qb.y), bfhi(qb.y)};
                v[j] = v[j] + gg * (pa + pb); *(f32x4*)(xw + (size_t)row * D + col) = v[j]; }
        }
#pragma unroll
        for (int j = 0; j < 8; ++j) ss += (v[j][0] * v[j][0] + v[j][1] * v[j][1]) + (v[j][2] * v[j][2] + v[j][3] * v[j][3]);
        const float r = rsqrtf(wave_sum(ss) * (1.f / D) + 1e-6f);
        const float* md = modl + (size_t)row_cvec(row) * 6 * D;
        float amax = 0.f;
#pragma unroll
        for (int j = 0; j < 8; ++j) { const int i = 4 * (lane + 64 * j);
            const f32x4 gg = *(const f32x4*)(g + i), sc = *(const f32x4*)(md + sc_off + i), sh = *(const f32x4*)(md + sh_off + i);
            const f32x4 o = v[j] * r * gg * (sc + 1.f) + sh; v[j] = o;
            amax = fmaxf(amax, fmaxf(fmaxf(fabsf(o[0]), fabsf(o[1])), fmaxf(fabsf(o[2]), fabsf(o[3])))); }
        if (H != nullptr) {
#pragma unroll
            for (int j = 0; j < 8; ++j) { const int i = 4 * (lane + 64 * j); u32x2 w; w.x = pk2(v[j][0], v[j][1]); w.y = pk2(v[j][2], v[j][3]); *(u32x2*)(H + (size_t)row * D + i) = w;
                if (F8c != nullptr) { unsigned w8 = 0u; w8 = __builtin_amdgcn_cvt_pk_fp8_f32(v[j][0], v[j][1], w8, false); w8 = __builtin_amdgcn_cvt_pk_fp8_f32(v[j][2], v[j][3], w8, true); *(unsigned*)(F8c + (size_t)row * D + i) = w8; } }
        }
        if (Q8 != nullptr) {
#pragma unroll
            for (int o2 = 1; o2 < 64; o2 <<= 1) amax = fmaxf(amax, __shfl_xor(amax, o2));
            const float inv = amax > 0.f ? 127.f / amax : 0.f;
            if (lane == 0) rsc[row] = amax > 0.f ? amax * (1.f / 127.f) : 1.f;
#pragma unroll
            for (int j = 0; j < 8; ++j) { const int i = 4 * (lane + 64 * j);
                const unsigned w = ((unsigned)(int)rintf(v[j][0] * inv) & 0xffu) | (((unsigned)(int)rintf(v[j][1] * inv) & 0xffu) << 8) | (((unsigned)(int)rintf(v[j][2] * inv) & 0xffu) << 16) | (((unsigned)(int)rintf(v[j][3] * inv) & 0xffu) << 24);
                *(unsigned*)(Q8 + (size_t)row * D + i) = w; }
        }
    }
}
__device__ __forceinline__ void final_fix_phase(const float* pend, const float* pmodl, int pg_off, float* X, int gw, int ngw, int lane_) {
    int lane = lane_; asm volatile("" : "+v"(lane));
    for (int row = 8192 + gw; row < M; row += ngw) {
        const float* pg = pmodl + (size_t)row_cvec(row) * 6 * D + pg_off; const int pm = row >> 8, r = row & 255;
#pragma unroll
        for (int j = 0; j < 8; ++j) { const int col = 4 * (lane + 64 * j), pn = col >> 8, cc = col & 255;
            const bf16_t* P = (const bf16_t*)pend + (size_t)(((pm - 32) * 8 + pn) * 2) * 65536 + (size_t)r * 256 + cc;
            const u32x2 qa = *(const u32x2*)P, qb = *(const u32x2*)(P + 65536); const f32x4 gg = *(const f32x4*)(pg + col);
            const f32x4 pa = (f32x4){bflo(qa.x), bfhi(qa.x), bflo(qa.y), bfhi(qa.y)}, pb = (f32x4){bflo(qb.x), bfhi(qb.x), bflo(qb.y), bfhi(qb.y)};
            float* xo = X + (size_t)row * D + col; *(f32x4*)xo = *(const f32x4*)xo + gg * (pa + pb); }
    }
}
constexpr int WQ_BASE = 3584;
#ifndef WQMASK
#define WQMASK 127
#endif
struct WaveQ { unsigned* h; int n, my, s, sh, dyn; };
__device__ __forceinline__ WaveQ waveq_init(const Args& a, int layer, int q, int n, int sh, int off = 0) {
    WaveQ Q; Q.h = (unsigned*)(a.ws + WS_CTL) + WQ_BASE + (layer * 8 + q) * 128; Q.n = n; Q.s = 0; Q.sh = sh; Q.dyn = (WQMASK >> q) & 1;
    if (Q.dyn) Q.my = (int)(xb_xcc_id() & 7u);
    else { const int gw = (int)blockIdx.x * 8 + __builtin_amdgcn_readfirstlane((int)(threadIdx.x >> 6)), ngw = (int)gridDim.x * 8; Q.my = gw - off; }
    return Q;
}
__device__ __forceinline__ int waveq_next(WaveQ& Q, int lane) {
    if (!Q.dyn) { for (;;) { const int it = Q.my + Q.s * (int)gridDim.x * 8; ++Q.s; if (it >= Q.n) return -1; if (it >= 0) return it; } }
    while (Q.s < 8) {
        const int x = (Q.my + Q.s) & 7;
        unsigned v = 0; if (lane == 0) v = __hip_atomic_fetch_add(Q.h + x * 16, 1u, __ATOMIC_RELAXED, __HIP_MEMORY_SCOPE_AGENT);
        v = (unsigned)__builtin_amdgcn_readfirstlane((int)v);
        const int it = (int)(((((v >> Q.sh) << 3) + (unsigned)x) << Q.sh) | (v & ((1u << Q.sh) - 1u)));
        if (it < Q.n) return it;
        ++Q.s;
    }
    return -1;
}
__device__ __forceinline__ void conv_pull(const Args& a, LAS unsigned char* lds, volatile LAS unsigned* qitem, int layer, int maxb, int qoff = 0) {
    unsigned* qhead = (unsigned*)(a.ws + WS_CTL) + 8200 + qoff + layer;
    for (int n = 0; maxb < 0 || n < maxb; ++n) {
        __syncthreads();
        if (threadIdx.x == 0) qitem[0] = __hip_atomic_fetch_add(qhead, 1u, __ATOMIC_RELAXED, __HIP_MEMORY_SCOPE_AGENT);
        __syncthreads();
        const int item = (int)qitem[0];
        if (item >= PRO_NCONV) break;
        const int wave = __builtin_amdgcn_readfirstlane((int)(threadIdx.x >> 6));
        int lane = (int)(threadIdx.x & 63); asm volatile("" : "+v"(lane));
        { const int w0 = (item - PRO_NQ8B) * 64 + wave * 8; convert_rest(a, lds, layer, w0, w0 + 8 < CV_REST ? w0 + 8 : CV_REST, wave, lane); }
    }
    __syncthreads();
}
}
namespace mk {
constexpr size_t WS_NAT = AL(WS_SCR);
constexpr int NATP = 2048, N_XBC = 0, N_Q = 1024, N_K = 1536;
constexpr size_t WS_TR = AL(WS_NAT + (size_t)M * NATP * 2);
constexpr int T_X = 0, T_B = 512, T_K = 768, T_MV = 1280, T_V = 1792, TRR = 2304;
constexpr int NCH = 96;
constexpr size_t WS_MLC = AL(WS_TR + (size_t)TRR * M * 2);
constexpr size_t WS_MLN = AL(WS_MLC + (size_t)NCH * 4 * 2 * 16384 * 4);
constexpr size_t WS_MLS = AL(WS_MLN + (size_t)NCH * 4 * 2 * 128 * 4);
constexpr size_t WS_MLCS = AL(WS_MLS + (size_t)NCH * 4 * 2 * 4 * 4);
constexpr size_t WS_MLNS = AL(WS_MLCS + (size_t)NCH * 4 * 2 * 16384 * 2);
constexpr size_t WS_MLMS = AL(WS_MLNS + (size_t)NCH * 4 * 2 * 128 * 4);
constexpr size_t WS_OPT_END = AL(WS_MLMS + (size_t)NCH * 4 * 2 * 4);

__device__ __forceinline__ f32x4 mfma16(bf16x8 a, bf16x8 b, f32x4 c) { return __builtin_amdgcn_mfma_f32_16x16x32_bf16(a, b, c, 0, 0, 0); }
__device__ __forceinline__ void chunk_info(int ch, int& row0, int& seq0, int& L, int& lat, int& b, int& ci, int& nc) {
    if (ch < 32) { b = ch >> 1; ci = ch & 1; nc = 2; seq0 = b * 256; L = 256; lat = 0; } else { const int c2 = ch - 32; b = c2 >> 4; ci = c2 & 15; nc = 16; seq0 = MP + b * 2048; L = 2048; lat = 1; }
    row0 = seq0 + ci * 128;
}
__device__ __forceinline__ float fast_exp(float x) { return __expf(x); }

__device__ __forceinline__ void prep_phase(const Args& a, int layer, LAS unsigned char* lds, int gw_, int ngw, int wave, int lane_, bf16_t* UPk) {
    int lane = lane_, gw = gw_; asm volatile("" : "+v"(lane));
    const bf16_t* PROJ = (const bf16_t*)(a.ws + WS_PROJ); bf16_t* NAT = (bf16_t*)(a.ws + WS_NAT); bf16_t* TR = (bf16_t*)(a.ws + WS_TR);
    LAS bf16_t* tile = (LAS bf16_t*)(lds + wave * 16896); LAS bf16_t* otile = tile + 68 * 64;
    const int c = lane & 7, r8 = lane >> 3;
    const float* cw = a.in[30] + layer * 5 * 1024; const float* cb = a.in[31] + layer * 1024;
    for (int u = gw; u < 48 * 192; u += ngw) {
        const int cg = u / 192, tt = u % 192, m0 = tt * 64;
        const int lat = m0 >= MP; const int seq0 = lat ? MP + ((m0 - MP) / 2048) * 2048 : (m0 / 256) * 256, L = lat ? 2048 : 256, t0 = m0 - seq0;
        int kind, src, natcol = -1, trrow = -1;
        if (cg < 16) { kind = 0; src = P_XBC + 64 * cg; natcol = N_XBC + 64 * cg; if (cg < 12) trrow = T_X + 64 * cg; }
        else if (cg < 24) { kind = 1; src = P_MQ + 64 * (cg - 16); natcol = N_Q + 64 * (cg - 16); }
        else if (cg < 32) { kind = 2; src = P_MK + 64 * (cg - 24); natcol = N_K + 64 * (cg - 24); trrow = T_K + 64 * (cg - 24); }
        else if (cg < 40) { kind = 3; src = P_MV + 64 * (cg - 32); trrow = T_MV + 64 * (cg - 32); }
        else if (cg < 48) { kind = 3; src = P_V + 64 * (cg - 40); trrow = T_V + 64 * (cg - 40); }
        else { kind = 4; src = P_S5U + 64 * (cg - 48); }
        const int roff = kind == 0 ? -2 : 0, nrows = kind == 0 ? 68 : 64;
#pragma unroll
        for (int i = 0; i < 9; ++i) { const int r = r8 + 8 * i; if (r < nrows) { const int t = t0 + r + roff; u32x4 v = {0u, 0u, 0u, 0u};
                if (t >= 0 && t < L) v = *(const u32x4*)(PROJ + (size_t)(seq0 + t) * PJ + src + 8 * c);
                *(LAS u32x4*)(tile + r * 64 + 8 * c) = v; } }
        LDS_WAIT(); asm volatile("" ::: "memory");
#define PREP_EMIT(i_, r_) do { if (natcol >= 0) *(u32x4*)(NAT + (size_t)(m0 + r8 + 8 * (i_)) * NATP + natcol + 8 * c) = (r_); if (trrow >= 0) *(LAS u32x4*)(otile + (r8 + 8 * (i_)) * 64 + 8 * c) = (r_); } while (0)
        if (kind == 0) {
            float w[5][8], bz[8];
#pragma unroll
            for (int e = 0; e < 8; ++e) { bz[e] = cb[64 * cg + 8 * c + e];
#pragma unroll
                for (int j = 0; j < 5; ++j) w[j][e] = cw[j * 1024 + 64 * cg + 8 * c + e]; }
#pragma unroll 2
            for (int i = 0; i < 8; ++i) { const int tk = r8 + 8 * i; float acc[8];
#pragma unroll
                for (int e = 0; e < 8; ++e) acc[e] = bz[e];
#pragma unroll
                for (int j = 0; j < 5; ++j) { const u32x4 v = *(const LAS u32x4*)(tile + (tk + j) * 64 + 8 * c);
                    acc[0] += bflo(v.x) * w[j][0]; acc[1] += bfhi(v.x) * w[j][1]; acc[2] += bflo(v.y) * w[j][2]; acc[3] += bfhi(v.y) * w[j][3];
                    acc[4] += bflo(v.z) * w[j][4]; acc[5] += bfhi(v.z) * w[j][5]; acc[6] += bflo(v.w) * w[j][6]; acc[7] += bfhi(v.w) * w[j][7]; }
#pragma unroll
                for (int e = 0; e < 8; ++e) acc[e] = fsilu(acc[e]);
                u32x4 rv; rv.x = pk2(acc[0], acc[1]); rv.y = pk2(acc[2], acc[3]); rv.z = pk2(acc[4], acc[5]); rv.w = pk2(acc[6], acc[7]); PREP_EMIT(i, rv); }
        } else if (kind == 4) {
#pragma unroll
            for (int i = 0; i < 8; ++i) { const int tk = r8 + 8 * i, m = m0 + tk; const u32x4 v = *(const LAS u32x4*)(tile + tk * 64 + 8 * c);
                *(u32x4*)(UPk + ((size_t)(4 * (cg - 48) + (c >> 1)) * 384 + (m >> 5)) * 512 + (m & 31) * 16 + 8 * (c & 1)) = v; }
        } else if (kind == 3 || !lat) {
            const float sc = kind == 2 ? 0.08838834764831845f : 1.f;
#pragma unroll
            for (int i = 0; i < 8; ++i) { const u32x4 v = *(const LAS u32x4*)(tile + (r8 + 8 * i) * 64 + 8 * c);
                u32x4 rv = v;
                if (kind == 2) { rv.x = pk2(bflo(v.x) * sc, bfhi(v.x) * sc); rv.y = pk2(bflo(v.y) * sc, bfhi(v.y) * sc); rv.z = pk2(bflo(v.z) * sc, bfhi(v.z) * sc); rv.w = pk2(bflo(v.w) * sc, bfhi(v.w) * sc); }
                PREP_EMIT(i, rv); }
        } else {
            const float sc = kind == 2 ? 0.08838834764831845f : 1.f; const int odd = cg & 1;
            float inv[8];
#pragma unroll
            for (int e = 0; e < 8; ++e) inv[e] = exp2f(-(float)(8 * (c & 3) + e) * (13.287712379549449f / 32.f));
#pragma unroll
            for (int i = 0; i < 8; ++i) { const int tk = r8 + 8 * i, t = t0 + tk; const float pos = odd ? (float)(t & 63) : (float)(t >> 6);
                const u32x4 vo = *(const LAS u32x4*)(tile + tk * 64 + 8 * c), vp = *(const LAS u32x4*)(tile + tk * 64 + 8 * (c ^ 4));
                float o[8], p[8], rr[8];
                o[0] = bflo(vo.x); o[1] = bfhi(vo.x); o[2] = bflo(vo.y); o[3] = bfhi(vo.y); o[4] = bflo(vo.z); o[5] = bfhi(vo.z); o[6] = bflo(vo.w); o[7] = bfhi(vo.w);
                p[0] = bflo(vp.x); p[1] = bfhi(vp.x); p[2] = bflo(vp.y); p[3] = bfhi(vp.y); p[4] = bflo(vp.z); p[5] = bfhi(vp.z); p[6] = bflo(vp.w); p[7] = bfhi(vp.w);
#pragma unroll
                for (int e = 0; e < 8; ++e) { const float ang = pos * inv[e], cs = __cosf(ang), sn = __sinf(ang);
                    rr[e] = (c < 4 ? o[e] * cs - p[e] * sn : p[e] * sn + o[e] * cs) * sc; }
                u32x4 rv; rv.x = pk2(rr[0], rr[1]); rv.y = pk2(rr[2], rr[3]); rv.z = pk2(rr[4], rr[5]); rv.w = pk2(rr[6], rr[7]); PREP_EMIT(i, rv); }
        }
        if (trrow >= 0) {
            LDS_WAIT(); asm volatile("" ::: "memory");
            bf16_t* dst = TR + (size_t)(trrow + lane) * M + m0;
#pragma unroll
            for (int j = 0; j < 8; ++j) { unsigned wv[4];
#pragma unroll
                for (int q = 0; q < 4; ++q) { const unsigned lo = otile[(8 * j + 2 * q) * 64 + lane], hi = otile[(8 * j + 2 * q + 1) * 64 + lane]; wv[q] = lo | (hi << 16); }
                u32x4 o; o.x = wv[0]; o.y = wv[1]; o.z = wv[2]; o.w = wv[3]; *(u32x4*)(dst + 8 * j) = o; }
        }
        LDS_WAIT(); asm volatile("" ::: "memory");
    }
}

struct MlGate { float lf0, lf1, ig0, ig1, P0, P1, tot; };
__device__ __forceinline__ float wave_incl_scan(float v, int lane) {
#pragma unroll
    for (int o = 1; o < 64; o <<= 1) { const float t = __shfl_up(v, o); if (lane >= o) v += t; }
    return v;
}
__device__ __forceinline__ float wave_max(float v) {
#pragma unroll
    for (int o = 1; o < 64; o <<= 1) v = fmaxf(v, __shfl_xor(v, o));
    return v;
}
__device__ __forceinline__ MlGate ml_gates(const Args& a, int layer, int row0, int hh, int dir, int lane) {
    const float* SMALL = (const float*)(a.ws + WS_SMALL);
    const float ib = a.in[36][layer * 8 + dir * 4 + hh], fb = a.in[37][layer * 8 + dir * 4 + hh];
    MlGate g;
    const float f0 = SMALL[(size_t)(row0 + lane) * 32 + S_MF + dir * 4 + hh] + fb, f1 = SMALL[(size_t)(row0 + lane + 64) * 32 + S_MF + dir * 4 + hh] + fb;
    g.ig0 = SMALL[(size_t)(row0 + lane) * 32 + S_MI + dir * 4 + hh] + ib; g.ig1 = SMALL[(size_t)(row0 + lane + 64) * 32 + S_MI + dir * 4 + hh] + ib;
    g.lf0 = fminf(f0, 0.f) - log1pf(__expf(-fabsf(f0))); g.lf1 = fminf(f1, 0.f) - log1pf(__expf(-fabsf(f1)));
    const float s0 = wave_incl_scan(g.lf0, lane); const float tot0 = __shfl(s0, 63);
    const float s1 = wave_incl_scan(g.lf1, lane) + tot0;
    g.P0 = s0; g.P1 = s1; g.tot = __shfl(s1, 63);
    return g;
}

__device__ __forceinline__ void ml_states_phase(const Args& a, int layer, int tid_, int G) {
    int tid = tid_; asm volatile("" : "+v"(tid));
    const int lane = tid & 63, wave = __builtin_amdgcn_readfirstlane(tid >> 6), fr = lane & 15, fq = lane >> 4;
    const bf16_t* TR = (const bf16_t*)(a.ws + WS_TR);
    bf16_t* MLC = (bf16_t*)(a.ws + WS_MLC); float* MLN = (float*)(a.ws + WS_MLN); float* MLS = (float*)(a.ws + WS_MLS);
    WaveQ Q = waveq_init(a, layer, 1, NCH * 4 * 4, 3, 3072);
    for (int it; (it = waveq_next(Q, lane)) >= 0; ) {
        const int u = it >> 2, wp = it & 3;
        const int ch = u >> 2, hh = u & 3; int row0, seq0, L, lat, b, ci, nc; chunk_info(ch, row0, seq0, L, lat, b, ci, nc);
#pragma unroll 1
        for (int dir = 0; dir < 2; ++dir) {
            const MlGate g = ml_gates(a, layer, row0, hh, dir, lane);
            const float w0 = (dir == 0 ? g.tot - g.P0 : g.P0 - g.lf0) + g.ig0, w1 = (dir == 0 ? g.tot - g.P1 : g.P1 - g.lf1) + g.ig1;
            const float mloc = wave_max(fmaxf(w0, w1));
            const float e0 = __expf(w0 - mloc), e1 = __expf(w1 - mloc);
            f32x4 acc[2][8];
#pragma unroll
            for (int q = 0; q < 2; ++q)
#pragma unroll
                for (int j = 0; j < 8; ++j) acc[q][j] = (f32x4){0.f, 0.f, 0.f, 0.f};
            float nacc[8];
#pragma unroll
            for (int j = 0; j < 8; ++j) nacc[j] = 0.f;
            const bf16_t* vrow = TR + (size_t)(T_MV + hh * 128 + wp * 32 + fr) * M + row0 + 8 * fq;
#pragma unroll
            for (int ks = 0; ks < 4; ++ks) {
                const bf16x8 af0 = *(const bf16x8*)(vrow + 32 * ks), af1 = *(const bf16x8*)(vrow + (size_t)16 * M + 32 * ks);
                float ev[8];
#pragma unroll
                for (int j = 0; j < 8; ++j) { const int tok = 32 * ks + 8 * fq + j; const float x0 = __shfl(e0, tok & 63), x1 = __shfl(e1, tok & 63); ev[j] = tok < 64 ? x0 : x1; }
#pragma unroll
                for (int jt = 0; jt < 8; ++jt) {
                    const u32x4 kv = *(const u32x4*)(TR + (size_t)(T_K + hh * 128 + jt * 16 + fr) * M + row0 + 32 * ks + 8 * fq);
                    const float k0 = bflo(kv.x) * ev[0], k1 = bfhi(kv.x) * ev[1], k2 = bflo(kv.y) * ev[2], k3 = bfhi(kv.y) * ev[3], k4 = bflo(kv.z) * ev[4], k5 = bfhi(kv.z) * ev[5], k6 = bflo(kv.w) * ev[6], k7 = bfhi(kv.w) * ev[7];
                    if (wp == 0) nacc[jt] += ((k0 + k1) + (k2 + k3)) + ((k4 + k5) + (k6 + k7));
                    u32x4 kb; kb.x = pk2(k0, k1); kb.y = pk2(k2, k3); kb.z = pk2(k4, k5); kb.w = pk2(k6, k7);
                    const bf16x8 kf = __builtin_bit_cast(bf16x8, kb);
                    acc[0][jt] = mfma16(kf, af0, acc[0][jt]); acc[1][jt] = mfma16(kf, af1, acc[1][jt]);
                }
            }
#pragma unroll
            for (int q = 0; q < 2; ++q) { bf16_t* cdst = MLC + ((size_t)(ch * 4 + hh) * 2 + dir) * 16384 + (size_t)(wp * 32 + 16 * q + fr) * 128 + 4 * fq;
#pragma unroll
                for (int jt = 0; jt < 8; ++jt) { u32x2 w; w.x = pk2(acc[q][jt][0], acc[q][jt][1]); w.y = pk2(acc[q][jt][2], acc[q][jt][3]); *(u32x2*)(cdst + jt * 16) = w; } }
            if (wp == 0) {
#pragma unroll
                for (int jt = 0; jt < 8; ++jt) { float v = nacc[jt]; v += __shfl_xor(v, 16); v += __shfl_xor(v, 32); if (fq == 0) MLN[((size_t)(ch * 4 + hh) * 2 + dir) * 128 + jt * 16 + fr] = v; }
                if (lane == 0) { MLS[((size_t)(ch * 4 + hh) * 2 + dir) * 4 + 0] = mloc; MLS[((size_t)(ch * 4 + hh) * 2 + dir) * 4 + 1] = g.tot; }
            }
        }
    }
}
template <int PER, int NB>
__device__ __forceinline__ void ml_scan_task(const Args& a, int layer, int tid, int lat, int b, int hh, int dir, int part) {
    const unsigned* MLC = (const unsigned*)(a.ws + WS_MLC); const float* MLN = (const float*)(a.ws + WS_MLN); const float* MLS = (const float*)(a.ws + WS_MLS);
    unsigned* CS = (unsigned*)(a.ws + WS_MLCS); float* NS = (float*)(a.ws + WS_MLNS); float* MS = (float*)(a.ws + WS_MLMS);
    const int nc = lat ? 16 : 2, ch0 = lat ? 32 + b * 16 : b * 2, e0 = part * PER * NT;
    float c[PER]; float n = 0.f, m = 0.f;
    const size_t so = (((size_t)b * DEPTH + layer) * 2 + dir) * 4 + hh;
#pragma unroll
    for (int i = 0; i < PER; ++i) { const int e = e0 + 2 * ((i >> 1) * NT + tid) + (i & 1), vd = e >> 7, kd = e & 127; c[i] = lat ? a.in[7][(so * 128 + kd) * 128 + vd] : 0.f; }
    if (tid < 128) n = lat ? a.in[8][so * 128 + tid] : 0.f;
    m = lat ? a.in[9][so] : 0.f;
    for (int s0 = 0; s0 < nc; s0 += NB) {
        unsigned w[NB][PER / 2]; float cn[NB], ml[NB], bl[NB];
#pragma unroll
        for (int q = 0; q < NB; ++q) { const int ci = dir ? nc - 1 - (s0 + q) : s0 + q; const size_t sb = (size_t)((ch0 + ci) * 4 + hh) * 2 + dir;
#pragma unroll
            for (int p = 0; p < PER / 2; ++p) w[q][p] = MLC[(sb * 16384 + e0) / 2 + p * NT + tid];
            cn[q] = tid < 128 ? MLN[sb * 128 + tid] : 0.f; ml[q] = MLS[sb * 4 + 0]; bl[q] = MLS[sb * 4 + 1]; }
#pragma unroll
        for (int q = 0; q < NB; ++q) { const int ci = dir ? nc - 1 - (s0 + q) : s0 + q; const size_t sb = (size_t)((ch0 + ci) * 4 + hh) * 2 + dir;
#pragma unroll
            for (int p = 0; p < PER / 2; ++p) CS[(sb * 16384 + e0) / 2 + p * NT + tid] = pk2(c[2 * p], c[2 * p + 1]);
            if (part == 0) { if (tid < 128) NS[sb * 128 + tid] = n; if (tid == 0) MS[sb] = m; }
            const float mn = fmaxf(bl[q] + m, ml[q]), fa = __expf(bl[q] + m - mn), fb = __expf(ml[q] - mn);
#pragma unroll
            for (int p = 0; p < PER / 2; ++p) { c[2 * p] = fa * c[2 * p] + fb * bflo(w[q][p]); c[2 * p + 1] = fa * c[2 * p + 1] + fb * bfhi(w[q][p]); }
            if (tid < 128) n = fa * n + fb * cn[q];
            m = mn; }
    }
    if (!lat) {
#pragma unroll
        for (int i = 0; i < PER; ++i) { const int e = e0 + 2 * ((i >> 1) * NT + tid) + (i & 1), vd = e >> 7, kd = e & 127; a.out[O_MLC + (so * 128 + kd) * 128 + vd] = c[i]; }
        if (tid < 128) a.out[O_MLN + so * 128 + tid] = n; if (tid == 0) a.out[O_MLM + so] = m; }
}
__device__ __forceinline__ void ml_scan_phase(const Args& a, int layer, int tid_, int G) {
    int tid = tid_; asm volatile("" : "+v"(tid));
    for (int task = blockIdx.x; task < 256; task += G) {
        if (task < 128) ml_scan_task<8, 8>(a, layer, tid, 1, task >> 5, (task >> 3) & 3, (task >> 2) & 1, task & 3);
        else { const int t2 = task - 128; ml_scan_task<32, 2>(a, layer, tid, 0, t2 >> 3, (t2 >> 1) & 3, t2 & 1, 0); }
    }
}
__device__ __forceinline__ void ml_out_phase(const Args& a, int layer, LAS unsigned char* lds, int gw, int ngw, int lane_) {
    int lane = lane_; asm volatile("" : "+v"(lane));
    LAS f32x4* stash = (LAS f32x4*)(lds + (size_t)__builtin_amdgcn_readfirstlane((int)(threadIdx.x >> 6)) * 16384) + lane;
    const int fr = lane & 15, fq = lane >> 4;
    const bf16_t* NAT = (const bf16_t*)(a.ws + WS_NAT); const bf16_t* TR = (const bf16_t*)(a.ws + WS_TR); const bf16_t* PROJ = (const bf16_t*)(a.ws + WS_PROJ);
    const bf16_t* CS = (const bf16_t*)(a.ws + WS_MLCS); const float* NS = (const float*)(a.ws + WS_MLNS); const float* MS = (const float*)(a.ws + WS_MLMS);
    bf16_t* BR = (bf16_t*)(a.ws + WS_BR);
    WaveQ Q = waveq_init(a, layer, 4, NCH * 4 * 4, 3, 0);
    for (int it; (it = waveq_next(Q, lane)) >= 0; ) {
        const int mp = it & 3, hh = (it >> 2) & 3, ch = it >> 4; int row0, seq0, L, lat, b, ci, nc; chunk_info(ch, row0, seq0, L, lat, b, ci, nc);
        const int t0 = mp * 32 + fr;
        int qoff = (row0 + t0) * NATP + N_Q + hh * 128 + 8 * fq;
#define MLQ(q, ks) (*(const bf16x8*)(NAT + qoff + (q) * 16 * NATP + 32 * (ks)))
        f32x4 hsum[2][8];
#pragma unroll
        for (int dir = 0; dir < 2; ++dir) {
            const size_t sb = (size_t)(ch * 4 + hh) * 2 + dir;
            const MlGate g = ml_gates(a, layer, row0, hh, dir, lane); const float ms = MS[sb];
            float u0, u1, c0, c1, ai0, ai1;
            if (dir == 0) { u0 = g.ig0 - g.P0; u1 = g.ig1 - g.P1; c0 = g.P0; c1 = g.P1; ai0 = g.P0 + ms; ai1 = g.P1 + ms; }
            else { const float E0 = g.P0 - g.lf0, E1 = g.P1 - g.lf1; u0 = E0 + g.ig0; u1 = E1 + g.ig1; c0 = -E0; c1 = -E1; ai0 = g.tot - E0 + ms; ai1 = g.tot - E1 + ms; }
            float g0 = u0, g1 = u1;
            if (dir == 0) {
#pragma unroll
                for (int o2 = 1; o2 < 64; o2 <<= 1) { const float x0 = __shfl_up(g0, o2), x1 = __shfl_up(g1, o2); if (lane >= o2) { g0 = fmaxf(g0, x0); g1 = fmaxf(g1, x1); } }
                g1 = fmaxf(g1, __shfl(g0, 63));
            } else {
#pragma unroll
                for (int o2 = 1; o2 < 64; o2 <<= 1) { const float x0 = __shfl_down(g0, o2), x1 = __shfl_down(g1, o2); if (lane + o2 < 64) { g0 = fmaxf(g0, x0); g1 = fmaxf(g1, x1); } }
                g0 = fmaxf(g0, __shfl(g1, 0));
            }
            const float mt0 = fmaxf(ai0, c0 + g0), mt1 = fmaxf(ai1, c1 + g1);
            const float w0 = c0 - mt0, w1 = c1 - mt1, si0 = __expf(ai0 - mt0), si1 = __expf(ai1 - mt1), em0 = __expf(-mt0), em1 = __expf(-mt1);
            const bool th = mp >= 2; float wt[2], sit[2], emt[2];
#pragma unroll
            for (int q = 0; q < 2; ++q) { const int tl = (t0 + 16 * q) & 63; wt[q] = th ? __shfl(w1, tl) : __shfl(w0, tl); sit[q] = th ? __shfl(si1, tl) : __shfl(si0, tl); emt[q] = th ? __shfl(em1, tl) : __shfl(em0, tl); }
            f32x4 acc[2][8];
#pragma unroll
            for (int q = 0; q < 2; ++q)
#pragma unroll
                for (int j = 0; j < 8; ++j) acc[q][j] = (f32x4){0.f, 0.f, 0.f, 0.f};
            float qn[2] = {0.f, 0.f};
            asm volatile("" : "+v"(qoff));
#pragma unroll
            for (int ks = 0; ks < 4; ++ks) { const bf16x8 qk[2] = {MLQ(0, ks), MLQ(1, ks)};
#pragma unroll
                for (int j = 0; j < 8; ++j) { const bf16x8 cf = *(const bf16x8*)(CS + sb * 16384 + (size_t)(16 * j + fr) * 128 + 32 * ks + 8 * fq); acc[0][j] = mfma16(cf, qk[0], acc[0][j]); acc[1][j] = mfma16(cf, qk[1], acc[1][j]); }
                const float* nn = NS + sb * 128 + 32 * ks + 8 * fq; const f32x4 n0 = *(const f32x4*)nn, n1 = *(const f32x4*)(nn + 4);
#pragma unroll
                for (int q = 0; q < 2; ++q) { const u32x4 qv = __builtin_bit_cast(u32x4, qk[q]);
                    qn[q] += bflo(qv.x) * n0[0] + bfhi(qv.x) * n0[1] + bflo(qv.y) * n0[2] + bfhi(qv.y) * n0[3] + bflo(qv.z) * n1[0] + bfhi(qv.z) * n1[1] + bflo(qv.w) * n1[2] + bfhi(qv.w) * n1[3]; } }
            float den[2], psum[2];
#pragma unroll
            for (int q = 0; q < 2; ++q) { qn[q] += __shfl_xor(qn[q], 16); qn[q] += __shfl_xor(qn[q], 32);
#pragma unroll
                for (int j = 0; j < 8; ++j) acc[q][j] *= sit[q];
                den[q] = sit[q] * qn[q]; psum[q] = 0.f; }
            const int jlo = dir == 0 ? 0 : mp, jhi = dir == 0 ? mp : 3;
            for (int jp = jlo; jp <= jhi; ++jp) {
                const int ta = 32 * jp + 8 * (fr >> 2) + (fr & 3);
                f32x4 sa[2], sc[2];
#pragma unroll
                for (int q = 0; q < 2; ++q) { sa[q] = (f32x4){0.f, 0.f, 0.f, 0.f}; sc[q] = (f32x4){0.f, 0.f, 0.f, 0.f}; }
                asm volatile("" : "+v"(qoff));
#pragma unroll
                for (int ks = 0; ks < 4; ++ks) {
                    const bf16x8 ka = *(const bf16x8*)(NAT + (size_t)(row0 + ta) * NATP + N_K + hh * 128 + 32 * ks + 8 * fq);
                    const bf16x8 kb = *(const bf16x8*)(NAT + (size_t)(row0 + ta + 4) * NATP + N_K + hh * 128 + 32 * ks + 8 * fq);
                    const bf16x8 q0 = MLQ(0, ks), q1 = MLQ(1, ks);
                    sa[0] = mfma16(ka, q0, sa[0]); sc[0] = mfma16(kb, q0, sc[0]); sa[1] = mfma16(ka, q1, sa[1]); sc[1] = mfma16(kb, q1, sc[1]);
                    if (ks & 1) __builtin_amdgcn_sched_barrier(0); }
                float us0[4], us1[4];
#pragma unroll
                for (int i = 0; i < 4; ++i) { const int s0 = 32 * jp + 8 * fq + i, s1 = s0 + 4;
                    us0[i] = jp < 2 ? __shfl(u0, s0 & 63) : __shfl(u1, s0 & 63); us1[i] = jp < 2 ? __shfl(u0, s1 & 63) : __shfl(u1, s1 & 63); }
                bf16x8 pf[2];
#pragma unroll
                for (int q = 0; q < 2; ++q) { const int t = t0 + 16 * q; float pa[4], pb[4];
#pragma unroll
                    for (int i = 0; i < 4; ++i) { const int s0 = 32 * jp + 8 * fq + i, s1 = s0 + 4;
                        const bool ok0 = dir == 0 ? s0 <= t : s0 >= t, ok1 = dir == 0 ? s1 <= t : s1 >= t;
                        pa[i] = ok0 ? sa[q][i] * __expf(us0[i] + wt[q]) : 0.f; pb[i] = ok1 ? sc[q][i] * __expf(us1[i] + wt[q]) : 0.f;
                        psum[q] += pa[i] + pb[i]; }
                    u32x4 pw; pw.x = pk2(pa[0], pa[1]); pw.y = pk2(pa[2], pa[3]); pw.z = pk2(pb[0], pb[1]); pw.w = pk2(pb[2], pb[3]);
                    pf[q] = __builtin_bit_cast(bf16x8, pw); }
#pragma unroll
                for (int j = 0; j < 8; ++j) { const bf16x8 vf = *(const bf16x8*)(TR + (size_t)(T_MV + hh * 128 + 16 * j + fr) * M + row0 + 32 * jp + 8 * fq); acc[0][j] = mfma16(vf, pf[0], acc[0][j]); acc[1][j] = mfma16(vf, pf[1], acc[1][j]); }
            }
#pragma unroll
            for (int q = 0; q < 2; ++q) { psum[q] += __shfl_xor(psum[q], 16); psum[q] += __shfl_xor(psum[q], 32);
                den[q] += psum[q];
                const float rden = 1.f / fmaxf(fabsf(den[q]), emt[q]);
#pragma unroll
                for (int j = 0; j < 8; ++j) { if (dir == 0) stash[(q * 8 + j) * 64] = acc[q][j] * rden; else hsum[q][j] = stash[(q * 8 + j) * 64] + acc[q][j] * rden; } }
        }
        const float* ng = a.in[38] + layer * 512 + hh * 128;
#pragma unroll
        for (int q = 0; q < 2; ++q) { const int t = t0 + 16 * q; float ss = 0.f;
#pragma unroll
            for (int j = 0; j < 8; ++j) ss += (hsum[q][j][0] * hsum[q][j][0] + hsum[q][j][1] * hsum[q][j][1]) + (hsum[q][j][2] * hsum[q][j][2] + hsum[q][j][3] * hsum[q][j][3]);
            ss += __shfl_xor(ss, 16); ss += __shfl_xor(ss, 32);
            const float r = rsqrtf(ss * (1.f / 128.f) + 1e-6f);
#pragma unroll
            for (int j = 0; j < 8; ++j) { const int vd = 16 * j + 4 * fq; const f32x4 gg = *(const f32x4*)(ng + vd);
                const u32x2 ov = *(const u32x2*)(PROJ + (size_t)(row0 + t) * PJ + P_MO + hh * 128 + vd);
                const float o0 = hsum[q][j][0] * r * gg[0] * fsigm(bflo(ov.x)), o1 = hsum[q][j][1] * r * gg[1] * fsigm(bfhi(ov.x)), o2 = hsum[q][j][2] * r * gg[2] * fsigm(bflo(ov.y)), o3 = hsum[q][j][3] * r * gg[3] * fsigm(bfhi(ov.y));
                u32x2 w; w.x = pk2(o0, o1); w.y = pk2(o2, o3); *(u32x2*)(BR + (size_t)(row0 + t) * D + 1536 + hh * 128 + vd) = w; } }
    }
}
#undef MLQ
}
namespace mk {
constexpr size_t WS_SST = WS_OPT_END;
constexpr size_t WS_SSL = AL(WS_SST + (size_t)NCH * 8 * 2 * 8192 * 4);
constexpr size_t WS_SSCS = AL(WS_SSL + (size_t)NCH * 8 * 2 * 4);
constexpr size_t WS_YPRE = AL(WS_SSCS + (size_t)NCH * 8 * 2 * 8192 * 2);
constexpr size_t WS_SSQ = AL(WS_YPRE + (size_t)M * 512 * 4);
constexpr size_t WS_SSD_END = AL(WS_SSQ + (size_t)M * 8 * 4);

struct SsdGate { float dt0, dt1, la0, la1, P0, P1, tot; };
__device__ __forceinline__ SsdGate ssd_gates(const Args& a, int layer, int row0, int hh, int dir, int lane) {
    const float* SMALL = (const float*)(a.ws + WS_SMALL);
    const float bias = a.in[32][layer * 16 + dir * 8 + hh], A = -__expf(a.in[33][layer * 16 + dir * 8 + hh]);
    SsdGate g;
    const float x0 = SMALL[(size_t)(row0 + lane) * 32 + S_DT + dir * 8 + hh] + bias, x1 = SMALL[(size_t)(row0 + lane + 64) * 32 + S_DT + dir * 8 + hh] + bias;
    g.dt0 = fmaxf(x0, 0.f) + log1pf(__expf(-fabsf(x0))); g.dt1 = fmaxf(x1, 0.f) + log1pf(__expf(-fabsf(x1)));
    g.la0 = g.dt0 * A; g.la1 = g.dt1 * A;
    const float s0 = wave_incl_scan(g.la0, lane); const float t0 = __shfl(s0, 63);
    const float s1 = wave_incl_scan(g.la1, lane) + t0;
    g.P0 = s0; g.P1 = s1; g.tot = __shfl(s1, 63);
    return g;
}
__device__ __forceinline__ void ssd_states_phase(const Args& a, int layer, int tid_, int G) {
    int tid = tid_; asm volatile("" : "+v"(tid));
    const int lane = tid & 63, wave = __builtin_amdgcn_readfirstlane(tid >> 6), fr = lane & 15, fq = lane >> 4;
    const bf16_t* TR = (const bf16_t*)(a.ws + WS_TR); bf16_t* SST = (bf16_t*)(a.ws + WS_SST); float* SSL = (float*)(a.ws + WS_SSL);
    WaveQ Q = waveq_init(a, layer, 2, NCH * 8 * 4, 3, 3072 + 1536 + 768);
    for (int it; (it = waveq_next(Q, lane)) >= 0; ) {
        const int u = it >> 2, wp = it & 3;
        const int ch = u >> 3, hh = u & 7, grp = hh >> 2; int row0, seq0, L, lat, b, ci, nc; chunk_info(ch, row0, seq0, L, lat, b, ci, nc);
#pragma unroll 1
        for (int dir = 0; dir < 2; ++dir) {
            const SsdGate g = ssd_gates(a, layer, row0, hh, dir, lane);
            const float w0 = g.dt0 * __expf(dir == 0 ? g.tot - g.P0 : g.P0 - g.la0), w1 = g.dt1 * __expf(dir == 0 ? g.tot - g.P1 : g.P1 - g.la1);
            f32x4 acc[2][4];
#pragma unroll
            for (int q = 0; q < 2; ++q)
#pragma unroll
                for (int j = 0; j < 4; ++j) acc[q][j] = (f32x4){0.f, 0.f, 0.f, 0.f};
#pragma unroll
            for (int ks = 0; ks < 4; ++ks) {
                float ev[8];
#pragma unroll
                for (int j = 0; j < 8; ++j) { const int tok = 32 * ks + 8 * fq + j; const float y0 = __shfl(w0, tok & 63), y1 = __shfl(w1, tok & 63); ev[j] = tok < 64 ? y0 : y1; }
                bf16x8 bf[2];
#pragma unroll
                for (int q = 0; q < 2; ++q) { const u32x4 bv = *(const u32x4*)(TR + (size_t)(T_B + grp * 128 + wp * 32 + 16 * q + fr) * M + row0 + 32 * ks + 8 * fq);
                    u32x4 bw; bw.x = pk2(bflo(bv.x) * ev[0], bfhi(bv.x) * ev[1]); bw.y = pk2(bflo(bv.y) * ev[2], bfhi(bv.y) * ev[3]); bw.z = pk2(bflo(bv.z) * ev[4], bfhi(bv.z) * ev[5]); bw.w = pk2(bflo(bv.w) * ev[6], bfhi(bv.w) * ev[7]);
                    bf[q] = __builtin_bit_cast(bf16x8, bw); }
#pragma unroll
                for (int j = 0; j < 4; ++j) { const bf16x8 xf = *(const bf16x8*)(TR + (size_t)(T_X + hh * 64 + 16 * j + fr) * M + row0 + 32 * ks + 8 * fq); acc[0][j] = mfma16(bf[0], xf, acc[0][j]); acc[1][j] = mfma16(bf[1], xf, acc[1][j]); }
            }
#pragma unroll
            for (int q = 0; q < 2; ++q) { bf16_t* dst = SST + ((size_t)(ch * 8 + hh) * 2 + dir) * 8192 + (size_t)fr * 128 + wp * 32 + 16 * q + 4 * fq;
#pragma unroll
                for (int j = 0; j < 4; ++j) { u32x2 w; w.x = pk2(acc[q][j][0], acc[q][j][1]); w.y = pk2(acc[q][j][2], acc[q][j][3]); *(u32x2*)(dst + (size_t)(16 * j) * 128) = w; } }
            if (wp == 0 && lane == 0) SSL[(size_t)(ch * 8 + hh) * 2 + dir] = g.tot;
        }
    }
}
template <int PER, int NB>
__device__ __forceinline__ void ssd_scan_task(const Args& a, int layer, int tid, int lat, int b, int hh, int dir, int part) {
    const unsigned* SST = (const unsigned*)(a.ws + WS_SST); const float* SSL = (const float*)(a.ws + WS_SSL); unsigned* CS = (unsigned*)(a.ws + WS_SSCS);
    const int nc = lat ? 16 : 2, ch0 = lat ? 32 + b * 16 : b * 2, e0 = part * PER * NT;
    float c[PER];
    const size_t so = ((((size_t)b * DEPTH + layer) * 2 + dir) * 8 + hh) * 8192;
#pragma unroll
    for (int i = 0; i < PER; ++i) c[i] = lat ? a.in[6][so + e0 + 2 * ((i >> 1) * NT + tid) + (i & 1)] : 0.f;
    for (int s0 = 0; s0 < nc; s0 += NB) {
        unsigned w[NB][PER / 2]; float nt[NB];
#pragma unroll
        for (int q = 0; q < NB; ++q) { const int ci = dir ? nc - 1 - (s0 + q) : s0 + q; const size_t sb = (size_t)((ch0 + ci) * 8 + hh) * 2 + dir;
#pragma unroll
            for (int p = 0; p < PER / 2; ++p) w[q][p] = SST[(sb * 8192 + e0) / 2 + p * NT + tid];
            nt[q] = SSL[sb]; }
#pragma unroll
        for (int q = 0; q < NB; ++q) { const int ci = dir ? nc - 1 - (s0 + q) : s0 + q; const size_t sb = (size_t)((ch0 + ci) * 8 + hh) * 2 + dir;
            const float dec = __expf(nt[q]);
#pragma unroll
            for (int p = 0; p < PER / 2; ++p) { CS[(sb * 8192 + e0) / 2 + p * NT + tid] = pk2(c[2 * p], c[2 * p + 1]); c[2 * p] = dec * c[2 * p] + bflo(w[q][p]); c[2 * p + 1] = dec * c[2 * p + 1] + bfhi(w[q][p]); } }
    }
    if (!lat) {
#pragma unroll
        for (int i = 0; i < PER; ++i) a.out[O_SSD + so + e0 + 2 * ((i >> 1) * NT + tid) + (i & 1)] = c[i]; }
}
__device__ __forceinline__ void ssd_scan_phase(const Args& a, int layer, int tid_, int G) {
    int tid = tid_; asm volatile("" : "+v"(tid));
    for (int task_ = blockIdx.x; task_ < 384; task_ += G) {
        const int task = task_ < 256 ? (task_ + 128) & 255 : task_;
        if (task < 128) ssd_scan_task<8, 8>(a, layer, tid, 1, task >> 5, (task >> 2) & 7, (task >> 1) & 1, task & 1);
        else { const int t2 = task - 128; ssd_scan_task<16, 2>(a, layer, tid, 0, t2 >> 4, (t2 >> 1) & 7, t2 & 1, 0); }
    }
}
__device__ __forceinline__ void ssd_out_phase(const Args& a, int layer, int gw, int ngw, int lane_) {
    int lane = lane_; asm volatile("" : "+v"(lane));
    const int fr = lane & 15, fq = lane >> 4;
    const bf16_t* NAT = (const bf16_t*)(a.ws + WS_NAT); const bf16_t* TR = (const bf16_t*)(a.ws + WS_TR); const bf16_t* PROJ = (const bf16_t*)(a.ws + WS_PROJ);
    const bf16_t* CS = (const bf16_t*)(a.ws + WS_SSCS); float* YPRE = (float*)(a.ws + WS_YPRE); float* SSQ = (float*)(a.ws + WS_SSQ);
    WaveQ Q = waveq_init(a, layer, 5, NCH * 8 * 4, 3, NCH * 4 * 4 + 32 * 48);
    for (int it; (it = waveq_next(Q, lane)) >= 0; ) {
        const int mp = it & 3, hh = (it >> 2) & 7, ch = it >> 5, grp = hh >> 2; int row0, seq0, L, lat, b, ci, nc; chunk_info(ch, row0, seq0, L, lat, b, ci, nc);
        const int t0 = mp * 32 + fr;
        bf16x8 cf[2][4];
#pragma unroll
        for (int q = 0; q < 2; ++q)
#pragma unroll
            for (int ks = 0; ks < 4; ++ks) cf[q][ks] = *(const bf16x8*)(NAT + (size_t)(row0 + t0 + 16 * q) * NATP + N_XBC + 768 + grp * 128 + 32 * ks + 8 * fq);
        f32x4 ysum[2][4];
#pragma unroll
        for (int q = 0; q < 2; ++q)
#pragma unroll
            for (int j = 0; j < 4; ++j) ysum[q][j] = (f32x4){0.f, 0.f, 0.f, 0.f};
#pragma unroll
        for (int dir = 0; dir < 2; ++dir) {
            const size_t sb = (size_t)(ch * 8 + hh) * 2 + dir;
            const SsdGate g = ssd_gates(a, layer, row0, hh, dir, lane);
            float u0, u1, w0, w1, e0, e1;
            if (dir == 0) { u0 = -g.P0; u1 = -g.P1; w0 = g.P0; w1 = g.P1; e0 = __expf(g.P0); e1 = __expf(g.P1); }
            else { const float E0 = g.P0 - g.la0, E1 = g.P1 - g.la1; u0 = E0; u1 = E1; w0 = -E0; w1 = -E1; e0 = __expf(g.tot - E0); e1 = __expf(g.tot - E1); }
            const bool th = mp >= 2; float wt[2], eot[2];
#pragma unroll
            for (int q = 0; q < 2; ++q) { const int tl = (t0 + 16 * q) & 63; wt[q] = th ? __shfl(w1, tl) : __shfl(w0, tl); eot[q] = th ? __shfl(e1, tl) : __shfl(e0, tl); }
            f32x4 acc[2][4];
#pragma unroll
            for (int q = 0; q < 2; ++q)
#pragma unroll
                for (int j = 0; j < 4; ++j) acc[q][j] = (f32x4){0.f, 0.f, 0.f, 0.f};
#pragma unroll
            for (int ks = 0; ks < 4; ++ks)
#pragma unroll
                for (int j = 0; j < 4; ++j) { const bf16x8 sf = *(const bf16x8*)(CS + sb * 8192 + (size_t)(16 * j + fr) * 128 + 32 * ks + 8 * fq); acc[0][j] = mfma16(sf, cf[0][ks], acc[0][j]); acc[1][j] = mfma16(sf, cf[1][ks], acc[1][j]); }
#pragma unroll
            for (int q = 0; q < 2; ++q)
#pragma unroll
                for (int j = 0; j < 4; ++j) acc[q][j] *= eot[q];
            const int jlo = dir == 0 ? 0 : mp, jhi = dir == 0 ? mp : 3;
            for (int jp = jlo; jp <= jhi; ++jp) {
                const int ta = 32 * jp + 8 * (fr >> 2) + (fr & 3);
                f32x4 sa[2], sc[2];
#pragma unroll
                for (int q = 0; q < 2; ++q) { sa[q] = (f32x4){0.f, 0.f, 0.f, 0.f}; sc[q] = (f32x4){0.f, 0.f, 0.f, 0.f}; }
#pragma unroll
                for (int ks = 0; ks < 4; ++ks) {
                    const bf16x8 ba = *(const bf16x8*)(NAT + (size_t)(row0 + ta) * NATP + N_XBC + 512 + grp * 128 + 32 * ks + 8 * fq);
                    const bf16x8 bb = *(const bf16x8*)(NAT + (size_t)(row0 + ta + 4) * NATP + N_XBC + 512 + grp * 128 + 32 * ks + 8 * fq);
                    sa[0] = mfma16(ba, cf[0][ks], sa[0]); sc[0] = mfma16(bb, cf[0][ks], sc[0]); sa[1] = mfma16(ba, cf[1][ks], sa[1]); sc[1] = mfma16(bb, cf[1][ks], sc[1]); }
                float us0[4], us1[4], d0[4], d1[4];
#pragma unroll
                for (int i = 0; i < 4; ++i) { const int s0 = 32 * jp + 8 * fq + i, s1 = s0 + 4;
                    us0[i] = jp < 2 ? __shfl(u0, s0 & 63) : __shfl(u1, s0 & 63); us1[i] = jp < 2 ? __shfl(u0, s1 & 63) : __shfl(u1, s1 & 63);
                    d0[i] = jp < 2 ? __shfl(g.dt0, s0 & 63) : __shfl(g.dt1, s0 & 63); d1[i] = jp < 2 ? __shfl(g.dt0, s1 & 63) : __shfl(g.dt1, s1 & 63); }
                bf16x8 pf[2];
#pragma unroll
                for (int q = 0; q < 2; ++q) { const int t = t0 + 16 * q; float pa[4], pb[4];
#pragma unroll
                    for (int i = 0; i < 4; ++i) { const int s0 = 32 * jp + 8 * fq + i, s1 = s0 + 4;
                        const bool ok0 = dir == 0 ? s0 <= t : s0 >= t, ok1 = dir == 0 ? s1 <= t : s1 >= t;
                        pa[i] = ok0 ? sa[q][i] * d0[i] * __expf(us0[i] + wt[q]) : 0.f; pb[i] = ok1 ? sc[q][i] * d1[i] * __expf(us1[i] + wt[q]) : 0.f; }
                    u32x4 pw; pw.x = pk2(pa[0], pa[1]); pw.y = pk2(pa[2], pa[3]); pw.z = pk2(pb[0], pb[1]); pw.w = pk2(pb[2], pb[3]);
                    pf[q] = __builtin_bit_cast(bf16x8, pw); }
#pragma unroll
                for (int j = 0; j < 4; ++j) { const bf16x8 xf = *(const bf16x8*)(TR + (size_t)(T_X + hh * 64 + 16 * j + fr) * M + row0 + 32 * jp + 8 * fq); acc[0][j] = mfma16(xf, pf[0], acc[0][j]); acc[1][j] = mfma16(xf, pf[1], acc[1][j]); }
            }
#pragma unroll
            for (int q = 0; q < 2; ++q)
#pragma unroll
                for (int j = 0; j < 4; ++j) ysum[q][j] += acc[q][j];
        }
        const float Dh = a.in[34][layer * 8 + hh];
#pragma unroll
        for (int q = 0; q < 2; ++q) { const int t = t0 + 16 * q; float ss = 0.f;
#pragma unroll
            for (int j = 0; j < 4; ++j) { const int p = 16 * j + 4 * fq;
                const u32x2 xv = *(const u32x2*)(NAT + (size_t)(row0 + t) * NATP + N_XBC + hh * 64 + p), zv = *(const u32x2*)(PROJ + (size_t)(row0 + t) * PJ + P_Z + hh * 64 + p);
                f32x4 y; y[0] = (ysum[q][j][0] + bflo(xv.x) * Dh) * fsilu(bflo(zv.x)); y[1] = (ysum[q][j][1] + bfhi(xv.x) * Dh) * fsilu(bfhi(zv.x));
                y[2] = (ysum[q][j][2] + bflo(xv.y) * Dh) * fsilu(bflo(zv.y)); y[3] = (ysum[q][j][3] + bfhi(xv.y) * Dh) * fsilu(bfhi(zv.y));
                ss += (y[0] * y[0] + y[1] * y[1]) + (y[2] * y[2] + y[3] * y[3]);
                { u32x2 yw; yw.x = pk2(y[0], y[1]); yw.y = pk2(y[2], y[3]); *(u32x2*)((bf16_t*)YPRE + (size_t)(row0 + t) * 512 + hh * 64 + p) = yw; } }
            ss += __shfl_xor(ss, 16); ss += __shfl_xor(ss, 32);
            if (fq == 0) SSQ[(size_t)(row0 + t) * 8 + hh] = ss; }
    }
}
__device__ __forceinline__ void ssd_fin_phase(const Args& a, int layer, int gw, int ngw, int lane_) {
    int lane = lane_; asm volatile("" : "+v"(lane));
    const float* YPRE = (const float*)(a.ws + WS_YPRE); const float* SSQ = (const float*)(a.ws + WS_SSQ); bf16_t* BR = (bf16_t*)(a.ws + WS_BR); const float* ng = a.in[35] + layer * 512;
    for (int row = gw; row < M; row += ngw) {
        float s = lane < 8 ? SSQ[(size_t)row * 8 + lane] : 0.f; s += __shfl_xor(s, 1); s += __shfl_xor(s, 2); s += __shfl_xor(s, 4); s = __shfl(s, 0);
        const float r = rsqrtf(s * (1.f / 512.f) + 1e-6f);
        const u32x4 yq = *(const u32x4*)((const bf16_t*)YPRE + (size_t)row * 512 + 8 * lane);
        const f32x4 y0 = (f32x4){bflo(yq.x), bfhi(yq.x), bflo(yq.y), bfhi(yq.y)}, y1 = (f32x4){bflo(yq.z), bfhi(yq.z), bflo(yq.w), bfhi(yq.w)};
        const f32x4 g0 = *(const f32x4*)(ng + 8 * lane), g1 = *(const f32x4*)(ng + 8 * lane + 4);
        *(u32x4*)(BR + (size_t)row * D + 1024 + 8 * lane) = pack8(y0 * r * g0, y1 * r * g1);
    }
}
}
namespace mk {
constexpr size_t WS_CK = WS_SSD_END;
constexpr size_t WS_CVT = AL(WS_CK + (size_t)16 * 512 * 512 * 2);
constexpr size_t WS_ATT_END = AL(WS_CVT + (size_t)16 * 512 * 512 * 2);

__device__ __forceinline__ void prologue_cache(const Args& a, int gw, int ngw, int lane) {
    bf16_t* CK = (bf16_t*)(a.ws + WS_CK); bf16_t* CVT = (bf16_t*)(a.ws + WS_CVT);
    for (size_t i = ((size_t)gw * 64 + lane) * 8; i < (size_t)16 * 512 * 512; i += (size_t)ngw * 64 * 8) {
        const f32x4 x0 = *(const f32x4*)(a.in[2] + i), x1 = *(const f32x4*)(a.in[2] + i + 4); *(u32x4*)(CK + i) = pack8(x0, x1); }
    for (size_t i = (size_t)gw * 64 + lane; i < (size_t)16 * 64 * 512; i += (size_t)ngw * 64) { const int c = i & 511, s8 = (i >> 9) & 63, bl = i >> 15;
        const float* src = a.in[3] + ((size_t)bl * 512 + 8 * s8) * 512 + c;
        u32x4 o; o.x = pk2(src[0], src[512]); o.y = pk2(src[1024], src[1536]); o.z = pk2(src[2048], src[2560]); o.w = pk2(src[3072], src[3584]);
        *(u32x4*)(CVT + ((size_t)bl * 512 + c) * 512 + 8 * s8) = o; }
}
struct AttState { float m, l; f32x4 o[4]; };
struct AttFrags { bf16x8 k[4]; const bf16_t* vt; size_t vp; };
__device__ __forceinline__ void attn_load(AttFrags& f, const bf16_t* kbase, size_t kp, const bf16_t* vt, size_t vp, int fr, int fq) {
    const int ra = 8 * (fr >> 2) + (fr & 3);
#pragma unroll
    for (int ks = 0; ks < 2; ++ks) { f.k[ks] = *(const bf16x8*)(kbase + (size_t)ra * kp + 32 * ks + 8 * fq); f.k[2 + ks] = *(const bf16x8*)(kbase + (size_t)(ra + 4) * kp + 32 * ks + 8 * fq); }
    f.vt = vt + (size_t)fr * vp + 8 * fq; f.vp = vp;
}
template <bool MASKED>
__device__ __forceinline__ void attn_compute(AttState& st, const bf16x8 (&qf)[2], const AttFrags& f, int fq, const float* bias, int kc0, int cq, int cs) {
    bf16x8 vf[4];
#pragma unroll
    for (int j = 0; j < 4; ++j) vf[j] = *(const bf16x8*)(f.vt + (size_t)(16 * j) * f.vp);
    f32x4 sa = (f32x4){0.f, 0.f, 0.f, 0.f}, sb = (f32x4){0.f, 0.f, 0.f, 0.f};
#pragma unroll
    for (int ks = 0; ks < 2; ++ks) { sa = mfma16(f.k[ks], qf[ks], sa); sb = mfma16(f.k[2 + ks], qf[ks], sb); }
    float s[8]; float gm = -1e30f;
#pragma unroll
    for (int i = 0; i < 4; ++i) { s[i] = sa[i]; s[4 + i] = sb[i]; }
    if (MASKED) {
#pragma unroll
        for (int e = 0; e < 8; ++e) { const int kc = kc0 + 8 * fq + e; const bool ok = kc >= cs && kc < cs + 16; const int bi = min(max(kc - cq + 15, 0), 30); s[e] = ok ? s[e] + bias[bi] * 1.44269504f : -1e30f; }
    }
#pragma unroll
    for (int e = 0; e < 8; ++e) gm = fmaxf(gm, s[e]);
    gm = fmaxf(gm, __shfl_xor(gm, 16)); gm = fmaxf(gm, __shfl_xor(gm, 32));
    const float mn = fmaxf(st.m, gm), al = __builtin_amdgcn_exp2f(st.m - mn); st.m = mn;
    float p[8], ps = 0.f;
#pragma unroll
    for (int e = 0; e < 8; ++e) { p[e] = __builtin_amdgcn_exp2f(s[e] - mn); ps += p[e]; }
    st.l = st.l * al + ps;
    u32x4 pw; pw.x = pk2(p[0], p[1]); pw.y = pk2(p[2], p[3]); pw.z = pk2(p[4], p[5]); pw.w = pk2(p[6], p[7]);
    const bf16x8 pf = __builtin_bit_cast(bf16x8, pw);
#pragma unroll
    for (int j = 0; j < 4; ++j) st.o[j] = mfma16(vf[j], pf, st.o[j] * al);
}
__device__ __forceinline__ void attn_compute2(AttState& s0, AttState& s1, const bf16x8 (&q0)[2], const bf16x8 (&q1)[2], const AttFrags& f, int fq) {
    bf16x8 vf[4];
#pragma unroll
    for (int j = 0; j < 4; ++j) vf[j] = *(const bf16x8*)(f.vt + (size_t)(16 * j) * f.vp);
    f32x4 a0 = (f32x4){0.f, 0.f, 0.f, 0.f}, b0 = a0, a1 = a0, b1 = a0;
#pragma unroll
    for (int ks = 0; ks < 2; ++ks) { a0 = mfma16(f.k[ks], q0[ks], a0); b0 = mfma16(f.k[2 + ks], q0[ks], b0); a1 = mfma16(f.k[ks], q1[ks], a1); b1 = mfma16(f.k[2 + ks], q1[ks], b1); }
    float x0[8], x1[8]; float g0 = -1e30f, g1 = -1e30f;
#pragma unroll
    for (int i = 0; i < 4; ++i) { x0[i] = a0[i]; x0[4 + i] = b0[i]; x1[i] = a1[i]; x1[4 + i] = b1[i]; }
#pragma unroll
    for (int e = 0; e < 8; ++e) { g0 = fmaxf(g0, x0[e]); g1 = fmaxf(g1, x1[e]); }
    g0 = fmaxf(g0, __shfl_xor(g0, 16)); g1 = fmaxf(g1, __shfl_xor(g1, 16)); g0 = fmaxf(g0, __shfl_xor(g0, 32)); g1 = fmaxf(g1, __shfl_xor(g1, 32));
    const float m0 = fmaxf(s0.m, g0), al0 = __builtin_amdgcn_exp2f(s0.m - m0), m1 = fmaxf(s1.m, g1), al1 = __builtin_amdgcn_exp2f(s1.m - m1); s0.m = m0; s1.m = m1;
    float p0 = 0.f, p1 = 0.f;
#pragma unroll
    for (int e = 0; e < 8; ++e) { x0[e] = __builtin_amdgcn_exp2f(x0[e] - m0); p0 += x0[e]; x1[e] = __builtin_amdgcn_exp2f(x1[e] - m1); p1 += x1[e]; }
    s0.l = s0.l * al0 + p0; s1.l = s1.l * al1 + p1;
    u32x4 w0, w1; w0.x = pk2(x0[0], x0[1]); w0.y = pk2(x0[2], x0[3]); w0.z = pk2(x0[4], x0[5]); w0.w = pk2(x0[6], x0[7]); w1.x = pk2(x1[0], x1[1]); w1.y = pk2(x1[2], x1[3]); w1.z = pk2(x1[4], x1[5]); w1.w = pk2(x1[6], x1[7]);
    const bf16x8 f0 = __builtin_bit_cast(bf16x8, w0), f1 = __builtin_bit_cast(bf16x8, w1);
#pragma unroll
    for (int j = 0; j < 4; ++j) { s0.o[j] = mfma16(vf[j], f0, s0.o[j] * al0); s1.o[j] = mfma16(vf[j], f1, s1.o[j] * al1); }
}
__device__ __forceinline__ void attn_store(const AttState& st, bf16_t* BR, int qrow, int hh, int fq) {
    float l = st.l; l += __shfl_xor(l, 16); l += __shfl_xor(l, 32);
    const float rl = 1.f / l;
#pragma unroll
    for (int j = 0; j < 4; ++j) { u32x2 w; w.x = pk2(st.o[j][0] * rl, st.o[j][1] * rl); w.y = pk2(st.o[j][2] * rl, st.o[j][3] * rl);
        *(u32x2*)(BR + (size_t)qrow * D + hh * 64 + 16 * j + 4 * fq) = w; }
}
__device__ __forceinline__ void attn_phase(const Args& a, int layer, int gw_, int ngw, int lane_) {
    int lane = lane_, gw = gw_; asm volatile("" : "+v"(lane));
    const int fr = lane & 15, fq = lane >> 4;
    const bf16_t* PROJ = (const bf16_t*)(a.ws + WS_PROJ); const bf16_t* TR = (const bf16_t*)(a.ws + WS_TR); bf16_t* BR = (bf16_t*)(a.ws + WS_BR);
    const bf16_t* CK = (const bf16_t*)(a.ws + WS_CK); const bf16_t* CVT = (const bf16_t*)(a.ws + WS_CVT);
    WaveQ Q = waveq_init(a, layer, 0, 3072, 3);
    for (int it_; (it_ = waveq_next(Q, lane)) >= 0; ) {
        int it;
        { const int blk = (it_ & 2047) >> 3, w = it_ & 7, x = blk & 7, sl = (blk >> 3) * 8 + w;
          it = it_ < 2048 ? (x + 8 * (sl >> 6)) * 64 + (sl & 63) : 2048 + (x + 8 * (sl >> 3)) * 8 + (sl & 7); }
        AttState s0, s1; s0.m = -1e30f; s0.l = 0.f; s1.m = -1e30f; s1.l = 0.f;
#pragma unroll
        for (int j = 0; j < 4; ++j) { s0.o[j] = (f32x4){0.f, 0.f, 0.f, 0.f}; s1.o[j] = (f32x4){0.f, 0.f, 0.f, 0.f}; }
        AttFrags fa, fb; bf16x8 q0[2], q1[2];
        if (it < 2048) {
            const int jp = it & 1, r = (it >> 1) & 31, hh = (it >> 6) & 7, b = it >> 9;
            const int seq0 = MP + b * 2048, qrow = seq0 + r * 64 + 32 * jp + fr;
#pragma unroll
            for (int ks = 0; ks < 2; ++ks) { q0[ks] = *(const bf16x8*)(PROJ + (size_t)qrow * PJ + P_Q + hh * 64 + 32 * ks + 8 * fq); q1[ks] = *(const bf16x8*)(PROJ + (size_t)(qrow + 16) * PJ + P_Q + hh * 64 + 32 * ks + 8 * fq); }
            const int rs = min(max(r - 4, 0), 24);
            const float* rpb = a.in[19] + ((size_t)layer * 8 + hh) * 15 * 31;
            const size_t cb = ((size_t)b * DEPTH + layer) * 512; const bf16_t* kc = CK + cb * 512 + hh * 64; const bf16_t* vc = CVT + (cb + hh * 64) * 512;
#pragma unroll 1
            for (int qt = 0; qt < 2; ++qt) { const int jq = 2 * jp + qt, cq = 16 * jq + fr, cs = min(max(cq - 8, 0), 48), kc0 = jq == 0 ? 0 : (jq == 1 ? 8 : (jq == 2 ? 24 : 32));
                const bf16_t* kw = PROJ + (size_t)(seq0 + rs * 64 + kc0) * PJ + P_K + hh * 64; const bf16_t* vw = TR + (size_t)(T_V + hh * 64) * M + seq0 + rs * 64 + kc0;
                AttState& st = qt == 0 ? s0 : s1; const bf16x8 (&qf)[2] = qt == 0 ? q0 : q1;
                attn_load(fa, kw, PJ, vw, M, fr, fq);
#pragma unroll 1
                for (int j = 0; j < 8; j += 2) {
                    attn_load(fb, kw + (size_t)(j + 1) * 64 * PJ, PJ, vw + (j + 1) * 64, M, fr, fq);
                    attn_compute<true>(st, qf, fa, fq, rpb + (rs + j - r + 7) * 31, kc0, cq, cs);
                    if (j + 2 < 8) attn_load(fa, kw + (size_t)(j + 2) * 64 * PJ, PJ, vw + (j + 2) * 64, M, fr, fq);
                    attn_compute<true>(st, qf, fb, fq, rpb + (rs + j + 1 - r + 7) * 31, kc0, cq, cs);
                }
            }
            attn_load(fa, kc, 512, vc, 512, fr, fq);
#pragma unroll 1
            for (int g = 0; g < 16; g += 2) {
                attn_load(fb, kc + (size_t)(32 * (g + 1)) * 512, 512, vc + 32 * (g + 1), 512, fr, fq);
                attn_compute2(s0, s1, q0, q1, fa, fq);
                if (g + 2 < 16) attn_load(fa, kc + (size_t)(32 * (g + 2)) * 512, 512, vc + 32 * (g + 2), 512, fr, fq);
                attn_compute2(s0, s1, q0, q1, fb, fq);
            }
            attn_store(s0, BR, qrow, hh, fq); attn_store(s1, BR, qrow + 16, hh, fq);
        } else {
            const int i2 = it - 2048, qp = i2 & 7, hh = (i2 >> 3) & 7, b = i2 >> 6, seq0 = b * 256, qrow = seq0 + 32 * qp + fr;
#pragma unroll
            for (int ks = 0; ks < 2; ++ks) { q0[ks] = *(const bf16x8*)(PROJ + (size_t)qrow * PJ + P_Q + hh * 64 + 32 * ks + 8 * fq); q1[ks] = *(const bf16x8*)(PROJ + (size_t)(qrow + 16) * PJ + P_Q + hh * 64 + 32 * ks + 8 * fq); }
            const bf16_t* kp = PROJ + (size_t)seq0 * PJ + P_K + hh * 64; const bf16_t* vp = TR + (size_t)(T_V + hh * 64) * M + seq0;
            attn_load(fa, kp, PJ, vp, M, fr, fq);
#pragma unroll 1
            for (int g = 0; g < 8; g += 2) {
                attn_load(fb, kp + (size_t)(32 * (g + 1)) * PJ, PJ, vp + 32 * (g + 1), M, fr, fq);
                attn_compute2(s0, s1, q0, q1, fa, fq);
                if (g + 2 < 8) attn_load(fa, kp + (size_t)(32 * (g + 2)) * PJ, PJ, vp + 32 * (g + 2), M, fr, fq);
                attn_compute2(s0, s1, q0, q1, fb, fq);
            }
            attn_store(s0, BR, qrow, hh, fq); attn_store(s1, BR, qrow + 16, hh, fq);
        }
    }
}
}
namespace mk {
constexpr int S5K = 768;
constexpr size_t WS_S5W = WS_ATT_END;
constexpr size_t WS_S5WS = AL(WS_S5W + (size_t)DEPTH * 32 * 512 * S5K * 2);
constexpr size_t WS_S5AP = AL(WS_S5WS + (size_t)DEPTH * 32 * 256 * 512 * 2);
constexpr size_t WS_S5UP = AL(WS_S5AP + (size_t)DEPTH * 32 * 2 * 64 * 2 * 4);
constexpr size_t WS_S5SS = AL(WS_S5UP + (size_t)32 * 384 * 512 * 2);
constexpr size_t WS_S5HS = AL(WS_S5SS + (size_t)32 * 384 * 256 * 4);
constexpr size_t WS_S5_END = AL(WS_S5HS + (size_t)32 * 384 * 256 * 2);

__device__ __forceinline__ void s5_param_task(const Args& a, LAS unsigned char* lds, int tid_, int task) {
    int tid = tid_; asm volatile("" : "+v"(tid));
    LAS float* PW = (LAS float*)lds; LAS float* BB = PW + 2 * 33 * 64 * 2; LAS float* CC = BB + 2 * 64 * 16 * 2; LAS float* KT = CC + 2 * 16 * 64 * 2;
    {
        const int layer = task >> 5, g = task & 31;
        const float* a_re = a.in[20] + layer * 4096; const float* a_im = a.in[21] + layer * 4096; const float* log_dt = a.in[22] + layer * 64;
        const float* b_re = a.in[23] + (size_t)layer * 65536; const float* b_im = a.in[24] + (size_t)layer * 65536; const float* c_re = a.in[25] + (size_t)layer * 65536; const float* c_im = a.in[26] + (size_t)layer * 65536;
        const float* s5d = a.in[27] + layer * 512;
        bf16_t* S5W = (bf16_t*)(a.ws + WS_S5W) + (size_t)layer * 32 * 512 * S5K; bf16_t* S5WS = (bf16_t*)(a.ws + WS_S5WS) + (size_t)layer * 32 * 256 * 512; float* S5AP = (float*)(a.ws + WS_S5AP) + (size_t)layer * 32 * 2 * 64 * 2;
        __syncthreads();
        if (tid < 128) { const int dir = tid >> 6, n = tid & 63, pi = (dir * 32 + g) * 64 + n;
            const float are = fminf(a_re[pi], -1e-4f), aim = a_im[pi], dt = expf(log_dt[dir * 32 + g]);
            const float mag = expf(dt * are), abr = mag * cosf(dt * aim), abi = mag * sinf(dt * aim);
            const float den = are * are + aim * aim, nr = abr - 1.f, cfr = (nr * are + abi * aim) / den, cfi = (abi * are - nr * aim) / den;
            float pr = 1.f, pim = 0.f;
            for (int p = 0; p <= 32; ++p) { PW[((dir * 33 + p) * 64 + n) * 2] = pr; PW[((dir * 33 + p) * 64 + n) * 2 + 1] = pim; const float t = pr * abr - pim * abi; pim = pr * abi + pim * abr; pr = t; }
            S5AP[((g * 2 + dir) * 64 + n) * 2] = PW[((dir * 33 + 32) * 64 + n) * 2]; S5AP[((g * 2 + dir) * 64 + n) * 2 + 1] = PW[((dir * 33 + 32) * 64 + n) * 2 + 1];
            for (int k = 0; k < 16; ++k) { const float br_ = b_re[(size_t)pi * 16 + k], bi_ = b_im[(size_t)pi * 16 + k];
                BB[((dir * 64 + n) * 16 + k) * 2] = cfr * br_ - cfi * bi_; BB[((dir * 64 + n) * 16 + k) * 2 + 1] = cfr * bi_ + cfi * br_; }
            for (int j = 0; j < 16; ++j) { CC[((dir * 64 + n) * 16 + j) * 2] = c_re[((size_t)(dir * 32 + g) * 16 + j) * 64 + n]; CC[((dir * 64 + n) * 16 + j) * 2 + 1] = c_im[((size_t)(dir * 32 + g) * 16 + j) * 64 + n]; }
        }
        __syncthreads();
        { const int lane = tid & 63, wave = tid >> 6, r16 = lane & 15, q4 = lane >> 4;
          for (int pt = wave; pt < 64; pt += NWV) { const int dir = pt >> 5, tau = pt & 31; f32x4 acc = (f32x4){0.f, 0.f, 0.f, 0.f};
#pragma unroll 4
            for (int ks = 0; ks < 16; ++ks) { const int n = 4 * ks + q4;
                const float cr = CC[((dir * 64 + n) * 16 + r16) * 2], ci = CC[((dir * 64 + n) * 16 + r16) * 2 + 1], pr = PW[((dir * 33 + tau) * 64 + n) * 2], pim = PW[((dir * 33 + tau) * 64 + n) * 2 + 1];
                const float xr = cr * pr - ci * pim, xi = cr * pim + ci * pr, br_ = BB[((dir * 64 + n) * 16 + r16) * 2], bi_ = BB[((dir * 64 + n) * 16 + r16) * 2 + 1];
                acc = __builtin_amdgcn_mfma_f32_16x16x4f32(xr, br_, acc, 0, 0, 0); acc = __builtin_amdgcn_mfma_f32_16x16x4f32(-xi, bi_, acc, 0, 0, 0); }
#pragma unroll
            for (int i = 0; i < 4; ++i) KT[((dir * 32 + tau) * 16 + r16) * 16 + 4 * q4 + i] = acc[i]; } }
        __syncthreads();
        { const int t = tid >> 4, j = tid & 15; bf16_t* dst = S5W + ((size_t)g * 512 + tid) * S5K;
            for (int s = 0; s < 32; ++s) { float v[16];
#pragma unroll
                for (int k = 0; k < 16; ++k) { float x;
                    if (s < t) x = KT[((0 * 32 + (t - s)) * 16 + k) * 16 + j]; else if (s > t) x = KT[((1 * 32 + (s - t)) * 16 + k) * 16 + j];
                    else x = KT[((0 * 32 + 0) * 16 + k) * 16 + j] + KT[((1 * 32 + 0) * 16 + k) * 16 + j] + (k == j ? s5d[g * 16 + k] : 0.f);
                    v[k] = x; }
                u32x4 o0, o1; o0.x = pk2(v[0], v[1]); o0.y = pk2(v[2], v[3]); o0.z = pk2(v[4], v[5]); o0.w = pk2(v[6], v[7]); o1.x = pk2(v[8], v[9]); o1.y = pk2(v[10], v[11]); o1.z = pk2(v[12], v[13]); o1.w = pk2(v[14], v[15]);
                *(u32x4*)(dst + s * 16) = o0; *(u32x4*)(dst + s * 16 + 8) = o1; }
            for (int dir = 0; dir < 2; ++dir) { const int p = dir == 0 ? t + 1 : 32 - t;
                for (int n8 = 0; n8 < 8; ++n8) { float gr[8], gi[8];
#pragma unroll
                    for (int q = 0; q < 8; ++q) { const int n = n8 * 8 + q; const float cr = CC[((dir * 64 + n) * 16 + j) * 2], ci = CC[((dir * 64 + n) * 16 + j) * 2 + 1], pr = PW[((dir * 33 + p) * 64 + n) * 2], pim = PW[((dir * 33 + p) * 64 + n) * 2 + 1];
                        gr[q] = cr * pr - ci * pim; gi[q] = -(cr * pim + ci * pr); }
                    u32x4 o; o.x = pk2(gr[0], gr[1]); o.y = pk2(gr[2], gr[3]); o.z = pk2(gr[4], gr[5]); o.w = pk2(gr[6], gr[7]); *(u32x4*)(dst + 512 + dir * 128 + n8 * 8) = o;
                    o.x = pk2(gi[0], gi[1]); o.y = pk2(gi[2], gi[3]); o.z = pk2(gi[4], gi[5]); o.w = pk2(gi[6], gi[7]); *(u32x4*)(dst + 512 + dir * 128 + 64 + n8 * 8) = o; } }
        }
        if (tid < 256) { const int dir = tid >> 7, reim = (tid >> 6) & 1, n = tid & 63; bf16_t* dst = S5WS + ((size_t)g * 256 + tid) * 512;
            for (int s = 0; s < 32; ++s) { const int p = dir == 0 ? 31 - s : s; const float pr = PW[((dir * 33 + p) * 64 + n) * 2], pim = PW[((dir * 33 + p) * 64 + n) * 2 + 1]; float v[16];
#pragma unroll
                for (int k = 0; k < 16; ++k) { const float br_ = BB[((dir * 64 + n) * 16 + k) * 2], bi_ = BB[((dir * 64 + n) * 16 + k) * 2 + 1]; v[k] = reim == 0 ? pr * br_ - pim * bi_ : pr * bi_ + pim * br_; }
                u32x4 o0, o1; o0.x = pk2(v[0], v[1]); o0.y = pk2(v[2], v[3]); o0.z = pk2(v[4], v[5]); o0.w = pk2(v[6], v[7]); o1.x = pk2(v[8], v[9]); o1.y = pk2(v[10], v[11]); o1.z = pk2(v[12], v[13]); o1.w = pk2(v[14], v[15]);
                *(u32x4*)(dst + s * 16) = o0; *(u32x4*)(dst + s * 16 + 8) = o1; } }
    }
    __syncthreads();
}
__device__ __forceinline__ void s5_statein_phase(const Args& a, int layer, int gw, int ngw, int lane_) {
    int lane = lane_; asm volatile("" : "+v"(lane));
    const int fr = lane & 15, fq = lane >> 4;
    const bf16_t* UP = (const bf16_t*)(a.ws + WS_S5UP); const bf16_t* S5WS = (const bf16_t*)(a.ws + WS_S5WS) + (size_t)layer * 32 * 256 * 512; float* SS = (float*)(a.ws + WS_S5SS);
    WaveQ Q = waveq_init(a, layer, 3, 32 * 24, 3, 3072 + 1536);
    for (int it; (it = waveq_next(Q, lane)) >= 0; ) {
        const int c_ = it + 4608, blk = (c_ & 2047) >> 3, sl = ((blk - 64) >> 3) * 8 + (c_ & 7);
        const int g = (blk & 7) + 8 * (sl / 24), r = sl % 24, og = r / 6, cq = r % 6;
        f32x4 acc[4][4];
#pragma unroll
        for (int i = 0; i < 4; ++i)
#pragma unroll
            for (int j = 0; j < 4; ++j) acc[i][j] = (f32x4){0.f, 0.f, 0.f, 0.f};
        const bf16_t* ap = S5WS + ((size_t)g * 256 + 64 * og + fr) * 512 + 8 * fq; const bf16_t* bp = UP + ((size_t)g * 384 + 64 * cq + fr) * 512 + 8 * fq;
#pragma unroll 2
        for (int ks = 0; ks < 16; ++ks) { bf16x8 af[4], bf[4];
#pragma unroll
            for (int i = 0; i < 4; ++i) { af[i] = *(const bf16x8*)(ap + (size_t)16 * i * 512 + 32 * ks); bf[i] = *(const bf16x8*)(bp + (size_t)16 * i * 512 + 32 * ks); }
#pragma unroll
            for (int i = 0; i < 4; ++i)
#pragma unroll
                for (int j = 0; j < 4; ++j) acc[i][j] = mfma16(af[i], bf[j], acc[i][j]); }
#pragma unroll
        for (int i = 0; i < 4; ++i)
#pragma unroll
            for (int j = 0; j < 4; ++j) *(f32x4*)(SS + ((size_t)g * 384 + 64 * cq + 16 * j + fr) * 256 + 64 * og + 16 * i + 4 * fq) = acc[i][j];
    }
}
__device__ __forceinline__ void s5_scan_phase(const Args& a, int layer, int gw, int ngw, int lane_) {
    int lane = lane_; asm volatile("" : "+v"(lane));
    const float* SS = (const float*)(a.ws + WS_S5SS); bf16_t* HS = (bf16_t*)(a.ws + WS_S5HS); const float* S5AP = (const float*)(a.ws + WS_S5AP) + (size_t)layer * 32 * 2 * 64 * 2;
    for (int task = gw; task < 1280; task += ngw) {
        int sq, g, dir; if (task < 256) { sq = 16 + (task >> 6); g = (task >> 1) & 31; dir = task & 1; } else { const int t2 = task - 256; sq = t2 >> 6; g = (t2 >> 1) & 31; dir = t2 & 1; }
        const int lat = sq >= 16, b = lat ? sq - 16 : sq, nc = lat ? 64 : 8, cg0 = lat ? 128 + b * 64 : b * 8;
        const float apr = S5AP[((g * 2 + dir) * 64 + lane) * 2], api = S5AP[((g * 2 + dir) * 64 + lane) * 2 + 1];
        float hr = 0.f, hi = 0.f;
        if (lat) { const size_t so = ((((size_t)b * DEPTH + layer) * 2 + dir) * 32 + g) * 64 + lane; hr = a.in[4][so]; hi = a.in[5][so]; }
        for (int s0 = 0; s0 < nc; s0 += 8) {
            float sr[8], si[8];
#pragma unroll
            for (int q = 0; q < 8; ++q) { const int cg = cg0 + (dir ? nc - 1 - (s0 + q) : s0 + q); const size_t base = ((size_t)g * 384 + cg) * 256 + dir * 128; sr[q] = SS[base + lane]; si[q] = SS[base + 64 + lane]; }
#pragma unroll
            for (int q = 0; q < 8; ++q) { const int cg = cg0 + (dir ? nc - 1 - (s0 + q) : s0 + q); const size_t base = ((size_t)g * 384 + cg) * 256 + dir * 128;
                HS[base + lane] = f2bf(hr); HS[base + 64 + lane] = f2bf(hi);
                const float t = apr * hr - api * hi + sr[q]; hi = apr * hi + api * hr + si[q]; hr = t; }
        }
        if (!lat) { const size_t oo = ((((size_t)b * DEPTH + layer) * 2 + dir) * 32 + g) * 64 + lane; a.out[O_S5R + oo] = hr; a.out[O_S5I + oo] = hi; }
    }
}
__device__ __forceinline__ void s5_out_phase(const Args& a, int layer, int gw, int ngw, int lane_) {
    int lane = lane_; asm volatile("" : "+v"(lane));
    const int fr = lane & 15, fq = lane >> 4;
    const bf16_t* UP = (const bf16_t*)(a.ws + WS_S5UP); const bf16_t* S5W = (const bf16_t*)(a.ws + WS_S5W) + (size_t)layer * 32 * 512 * S5K; const bf16_t* HS = (const bf16_t*)(a.ws + WS_S5HS); bf16_t* ZB = (bf16_t*)(a.ws + WS_ZB);
    WaveQ Q = waveq_init(a, layer, 6, 32 * 48, 3, NCH * 4 * 4);
    for (int it; (it = waveq_next(Q, lane)) >= 0; ) {
        const int c_ = it + 1536, blk = (c_ & 2047) >> 3, sl = blk >= 192 ? ((blk - 192) >> 3) * 8 + (c_ & 7) : 64 + (blk >> 3) * 8 + (c_ & 7);
        const int g = (blk & 7) + 8 * (sl / 48), r = sl % 48, og = r / 6, cq = r % 6;
        f32x4 acc[4][4];
#pragma unroll
        for (int i = 0; i < 4; ++i)
#pragma unroll
            for (int j = 0; j < 4; ++j) acc[i][j] = (f32x4){0.f, 0.f, 0.f, 0.f};
        const bf16_t* ap = S5W + ((size_t)g * 512 + 64 * og + fr) * S5K + 8 * fq;
        const bf16_t* bp = UP + ((size_t)g * 384 + 64 * cq + fr) * 512 + 8 * fq; const bf16_t* hp = HS + ((size_t)g * 384 + 64 * cq + fr) * 256 + 8 * fq;
#pragma unroll 2
        for (int ks = 0; ks < 16; ++ks) { bf16x8 af[4], bf[4];
#pragma unroll
            for (int i = 0; i < 4; ++i) { af[i] = *(const bf16x8*)(ap + (size_t)16 * i * S5K + 32 * ks); bf[i] = *(const bf16x8*)(bp + (size_t)16 * i * 512 + 32 * ks); }
#pragma unroll
            for (int i = 0; i < 4; ++i)
#pragma unroll
                for (int j = 0; j < 4; ++j) acc[i][j] = mfma16(af[i], bf[j], acc[i][j]); }
#pragma unroll 2
        for (int ks = 0; ks < 8; ++ks) { bf16x8 af[4], bf[4];
#pragma unroll
            for (int i = 0; i < 4; ++i) { af[i] = *(const bf16x8*)(ap + (size_t)16 * i * S5K + 512 + 32 * ks); bf[i] = *(const bf16x8*)(hp + (size_t)16 * i * 256 + 32 * ks); }
#pragma unroll
            for (int i = 0; i < 4; ++i)
#pragma unroll
                for (int j = 0; j < 4; ++j) acc[i][j] = mfma16(af[i], bf[j], acc[i][j]); }
#pragma unroll
        for (int i = 0; i < 4; ++i)
#pragma unroll
            for (int j = 0; j < 4; ++j) { float z[4];
#pragma unroll
                for (int e = 0; e < 4; ++e) { const float x = acc[i][j][e]; const float th = 0.7978845608028654f * (x + 0.044715f * x * x * x); const float e2 = __expf(2.f * th); const float tnh = 1.f - 2.f * __builtin_amdgcn_rcpf(e2 + 1.f); z[e] = 0.5f * x * (1.f + tnh); }
                u32x2 w; w.x = pk2(z[0], z[1]); w.y = pk2(z[2], z[3]);
                *(u32x2*)(ZB + (size_t)(32 * (64 * cq + 16 * j + fr) + 4 * og + i) * 512 + g * 16 + 4 * fq) = w; }
    }
}
}
namespace mk { static_assert(WS_S5_END < (size_t)1780 * 1024 * 1024, "workspace map exceeds the guaranteed size"); }
namespace mk {
#ifndef PHMASK
#define PHMASK 0xfffff
#endif
#define PHM(k) ((PHMASK >> (k)) & 1)
#ifndef DUPMASK
#define DUPMASK 0
#endif
#define DUP(k) ((DUPMASK >> (k)) & 1)
constexpr int NPH = 12;
constexpr int PH_TOTAL = 2 + DEPTH * NPH;
__global__ void __launch_bounds__(NT, 2) mk_fwd(Args a) {
    extern __shared__ __attribute__((aligned(16))) unsigned char lds_raw[];
    LAS unsigned char* lds = (LAS unsigned char*)lds_raw;
#define TID ((int)threadIdx.x)
#define LANE ((int)(threadIdx.x & 63))
#define WAVE (__builtin_amdgcn_readfirstlane((int)(threadIdx.x >> 6)))
#define GW ((int)blockIdx.x * NWV + WAVE)
    const int G = gridDim.x, ngw = G * NWV;
    volatile LAS unsigned* ctlw = (volatile LAS unsigned*)(lds + LDS_CTL);
    if (TID < 64) ctlw[TID] = 0u;
    __syncthreads();
    XcdBarrier bar = xcd_barrier_post((unsigned*)(a.ws + WS_CTL), ctlw);
    if (TPROBE >= 0 && TID == 0) { const unsigned long long t_ = wall_clock64(); ctlw[16] = (unsigned)t_; ctlw[17] = (unsigned)(t_ >> 32); }
    const int lo = a.ph_lo; int hi = a.ph_hi;
#define IN(k) (lo <= (k) && (k) < hi)
#ifndef TPROBE
#define TPROBE -1
#endif
#define TSTAMP(kind) do { if (TPROBE >= 0 && blockIdx.x == 0 && TID == 0) { const unsigned long long t_ = wall_clock64(); const unsigned long long p_ = ((unsigned long long)ctlw[17] << 32) | ctlw[16]; \
    volatile LAS float* ta_ = (volatile LAS float*)(ctlw + 24); ta_[kind] = ta_[kind] + (float)(t_ - p_); ctlw[16] = (unsigned)t_; ctlw[17] = (unsigned)(t_ >> 32); } } while (0)
#define SEAM(k) do { if (IN(k) && IN((k) + 1)) { xcd_barrier(bar); if (DUP(13)) xcd_barrier(bar); TSTAMP((k) == 0 ? 0 : 1 + ((k) - 1) % NPH); } } while (0)
#define H ((bf16_t*)(a.ws + WS_H))
#define PROJ ((bf16_t*)(a.ws + WS_PROJ))
#define SMALL ((float*)(a.ws + WS_SMALL))
#define BR ((bf16_t*)(a.ws + WS_BR))
#define MERGED ((bf16_t*)(a.ws + WS_MERGED))
#define MACC ((float*)(a.ws + WS_MACC))
#define ZB ((bf16_t*)(a.ws + WS_ZB))
#define HID ((bf16_t*)(a.ws + WS_PROJ))
#define MOD ((const float*)(a.ws + WS_MOD))
#define X (a.out)
    if (PHM(0) && IN(0)) {
        for (int it = GW; it < CM_ITEMS / DEPTH; it += ngw) colmax_item(a, (unsigned*)(a.ws + WS_WSC), it, LANE);
        xcd_barrier(bar);
        for (int rep_ = 0; rep_ < 1 + DUP(17); ++rep_) {
        unsigned* qhead = (unsigned*)(a.ws + WS_CTL) + 8192 + 64 * rep_;
        volatile LAS unsigned* qitem = ctlw + 8;
        for (;;) {
            __syncthreads();
            if (TID == 0) qitem[0] = __hip_atomic_fetch_add(qhead, 1u, __ATOMIC_RELAXED, __HIP_MEMORY_SCOPE_AGENT);
            __syncthreads();
            int item = (int)qitem[0];
            if (item >= DEPTH * 32 + PRO_NADA + PRO_NCACHE) break;
            if (item < DEPTH * 32) { s5_param_task(a, lds, TID, item); continue; } item -= DEPTH * 32;
            if (item < PRO_NADA) { prologue_ada_unit(a, lds, TID, item); continue; } item -= PRO_NADA;
            prologue_cache(a, item * NWV + WAVE, PRO_NCACHE * NWV, LANE);
        }
        }
        conv_pull(a, lds, ctlw + 8, 0, -1);
        if (DUP(20)) conv_pull(a, lds, ctlw + 8, 0, -1, 16);
    }
    SEAM(0);
#ifndef NREP
#define NREP 1
#endif
#ifndef PPASS
#define PPASS 1000
#endif
    for (int rep_ = 0; rep_ < NREP; ++rep_) {
    if (rep_ > 0) xcd_barrier(bar);
    hi = (NREP == 2 && rep_ == 0 && 1 + PPASS < a.ph_hi) ? 1 + PPASS : a.ph_hi;
    for (int l = 0; l < DEPTH; ++l) {
        const int pb = 1 + l * NPH;
#define xp (l == 0 ? a.in[0] : X)
#define xs (l == 0 ? a.in[1] : X + (size_t)MP * D)
#define modl (MOD + (size_t)l * 5 * 6 * D)
#define wl ((const bf16_t*)(a.ws + WS_W) + (size_t)l * W_LAYER)
        if (PHM(1) && IN(pb + 0) && l > 0) conv_pull(a, lds, ctlw + 8, l, -1);
        if (PHM(1) && IN(pb + 0)) for (int r_ = 0; r_ < 1 + DUP(11); ++r_) norm_phase(xp, xs, a.in[14] + l * D, modl, 0, D, H, GW, ngw, LANE, l > 0 ? MACC : nullptr, modl - (size_t)5 * 6 * D, 5 * D, X, xs, a.ws + WS_H8);
        SEAM(pb + 0);
        if (PHM(2) && IN(pb + 1)) {
            { Gemm g{H, wl + W_IN, M, 5888, D, D, 1, 0, 0}; StaticOrder S; S.init(M, 5888, G, blockIdx.x, 1, D);
              EpiInT<false> E{PROJ, SMALL, a.out, a.in[17] + l * 64, a.in[18] + l * 64, l, (bf16_t*)(a.ws + WS_S5UP)}; for (int r_ = 0; r_ < 1 + DUP(18); ++r_) gemm_phase(lds, g, S, E); }
            if (l + 1 < DEPTH && (int)blockIdx.x >= 80) {
                int ln_ = LANE; asm volatile("" : "+v"(ln_));
                for (int it = ((int)blockIdx.x - 80) * NWV + WAVE; it < CM_ITEMS / DEPTH; it += 176 * NWV) colmax_item(a, (unsigned*)(a.ws + WS_WSC), (l + 1) * (CM_ITEMS / DEPTH) + it, ln_);
                conv_pull(a, lds, ctlw + 8, l + 1, 1); } }
        SEAM(pb + 1);
        if (PHM(3) && IN(pb + 2)) { for (int r_ = 0; r_ < 1 + DUP(0); ++r_) { prep_phase(a, l, lds, GW, ngw, WAVE, LANE, (bf16_t*)(a.ws + WS_S5UP)); __syncthreads(); } }
        SEAM(pb + 2);
        if (PHM(4) && IN(pb + 3)) { for (int r_ = 0; r_ < 1 + DUP(2); ++r_) attn_phase(a, l, GW, ngw, LANE); for (int r_ = 0; r_ < 1 + DUP(3); ++r_) { ml_states_phase(a, l, TID, G); ssd_states_phase(a, l, TID, G); s5_statein_phase(a, l, GW, ngw, LANE); } }
        SEAM(pb + 3);
        if (PHM(5) && IN(pb + 4)) { for (int r_ = 0; r_ < 1 + DUP(4); ++r_) { ml_scan_phase(a, l, TID, G); ssd_scan_phase(a, l, TID, G); s5_scan_phase(a, l, GW, ngw, LANE); } }
        SEAM(pb + 4);
        if (PHM(12) && IN(pb + 5)) { for (int r_ = 0; r_ < 1 + DUP(5); ++r_) ml_out_phase(a, l, lds, GW, ngw, LANE); for (int r_ = 0; r_ < 1 + DUP(6); ++r_) ssd_out_phase(a, l, GW, ngw, LANE); for (int r_ = 0; r_ < 1 + DUP(7); ++r_) s5_out_phase(a, l, GW, ngw, LANE); }
        SEAM(pb + 5);
        if (PHM(6) && IN(pb + 6)) {
            { Gemm g8{(const bf16_t*)(a.ws + WS_H8), wl + W_IN8, M, 8192, 1024, 1024, 1, 0, 0}; StaticOrder S; S.init(M, 8192, G, blockIdx.x, 1, 1024);
              EpiInT<true> E{PROJ, SMALL, a.out, a.in[17] + l * 64, a.in[18] + l * 64, l, (bf16_t*)(a.ws + WS_S5UP)}; for (int r_ = 0; r_ < 1 + DUP(9); ++r_) gemm_phase(lds, g8, S, E); }
        }
        if (PHM(6) && IN(pb + 6)) { Gemm g{ZB, wl + W_GLU, M, 512, 512, 512, 1, 0, 0}; StaticOrder S; S.init(M, 512, G, blockIdx.x, 1, 512);
            EpiGlu E{ZB, a.in[29] + l * 512, BR}; for (int r_ = 0; r_ < 1 + DUP(16); ++r_) gemm_phase(lds, g, S, E); for (int r_ = 0; r_ < 1 + DUP(16); ++r_) ssd_fin_phase(a, l, GW, ngw, LANE); }
        SEAM(pb + 6);
        if (PHM(7) && IN(pb + 7)) { Gemm g{BR, wl + W_BR, M, D, 512, D, 4, 512, (size_t)D * 512}; StaticOrder S; S.init(M, D, G, blockIdx.x, 4, 512);
            EpiBranch E{PROJ, MERGED}; for (int r_ = 0; r_ < 1 + DUP(12); ++r_) gemm_phase(lds, g, S, E);
            if (l + 1 < DEPTH && (int)blockIdx.x >= 128) conv_pull(a, lds, ctlw + 8, l + 1, 3); }
        SEAM(pb + 7);
        if (PHM(8) && IN(pb + 8)) { Gemm g{MERGED, wl + W_OUT, M, D, D, D, 1, 0, 0}; SplitOrder S; S.init(blockIdx.x, D);
            EpiResid E{xp, xs, modl, 2 * D, X, MACC}; if (DUP(14)) { EpiResid E2{xp, xs, modl, 2 * D, (float*)(a.ws + WS_PROJ), MACC}; gemm_phase(lds, g, S, E2); } gemm_phase(lds, g, S, E); }
        SEAM(pb + 8);
        if (PHM(9) && IN(pb + 9)) for (int r_ = 0; r_ < 1 + DUP(19); ++r_) norm_phase(X, X + (size_t)MP * D, a.in[15] + l * D, modl, 3 * D, 4 * D, nullptr, GW, ngw, LANE, MACC, modl, 2 * D, X, xs, nullptr, a.ws + WS_H8, (float*)(a.ws + WS_RSC));
        SEAM(pb + 9);
        if (PHM(10) && IN(pb + 10)) { Gemm g{(const bf16_t*)(a.ws + WS_H8), wl + W_1, M, DFF, 1024, 1024, 1, 0, 0}; StaticOrder S; S.init(M, DFF, G, blockIdx.x, 1, 1024);
            EpiRelu2 E{HID, DFF, (const float*)(a.ws + WS_RSC), (const float*)(a.ws + WS_WSC) + (size_t)l * DFF}; for (int r_ = 0; r_ < 1 + DUP(10); ++r_) gemm_phase(lds, g, S, E); }
        SEAM(pb + 10);
        if (PHM(11) && IN(pb + 11)) { Gemm g{HID, wl + W_2, M, D, DFF, DFF, 1, 0, 0, 1}; SplitOrder S; S.init(blockIdx.x, DFF);
            EpiResid E{X, X + (size_t)MP * D, modl, 5 * D, X, MACC}; if (DUP(15)) { EpiResid E2{X, X + (size_t)MP * D, modl, 5 * D, (float*)(a.ws + WS_BR), MACC}; gemm_phase(lds, g, S, E2); } gemm_phase(lds, g, S, E); }
        SEAM(pb + 11);
    }
    if (IN(1 + DEPTH * NPH)) final_fix_phase(MACC, MOD + (size_t)(DEPTH - 1) * 5 * 6 * D, 5 * D, X, GW, ngw, LANE);
    }
    if (TPROBE >= 0) { xcd_barrier(bar); TSTAMP(13); if (blockIdx.x == 0 && TID == 0) { volatile LAS float* ta_ = (volatile LAS float*)(ctlw + 24); float tot_ = 0.f; for (int q_ = 0; q_ < 14; ++q_) tot_ += ta_[q_]; a.out[0] = (TPROBE == 99 ? tot_ : ta_[TPROBE]) * 10.f; } }
#undef IN
#undef SEAM
#undef H
#undef PROJ
#undef SMALL
#undef BR
#undef MERGED
#undef MACC
#undef ZB
#undef HID
#undef MOD
#undef X
#undef xp
#undef xs
#undef modl
#undef wl
}
}
extern "C" void kernel_launch(void* const* d_in, const int* in_sizes, int n_in, void* d_out, int out_size, void* d_ws, size_t ws_size, hipStream_t stream) {
    static int grid = 0;
    if (grid == 0) {
        int dev = 0, cus = 0; (void)hipGetDevice(&dev); (void)hipDeviceGetAttribute(&cus, hipDeviceAttributeMultiprocessorCount, dev);
        (void)hipFuncSetAttribute((const void*)mk::mk_fwd, hipFuncAttributeMaxDynamicSharedMemorySize, mk::LDS_BYTES);
        int per_cu = 0; (void)hipOccupancyMaxActiveBlocksPerMultiprocessor(&per_cu, (const void*)mk::mk_fwd, mk::NT, mk::LDS_BYTES); (void)hipGetLastError();
        (void)cus; grid = 256;
    }
    mk::Args a{}; for (int i = 0; i < 43; ++i) a.in[i] = (const float*)d_in[i];
    a.out = (float*)d_out; a.ws = (unsigned char*)d_ws; a.ph_lo = 0; a.ph_hi = mk::PH_TOTAL;
    (void)hipMemsetAsync(a.ws + mk::WS_CTL, 0, mk::CTL_BYTES, stream);
    hipLaunchKernelGGL(mk::mk_fwd, dim3(grid), dim3(mk::NT), mk::LDS_BYTES, stream, a);
}
```
